# Optimizing an MI355X kernel written in HIP

```python
import math
import jax, jax.numpy as jnp
from jax import lax
import numpy as np

D_MODEL = 1024
BATCH = 2
SEQ = 8192
DEPTH = 2

CHUNK = 64
N_MIXERS = 2
N_A_LAYERS = (DEPTH + 1) // 2
N_B_LAYERS = DEPTH // 2
EPS = 1e-6

RET_HEADS = 4
RET_QK_DIM = D_MODEL // RET_HEADS
RET_V_DIM = 2 * RET_QK_DIM
RET_V_WIDTH = RET_HEADS * RET_V_DIM
RET_IN_WIDTH = 2 * D_MODEL + 2 * RET_V_WIDTH
ROPE_BASE = 10000.0

SGU_BLOCK = 128
SGU_GROUPS = 8
SGU_FFN = 6 * D_MODEL
SGU_HALF = SGU_FFN // 2
SGU_GROUP_DIM = SGU_HALF // SGU_GROUPS

PEER_HEADS = 8
PEER_NKEYS = 128
PEER_EXPERTS = PEER_NKEYS * PEER_NKEYS
PEER_KEY_DIM = 256
PEER_HALF = PEER_KEY_DIM // 2
PEER_TOPK = 16
PEER_TOKEN_BLOCK = 128

kernel_name = "hybrid_retention_sgu_peer_adaln"


def rmsnorm(x, gain):
    x32 = x.astype(jnp.float32)
    y = x32 * lax.rsqrt(jnp.mean(x32 * x32, axis=-1, keepdims=True) + EPS)
    return (y * gain.astype(jnp.float32)).astype(x.dtype)


def layernorm(x, gain, bias):
    x32 = x.astype(jnp.float32)
    mu = jnp.mean(x32, axis=-1, keepdims=True)
    xc = x32 - mu
    y = xc * lax.rsqrt(jnp.mean(xc * xc, axis=-1, keepdims=True) + EPS)
    return (y * gain.astype(jnp.float32) + bias.astype(jnp.float32)).astype(x.dtype)


def modulate(h, shift, scale):
    return h * (1 + scale[:, None, :]) + shift[:, None, :]


def rotary(x, positions):
    half = x.shape[-1] // 2
    inv_freq = 1.0 / (ROPE_BASE ** (jnp.arange(half, dtype=jnp.float32) / half))
    ang = positions.astype(jnp.float32)[..., None] * inv_freq
    cos = jnp.cos(ang)[:, :, None, :]
    sin = jnp.sin(ang)[:, :, None, :]
    x32 = x.astype(jnp.float32)
    x1, x2 = x32[..., :half], x32[..., half:]
    return jnp.concatenate([x1 * cos - x2 * sin, x1 * sin + x2 * cos], axis=-1)


def retention_mixer(h, positions, w_in, w_out):
    B, S, _ = h.shape
    nc = S // CHUNK
    H, Dk, Dv = RET_HEADS, RET_QK_DIM, RET_V_DIM
    proj = h @ w_in
    q, k, v, g = jnp.split(proj, [D_MODEL, 2 * D_MODEL, 2 * D_MODEL + RET_V_WIDTH], axis=-1)
    q = rotary(q.reshape(B, S, H, Dk), positions)
    k = rotary(k.reshape(B, S, H, Dk), positions) * (Dk ** -0.5)
    v = v.reshape(B, S, H, Dv).astype(jnp.float32)
    log_gamma = jnp.log(1.0 - 2.0 ** (-5.0 - jnp.arange(H, dtype=jnp.float32)))
    idx = jnp.arange(CHUNK, dtype=jnp.float32)
    d_intra = jnp.exp(log_gamma[:, None, None] * jnp.abs(idx[:, None] - idx[None, :]))
    xi = jnp.exp(log_gamma[None, :] * (idx[:, None] + 1.0))
    zeta = jnp.exp(log_gamma[None, :] * (CHUNK - 1.0 - idx[:, None]))
    gamma_chunk = jnp.exp(log_gamma * CHUNK)

    def to_chunks(t):
        return jnp.moveaxis(t.reshape(B, nc, CHUNK, H, t.shape[-1]), 1, 0)

    def step(state, inp):
        qi, ki, vi = inp
        scores = jnp.einsum('bihd,bjhd->bhij', qi, ki) * d_intra[None]
        intra = jnp.einsum('bhij,bjhe->bihe', scores, vi)
        cross = jnp.einsum('bihd,bhde->bihe', qi * xi[None, :, :, None], state)
        state = state * gamma_chunk[None, :, None, None] + jnp.einsum(
            'bjhd,bjhe->bhde', ki * zeta[None, :, :, None], vi)
        return state, intra + cross

    state0 = jnp.zeros((B, H, Dk, Dv), jnp.float32)
    _, y = lax.scan(step, state0, (to_chunks(q), to_chunks(k), to_chunks(v)))
    y = jnp.moveaxis(y, 0, 1).reshape(B, S, H, Dv)
    y = y * lax.rsqrt(jnp.mean(y * y, axis=-1, keepdims=True) + EPS)
    y = y.reshape(B, S, RET_V_WIDTH).astype(h.dtype)
    return (jax.nn.silu(g) * y) @ w_out


def sgu_mixer(h, w_in, b_in, ln_g, ln_b, w_s, b_s, w_out):
    B, S, _ = h.shape
    nb = S // SGU_BLOCK
    z = jax.nn.gelu(h @ w_in + b_in)
    u, v = jnp.split(z, 2, axis=-1)
    v = layernorm(v, ln_g, ln_b)
    pos_chunk = jnp.arange(SGU_BLOCK) // CHUNK
    mask = (pos_chunk[None, :] <= pos_chunk[:, None]).astype(w_s.dtype)
    vb = v.reshape(B, nb, SGU_BLOCK, SGU_GROUPS, SGU_GROUP_DIM)
    s = jnp.einsum('gij,bnjgc->bnigc', w_s * mask[None], vb) + b_s.T[None, None, :, :, None]
    s = s.reshape(B, S, SGU_HALF)
    return (u * s) @ w_out


def peer_ffn(h, w_query, sub_keys, expert_u, expert_v):
    B, S, D = h.shape
    T = B * S
    Hh, K = PEER_HEADS, PEER_TOPK
    ht = h.reshape(T, D)
    q = (ht @ w_query).reshape(T, Hh, 2, PEER_HALF).astype(jnp.float32)
    scores = jnp.einsum('thpd,hpkd->thpk', q, sub_keys.astype(jnp.float32))
    s_top, i_top = lax.top_k(scores, K)
    cand = (s_top[:, :, 0, :, None] + s_top[:, :, 1, None, :]).reshape(T, Hh, K * K)
    cand_idx = (i_top[:, :, 0, :, None] * PEER_NKEYS + i_top[:, :, 1, None, :]).reshape(T, Hh, K * K)
    best, pos = lax.top_k(cand, K)
    expert_idx = jnp.take_along_axis(cand_idx, pos, axis=-1)
    gates = jax.nn.softmax(best, axis=-1).astype(h.dtype)
    nb = T // PEER_TOKEN_BLOCK

    def block(args):
        xb, idx, g = args
        u = expert_u[idx]
        a = jax.nn.gelu(jnp.einsum('tkd,td->tk', u, xb)) * g
        return jnp.einsum('tk,tkd->td', a, expert_v[idx])

    out = lax.map(block, (ht.reshape(nb, PEER_TOKEN_BLOCK, D),
                          expert_idx.reshape(nb, PEER_TOKEN_BLOCK, Hh * K),
                          gates.reshape(nb, PEER_TOKEN_BLOCK, Hh * K)))
    return out.reshape(B, S, D)


def setup_inputs(seed: int = 0) -> dict:
    key = jax.random.key(seed)
    ks = jax.random.split(key, 24)
    f32 = jnp.float32
    D = D_MODEL

    def nrm(k, shape, scale):
        return jax.random.normal(k, shape, f32) * scale

    return {
        "x": nrm(ks[0], (BATCH, SEQ, D), 1.0),
        "c": nrm(ks[1], (BATCH, D), 1.0),
        "positions": jnp.broadcast_to(jnp.arange(SEQ, dtype=jnp.int32), (BATCH, SEQ)),
        "norm_mix": 1.0 + nrm(ks[2], (DEPTH, D), 0.05),
        "norm_ffn": 1.0 + nrm(ks[3], (DEPTH, D), 0.05),
        "ada_w": nrm(ks[4], (DEPTH, D, 6 * D), 0.5 * D ** -0.5),
        "ada_b": nrm(ks[5], (DEPTH, 6 * D), 0.02),
        "ret_w_in": nrm(ks[6], (N_A_LAYERS, D, RET_IN_WIDTH), D ** -0.5),
        "ret_w_out": nrm(ks[7], (N_A_LAYERS, RET_V_WIDTH, D), RET_V_WIDTH ** -0.5),
        "sgu_w_in": nrm(ks[8], (N_B_LAYERS, D, SGU_FFN), D ** -0.5),
        "sgu_b_in": nrm(ks[9], (N_B_LAYERS, SGU_FFN), 0.02),
        "sgu_ln_g": 1.0 + nrm(ks[10], (N_B_LAYERS, SGU_HALF), 0.05),
        "sgu_ln_b": nrm(ks[11], (N_B_LAYERS, SGU_HALF), 0.02),
        "sgu_w_s": nrm(ks[12], (N_B_LAYERS, SGU_GROUPS, SGU_BLOCK, SGU_BLOCK), SGU_BLOCK ** -0.5),
        "sgu_b_s": 1.0 + nrm(ks[13], (N_B_LAYERS, SGU_GROUPS, SGU_BLOCK), 0.1),
        "sgu_w_out": nrm(ks[14], (N_B_LAYERS, SGU_HALF, D), SGU_HALF ** -0.5),
        "peer_w_query": nrm(ks[15], (DEPTH, D, PEER_HEADS * PEER_KEY_DIM), D ** -0.5),
        "peer_sub_keys": nrm(ks[16], (DEPTH, PEER_HEADS, 2, PEER_NKEYS, PEER_HALF), PEER_HALF ** -0.5),
        "peer_u": nrm(ks[17], (DEPTH, PEER_EXPERTS, D), D ** -0.5),
        "peer_v": nrm(ks[18], (DEPTH, PEER_EXPERTS, D), 0.5),
        "norm_final": 1.0 + nrm(ks[19], (D,), 0.05),
    }


def reference(x, c, positions, norm_mix, norm_ffn, ada_w, ada_b, ret_w_in, ret_w_out,
              sgu_w_in, sgu_b_in, sgu_ln_g, sgu_ln_b, sgu_w_s, sgu_b_s, sgu_w_out,
              peer_w_query, peer_sub_keys, peer_u, peer_v, norm_final):
    c_act = jax.nn.silu(c)
    for layer in range(DEPTH):
        mod = c_act @ ada_w[layer] + ada_b[layer]
        sh1, sc1, g1, sh2, sc2, g2 = jnp.split(mod, 6, axis=-1)
        h = modulate(rmsnorm(x, norm_mix[layer]), sh1, sc1)
        j = layer // N_MIXERS
        if layer % N_MIXERS == 0:
            y = retention_mixer(h, positions, ret_w_in[j], ret_w_out[j])
        else:
            y = sgu_mixer(h, sgu_w_in[j], sgu_b_in[j], sgu_ln_g[j], sgu_ln_b[j],
                          sgu_w_s[j], sgu_b_s[j], sgu_w_out[j])
        x = x + g1[:, None, :] * y
        h = modulate(rmsnorm(x, norm_ffn[layer]), sh2, sc2)
        x = x + g2[:, None, :] * peer_ffn(h, peer_w_query[layer], peer_sub_keys[layer],
                                          peer_u[layer], peer_v[layer])
    return rmsnorm(x, norm_final)
```

```cpp
#include <hip/hip_runtime.h>
#include <cstdio>
#include <cstdint>
#include <cstring>
#include <cmath>
namespace pg8 {
#define PG8_LAS __attribute__((address_space(3)))
typedef unsigned short bf16_t;
typedef short bf16x8 __attribute__((ext_vector_type(8)));
typedef float f32x4 __attribute__((ext_vector_type(4)));
typedef unsigned u32x4 __attribute__((ext_vector_type(4)));
constexpr int BM = 256, BK = 64, HALF = 128, HTB = HALF * BK * 2  , STAGE_BYTES = 8 * HTB, NXCD = 8, WGM = 8;

__host__ __device__ __forceinline__ int lds_byte(int r, int c) { const int st = (r >> 4) * 2 + (c >> 5), rr = r & 15, cc = c & 31, ob = rr * 64 + cc * 2; return st * 1024 + (ob ^ (((ob >> 9) & 1) << 5)); }
__host__ __device__ __forceinline__ void stage_rc(int b, int& R, int& C) { const int st = b / 1024, sb = b % 1024, swz = sb ^ (((sb >> 9) & 1) << 5); R = (st >> 1) * 16 + swz / 64; C = (st & 1) * 32 + (swz % 64) / 2; }
__host__ __device__ __forceinline__ int perm32(int rho) { const int n = rho >> 4, i = rho & 15; return 8 * (i >> 2) + 4 * n + (i & 3); }

struct Unit { int pm, pn; };
struct Gemm { const bf16_t* A; const bf16_t* Bt; int M, N, K; };

struct StaticOrder {
    int nM, nN, nwg, G, c;
    __host__ __device__ void init(int M, int N, int G_, int c_) { nM = M / BM; nN = N / BM; nwg = nM * nN; G = G_; c = c_; }
    __host__ __device__ bool next(int i, Unit& u) const {
        const long L = (long)i * G + c; if (L >= nwg) return false;
        int wgid = (int)L; { const int q = nwg / NXCD, r = nwg % NXCD, xcd = wgid % NXCD, off = wgid / NXCD; wgid = (xcd < r ? xcd * (q + 1) : r * (q + 1) + (xcd - r) * q) + off; }
        const int nig = WGM * nN, gid = wgid / nig, fm = gid * WGM, gsz = (nM - fm) < WGM ? (nM - fm) : WGM;
        u.pm = fm + ((wgid % nig) % gsz); u.pn = (wgid % nig) / gsz; return true;
    }
    __device__ __forceinline__ void a_ready(const Unit&) const {}
    __device__ __forceinline__ void done(const Unit&) const {}
};

__device__ __forceinline__ unsigned cvt_pk_bf16(float lo, float hi) { unsigned r; asm volatile("v_cvt_pk_bf16_f32 %0, %1, %2" : "=v"(r) : "v"(lo), "v"(hi)); return r; }
typedef float f32x2 __attribute__((ext_vector_type(2)));
__device__ __forceinline__ f32x2 gelu_pk(f32x2 v) {
    const f32x2 av = __builtin_elementwise_abs(v), d = av * 0.2316418882f + 1.0f;
    f32x2 t; t.x = __builtin_amdgcn_rcpf(d.x); t.y = __builtin_amdgcn_rcpf(d.y);
    f32x2 q = t * 0.5307027145f + (-0.7265760135f); q = q * t + 0.7107068705f; q = q * t + (-0.142248368f); q = q * t + 0.127414796f; q = q * t;
    const f32x2 s = (v * v) * (-0.72134752044f);
    f32x2 e; e.x = __builtin_amdgcn_exp2f(s.x); e.y = __builtin_amdgcn_exp2f(s.y);
    const f32x2 m = v * (q * e), r = v - m;
    f32x2 o; o.x = v.x < 0.f ? m.x : r.x; o.y = v.y < 0.f ? m.y : r.y; return o;
}

template <int ACT  > struct EpiBf16 {
    static constexpr bool PERM = true, AFTER_DRAIN = false; static_assert(ACT == 0 || ACT == 1, "EpiBf16: ACT is 0 (none) or 1 (gelu_pk)");
    bf16_t* O; int ldc; const float* bias; int split_cols; size_t split_stride; float scale0;
    __device__ __forceinline__ void operator()(const f32x4 (&acc)[2][2][4][2], const Unit& u, int wr, int wc, int fr, int fq) const {
        const int row0 = u.pm * BM + wr * 64 + fr; int colt = u.pn * BM; bf16_t* base = O;
        float sc = 1.f; if (split_cols) { const int t = colt / split_cols; base += (size_t)t * split_stride; colt -= t * split_cols; if (t == 0) sc = scale0; }
        const int col0 = colt + wc * 32 + 8 * fq, bcol0 = u.pn * BM + wc * 32 + 8 * fq;
        f32x4 bv[2][2];
#pragma unroll
        for (int bj = 0; bj < 2; ++bj)
#pragma unroll
            for (int n = 0; n < 2; ++n) bv[bj][n] = bias ? *(const f32x4*)(bias + bcol0 + bj * HALF + 4 * n) : (f32x4){0.f, 0.f, 0.f, 0.f};
#pragma unroll
        for (int ai = 0; ai < 2; ++ai)
#pragma unroll
            for (int m = 0; m < 4; ++m) { bf16_t* rowp = base + (size_t)(row0 + ai * HALF + m * 16) * ldc + col0;
#pragma unroll
                for (int bj = 0; bj < 2; ++bj) { f32x4 v0 = acc[ai][bj][m][0] + bv[bj][0], v1 = acc[ai][bj][m][1] + bv[bj][1];
                    if (ACT == 1) { f32x2 a = gelu_pk((f32x2){v0[0], v0[1]}), b = gelu_pk((f32x2){v0[2], v0[3]}), c = gelu_pk((f32x2){v1[0], v1[1]}), d = gelu_pk((f32x2){v1[2], v1[3]});
                        v0 = (f32x4){a.x, a.y, b.x, b.y}; v1 = (f32x4){c.x, c.y, d.x, d.y}; }
                    v0 = v0 * sc; v1 = v1 * sc; u32x4 w; w.x = cvt_pk_bf16(v0[0], v0[1]); w.y = cvt_pk_bf16(v0[2], v0[3]); w.z = cvt_pk_bf16(v1[0], v1[1]); w.w = cvt_pk_bf16(v1[2], v1[3]);
                    *(u32x4*)(rowp + bj * HALF) = w; } }
    }
};
template <class Epi, class Sched, bool ALIGN_EPI = false, bool SP2 = false>
__device__ __forceinline__ void gemm_phase(PG8_LAS unsigned char* lds, const Gemm g, const Sched& S, const Epi& E) {
    const int tid = threadIdx.x, wid = __builtin_amdgcn_readfirstlane(tid >> 6), lane = tid & 63, wr = wid >> 2, wc = wid & 3, fr = lane & 15, fq = lane >> 4;
    const int K = g.K, nt = K / BK;
    unsigned voffA[2], voffB[2];
#pragma unroll
    for (int i = 0; i < 2; ++i) { int R, C; stage_rc(tid * 16 + i * 8192, R, C); const int Rb = Epi::PERM ? ((R & ~31) + perm32(R & 31)) : R;
        voffA[i] = (unsigned)(R * K + C) * 2u; voffB[i] = (unsigned)(Rb * K + C) * 2u; }
    const size_t kstep = (size_t)(BK * 2);
    const size_t hstep = (size_t)HALF * K * 2;
    const size_t tstep = 2 * hstep;
    const unsigned ldsw = (unsigned)wid * 1024u;
    const int aoff = lds_byte(wr * 64 + fr, fq * 8), boff = lds_byte(wc * 32 + fr, fq * 8);
#define PG8_SA(b, h) (((b) * 2 + (h)) * HTB)
#define PG8_SB(b, h) ((4 + (b) * 2 + (h)) * HTB)
#define PG8_STAGE(bufoff, gbase, voff) do { _Pragma("unroll") for (int _i = 0; _i < 2; ++_i) \
        __builtin_amdgcn_global_load_lds((const unsigned*)((const char*)(gbase) + (voff)[_i]), (PG8_LAS unsigned*)(lds + (bufoff) + ldsw + _i * 8192), 16, 0, 0); } while (0)
#define PG8_LDA(dst, b, h) do { _Pragma("unroll") for (int m = 0; m < 4; ++m) _Pragma("unroll") for (int k = 0; k < 2; ++k) dst[m][k] = *(const PG8_LAS bf16x8*)(lds + PG8_SA(b, h) + aoff + m * 2048 + k * 1024); } while (0)
#define PG8_LDB(dst, b, h) do { _Pragma("unroll") for (int n = 0; n < 2; ++n) _Pragma("unroll") for (int k = 0; k < 2; ++k) dst[n][k] = *(const PG8_LAS bf16x8*)(lds + PG8_SB(b, h) + boff + n * 2048 + k * 1024); } while (0)
#define PG8_MMA(ai, bj, At, Bt) do { __builtin_amdgcn_s_setprio(1); _Pragma("unroll") for (int m = 0; m < 4; ++m) _Pragma("unroll") for (int n = 0; n < 2; ++n) _Pragma("unroll") for (int k = 0; k < 2; ++k) \
        acc[ai][bj][m][n] = __builtin_amdgcn_mfma_f32_16x16x32_bf16(Bt[n][k], At[m][k], acc[ai][bj][m][n], 0, 0, 0); __builtin_amdgcn_s_setprio(0); } while (0)
#define PG8_WAIT_V(n) asm volatile("s_waitcnt vmcnt(" #n ")" ::: "memory")
#define PG8_WAIT_L(n) asm volatile("s_waitcnt lgkmcnt(" #n ")" ::: "memory")
#define PG8_BAR __builtin_amdgcn_s_barrier()
#define PG8_SCHED __builtin_amdgcn_sched_barrier(0)
    Unit cur, nxt; int ui = 0;
    if (!S.next(0, cur)) return;
    f32x4 acc[2][2][4][2];
#pragma unroll
    for (int a = 0; a < 2; ++a)
#pragma unroll
        for (int b = 0; b < 2; ++b)
#pragma unroll
            for (int m = 0; m < 4; ++m)
#pragma unroll
                for (int n = 0; n < 2; ++n) acc[a][b][m][n] = (f32x4){0.f, 0.f, 0.f, 0.f};
    bf16x8 At[4][2], B0[2][2], B1[2][2];
    const char* cA = (const char*)g.A + (size_t)cur.pm * tstep; const char* cB = (const char*)g.Bt + (size_t)cur.pn * tstep;
    S.a_ready(cur);
    if constexpr (SP2) {
        PG8_STAGE(PG8_SB(0, 0), cB, voffB); PG8_STAGE(PG8_SB(0, 1), cB + hstep, voffB); PG8_STAGE(PG8_SA(0, 0), cA, voffA); PG8_STAGE(PG8_SA(0, 1), cA + hstep, voffA);
        if (wr == 1) PG8_BAR;
        PG8_WAIT_V(2); PG8_BAR;
        PG8_STAGE(PG8_SB(1, 0), cB + kstep, voffB); PG8_STAGE(PG8_SA(1, 0), cA + kstep, voffA); PG8_STAGE(PG8_SB(1, 1), cB + hstep + kstep, voffB);
        PG8_WAIT_V(6); PG8_BAR;
    } else {
        PG8_STAGE(PG8_SB(0, 0), cB, voffB); PG8_STAGE(PG8_SA(0, 0), cA, voffA); PG8_STAGE(PG8_SB(0, 1), cB + hstep, voffB); PG8_STAGE(PG8_SA(0, 1), cA + hstep, voffA);
        if (wr == 1) PG8_BAR;
        PG8_WAIT_V(4); PG8_BAR;
        PG8_STAGE(PG8_SB(1, 0), cB + kstep, voffB); PG8_STAGE(PG8_SA(1, 0), cA + kstep, voffA); PG8_STAGE(PG8_SB(1, 1), cB + hstep + kstep, voffB);
        PG8_WAIT_V(6); PG8_BAR;
    }
    for (;;) {
        const bool has_next = S.next(ui + 1, nxt);
        const char* nA = has_next ? (const char*)g.A + (size_t)nxt.pm * tstep : cA; const char* nB = has_next ? (const char*)g.Bt + (size_t)nxt.pn * tstep : cB;
        for (int t = 0; t < nt; t += 2) {
            const bool last = (t == nt - 2);
            const char* a1 = cA + (size_t)(t + 1) * kstep;
            const char* a2 = last ? nA : cA + (size_t)(t + 2) * kstep; const char* b2 = last ? nB : cB + (size_t)(t + 2) * kstep;
            const char* a3 = a2 + kstep; const char* b3 = b2 + kstep;
            if (last && has_next) S.a_ready(nxt);
            if constexpr (SP2) {
            PG8_LDB(B0, 0, 0); PG8_LDB(B1, 0, 1); PG8_SCHED; PG8_LDA(At, 0, 0); PG8_STAGE(PG8_SA(1, 1), a1 + hstep, voffA);
            PG8_WAIT_V(8); PG8_WAIT_L(0); PG8_BAR; PG8_MMA(0, 0, At, B0); PG8_MMA(0, 1, At, B1); PG8_BAR; PG8_SCHED;
            PG8_LDA(At, 0, 1); PG8_STAGE(PG8_SB(0, 0), b2, voffB); PG8_STAGE(PG8_SB(0, 1), b2 + hstep, voffB); PG8_STAGE(PG8_SA(0, 0), a2, voffA);
            PG8_WAIT_V(8); PG8_WAIT_L(0); PG8_BAR; PG8_MMA(1, 0, At, B0); PG8_MMA(1, 1, At, B1); PG8_BAR; PG8_SCHED;
            PG8_LDB(B0, 1, 0); PG8_LDB(B1, 1, 1); PG8_SCHED; PG8_LDA(At, 1, 0); PG8_STAGE(PG8_SA(0, 1), a2 + hstep, voffA);
            PG8_WAIT_V(8); PG8_WAIT_L(0); PG8_BAR; PG8_MMA(0, 0, At, B0); PG8_MMA(0, 1, At, B1); PG8_BAR; PG8_SCHED;
            PG8_LDA(At, 1, 1); PG8_STAGE(PG8_SB(1, 0), b3, voffB); PG8_STAGE(PG8_SB(1, 1), b3 + hstep, voffB); PG8_STAGE(PG8_SA(1, 0), a3, voffA);
            PG8_WAIT_V(8); PG8_WAIT_L(0); PG8_BAR; PG8_MMA(1, 0, At, B0); PG8_MMA(1, 1, At, B1); PG8_BAR; PG8_SCHED;
            } else {
            PG8_LDB(B0, 0, 0); PG8_SCHED; PG8_LDA(At, 0, 0); PG8_STAGE(PG8_SA(1, 1), a1 + hstep, voffA);
            PG8_WAIT_L(8); PG8_BAR; PG8_WAIT_L(0); PG8_MMA(0, 0, At, B0); PG8_BAR; PG8_SCHED;
            PG8_LDB(B1, 0, 1); PG8_STAGE(PG8_SB(0, 0), b2, voffB);
            PG8_BAR; PG8_WAIT_L(0); PG8_MMA(0, 1, At, B1); PG8_BAR;
            PG8_LDA(At, 0, 1); PG8_STAGE(PG8_SA(0, 0), a2, voffA);
            PG8_BAR; PG8_WAIT_L(0); PG8_MMA(1, 0, At, B0); PG8_BAR; PG8_SCHED;
            PG8_STAGE(PG8_SB(0, 1), b2 + hstep, voffB);
            PG8_WAIT_V(6); PG8_BAR; PG8_MMA(1, 1, At, B1); PG8_BAR;
            PG8_LDB(B0, 1, 0); PG8_SCHED; PG8_LDA(At, 1, 0); PG8_STAGE(PG8_SA(0, 1), a2 + hstep, voffA);
            PG8_WAIT_L(8); PG8_BAR; PG8_WAIT_L(0); PG8_MMA(0, 0, At, B0); PG8_BAR; PG8_SCHED;
            PG8_LDB(B1, 1, 1); PG8_STAGE(PG8_SB(1, 0), b3, voffB);
            PG8_BAR; PG8_WAIT_L(0); PG8_MMA(0, 1, At, B1); PG8_BAR;
            PG8_LDA(At, 1, 1); PG8_STAGE(PG8_SA(1, 0), a3, voffA);
            PG8_BAR; PG8_WAIT_L(0); PG8_MMA(1, 0, At, B0); PG8_BAR; PG8_SCHED;
            PG8_STAGE(PG8_SB(1, 1), b3 + hstep, voffB);
            PG8_WAIT_V(6); PG8_BAR; PG8_MMA(1, 1, At, B1); PG8_BAR;
            }
        }
        if constexpr (ALIGN_EPI) { if (wr == 0) PG8_BAR; }
        if constexpr (!Epi::AFTER_DRAIN) { E(acc, cur, wr, wc, fr, fq); S.done(cur); }
        if (!has_next) break;
#pragma unroll
        for (int a = 0; a < 2; ++a)
#pragma unroll
            for (int b = 0; b < 2; ++b)
#pragma unroll
                for (int m = 0; m < 4; ++m)
#pragma unroll
                    for (int n = 0; n < 2; ++n) acc[a][b][m][n] = (f32x4){0.f, 0.f, 0.f, 0.f};
        cur = nxt; cA = nA; cB = nB; ++ui;
        if constexpr (ALIGN_EPI) { if (wr == 1) PG8_BAR; }
    }
    PG8_WAIT_V(0);
    if constexpr (!ALIGN_EPI) { if (wr == 0) PG8_BAR; }
    PG8_BAR;
    if constexpr (Epi::AFTER_DRAIN) { E.fused(acc, cur, wr, wc, fr, fq, lds, wid, lane); S.done(cur); }
#undef PG8_SA
#undef PG8_SB
#undef PG8_STAGE
#undef PG8_LDA
#undef PG8_LDB
#undef PG8_MMA
#undef PG8_WAIT_V
#undef PG8_WAIT_L
#undef PG8_BAR
#undef PG8_SCHED
}
}
namespace pg8 {
typedef unsigned u32x2 __attribute__((ext_vector_type(2)));
__device__ __forceinline__ float gelu_tanh(float x) {
    const float e = __builtin_amdgcn_exp2f(x * (-2.302208198f - 0.1029432397f * x * x));
    return x * __builtin_amdgcn_rcpf(1.0f + e);
}
__device__ __forceinline__ float silu_f(float x) { return x * __builtin_amdgcn_rcpf(1.0f + __builtin_amdgcn_exp2f(-1.4426950409f * x)); }

struct EpiRetProj {
    static constexpr bool PERM = false, AFTER_DRAIN = false;
    bf16_t *Q, *K, *V, *G; const float *cosT, *sinT;
    __device__ __forceinline__ void operator()(const f32x4 (&acc)[2][2][4][2], const Unit& u, int wr, int wc, int fr, int fq) const {
        const int pn = u.pn;
        if (pn < 8) {
            bf16_t* dst = pn < 4 ? Q : K; const int head = pn & 3; const float sc = pn < 4 ? 1.0f : 0.0625f;
#pragma unroll
            for (int ai = 0; ai < 2; ++ai)
#pragma unroll
                for (int m = 0; m < 4; ++m) {
                    const int row = u.pm * BM + ai * HALF + wr * 64 + m * 16 + fr;
#pragma unroll
                    for (int n = 0; n < 2; ++n) {
                        const int f0 = wc * 32 + n * 16 + fq * 4;
                        const f32x4 c4 = *(const f32x4*)(cosT + (size_t)row * 128 + f0), s4 = *(const f32x4*)(sinT + (size_t)row * 128 + f0);
                        const f32x4 x1 = acc[ai][0][m][n], x2 = acc[ai][1][m][n];
                        const f32x4 o1 = (x1 * c4 - x2 * s4) * sc, o2 = (x1 * s4 + x2 * c4) * sc;
                        u32x2 w1, w2; w1.x = cvt_pk_bf16(o1[0], o1[1]); w1.y = cvt_pk_bf16(o1[2], o1[3]); w2.x = cvt_pk_bf16(o2[0], o2[1]); w2.y = cvt_pk_bf16(o2[2], o2[3]);
                        bf16_t* p = dst + (size_t)row * 1024 + head * 256 + f0;
                        *(u32x2*)p = w1; *(u32x2*)(p + 128) = w2;
                    }
                }
        } else {
            const bool isg = pn >= 16; bf16_t* dst = isg ? G : V; const int colbase = ((pn - 8) & 7) * 256;
#pragma unroll
            for (int ai = 0; ai < 2; ++ai)
#pragma unroll
                for (int m = 0; m < 4; ++m) {
                    const int row = u.pm * BM + ai * HALF + wr * 64 + m * 16 + fr;
#pragma unroll
                    for (int bj = 0; bj < 2; ++bj)
#pragma unroll
                        for (int n = 0; n < 2; ++n) {
                            f32x4 v = acc[ai][bj][m][n];
                            if (isg) { v[0] = silu_f(v[0]); v[1] = silu_f(v[1]); v[2] = silu_f(v[2]); v[3] = silu_f(v[3]); }
                            u32x2 w; w.x = cvt_pk_bf16(v[0], v[1]); w.y = cvt_pk_bf16(v[2], v[3]);
                            *(u32x2*)(dst + (size_t)row * 2048 + colbase + bj * HALF + wc * 32 + n * 16 + fq * 4) = w;
                        }
                }
        }
    }
};
struct EpiResGate {
    static constexpr bool PERM = false, AFTER_DRAIN = false;
    const float* base; float* out; const float* gate; int gstride;
    __device__ __forceinline__ void operator()(const f32x4 (&acc)[2][2][4][2], const Unit& u, int wr, int wc, int fr, int fq) const {
        const int b = (u.pm * BM) >> 13; const float* gp = gate + (size_t)b * gstride;
        const int col0 = u.pn * BM + wc * 32 + 4 * fq;
        f32x4 gv[2][2];
#pragma unroll
        for (int bj = 0; bj < 2; ++bj)
#pragma unroll
            for (int n = 0; n < 2; ++n) gv[bj][n] = *(const f32x4*)(gp + col0 + bj * HALF + n * 16);
#pragma unroll
        for (int ai = 0; ai < 2; ++ai)
#pragma unroll
            for (int m = 0; m < 4; ++m) {
                const size_t off = (size_t)(u.pm * BM + ai * HALF + wr * 64 + m * 16 + fr) * 1024 + col0;
#pragma unroll
                for (int bj = 0; bj < 2; ++bj)
#pragma unroll
                    for (int n = 0; n < 2; ++n) { const f32x4 bs = *(const f32x4*)(base + off + bj * HALF + n * 16); *(f32x4*)(out + off + bj * HALF + n * 16) = bs + gv[bj][n] * acc[ai][bj][m][n]; }
            }
    }
};
struct EpiSguIn {
    static constexpr bool PERM = true, AFTER_DRAIN = false;
    bf16_t* U; bf16_t* Vb; const float* bias; float* stats;
    __device__ __forceinline__ void operator()(const f32x4 (&acc)[2][2][4][2], const Unit& u, int wr, int wc, int fr, int fq) const {
        const bool isv = u.pn >= 12; bf16_t* base = isv ? Vb : U; const int colt = (isv ? u.pn - 12 : u.pn) * BM;
        const int col0 = colt + wc * 32 + 8 * fq, bcol0 = u.pn * BM + wc * 32 + 8 * fq;
        f32x4 bv[2][2];
#pragma unroll
        for (int bj = 0; bj < 2; ++bj)
#pragma unroll
            for (int n = 0; n < 2; ++n) bv[bj][n] = *(const f32x4*)(bias + bcol0 + bj * HALF + 4 * n);
#pragma unroll
        for (int ai = 0; ai < 2; ++ai)
#pragma unroll
            for (int m = 0; m < 4; ++m) {
                const int row = u.pm * BM + ai * HALF + wr * 64 + m * 16 + fr;
                bf16_t* rowp = base + (size_t)row * 3072 + col0;
                float s1 = 0.f, s2 = 0.f;
#pragma unroll
                for (int bj = 0; bj < 2; ++bj) {
                    f32x4 v0 = acc[ai][bj][m][0] + bv[bj][0], v1 = acc[ai][bj][m][1] + bv[bj][1];
#pragma unroll
                    for (int j = 0; j < 4; ++j) { v0[j] = gelu_tanh(v0[j]); v1[j] = gelu_tanh(v1[j]); }
                    u32x4 w; w.x = cvt_pk_bf16(v0[0], v0[1]); w.y = cvt_pk_bf16(v0[2], v0[3]); w.z = cvt_pk_bf16(v1[0], v1[1]); w.w = cvt_pk_bf16(v1[2], v1[3]);
                    *(u32x4*)(rowp + bj * HALF) = w;
                    if (isv) {
#pragma unroll
                        for (int j = 0; j < 4; ++j) { const unsigned ww = j == 0 ? w.x : j == 1 ? w.y : j == 2 ? w.z : w.w;
                            const float a = __uint_as_float(ww << 16), bq = __uint_as_float(ww & 0xffff0000u); s1 += a + bq; s2 += a * a + bq * bq; }
                    }
                }
                if (isv) {
                    s1 += __shfl_xor(s1, 16); s1 += __shfl_xor(s1, 32); s2 += __shfl_xor(s2, 16); s2 += __shfl_xor(s2, 32);
                    if (fq == 0) { float* sp = stats + ((size_t)row * 48 + (u.pn - 12) * 4 + wc) * 2; sp[0] = s1; sp[1] = s2; }
                }
            }
    }
};
}
typedef unsigned u32x4 __attribute__((ext_vector_type(4)));
#define GAS __attribute__((address_space(1)))
#define LAS __attribute__((address_space(3)))
typedef unsigned short bf16;
typedef unsigned v4u __attribute__((ext_vector_type(4)));
typedef float f32x4 __attribute__((ext_vector_type(4)));
typedef short bf16x8 __attribute__((ext_vector_type(8)));
typedef GAS unsigned gu32;
typedef GAS unsigned long long gu64;
#define RLX_AGENT __ATOMIC_RELAXED, __HIP_MEMORY_SCOPE_AGENT
#define LDS_WAIT() asm volatile("s_waitcnt lgkmcnt(0)" ::: "memory")
#define VM_WAIT() asm volatile("s_waitcnt vmcnt(0)" ::: "memory")
__device__ __forceinline__ unsigned long long rt() { return __builtin_amdgcn_s_memrealtime(); }
__device__ __forceinline__ unsigned f2bf(float f) { unsigned u = __builtin_bit_cast(unsigned, f); return (u + 0x7fffu + ((u >> 16) & 1u)) >> 16; }
__device__ __forceinline__ unsigned pk2(float lo, float hi) { return f2bf(lo) | (f2bf(hi) << 16); }

#define XB_TMO      128
#define XB_XCNT(j)  (256  + 64 * (j))
#define XB_XSUB(j)  (1280 + 64 * (j))
#define XB_XGEN(j)  (2304 + 64 * (j))
#define XB_TOP      3328
#define XB_TOPGEN   3392
#define XCD_BAR_WORDS 3456
#define XB_SPIN_CAP (1u << 18)

__device__ __forceinline__ unsigned xb_ld(unsigned* p)              { return __hip_atomic_load(p, __ATOMIC_RELAXED, __HIP_MEMORY_SCOPE_AGENT); }
__device__ __forceinline__ unsigned xb_add(unsigned* p, unsigned v) { return __hip_atomic_fetch_add(p, v, __ATOMIC_RELAXED, __HIP_MEMORY_SCOPE_AGENT); }
__device__ __forceinline__ unsigned xb_xcc_id() { return (unsigned)__builtin_amdgcn_s_getreg((3 << 11) | 20) & 0xFu; }
#define XB_SPIN(cond, bar) do { unsigned _sp = 0; while (cond) { __builtin_amdgcn_s_sleep(1); \
    if ((++_sp & 255u) == 0u) { if (xb_ld(&(bar)[XB_TMO])) break; if (_sp > XB_SPIN_CAP) { atomicAdd(&(bar)[XB_TMO], 1u); break; } } } } while (0)

struct XcdBarrier {
    unsigned* bar; unsigned x;
    volatile LAS unsigned* st;
};

__device__ __forceinline__ XcdBarrier xcd_barrier_post(unsigned* bar, volatile LAS unsigned* st) {
    XcdBarrier b; b.bar = bar; b.x = xb_xcc_id(); b.st = st;
    if (threadIdx.x == 0) (void)xb_add(&bar[XB_XCNT(b.x)], 1u);
    return b;
}
__device__ __forceinline__ void xcd_barrier_complete(unsigned* bar, unsigned x, unsigned& nloc, unsigned& nx) {
    const unsigned G = gridDim.x * gridDim.y * gridDim.z;
    unsigned sum, cnt, mine, sp = 0u;
    for (;;) {
        sum = 0u; cnt = 0u; mine = 0u;
#pragma unroll
        for (unsigned j = 0; j < 16; ++j) { const unsigned c = xb_ld(&bar[XB_XCNT(j)]); sum += c; cnt += (c > 0u) ? 1u : 0u; mine = (j == x) ? c : mine; }
        if (sum == G) break;
        __builtin_amdgcn_s_sleep(1);
        if ((++sp & 255u) == 0u) { if (xb_ld(&bar[XB_TMO])) break; if (sp > XB_SPIN_CAP) { atomicAdd(&bar[XB_TMO], 1u); break; } }
    }
    nloc = mine > 0u ? mine : 1u; nx = cnt > 0u ? cnt : 1u;
}

__device__ __forceinline__ void xcd_barrier(const XcdBarrier& b) {
    asm volatile("s_waitcnt vmcnt(0)" ::: "memory");
    __syncthreads();
    if (threadIdx.x == 0) {
        unsigned* bar = b.bar;
        __builtin_amdgcn_s_waitcnt(0);
        unsigned nloc = b.st[0], nx = b.st[1];
        if (nloc == 0u) { xcd_barrier_complete(bar, b.x, nloc, nx); b.st[0] = nloc; b.st[1] = nx; }
        const unsigned old = xb_add(&bar[XB_XSUB(b.x)], 1u);
        const unsigned gen = old / nloc;
        if (old + 1u == (gen + 1u) * nloc) {
            __builtin_amdgcn_fence(__ATOMIC_RELEASE, "agent");
            asm volatile("s_waitcnt vmcnt(0)" ::: "memory");
            const unsigned og = xb_add(&bar[XB_TOP], 1u);
            const unsigned tg = og / nx;
            if (og + 1u == (tg + 1u) * nx) xb_add(&bar[XB_TOPGEN], 1u);
            else XB_SPIN(xb_ld(&bar[XB_TOPGEN]) == tg, bar);
            __builtin_amdgcn_fence(__ATOMIC_ACQUIRE, "agent");
            xb_add(&bar[XB_XGEN(b.x)], 1u);
            asm volatile("s_waitcnt vmcnt(0)" ::: "memory");
        } else {
            XB_SPIN(xb_ld(&bar[XB_XGEN(b.x)]) == gen, bar);
            __builtin_amdgcn_fence(__ATOMIC_ACQUIRE, "agent");
            asm volatile("s_waitcnt vmcnt(0)" ::: "memory");
        }
    }
    __syncthreads();
}
__device__ __forceinline__ float wave_sum(float v) {
#pragma unroll
    for (int o = 1; o < 64; o <<= 1) v += __shfl_xor(v, o);
    return v;
}
__device__ __forceinline__ void p0_transpose_item(const float* W, int K, int N, bf16* WT, int row_off, LAS float* scr, int item, int lane) {
    const int nblk = N / 32, kb = item / nblk, nb = item % nblk, k0 = 64 * kb, n0 = 32 * nb;
#pragma unroll 8
    for (int i = 0; i < 32; ++i) { const int kk = 2 * i + (lane >> 5); scr[kk * 33 + (lane & 31)] = W[(size_t)(k0 + kk) * N + n0 + (lane & 31)]; }
    LDS_WAIT(); asm volatile("" ::: "memory");
    const int c = lane & 7;
#pragma unroll
    for (int j = 0; j < 4; ++j) { const int n = (lane >> 3) + 8 * j; const LAS float* s = scr + (8 * c) * 33 + n;
        v4u o; o.x = pk2(s[0 * 33], s[1 * 33]); o.y = pk2(s[2 * 33], s[3 * 33]); o.z = pk2(s[4 * 33], s[5 * 33]); o.w = pk2(s[6 * 33], s[7 * 33]);
        *(GAS v4u*)(WT + (size_t)(row_off + n0 + n) * K + k0 + 8 * c) = o; }
    LDS_WAIT(); asm volatile("" ::: "memory");
}
#define DI __device__ __forceinline__
constexpr int NWAVES = 8;
constexpr int TT = 16384, DM = 1024, SEQ = 8192;
constexpr size_t MiB = 1u << 20;
constexpr size_t WS_CTL = 0, CTL_ZERO_BYTES = 1 * MiB, WS_MOD = 512 * 1024;
constexpr size_t WS_COS = 2 * MiB, WS_SIN = 10 * MiB;
constexpr size_t WS_WRI = 18 * MiB, WS_WRO = 30 * MiB, WS_WSI = 34 * MiB, WS_WSO = 46 * MiB, WS_WQ = 52 * MiB, WS_KEYS = 60 * MiB;
constexpr size_t WS_STATS = 62 * MiB, WS_IDX = 68 * MiB, WS_GATE = 76 * MiB, WS_H = 84 * MiB, WS_PU = 116 * MiB, WS_PV = 180 * MiB;
constexpr size_t WS_R = 244 * MiB;
constexpr size_t WS_Q = WS_R, WS_K = WS_R + 32 * MiB, WS_V = WS_R + 64 * MiB, WS_G = WS_R + 128 * MiB, WS_CROSS = WS_R + 192 * MiB;
constexpr size_t WS_QP = WS_R, WS_SC = WS_R + 64 * MiB;
constexpr size_t WS_U = WS_R, WS_VB = WS_R + 96 * MiB;
constexpr size_t WS_END = 500 * MiB;
constexpr int CW_TMO = 0, CW_BAR = 4096;
constexpr int RING_OFF = 0, RING_BYTES = 131072, LDSCTL_OFF = RING_BYTES, MISC_OFF = LDSCTL_OFF + 320, LDS_BYTES = 147456;
constexpr int PTR_OFF = LDSCTL_OFF + 512;
constexpr float EPS = 1e-6f;

DI float bf2f(bf16 h) { return __uint_as_float((unsigned)h << 16); }
DI float bflo(unsigned w) { return __uint_as_float(w << 16); }
DI float bfhi(unsigned w) { return __uint_as_float(w & 0xffff0000u); }
DI float wave_max(float v) {
#pragma unroll
    for (int o = 1; o < 64; o <<= 1) v = fmaxf(v, __shfl_xor(v, o));
    return v;
}
DI float gelu_t(float x) { return pg8::gelu_tanh(x); }

struct Ctx {
    LAS unsigned char* lds; int tid, lane, wave, vcu, G;
    unsigned char* ws;
};

DI const void* ldp(const Ctx& C, int i) {
    const unsigned long long v = ((const LAS unsigned long long*)(C.lds + PTR_OFF))[i];
    const unsigned lo = __builtin_amdgcn_readfirstlane((unsigned)v), hi = __builtin_amdgcn_readfirstlane((unsigned)(v >> 32));
    return (const void*)(((unsigned long long)hi << 32) | lo);
}
DI void cvt_stream(const float* src, bf16* dst, size_t n4, size_t gtid, size_t gthreads) {
    const f32x4* s = (const f32x4*)src; uint2* d = (uint2*)dst;
    for (size_t i = gtid; i < n4; i += gthreads) { const f32x4 v = s[i]; uint2 o; o.x = pk2(v.x, v.y); o.y = pk2(v.z, v.w); d[i] = o; }
}
struct P0In { const float *c, *ada_w, *ada_b, *ret_w_in, *ret_w_out, *sgu_w_in, *sgu_w_out, *wq, *keys, *pu, *pv; const int* pos; };
DI void p0_prologue(const Ctx& C, const P0In& I) {
    LAS float* scr = (LAS float*)(C.lds + RING_OFF + C.wave * 16384);
    const int gw = C.vcu * NWAVES + C.wave, NGW = C.G * NWAVES;
    bf16* wri = (bf16*)(C.ws + WS_WRI); bf16* wro = (bf16*)(C.ws + WS_WRO); bf16* wsi = (bf16*)(C.ws + WS_WSI); bf16* wso = (bf16*)(C.ws + WS_WSO); bf16* wq = (bf16*)(C.ws + WS_WQ);
    constexpr int I_RI = 16 * 192, I_RO = 32 * 32, I_SI = 16 * 192, I_SO = 48 * 32, I_Q = 16 * 64;
    constexpr int NITEMS = I_RI + I_RO + I_SI + I_SO + 2 * I_Q;
    for (int it = gw; it < NITEMS; it += NGW) {
        int r = it;
        if (r < I_RI) { p0_transpose_item(I.ret_w_in, 1024, 6144, wri, 0, scr, r, C.lane); continue; } r -= I_RI;
        if (r < I_RO) { p0_transpose_item(I.ret_w_out, 2048, 1024, wro, 0, scr, r, C.lane); continue; } r -= I_RO;
        if (r < I_SI) { p0_transpose_item(I.sgu_w_in, 1024, 6144, wsi, 0, scr, r, C.lane); continue; } r -= I_SI;
        if (r < I_SO) { p0_transpose_item(I.sgu_w_out, 3072, 1024, wso, 0, scr, r, C.lane); continue; } r -= I_SO;
        if (r < I_Q) { p0_transpose_item(I.wq, 1024, 2048, wq, 0, scr, r, C.lane); continue; } r -= I_Q;
        p0_transpose_item(I.wq + (size_t)1024 * 2048, 1024, 2048, wq + (size_t)2048 * 1024, 0, scr, r, C.lane);
    }
    const size_t gtid = (size_t)C.vcu * 512 + C.tid, gth = (size_t)C.G * 512;
    cvt_stream(I.keys, (bf16*)(C.ws + WS_KEYS), (size_t)2 * 8 * 2 * 128 * 128 / 4, gtid, gth);
    cvt_stream(I.pu, (bf16*)(C.ws + WS_PU), (size_t)2 * 16384 * 1024 / 4, gtid, gth);
    cvt_stream(I.pv, (bf16*)(C.ws + WS_PV), (size_t)2 * 16384 * 1024 / 4, gtid, gth);
    float* mod = (float*)(C.ws + WS_MOD);
    __syncthreads();
    for (int it = C.vcu; it < 2 * 96; it += C.G) {
        const int l = it / 96, cb = it % 96, kp = C.wave, n = cb * 64 + C.lane;
        const float* W = I.ada_w + (size_t)l * 1024 * 6144 + n;
        float a0 = 0.f, a1 = 0.f;
#pragma unroll 8
        for (int k = kp * 128; k < kp * 128 + 128; ++k) {
            const float w = W[(size_t)k * 6144]; const float c0 = I.c[k], c1 = I.c[1024 + k];
            a0 += pg8::silu_f(c0) * w; a1 += pg8::silu_f(c1) * w;
        }
        LAS float* red = (LAS float*)(C.lds + RING_OFF);
        red[(kp * 2 + 0) * 64 + C.lane] = a0; red[(kp * 2 + 1) * 64 + C.lane] = a1;
        __syncthreads();
        if (C.wave < 2) { float s = I.ada_b[l * 6144 + n];
#pragma unroll
            for (int q = 0; q < 8; ++q) s += red[(q * 2 + C.wave) * 64 + C.lane];
            mod[(size_t)(l * 2 + C.wave) * 6144 + n] = s; }
        __syncthreads();
    }
    float* cosT = (float*)(C.ws + WS_COS); float* sinT = (float*)(C.ws + WS_SIN);
    for (int it = gw; it < TT / 2; it += NGW) {
        const int row = 2 * it + (C.lane >> 5), f0 = (C.lane & 31) * 4; const float p = (float)I.pos[row];
        f32x4 cv, sv;
#pragma unroll
        for (int j = 0; j < 4; ++j) { const int f = f0 + j; double w = 1.0, bs = 0.93057204092969898;
#pragma unroll
            for (int bit = 0; bit < 7; ++bit) { if ((f >> bit) & 1) w *= bs; bs *= bs; }
            const float ang = p * (float)w; const double r = (double)ang * 0.15915494309189535; const float fr = (float)(r - floor(r)); cv[j] = __builtin_amdgcn_cosf(fr); sv[j] = __builtin_amdgcn_sinf(fr); }
        *(f32x4*)(cosT + (size_t)row * 128 + f0) = cv; *(f32x4*)(sinT + (size_t)row * 128 + f0) = sv;
    }
}
DI void rms_mod_row(const float* xrow, const float* gain, const float* shift, const float* scale, bf16* orow, int lane) {
    const f32x4* xr = (const f32x4*)xrow + lane; f32x4 v[4]; float s = 0.f;
#pragma unroll
    for (int j = 0; j < 4; ++j) { v[j] = xr[64 * j]; s += (v[j].x * v[j].x + v[j].y * v[j].y) + (v[j].z * v[j].z + v[j].w * v[j].w); }
    const float rstd = 1.0f / sqrtf(wave_sum(s) * (1.0f / 1024.0f) + EPS);
    uint2* o8 = (uint2*)orow + lane;
#pragma unroll
    for (int j = 0; j < 4; ++j) { const f32x4 g = ((const f32x4*)gain)[lane + 64 * j], sh = ((const f32x4*)shift)[lane + 64 * j], sc = ((const f32x4*)scale)[lane + 64 * j];
        const f32x4 y = v[j] * rstd * g * (sc + 1.0f) + sh; uint2 o; o.x = pk2(y.x, y.y); o.y = pk2(y.z, y.w); o8[64 * j] = o; }
}
DI void rms_mod_phase(const Ctx& C, const float* x, const float* gain, const float* mod_l, int sh_off, int sc_off, bf16* H) {
    const int gw = C.vcu * NWAVES + C.wave, NGW = C.G * NWAVES;
    for (int m = gw; m < TT; m += NGW) { const float* ml = mod_l + (size_t)(m >> 13) * 6144; rms_mod_row(x + (size_t)m * DM, gain, ml + sh_off, ml + sc_off, H + (size_t)m * DM, C.lane); }
}

DI void scan_naive(const Ctx& C, const bf16* Q, const bf16* K, const bf16* V, bf16* CROSS) {
    LAS float* Sst = (LAS float*)(C.lds);
    LAS unsigned* Qs = (LAS unsigned*)(C.lds + 16384);
    LAS bf16* Ks = (LAS bf16*)(C.lds + 16384 + 32768);
    LAS float* Vs = (LAS float*)(C.lds + 16384 + 65536);
    const int tid = C.tid;
    for (int item = C.vcu; item < 256; item += C.G) {
        const int b = item >> 7, h = (item >> 5) & 3, es = item & 31;
        const float lg2 = log2f(1.0f - exp2f(-5.0f - (float)h)); const float gc = exp2f(lg2 * 64.0f);
        for (int i = tid; i < 4096; i += 512) Sst[i] = 0.f;
        __syncthreads();
        for (int n = 0; n < 128; ++n) {
            const size_t tok0 = (size_t)b * SEQ + (size_t)n * 64;
            for (int ch = tid; ch < 2048; ch += 512) { const int r = ch >> 5, c = ch & 31;
                const u32x4 q = *(const u32x4*)(Q + (tok0 + r) * 1024 + h * 256 + c * 8); *(LAS u32x4*)(Qs + r * 128 + c * 4) = q;
                const u32x4 k = *(const u32x4*)(K + (tok0 + r) * 1024 + h * 256 + c * 8); *(LAS u32x4*)((LAS unsigned*)Ks + r * 128 + c * 4) = k; }
            for (int o = tid; o < 1024; o += 512) { const int j = o >> 4, e = o & 15; Vs[o] = bf2f(V[(tok0 + j) * 2048 + h * 512 + es * 16 + e]) * exp2f(lg2 * (float)(63 - j)); }
            __syncthreads();
#pragma unroll
            for (int oo = 0; oo < 2; ++oo) { const int o = tid + oo * 512, i = o >> 4, e = o & 15; float acc = 0.f;
#pragma unroll 8
                for (int d2 = 0; d2 < 128; ++d2) { const unsigned q2 = Qs[i * 128 + d2]; acc += bflo(q2) * Sst[(2 * d2) * 16 + e] + bfhi(q2) * Sst[(2 * d2 + 1) * 16 + e]; }
                CROSS[(tok0 + i) * 2048 + h * 512 + es * 16 + e] = (bf16)f2bf(acc * exp2f(lg2 * (float)(i + 1))); }
            __syncthreads();
            { const int e = tid & 15, dg = tid >> 4; float a[8];
#pragma unroll
              for (int r = 0; r < 8; ++r) a[r] = gc * Sst[(dg + 32 * r) * 16 + e];
#pragma unroll 4
              for (int j = 0; j < 64; ++j) { const float vz = Vs[j * 16 + e];
#pragma unroll
                  for (int r = 0; r < 8; ++r) a[r] += bf2f(Ks[j * 256 + dg + 32 * r]) * vz; }
#pragma unroll
              for (int r = 0; r < 8; ++r) Sst[(dg + 32 * r) * 16 + e] = a[r]; }
            __syncthreads();
        }
    }
}
DI void intra_naive(const Ctx& C, const bf16* Q, const bf16* K, const bf16* V, const bf16* CROSS, bf16* G) {
    LAS unsigned* Qs = (LAS unsigned*)(C.lds);
    LAS unsigned* Ks = (LAS unsigned*)(C.lds + 32768);
    LAS float* SC = (LAS float*)(C.lds + 65536);
    LAS float* red = (LAS float*)(C.lds + 65536 + 16384);
    LAS float* rs = red + 512;
    const int tid = C.tid;
    for (int item = C.vcu; item < 1024; item += C.G) {
        const int b = item >> 9, h = (item >> 7) & 3, n = item & 127;
        const float lg2 = log2f(1.0f - exp2f(-5.0f - (float)h));
        const size_t tok0 = (size_t)b * SEQ + (size_t)n * 64;
        for (int ch = tid; ch < 2048; ch += 512) { const int r = ch >> 5, c = ch & 31;
            *(LAS u32x4*)(Qs + r * 128 + c * 4) = *(const u32x4*)(Q + (tok0 + r) * 1024 + h * 256 + c * 8);
            *(LAS u32x4*)(Ks + r * 128 + c * 4) = *(const u32x4*)(K + (tok0 + r) * 1024 + h * 256 + c * 8); }
        __syncthreads();
        { const int i = tid >> 3, jb = (tid & 7) * 8;
#pragma unroll
          for (int jj = 0; jj < 8; ++jj) { const int j = jb + jj; float acc = 0.f;
#pragma unroll 8
              for (int d2 = 0; d2 < 128; ++d2) { const unsigned q2 = Qs[i * 128 + d2], k2 = Ks[j * 128 + d2]; acc += bflo(q2) * bflo(k2) + bfhi(q2) * bfhi(k2); }
              const int dd = i > j ? i - j : j - i; SC[i * 64 + j] = acc * exp2f(lg2 * (float)dd); } }
        __syncthreads();
#pragma unroll 1
        for (int pass = 0; pass < 2; ++pass) { const int e = tid, ib = pass * 32; float y[32];
#pragma unroll
          for (int i = 0; i < 32; ++i) y[i] = 0.f;
          const bf16* vp = V + tok0 * 2048 + h * 512 + e;
#pragma unroll 1
          for (int j4 = 0; j4 < 16; ++j4) {
              const float v0 = bf2f(vp[(size_t)(4 * j4 + 0) * 2048]), v1 = bf2f(vp[(size_t)(4 * j4 + 1) * 2048]), v2 = bf2f(vp[(size_t)(4 * j4 + 2) * 2048]), v3 = bf2f(vp[(size_t)(4 * j4 + 3) * 2048]);
#pragma unroll
              for (int i = 0; i < 32; ++i) { const f32x4 s4 = *(const LAS f32x4*)(SC + (ib + i) * 64 + 4 * j4); y[i] += (s4.x * v0 + s4.y * v1) + (s4.z * v2 + s4.w * v3); }
          }
          const bf16* cp = CROSS + (tok0 + ib) * 2048 + h * 512 + e;
#pragma unroll
          for (int i = 0; i < 32; ++i) { y[i] += bf2f(cp[(size_t)i * 2048]); const float ss = wave_sum(y[i] * y[i]); if (C.lane == 0) red[C.wave * 64 + i] = ss; }
          __syncthreads();
          if (tid < 32) { float s = 0.f;
#pragma unroll
              for (int w = 0; w < 8; ++w) s += red[w * 64 + tid];
              rs[tid] = 1.0f / sqrtf(s * (1.0f / 512.0f) + EPS); }
          __syncthreads();
          bf16* gp = G + (tok0 + ib) * 2048 + h * 512 + e;
#pragma unroll
          for (int i = 0; i < 32; ++i) { const float g = bf2f(gp[(size_t)i * 2048]); gp[(size_t)i * 2048] = (bf16)f2bf(y[i] * rs[i] * g); }
          __syncthreads();
        }
        __syncthreads();
    }
}
DI void peer_scores(const Ctx& C, const bf16* QP, const bf16* KEYS  , float* SCO) {
    const int gw = C.vcu * NWAVES + C.wave, NGW = C.G * NWAVES; const int fr = C.lane & 15, fq = C.lane >> 4;
    for (int it = gw; it < 1024 * 8; it += NGW) {
        const int tt = it >> 3, h = it & 7; const int tok = tt * 16 + fr;
#pragma unroll
        for (int p = 0; p < 2; ++p) {
            bf16x8 qf[4];
#pragma unroll
            for (int ks = 0; ks < 4; ++ks) qf[ks] = *(const bf16x8*)(QP + (size_t)tok * 2048 + h * 256 + p * 128 + ks * 32 + fq * 8);
            const bf16* kb = KEYS + (size_t)(h * 2 + p) * 128 * 128;
#pragma unroll
            for (int kt = 0; kt < 8; ++kt) {
                f32x4 acc = {0.f, 0.f, 0.f, 0.f};
#pragma unroll
                for (int ks = 0; ks < 4; ++ks) { const bf16x8 kf = *(const bf16x8*)(kb + (size_t)(kt * 16 + fr) * 128 + ks * 32 + fq * 8);
                    acc = __builtin_amdgcn_mfma_f32_16x16x32_bf16(kf, qf[ks], acc, 0, 0, 0); }
                *(f32x4*)(SCO + ((size_t)tok * 8 + h) * 256 + p * 128 + kt * 16 + fq * 4) = acc;
            }
        }
    }
}
template <bool HALVES> DI void select16(const float (&v)[4], int lane, bool (&sel)[4], int (&pos)[4]) {
    float mx = fmaxf(fmaxf(v[0], v[1]), fmaxf(v[2], v[3])), mn = fminf(fminf(v[0], v[1]), fminf(v[2], v[3]));
#pragma unroll
    for (int o = 1; o < (HALVES ? 32 : 64); o <<= 1) { mx = fmaxf(mx, __shfl_xor(mx, o)); mn = fminf(mn, __shfl_xor(mn, o)); }
    const bool up = HALVES && lane >= 32;
    float lo = mn, hi = mx, thr = mn; bool done = false;
    for (int iter = 0; iter < 48; ++iter) {
        const float mid = done ? thr : 0.5f * (lo + hi);
        int cnt = 0;
#pragma unroll
        for (int c = 0; c < 4; ++c) { const unsigned long long m = __ballot(v[c] >= mid);
            cnt += HALVES ? (up ? __popc((unsigned)(m >> 32)) : __popc((unsigned)m)) : __popcll(m); }
        if (!done) { if (cnt == 16) { thr = mid; done = true; } else if (cnt > 16) { lo = mid; thr = mid; } else hi = mid; }
        if (__all(done)) break;
    }
    int base = 0;
#pragma unroll
    for (int c = 0; c < 4; ++c) { sel[c] = v[c] >= thr; const unsigned long long m = __ballot(sel[c]);
        const unsigned long long gm = HALVES ? (up ? (m >> 32) : (m & 0xffffffffull)) : m; const int ll = HALVES ? (lane & 31) : lane;
        pos[c] = base + __popcll(gm & ((1ull << ll) - 1ull)); base += __popcll(gm); sel[c] = sel[c] && pos[c] < 16; }
}
DI void peer_topk(const Ctx& C, const float* SCO, int* IDX, float* GATE) {
    LAS float* sv = (LAS float*)(C.lds + C.wave * 512);
    LAS int* si = (LAS int*)(C.lds + C.wave * 512 + 128);
    LAS float* fv = (LAS float*)(C.lds + C.wave * 512 + 256);
    LAS int* fi = (LAS int*)(C.lds + C.wave * 512 + 320);
    const int gw = C.vcu * NWAVES + C.wave, NGW = C.G * NWAVES, lane = C.lane;
    for (int it = gw; it < TT * 8; it += NGW) {
        const f32x4 s4 = *(const f32x4*)(SCO + (size_t)it * 256 + lane * 4);
        float v[4] = {s4.x, s4.y, s4.z, s4.w}; bool sel[4]; int pos[4];
        select16<true>(v, lane, sel, pos);
        const int p = lane >> 5;
#pragma unroll
        for (int c = 0; c < 4; ++c) if (sel[c]) { sv[p * 16 + pos[c]] = v[c]; si[p * 16 + pos[c]] = (lane & 31) * 4 + c; }
        LDS_WAIT();
        const int a = lane >> 2, bq = (lane & 3) * 4; const float va = sv[a]; const int ia = si[a];
        float w[4]; int wi[4];
#pragma unroll
        for (int c = 0; c < 4; ++c) { w[c] = va + sv[16 + bq + c]; wi[c] = ia * 128 + si[16 + bq + c]; }
        select16<false>(w, lane, sel, pos);
#pragma unroll
        for (int c = 0; c < 4; ++c) if (sel[c]) { fv[pos[c]] = w[c]; fi[pos[c]] = wi[c]; }
        LDS_WAIT();
        const float x = fv[lane & 15]; const int xi = fi[lane & 15];
        float m = x;
#pragma unroll
        for (int o = 1; o < 16; o <<= 1) m = fmaxf(m, __shfl_xor(m, o));
        const float e = __expf(x - m); float s = e;
#pragma unroll
        for (int o = 1; o < 16; o <<= 1) s += __shfl_xor(s, o);
        if (lane < 16) { IDX[(size_t)it * 16 + lane] = xi; GATE[(size_t)it * 16 + lane] = e / s; }
        LDS_WAIT();
    }
}
template <bool FINAL> DI void peer_gather(const Ctx& C, const bf16* H, const int* IDX, const float* GATE, const bf16* PU, const bf16* PV, float* X, const float* g2  ,
                                          const float* ngain, const float* nmod  , bf16* Hn) {
    const int gw = C.vcu * NWAVES + C.wave, NGW = C.G * NWAVES, lane = C.lane;
    for (int t = gw; t < TT; t += NGW) {
        float hv[16];
        { const u32x4 a = *(const u32x4*)(H + (size_t)t * 1024 + lane * 8), bq = *(const u32x4*)(H + (size_t)t * 1024 + 512 + lane * 8);
          hv[0] = bflo(a.x); hv[1] = bfhi(a.x); hv[2] = bflo(a.y); hv[3] = bfhi(a.y); hv[4] = bflo(a.z); hv[5] = bfhi(a.z); hv[6] = bflo(a.w); hv[7] = bfhi(a.w);
          hv[8] = bflo(bq.x); hv[9] = bfhi(bq.x); hv[10] = bflo(bq.y); hv[11] = bfhi(bq.y); hv[12] = bflo(bq.z); hv[13] = bfhi(bq.z); hv[14] = bflo(bq.w); hv[15] = bfhi(bq.w); }
        const int i0 = IDX[(size_t)t * 128 + lane], i1 = IDX[(size_t)t * 128 + 64 + lane];
        const float g0 = GATE[(size_t)t * 128 + lane], g1 = GATE[(size_t)t * 128 + 64 + lane];
        float a0 = 0.f, a1 = 0.f;
        for (int k = 0; k < 128; k += 4) {
            float dsum[4];
#pragma unroll
            for (int kk = 0; kk < 4; ++kk) { const int kq = k + kk; const int e = kq < 64 ? __builtin_amdgcn_readlane(i0, kq) : __builtin_amdgcn_readlane(i1, kq - 64);
                const bf16* ur = PU + (size_t)e * 1024; const u32x4 a = *(const u32x4*)(ur + lane * 8), bq = *(const u32x4*)(ur + 512 + lane * 8);
                float d = bflo(a.x) * hv[0] + bfhi(a.x) * hv[1]; d += bflo(a.y) * hv[2] + bfhi(a.y) * hv[3]; d += bflo(a.z) * hv[4] + bfhi(a.z) * hv[5]; d += bflo(a.w) * hv[6] + bfhi(a.w) * hv[7];
                d += bflo(bq.x) * hv[8] + bfhi(bq.x) * hv[9]; d += bflo(bq.y) * hv[10] + bfhi(bq.y) * hv[11]; d += bflo(bq.z) * hv[12] + bfhi(bq.z) * hv[13]; d += bflo(bq.w) * hv[14] + bfhi(bq.w) * hv[15];
                dsum[kk] = d; }
#pragma unroll
            for (int kk = 0; kk < 4; ++kk) { const int kq = k + kk; const float d = gelu_t(wave_sum(dsum[kk]));
                if (kq < 64) { if (lane == kq) a0 = d * g0; } else { if (lane == kq - 64) a1 = d * g1; } }
        }
        float o[16];
#pragma unroll
        for (int j = 0; j < 16; ++j) o[j] = 0.f;
        for (int k = 0; k < 128; k += 4) {
#pragma unroll
            for (int kk = 0; kk < 4; ++kk) { const int kq = k + kk; const int e = kq < 64 ? __builtin_amdgcn_readlane(i0, kq) : __builtin_amdgcn_readlane(i1, kq - 64);
                const float ak = __int_as_float(kq < 64 ? __builtin_amdgcn_readlane(__float_as_int(a0), kq) : __builtin_amdgcn_readlane(__float_as_int(a1), kq - 64));
                const bf16* vr = PV + (size_t)e * 1024; const u32x4 a = *(const u32x4*)(vr + lane * 8), bq = *(const u32x4*)(vr + 512 + lane * 8);
                o[0] += ak * bflo(a.x); o[1] += ak * bfhi(a.x); o[2] += ak * bflo(a.y); o[3] += ak * bfhi(a.y); o[4] += ak * bflo(a.z); o[5] += ak * bfhi(a.z); o[6] += ak * bflo(a.w); o[7] += ak * bfhi(a.w);
                o[8] += ak * bflo(bq.x); o[9] += ak * bfhi(bq.x); o[10] += ak * bflo(bq.y); o[11] += ak * bfhi(bq.y); o[12] += ak * bflo(bq.z); o[13] += ak * bfhi(bq.z); o[14] += ak * bflo(bq.w); o[15] += ak * bfhi(bq.w); }
        }
#ifdef DBG_ZERO_PEER
#pragma unroll
        for (int j = 0; j < 16; ++j) o[j] = 0.f;
#endif
        const int b = t >> 13; const float* gp = g2 + (size_t)b * 6144; float* xr = X + (size_t)t * 1024;
        float xn[16]; float ss = 0.f;
#pragma unroll
        for (int q = 0; q < 4; ++q) { const int col = (q >> 1) * 512 + lane * 8 + (q & 1) * 4; const f32x4 xv = *(const f32x4*)(xr + col), gv = *(const f32x4*)(gp + col);
#pragma unroll
            for (int j = 0; j < 4; ++j) { const float y = xv[j] + gv[j] * o[q * 4 + j]; xn[q * 4 + j] = y; ss += y * y; } }
        const float rstd = 1.0f / sqrtf(wave_sum(ss) * (1.0f / 1024.0f) + EPS);
        if (FINAL) {
#pragma unroll
            for (int q = 0; q < 4; ++q) { const int col = (q >> 1) * 512 + lane * 8 + (q & 1) * 4; const f32x4 gn = *(const f32x4*)(ngain + col); f32x4 y;
#pragma unroll
                for (int j = 0; j < 4; ++j) y[j] = xn[q * 4 + j] * rstd * gn[j];
                *(f32x4*)(xr + col) = y; }
        } else {
            const float* nm = nmod + (size_t)b * 6144;
#pragma unroll
            for (int q = 0; q < 4; ++q) { const int col = (q >> 1) * 512 + lane * 8 + (q & 1) * 4; const f32x4 gn = *(const f32x4*)(ngain + col), sh = *(const f32x4*)(nm + col), sc = *(const f32x4*)(nm + 1024 + col); f32x4 xo; float y[4];
#pragma unroll
                for (int j = 0; j < 4; ++j) { xo[j] = xn[q * 4 + j]; y[j] = xn[q * 4 + j] * rstd * gn[j] * (1.0f + sc[j]) + sh[j]; }
                *(f32x4*)(xr + col) = xo; uint2 w; w.x = pk2(y[0], y[1]); w.y = pk2(y[2], y[3]); *(uint2*)(Hn + (size_t)t * 1024 + col) = w; }
        }
    }
}
DI void sgu_gate_naive(const Ctx& C, bf16* U, const bf16* VB, const float* stats, const float* w_s, const float* b_s, const float* ln_g, const float* ln_b) {
    LAS float* Wm = (LAS float*)(C.lds);
    LAS float* mu = (LAS float*)(C.lds + 65536);
    LAS float* rsd = mu + 128;
    const int tid = C.tid;
    for (int item = C.vcu; item < 1024; item += C.G) {
        const int n = item >> 3, g = item & 7; const size_t row0 = (size_t)n * 128;
        for (int i = tid; i < 16384; i += 512) { const int r = i >> 7, c = i & 127; const float w = w_s[(size_t)g * 16384 + i]; Wm[i] = (r < 64 && c >= 64) ? 0.f : w; }
        if (tid < 128) { const float* sp = stats + (row0 + tid) * 96; float s1 = 0.f, s2 = 0.f;
            for (int q = 0; q < 48; ++q) { s1 += sp[2 * q]; s2 += sp[2 * q + 1]; }
            const float m = s1 * (1.0f / 3072.0f); const float var = s2 * (1.0f / 3072.0f) - m * m; mu[tid] = m; rsd[tid] = 1.0f / sqrtf(fmaxf(var, 0.f) + EPS); }
        __syncthreads();
        if (tid < 384) {
            const int col = g * 384 + tid; const float lg = ln_g[col], lb = ln_b[col];
#pragma unroll
            for (int pass = 0; pass < 2; ++pass) {
                float acc[64];
#pragma unroll
                for (int i = 0; i < 64; ++i) acc[i] = 0.f;
                const int jmax = pass == 0 ? 64 : 128;
                for (int j = 0; j < jmax; ++j) { const float v = bf2f(VB[(row0 + j) * 3072 + col]); const float vl = (v - mu[j]) * rsd[j] * lg + lb;
#pragma unroll
                    for (int i = 0; i < 64; ++i) acc[i] += Wm[(pass * 64 + i) * 128 + j] * vl; }
#pragma unroll
                for (int i = 0; i < 64; ++i) { const int r = pass * 64 + i; const float s = acc[i] + b_s[g * 128 + r]; bf16* up = U + (row0 + r) * 3072 + col; *up = (bf16)f2bf(bf2f(*up) * s); }
            }
        }
        __syncthreads();
    }
}
#ifndef PHMASK
#define PHMASK 0xFFFFFFu
#endif
#define PH(k) ((PHMASK >> (k)) & 1u)
struct Args { const void* in[21]; float* out; unsigned char* ws; };
__global__ void __launch_bounds__(NWAVES * 64, 2) mk_fwd(Args args) {
    extern __shared__ __attribute__((aligned(16))) unsigned char lds[];
    Ctx C; C.lds = (LAS unsigned char*)lds; C.tid = threadIdx.x; C.lane = C.tid & 63; C.wave = __builtin_amdgcn_readfirstlane(C.tid >> 6);
    C.G = gridDim.x; { const int bx = blockIdx.x; C.vcu = (C.G % 8 == 0) ? (bx % 8) * (C.G / 8) + bx / 8 : bx; }
    C.ws = args.ws;
    volatile LAS unsigned* MISC = (volatile LAS unsigned*)(C.lds + MISC_OFF);
    gu32* ctl = (gu32*)(args.ws + WS_CTL);
    for (int u = C.tid; u < (LDS_BYTES - LDSCTL_OFF) / 4; u += NWAVES * 64) ((LAS unsigned*)(C.lds + LDSCTL_OFF))[u] = 0u;
    __syncthreads();
    XcdBarrier bar = xcd_barrier_post((unsigned*)(ctl + CW_BAR), MISC + 8);
#define GRID_BAR() do { xcd_barrier(bar); asm volatile("" : "+v"(C.tid)); C.lane = C.tid & 63; C.wave = __builtin_amdgcn_readfirstlane(C.tid >> 6); } while (0)
    { LAS unsigned long long* PT = (LAS unsigned long long*)(C.lds + PTR_OFF);
      if (C.tid == 0) {
#pragma unroll
          for (int i = 0; i < 21; ++i) PT[i] = (unsigned long long)args.in[i];
      } }
    __syncthreads();
#define INP(T, i) ((const T*)ldp(C, i))
    float* out = args.out; unsigned char* ws = args.ws;
#define MODP ((float*)(ws + WS_MOD))
#define MOD0 ((const float*)(ws + WS_MOD))
#define MOD1 ((const float*)(ws + WS_MOD) + 2 * 6144)
#define cosT ((float*)(ws + WS_COS))
#define sinT ((float*)(ws + WS_SIN))
#define WRI ((bf16*)(ws + WS_WRI))
#define WRO ((bf16*)(ws + WS_WRO))
#define WSI ((bf16*)(ws + WS_WSI))
#define WSO ((bf16*)(ws + WS_WSO))
#define WQ ((bf16*)(ws + WS_WQ))
#define KEYS ((bf16*)(ws + WS_KEYS))
#define STATS ((float*)(ws + WS_STATS))
#define IDX ((int*)(ws + WS_IDX))
#define GATE ((float*)(ws + WS_GATE))
#define H ((bf16*)(ws + WS_H))
#define PU ((bf16*)(ws + WS_PU))
#define PV ((bf16*)(ws + WS_PV))
#define Qb ((bf16*)(ws + WS_Q))
#define Kb ((bf16*)(ws + WS_K))
#define Vb ((bf16*)(ws + WS_V))
#define Gb ((bf16*)(ws + WS_G))
#define CROSS ((bf16*)(ws + WS_CROSS))
#define QP ((bf16*)(ws + WS_QP))
#define SCO ((float*)(ws + WS_SC))
#define Ub ((bf16*)(ws + WS_U))
#define VBb ((bf16*)(ws + WS_VB))

    { P0In I; I.c = INP(float, 1); I.ada_w = INP(float, 5); I.ada_b = INP(float, 6); I.ret_w_in = INP(float, 7); I.ret_w_out = INP(float, 8); I.sgu_w_in = INP(float, 9); I.sgu_w_out = INP(float, 15); I.wq = INP(float, 16); I.keys = INP(float, 17); I.pu = INP(float, 18); I.pv = INP(float, 19); I.pos = INP(int, 2);
      if (PH(0)) p0_prologue(C, I); }
    GRID_BAR();
    if (PH(1)) rms_mod_phase(C, INP(float, 0), INP(float, 3), MOD0, 0, 1024, H);
    GRID_BAR();
    { pg8::Gemm g{H, WRI, TT, 6144, 1024}; pg8::StaticOrder S; S.init(TT, 6144, C.G, (int)blockIdx.x);
      pg8::EpiRetProj E{Qb, Kb, Vb, Gb, cosT, sinT};
      if (PH(2)) pg8::gemm_phase<pg8::EpiRetProj, pg8::StaticOrder, true, true>(C.lds + RING_OFF, g, S, E); }
    GRID_BAR();
    if (PH(3)) scan_naive(C, Qb, Kb, Vb, CROSS);
    GRID_BAR();
    if (PH(4)) intra_naive(C, Qb, Kb, Vb, CROSS, Gb);
    GRID_BAR();
    { pg8::Gemm g{Gb, WRO, TT, 1024, 2048}; pg8::StaticOrder S; S.init(TT, 1024, C.G, (int)blockIdx.x);
      pg8::EpiResGate E{INP(float, 0), out, MOD0 + 2048, 6144};
      if (PH(5)) pg8::gemm_phase<pg8::EpiResGate, pg8::StaticOrder, true, true>(C.lds + RING_OFF, g, S, E); }
    GRID_BAR();
    if (PH(6)) rms_mod_phase(C, out, INP(float, 4), MOD0, 3072, 4096, H);
    GRID_BAR();
    { pg8::Gemm g{H, WQ, TT, 2048, 1024}; pg8::StaticOrder S; S.init(TT, 2048, C.G, (int)blockIdx.x);
      pg8::EpiBf16<0> E{QP, 2048, nullptr, 0, 0, 1.f};
      if (PH(7)) pg8::gemm_phase<pg8::EpiBf16<0>, pg8::StaticOrder, true, true>(C.lds + RING_OFF, g, S, E); }
    GRID_BAR();
    if (PH(8)) peer_scores(C, QP, KEYS, SCO);
    GRID_BAR();
    if (PH(9)) peer_topk(C, SCO, IDX, GATE);
    GRID_BAR();
    if (PH(10)) peer_gather<false>(C, H, IDX, GATE, PU, PV, out, MOD0 + 5120, INP(float, 3) + 1024, MOD1, H);
    GRID_BAR();
    { pg8::Gemm g{H, WSI, TT, 6144, 1024}; pg8::StaticOrder S; S.init(TT, 6144, C.G, (int)blockIdx.x);
      pg8::EpiSguIn E{Ub, VBb, INP(float, 10), STATS};
      if (PH(11)) pg8::gemm_phase<pg8::EpiSguIn, pg8::StaticOrder, true, true>(C.lds + RING_OFF, g, S, E); }
    GRID_BAR();
    if (PH(12)) sgu_gate_naive(C, Ub, VBb, STATS, INP(float, 13), INP(float, 14), INP(float, 11), INP(float, 12));
    GRID_BAR();
    { pg8::Gemm g{Ub, WSO, TT, 1024, 3072}; pg8::StaticOrder S; S.init(TT, 1024, C.G, (int)blockIdx.x);
      pg8::EpiResGate E{out, out, MOD1 + 2048, 6144};
      if (PH(13)) pg8::gemm_phase<pg8::EpiResGate, pg8::StaticOrder, true, true>(C.lds + RING_OFF, g, S, E); }
    GRID_BAR();
    if (PH(14)) rms_mod_phase(C, out, INP(float, 4) + 1024, MOD1, 3072, 4096, H);
    GRID_BAR();
    { pg8::Gemm g{H, WQ + (size_t)2048 * 1024, TT, 2048, 1024}; pg8::StaticOrder S; S.init(TT, 2048, C.G, (int)blockIdx.x);
      pg8::EpiBf16<0> E{QP, 2048, nullptr, 0, 0, 1.f};
      if (PH(15)) pg8::gemm_phase<pg8::EpiBf16<0>, pg8::StaticOrder, true, true>(C.lds + RING_OFF, g, S, E); }
    GRID_BAR();
    if (PH(16)) peer_scores(C, QP, KEYS + (size_t)8 * 2 * 128 * 128, SCO);
    GRID_BAR();
    if (PH(17)) peer_topk(C, SCO, IDX, GATE);
    GRID_BAR();
    if (PH(18)) peer_gather<true>(C, H, IDX, GATE, PU + (size_t)16384 * 1024, PV + (size_t)16384 * 1024, out, MOD1 + 5120, INP(float, 20), nullptr, nullptr);
#undef GRID_BAR
}

extern "C" void kernel_launch(void* const* d_in, const int* in_sizes, int n_in, void* d_out, int out_size, void* d_ws, size_t ws_size, hipStream_t stream) {
    static int grid = 0;
    if (grid == 0) {
        if (n_in != 21 || in_sizes[0] != TT * DM || out_size != TT * DM || ws_size < WS_END) { fprintf(stderr, "kernel_launch: unexpected shapes/workspace: n_in %d in0 %d out %d ws %zu (need %zu)\n", n_in, n_in > 0 ? in_sizes[0] : -1, out_size, ws_size, (size_t)WS_END); grid = -1; return; }
        int dev = 0, cus = 0;
        if (hipGetDevice(&dev) != hipSuccess || hipDeviceGetAttribute(&cus, hipDeviceAttributeMultiprocessorCount, dev) != hipSuccess) { fprintf(stderr, "kernel_launch: device query failed\n"); grid = -1; return; }
        if (hipFuncSetAttribute((const void*)mk_fwd, hipFuncAttributeMaxDynamicSharedMemorySize, LDS_BYTES) != hipSuccess) { fprintf(stderr, "kernel_launch: hipFuncSetAttribute failed\n"); grid = -1; return; }
        (void)hipGetLastError();
        grid = cus;
    }
    if (grid < 0) return;
    if (hipMemsetAsync((char*)d_ws + WS_CTL, 0, CTL_ZERO_BYTES, stream) != hipSuccess) { fprintf(stderr, "kernel_launch: memset failed\n"); return; }
    Args a; memset(&a, 0, sizeof(a));
    for (int i = 0; i < 21; ++i) a.in[i] = d_in[i];
    a.out = (float*)d_out; a.ws = (unsigned char*)d_ws;
    hipLaunchKernelGGL(mk_fwd, dim3(grid), dim3(NWAVES * 64), LDS_BYTES, stream, a);
    const hipError_t le = hipPeekAtLastError();
    if (le != hipSuccess) fprintf(stderr, "kernel_launch: launch failed: %s\n", hipGetErrorName(le));
}
```

```cpp
#define USE_GATHER_ROUNDS 1
#include <hip/hip_runtime.h>
#include <cstdio>
#include <cstdint>
#include <cstring>
#include <cmath>
namespace pg8 {
#define PG8_LAS __attribute__((address_space(3)))
typedef unsigned short bf16_t;
typedef short bf16x8 __attribute__((ext_vector_type(8)));
typedef float f32x4 __attribute__((ext_vector_type(4)));
typedef unsigned u32x4 __attribute__((ext_vector_type(4)));
constexpr int BM = 256, BK = 64, HALF = 128, HTB = HALF * BK * 2  , STAGE_BYTES = 8 * HTB, NXCD = 8, WGM = 8;

__host__ __device__ __forceinline__ int lds_byte(int r, int c) { const int st = (r >> 4) * 2 + (c >> 5), rr = r & 15, cc = c & 31, ob = rr * 64 + cc * 2; return st * 1024 + (ob ^ (((ob >> 9) & 1) << 5)); }
__host__ __device__ __forceinline__ void stage_rc(int b, int& R, int& C) { const int st = b / 1024, sb = b % 1024, swz = sb ^ (((sb >> 9) & 1) << 5); R = (st >> 1) * 16 + swz / 64; C = (st & 1) * 32 + (swz % 64) / 2; }
__host__ __device__ __forceinline__ int perm32(int rho) { const int n = rho >> 4, i = rho & 15; return 8 * (i >> 2) + 4 * n + (i & 3); }

struct Unit { int pm, pn; };
struct Gemm { const bf16_t* A; const bf16_t* Bt; int M, N, K; };

struct StaticOrder {
    int nM, nN, nwg, G, c;
    __host__ __device__ void init(int M, int N, int G_, int c_) { nM = M / BM; nN = N / BM; nwg = nM * nN; G = G_; c = c_; }
    __host__ __device__ bool next(int i, Unit& u) const {
        const long L = (long)i * G + c; if (L >= nwg) return false;
        int wgid = (int)L; { const int q = nwg / NXCD, r = nwg % NXCD, xcd = wgid % NXCD, off = wgid / NXCD; wgid = (xcd < r ? xcd * (q + 1) : r * (q + 1) + (xcd - r) * q) + off; }
        const int nig = WGM * nN, gid = wgid / nig, fm = gid * WGM, gsz = (nM - fm) < WGM ? (nM - fm) : WGM;
        u.pm = fm + ((wgid % nig) % gsz); u.pn = (wgid % nig) / gsz; return true;
    }
    __device__ __forceinline__ void a_ready(const Unit&) const {}
    __device__ __forceinline__ void done(const Unit&) const {}
};

__device__ __forceinline__ unsigned cvt_pk_bf16(float lo, float hi) { unsigned r; asm volatile("v_cvt_pk_bf16_f32 %0, %1, %2" : "=v"(r) : "v"(lo), "v"(hi)); return r; }
typedef float f32x2 __attribute__((ext_vector_type(2)));
__device__ __forceinline__ f32x2 gelu_pk(f32x2 v) {
    const f32x2 av = __builtin_elementwise_abs(v), d = av * 0.2316418882f + 1.0f;
    f32x2 t; t.x = __builtin_amdgcn_rcpf(d.x); t.y = __builtin_amdgcn_rcpf(d.y);
    f32x2 q = t * 0.5307027145f + (-0.7265760135f); q = q * t + 0.7107068705f; q = q * t + (-0.142248368f); q = q * t + 0.127414796f; q = q * t;
    const f32x2 s = (v * v) * (-0.72134752044f);
    f32x2 e; e.x = __builtin_amdgcn_exp2f(s.x); e.y = __builtin_amdgcn_exp2f(s.y);
    const f32x2 m = v * (q * e), r = v - m;
    f32x2 o; o.x = v.x < 0.f ? m.x : r.x; o.y = v.y < 0.f ? m.y : r.y; return o;
}

template <int ACT  > struct EpiBf16 {
    static constexpr bool PERM = true, AFTER_DRAIN = false; static_assert(ACT == 0 || ACT == 1, "EpiBf16: ACT is 0 (none) or 1 (gelu_pk)");
    bf16_t* O; int ldc; const float* bias; int split_cols; size_t split_stride; float scale0;
    __device__ __forceinline__ void operator()(const f32x4 (&acc)[2][2][4][2], const Unit& u, int wr, int wc, int fr, int fq) const {
        const int row0 = u.pm * BM + wr * 64 + fr; int colt = u.pn * BM; bf16_t* base = O;
        float sc = 1.f; if (split_cols) { const int t = colt / split_cols; base += (size_t)t * split_stride; colt -= t * split_cols; if (t == 0) sc = scale0; }
        const int col0 = colt + wc * 32 + 8 * fq, bcol0 = u.pn * BM + wc * 32 + 8 * fq;
        f32x4 bv[2][2];
#pragma unroll
        for (int bj = 0; bj < 2; ++bj)
#pragma unroll
            for (int n = 0; n < 2; ++n) bv[bj][n] = bias ? *(const f32x4*)(bias + bcol0 + bj * HALF + 4 * n) : (f32x4){0.f, 0.f, 0.f, 0.f};
#pragma unroll
        for (int ai = 0; ai < 2; ++ai)
#pragma unroll
            for (int m = 0; m < 4; ++m) { bf16_t* rowp = base + (size_t)(row0 + ai * HALF + m * 16) * ldc + col0;
#pragma unroll
                for (int bj = 0; bj < 2; ++bj) { f32x4 v0 = acc[ai][bj][m][0] + bv[bj][0], v1 = acc[ai][bj][m][1] + bv[bj][1];
                    if (ACT == 1) { f32x2 a = gelu_pk((f32x2){v0[0], v0[1]}), b = gelu_pk((f32x2){v0[2], v0[3]}), c = gelu_pk((f32x2){v1[0], v1[1]}), d = gelu_pk((f32x2){v1[2], v1[3]});
                        v0 = (f32x4){a.x, a.y, b.x, b.y}; v1 = (f32x4){c.x, c.y, d.x, d.y}; }
                    v0 = v0 * sc; v1 = v1 * sc; u32x4 w; w.x = cvt_pk_bf16(v0[0], v0[1]); w.y = cvt_pk_bf16(v0[2], v0[3]); w.z = cvt_pk_bf16(v1[0], v1[1]); w.w = cvt_pk_bf16(v1[2], v1[3]);
                    *(u32x4*)(rowp + bj * HALF) = w; } }
    }
};
template <class Epi, class Sched, bool ALIGN_EPI = false, bool SP2 = false>
__device__ __forceinline__ void gemm_phase(PG8_LAS unsigned char* lds, const Gemm g, const Sched& S, const Epi& E) {
    int tid_ = threadIdx.x; asm volatile("" : "+v"(tid_));
    const int tid = tid_, wid = __builtin_amdgcn_readfirstlane(tid >> 6), lane = tid & 63, wr = wid >> 2, wc = wid & 3, fr = lane & 15, fq = lane >> 4;
    const int K = g.K, nt = K / BK;
    unsigned voffA[2], voffB[2];
#pragma unroll
    for (int i = 0; i < 2; ++i) { int R, C; stage_rc(tid * 16 + i * 8192, R, C); const int Rb = Epi::PERM ? ((R & ~31) + perm32(R & 31)) : R;
        voffA[i] = (unsigned)(R * K + C) * 2u; voffB[i] = (unsigned)(Rb * K + C) * 2u; }
    const size_t kstep = (size_t)(BK * 2);
    const size_t hstep = (size_t)HALF * K * 2;
    const size_t tstep = 2 * hstep;
    const unsigned ldsw = (unsigned)wid * 1024u;
    const int aoff = lds_byte(wr * 64 + fr, fq * 8), boff = lds_byte(wc * 32 + fr, fq * 8);
#define PG8_SA(b, h) (((b) * 2 + (h)) * HTB)
#define PG8_SB(b, h) ((4 + (b) * 2 + (h)) * HTB)
#define PG8_STAGE(bufoff, gbase, voff) do { _Pragma("unroll") for (int _i = 0; _i < 2; ++_i) \
        __builtin_amdgcn_global_load_lds((const unsigned*)((const char*)(gbase) + (voff)[_i]), (PG8_LAS unsigned*)(lds + (bufoff) + ldsw + _i * 8192), 16, 0, 0); } while (0)
#define PG8_LDA(dst, b, h) do { _Pragma("unroll") for (int m = 0; m < 4; ++m) _Pragma("unroll") for (int k = 0; k < 2; ++k) dst[m][k] = *(const PG8_LAS bf16x8*)(lds + PG8_SA(b, h) + aoff + m * 2048 + k * 1024); } while (0)
#define PG8_LDB(dst, b, h) do { _Pragma("unroll") for (int n = 0; n < 2; ++n) _Pragma("unroll") for (int k = 0; k < 2; ++k) dst[n][k] = *(const PG8_LAS bf16x8*)(lds + PG8_SB(b, h) + boff + n * 2048 + k * 1024); } while (0)
#define PG8_MMA(ai, bj, At, Bt) do { __builtin_amdgcn_s_setprio(1); _Pragma("unroll") for (int m = 0; m < 4; ++m) _Pragma("unroll") for (int n = 0; n < 2; ++n) _Pragma("unroll") for (int k = 0; k < 2; ++k) \
        acc[ai][bj][m][n] = __builtin_amdgcn_mfma_f32_16x16x32_bf16(Bt[n][k], At[m][k], acc[ai][bj][m][n], 0, 0, 0); __builtin_amdgcn_s_setprio(0); } while (0)
#define PG8_WAIT_V(n) asm volatile("s_waitcnt vmcnt(" #n ")" ::: "memory")
#define PG8_WAIT_L(n) asm volatile("s_waitcnt lgkmcnt(" #n ")" ::: "memory")
#define PG8_BAR __builtin_amdgcn_s_barrier()
#define PG8_SCHED __builtin_amdgcn_sched_barrier(0)
    Unit cur, nxt; int ui = 0;
    if (!S.next(0, cur)) return;
    f32x4 acc[2][2][4][2];
#pragma unroll
    for (int a = 0; a < 2; ++a)
#pragma unroll
        for (int b = 0; b < 2; ++b)
#pragma unroll
            for (int m = 0; m < 4; ++m)
#pragma unroll
                for (int n = 0; n < 2; ++n) acc[a][b][m][n] = (f32x4){0.f, 0.f, 0.f, 0.f};
    bf16x8 At[4][2], B0[2][2], B1[2][2];
    const char* cA = (const char*)g.A + (size_t)cur.pm * tstep; const char* cB = (const char*)g.Bt + (size_t)cur.pn * tstep;
    S.a_ready(cur);
    if constexpr (SP2) {
        PG8_STAGE(PG8_SB(0, 0), cB, voffB); PG8_STAGE(PG8_SB(0, 1), cB + hstep, voffB); PG8_STAGE(PG8_SA(0, 0), cA, voffA); PG8_STAGE(PG8_SA(0, 1), cA + hstep, voffA);
        if (wr == 1) PG8_BAR;
        PG8_WAIT_V(2); PG8_BAR;
        PG8_STAGE(PG8_SB(1, 0), cB + kstep, voffB); PG8_STAGE(PG8_SA(1, 0), cA + kstep, voffA); PG8_STAGE(PG8_SB(1, 1), cB + hstep + kstep, voffB);
        PG8_WAIT_V(6); PG8_BAR;
    } else {
        PG8_STAGE(PG8_SB(0, 0), cB, voffB); PG8_STAGE(PG8_SA(0, 0), cA, voffA); PG8_STAGE(PG8_SB(0, 1), cB + hstep, voffB); PG8_STAGE(PG8_SA(0, 1), cA + hstep, voffA);
        if (wr == 1) PG8_BAR;
        PG8_WAIT_V(4); PG8_BAR;
        PG8_STAGE(PG8_SB(1, 0), cB + kstep, voffB); PG8_STAGE(PG8_SA(1, 0), cA + kstep, voffA); PG8_STAGE(PG8_SB(1, 1), cB + hstep + kstep, voffB);
        PG8_WAIT_V(6); PG8_BAR;
    }
    for (;;) {
        const bool has_next = S.next(ui + 1, nxt);
        const char* nA = has_next ? (const char*)g.A + (size_t)nxt.pm * tstep : cA; const char* nB = has_next ? (const char*)g.Bt + (size_t)nxt.pn * tstep : cB;
        for (int t = 0; t < nt; t += 2) {
            const bool last = (t == nt - 2);
            const char* a1 = cA + (size_t)(t + 1) * kstep;
            const char* a2 = last ? nA : cA + (size_t)(t + 2) * kstep; const char* b2 = last ? nB : cB + (size_t)(t + 2) * kstep;
            const char* a3 = a2 + kstep; const char* b3 = b2 + kstep;
            if (last && has_next) S.a_ready(nxt);
            if constexpr (SP2) {
            PG8_LDB(B0, 0, 0); PG8_LDB(B1, 0, 1); PG8_SCHED; PG8_LDA(At, 0, 0); PG8_STAGE(PG8_SA(1, 1), a1 + hstep, voffA);
            PG8_WAIT_V(8); PG8_WAIT_L(0); PG8_BAR; PG8_MMA(0, 0, At, B0); PG8_MMA(0, 1, At, B1); PG8_BAR; PG8_SCHED;
            PG8_LDA(At, 0, 1); PG8_STAGE(PG8_SB(0, 0), b2, voffB); PG8_STAGE(PG8_SB(0, 1), b2 + hstep, voffB); PG8_STAGE(PG8_SA(0, 0), a2, voffA);
            PG8_WAIT_V(8); PG8_WAIT_L(0); PG8_BAR; PG8_MMA(1, 0, At, B0); PG8_MMA(1, 1, At, B1); PG8_BAR; PG8_SCHED;
            PG8_LDB(B0, 1, 0); PG8_LDB(B1, 1, 1); PG8_SCHED; PG8_LDA(At, 1, 0); PG8_STAGE(PG8_SA(0, 1), a2 + hstep, voffA);
            PG8_WAIT_V(8); PG8_WAIT_L(0); PG8_BAR; PG8_MMA(0, 0, At, B0); PG8_MMA(0, 1, At, B1); PG8_BAR; PG8_SCHED;
            PG8_LDA(At, 1, 1); PG8_STAGE(PG8_SB(1, 0), b3, voffB); PG8_STAGE(PG8_SB(1, 1), b3 + hstep, voffB); PG8_STAGE(PG8_SA(1, 0), a3, voffA);
            PG8_WAIT_V(8); PG8_WAIT_L(0); PG8_BAR; PG8_MMA(1, 0, At, B0); PG8_MMA(1, 1, At, B1); PG8_BAR; PG8_SCHED;
            } else {
            PG8_LDB(B0, 0, 0); PG8_SCHED; PG8_LDA(At, 0, 0); PG8_STAGE(PG8_SA(1, 1), a1 + hstep, voffA);
            PG8_WAIT_L(8); PG8_BAR; PG8_WAIT_L(0); PG8_MMA(0, 0, At, B0); PG8_BAR; PG8_SCHED;
            PG8_LDB(B1, 0, 1); PG8_STAGE(PG8_SB(0, 0), b2, voffB);
            PG8_BAR; PG8_WAIT_L(0); PG8_MMA(0, 1, At, B1); PG8_BAR;
            PG8_LDA(At, 0, 1); PG8_STAGE(PG8_SA(0, 0), a2, voffA);
            PG8_BAR; PG8_WAIT_L(0); PG8_MMA(1, 0, At, B0); PG8_BAR; PG8_SCHED;
            PG8_STAGE(PG8_SB(0, 1), b2 + hstep, voffB);
            PG8_WAIT_V(6); PG8_BAR; PG8_MMA(1, 1, At, B1); PG8_BAR;
            PG8_LDB(B0, 1, 0); PG8_SCHED; PG8_LDA(At, 1, 0); PG8_STAGE(PG8_SA(0, 1), a2 + hstep, voffA);
            PG8_WAIT_L(8); PG8_BAR; PG8_WAIT_L(0); PG8_MMA(0, 0, At, B0); PG8_BAR; PG8_SCHED;
            PG8_LDB(B1, 1, 1); PG8_STAGE(PG8_SB(1, 0), b3, voffB);
            PG8_BAR; PG8_WAIT_L(0); PG8_MMA(0, 1, At, B1); PG8_BAR;
            PG8_LDA(At, 1, 1); PG8_STAGE(PG8_SA(1, 0), a3, voffA);
            PG8_BAR; PG8_WAIT_L(0); PG8_MMA(1, 0, At, B0); PG8_BAR; PG8_SCHED;
            PG8_STAGE(PG8_SB(1, 1), b3 + hstep, voffB);
            PG8_WAIT_V(6); PG8_BAR; PG8_MMA(1, 1, At, B1); PG8_BAR;
            }
        }
        if constexpr (ALIGN_EPI) { if (wr == 0) PG8_BAR; }
        if constexpr (!Epi::AFTER_DRAIN) { E(acc, cur, wr, wc, fr, fq); S.done(cur); }
        if (!has_next) break;
#pragma unroll
        for (int a = 0; a < 2; ++a)
#pragma unroll
            for (int b = 0; b < 2; ++b)
#pragma unroll
                for (int m = 0; m < 4; ++m)
#pragma unroll
                    for (int n = 0; n < 2; ++n) acc[a][b][m][n] = (f32x4){0.f, 0.f, 0.f, 0.f};
        cur = nxt; cA = nA; cB = nB; ++ui;
        if constexpr (ALIGN_EPI) { if (wr == 1) PG8_BAR; }
    }
    PG8_WAIT_V(0);
    if constexpr (!ALIGN_EPI) { if (wr == 0) PG8_BAR; }
    PG8_BAR;
    if constexpr (Epi::AFTER_DRAIN) { E.fused(acc, cur, wr, wc, fr, fq, lds, wid, lane); S.done(cur); }
#undef PG8_SA
#undef PG8_SB
#undef PG8_STAGE
#undef PG8_LDA
#undef PG8_LDB
#undef PG8_MMA
#undef PG8_WAIT_V
#undef PG8_WAIT_L
#undef PG8_BAR
#undef PG8_SCHED
}
}
namespace pg8 {
typedef unsigned u32x2 __attribute__((ext_vector_type(2)));
__device__ __forceinline__ float gelu_tanh(float x) {
    const float e = __builtin_amdgcn_exp2f(x * (-2.302208198f - 0.1029432397f * x * x));
    return x * __builtin_amdgcn_rcpf(1.0f + e);
}
__device__ __forceinline__ float silu_f(float x) { return x * __builtin_amdgcn_rcpf(1.0f + __builtin_amdgcn_exp2f(-1.4426950409f * x)); }

struct EpiRetProj {
    static constexpr bool PERM = false, AFTER_DRAIN = false;
    bf16_t *Q, *K, *V, *G; const float *cosT, *sinT;
    __device__ __forceinline__ void operator()(const f32x4 (&acc)[2][2][4][2], const Unit& u, int wr, int wc, int fr, int fq) const {
        const int pn = u.pn;
        if (pn < 8) {
            bf16_t* dst = pn < 4 ? Q : K; const int head = pn & 3; const float sc = pn < 4 ? 1.0f : 0.0625f;
#pragma unroll
            for (int ai = 0; ai < 2; ++ai)
#pragma unroll
                for (int m = 0; m < 4; ++m) {
                    const int row = u.pm * BM + ai * HALF + wr * 64 + m * 16 + fr;
#pragma unroll
                    for (int n = 0; n < 2; ++n) {
                        const int f0 = wc * 32 + n * 16 + fq * 4;
                        const f32x4 c4 = *(const f32x4*)(cosT + (size_t)row * 128 + f0), s4 = *(const f32x4*)(sinT + (size_t)row * 128 + f0);
                        const f32x4 x1 = acc[ai][0][m][n], x2 = acc[ai][1][m][n];
                        const f32x4 o1 = (x1 * c4 - x2 * s4) * sc, o2 = (x1 * s4 + x2 * c4) * sc;
                        u32x2 w1, w2; w1.x = cvt_pk_bf16(o1[0], o1[1]); w1.y = cvt_pk_bf16(o1[2], o1[3]); w2.x = cvt_pk_bf16(o2[0], o2[1]); w2.y = cvt_pk_bf16(o2[2], o2[3]);
                        bf16_t* p = dst + (size_t)row * 1024 + head * 256 + f0;
                        *(u32x2*)p = w1; *(u32x2*)(p + 128) = w2;
                    }
                }
        } else {
            const bool isg = pn >= 16; bf16_t* dst = isg ? G : V; const int colbase = ((pn - 8) & 7) * 256;
#pragma unroll
            for (int ai = 0; ai < 2; ++ai)
#pragma unroll
                for (int m = 0; m < 4; ++m) {
                    const int row = u.pm * BM + ai * HALF + wr * 64 + m * 16 + fr;
#pragma unroll
                    for (int bj = 0; bj < 2; ++bj)
#pragma unroll
                        for (int n = 0; n < 2; ++n) {
                            f32x4 v = acc[ai][bj][m][n];
                            if (isg) { v[0] = silu_f(v[0]); v[1] = silu_f(v[1]); v[2] = silu_f(v[2]); v[3] = silu_f(v[3]); }
                            u32x2 w; w.x = cvt_pk_bf16(v[0], v[1]); w.y = cvt_pk_bf16(v[2], v[3]);
                            *(u32x2*)(dst + (size_t)row * 2048 + colbase + bj * HALF + wc * 32 + n * 16 + fq * 4) = w;
                        }
                }
        }
    }
};
struct EpiResGate {
    static constexpr bool PERM = false, AFTER_DRAIN = false;
    const float* base; float* out; const float* gate; int gstride;
    __device__ __forceinline__ void operator()(const f32x4 (&acc)[2][2][4][2], const Unit& u, int wr, int wc, int fr, int fq) const {
        const int b = (u.pm * BM) >> 13; const float* gp = gate + (size_t)b * gstride;
        const int col0 = u.pn * BM + wc * 32 + 4 * fq;
        f32x4 gv[2][2];
#pragma unroll
        for (int bj = 0; bj < 2; ++bj)
#pragma unroll
            for (int n = 0; n < 2; ++n) gv[bj][n] = *(const f32x4*)(gp + col0 + bj * HALF + n * 16);
#pragma unroll
        for (int ai = 0; ai < 2; ++ai)
#pragma unroll
            for (int m = 0; m < 4; ++m) {
                const size_t off = (size_t)(u.pm * BM + ai * HALF + wr * 64 + m * 16 + fr) * 1024 + col0;
#pragma unroll
                for (int bj = 0; bj < 2; ++bj)
#pragma unroll
                    for (int n = 0; n < 2; ++n) { const f32x4 bs = *(const f32x4*)(base + off + bj * HALF + n * 16); *(f32x4*)(out + off + bj * HALF + n * 16) = bs + gv[bj][n] * acc[ai][bj][m][n]; }
            }
    }
};
struct EpiSguIn {
    static constexpr bool PERM = true, AFTER_DRAIN = false;
    bf16_t* U; bf16_t* Vb; const float* bias; float* stats;
    __device__ __forceinline__ void operator()(const f32x4 (&acc)[2][2][4][2], const Unit& u, int wr, int wc, int fr, int fq) const {
        const bool isv = u.pn >= 12; bf16_t* base = isv ? Vb : U; const int colt = (isv ? u.pn - 12 : u.pn) * BM;
        const int col0 = colt + wc * 32 + 8 * fq, bcol0 = u.pn * BM + wc * 32 + 8 * fq;
        f32x4 bv[2][2];
#pragma unroll
        for (int bj = 0; bj < 2; ++bj)
#pragma unroll
            for (int n = 0; n < 2; ++n) bv[bj][n] = *(const f32x4*)(bias + bcol0 + bj * HALF + 4 * n);
#pragma unroll
        for (int ai = 0; ai < 2; ++ai)
#pragma unroll
            for (int m = 0; m < 4; ++m) {
                const int row = u.pm * BM + ai * HALF + wr * 64 + m * 16 + fr;
                bf16_t* rowp = base + (size_t)row * 3072 + col0;
                float s1 = 0.f, s2 = 0.f;
#pragma unroll
                for (int bj = 0; bj < 2; ++bj) {
                    f32x4 v0 = acc[ai][bj][m][0] + bv[bj][0], v1 = acc[ai][bj][m][1] + bv[bj][1];
#pragma unroll
                    for (int j = 0; j < 4; ++j) { v0[j] = gelu_tanh(v0[j]); v1[j] = gelu_tanh(v1[j]); }
                    u32x4 w; w.x = cvt_pk_bf16(v0[0], v0[1]); w.y = cvt_pk_bf16(v0[2], v0[3]); w.z = cvt_pk_bf16(v1[0], v1[1]); w.w = cvt_pk_bf16(v1[2], v1[3]);
                    *(u32x4*)(rowp + bj * HALF) = w;
                    if (isv) {
#pragma unroll
                        for (int j = 0; j < 4; ++j) { const unsigned ww = j == 0 ? w.x : j == 1 ? w.y : j == 2 ? w.z : w.w;
                            const float a = __uint_as_float(ww << 16), bq = __uint_as_float(ww & 0xffff0000u); s1 += a + bq; s2 += a * a + bq * bq; }
                    }
                }
                if (isv) {
                    s1 += __shfl_xor(s1, 16); s1 += __shfl_xor(s1, 32); s2 += __shfl_xor(s2, 16); s2 += __shfl_xor(s2, 32);
                    if (fq == 0) { float* sp = stats + ((size_t)row * 48 + (u.pn - 12) * 4 + wc) * 2; sp[0] = s1; sp[1] = s2; }
                }
            }
    }
};
}
typedef unsigned u32x4 __attribute__((ext_vector_type(4)));
#define GAS __attribute__((address_space(1)))
#define LAS __attribute__((address_space(3)))
typedef unsigned short bf16;
typedef unsigned v4u __attribute__((ext_vector_type(4)));
typedef float f32x4 __attribute__((ext_vector_type(4)));
typedef short bf16x8 __attribute__((ext_vector_type(8)));
typedef GAS unsigned gu32;
typedef GAS unsigned long long gu64;
#define RLX_AGENT __ATOMIC_RELAXED, __HIP_MEMORY_SCOPE_AGENT
#define LDS_WAIT() asm volatile("s_waitcnt lgkmcnt(0)" ::: "memory")
#define VM_WAIT() asm volatile("s_waitcnt vmcnt(0)" ::: "memory")
__device__ __forceinline__ unsigned long long rt() { return __builtin_amdgcn_s_memrealtime(); }
__device__ __forceinline__ unsigned f2bf(float f) { unsigned u = __builtin_bit_cast(unsigned, f); return (u + 0x7fffu + ((u >> 16) & 1u)) >> 16; }
__device__ __forceinline__ unsigned pk2(float lo, float hi) { return f2bf(lo) | (f2bf(hi) << 16); }

#define XB_TMO      128
#define XB_XCNT(j)  (256  + 64 * (j))
#define XB_XSUB(j)  (1280 + 64 * (j))
#define XB_XGEN(j)  (2304 + 64 * (j))
#define XB_TOP      3328
#define XB_TOPGEN   3392
#define XCD_BAR_WORDS 3456
#define XB_SPIN_CAP (1u << 18)

__device__ __forceinline__ unsigned xb_ld(unsigned* p)              { return __hip_atomic_load(p, __ATOMIC_RELAXED, __HIP_MEMORY_SCOPE_AGENT); }
__device__ __forceinline__ unsigned xb_add(unsigned* p, unsigned v) { return __hip_atomic_fetch_add(p, v, __ATOMIC_RELAXED, __HIP_MEMORY_SCOPE_AGENT); }
__device__ __forceinline__ unsigned xb_xcc_id() { return (unsigned)__builtin_amdgcn_s_getreg((3 << 11) | 20) & 0xFu; }
#define XB_SPIN(cond, bar) do { unsigned _sp = 0; while (cond) { __builtin_amdgcn_s_sleep(1); \
    if ((++_sp & 255u) == 0u) { if (xb_ld(&(bar)[XB_TMO])) break; if (_sp > XB_SPIN_CAP) { atomicAdd(&(bar)[XB_TMO], 1u); break; } } } } while (0)

struct XcdBarrier {
    unsigned* bar; unsigned x;
    volatile LAS unsigned* st;
};

__device__ __forceinline__ XcdBarrier xcd_barrier_post(unsigned* bar, volatile LAS unsigned* st) {
    XcdBarrier b; b.bar = bar; b.x = xb_xcc_id(); b.st = st;
    if (threadIdx.x == 0) (void)xb_add(&bar[XB_XCNT(b.x)], 1u);
    return b;
}
__device__ __forceinline__ void xcd_barrier_complete(unsigned* bar, unsigned x, unsigned& nloc, unsigned& nx) {
    const unsigned G = gridDim.x * gridDim.y * gridDim.z;
    unsigned sum, cnt, mine, sp = 0u;
    for (;;) {
        sum = 0u; cnt = 0u; mine = 0u;
#pragma unroll
        for (unsigned j = 0; j < 16; ++j) { const unsigned c = xb_ld(&bar[XB_XCNT(j)]); sum += c; cnt += (c > 0u) ? 1u : 0u; mine = (j == x) ? c : mine; }
        if (sum == G) break;
        __builtin_amdgcn_s_sleep(1);
        if ((++sp & 255u) == 0u) { if (xb_ld(&bar[XB_TMO])) break; if (sp > XB_SPIN_CAP) { atomicAdd(&bar[XB_TMO], 1u); break; } }
    }
    nloc = mine > 0u ? mine : 1u; nx = cnt > 0u ? cnt : 1u;
}

__device__ __forceinline__ void xcd_barrier(const XcdBarrier& b) {
    asm volatile("s_waitcnt vmcnt(0)" ::: "memory");
    __syncthreads();
    if (threadIdx.x == 0) {
        unsigned* bar = b.bar;
        __builtin_amdgcn_s_waitcnt(0);
        unsigned nloc = b.st[0], nx = b.st[1];
        if (nloc == 0u) { xcd_barrier_complete(bar, b.x, nloc, nx); b.st[0] = nloc; b.st[1] = nx; }
        const unsigned old = xb_add(&bar[XB_XSUB(b.x)], 1u);
        const unsigned gen = old / nloc;
        if (old + 1u == (gen + 1u) * nloc) {
            __builtin_amdgcn_fence(__ATOMIC_RELEASE, "agent");
            asm volatile("s_waitcnt vmcnt(0)" ::: "memory");
            const unsigned og = xb_add(&bar[XB_TOP], 1u);
            const unsigned tg = og / nx;
            if (og + 1u == (tg + 1u) * nx) xb_add(&bar[XB_TOPGEN], 1u);
            else XB_SPIN(xb_ld(&bar[XB_TOPGEN]) == tg, bar);
            __builtin_amdgcn_fence(__ATOMIC_ACQUIRE, "agent");
            xb_add(&bar[XB_XGEN(b.x)], 1u);
            asm volatile("s_waitcnt vmcnt(0)" ::: "memory");
        } else {
            XB_SPIN(xb_ld(&bar[XB_XGEN(b.x)]) == gen, bar);
            __builtin_amdgcn_fence(__ATOMIC_ACQUIRE, "agent");
            asm volatile("s_waitcnt vmcnt(0)" ::: "memory");
        }
    }
    __syncthreads();
}
__device__ __forceinline__ float wave_sum(float v) {
#pragma unroll
    for (int o = 1; o < 64; o <<= 1) v += __shfl_xor(v, o);
    return v;
}
__device__ __forceinline__ void p0_transpose_item(const float* W, int K, int N, bf16* WT, int row_off, LAS float* scr, int item, int lane) {
    const int nblk = N / 32, kb = item / nblk, nb = item % nblk, k0 = 64 * kb, n0 = 32 * nb;
#pragma unroll 8
    for (int i = 0; i < 32; ++i) { const int kk = 2 * i + (lane >> 5); scr[kk * 33 + (lane & 31)] = W[(size_t)(k0 + kk) * N + n0 + (lane & 31)]; }
    LDS_WAIT(); asm volatile("" ::: "memory");
    const int c = lane & 7;
#pragma unroll
    for (int j = 0; j < 4; ++j) { const int n = (lane >> 3) + 8 * j; const LAS float* s = scr + (8 * c) * 33 + n;
        v4u o; o.x = pk2(s[0 * 33], s[1 * 33]); o.y = pk2(s[2 * 33], s[3 * 33]); o.z = pk2(s[4 * 33], s[5 * 33]); o.w = pk2(s[6 * 33], s[7 * 33]);
        *(GAS v4u*)(WT + (size_t)(row_off + n0 + n) * K + k0 + 8 * c) = o; }
    LDS_WAIT(); asm volatile("" ::: "memory");
}
#define DI __device__ __forceinline__
constexpr int NWAVES = 8;
constexpr int TT = 16384, DM = 1024, SEQ = 8192;
constexpr size_t MiB = 1u << 20;
constexpr size_t WS_CTL = 0, CTL_ZERO_BYTES = 32768, WS_MOD = 512 * 1024;
constexpr size_t WS_COS = 2 * MiB, WS_SIN = 10 * MiB;
constexpr size_t WS_WRI = 18 * MiB, WS_WRO = 30 * MiB, WS_WSI = 34 * MiB, WS_WSO = 46 * MiB, WS_WQ = 52 * MiB, WS_KEYS = 60 * MiB;
constexpr size_t WS_ISU = 61 * MiB, WS_ISV = 61 * MiB + 256 * 1024;
constexpr size_t WS_STATS = 62 * MiB, WS_IDX = 68 * MiB, WS_GATE = 76 * MiB, WS_H = 84 * MiB, WS_PU = 116 * MiB, WS_PV = 180 * MiB;
constexpr size_t WS_R = 244 * MiB;
constexpr size_t WS_Q = WS_R, WS_K = WS_R + 32 * MiB, WS_V = WS_R + 64 * MiB, WS_G = WS_R + 128 * MiB, WS_CROSS = WS_R + 192 * MiB;
constexpr size_t WS_QP = WS_R, WS_SC = WS_R + 64 * MiB;
constexpr size_t WS_U = WS_R, WS_VB = WS_R + 96 * MiB;
constexpr size_t WS_END = 500 * MiB;
constexpr int CW_TMO = 0, CW_BAR = 4096;
constexpr int RING_OFF = 0, RING_BYTES = 131072, LDS_BYTES = 163840, LDSCTL_OFF = LDS_BYTES - 1024, MISC_OFF = LDSCTL_OFF + 320;
constexpr int PTR_OFF = LDSCTL_OFF + 512;
constexpr float EPS = 1e-6f;
typedef float f32x2_t __attribute__((ext_vector_type(2)));

DI float bf2f(bf16 h) { return __uint_as_float((unsigned)h << 16); }
DI float bflo(unsigned w) { return __uint_as_float(w << 16); }
DI float bfhi(unsigned w) { return __uint_as_float(w & 0xffff0000u); }
DI float wave_max(float v) {
#pragma unroll
    for (int o = 1; o < 64; o <<= 1) v = fmaxf(v, __shfl_xor(v, o));
    return v;
}
DI float gelu_t(float x) { return pg8::gelu_tanh(x); }

struct Ctx {
    LAS unsigned char* lds; int tid, lane, wave, vcu, G;
    unsigned char* ws;
};

DI const void* ldp(const Ctx& C, int i) {
    const unsigned long long v = ((const LAS unsigned long long*)(C.lds + PTR_OFF))[i];
    const unsigned lo = __builtin_amdgcn_readfirstlane((unsigned)v), hi = __builtin_amdgcn_readfirstlane((unsigned)(v >> 32));
    return (const void*)(((unsigned long long)hi << 32) | lo);
}
DI void cvt_rows_fp8(const float* src, unsigned char* dst, float* inv_scale, int nrows, int gw, int NGW, int lane) {
    for (int r = gw; r < nrows; r += NGW) {
        const f32x4* s = (const f32x4*)(src + (size_t)r * 1024) + lane * 4;
        f32x4 v[4]; float am = 0.f;
#pragma unroll
        for (int q = 0; q < 4; ++q) { v[q] = s[q]; am = fmaxf(am, fmaxf(fmaxf(fabsf(v[q][0]), fabsf(v[q][1])), fmaxf(fabsf(v[q][2]), fabsf(v[q][3])))); }
        am = wave_max(am);
        const int e = (int)((__float_as_uint(am) >> 23) & 0xffu) - 127;
        const bool ok = am > 1e-30f;
        const float sc = ok ? __uint_as_float((unsigned)(127 + 7 - e) << 23) : 1.0f, isc = ok ? __uint_as_float((unsigned)(127 - 7 + e) << 23) : 1.0f;
        u32x4 o;
#pragma unroll
        for (int q = 0; q < 4; ++q) { int wd = __builtin_amdgcn_cvt_pk_fp8_f32(v[q][0] * sc, v[q][1] * sc, 0, false); wd = __builtin_amdgcn_cvt_pk_fp8_f32(v[q][2] * sc, v[q][3] * sc, wd, true); o[q] = (unsigned)wd; }
        *(u32x4*)(dst + (size_t)r * 1024 + lane * 16) = o;
        if (lane == 0) inv_scale[r] = isc;
    }
}
DI void cvt_stream(const float* src, bf16* dst, size_t n4, size_t gtid, size_t gthreads) {
    const f32x4* s = (const f32x4*)src; uint2* d = (uint2*)dst;
    for (size_t i = gtid; i < n4; i += gthreads) { const f32x4 v = s[i]; uint2 o; o.x = pk2(v.x, v.y); o.y = pk2(v.z, v.w); d[i] = o; }
}
struct P0In { const float *c, *ada_w, *ada_b, *ret_w_in, *ret_w_out, *sgu_w_in, *sgu_w_out, *wq, *keys, *pu, *pv; const int* pos; };
DI void p0_prologue(const Ctx& C, const P0In& I) {
    LAS float* scr = (LAS float*)(C.lds + RING_OFF + C.wave * 16384);
    const int gw = C.vcu * NWAVES + C.wave, NGW = C.G * NWAVES;
    bf16* wri = (bf16*)(C.ws + WS_WRI); bf16* wro = (bf16*)(C.ws + WS_WRO);
    constexpr int I_RI = 16 * 192, I_RO = 32 * 32;
    constexpr int NITEMS = I_RI + I_RO;
    for (int it = gw; it < NITEMS; it += NGW) {
        int r = it;
        if (r < I_RI) { p0_transpose_item(I.ret_w_in, 1024, 6144, wri, 0, scr, r, C.lane); continue; } r -= I_RI;
        p0_transpose_item(I.ret_w_out, 2048, 1024, wro, 0, scr, r, C.lane);
    }
    const size_t gtid = (size_t)C.vcu * 512 + C.tid, gth = (size_t)C.G * 512;
    cvt_stream(I.keys, (bf16*)(C.ws + WS_KEYS), (size_t)2 * 8 * 2 * 128 * 128 / 4, gtid, gth);
    float* mod = (float*)(C.ws + WS_MOD);
    __syncthreads();
    for (int it = C.vcu; it < 2 * 96; it += C.G) {
        const int l = it / 96, cb = it % 96, kp = C.wave, n = cb * 64 + C.lane;
        const float* W = I.ada_w + (size_t)l * 1024 * 6144 + n;
        float a0 = 0.f, a1 = 0.f;
#pragma unroll 8
        for (int k = kp * 128; k < kp * 128 + 128; ++k) {
            const float w = W[(size_t)k * 6144]; const float c0 = I.c[k], c1 = I.c[1024 + k];
            a0 += pg8::silu_f(c0) * w; a1 += pg8::silu_f(c1) * w;
        }
        LAS float* red = (LAS float*)(C.lds + RING_OFF);
        red[(kp * 2 + 0) * 64 + C.lane] = a0; red[(kp * 2 + 1) * 64 + C.lane] = a1;
        __syncthreads();
        if (C.wave < 2) { float s = I.ada_b[l * 6144 + n];
#pragma unroll
            for (int q = 0; q < 8; ++q) s += red[(q * 2 + C.wave) * 64 + C.lane];
            mod[(size_t)(l * 2 + C.wave) * 6144 + n] = s; }
        __syncthreads();
    }
    float* cosT = (float*)(C.ws + WS_COS); float* sinT = (float*)(C.ws + WS_SIN);
    for (int it = gw; it < TT / 2; it += NGW) {
        const int row = 2 * it + (C.lane >> 5), f0 = (C.lane & 31) * 4; const float p = (float)I.pos[row];
        f32x4 cv, sv;
#pragma unroll
        for (int j = 0; j < 4; ++j) { const int f = f0 + j; double w = 1.0, bs = 0.93057204092969898;
#pragma unroll
            for (int bit = 0; bit < 7; ++bit) { if ((f >> bit) & 1) w *= bs; bs *= bs; }
            const float ang = p * (float)w; const double r = (double)ang * 0.15915494309189535; const float fr = (float)(r - floor(r)); cv[j] = __builtin_amdgcn_cosf(fr); sv[j] = __builtin_amdgcn_sinf(fr); }
        *(f32x4*)(cosT + (size_t)row * 128 + f0) = cv; *(f32x4*)(sinT + (size_t)row * 128 + f0) = sv;
    }
}
DI void side_work(const Ctx& C, const P0In& I, int nskip) {
    LAS float* scr = (LAS float*)(C.lds + RING_OFF + C.wave * 16384);
    const int gw = (C.vcu - nskip) * NWAVES + C.wave, NGW = (C.G - nskip) * NWAVES;
    bf16* wsi = (bf16*)(C.ws + WS_WSI); bf16* wso = (bf16*)(C.ws + WS_WSO); bf16* wq = (bf16*)(C.ws + WS_WQ);
    constexpr int I_SI = 16 * 192, I_SO = 48 * 32, I_Q = 16 * 64;
    constexpr int NITEMS = I_SI + I_SO + 2 * I_Q;
    for (int it = gw; it < NITEMS; it += NGW) {
        int r = it;
        if (r < I_SI) { p0_transpose_item(I.sgu_w_in, 1024, 6144, wsi, 0, scr, r, C.lane); continue; } r -= I_SI;
        if (r < I_SO) { p0_transpose_item(I.sgu_w_out, 3072, 1024, wso, 0, scr, r, C.lane); continue; } r -= I_SO;
        if (r < I_Q) { p0_transpose_item(I.wq, 1024, 2048, wq, 0, scr, r, C.lane); continue; } r -= I_Q;
        p0_transpose_item(I.wq + (size_t)1024 * 2048, 1024, 2048, wq + (size_t)2048 * 1024, 0, scr, r, C.lane);
    }
    cvt_rows_fp8(I.pu, (unsigned char*)(C.ws + WS_PU), (float*)(C.ws + WS_ISU), 2 * 16384, gw, NGW, C.lane);
    cvt_rows_fp8(I.pv, (unsigned char*)(C.ws + WS_PV), (float*)(C.ws + WS_ISV), 2 * 16384, gw, NGW, C.lane);
}
DI void rms_mod_row(const float* xrow, const float* gain, const float* shift, const float* scale, bf16* orow, int lane) {
    const f32x4* xr = (const f32x4*)xrow + lane; f32x4 v[4]; float s = 0.f;
#pragma unroll
    for (int j = 0; j < 4; ++j) { v[j] = xr[64 * j]; s += (v[j].x * v[j].x + v[j].y * v[j].y) + (v[j].z * v[j].z + v[j].w * v[j].w); }
    const float rstd = 1.0f / sqrtf(wave_sum(s) * (1.0f / 1024.0f) + EPS);
    uint2* o8 = (uint2*)orow + lane;
#pragma unroll
    for (int j = 0; j < 4; ++j) { const f32x4 g = ((const f32x4*)gain)[lane + 64 * j], sh = ((const f32x4*)shift)[lane + 64 * j], sc = ((const f32x4*)scale)[lane + 64 * j];
        const f32x4 y = v[j] * rstd * g * (sc + 1.0f) + sh; uint2 o; o.x = pk2(y.x, y.y); o.y = pk2(y.z, y.w); o8[64 * j] = o; }
}
DI void rms_mod_phase(const Ctx& C, const float* x, const float* gain, const float* mod_l, int sh_off, int sc_off, bf16* H) {
    const int gw = C.vcu * NWAVES + C.wave, NGW = C.G * NWAVES;
    for (int m = gw; m < TT; m += NGW) { const float* ml = mod_l + (size_t)(m >> 13) * 6144; rms_mod_row(x + (size_t)m * DM, gain, ml + sh_off, ml + sc_off, H + (size_t)m * DM, C.lane); }
}

DI void scan_naive(const Ctx& C, const bf16* Q, const bf16* K, const bf16* V, bf16* CROSS) {
    LAS float* Sst = (LAS float*)(C.lds);
    LAS unsigned* Qs = (LAS unsigned*)(C.lds + 16384);
    LAS bf16* Ks = (LAS bf16*)(C.lds + 16384 + 32768);
    LAS float* Vs = (LAS float*)(C.lds + 16384 + 65536);
    const int tid = C.tid;
    for (int item = C.vcu; item < 256; item += C.G) {
        const int b = item >> 7, h = (item >> 5) & 3, es = item & 31;
        const float lg2 = log2f(1.0f - exp2f(-5.0f - (float)h)); const float gc = exp2f(lg2 * 64.0f);
        for (int i = tid; i < 4096; i += 512) Sst[i] = 0.f;
        __syncthreads();
        for (int n = 0; n < 128; ++n) {
            const size_t tok0 = (size_t)b * SEQ + (size_t)n * 64;
            for (int ch = tid; ch < 2048; ch += 512) { const int r = ch >> 5, c = ch & 31;
                const u32x4 q = *(const u32x4*)(Q + (tok0 + r) * 1024 + h * 256 + c * 8); *(LAS u32x4*)(Qs + r * 128 + c * 4) = q;
                const u32x4 k = *(const u32x4*)(K + (tok0 + r) * 1024 + h * 256 + c * 8); *(LAS u32x4*)((LAS unsigned*)Ks + r * 128 + c * 4) = k; }
            for (int o = tid; o < 1024; o += 512) { const int j = o >> 4, e = o & 15; Vs[o] = bf2f(V[(tok0 + j) * 2048 + h * 512 + es * 16 + e]) * exp2f(lg2 * (float)(63 - j)); }
            __syncthreads();
#pragma unroll
            for (int oo = 0; oo < 2; ++oo) { const int o = tid + oo * 512, i = o >> 4, e = o & 15; float acc = 0.f;
#pragma unroll 8
                for (int d2 = 0; d2 < 128; ++d2) { const unsigned q2 = Qs[i * 128 + d2]; acc += bflo(q2) * Sst[(2 * d2) * 16 + e] + bfhi(q2) * Sst[(2 * d2 + 1) * 16 + e]; }
                CROSS[(tok0 + i) * 2048 + h * 512 + es * 16 + e] = (bf16)f2bf(acc * exp2f(lg2 * (float)(i + 1))); }
            __syncthreads();
            { const int e = tid & 15, dg = tid >> 4; float a[8];
#pragma unroll
              for (int r = 0; r < 8; ++r) a[r] = gc * Sst[(dg + 32 * r) * 16 + e];
#pragma unroll 4
              for (int j = 0; j < 64; ++j) { const float vz = Vs[j * 16 + e];
#pragma unroll
                  for (int r = 0; r < 8; ++r) a[r] += bf2f(Ks[j * 256 + dg + 32 * r]) * vz; }
#pragma unroll
              for (int r = 0; r < 8; ++r) Sst[(dg + 32 * r) * 16 + e] = a[r]; }
            __syncthreads();
        }
    }
}
DI void intra_naive(const Ctx& C, const bf16* Q, const bf16* K, const bf16* V, const bf16* CROSS, bf16* G) {
    LAS unsigned* Qs = (LAS unsigned*)(C.lds);
    LAS unsigned* Ks = (LAS unsigned*)(C.lds + 32768);
    LAS float* SC = (LAS float*)(C.lds + 65536);
    LAS float* red = (LAS float*)(C.lds + 65536 + 16384);
    LAS float* rs = red + 512;
    const int tid = C.tid;
    for (int item = C.vcu; item < 1024; item += C.G) {
        const int b = item >> 9, h = (item >> 7) & 3, n = item & 127;
        const float lg2 = log2f(1.0f - exp2f(-5.0f - (float)h));
        const size_t tok0 = (size_t)b * SEQ + (size_t)n * 64;
        for (int ch = tid; ch < 2048; ch += 512) { const int r = ch >> 5, c = ch & 31;
            *(LAS u32x4*)(Qs + r * 128 + c * 4) = *(const u32x4*)(Q + (tok0 + r) * 1024 + h * 256 + c * 8);
            *(LAS u32x4*)(Ks + r * 128 + c * 4) = *(const u32x4*)(K + (tok0 + r) * 1024 + h * 256 + c * 8); }
        __syncthreads();
        { const int i = tid >> 3, jb = (tid & 7) * 8;
#pragma unroll
          for (int jj = 0; jj < 8; ++jj) { const int j = jb + jj; float acc = 0.f;
#pragma unroll 8
              for (int d2 = 0; d2 < 128; ++d2) { const unsigned q2 = Qs[i * 128 + d2], k2 = Ks[j * 128 + d2]; acc += bflo(q2) * bflo(k2) + bfhi(q2) * bfhi(k2); }
              const int dd = i > j ? i - j : j - i; SC[i * 64 + j] = acc * exp2f(lg2 * (float)dd); } }
        __syncthreads();
#pragma unroll 1
        for (int pass = 0; pass < 2; ++pass) { const int e = tid, ib = pass * 32; float y[32];
#pragma unroll
          for (int i = 0; i < 32; ++i) y[i] = 0.f;
          const bf16* vp = V + tok0 * 2048 + h * 512 + e;
#pragma unroll 1
          for (int j4 = 0; j4 < 16; ++j4) {
              const float v0 = bf2f(vp[(size_t)(4 * j4 + 0) * 2048]), v1 = bf2f(vp[(size_t)(4 * j4 + 1) * 2048]), v2 = bf2f(vp[(size_t)(4 * j4 + 2) * 2048]), v3 = bf2f(vp[(size_t)(4 * j4 + 3) * 2048]);
#pragma unroll
              for (int i = 0; i < 32; ++i) { const f32x4 s4 = *(const LAS f32x4*)(SC + (ib + i) * 64 + 4 * j4); y[i] += (s4.x * v0 + s4.y * v1) + (s4.z * v2 + s4.w * v3); }
          }
          const bf16* cp = CROSS + (tok0 + ib) * 2048 + h * 512 + e;
#pragma unroll
          for (int i = 0; i < 32; ++i) { y[i] += bf2f(cp[(size_t)i * 2048]); const float ss = wave_sum(y[i] * y[i]); if (C.lane == 0) red[C.wave * 64 + i] = ss; }
          __syncthreads();
          if (tid < 32) { float s = 0.f;
#pragma unroll
              for (int w = 0; w < 8; ++w) s += red[w * 64 + tid];
              rs[tid] = 1.0f / sqrtf(s * (1.0f / 512.0f) + EPS); }
          __syncthreads();
          bf16* gp = G + (tok0 + ib) * 2048 + h * 512 + e;
#pragma unroll
          for (int i = 0; i < 32; ++i) { const float g = bf2f(gp[(size_t)i * 2048]); gp[(size_t)i * 2048] = (bf16)f2bf(y[i] * rs[i] * g); }
          __syncthreads();
        }
        __syncthreads();
    }
}
DI void peer_scores(const Ctx& C, const bf16* QP, const bf16* KEYS  , float* SCO) {
    const int gw = C.vcu * NWAVES + C.wave, NGW = C.G * NWAVES; const int fr = C.lane & 15, fq = C.lane >> 4;
    for (int it = gw; it < 1024 * 8; it += NGW) {
        const int tt = it >> 3, h = it & 7; const int tok = tt * 16 + fr;
#pragma unroll
        for (int p = 0; p < 2; ++p) {
            bf16x8 qf[4];
#pragma unroll
            for (int ks = 0; ks < 4; ++ks) qf[ks] = *(const bf16x8*)(QP + (size_t)tok * 2048 + h * 256 + p * 128 + ks * 32 + fq * 8);
            const bf16* kb = KEYS + (size_t)(h * 2 + p) * 128 * 128;
#pragma unroll
            for (int kt = 0; kt < 8; ++kt) {
                f32x4 acc = {0.f, 0.f, 0.f, 0.f};
#pragma unroll
                for (int ks = 0; ks < 4; ++ks) { const bf16x8 kf = *(const bf16x8*)(kb + (size_t)(kt * 16 + fr) * 128 + ks * 32 + fq * 8);
                    acc = __builtin_amdgcn_mfma_f32_16x16x32_bf16(kf, qf[ks], acc, 0, 0, 0); }
                *(f32x4*)(SCO + ((size_t)tok * 8 + h) * 256 + p * 128 + kt * 16 + fq * 4) = acc;
            }
        }
    }
}
template <bool HALVES> DI void select16(const float (&v)[4], int lane, bool (&sel)[4], int (&pos)[4]) {
    float mx = fmaxf(fmaxf(v[0], v[1]), fmaxf(v[2], v[3])), mn = fminf(fminf(v[0], v[1]), fminf(v[2], v[3]));
#pragma unroll
    for (int o = 1; o < (HALVES ? 32 : 64); o <<= 1) { mx = fmaxf(mx, __shfl_xor(mx, o)); mn = fminf(mn, __shfl_xor(mn, o)); }
    const bool up = HALVES && lane >= 32;
    float lo = mn, hi = mx, thr = mn; bool done = false;
    for (int iter = 0; iter < 48; ++iter) {
        const float mid = done ? thr : 0.5f * (lo + hi);
        int cnt = 0;
#pragma unroll
        for (int c = 0; c < 4; ++c) { const unsigned long long m = __ballot(v[c] >= mid);
            cnt += HALVES ? (up ? __popc((unsigned)(m >> 32)) : __popc((unsigned)m)) : __popcll(m); }
        if (!done) { if (cnt == 16) { thr = mid; done = true; } else if (cnt > 16) { lo = mid; thr = mid; } else hi = mid; }
        if (__all(done)) break;
    }
    int base = 0;
#pragma unroll
    for (int c = 0; c < 4; ++c) { sel[c] = v[c] >= thr; const unsigned long long m = __ballot(sel[c]);
        const unsigned long long gm = HALVES ? (up ? (m >> 32) : (m & 0xffffffffull)) : m; const int ll = HALVES ? (lane & 31) : lane;
        pos[c] = base + __popcll(gm & ((1ull << ll) - 1ull)); base += __popcll(gm); sel[c] = sel[c] && pos[c] < 16; }
}
DI void peer_topk(const Ctx& C, const float* SCO, int* IDX, float* GATE) {
    LAS float* sv = (LAS float*)(C.lds + C.wave * 512);
    LAS int* si = (LAS int*)(C.lds + C.wave * 512 + 128);
    LAS float* fv = (LAS float*)(C.lds + C.wave * 512 + 256);
    LAS int* fi = (LAS int*)(C.lds + C.wave * 512 + 320);
    const int gw = C.vcu * NWAVES + C.wave, NGW = C.G * NWAVES, lane = C.lane;
    for (int it = gw; it < TT * 8; it += NGW) {
        const f32x4 s4 = *(const f32x4*)(SCO + (size_t)it * 256 + lane * 4);
        float v[4] = {s4.x, s4.y, s4.z, s4.w}; bool sel[4]; int pos[4];
        select16<true>(v, lane, sel, pos);
        const int p = lane >> 5;
#pragma unroll
        for (int c = 0; c < 4; ++c) if (sel[c]) { sv[p * 16 + pos[c]] = v[c]; si[p * 16 + pos[c]] = (lane & 31) * 4 + c; }
        LDS_WAIT();
        const int a = lane >> 2, bq = (lane & 3) * 4; const float va = sv[a]; const int ia = si[a];
        float w[4]; int wi[4];
#pragma unroll
        for (int c = 0; c < 4; ++c) { w[c] = va + sv[16 + bq + c]; wi[c] = ia * 128 + si[16 + bq + c]; }
        select16<false>(w, lane, sel, pos);
#pragma unroll
        for (int c = 0; c < 4; ++c) if (sel[c]) { fv[pos[c]] = w[c]; fi[pos[c]] = wi[c]; }
        LDS_WAIT();
        const float x = fv[lane & 15]; const int xi = fi[lane & 15];
        float m = x;
#pragma unroll
        for (int o = 1; o < 16; o <<= 1) m = fmaxf(m, __shfl_xor(m, o));
        const float e = __expf(x - m); float s = e;
#pragma unroll
        for (int o = 1; o < 16; o <<= 1) s += __shfl_xor(s, o);
        if (lane < 16) { IDX[(size_t)it * 16 + lane] = xi; GATE[(size_t)it * 16 + lane] = e / s; }
        LDS_WAIT();
    }
}
template <bool FINAL> DI void peer_gather(const Ctx& C, const bf16* H, const int* IDX, const float* GATE, const bf16* PU, const bf16* PV, float* X, const float* g2  ,
                                          const float* ngain, const float* nmod  , bf16* Hn) {
    const int gw = C.vcu * NWAVES + C.wave, NGW = C.G * NWAVES, lane = C.lane;
    for (int t = gw; t < TT; t += NGW) {
        float hv[16];
        { const u32x4 a = *(const u32x4*)(H + (size_t)t * 1024 + lane * 8), bq = *(const u32x4*)(H + (size_t)t * 1024 + 512 + lane * 8);
          hv[0] = bflo(a.x); hv[1] = bfhi(a.x); hv[2] = bflo(a.y); hv[3] = bfhi(a.y); hv[4] = bflo(a.z); hv[5] = bfhi(a.z); hv[6] = bflo(a.w); hv[7] = bfhi(a.w);
          hv[8] = bflo(bq.x); hv[9] = bfhi(bq.x); hv[10] = bflo(bq.y); hv[11] = bfhi(bq.y); hv[12] = bflo(bq.z); hv[13] = bfhi(bq.z); hv[14] = bflo(bq.w); hv[15] = bfhi(bq.w); }
        const int i0 = IDX[(size_t)t * 128 + lane], i1 = IDX[(size_t)t * 128 + 64 + lane];
        const float g0 = GATE[(size_t)t * 128 + lane], g1 = GATE[(size_t)t * 128 + 64 + lane];
        float a0 = 0.f, a1 = 0.f;
        for (int k = 0; k < 128; k += 4) {
            float dsum[4];
#pragma unroll
            for (int kk = 0; kk < 4; ++kk) { const int kq = k + kk; const int e = kq < 64 ? __builtin_amdgcn_readlane(i0, kq) : __builtin_amdgcn_readlane(i1, kq - 64);
                const bf16* ur = PU + (size_t)e * 1024; const u32x4 a = *(const u32x4*)(ur + lane * 8), bq = *(const u32x4*)(ur + 512 + lane * 8);
                float d = bflo(a.x) * hv[0] + bfhi(a.x) * hv[1]; d += bflo(a.y) * hv[2] + bfhi(a.y) * hv[3]; d += bflo(a.z) * hv[4] + bfhi(a.z) * hv[5]; d += bflo(a.w) * hv[6] + bfhi(a.w) * hv[7];
                d += bflo(bq.x) * hv[8] + bfhi(bq.x) * hv[9]; d += bflo(bq.y) * hv[10] + bfhi(bq.y) * hv[11]; d += bflo(bq.z) * hv[12] + bfhi(bq.z) * hv[13]; d += bflo(bq.w) * hv[14] + bfhi(bq.w) * hv[15];
                dsum[kk] = d; }
#pragma unroll
            for (int kk = 0; kk < 4; ++kk) { const int kq = k + kk; const float d = gelu_t(wave_sum(dsum[kk]));
                if (kq < 64) { if (lane == kq) a0 = d * g0; } else { if (lane == kq - 64) a1 = d * g1; } }
        }
        float o[16];
#pragma unroll
        for (int j = 0; j < 16; ++j) o[j] = 0.f;
        for (int k = 0; k < 128; k += 4) {
#pragma unroll
            for (int kk = 0; kk < 4; ++kk) { const int kq = k + kk; const int e = kq < 64 ? __builtin_amdgcn_readlane(i0, kq) : __builtin_amdgcn_readlane(i1, kq - 64);
                const float ak = __int_as_float(kq < 64 ? __builtin_amdgcn_readlane(__float_as_int(a0), kq) : __builtin_amdgcn_readlane(__float_as_int(a1), kq - 64));
                const bf16* vr = PV + (size_t)e * 1024; const u32x4 a = *(const u32x4*)(vr + lane * 8), bq = *(const u32x4*)(vr + 512 + lane * 8);
                o[0] += ak * bflo(a.x); o[1] += ak * bfhi(a.x); o[2] += ak * bflo(a.y); o[3] += ak * bfhi(a.y); o[4] += ak * bflo(a.z); o[5] += ak * bfhi(a.z); o[6] += ak * bflo(a.w); o[7] += ak * bfhi(a.w);
                o[8] += ak * bflo(bq.x); o[9] += ak * bfhi(bq.x); o[10] += ak * bflo(bq.y); o[11] += ak * bfhi(bq.y); o[12] += ak * bflo(bq.z); o[13] += ak * bfhi(bq.z); o[14] += ak * bflo(bq.w); o[15] += ak * bfhi(bq.w); }
        }
#ifdef DBG_ZERO_PEER
#pragma unroll
        for (int j = 0; j < 16; ++j) o[j] = 0.f;
#endif
        const int b = t >> 13; const float* gp = g2 + (size_t)b * 6144; float* xr = X + (size_t)t * 1024;
        float xn[16]; float ss = 0.f;
#pragma unroll
        for (int q = 0; q < 4; ++q) { const int col = (q >> 1) * 512 + lane * 8 + (q & 1) * 4; const f32x4 xv = *(const f32x4*)(xr + col), gv = *(const f32x4*)(gp + col);
#pragma unroll
            for (int j = 0; j < 4; ++j) { const float y = xv[j] + gv[j] * o[q * 4 + j]; xn[q * 4 + j] = y; ss += y * y; } }
        const float rstd = 1.0f / sqrtf(wave_sum(ss) * (1.0f / 1024.0f) + EPS);
        if (FINAL) {
#pragma unroll
            for (int q = 0; q < 4; ++q) { const int col = (q >> 1) * 512 + lane * 8 + (q & 1) * 4; const f32x4 gn = *(const f32x4*)(ngain + col); f32x4 y;
#pragma unroll
                for (int j = 0; j < 4; ++j) y[j] = xn[q * 4 + j] * rstd * gn[j];
                *(f32x4*)(xr + col) = y; }
        } else {
            const float* nm = nmod + (size_t)b * 6144;
#pragma unroll
            for (int q = 0; q < 4; ++q) { const int col = (q >> 1) * 512 + lane * 8 + (q & 1) * 4; const f32x4 gn = *(const f32x4*)(ngain + col), sh = *(const f32x4*)(nm + col), sc = *(const f32x4*)(nm + 1024 + col); f32x4 xo; float y[4];
#pragma unroll
                for (int j = 0; j < 4; ++j) { xo[j] = xn[q * 4 + j]; y[j] = xn[q * 4 + j] * rstd * gn[j] * (1.0f + sc[j]) + sh[j]; }
                *(f32x4*)(xr + col) = xo; uint2 w; w.x = pk2(y[0], y[1]); w.y = pk2(y[2], y[3]); *(uint2*)(Hn + (size_t)t * 1024 + col) = w; }
        }
    }
}
DI void sgu_gate_naive(const Ctx& C, bf16* U, const bf16* VB, const float* stats, const float* w_s, const float* b_s, const float* ln_g, const float* ln_b) {
    LAS float* Wm = (LAS float*)(C.lds);
    LAS float* mu = (LAS float*)(C.lds + 65536);
    LAS float* rsd = mu + 128;
    const int tid = C.tid;
    for (int item = C.vcu; item < 1024; item += C.G) {
        const int n = item >> 3, g = item & 7; const size_t row0 = (size_t)n * 128;
        for (int i = tid; i < 16384; i += 512) { const int r = i >> 7, c = i & 127; const float w = w_s[(size_t)g * 16384 + i]; Wm[i] = (r < 64 && c >= 64) ? 0.f : w; }
        if (tid < 128) { const float* sp = stats + (row0 + tid) * 96; float s1 = 0.f, s2 = 0.f;
            for (int q = 0; q < 48; ++q) { s1 += sp[2 * q]; s2 += sp[2 * q + 1]; }
            const float m = s1 * (1.0f / 3072.0f); const float var = s2 * (1.0f / 3072.0f) - m * m; mu[tid] = m; rsd[tid] = 1.0f / sqrtf(fmaxf(var, 0.f) + EPS); }
        __syncthreads();
        if (tid < 384) {
            const int col = g * 384 + tid; const float lg = ln_g[col], lb = ln_b[col];
#pragma unroll
            for (int pass = 0; pass < 2; ++pass) {
                float acc[64];
#pragma unroll
                for (int i = 0; i < 64; ++i) acc[i] = 0.f;
                const int jmax = pass == 0 ? 64 : 128;
                for (int j = 0; j < jmax; ++j) { const float v = bf2f(VB[(row0 + j) * 3072 + col]); const float vl = (v - mu[j]) * rsd[j] * lg + lb;
#pragma unroll
                    for (int i = 0; i < 64; ++i) acc[i] += Wm[(pass * 64 + i) * 128 + j] * vl; }
#pragma unroll
                for (int i = 0; i < 64; ++i) { const int r = pass * 64 + i; const float s = acc[i] + b_s[g * 128 + r]; bf16* up = U + (row0 + r) * 3072 + col; *up = (bf16)f2bf(bf2f(*up) * s); }
            }
        }
        __syncthreads();
    }
}
typedef short v4i16_t __attribute__((ext_vector_type(4)));
typedef unsigned u32x2_t __attribute__((ext_vector_type(2)));
typedef __bf16 bf16x2_t __attribute__((ext_vector_type(2)));
DI unsigned cvtpk(float lo, float hi) { f32x2_t v = {lo, hi}; bf16x2_t b = __builtin_convertvector(v, bf16x2_t); return __builtin_bit_cast(unsigned, b); }
DI v4i16_t trr(const LAS unsigned char* p) { return __builtin_amdgcn_ds_read_tr16_b64_v4i16((LAS v4i16_t*)p); }
DI bf16x8 cat8(v4i16_t a, v4i16_t b) { return __builtin_shufflevector(a, b, 0, 1, 2, 3, 4, 5, 6, 7); }
DI bf16x8 pack2(const f32x4& a, const f32x4& b) { u32x4 p; p.x = cvtpk(a[0], a[1]); p.y = cvtpk(a[2], a[3]); p.z = cvtpk(b[0], b[1]); p.w = cvtpk(b[2], b[3]); return __builtin_bit_cast(bf16x8, p); }
DI u32x4 scale8(u32x4 v, float s) { u32x4 o; o.x = cvtpk(bflo(v.x) * s, bfhi(v.x) * s); o.y = cvtpk(bflo(v.y) * s, bfhi(v.y) * s); o.z = cvtpk(bflo(v.z) * s, bfhi(v.z) * s); o.w = cvtpk(bflo(v.w) * s, bfhi(v.w) * s); return o; }
constexpr int SCAN_ESL = 32, SCAN_NCW = SCAN_ESL / 16, SCAN_NSL = 512 / SCAN_ESL, SCAN_NIT = 8 * SCAN_NSL;
#define SCAN_BAR() do { asm volatile("s_waitcnt lgkmcnt(0)" ::: "memory"); __builtin_amdgcn_s_barrier(); asm volatile("" ::: "memory"); } while (0)
template <int MODE = 0> DI void scan_mfma(const Ctx& C, const bf16* Q, const bf16* K, const bf16* V, bf16* CROSS) {
    constexpr int QPI = 544, KPI = 544, VPI = SCAN_ESL * 2 + 32, VCH = SCAN_ESL / 8  , NVC = 64 * VCH;
    constexpr int OQ = 0, OK_ = 64 * QPI, OV = OK_ + 64 * KPI, BUFB = OV + 64 * VPI;
    constexpr int NST = (NWAVES - 1 - SCAN_NCW) * 64;
    const int w = C.wave;
    for (int item = C.vcu; item < SCAN_NIT; item += C.G) {
        const int b = item / (4 * SCAN_NSL), h = (item / SCAN_NSL) & 3, es = item % SCAN_NSL;
        const float lg2 = log2f(1.0f - exp2f(-5.0f - (float)h)); const float gc = exp2f(lg2 * 64.0f);
        const size_t tokb = (size_t)b * SEQ;
        if (w >= SCAN_NCW) {
            int tl_ = C.tid; asm volatile("" : "+v"(tl_));
            const int st = (w == NWAVES - 1) ? (tl_ & 63) : tl_ - SCAN_NCW * 64;
            if (w == NWAVES - 1) {
                unsigned dmy = 0u;
#define SCAN_PF1(ptr) asm volatile("global_load_dword %0, %1, off" : "+v"(dmy) : "v"(ptr) : "memory")
#define SCAN_PF(n) do { const size_t t0_ = tokb + (size_t)(n) * 64; \
                _Pragma("unroll") for (int u = 0; u < 4; ++u) { const int ln = st + 64 * u, r = ln >> 2, q = ln & 3; SCAN_PF1(Q + (t0_ + r) * 1024 + h * 256 + q * 64); SCAN_PF1(K + (t0_ + r) * 1024 + h * 256 + q * 64); } \
                SCAN_PF1(V + (t0_ + st) * 2048 + h * 512 + es * SCAN_ESL); } while (0)
                SCAN_PF(2); SCAN_PF(3); SCAN_PF(4);
                SCAN_BAR();
#pragma unroll 1
                for (int n = 0; n < 128; ++n) { if (n + 5 < 128) SCAN_PF(n + 5); SCAN_BAR(); }
                asm volatile("s_waitcnt vmcnt(0)" : "+v"(dmy) :: "memory");
#undef SCAN_PF
#undef SCAN_PF1
            } else {
            u32x4 rq_[7], rk_[7], rv_;
#define SCAN_LD(n) do { const size_t t0_ = tokb + (size_t)(n) * 64; \
            _Pragma("unroll") for (int u = 0; u < 7; ++u) { const int c = st + NST * u; if (c < 2048) { const int r = c >> 5, cc = c & 31; \
                rq_[u] = *(const u32x4*)(Q + (t0_ + r) * 1024 + h * 256 + cc * 8); rk_[u] = *(const u32x4*)(K + (t0_ + r) * 1024 + h * 256 + cc * 8); } } \
            if (st < NVC) { const int r = st / VCH, cc = st % VCH; rv_ = *(const u32x4*)(V + (t0_ + r) * 2048 + h * 512 + es * SCAN_ESL + cc * 8); } } while (0)
#define SCAN_WR(bufo) do { LAS unsigned char* B_ = C.lds + (bufo); \
            _Pragma("unroll") for (int u = 0; u < 7; ++u) { const int c = st + NST * u; if (c < 2048) { const int r = c >> 5, cc = c & 31; \
                *(LAS u32x4*)(B_ + OQ + r * QPI + cc * 16) = rq_[u]; *(LAS u32x4*)(B_ + OK_ + r * KPI + cc * 16) = rk_[u]; } } \
            if (st < NVC) { const int r = st / VCH, cc = st % VCH; *(LAS u32x4*)(B_ + OV + r * VPI + cc * 16) = scale8(rv_, exp2f(lg2 * (float)(63 - r))); } } while (0)
            SCAN_LD(0); SCAN_WR(0); SCAN_LD(1);
            SCAN_BAR();
#pragma unroll 1
            for (int n = 0; n < 128; ++n) { if (MODE != 2 && n + 1 < 128) { SCAN_WR(((n + 1) & 1) * BUFB); if (n + 2 < 128) SCAN_LD(n + 2); } SCAN_BAR(); }
#undef SCAN_LD
#undef SCAN_WR
            }
        } else {
            int tl_ = C.tid; asm volatile("" : "+v"(tl_)); const int lane = tl_ & 63, fr = lane & 15, fq = lane >> 4;
            f32x4 S[16];
#pragma unroll
            for (int t = 0; t < 16; ++t) S[t] = (f32x4){0.f, 0.f, 0.f, 0.f};
            SCAN_BAR();
#define SC_LQ(QF, DB) do { _Pragma("unroll") for (int m = 0; m < 4; ++m) QF[m] = *(const LAS bf16x8*)(Qs + (16 * m + fr) * QPI + (32 * (DB) + 8 * fq) * 2); __builtin_amdgcn_sched_barrier(0); } while (0)
#define SC_MQ(QF, DB) do { const bf16x8 sa0 = pack2(S[2 * (DB)], S[2 * (DB) + 1]); \
            _Pragma("unroll") for (int m = 0; m < 4; ++m) acc[m] = __builtin_amdgcn_mfma_f32_16x16x32_bf16(sa0, QF[m], acc[m], 0, 0, 0); __builtin_amdgcn_sched_barrier(0); } while (0)
#define SC_LK(KF, KS, TQ) do { const LAS unsigned char* kp = Ks + (32 * (KS) + 4 * fq + (fr >> 2)) * KPI + (8 * (fr & 3)) * 2;     \
            _Pragma("unroll") for (int t4 = 0; t4 < 4; ++t4) { const int t = 4 * (TQ) + t4; KF[t4] = cat8(trr(kp + 64 * (t >> 1) + 8 * (t & 1)), trr(kp + 64 * (t >> 1) + 8 * (t & 1) + 16 * KPI)); } __builtin_amdgcn_sched_barrier(0); } while (0)
#define SC_LV(VF, KS) do { const LAS unsigned char* vp = Vs + (32 * (KS) + 4 * fq + (fr >> 2)) * VPI + (16 * w + 4 * (fr & 3)) * 2; VF = cat8(trr(vp), trr(vp + 16 * VPI)); } while (0)
#define SC_MK(KF, VF, TQ) do { _Pragma("unroll") for (int t4 = 0; t4 < 4; ++t4) S[4 * (TQ) + t4] = __builtin_amdgcn_mfma_f32_16x16x32_bf16(KF[t4], VF, S[4 * (TQ) + t4], 0, 0, 0); __builtin_amdgcn_sched_barrier(0); } while (0)
#define SCAN_CHUNK(n_, BO) do { const size_t tok0 = tokb + (size_t)(n_) * 64; LAS unsigned char* Qs = C.lds + (BO) + OQ; LAS unsigned char* Ks = C.lds + (BO) + OK_; LAS unsigned char* Vs = C.lds + (BO) + OV; \
                f32x4 acc[4]; bf16x8 fA[4], fB[4], kA[4], kB[4], vf0, vf1; \
                _Pragma("unroll") for (int m = 0; m < 4; ++m) acc[m] = (f32x4){0.f, 0.f, 0.f, 0.f}; \
                SC_LQ(fA, 0); SC_LQ(fB, 1); SC_MQ(fA, 0); SC_LQ(fA, 2); SC_MQ(fB, 1); SC_LQ(fB, 3); SC_MQ(fA, 2); SC_LQ(fA, 4); SC_MQ(fB, 3); SC_LQ(fB, 5); SC_MQ(fA, 4); SC_LQ(fA, 6); SC_MQ(fB, 5); SC_LQ(fB, 7); SC_MQ(fA, 6); SC_LV(vf0, 0); SC_LV(vf1, 1); SC_LK(kA, 0, 0); SC_MQ(fB, 7); \
                _Pragma("unroll") for (int m = 0; m < 4; ++m) { const f32x4 v = acc[m] * exp2f(lg2 * (float)(16 * m + fr + 1)); uint2 o; o.x = cvtpk(v[0], v[1]); o.y = cvtpk(v[2], v[3]); \
                    *(uint2*)(CROSS + (tok0 + 16 * m + fr) * 2048 + h * 512 + es * SCAN_ESL + 16 * w + 4 * fq) = o; } \
                _Pragma("unroll") for (int t = 0; t < 16; ++t) S[t] = S[t] * gc; \
                __builtin_amdgcn_sched_barrier(0); \
                SC_LK(kB, 0, 1); SC_MK(kA, vf0, 0); SC_LK(kA, 0, 2); SC_MK(kB, vf0, 1); SC_LK(kB, 0, 3); SC_MK(kA, vf0, 2); SC_LK(kA, 1, 0); SC_MK(kB, vf0, 3); SC_LK(kB, 1, 1); SC_MK(kA, vf1, 0); SC_LK(kA, 1, 2); SC_MK(kB, vf1, 1); SC_LK(kB, 1, 3); SC_MK(kA, vf1, 2); SC_MK(kB, vf1, 3); \
                SCAN_BAR(); } while (0)
#pragma unroll 1
            for (int n = 0; n < 128; n += 2) { if (MODE == 1) { SCAN_BAR(); SCAN_BAR(); } else { SCAN_CHUNK(n, 0); SCAN_CHUNK(n + 1, BUFB); } }
#undef SCAN_CHUNK
#undef SC_LQ
#undef SC_MQ
#undef SC_LK
#undef SC_LV
#undef SC_MK
        }
    }
}
#undef SCAN_BAR
DI void sgu_gate_mfma(const Ctx& C, bf16* U, const bf16* VB, const float* stats, const float* w_s, const float* b_s, const float* ln_g, const float* ln_b) {
    constexpr int WPI = 272, VPI = 288;
    LAS unsigned char* Ws = C.lds; LAS unsigned char* Vs = C.lds + 128 * WPI;
    LAS float* mu = (LAS float*)(C.lds + 128 * WPI + 128 * VPI); LAS float* rsd = mu + 128; LAS float* r1 = mu + 256; LAS float* r2 = mu + 384; LAS float* bsl = mu + 512;
    const int tid = C.tid, lane = C.lane, w = C.wave, fr = lane & 15, fq = lane >> 4;
    for (int item = C.vcu; item < 1024; item += C.G) {
        const int n = item >> 3, g = item & 7; const size_t row0 = (size_t)n * 128;
        if (tid < 128) { const float* sp = stats + (row0 + tid) * 96; float s1 = 0.f, s2 = 0.f;
#pragma unroll 8
            for (int q = 0; q < 48; ++q) { s1 += sp[2 * q]; s2 += sp[2 * q + 1]; }
            const float m = s1 * (1.0f / 3072.0f); const float var = s2 * (1.0f / 3072.0f) - m * m; mu[tid] = m; rsd[tid] = 1.0f / sqrtf(fmaxf(var, 0.f) + EPS); bsl[tid] = b_s[g * 128 + tid]; }
        __syncthreads();
        { const int i = tid >> 2, jq = tid & 3; const float* wp = w_s + (size_t)g * 16384 + i * 128 + jq * 32; float a1 = 0.f, a2 = 0.f;
#pragma unroll
          for (int c8 = 0; c8 < 4; ++c8) { const f32x4 wa = *(const f32x4*)(wp + c8 * 8), wb = *(const f32x4*)(wp + c8 * 8 + 4); float wv[8] = {wa[0], wa[1], wa[2], wa[3], wb[0], wb[1], wb[2], wb[3]}; float o[8];
#pragma unroll
              for (int q = 0; q < 8; ++q) { const int j = jq * 32 + c8 * 8 + q; const float wm = (i < 64 && j >= 64) ? 0.f : wv[q]; const float wr_ = wm * rsd[j]; o[q] = wr_; a1 += wr_ * mu[j]; a2 += wm; }
              u32x4 pk; pk.x = cvtpk(o[0], o[1]); pk.y = cvtpk(o[2], o[3]); pk.z = cvtpk(o[4], o[5]); pk.w = cvtpk(o[6], o[7]);
              *(LAS u32x4*)(Ws + i * WPI + (jq * 32 + c8 * 8) * 2) = pk; }
          a1 += __shfl_xor(a1, 1); a1 += __shfl_xor(a1, 2); a2 += __shfl_xor(a2, 1); a2 += __shfl_xor(a2, 2);
          if (jq == 0) { r1[i] = a1; r2[i] = a2; } }
#pragma unroll 1
        for (int cs = 0; cs < 3; ++cs) {
            const int colb = g * 384 + cs * 128;
#pragma unroll
            for (int u = 0; u < 4; ++u) { const int c = tid + 512 * u, r = c >> 4, cc = c & 15;
                *(LAS u32x4*)(Vs + r * VPI + cc * 16) = *(const u32x4*)(VB + (row0 + r) * 3072 + colb + cc * 8); }
            __syncthreads();
            f32x4 acc[8];
#pragma unroll
            for (int it = 0; it < 8; ++it) acc[it] = (f32x4){0.f, 0.f, 0.f, 0.f};
#pragma unroll
            for (int ks = 0; ks < 4; ++ks) {
                const LAS unsigned char* vp = Vs + (32 * ks + 4 * fq + (fr >> 2)) * VPI + (16 * w + 4 * (fr & 3)) * 2;
                const bf16x8 vf = cat8(trr(vp), trr(vp + 16 * VPI));
#pragma unroll
                for (int it = 0; it < 8; ++it) { if (it < 4 && ks >= 2) continue;
                    const LAS unsigned char* wp = Ws + (16 * it + fr) * WPI + (32 * ks + 4 * fq) * 2;
                    const u32x2_t lo = *(const LAS u32x2_t*)wp, hi = *(const LAS u32x2_t*)(wp + 32);
                    u32x4 ww; ww.x = lo.x; ww.y = lo.y; ww.z = hi.x; ww.w = hi.y;
                    acc[it] = __builtin_amdgcn_mfma_f32_16x16x32_bf16(vf, __builtin_bit_cast(bf16x8, ww), acc[it], 0, 0, 0); }
            }
            const int c0 = colb + 16 * w + 4 * fq;
            const f32x4 lg = *(const f32x4*)(ln_g + c0), lb = *(const f32x4*)(ln_b + c0);
#pragma unroll
            for (int it = 0; it < 8; ++it) { const int i = 16 * it + fr; const float q1 = r1[i], q2 = r2[i], bb = bsl[i];
                bf16* up = U + (row0 + i) * 3072 + c0; const u32x2_t uu = *(const u32x2_t*)up;
                const f32x4 s = lg * (acc[it] - q1) + lb * q2 + bb;
                u32x2_t o; o.x = cvtpk(bflo(uu.x) * s[0], bfhi(uu.x) * s[1]); o.y = cvtpk(bflo(uu.y) * s[2], bfhi(uu.y) * s[3]);
                *(u32x2_t*)up = o; }
            __syncthreads();
        }
    }
}
DI void up8(unsigned wd, float& a, float& b, float& c, float& d) { const f32x2_t lo = __builtin_amdgcn_cvt_pk_f32_fp8((int)wd, false), hi = __builtin_amdgcn_cvt_pk_f32_fp8((int)wd, true); a = lo.x; b = lo.y; c = hi.x; d = hi.y; }
DI float dot16(const u32x4 u, const float (&hv)[16]) {
    float f[16];
    up8(u.x, f[0], f[1], f[2], f[3]); up8(u.y, f[4], f[5], f[6], f[7]); up8(u.z, f[8], f[9], f[10], f[11]); up8(u.w, f[12], f[13], f[14], f[15]);
    float d0 = f[0] * hv[0], d1 = f[1] * hv[1];
#pragma unroll
    for (int j = 2; j < 16; j += 2) { d0 += f[j] * hv[j]; d1 += f[j + 1] * hv[j + 1]; }
    return d0 + d1;
}
template <bool FINAL> DI void peer_gather8(const Ctx& C, const bf16* Hin, const int* IDX, const float* GATE, const unsigned char* PU8, const unsigned char* PV8, const float* ISU, const float* ISV,
                                           float* X, const float* g2, const float* ngain, const float* nmod, bf16* Hn) {
    const int gw = C.vcu * NWAVES + C.wave, NGW = C.G * NWAVES, lane = C.lane;
    LAS float* DL = (LAS float*)(C.lds + C.wave * 1024);
    LAS float* AL = DL + 128;
    for (int t = gw; t < TT; t += NGW) {
        float hv[16];
        { const u32x4 a = *(const u32x4*)(Hin + (size_t)t * 1024 + lane * 16), bq = *(const u32x4*)(Hin + (size_t)t * 1024 + lane * 16 + 8);
          hv[0] = bflo(a.x); hv[1] = bfhi(a.x); hv[2] = bflo(a.y); hv[3] = bfhi(a.y); hv[4] = bflo(a.z); hv[5] = bfhi(a.z); hv[6] = bflo(a.w); hv[7] = bfhi(a.w);
          hv[8] = bflo(bq.x); hv[9] = bfhi(bq.x); hv[10] = bflo(bq.y); hv[11] = bfhi(bq.y); hv[12] = bflo(bq.z); hv[13] = bfhi(bq.z); hv[14] = bflo(bq.w); hv[15] = bfhi(bq.w); }
        const int i0 = IDX[(size_t)t * 128 + lane], i1 = IDX[(size_t)t * 128 + 64 + lane];
        const float g0 = GATE[(size_t)t * 128 + lane], g1 = GATE[(size_t)t * 128 + 64 + lane];
        const float su0 = ISU[i0], su1 = ISU[i1], sv0 = ISV[i0], sv1 = ISV[i1];
        u32x4 ub[8];
#define PG_LOADU(k0) do { _Pragma("unroll") for (int j = 0; j < 8; ++j) { const int kq = (k0) + j; const int e = kq < 64 ? __builtin_amdgcn_readlane(i0, kq) : __builtin_amdgcn_readlane(i1, kq - 64); \
            ub[j] = *(const u32x4*)(PU8 + (size_t)e * 1024 + lane * 16); } } while (0)
        PG_LOADU(0);
#pragma unroll 1
        for (int k0 = 0; k0 < 128; k0 += 8) {
            float p[8];
#pragma unroll
            for (int j = 0; j < 8; ++j) p[j] = dot16(ub[j], hv);
            if (k0 + 8 < 128) PG_LOADU(k0 + 8);
            const bool h32 = lane & 32, h16 = lane & 16, h8 = lane & 8;
            float q4[4];
#pragma unroll
            for (int j = 0; j < 4; ++j) { const float keep = h32 ? p[j + 4] : p[j], send = h32 ? p[j] : p[j + 4]; q4[j] = keep + __shfl_xor(send, 32); }
            float q2[2];
#pragma unroll
            for (int j = 0; j < 2; ++j) { const float keep = h16 ? q4[j + 2] : q4[j], send = h16 ? q4[j] : q4[j + 2]; q2[j] = keep + __shfl_xor(send, 16); }
            float q1; { const float keep = h8 ? q2[1] : q2[0], send = h8 ? q2[0] : q2[1]; q1 = keep + __shfl_xor(send, 8); }
            q1 += __shfl_xor(q1, 4); q1 += __shfl_xor(q1, 2); q1 += __shfl_xor(q1, 1);
            if ((lane & 7) == 0) DL[k0 + ((lane >> 5) & 1) * 4 + ((lane >> 4) & 1) * 2 + ((lane >> 3) & 1)] = q1;
        }
#undef PG_LOADU
        LDS_WAIT();
        { const float d0 = DL[lane], d1 = DL[64 + lane]; AL[lane] = gelu_t(d0 * su0) * g0 * sv0; AL[64 + lane] = gelu_t(d1 * su1) * g1 * sv1; }
        LDS_WAIT();
        float o[16];
#pragma unroll
        for (int j = 0; j < 16; ++j) o[j] = 0.f;
        u32x4 vb[8];
#define PG_LOADV(k0) do { _Pragma("unroll") for (int j = 0; j < 8; ++j) { const int kq = (k0) + j; const int e = kq < 64 ? __builtin_amdgcn_readlane(i0, kq) : __builtin_amdgcn_readlane(i1, kq - 64); \
            vb[j] = *(const u32x4*)(PV8 + (size_t)e * 1024 + lane * 16); } } while (0)
        PG_LOADV(0);
#pragma unroll 1
        for (int k0 = 0; k0 < 128; k0 += 8) {
            float f[8][16];
#pragma unroll
            for (int j = 0; j < 8; ++j) { up8(vb[j].x, f[j][0], f[j][1], f[j][2], f[j][3]); up8(vb[j].y, f[j][4], f[j][5], f[j][6], f[j][7]); up8(vb[j].z, f[j][8], f[j][9], f[j][10], f[j][11]); up8(vb[j].w, f[j][12], f[j][13], f[j][14], f[j][15]); }
            if (k0 + 8 < 128) PG_LOADV(k0 + 8);
#pragma unroll
            for (int j = 0; j < 8; ++j) { const float ak = AL[k0 + j];
#pragma unroll
                for (int q = 0; q < 16; ++q) o[q] += ak * f[j][q]; }
        }
#undef PG_LOADV
        const int b = t >> 13; const float* gp = g2 + (size_t)b * 6144; float* xr = X + (size_t)t * 1024;
        float xn[16]; float ss = 0.f;
#pragma unroll
        for (int q = 0; q < 4; ++q) { const int col = lane * 16 + q * 4; const f32x4 xv = *(const f32x4*)(xr + col), gv = *(const f32x4*)(gp + col);
#pragma unroll
            for (int j = 0; j < 4; ++j) { const float y = xv[j] + gv[j] * o[q * 4 + j]; xn[q * 4 + j] = y; ss += y * y; } }
        const float rstd = 1.0f / sqrtf(wave_sum(ss) * (1.0f / 1024.0f) + EPS);
        if (FINAL) {
#pragma unroll
            for (int q = 0; q < 4; ++q) { const int col = lane * 16 + q * 4; const f32x4 gn = *(const f32x4*)(ngain + col); f32x4 y;
#pragma unroll
                for (int j = 0; j < 4; ++j) y[j] = xn[q * 4 + j] * rstd * gn[j];
                *(f32x4*)(xr + col) = y; }
        } else {
            const float* nm = nmod + (size_t)b * 6144;
#pragma unroll
            for (int q = 0; q < 4; ++q) { const int col = lane * 16 + q * 4; const f32x4 gn = *(const f32x4*)(ngain + col), sh = *(const f32x4*)(nm + col), sc = *(const f32x4*)(nm + 1024 + col); f32x4 xo; float y[4];
#pragma unroll
                for (int j = 0; j < 4; ++j) { xo[j] = xn[q * 4 + j]; y[j] = xn[q * 4 + j] * rstd * gn[j] * (1.0f + sc[j]) + sh[j]; }
                *(f32x4*)(xr + col) = xo; u32x2_t wv; wv.x = cvtpk(y[0], y[1]); wv.y = cvtpk(y[2], y[3]); *(u32x2_t*)(Hn + (size_t)t * 1024 + col) = wv; }
        }
    }
}
template <int CTRL> DI float dpp_f(float x) { return __int_as_float(__builtin_amdgcn_update_dpp(0, __float_as_int(x), CTRL, 0xF, 0xF, false)); }
DI float x32(float x) { auto r = __builtin_amdgcn_permlane32_swap(__float_as_uint(x), __float_as_uint(x), false, false); return (threadIdx.x & 32) ? __uint_as_float(r[0]) : __uint_as_float(r[1]); }
DI float x16(float x) { auto r = __builtin_amdgcn_permlane16_swap(__float_as_uint(x), __float_as_uint(x), false, false); return (threadIdx.x & 16) ? __uint_as_float(r[0]) : __uint_as_float(r[1]); }
typedef _Float16 h2_t __attribute__((ext_vector_type(2)));
DI unsigned f2hu(float lo, float hi) { const f32x2_t v = {lo, hi}; const h2_t h = __builtin_convertvector(v, h2_t); return __builtin_bit_cast(unsigned, h); }
DI unsigned bf2hu(unsigned w) { const f32x2_t v = {bflo(w), bfhi(w)}; const h2_t h = __builtin_convertvector(v, h2_t); return __builtin_bit_cast(unsigned, h); }
DI h2_t bf2h(unsigned w) { return (h2_t){(_Float16)bflo(w), (_Float16)bfhi(w)}; }
template <bool FAKE> DI void up8h(const u32x4 u, h2_t (&f)[8]) {
    if (FAKE) { f[0] = __builtin_bit_cast(h2_t, u.x & 0x3bff3bffu); f[1] = __builtin_bit_cast(h2_t, u.y & 0x3bff3bffu); f[2] = __builtin_bit_cast(h2_t, u.z & 0x3bff3bffu); f[3] = __builtin_bit_cast(h2_t, u.w & 0x3bff3bffu);
        f[4] = __builtin_bit_cast(h2_t, (u.x >> 1) & 0x3bff3bffu); f[5] = __builtin_bit_cast(h2_t, (u.y >> 1) & 0x3bff3bffu); f[6] = __builtin_bit_cast(h2_t, (u.z >> 1) & 0x3bff3bffu); f[7] = __builtin_bit_cast(h2_t, (u.w >> 1) & 0x3bff3bffu); return; }
    f[0] = __builtin_amdgcn_cvt_scalef32_pk_f16_fp8((int)u.x, 1.0f, false); f[1] = __builtin_amdgcn_cvt_scalef32_pk_f16_fp8((int)u.x, 1.0f, true);
    f[2] = __builtin_amdgcn_cvt_scalef32_pk_f16_fp8((int)u.y, 1.0f, false); f[3] = __builtin_amdgcn_cvt_scalef32_pk_f16_fp8((int)u.y, 1.0f, true);
    f[4] = __builtin_amdgcn_cvt_scalef32_pk_f16_fp8((int)u.z, 1.0f, false); f[5] = __builtin_amdgcn_cvt_scalef32_pk_f16_fp8((int)u.z, 1.0f, true);
    f[6] = __builtin_amdgcn_cvt_scalef32_pk_f16_fp8((int)u.w, 1.0f, false); f[7] = __builtin_amdgcn_cvt_scalef32_pk_f16_fp8((int)u.w, 1.0f, true); }
template <bool FAKE> DI float dot16h(const u32x4 u, const h2_t (&hh)[8]) { h2_t f[8]; up8h<FAKE>(u, f); float d0 = 0.f, d1 = 0.f;
#pragma unroll
    for (int q = 0; q < 8; q += 2) { d0 = __builtin_amdgcn_fdot2(f[q], hh[q], d0, false); d1 = __builtin_amdgcn_fdot2(f[q + 1], hh[q + 1], d1, false); }
    return d0 + d1; }
template <bool FINAL, bool FAKE = false, int SKIP = 0> DI void peer_gather_rounds(const Ctx& C, const bf16* Hin, const int* IDX, const float* GATE, const unsigned char* PU8, const unsigned char* PV8, const float* ISU, const float* ISV,
                                                 float* X, const float* g2, const float* ngain, const float* nmod, bf16* Hn) {
    const int lane = C.lane, w = C.wave;
    LAS u32x2_t* LIST = (LAS u32x2_t*)(C.lds + w * 14592);
    LAS unsigned char* HL = C.lds + w * 14592 + 4096;
    LAS unsigned* ALU = (LAS unsigned*)(C.lds + w * 14592 + 12288);
    LAS int* OFFS = (LAS int*)(C.lds + w * 14592 + 14336);
    const unsigned long long ltmask = (1ull << lane) - 1ull;
    for (int grp = C.vcu; grp < TT / 32; grp += C.G) {
        const int t0 = grp * 32 + w * 4;
        {
            int ee[8]; float gg[8]; unsigned su[8]; float sv[8];
#pragma unroll
            for (int r = 0; r < 8; ++r) { const size_t a = (size_t)(t0 + (r >> 1)) * 128 + 64 * (r & 1) + lane; ee[r] = IDX[a]; gg[r] = GATE[a]; }
#pragma unroll
            for (int r = 0; r < 8; ++r) { su[r] = __float_as_uint(ISU[ee[r]]) >> 23; sv[r] = ISV[ee[r]]; }
            int pos[8]; int base = 0;
#pragma unroll 1
            for (int b = 0; b < 8; ++b) {
#pragma unroll
                for (int r = 0; r < 8; ++r) { if ((r & 1) == 0 && lane == 0) OFFS[b * 4 + (r >> 1)] = base;
                    const bool mine = (ee[r] >> 11) == b; const unsigned long long m = __ballot(mine); if (mine) pos[r] = base + __popcll(m & ltmask); base += __popcll(m); }
            }
            if (lane == 0) OFFS[32] = 512;
#pragma unroll
            for (int r = 0; r < 8; ++r) { u32x2_t en; en.x = (unsigned)ee[r] | ((unsigned)(r >> 1) << 14) | (su[r] << 16); en.y = __float_as_uint(gg[r] * sv[r]); LIST[pos[r]] = en; }
#pragma unroll
            for (int tk = 0; tk < 4; ++tk) { const u32x4 a = *(const u32x4*)(Hin + (size_t)(t0 + tk) * 1024 + lane * 16), bq = *(const u32x4*)(Hin + (size_t)(t0 + tk) * 1024 + lane * 16 + 8);
                u32x4 ha, hb; ha.x = bf2hu(a.x); ha.y = bf2hu(a.y); ha.z = bf2hu(a.z); ha.w = bf2hu(a.w); hb.x = bf2hu(bq.x); hb.y = bf2hu(bq.y); hb.z = bf2hu(bq.z); hb.w = bf2hu(bq.w);
                *(LAS u32x4*)(HL + tk * 2048 + lane * 32) = ha; *(LAS u32x4*)(HL + tk * 2048 + lane * 32 + 16) = hb; }
        }
        LDS_WAIT();
        {
            const int jL = ((lane >> 5) & 1) * 4 + ((lane >> 4) & 1) * 2 + ((lane >> 3) & 1);
#define G1_LOAD(UB, TK, G0) do { const unsigned exl_ = LIST[(G0) + (lane & 7)].x; \
            _Pragma("unroll") for (int j = 0; j < 8; ++j) { const unsigned ex = (unsigned)__builtin_amdgcn_readlane((int)exl_, j); TK[j] = (int)((ex >> 14) & 3u); \
                UB[j] = *(const u32x4*)(PU8 + (size_t)(ex & (FAKE ? 0x7fu : 0x3fffu)) * 1024 + lane * 16); } } while (0)
#define G1_RUN(UB, TK, G0) do { float p[8]; \
            _Pragma("unroll") for (int j = 0; j < 8; ++j) { const LAS h2_t* hp_ = (const LAS h2_t*)(HL + TK[j] * 2048 + lane * 32); \
                h2_t hv[8]; _Pragma("unroll") for (int q_ = 0; q_ < 8; ++q_) hv[q_] = hp_[q_]; \
                p[j] = dot16h<FAKE>(UB[j], hv); } \
            const bool h32 = lane & 32, h16 = lane & 16, h8 = lane & 8; float q4[4]; \
            _Pragma("unroll") for (int j = 0; j < 4; ++j) { const float keep = h32 ? p[j + 4] : p[j], send = h32 ? p[j] : p[j + 4]; q4[j] = keep + x32(send); } \
            float q2[2]; \
            _Pragma("unroll") for (int j = 0; j < 2; ++j) { const float keep = h16 ? q4[j + 2] : q4[j], send = h16 ? q4[j] : q4[j + 2]; q2[j] = keep + x16(send); } \
            float q1; { const float keep = h8 ? q2[1] : q2[0], send = h8 ? q2[0] : q2[1]; q1 = keep + dpp_f<0x128>(send); } \
            q1 += dpp_f<0x141>(q1); q1 += dpp_f<0xB1>(q1); q1 += dpp_f<0x4E>(q1); \
            if ((lane & 7) == 0) { const u32x2_t me = LIST[(G0) + jL]; const float av_ = gelu_t(q1 * __uint_as_float((me.x >> 16) << 23)) * __uint_as_float(me.y); ALU[(G0) + jL] = f2hu(av_, av_); } } while (0)
            u32x4 ubA[8], ubB[8]; int tkA[8], tkB[8];
            G1_LOAD(ubA, tkA, 0);
#pragma unroll 1
            for (int g0 = 0; g0 < ((SKIP & 1) ? 0 : 512); g0 += 16) {
                G1_LOAD(ubB, tkB, g0 + 8);
                G1_RUN(ubA, tkA, g0);
                if (g0 + 16 < 512) G1_LOAD(ubA, tkA, g0 + 16);
                G1_RUN(ubB, tkB, g0 + 8);
            }
#undef G1_LOAD
#undef G1_RUN
        }
        LDS_WAIT();
        h2_t o[4][8];
#pragma unroll
        for (int tk = 0; tk < 4; ++tk)
#pragma unroll
            for (int q = 0; q < 8; ++q) o[tk][q] = (h2_t){(_Float16)0.f, (_Float16)0.f};
#pragma unroll 1
        for (int r = 0; r < ((SKIP & 2) ? 0 : 8); ++r) {
#pragma unroll
            for (int tk = 0; tk < 4; ++tk) {
                const int beg = __builtin_amdgcn_readfirstlane(OFFS[r * 4 + tk]), end = __builtin_amdgcn_readfirstlane(OFFS[r * 4 + tk + 1]);
#define GS_LOAD(VB, AJ, G0) do { const int idl_ = ((G0) + (lane & 7) < end) ? (G0) + (lane & 7) : end - 1; const unsigned exl_ = LIST[idl_].x; const unsigned all_ = ((G0) + (lane & 7) < end) ? ALU[idl_] : 0u; \
                    _Pragma("unroll") for (int j = 0; j < 8; ++j) { const unsigned ex = (unsigned)__builtin_amdgcn_readlane((int)exl_, j); AJ[j] = __builtin_bit_cast(h2_t, (unsigned)__builtin_amdgcn_readlane((int)all_, j)); \
                        VB[j] = *(const u32x4*)(PV8 + (size_t)(ex & (FAKE ? 0x7fu : 0x3fffu)) * 1024 + lane * 16); } } while (0)
#define GS_ACC(VB, AJ) do { _Pragma("unroll") for (int j = 0; j < 8; ++j) { h2_t f_[8]; up8h<FAKE>(VB[j], f_); _Pragma("unroll") for (int q = 0; q < 8; ++q) o[tk][q] = f_[q] * AJ[j] + o[tk][q]; } } while (0)
                if (beg < end) {
                    u32x4 vbA[8], vbB[8]; h2_t ajA[8], ajB[8];
                    GS_LOAD(vbA, ajA, beg);
#pragma unroll 1
                    for (int g0 = beg; g0 < end; g0 += 16) {
                        if (g0 + 8 < end) GS_LOAD(vbB, ajB, g0 + 8);
                        GS_ACC(vbA, ajA);
                        if (g0 + 8 < end) { if (g0 + 16 < end) GS_LOAD(vbA, ajA, g0 + 16); GS_ACC(vbB, ajB); }
                    }
                }
#undef GS_LOAD
#undef GS_ACC
            }
        }
#pragma unroll
        for (int tk = 0; tk < 4; ++tk) {
            __builtin_amdgcn_sched_barrier(0);
            const int t = t0 + tk; const int b = t >> 13; const float* gp = g2 + (size_t)b * 6144; float* xr = X + (size_t)t * 1024;
            float xn[16]; float ss = 0.f;
#pragma unroll
            for (int q = 0; q < 4; ++q) { const int col = lane * 16 + q * 4; const f32x4 xv = *(const f32x4*)(xr + col), gv = *(const f32x4*)(gp + col);
#pragma unroll
                for (int j = 0; j < 4; ++j) { const float y = xv[j] + gv[j] * (float)o[tk][q * 2 + (j >> 1)][j & 1]; xn[q * 4 + j] = y; ss += y * y; } }
            const float rstd = 1.0f / sqrtf(wave_sum(ss) * (1.0f / 1024.0f) + EPS);
            if (FINAL) {
#pragma unroll
                for (int q = 0; q < 4; ++q) { const int col = lane * 16 + q * 4; const f32x4 gn = *(const f32x4*)(ngain + col); f32x4 y;
#pragma unroll
                    for (int j = 0; j < 4; ++j) y[j] = xn[q * 4 + j] * rstd * gn[j];
                    *(f32x4*)(xr + col) = y; }
            } else {
                const float* nm = nmod + (size_t)b * 6144;
#pragma unroll
                for (int q = 0; q < 4; ++q) { const int col = lane * 16 + q * 4; const f32x4 gn = *(const f32x4*)(ngain + col), sh = *(const f32x4*)(nm + col), sc = *(const f32x4*)(nm + 1024 + col); f32x4 xo; float y[4];
#pragma unroll
                    for (int j = 0; j < 4; ++j) { xo[j] = xn[q * 4 + j]; y[j] = xn[q * 4 + j] * rstd * gn[j] * (1.0f + sc[j]) + sh[j]; }
                    *(f32x4*)(xr + col) = xo; u32x2_t wv; wv.x = cvtpk(y[0], y[1]); wv.y = cvtpk(y[2], y[3]); *(u32x2_t*)(Hn + (size_t)t * 1024 + col) = wv; }
            }
        }
        LDS_WAIT();
    }
}
constexpr int GR_R = 12;
DI void glds_row(const unsigned char* gsrc_lane, unsigned lds_dst) { unsigned keep;
    asm volatile("s_mov_b32 %0, m0\n\ts_mov_b32 m0, %2\n\ts_nop 0\n\tglobal_load_lds_dwordx4 %1, off\n\ts_mov_b32 m0, %0" : "=&s"(keep) : "v"(gsrc_lane), "s"(lds_dst) : "memory"); }
template <bool FINAL> DI void peer_gather_dma(const Ctx& C, const bf16* Hin, const int* IDX, const float* GATE, const unsigned char* PU8, const unsigned char* PV8, const float* ISU, const float* ISV,
                                              float* X, const float* g2, const float* ngain, const float* nmod, bf16* Hn) {
    const int lane = C.lane, w = C.wave;
    constexpr int WB = 4096 + 2048 + 256 + GR_R * 1024;
    LAS u32x2_t* LIST = (LAS u32x2_t*)(C.lds + w * WB);
    LAS float* AL = (LAS float*)(C.lds + w * WB + 4096);
    LAS int* OFFS = (LAS int*)(C.lds + w * WB + 6144);
    LAS unsigned char* RING = C.lds + w * WB + 6400;
    const unsigned ring0 = (unsigned)__builtin_amdgcn_readfirstlane((int)(unsigned)(size_t)RING);
    const unsigned long long ltmask = (1ull << lane) - 1ull;
#define GR_REFILL(nv_) do { unsigned ex8_[8]; _Pragma("unroll") for (int j_ = 0; j_ < 8; ++j_) ex8_[j_] = (j_ < (nv_) && nf + j_ < 1024) ? LIST[(nf + j_) & 511].x : 0u; \
        _Pragma("unroll") for (int j_ = 0; j_ < 8; ++j_) if (j_ < (nv_) && nf + j_ < 1024) { const int f_ = nf + j_; const unsigned e_ = (unsigned)__builtin_amdgcn_readfirstlane((int)ex8_[j_]) & 0x3fffu; \
            const unsigned char* tb_ = (f_ < 512) ? PU8 : PV8; glds_row(tb_ + (size_t)e_ * 1024 + lane * 16, ring0 + (unsigned)(f_ % GR_R) * 1024u); } \
        nf += (nv_); if (nf > 1024) nf = 1024; } while (0)
#define GR_ISSUE(f) do { const int f_ = (f); const unsigned ex_ = (unsigned)__builtin_amdgcn_readfirstlane((int)LIST[f_ & 511].x); \
        const unsigned char* tb_ = (f_ < 512) ? PU8 : PV8; glds_row(tb_ + (size_t)(ex_ & 0x3fffu) * 1024 + lane * 16, ring0 + (unsigned)(f_ % GR_R) * 1024u); } while (0)
    for (int grp = C.vcu; grp < TT / 32; grp += C.G) {
        const int t0 = grp * 32 + w * 4;
        float hv4[4][16];
        {
            int ee[8]; float gg[8]; unsigned su[8]; float sv[8];
#pragma unroll
            for (int r = 0; r < 8; ++r) { const size_t a = (size_t)(t0 + (r >> 1)) * 128 + 64 * (r & 1) + lane; ee[r] = IDX[a]; gg[r] = GATE[a]; }
#pragma unroll
            for (int r = 0; r < 8; ++r) { su[r] = __float_as_uint(ISU[ee[r]]) >> 23; sv[r] = ISV[ee[r]]; }
            int pos[8]; int base = 0;
#pragma unroll 1
            for (int b = 0; b < 8; ++b) {
#pragma unroll
                for (int r = 0; r < 8; ++r) { if ((r & 1) == 0 && lane == 0) OFFS[b * 4 + (r >> 1)] = base;
                    const bool mine = (ee[r] >> 11) == b; const unsigned long long m = __ballot(mine); if (mine) pos[r] = base + __popcll(m & ltmask); base += __popcll(m); }
            }
            if (lane == 0) OFFS[32] = 512;
#pragma unroll
            for (int r = 0; r < 8; ++r) { u32x2_t en; en.x = (unsigned)ee[r] | ((unsigned)(r >> 1) << 14) | (su[r] << 16); en.y = __float_as_uint(gg[r] * sv[r]); LIST[pos[r]] = en; }
#pragma unroll
            for (int tk = 0; tk < 4; ++tk) { const u32x4 a = *(const u32x4*)(Hin + (size_t)(t0 + tk) * 1024 + lane * 16), bq = *(const u32x4*)(Hin + (size_t)(t0 + tk) * 1024 + lane * 16 + 8);
                hv4[tk][0] = bflo(a.x); hv4[tk][1] = bfhi(a.x); hv4[tk][2] = bflo(a.y); hv4[tk][3] = bfhi(a.y); hv4[tk][4] = bflo(a.z); hv4[tk][5] = bfhi(a.z); hv4[tk][6] = bflo(a.w); hv4[tk][7] = bfhi(a.w);
                hv4[tk][8] = bflo(bq.x); hv4[tk][9] = bfhi(bq.x); hv4[tk][10] = bflo(bq.y); hv4[tk][11] = bfhi(bq.y); hv4[tk][12] = bflo(bq.z); hv4[tk][13] = bfhi(bq.z); hv4[tk][14] = bflo(bq.w); hv4[tk][15] = bfhi(bq.w); }
        }
        asm volatile("s_waitcnt vmcnt(0) lgkmcnt(0)" ::: "memory");
        int nf = GR_R;
#pragma unroll 1
        for (int f = 0; f < GR_R; ++f) GR_ISSUE(f);
        {
            const int jL = ((lane >> 5) & 1) * 4 + ((lane >> 4) & 1) * 2 + ((lane >> 3) & 1);
#pragma unroll 1
            for (int r = 0; r < 8; ++r) {
#pragma unroll
                for (int tk = 0; tk < 4; ++tk) {
                    const int beg = __builtin_amdgcn_readfirstlane(OFFS[r * 4 + tk]), end = __builtin_amdgcn_readfirstlane(OFFS[r * 4 + tk + 1]);
#pragma unroll 1
                    for (int g0 = beg; g0 < end; g0 += 8) {
                        const int nv = (end - g0) < 8 ? (end - g0) : 8;
                        asm volatile("s_waitcnt vmcnt(4)" ::: "memory");
                        float p[8];
#pragma unroll
                        for (int j = 0; j < 8; ++j) { p[j] = 0.f;
                            if (j < nv) { const u32x4 row = *(const LAS u32x4*)(RING + ((g0 + j) % GR_R) * 1024 + lane * 16); p[j] = dot16(row, hv4[tk]); } }
                        asm volatile("s_waitcnt lgkmcnt(0)" ::: "memory");
                        GR_REFILL(nv);
                        const bool h32 = lane & 32, h16 = lane & 16, h8 = lane & 8;
                        float q4[4];
#pragma unroll
                        for (int j = 0; j < 4; ++j) { const float keep = h32 ? p[j + 4] : p[j], send = h32 ? p[j] : p[j + 4]; q4[j] = keep + __shfl_xor(send, 32); }
                        float q2[2];
#pragma unroll
                        for (int j = 0; j < 2; ++j) { const float keep = h16 ? q4[j + 2] : q4[j], send = h16 ? q4[j] : q4[j + 2]; q2[j] = keep + __shfl_xor(send, 16); }
                        float q1; { const float keep = h8 ? q2[1] : q2[0], send = h8 ? q2[0] : q2[1]; q1 = keep + __shfl_xor(send, 8); }
                        q1 += __shfl_xor(q1, 4); q1 += __shfl_xor(q1, 2); q1 += __shfl_xor(q1, 1);
                        if ((lane & 7) == 0 && jL < nv) { const u32x2_t me = LIST[g0 + jL]; AL[g0 + jL] = gelu_t(q1 * __uint_as_float((me.x >> 16) << 23)) * __uint_as_float(me.y); }
                    }
                }
            }
        }
        float o[4][16];
#pragma unroll
        for (int tk = 0; tk < 4; ++tk)
#pragma unroll
            for (int q = 0; q < 16; ++q) o[tk][q] = 0.f;
#pragma unroll 1
        for (int r = 0; r < 8; ++r) {
#pragma unroll
            for (int tk = 0; tk < 4; ++tk) {
                const int beg = __builtin_amdgcn_readfirstlane(OFFS[r * 4 + tk]), end = __builtin_amdgcn_readfirstlane(OFFS[r * 4 + tk + 1]);
#pragma unroll 1
                for (int i0 = beg; i0 < end; i0 += 8) {
                    const int nv = (end - i0) < 8 ? (end - i0) : 8;
                    if (i0 <= 500) asm volatile("s_waitcnt vmcnt(4)" ::: "memory"); else asm volatile("s_waitcnt vmcnt(0)" ::: "memory");
                    float aq[8]; u32x4 rw[8];
#pragma unroll
                    for (int j = 0; j < 8; ++j) { aq[j] = (j < nv) ? AL[i0 + j] : 0.f; }
#pragma unroll
                    for (int j = 0; j < 8; ++j) if (j < nv) rw[j] = *(const LAS u32x4*)(RING + ((512 + i0 + j) % GR_R) * 1024 + lane * 16);
#pragma unroll
                    for (int j = 0; j < 8; ++j) if (j < nv) { const float aj = __int_as_float(__builtin_amdgcn_readfirstlane(__float_as_int(aq[j])));
                        float f_[16]; up8(rw[j].x, f_[0], f_[1], f_[2], f_[3]); up8(rw[j].y, f_[4], f_[5], f_[6], f_[7]); up8(rw[j].z, f_[8], f_[9], f_[10], f_[11]); up8(rw[j].w, f_[12], f_[13], f_[14], f_[15]);
#pragma unroll
                        for (int q = 0; q < 16; ++q) o[tk][q] += aj * f_[q]; }
                    asm volatile("s_waitcnt lgkmcnt(0)" ::: "memory");
                    GR_REFILL(nv);
                }
            }
        }
        asm volatile("s_waitcnt vmcnt(0)" ::: "memory");
#pragma unroll
        for (int tk = 0; tk < 4; ++tk) {
            const int t = t0 + tk; const int b = t >> 13; const float* gp = g2 + (size_t)b * 6144; float* xr = X + (size_t)t * 1024;
            float xn[16]; float ss = 0.f;
#pragma unroll
            for (int q = 0; q < 4; ++q) { const int col = lane * 16 + q * 4; const f32x4 xv = *(const f32x4*)(xr + col), gv = *(const f32x4*)(gp + col);
#pragma unroll
                for (int j = 0; j < 4; ++j) { const float y = xv[j] + gv[j] * o[tk][q * 4 + j]; xn[q * 4 + j] = y; ss += y * y; } }
            const float rstd = 1.0f / sqrtf(wave_sum(ss) * (1.0f / 1024.0f) + EPS);
            if (FINAL) {
#pragma unroll
                for (int q = 0; q < 4; ++q) { const int col = lane * 16 + q * 4; const f32x4 gn = *(const f32x4*)(ngain + col); f32x4 y;
#pragma unroll
                    for (int j = 0; j < 4; ++j) y[j] = xn[q * 4 + j] * rstd * gn[j];
                    *(f32x4*)(xr + col) = y; }
            } else {
                const float* nm = nmod + (size_t)b * 6144;
#pragma unroll
                for (int q = 0; q < 4; ++q) { const int col = lane * 16 + q * 4; const f32x4 gn = *(const f32x4*)(ngain + col), sh = *(const f32x4*)(nm + col), sc = *(const f32x4*)(nm + 1024 + col); f32x4 xo; float y[4];
#pragma unroll
                    for (int j = 0; j < 4; ++j) { xo[j] = xn[q * 4 + j]; y[j] = xn[q * 4 + j] * rstd * gn[j] * (1.0f + sc[j]) + sh[j]; }
                    *(f32x4*)(xr + col) = xo; u32x2_t wv; wv.x = cvtpk(y[0], y[1]); wv.y = cvtpk(y[2], y[3]); *(u32x2_t*)(Hn + (size_t)t * 1024 + col) = wv; }
            }
        }
        asm volatile("s_waitcnt vmcnt(0) lgkmcnt(0)" ::: "memory");
    }
#undef GR_ISSUE
#undef GR_REFILL
}
DI float red4_sum(float x) { auto a = __builtin_amdgcn_permlane16_swap(__float_as_uint(x), __float_as_uint(x), false, false); x = __uint_as_float(a[0]) + __uint_as_float(a[1]);
    auto b = __builtin_amdgcn_permlane32_swap(__float_as_uint(x), __float_as_uint(x), false, false); return __uint_as_float(b[0]) + __uint_as_float(b[1]); }
DI float red4_max(float x) { auto a = __builtin_amdgcn_permlane16_swap(__float_as_uint(x), __float_as_uint(x), false, false); x = fmaxf(__uint_as_float(a[0]), __uint_as_float(a[1]));
    auto b = __builtin_amdgcn_permlane32_swap(__float_as_uint(x), __float_as_uint(x), false, false); return fmaxf(__uint_as_float(b[0]), __uint_as_float(b[1])); }
DI float red4_min(float x) { auto a = __builtin_amdgcn_permlane16_swap(__float_as_uint(x), __float_as_uint(x), false, false); x = fminf(__uint_as_float(a[0]), __uint_as_float(a[1]));
    auto b = __builtin_amdgcn_permlane32_swap(__float_as_uint(x), __float_as_uint(x), false, false); return fminf(__uint_as_float(b[0]), __uint_as_float(b[1])); }
constexpr int TK_NI = 6;
DI float tk_pivot(float clo, float chi) {
    const float lc = __builtin_amdgcn_logf(clo), lh = __builtin_amdgcn_logf(fmaxf(chi, 0.5f));
    const float f = (lc - 4.0443941f) * __builtin_amdgcn_rcpf(lc - lh);
    return fminf(fmaxf(f, 0.06f), 0.94f);
}
template <int NV> DI float tk_count(const float (&v)[NV], float mid) {
    const float nb = -mid * 1.099511627776e12f;
    float c0 = 0.f, c1 = 0.f, c2 = 0.f, c3 = 0.f;
#pragma unroll
    for (int i = 0; i < NV; i += 4) {
        c0 += __builtin_amdgcn_fmed3f(__builtin_fmaf(v[i], 1.099511627776e12f, nb), 0.f, 1.f); c1 += __builtin_amdgcn_fmed3f(__builtin_fmaf(v[i + 1], 1.099511627776e12f, nb), 0.f, 1.f);
        c2 += __builtin_amdgcn_fmed3f(__builtin_fmaf(v[i + 2], 1.099511627776e12f, nb), 0.f, 1.f); c3 += __builtin_amdgcn_fmed3f(__builtin_fmaf(v[i + 3], 1.099511627776e12f, nb), 0.f, 1.f);
    }
    float c = (c0 + c1) + (c2 + c3);
    return red4_sum(c);
}
template <int NV> DI void tk_search(const float (&v)[NV], float ntot, float& thr_out) {
    float mx = v[0], mn = v[0];
#pragma unroll
    for (int i = 1; i < NV; ++i) { mx = fmaxf(mx, v[i]); mn = fminf(mn, v[i]); }
    mx = red4_max(mx); mn = red4_min(mn);
    float lo = mn, hi = mx, clo = ntot - 1.0f, chi = 0.0f, thr = mn - 1.0f; bool done = false;
#pragma unroll 1
    for (int iter = 0; iter < 48; ++iter) {
        float fr_ = tk_pivot(clo, chi); if (iter >= TK_NI) fr_ = 0.5f;
        const float mid = done ? thr : lo + (hi - lo) * fr_;
        const float cnt = tk_count<NV>(v, mid);
        if (!done) { if (cnt == 16.0f) { thr = mid; done = true; } else if (cnt > 16.0f) { lo = mid; clo = cnt; thr = mid; } else { hi = mid; chi = cnt; } }
        if (__all(done)) break;
    }
    thr_out = thr;
}
DI void tk_search2(const float (&v0)[32], const float (&v1)[32], float& t0, float& t1) {
    float mx0 = v0[0], mn0 = v0[0], mx1 = v1[0], mn1 = v1[0];
#pragma unroll
    for (int i = 1; i < 32; ++i) { mx0 = fmaxf(mx0, v0[i]); mn0 = fminf(mn0, v0[i]); mx1 = fmaxf(mx1, v1[i]); mn1 = fminf(mn1, v1[i]); }
    mx0 = red4_max(mx0); mn0 = red4_min(mn0); mx1 = red4_max(mx1); mn1 = red4_min(mn1);
    float lo0 = mn0, hi0 = mx0, clo0 = 127.0f, chi0 = 0.0f, thr0 = mn0 - 1.0f; bool done0 = false;
    float lo1 = mn1, hi1 = mx1, clo1 = 127.0f, chi1 = 0.0f, thr1 = mn1 - 1.0f; bool done1 = false;
#pragma unroll 1
    for (int iter = 0; iter < 48; ++iter) {
        float f0 = tk_pivot(clo0, chi0), f1 = tk_pivot(clo1, chi1); if (iter >= TK_NI) { f0 = 0.5f; f1 = 0.5f; }
        const float mid0 = done0 ? thr0 : lo0 + (hi0 - lo0) * f0, mid1 = done1 ? thr1 : lo1 + (hi1 - lo1) * f1;
        const float c0 = tk_count<32>(v0, mid0), c1 = tk_count<32>(v1, mid1);
        if (!done0) { if (c0 == 16.0f) { thr0 = mid0; done0 = true; } else if (c0 > 16.0f) { lo0 = mid0; clo0 = c0; thr0 = mid0; } else { hi0 = mid0; chi0 = c0; } }
        if (!done1) { if (c1 == 16.0f) { thr1 = mid1; done1 = true; } else if (c1 > 16.0f) { lo1 = mid1; clo1 = c1; thr1 = mid1; } else { hi1 = mid1; chi1 = c1; } }
        if (__all(done0 && done1)) break;
    }
    t0 = thr0; t1 = thr1;
}
template <int MODE = 0> DI void peer_topk_fused(const Ctx& C, const bf16* QP, const bf16* KEYS, int* IDX, float* GATE) {
    constexpr int KPI = 288;
    const int lane = C.lane, fr = lane & 15, fq = lane >> 4, w = C.wave;
    LAS unsigned char* KS = C.lds;
    LAS unsigned char* WB = C.lds + 73728 + w * 7168;
    LAS float* LV = (LAS float*)(WB);
    LAS int* LK = (LAS int*)(WB + 2176);
    LAS float* FV = (LAS float*)(WB + 4352);
    LAS int* FI = (LAS int*)(WB + 5504);
    LAS float* TRASH = (LAS float*)(WB + 6656) + lane;
    const int h = C.vcu & 7, nb = C.G >> 3;
    { const bf16* kg = KEYS + (size_t)h * 2 * 128 * 128;
      for (int c = C.tid; c < 4096; c += 512) { const int r = c >> 4, cc = c & 15; *(LAS u32x4*)(KS + r * KPI + cc * 16) = *(const u32x4*)(kg + (size_t)r * 128 + cc * 8); } }
    __syncthreads();
    for (int tt = (C.vcu >> 3) + nb * w; tt < 1024; tt += nb * 8) {
        const int tok = tt * 16 + fr;
        float sc0[32], sc1[32];
#pragma unroll
        for (int p = 0; p < 2; ++p) {
            bf16x8 qf[4];
#pragma unroll
            for (int ks = 0; ks < 4; ++ks) qf[ks] = *(const bf16x8*)(QP + (size_t)tok * 2048 + h * 256 + p * 128 + ks * 32 + fq * 8);
#pragma unroll
            for (int kt = 0; kt < 8; ++kt) {
                f32x4 acc = {0.f, 0.f, 0.f, 0.f};
#pragma unroll
                for (int ks = 0; ks < 4; ++ks) { const bf16x8 kf = *(const LAS bf16x8*)(KS + (p * 128 + kt * 16 + fr) * KPI + (ks * 32 + fq * 8) * 2);
                    acc = __builtin_amdgcn_mfma_f32_16x16x32_bf16(kf, qf[ks], acc, 0, 0, 0); }
                if (p == 0) { sc0[kt * 4 + 0] = acc[0]; sc0[kt * 4 + 1] = acc[1]; sc0[kt * 4 + 2] = acc[2]; sc0[kt * 4 + 3] = acc[3]; }
                else { sc1[kt * 4 + 0] = acc[0]; sc1[kt * 4 + 1] = acc[1]; sc1[kt * 4 + 2] = acc[2]; sc1[kt * 4 + 3] = acc[3]; }
            }
        }
        float thrA = 1.0f, thrB = 1.0f; if (MODE == 0) tk_search2(sc0, sc1, thrA, thrB);
#pragma unroll
        for (int p = 0; p < 2; ++p) {
            const float thr = p == 0 ? thrA : thrB;
            int cnt = 0;
#pragma unroll
            for (int i = 0; i < 32; ++i) cnt += ((p == 0 ? sc0[i] : sc1[i]) > thr) ? 1 : 0;
            const int c0 = __shfl(cnt, fr), c1 = __shfl(cnt, fr + 16), c2 = __shfl(cnt, fr + 32);
            int pos = (fq > 0 ? c0 : 0) + (fq > 1 ? c1 : 0) + (fq > 2 ? c2 : 0);
#pragma unroll
            for (int i = 0; i < 32; ++i) { const float vv = p == 0 ? sc0[i] : sc1[i]; const bool s = vv > thr && pos < 16;
                LAS float* pv = s ? (LV + fr * 33 + p * 16 + pos) : TRASH; LAS int* pk = s ? (LK + fr * 33 + p * 16 + pos) : (LAS int*)TRASH;
                *pv = vv; *pk = (i >> 2) * 16 + 4 * fq + (i & 3); pos += (vv > thr) ? 1 : 0; }
        }
        LDS_WAIT();
        float A[4], Bv[16]; int KA[4], KB[16];
#pragma unroll
        for (int a = 0; a < 4; ++a) { A[a] = LV[fr * 33 + 4 * fq + a]; KA[a] = LK[fr * 33 + 4 * fq + a]; }
#pragma unroll
        for (int bq = 0; bq < 16; ++bq) { Bv[bq] = LV[fr * 33 + 16 + bq]; KB[bq] = LK[fr * 33 + 16 + bq]; }
        float sm[64];
#pragma unroll
        for (int a = 0; a < 4; ++a)
#pragma unroll
            for (int bq = 0; bq < 16; ++bq) sm[a * 16 + bq] = A[a] + Bv[bq];
        float thr2 = 4.0f; if (MODE == 0) tk_search<64>(sm, 256.0f, thr2);
        {
            int cnt = 0;
#pragma unroll
            for (int i = 0; i < 64; ++i) cnt += (sm[i] > thr2) ? 1 : 0;
            const int c0 = __shfl(cnt, fr), c1 = __shfl(cnt, fr + 16), c2 = __shfl(cnt, fr + 32);
            int pos = (fq > 0 ? c0 : 0) + (fq > 1 ? c1 : 0) + (fq > 2 ? c2 : 0);
#pragma unroll
            for (int i = 0; i < 64; ++i) { const bool s = sm[i] > thr2 && pos < 16;
                LAS float* pv = s ? (FV + fr * 17 + pos) : TRASH; LAS int* pk = s ? (FI + fr * 17 + pos) : (LAS int*)TRASH;
                *pv = sm[i]; *pk = KA[i >> 4] * 128 + KB[i & 15]; pos += (sm[i] > thr2) ? 1 : 0; }
        }
        LDS_WAIT();
        float x[4]; int xi[4];
#pragma unroll
        for (int j = 0; j < 4; ++j) { x[j] = FV[fr * 17 + 4 * fq + j]; xi[j] = FI[fr * 17 + 4 * fq + j]; }
        float m = red4_max(fmaxf(fmaxf(x[0], x[1]), fmaxf(x[2], x[3])));
        float e[4]; float s = 0.f;
#pragma unroll
        for (int j = 0; j < 4; ++j) { e[j] = __expf(x[j] - m); s += e[j]; }
        s = red4_sum(s);
        const float inv = 1.0f / s;
        const size_t ob = ((size_t)tok * 8 + h) * 16 + 4 * fq;
        typedef int i32x4 __attribute__((ext_vector_type(4)));
        *(i32x4*)(IDX + ob) = (i32x4){xi[0], xi[1], xi[2], xi[3]}; *(f32x4*)(GATE + ob) = (f32x4){e[0] * inv, e[1] * inv, e[2] * inv, e[3] * inv};
        LDS_WAIT();
    }
}
DI void intra_mfma(const Ctx& C, const bf16* Q, const bf16* K, const bf16* V, const bf16* CROSS, bf16* G) {
    constexpr int RPI = 544, PPI = 144, VPI = 544;
    LAS unsigned char* Qs = C.lds; LAS unsigned char* Ks = Qs + 64 * RPI; LAS unsigned char* Ps = Ks + 64 * RPI; LAS unsigned char* Vs = Ps + 64 * PPI;
    LAS float* red = (LAS float*)(Vs + 64 * VPI);
    const int tid = C.tid, lane = C.lane, w = C.wave, fr = lane & 15, fq = lane >> 4;
    for (int item = C.vcu; item < 1024; item += C.G) {
        const int b = item >> 9, h = (item >> 7) & 3, n = item & 127;
        const float lg2 = log2f(1.0f - exp2f(-5.0f - (float)h));
        const size_t tok0 = (size_t)b * SEQ + (size_t)n * 64;
#pragma unroll
        for (int u = 0; u < 4; ++u) { const int c = tid + 512 * u, r = c >> 5, cc = c & 31;
            *(LAS u32x4*)(Qs + r * RPI + cc * 16) = *(const u32x4*)(Q + (tok0 + r) * 1024 + h * 256 + cc * 8);
            *(LAS u32x4*)(Ks + r * RPI + cc * 16) = *(const u32x4*)(K + (tok0 + r) * 1024 + h * 256 + cc * 8);
            *(LAS u32x4*)(Vs + r * VPI + cc * 16) = *(const u32x4*)(V + (tok0 + r) * 2048 + h * 512 + cc * 8); }
        __syncthreads();
        { const int jt = w >> 1; f32x4 sa[2] = {(f32x4){0.f, 0.f, 0.f, 0.f}, (f32x4){0.f, 0.f, 0.f, 0.f}};
#pragma unroll
          for (int ks = 0; ks < 8; ++ks) { const bf16x8 kf = *(const LAS bf16x8*)(Ks + (16 * jt + fr) * RPI + (32 * ks + 8 * fq) * 2);
#pragma unroll
              for (int q = 0; q < 2; ++q) { const int it = 2 * (w & 1) + q; const bf16x8 qf = *(const LAS bf16x8*)(Qs + (16 * it + fr) * RPI + (32 * ks + 8 * fq) * 2);
                  sa[q] = __builtin_amdgcn_mfma_f32_16x16x32_bf16(kf, qf, sa[q], 0, 0, 0); } }
#pragma unroll
          for (int q = 0; q < 2; ++q) { const int i = 16 * (2 * (w & 1) + q) + fr, j0 = 16 * jt + 4 * fq; float pv[4];
#pragma unroll
              for (int r = 0; r < 4; ++r) { const int dd = i > j0 + r ? i - j0 - r : j0 + r - i; pv[r] = sa[q][r] * exp2f(lg2 * (float)dd); }
              u32x2_t o; o.x = cvtpk(pv[0], pv[1]); o.y = cvtpk(pv[2], pv[3]); *(LAS u32x2_t*)(Ps + i * PPI + j0 * 2) = o; } }
        __syncthreads();
        f32x4 acc[2][2][4];
#pragma unroll
        for (int hf = 0; hf < 2; ++hf) {
#pragma unroll
            for (int et = 0; et < 2; ++et)
#pragma unroll
                for (int it = 0; it < 4; ++it) acc[hf][et][it] = (f32x4){0.f, 0.f, 0.f, 0.f};
            if (hf == 1) { __syncthreads();
#pragma unroll
                for (int u = 0; u < 4; ++u) { const int c = tid + 512 * u, r = c >> 5, cc = c & 31;
                    *(LAS u32x4*)(Vs + r * VPI + cc * 16) = *(const u32x4*)(V + (tok0 + r) * 2048 + h * 512 + 256 + cc * 8); }
                __syncthreads(); }
#pragma unroll
            for (int ks = 0; ks < 2; ++ks) {
                bf16x8 pf[4];
#pragma unroll
                for (int it = 0; it < 4; ++it) { const LAS unsigned char* pp = Ps + (16 * it + fr) * PPI + (32 * ks + 4 * fq) * 2;
                    const u32x2_t lo = *(const LAS u32x2_t*)pp, hi = *(const LAS u32x2_t*)(pp + 32); u32x4 ww; ww.x = lo.x; ww.y = lo.y; ww.z = hi.x; ww.w = hi.y; pf[it] = __builtin_bit_cast(bf16x8, ww); }
#pragma unroll
                for (int et = 0; et < 2; ++et) { const LAS unsigned char* vp = Vs + (32 * ks + 4 * fq + (fr >> 2)) * VPI + (32 * w + 16 * et + 4 * (fr & 3)) * 2;
                    const bf16x8 vf = cat8(trr(vp), trr(vp + 16 * VPI));
#pragma unroll
                    for (int it = 0; it < 4; ++it) acc[hf][et][it] = __builtin_amdgcn_mfma_f32_16x16x32_bf16(vf, pf[it], acc[hf][et][it], 0, 0, 0); }
            }
        }
        float ssq[4] = {0.f, 0.f, 0.f, 0.f};
#pragma unroll
        for (int hf = 0; hf < 2; ++hf)
#pragma unroll
            for (int et = 0; et < 2; ++et)
#pragma unroll
                for (int it = 0; it < 4; ++it) { const u32x2_t cv = *(const u32x2_t*)(CROSS + (tok0 + 16 * it + fr) * 2048 + h * 512 + hf * 256 + 32 * w + 16 * et + 4 * fq);
                    f32x4 y = acc[hf][et][it]; y[0] += bflo(cv.x); y[1] += bfhi(cv.x); y[2] += bflo(cv.y); y[3] += bfhi(cv.y); acc[hf][et][it] = y;
                    ssq[it] += (y[0] * y[0] + y[1] * y[1]) + (y[2] * y[2] + y[3] * y[3]); }
#pragma unroll
        for (int it = 0; it < 4; ++it) { float s = ssq[it]; s += __shfl_xor(s, 16); s += __shfl_xor(s, 32); if (fq == 0) red[w * 64 + 16 * it + fr] = s; }
        __syncthreads();
        float rs[4];
#pragma unroll
        for (int it = 0; it < 4; ++it) { float s = 0.f;
#pragma unroll
            for (int ww = 0; ww < 8; ++ww) s += red[ww * 64 + 16 * it + fr];
            rs[it] = 1.0f / sqrtf(s * (1.0f / 512.0f) + EPS); }
#pragma unroll
        for (int hf = 0; hf < 2; ++hf)
#pragma unroll
            for (int et = 0; et < 2; ++et)
#pragma unroll
                for (int it = 0; it < 4; ++it) { bf16* gp = G + (tok0 + 16 * it + fr) * 2048 + h * 512 + hf * 256 + 32 * w + 16 * et + 4 * fq; const u32x2_t gv = *(const u32x2_t*)gp;
                    const f32x4 y = acc[hf][et][it] * rs[it]; u32x2_t o; o.x = cvtpk(y[0] * bflo(gv.x), y[1] * bfhi(gv.x)); o.y = cvtpk(y[2] * bflo(gv.y), y[3] * bfhi(gv.y)); *(u32x2_t*)gp = o; }
        __syncthreads();
    }
}
#ifndef PHMASK
#define PHMASK 0xFFFFFFu
#endif
#define PH(k) ((PHMASK >> (k)) & 1u)
#ifdef USE_SGU_NAIVE
#define SGU_GATE_FN sgu_gate_naive
#else
#define SGU_GATE_FN sgu_gate_mfma
#endif
#ifdef USE_GATHER_TOKEN
#define GATHER_FN peer_gather8
#else
#ifdef USE_GATHER_ROUNDS
#define GATHER_FN peer_gather_rounds
#else
#define GATHER_FN peer_gather_dma
#endif
#endif
#ifndef DUP_GATHER_SKIP
#define DUP_GATHER_SKIP 0
#endif
#ifndef DUP_GATHER_FAKE
#define DUP_GATHER_FAKE false
#endif
struct Args { const void* in[21]; float* out; unsigned char* ws; };
__global__ void __launch_bounds__(NWAVES * 64, 2) mk_fwd(Args args) {
    extern __shared__ __attribute__((aligned(16))) unsigned char lds[];
    Ctx C; C.lds = (LAS unsigned char*)lds; C.tid = threadIdx.x; C.lane = C.tid & 63; C.wave = __builtin_amdgcn_readfirstlane(C.tid >> 6);
    C.G = gridDim.x; { const int bx = blockIdx.x; C.vcu = (C.G % 8 == 0) ? (bx % 8) * (C.G / 8) + bx / 8 : bx; }
    C.ws = args.ws;
    volatile LAS unsigned* MISC = (volatile LAS unsigned*)(C.lds + MISC_OFF);
    gu32* ctl = (gu32*)(args.ws + WS_CTL);
    for (int u = C.tid; u < (LDS_BYTES - LDSCTL_OFF) / 4; u += NWAVES * 64) ((LAS unsigned*)(C.lds + LDSCTL_OFF))[u] = 0u;
    __syncthreads();
    XcdBarrier bar = xcd_barrier_post((unsigned*)(ctl + CW_BAR), MISC + 8);
#define GRID_BAR() do { xcd_barrier(bar); asm volatile("" : "+v"(C.tid)); C.lane = C.tid & 63; C.wave = __builtin_amdgcn_readfirstlane(C.tid >> 6); } while (0)
    { LAS unsigned long long* PT = (LAS unsigned long long*)(C.lds + PTR_OFF);
      if (C.tid == 0) {
#pragma unroll
          for (int i = 0; i < 21; ++i) PT[i] = (unsigned long long)args.in[i];
      } }
    __syncthreads();
#define INP(T, i) ((const T*)ldp(C, i))
    float* out = args.out; unsigned char* ws = args.ws;
#define MODP ((float*)(ws + WS_MOD))
#define MOD0 ((const float*)(ws + WS_MOD))
#define MOD1 ((const float*)(ws + WS_MOD) + 2 * 6144)
#define cosT ((float*)(ws + WS_COS))
#define sinT ((float*)(ws + WS_SIN))
#define WRI ((bf16*)(ws + WS_WRI))
#define WRO ((bf16*)(ws + WS_WRO))
#define WSI ((bf16*)(ws + WS_WSI))
#define WSO ((bf16*)(ws + WS_WSO))
#define WQ ((bf16*)(ws + WS_WQ))
#define KEYS ((bf16*)(ws + WS_KEYS))
#define STATS ((float*)(ws + WS_STATS))
#define IDX ((int*)(ws + WS_IDX))
#define GATE ((float*)(ws + WS_GATE))
#define H ((bf16*)(ws + WS_H))
#define PU8 ((const unsigned char*)(ws + WS_PU))
#define PV8 ((const unsigned char*)(ws + WS_PV))
#define ISU ((const float*)(ws + WS_ISU))
#define ISV ((const float*)(ws + WS_ISV))
#define Qb ((bf16*)(ws + WS_Q))
#define Kb ((bf16*)(ws + WS_K))
#define Vb ((bf16*)(ws + WS_V))
#define Gb ((bf16*)(ws + WS_G))
#define CROSS ((bf16*)(ws + WS_CROSS))
#define QP ((bf16*)(ws + WS_QP))
#define SCO ((float*)(ws + WS_SC))
#define Ub ((bf16*)(ws + WS_U))
#define VBb ((bf16*)(ws + WS_VB))

    { P0In I; I.c = INP(float, 1); I.ada_w = INP(float, 5); I.ada_b = INP(float, 6); I.ret_w_in = INP(float, 7); I.ret_w_out = INP(float, 8); I.sgu_w_in = INP(float, 9); I.sgu_w_out = INP(float, 15); I.wq = INP(float, 16); I.keys = INP(float, 17); I.pu = INP(float, 18); I.pv = INP(float, 19); I.pos = INP(int, 2);
#ifdef DUP_P0
      p0_prologue(C, I);
      GRID_BAR();
#endif
      if (PH(0)) p0_prologue(C, I); }
    GRID_BAR();
    if (PH(1)) rms_mod_phase(C, INP(float, 0), INP(float, 3), MOD0, 0, 1024, H);
    GRID_BAR();
    { pg8::Gemm g{H, WRI, TT, 6144, 1024}; pg8::StaticOrder S; S.init(TT, 6144, C.G, (int)blockIdx.x);
      pg8::EpiRetProj E{Qb, Kb, Vb, Gb, cosT, sinT};
#ifdef DUP_G1
      pg8::gemm_phase<pg8::EpiRetProj, pg8::StaticOrder, true, true>(C.lds + RING_OFF, g, S, E); GRID_BAR();
#endif
      if (PH(2)) pg8::gemm_phase<pg8::EpiRetProj, pg8::StaticOrder, true, true>(C.lds + RING_OFF, g, S, E); }
    GRID_BAR();
    #ifdef USE_SCAN_NAIVE
    if (PH(3)) scan_naive(C, Qb, Kb, Vb, CROSS);
#else
#ifdef DUP_SCAN
    scan_mfma<DUP_SCAN>(C, Qb, Kb, Vb, CROSS);
    GRID_BAR();
#endif
    if (C.vcu < SCAN_NIT) { if (PH(3)) scan_mfma<0>(C, Qb, Kb, Vb, CROSS); }
    else { P0In I; I.c = nullptr; I.ada_w = nullptr; I.ada_b = nullptr; I.ret_w_in = nullptr; I.ret_w_out = nullptr; I.sgu_w_in = INP(float, 9); I.sgu_w_out = INP(float, 15); I.wq = INP(float, 16); I.keys = nullptr; I.pu = INP(float, 18); I.pv = INP(float, 19); I.pos = nullptr;
      side_work(C, I, SCAN_NIT); }
#endif
    GRID_BAR();
#ifdef USE_INTRA_NAIVE
    if (PH(4)) intra_naive(C, Qb, Kb, Vb, CROSS, Gb);
#else
    if (PH(4)) intra_mfma(C, Qb, Kb, Vb, CROSS, Gb);
#endif
    GRID_BAR();
    { pg8::Gemm g{Gb, WRO, TT, 1024, 2048}; pg8::StaticOrder S; S.init(TT, 1024, C.G, (int)blockIdx.x);
      pg8::EpiResGate E{INP(float, 0), out, MOD0 + 2048, 6144};
      if (PH(5)) pg8::gemm_phase<pg8::EpiResGate, pg8::StaticOrder, true, true>(C.lds + RING_OFF, g, S, E); }
    GRID_BAR();
    if (PH(6)) rms_mod_phase(C, out, INP(float, 4), MOD0, 3072, 4096, H);
    GRID_BAR();
    { pg8::Gemm g{H, WQ, TT, 2048, 1024}; pg8::StaticOrder S; S.init(TT, 2048, C.G, (int)blockIdx.x);
      pg8::EpiBf16<0> E{QP, 2048, nullptr, 0, 0, 1.f};
      if (PH(7)) pg8::gemm_phase<pg8::EpiBf16<0>, pg8::StaticOrder, true, true>(C.lds + RING_OFF, g, S, E); }
    GRID_BAR();
#ifdef USE_TOPK_NAIVE
    if (PH(8)) peer_scores(C, QP, KEYS, SCO);
    GRID_BAR();
    if (PH(9)) peer_topk(C, SCO, IDX, GATE);
#else
#ifdef DUP_TOPK
    peer_topk_fused<DUP_TOPK>(C, QP, KEYS, IDX, GATE);
    GRID_BAR();
#endif
    if (PH(9)) peer_topk_fused<0>(C, QP, KEYS, IDX, GATE);
#endif
    GRID_BAR();
#ifdef DUP_GATHER
    GATHER_FN<false, DUP_GATHER_FAKE, DUP_GATHER_SKIP>(C, H, IDX, GATE, PU8, PV8, ISU, ISV, (float*)(ws + WS_R), MOD0 + 5120, INP(float, 3) + 1024, MOD1, (bf16*)(ws + WS_R + 128 * MiB));
    GRID_BAR();
#endif
    if (PH(10)) GATHER_FN<false>(C, H, IDX, GATE, PU8, PV8, ISU, ISV, out, MOD0 + 5120, INP(float, 3) + 1024, MOD1, H);
    GRID_BAR();
#ifdef DUP_BAR
    for (int q_ = 0; q_ < 10; ++q_) GRID_BAR();
#endif
    { pg8::Gemm g{H, WSI, TT, 6144, 1024}; pg8::StaticOrder S; S.init(TT, 6144, C.G, (int)blockIdx.x);
      pg8::EpiSguIn E{Ub, VBb, INP(float, 10), STATS};
#ifdef DUP_G7
      pg8::gemm_phase<pg8::EpiSguIn, pg8::StaticOrder, true, true>(C.lds + RING_OFF, g, S, E); GRID_BAR();
#endif
      if (PH(11)) pg8::gemm_phase<pg8::EpiSguIn, pg8::StaticOrder, true, true>(C.lds + RING_OFF, g, S, E); }
    GRID_BAR();
    if (PH(12)) SGU_GATE_FN(C, Ub, VBb, STATS, INP(float, 13), INP(float, 14), INP(float, 11), INP(float, 12));
    GRID_BAR();
    { pg8::Gemm g{Ub, WSO, TT, 1024, 3072}; pg8::StaticOrder S; S.init(TT, 1024, C.G, (int)blockIdx.x);
      pg8::EpiResGate E{out, out, MOD1 + 2048, 6144};
      if (PH(13)) pg8::gemm_phase<pg8::EpiResGate, pg8::StaticOrder, true, true>(C.lds + RING_OFF, g, S, E); }
    GRID_BAR();
    if (PH(14)) rms_mod_phase(C, out, INP(float, 4) + 1024, MOD1, 3072, 4096, H);
    GRID_BAR();
    { pg8::Gemm g{H, WQ + (size_t)2048 * 1024, TT, 2048, 1024}; pg8::StaticOrder S; S.init(TT, 2048, C.G, (int)blockIdx.x);
      pg8::EpiBf16<0> E{QP, 2048, nullptr, 0, 0, 1.f};
      if (PH(15)) pg8::gemm_phase<pg8::EpiBf16<0>, pg8::StaticOrder, true, true>(C.lds + RING_OFF, g, S, E); }
    GRID_BAR();
#ifdef USE_TOPK_NAIVE
    if (PH(16)) peer_scores(C, QP, KEYS + (size_t)8 * 2 * 128 * 128, SCO);
    GRID_BAR();
    if (PH(17)) peer_topk(C, SCO, IDX, GATE);
#else
    if (PH(17)) peer_topk_fused<0>(C, QP, KEYS + (size_t)8 * 2 * 128 * 128, IDX, GATE);
#endif
    GRID_BAR();
    if (PH(18)) GATHER_FN<true>(C, H, IDX, GATE, PU8 + (size_t)16384 * 1024, PV8 + (size_t)16384 * 1024, ISU + 16384, ISV + 16384, out, MOD1 + 5120, INP(float, 20), nullptr, nullptr);
#undef GRID_BAR
}

extern "C" void kernel_launch(void* const* d_in, const int* in_sizes, int n_in, void* d_out, int out_size, void* d_ws, size_t ws_size, hipStream_t stream) {
    static int grid = 0;
    if (grid == 0) {
        if (n_in != 21 || in_sizes[0] != TT * DM || out_size != TT * DM || ws_size < WS_END) { fprintf(stderr, "kernel_launch: unexpected shapes/workspace: n_in %d in0 %d out %d ws %zu (need %zu)\n", n_in, n_in > 0 ? in_sizes[0] : -1, out_size, ws_size, (size_t)WS_END); grid = -1; return; }
        int dev = 0, cus = 0;
        if (hipGetDevice(&dev) != hipSuccess || hipDeviceGetAttribute(&cus, hipDeviceAttributeMultiprocessorCount, dev) != hipSuccess) { fprintf(stderr, "kernel_launch: device query failed\n"); grid = -1; return; }
        if (hipFuncSetAttribute((const void*)mk_fwd, hipFuncAttributeMaxDynamicSharedMemorySize, LDS_BYTES) != hipSuccess) { fprintf(stderr, "kernel_launch: hipFuncSetAttribute failed\n"); grid = -1; return; }
        (void)hipGetLastError();
        grid = cus;
    }
    if (grid < 0) return;
    if (hipMemsetAsync((char*)d_ws + WS_CTL, 0, CTL_ZERO_BYTES, stream) != hipSuccess) { fprintf(stderr, "kernel_launch: memset failed\n"); return; }
    Args a; memset(&a, 0, sizeof(a));
    for (int i = 0; i < 21; ++i) a.in[i] = d_in[i];
    a.out = (float*)d_out; a.ws = (unsigned char*)d_ws;
    hipLaunchKernelGGL(mk_fwd, dim3(grid), dim3(NWAVES * 64), LDS_BYTES, stream, a);
    const hipError_t le = hipPeekAtLastError();
    if (le != hipSuccess) fprintf(stderr, "kernel_launch: launch failed: %s\n", hipGetErrorName(le));
}
```

```cpp
#define USE_GATHER_ROUNDS 1
#include <hip/hip_runtime.h>
#include <cstdio>
#include <cstdint>
#include <cstring>
#include <cmath>
namespace pg8 {
#define PG8_LAS __attribute__((address_space(3)))
typedef unsigned short bf16_t;
typedef short bf16x8 __attribute__((ext_vector_type(8)));
typedef float f32x4 __attribute__((ext_vector_type(4)));
typedef unsigned u32x4 __attribute__((ext_vector_type(4)));
constexpr int BM = 256, BK = 64, HALF = 128, HTB = HALF * BK * 2  , STAGE_BYTES = 8 * HTB, NXCD = 8, WGM = 8;

__host__ __device__ __forceinline__ int lds_byte(int r, int c) { const int st = (r >> 4) * 2 + (c >> 5), rr = r & 15, cc = c & 31, ob = rr * 64 + cc * 2; return st * 1024 + (ob ^ (((ob >> 9) & 1) << 5)); }
__host__ __device__ __forceinline__ void stage_rc(int b, int& R, int& C) { const int st = b / 1024, sb = b % 1024, swz = sb ^ (((sb >> 9) & 1) << 5); R = (st >> 1) * 16 + swz / 64; C = (st & 1) * 32 + (swz % 64) / 2; }
__host__ __device__ __forceinline__ int perm32(int rho) { const int n = rho >> 4, i = rho & 15; return 8 * (i >> 2) + 4 * n + (i & 3); }

struct Unit { int pm, pn; };
struct Gemm { const bf16_t* A; const bf16_t* Bt; int M, N, K; };

struct StaticOrder {
    int nM, nN, nwg, G, c;
    __host__ __device__ void init(int M, int N, int G_, int c_) { nM = M / BM; nN = N / BM; nwg = nM * nN; G = G_; c = c_; }
    __host__ __device__ bool next(int i, Unit& u) const {
        const long L = (long)i * G + c; if (L >= nwg) return false;
        int wgid = (int)L; { const int q = nwg / NXCD, r = nwg % NXCD, xcd = wgid % NXCD, off = wgid / NXCD; wgid = (xcd < r ? xcd * (q + 1) : r * (q + 1) + (xcd - r) * q) + off; }
        const int nig = WGM * nN, gid = wgid / nig, fm = gid * WGM, gsz = (nM - fm) < WGM ? (nM - fm) : WGM;
        u.pm = fm + ((wgid % nig) % gsz); u.pn = (wgid % nig) / gsz; return true;
    }
    __device__ __forceinline__ void a_ready(const Unit&) const {}
    __device__ __forceinline__ void done(const Unit&) const {}
};

__device__ __forceinline__ unsigned cvt_pk_bf16(float lo, float hi) { unsigned r; asm volatile("v_cvt_pk_bf16_f32 %0, %1, %2" : "=v"(r) : "v"(lo), "v"(hi)); return r; }
typedef float f32x2 __attribute__((ext_vector_type(2)));
__device__ __forceinline__ f32x2 gelu_pk(f32x2 v) {
    const f32x2 av = __builtin_elementwise_abs(v), d = av * 0.2316418882f + 1.0f;
    f32x2 t; t.x = __builtin_amdgcn_rcpf(d.x); t.y = __builtin_amdgcn_rcpf(d.y);
    f32x2 q = t * 0.5307027145f + (-0.7265760135f); q = q * t + 0.7107068705f; q = q * t + (-0.142248368f); q = q * t + 0.127414796f; q = q * t;
    const f32x2 s = (v * v) * (-0.72134752044f);
    f32x2 e; e.x = __builtin_amdgcn_exp2f(s.x); e.y = __builtin_amdgcn_exp2f(s.y);
    const f32x2 m = v * (q * e), r = v - m;
    f32x2 o; o.x = v.x < 0.f ? m.x : r.x; o.y = v.y < 0.f ? m.y : r.y; return o;
}

template <int ACT  > struct EpiBf16 {
    static constexpr bool PERM = true, AFTER_DRAIN = false; static_assert(ACT == 0 || ACT == 1, "EpiBf16: ACT is 0 (none) or 1 (gelu_pk)");
    bf16_t* O; int ldc; const float* bias; int split_cols; size_t split_stride; float scale0;
    __device__ __forceinline__ void operator()(const f32x4 (&acc)[2][2][4][2], const Unit& u, int wr, int wc, int fr, int fq) const {
        const int row0 = u.pm * BM + wr * 64 + fr; int colt = u.pn * BM; bf16_t* base = O;
        float sc = 1.f; if (split_cols) { const int t = colt / split_cols; base += (size_t)t * split_stride; colt -= t * split_cols; if (t == 0) sc = scale0; }
        const int col0 = colt + wc * 32 + 8 * fq, bcol0 = u.pn * BM + wc * 32 + 8 * fq;
        f32x4 bv[2][2];
#pragma unroll
        for (int bj = 0; bj < 2; ++bj)
#pragma unroll
            for (int n = 0; n < 2; ++n) bv[bj][n] = bias ? *(const f32x4*)(bias + bcol0 + bj * HALF + 4 * n) : (f32x4){0.f, 0.f, 0.f, 0.f};
#pragma unroll
        for (int ai = 0; ai < 2; ++ai)
#pragma unroll
            for (int m = 0; m < 4; ++m) { bf16_t* rowp = base + (size_t)(row0 + ai * HALF + m * 16) * ldc + col0;
#pragma unroll
                for (int bj = 0; bj < 2; ++bj) { f32x4 v0 = acc[ai][bj][m][0] + bv[bj][0], v1 = acc[ai][bj][m][1] + bv[bj][1];
                    if (ACT == 1) { f32x2 a = gelu_pk((f32x2){v0[0], v0[1]}), b = gelu_pk((f32x2){v0[2], v0[3]}), c = gelu_pk((f32x2){v1[0], v1[1]}), d = gelu_pk((f32x2){v1[2], v1[3]});
                        v0 = (f32x4){a.x, a.y, b.x, b.y}; v1 = (f32x4){c.x, c.y, d.x, d.y}; }
                    v0 = v0 * sc; v1 = v1 * sc; u32x4 w; w.x = cvt_pk_bf16(v0[0], v0[1]); w.y = cvt_pk_bf16(v0[2], v0[3]); w.z = cvt_pk_bf16(v1[0], v1[1]); w.w = cvt_pk_bf16(v1[2], v1[3]);
                    *(u32x4*)(rowp + bj * HALF) = w; } }
    }
};
template <class Epi, class Sched, bool ALIGN_EPI = false, bool SP2 = false>
__device__ __forceinline__ void gemm_phase(PG8_LAS unsigned char* lds, const Gemm g, const Sched& S, const Epi& E) {
    int tid_ = threadIdx.x; asm volatile("" : "+v"(tid_));
    const int tid = tid_, wid = __builtin_amdgcn_readfirstlane(tid >> 6), lane = tid & 63, wr = wid >> 2, wc = wid & 3, fr = lane & 15, fq = lane >> 4;
    const int K = g.K, nt = K / BK;
    unsigned voffA[2], voffB[2];
#pragma unroll
    for (int i = 0; i < 2; ++i) { int R, C; stage_rc(tid * 16 + i * 8192, R, C); const int Rb = Epi::PERM ? ((R & ~31) + perm32(R & 31)) : R;
        voffA[i] = (unsigned)(R * K + C) * 2u; voffB[i] = (unsigned)(Rb * K + C) * 2u; }
    const size_t kstep = (size_t)(BK * 2);
    const size_t hstep = (size_t)HALF * K * 2;
    const size_t tstep = 2 * hstep;
    const unsigned ldsw = (unsigned)wid * 1024u;
    const int aoff = lds_byte(wr * 64 + fr, fq * 8), boff = lds_byte(wc * 32 + fr, fq * 8);
#define PG8_SA(b, h) (((b) * 2 + (h)) * HTB)
#define PG8_SB(b, h) ((4 + (b) * 2 + (h)) * HTB)
#define PG8_STAGE(bufoff, gbase, voff) do { _Pragma("unroll") for (int _i = 0; _i < 2; ++_i) \
        __builtin_amdgcn_global_load_lds((const unsigned*)((const char*)(gbase) + (voff)[_i]), (PG8_LAS unsigned*)(lds + (bufoff) + ldsw + _i * 8192), 16, 0, 0); } while (0)
#define PG8_LDA(dst, b, h) do { _Pragma("unroll") for (int m = 0; m < 4; ++m) _Pragma("unroll") for (int k = 0; k < 2; ++k) dst[m][k] = *(const PG8_LAS bf16x8*)(lds + PG8_SA(b, h) + aoff + m * 2048 + k * 1024); } while (0)
#define PG8_LDB(dst, b, h) do { _Pragma("unroll") for (int n = 0; n < 2; ++n) _Pragma("unroll") for (int k = 0; k < 2; ++k) dst[n][k] = *(const PG8_LAS bf16x8*)(lds + PG8_SB(b, h) + boff + n * 2048 + k * 1024); } while (0)
#define PG8_MMA(ai, bj, At, Bt) do { __builtin_amdgcn_s_setprio(1); _Pragma("unroll") for (int m = 0; m < 4; ++m) _Pragma("unroll") for (int n = 0; n < 2; ++n) _Pragma("unroll") for (int k = 0; k < 2; ++k) \
        acc[ai][bj][m][n] = __builtin_amdgcn_mfma_f32_16x16x32_bf16(Bt[n][k], At[m][k], acc[ai][bj][m][n], 0, 0, 0); __builtin_amdgcn_s_setprio(0); } while (0)
#define PG8_WAIT_V(n) asm volatile("s_waitcnt vmcnt(" #n ")" ::: "memory")
#define PG8_WAIT_L(n) asm volatile("s_waitcnt lgkmcnt(" #n ")" ::: "memory")
#define PG8_BAR __builtin_amdgcn_s_barrier()
#define PG8_SCHED __builtin_amdgcn_sched_barrier(0)
    Unit cur, nxt; int ui = 0;
    if (!S.next(0, cur)) return;
    f32x4 acc[2][2][4][2];
#pragma unroll
    for (int a = 0; a < 2; ++a)
#pragma unroll
        for (int b = 0; b < 2; ++b)
#pragma unroll
            for (int m = 0; m < 4; ++m)
#pragma unroll
                for (int n = 0; n < 2; ++n) acc[a][b][m][n] = (f32x4){0.f, 0.f, 0.f, 0.f};
    bf16x8 At[4][2], B0[2][2], B1[2][2];
    const char* cA = (const char*)g.A + (size_t)cur.pm * tstep; const char* cB = (const char*)g.Bt + (size_t)cur.pn * tstep;
    S.a_ready(cur);
    if constexpr (SP2) {
        PG8_STAGE(PG8_SB(0, 0), cB, voffB); PG8_STAGE(PG8_SB(0, 1), cB + hstep, voffB); PG8_STAGE(PG8_SA(0, 0), cA, voffA); PG8_STAGE(PG8_SA(0, 1), cA + hstep, voffA);
        if (wr == 1) PG8_BAR;
        PG8_WAIT_V(2); PG8_BAR;
        PG8_STAGE(PG8_SB(1, 0), cB + kstep, voffB); PG8_STAGE(PG8_SA(1, 0), cA + kstep, voffA); PG8_STAGE(PG8_SB(1, 1), cB + hstep + kstep, voffB);
        PG8_WAIT_V(6); PG8_BAR;
    } else {
        PG8_STAGE(PG8_SB(0, 0), cB, voffB); PG8_STAGE(PG8_SA(0, 0), cA, voffA); PG8_STAGE(PG8_SB(0, 1), cB + hstep, voffB); PG8_STAGE(PG8_SA(0, 1), cA + hstep, voffA);
        if (wr == 1) PG8_BAR;
        PG8_WAIT_V(4); PG8_BAR;
        PG8_STAGE(PG8_SB(1, 0), cB + kstep, voffB); PG8_STAGE(PG8_SA(1, 0), cA + kstep, voffA); PG8_STAGE(PG8_SB(1, 1), cB + hstep + kstep, voffB);
        PG8_WAIT_V(6); PG8_BAR;
    }
    for (;;) {
        const bool has_next = S.next(ui + 1, nxt);
        const char* nA = has_next ? (const char*)g.A + (size_t)nxt.pm * tstep : cA; const char* nB = has_next ? (const char*)g.Bt + (size_t)nxt.pn * tstep : cB;
        for (int t = 0; t < nt; t += 2) {
            const bool last = (t == nt - 2);
            const char* a1 = cA + (size_t)(t + 1) * kstep;
            const char* a2 = last ? nA : cA + (size_t)(t + 2) * kstep; const char* b2 = last ? nB : cB + (size_t)(t + 2) * kstep;
            const char* a3 = a2 + kstep; const char* b3 = b2 + kstep;
            if (last && has_next) S.a_ready(nxt);
            if constexpr (SP2) {
            PG8_LDB(B0, 0, 0); PG8_LDB(B1, 0, 1); PG8_SCHED; PG8_LDA(At, 0, 0); PG8_STAGE(PG8_SA(1, 1), a1 + hstep, voffA);
            PG8_WAIT_V(8); PG8_WAIT_L(0); PG8_BAR; PG8_MMA(0, 0, At, B0); PG8_MMA(0, 1, At, B1); PG8_BAR; PG8_SCHED;
            PG8_LDA(At, 0, 1); PG8_STAGE(PG8_SB(0, 0), b2, voffB); PG8_STAGE(PG8_SB(0, 1), b2 + hstep, voffB); PG8_STAGE(PG8_SA(0, 0), a2, voffA);
            PG8_WAIT_V(8); PG8_WAIT_L(0); PG8_BAR; PG8_MMA(1, 0, At, B0); PG8_MMA(1, 1, At, B1); PG8_BAR; PG8_SCHED;
            PG8_LDB(B0, 1, 0); PG8_LDB(B1, 1, 1); PG8_SCHED; PG8_LDA(At, 1, 0); PG8_STAGE(PG8_SA(0, 1), a2 + hstep, voffA);
            PG8_WAIT_V(8); PG8_WAIT_L(0); PG8_BAR; PG8_MMA(0, 0, At, B0); PG8_MMA(0, 1, At, B1); PG8_BAR; PG8_SCHED;
            PG8_LDA(At, 1, 1); PG8_STAGE(PG8_SB(1, 0), b3, voffB); PG8_STAGE(PG8_SB(1, 1), b3 + hstep, voffB); PG8_STAGE(PG8_SA(1, 0), a3, voffA);
            PG8_WAIT_V(8); PG8_WAIT_L(0); PG8_BAR; PG8_MMA(1, 0, At, B0); PG8_MMA(1, 1, At, B1); PG8_BAR; PG8_SCHED;
            } else {
            PG8_LDB(B0, 0, 0); PG8_SCHED; PG8_LDA(At, 0, 0); PG8_STAGE(PG8_SA(1, 1), a1 + hstep, voffA);
            PG8_WAIT_L(8); PG8_BAR; PG8_WAIT_L(0); PG8_MMA(0, 0, At, B0); PG8_BAR; PG8_SCHED;
            PG8_LDB(B1, 0, 1); PG8_STAGE(PG8_SB(0, 0), b2, voffB);
            PG8_BAR; PG8_WAIT_L(0); PG8_MMA(0, 1, At, B1); PG8_BAR;
            PG8_LDA(At, 0, 1); PG8_STAGE(PG8_SA(0, 0), a2, voffA);
            PG8_BAR; PG8_WAIT_L(0); PG8_MMA(1, 0, At, B0); PG8_BAR; PG8_SCHED;
            PG8_STAGE(PG8_SB(0, 1), b2 + hstep, voffB);
            PG8_WAIT_V(6); PG8_BAR; PG8_MMA(1, 1, At, B1); PG8_BAR;
            PG8_LDB(B0, 1, 0); PG8_SCHED; PG8_LDA(At, 1, 0); PG8_STAGE(PG8_SA(0, 1), a2 + hstep, voffA);
            PG8_WAIT_L(8); PG8_BAR; PG8_WAIT_L(0); PG8_MMA(0, 0, At, B0); PG8_BAR; PG8_SCHED;
            PG8_LDB(B1, 1, 1); PG8_STAGE(PG8_SB(1, 0), b3, voffB);
            PG8_BAR; PG8_WAIT_L(0); PG8_MMA(0, 1, At, B1); PG8_BAR;
            PG8_LDA(At, 1, 1); PG8_STAGE(PG8_SA(1, 0), a3, voffA);
            PG8_BAR; PG8_WAIT_L(0); PG8_MMA(1, 0, At, B0); PG8_BAR; PG8_SCHED;
            PG8_STAGE(PG8_SB(1, 1), b3 + hstep, voffB);
            PG8_WAIT_V(6); PG8_BAR; PG8_MMA(1, 1, At, B1); PG8_BAR;
            }
        }
        if constexpr (ALIGN_EPI) { if (wr == 0) PG8_BAR; }
        if constexpr (!Epi::AFTER_DRAIN) { E(acc, cur, wr, wc, fr, fq); S.done(cur); }
        if (!has_next) break;
#pragma unroll
        for (int a = 0; a < 2; ++a)
#pragma unroll
            for (int b = 0; b < 2; ++b)
#pragma unroll
                for (int m = 0; m < 4; ++m)
#pragma unroll
                    for (int n = 0; n < 2; ++n) acc[a][b][m][n] = (f32x4){0.f, 0.f, 0.f, 0.f};
        cur = nxt; cA = nA; cB = nB; ++ui;
        if constexpr (ALIGN_EPI) { if (wr == 1) PG8_BAR; }
    }
    PG8_WAIT_V(0);
    if constexpr (!ALIGN_EPI) { if (wr == 0) PG8_BAR; }
    PG8_BAR;
    if constexpr (Epi::AFTER_DRAIN) { E.fused(acc, cur, wr, wc, fr, fq, lds, wid, lane); S.done(cur); }
#undef PG8_SA
#undef PG8_SB
#undef PG8_STAGE
#undef PG8_LDA
#undef PG8_LDB
#undef PG8_MMA
#undef PG8_WAIT_V
#undef PG8_WAIT_L
#undef PG8_BAR
#undef PG8_SCHED
}
}
namespace pg8 {
typedef unsigned u32x2 __attribute__((ext_vector_type(2)));
__device__ __forceinline__ float gelu_tanh(float x) {
    const float e = __builtin_amdgcn_exp2f(x * (-2.302208198f - 0.1029432397f * x * x));
    return x * __builtin_amdgcn_rcpf(1.0f + e);
}
__device__ __forceinline__ float silu_f(float x) { return x * __builtin_amdgcn_rcpf(1.0f + __builtin_amdgcn_exp2f(-1.4426950409f * x)); }

struct EpiRetProj {
    static constexpr bool PERM = false, AFTER_DRAIN = false;
    bf16_t *Q, *K, *V, *G; const float *cosT, *sinT;
    __device__ __forceinline__ void operator()(const f32x4 (&acc)[2][2][4][2], const Unit& u, int wr, int wc, int fr, int fq) const {
        const int pn = u.pn;
        if (pn < 8) {
            bf16_t* dst = pn < 4 ? Q : K; const int head = pn & 3; const float sc = pn < 4 ? 1.0f : 0.0625f;
#pragma unroll
            for (int ai = 0; ai < 2; ++ai)
#pragma unroll
                for (int m = 0; m < 4; ++m) {
                    const int row = u.pm * BM + ai * HALF + wr * 64 + m * 16 + fr;
#pragma unroll
                    for (int n = 0; n < 2; ++n) {
                        const int f0 = wc * 32 + n * 16 + fq * 4;
                        const f32x4 c4 = *(const f32x4*)(cosT + (size_t)row * 128 + f0), s4 = *(const f32x4*)(sinT + (size_t)row * 128 + f0);
                        const f32x4 x1 = acc[ai][0][m][n], x2 = acc[ai][1][m][n];
                        const f32x4 o1 = (x1 * c4 - x2 * s4) * sc, o2 = (x1 * s4 + x2 * c4) * sc;
                        u32x2 w1, w2; w1.x = cvt_pk_bf16(o1[0], o1[1]); w1.y = cvt_pk_bf16(o1[2], o1[3]); w2.x = cvt_pk_bf16(o2[0], o2[1]); w2.y = cvt_pk_bf16(o2[2], o2[3]);
                        bf16_t* p = dst + (size_t)row * 1024 + head * 256 + f0;
                        *(u32x2*)p = w1; *(u32x2*)(p + 128) = w2;
                    }
                }
        } else {
            const bool isg = pn >= 16; bf16_t* dst = isg ? G : V; const int colbase = ((pn - 8) & 7) * 256;
#pragma unroll
            for (int ai = 0; ai < 2; ++ai)
#pragma unroll
                for (int m = 0; m < 4; ++m) {
                    const int row = u.pm * BM + ai * HALF + wr * 64 + m * 16 + fr;
#pragma unroll
                    for (int bj = 0; bj < 2; ++bj)
#pragma unroll
                        for (int n = 0; n < 2; ++n) {
                            f32x4 v = acc[ai][bj][m][n];
                            if (isg) { v[0] = silu_f(v[0]); v[1] = silu_f(v[1]); v[2] = silu_f(v[2]); v[3] = silu_f(v[3]); }
                            u32x2 w; w.x = cvt_pk_bf16(v[0], v[1]); w.y = cvt_pk_bf16(v[2], v[3]);
                            *(u32x2*)(dst + (size_t)row * 2048 + colbase + bj * HALF + wc * 32 + n * 16 + fq * 4) = w;
                        }
                }
        }
    }
};
struct EpiResGate {
    static constexpr bool PERM = false, AFTER_DRAIN = false;
    const float* base; float* out; const float* gate; int gstride;
    __device__ __forceinline__ void operator()(const f32x4 (&acc)[2][2][4][2], const Unit& u, int wr, int wc, int fr, int fq) const {
        const int b = (u.pm * BM) >> 13; const float* gp = gate + (size_t)b * gstride;
        const int col0 = u.pn * BM + wc * 32 + 4 * fq;
        f32x4 gv[2][2];
#pragma unroll
        for (int bj = 0; bj < 2; ++bj)
#pragma unroll
            for (int n = 0; n < 2; ++n) gv[bj][n] = *(const f32x4*)(gp + col0 + bj * HALF + n * 16);
#pragma unroll
        for (int ai = 0; ai < 2; ++ai)
#pragma unroll
            for (int m = 0; m < 4; ++m) {
                const size_t off = (size_t)(u.pm * BM + ai * HALF + wr * 64 + m * 16 + fr) * 1024 + col0;
#pragma unroll
                for (int bj = 0; bj < 2; ++bj)
#pragma unroll
                    for (int n = 0; n < 2; ++n) { const f32x4 bs = *(const f32x4*)(base + off + bj * HALF + n * 16); *(f32x4*)(out + off + bj * HALF + n * 16) = bs + gv[bj][n] * acc[ai][bj][m][n]; }
            }
    }
};
struct EpiSguIn {
    static constexpr bool PERM = true, AFTER_DRAIN = false;
    bf16_t* U; bf16_t* Vb; const float* bias; float* stats;
    __device__ __forceinline__ void operator()(const f32x4 (&acc)[2][2][4][2], const Unit& u, int wr, int wc, int fr, int fq) const {
        const bool isv = u.pn >= 12; bf16_t* base = isv ? Vb : U; const int colt = (isv ? u.pn - 12 : u.pn) * BM;
        const int col0 = colt + wc * 32 + 8 * fq, bcol0 = u.pn * BM + wc * 32 + 8 * fq;
        f32x4 bv[2][2];
#pragma unroll
        for (int bj = 0; bj < 2; ++bj)
#pragma unroll
            for (int n = 0; n < 2; ++n) bv[bj][n] = *(const f32x4*)(bias + bcol0 + bj * HALF + 4 * n);
#pragma unroll
        for (int ai = 0; ai < 2; ++ai)
#pragma unroll
            for (int m = 0; m < 4; ++m) {
                const int row = u.pm * BM + ai * HALF + wr * 64 + m * 16 + fr;
                bf16_t* rowp = base + (size_t)row * 3072 + col0;
                float s1 = 0.f, s2 = 0.f;
#pragma unroll
                for (int bj = 0; bj < 2; ++bj) {
                    f32x4 v0 = acc[ai][bj][m][0] + bv[bj][0], v1 = acc[ai][bj][m][1] + bv[bj][1];
#pragma unroll
                    for (int j = 0; j < 4; ++j) { v0[j] = gelu_tanh(v0[j]); v1[j] = gelu_tanh(v1[j]); }
                    u32x4 w; w.x = cvt_pk_bf16(v0[0], v0[1]); w.y = cvt_pk_bf16(v0[2], v0[3]); w.z = cvt_pk_bf16(v1[0], v1[1]); w.w = cvt_pk_bf16(v1[2], v1[3]);
                    *(u32x4*)(rowp + bj * HALF) = w;
                    if (isv) {
#pragma unroll
                        for (int j = 0; j < 4; ++j) { const unsigned ww = j == 0 ? w.x : j == 1 ? w.y : j == 2 ? w.z : w.w;
                            const float a = __uint_as_float(ww << 16), bq = __uint_as_float(ww & 0xffff0000u); s1 += a + bq; s2 += a * a + bq * bq; }
                    }
                }
                if (isv) {
                    s1 += __shfl_xor(s1, 16); s1 += __shfl_xor(s1, 32); s2 += __shfl_xor(s2, 16); s2 += __shfl_xor(s2, 32);
                    if (fq == 0) { float* sp = stats + ((size_t)row * 48 + (u.pn - 12) * 4 + wc) * 2; sp[0] = s1; sp[1] = s2; }
                }
            }
    }
};
}
typedef unsigned u32x4 __attribute__((ext_vector_type(4)));
#define GAS __attribute__((address_space(1)))
#define LAS __attribute__((address_space(3)))
typedef unsigned short bf16;
typedef unsigned v4u __attribute__((ext_vector_type(4)));
typedef float f32x4 __attribute__((ext_vector_type(4)));
typedef short bf16x8 __attribute__((ext_vector_type(8)));
typedef GAS unsigned gu32;
typedef GAS unsigned long long gu64;
#define RLX_AGENT __ATOMIC_RELAXED, __HIP_MEMORY_SCOPE_AGENT
#define LDS_WAIT() asm volatile("s_waitcnt lgkmcnt(0)" ::: "memory")
#define VM_WAIT() asm volatile("s_waitcnt vmcnt(0)" ::: "memory")
__device__ __forceinline__ unsigned long long rt() { return __builtin_amdgcn_s_memrealtime(); }
__device__ __forceinline__ unsigned f2bf(float f) { unsigned u = __builtin_bit_cast(unsigned, f); return (u + 0x7fffu + ((u >> 16) & 1u)) >> 16; }
__device__ __forceinline__ unsigned pk2(float lo, float hi) { return f2bf(lo) | (f2bf(hi) << 16); }

#define XB_TMO      128
#define XB_XCNT(j)  (256  + 64 * (j))
#define XB_XSUB(j)  (1280 + 64 * (j))
#define XB_XGEN(j)  (2304 + 64 * (j))
#define XB_TOP      3328
#define XB_TOPGEN   3392
#define XCD_BAR_WORDS 3456
#define XB_SPIN_CAP (1u << 18)

__device__ __forceinline__ unsigned xb_ld(unsigned* p)              { return __hip_atomic_load(p, __ATOMIC_RELAXED, __HIP_MEMORY_SCOPE_AGENT); }
__device__ __forceinline__ unsigned xb_add(unsigned* p, unsigned v) { return __hip_atomic_fetch_add(p, v, __ATOMIC_RELAXED, __HIP_MEMORY_SCOPE_AGENT); }
__device__ __forceinline__ unsigned xb_xcc_id() { return (unsigned)__builtin_amdgcn_s_getreg((3 << 11) | 20) & 0xFu; }
#define XB_SPIN(cond, bar) do { unsigned _sp = 0; while (cond) { __builtin_amdgcn_s_sleep(1); \
    if ((++_sp & 255u) == 0u) { if (xb_ld(&(bar)[XB_TMO])) break; if (_sp > XB_SPIN_CAP) { atomicAdd(&(bar)[XB_TMO], 1u); break; } } } } while (0)

struct XcdBarrier {
    unsigned* bar; unsigned x;
    volatile LAS unsigned* st;
};

__device__ __forceinline__ XcdBarrier xcd_barrier_post(unsigned* bar, volatile LAS unsigned* st) {
    XcdBarrier b; b.bar = bar; b.x = xb_xcc_id(); b.st = st;
    if (threadIdx.x == 0) (void)xb_add(&bar[XB_XCNT(b.x)], 1u);
    return b;
}
__device__ __forceinline__ void xcd_barrier_complete(unsigned* bar, unsigned x, unsigned& nloc, unsigned& nx) {
    const unsigned G = gridDim.x * gridDim.y * gridDim.z;
    unsigned sum, cnt, mine, sp = 0u;
    for (;;) {
        sum = 0u; cnt = 0u; mine = 0u;
#pragma unroll
        for (unsigned j = 0; j < 16; ++j) { const unsigned c = xb_ld(&bar[XB_XCNT(j)]); sum += c; cnt += (c > 0u) ? 1u : 0u; mine = (j == x) ? c : mine; }
        if (sum == G) break;
        __builtin_amdgcn_s_sleep(1);
        if ((++sp & 255u) == 0u) { if (xb_ld(&bar[XB_TMO])) break; if (sp > XB_SPIN_CAP) { atomicAdd(&bar[XB_TMO], 1u); break; } }
    }
    nloc = mine > 0u ? mine : 1u; nx = cnt > 0u ? cnt : 1u;
}

__device__ __forceinline__ void xcd_barrier(const XcdBarrier& b) {
    asm volatile("s_waitcnt vmcnt(0)" ::: "memory");
    __syncthreads();
    if (threadIdx.x == 0) {
        unsigned* bar = b.bar;
        __builtin_amdgcn_s_waitcnt(0);
        unsigned nloc = b.st[0], nx = b.st[1];
        if (nloc == 0u) { xcd_barrier_complete(bar, b.x, nloc, nx); b.st[0] = nloc; b.st[1] = nx; }
        const unsigned old = xb_add(&bar[XB_XSUB(b.x)], 1u);
        const unsigned gen = old / nloc;
        if (old + 1u == (gen + 1u) * nloc) {
            __builtin_amdgcn_fence(__ATOMIC_RELEASE, "agent");
            asm volatile("s_waitcnt vmcnt(0)" ::: "memory");
            const unsigned og = xb_add(&bar[XB_TOP], 1u);
            const unsigned tg = og / nx;
            if (og + 1u == (tg + 1u) * nx) xb_add(&bar[XB_TOPGEN], 1u);
            else XB_SPIN(xb_ld(&bar[XB_TOPGEN]) == tg, bar);
            __builtin_amdgcn_fence(__ATOMIC_ACQUIRE, "agent");
            xb_add(&bar[XB_XGEN(b.x)], 1u);
            asm volatile("s_waitcnt vmcnt(0)" ::: "memory");
        } else {
            XB_SPIN(xb_ld(&bar[XB_XGEN(b.x)]) == gen, bar);
            __builtin_amdgcn_fence(__ATOMIC_ACQUIRE, "agent");
            asm volatile("s_waitcnt vmcnt(0)" ::: "memory");
        }
    }
    __syncthreads();
}
__device__ __forceinline__ float wave_sum(float v) {
#pragma unroll
    for (int o = 1; o < 64; o <<= 1) v += __shfl_xor(v, o);
    return v;
}
__device__ __forceinline__ void p0_transpose_item(const float* W, int K, int N, bf16* WT, int row_off, LAS float* scr, int item, int lane) {
    const int nblk = N / 32, kb = item / nblk, nb = item % nblk, k0 = 64 * kb, n0 = 32 * nb;
#pragma unroll 8
    for (int i = 0; i < 32; ++i) { const int kk = 2 * i + (lane >> 5); scr[kk * 33 + (lane & 31)] = W[(size_t)(k0 + kk) * N + n0 + (lane & 31)]; }
    LDS_WAIT(); asm volatile("" ::: "memory");
    const int c = lane & 7;
#pragma unroll
    for (int j = 0; j < 4; ++j) { const int n = (lane >> 3) + 8 * j; const LAS float* s = scr + (8 * c) * 33 + n;
        v4u o; o.x = pk2(s[0 * 33], s[1 * 33]); o.y = pk2(s[2 * 33], s[3 * 33]); o.z = pk2(s[4 * 33], s[5 * 33]); o.w = pk2(s[6 * 33], s[7 * 33]);
        *(GAS v4u*)(WT + (size_t)(row_off + n0 + n) * K + k0 + 8 * c) = o; }
    LDS_WAIT(); asm volatile("" ::: "memory");
}
#define DI __device__ __forceinline__
constexpr int NWAVES = 8;
constexpr int TT = 16384, DM = 1024, SEQ = 8192;
constexpr size_t MiB = 1u << 20;
constexpr size_t WS_CTL = 0, CTL_ZERO_BYTES = 32768, WS_MOD = 512 * 1024;
constexpr size_t WS_COS = 2 * MiB, WS_SIN = 10 * MiB;
constexpr size_t WS_WRI = 18 * MiB, WS_WRO = 30 * MiB, WS_WSI = 34 * MiB, WS_WSO = 46 * MiB, WS_WQ = 52 * MiB, WS_KEYS = 60 * MiB;
constexpr size_t WS_ISU = 61 * MiB, WS_ISV = 61 * MiB + 256 * 1024;
constexpr size_t WS_STATS = 62 * MiB, WS_IDX = 68 * MiB, WS_GATE = 76 * MiB, WS_H = 84 * MiB, WS_PU = 116 * MiB, WS_PV = 180 * MiB;
constexpr size_t WS_R = 244 * MiB;
constexpr size_t WS_Q = WS_R, WS_K = WS_R + 32 * MiB, WS_V = WS_R + 64 * MiB, WS_G = WS_R + 128 * MiB, WS_CROSS = WS_R + 192 * MiB;
constexpr size_t WS_QP = WS_R, WS_SC = WS_R + 64 * MiB;
constexpr size_t WS_U = WS_R, WS_VB = WS_R + 96 * MiB;
constexpr size_t WS_END = 500 * MiB;
constexpr int CW_TMO = 0, CW_BAR = 4096;
constexpr int RING_OFF = 0, RING_BYTES = 131072, LDS_BYTES = 163840, LDSCTL_OFF = LDS_BYTES - 1024, MISC_OFF = LDSCTL_OFF + 320;
constexpr int PTR_OFF = LDSCTL_OFF + 512;
constexpr float EPS = 1e-6f;
typedef float f32x2_t __attribute__((ext_vector_type(2)));

DI float bf2f(bf16 h) { return __uint_as_float((unsigned)h << 16); }
DI float bflo(unsigned w) { return __uint_as_float(w << 16); }
DI float bfhi(unsigned w) { return __uint_as_float(w & 0xffff0000u); }
DI float wave_max(float v) {
#pragma unroll
    for (int o = 1; o < 64; o <<= 1) v = fmaxf(v, __shfl_xor(v, o));
    return v;
}
DI float gelu_t(float x) { return pg8::gelu_tanh(x); }

struct Ctx {
    LAS unsigned char* lds; int tid, lane, wave, vcu, G;
    unsigned char* ws;
};

DI const void* ldp(const Ctx& C, int i) {
    const unsigned long long v = ((const LAS unsigned long long*)(C.lds + PTR_OFF))[i];
    const unsigned lo = __builtin_amdgcn_readfirstlane((unsigned)v), hi = __builtin_amdgcn_readfirstlane((unsigned)(v >> 32));
    return (const void*)(((unsigned long long)hi << 32) | lo);
}
DI void cvt_rows_fp8(const float* src, unsigned char* dst, float* inv_scale, int nrows, int gw, int NGW, int lane) {
    for (int r = gw; r < nrows; r += NGW) {
        const f32x4* s = (const f32x4*)(src + (size_t)r * 1024) + lane * 4;
        f32x4 v[4]; float am = 0.f;
#pragma unroll
        for (int q = 0; q < 4; ++q) { v[q] = s[q]; am = fmaxf(am, fmaxf(fmaxf(fabsf(v[q][0]), fabsf(v[q][1])), fmaxf(fabsf(v[q][2]), fabsf(v[q][3])))); }
        am = wave_max(am);
        const int e = (int)((__float_as_uint(am) >> 23) & 0xffu) - 127;
        const bool ok = am > 1e-30f;
        const float sc = ok ? __uint_as_float((unsigned)(127 + 7 - e) << 23) : 1.0f, isc = ok ? __uint_as_float((unsigned)(127 - 7 + e) << 23) : 1.0f;
        u32x4 o;
#pragma unroll
        for (int q = 0; q < 4; ++q) { int wd = __builtin_amdgcn_cvt_pk_fp8_f32(v[q][0] * sc, v[q][1] * sc, 0, false); wd = __builtin_amdgcn_cvt_pk_fp8_f32(v[q][2] * sc, v[q][3] * sc, wd, true); o[q] = (unsigned)wd; }
        *(u32x4*)(dst + (size_t)r * 1024 + lane * 16) = o;
        if (lane == 0) inv_scale[r] = isc;
    }
}
DI void cvt_rows_i8(const float* src, unsigned char* dst, float* inv_scale, int nrows, int gw, int NGW, int lane) {
    for (int r = gw; r < nrows; r += NGW) {
        const f32x4* s = (const f32x4*)(src + (size_t)r * 1024) + lane * 4;
        f32x4 v[4]; float am = 0.f;
#pragma unroll
        for (int q = 0; q < 4; ++q) { v[q] = s[q]; am = fmaxf(am, fmaxf(fmaxf(fabsf(v[q][0]), fabsf(v[q][1])), fmaxf(fabsf(v[q][2]), fabsf(v[q][3])))); }
        am = wave_max(am);
        const int e = (int)((__float_as_uint(am) >> 23) & 0xffu) - 127;
        const bool ok = am > 1e-30f;
        const float sc = ok ? __uint_as_float((unsigned)(127 + 6 - e) << 23) : 1.0f, isc = ok ? __uint_as_float((unsigned)(127 - 6 + e) << 23) : 1.0f;
        u32x4 o;
#pragma unroll
        for (int q = 0; q < 4; ++q) { unsigned wd = 0u;
#pragma unroll
            for (int j = 0; j < 4; ++j) { int qi = (int)rintf(v[q][j] * sc); qi = qi > 127 ? 127 : (qi < -127 ? -127 : qi); wd |= ((unsigned)qi & 0xffu) << (8 * j); }
            o[q] = wd; }
        *(u32x4*)(dst + (size_t)r * 1024 + lane * 16) = o;
        if (lane == 0) inv_scale[r] = isc;
    }
}
DI void cvt_stream(const float* src, bf16* dst, size_t n4, size_t gtid, size_t gthreads) {
    const f32x4* s = (const f32x4*)src; uint2* d = (uint2*)dst;
    for (size_t i = gtid; i < n4; i += gthreads) { const f32x4 v = s[i]; uint2 o; o.x = pk2(v.x, v.y); o.y = pk2(v.z, v.w); d[i] = o; }
}
struct P0In { const float *c, *ada_w, *ada_b, *ret_w_in, *ret_w_out, *sgu_w_in, *sgu_w_out, *wq, *keys, *pu, *pv; const int* pos; };
DI void p0_prologue(const Ctx& C, const P0In& I) {
    LAS float* scr = (LAS float*)(C.lds + RING_OFF + C.wave * 16384);
    const int gw = C.vcu * NWAVES + C.wave, NGW = C.G * NWAVES;
    bf16* wri = (bf16*)(C.ws + WS_WRI); bf16* wro = (bf16*)(C.ws + WS_WRO);
    constexpr int I_RI = 16 * 192, I_RO = 32 * 32;
    constexpr int NITEMS = I_RI + I_RO;
    for (int it = gw; it < NITEMS; it += NGW) {
        int r = it;
        if (r < I_RI) { p0_transpose_item(I.ret_w_in, 1024, 6144, wri, 0, scr, r, C.lane); continue; } r -= I_RI;
        p0_transpose_item(I.ret_w_out, 2048, 1024, wro, 0, scr, r, C.lane);
    }
    const size_t gtid = (size_t)C.vcu * 512 + C.tid, gth = (size_t)C.G * 512;
    cvt_stream(I.keys, (bf16*)(C.ws + WS_KEYS), (size_t)2 * 8 * 2 * 128 * 128 / 4, gtid, gth);
    float* mod = (float*)(C.ws + WS_MOD);
    __syncthreads();
    for (int it = C.vcu; it < 2 * 96; it += C.G) {
        const int l = it / 96, cb = it % 96, kp = C.wave, n = cb * 64 + C.lane;
        const float* W = I.ada_w + (size_t)l * 1024 * 6144 + n;
        float a0 = 0.f, a1 = 0.f;
#pragma unroll 8
        for (int k = kp * 128; k < kp * 128 + 128; ++k) {
            const float w = W[(size_t)k * 6144]; const float c0 = I.c[k], c1 = I.c[1024 + k];
            a0 += pg8::silu_f(c0) * w; a1 += pg8::silu_f(c1) * w;
        }
        LAS float* red = (LAS float*)(C.lds + RING_OFF);
        red[(kp * 2 + 0) * 64 + C.lane] = a0; red[(kp * 2 + 1) * 64 + C.lane] = a1;
        __syncthreads();
        if (C.wave < 2) { float s = I.ada_b[l * 6144 + n];
#pragma unroll
            for (int q = 0; q < 8; ++q) s += red[(q * 2 + C.wave) * 64 + C.lane];
            mod[(size_t)(l * 2 + C.wave) * 6144 + n] = s; }
        __syncthreads();
    }
    float* cosT = (float*)(C.ws + WS_COS); float* sinT = (float*)(C.ws + WS_SIN);
    for (int it = gw; it < TT / 2; it += NGW) {
        const int row = 2 * it + (C.lane >> 5), f0 = (C.lane & 31) * 4; const float p = (float)I.pos[row];
        f32x4 cv, sv;
#pragma unroll
        for (int j = 0; j < 4; ++j) { const int f = f0 + j; double w = 1.0, bs = 0.93057204092969898;
#pragma unroll
            for (int bit = 0; bit < 7; ++bit) { if ((f >> bit) & 1) w *= bs; bs *= bs; }
            const float ang = p * (float)w; const double r = (double)ang * 0.15915494309189535; const float fr = (float)(r - floor(r)); cv[j] = __builtin_amdgcn_cosf(fr); sv[j] = __builtin_amdgcn_sinf(fr); }
        *(f32x4*)(cosT + (size_t)row * 128 + f0) = cv; *(f32x4*)(sinT + (size_t)row * 128 + f0) = sv;
    }
}
DI void side_work(const Ctx& C, const P0In& I, int nskip) {
    LAS float* scr = (LAS float*)(C.lds + RING_OFF + C.wave * 16384);
    const int gw = (C.vcu - nskip) * NWAVES + C.wave, NGW = (C.G - nskip) * NWAVES;
    bf16* wsi = (bf16*)(C.ws + WS_WSI); bf16* wso = (bf16*)(C.ws + WS_WSO); bf16* wq = (bf16*)(C.ws + WS_WQ);
    constexpr int I_SI = 16 * 192, I_SO = 48 * 32, I_Q = 16 * 64;
    constexpr int NITEMS = I_SI + I_SO + 2 * I_Q;
    for (int it = gw; it < NITEMS; it += NGW) {
        int r = it;
        if (r < I_SI) { p0_transpose_item(I.sgu_w_in, 1024, 6144, wsi, 0, scr, r, C.lane); continue; } r -= I_SI;
        if (r < I_SO) { p0_transpose_item(I.sgu_w_out, 3072, 1024, wso, 0, scr, r, C.lane); continue; } r -= I_SO;
        if (r < I_Q) { p0_transpose_item(I.wq, 1024, 2048, wq, 0, scr, r, C.lane); continue; } r -= I_Q;
        p0_transpose_item(I.wq + (size_t)1024 * 2048, 1024, 2048, wq + (size_t)2048 * 1024, 0, scr, r, C.lane);
    }
    cvt_rows_i8(I.pu, (unsigned char*)(C.ws + WS_PU), (float*)(C.ws + WS_ISU), 2 * 16384, gw, NGW, C.lane);
    cvt_rows_fp8(I.pv, (unsigned char*)(C.ws + WS_PV), (float*)(C.ws + WS_ISV), 2 * 16384, gw, NGW, C.lane);
}
DI void rms_mod_row(const float* xrow, const float* gain, const float* shift, const float* scale, bf16* orow, int lane) {
    const f32x4* xr = (const f32x4*)xrow + lane; f32x4 v[4]; float s = 0.f;
#pragma unroll
    for (int j = 0; j < 4; ++j) { v[j] = xr[64 * j]; s += (v[j].x * v[j].x + v[j].y * v[j].y) + (v[j].z * v[j].z + v[j].w * v[j].w); }
    const float rstd = 1.0f / sqrtf(wave_sum(s) * (1.0f / 1024.0f) + EPS);
    uint2* o8 = (uint2*)orow + lane;
#pragma unroll
    for (int j = 0; j < 4; ++j) { const f32x4 g = ((const f32x4*)gain)[lane + 64 * j], sh = ((const f32x4*)shift)[lane + 64 * j], sc = ((const f32x4*)scale)[lane + 64 * j];
        const f32x4 y = v[j] * rstd * g * (sc + 1.0f) + sh; uint2 o; o.x = pk2(y.x, y.y); o.y = pk2(y.z, y.w); o8[64 * j] = o; }
}
DI void rms_mod_phase(const Ctx& C, const float* x, const float* gain, const float* mod_l, int sh_off, int sc_off, bf16* H) {
    const int gw = C.vcu * NWAVES + C.wave, NGW = C.G * NWAVES;
    for (int m = gw; m < TT; m += NGW) { const float* ml = mod_l + (size_t)(m >> 13) * 6144; rms_mod_row(x + (size_t)m * DM, gain, ml + sh_off, ml + sc_off, H + (size_t)m * DM, C.lane); }
}

DI void scan_naive(const Ctx& C, const bf16* Q, const bf16* K, const bf16* V, bf16* CROSS) {
    LAS float* Sst = (LAS float*)(C.lds);
    LAS unsigned* Qs = (LAS unsigned*)(C.lds + 16384);
    LAS bf16* Ks = (LAS bf16*)(C.lds + 16384 + 32768);
    LAS float* Vs = (LAS float*)(C.lds + 16384 + 65536);
    const int tid = C.tid;
    for (int item = C.vcu; item < 256; item += C.G) {
        const int b = item >> 7, h = (item >> 5) & 3, es = item & 31;
        const float lg2 = log2f(1.0f - exp2f(-5.0f - (float)h)); const float gc = exp2f(lg2 * 64.0f);
        for (int i = tid; i < 4096; i += 512) Sst[i] = 0.f;
        __syncthreads();
        for (int n = 0; n < 128; ++n) {
            const size_t tok0 = (size_t)b * SEQ + (size_t)n * 64;
            for (int ch = tid; ch < 2048; ch += 512) { const int r = ch >> 5, c = ch & 31;
                const u32x4 q = *(const u32x4*)(Q + (tok0 + r) * 1024 + h * 256 + c * 8); *(LAS u32x4*)(Qs + r * 128 + c * 4) = q;
                const u32x4 k = *(const u32x4*)(K + (tok0 + r) * 1024 + h * 256 + c * 8); *(LAS u32x4*)((LAS unsigned*)Ks + r * 128 + c * 4) = k; }
            for (int o = tid; o < 1024; o += 512) { const int j = o >> 4, e = o & 15; Vs[o] = bf2f(V[(tok0 + j) * 2048 + h * 512 + es * 16 + e]) * exp2f(lg2 * (float)(63 - j)); }
            __syncthreads();
#pragma unroll
            for (int oo = 0; oo < 2; ++oo) { const int o = tid + oo * 512, i = o >> 4, e = o & 15; float acc = 0.f;
#pragma unroll 8
                for (int d2 = 0; d2 < 128; ++d2) { const unsigned q2 = Qs[i * 128 + d2]; acc += bflo(q2) * Sst[(2 * d2) * 16 + e] + bfhi(q2) * Sst[(2 * d2 + 1) * 16 + e]; }
                CROSS[(tok0 + i) * 2048 + h * 512 + es * 16 + e] = (bf16)f2bf(acc * exp2f(lg2 * (float)(i + 1))); }
            __syncthreads();
            { const int e = tid & 15, dg = tid >> 4; float a[8];
#pragma unroll
              for (int r = 0; r < 8; ++r) a[r] = gc * Sst[(dg + 32 * r) * 16 + e];
#pragma unroll 4
              for (int j = 0; j < 64; ++j) { const float vz = Vs[j * 16 + e];
#pragma unroll
                  for (int r = 0; r < 8; ++r) a[r] += bf2f(Ks[j * 256 + dg + 32 * r]) * vz; }
#pragma unroll
              for (int r = 0; r < 8; ++r) Sst[(dg + 32 * r) * 16 + e] = a[r]; }
            __syncthreads();
        }
    }
}
DI void intra_naive(const Ctx& C, const bf16* Q, const bf16* K, const bf16* V, const bf16* CROSS, bf16* G) {
    LAS unsigned* Qs = (LAS unsigned*)(C.lds);
    LAS unsigned* Ks = (LAS unsigned*)(C.lds + 32768);
    LAS float* SC = (LAS float*)(C.lds + 65536);
    LAS float* red = (LAS float*)(C.lds + 65536 + 16384);
    LAS float* rs = red + 512;
    const int tid = C.tid;
    for (int item = C.vcu; item < 1024; item += C.G) {
        const int b = item >> 9, h = (item >> 7) & 3, n = item & 127;
        const float lg2 = log2f(1.0f - exp2f(-5.0f - (float)h));
        const size_t tok0 = (size_t)b * SEQ + (size_t)n * 64;
        for (int ch = tid; ch < 2048; ch += 512) { const int r = ch >> 5, c = ch & 31;
            *(LAS u32x4*)(Qs + r * 128 + c * 4) = *(const u32x4*)(Q + (tok0 + r) * 1024 + h * 256 + c * 8);
            *(LAS u32x4*)(Ks + r * 128 + c * 4) = *(const u32x4*)(K + (tok0 + r) * 1024 + h * 256 + c * 8); }
        __syncthreads();
        { const int i = tid >> 3, jb = (tid & 7) * 8;
#pragma unroll
          for (int jj = 0; jj < 8; ++jj) { const int j = jb + jj; float acc = 0.f;
#pragma unroll 8
              for (int d2 = 0; d2 < 128; ++d2) { const unsigned q2 = Qs[i * 128 + d2], k2 = Ks[j * 128 + d2]; acc += bflo(q2) * bflo(k2) + bfhi(q2) * bfhi(k2); }
              const int dd = i > j ? i - j : j - i; SC[i * 64 + j] = acc * exp2f(lg2 * (float)dd); } }
        __syncthreads();
#pragma unroll 1
        for (int pass = 0; pass < 2; ++pass) { const int e = tid, ib = pass * 32; float y[32];
#pragma unroll
          for (int i = 0; i < 32; ++i) y[i] = 0.f;
          const bf16* vp = V + tok0 * 2048 + h * 512 + e;
#pragma unroll 1
          for (int j4 = 0; j4 < 16; ++j4) {
              const float v0 = bf2f(vp[(size_t)(4 * j4 + 0) * 2048]), v1 = bf2f(vp[(size_t)(4 * j4 + 1) * 2048]), v2 = bf2f(vp[(size_t)(4 * j4 + 2) * 2048]), v3 = bf2f(vp[(size_t)(4 * j4 + 3) * 2048]);
#pragma unroll
              for (int i = 0; i < 32; ++i) { const f32x4 s4 = *(const LAS f32x4*)(SC + (ib + i) * 64 + 4 * j4); y[i] += (s4.x * v0 + s4.y * v1) + (s4.z * v2 + s4.w * v3); }
          }
          const bf16* cp = CROSS + (tok0 + ib) * 2048 + h * 512 + e;
#pragma unroll
          for (int i = 0; i < 32; ++i) { y[i] += bf2f(cp[(size_t)i * 2048]); const float ss = wave_sum(y[i] * y[i]); if (C.lane == 0) red[C.wave * 64 + i] = ss; }
          __syncthreads();
          if (tid < 32) { float s = 0.f;
#pragma unroll
              for (int w = 0; w < 8; ++w) s += red[w * 64 + tid];
              rs[tid] = 1.0f / sqrtf(s * (1.0f / 512.0f) + EPS); }
          __syncthreads();
          bf16* gp = G + (tok0 + ib) * 2048 + h * 512 + e;
#pragma unroll
          for (int i = 0; i < 32; ++i) { const float g = bf2f(gp[(size_t)i * 2048]); gp[(size_t)i * 2048] = (bf16)f2bf(y[i] * rs[i] * g); }
          __syncthreads();
        }
        __syncthreads();
    }
}
DI void peer_scores(const Ctx& C, const bf16* QP, const bf16* KEYS  , float* SCO) {
    const int gw = C.vcu * NWAVES + C.wave, NGW = C.G * NWAVES; const int fr = C.lane & 15, fq = C.lane >> 4;
    for (int it = gw; it < 1024 * 8; it += NGW) {
        const int tt = it >> 3, h = it & 7; const int tok = tt * 16 + fr;
#pragma unroll
        for (int p = 0; p < 2; ++p) {
            bf16x8 qf[4];
#pragma unroll
            for (int ks = 0; ks < 4; ++ks) qf[ks] = *(const bf16x8*)(QP + (size_t)tok * 2048 + h * 256 + p * 128 + ks * 32 + fq * 8);
            const bf16* kb = KEYS + (size_t)(h * 2 + p) * 128 * 128;
#pragma unroll
            for (int kt = 0; kt < 8; ++kt) {
                f32x4 acc = {0.f, 0.f, 0.f, 0.f};
#pragma unroll
                for (int ks = 0; ks < 4; ++ks) { const bf16x8 kf = *(const bf16x8*)(kb + (size_t)(kt * 16 + fr) * 128 + ks * 32 + fq * 8);
                    acc = __builtin_amdgcn_mfma_f32_16x16x32_bf16(kf, qf[ks], acc, 0, 0, 0); }
                *(f32x4*)(SCO + ((size_t)tok * 8 + h) * 256 + p * 128 + kt * 16 + fq * 4) = acc;
            }
        }
    }
}
template <bool HALVES> DI void select16(const float (&v)[4], int lane, bool (&sel)[4], int (&pos)[4]) {
    float mx = fmaxf(fmaxf(v[0], v[1]), fmaxf(v[2], v[3])), mn = fminf(fminf(v[0], v[1]), fminf(v[2], v[3]));
#pragma unroll
    for (int o = 1; o < (HALVES ? 32 : 64); o <<= 1) { mx = fmaxf(mx, __shfl_xor(mx, o)); mn = fminf(mn, __shfl_xor(mn, o)); }
    const bool up = HALVES && lane >= 32;
    float lo = mn, hi = mx, thr = mn; bool done = false;
    for (int iter = 0; iter < 48; ++iter) {
        const float mid = done ? thr : 0.5f * (lo + hi);
        int cnt = 0;
#pragma unroll
        for (int c = 0; c < 4; ++c) { const unsigned long long m = __ballot(v[c] >= mid);
            cnt += HALVES ? (up ? __popc((unsigned)(m >> 32)) : __popc((unsigned)m)) : __popcll(m); }
        if (!done) { if (cnt == 16) { thr = mid; done = true; } else if (cnt > 16) { lo = mid; thr = mid; } else hi = mid; }
        if (__all(done)) break;
    }
    int base = 0;
#pragma unroll
    for (int c = 0; c < 4; ++c) { sel[c] = v[c] >= thr; const unsigned long long m = __ballot(sel[c]);
        const unsigned long long gm = HALVES ? (up ? (m >> 32) : (m & 0xffffffffull)) : m; const int ll = HALVES ? (lane & 31) : lane;
        pos[c] = base + __popcll(gm & ((1ull << ll) - 1ull)); base += __popcll(gm); sel[c] = sel[c] && pos[c] < 16; }
}
DI void peer_topk(const Ctx& C, const float* SCO, int* IDX, float* GATE) {
    LAS float* sv = (LAS float*)(C.lds + C.wave * 512);
    LAS int* si = (LAS int*)(C.lds + C.wave * 512 + 128);
    LAS float* fv = (LAS float*)(C.lds + C.wave * 512 + 256);
    LAS int* fi = (LAS int*)(C.lds + C.wave * 512 + 320);
    const int gw = C.vcu * NWAVES + C.wave, NGW = C.G * NWAVES, lane = C.lane;
    for (int it = gw; it < TT * 8; it += NGW) {
        const f32x4 s4 = *(const f32x4*)(SCO + (size_t)it * 256 + lane * 4);
        float v[4] = {s4.x, s4.y, s4.z, s4.w}; bool sel[4]; int pos[4];
        select16<true>(v, lane, sel, pos);
        const int p = lane >> 5;
#pragma unroll
        for (int c = 0; c < 4; ++c) if (sel[c]) { sv[p * 16 + pos[c]] = v[c]; si[p * 16 + pos[c]] = (lane & 31) * 4 + c; }
        LDS_WAIT();
        const int a = lane >> 2, bq = (lane & 3) * 4; const float va = sv[a]; const int ia = si[a];
        float w[4]; int wi[4];
#pragma unroll
        for (int c = 0; c < 4; ++c) { w[c] = va + sv[16 + bq + c]; wi[c] = ia * 128 + si[16 + bq + c]; }
        select16<false>(w, lane, sel, pos);
#pragma unroll
        for (int c = 0; c < 4; ++c) if (sel[c]) { fv[pos[c]] = w[c]; fi[pos[c]] = wi[c]; }
        LDS_WAIT();
        const float x = fv[lane & 15]; const int xi = fi[lane & 15];
        float m = x;
#pragma unroll
        for (int o = 1; o < 16; o <<= 1) m = fmaxf(m, __shfl_xor(m, o));
        const float e = __expf(x - m); float s = e;
#pragma unroll
        for (int o = 1; o < 16; o <<= 1) s += __shfl_xor(s, o);
        if (lane < 16) { IDX[(size_t)it * 16 + lane] = xi; GATE[(size_t)it * 16 + lane] = e / s; }
        LDS_WAIT();
    }
}
template <bool FINAL> DI void peer_gather(const Ctx& C, const bf16* H, const int* IDX, const float* GATE, const bf16* PU, const bf16* PV, float* X, const float* g2  ,
                                          const float* ngain, const float* nmod  , bf16* Hn) {
    const int gw = C.vcu * NWAVES + C.wave, NGW = C.G * NWAVES, lane = C.lane;
    for (int t = gw; t < TT; t += NGW) {
        float hv[16];
        { const u32x4 a = *(const u32x4*)(H + (size_t)t * 1024 + lane * 8), bq = *(const u32x4*)(H + (size_t)t * 1024 + 512 + lane * 8);
          hv[0] = bflo(a.x); hv[1] = bfhi(a.x); hv[2] = bflo(a.y); hv[3] = bfhi(a.y); hv[4] = bflo(a.z); hv[5] = bfhi(a.z); hv[6] = bflo(a.w); hv[7] = bfhi(a.w);
          hv[8] = bflo(bq.x); hv[9] = bfhi(bq.x); hv[10] = bflo(bq.y); hv[11] = bfhi(bq.y); hv[12] = bflo(bq.z); hv[13] = bfhi(bq.z); hv[14] = bflo(bq.w); hv[15] = bfhi(bq.w); }
        const int i0 = IDX[(size_t)t * 128 + lane], i1 = IDX[(size_t)t * 128 + 64 + lane];
        const float g0 = GATE[(size_t)t * 128 + lane], g1 = GATE[(size_t)t * 128 + 64 + lane];
        float a0 = 0.f, a1 = 0.f;
        for (int k = 0; k < 128; k += 4) {
            float dsum[4];
#pragma unroll
            for (int kk = 0; kk < 4; ++kk) { const int kq = k + kk; const int e = kq < 64 ? __builtin_amdgcn_readlane(i0, kq) : __builtin_amdgcn_readlane(i1, kq - 64);
                const bf16* ur = PU + (size_t)e * 1024; const u32x4 a = *(const u32x4*)(ur + lane * 8), bq = *(const u32x4*)(ur + 512 + lane * 8);
                float d = bflo(a.x) * hv[0] + bfhi(a.x) * hv[1]; d += bflo(a.y) * hv[2] + bfhi(a.y) * hv[3]; d += bflo(a.z) * hv[4] + bfhi(a.z) * hv[5]; d += bflo(a.w) * hv[6] + bfhi(a.w) * hv[7];
                d += bflo(bq.x) * hv[8] + bfhi(bq.x) * hv[9]; d += bflo(bq.y) * hv[10] + bfhi(bq.y) * hv[11]; d += bflo(bq.z) * hv[12] + bfhi(bq.z) * hv[13]; d += bflo(bq.w) * hv[14] + bfhi(bq.w) * hv[15];
                dsum[kk] = d; }
#pragma unroll
            for (int kk = 0; kk < 4; ++kk) { const int kq = k + kk; const float d = gelu_t(wave_sum(dsum[kk]));
                if (kq < 64) { if (lane == kq) a0 = d * g0; } else { if (lane == kq - 64) a1 = d * g1; } }
        }
        float o[16];
#pragma unroll
        for (int j = 0; j < 16; ++j) o[j] = 0.f;
        for (int k = 0; k < 128; k += 4) {
#pragma unroll
            for (int kk = 0; kk < 4; ++kk) { const int kq = k + kk; const int e = kq < 64 ? __builtin_amdgcn_readlane(i0, kq) : __builtin_amdgcn_readlane(i1, kq - 64);
                const float ak = __int_as_float(kq < 64 ? __builtin_amdgcn_readlane(__float_as_int(a0), kq) : __builtin_amdgcn_readlane(__float_as_int(a1), kq - 64));
                const bf16* vr = PV + (size_t)e * 1024; const u32x4 a = *(const u32x4*)(vr + lane * 8), bq = *(const u32x4*)(vr + 512 + lane * 8);
                o[0] += ak * bflo(a.x); o[1] += ak * bfhi(a.x); o[2] += ak * bflo(a.y); o[3] += ak * bfhi(a.y); o[4] += ak * bflo(a.z); o[5] += ak * bfhi(a.z); o[6] += ak * bflo(a.w); o[7] += ak * bfhi(a.w);
                o[8] += ak * bflo(bq.x); o[9] += ak * bfhi(bq.x); o[10] += ak * bflo(bq.y); o[11] += ak * bfhi(bq.y); o[12] += ak * bflo(bq.z); o[13] += ak * bfhi(bq.z); o[14] += ak * bflo(bq.w); o[15] += ak * bfhi(bq.w); }
        }
#ifdef DBG_ZERO_PEER
#pragma unroll
        for (int j = 0; j < 16; ++j) o[j] = 0.f;
#endif
        const int b = t >> 13; const float* gp = g2 + (size_t)b * 6144; float* xr = X + (size_t)t * 1024;
        float xn[16]; float ss = 0.f;
#pragma unroll
        for (int q = 0; q < 4; ++q) { const int col = (q >> 1) * 512 + lane * 8 + (q & 1) * 4; const f32x4 xv = *(const f32x4*)(xr + col), gv = *(const f32x4*)(gp + col);
#pragma unroll
            for (int j = 0; j < 4; ++j) { const float y = xv[j] + gv[j] * o[q * 4 + j]; xn[q * 4 + j] = y; ss += y * y; } }
        const float rstd = 1.0f / sqrtf(wave_sum(ss) * (1.0f / 1024.0f) + EPS);
        if (FINAL) {
#pragma unroll
            for (int q = 0; q < 4; ++q) { const int col = (q >> 1) * 512 + lane * 8 + (q & 1) * 4; const f32x4 gn = *(const f32x4*)(ngain + col); f32x4 y;
#pragma unroll
                for (int j = 0; j < 4; ++j) y[j] = xn[q * 4 + j] * rstd * gn[j];
                *(f32x4*)(xr + col) = y; }
        } else {
            const float* nm = nmod + (size_t)b * 6144;
#pragma unroll
            for (int q = 0; q < 4; ++q) { const int col = (q >> 1) * 512 + lane * 8 + (q & 1) * 4; const f32x4 gn = *(const f32x4*)(ngain + col), sh = *(const f32x4*)(nm + col), sc = *(const f32x4*)(nm + 1024 + col); f32x4 xo; float y[4];
#pragma unroll
                for (int j = 0; j < 4; ++j) { xo[j] = xn[q * 4 + j]; y[j] = xn[q * 4 + j] * rstd * gn[j] * (1.0f + sc[j]) + sh[j]; }
                *(f32x4*)(xr + col) = xo; uint2 w; w.x = pk2(y[0], y[1]); w.y = pk2(y[2], y[3]); *(uint2*)(Hn + (size_t)t * 1024 + col) = w; }
        }
    }
}
DI void sgu_gate_naive(const Ctx& C, bf16* U, const bf16* VB, const float* stats, const float* w_s, const float* b_s, const float* ln_g, const float* ln_b) {
    LAS float* Wm = (LAS float*)(C.lds);
    LAS float* mu = (LAS float*)(C.lds + 65536);
    LAS float* rsd = mu + 128;
    const int tid = C.tid;
    for (int item = C.vcu; item < 1024; item += C.G) {
        const int n = item >> 3, g = item & 7; const size_t row0 = (size_t)n * 128;
        for (int i = tid; i < 16384; i += 512) { const int r = i >> 7, c = i & 127; const float w = w_s[(size_t)g * 16384 + i]; Wm[i] = (r < 64 && c >= 64) ? 0.f : w; }
        if (tid < 128) { const float* sp = stats + (row0 + tid) * 96; float s1 = 0.f, s2 = 0.f;
            for (int q = 0; q < 48; ++q) { s1 += sp[2 * q]; s2 += sp[2 * q + 1]; }
            const float m = s1 * (1.0f / 3072.0f); const float var = s2 * (1.0f / 3072.0f) - m * m; mu[tid] = m; rsd[tid] = 1.0f / sqrtf(fmaxf(var, 0.f) + EPS); }
        __syncthreads();
        if (tid < 384) {
            const int col = g * 384 + tid; const float lg = ln_g[col], lb = ln_b[col];
#pragma unroll
            for (int pass = 0; pass < 2; ++pass) {
                float acc[64];
#pragma unroll
                for (int i = 0; i < 64; ++i) acc[i] = 0.f;
                const int jmax = pass == 0 ? 64 : 128;
                for (int j = 0; j < jmax; ++j) { const float v = bf2f(VB[(row0 + j) * 3072 + col]); const float vl = (v - mu[j]) * rsd[j] * lg + lb;
#pragma unroll
                    for (int i = 0; i < 64; ++i) acc[i] += Wm[(pass * 64 + i) * 128 + j] * vl; }
#pragma unroll
                for (int i = 0; i < 64; ++i) { const int r = pass * 64 + i; const float s = acc[i] + b_s[g * 128 + r]; bf16* up = U + (row0 + r) * 3072 + col; *up = (bf16)f2bf(bf2f(*up) * s); }
            }
        }
        __syncthreads();
    }
}
typedef short v4i16_t __attribute__((ext_vector_type(4)));
typedef unsigned u32x2_t __attribute__((ext_vector_type(2)));
typedef __bf16 bf16x2_t __attribute__((ext_vector_type(2)));
DI unsigned cvtpk(float lo, float hi) { f32x2_t v = {lo, hi}; bf16x2_t b = __builtin_convertvector(v, bf16x2_t); return __builtin_bit_cast(unsigned, b); }
DI v4i16_t trr(const LAS unsigned char* p) { return __builtin_amdgcn_ds_read_tr16_b64_v4i16((LAS v4i16_t*)p); }
DI bf16x8 cat8(v4i16_t a, v4i16_t b) { return __builtin_shufflevector(a, b, 0, 1, 2, 3, 4, 5, 6, 7); }
DI bf16x8 pack2(const f32x4& a, const f32x4& b) { u32x4 p; p.x = cvtpk(a[0], a[1]); p.y = cvtpk(a[2], a[3]); p.z = cvtpk(b[0], b[1]); p.w = cvtpk(b[2], b[3]); return __builtin_bit_cast(bf16x8, p); }
DI u32x4 scale8(u32x4 v, float s) { u32x4 o; o.x = cvtpk(bflo(v.x) * s, bfhi(v.x) * s); o.y = cvtpk(bflo(v.y) * s, bfhi(v.y) * s); o.z = cvtpk(bflo(v.z) * s, bfhi(v.z) * s); o.w = cvtpk(bflo(v.w) * s, bfhi(v.w) * s); return o; }
constexpr int SCAN_ESL = 32, SCAN_NCW = SCAN_ESL / 16, SCAN_NSL = 512 / SCAN_ESL, SCAN_NIT = 8 * SCAN_NSL;
#define SCAN_BAR() do { asm volatile("s_waitcnt lgkmcnt(0)" ::: "memory"); __builtin_amdgcn_s_barrier(); asm volatile("" ::: "memory"); } while (0)
template <int MODE = 0> DI void scan_mfma(const Ctx& C, const bf16* Q, const bf16* K, const bf16* V, bf16* CROSS) {
    constexpr int QPI = 544, KPI = 544, VPI = SCAN_ESL * 2 + 32, VCH = SCAN_ESL / 8  , NVC = 64 * VCH;
    constexpr int OQ = 0, OK_ = 64 * QPI, OV = OK_ + 64 * KPI, BUFB = OV + 64 * VPI;
    constexpr int NST = (NWAVES - 1 - SCAN_NCW) * 64;
    const int w = C.wave;
    for (int item = C.vcu; item < SCAN_NIT; item += C.G) {
        const int b = item / (4 * SCAN_NSL), h = (item / SCAN_NSL) & 3, es = item % SCAN_NSL;
        const float lg2 = log2f(1.0f - exp2f(-5.0f - (float)h)); const float gc = exp2f(lg2 * 64.0f);
        const size_t tokb = (size_t)b * SEQ;
        if (w >= SCAN_NCW) {
            int tl_ = C.tid; asm volatile("" : "+v"(tl_));
            const int st = (w == NWAVES - 1) ? (tl_ & 63) : tl_ - SCAN_NCW * 64;
            if (w == NWAVES - 1) {
                unsigned dmy = 0u;
#define SCAN_PF1(ptr) asm volatile("global_load_dword %0, %1, off" : "+v"(dmy) : "v"(ptr) : "memory")
#define SCAN_PF(n) do { const size_t t0_ = tokb + (size_t)(n) * 64; \
                _Pragma("unroll") for (int u = 0; u < 4; ++u) { const int ln = st + 64 * u, r = ln >> 2, q = ln & 3; SCAN_PF1(Q + (t0_ + r) * 1024 + h * 256 + q * 64); SCAN_PF1(K + (t0_ + r) * 1024 + h * 256 + q * 64); } \
                SCAN_PF1(V + (t0_ + st) * 2048 + h * 512 + es * SCAN_ESL); } while (0)
                SCAN_PF(2); SCAN_PF(3); SCAN_PF(4);
                SCAN_BAR();
#pragma unroll 1
                for (int n = 0; n < 128; ++n) { if (n + 5 < 128) SCAN_PF(n + 5); SCAN_BAR(); }
                asm volatile("s_waitcnt vmcnt(0)" : "+v"(dmy) :: "memory");
#undef SCAN_PF
#undef SCAN_PF1
            } else {
            u32x4 rq_[7], rk_[7], rv_;
#define SCAN_LD(n) do { const size_t t0_ = tokb + (size_t)(n) * 64; \
            _Pragma("unroll") for (int u = 0; u < 7; ++u) { const int c = st + NST * u; if (c < 2048) { const int r = c >> 5, cc = c & 31; \
                rq_[u] = *(const u32x4*)(Q + (t0_ + r) * 1024 + h * 256 + cc * 8); rk_[u] = *(const u32x4*)(K + (t0_ + r) * 1024 + h * 256 + cc * 8); } } \
            if (st < NVC) { const int r = st / VCH, cc = st % VCH; rv_ = *(const u32x4*)(V + (t0_ + r) * 2048 + h * 512 + es * SCAN_ESL + cc * 8); } } while (0)
#define SCAN_WR(bufo) do { LAS unsigned char* B_ = C.lds + (bufo); \
            _Pragma("unroll") for (int u = 0; u < 7; ++u) { const int c = st + NST * u; if (c < 2048) { const int r = c >> 5, cc = c & 31; \
                *(LAS u32x4*)(B_ + OQ + r * QPI + cc * 16) = rq_[u]; *(LAS u32x4*)(B_ + OK_ + r * KPI + cc * 16) = rk_[u]; } } \
            if (st < NVC) { const int r = st / VCH, cc = st % VCH; *(LAS u32x4*)(B_ + OV + r * VPI + cc * 16) = scale8(rv_, exp2f(lg2 * (float)(63 - r))); } } while (0)
            SCAN_LD(0); SCAN_WR(0); SCAN_LD(1);
            SCAN_BAR();
#pragma unroll 1
            for (int n = 0; n < 128; ++n) { if (MODE != 2 && n + 1 < 128) { SCAN_WR(((n + 1) & 1) * BUFB); if (n + 2 < 128) SCAN_LD(n + 2); } SCAN_BAR(); }
#undef SCAN_LD
#undef SCAN_WR
            }
        } else {
            int tl_ = C.tid; asm volatile("" : "+v"(tl_)); const int lane = tl_ & 63, fr = lane & 15, fq = lane >> 4;
            f32x4 S[16];
#pragma unroll
            for (int t = 0; t < 16; ++t) S[t] = (f32x4){0.f, 0.f, 0.f, 0.f};
            SCAN_BAR();
#define SC_LQ(QF, DB) do { _Pragma("unroll") for (int m = 0; m < 4; ++m) QF[m] = *(const LAS bf16x8*)(Qs + (16 * m + fr) * QPI + (32 * (DB) + 8 * fq) * 2); __builtin_amdgcn_sched_barrier(0); } while (0)
#define SC_MQ(QF, DB) do { const bf16x8 sa0 = pack2(S[2 * (DB)], S[2 * (DB) + 1]); \
            _Pragma("unroll") for (int m = 0; m < 4; ++m) acc[m] = __builtin_amdgcn_mfma_f32_16x16x32_bf16(sa0, QF[m], acc[m], 0, 0, 0); __builtin_amdgcn_sched_barrier(0); } while (0)
#define SC_LK(KF, KS, TQ) do { const LAS unsigned char* kp = Ks + (32 * (KS) + 4 * fq + (fr >> 2)) * KPI + (8 * (fr & 3)) * 2;     \
            _Pragma("unroll") for (int t4 = 0; t4 < 4; ++t4) { const int t = 4 * (TQ) + t4; KF[t4] = cat8(trr(kp + 64 * (t >> 1) + 8 * (t & 1)), trr(kp + 64 * (t >> 1) + 8 * (t & 1) + 16 * KPI)); } __builtin_amdgcn_sched_barrier(0); } while (0)
#define SC_LV(VF, KS) do { const LAS unsigned char* vp = Vs + (32 * (KS) + 4 * fq + (fr >> 2)) * VPI + (16 * w + 4 * (fr & 3)) * 2; VF = cat8(trr(vp), trr(vp + 16 * VPI)); } while (0)
#define SC_MK(KF, VF, TQ) do { _Pragma("unroll") for (int t4 = 0; t4 < 4; ++t4) S[4 * (TQ) + t4] = __builtin_amdgcn_mfma_f32_16x16x32_bf16(KF[t4], VF, S[4 * (TQ) + t4], 0, 0, 0); __builtin_amdgcn_sched_barrier(0); } while (0)
#define SCAN_CHUNK(n_, BO) do { const size_t tok0 = tokb + (size_t)(n_) * 64; LAS unsigned char* Qs = C.lds + (BO) + OQ; LAS unsigned char* Ks = C.lds + (BO) + OK_; LAS unsigned char* Vs = C.lds + (BO) + OV; \
                f32x4 acc[4]; bf16x8 fA[4], fB[4], kA[4], kB[4], vf0, vf1; \
                _Pragma("unroll") for (int m = 0; m < 4; ++m) acc[m] = (f32x4){0.f, 0.f, 0.f, 0.f}; \
                SC_LQ(fA, 0); SC_LQ(fB, 1); SC_MQ(fA, 0); SC_LQ(fA, 2); SC_MQ(fB, 1); SC_LQ(fB, 3); SC_MQ(fA, 2); SC_LQ(fA, 4); SC_MQ(fB, 3); SC_LQ(fB, 5); SC_MQ(fA, 4); SC_LQ(fA, 6); SC_MQ(fB, 5); SC_LQ(fB, 7); SC_MQ(fA, 6); SC_LV(vf0, 0); SC_LV(vf1, 1); SC_LK(kA, 0, 0); SC_MQ(fB, 7); \
                _Pragma("unroll") for (int m = 0; m < 4; ++m) { const f32x4 v = acc[m] * exp2f(lg2 * (float)(16 * m + fr + 1)); uint2 o; o.x = cvtpk(v[0], v[1]); o.y = cvtpk(v[2], v[3]); \
                    *(uint2*)(CROSS + (tok0 + 16 * m + fr) * 2048 + h * 512 + es * SCAN_ESL + 16 * w + 4 * fq) = o; } \
                _Pragma("unroll") for (int t = 0; t < 16; ++t) S[t] = S[t] * gc; \
                __builtin_amdgcn_sched_barrier(0); \
                SC_LK(kB, 0, 1); SC_MK(kA, vf0, 0); SC_LK(kA, 0, 2); SC_MK(kB, vf0, 1); SC_LK(kB, 0, 3); SC_MK(kA, vf0, 2); SC_LK(kA, 1, 0); SC_MK(kB, vf0, 3); SC_LK(kB, 1, 1); SC_MK(kA, vf1, 0); SC_LK(kA, 1, 2); SC_MK(kB, vf1, 1); SC_LK(kB, 1, 3); SC_MK(kA, vf1, 2); SC_MK(kB, vf1, 3); \
                SCAN_BAR(); } while (0)
#pragma unroll 1
            for (int n = 0; n < 128; n += 2) { if (MODE == 1) { SCAN_BAR(); SCAN_BAR(); } else { SCAN_CHUNK(n, 0); SCAN_CHUNK(n + 1, BUFB); } }
#undef SCAN_CHUNK
#undef SC_LQ
#undef SC_MQ
#undef SC_LK
#undef SC_LV
#undef SC_MK
        }
    }
}
#undef SCAN_BAR
DI void sgu_gate_mfma(const Ctx& C, bf16* U, const bf16* VB, const float* stats, const float* w_s, const float* b_s, const float* ln_g, const float* ln_b) {
    constexpr int WPI = 272, VPI = 288;
    LAS unsigned char* Ws = C.lds; LAS unsigned char* Vs = C.lds + 128 * WPI;
    LAS float* mu = (LAS float*)(C.lds + 128 * WPI + 128 * VPI); LAS float* rsd = mu + 128; LAS float* r1 = mu + 256; LAS float* r2 = mu + 384; LAS float* bsl = mu + 512;
    const int tid = C.tid, lane = C.lane, w = C.wave, fr = lane & 15, fq = lane >> 4;
    for (int item = C.vcu; item < 1024; item += C.G) {
        const int n = item >> 3, g = item & 7; const size_t row0 = (size_t)n * 128;
        if (tid < 128) { const float* sp = stats + (row0 + tid) * 96; float s1 = 0.f, s2 = 0.f;
#pragma unroll 8
            for (int q = 0; q < 48; ++q) { s1 += sp[2 * q]; s2 += sp[2 * q + 1]; }
            const float m = s1 * (1.0f / 3072.0f); const float var = s2 * (1.0f / 3072.0f) - m * m; mu[tid] = m; rsd[tid] = 1.0f / sqrtf(fmaxf(var, 0.f) + EPS); bsl[tid] = b_s[g * 128 + tid]; }
        __syncthreads();
        { const int i = tid >> 2, jq = tid & 3; const float* wp = w_s + (size_t)g * 16384 + i * 128 + jq * 32; float a1 = 0.f, a2 = 0.f;
#pragma unroll
          for (int c8 = 0; c8 < 4; ++c8) { const f32x4 wa = *(const f32x4*)(wp + c8 * 8), wb = *(const f32x4*)(wp + c8 * 8 + 4); float wv[8] = {wa[0], wa[1], wa[2], wa[3], wb[0], wb[1], wb[2], wb[3]}; float o[8];
#pragma unroll
              for (int q = 0; q < 8; ++q) { const int j = jq * 32 + c8 * 8 + q; const float wm = (i < 64 && j >= 64) ? 0.f : wv[q]; const float wr_ = wm * rsd[j]; o[q] = wr_; a1 += wr_ * mu[j]; a2 += wm; }
              u32x4 pk; pk.x = cvtpk(o[0], o[1]); pk.y = cvtpk(o[2], o[3]); pk.z = cvtpk(o[4], o[5]); pk.w = cvtpk(o[6], o[7]);
              *(LAS u32x4*)(Ws + i * WPI + (jq * 32 + c8 * 8) * 2) = pk; }
          a1 += __shfl_xor(a1, 1); a1 += __shfl_xor(a1, 2); a2 += __shfl_xor(a2, 1); a2 += __shfl_xor(a2, 2);
          if (jq == 0) { r1[i] = a1; r2[i] = a2; } }
#pragma unroll 1
        for (int cs = 0; cs < 3; ++cs) {
            const int colb = g * 384 + cs * 128;
#pragma unroll
            for (int u = 0; u < 4; ++u) { const int c = tid + 512 * u, r = c >> 4, cc = c & 15;
                *(LAS u32x4*)(Vs + r * VPI + cc * 16) = *(const u32x4*)(VB + (row0 + r) * 3072 + colb + cc * 8); }
            __syncthreads();
            f32x4 acc[8];
#pragma unroll
            for (int it = 0; it < 8; ++it) acc[it] = (f32x4){0.f, 0.f, 0.f, 0.f};
#pragma unroll
            for (int ks = 0; ks < 4; ++ks) {
                const LAS unsigned char* vp = Vs + (32 * ks + 4 * fq + (fr >> 2)) * VPI + (16 * w + 4 * (fr & 3)) * 2;
                const bf16x8 vf = cat8(trr(vp), trr(vp + 16 * VPI));
#pragma unroll
                for (int it = 0; it < 8; ++it) { if (it < 4 && ks >= 2) continue;
                    const LAS unsigned char* wp = Ws + (16 * it + fr) * WPI + (32 * ks + 4 * fq) * 2;
                    const u32x2_t lo = *(const LAS u32x2_t*)wp, hi = *(const LAS u32x2_t*)(wp + 32);
                    u32x4 ww; ww.x = lo.x; ww.y = lo.y; ww.z = hi.x; ww.w = hi.y;
                    acc[it] = __builtin_amdgcn_mfma_f32_16x16x32_bf16(vf, __builtin_bit_cast(bf16x8, ww), acc[it], 0, 0, 0); }
            }
            const int c0 = colb + 16 * w + 4 * fq;
            const f32x4 lg = *(const f32x4*)(ln_g + c0), lb = *(const f32x4*)(ln_b + c0);
#pragma unroll
            for (int it = 0; it < 8; ++it) { const int i = 16 * it + fr; const float q1 = r1[i], q2 = r2[i], bb = bsl[i];
                bf16* up = U + (row0 + i) * 3072 + c0; const u32x2_t uu = *(const u32x2_t*)up;
                const f32x4 s = lg * (acc[it] - q1) + lb * q2 + bb;
                u32x2_t o; o.x = cvtpk(bflo(uu.x) * s[0], bfhi(uu.x) * s[1]); o.y = cvtpk(bflo(uu.y) * s[2], bfhi(uu.y) * s[3]);
                *(u32x2_t*)up = o; }
            __syncthreads();
        }
    }
}
DI void up8(unsigned wd, float& a, float& b, float& c, float& d) { const f32x2_t lo = __builtin_amdgcn_cvt_pk_f32_fp8((int)wd, false), hi = __builtin_amdgcn_cvt_pk_f32_fp8((int)wd, true); a = lo.x; b = lo.y; c = hi.x; d = hi.y; }
DI float dot16(const u32x4 u, const float (&hv)[16]) {
    float f[16];
    up8(u.x, f[0], f[1], f[2], f[3]); up8(u.y, f[4], f[5], f[6], f[7]); up8(u.z, f[8], f[9], f[10], f[11]); up8(u.w, f[12], f[13], f[14], f[15]);
    float d0 = f[0] * hv[0], d1 = f[1] * hv[1];
#pragma unroll
    for (int j = 2; j < 16; j += 2) { d0 += f[j] * hv[j]; d1 += f[j + 1] * hv[j + 1]; }
    return d0 + d1;
}
template <bool FINAL> DI void peer_gather8(const Ctx& C, const bf16* Hin, const int* IDX, const float* GATE, const unsigned char* PU8, const unsigned char* PV8, const float* ISU, const float* ISV,
                                           float* X, const float* g2, const float* ngain, const float* nmod, bf16* Hn) {
    const int gw = C.vcu * NWAVES + C.wave, NGW = C.G * NWAVES, lane = C.lane;
    LAS float* DL = (LAS float*)(C.lds + C.wave * 1024);
    LAS float* AL = DL + 128;
    for (int t = gw; t < TT; t += NGW) {
        float hv[16];
        { const u32x4 a = *(const u32x4*)(Hin + (size_t)t * 1024 + lane * 16), bq = *(const u32x4*)(Hin + (size_t)t * 1024 + lane * 16 + 8);
          hv[0] = bflo(a.x); hv[1] = bfhi(a.x); hv[2] = bflo(a.y); hv[3] = bfhi(a.y); hv[4] = bflo(a.z); hv[5] = bfhi(a.z); hv[6] = bflo(a.w); hv[7] = bfhi(a.w);
          hv[8] = bflo(bq.x); hv[9] = bfhi(bq.x); hv[10] = bflo(bq.y); hv[11] = bfhi(bq.y); hv[12] = bflo(bq.z); hv[13] = bfhi(bq.z); hv[14] = bflo(bq.w); hv[15] = bfhi(bq.w); }
        const int i0 = IDX[(size_t)t * 128 + lane], i1 = IDX[(size_t)t * 128 + 64 + lane];
        const float g0 = GATE[(size_t)t * 128 + lane], g1 = GATE[(size_t)t * 128 + 64 + lane];
        const float su0 = ISU[i0], su1 = ISU[i1], sv0 = ISV[i0], sv1 = ISV[i1];
        u32x4 ub[8];
#define PG_LOADU(k0) do { _Pragma("unroll") for (int j = 0; j < 8; ++j) { const int kq = (k0) + j; const int e = kq < 64 ? __builtin_amdgcn_readlane(i0, kq) : __builtin_amdgcn_readlane(i1, kq - 64); \
            ub[j] = *(const u32x4*)(PU8 + (size_t)e * 1024 + lane * 16); } } while (0)
        PG_LOADU(0);
#pragma unroll 1
        for (int k0 = 0; k0 < 128; k0 += 8) {
            float p[8];
#pragma unroll
            for (int j = 0; j < 8; ++j) p[j] = dot16(ub[j], hv);
            if (k0 + 8 < 128) PG_LOADU(k0 + 8);
            const bool h32 = lane & 32, h16 = lane & 16, h8 = lane & 8;
            float q4[4];
#pragma unroll
            for (int j = 0; j < 4; ++j) { const float keep = h32 ? p[j + 4] : p[j], send = h32 ? p[j] : p[j + 4]; q4[j] = keep + __shfl_xor(send, 32); }
            float q2[2];
#pragma unroll
            for (int j = 0; j < 2; ++j) { const float keep = h16 ? q4[j + 2] : q4[j], send = h16 ? q4[j] : q4[j + 2]; q2[j] = keep + __shfl_xor(send, 16); }
            float q1; { const float keep = h8 ? q2[1] : q2[0], send = h8 ? q2[0] : q2[1]; q1 = keep + __shfl_xor(send, 8); }
            q1 += __shfl_xor(q1, 4); q1 += __shfl_xor(q1, 2); q1 += __shfl_xor(q1, 1);
            if ((lane & 7) == 0) DL[k0 + ((lane >> 5) & 1) * 4 + ((lane >> 4) & 1) * 2 + ((lane >> 3) & 1)] = q1;
        }
#undef PG_LOADU
        LDS_WAIT();
        { const float d0 = DL[lane], d1 = DL[64 + lane]; AL[lane] = gelu_t(d0 * su0) * g0 * sv0; AL[64 + lane] = gelu_t(d1 * su1) * g1 * sv1; }
        LDS_WAIT();
        float o[16];
#pragma unroll
        for (int j = 0; j < 16; ++j) o[j] = 0.f;
        u32x4 vb[8];
#define PG_LOADV(k0) do { _Pragma("unroll") for (int j = 0; j < 8; ++j) { const int kq = (k0) + j; const int e = kq < 64 ? __builtin_amdgcn_readlane(i0, kq) : __builtin_amdgcn_readlane(i1, kq - 64); \
            vb[j] = *(const u32x4*)(PV8 + (size_t)e * 1024 + lane * 16); } } while (0)
        PG_LOADV(0);
#pragma unroll 1
        for (int k0 = 0; k0 < 128; k0 += 8) {
            float f[8][16];
#pragma unroll
            for (int j = 0; j < 8; ++j) { up8(vb[j].x, f[j][0], f[j][1], f[j][2], f[j][3]); up8(vb[j].y, f[j][4], f[j][5], f[j][6], f[j][7]); up8(vb[j].z, f[j][8], f[j][9], f[j][10], f[j][11]); up8(vb[j].w, f[j][12], f[j][13], f[j][14], f[j][15]); }
            if (k0 + 8 < 128) PG_LOADV(k0 + 8);
#pragma unroll
            for (int j = 0; j < 8; ++j) { const float ak = AL[k0 + j];
#pragma unroll
                for (int q = 0; q < 16; ++q) o[q] += ak * f[j][q]; }
        }
#undef PG_LOADV
        const int b = t >> 13; const float* gp = g2 + (size_t)b * 6144; float* xr = X + (size_t)t * 1024;
        float xn[16]; float ss = 0.f;
#pragma unroll
        for (int q = 0; q < 4; ++q) { const int col = lane * 16 + q * 4; const f32x4 xv = *(const f32x4*)(xr + col), gv = *(const f32x4*)(gp + col);
#pragma unroll
            for (int j = 0; j < 4; ++j) { const float y = xv[j] + gv[j] * o[q * 4 + j]; xn[q * 4 + j] = y; ss += y * y; } }
        const float rstd = 1.0f / sqrtf(wave_sum(ss) * (1.0f / 1024.0f) + EPS);
        if (FINAL) {
#pragma unroll
            for (int q = 0; q < 4; ++q) { const int col = lane * 16 + q * 4; const f32x4 gn = *(const f32x4*)(ngain + col); f32x4 y;
#pragma unroll
                for (int j = 0; j < 4; ++j) y[j] = xn[q * 4 + j] * rstd * gn[j];
                *(f32x4*)(xr + col) = y; }
        } else {
            const float* nm = nmod + (size_t)b * 6144;
#pragma unroll
            for (int q = 0; q < 4; ++q) { const int col = lane * 16 + q * 4; const f32x4 gn = *(const f32x4*)(ngain + col), sh = *(const f32x4*)(nm + col), sc = *(const f32x4*)(nm + 1024 + col); f32x4 xo; float y[4];
#pragma unroll
                for (int j = 0; j < 4; ++j) { xo[j] = xn[q * 4 + j]; y[j] = xn[q * 4 + j] * rstd * gn[j] * (1.0f + sc[j]) + sh[j]; }
                *(f32x4*)(xr + col) = xo; u32x2_t wv; wv.x = cvtpk(y[0], y[1]); wv.y = cvtpk(y[2], y[3]); *(u32x2_t*)(Hn + (size_t)t * 1024 + col) = wv; }
        }
    }
}
template <int CTRL> DI float dpp_f(float x) { return __int_as_float(__builtin_amdgcn_update_dpp(0, __float_as_int(x), CTRL, 0xF, 0xF, false)); }
DI float x32(float x) { auto r = __builtin_amdgcn_permlane32_swap(__float_as_uint(x), __float_as_uint(x), false, false); return (threadIdx.x & 32) ? __uint_as_float(r[0]) : __uint_as_float(r[1]); }
DI float x16(float x) { auto r = __builtin_amdgcn_permlane16_swap(__float_as_uint(x), __float_as_uint(x), false, false); return (threadIdx.x & 16) ? __uint_as_float(r[0]) : __uint_as_float(r[1]); }
typedef _Float16 h2_t __attribute__((ext_vector_type(2)));
DI unsigned f2hu(float lo, float hi) { const f32x2_t v = {lo, hi}; const h2_t h = __builtin_convertvector(v, h2_t); return __builtin_bit_cast(unsigned, h); }
DI unsigned bf2hu(unsigned w) { const f32x2_t v = {bflo(w), bfhi(w)}; const h2_t h = __builtin_convertvector(v, h2_t); return __builtin_bit_cast(unsigned, h); }
DI h2_t bf2h(unsigned w) { return (h2_t){(_Float16)bflo(w), (_Float16)bfhi(w)}; }
template <bool FAKE> DI void up8h(const u32x4 u, h2_t (&f)[8]) {
    if (FAKE) { f[0] = __builtin_bit_cast(h2_t, u.x & 0x3bff3bffu); f[1] = __builtin_bit_cast(h2_t, u.y & 0x3bff3bffu); f[2] = __builtin_bit_cast(h2_t, u.z & 0x3bff3bffu); f[3] = __builtin_bit_cast(h2_t, u.w & 0x3bff3bffu);
        f[4] = __builtin_bit_cast(h2_t, (u.x >> 1) & 0x3bff3bffu); f[5] = __builtin_bit_cast(h2_t, (u.y >> 1) & 0x3bff3bffu); f[6] = __builtin_bit_cast(h2_t, (u.z >> 1) & 0x3bff3bffu); f[7] = __builtin_bit_cast(h2_t, (u.w >> 1) & 0x3bff3bffu); return; }
    f[0] = __builtin_amdgcn_cvt_scalef32_pk_f16_fp8((int)u.x, 1.0f, false); f[1] = __builtin_amdgcn_cvt_scalef32_pk_f16_fp8((int)u.x, 1.0f, true);
    f[2] = __builtin_amdgcn_cvt_scalef32_pk_f16_fp8((int)u.y, 1.0f, false); f[3] = __builtin_amdgcn_cvt_scalef32_pk_f16_fp8((int)u.y, 1.0f, true);
    f[4] = __builtin_amdgcn_cvt_scalef32_pk_f16_fp8((int)u.z, 1.0f, false); f[5] = __builtin_amdgcn_cvt_scalef32_pk_f16_fp8((int)u.z, 1.0f, true);
    f[6] = __builtin_amdgcn_cvt_scalef32_pk_f16_fp8((int)u.w, 1.0f, false); f[7] = __builtin_amdgcn_cvt_scalef32_pk_f16_fp8((int)u.w, 1.0f, true); }
template <bool FAKE> DI float dot16h(const u32x4 u, const h2_t (&hh)[8]) { h2_t f[8]; up8h<FAKE>(u, f); float d0 = 0.f, d1 = 0.f;
#pragma unroll
    for (int q = 0; q < 8; q += 2) { d0 = __builtin_amdgcn_fdot2(f[q], hh[q], d0, false); d1 = __builtin_amdgcn_fdot2(f[q + 1], hh[q + 1], d1, false); }
    return d0 + d1; }
template <bool FINAL, bool FAKE = false, int SKIP = 0> DI void peer_gather_rounds(const Ctx& C, const bf16* Hin, const int* IDX, const float* GATE, const unsigned char* PU8, const unsigned char* PV8, const float* ISU, const float* ISV,
                                                 float* X, const float* g2, const float* ngain, const float* nmod, bf16* Hn) {
    const int lane = C.lane, w = C.wave;
    LAS u32x2_t* LIST = (LAS u32x2_t*)(C.lds + w * 14592);
    LAS unsigned char* HL = C.lds + w * 14592 + 4096;
    LAS unsigned* ALU = (LAS unsigned*)(C.lds + w * 14592 + 12288);
    LAS int* OFFS = (LAS int*)(C.lds + w * 14592 + 14336);
    LAS float* IHS = (LAS float*)(C.lds + w * 14592 + 14336 + 160);
    const unsigned long long ltmask = (1ull << lane) - 1ull;
    for (int grp = C.vcu; grp < TT / 32; grp += C.G) {
        const int t0 = grp * 32 + w * 4;
        {
            int ee[8]; float gg[8]; unsigned su[8]; float sv[8];
#pragma unroll
            for (int r = 0; r < 8; ++r) { const size_t a = (size_t)(t0 + (r >> 1)) * 128 + 64 * (r & 1) + lane; ee[r] = IDX[a]; gg[r] = GATE[a]; }
#pragma unroll
            for (int r = 0; r < 8; ++r) { su[r] = __float_as_uint(ISU[ee[r]]) >> 23; sv[r] = ISV[ee[r]]; }
            int pos[8]; int base = 0;
#pragma unroll 1
            for (int b = 0; b < 8; ++b) {
#pragma unroll
                for (int r = 0; r < 8; ++r) { if ((r & 1) == 0 && lane == 0) OFFS[b * 4 + (r >> 1)] = base;
                    const bool mine = (ee[r] >> 11) == b; const unsigned long long m = __ballot(mine); if (mine) pos[r] = base + __popcll(m & ltmask); base += __popcll(m); }
            }
            if (lane == 0) OFFS[32] = 512;
#pragma unroll
            for (int r = 0; r < 8; ++r) { u32x2_t en; en.x = (unsigned)ee[r] | ((unsigned)(r >> 1) << 14) | (su[r] << 16); en.y = __float_as_uint(gg[r] * sv[r]); LIST[pos[r]] = en; }
#pragma unroll
            for (int tk = 0; tk < 4; ++tk) { const u32x4 a = *(const u32x4*)(Hin + (size_t)(t0 + tk) * 1024 + lane * 16), bq = *(const u32x4*)(Hin + (size_t)(t0 + tk) * 1024 + lane * 16 + 8);
                const float hv_[16] = {bflo(a.x), bfhi(a.x), bflo(a.y), bfhi(a.y), bflo(a.z), bfhi(a.z), bflo(a.w), bfhi(a.w), bflo(bq.x), bfhi(bq.x), bflo(bq.y), bfhi(bq.y), bflo(bq.z), bfhi(bq.z), bflo(bq.w), bfhi(bq.w)};
                float am = 0.f;
#pragma unroll
                for (int q = 0; q < 16; ++q) am = fmaxf(am, fabsf(hv_[q]));
                am = wave_max(am);
                const int e_ = (int)((__float_as_uint(am) >> 23) & 0xffu) - 127; const bool ok_ = am > 1e-30f;
                const float sc_ = ok_ ? __uint_as_float((unsigned)(127 + 6 - e_) << 23) : 1.0f, isc_ = ok_ ? __uint_as_float((unsigned)(127 - 6 + e_) << 23) : 1.0f;
                u32x4 o8;
#pragma unroll
                for (int q = 0; q < 4; ++q) { unsigned wd = 0u;
#pragma unroll
                    for (int j = 0; j < 4; ++j) { int qi = (int)rintf(hv_[4 * q + j] * sc_); qi = qi > 127 ? 127 : (qi < -127 ? -127 : qi); wd |= ((unsigned)qi & 0xffu) << (8 * j); }
                    o8[q] = wd; }
                *(LAS u32x4*)(HL + tk * 1024 + lane * 16) = o8; if (lane == 0) IHS[tk] = isc_; }
        }
        LDS_WAIT();
        {
            const int jL = ((lane >> 5) & 1) * 4 + ((lane >> 4) & 1) * 2 + ((lane >> 3) & 1);
#define G1_LOAD(UB, TK, G0) do { const unsigned exl_ = LIST[(G0) + (lane & 7)].x; \
            _Pragma("unroll") for (int j = 0; j < 8; ++j) { const unsigned ex = (unsigned)__builtin_amdgcn_readlane((int)exl_, j); TK[j] = (int)((ex >> 14) & 3u); \
                UB[j] = *(const u32x4*)(PU8 + (size_t)(ex & (FAKE ? 0x7fu : 0x3fffu)) * 1024 + lane * 16); } } while (0)
#define G1_RUN(UB, TK, G0) do { int p[8]; \
            _Pragma("unroll") for (int j = 0; j < 8; ++j) { const u32x4 hq = *(const LAS u32x4*)(HL + TK[j] * 1024 + lane * 16); \
                int d_ = __builtin_amdgcn_sdot4((int)UB[j].x, (int)hq.x, 0, false); d_ = __builtin_amdgcn_sdot4((int)UB[j].y, (int)hq.y, d_, false); \
                d_ = __builtin_amdgcn_sdot4((int)UB[j].z, (int)hq.z, d_, false); p[j] = __builtin_amdgcn_sdot4((int)UB[j].w, (int)hq.w, d_, false); } \
            const bool h32 = lane & 32, h16 = lane & 16, h8 = lane & 8; int q4[4]; \
            _Pragma("unroll") for (int j = 0; j < 4; ++j) { const int keep = h32 ? p[j + 4] : p[j], send = h32 ? p[j] : p[j + 4]; q4[j] = keep + __float_as_int(x32(__int_as_float(send))); } \
            int q2[2]; \
            _Pragma("unroll") for (int j = 0; j < 2; ++j) { const int keep = h16 ? q4[j + 2] : q4[j], send = h16 ? q4[j] : q4[j + 2]; q2[j] = keep + __float_as_int(x16(__int_as_float(send))); } \
            int q1; { const int keep = h8 ? q2[1] : q2[0], send = h8 ? q2[0] : q2[1]; q1 = keep + __float_as_int(dpp_f<0x128>(__int_as_float(send))); } \
            q1 += __float_as_int(dpp_f<0x141>(__int_as_float(q1))); q1 += __float_as_int(dpp_f<0xB1>(__int_as_float(q1))); q1 += __float_as_int(dpp_f<0x4E>(__int_as_float(q1))); \
            if ((lane & 7) == 0) { const u32x2_t me = LIST[(G0) + jL]; const float av_ = gelu_t((float)q1 * IHS[(me.x >> 14) & 3u] * __uint_as_float((me.x >> 16) << 23)) * __uint_as_float(me.y); ALU[(G0) + jL] = f2hu(av_, av_); } } while (0)
            u32x4 ubA[8], ubB[8]; int tkA[8], tkB[8];
            G1_LOAD(ubA, tkA, 0);
#pragma unroll 1
            for (int g0 = 0; g0 < ((SKIP & 1) ? 0 : 512); g0 += 16) {
                G1_LOAD(ubB, tkB, g0 + 8);
                G1_RUN(ubA, tkA, g0);
                if (g0 + 16 < 512) G1_LOAD(ubA, tkA, g0 + 16);
                G1_RUN(ubB, tkB, g0 + 8);
            }
#undef G1_LOAD
#undef G1_RUN
        }
        LDS_WAIT();
        h2_t o[4][8];
#pragma unroll
        for (int tk = 0; tk < 4; ++tk)
#pragma unroll
            for (int q = 0; q < 8; ++q) o[tk][q] = (h2_t){(_Float16)0.f, (_Float16)0.f};
#pragma unroll 1
        for (int r = 0; r < ((SKIP & 2) ? 0 : 8); ++r) {
#pragma unroll
            for (int tk = 0; tk < 4; ++tk) {
                const int beg = __builtin_amdgcn_readfirstlane(OFFS[r * 4 + tk]), end = __builtin_amdgcn_readfirstlane(OFFS[r * 4 + tk + 1]);
#define GS_LOAD(VB, AJ, G0) do { const int idl_ = ((G0) + (lane & 7) < end) ? (G0) + (lane & 7) : end - 1; const unsigned exl_ = LIST[idl_].x; const unsigned all_ = ((G0) + (lane & 7) < end) ? ALU[idl_] : 0u; \
                    _Pragma("unroll") for (int j = 0; j < 8; ++j) { const unsigned ex = (unsigned)__builtin_amdgcn_readlane((int)exl_, j); AJ[j] = __builtin_bit_cast(h2_t, (unsigned)__builtin_amdgcn_readlane((int)all_, j)); \
                        VB[j] = *(const u32x4*)(PV8 + (size_t)(ex & (FAKE ? 0x7fu : 0x3fffu)) * 1024 + lane * 16); } } while (0)
#define GS_ACC(VB, AJ) do { _Pragma("unroll") for (int j = 0; j < 8; ++j) { h2_t f_[8]; up8h<FAKE>(VB[j], f_); _Pragma("unroll") for (int q = 0; q < 8; ++q) o[tk][q] = f_[q] * AJ[j] + o[tk][q]; } } while (0)
                if (beg < end) {
                    u32x4 vbA[8], vbB[8]; h2_t ajA[8], ajB[8];
                    GS_LOAD(vbA, ajA, beg);
#pragma unroll 1
                    for (int g0 = beg; g0 < end; g0 += 16) {
                        if (g0 + 8 < end) GS_LOAD(vbB, ajB, g0 + 8);
                        GS_ACC(vbA, ajA);
                        if (g0 + 8 < end) { if (g0 + 16 < end) GS_LOAD(vbA, ajA, g0 + 16); GS_ACC(vbB, ajB); }
                    }
                }
#undef GS_LOAD
#undef GS_ACC
            }
        }
#pragma unroll
        for (int tk = 0; tk < 4; ++tk) {
            __builtin_amdgcn_sched_barrier(0);
            const int t = t0 + tk; const int b = t >> 13; const float* gp = g2 + (size_t)b * 6144; float* xr = X + (size_t)t * 1024;
            float xn[16]; float ss = 0.f;
#pragma unroll
            for (int q = 0; q < 4; ++q) { const int col = lane * 16 + q * 4; const f32x4 xv = *(const f32x4*)(xr + col), gv = *(const f32x4*)(gp + col);
#pragma unroll
                for (int j = 0; j < 4; ++j) { const float y = xv[j] + gv[j] * (float)o[tk][q * 2 + (j >> 1)][j & 1]; xn[q * 4 + j] = y; ss += y * y; } }
            const float rstd = 1.0f / sqrtf(wave_sum(ss) * (1.0f / 1024.0f) + EPS);
            if (FINAL) {
#pragma unroll
                for (int q = 0; q < 4; ++q) { const int col = lane * 16 + q * 4; const f32x4 gn = *(const f32x4*)(ngain + col); f32x4 y;
#pragma unroll
                    for (int j = 0; j < 4; ++j) y[j] = xn[q * 4 + j] * rstd * gn[j];
                    *(f32x4*)(xr + col) = y; }
            } else {
                const float* nm = nmod + (size_t)b * 6144;
#pragma unroll
                for (int q = 0; q < 4; ++q) { const int col = lane * 16 + q * 4; const f32x4 gn = *(const f32x4*)(ngain + col), sh = *(const f32x4*)(nm + col), sc = *(const f32x4*)(nm + 1024 + col); f32x4 xo; float y[4];
#pragma unroll
                    for (int j = 0; j < 4; ++j) { xo[j] = xn[q * 4 + j]; y[j] = xn[q * 4 + j] * rstd * gn[j] * (1.0f + sc[j]) + sh[j]; }
                    *(f32x4*)(xr + col) = xo; u32x2_t wv; wv.x = cvtpk(y[0], y[1]); wv.y = cvtpk(y[2], y[3]); *(u32x2_t*)(Hn + (size_t)t * 1024 + col) = wv; }
            }
        }
        LDS_WAIT();
    }
}
constexpr int GR_R = 12;
DI void glds_row(const unsigned char* gsrc_lane, unsigned lds_dst) { unsigned keep;
    asm volatile("s_mov_b32 %0, m0\n\ts_mov_b32 m0, %2\n\ts_nop 0\n\tglobal_load_lds_dwordx4 %1, off\n\ts_mov_b32 m0, %0" : "=&s"(keep) : "v"(gsrc_lane), "s"(lds_dst) : "memory"); }
template <bool FINAL> DI void peer_gather_dma(const Ctx& C, const bf16* Hin, const int* IDX, const float* GATE, const unsigned char* PU8, const unsigned char* PV8, const float* ISU, const float* ISV,
                                              float* X, const float* g2, const float* ngain, const float* nmod, bf16* Hn) {
    const int lane = C.lane, w = C.wave;
    constexpr int WB = 4096 + 2048 + 256 + GR_R * 1024;
    LAS u32x2_t* LIST = (LAS u32x2_t*)(C.lds + w * WB);
    LAS float* AL = (LAS float*)(C.lds + w * WB + 4096);
    LAS int* OFFS = (LAS int*)(C.lds + w * WB + 6144);
    LAS unsigned char* RING = C.lds + w * WB + 6400;
    const unsigned ring0 = (unsigned)__builtin_amdgcn_readfirstlane((int)(unsigned)(size_t)RING);
    const unsigned long long ltmask = (1ull << lane) - 1ull;
#define GR_REFILL(nv_) do { unsigned ex8_[8]; _Pragma("unroll") for (int j_ = 0; j_ < 8; ++j_) ex8_[j_] = (j_ < (nv_) && nf + j_ < 1024) ? LIST[(nf + j_) & 511].x : 0u; \
        _Pragma("unroll") for (int j_ = 0; j_ < 8; ++j_) if (j_ < (nv_) && nf + j_ < 1024) { const int f_ = nf + j_; const unsigned e_ = (unsigned)__builtin_amdgcn_readfirstlane((int)ex8_[j_]) & 0x3fffu; \
            const unsigned char* tb_ = (f_ < 512) ? PU8 : PV8; glds_row(tb_ + (size_t)e_ * 1024 + lane * 16, ring0 + (unsigned)(f_ % GR_R) * 1024u); } \
        nf += (nv_); if (nf > 1024) nf = 1024; } while (0)
#define GR_ISSUE(f) do { const int f_ = (f); const unsigned ex_ = (unsigned)__builtin_amdgcn_readfirstlane((int)LIST[f_ & 511].x); \
        const unsigned char* tb_ = (f_ < 512) ? PU8 : PV8; glds_row(tb_ + (size_t)(ex_ & 0x3fffu) * 1024 + lane * 16, ring0 + (unsigned)(f_ % GR_R) * 1024u); } while (0)
    for (int grp = C.vcu; grp < TT / 32; grp += C.G) {
        const int t0 = grp * 32 + w * 4;
        float hv4[4][16];
        {
            int ee[8]; float gg[8]; unsigned su[8]; float sv[8];
#pragma unroll
            for (int r = 0; r < 8; ++r) { const size_t a = (size_t)(t0 + (r >> 1)) * 128 + 64 * (r & 1) + lane; ee[r] = IDX[a]; gg[r] = GATE[a]; }
#pragma unroll
            for (int r = 0; r < 8; ++r) { su[r] = __float_as_uint(ISU[ee[r]]) >> 23; sv[r] = ISV[ee[r]]; }
            int pos[8]; int base = 0;
#pragma unroll 1
            for (int b = 0; b < 8; ++b) {
#pragma unroll
                for (int r = 0; r < 8; ++r) { if ((r & 1) == 0 && lane == 0) OFFS[b * 4 + (r >> 1)] = base;
                    const bool mine = (ee[r] >> 11) == b; const unsigned long long m = __ballot(mine); if (mine) pos[r] = base + __popcll(m & ltmask); base += __popcll(m); }
            }
            if (lane == 0) OFFS[32] = 512;
#pragma unroll
            for (int r = 0; r < 8; ++r) { u32x2_t en; en.x = (unsigned)ee[r] | ((unsigned)(r >> 1) << 14) | (su[r] << 16); en.y = __float_as_uint(gg[r] * sv[r]); LIST[pos[r]] = en; }
#pragma unroll
            for (int tk = 0; tk < 4; ++tk) { const u32x4 a = *(const u32x4*)(Hin + (size_t)(t0 + tk) * 1024 + lane * 16), bq = *(const u32x4*)(Hin + (size_t)(t0 + tk) * 1024 + lane * 16 + 8);
                hv4[tk][0] = bflo(a.x); hv4[tk][1] = bfhi(a.x); hv4[tk][2] = bflo(a.y); hv4[tk][3] = bfhi(a.y); hv4[tk][4] = bflo(a.z); hv4[tk][5] = bfhi(a.z); hv4[tk][6] = bflo(a.w); hv4[tk][7] = bfhi(a.w);
                hv4[tk][8] = bflo(bq.x); hv4[tk][9] = bfhi(bq.x); hv4[tk][10] = bflo(bq.y); hv4[tk][11] = bfhi(bq.y); hv4[tk][12] = bflo(bq.z); hv4[tk][13] = bfhi(bq.z); hv4[tk][14] = bflo(bq.w); hv4[tk][15] = bfhi(bq.w); }
        }
        asm volatile("s_waitcnt vmcnt(0) lgkmcnt(0)" ::: "memory");
        int nf = GR_R;
#pragma unroll 1
        for (int f = 0; f < GR_R; ++f) GR_ISSUE(f);
        {
            const int jL = ((lane >> 5) & 1) * 4 + ((lane >> 4) & 1) * 2 + ((lane >> 3) & 1);
#pragma unroll 1
            for (int r = 0; r < 8; ++r) {
#pragma unroll
                for (int tk = 0; tk < 4; ++tk) {
                    const int beg = __builtin_amdgcn_readfirstlane(OFFS[r * 4 + tk]), end = __builtin_amdgcn_readfirstlane(OFFS[r * 4 + tk + 1]);
#pragma unroll 1
                    for (int g0 = beg; g0 < end; g0 += 8) {
                        const int nv = (end - g0) < 8 ? (end - g0) : 8;
                        asm volatile("s_waitcnt vmcnt(4)" ::: "memory");
                        float p[8];
#pragma unroll
                        for (int j = 0; j < 8; ++j) { p[j] = 0.f;
                            if (j < nv) { const u32x4 row = *(const LAS u32x4*)(RING + ((g0 + j) % GR_R) * 1024 + lane * 16); p[j] = dot16(row, hv4[tk]); } }
                        asm volatile("s_waitcnt lgkmcnt(0)" ::: "memory");
                        GR_REFILL(nv);
                        const bool h32 = lane & 32, h16 = lane & 16, h8 = lane & 8;
                        float q4[4];
#pragma unroll
                        for (int j = 0; j < 4; ++j) { const float keep = h32 ? p[j + 4] : p[j], send = h32 ? p[j] : p[j + 4]; q4[j] = keep + __shfl_xor(send, 32); }
                        float q2[2];
#pragma unroll
                        for (int j = 0; j < 2; ++j) { const float keep = h16 ? q4[j + 2] : q4[j], send = h16 ? q4[j] : q4[j + 2]; q2[j] = keep + __shfl_xor(send, 16); }
                        float q1; { const float keep = h8 ? q2[1] : q2[0], send = h8 ? q2[0] : q2[1]; q1 = keep + __shfl_xor(send, 8); }
                        q1 += __shfl_xor(q1, 4); q1 += __shfl_xor(q1, 2); q1 += __shfl_xor(q1, 1);
                        if ((lane & 7) == 0 && jL < nv) { const u32x2_t me = LIST[g0 + jL]; AL[g0 + jL] = gelu_t(q1 * __uint_as_float((me.x >> 16) << 23)) * __uint_as_float(me.y); }
                    }
                }
            }
        }
        float o[4][16];
#pragma unroll
        for (int tk = 0; tk < 4; ++tk)
#pragma unroll
            for (int q = 0; q < 16; ++q) o[tk][q] = 0.f;
#pragma unroll 1
        for (int r = 0; r < 8; ++r) {
#pragma unroll
            for (int tk = 0; tk < 4; ++tk) {
                const int beg = __builtin_amdgcn_readfirstlane(OFFS[r * 4 + tk]), end = __builtin_amdgcn_readfirstlane(OFFS[r * 4 + tk + 1]);
#pragma unroll 1
                for (int i0 = beg; i0 < end; i0 += 8) {
                    const int nv = (end - i0) < 8 ? (end - i0) : 8;
                    if (i0 <= 500) asm volatile("s_waitcnt vmcnt(4)" ::: "memory"); else asm volatile("s_waitcnt vmcnt(0)" ::: "memory");
                    float aq[8]; u32x4 rw[8];
#pragma unroll
                    for (int j = 0; j < 8; ++j) { aq[j] = (j < nv) ? AL[i0 + j] : 0.f; }
#pragma unroll
                    for (int j = 0; j < 8; ++j) if (j < nv) rw[j] = *(const LAS u32x4*)(RING + ((512 + i0 + j) % GR_R) * 1024 + lane * 16);
#pragma unroll
                    for (int j = 0; j < 8; ++j) if (j < nv) { const float aj = __int_as_float(__builtin_amdgcn_readfirstlane(__float_as_int(aq[j])));
                        float f_[16]; up8(rw[j].x, f_[0], f_[1], f_[2], f_[3]); up8(rw[j].y, f_[4], f_[5], f_[6], f_[7]); up8(rw[j].z, f_[8], f_[9], f_[10], f_[11]); up8(rw[j].w, f_[12], f_[13], f_[14], f_[15]);
#pragma unroll
                        for (int q = 0; q < 16; ++q) o[tk][q] += aj * f_[q]; }
                    asm volatile("s_waitcnt lgkmcnt(0)" ::: "memory");
                    GR_REFILL(nv);
                }
            }
        }
        asm volatile("s_waitcnt vmcnt(0)" ::: "memory");
#pragma unroll
        for (int tk = 0; tk < 4; ++tk) {
            const int t = t0 + tk; const int b = t >> 13; const float* gp = g2 + (size_t)b * 6144; float* xr = X + (size_t)t * 1024;
            float xn[16]; float ss = 0.f;
#pragma unroll
            for (int q = 0; q < 4; ++q) { const int col = lane * 16 + q * 4; const f32x4 xv = *(const f32x4*)(xr + col), gv = *(const f32x4*)(gp + col);
#pragma unroll
                for (int j = 0; j < 4; ++j) { const float y = xv[j] + gv[j] * o[tk][q * 4 + j]; xn[q * 4 + j] = y; ss += y * y; } }
            const float rstd = 1.0f / sqrtf(wave_sum(ss) * (1.0f / 1024.0f) + EPS);
            if (FINAL) {
#pragma unroll
                for (int q = 0; q < 4; ++q) { const int col = lane * 16 + q * 4; const f32x4 gn = *(const f32x4*)(ngain + col); f32x4 y;
#pragma unroll
                    for (int j = 0; j < 4; ++j) y[j] = xn[q * 4 + j] * rstd * gn[j];
                    *(f32x4*)(xr + col) = y; }
            } else {
                const float* nm = nmod + (size_t)b * 6144;
#pragma unroll
                for (int q = 0; q < 4; ++q) { const int col = lane * 16 + q * 4; const f32x4 gn = *(const f32x4*)(ngain + col), sh = *(const f32x4*)(nm + col), sc = *(const f32x4*)(nm + 1024 + col); f32x4 xo; float y[4];
#pragma unroll
                    for (int j = 0; j < 4; ++j) { xo[j] = xn[q * 4 + j]; y[j] = xn[q * 4 + j] * rstd * gn[j] * (1.0f + sc[j]) + sh[j]; }
                    *(f32x4*)(xr + col) = xo; u32x2_t wv; wv.x = cvtpk(y[0], y[1]); wv.y = cvtpk(y[2], y[3]); *(u32x2_t*)(Hn + (size_t)t * 1024 + col) = wv; }
            }
        }
        asm volatile("s_waitcnt vmcnt(0) lgkmcnt(0)" ::: "memory");
    }
#undef GR_ISSUE
#undef GR_REFILL
}
DI float red4_sum(float x) { auto a = __builtin_amdgcn_permlane16_swap(__float_as_uint(x), __float_as_uint(x), false, false); x = __uint_as_float(a[0]) + __uint_as_float(a[1]);
    auto b = __builtin_amdgcn_permlane32_swap(__float_as_uint(x), __float_as_uint(x), false, false); return __uint_as_float(b[0]) + __uint_as_float(b[1]); }
DI float red4_max(float x) { auto a = __builtin_amdgcn_permlane16_swap(__float_as_uint(x), __float_as_uint(x), false, false); x = fmaxf(__uint_as_float(a[0]), __uint_as_float(a[1]));
    auto b = __builtin_amdgcn_permlane32_swap(__float_as_uint(x), __float_as_uint(x), false, false); return fmaxf(__uint_as_float(b[0]), __uint_as_float(b[1])); }
DI float red4_min(float x) { auto a = __builtin_amdgcn_permlane16_swap(__float_as_uint(x), __float_as_uint(x), false, false); x = fminf(__uint_as_float(a[0]), __uint_as_float(a[1]));
    auto b = __builtin_amdgcn_permlane32_swap(__float_as_uint(x), __float_as_uint(x), false, false); return fminf(__uint_as_float(b[0]), __uint_as_float(b[1])); }
constexpr int TK_NI = 6;
DI float tk_pivot(float clo, float chi) {
    const float lc = __builtin_amdgcn_logf(clo), lh = __builtin_amdgcn_logf(fmaxf(chi, 0.5f));
    const float f = (lc - 4.0443941f) * __builtin_amdgcn_rcpf(lc - lh);
    return fminf(fmaxf(f, 0.06f), 0.94f);
}
template <int NV> DI float tk_count(const float (&v)[NV], float mid) {
    const float nb = -mid * 1.099511627776e12f;
    float c0 = 0.f, c1 = 0.f, c2 = 0.f, c3 = 0.f;
#pragma unroll
    for (int i = 0; i < NV; i += 4) {
        c0 += __builtin_amdgcn_fmed3f(__builtin_fmaf(v[i], 1.099511627776e12f, nb), 0.f, 1.f); c1 += __builtin_amdgcn_fmed3f(__builtin_fmaf(v[i + 1], 1.099511627776e12f, nb), 0.f, 1.f);
        c2 += __builtin_amdgcn_fmed3f(__builtin_fmaf(v[i + 2], 1.099511627776e12f, nb), 0.f, 1.f); c3 += __builtin_amdgcn_fmed3f(__builtin_fmaf(v[i + 3], 1.099511627776e12f, nb), 0.f, 1.f);
    }
    float c = (c0 + c1) + (c2 + c3);
    return red4_sum(c);
}
template <int NV> DI void tk_search(const float (&v)[NV], float ntot, float& thr_out) {
    float mx = v[0], mn = v[0];
#pragma unroll
    for (int i = 1; i < NV; ++i) { mx = fmaxf(mx, v[i]); mn = fminf(mn, v[i]); }
    mx = red4_max(mx); mn = red4_min(mn);
    float lo = mn, hi = mx, clo = ntot - 1.0f, chi = 0.0f, thr = mn - 1.0f; bool done = false;
#pragma unroll 1
    for (int iter = 0; iter < 48; ++iter) {
        float fr_ = tk_pivot(clo, chi); if (iter >= TK_NI) fr_ = 0.5f;
        const float mid = done ? thr : lo + (hi - lo) * fr_;
        const float cnt = tk_count<NV>(v, mid);
        if (!done) { if (cnt == 16.0f) { thr = mid; done = true; } else if (cnt > 16.0f) { lo = mid; clo = cnt; thr = mid; } else { hi = mid; chi = cnt; } }
        if (__all(done)) break;
    }
    thr_out = thr;
}
DI void tk_search2(const float (&v0)[32], const float (&v1)[32], float& t0, float& t1) {
    float mx0 = v0[0], mn0 = v0[0], mx1 = v1[0], mn1 = v1[0];
#pragma unroll
    for (int i = 1; i < 32; ++i) { mx0 = fmaxf(mx0, v0[i]); mn0 = fminf(mn0, v0[i]); mx1 = fmaxf(mx1, v1[i]); mn1 = fminf(mn1, v1[i]); }
    mx0 = red4_max(mx0); mn0 = red4_min(mn0); mx1 = red4_max(mx1); mn1 = red4_min(mn1);
    float lo0 = mn0, hi0 = mx0, clo0 = 127.0f, chi0 = 0.0f, thr0 = mn0 - 1.0f; bool done0 = false;
    float lo1 = mn1, hi1 = mx1, clo1 = 127.0f, chi1 = 0.0f, thr1 = mn1 - 1.0f; bool done1 = false;
#pragma unroll 1
    for (int iter = 0; iter < 48; ++iter) {
        float f0 = tk_pivot(clo0, chi0), f1 = tk_pivot(clo1, chi1); if (iter >= TK_NI) { f0 = 0.5f; f1 = 0.5f; }
        const float mid0 = done0 ? thr0 : lo0 + (hi0 - lo0) * f0, mid1 = done1 ? thr1 : lo1 + (hi1 - lo1) * f1;
        const float c0 = tk_count<32>(v0, mid0), c1 = tk_count<32>(v1, mid1);
        if (!done0) { if (c0 == 16.0f) { thr0 = mid0; done0 = true; } else if (c0 > 16.0f) { lo0 = mid0; clo0 = c0; thr0 = mid0; } else { hi0 = mid0; chi0 = c0; } }
        if (!done1) { if (c1 == 16.0f) { thr1 = mid1; done1 = true; } else if (c1 > 16.0f) { lo1 = mid1; clo1 = c1; thr1 = mid1; } else { hi1 = mid1; chi1 = c1; } }
        if (__all(done0 && done1)) break;
    }
    t0 = thr0; t1 = thr1;
}
template <int MODE = 0> DI void peer_topk_fused(const Ctx& C, const bf16* QP, const bf16* KEYS, int* IDX, float* GATE) {
    constexpr int KPI = 288;
    const int lane = C.lane, fr = lane & 15, fq = lane >> 4, w = C.wave;
    LAS unsigned char* KS = C.lds;
    LAS unsigned char* WB = C.lds + 73728 + w * 7168;
    LAS float* LV = (LAS float*)(WB);
    LAS int* LK = (LAS int*)(WB + 2176);
    LAS float* FV = (LAS float*)(WB + 4352);
    LAS int* FI = (LAS int*)(WB + 5504);
    LAS float* TRASH = (LAS float*)(WB + 6656) + lane;
    const int h = C.vcu & 7, nb = C.G >> 3;
    { const bf16* kg = KEYS + (size_t)h * 2 * 128 * 128;
      for (int c = C.tid; c < 4096; c += 512) { const int r = c >> 4, cc = c & 15; *(LAS u32x4*)(KS + r * KPI + cc * 16) = *(const u32x4*)(kg + (size_t)r * 128 + cc * 8); } }
    __syncthreads();
    for (int tt = (C.vcu >> 3) + nb * w; tt < 1024; tt += nb * 8) {
        const int tok = tt * 16 + fr;
        float sc0[32], sc1[32];
#pragma unroll
        for (int p = 0; p < 2; ++p) {
            bf16x8 qf[4];
#pragma unroll
            for (int ks = 0; ks < 4; ++ks) qf[ks] = *(const bf16x8*)(QP + (size_t)tok * 2048 + h * 256 + p * 128 + ks * 32 + fq * 8);
#pragma unroll
            for (int kt = 0; kt < 8; ++kt) {
                f32x4 acc = {0.f, 0.f, 0.f, 0.f};
#pragma unroll
                for (int ks = 0; ks < 4; ++ks) { const bf16x8 kf = *(const LAS bf16x8*)(KS + (p * 128 + kt * 16 + fr) * KPI + (ks * 32 + fq * 8) * 2);
                    acc = __builtin_amdgcn_mfma_f32_16x16x32_bf16(kf, qf[ks], acc, 0, 0, 0); }
                if (p == 0) { sc0[kt * 4 + 0] = acc[0]; sc0[kt * 4 + 1] = acc[1]; sc0[kt * 4 + 2] = acc[2]; sc0[kt * 4 + 3] = acc[3]; }
                else { sc1[kt * 4 + 0] = acc[0]; sc1[kt * 4 + 1] = acc[1]; sc1[kt * 4 + 2] = acc[2]; sc1[kt * 4 + 3] = acc[3]; }
            }
        }
        float thrA = 1.0f, thrB = 1.0f; if (MODE == 0) tk_search2(sc0, sc1, thrA, thrB);
#pragma unroll
        for (int p = 0; p < 2; ++p) {
            const float thr = p == 0 ? thrA : thrB;
            int cnt = 0;
#pragma unroll
            for (int i = 0; i < 32; ++i) cnt += ((p == 0 ? sc0[i] : sc1[i]) > thr) ? 1 : 0;
            const int c0 = __shfl(cnt, fr), c1 = __shfl(cnt, fr + 16), c2 = __shfl(cnt, fr + 32);
            int pos = (fq > 0 ? c0 : 0) + (fq > 1 ? c1 : 0) + (fq > 2 ? c2 : 0);
#pragma unroll
            for (int i = 0; i < 32; ++i) { const float vv = p == 0 ? sc0[i] : sc1[i]; const bool s = vv > thr && pos < 16;
                LAS float* pv = s ? (LV + fr * 33 + p * 16 + pos) : TRASH; LAS int* pk = s ? (LK + fr * 33 + p * 16 + pos) : (LAS int*)TRASH;
                *pv = vv; *pk = (i >> 2) * 16 + 4 * fq + (i & 3); pos += (vv > thr) ? 1 : 0; }
        }
        LDS_WAIT();
        float A[4], Bv[16]; int KA[4], KB[16];
#pragma unroll
        for (int a = 0; a < 4; ++a) { A[a] = LV[fr * 33 + 4 * fq + a]; KA[a] = LK[fr * 33 + 4 * fq + a]; }
#pragma unroll
        for (int bq = 0; bq < 16; ++bq) { Bv[bq] = LV[fr * 33 + 16 + bq]; KB[bq] = LK[fr * 33 + 16 + bq]; }
        float sm[64];
#pragma unroll
        for (int a = 0; a < 4; ++a)
#pragma unroll
            for (int bq = 0; bq < 16; ++bq) sm[a * 16 + bq] = A[a] + Bv[bq];
        float thr2 = 4.0f; if (MODE == 0) tk_search<64>(sm, 256.0f, thr2);
        {
            int cnt = 0;
#pragma unroll
            for (int i = 0; i < 64; ++i) cnt += (sm[i] > thr2) ? 1 : 0;
            const int c0 = __shfl(cnt, fr), c1 = __shfl(cnt, fr + 16), c2 = __shfl(cnt, fr + 32);
            int pos = (fq > 0 ? c0 : 0) + (fq > 1 ? c1 : 0) + (fq > 2 ? c2 : 0);
#pragma unroll
            for (int i = 0; i < 64; ++i) { const bool s = sm[i] > thr2 && pos < 16;
                LAS float* pv = s ? (FV + fr * 17 + pos) : TRASH; LAS int* pk = s ? (FI + fr * 17 + pos) : (LAS int*)TRASH;
                *pv = sm[i]; *pk = KA[i >> 4] * 128 + KB[i & 15]; pos += (sm[i] > thr2) ? 1 : 0; }
        }
        LDS_WAIT();
        float x[4]; int xi[4];
#pragma unroll
        for (int j = 0; j < 4; ++j) { x[j] = FV[fr * 17 + 4 * fq + j]; xi[j] = FI[fr * 17 + 4 * fq + j]; }
        float m = red4_max(fmaxf(fmaxf(x[0], x[1]), fmaxf(x[2], x[3])));
        float e[4]; float s = 0.f;
#pragma unroll
        for (int j = 0; j < 4; ++j) { e[j] = __expf(x[j] - m); s += e[j]; }
        s = red4_sum(s);
        const float inv = 1.0f / s;
        const size_t ob = ((size_t)tok * 8 + h) * 16 + 4 * fq;
        typedef int i32x4 __attribute__((ext_vector_type(4)));
        *(i32x4*)(IDX + ob) = (i32x4){xi[0], xi[1], xi[2], xi[3]}; *(f32x4*)(GATE + ob) = (f32x4){e[0] * inv, e[1] * inv, e[2] * inv, e[3] * inv};
        LDS_WAIT();
    }
}
DI void intra_mfma(const Ctx& C, const bf16* Q, const bf16* K, const bf16* V, const bf16* CROSS, bf16* G) {
    constexpr int RPI = 544, PPI = 144, VPI = 544;
    LAS unsigned char* Qs = C.lds; LAS unsigned char* Ks = Qs + 64 * RPI; LAS unsigned char* Ps = Ks + 64 * RPI; LAS unsigned char* Vs = Ps + 64 * PPI;
    LAS float* red = (LAS float*)(Vs + 64 * VPI);
    const int tid = C.tid, lane = C.lane, w = C.wave, fr = lane & 15, fq = lane >> 4;
    for (int item = C.vcu; item < 1024; item += C.G) {
        const int b = item >> 9, h = (item >> 7) & 3, n = item & 127;
        const float lg2 = log2f(1.0f - exp2f(-5.0f - (float)h));
        const size_t tok0 = (size_t)b * SEQ + (size_t)n * 64;
#pragma unroll
        for (int u = 0; u < 4; ++u) { const int c = tid + 512 * u, r = c >> 5, cc = c & 31;
            *(LAS u32x4*)(Qs + r * RPI + cc * 16) = *(const u32x4*)(Q + (tok0 + r) * 1024 + h * 256 + cc * 8);
            *(LAS u32x4*)(Ks + r * RPI + cc * 16) = *(const u32x4*)(K + (tok0 + r) * 1024 + h * 256 + cc * 8);
            *(LAS u32x4*)(Vs + r * VPI + cc * 16) = *(const u32x4*)(V + (tok0 + r) * 2048 + h * 512 + cc * 8); }
        __syncthreads();
        { const int jt = w >> 1; f32x4 sa[2] = {(f32x4){0.f, 0.f, 0.f, 0.f}, (f32x4){0.f, 0.f, 0.f, 0.f}};
#pragma unroll
          for (int ks = 0; ks < 8; ++ks) { const bf16x8 kf = *(const LAS bf16x8*)(Ks + (16 * jt + fr) * RPI + (32 * ks + 8 * fq) * 2);
#pragma unroll
              for (int q = 0; q < 2; ++q) { const int it = 2 * (w & 1) + q; const bf16x8 qf = *(const LAS bf16x8*)(Qs + (16 * it + fr) * RPI + (32 * ks + 8 * fq) * 2);
                  sa[q] = __builtin_amdgcn_mfma_f32_16x16x32_bf16(kf, qf, sa[q], 0, 0, 0); } }
#pragma unroll
          for (int q = 0; q < 2; ++q) { const int i = 16 * (2 * (w & 1) + q) + fr, j0 = 16 * jt + 4 * fq; float pv[4];
#pragma unroll
              for (int r = 0; r < 4; ++r) { const int dd = i > j0 + r ? i - j0 - r : j0 + r - i; pv[r] = sa[q][r] * exp2f(lg2 * (float)dd); }
              u32x2_t o; o.x = cvtpk(pv[0], pv[1]); o.y = cvtpk(pv[2], pv[3]); *(LAS u32x2_t*)(Ps + i * PPI + j0 * 2) = o; } }
        __syncthreads();
        f32x4 acc[2][2][4];
#pragma unroll
        for (int hf = 0; hf < 2; ++hf) {
#pragma unroll
            for (int et = 0; et < 2; ++et)
#pragma unroll
                for (int it = 0; it < 4; ++it) acc[hf][et][it] = (f32x4){0.f, 0.f, 0.f, 0.f};
            if (hf == 1) { __syncthreads();
#pragma unroll
                for (int u = 0; u < 4; ++u) { const int c = tid + 512 * u, r = c >> 5, cc = c & 31;
                    *(LAS u32x4*)(Vs + r * VPI + cc * 16) = *(const u32x4*)(V + (tok0 + r) * 2048 + h * 512 + 256 + cc * 8); }
                __syncthreads(); }
#pragma unroll
            for (int ks = 0; ks < 2; ++ks) {
                bf16x8 pf[4];
#pragma unroll
                for (int it = 0; it < 4; ++it) { const LAS unsigned char* pp = Ps + (16 * it + fr) * PPI + (32 * ks + 4 * fq) * 2;
                    const u32x2_t lo = *(const LAS u32x2_t*)pp, hi = *(const LAS u32x2_t*)(pp + 32); u32x4 ww; ww.x = lo.x; ww.y = lo.y; ww.z = hi.x; ww.w = hi.y; pf[it] = __builtin_bit_cast(bf16x8, ww); }
#pragma unroll
                for (int et = 0; et < 2; ++et) { const LAS unsigned char* vp = Vs + (32 * ks + 4 * fq + (fr >> 2)) * VPI + (32 * w + 16 * et + 4 * (fr & 3)) * 2;
                    const bf16x8 vf = cat8(trr(vp), trr(vp + 16 * VPI));
#pragma unroll
                    for (int it = 0; it < 4; ++it) acc[hf][et][it] = __builtin_amdgcn_mfma_f32_16x16x32_bf16(vf, pf[it], acc[hf][et][it], 0, 0, 0); }
            }
        }
        float ssq[4] = {0.f, 0.f, 0.f, 0.f};
#pragma unroll
        for (int hf = 0; hf < 2; ++hf)
#pragma unroll
            for (int et = 0; et < 2; ++et)
#pragma unroll
                for (int it = 0; it < 4; ++it) { const u32x2_t cv = *(const u32x2_t*)(CROSS + (tok0 + 16 * it + fr) * 2048 + h * 512 + hf * 256 + 32 * w + 16 * et + 4 * fq);
                    f32x4 y = acc[hf][et][it]; y[0] += bflo(cv.x); y[1] += bfhi(cv.x); y[2] += bflo(cv.y); y[3] += bfhi(cv.y); acc[hf][et][it] = y;
                    ssq[it] += (y[0] * y[0] + y[1] * y[1]) + (y[2] * y[2] + y[3] * y[3]); }
#pragma unroll
        for (int it = 0; it < 4; ++it) { float s = ssq[it]; s += __shfl_xor(s, 16); s += __shfl_xor(s, 32); if (fq == 0) red[w * 64 + 16 * it + fr] = s; }
        __syncthreads();
        float rs[4];
#pragma unroll
        for (int it = 0; it < 4; ++it) { float s = 0.f;
#pragma unroll
            for (int ww = 0; ww < 8; ++ww) s += red[ww * 64 + 16 * it + fr];
            rs[it] = 1.0f / sqrtf(s * (1.0f / 512.0f) + EPS); }
#pragma unroll
        for (int hf = 0; hf < 2; ++hf)
#pragma unroll
            for (int et = 0; et < 2; ++et)
#pragma unroll
                for (int it = 0; it < 4; ++it) { bf16* gp = G + (tok0 + 16 * it + fr) * 2048 + h * 512 + hf * 256 + 32 * w + 16 * et + 4 * fq; const u32x2_t gv = *(const u32x2_t*)gp;
                    const f32x4 y = acc[hf][et][it] * rs[it]; u32x2_t o; o.x = cvtpk(y[0] * bflo(gv.x), y[1] * bfhi(gv.x)); o.y = cvtpk(y[2] * bflo(gv.y), y[3] * bfhi(gv.y)); *(u32x2_t*)gp = o; }
        __syncthreads();
    }
}
#ifndef PHMASK
#define PHMASK 0xFFFFFFu
#endif
#define PH(k) ((PHMASK >> (k)) & 1u)
#ifdef USE_SGU_NAIVE
#define SGU_GATE_FN sgu_gate_naive
#else
#define SGU_GATE_FN sgu_gate_mfma
#endif
#ifdef USE_GATHER_TOKEN
#define GATHER_FN peer_gather8
#else
#ifdef USE_GATHER_ROUNDS
#define GATHER_FN peer_gather_rounds
#else
#define GATHER_FN peer_gather_dma
#endif
#endif
#ifndef DUP_GATHER_SKIP
#define DUP_GATHER_SKIP 0
#endif
#ifndef DUP_GATHER_FAKE
#define DUP_GATHER_FAKE false
#endif
struct Args { const void* in[21]; float* out; unsigned char* ws; };
__global__ void __launch_bounds__(NWAVES * 64, 2) mk_fwd(Args args) {
    extern __shared__ __attribute__((aligned(16))) unsigned char lds[];
    Ctx C; C.lds = (LAS unsigned char*)lds; C.tid = threadIdx.x; C.lane = C.tid & 63; C.wave = __builtin_amdgcn_readfirstlane(C.tid >> 6);
    C.G = gridDim.x; { const int bx = blockIdx.x; C.vcu = (C.G % 8 == 0) ? (bx % 8) * (C.G / 8) + bx / 8 : bx; }
    C.ws = args.ws;
    volatile LAS unsigned* MISC = (volatile LAS unsigned*)(C.lds + MISC_OFF);
    gu32* ctl = (gu32*)(args.ws + WS_CTL);
    for (int u = C.tid; u < (LDS_BYTES - LDSCTL_OFF) / 4; u += NWAVES * 64) ((LAS unsigned*)(C.lds + LDSCTL_OFF))[u] = 0u;
    __syncthreads();
    XcdBarrier bar = xcd_barrier_post((unsigned*)(ctl + CW_BAR), MISC + 8);
#define GRID_BAR() do { xcd_barrier(bar); asm volatile("" : "+v"(C.tid)); C.lane = C.tid & 63; C.wave = __builtin_amdgcn_readfirstlane(C.tid >> 6); } while (0)
    { LAS unsigned long long* PT = (LAS unsigned long long*)(C.lds + PTR_OFF);
      if (C.tid == 0) {
#pragma unroll
          for (int i = 0; i < 21; ++i) PT[i] = (unsigned long long)args.in[i];
      } }
    __syncthreads();
#define INP(T, i) ((const T*)ldp(C, i))
    float* out = args.out; unsigned char* ws = args.ws;
#define MODP ((float*)(ws + WS_MOD))
#define MOD0 ((const float*)(ws + WS_MOD))
#define MOD1 ((const float*)(ws + WS_MOD) + 2 * 6144)
#define cosT ((float*)(ws + WS_COS))
#define sinT ((float*)(ws + WS_SIN))
#define WRI ((bf16*)(ws + WS_WRI))
#define WRO ((bf16*)(ws + WS_WRO))
#define WSI ((bf16*)(ws + WS_WSI))
#define WSO ((bf16*)(ws + WS_WSO))
#define WQ ((bf16*)(ws + WS_WQ))
#define KEYS ((bf16*)(ws + WS_KEYS))
#define STATS ((float*)(ws + WS_STATS))
#define IDX ((int*)(ws + WS_IDX))
#define GATE ((float*)(ws + WS_GATE))
#define H ((bf16*)(ws + WS_H))
#define PU8 ((const unsigned char*)(ws + WS_PU))
#define PV8 ((const unsigned char*)(ws + WS_PV))
#define ISU ((const float*)(ws + WS_ISU))
#define ISV ((const float*)(ws + WS_ISV))
#define Qb ((bf16*)(ws + WS_Q))
#define Kb ((bf16*)(ws + WS_K))
#define Vb ((bf16*)(ws + WS_V))
#define Gb ((bf16*)(ws + WS_G))
#define CROSS ((bf16*)(ws + WS_CROSS))
#define QP ((bf16*)(ws + WS_QP))
#define SCO ((float*)(ws + WS_SC))
#define Ub ((bf16*)(ws + WS_U))
#define VBb ((bf16*)(ws + WS_VB))

    { P0In I; I.c = INP(float, 1); I.ada_w = INP(float, 5); I.ada_b = INP(float, 6); I.ret_w_in = INP(float, 7); I.ret_w_out = INP(float, 8); I.sgu_w_in = INP(float, 9); I.sgu_w_out = INP(float, 15); I.wq = INP(float, 16); I.keys = INP(float, 17); I.pu = INP(float, 18); I.pv = INP(float, 19); I.pos = INP(int, 2);
#ifdef DUP_P0
      p0_prologue(C, I);
      GRID_BAR();
#endif
      if (PH(0)) p0_prologue(C, I); }
    GRID_BAR();
    if (PH(1)) rms_mod_phase(C, INP(float, 0), INP(float, 3), MOD0, 0, 1024, H);
    GRID_BAR();
    { pg8::Gemm g{H, WRI, TT, 6144, 1024}; pg8::StaticOrder S; S.init(TT, 6144, C.G, (int)blockIdx.x);
      pg8::EpiRetProj E{Qb, Kb, Vb, Gb, cosT, sinT};
#ifdef DUP_G1
      pg8::gemm_phase<pg8::EpiRetProj, pg8::StaticOrder, true, true>(C.lds + RING_OFF, g, S, E); GRID_BAR();
#endif
      if (PH(2)) pg8::gemm_phase<pg8::EpiRetProj, pg8::StaticOrder, true, true>(C.lds + RING_OFF, g, S, E); }
    GRID_BAR();
    #ifdef USE_SCAN_NAIVE
    if (PH(3)) scan_naive(C, Qb, Kb, Vb, CROSS);
#else
#ifdef DUP_SCAN
    scan_mfma<DUP_SCAN>(C, Qb, Kb, Vb, CROSS);
    GRID_BAR();
#endif
    if (C.vcu < SCAN_NIT) { if (PH(3)) scan_mfma<0>(C, Qb, Kb, Vb, CROSS); }
    else { P0In I; I.c = nullptr; I.ada_w = nullptr; I.ada_b = nullptr; I.ret_w_in = nullptr; I.ret_w_out = nullptr; I.sgu_w_in = INP(float, 9); I.sgu_w_out = INP(float, 15); I.wq = INP(float, 16); I.keys = nullptr; I.pu = INP(float, 18); I.pv = INP(float, 19); I.pos = nullptr;
      side_work(C, I, SCAN_NIT); }
#endif
    GRID_BAR();
#ifdef USE_INTRA_NAIVE
    if (PH(4)) intra_naive(C, Qb, Kb, Vb, CROSS, Gb);
#else
    if (PH(4)) intra_mfma(C, Qb, Kb, Vb, CROSS, Gb);
#endif
    GRID_BAR();
    { pg8::Gemm g{Gb, WRO, TT, 1024, 2048}; pg8::StaticOrder S; S.init(TT, 1024, C.G, (int)blockIdx.x);
      pg8::EpiResGate E{INP(float, 0), out, MOD0 + 2048, 6144};
      if (PH(5)) pg8::gemm_phase<pg8::EpiResGate, pg8::StaticOrder, true, true>(C.lds + RING_OFF, g, S, E); }
    GRID_BAR();
    if (PH(6)) rms_mod_phase(C, out, INP(float, 4), MOD0, 3072, 4096, H);
    GRID_BAR();
    { pg8::Gemm g{H, WQ, TT, 2048, 1024}; pg8::StaticOrder S; S.init(TT, 2048, C.G, (int)blockIdx.x);
      pg8::EpiBf16<0> E{QP, 2048, nullptr, 0, 0, 1.f};
      if (PH(7)) pg8::gemm_phase<pg8::EpiBf16<0>, pg8::StaticOrder, true, true>(C.lds + RING_OFF, g, S, E); }
    GRID_BAR();
#ifdef USE_TOPK_NAIVE
    if (PH(8)) peer_scores(C, QP, KEYS, SCO);
    GRID_BAR();
    if (PH(9)) peer_topk(C, SCO, IDX, GATE);
#else
#ifdef DUP_TOPK
    peer_topk_fused<DUP_TOPK>(C, QP, KEYS, IDX, GATE);
    GRID_BAR();
#endif
    if (PH(9)) peer_topk_fused<0>(C, QP, KEYS, IDX, GATE);
#endif
    GRID_BAR();
#ifdef DUP_GATHER
    GATHER_FN<false, DUP_GATHER_FAKE, DUP_GATHER_SKIP>(C, H, IDX, GATE, PU8, PV8, ISU, ISV, (float*)(ws + WS_R), MOD0 + 5120, INP(float, 3) + 1024, MOD1, (bf16*)(ws + WS_R + 128 * MiB));
    GRID_BAR();
#endif
    if (PH(10)) GATHER_FN<false>(C, H, IDX, GATE, PU8, PV8, ISU, ISV, out, MOD0 + 5120, INP(float, 3) + 1024, MOD1, H);
    GRID_BAR();
#ifdef DUP_BAR
    for (int q_ = 0; q_ < 10; ++q_) GRID_BAR();
#endif
    { pg8::Gemm g{H, WSI, TT, 6144, 1024}; pg8::StaticOrder S; S.init(TT, 6144, C.G, (int)blockIdx.x);
      pg8::EpiSguIn E{Ub, VBb, INP(float, 10), STATS};
#ifdef DUP_G7
      pg8::gemm_phase<pg8::EpiSguIn, pg8::StaticOrder, true, true>(C.lds + RING_OFF, g, S, E); GRID_BAR();
#endif
      if (PH(11)) pg8::gemm_phase<pg8::EpiSguIn, pg8::StaticOrder, true, true>(C.lds + RING_OFF, g, S, E); }
    GRID_BAR();
    if (PH(12)) SGU_GATE_FN(C, Ub, VBb, STATS, INP(float, 13), INP(float, 14), INP(float, 11), INP(float, 12));
    GRID_BAR();
    { pg8::Gemm g{Ub, WSO, TT, 1024, 3072}; pg8::StaticOrder S; S.init(TT, 1024, C.G, (int)blockIdx.x);
      pg8::EpiResGate E{out, out, MOD1 + 2048, 6144};
      if (PH(13)) pg8::gemm_phase<pg8::EpiResGate, pg8::StaticOrder, true, true>(C.lds + RING_OFF, g, S, E); }
    GRID_BAR();
    if (PH(14)) rms_mod_phase(C, out, INP(float, 4) + 1024, MOD1, 3072, 4096, H);
    GRID_BAR();
    { pg8::Gemm g{H, WQ + (size_t)2048 * 1024, TT, 2048, 1024}; pg8::StaticOrder S; S.init(TT, 2048, C.G, (int)blockIdx.x);
      pg8::EpiBf16<0> E{QP, 2048, nullptr, 0, 0, 1.f};
      if (PH(15)) pg8::gemm_phase<pg8::EpiBf16<0>, pg8::StaticOrder, true, true>(C.lds + RING_OFF, g, S, E); }
    GRID_BAR();
#ifdef USE_TOPK_NAIVE
    if (PH(16)) peer_scores(C, QP, KEYS + (size_t)8 * 2 * 128 * 128, SCO);
    GRID_BAR();
    if (PH(17)) peer_topk(C, SCO, IDX, GATE);
#else
    if (PH(17)) peer_topk_fused<0>(C, QP, KEYS + (size_t)8 * 2 * 128 * 128, IDX, GATE);
#endif
    GRID_BAR();
    if (PH(18)) GATHER_FN<true>(C, H, IDX, GATE, PU8 + (size_t)16384 * 1024, PV8 + (size_t)16384 * 1024, ISU + 16384, ISV + 16384, out, MOD1 + 5120, INP(float, 20), nullptr, nullptr);
#undef GRID_BAR
}

extern "C" void kernel_launch(void* const* d_in, const int* in_sizes, int n_in, void* d_out, int out_size, void* d_ws, size_t ws_size, hipStream_t stream) {
    static int grid = 0;
    if (grid == 0) {
        if (n_in != 21 || in_sizes[0] != TT * DM || out_size != TT * DM || ws_size < WS_END) { fprintf(stderr, "kernel_launch: unexpected shapes/workspace: n_in %d in0 %d out %d ws %zu (need %zu)\n", n_in, n_in > 0 ? in_sizes[0] : -1, out_size, ws_size, (size_t)WS_END); grid = -1; return; }
        int dev = 0, cus = 0;
        if (hipGetDevice(&dev) != hipSuccess || hipDeviceGetAttribute(&cus, hipDeviceAttributeMultiprocessorCount, dev) != hipSuccess) { fprintf(stderr, "kernel_launch: device query failed\n"); grid = -1; return; }
        if (hipFuncSetAttribute((const void*)mk_fwd, hipFuncAttributeMaxDynamicSharedMemorySize, LDS_BYTES) != hipSuccess) { fprintf(stderr, "kernel_launch: hipFuncSetAttribute failed\n"); grid = -1; return; }
        (void)hipGetLastError();
        grid = cus;
    }
    if (grid < 0) return;
    if (hipMemsetAsync((char*)d_ws + WS_CTL, 0, CTL_ZERO_BYTES, stream) != hipSuccess) { fprintf(stderr, "kernel_launch: memset failed\n"); return; }
    Args a; memset(&a, 0, sizeof(a));
    for (int i = 0; i < 21; ++i) a.in[i] = d_in[i];
    a.out = (float*)d_out; a.ws = (unsigned char*)d_ws;
    hipLaunchKernelGGL(mk_fwd, dim3(grid), dim3(NWAVES * 64), LDS_BYTES, stream, a);
    const hipError_t le = hipPeekAtLastError();
    if (le != hipSuccess) fprintf(stderr, "kernel_launch: launch failed: %s\n", hipGetErrorName(le));
}
```

```cpp
#define USE_GATHER_ROUNDS 1
#include <hip/hip_runtime.h>
#include <cstdio>
#include <cstdint>
#include <cstring>
#include <cmath>
namespace pg8 {
#define PG8_LAS __attribute__((address_space(3)))
typedef unsigned short bf16_t;
typedef short bf16x8 __attribute__((ext_vector_type(8)));
typedef float f32x4 __attribute__((ext_vector_type(4)));
typedef unsigned u32x4 __attribute__((ext_vector_type(4)));
constexpr int BM = 256, BK = 64, HALF = 128, HTB = HALF * BK * 2  , STAGE_BYTES = 8 * HTB, NXCD = 8, WGM = 8;

__host__ __device__ __forceinline__ int lds_byte(int r, int c) { const int st = (r >> 4) * 2 + (c >> 5), rr = r & 15, cc = c & 31, ob = rr * 64 + cc * 2; return st * 1024 + (ob ^ (((ob >> 9) & 1) << 5)); }
__host__ __device__ __forceinline__ void stage_rc(int b, int& R, int& C) { const int st = b / 1024, sb = b % 1024, swz = sb ^ (((sb >> 9) & 1) << 5); R = (st >> 1) * 16 + swz / 64; C = (st & 1) * 32 + (swz % 64) / 2; }
__host__ __device__ __forceinline__ int perm32(int rho) { const int n = rho >> 4, i = rho & 15; return 8 * (i >> 2) + 4 * n + (i & 3); }

struct Unit { int pm, pn; };
struct Gemm { const bf16_t* A; const bf16_t* Bt; int M, N, K; };

struct StaticOrder {
    int nM, nN, nwg, G, c;
    __host__ __device__ void init(int M, int N, int G_, int c_) { nM = M / BM; nN = N / BM; nwg = nM * nN; G = G_; c = c_; }
    __host__ __device__ bool next(int i, Unit& u) const {
        const long L = (long)i * G + c; if (L >= nwg) return false;
        int wgid = (int)L; { const int q = nwg / NXCD, r = nwg % NXCD, xcd = wgid % NXCD, off = wgid / NXCD; wgid = (xcd < r ? xcd * (q + 1) : r * (q + 1) + (xcd - r) * q) + off; }
        const int nig = WGM * nN, gid = wgid / nig, fm = gid * WGM, gsz = (nM - fm) < WGM ? (nM - fm) : WGM;
        u.pm = fm + ((wgid % nig) % gsz); u.pn = (wgid % nig) / gsz; return true;
    }
    __device__ __forceinline__ void a_ready(const Unit&) const {}
    __device__ __forceinline__ void done(const Unit&) const {}
};

__device__ __forceinline__ unsigned cvt_pk_bf16(float lo, float hi) { unsigned r; asm volatile("v_cvt_pk_bf16_f32 %0, %1, %2" : "=v"(r) : "v"(lo), "v"(hi)); return r; }
typedef float f32x2 __attribute__((ext_vector_type(2)));
__device__ __forceinline__ f32x2 gelu_pk(f32x2 v) {
    const f32x2 av = __builtin_elementwise_abs(v), d = av * 0.2316418882f + 1.0f;
    f32x2 t; t.x = __builtin_amdgcn_rcpf(d.x); t.y = __builtin_amdgcn_rcpf(d.y);
    f32x2 q = t * 0.5307027145f + (-0.7265760135f); q = q * t + 0.7107068705f; q = q * t + (-0.142248368f); q = q * t + 0.127414796f; q = q * t;
    const f32x2 s = (v * v) * (-0.72134752044f);
    f32x2 e; e.x = __builtin_amdgcn_exp2f(s.x); e.y = __builtin_amdgcn_exp2f(s.y);
    const f32x2 m = v * (q * e), r = v - m;
    f32x2 o; o.x = v.x < 0.f ? m.x : r.x; o.y = v.y < 0.f ? m.y : r.y; return o;
}

template <int ACT  > struct EpiBf16 {
    static constexpr bool PERM = true, AFTER_DRAIN = false; static_assert(ACT == 0 || ACT == 1, "EpiBf16: ACT is 0 (none) or 1 (gelu_pk)");
    bf16_t* O; int ldc; const float* bias; int split_cols; size_t split_stride; float scale0;
    __device__ __forceinline__ void operator()(const f32x4 (&acc)[2][2][4][2], const Unit& u, int wr, int wc, int fr, int fq) const {
        const int row0 = u.pm * BM + wr * 64 + fr; int colt = u.pn * BM; bf16_t* base = O;
        float sc = 1.f; if (split_cols) { const int t = colt / split_cols; base += (size_t)t * split_stride; colt -= t * split_cols; if (t == 0) sc = scale0; }
        const int col0 = colt + wc * 32 + 8 * fq, bcol0 = u.pn * BM + wc * 32 + 8 * fq;
        f32x4 bv[2][2];
#pragma unroll
        for (int bj = 0; bj < 2; ++bj)
#pragma unroll
            for (int n = 0; n < 2; ++n) bv[bj][n] = bias ? *(const f32x4*)(bias + bcol0 + bj * HALF + 4 * n) : (f32x4){0.f, 0.f, 0.f, 0.f};
#pragma unroll
        for (int ai = 0; ai < 2; ++ai)
#pragma unroll
            for (int m = 0; m < 4; ++m) { bf16_t* rowp = base + (size_t)(row0 + ai * HALF + m * 16) * ldc + col0;
#pragma unroll
                for (int bj = 0; bj < 2; ++bj) { f32x4 v0 = acc[ai][bj][m][0] + bv[bj][0], v1 = acc[ai][bj][m][1] + bv[bj][1];
                    if (ACT == 1) { f32x2 a = gelu_pk((f32x2){v0[0], v0[1]}), b = gelu_pk((f32x2){v0[2], v0[3]}), c = gelu_pk((f32x2){v1[0], v1[1]}), d = gelu_pk((f32x2){v1[2], v1[3]});
                        v0 = (f32x4){a.x, a.y, b.x, b.y}; v1 = (f32x4){c.x, c.y, d.x, d.y}; }
                    v0 = v0 * sc; v1 = v1 * sc; u32x4 w; w.x = cvt_pk_bf16(v0[0], v0[1]); w.y = cvt_pk_bf16(v0[2], v0[3]); w.z = cvt_pk_bf16(v1[0], v1[1]); w.w = cvt_pk_bf16(v1[2], v1[3]);
                    *(u32x4*)(rowp + bj * HALF) = w; } }
    }
};
template <class Epi, class Sched, bool ALIGN_EPI = false, bool SP2 = false>
__device__ __forceinline__ void gemm_phase(PG8_LAS unsigned char* lds, const Gemm g, const Sched& S, const Epi& E) {
    int tid_ = threadIdx.x; asm volatile("" : "+v"(tid_));
    const int tid = tid_, wid = __builtin_amdgcn_readfirstlane(tid >> 6), lane = tid & 63, wr = wid >> 2, wc = wid & 3, fr = lane & 15, fq = lane >> 4;
    const int K = g.K, nt = K / BK;
    unsigned voffA[2], voffB[2];
#pragma unroll
    for (int i = 0; i < 2; ++i) { int R, C; stage_rc(tid * 16 + i * 8192, R, C); const int Rb = Epi::PERM ? ((R & ~31) + perm32(R & 31)) : R;
        voffA[i] = (unsigned)(R * K + C) * 2u; voffB[i] = (unsigned)(Rb * K + C) * 2u; }
    const size_t kstep = (size_t)(BK * 2);
    const size_t hstep = (size_t)HALF * K * 2;
    const size_t tstep = 2 * hstep;
    const unsigned ldsw = (unsigned)wid * 1024u;
    const int aoff = lds_byte(wr * 64 + fr, fq * 8), boff = lds_byte(wc * 32 + fr, fq * 8);
#define PG8_SA(b, h) (((b) * 2 + (h)) * HTB)
#define PG8_SB(b, h) ((4 + (b) * 2 + (h)) * HTB)
#define PG8_STAGE(bufoff, gbase, voff) do { _Pragma("unroll") for (int _i = 0; _i < 2; ++_i) \
        __builtin_amdgcn_global_load_lds((const unsigned*)((const char*)(gbase) + (voff)[_i]), (PG8_LAS unsigned*)(lds + (bufoff) + ldsw + _i * 8192), 16, 0, 0); } while (0)
#define PG8_LDA(dst, b, h) do { _Pragma("unroll") for (int m = 0; m < 4; ++m) _Pragma("unroll") for (int k = 0; k < 2; ++k) dst[m][k] = *(const PG8_LAS bf16x8*)(lds + PG8_SA(b, h) + aoff + m * 2048 + k * 1024); } while (0)
#define PG8_LDB(dst, b, h) do { _Pragma("unroll") for (int n = 0; n < 2; ++n) _Pragma("unroll") for (int k = 0; k < 2; ++k) dst[n][k] = *(const PG8_LAS bf16x8*)(lds + PG8_SB(b, h) + boff + n * 2048 + k * 1024); } while (0)
#define PG8_MMA(ai, bj, At, Bt) do { __builtin_amdgcn_s_setprio(1); _Pragma("unroll") for (int m = 0; m < 4; ++m) _Pragma("unroll") for (int n = 0; n < 2; ++n) _Pragma("unroll") for (int k = 0; k < 2; ++k) \
        acc[ai][bj][m][n] = __builtin_amdgcn_mfma_f32_16x16x32_bf16(Bt[n][k], At[m][k], acc[ai][bj][m][n], 0, 0, 0); __builtin_amdgcn_s_setprio(0); } while (0)
#define PG8_WAIT_V(n) asm volatile("s_waitcnt vmcnt(" #n ")" ::: "memory")
#define PG8_WAIT_L(n) asm volatile("s_waitcnt lgkmcnt(" #n ")" ::: "memory")
#define PG8_BAR __builtin_amdgcn_s_barrier()
#define PG8_SCHED __builtin_amdgcn_sched_barrier(0)
    Unit cur, nxt; int ui = 0;
    if (!S.next(0, cur)) return;
    f32x4 acc[2][2][4][2];
#pragma unroll
    for (int a = 0; a < 2; ++a)
#pragma unroll
        for (int b = 0; b < 2; ++b)
#pragma unroll
            for (int m = 0; m < 4; ++m)
#pragma unroll
                for (int n = 0; n < 2; ++n) acc[a][b][m][n] = (f32x4){0.f, 0.f, 0.f, 0.f};
    bf16x8 At[4][2], B0[2][2], B1[2][2];
    const char* cA = (const char*)g.A + (size_t)cur.pm * tstep; const char* cB = (const char*)g.Bt + (size_t)cur.pn * tstep;
    S.a_ready(cur);
    if constexpr (SP2) {
        PG8_STAGE(PG8_SB(0, 0), cB, voffB); PG8_STAGE(PG8_SB(0, 1), cB + hstep, voffB); PG8_STAGE(PG8_SA(0, 0), cA, voffA); PG8_STAGE(PG8_SA(0, 1), cA + hstep, voffA);
        if (wr == 1) PG8_BAR;
        PG8_WAIT_V(2); PG8_BAR;
        PG8_STAGE(PG8_SB(1, 0), cB + kstep, voffB); PG8_STAGE(PG8_SA(1, 0), cA + kstep, voffA); PG8_STAGE(PG8_SB(1, 1), cB + hstep + kstep, voffB);
        PG8_WAIT_V(6); PG8_BAR;
    } else {
        PG8_STAGE(PG8_SB(0, 0), cB, voffB); PG8_STAGE(PG8_SA(0, 0), cA, voffA); PG8_STAGE(PG8_SB(0, 1), cB + hstep, voffB); PG8_STAGE(PG8_SA(0, 1), cA + hstep, voffA);
        if (wr == 1) PG8_BAR;
        PG8_WAIT_V(4); PG8_BAR;
        PG8_STAGE(PG8_SB(1, 0), cB + kstep, voffB); PG8_STAGE(PG8_SA(1, 0), cA + kstep, voffA); PG8_STAGE(PG8_SB(1, 1), cB + hstep + kstep, voffB);
        PG8_WAIT_V(6); PG8_BAR;
    }
    for (;;) {
        const bool has_next = S.next(ui + 1, nxt);
        const char* nA = has_next ? (const char*)g.A + (size_t)nxt.pm * tstep : cA; const char* nB = has_next ? (const char*)g.Bt + (size_t)nxt.pn * tstep : cB;
        for (int t = 0; t < nt; t += 2) {
            const bool last = (t == nt - 2);
            const char* a1 = cA + (size_t)(t + 1) * kstep;
            const char* a2 = last ? nA : cA + (size_t)(t + 2) * kstep; const char* b2 = last ? nB : cB + (size_t)(t + 2) * kstep;
            const char* a3 = a2 + kstep; const char* b3 = b2 + kstep;
            if (last && has_next) S.a_ready(nxt);
            if constexpr (SP2) {
            PG8_LDB(B0, 0, 0); PG8_LDB(B1, 0, 1); PG8_SCHED; PG8_LDA(At, 0, 0); PG8_STAGE(PG8_SA(1, 1), a1 + hstep, voffA);
            PG8_WAIT_V(8); PG8_WAIT_L(0); PG8_BAR; PG8_MMA(0, 0, At, B0); PG8_MMA(0, 1, At, B1); PG8_BAR; PG8_SCHED;
            PG8_LDA(At, 0, 1); PG8_STAGE(PG8_SB(0, 0), b2, voffB); PG8_STAGE(PG8_SB(0, 1), b2 + hstep, voffB); PG8_STAGE(PG8_SA(0, 0), a2, voffA);
            PG8_WAIT_V(8); PG8_WAIT_L(0); PG8_BAR; PG8_MMA(1, 0, At, B0); PG8_MMA(1, 1, At, B1); PG8_BAR; PG8_SCHED;
            PG8_LDB(B0, 1, 0); PG8_LDB(B1, 1, 1); PG8_SCHED; PG8_LDA(At, 1, 0); PG8_STAGE(PG8_SA(0, 1), a2 + hstep, voffA);
            PG8_WAIT_V(8); PG8_WAIT_L(0); PG8_BAR; PG8_MMA(0, 0, At, B0); PG8_MMA(0, 1, At, B1); PG8_BAR; PG8_SCHED;
            PG8_LDA(At, 1, 1); PG8_STAGE(PG8_SB(1, 0), b3, voffB); PG8_STAGE(PG8_SB(1, 1), b3 + hstep, voffB); PG8_STAGE(PG8_SA(1, 0), a3, voffA);
            PG8_WAIT_V(8); PG8_WAIT_L(0); PG8_BAR; PG8_MMA(1, 0, At, B0); PG8_MMA(1, 1, At, B1); PG8_BAR; PG8_SCHED;
            } else {
            PG8_LDB(B0, 0, 0); PG8_SCHED; PG8_LDA(At, 0, 0); PG8_STAGE(PG8_SA(1, 1), a1 + hstep, voffA);
            PG8_WAIT_L(8); PG8_BAR; PG8_WAIT_L(0); PG8_MMA(0, 0, At, B0); PG8_BAR; PG8_SCHED;
            PG8_LDB(B1, 0, 1); PG8_STAGE(PG8_SB(0, 0), b2, voffB);
            PG8_BAR; PG8_WAIT_L(0); PG8_MMA(0, 1, At, B1); PG8_BAR;
            PG8_LDA(At, 0, 1); PG8_STAGE(PG8_SA(0, 0), a2, voffA);
            PG8_BAR; PG8_WAIT_L(0); PG8_MMA(1, 0, At, B0); PG8_BAR; PG8_SCHED;
            PG8_STAGE(PG8_SB(0, 1), b2 + hstep, voffB);
            PG8_WAIT_V(6); PG8_BAR; PG8_MMA(1, 1, At, B1); PG8_BAR;
            PG8_LDB(B0, 1, 0); PG8_SCHED; PG8_LDA(At, 1, 0); PG8_STAGE(PG8_SA(0, 1), a2 + hstep, voffA);
            PG8_WAIT_L(8); PG8_BAR; PG8_WAIT_L(0); PG8_MMA(0, 0, At, B0); PG8_BAR; PG8_SCHED;
            PG8_LDB(B1, 1, 1); PG8_STAGE(PG8_SB(1, 0), b3, voffB);
            PG8_BAR; PG8_WAIT_L(0); PG8_MMA(0, 1, At, B1); PG8_BAR;
            PG8_LDA(At, 1, 1); PG8_STAGE(PG8_SA(1, 0), a3, voffA);
            PG8_BAR; PG8_WAIT_L(0); PG8_MMA(1, 0, At, B0); PG8_BAR; PG8_SCHED;
            PG8_STAGE(PG8_SB(1, 1), b3 + hstep, voffB);
            PG8_WAIT_V(6); PG8_BAR; PG8_MMA(1, 1, At, B1); PG8_BAR;
            }
        }
        if constexpr (ALIGN_EPI) { if (wr == 0) PG8_BAR; }
        if constexpr (!Epi::AFTER_DRAIN) { E(acc, cur, wr, wc, fr, fq); S.done(cur); }
        if (!has_next) break;
#pragma unroll
        for (int a = 0; a < 2; ++a)
#pragma unroll
            for (int b = 0; b < 2; ++b)
#pragma unroll
                for (int m = 0; m < 4; ++m)
#pragma unroll
                    for (int n = 0; n < 2; ++n) acc[a][b][m][n] = (f32x4){0.f, 0.f, 0.f, 0.f};
        cur = nxt; cA = nA; cB = nB; ++ui;
        if constexpr (ALIGN_EPI) { if (wr == 1) PG8_BAR; }
    }
    PG8_WAIT_V(0);
    if constexpr (!ALIGN_EPI) { if (wr == 0) PG8_BAR; }
    PG8_BAR;
    if constexpr (Epi::AFTER_DRAIN) { E.fused(acc, cur, wr, wc, fr, fq, lds, wid, lane); S.done(cur); }
#undef PG8_SA
#undef PG8_SB
#undef PG8_STAGE
#undef PG8_LDA
#undef PG8_LDB
#undef PG8_MMA
#undef PG8_WAIT_V
#undef PG8_WAIT_L
#undef PG8_BAR
#undef PG8_SCHED
}
}
namespace pg8 {
typedef unsigned u32x2 __attribute__((ext_vector_type(2)));
__device__ __forceinline__ float gelu_tanh(float x) {
    const float e = __builtin_amdgcn_exp2f(x * (-2.302208198f - 0.1029432397f * x * x));
    return x * __builtin_amdgcn_rcpf(1.0f + e);
}
__device__ __forceinline__ float silu_f(float x) { return x * __builtin_amdgcn_rcpf(1.0f + __builtin_amdgcn_exp2f(-1.4426950409f * x)); }

struct EpiRetProj {
    static constexpr bool PERM = false, AFTER_DRAIN = false;
    bf16_t *Q, *K, *V, *G; const float *cosT, *sinT;
    __device__ __forceinline__ void operator()(const f32x4 (&acc)[2][2][4][2], const Unit& u, int wr, int wc, int fr, int fq) const {
        const int pn = u.pn;
        if (pn < 8) {
            bf16_t* dst = pn < 4 ? Q : K; const int head = pn & 3; const float sc = pn < 4 ? 1.0f : 0.0625f;
#pragma unroll
            for (int ai = 0; ai < 2; ++ai)
#pragma unroll
                for (int m = 0; m < 4; ++m) {
                    const int row = u.pm * BM + ai * HALF + wr * 64 + m * 16 + fr;
#pragma unroll
                    for (int n = 0; n < 2; ++n) {
                        const int f0 = wc * 32 + n * 16 + fq * 4;
                        const f32x4 c4 = *(const f32x4*)(cosT + (size_t)row * 128 + f0), s4 = *(const f32x4*)(sinT + (size_t)row * 128 + f0);
                        const f32x4 x1 = acc[ai][0][m][n], x2 = acc[ai][1][m][n];
                        const f32x4 o1 = (x1 * c4 - x2 * s4) * sc, o2 = (x1 * s4 + x2 * c4) * sc;
                        u32x2 w1, w2; w1.x = cvt_pk_bf16(o1[0], o1[1]); w1.y = cvt_pk_bf16(o1[2], o1[3]); w2.x = cvt_pk_bf16(o2[0], o2[1]); w2.y = cvt_pk_bf16(o2[2], o2[3]);
                        bf16_t* p = dst + (size_t)row * 1024 + head * 256 + f0;
                        *(u32x2*)p = w1; *(u32x2*)(p + 128) = w2;
                    }
                }
        } else {
            const bool isg = pn >= 16; bf16_t* dst = isg ? G : V; const int colbase = ((pn - 8) & 7) * 256;
#pragma unroll
            for (int ai = 0; ai < 2; ++ai)
#pragma unroll
                for (int m = 0; m < 4; ++m) {
                    const int row = u.pm * BM + ai * HALF + wr * 64 + m * 16 + fr;
#pragma unroll
                    for (int bj = 0; bj < 2; ++bj)
#pragma unroll
                        for (int n = 0; n < 2; ++n) {
                            f32x4 v = acc[ai][bj][m][n];
                            if (isg) { v[0] = silu_f(v[0]); v[1] = silu_f(v[1]); v[2] = silu_f(v[2]); v[3] = silu_f(v[3]); }
                            u32x2 w; w.x = cvt_pk_bf16(v[0], v[1]); w.y = cvt_pk_bf16(v[2], v[3]);
                            *(u32x2*)(dst + (size_t)row * 2048 + colbase + bj * HALF + wc * 32 + n * 16 + fq * 4) = w;
                        }
                }
        }
    }
};
struct EpiResGate {
    static constexpr bool PERM = false, AFTER_DRAIN = false;
    const float* base; float* out; const float* gate; int gstride;
    __device__ __forceinline__ void operator()(const f32x4 (&acc)[2][2][4][2], const Unit& u, int wr, int wc, int fr, int fq) const {
        const int b = (u.pm * BM) >> 13; const float* gp = gate + (size_t)b * gstride;
        const int col0 = u.pn * BM + wc * 32 + 4 * fq;
        f32x4 gv[2][2];
#pragma unroll
        for (int bj = 0; bj < 2; ++bj)
#pragma unroll
            for (int n = 0; n < 2; ++n) gv[bj][n] = *(const f32x4*)(gp + col0 + bj * HALF + n * 16);
#pragma unroll
        for (int ai = 0; ai < 2; ++ai)
#pragma unroll
            for (int m = 0; m < 4; ++m) {
                const size_t off = (size_t)(u.pm * BM + ai * HALF + wr * 64 + m * 16 + fr) * 1024 + col0;
#pragma unroll
                for (int bj = 0; bj < 2; ++bj)
#pragma unroll
                    for (int n = 0; n < 2; ++n) { const f32x4 bs = *(const f32x4*)(base + off + bj * HALF + n * 16); *(f32x4*)(out + off + bj * HALF + n * 16) = bs + gv[bj][n] * acc[ai][bj][m][n]; }
            }
    }
};
struct EpiSguIn {
    static constexpr bool PERM = true, AFTER_DRAIN = false;
    bf16_t* U; bf16_t* Vb; const float* bias; float* stats;
    __device__ __forceinline__ void operator()(const f32x4 (&acc)[2][2][4][2], const Unit& u, int wr, int wc, int fr, int fq) const {
        const bool isv = u.pn >= 12; bf16_t* base = isv ? Vb : U; const int colt = (isv ? u.pn - 12 : u.pn) * BM;
        const int col0 = colt + wc * 32 + 8 * fq, bcol0 = u.pn * BM + wc * 32 + 8 * fq;
        f32x4 bv[2][2];
#pragma unroll
        for (int bj = 0; bj < 2; ++bj)
#pragma unroll
            for (int n = 0; n < 2; ++n) bv[bj][n] = *(const f32x4*)(bias + bcol0 + bj * HALF + 4 * n);
#pragma unroll
        for (int ai = 0; ai < 2; ++ai)
#pragma unroll
            for (int m = 0; m < 4; ++m) {
                const int row = u.pm * BM + ai * HALF + wr * 64 + m * 16 + fr;
                bf16_t* rowp = base + (size_t)row * 3072 + col0;
                float s1 = 0.f, s2 = 0.f;
#pragma unroll
                for (int bj = 0; bj < 2; ++bj) {
                    f32x4 v0 = acc[ai][bj][m][0] + bv[bj][0], v1 = acc[ai][bj][m][1] + bv[bj][1];
#pragma unroll
                    for (int j = 0; j < 4; ++j) { v0[j] = gelu_tanh(v0[j]); v1[j] = gelu_tanh(v1[j]); }
                    u32x4 w; w.x = cvt_pk_bf16(v0[0], v0[1]); w.y = cvt_pk_bf16(v0[2], v0[3]); w.z = cvt_pk_bf16(v1[0], v1[1]); w.w = cvt_pk_bf16(v1[2], v1[3]);
                    *(u32x4*)(rowp + bj * HALF) = w;
                    if (isv) {
#pragma unroll
                        for (int j = 0; j < 4; ++j) { const unsigned ww = j == 0 ? w.x : j == 1 ? w.y : j == 2 ? w.z : w.w;
                            const float a = __uint_as_float(ww << 16), bq = __uint_as_float(ww & 0xffff0000u); s1 += a + bq; s2 += a * a + bq * bq; }
                    }
                }
                if (isv) {
                    s1 += __shfl_xor(s1, 16); s1 += __shfl_xor(s1, 32); s2 += __shfl_xor(s2, 16); s2 += __shfl_xor(s2, 32);
                    if (fq == 0) { float* sp = stats + ((size_t)row * 48 + (u.pn - 12) * 4 + wc) * 2; sp[0] = s1; sp[1] = s2; }
                }
            }
    }
};
}
typedef unsigned u32x4 __attribute__((ext_vector_type(4)));
#define GAS __attribute__((address_space(1)))
#define LAS __attribute__((address_space(3)))
typedef unsigned short bf16;
typedef unsigned v4u __attribute__((ext_vector_type(4)));
typedef float f32x4 __attribute__((ext_vector_type(4)));
typedef short bf16x8 __attribute__((ext_vector_type(8)));
typedef GAS unsigned gu32;
typedef GAS unsigned long long gu64;
#define RLX_AGENT __ATOMIC_RELAXED, __HIP_MEMORY_SCOPE_AGENT
#define LDS_WAIT() asm volatile("s_waitcnt lgkmcnt(0)" ::: "memory")
#define VM_WAIT() asm volatile("s_waitcnt vmcnt(0)" ::: "memory")
__device__ __forceinline__ unsigned long long rt() { return __builtin_amdgcn_s_memrealtime(); }
__device__ __forceinline__ unsigned f2bf(float f) { unsigned u = __builtin_bit_cast(unsigned, f); return (u + 0x7fffu + ((u >> 16) & 1u)) >> 16; }
__device__ __forceinline__ unsigned pk2(float lo, float hi) { return f2bf(lo) | (f2bf(hi) << 16); }

#define XB_TMO      128
#define XB_XCNT(j)  (256  + 64 * (j))
#define XB_XSUB(j)  (1280 + 64 * (j))
#define XB_XGEN(j)  (2304 + 64 * (j))
#define XB_TOP      3328
#define XB_TOPGEN   3392
#define XCD_BAR_WORDS 3456
#define XB_SPIN_CAP (1u << 18)

__device__ __forceinline__ unsigned xb_ld(unsigned* p)              { return __hip_atomic_load(p, __ATOMIC_RELAXED, __HIP_MEMORY_SCOPE_AGENT); }
__device__ __forceinline__ unsigned xb_add(unsigned* p, unsigned v) { return __hip_atomic_fetch_add(p, v, __ATOMIC_RELAXED, __HIP_MEMORY_SCOPE_AGENT); }
__device__ __forceinline__ unsigned xb_xcc_id() { return (unsigned)__builtin_amdgcn_s_getreg((3 << 11) | 20) & 0xFu; }
#define XB_SPIN(cond, bar) do { unsigned _sp = 0; while (cond) { __builtin_amdgcn_s_sleep(1); \
    if ((++_sp & 255u) == 0u) { if (xb_ld(&(bar)[XB_TMO])) break; if (_sp > XB_SPIN_CAP) { atomicAdd(&(bar)[XB_TMO], 1u); break; } } } } while (0)

struct XcdBarrier {
    unsigned* bar; unsigned x;
    volatile LAS unsigned* st;
};

__device__ __forceinline__ XcdBarrier xcd_barrier_post(unsigned* bar, volatile LAS unsigned* st) {
    XcdBarrier b; b.bar = bar; b.x = xb_xcc_id(); b.st = st;
    if (threadIdx.x == 0) (void)xb_add(&bar[XB_XCNT(b.x)], 1u);
    return b;
}
__device__ __forceinline__ void xcd_barrier_complete(unsigned* bar, unsigned x, unsigned& nloc, unsigned& nx) {
    const unsigned G = gridDim.x * gridDim.y * gridDim.z;
    unsigned sum, cnt, mine, sp = 0u;
    for (;;) {
        sum = 0u; cnt = 0u; mine = 0u;
#pragma unroll
        for (unsigned j = 0; j < 16; ++j) { const unsigned c = xb_ld(&bar[XB_XCNT(j)]); sum += c; cnt += (c > 0u) ? 1u : 0u; mine = (j == x) ? c : mine; }
        if (sum == G) break;
        __builtin_amdgcn_s_sleep(1);
        if ((++sp & 255u) == 0u) { if (xb_ld(&bar[XB_TMO])) break; if (sp > XB_SPIN_CAP) { atomicAdd(&bar[XB_TMO], 1u); break; } }
    }
    nloc = mine > 0u ? mine : 1u; nx = cnt > 0u ? cnt : 1u;
}

__device__ __forceinline__ void xcd_barrier(const XcdBarrier& b) {
    asm volatile("s_waitcnt vmcnt(0)" ::: "memory");
    __syncthreads();
    if (threadIdx.x == 0) {
        unsigned* bar = b.bar;
        __builtin_amdgcn_s_waitcnt(0);
        unsigned nloc = b.st[0], nx = b.st[1];
        if (nloc == 0u) { xcd_barrier_complete(bar, b.x, nloc, nx); b.st[0] = nloc; b.st[1] = nx; }
        const unsigned old = xb_add(&bar[XB_XSUB(b.x)], 1u);
        const unsigned gen = old / nloc;
        if (old + 1u == (gen + 1u) * nloc) {
            __builtin_amdgcn_fence(__ATOMIC_RELEASE, "agent");
            asm volatile("s_waitcnt vmcnt(0)" ::: "memory");
            const unsigned og = xb_add(&bar[XB_TOP], 1u);
            const unsigned tg = og / nx;
            if (og + 1u == (tg + 1u) * nx) xb_add(&bar[XB_TOPGEN], 1u);
            else XB_SPIN(xb_ld(&bar[XB_TOPGEN]) == tg, bar);
            __builtin_amdgcn_fence(__ATOMIC_ACQUIRE, "agent");
            xb_add(&bar[XB_XGEN(b.x)], 1u);
            asm volatile("s_waitcnt vmcnt(0)" ::: "memory");
        } else {
            XB_SPIN(xb_ld(&bar[XB_XGEN(b.x)]) == gen, bar);
            __builtin_amdgcn_fence(__ATOMIC_ACQUIRE, "agent");
            asm volatile("s_waitcnt vmcnt(0)" ::: "memory");
        }
    }
    __syncthreads();
}
__device__ __forceinline__ float wave_sum(float v) {
#pragma unroll
    for (int o = 1; o < 64; o <<= 1) v += __shfl_xor(v, o);
    return v;
}
__device__ __forceinline__ void p0_transpose_item(const float* W, int K, int N, bf16* WT, int row_off, LAS float* scr, int item, int lane) {
    const int nblk = N / 32, kb = item / nblk, nb = item % nblk, k0 = 64 * kb, n0 = 32 * nb;
#pragma unroll 8
    for (int i = 0; i < 32; ++i) { const int kk = 2 * i + (lane >> 5); scr[kk * 33 + (lane & 31)] = W[(size_t)(k0 + kk) * N + n0 + (lane & 31)]; }
    LDS_WAIT(); asm volatile("" ::: "memory");
    const int c = lane & 7;
#pragma unroll
    for (int j = 0; j < 4; ++j) { const int n = (lane >> 3) + 8 * j; const LAS float* s = scr + (8 * c) * 33 + n;
        v4u o; o.x = pk2(s[0 * 33], s[1 * 33]); o.y = pk2(s[2 * 33], s[3 * 33]); o.z = pk2(s[4 * 33], s[5 * 33]); o.w = pk2(s[6 * 33], s[7 * 33]);
        *(GAS v4u*)(WT + (size_t)(row_off + n0 + n) * K + k0 + 8 * c) = o; }
    LDS_WAIT(); asm volatile("" ::: "memory");
}
#define DI __device__ __forceinline__
constexpr int NWAVES = 8;
constexpr int TT = 16384, DM = 1024, SEQ = 8192;
constexpr size_t MiB = 1u << 20;
constexpr size_t WS_CTL = 0, CTL_ZERO_BYTES = 32768, WS_MOD = 512 * 1024;
constexpr size_t WS_COS = 2 * MiB, WS_SIN = 10 * MiB;
constexpr size_t WS_WRI = 18 * MiB, WS_WRO = 30 * MiB, WS_WSI = 34 * MiB, WS_WSO = 46 * MiB, WS_WQ = 52 * MiB, WS_KEYS = 60 * MiB;
constexpr size_t WS_ISU = 61 * MiB, WS_ISV = 61 * MiB + 256 * 1024;
constexpr size_t WS_STATS = 62 * MiB, WS_IDX = 68 * MiB, WS_GATE = 76 * MiB, WS_H = 84 * MiB, WS_PU = 116 * MiB, WS_PV = 180 * MiB;
constexpr size_t WS_R = 244 * MiB;
constexpr size_t WS_Q = WS_R, WS_K = WS_R + 32 * MiB, WS_V = WS_R + 64 * MiB, WS_G = WS_R + 128 * MiB, WS_CROSS = WS_R + 192 * MiB;
constexpr size_t WS_QP = WS_R, WS_SC = WS_R + 64 * MiB;
constexpr size_t WS_U = WS_R, WS_VB = WS_R + 96 * MiB;
constexpr size_t WS_END = 500 * MiB;
constexpr int CW_TMO = 0, CW_BAR = 4096;
constexpr int RING_OFF = 0, RING_BYTES = 131072, LDS_BYTES = 163840, LDSCTL_OFF = LDS_BYTES - 1024, MISC_OFF = LDSCTL_OFF + 320;
constexpr int PTR_OFF = LDSCTL_OFF + 512;
constexpr float EPS = 1e-6f;
typedef float f32x2_t __attribute__((ext_vector_type(2)));

DI float bf2f(bf16 h) { return __uint_as_float((unsigned)h << 16); }
DI float bflo(unsigned w) { return __uint_as_float(w << 16); }
DI float bfhi(unsigned w) { return __uint_as_float(w & 0xffff0000u); }
DI float wave_max(float v) {
#pragma unroll
    for (int o = 1; o < 64; o <<= 1) v = fmaxf(v, __shfl_xor(v, o));
    return v;
}
DI float gelu_t(float x) { return pg8::gelu_tanh(x); }

struct Ctx {
    LAS unsigned char* lds; int tid, lane, wave, vcu, G;
    unsigned char* ws;
};

DI const void* ldp(const Ctx& C, int i) {
    const unsigned long long v = ((const LAS unsigned long long*)(C.lds + PTR_OFF))[i];
    const unsigned lo = __builtin_amdgcn_readfirstlane((unsigned)v), hi = __builtin_amdgcn_readfirstlane((unsigned)(v >> 32));
    return (const void*)(((unsigned long long)hi << 32) | lo);
}
DI void cvt_rows_fp8(const float* src, unsigned char* dst, float* inv_scale, int nrows, int gw, int NGW, int lane) {
    for (int r = gw; r < nrows; r += NGW) {
        const f32x4* s = (const f32x4*)(src + (size_t)r * 1024) + lane * 4;
        f32x4 v[4]; float am = 0.f;
#pragma unroll
        for (int q = 0; q < 4; ++q) { v[q] = s[q]; am = fmaxf(am, fmaxf(fmaxf(fabsf(v[q][0]), fabsf(v[q][1])), fmaxf(fabsf(v[q][2]), fabsf(v[q][3])))); }
        am = wave_max(am);
        const int e = (int)((__float_as_uint(am) >> 23) & 0xffu) - 127;
        const bool ok = am > 1e-30f;
        const float sc = ok ? __uint_as_float((unsigned)(127 + 7 - e) << 23) : 1.0f, isc = ok ? __uint_as_float((unsigned)(127 - 7 + e) << 23) : 1.0f;
        u32x4 o;
#pragma unroll
        for (int q = 0; q < 4; ++q) { int wd = __builtin_amdgcn_cvt_pk_fp8_f32(v[q][0] * sc, v[q][1] * sc, 0, false); wd = __builtin_amdgcn_cvt_pk_fp8_f32(v[q][2] * sc, v[q][3] * sc, wd, true); o[q] = (unsigned)wd; }
        *(u32x4*)(dst + (size_t)r * 1024 + lane * 16) = o;
        if (lane == 0) inv_scale[r] = isc;
    }
}
DI void cvt_rows_i8(const float* src, unsigned char* dst, float* inv_scale, int nrows, int gw, int NGW, int lane) {
    for (int r = gw; r < nrows; r += NGW) {
        const f32x4* s = (const f32x4*)(src + (size_t)r * 1024) + lane * 4;
        f32x4 v[4]; float am = 0.f;
#pragma unroll
        for (int q = 0; q < 4; ++q) { v[q] = s[q]; am = fmaxf(am, fmaxf(fmaxf(fabsf(v[q][0]), fabsf(v[q][1])), fmaxf(fabsf(v[q][2]), fabsf(v[q][3])))); }
        am = wave_max(am);
        const int e = (int)((__float_as_uint(am) >> 23) & 0xffu) - 127;
        const bool ok = am > 1e-30f;
        const float sc = ok ? __uint_as_float((unsigned)(127 + 6 - e) << 23) : 1.0f, isc = ok ? __uint_as_float((unsigned)(127 - 6 + e) << 23) : 1.0f;
        u32x4 o;
#pragma unroll
        for (int q = 0; q < 4; ++q) { unsigned wd = 0u;
#pragma unroll
            for (int j = 0; j < 4; ++j) { int qi = (int)rintf(v[q][j] * sc); qi = qi > 127 ? 127 : (qi < -127 ? -127 : qi); wd |= ((unsigned)qi & 0xffu) << (8 * j); }
            o[q] = wd; }
        *(u32x4*)(dst + (size_t)r * 1024 + lane * 16) = o;
        if (lane == 0) inv_scale[r] = isc;
    }
}
DI void cvt_stream(const float* src, bf16* dst, size_t n4, size_t gtid, size_t gthreads) {
    const f32x4* s = (const f32x4*)src; uint2* d = (uint2*)dst;
    for (size_t i = gtid; i < n4; i += gthreads) { const f32x4 v = s[i]; uint2 o; o.x = pk2(v.x, v.y); o.y = pk2(v.z, v.w); d[i] = o; }
}
struct P0In { const float *c, *ada_w, *ada_b, *ret_w_in, *ret_w_out, *sgu_w_in, *sgu_w_out, *wq, *keys, *pu, *pv; const int* pos; };
DI void p0_prologue(const Ctx& C, const P0In& I) {
    LAS float* scr = (LAS float*)(C.lds + RING_OFF + C.wave * 16384);
    const int gw = C.vcu * NWAVES + C.wave, NGW = C.G * NWAVES;
    bf16* wri = (bf16*)(C.ws + WS_WRI); bf16* wro = (bf16*)(C.ws + WS_WRO);
    constexpr int I_RI = 16 * 192, I_RO = 32 * 32;
    constexpr int NITEMS = I_RI + I_RO;
    for (int it = gw; it < NITEMS; it += NGW) {
        int r = it;
        if (r < I_RI) { p0_transpose_item(I.ret_w_in, 1024, 6144, wri, 0, scr, r, C.lane); continue; } r -= I_RI;
        p0_transpose_item(I.ret_w_out, 2048, 1024, wro, 0, scr, r, C.lane);
    }
    const size_t gtid = (size_t)C.vcu * 512 + C.tid, gth = (size_t)C.G * 512;
    cvt_stream(I.keys, (bf16*)(C.ws + WS_KEYS), (size_t)2 * 8 * 2 * 128 * 128 / 4, gtid, gth);
    float* mod = (float*)(C.ws + WS_MOD);
    __syncthreads();
    for (int it = C.vcu; it < 2 * 96; it += C.G) {
        const int l = it / 96, cb = it % 96, kp = C.wave, n = cb * 64 + C.lane;
        const float* W = I.ada_w + (size_t)l * 1024 * 6144 + n;
        float a0 = 0.f, a1 = 0.f;
#pragma unroll 8
        for (int k = kp * 128; k < kp * 128 + 128; ++k) {
            const float w = W[(size_t)k * 6144]; const float c0 = I.c[k], c1 = I.c[1024 + k];
            a0 += pg8::silu_f(c0) * w; a1 += pg8::silu_f(c1) * w;
        }
        LAS float* red = (LAS float*)(C.lds + RING_OFF);
        red[(kp * 2 + 0) * 64 + C.lane] = a0; red[(kp * 2 + 1) * 64 + C.lane] = a1;
        __syncthreads();
        if (C.wave < 2) { float s = I.ada_b[l * 6144 + n];
#pragma unroll
            for (int q = 0; q < 8; ++q) s += red[(q * 2 + C.wave) * 64 + C.lane];
            mod[(size_t)(l * 2 + C.wave) * 6144 + n] = s; }
        __syncthreads();
    }
    float* cosT = (float*)(C.ws + WS_COS); float* sinT = (float*)(C.ws + WS_SIN);
    for (int it = gw; it < TT / 2; it += NGW) {
        const int row = 2 * it + (C.lane >> 5), f0 = (C.lane & 31) * 4; const float p = (float)I.pos[row];
        f32x4 cv, sv;
#pragma unroll
        for (int j = 0; j < 4; ++j) { const int f = f0 + j; double w = 1.0, bs = 0.93057204092969898;
#pragma unroll
            for (int bit = 0; bit < 7; ++bit) { if ((f >> bit) & 1) w *= bs; bs *= bs; }
            const float ang = p * (float)w; const double r = (double)ang * 0.15915494309189535; const float fr = (float)(r - floor(r)); cv[j] = __builtin_amdgcn_cosf(fr); sv[j] = __builtin_amdgcn_sinf(fr); }
        *(f32x4*)(cosT + (size_t)row * 128 + f0) = cv; *(f32x4*)(sinT + (size_t)row * 128 + f0) = sv;
    }
}
DI void side_work(const Ctx& C, const P0In& I, int nskip) {
    LAS float* scr = (LAS float*)(C.lds + RING_OFF + C.wave * 16384);
    const int gw = (C.vcu - nskip) * NWAVES + C.wave, NGW = (C.G - nskip) * NWAVES;
    bf16* wsi = (bf16*)(C.ws + WS_WSI); bf16* wso = (bf16*)(C.ws + WS_WSO); bf16* wq = (bf16*)(C.ws + WS_WQ);
    constexpr int I_SI = 16 * 192, I_SO = 48 * 32, I_Q = 16 * 64;
    constexpr int NITEMS = I_SI + I_SO + 2 * I_Q;
    for (int it = gw; it < NITEMS; it += NGW) {
        int r = it;
        if (r < I_SI) { p0_transpose_item(I.sgu_w_in, 1024, 6144, wsi, 0, scr, r, C.lane); continue; } r -= I_SI;
        if (r < I_SO) { p0_transpose_item(I.sgu_w_out, 3072, 1024, wso, 0, scr, r, C.lane); continue; } r -= I_SO;
        if (r < I_Q) { p0_transpose_item(I.wq, 1024, 2048, wq, 0, scr, r, C.lane); continue; } r -= I_Q;
        p0_transpose_item(I.wq + (size_t)1024 * 2048, 1024, 2048, wq + (size_t)2048 * 1024, 0, scr, r, C.lane);
    }
    cvt_rows_i8(I.pu, (unsigned char*)(C.ws + WS_PU), (float*)(C.ws + WS_ISU), 2 * 16384, gw, NGW, C.lane);
    cvt_rows_fp8(I.pv, (unsigned char*)(C.ws + WS_PV), (float*)(C.ws + WS_ISV), 2 * 16384, gw, NGW, C.lane);
}
DI void rms_mod_row(const float* xrow, const float* gain, const float* shift, const float* scale, bf16* orow, int lane) {
    const f32x4* xr = (const f32x4*)xrow + lane; f32x4 v[4]; float s = 0.f;
#pragma unroll
    for (int j = 0; j < 4; ++j) { v[j] = xr[64 * j]; s += (v[j].x * v[j].x + v[j].y * v[j].y) + (v[j].z * v[j].z + v[j].w * v[j].w); }
    const float rstd = 1.0f / sqrtf(wave_sum(s) * (1.0f / 1024.0f) + EPS);
    uint2* o8 = (uint2*)orow + lane;
#pragma unroll
    for (int j = 0; j < 4; ++j) { const f32x4 g = ((const f32x4*)gain)[lane + 64 * j], sh = ((const f32x4*)shift)[lane + 64 * j], sc = ((const f32x4*)scale)[lane + 64 * j];
        const f32x4 y = v[j] * rstd * g * (sc + 1.0f) + sh; uint2 o; o.x = pk2(y.x, y.y); o.y = pk2(y.z, y.w); o8[64 * j] = o; }
}
DI void rms_mod_phase(const Ctx& C, const float* x, const float* gain, const float* mod_l, int sh_off, int sc_off, bf16* H) {
    const int gw = C.vcu * NWAVES + C.wave, NGW = C.G * NWAVES;
    for (int m = gw; m < TT; m += NGW) { const float* ml = mod_l + (size_t)(m >> 13) * 6144; rms_mod_row(x + (size_t)m * DM, gain, ml + sh_off, ml + sc_off, H + (size_t)m * DM, C.lane); }
}

DI void scan_naive(const Ctx& C, const bf16* Q, const bf16* K, const bf16* V, bf16* CROSS) {
    LAS float* Sst = (LAS float*)(C.lds);
    LAS unsigned* Qs = (LAS unsigned*)(C.lds + 16384);
    LAS bf16* Ks = (LAS bf16*)(C.lds + 16384 + 32768);
    LAS float* Vs = (LAS float*)(C.lds + 16384 + 65536);
    const int tid = C.tid;
    for (int item = C.vcu; item < 256; item += C.G) {
        const int b = item >> 7, h = (item >> 5) & 3, es = item & 31;
        const float lg2 = log2f(1.0f - exp2f(-5.0f - (float)h)); const float gc = exp2f(lg2 * 64.0f);
        for (int i = tid; i < 4096; i += 512) Sst[i] = 0.f;
        __syncthreads();
        for (int n = 0; n < 128; ++n) {
            const size_t tok0 = (size_t)b * SEQ + (size_t)n * 64;
            for (int ch = tid; ch < 2048; ch += 512) { const int r = ch >> 5, c = ch & 31;
                const u32x4 q = *(const u32x4*)(Q + (tok0 + r) * 1024 + h * 256 + c * 8); *(LAS u32x4*)(Qs + r * 128 + c * 4) = q;
                const u32x4 k = *(const u32x4*)(K + (tok0 + r) * 1024 + h * 256 + c * 8); *(LAS u32x4*)((LAS unsigned*)Ks + r * 128 + c * 4) = k; }
            for (int o = tid; o < 1024; o += 512) { const int j = o >> 4, e = o & 15; Vs[o] = bf2f(V[(tok0 + j) * 2048 + h * 512 + es * 16 + e]) * exp2f(lg2 * (float)(63 - j)); }
            __syncthreads();
#pragma unroll
            for (int oo = 0; oo < 2; ++oo) { const int o = tid + oo * 512, i = o >> 4, e = o & 15; float acc = 0.f;
#pragma unroll 8
                for (int d2 = 0; d2 < 128; ++d2) { const unsigned q2 = Qs[i * 128 + d2]; acc += bflo(q2) * Sst[(2 * d2) * 16 + e] + bfhi(q2) * Sst[(2 * d2 + 1) * 16 + e]; }
                CROSS[(tok0 + i) * 2048 + h * 512 + es * 16 + e] = (bf16)f2bf(acc * exp2f(lg2 * (float)(i + 1))); }
            __syncthreads();
            { const int e = tid & 15, dg = tid >> 4; float a[8];
#pragma unroll
              for (int r = 0; r < 8; ++r) a[r] = gc * Sst[(dg + 32 * r) * 16 + e];
#pragma unroll 4
              for (int j = 0; j < 64; ++j) { const float vz = Vs[j * 16 + e];
#pragma unroll
                  for (int r = 0; r < 8; ++r) a[r] += bf2f(Ks[j * 256 + dg + 32 * r]) * vz; }
#pragma unroll
              for (int r = 0; r < 8; ++r) Sst[(dg + 32 * r) * 16 + e] = a[r]; }
            __syncthreads();
        }
    }
}
DI void intra_naive(const Ctx& C, const bf16* Q, const bf16* K, const bf16* V, const bf16* CROSS, bf16* G) {
    LAS unsigned* Qs = (LAS unsigned*)(C.lds);
    LAS unsigned* Ks = (LAS unsigned*)(C.lds + 32768);
    LAS float* SC = (LAS float*)(C.lds + 65536);
    LAS float* red = (LAS float*)(C.lds + 65536 + 16384);
    LAS float* rs = red + 512;
    const int tid = C.tid;
    for (int item = C.vcu; item < 1024; item += C.G) {
        const int b = item >> 9, h = (item >> 7) & 3, n = item & 127;
        const float lg2 = log2f(1.0f - exp2f(-5.0f - (float)h));
        const size_t tok0 = (size_t)b * SEQ + (size_t)n * 64;
        for (int ch = tid; ch < 2048; ch += 512) { const int r = ch >> 5, c = ch & 31;
            *(LAS u32x4*)(Qs + r * 128 + c * 4) = *(const u32x4*)(Q + (tok0 + r) * 1024 + h * 256 + c * 8);
            *(LAS u32x4*)(Ks + r * 128 + c * 4) = *(const u32x4*)(K + (tok0 + r) * 1024 + h * 256 + c * 8); }
        __syncthreads();
        { const int i = tid >> 3, jb = (tid & 7) * 8;
#pragma unroll
          for (int jj = 0; jj < 8; ++jj) { const int j = jb + jj; float acc = 0.f;
#pragma unroll 8
              for (int d2 = 0; d2 < 128; ++d2) { const unsigned q2 = Qs[i * 128 + d2], k2 = Ks[j * 128 + d2]; acc += bflo(q2) * bflo(k2) + bfhi(q2) * bfhi(k2); }
              const int dd = i > j ? i - j : j - i; SC[i * 64 + j] = acc * exp2f(lg2 * (float)dd); } }
        __syncthreads();
#pragma unroll 1
        for (int pass = 0; pass < 2; ++pass) { const int e = tid, ib = pass * 32; float y[32];
#pragma unroll
          for (int i = 0; i < 32; ++i) y[i] = 0.f;
          const bf16* vp = V + tok0 * 2048 + h * 512 + e;
#pragma unroll 1
          for (int j4 = 0; j4 < 16; ++j4) {
              const float v0 = bf2f(vp[(size_t)(4 * j4 + 0) * 2048]), v1 = bf2f(vp[(size_t)(4 * j4 + 1) * 2048]), v2 = bf2f(vp[(size_t)(4 * j4 + 2) * 2048]), v3 = bf2f(vp[(size_t)(4 * j4 + 3) * 2048]);
#pragma unroll
              for (int i = 0; i < 32; ++i) { const f32x4 s4 = *(const LAS f32x4*)(SC + (ib + i) * 64 + 4 * j4); y[i] += (s4.x * v0 + s4.y * v1) + (s4.z * v2 + s4.w * v3); }
          }
          const bf16* cp = CROSS + (tok0 + ib) * 2048 + h * 512 + e;
#pragma unroll
          for (int i = 0; i < 32; ++i) { y[i] += bf2f(cp[(size_t)i * 2048]); const float ss = wave_sum(y[i] * y[i]); if (C.lane == 0) red[C.wave * 64 + i] = ss; }
          __syncthreads();
          if (tid < 32) { float s = 0.f;
#pragma unroll
              for (int w = 0; w < 8; ++w) s += red[w * 64 + tid];
              rs[tid] = 1.0f / sqrtf(s * (1.0f / 512.0f) + EPS); }
          __syncthreads();
          bf16* gp = G + (tok0 + ib) * 2048 + h * 512 + e;
#pragma unroll
          for (int i = 0; i < 32; ++i) { const float g = bf2f(gp[(size_t)i * 2048]); gp[(size_t)i * 2048] = (bf16)f2bf(y[i] * rs[i] * g); }
          __syncthreads();
        }
        __syncthreads();
    }
}
DI void peer_scores(const Ctx& C, const bf16* QP, const bf16* KEYS  , float* SCO) {
    const int gw = C.vcu * NWAVES + C.wave, NGW = C.G * NWAVES; const int fr = C.lane & 15, fq = C.lane >> 4;
    for (int it = gw; it < 1024 * 8; it += NGW) {
        const int tt = it >> 3, h = it & 7; const int tok = tt * 16 + fr;
#pragma unroll
        for (int p = 0; p < 2; ++p) {
            bf16x8 qf[4];
#pragma unroll
            for (int ks = 0; ks < 4; ++ks) qf[ks] = *(const bf16x8*)(QP + (size_t)tok * 2048 + h * 256 + p * 128 + ks * 32 + fq * 8);
            const bf16* kb = KEYS + (size_t)(h * 2 + p) * 128 * 128;
#pragma unroll
            for (int kt = 0; kt < 8; ++kt) {
                f32x4 acc = {0.f, 0.f, 0.f, 0.f};
#pragma unroll
                for (int ks = 0; ks < 4; ++ks) { const bf16x8 kf = *(const bf16x8*)(kb + (size_t)(kt * 16 + fr) * 128 + ks * 32 + fq * 8);
                    acc = __builtin_amdgcn_mfma_f32_16x16x32_bf16(kf, qf[ks], acc, 0, 0, 0); }
                *(f32x4*)(SCO + ((size_t)tok * 8 + h) * 256 + p * 128 + kt * 16 + fq * 4) = acc;
            }
        }
    }
}
template <bool HALVES> DI void select16(const float (&v)[4], int lane, bool (&sel)[4], int (&pos)[4]) {
    float mx = fmaxf(fmaxf(v[0], v[1]), fmaxf(v[2], v[3])), mn = fminf(fminf(v[0], v[1]), fminf(v[2], v[3]));
#pragma unroll
    for (int o = 1; o < (HALVES ? 32 : 64); o <<= 1) { mx = fmaxf(mx, __shfl_xor(mx, o)); mn = fminf(mn, __shfl_xor(mn, o)); }
    const bool up = HALVES && lane >= 32;
    float lo = mn, hi = mx, thr = mn; bool done = false;
    for (int iter = 0; iter < 48; ++iter) {
        const float mid = done ? thr : 0.5f * (lo + hi);
        int cnt = 0;
#pragma unroll
        for (int c = 0; c < 4; ++c) { const unsigned long long m = __ballot(v[c] >= mid);
            cnt += HALVES ? (up ? __popc((unsigned)(m >> 32)) : __popc((unsigned)m)) : __popcll(m); }
        if (!done) { if (cnt == 16) { thr = mid; done = true; } else if (cnt > 16) { lo = mid; thr = mid; } else hi = mid; }
        if (__all(done)) break;
    }
    int base = 0;
#pragma unroll
    for (int c = 0; c < 4; ++c) { sel[c] = v[c] >= thr; const unsigned long long m = __ballot(sel[c]);
        const unsigned long long gm = HALVES ? (up ? (m >> 32) : (m & 0xffffffffull)) : m; const int ll = HALVES ? (lane & 31) : lane;
        pos[c] = base + __popcll(gm & ((1ull << ll) - 1ull)); base += __popcll(gm); sel[c] = sel[c] && pos[c] < 16; }
}
DI void peer_topk(const Ctx& C, const float* SCO, int* IDX, float* GATE) {
    LAS float* sv = (LAS float*)(C.lds + C.wave * 512);
    LAS int* si = (LAS int*)(C.lds + C.wave * 512 + 128);
    LAS float* fv = (LAS float*)(C.lds + C.wave * 512 + 256);
    LAS int* fi = (LAS int*)(C.lds + C.wave * 512 + 320);
    const int gw = C.vcu * NWAVES + C.wave, NGW = C.G * NWAVES, lane = C.lane;
    for (int it = gw; it < TT * 8; it += NGW) {
        const f32x4 s4 = *(const f32x4*)(SCO + (size_t)it * 256 + lane * 4);
        float v[4] = {s4.x, s4.y, s4.z, s4.w}; bool sel[4]; int pos[4];
        select16<true>(v, lane, sel, pos);
        const int p = lane >> 5;
#pragma unroll
        for (int c = 0; c < 4; ++c) if (sel[c]) { sv[p * 16 + pos[c]] = v[c]; si[p * 16 + pos[c]] = (lane & 31) * 4 + c; }
        LDS_WAIT();
        const int a = lane >> 2, bq = (lane & 3) * 4; const float va = sv[a]; const int ia = si[a];
        float w[4]; int wi[4];
#pragma unroll
        for (int c = 0; c < 4; ++c) { w[c] = va + sv[16 + bq + c]; wi[c] = ia * 128 + si[16 + bq + c]; }
        select16<false>(w, lane, sel, pos);
#pragma unroll
        for (int c = 0; c < 4; ++c) if (sel[c]) { fv[pos[c]] = w[c]; fi[pos[c]] = wi[c]; }
        LDS_WAIT();
        const float x = fv[lane & 15]; const int xi = fi[lane & 15];
        float m = x;
#pragma unroll
        for (int o = 1; o < 16; o <<= 1) m = fmaxf(m, __shfl_xor(m, o));
        const float e = __expf(x - m); float s = e;
#pragma unroll
        for (int o = 1; o < 16; o <<= 1) s += __shfl_xor(s, o);
        if (lane < 16) { IDX[(size_t)it * 16 + lane] = xi; GATE[(size_t)it * 16 + lane] = e / s; }
        LDS_WAIT();
    }
}
template <bool FINAL> DI void peer_gather(const Ctx& C, const bf16* H, const int* IDX, const float* GATE, const bf16* PU, const bf16* PV, float* X, const float* g2  ,
                                          const float* ngain, const float* nmod  , bf16* Hn) {
    const int gw = C.vcu * NWAVES + C.wave, NGW = C.G * NWAVES, lane = C.lane;
    for (int t = gw; t < TT; t += NGW) {
        float hv[16];
        { const u32x4 a = *(const u32x4*)(H + (size_t)t * 1024 + lane * 8), bq = *(const u32x4*)(H + (size_t)t * 1024 + 512 + lane * 8);
          hv[0] = bflo(a.x); hv[1] = bfhi(a.x); hv[2] = bflo(a.y); hv[3] = bfhi(a.y); hv[4] = bflo(a.z); hv[5] = bfhi(a.z); hv[6] = bflo(a.w); hv[7] = bfhi(a.w);
          hv[8] = bflo(bq.x); hv[9] = bfhi(bq.x); hv[10] = bflo(bq.y); hv[11] = bfhi(bq.y); hv[12] = bflo(bq.z); hv[13] = bfhi(bq.z); hv[14] = bflo(bq.w); hv[15] = bfhi(bq.w); }
        const int i0 = IDX[(size_t)t * 128 + lane], i1 = IDX[(size_t)t * 128 + 64 + lane];
        const float g0 = GATE[(size_t)t * 128 + lane], g1 = GATE[(size_t)t * 128 + 64 + lane];
        float a0 = 0.f, a1 = 0.f;
        for (int k = 0; k < 128; k += 4) {
            float dsum[4];
#pragma unroll
            for (int kk = 0; kk < 4; ++kk) { const int kq = k + kk; const int e = kq < 64 ? __builtin_amdgcn_readlane(i0, kq) : __builtin_amdgcn_readlane(i1, kq - 64);
                const bf16* ur = PU + (size_t)e * 1024; const u32x4 a = *(const u32x4*)(ur + lane * 8), bq = *(const u32x4*)(ur + 512 + lane * 8);
                float d = bflo(a.x) * hv[0] + bfhi(a.x) * hv[1]; d += bflo(a.y) * hv[2] + bfhi(a.y) * hv[3]; d += bflo(a.z) * hv[4] + bfhi(a.z) * hv[5]; d += bflo(a.w) * hv[6] + bfhi(a.w) * hv[7];
                d += bflo(bq.x) * hv[8] + bfhi(bq.x) * hv[9]; d += bflo(bq.y) * hv[10] + bfhi(bq.y) * hv[11]; d += bflo(bq.z) * hv[12] + bfhi(bq.z) * hv[13]; d += bflo(bq.w) * hv[14] + bfhi(bq.w) * hv[15];
                dsum[kk] = d; }
#pragma unroll
            for (int kk = 0; kk < 4; ++kk) { const int kq = k + kk; const float d = gelu_t(wave_sum(dsum[kk]));
                if (kq < 64) { if (lane == kq) a0 = d * g0; } else { if (lane == kq - 64) a1 = d * g1; } }
        }
        float o[16];
#pragma unroll
        for (int j = 0; j < 16; ++j) o[j] = 0.f;
        for (int k = 0; k < 128; k += 4) {
#pragma unroll
            for (int kk = 0; kk < 4; ++kk) { const int kq = k + kk; const int e = kq < 64 ? __builtin_amdgcn_readlane(i0, kq) : __builtin_amdgcn_readlane(i1, kq - 64);
                const float ak = __int_as_float(kq < 64 ? __builtin_amdgcn_readlane(__float_as_int(a0), kq) : __builtin_amdgcn_readlane(__float_as_int(a1), kq - 64));
                const bf16* vr = PV + (size_t)e * 1024; const u32x4 a = *(const u32x4*)(vr + lane * 8), bq = *(const u32x4*)(vr + 512 + lane * 8);
                o[0] += ak * bflo(a.x); o[1] += ak * bfhi(a.x); o[2] += ak * bflo(a.y); o[3] += ak * bfhi(a.y); o[4] += ak * bflo(a.z); o[5] += ak * bfhi(a.z); o[6] += ak * bflo(a.w); o[7] += ak * bfhi(a.w);
                o[8] += ak * bflo(bq.x); o[9] += ak * bfhi(bq.x); o[10] += ak * bflo(bq.y); o[11] += ak * bfhi(bq.y); o[12] += ak * bflo(bq.z); o[13] += ak * bfhi(bq.z); o[14] += ak * bflo(bq.w); o[15] += ak * bfhi(bq.w); }
        }
#ifdef DBG_ZERO_PEER
#pragma unroll
        for (int j = 0; j < 16; ++j) o[j] = 0.f;
#endif
        const int b = t >> 13; const float* gp = g2 + (size_t)b * 6144; float* xr = X + (size_t)t * 1024;
        float xn[16]; float ss = 0.f;
#pragma unroll
        for (int q = 0; q < 4; ++q) { const int col = (q >> 1) * 512 + lane * 8 + (q & 1) * 4; const f32x4 xv = *(const f32x4*)(xr + col), gv = *(const f32x4*)(gp + col);
#pragma unroll
            for (int j = 0; j < 4; ++j) { const float y = xv[j] + gv[j] * o[q * 4 + j]; xn[q * 4 + j] = y; ss += y * y; } }
        const float rstd = 1.0f / sqrtf(wave_sum(ss) * (1.0f / 1024.0f) + EPS);
        if (FINAL) {
#pragma unroll
            for (int q = 0; q < 4; ++q) { const int col = (q >> 1) * 512 + lane * 8 + (q & 1) * 4; const f32x4 gn = *(const f32x4*)(ngain + col); f32x4 y;
#pragma unroll
                for (int j = 0; j < 4; ++j) y[j] = xn[q * 4 + j] * rstd * gn[j];
                *(f32x4*)(xr + col) = y; }
        } else {
            const float* nm = nmod + (size_t)b * 6144;
#pragma unroll
            for (int q = 0; q < 4; ++q) { const int col = (q >> 1) * 512 + lane * 8 + (q & 1) * 4; const f32x4 gn = *(const f32x4*)(ngain + col), sh = *(const f32x4*)(nm + col), sc = *(const f32x4*)(nm + 1024 + col); f32x4 xo; float y[4];
#pragma unroll
                for (int j = 0; j < 4; ++j) { xo[j] = xn[q * 4 + j]; y[j] = xn[q * 4 + j] * rstd * gn[j] * (1.0f + sc[j]) + sh[j]; }
                *(f32x4*)(xr + col) = xo; uint2 w; w.x = pk2(y[0], y[1]); w.y = pk2(y[2], y[3]); *(uint2*)(Hn + (size_t)t * 1024 + col) = w; }
        }
    }
}
DI void sgu_gate_naive(const Ctx& C, bf16* U, const bf16* VB, const float* stats, const float* w_s, const float* b_s, const float* ln_g, const float* ln_b) {
    LAS float* Wm = (LAS float*)(C.lds);
    LAS float* mu = (LAS float*)(C.lds + 65536);
    LAS float* rsd = mu + 128;
    const int tid = C.tid;
    for (int item = C.vcu; item < 1024; item += C.G) {
        const int n = item >> 3, g = item & 7; const size_t row0 = (size_t)n * 128;
        for (int i = tid; i < 16384; i += 512) { const int r = i >> 7, c = i & 127; const float w = w_s[(size_t)g * 16384 + i]; Wm[i] = (r < 64 && c >= 64) ? 0.f : w; }
        if (tid < 128) { const float* sp = stats + (row0 + tid) * 96; float s1 = 0.f, s2 = 0.f;
            for (int q = 0; q < 48; ++q) { s1 += sp[2 * q]; s2 += sp[2 * q + 1]; }
            const float m = s1 * (1.0f / 3072.0f); const float var = s2 * (1.0f / 3072.0f) - m * m; mu[tid] = m; rsd[tid] = 1.0f / sqrtf(fmaxf(var, 0.f) + EPS); }
        __syncthreads();
        if (tid < 384) {
            const int col = g * 384 + tid; const float lg = ln_g[col], lb = ln_b[col];
#pragma unroll
            for (int pass = 0; pass < 2; ++pass) {
                float acc[64];
#pragma unroll
                for (int i = 0; i < 64; ++i) acc[i] = 0.f;
                const int jmax = pass == 0 ? 64 : 128;
                for (int j = 0; j < jmax; ++j) { const float v = bf2f(VB[(row0 + j) * 3072 + col]); const float vl = (v - mu[j]) * rsd[j] * lg + lb;
#pragma unroll
                    for (int i = 0; i < 64; ++i) acc[i] += Wm[(pass * 64 + i) * 128 + j] * vl; }
#pragma unroll
                for (int i = 0; i < 64; ++i) { const int r = pass * 64 + i; const float s = acc[i] + b_s[g * 128 + r]; bf16* up = U + (row0 + r) * 3072 + col; *up = (bf16)f2bf(bf2f(*up) * s); }
            }
        }
        __syncthreads();
    }
}
typedef short v4i16_t __attribute__((ext_vector_type(4)));
typedef unsigned u32x2_t __attribute__((ext_vector_type(2)));
typedef __bf16 bf16x2_t __attribute__((ext_vector_type(2)));
DI unsigned cvtpk(float lo, float hi) { f32x2_t v = {lo, hi}; bf16x2_t b = __builtin_convertvector(v, bf16x2_t); return __builtin_bit_cast(unsigned, b); }
DI v4i16_t trr(const LAS unsigned char* p) { return __builtin_amdgcn_ds_read_tr16_b64_v4i16((LAS v4i16_t*)p); }
DI bf16x8 cat8(v4i16_t a, v4i16_t b) { return __builtin_shufflevector(a, b, 0, 1, 2, 3, 4, 5, 6, 7); }
DI bf16x8 pack2(const f32x4& a, const f32x4& b) { u32x4 p; p.x = cvtpk(a[0], a[1]); p.y = cvtpk(a[2], a[3]); p.z = cvtpk(b[0], b[1]); p.w = cvtpk(b[2], b[3]); return __builtin_bit_cast(bf16x8, p); }
DI u32x4 scale8(u32x4 v, float s) { u32x4 o; o.x = cvtpk(bflo(v.x) * s, bfhi(v.x) * s); o.y = cvtpk(bflo(v.y) * s, bfhi(v.y) * s); o.z = cvtpk(bflo(v.z) * s, bfhi(v.z) * s); o.w = cvtpk(bflo(v.w) * s, bfhi(v.w) * s); return o; }
constexpr int SCAN_ESL = 32, SCAN_NCW = SCAN_ESL / 16, SCAN_NSL = 512 / SCAN_ESL, SCAN_NIT = 8 * SCAN_NSL;
#define SCAN_BAR() do { asm volatile("s_waitcnt lgkmcnt(0)" ::: "memory"); __builtin_amdgcn_s_barrier(); asm volatile("" ::: "memory"); } while (0)
template <int MODE = 0> DI void scan_mfma(const Ctx& C, const bf16* Q, const bf16* K, const bf16* V, bf16* CROSS) {
    constexpr int QPI = 544, KPI = 544, VPI = SCAN_ESL * 2 + 32, VCH = SCAN_ESL / 8  , NVC = 64 * VCH;
    constexpr int OQ = 0, OK_ = 64 * QPI, OV = OK_ + 64 * KPI, BUFB = OV + 64 * VPI;
    constexpr int NST = (NWAVES - 1 - SCAN_NCW) * 64;
    const int w = C.wave;
    for (int item = C.vcu; item < SCAN_NIT; item += C.G) {
        const int b = item / (4 * SCAN_NSL), h = (item / SCAN_NSL) & 3, es = item % SCAN_NSL;
        const float lg2 = log2f(1.0f - exp2f(-5.0f - (float)h)); const float gc = exp2f(lg2 * 64.0f);
        const size_t tokb = (size_t)b * SEQ;
        if (w >= SCAN_NCW) {
            int tl_ = C.tid; asm volatile("" : "+v"(tl_));
            const int st = (w == NWAVES - 1) ? (tl_ & 63) : tl_ - SCAN_NCW * 64;
            if (w == NWAVES - 1) {
                unsigned dmy = 0u;
#define SCAN_PF1(ptr) asm volatile("global_load_dword %0, %1, off" : "+v"(dmy) : "v"(ptr) : "memory")
#define SCAN_PF(n) do { const size_t t0_ = tokb + (size_t)(n) * 64; \
                if ((es & 3) == 0) { _Pragma("unroll") for (int u = 0; u < 4; ++u) { const int ln = st + 64 * u, r = ln >> 2, q = ln & 3; SCAN_PF1(Q + (t0_ + r) * 1024 + h * 256 + q * 64); SCAN_PF1(K + (t0_ + r) * 1024 + h * 256 + q * 64); } } \
                SCAN_PF1(V + (t0_ + st) * 2048 + h * 512 + es * SCAN_ESL); } while (0)
#ifndef SCAN_NOPF
                SCAN_PF(2);
#endif
                SCAN_BAR();
#pragma unroll 1
                for (int n = 0; n < 128; ++n) {
#ifndef SCAN_NOPF
                    if (n + 3 < 128) SCAN_PF(n + 3);
#endif
                    SCAN_BAR(); }
                asm volatile("s_waitcnt vmcnt(0)" : "+v"(dmy) :: "memory");
#undef SCAN_PF
#undef SCAN_PF1
            } else {
            u32x4 rq_[7], rk_[7], rv_;
#define SCAN_LD(n) do { const size_t t0_ = tokb + (size_t)(n) * 64; \
            _Pragma("unroll") for (int u = 0; u < 7; ++u) { const int c = st + NST * u; if (c < 2048) { const int r = c >> 5, cc = c & 31; \
                rq_[u] = *(const u32x4*)(Q + (t0_ + r) * 1024 + h * 256 + cc * 8); rk_[u] = *(const u32x4*)(K + (t0_ + r) * 1024 + h * 256 + cc * 8); } } \
            if (st < NVC) { const int r = st / VCH, cc = st % VCH; rv_ = *(const u32x4*)(V + (t0_ + r) * 2048 + h * 512 + es * SCAN_ESL + cc * 8); } } while (0)
#define SCAN_WR(bufo) do { LAS unsigned char* B_ = C.lds + (bufo); \
            _Pragma("unroll") for (int u = 0; u < 7; ++u) { const int c = st + NST * u; if (c < 2048) { const int r = c >> 5, cc = c & 31; \
                *(LAS u32x4*)(B_ + OQ + r * QPI + cc * 16) = rq_[u]; *(LAS u32x4*)(B_ + OK_ + r * KPI + cc * 16) = rk_[u]; } } \
            if (st < NVC) { const int r = st / VCH, cc = st % VCH; *(LAS u32x4*)(B_ + OV + r * VPI + cc * 16) = scale8(rv_, exp2f(lg2 * (float)(63 - r))); } } while (0)
            SCAN_LD(0); SCAN_WR(0); SCAN_LD(1);
            SCAN_BAR();
#pragma unroll 1
            for (int n = 0; n < 128; ++n) { if (MODE != 2 && n + 1 < 128) { SCAN_WR(((n + 1) & 1) * BUFB); if (n + 2 < 128) SCAN_LD(n + 2); } SCAN_BAR(); }
#undef SCAN_LD
#undef SCAN_WR
            }
        } else {
            int tl_ = C.tid; asm volatile("" : "+v"(tl_)); const int lane = tl_ & 63, fr = lane & 15, fq = lane >> 4;
            f32x4 S[16];
#pragma unroll
            for (int t = 0; t < 16; ++t) S[t] = (f32x4){0.f, 0.f, 0.f, 0.f};
            SCAN_BAR();
#define SC_LQ(QF, DB) do { _Pragma("unroll") for (int m = 0; m < 4; ++m) QF[m] = *(const LAS bf16x8*)(Qs + (16 * m + fr) * QPI + (32 * (DB) + 8 * fq) * 2); __builtin_amdgcn_sched_barrier(0); } while (0)
#define SC_MQ(QF, DB) do { const bf16x8 sa0 = pack2(S[2 * (DB)], S[2 * (DB) + 1]); \
            _Pragma("unroll") for (int m = 0; m < 4; ++m) acc[m] = __builtin_amdgcn_mfma_f32_16x16x32_bf16(sa0, QF[m], acc[m], 0, 0, 0); __builtin_amdgcn_sched_barrier(0); } while (0)
#define SC_LK(KF, KS, TQ) do { const LAS unsigned char* kp = Ks + (32 * (KS) + 4 * fq + (fr >> 2)) * KPI + (8 * (fr & 3)) * 2;     \
            _Pragma("unroll") for (int t4 = 0; t4 < 4; ++t4) { const int t = 4 * (TQ) + t4; KF[t4] = cat8(trr(kp + 64 * (t >> 1) + 8 * (t & 1)), trr(kp + 64 * (t >> 1) + 8 * (t & 1) + 16 * KPI)); } __builtin_amdgcn_sched_barrier(0); } while (0)
#define SC_LV(VF, KS) do { const LAS unsigned char* vp = Vs + (32 * (KS) + 4 * fq + (fr >> 2)) * VPI + (16 * w + 4 * (fr & 3)) * 2; VF = cat8(trr(vp), trr(vp + 16 * VPI)); } while (0)
#define SC_MK(KF, VF, TQ) do { _Pragma("unroll") for (int t4 = 0; t4 < 4; ++t4) S[4 * (TQ) + t4] = __builtin_amdgcn_mfma_f32_16x16x32_bf16(KF[t4], VF, S[4 * (TQ) + t4], 0, 0, 0); __builtin_amdgcn_sched_barrier(0); } while (0)
#define SCAN_CHUNK(n_, BO) do { const size_t tok0 = tokb + (size_t)(n_) * 64; LAS unsigned char* Qs = C.lds + (BO) + OQ; LAS unsigned char* Ks = C.lds + (BO) + OK_; LAS unsigned char* Vs = C.lds + (BO) + OV; \
                f32x4 acc[4]; bf16x8 fA[4], fB[4], kA[4], kB[4], vf0, vf1; \
                _Pragma("unroll") for (int m = 0; m < 4; ++m) acc[m] = (f32x4){0.f, 0.f, 0.f, 0.f}; \
                SC_LQ(fA, 0); SC_LQ(fB, 1); SC_MQ(fA, 0); SC_LQ(fA, 2); SC_MQ(fB, 1); SC_LQ(fB, 3); SC_MQ(fA, 2); SC_LQ(fA, 4); SC_MQ(fB, 3); SC_LQ(fB, 5); SC_MQ(fA, 4); SC_LQ(fA, 6); SC_MQ(fB, 5); SC_LQ(fB, 7); SC_MQ(fA, 6); SC_LV(vf0, 0); SC_LV(vf1, 1); SC_LK(kA, 0, 0); SC_MQ(fB, 7); \
                _Pragma("unroll") for (int m = 0; m < 4; ++m) { const f32x4 v = acc[m] * exp2f(lg2 * (float)(16 * m + fr + 1)); uint2 o; o.x = cvtpk(v[0], v[1]); o.y = cvtpk(v[2], v[3]); \
                    *(uint2*)(CROSS + (tok0 + 16 * m + fr) * 2048 + h * 512 + es * SCAN_ESL + 16 * w + 4 * fq) = o; } \
                _Pragma("unroll") for (int t = 0; t < 16; ++t) S[t] = S[t] * gc; \
                __builtin_amdgcn_sched_barrier(0); \
                SC_LK(kB, 0, 1); SC_MK(kA, vf0, 0); SC_LK(kA, 0, 2); SC_MK(kB, vf0, 1); SC_LK(kB, 0, 3); SC_MK(kA, vf0, 2); SC_LK(kA, 1, 0); SC_MK(kB, vf0, 3); SC_LK(kB, 1, 1); SC_MK(kA, vf1, 0); SC_LK(kA, 1, 2); SC_MK(kB, vf1, 1); SC_LK(kB, 1, 3); SC_MK(kA, vf1, 2); SC_MK(kB, vf1, 3); \
                SCAN_BAR(); } while (0)
#pragma unroll 1
            for (int n = 0; n < 128; n += 2) { if (MODE == 1) { SCAN_BAR(); SCAN_BAR(); } else { SCAN_CHUNK(n, 0); SCAN_CHUNK(n + 1, BUFB); } }
#undef SCAN_CHUNK
#undef SC_LQ
#undef SC_MQ
#undef SC_LK
#undef SC_LV
#undef SC_MK
        }
    }
}
#undef SCAN_BAR
DI void sgu_gate_mfma(const Ctx& C, bf16* U, const bf16* VB, const float* stats, const float* w_s, const float* b_s, const float* ln_g, const float* ln_b) {
    constexpr int WPI = 272, VPI = 288;
    LAS unsigned char* Ws = C.lds; LAS unsigned char* Vs = C.lds + 128 * WPI;
    LAS float* mu = (LAS float*)(C.lds + 128 * WPI + 128 * VPI); LAS float* rsd = mu + 128; LAS float* r1 = mu + 256; LAS float* r2 = mu + 384; LAS float* bsl = mu + 512;
    const int tid = C.tid, lane = C.lane, w = C.wave, fr = lane & 15, fq = lane >> 4;
    for (int item = C.vcu; item < 1024; item += C.G) {
        const int n = item >> 3, g = item & 7; const size_t row0 = (size_t)n * 128;
        if (tid < 128) { const float* sp = stats + (row0 + tid) * 96; float s1 = 0.f, s2 = 0.f;
#pragma unroll 8
            for (int q = 0; q < 48; ++q) { s1 += sp[2 * q]; s2 += sp[2 * q + 1]; }
            const float m = s1 * (1.0f / 3072.0f); const float var = s2 * (1.0f / 3072.0f) - m * m; mu[tid] = m; rsd[tid] = 1.0f / sqrtf(fmaxf(var, 0.f) + EPS); bsl[tid] = b_s[g * 128 + tid]; }
        __syncthreads();
        { const int i = tid >> 2, jq = tid & 3; const float* wp = w_s + (size_t)g * 16384 + i * 128 + jq * 32; float a1 = 0.f, a2 = 0.f;
#pragma unroll
          for (int c8 = 0; c8 < 4; ++c8) { const f32x4 wa = *(const f32x4*)(wp + c8 * 8), wb = *(const f32x4*)(wp + c8 * 8 + 4); float wv[8] = {wa[0], wa[1], wa[2], wa[3], wb[0], wb[1], wb[2], wb[3]}; float o[8];
#pragma unroll
              for (int q = 0; q < 8; ++q) { const int j = jq * 32 + c8 * 8 + q; const float wm = (i < 64 && j >= 64) ? 0.f : wv[q]; const float wr_ = wm * rsd[j]; o[q] = wr_; a1 += wr_ * mu[j]; a2 += wm; }
              u32x4 pk; pk.x = cvtpk(o[0], o[1]); pk.y = cvtpk(o[2], o[3]); pk.z = cvtpk(o[4], o[5]); pk.w = cvtpk(o[6], o[7]);
              *(LAS u32x4*)(Ws + i * WPI + (jq * 32 + c8 * 8) * 2) = pk; }
          a1 += __shfl_xor(a1, 1); a1 += __shfl_xor(a1, 2); a2 += __shfl_xor(a2, 1); a2 += __shfl_xor(a2, 2);
          if (jq == 0) { r1[i] = a1; r2[i] = a2; } }
#pragma unroll 1
        for (int cs = 0; cs < 3; ++cs) {
            const int colb = g * 384 + cs * 128;
#pragma unroll
            for (int u = 0; u < 4; ++u) { const int c = tid + 512 * u, r = c >> 4, cc = c & 15;
                *(LAS u32x4*)(Vs + r * VPI + cc * 16) = *(const u32x4*)(VB + (row0 + r) * 3072 + colb + cc * 8); }
            __syncthreads();
            f32x4 acc[8];
#pragma unroll
            for (int it = 0; it < 8; ++it) acc[it] = (f32x4){0.f, 0.f, 0.f, 0.f};
#pragma unroll
            for (int ks = 0; ks < 4; ++ks) {
                const LAS unsigned char* vp = Vs + (32 * ks + 4 * fq + (fr >> 2)) * VPI + (16 * w + 4 * (fr & 3)) * 2;
                const bf16x8 vf = cat8(trr(vp), trr(vp + 16 * VPI));
#pragma unroll
                for (int it = 0; it < 8; ++it) { if (it < 4 && ks >= 2) continue;
                    const LAS unsigned char* wp = Ws + (16 * it + fr) * WPI + (32 * ks + 4 * fq) * 2;
                    const u32x2_t lo = *(const LAS u32x2_t*)wp, hi = *(const LAS u32x2_t*)(wp + 32);
                    u32x4 ww; ww.x = lo.x; ww.y = lo.y; ww.z = hi.x; ww.w = hi.y;
                    acc[it] = __builtin_amdgcn_mfma_f32_16x16x32_bf16(vf, __builtin_bit_cast(bf16x8, ww), acc[it], 0, 0, 0); }
            }
            const int c0 = colb + 16 * w + 4 * fq;
            const f32x4 lg = *(const f32x4*)(ln_g + c0), lb = *(const f32x4*)(ln_b + c0);
#pragma unroll
            for (int it = 0; it < 8; ++it) { const int i = 16 * it + fr; const float q1 = r1[i], q2 = r2[i], bb = bsl[i];
                bf16* up = U + (row0 + i) * 3072 + c0; const u32x2_t uu = *(const u32x2_t*)up;
                const f32x4 s = lg * (acc[it] - q1) + lb * q2 + bb;
                u32x2_t o; o.x = cvtpk(bflo(uu.x) * s[0], bfhi(uu.x) * s[1]); o.y = cvtpk(bflo(uu.y) * s[2], bfhi(uu.y) * s[3]);
                *(u32x2_t*)up = o; }
            __syncthreads();
        }
    }
}
DI void up8(unsigned wd, float& a, float& b, float& c, float& d) { const f32x2_t lo = __builtin_amdgcn_cvt_pk_f32_fp8((int)wd, false), hi = __builtin_amdgcn_cvt_pk_f32_fp8((int)wd, true); a = lo.x; b = lo.y; c = hi.x; d = hi.y; }
DI float dot16(const u32x4 u, const float (&hv)[16]) {
    float f[16];
    up8(u.x, f[0], f[1], f[2], f[3]); up8(u.y, f[4], f[5], f[6], f[7]); up8(u.z, f[8], f[9], f[10], f[11]); up8(u.w, f[12], f[13], f[14], f[15]);
    float d0 = f[0] * hv[0], d1 = f[1] * hv[1];
#pragma unroll
    for (int j = 2; j < 16; j += 2) { d0 += f[j] * hv[j]; d1 += f[j + 1] * hv[j + 1]; }
    return d0 + d1;
}
template <bool FINAL> DI void peer_gather8(const Ctx& C, const bf16* Hin, const int* IDX, const float* GATE, const unsigned char* PU8, const unsigned char* PV8, const float* ISU, const float* ISV,
                                           float* X, const float* g2, const float* ngain, const float* nmod, bf16* Hn) {
    const int gw = C.vcu * NWAVES + C.wave, NGW = C.G * NWAVES, lane = C.lane;
    LAS float* DL = (LAS float*)(C.lds + C.wave * 1024);
    LAS float* AL = DL + 128;
    for (int t = gw; t < TT; t += NGW) {
        float hv[16];
        { const u32x4 a = *(const u32x4*)(Hin + (size_t)t * 1024 + lane * 16), bq = *(const u32x4*)(Hin + (size_t)t * 1024 + lane * 16 + 8);
          hv[0] = bflo(a.x); hv[1] = bfhi(a.x); hv[2] = bflo(a.y); hv[3] = bfhi(a.y); hv[4] = bflo(a.z); hv[5] = bfhi(a.z); hv[6] = bflo(a.w); hv[7] = bfhi(a.w);
          hv[8] = bflo(bq.x); hv[9] = bfhi(bq.x); hv[10] = bflo(bq.y); hv[11] = bfhi(bq.y); hv[12] = bflo(bq.z); hv[13] = bfhi(bq.z); hv[14] = bflo(bq.w); hv[15] = bfhi(bq.w); }
        const int i0 = IDX[(size_t)t * 128 + lane], i1 = IDX[(size_t)t * 128 + 64 + lane];
        const float g0 = GATE[(size_t)t * 128 + lane], g1 = GATE[(size_t)t * 128 + 64 + lane];
        const float su0 = ISU[i0], su1 = ISU[i1], sv0 = ISV[i0], sv1 = ISV[i1];
        u32x4 ub[8];
#define PG_LOADU(k0) do { _Pragma("unroll") for (int j = 0; j < 8; ++j) { const int kq = (k0) + j; const int e = kq < 64 ? __builtin_amdgcn_readlane(i0, kq) : __builtin_amdgcn_readlane(i1, kq - 64); \
            ub[j] = *(const u32x4*)(PU8 + (size_t)e * 1024 + lane * 16); } } while (0)
        PG_LOADU(0);
#pragma unroll 1
        for (int k0 = 0; k0 < 128; k0 += 8) {
            float p[8];
#pragma unroll
            for (int j = 0; j < 8; ++j) p[j] = dot16(ub[j], hv);
            if (k0 + 8 < 128) PG_LOADU(k0 + 8);
            const bool h32 = lane & 32, h16 = lane & 16, h8 = lane & 8;
            float q4[4];
#pragma unroll
            for (int j = 0; j < 4; ++j) { const float keep = h32 ? p[j + 4] : p[j], send = h32 ? p[j] : p[j + 4]; q4[j] = keep + __shfl_xor(send, 32); }
            float q2[2];
#pragma unroll
            for (int j = 0; j < 2; ++j) { const float keep = h16 ? q4[j + 2] : q4[j], send = h16 ? q4[j] : q4[j + 2]; q2[j] = keep + __shfl_xor(send, 16); }
            float q1; { const float keep = h8 ? q2[1] : q2[0], send = h8 ? q2[0] : q2[1]; q1 = keep + __shfl_xor(send, 8); }
            q1 += __shfl_xor(q1, 4); q1 += __shfl_xor(q1, 2); q1 += __shfl_xor(q1, 1);
            if ((lane & 7) == 0) DL[k0 + ((lane >> 5) & 1) * 4 + ((lane >> 4) & 1) * 2 + ((lane >> 3) & 1)] = q1;
        }
#undef PG_LOADU
        LDS_WAIT();
        { const float d0 = DL[lane], d1 = DL[64 + lane]; AL[lane] = gelu_t(d0 * su0) * g0 * sv0; AL[64 + lane] = gelu_t(d1 * su1) * g1 * sv1; }
        LDS_WAIT();
        float o[16];
#pragma unroll
        for (int j = 0; j < 16; ++j) o[j] = 0.f;
        u32x4 vb[8];
#define PG_LOADV(k0) do { _Pragma("unroll") for (int j = 0; j < 8; ++j) { const int kq = (k0) + j; const int e = kq < 64 ? __builtin_amdgcn_readlane(i0, kq) : __builtin_amdgcn_readlane(i1, kq - 64); \
            vb[j] = *(const u32x4*)(PV8 + (size_t)e * 1024 + lane * 16); } } while (0)
        PG_LOADV(0);
#pragma unroll 1
        for (int k0 = 0; k0 < 128; k0 += 8) {
            float f[8][16];
#pragma unroll
            for (int j = 0; j < 8; ++j) { up8(vb[j].x, f[j][0], f[j][1], f[j][2], f[j][3]); up8(vb[j].y, f[j][4], f[j][5], f[j][6], f[j][7]); up8(vb[j].z, f[j][8], f[j][9], f[j][10], f[j][11]); up8(vb[j].w, f[j][12], f[j][13], f[j][14], f[j][15]); }
            if (k0 + 8 < 128) PG_LOADV(k0 + 8);
#pragma unroll
            for (int j = 0; j < 8; ++j) { const float ak = AL[k0 + j];
#pragma unroll
                for (int q = 0; q < 16; ++q) o[q] += ak * f[j][q]; }
        }
#undef PG_LOADV
        const int b = t >> 13; const float* gp = g2 + (size_t)b * 6144; float* xr = X + (size_t)t * 1024;
        float xn[16]; float ss = 0.f;
#pragma unroll
        for (int q = 0; q < 4; ++q) { const int col = lane * 16 + q * 4; const f32x4 xv = *(const f32x4*)(xr + col), gv = *(const f32x4*)(gp + col);
#pragma unroll
            for (int j = 0; j < 4; ++j) { const float y = xv[j] + gv[j] * o[q * 4 + j]; xn[q * 4 + j] = y; ss += y * y; } }
        const float rstd = 1.0f / sqrtf(wave_sum(ss) * (1.0f / 1024.0f) + EPS);
        if (FINAL) {
#pragma unroll
            for (int q = 0; q < 4; ++q) { const int col = lane * 16 + q * 4; const f32x4 gn = *(const f32x4*)(ngain + col); f32x4 y;
#pragma unroll
                for (int j = 0; j < 4; ++j) y[j] = xn[q * 4 + j] * rstd * gn[j];
                *(f32x4*)(xr + col) = y; }
        } else {
            const float* nm = nmod + (size_t)b * 6144;
#pragma unroll
            for (int q = 0; q < 4; ++q) { const int col = lane * 16 + q * 4; const f32x4 gn = *(const f32x4*)(ngain + col), sh = *(const f32x4*)(nm + col), sc = *(const f32x4*)(nm + 1024 + col); f32x4 xo; float y[4];
#pragma unroll
                for (int j = 0; j < 4; ++j) { xo[j] = xn[q * 4 + j]; y[j] = xn[q * 4 + j] * rstd * gn[j] * (1.0f + sc[j]) + sh[j]; }
                *(f32x4*)(xr + col) = xo; u32x2_t wv; wv.x = cvtpk(y[0], y[1]); wv.y = cvtpk(y[2], y[3]); *(u32x2_t*)(Hn + (size_t)t * 1024 + col) = wv; }
        }
    }
}
template <int CTRL> DI float dpp_f(float x) { return __int_as_float(__builtin_amdgcn_update_dpp(0, __float_as_int(x), CTRL, 0xF, 0xF, false)); }
DI float x32(float x) { auto r = __builtin_amdgcn_permlane32_swap(__float_as_uint(x), __float_as_uint(x), false, false); return (threadIdx.x & 32) ? __uint_as_float(r[0]) : __uint_as_float(r[1]); }
DI float x16(float x) { auto r = __builtin_amdgcn_permlane16_swap(__float_as_uint(x), __float_as_uint(x), false, false); return (threadIdx.x & 16) ? __uint_as_float(r[0]) : __uint_as_float(r[1]); }
typedef _Float16 h2_t __attribute__((ext_vector_type(2)));
DI unsigned f2hu(float lo, float hi) { const f32x2_t v = {lo, hi}; const h2_t h = __builtin_convertvector(v, h2_t); return __builtin_bit_cast(unsigned, h); }
DI unsigned bf2hu(unsigned w) { const f32x2_t v = {bflo(w), bfhi(w)}; const h2_t h = __builtin_convertvector(v, h2_t); return __builtin_bit_cast(unsigned, h); }
DI h2_t bf2h(unsigned w) { return (h2_t){(_Float16)bflo(w), (_Float16)bfhi(w)}; }
template <bool FAKE> DI void up8h(const u32x4 u, h2_t (&f)[8]) {
    if (FAKE) { f[0] = __builtin_bit_cast(h2_t, u.x & 0x3bff3bffu); f[1] = __builtin_bit_cast(h2_t, u.y & 0x3bff3bffu); f[2] = __builtin_bit_cast(h2_t, u.z & 0x3bff3bffu); f[3] = __builtin_bit_cast(h2_t, u.w & 0x3bff3bffu);
        f[4] = __builtin_bit_cast(h2_t, (u.x >> 1) & 0x3bff3bffu); f[5] = __builtin_bit_cast(h2_t, (u.y >> 1) & 0x3bff3bffu); f[6] = __builtin_bit_cast(h2_t, (u.z >> 1) & 0x3bff3bffu); f[7] = __builtin_bit_cast(h2_t, (u.w >> 1) & 0x3bff3bffu); return; }
    f[0] = __builtin_amdgcn_cvt_scalef32_pk_f16_fp8((int)u.x, 1.0f, false); f[1] = __builtin_amdgcn_cvt_scalef32_pk_f16_fp8((int)u.x, 1.0f, true);
    f[2] = __builtin_amdgcn_cvt_scalef32_pk_f16_fp8((int)u.y, 1.0f, false); f[3] = __builtin_amdgcn_cvt_scalef32_pk_f16_fp8((int)u.y, 1.0f, true);
    f[4] = __builtin_amdgcn_cvt_scalef32_pk_f16_fp8((int)u.z, 1.0f, false); f[5] = __builtin_amdgcn_cvt_scalef32_pk_f16_fp8((int)u.z, 1.0f, true);
    f[6] = __builtin_amdgcn_cvt_scalef32_pk_f16_fp8((int)u.w, 1.0f, false); f[7] = __builtin_amdgcn_cvt_scalef32_pk_f16_fp8((int)u.w, 1.0f, true); }
template <bool FAKE> DI float dot16h(const u32x4 u, const h2_t (&hh)[8]) { h2_t f[8]; up8h<FAKE>(u, f); float d0 = 0.f, d1 = 0.f;
#pragma unroll
    for (int q = 0; q < 8; q += 2) { d0 = __builtin_amdgcn_fdot2(f[q], hh[q], d0, false); d1 = __builtin_amdgcn_fdot2(f[q + 1], hh[q + 1], d1, false); }
    return d0 + d1; }
template <bool FINAL, bool FAKE = false, int SKIP = 0> DI void peer_gather_rounds(const Ctx& C, const bf16* Hin, const int* IDX, const float* GATE, const unsigned char* PU8, const unsigned char* PV8, const float* ISU, const float* ISV,
                                                 float* X, const float* g2, const float* ngain, const float* nmod, bf16* Hn) {
    const int lane = C.lane, w = C.wave;
    LAS u32x2_t* LIST = (LAS u32x2_t*)(C.lds + w * 14592);
    LAS unsigned char* HL = C.lds + w * 14592 + 4096;
    LAS unsigned* ALU = (LAS unsigned*)(C.lds + w * 14592 + 12288);
    LAS int* OFFS = (LAS int*)(C.lds + w * 14592 + 14336);
    LAS float* IHS = (LAS float*)(C.lds + w * 14592 + 14336 + 160);
    const unsigned long long ltmask = (1ull << lane) - 1ull;
    for (int grp = C.vcu; grp < TT / 32; grp += C.G) {
        const int t0 = grp * 32 + w * 4;
        {
            int ee[8]; float gg[8]; unsigned su[8]; float sv[8];
#pragma unroll
            for (int r = 0; r < 8; ++r) { const size_t a = (size_t)(t0 + (r >> 1)) * 128 + 64 * (r & 1) + lane; ee[r] = IDX[a]; gg[r] = GATE[a]; }
#pragma unroll
            for (int r = 0; r < 8; ++r) { su[r] = __float_as_uint(ISU[ee[r]]) >> 23; sv[r] = ISV[ee[r]]; }
            int pos[8]; int base = 0;
#pragma unroll 1
            for (int b = 0; b < 8; ++b) {
#pragma unroll
                for (int r = 0; r < 8; ++r) { if ((r & 1) == 0 && lane == 0) OFFS[b * 4 + (r >> 1)] = base;
                    const bool mine = (ee[r] >> 11) == b; const unsigned long long m = __ballot(mine); if (mine) pos[r] = base + __popcll(m & ltmask); base += __popcll(m); }
            }
            if (lane == 0) OFFS[32] = 512;
#pragma unroll
            for (int r = 0; r < 8; ++r) { u32x2_t en; en.x = (unsigned)ee[r] | ((unsigned)(r >> 1) << 14) | (su[r] << 16); en.y = __float_as_uint(gg[r] * sv[r]); LIST[pos[r]] = en; }
#pragma unroll
            for (int tk = 0; tk < 4; ++tk) { const u32x4 a = *(const u32x4*)(Hin + (size_t)(t0 + tk) * 1024 + lane * 16), bq = *(const u32x4*)(Hin + (size_t)(t0 + tk) * 1024 + lane * 16 + 8);
                const float hv_[16] = {bflo(a.x), bfhi(a.x), bflo(a.y), bfhi(a.y), bflo(a.z), bfhi(a.z), bflo(a.w), bfhi(a.w), bflo(bq.x), bfhi(bq.x), bflo(bq.y), bfhi(bq.y), bflo(bq.z), bfhi(bq.z), bflo(bq.w), bfhi(bq.w)};
                float am = 0.f;
#pragma unroll
                for (int q = 0; q < 16; ++q) am = fmaxf(am, fabsf(hv_[q]));
                am = wave_max(am);
                const int e_ = (int)((__float_as_uint(am) >> 23) & 0xffu) - 127; const bool ok_ = am > 1e-30f;
                const float sc_ = ok_ ? __uint_as_float((unsigned)(127 + 6 - e_) << 23) : 1.0f, isc_ = ok_ ? __uint_as_float((unsigned)(127 - 6 + e_) << 23) : 1.0f;
                u32x4 o8;
#pragma unroll
                for (int q = 0; q < 4; ++q) { unsigned wd = 0u;
#pragma unroll
                    for (int j = 0; j < 4; ++j) { int qi = (int)rintf(hv_[4 * q + j] * sc_); qi = qi > 127 ? 127 : (qi < -127 ? -127 : qi); wd |= ((unsigned)qi & 0xffu) << (8 * j); }
                    o8[q] = wd; }
                *(LAS u32x4*)(HL + tk * 1024 + lane * 16) = o8; if (lane == 0) IHS[tk] = isc_; }
        }
        LDS_WAIT();
        {
            const int jL = ((lane >> 5) & 1) * 4 + ((lane >> 4) & 1) * 2 + ((lane >> 3) & 1);
#define G1_LOAD(UB, TK, G0) do { const unsigned exl_ = LIST[(G0) + (lane & 7)].x; \
            _Pragma("unroll") for (int j = 0; j < 8; ++j) { const unsigned ex = (unsigned)__builtin_amdgcn_readlane((int)exl_, j); TK[j] = (int)((ex >> 14) & 3u); \
                UB[j] = *(const u32x4*)(PU8 + (size_t)(ex & (FAKE ? 0x7fu : 0x3fffu)) * 1024 + lane * 16); } } while (0)
#define G1_RUN(UB, TK, G0) do { int p[8]; \
            _Pragma("unroll") for (int j = 0; j < 8; ++j) { const u32x4 hq = *(const LAS u32x4*)(HL + TK[j] * 1024 + lane * 16); \
                int d_ = __builtin_amdgcn_sdot4((int)UB[j].x, (int)hq.x, 0, false); d_ = __builtin_amdgcn_sdot4((int)UB[j].y, (int)hq.y, d_, false); \
                d_ = __builtin_amdgcn_sdot4((int)UB[j].z, (int)hq.z, d_, false); p[j] = __builtin_amdgcn_sdot4((int)UB[j].w, (int)hq.w, d_, false); } \
            const bool h32 = lane & 32, h16 = lane & 16, h8 = lane & 8; int q4[4]; \
            _Pragma("unroll") for (int j = 0; j < 4; ++j) { const int keep = h32 ? p[j + 4] : p[j], send = h32 ? p[j] : p[j + 4]; q4[j] = keep + __float_as_int(x32(__int_as_float(send))); } \
            int q2[2]; \
            _Pragma("unroll") for (int j = 0; j < 2; ++j) { const int keep = h16 ? q4[j + 2] : q4[j], send = h16 ? q4[j] : q4[j + 2]; q2[j] = keep + __float_as_int(x16(__int_as_float(send))); } \
            int q1; { const int keep = h8 ? q2[1] : q2[0], send = h8 ? q2[0] : q2[1]; q1 = keep + __float_as_int(dpp_f<0x128>(__int_as_float(send))); } \
            q1 += __float_as_int(dpp_f<0x141>(__int_as_float(q1))); q1 += __float_as_int(dpp_f<0xB1>(__int_as_float(q1))); q1 += __float_as_int(dpp_f<0x4E>(__int_as_float(q1))); \
            if ((lane & 7) == 0) { const u32x2_t me = LIST[(G0) + jL]; const float av_ = gelu_t((float)q1 * IHS[(me.x >> 14) & 3u] * __uint_as_float((me.x >> 16) << 23)) * __uint_as_float(me.y); ALU[(G0) + jL] = f2hu(av_, av_); } } while (0)
            u32x4 ubA[8], ubB[8]; int tkA[8], tkB[8];
            G1_LOAD(ubA, tkA, 0);
#pragma unroll 1
            for (int g0 = 0; g0 < ((SKIP & 1) ? 0 : 512); g0 += 16) {
                G1_LOAD(ubB, tkB, g0 + 8);
                G1_RUN(ubA, tkA, g0);
                if (g0 + 16 < 512) G1_LOAD(ubA, tkA, g0 + 16);
                G1_RUN(ubB, tkB, g0 + 8);
            }
#undef G1_LOAD
#undef G1_RUN
        }
        LDS_WAIT();
        h2_t o[4][8];
#pragma unroll
        for (int tk = 0; tk < 4; ++tk)
#pragma unroll
            for (int q = 0; q < 8; ++q) o[tk][q] = (h2_t){(_Float16)0.f, (_Float16)0.f};
#pragma unroll 1
        for (int r = 0; r < ((SKIP & 2) ? 0 : 8); ++r) {
#pragma unroll
            for (int tk = 0; tk < 4; ++tk) {
                const int beg = __builtin_amdgcn_readfirstlane(OFFS[r * 4 + tk]), end = __builtin_amdgcn_readfirstlane(OFFS[r * 4 + tk + 1]);
#define GS_LOAD(VB, AJ, G0) do { const int idl_ = ((G0) + (lane & 7) < end) ? (G0) + (lane & 7) : end - 1; const unsigned exl_ = LIST[idl_].x; const unsigned all_ = ((G0) + (lane & 7) < end) ? ALU[idl_] : 0u; \
                    _Pragma("unroll") for (int j = 0; j < 8; ++j) { const unsigned ex = (unsigned)__builtin_amdgcn_readlane((int)exl_, j); AJ[j] = __builtin_bit_cast(h2_t, (unsigned)__builtin_amdgcn_readlane((int)all_, j)); \
                        VB[j] = *(const u32x4*)(PV8 + (size_t)(ex & (FAKE ? 0x7fu : 0x3fffu)) * 1024 + lane * 16); } } while (0)
#define GS_ACC(VB, AJ) do { _Pragma("unroll") for (int j = 0; j < 8; ++j) { h2_t f_[8]; up8h<FAKE>(VB[j], f_); _Pragma("unroll") for (int q = 0; q < 8; ++q) o[tk][q] = f_[q] * AJ[j] + o[tk][q]; } } while (0)
                if (beg < end) {
                    u32x4 vbA[8], vbB[8]; h2_t ajA[8], ajB[8];
                    GS_LOAD(vbA, ajA, beg);
#pragma unroll 1
                    for (int g0 = beg; g0 < end; g0 += 16) {
                        if (g0 + 8 < end) GS_LOAD(vbB, ajB, g0 + 8);
                        GS_ACC(vbA, ajA);
                        if (g0 + 8 < end) { if (g0 + 16 < end) GS_LOAD(vbA, ajA, g0 + 16); GS_ACC(vbB, ajB); }
                    }
                }
#undef GS_LOAD
#undef GS_ACC
            }
        }
#pragma unroll
        for (int tk = 0; tk < 4; ++tk) {
            __builtin_amdgcn_sched_barrier(0);
            const int t = t0 + tk; const int b = t >> 13; const float* gp = g2 + (size_t)b * 6144; float* xr = X + (size_t)t * 1024;
            float xn[16]; float ss = 0.f;
#pragma unroll
            for (int q = 0; q < 4; ++q) { const int col = lane * 16 + q * 4; const f32x4 xv = *(const f32x4*)(xr + col), gv = *(const f32x4*)(gp + col);
#pragma unroll
                for (int j = 0; j < 4; ++j) { const float y = xv[j] + gv[j] * (float)o[tk][q * 2 + (j >> 1)][j & 1]; xn[q * 4 + j] = y; ss += y * y; } }
            const float rstd = 1.0f / sqrtf(wave_sum(ss) * (1.0f / 1024.0f) + EPS);
            if (FINAL) {
#pragma unroll
                for (int q = 0; q < 4; ++q) { const int col = lane * 16 + q * 4; const f32x4 gn = *(const f32x4*)(ngain + col); f32x4 y;
#pragma unroll
                    for (int j = 0; j < 4; ++j) y[j] = xn[q * 4 + j] * rstd * gn[j];
                    *(f32x4*)(xr + col) = y; }
            } else {
                const float* nm = nmod + (size_t)b * 6144;
#pragma unroll
                for (int q = 0; q < 4; ++q) { const int col = lane * 16 + q * 4; const f32x4 gn = *(const f32x4*)(ngain + col), sh = *(const f32x4*)(nm + col), sc = *(const f32x4*)(nm + 1024 + col); f32x4 xo; float y[4];
#pragma unroll
                    for (int j = 0; j < 4; ++j) { xo[j] = xn[q * 4 + j]; y[j] = xn[q * 4 + j] * rstd * gn[j] * (1.0f + sc[j]) + sh[j]; }
                    *(f32x4*)(xr + col) = xo; u32x2_t wv; wv.x = cvtpk(y[0], y[1]); wv.y = cvtpk(y[2], y[3]); *(u32x2_t*)(Hn + (size_t)t * 1024 + col) = wv; }
            }
        }
        LDS_WAIT();
    }
}
constexpr int GR_R = 12;
DI void glds_row(const unsigned char* gsrc_lane, unsigned lds_dst) { unsigned keep;
    asm volatile("s_mov_b32 %0, m0\n\ts_mov_b32 m0, %2\n\ts_nop 0\n\tglobal_load_lds_dwordx4 %1, off\n\ts_mov_b32 m0, %0" : "=&s"(keep) : "v"(gsrc_lane), "s"(lds_dst) : "memory"); }
template <bool FINAL> DI void peer_gather_dma(const Ctx& C, const bf16* Hin, const int* IDX, const float* GATE, const unsigned char* PU8, const unsigned char* PV8, const float* ISU, const float* ISV,
                                              float* X, const float* g2, const float* ngain, const float* nmod, bf16* Hn) {
    const int lane = C.lane, w = C.wave;
    constexpr int WB = 4096 + 2048 + 256 + GR_R * 1024;
    LAS u32x2_t* LIST = (LAS u32x2_t*)(C.lds + w * WB);
    LAS float* AL = (LAS float*)(C.lds + w * WB + 4096);
    LAS int* OFFS = (LAS int*)(C.lds + w * WB + 6144);
    LAS unsigned char* RING = C.lds + w * WB + 6400;
    const unsigned ring0 = (unsigned)__builtin_amdgcn_readfirstlane((int)(unsigned)(size_t)RING);
    const unsigned long long ltmask = (1ull << lane) - 1ull;
#define GR_REFILL(nv_) do { unsigned ex8_[8]; _Pragma("unroll") for (int j_ = 0; j_ < 8; ++j_) ex8_[j_] = (j_ < (nv_) && nf + j_ < 1024) ? LIST[(nf + j_) & 511].x : 0u; \
        _Pragma("unroll") for (int j_ = 0; j_ < 8; ++j_) if (j_ < (nv_) && nf + j_ < 1024) { const int f_ = nf + j_; const unsigned e_ = (unsigned)__builtin_amdgcn_readfirstlane((int)ex8_[j_]) & 0x3fffu; \
            const unsigned char* tb_ = (f_ < 512) ? PU8 : PV8; glds_row(tb_ + (size_t)e_ * 1024 + lane * 16, ring0 + (unsigned)(f_ % GR_R) * 1024u); } \
        nf += (nv_); if (nf > 1024) nf = 1024; } while (0)
#define GR_ISSUE(f) do { const int f_ = (f); const unsigned ex_ = (unsigned)__builtin_amdgcn_readfirstlane((int)LIST[f_ & 511].x); \
        const unsigned char* tb_ = (f_ < 512) ? PU8 : PV8; glds_row(tb_ + (size_t)(ex_ & 0x3fffu) * 1024 + lane * 16, ring0 + (unsigned)(f_ % GR_R) * 1024u); } while (0)
    for (int grp = C.vcu; grp < TT / 32; grp += C.G) {
        const int t0 = grp * 32 + w * 4;
        float hv4[4][16];
        {
            int ee[8]; float gg[8]; unsigned su[8]; float sv[8];
#pragma unroll
            for (int r = 0; r < 8; ++r) { const size_t a = (size_t)(t0 + (r >> 1)) * 128 + 64 * (r & 1) + lane; ee[r] = IDX[a]; gg[r] = GATE[a]; }
#pragma unroll
            for (int r = 0; r < 8; ++r) { su[r] = __float_as_uint(ISU[ee[r]]) >> 23; sv[r] = ISV[ee[r]]; }
            int pos[8]; int base = 0;
#pragma unroll 1
            for (int b = 0; b < 8; ++b) {
#pragma unroll
                for (int r = 0; r < 8; ++r) { if ((r & 1) == 0 && lane == 0) OFFS[b * 4 + (r >> 1)] = base;
                    const bool mine = (ee[r] >> 11) == b; const unsigned long long m = __ballot(mine); if (mine) pos[r] = base + __popcll(m & ltmask); base += __popcll(m); }
            }
            if (lane == 0) OFFS[32] = 512;
#pragma unroll
            for (int r = 0; r < 8; ++r) { u32x2_t en; en.x = (unsigned)ee[r] | ((unsigned)(r >> 1) << 14) | (su[r] << 16); en.y = __float_as_uint(gg[r] * sv[r]); LIST[pos[r]] = en; }
#pragma unroll
            for (int tk = 0; tk < 4; ++tk) { const u32x4 a = *(const u32x4*)(Hin + (size_t)(t0 + tk) * 1024 + lane * 16), bq = *(const u32x4*)(Hin + (size_t)(t0 + tk) * 1024 + lane * 16 + 8);
                hv4[tk][0] = bflo(a.x); hv4[tk][1] = bfhi(a.x); hv4[tk][2] = bflo(a.y); hv4[tk][3] = bfhi(a.y); hv4[tk][4] = bflo(a.z); hv4[tk][5] = bfhi(a.z); hv4[tk][6] = bflo(a.w); hv4[tk][7] = bfhi(a.w);
                hv4[tk][8] = bflo(bq.x); hv4[tk][9] = bfhi(bq.x); hv4[tk][10] = bflo(bq.y); hv4[tk][11] = bfhi(bq.y); hv4[tk][12] = bflo(bq.z); hv4[tk][13] = bfhi(bq.z); hv4[tk][14] = bflo(bq.w); hv4[tk][15] = bfhi(bq.w); }
        }
        asm volatile("s_waitcnt vmcnt(0) lgkmcnt(0)" ::: "memory");
        int nf = GR_R;
#pragma unroll 1
        for (int f = 0; f < GR_R; ++f) GR_ISSUE(f);
        {
            const int jL = ((lane >> 5) & 1) * 4 + ((lane >> 4) & 1) * 2 + ((lane >> 3) & 1);
#pragma unroll 1
            for (int r = 0; r < 8; ++r) {
#pragma unroll
                for (int tk = 0; tk < 4; ++tk) {
                    const int beg = __builtin_amdgcn_readfirstlane(OFFS[r * 4 + tk]), end = __builtin_amdgcn_readfirstlane(OFFS[r * 4 + tk + 1]);
#pragma unroll 1
                    for (int g0 = beg; g0 < end; g0 += 8) {
                        const int nv = (end - g0) < 8 ? (end - g0) : 8;
                        asm volatile("s_waitcnt vmcnt(4)" ::: "memory");
                        float p[8];
#pragma unroll
                        for (int j = 0; j < 8; ++j) { p[j] = 0.f;
                            if (j < nv) { const u32x4 row = *(const LAS u32x4*)(RING + ((g0 + j) % GR_R) * 1024 + lane * 16); p[j] = dot16(row, hv4[tk]); } }
                        asm volatile("s_waitcnt lgkmcnt(0)" ::: "memory");
                        GR_REFILL(nv);
                        const bool h32 = lane & 32, h16 = lane & 16, h8 = lane & 8;
                        float q4[4];
#pragma unroll
                        for (int j = 0; j < 4; ++j) { const float keep = h32 ? p[j + 4] : p[j], send = h32 ? p[j] : p[j + 4]; q4[j] = keep + __shfl_xor(send, 32); }
                        float q2[2];
#pragma unroll
                        for (int j = 0; j < 2; ++j) { const float keep = h16 ? q4[j + 2] : q4[j], send = h16 ? q4[j] : q4[j + 2]; q2[j] = keep + __shfl_xor(send, 16); }
                        float q1; { const float keep = h8 ? q2[1] : q2[0], send = h8 ? q2[0] : q2[1]; q1 = keep + __shfl_xor(send, 8); }
                        q1 += __shfl_xor(q1, 4); q1 += __shfl_xor(q1, 2); q1 += __shfl_xor(q1, 1);
                        if ((lane & 7) == 0 && jL < nv) { const u32x2_t me = LIST[g0 + jL]; AL[g0 + jL] = gelu_t(q1 * __uint_as_float((me.x >> 16) << 23)) * __uint_as_float(me.y); }
                    }
                }
            }
        }
        float o[4][16];
#pragma unroll
        for (int tk = 0; tk < 4; ++tk)
#pragma unroll
            for (int q = 0; q < 16; ++q) o[tk][q] = 0.f;
#pragma unroll 1
        for (int r = 0; r < 8; ++r) {
#pragma unroll
            for (int tk = 0; tk < 4; ++tk) {
                const int beg = __builtin_amdgcn_readfirstlane(OFFS[r * 4 + tk]), end = __builtin_amdgcn_readfirstlane(OFFS[r * 4 + tk + 1]);
#pragma unroll 1
                for (int i0 = beg; i0 < end; i0 += 8) {
                    const int nv = (end - i0) < 8 ? (end - i0) : 8;
                    if (i0 <= 500) asm volatile("s_waitcnt vmcnt(4)" ::: "memory"); else asm volatile("s_waitcnt vmcnt(0)" ::: "memory");
                    float aq[8]; u32x4 rw[8];
#pragma unroll
                    for (int j = 0; j < 8; ++j) { aq[j] = (j < nv) ? AL[i0 + j] : 0.f; }
#pragma unroll
                    for (int j = 0; j < 8; ++j) if (j < nv) rw[j] = *(const LAS u32x4*)(RING + ((512 + i0 + j) % GR_R) * 1024 + lane * 16);
#pragma unroll
                    for (int j = 0; j < 8; ++j) if (j < nv) { const float aj = __int_as_float(__builtin_amdgcn_readfirstlane(__float_as_int(aq[j])));
                        float f_[16]; up8(rw[j].x, f_[0], f_[1], f_[2], f_[3]); up8(rw[j].y, f_[4], f_[5], f_[6], f_[7]); up8(rw[j].z, f_[8], f_[9], f_[10], f_[11]); up8(rw[j].w, f_[12], f_[13], f_[14], f_[15]);
#pragma unroll
                        for (int q = 0; q < 16; ++q) o[tk][q] += aj * f_[q]; }
                    asm volatile("s_waitcnt lgkmcnt(0)" ::: "memory");
                    GR_REFILL(nv);
                }
            }
        }
        asm volatile("s_waitcnt vmcnt(0)" ::: "memory");
#pragma unroll
        for (int tk = 0; tk < 4; ++tk) {
            const int t = t0 + tk; const int b = t >> 13; const float* gp = g2 + (size_t)b * 6144; float* xr = X + (size_t)t * 1024;
            float xn[16]; float ss = 0.f;
#pragma unroll
            for (int q = 0; q < 4; ++q) { const int col = lane * 16 + q * 4; const f32x4 xv = *(const f32x4*)(xr + col), gv = *(const f32x4*)(gp + col);
#pragma unroll
                for (int j = 0; j < 4; ++j) { const float y = xv[j] + gv[j] * o[tk][q * 4 + j]; xn[q * 4 + j] = y; ss += y * y; } }
            const float rstd = 1.0f / sqrtf(wave_sum(ss) * (1.0f / 1024.0f) + EPS);
            if (FINAL) {
#pragma unroll
                for (int q = 0; q < 4; ++q) { const int col = lane * 16 + q * 4; const f32x4 gn = *(const f32x4*)(ngain + col); f32x4 y;
#pragma unroll
                    for (int j = 0; j < 4; ++j) y[j] = xn[q * 4 + j] * rstd * gn[j];
                    *(f32x4*)(xr + col) = y; }
            } else {
                const float* nm = nmod + (size_t)b * 6144;
#pragma unroll
                for (int q = 0; q < 4; ++q) { const int col = lane * 16 + q * 4; const f32x4 gn = *(const f32x4*)(ngain + col), sh = *(const f32x4*)(nm + col), sc = *(const f32x4*)(nm + 1024 + col); f32x4 xo; float y[4];
#pragma unroll
                    for (int j = 0; j < 4; ++j) { xo[j] = xn[q * 4 + j]; y[j] = xn[q * 4 + j] * rstd * gn[j] * (1.0f + sc[j]) + sh[j]; }
                    *(f32x4*)(xr + col) = xo; u32x2_t wv; wv.x = cvtpk(y[0], y[1]); wv.y = cvtpk(y[2], y[3]); *(u32x2_t*)(Hn + (size_t)t * 1024 + col) = wv; }
            }
        }
        asm volatile("s_waitcnt vmcnt(0) lgkmcnt(0)" ::: "memory");
    }
#undef GR_ISSUE
#undef GR_REFILL
}
DI float red4_sum(float x) { auto a = __builtin_amdgcn_permlane16_swap(__float_as_uint(x), __float_as_uint(x), false, false); x = __uint_as_float(a[0]) + __uint_as_float(a[1]);
    auto b = __builtin_amdgcn_permlane32_swap(__float_as_uint(x), __float_as_uint(x), false, false); return __uint_as_float(b[0]) + __uint_as_float(b[1]); }
DI float red4_max(float x) { auto a = __builtin_amdgcn_permlane16_swap(__float_as_uint(x), __float_as_uint(x), false, false); x = fmaxf(__uint_as_float(a[0]), __uint_as_float(a[1]));
    auto b = __builtin_amdgcn_permlane32_swap(__float_as_uint(x), __float_as_uint(x), false, false); return fmaxf(__uint_as_float(b[0]), __uint_as_float(b[1])); }
DI float red4_min(float x) { auto a = __builtin_amdgcn_permlane16_swap(__float_as_uint(x), __float_as_uint(x), false, false); x = fminf(__uint_as_float(a[0]), __uint_as_float(a[1]));
    auto b = __builtin_amdgcn_permlane32_swap(__float_as_uint(x), __float_as_uint(x), false, false); return fminf(__uint_as_float(b[0]), __uint_as_float(b[1])); }
constexpr int TK_NI = 6;
DI float tk_pivot(float clo, float chi) {
    const float lc = __builtin_amdgcn_logf(clo), lh = __builtin_amdgcn_logf(fmaxf(chi, 0.5f));
    const float f = (lc - 4.0443941f) * __builtin_amdgcn_rcpf(lc - lh);
    return fminf(fmaxf(f, 0.06f), 0.94f);
}
template <int NV> DI float tk_count(const float (&v)[NV], float mid) {
    const float nb = -mid * 1.099511627776e12f;
    float c0 = 0.f, c1 = 0.f, c2 = 0.f, c3 = 0.f;
#pragma unroll
    for (int i = 0; i < NV; i += 4) {
        c0 += __builtin_amdgcn_fmed3f(__builtin_fmaf(v[i], 1.099511627776e12f, nb), 0.f, 1.f); c1 += __builtin_amdgcn_fmed3f(__builtin_fmaf(v[i + 1], 1.099511627776e12f, nb), 0.f, 1.f);
        c2 += __builtin_amdgcn_fmed3f(__builtin_fmaf(v[i + 2], 1.099511627776e12f, nb), 0.f, 1.f); c3 += __builtin_amdgcn_fmed3f(__builtin_fmaf(v[i + 3], 1.099511627776e12f, nb), 0.f, 1.f);
    }
    float c = (c0 + c1) + (c2 + c3);
    return red4_sum(c);
}
template <int NV> DI void tk_search(const float (&v)[NV], float ntot, float& thr_out) {
    float mx = v[0], mn = v[0];
#pragma unroll
    for (int i = 1; i < NV; ++i) { mx = fmaxf(mx, v[i]); mn = fminf(mn, v[i]); }
    mx = red4_max(mx); mn = red4_min(mn);
    float lo = mn, hi = mx, clo = ntot - 1.0f, chi = 0.0f, thr = mn - 1.0f; bool done = false;
#pragma unroll 1
    for (int iter = 0; iter < 48; ++iter) {
        float fr_ = tk_pivot(clo, chi); if (iter >= TK_NI) fr_ = 0.5f;
        const float mid = done ? thr : lo + (hi - lo) * fr_;
        const float cnt = tk_count<NV>(v, mid);
        if (!done) { if (cnt == 16.0f) { thr = mid; done = true; } else if (cnt > 16.0f) { lo = mid; clo = cnt; thr = mid; } else { hi = mid; chi = cnt; } }
        if (__all(done)) break;
    }
    thr_out = thr;
}
DI void tk_search2(const float (&v0)[32], const float (&v1)[32], float& t0, float& t1) {
    float mx0 = v0[0], mn0 = v0[0], mx1 = v1[0], mn1 = v1[0];
#pragma unroll
    for (int i = 1; i < 32; ++i) { mx0 = fmaxf(mx0, v0[i]); mn0 = fminf(mn0, v0[i]); mx1 = fmaxf(mx1, v1[i]); mn1 = fminf(mn1, v1[i]); }
    mx0 = red4_max(mx0); mn0 = red4_min(mn0); mx1 = red4_max(mx1); mn1 = red4_min(mn1);
    float lo0 = mn0, hi0 = mx0, clo0 = 127.0f, chi0 = 0.0f, thr0 = mn0 - 1.0f; bool done0 = false;
    float lo1 = mn1, hi1 = mx1, clo1 = 127.0f, chi1 = 0.0f, thr1 = mn1 - 1.0f; bool done1 = false;
#pragma unroll 1
    for (int iter = 0; iter < 48; ++iter) {
        float f0 = tk_pivot(clo0, chi0), f1 = tk_pivot(clo1, chi1); if (iter >= TK_NI) { f0 = 0.5f; f1 = 0.5f; }
        const float mid0 = done0 ? thr0 : lo0 + (hi0 - lo0) * f0, mid1 = done1 ? thr1 : lo1 + (hi1 - lo1) * f1;
        const float c0 = tk_count<32>(v0, mid0), c1 = tk_count<32>(v1, mid1);
        if (!done0) { if (c0 == 16.0f) { thr0 = mid0; done0 = true; } else if (c0 > 16.0f) { lo0 = mid0; clo0 = c0; thr0 = mid0; } else { hi0 = mid0; chi0 = c0; } }
        if (!done1) { if (c1 == 16.0f) { thr1 = mid1; done1 = true; } else if (c1 > 16.0f) { lo1 = mid1; clo1 = c1; thr1 = mid1; } else { hi1 = mid1; chi1 = c1; } }
        if (__all(done0 && done1)) break;
    }
    t0 = thr0; t1 = thr1;
}
template <int MODE = 0> DI void peer_topk_fused(const Ctx& C, const bf16* QP, const bf16* KEYS, int* IDX, float* GATE) {
    constexpr int KPI = 288;
    const int lane = C.lane, fr = lane & 15, fq = lane >> 4, w = C.wave;
    LAS unsigned char* KS = C.lds;
    LAS unsigned char* WB = C.lds + 73728 + w * 7168;
    LAS float* LV = (LAS float*)(WB);
    LAS int* LK = (LAS int*)(WB + 2176);
    LAS float* FV = (LAS float*)(WB + 4352);
    LAS int* FI = (LAS int*)(WB + 5504);
    LAS float* TRASH = (LAS float*)(WB + 6656) + lane;
    const int h = C.vcu & 7, nb = C.G >> 3;
    { const bf16* kg = KEYS + (size_t)h * 2 * 128 * 128;
      for (int c = C.tid; c < 4096; c += 512) { const int r = c >> 4, cc = c & 15; *(LAS u32x4*)(KS + r * KPI + cc * 16) = *(const u32x4*)(kg + (size_t)r * 128 + cc * 8); } }
    __syncthreads();
    for (int tt = (C.vcu >> 3) + nb * w; tt < 1024; tt += nb * 8) {
        const int tok = tt * 16 + fr;
        float sc0[32], sc1[32];
#pragma unroll
        for (int p = 0; p < 2; ++p) {
            bf16x8 qf[4];
#pragma unroll
            for (int ks = 0; ks < 4; ++ks) qf[ks] = *(const bf16x8*)(QP + (size_t)tok * 2048 + h * 256 + p * 128 + ks * 32 + fq * 8);
#pragma unroll
            for (int kt = 0; kt < 8; ++kt) {
                f32x4 acc = {0.f, 0.f, 0.f, 0.f};
#pragma unroll
                for (int ks = 0; ks < 4; ++ks) { const bf16x8 kf = *(const LAS bf16x8*)(KS + (p * 128 + kt * 16 + fr) * KPI + (ks * 32 + fq * 8) * 2);
                    acc = __builtin_amdgcn_mfma_f32_16x16x32_bf16(kf, qf[ks], acc, 0, 0, 0); }
                if (p == 0) { sc0[kt * 4 + 0] = acc[0]; sc0[kt * 4 + 1] = acc[1]; sc0[kt * 4 + 2] = acc[2]; sc0[kt * 4 + 3] = acc[3]; }
                else { sc1[kt * 4 + 0] = acc[0]; sc1[kt * 4 + 1] = acc[1]; sc1[kt * 4 + 2] = acc[2]; sc1[kt * 4 + 3] = acc[3]; }
            }
        }
        float thrA = 1.0f, thrB = 1.0f; if (MODE == 0) tk_search2(sc0, sc1, thrA, thrB);
#pragma unroll
        for (int p = 0; p < 2; ++p) {
            const float thr = p == 0 ? thrA : thrB;
            int cnt = 0;
#pragma unroll
            for (int i = 0; i < 32; ++i) cnt += ((p == 0 ? sc0[i] : sc1[i]) > thr) ? 1 : 0;
            const int c0 = __shfl(cnt, fr), c1 = __shfl(cnt, fr + 16), c2 = __shfl(cnt, fr + 32);
            int pos = (fq > 0 ? c0 : 0) + (fq > 1 ? c1 : 0) + (fq > 2 ? c2 : 0);
#pragma unroll
            for (int i = 0; i < 32; ++i) { const float vv = p == 0 ? sc0[i] : sc1[i]; const bool s = vv > thr && pos < 16;
                LAS float* pv = s ? (LV + fr * 33 + p * 16 + pos) : TRASH; LAS int* pk = s ? (LK + fr * 33 + p * 16 + pos) : (LAS int*)TRASH;
                *pv = vv; *pk = (i >> 2) * 16 + 4 * fq + (i & 3); pos += (vv > thr) ? 1 : 0; }
        }
        LDS_WAIT();
        float A[4], Bv[16]; int KA[4], KB[16];
#pragma unroll
        for (int a = 0; a < 4; ++a) { A[a] = LV[fr * 33 + 4 * fq + a]; KA[a] = LK[fr * 33 + 4 * fq + a]; }
#pragma unroll
        for (int bq = 0; bq < 16; ++bq) { Bv[bq] = LV[fr * 33 + 16 + bq]; KB[bq] = LK[fr * 33 + 16 + bq]; }
        float sm[64];
#pragma unroll
        for (int a = 0; a < 4; ++a)
#pragma unroll
            for (int bq = 0; bq < 16; ++bq) sm[a * 16 + bq] = A[a] + Bv[bq];
        float thr2 = 4.0f; if (MODE == 0) tk_search<64>(sm, 256.0f, thr2);
        {
            int cnt = 0;
#pragma unroll
            for (int i = 0; i < 64; ++i) cnt += (sm[i] > thr2) ? 1 : 0;
            const int c0 = __shfl(cnt, fr), c1 = __shfl(cnt, fr + 16), c2 = __shfl(cnt, fr + 32);
            int pos = (fq > 0 ? c0 : 0) + (fq > 1 ? c1 : 0) + (fq > 2 ? c2 : 0);
#pragma unroll
            for (int i = 0; i < 64; ++i) { const bool s = sm[i] > thr2 && pos < 16;
                LAS float* pv = s ? (FV + fr * 17 + pos) : TRASH; LAS int* pk = s ? (FI + fr * 17 + pos) : (LAS int*)TRASH;
                *pv = sm[i]; *pk = KA[i >> 4] * 128 + KB[i & 15]; pos += (sm[i] > thr2) ? 1 : 0; }
        }
        LDS_WAIT();
        float x[4]; int xi[4];
#pragma unroll
        for (int j = 0; j < 4; ++j) { x[j] = FV[fr * 17 + 4 * fq + j]; xi[j] = FI[fr * 17 + 4 * fq + j]; }
        float m = red4_max(fmaxf(fmaxf(x[0], x[1]), fmaxf(x[2], x[3])));
        float e[4]; float s = 0.f;
#pragma unroll
        for (int j = 0; j < 4; ++j) { e[j] = __expf(x[j] - m); s += e[j]; }
        s = red4_sum(s);
        const float inv = 1.0f / s;
        const size_t ob = ((size_t)tok * 8 + h) * 16 + 4 * fq;
        typedef int i32x4 __attribute__((ext_vector_type(4)));
        *(i32x4*)(IDX + ob) = (i32x4){xi[0], xi[1], xi[2], xi[3]}; *(f32x4*)(GATE + ob) = (f32x4){e[0] * inv, e[1] * inv, e[2] * inv, e[3] * inv};
        LDS_WAIT();
    }
}
DI void intra_mfma(const Ctx& C, const bf16* Q, const bf16* K, const bf16* V, const bf16* CROSS, bf16* G) {
    constexpr int RPI = 544, PPI = 144, VPI = 544;
    LAS unsigned char* Qs = C.lds; LAS unsigned char* Ks = Qs + 64 * RPI; LAS unsigned char* Ps = Ks + 64 * RPI; LAS unsigned char* Vs = Ps + 64 * PPI;
    LAS float* red = (LAS float*)(Vs + 64 * VPI);
    const int tid = C.tid, lane = C.lane, w = C.wave, fr = lane & 15, fq = lane >> 4;
    for (int item = C.vcu; item < 1024; item += C.G) {
        const int b = item >> 9, h = (item >> 7) & 3, n = item & 127;
        const float lg2 = log2f(1.0f - exp2f(-5.0f - (float)h));
        const size_t tok0 = (size_t)b * SEQ + (size_t)n * 64;
#pragma unroll
        for (int u = 0; u < 4; ++u) { const int c = tid + 512 * u, r = c >> 5, cc = c & 31;
            *(LAS u32x4*)(Qs + r * RPI + cc * 16) = *(const u32x4*)(Q + (tok0 + r) * 1024 + h * 256 + cc * 8);
            *(LAS u32x4*)(Ks + r * RPI + cc * 16) = *(const u32x4*)(K + (tok0 + r) * 1024 + h * 256 + cc * 8);
            *(LAS u32x4*)(Vs + r * VPI + cc * 16) = *(const u32x4*)(V + (tok0 + r) * 2048 + h * 512 + cc * 8); }
        __syncthreads();
        { const int jt = w >> 1; f32x4 sa[2] = {(f32x4){0.f, 0.f, 0.f, 0.f}, (f32x4){0.f, 0.f, 0.f, 0.f}};
#pragma unroll
          for (int ks = 0; ks < 8; ++ks) { const bf16x8 kf = *(const LAS bf16x8*)(Ks + (16 * jt + fr) * RPI + (32 * ks + 8 * fq) * 2);
#pragma unroll
              for (int q = 0; q < 2; ++q) { const int it = 2 * (w & 1) + q; const bf16x8 qf = *(const LAS bf16x8*)(Qs + (16 * it + fr) * RPI + (32 * ks + 8 * fq) * 2);
                  sa[q] = __builtin_amdgcn_mfma_f32_16x16x32_bf16(kf, qf, sa[q], 0, 0, 0); } }
#pragma unroll
          for (int q = 0; q < 2; ++q) { const int i = 16 * (2 * (w & 1) + q) + fr, j0 = 16 * jt + 4 * fq; float pv[4];
#pragma unroll
              for (int r = 0; r < 4; ++r) { const int dd = i > j0 + r ? i - j0 - r : j0 + r - i; pv[r] = sa[q][r] * exp2f(lg2 * (float)dd); }
              u32x2_t o; o.x = cvtpk(pv[0], pv[1]); o.y = cvtpk(pv[2], pv[3]); *(LAS u32x2_t*)(Ps + i * PPI + j0 * 2) = o; } }
        __syncthreads();
        f32x4 acc[2][2][4];
#pragma unroll
        for (int hf = 0; hf < 2; ++hf) {
#pragma unroll
            for (int et = 0; et < 2; ++et)
#pragma unroll
                for (int it = 0; it < 4; ++it) acc[hf][et][it] = (f32x4){0.f, 0.f, 0.f, 0.f};
            if (hf == 1) { __syncthreads();
#pragma unroll
                for (int u = 0; u < 4; ++u) { const int c = tid + 512 * u, r = c >> 5, cc = c & 31;
                    *(LAS u32x4*)(Vs + r * VPI + cc * 16) = *(const u32x4*)(V + (tok0 + r) * 2048 + h * 512 + 256 + cc * 8); }
                __syncthreads(); }
#pragma unroll
            for (int ks = 0; ks < 2; ++ks) {
                bf16x8 pf[4];
#pragma unroll
                for (int it = 0; it < 4; ++it) { const LAS unsigned char* pp = Ps + (16 * it + fr) * PPI + (32 * ks + 4 * fq) * 2;
                    const u32x2_t lo = *(const LAS u32x2_t*)pp, hi = *(const LAS u32x2_t*)(pp + 32); u32x4 ww; ww.x = lo.x; ww.y = lo.y; ww.z = hi.x; ww.w = hi.y; pf[it] = __builtin_bit_cast(bf16x8, ww); }
#pragma unroll
                for (int et = 0; et < 2; ++et) { const LAS unsigned char* vp = Vs + (32 * ks + 4 * fq + (fr >> 2)) * VPI + (32 * w + 16 * et + 4 * (fr & 3)) * 2;
                    const bf16x8 vf = cat8(trr(vp), trr(vp + 16 * VPI));
#pragma unroll
                    for (int it = 0; it < 4; ++it) acc[hf][et][it] = __builtin_amdgcn_mfma_f32_16x16x32_bf16(vf, pf[it], acc[hf][et][it], 0, 0, 0); }
            }
        }
        float ssq[4] = {0.f, 0.f, 0.f, 0.f};
#pragma unroll
        for (int hf = 0; hf < 2; ++hf)
#pragma unroll
            for (int et = 0; et < 2; ++et)
#pragma unroll
                for (int it = 0; it < 4; ++it) { const u32x2_t cv = *(const u32x2_t*)(CROSS + (tok0 + 16 * it + fr) * 2048 + h * 512 + hf * 256 + 32 * w + 16 * et + 4 * fq);
                    f32x4 y = acc[hf][et][it]; y[0] += bflo(cv.x); y[1] += bfhi(cv.x); y[2] += bflo(cv.y); y[3] += bfhi(cv.y); acc[hf][et][it] = y;
                    ssq[it] += (y[0] * y[0] + y[1] * y[1]) + (y[2] * y[2] + y[3] * y[3]); }
#pragma unroll
        for (int it = 0; it < 4; ++it) { float s = ssq[it]; s += __shfl_xor(s, 16); s += __shfl_xor(s, 32); if (fq == 0) red[w * 64 + 16 * it + fr] = s; }
        __syncthreads();
        float rs[4];
#pragma unroll
        for (int it = 0; it < 4; ++it) { float s = 0.f;
#pragma unroll
            for (int ww = 0; ww < 8; ++ww) s += red[ww * 64 + 16 * it + fr];
            rs[it] = 1.0f / sqrtf(s * (1.0f / 512.0f) + EPS); }
#pragma unroll
        for (int hf = 0; hf < 2; ++hf)
#pragma unroll
            for (int et = 0; et < 2; ++et)
#pragma unroll
                for (int it = 0; it < 4; ++it) { bf16* gp = G + (tok0 + 16 * it + fr) * 2048 + h * 512 + hf * 256 + 32 * w + 16 * et + 4 * fq; const u32x2_t gv = *(const u32x2_t*)gp;
                    const f32x4 y = acc[hf][et][it] * rs[it]; u32x2_t o; o.x = cvtpk(y[0] * bflo(gv.x), y[1] * bfhi(gv.x)); o.y = cvtpk(y[2] * bflo(gv.y), y[3] * bfhi(gv.y)); *(u32x2_t*)gp = o; }
        __syncthreads();
    }
}
#ifndef PHMASK
#define PHMASK 0xFFFFFFu
#endif
#define PH(k) ((PHMASK >> (k)) & 1u)
#ifdef USE_SGU_NAIVE
#define SGU_GATE_FN sgu_gate_naive
#else
#define SGU_GATE_FN sgu_gate_mfma
#endif
#ifdef USE_GATHER_TOKEN
#define GATHER_FN peer_gather8
#else
#ifdef USE_GATHER_ROUNDS
#define GATHER_FN peer_gather_rounds
#else
#define GATHER_FN peer_gather_dma
#endif
#endif
#ifndef DUP_GATHER_SKIP
#define DUP_GATHER_SKIP 0
#endif
#ifndef DUP_GATHER_FAKE
#define DUP_GATHER_FAKE false
#endif
struct Args { const void* in[21]; float* out; unsigned char* ws; };
__global__ void __launch_bounds__(NWAVES * 64, 2) mk_fwd(Args args) {
    extern __shared__ __attribute__((aligned(16))) unsigned char lds[];
    Ctx C; C.lds = (LAS unsigned char*)lds; C.tid = threadIdx.x; C.lane = C.tid & 63; C.wave = __builtin_amdgcn_readfirstlane(C.tid >> 6);
    C.G = gridDim.x; { const int bx = blockIdx.x; C.vcu = (C.G % 8 == 0) ? (bx % 8) * (C.G / 8) + bx / 8 : bx; }
    C.ws = args.ws;
    volatile LAS unsigned* MISC = (volatile LAS unsigned*)(C.lds + MISC_OFF);
    gu32* ctl = (gu32*)(args.ws + WS_CTL);
    for (int u = C.tid; u < (LDS_BYTES - LDSCTL_OFF) / 4; u += NWAVES * 64) ((LAS unsigned*)(C.lds + LDSCTL_OFF))[u] = 0u;
    __syncthreads();
    XcdBarrier bar = xcd_barrier_post((unsigned*)(ctl + CW_BAR), MISC + 8);
#define GRID_BAR() do { xcd_barrier(bar); asm volatile("" : "+v"(C.tid)); C.lane = C.tid & 63; C.wave = __builtin_amdgcn_readfirstlane(C.tid >> 6); } while (0)
    { LAS unsigned long long* PT = (LAS unsigned long long*)(C.lds + PTR_OFF);
      if (C.tid == 0) {
#pragma unroll
          for (int i = 0; i < 21; ++i) PT[i] = (unsigned long long)args.in[i];
      } }
    __syncthreads();
#define INP(T, i) ((const T*)ldp(C, i))
    float* out = args.out; unsigned char* ws = args.ws;
#define MODP ((float*)(ws + WS_MOD))
#define MOD0 ((const float*)(ws + WS_MOD))
#define MOD1 ((const float*)(ws + WS_MOD) + 2 * 6144)
#define cosT ((float*)(ws + WS_COS))
#define sinT ((float*)(ws + WS_SIN))
#define WRI ((bf16*)(ws + WS_WRI))
#define WRO ((bf16*)(ws + WS_WRO))
#define WSI ((bf16*)(ws + WS_WSI))
#define WSO ((bf16*)(ws + WS_WSO))
#define WQ ((bf16*)(ws + WS_WQ))
#define KEYS ((bf16*)(ws + WS_KEYS))
#define STATS ((float*)(ws + WS_STATS))
#define IDX ((int*)(ws + WS_IDX))
#define GATE ((float*)(ws + WS_GATE))
#define H ((bf16*)(ws + WS_H))
#define PU8 ((const unsigned char*)(ws + WS_PU))
#define PV8 ((const unsigned char*)(ws + WS_PV))
#define ISU ((const float*)(ws + WS_ISU))
#define ISV ((const float*)(ws + WS_ISV))
#define Qb ((bf16*)(ws + WS_Q))
#define Kb ((bf16*)(ws + WS_K))
#define Vb ((bf16*)(ws + WS_V))
#define Gb ((bf16*)(ws + WS_G))
#define CROSS ((bf16*)(ws + WS_CROSS))
#define QP ((bf16*)(ws + WS_QP))
#define SCO ((float*)(ws + WS_SC))
#define Ub ((bf16*)(ws + WS_U))
#define VBb ((bf16*)(ws + WS_VB))

    { P0In I; I.c = INP(float, 1); I.ada_w = INP(float, 5); I.ada_b = INP(float, 6); I.ret_w_in = INP(float, 7); I.ret_w_out = INP(float, 8); I.sgu_w_in = INP(float, 9); I.sgu_w_out = INP(float, 15); I.wq = INP(float, 16); I.keys = INP(float, 17); I.pu = INP(float, 18); I.pv = INP(float, 19); I.pos = INP(int, 2);
#ifdef DUP_P0
      p0_prologue(C, I);
      GRID_BAR();
#endif
      if (PH(0)) p0_prologue(C, I); }
    GRID_BAR();
    if (PH(1)) rms_mod_phase(C, INP(float, 0), INP(float, 3), MOD0, 0, 1024, H);
    GRID_BAR();
    { pg8::Gemm g{H, WRI, TT, 6144, 1024}; pg8::StaticOrder S; S.init(TT, 6144, C.G, (int)blockIdx.x);
      pg8::EpiRetProj E{Qb, Kb, Vb, Gb, cosT, sinT};
#ifdef DUP_G1
      pg8::gemm_phase<pg8::EpiRetProj, pg8::StaticOrder, true, true>(C.lds + RING_OFF, g, S, E); GRID_BAR();
#endif
      if (PH(2)) pg8::gemm_phase<pg8::EpiRetProj, pg8::StaticOrder, true, true>(C.lds + RING_OFF, g, S, E); }
    GRID_BAR();
    #ifdef USE_SCAN_NAIVE
    if (PH(3)) scan_naive(C, Qb, Kb, Vb, CROSS);
#else
#ifdef DUP_SCAN
    scan_mfma<DUP_SCAN>(C, Qb, Kb, Vb, CROSS);
    GRID_BAR();
#endif
    if (C.vcu < SCAN_NIT) { if (PH(3)) scan_mfma<0>(C, Qb, Kb, Vb, CROSS); }
    else { P0In I; I.c = nullptr; I.ada_w = nullptr; I.ada_b = nullptr; I.ret_w_in = nullptr; I.ret_w_out = nullptr; I.sgu_w_in = INP(float, 9); I.sgu_w_out = INP(float, 15); I.wq = INP(float, 16); I.keys = nullptr; I.pu = INP(float, 18); I.pv = INP(float, 19); I.pos = nullptr;
      side_work(C, I, SCAN_NIT); }
#endif
    GRID_BAR();
#ifdef USE_INTRA_NAIVE
    if (PH(4)) intra_naive(C, Qb, Kb, Vb, CROSS, Gb);
#else
    if (PH(4)) intra_mfma(C, Qb, Kb, Vb, CROSS, Gb);
#endif
    GRID_BAR();
    { pg8::Gemm g{Gb, WRO, TT, 1024, 2048}; pg8::StaticOrder S; S.init(TT, 1024, C.G, (int)blockIdx.x);
      pg8::EpiResGate E{INP(float, 0), out, MOD0 + 2048, 6144};
      if (PH(5)) pg8::gemm_phase<pg8::EpiResGate, pg8::StaticOrder, true, true>(C.lds + RING_OFF, g, S, E); }
    GRID_BAR();
    if (PH(6)) rms_mod_phase(C, out, INP(float, 4), MOD0, 3072, 4096, H);
    GRID_BAR();
    { pg8::Gemm g{H, WQ, TT, 2048, 1024}; pg8::StaticOrder S; S.init(TT, 2048, C.G, (int)blockIdx.x);
      pg8::EpiBf16<0> E{QP, 2048, nullptr, 0, 0, 1.f};
      if (PH(7)) pg8::gemm_phase<pg8::EpiBf16<0>, pg8::StaticOrder, true, true>(C.lds + RING_OFF, g, S, E); }
    GRID_BAR();
#ifdef USE_TOPK_NAIVE
    if (PH(8)) peer_scores(C, QP, KEYS, SCO);
    GRID_BAR();
    if (PH(9)) peer_topk(C, SCO, IDX, GATE);
#else
#ifdef DUP_TOPK
    peer_topk_fused<DUP_TOPK>(C, QP, KEYS, IDX, GATE);
    GRID_BAR();
#endif
    if (PH(9)) peer_topk_fused<0>(C, QP, KEYS, IDX, GATE);
#endif
    GRID_BAR();
#ifdef DUP_GATHER
    GATHER_FN<false, DUP_GATHER_FAKE, DUP_GATHER_SKIP>(C, H, IDX, GATE, PU8, PV8, ISU, ISV, (float*)(ws + WS_R), MOD0 + 5120, INP(float, 3) + 1024, MOD1, (bf16*)(ws + WS_R + 128 * MiB));
    GRID_BAR();
#endif
    if (PH(10)) GATHER_FN<false>(C, H, IDX, GATE, PU8, PV8, ISU, ISV, out, MOD0 + 5120, INP(float, 3) + 1024, MOD1, H);
    GRID_BAR();
#ifdef DUP_BAR
    for (int q_ = 0; q_ < 10; ++q_) GRID_BAR();
#endif
    { pg8::Gemm g{H, WSI, TT, 6144, 1024}; pg8::StaticOrder S; S.init(TT, 6144, C.G, (int)blockIdx.x);
      pg8::EpiSguIn E{Ub, VBb, INP(float, 10), STATS};
#ifdef DUP_G7
      pg8::gemm_phase<pg8::EpiSguIn, pg8::StaticOrder, true, true>(C.lds + RING_OFF, g, S, E); GRID_BAR();
#endif
      if (PH(11)) pg8::gemm_phase<pg8::EpiSguIn, pg8::StaticOrder, true, true>(C.lds + RING_OFF, g, S, E); }
    GRID_BAR();
    if (PH(12)) SGU_GATE_FN(C, Ub, VBb, STATS, INP(float, 13), INP(float, 14), INP(float, 11), INP(float, 12));
    GRID_BAR();
    { pg8::Gemm g{Ub, WSO, TT, 1024, 3072}; pg8::StaticOrder S; S.init(TT, 1024, C.G, (int)blockIdx.x);
      pg8::EpiResGate E{out, out, MOD1 + 2048, 6144};
      if (PH(13)) pg8::gemm_phase<pg8::EpiResGate, pg8::StaticOrder, true, true>(C.lds + RING_OFF, g, S, E); }
    GRID_BAR();
    if (PH(14)) rms_mod_phase(C, out, INP(float, 4) + 1024, MOD1, 3072, 4096, H);
    GRID_BAR();
    { pg8::Gemm g{H, WQ + (size_t)2048 * 1024, TT, 2048, 1024}; pg8::StaticOrder S; S.init(TT, 2048, C.G, (int)blockIdx.x);
      pg8::EpiBf16<0> E{QP, 2048, nullptr, 0, 0, 1.f};
      if (PH(15)) pg8::gemm_phase<pg8::EpiBf16<0>, pg8::StaticOrder, true, true>(C.lds + RING_OFF, g, S, E); }
    GRID_BAR();
#ifdef USE_TOPK_NAIVE
    if (PH(16)) peer_scores(C, QP, KEYS + (size_t)8 * 2 * 128 * 128, SCO);
    GRID_BAR();
    if (PH(17)) peer_topk(C, SCO, IDX, GATE);
#else
    if (PH(17)) peer_topk_fused<0>(C, QP, KEYS + (size_t)8 * 2 * 128 * 128, IDX, GATE);
#endif
    GRID_BAR();
    if (PH(18)) GATHER_FN<true>(C, H, IDX, GATE, PU8 + (size_t)16384 * 1024, PV8 + (size_t)16384 * 1024, ISU + 16384, ISV + 16384, out, MOD1 + 5120, INP(float, 20), nullptr, nullptr);
#undef GRID_BAR
}

extern "C" void kernel_launch(void* const* d_in, const int* in_sizes, int n_in, void* d_out, int out_size, void* d_ws, size_t ws_size, hipStream_t stream) {
    static int grid = 0;
    if (grid == 0) {
        if (n_in != 21 || in_sizes[0] != TT * DM || out_size != TT * DM || ws_size < WS_END) { fprintf(stderr, "kernel_launch: unexpected shapes/workspace: n_in %d in0 %d out %d ws %zu (need %zu)\n", n_in, n_in > 0 ? in_sizes[0] : -1, out_size, ws_size, (size_t)WS_END); grid = -1; return; }
        int dev = 0, cus = 0;
        if (hipGetDevice(&dev) != hipSuccess || hipDeviceGetAttribute(&cus, hipDeviceAttributeMultiprocessorCount, dev) != hipSuccess) { fprintf(stderr, "kernel_launch: device query failed\n"); grid = -1; return; }
        if (hipFuncSetAttribute((const void*)mk_fwd, hipFuncAttributeMaxDynamicSharedMemorySize, LDS_BYTES) != hipSuccess) { fprintf(stderr, "kernel_launch: hipFuncSetAttribute failed\n"); grid = -1; return; }
        (void)hipGetLastError();
        grid = cus;
    }
    if (grid < 0) return;
    if (hipMemsetAsync((char*)d_ws + WS_CTL, 0, CTL_ZERO_BYTES, stream) != hipSuccess) { fprintf(stderr, "kernel_launch: memset failed\n"); return; }
    Args a; memset(&a, 0, sizeof(a));
    for (int i = 0; i < 21; ++i) a.in[i] = d_in[i];
    a.out = (float*)d_out; a.ws = (unsigned char*)d_ws;
    hipLaunchKernelGGL(mk_fwd, dim3(grid), dim3(NWAVES * 64), LDS_BYTES, stream, a);
    const hipError_t le = hipPeekAtLastError();
    if (le != hipSuccess) fprintf(stderr, "kernel_launch: launch failed: %s\n", hipGetErrorName(le));
}
```

```cpp
#define USE_GATHER_ROUNDS 1
#include <hip/hip_runtime.h>
#include <cstdio>
#include <cstdint>
#include <cstring>
#include <cmath>
namespace pg8 {
#define PG8_LAS __attribute__((address_space(3)))
typedef unsigned short bf16_t;
typedef short bf16x8 __attribute__((ext_vector_type(8)));
typedef float f32x4 __attribute__((ext_vector_type(4)));
typedef unsigned u32x4 __attribute__((ext_vector_type(4)));
constexpr int BM = 256, BK = 64, HALF = 128, HTB = HALF * BK * 2  , STAGE_BYTES = 8 * HTB, NXCD = 8, WGM = 8;

__host__ __device__ __forceinline__ int lds_byte(int r, int c) { const int st = (r >> 4) * 2 + (c >> 5), rr = r & 15, cc = c & 31, ob = rr * 64 + cc * 2; return st * 1024 + (ob ^ (((ob >> 9) & 1) << 5)); }
__host__ __device__ __forceinline__ void stage_rc(int b, int& R, int& C) { const int st = b / 1024, sb = b % 1024, swz = sb ^ (((sb >> 9) & 1) << 5); R = (st >> 1) * 16 + swz / 64; C = (st & 1) * 32 + (swz % 64) / 2; }
__host__ __device__ __forceinline__ int perm32(int rho) { const int n = rho >> 4, i = rho & 15; return 8 * (i >> 2) + 4 * n + (i & 3); }

struct Unit { int pm, pn; };
struct Gemm { const bf16_t* A; const bf16_t* Bt; int M, N, K; };

struct StaticOrder {
    int nM, nN, nwg, G, c;
    __host__ __device__ void init(int M, int N, int G_, int c_) { nM = M / BM; nN = N / BM; nwg = nM * nN; G = G_; c = c_; }
    __host__ __device__ bool next(int i, Unit& u) const {
        const long L = (long)i * G + c; if (L >= nwg) return false;
        int wgid = (int)L; { const int q = nwg / NXCD, r = nwg % NXCD, xcd = wgid % NXCD, off = wgid / NXCD; wgid = (xcd < r ? xcd * (q + 1) : r * (q + 1) + (xcd - r) * q) + off; }
        const int nig = WGM * nN, gid = wgid / nig, fm = gid * WGM, gsz = (nM - fm) < WGM ? (nM - fm) : WGM;
        u.pm = fm + ((wgid % nig) % gsz); u.pn = (wgid % nig) / gsz; return true;
    }
    __device__ __forceinline__ void a_ready(const Unit&) const {}
    __device__ __forceinline__ void done(const Unit&) const {}
};

__device__ __forceinline__ unsigned cvt_pk_bf16(float lo, float hi) { unsigned r; asm volatile("v_cvt_pk_bf16_f32 %0, %1, %2" : "=v"(r) : "v"(lo), "v"(hi)); return r; }
typedef float f32x2 __attribute__((ext_vector_type(2)));
__device__ __forceinline__ f32x2 gelu_pk(f32x2 v) {
    const f32x2 av = __builtin_elementwise_abs(v), d = av * 0.2316418882f + 1.0f;
    f32x2 t; t.x = __builtin_amdgcn_rcpf(d.x); t.y = __builtin_amdgcn_rcpf(d.y);
    f32x2 q = t * 0.5307027145f + (-0.7265760135f); q = q * t + 0.7107068705f; q = q * t + (-0.142248368f); q = q * t + 0.127414796f; q = q * t;
    const f32x2 s = (v * v) * (-0.72134752044f);
    f32x2 e; e.x = __builtin_amdgcn_exp2f(s.x); e.y = __builtin_amdgcn_exp2f(s.y);
    const f32x2 m = v * (q * e), r = v - m;
    f32x2 o; o.x = v.x < 0.f ? m.x : r.x; o.y = v.y < 0.f ? m.y : r.y; return o;
}

template <int ACT  > struct EpiBf16 {
    static constexpr bool PERM = true, AFTER_DRAIN = false; static_assert(ACT == 0 || ACT == 1, "EpiBf16: ACT is 0 (none) or 1 (gelu_pk)");
    bf16_t* O; int ldc; const float* bias; int split_cols; size_t split_stride; float scale0;
    __device__ __forceinline__ void operator()(const f32x4 (&acc)[2][2][4][2], const Unit& u, int wr, int wc, int fr, int fq) const {
        const int row0 = u.pm * BM + wr * 64 + fr; int colt = u.pn * BM; bf16_t* base = O;
        float sc = 1.f; if (split_cols) { const int t = colt / split_cols; base += (size_t)t * split_stride; colt -= t * split_cols; if (t == 0) sc = scale0; }
        const int col0 = colt + wc * 32 + 8 * fq, bcol0 = u.pn * BM + wc * 32 + 8 * fq;
        f32x4 bv[2][2];
#pragma unroll
        for (int bj = 0; bj < 2; ++bj)
#pragma unroll
            for (int n = 0; n < 2; ++n) bv[bj][n] = bias ? *(const f32x4*)(bias + bcol0 + bj * HALF + 4 * n) : (f32x4){0.f, 0.f, 0.f, 0.f};
#pragma unroll
        for (int ai = 0; ai < 2; ++ai)
#pragma unroll
            for (int m = 0; m < 4; ++m) { bf16_t* rowp = base + (size_t)(row0 + ai * HALF + m * 16) * ldc + col0;
#pragma unroll
                for (int bj = 0; bj < 2; ++bj) { f32x4 v0 = acc[ai][bj][m][0] + bv[bj][0], v1 = acc[ai][bj][m][1] + bv[bj][1];
                    if (ACT == 1) { f32x2 a = gelu_pk((f32x2){v0[0], v0[1]}), b = gelu_pk((f32x2){v0[2], v0[3]}), c = gelu_pk((f32x2){v1[0], v1[1]}), d = gelu_pk((f32x2){v1[2], v1[3]});
                        v0 = (f32x4){a.x, a.y, b.x, b.y}; v1 = (f32x4){c.x, c.y, d.x, d.y}; }
                    v0 = v0 * sc; v1 = v1 * sc; u32x4 w; w.x = cvt_pk_bf16(v0[0], v0[1]); w.y = cvt_pk_bf16(v0[2], v0[3]); w.z = cvt_pk_bf16(v1[0], v1[1]); w.w = cvt_pk_bf16(v1[2], v1[3]);
                    *(u32x4*)(rowp + bj * HALF) = w; } }
    }
};
template <class Epi, class Sched, bool ALIGN_EPI = false, bool SP2 = false>
__device__ __forceinline__ void gemm_phase(PG8_LAS unsigned char* lds, const Gemm g, const Sched& S, const Epi& E) {
    int tid_ = threadIdx.x; asm volatile("" : "+v"(tid_));
    const int tid = tid_, wid = __builtin_amdgcn_readfirstlane(tid >> 6), lane = tid & 63, wr = wid >> 2, wc = wid & 3, fr = lane & 15, fq = lane >> 4;
    const int K = g.K, nt = K / BK;
    unsigned voffA[2], voffB[2];
#pragma unroll
    for (int i = 0; i < 2; ++i) { int R, C; stage_rc(tid * 16 + i * 8192, R, C); const int Rb = Epi::PERM ? ((R & ~31) + perm32(R & 31)) : R;
        voffA[i] = (unsigned)(R * K + C) * 2u; voffB[i] = (unsigned)(Rb * K + C) * 2u; }
    const size_t kstep = (size_t)(BK * 2);
    const size_t hstep = (size_t)HALF * K * 2;
    const size_t tstep = 2 * hstep;
    const unsigned ldsw = (unsigned)wid * 1024u;
    const int aoff = lds_byte(wr * 64 + fr, fq * 8), boff = lds_byte(wc * 32 + fr, fq * 8);
#define PG8_SA(b, h) (((b) * 2 + (h)) * HTB)
#define PG8_SB(b, h) ((4 + (b) * 2 + (h)) * HTB)
#define PG8_STAGE(bufoff, gbase, voff) do { _Pragma("unroll") for (int _i = 0; _i < 2; ++_i) \
        __builtin_amdgcn_global_load_lds((const unsigned*)((const char*)(gbase) + (voff)[_i]), (PG8_LAS unsigned*)(lds + (bufoff) + ldsw + _i * 8192), 16, 0, 0); } while (0)
#define PG8_LDA(dst, b, h) do { _Pragma("unroll") for (int m = 0; m < 4; ++m) _Pragma("unroll") for (int k = 0; k < 2; ++k) dst[m][k] = *(const PG8_LAS bf16x8*)(lds + PG8_SA(b, h) + aoff + m * 2048 + k * 1024); } while (0)
#define PG8_LDB(dst, b, h) do { _Pragma("unroll") for (int n = 0; n < 2; ++n) _Pragma("unroll") for (int k = 0; k < 2; ++k) dst[n][k] = *(const PG8_LAS bf16x8*)(lds + PG8_SB(b, h) + boff + n * 2048 + k * 1024); } while (0)
#define PG8_MMA(ai, bj, At, Bt) do { __builtin_amdgcn_s_setprio(1); _Pragma("unroll") for (int m = 0; m < 4; ++m) _Pragma("unroll") for (int n = 0; n < 2; ++n) _Pragma("unroll") for (int k = 0; k < 2; ++k) \
        acc[ai][bj][m][n] = __builtin_amdgcn_mfma_f32_16x16x32_bf16(Bt[n][k], At[m][k], acc[ai][bj][m][n], 0, 0, 0); __builtin_amdgcn_s_setprio(0); } while (0)
#define PG8_WAIT_V(n) asm volatile("s_waitcnt vmcnt(" #n ")" ::: "memory")
#define PG8_WAIT_L(n) asm volatile("s_waitcnt lgkmcnt(" #n ")" ::: "memory")
#define PG8_BAR __builtin_amdgcn_s_barrier()
#define PG8_SCHED __builtin_amdgcn_sched_barrier(0)
    Unit cur, nxt; int ui = 0;
    if (!S.next(0, cur)) return;
    f32x4 acc[2][2][4][2];
#pragma unroll
    for (int a = 0; a < 2; ++a)
#pragma unroll
        for (int b = 0; b < 2; ++b)
#pragma unroll
            for (int m = 0; m < 4; ++m)
#pragma unroll
                for (int n = 0; n < 2; ++n) acc[a][b][m][n] = (f32x4){0.f, 0.f, 0.f, 0.f};
    bf16x8 At[4][2], B0[2][2], B1[2][2];
    const char* cA = (const char*)g.A + (size_t)cur.pm * tstep; const char* cB = (const char*)g.Bt + (size_t)cur.pn * tstep;
    S.a_ready(cur);
    if constexpr (SP2) {
        PG8_STAGE(PG8_SB(0, 0), cB, voffB); PG8_STAGE(PG8_SB(0, 1), cB + hstep, voffB); PG8_STAGE(PG8_SA(0, 0), cA, voffA); PG8_STAGE(PG8_SA(0, 1), cA + hstep, voffA);
        if (wr == 1) PG8_BAR;
        PG8_WAIT_V(2); PG8_BAR;
        PG8_STAGE(PG8_SB(1, 0), cB + kstep, voffB); PG8_STAGE(PG8_SA(1, 0), cA + kstep, voffA); PG8_STAGE(PG8_SB(1, 1), cB + hstep + kstep, voffB);
        PG8_WAIT_V(6); PG8_BAR;
    } else {
        PG8_STAGE(PG8_SB(0, 0), cB, voffB); PG8_STAGE(PG8_SA(0, 0), cA, voffA); PG8_STAGE(PG8_SB(0, 1), cB + hstep, voffB); PG8_STAGE(PG8_SA(0, 1), cA + hstep, voffA);
        if (wr == 1) PG8_BAR;
        PG8_WAIT_V(4); PG8_BAR;
        PG8_STAGE(PG8_SB(1, 0), cB + kstep, voffB); PG8_STAGE(PG8_SA(1, 0), cA + kstep, voffA); PG8_STAGE(PG8_SB(1, 1), cB + hstep + kstep, voffB);
        PG8_WAIT_V(6); PG8_BAR;
    }
    for (;;) {
        const bool has_next = S.next(ui + 1, nxt);
        const char* nA = has_next ? (const char*)g.A + (size_t)nxt.pm * tstep : cA; const char* nB = has_next ? (const char*)g.Bt + (size_t)nxt.pn * tstep : cB;
        for (int t = 0; t < nt; t += 2) {
            const bool last = (t == nt - 2);
            const char* a1 = cA + (size_t)(t + 1) * kstep;
            const char* a2 = last ? nA : cA + (size_t)(t + 2) * kstep; const char* b2 = last ? nB : cB + (size_t)(t + 2) * kstep;
            const char* a3 = a2 + kstep; const char* b3 = b2 + kstep;
            if (last && has_next) S.a_ready(nxt);
            if constexpr (SP2) {
            PG8_LDB(B0, 0, 0); PG8_LDB(B1, 0, 1); PG8_SCHED; PG8_LDA(At, 0, 0); PG8_STAGE(PG8_SA(1, 1), a1 + hstep, voffA);
            PG8_WAIT_V(8); PG8_WAIT_L(0); PG8_BAR; PG8_MMA(0, 0, At, B0); PG8_MMA(0, 1, At, B1); PG8_BAR; PG8_SCHED;
            PG8_LDA(At, 0, 1); PG8_STAGE(PG8_SB(0, 0), b2, voffB); PG8_STAGE(PG8_SB(0, 1), b2 + hstep, voffB); PG8_STAGE(PG8_SA(0, 0), a2, voffA);
            PG8_WAIT_V(8); PG8_WAIT_L(0); PG8_BAR; PG8_MMA(1, 0, At, B0); PG8_MMA(1, 1, At, B1); PG8_BAR; PG8_SCHED;
            PG8_LDB(B0, 1, 0); PG8_LDB(B1, 1, 1); PG8_SCHED; PG8_LDA(At, 1, 0); PG8_STAGE(PG8_SA(0, 1), a2 + hstep, voffA);
            PG8_WAIT_V(8); PG8_WAIT_L(0); PG8_BAR; PG8_MMA(0, 0, At, B0); PG8_MMA(0, 1, At, B1); PG8_BAR; PG8_SCHED;
            PG8_LDA(At, 1, 1); PG8_STAGE(PG8_SB(1, 0), b3, voffB); PG8_STAGE(PG8_SB(1, 1), b3 + hstep, voffB); PG8_STAGE(PG8_SA(1, 0), a3, voffA);
            PG8_WAIT_V(8); PG8_WAIT_L(0); PG8_BAR; PG8_MMA(1, 0, At, B0); PG8_MMA(1, 1, At, B1); PG8_BAR; PG8_SCHED;
            } else {
            PG8_LDB(B0, 0, 0); PG8_SCHED; PG8_LDA(At, 0, 0); PG8_STAGE(PG8_SA(1, 1), a1 + hstep, voffA);
            PG8_WAIT_L(8); PG8_BAR; PG8_WAIT_L(0); PG8_MMA(0, 0, At, B0); PG8_BAR; PG8_SCHED;
            PG8_LDB(B1, 0, 1); PG8_STAGE(PG8_SB(0, 0), b2, voffB);
            PG8_BAR; PG8_WAIT_L(0); PG8_MMA(0, 1, At, B1); PG8_BAR;
            PG8_LDA(At, 0, 1); PG8_STAGE(PG8_SA(0, 0), a2, voffA);
            PG8_BAR; PG8_WAIT_L(0); PG8_MMA(1, 0, At, B0); PG8_BAR; PG8_SCHED;
            PG8_STAGE(PG8_SB(0, 1), b2 + hstep, voffB);
            PG8_WAIT_V(6); PG8_BAR; PG8_MMA(1, 1, At, B1); PG8_BAR;
            PG8_LDB(B0, 1, 0); PG8_SCHED; PG8_LDA(At, 1, 0); PG8_STAGE(PG8_SA(0, 1), a2 + hstep, voffA);
            PG8_WAIT_L(8); PG8_BAR; PG8_WAIT_L(0); PG8_MMA(0, 0, At, B0); PG8_BAR; PG8_SCHED;
            PG8_LDB(B1, 1, 1); PG8_STAGE(PG8_SB(1, 0), b3, voffB);
            PG8_BAR; PG8_WAIT_L(0); PG8_MMA(0, 1, At, B1); PG8_BAR;
            PG8_LDA(At, 1, 1); PG8_STAGE(PG8_SA(1, 0), a3, voffA);
            PG8_BAR; PG8_WAIT_L(0); PG8_MMA(1, 0, At, B0); PG8_BAR; PG8_SCHED;
            PG8_STAGE(PG8_SB(1, 1), b3 + hstep, voffB);
            PG8_WAIT_V(6); PG8_BAR; PG8_MMA(1, 1, At, B1); PG8_BAR;
            }
        }
        if constexpr (ALIGN_EPI) { if (wr == 0) PG8_BAR; }
        if constexpr (!Epi::AFTER_DRAIN) { E(acc, cur, wr, wc, fr, fq); S.done(cur); }
        if (!has_next) break;
#pragma unroll
        for (int a = 0; a < 2; ++a)
#pragma unroll
            for (int b = 0; b < 2; ++b)
#pragma unroll
                for (int m = 0; m < 4; ++m)
#pragma unroll
                    for (int n = 0; n < 2; ++n) acc[a][b][m][n] = (f32x4){0.f, 0.f, 0.f, 0.f};
        cur = nxt; cA = nA; cB = nB; ++ui;
        if constexpr (ALIGN_EPI) { if (wr == 1) PG8_BAR; }
    }
    PG8_WAIT_V(0);
    if constexpr (!ALIGN_EPI) { if (wr == 0) PG8_BAR; }
    PG8_BAR;
    if constexpr (Epi::AFTER_DRAIN) { E.fused(acc, cur, wr, wc, fr, fq, lds, wid, lane); S.done(cur); }
#undef PG8_SA
#undef PG8_SB
#undef PG8_STAGE
#undef PG8_LDA
#undef PG8_LDB
#undef PG8_MMA
#undef PG8_WAIT_V
#undef PG8_WAIT_L
#undef PG8_BAR
#undef PG8_SCHED
}
}
namespace pg8 {
typedef unsigned u32x2 __attribute__((ext_vector_type(2)));
__device__ __forceinline__ float gelu_tanh(float x) {
    const float e = __builtin_amdgcn_exp2f(x * (-2.302208198f - 0.1029432397f * x * x));
    return x * __builtin_amdgcn_rcpf(1.0f + e);
}
__device__ __forceinline__ float silu_f(float x) { return x * __builtin_amdgcn_rcpf(1.0f + __builtin_amdgcn_exp2f(-1.4426950409f * x)); }

struct EpiRetProj {
    static constexpr bool PERM = false, AFTER_DRAIN = false;
    bf16_t *Q, *K, *V, *G; const float *cosT, *sinT;
    __device__ __forceinline__ void operator()(const f32x4 (&acc)[2][2][4][2], const Unit& u, int wr, int wc, int fr, int fq) const {
        const int pn = u.pn;
        if (pn < 8) {
            bf16_t* dst = pn < 4 ? Q : K; const int head = pn & 3; const float sc = pn < 4 ? 1.0f : 0.0625f;
#pragma unroll
            for (int ai = 0; ai < 2; ++ai)
#pragma unroll
                for (int m = 0; m < 4; ++m) {
                    const int row = u.pm * BM + ai * HALF + wr * 64 + m * 16 + fr;
#pragma unroll
                    for (int n = 0; n < 2; ++n) {
                        const int f0 = wc * 32 + n * 16 + fq * 4;
                        const f32x4 c4 = *(const f32x4*)(cosT + (size_t)row * 128 + f0), s4 = *(const f32x4*)(sinT + (size_t)row * 128 + f0);
                        const f32x4 x1 = acc[ai][0][m][n], x2 = acc[ai][1][m][n];
                        const f32x4 o1 = (x1 * c4 - x2 * s4) * sc, o2 = (x1 * s4 + x2 * c4) * sc;
                        u32x2 w1, w2; w1.x = cvt_pk_bf16(o1[0], o1[1]); w1.y = cvt_pk_bf16(o1[2], o1[3]); w2.x = cvt_pk_bf16(o2[0], o2[1]); w2.y = cvt_pk_bf16(o2[2], o2[3]);
                        bf16_t* p = dst + (size_t)row * 1024 + head * 256 + f0;
                        *(u32x2*)p = w1; *(u32x2*)(p + 128) = w2;
                    }
                }
        } else {
            const bool isg = pn >= 16; bf16_t* dst = isg ? G : V; const int colbase = ((pn - 8) & 7) * 256;
#pragma unroll
            for (int ai = 0; ai < 2; ++ai)
#pragma unroll
                for (int m = 0; m < 4; ++m) {
                    const int row = u.pm * BM + ai * HALF + wr * 64 + m * 16 + fr;
#pragma unroll
                    for (int bj = 0; bj < 2; ++bj)
#pragma unroll
                        for (int n = 0; n < 2; ++n) {
                            f32x4 v = acc[ai][bj][m][n];
                            if (isg) { v[0] = silu_f(v[0]); v[1] = silu_f(v[1]); v[2] = silu_f(v[2]); v[3] = silu_f(v[3]); }
                            u32x2 w; w.x = cvt_pk_bf16(v[0], v[1]); w.y = cvt_pk_bf16(v[2], v[3]);
                            *(u32x2*)(dst + (size_t)row * 2048 + colbase + bj * HALF + wc * 32 + n * 16 + fq * 4) = w;
                        }
                }
        }
    }
};
struct EpiResGate {
    static constexpr bool PERM = false, AFTER_DRAIN = false;
    const float* base; float* out; const float* gate; int gstride;
    __device__ __forceinline__ void operator()(const f32x4 (&acc)[2][2][4][2], const Unit& u, int wr, int wc, int fr, int fq) const {
        const int b = (u.pm * BM) >> 13; const float* gp = gate + (size_t)b * gstride;
        const int col0 = u.pn * BM + wc * 32 + 4 * fq;
        f32x4 gv[2][2];
#pragma unroll
        for (int bj = 0; bj < 2; ++bj)
#pragma unroll
            for (int n = 0; n < 2; ++n) gv[bj][n] = *(const f32x4*)(gp + col0 + bj * HALF + n * 16);
#pragma unroll
        for (int ai = 0; ai < 2; ++ai)
#pragma unroll
            for (int m = 0; m < 4; ++m) {
                const size_t off = (size_t)(u.pm * BM + ai * HALF + wr * 64 + m * 16 + fr) * 1024 + col0;
#pragma unroll
                for (int bj = 0; bj < 2; ++bj)
#pragma unroll
                    for (int n = 0; n < 2; ++n) { const f32x4 bs = *(const f32x4*)(base + off + bj * HALF + n * 16); *(f32x4*)(out + off + bj * HALF + n * 16) = bs + gv[bj][n] * acc[ai][bj][m][n]; }
            }
    }
};
struct EpiSguIn {
    static constexpr bool PERM = true, AFTER_DRAIN = false;
    bf16_t* U; bf16_t* Vb; const float* bias; float* stats;
    __device__ __forceinline__ void operator()(const f32x4 (&acc)[2][2][4][2], const Unit& u, int wr, int wc, int fr, int fq) const {
        const bool isv = u.pn >= 12; bf16_t* base = isv ? Vb : U; const int colt = (isv ? u.pn - 12 : u.pn) * BM;
        const int col0 = colt + wc * 32 + 8 * fq, bcol0 = u.pn * BM + wc * 32 + 8 * fq;
        f32x4 bv[2][2];
#pragma unroll
        for (int bj = 0; bj < 2; ++bj)
#pragma unroll
            for (int n = 0; n < 2; ++n) bv[bj][n] = *(const f32x4*)(bias + bcol0 + bj * HALF + 4 * n);
#pragma unroll
        for (int ai = 0; ai < 2; ++ai)
#pragma unroll
            for (int m = 0; m < 4; ++m) {
                const int row = u.pm * BM + ai * HALF + wr * 64 + m * 16 + fr;
                bf16_t* rowp = base + (size_t)row * 3072 + col0;
                float s1 = 0.f, s2 = 0.f;
#pragma unroll
                for (int bj = 0; bj < 2; ++bj) {
                    f32x4 v0 = acc[ai][bj][m][0] + bv[bj][0], v1 = acc[ai][bj][m][1] + bv[bj][1];
#pragma unroll
                    for (int j = 0; j < 4; ++j) { v0[j] = gelu_tanh(v0[j]); v1[j] = gelu_tanh(v1[j]); }
                    u32x4 w; w.x = cvt_pk_bf16(v0[0], v0[1]); w.y = cvt_pk_bf16(v0[2], v0[3]); w.z = cvt_pk_bf16(v1[0], v1[1]); w.w = cvt_pk_bf16(v1[2], v1[3]);
                    *(u32x4*)(rowp + bj * HALF) = w;
                    if (isv) {
#pragma unroll
                        for (int j = 0; j < 4; ++j) { const unsigned ww = j == 0 ? w.x : j == 1 ? w.y : j == 2 ? w.z : w.w;
                            const float a = __uint_as_float(ww << 16), bq = __uint_as_float(ww & 0xffff0000u); s1 += a + bq; s2 += a * a + bq * bq; }
                    }
                }
                if (isv) {
                    s1 += __shfl_xor(s1, 16); s1 += __shfl_xor(s1, 32); s2 += __shfl_xor(s2, 16); s2 += __shfl_xor(s2, 32);
                    if (fq == 0) { float* sp = stats + ((size_t)row * 48 + (u.pn - 12) * 4 + wc) * 2; sp[0] = s1; sp[1] = s2; }
                }
            }
    }
};
}
typedef unsigned u32x4 __attribute__((ext_vector_type(4)));
#define GAS __attribute__((address_space(1)))
#define LAS __attribute__((address_space(3)))
typedef unsigned short bf16;
typedef unsigned v4u __attribute__((ext_vector_type(4)));
typedef float f32x4 __attribute__((ext_vector_type(4)));
typedef short bf16x8 __attribute__((ext_vector_type(8)));
typedef GAS unsigned gu32;
typedef GAS unsigned long long gu64;
#define RLX_AGENT __ATOMIC_RELAXED, __HIP_MEMORY_SCOPE_AGENT
#define LDS_WAIT() asm volatile("s_waitcnt lgkmcnt(0)" ::: "memory")
#define VM_WAIT() asm volatile("s_waitcnt vmcnt(0)" ::: "memory")
__device__ __forceinline__ unsigned long long rt() { return __builtin_amdgcn_s_memrealtime(); }
__device__ __forceinline__ unsigned f2bf(float f) { unsigned u = __builtin_bit_cast(unsigned, f); return (u + 0x7fffu + ((u >> 16) & 1u)) >> 16; }
__device__ __forceinline__ unsigned pk2(float lo, float hi) { return f2bf(lo) | (f2bf(hi) << 16); }

#define XB_TMO      128
#define XB_XCNT(j)  (256  + 64 * (j))
#define XB_XSUB(j)  (1280 + 64 * (j))
#define XB_XGEN(j)  (2304 + 64 * (j))
#define XB_TOP      3328
#define XB_TOPGEN   3392
#define XCD_BAR_WORDS 3456
#define XB_SPIN_CAP (1u << 18)

__device__ __forceinline__ unsigned xb_ld(unsigned* p)              { return __hip_atomic_load(p, __ATOMIC_RELAXED, __HIP_MEMORY_SCOPE_AGENT); }
__device__ __forceinline__ unsigned xb_add(unsigned* p, unsigned v) { return __hip_atomic_fetch_add(p, v, __ATOMIC_RELAXED, __HIP_MEMORY_SCOPE_AGENT); }
__device__ __forceinline__ unsigned xb_xcc_id() { return (unsigned)__builtin_amdgcn_s_getreg((3 << 11) | 20) & 0xFu; }
#define XB_SPIN(cond, bar) do { unsigned _sp = 0; while (cond) { __builtin_amdgcn_s_sleep(1); \
    if ((++_sp & 255u) == 0u) { if (xb_ld(&(bar)[XB_TMO])) break; if (_sp > XB_SPIN_CAP) { atomicAdd(&(bar)[XB_TMO], 1u); break; } } } } while (0)

struct XcdBarrier {
    unsigned* bar; unsigned x;
    volatile LAS unsigned* st;
};

__device__ __forceinline__ XcdBarrier xcd_barrier_post(unsigned* bar, volatile LAS unsigned* st) {
    XcdBarrier b; b.bar = bar; b.x = xb_xcc_id(); b.st = st;
    if (threadIdx.x == 0) (void)xb_add(&bar[XB_XCNT(b.x)], 1u);
    return b;
}
__device__ __forceinline__ void xcd_barrier_complete(unsigned* bar, unsigned x, unsigned& nloc, unsigned& nx) {
    const unsigned G = gridDim.x * gridDim.y * gridDim.z;
    unsigned sum, cnt, mine, sp = 0u;
    for (;;) {
        sum = 0u; cnt = 0u; mine = 0u;
#pragma unroll
        for (unsigned j = 0; j < 16; ++j) { const unsigned c = xb_ld(&bar[XB_XCNT(j)]); sum += c; cnt += (c > 0u) ? 1u : 0u; mine = (j == x) ? c : mine; }
        if (sum == G) break;
        __builtin_amdgcn_s_sleep(1);
        if ((++sp & 255u) == 0u) { if (xb_ld(&bar[XB_TMO])) break; if (sp > XB_SPIN_CAP) { atomicAdd(&bar[XB_TMO], 1u); break; } }
    }
    nloc = mine > 0u ? mine : 1u; nx = cnt > 0u ? cnt : 1u;
}

__device__ __forceinline__ void xcd_barrier(const XcdBarrier& b) {
    asm volatile("s_waitcnt vmcnt(0)" ::: "memory");
    __syncthreads();
    if (threadIdx.x == 0) {
        unsigned* bar = b.bar;
        __builtin_amdgcn_s_waitcnt(0);
        unsigned nloc = b.st[0], nx = b.st[1];
        if (nloc == 0u) { xcd_barrier_complete(bar, b.x, nloc, nx); b.st[0] = nloc; b.st[1] = nx; }
        const unsigned old = xb_add(&bar[XB_XSUB(b.x)], 1u);
        const unsigned gen = old / nloc;
        if (old + 1u == (gen + 1u) * nloc) {
            __builtin_amdgcn_fence(__ATOMIC_RELEASE, "agent");
            asm volatile("s_waitcnt vmcnt(0)" ::: "memory");
            const unsigned og = xb_add(&bar[XB_TOP], 1u);
            const unsigned tg = og / nx;
            if (og + 1u == (tg + 1u) * nx) xb_add(&bar[XB_TOPGEN], 1u);
            else XB_SPIN(xb_ld(&bar[XB_TOPGEN]) == tg, bar);
            __builtin_amdgcn_fence(__ATOMIC_ACQUIRE, "agent");
            xb_add(&bar[XB_XGEN(b.x)], 1u);
            asm volatile("s_waitcnt vmcnt(0)" ::: "memory");
        } else {
            XB_SPIN(xb_ld(&bar[XB_XGEN(b.x)]) == gen, bar);
            __builtin_amdgcn_fence(__ATOMIC_ACQUIRE, "agent");
            asm volatile("s_waitcnt vmcnt(0)" ::: "memory");
        }
    }
    __syncthreads();
}
__device__ __forceinline__ float wave_sum(float v) {
#pragma unroll
    for (int o = 1; o < 64; o <<= 1) v += __shfl_xor(v, o);
    return v;
}
__device__ __forceinline__ void p0_transpose_item(const float* W, int K, int N, bf16* WT, int row_off, LAS float* scr, int item, int lane) {
    const int nblk = N / 32, kb = item / nblk, nb = item % nblk, k0 = 64 * kb, n0 = 32 * nb;
#pragma unroll 8
    for (int i = 0; i < 32; ++i) { const int kk = 2 * i + (lane >> 5); scr[kk * 33 + (lane & 31)] = W[(size_t)(k0 + kk) * N + n0 + (lane & 31)]; }
    LDS_WAIT(); asm volatile("" ::: "memory");
    const int c = lane & 7;
#pragma unroll
    for (int j = 0; j < 4; ++j) { const int n = (lane >> 3) + 8 * j; const LAS float* s = scr + (8 * c) * 33 + n;
        v4u o; o.x = pk2(s[0 * 33], s[1 * 33]); o.y = pk2(s[2 * 33], s[3 * 33]); o.z = pk2(s[4 * 33], s[5 * 33]); o.w = pk2(s[6 * 33], s[7 * 33]);
        *(GAS v4u*)(WT + (size_t)(row_off + n0 + n) * K + k0 + 8 * c) = o; }
    LDS_WAIT(); asm volatile("" ::: "memory");
}
#define DI __device__ __forceinline__
constexpr int NWAVES = 8;
constexpr int TT = 16384, DM = 1024, SEQ = 8192;
constexpr size_t MiB = 1u << 20;
constexpr size_t WS_CTL = 0, CTL_ZERO_BYTES = 32768, WS_MOD = 512 * 1024;
constexpr size_t WS_COS = 2 * MiB, WS_SIN = 10 * MiB;
constexpr size_t WS_WRI = 18 * MiB, WS_WRO = 30 * MiB, WS_WSI = 34 * MiB, WS_WSO = 46 * MiB, WS_WQ = 52 * MiB, WS_KEYS = 60 * MiB;
constexpr size_t WS_ISU = 61 * MiB, WS_ISV = 61 * MiB + 256 * 1024;
constexpr size_t WS_STATS = 62 * MiB, WS_IDX = 68 * MiB, WS_GATE = 76 * MiB, WS_H = 84 * MiB, WS_PU = 116 * MiB, WS_PV = 180 * MiB;
constexpr size_t WS_R = 244 * MiB;
constexpr size_t WS_Q = WS_R, WS_K = WS_R + 32 * MiB, WS_V = WS_R + 64 * MiB, WS_G = WS_R + 128 * MiB, WS_CROSS = WS_R + 192 * MiB;
constexpr size_t WS_QP = WS_R, WS_SC = WS_R + 64 * MiB;
constexpr size_t WS_U = WS_R, WS_VB = WS_R + 96 * MiB;
constexpr size_t WS_END = 500 * MiB;
constexpr int CW_TMO = 0, CW_BAR = 4096;
constexpr int RING_OFF = 0, RING_BYTES = 131072, LDS_BYTES = 163840, LDSCTL_OFF = LDS_BYTES - 1024, MISC_OFF = LDSCTL_OFF + 320;
constexpr int PTR_OFF = LDSCTL_OFF + 512;
constexpr float EPS = 1e-6f;
typedef float f32x2_t __attribute__((ext_vector_type(2)));

DI float bf2f(bf16 h) { return __uint_as_float((unsigned)h << 16); }
DI float bflo(unsigned w) { return __uint_as_float(w << 16); }
DI float bfhi(unsigned w) { return __uint_as_float(w & 0xffff0000u); }
DI float wave_max(float v) {
#pragma unroll
    for (int o = 1; o < 64; o <<= 1) v = fmaxf(v, __shfl_xor(v, o));
    return v;
}
DI float gelu_t(float x) { return pg8::gelu_tanh(x); }

struct Ctx {
    LAS unsigned char* lds; int tid, lane, wave, vcu, G;
    unsigned char* ws;
};

DI const void* ldp(const Ctx& C, int i) {
    const unsigned long long v = ((const LAS unsigned long long*)(C.lds + PTR_OFF))[i];
    const unsigned lo = __builtin_amdgcn_readfirstlane((unsigned)v), hi = __builtin_amdgcn_readfirstlane((unsigned)(v >> 32));
    return (const void*)(((unsigned long long)hi << 32) | lo);
}
DI void cvt_rows_fp8(const float* src, unsigned char* dst, float* inv_scale, int nrows, int gw, int NGW, int lane) {
    for (int r = gw; r < nrows; r += NGW) {
        const f32x4* s = (const f32x4*)(src + (size_t)r * 1024) + lane * 4;
        f32x4 v[4]; float am = 0.f;
#pragma unroll
        for (int q = 0; q < 4; ++q) { v[q] = s[q]; am = fmaxf(am, fmaxf(fmaxf(fabsf(v[q][0]), fabsf(v[q][1])), fmaxf(fabsf(v[q][2]), fabsf(v[q][3])))); }
        am = wave_max(am);
        const int e = (int)((__float_as_uint(am) >> 23) & 0xffu) - 127;
        const bool ok = am > 1e-30f;
        const float sc = ok ? __uint_as_float((unsigned)(127 + 7 - e) << 23) : 1.0f, isc = ok ? __uint_as_float((unsigned)(127 - 7 + e) << 23) : 1.0f;
        u32x4 o;
#pragma unroll
        for (int q = 0; q < 4; ++q) { int wd = __builtin_amdgcn_cvt_pk_fp8_f32(v[q][0] * sc, v[q][1] * sc, 0, false); wd = __builtin_amdgcn_cvt_pk_fp8_f32(v[q][2] * sc, v[q][3] * sc, wd, true); o[q] = (unsigned)wd; }
        *(u32x4*)(dst + (size_t)r * 1024 + lane * 16) = o;
        if (lane == 0) inv_scale[r] = isc;
    }
}
DI void cvt_rows_i8(const float* src, unsigned char* dst, float* inv_scale, int nrows, int gw, int NGW, int lane) {
    for (int r = gw; r < nrows; r += NGW) {
        const f32x4* s = (const f32x4*)(src + (size_t)r * 1024) + lane * 4;
        f32x4 v[4]; float am = 0.f;
#pragma unroll
        for (int q = 0; q < 4; ++q) { v[q] = s[q]; am = fmaxf(am, fmaxf(fmaxf(fabsf(v[q][0]), fabsf(v[q][1])), fmaxf(fabsf(v[q][2]), fabsf(v[q][3])))); }
        am = wave_max(am);
        const int e = (int)((__float_as_uint(am) >> 23) & 0xffu) - 127;
        const bool ok = am > 1e-30f;
        const float sc = ok ? __uint_as_float((unsigned)(127 + 6 - e) << 23) : 1.0f, isc = ok ? __uint_as_float((unsigned)(127 - 6 + e) << 23) : 1.0f;
        u32x4 o;
#pragma unroll
        for (int q = 0; q < 4; ++q) { unsigned wd = 0u;
#pragma unroll
            for (int j = 0; j < 4; ++j) { int qi = (int)rintf(v[q][j] * sc); qi = qi > 127 ? 127 : (qi < -127 ? -127 : qi); wd |= ((unsigned)qi & 0xffu) << (8 * j); }
            o[q] = wd; }
        *(u32x4*)(dst + (size_t)r * 1024 + lane * 16) = o;
        if (lane == 0) inv_scale[r] = isc;
    }
}
DI void cvt_stream(const float* src, bf16* dst, size_t n4, size_t gtid, size_t gthreads) {
    const f32x4* s = (const f32x4*)src; uint2* d = (uint2*)dst;
    for (size_t i = gtid; i < n4; i += gthreads) { const f32x4 v = s[i]; uint2 o; o.x = pk2(v.x, v.y); o.y = pk2(v.z, v.w); d[i] = o; }
}
struct P0In { const float *c, *ada_w, *ada_b, *ret_w_in, *ret_w_out, *sgu_w_in, *sgu_w_out, *wq, *keys, *pu, *pv; const int* pos; };
DI void p0_prologue(const Ctx& C, const P0In& I) {
    LAS float* scr = (LAS float*)(C.lds + RING_OFF + C.wave * 16384);
    const int gw = C.vcu * NWAVES + C.wave, NGW = C.G * NWAVES;
    bf16* wri = (bf16*)(C.ws + WS_WRI); bf16* wro = (bf16*)(C.ws + WS_WRO);
    constexpr int I_RI = 16 * 192, I_RO = 32 * 32;
    constexpr int NITEMS = I_RI + I_RO;
    for (int it = gw; it < NITEMS; it += NGW) {
        int r = it;
        if (r < I_RI) { p0_transpose_item(I.ret_w_in, 1024, 6144, wri, 0, scr, r, C.lane); continue; } r -= I_RI;
        p0_transpose_item(I.ret_w_out, 2048, 1024, wro, 0, scr, r, C.lane);
    }
    const size_t gtid = (size_t)C.vcu * 512 + C.tid, gth = (size_t)C.G * 512;
    cvt_stream(I.keys, (bf16*)(C.ws + WS_KEYS), (size_t)2 * 8 * 2 * 128 * 128 / 4, gtid, gth);
    float* mod = (float*)(C.ws + WS_MOD);
    __syncthreads();
    for (int it = C.vcu; it < 2 * 96; it += C.G) {
        const int l = it / 96, cb = it % 96, kp = C.wave, n = cb * 64 + C.lane;
        const float* W = I.ada_w + (size_t)l * 1024 * 6144 + n;
        float a0 = 0.f, a1 = 0.f;
#pragma unroll 8
        for (int k = kp * 128; k < kp * 128 + 128; ++k) {
            const float w = W[(size_t)k * 6144]; const float c0 = I.c[k], c1 = I.c[1024 + k];
            a0 += pg8::silu_f(c0) * w; a1 += pg8::silu_f(c1) * w;
        }
        LAS float* red = (LAS float*)(C.lds + RING_OFF);
        red[(kp * 2 + 0) * 64 + C.lane] = a0; red[(kp * 2 + 1) * 64 + C.lane] = a1;
        __syncthreads();
        if (C.wave < 2) { float s = I.ada_b[l * 6144 + n];
#pragma unroll
            for (int q = 0; q < 8; ++q) s += red[(q * 2 + C.wave) * 64 + C.lane];
            mod[(size_t)(l * 2 + C.wave) * 6144 + n] = s; }
        __syncthreads();
    }
    float* cosT = (float*)(C.ws + WS_COS); float* sinT = (float*)(C.ws + WS_SIN);
    for (int it = gw; it < TT / 2; it += NGW) {
        const int row = 2 * it + (C.lane >> 5), f0 = (C.lane & 31) * 4; const float p = (float)I.pos[row];
        f32x4 cv, sv;
#pragma unroll
        for (int j = 0; j < 4; ++j) { const int f = f0 + j; double w = 1.0, bs = 0.93057204092969898;
#pragma unroll
            for (int bit = 0; bit < 7; ++bit) { if ((f >> bit) & 1) w *= bs; bs *= bs; }
            const float ang = p * (float)w; const double r = (double)ang * 0.15915494309189535; const float fr = (float)(r - floor(r)); cv[j] = __builtin_amdgcn_cosf(fr); sv[j] = __builtin_amdgcn_sinf(fr); }
        *(f32x4*)(cosT + (size_t)row * 128 + f0) = cv; *(f32x4*)(sinT + (size_t)row * 128 + f0) = sv;
    }
}
DI void side_work(const Ctx& C, const P0In& I, int nskip) {
    LAS float* scr = (LAS float*)(C.lds + RING_OFF + C.wave * 16384);
    const int gw = (C.vcu - nskip) * NWAVES + C.wave, NGW = (C.G - nskip) * NWAVES;
    bf16* wsi = (bf16*)(C.ws + WS_WSI); bf16* wso = (bf16*)(C.ws + WS_WSO); bf16* wq = (bf16*)(C.ws + WS_WQ);
    constexpr int I_SI = 16 * 192, I_SO = 48 * 32, I_Q = 16 * 64;
    constexpr int NITEMS = I_SI + I_SO + 2 * I_Q;
    for (int it = gw; it < NITEMS; it += NGW) {
        int r = it;
        if (r < I_SI) { p0_transpose_item(I.sgu_w_in, 1024, 6144, wsi, 0, scr, r, C.lane); continue; } r -= I_SI;
        if (r < I_SO) { p0_transpose_item(I.sgu_w_out, 3072, 1024, wso, 0, scr, r, C.lane); continue; } r -= I_SO;
        if (r < I_Q) { p0_transpose_item(I.wq, 1024, 2048, wq, 0, scr, r, C.lane); continue; } r -= I_Q;
        p0_transpose_item(I.wq + (size_t)1024 * 2048, 1024, 2048, wq + (size_t)2048 * 1024, 0, scr, r, C.lane);
    }
    cvt_rows_i8(I.pu, (unsigned char*)(C.ws + WS_PU), (float*)(C.ws + WS_ISU), 2 * 16384, gw, NGW, C.lane);
    cvt_rows_fp8(I.pv, (unsigned char*)(C.ws + WS_PV), (float*)(C.ws + WS_ISV), 2 * 16384, gw, NGW, C.lane);
}
DI void rms_mod_row(const float* xrow, const float* gain, const float* shift, const float* scale, bf16* orow, int lane) {
    const f32x4* xr = (const f32x4*)xrow + lane; f32x4 v[4]; float s = 0.f;
#pragma unroll
    for (int j = 0; j < 4; ++j) { v[j] = xr[64 * j]; s += (v[j].x * v[j].x + v[j].y * v[j].y) + (v[j].z * v[j].z + v[j].w * v[j].w); }
    const float rstd = 1.0f / sqrtf(wave_sum(s) * (1.0f / 1024.0f) + EPS);
    uint2* o8 = (uint2*)orow + lane;
#pragma unroll
    for (int j = 0; j < 4; ++j) { const f32x4 g = ((const f32x4*)gain)[lane + 64 * j], sh = ((const f32x4*)shift)[lane + 64 * j], sc = ((const f32x4*)scale)[lane + 64 * j];
        const f32x4 y = v[j] * rstd * g * (sc + 1.0f) + sh; uint2 o; o.x = pk2(y.x, y.y); o.y = pk2(y.z, y.w); o8[64 * j] = o; }
}
DI void rms_mod_phase(const Ctx& C, const float* x, const float* gain, const float* mod_l, int sh_off, int sc_off, bf16* H) {
    const int gw = C.vcu * NWAVES + C.wave, NGW = C.G * NWAVES;
    for (int m = gw; m < TT; m += NGW) { const float* ml = mod_l + (size_t)(m >> 13) * 6144; rms_mod_row(x + (size_t)m * DM, gain, ml + sh_off, ml + sc_off, H + (size_t)m * DM, C.lane); }
}

DI void scan_naive(const Ctx& C, const bf16* Q, const bf16* K, const bf16* V, bf16* CROSS) {
    LAS float* Sst = (LAS float*)(C.lds);
    LAS unsigned* Qs = (LAS unsigned*)(C.lds + 16384);
    LAS bf16* Ks = (LAS bf16*)(C.lds + 16384 + 32768);
    LAS float* Vs = (LAS float*)(C.lds + 16384 + 65536);
    const int tid = C.tid;
    for (int item = C.vcu; item < 256; item += C.G) {
        const int b = item >> 7, h = (item >> 5) & 3, es = item & 31;
        const float lg2 = log2f(1.0f - exp2f(-5.0f - (float)h)); const float gc = exp2f(lg2 * 64.0f);
        for (int i = tid; i < 4096; i += 512) Sst[i] = 0.f;
        __syncthreads();
        for (int n = 0; n < 128; ++n) {
            const size_t tok0 = (size_t)b * SEQ + (size_t)n * 64;
            for (int ch = tid; ch < 2048; ch += 512) { const int r = ch >> 5, c = ch & 31;
                const u32x4 q = *(const u32x4*)(Q + (tok0 + r) * 1024 + h * 256 + c * 8); *(LAS u32x4*)(Qs + r * 128 + c * 4) = q;
                const u32x4 k = *(const u32x4*)(K + (tok0 + r) * 1024 + h * 256 + c * 8); *(LAS u32x4*)((LAS unsigned*)Ks + r * 128 + c * 4) = k; }
            for (int o = tid; o < 1024; o += 512) { const int j = o >> 4, e = o & 15; Vs[o] = bf2f(V[(tok0 + j) * 2048 + h * 512 + es * 16 + e]) * exp2f(lg2 * (float)(63 - j)); }
            __syncthreads();
#pragma unroll
            for (int oo = 0; oo < 2; ++oo) { const int o = tid + oo * 512, i = o >> 4, e = o & 15; float acc = 0.f;
#pragma unroll 8
                for (int d2 = 0; d2 < 128; ++d2) { const unsigned q2 = Qs[i * 128 + d2]; acc += bflo(q2) * Sst[(2 * d2) * 16 + e] + bfhi(q2) * Sst[(2 * d2 + 1) * 16 + e]; }
                CROSS[(tok0 + i) * 2048 + h * 512 + es * 16 + e] = (bf16)f2bf(acc * exp2f(lg2 * (float)(i + 1))); }
            __syncthreads();
            { const int e = tid & 15, dg = tid >> 4; float a[8];
#pragma unroll
              for (int r = 0; r < 8; ++r) a[r] = gc * Sst[(dg + 32 * r) * 16 + e];
#pragma unroll 4
              for (int j = 0; j < 64; ++j) { const float vz = Vs[j * 16 + e];
#pragma unroll
                  for (int r = 0; r < 8; ++r) a[r] += bf2f(Ks[j * 256 + dg + 32 * r]) * vz; }
#pragma unroll
              for (int r = 0; r < 8; ++r) Sst[(dg + 32 * r) * 16 + e] = a[r]; }
            __syncthreads();
        }
    }
}
DI void intra_naive(const Ctx& C, const bf16* Q, const bf16* K, const bf16* V, const bf16* CROSS, bf16* G) {
    LAS unsigned* Qs = (LAS unsigned*)(C.lds);
    LAS unsigned* Ks = (LAS unsigned*)(C.lds + 32768);
    LAS float* SC = (LAS float*)(C.lds + 65536);
    LAS float* red = (LAS float*)(C.lds + 65536 + 16384);
    LAS float* rs = red + 512;
    const int tid = C.tid;
    for (int item = C.vcu; item < 1024; item += C.G) {
        const int b = item >> 9, h = (item >> 7) & 3, n = item & 127;
        const float lg2 = log2f(1.0f - exp2f(-5.0f - (float)h));
        const size_t tok0 = (size_t)b * SEQ + (size_t)n * 64;
        for (int ch = tid; ch < 2048; ch += 512) { const int r = ch >> 5, c = ch & 31;
            *(LAS u32x4*)(Qs + r * 128 + c * 4) = *(const u32x4*)(Q + (tok0 + r) * 1024 + h * 256 + c * 8);
            *(LAS u32x4*)(Ks + r * 128 + c * 4) = *(const u32x4*)(K + (tok0 + r) * 1024 + h * 256 + c * 8); }
        __syncthreads();
        { const int i = tid >> 3, jb = (tid & 7) * 8;
#pragma unroll
          for (int jj = 0; jj < 8; ++jj) { const int j = jb + jj; float acc = 0.f;
#pragma unroll 8
              for (int d2 = 0; d2 < 128; ++d2) { const unsigned q2 = Qs[i * 128 + d2], k2 = Ks[j * 128 + d2]; acc += bflo(q2) * bflo(k2) + bfhi(q2) * bfhi(k2); }
              const int dd = i > j ? i - j : j - i; SC[i * 64 + j] = acc * exp2f(lg2 * (float)dd); } }
        __syncthreads();
#pragma unroll 1
        for (int pass = 0; pass < 2; ++pass) { const int e = tid, ib = pass * 32; float y[32];
#pragma unroll
          for (int i = 0; i < 32; ++i) y[i] = 0.f;
          const bf16* vp = V + tok0 * 2048 + h * 512 + e;
#pragma unroll 1
          for (int j4 = 0; j4 < 16; ++j4) {
              const float v0 = bf2f(vp[(size_t)(4 * j4 + 0) * 2048]), v1 = bf2f(vp[(size_t)(4 * j4 + 1) * 2048]), v2 = bf2f(vp[(size_t)(4 * j4 + 2) * 2048]), v3 = bf2f(vp[(size_t)(4 * j4 + 3) * 2048]);
#pragma unroll
              for (int i = 0; i < 32; ++i) { const f32x4 s4 = *(const LAS f32x4*)(SC + (ib + i) * 64 + 4 * j4); y[i] += (s4.x * v0 + s4.y * v1) + (s4.z * v2 + s4.w * v3); }
          }
          const bf16* cp = CROSS + (tok0 + ib) * 2048 + h * 512 + e;
#pragma unroll
          for (int i = 0; i < 32; ++i) { y[i] += bf2f(cp[(size_t)i * 2048]); const float ss = wave_sum(y[i] * y[i]); if (C.lane == 0) red[C.wave * 64 + i] = ss; }
          __syncthreads();
          if (tid < 32) { float s = 0.f;
#pragma unroll
              for (int w = 0; w < 8; ++w) s += red[w * 64 + tid];
              rs[tid] = 1.0f / sqrtf(s * (1.0f / 512.0f) + EPS); }
          __syncthreads();
          bf16* gp = G + (tok0 + ib) * 2048 + h * 512 + e;
#pragma unroll
          for (int i = 0; i < 32; ++i) { const float g = bf2f(gp[(size_t)i * 2048]); gp[(size_t)i * 2048] = (bf16)f2bf(y[i] * rs[i] * g); }
          __syncthreads();
        }
        __syncthreads();
    }
}
DI void peer_scores(const Ctx& C, const bf16* QP, const bf16* KEYS  , float* SCO) {
    const int gw = C.vcu * NWAVES + C.wave, NGW = C.G * NWAVES; const int fr = C.lane & 15, fq = C.lane >> 4;
    for (int it = gw; it < 1024 * 8; it += NGW) {
        const int tt = it >> 3, h = it & 7; const int tok = tt * 16 + fr;
#pragma unroll
        for (int p = 0; p < 2; ++p) {
            bf16x8 qf[4];
#pragma unroll
            for (int ks = 0; ks < 4; ++ks) qf[ks] = *(const bf16x8*)(QP + (size_t)tok * 2048 + h * 256 + p * 128 + ks * 32 + fq * 8);
            const bf16* kb = KEYS + (size_t)(h * 2 + p) * 128 * 128;
#pragma unroll
            for (int kt = 0; kt < 8; ++kt) {
                f32x4 acc = {0.f, 0.f, 0.f, 0.f};
#pragma unroll
                for (int ks = 0; ks < 4; ++ks) { const bf16x8 kf = *(const bf16x8*)(kb + (size_t)(kt * 16 + fr) * 128 + ks * 32 + fq * 8);
                    acc = __builtin_amdgcn_mfma_f32_16x16x32_bf16(kf, qf[ks], acc, 0, 0, 0); }
                *(f32x4*)(SCO + ((size_t)tok * 8 + h) * 256 + p * 128 + kt * 16 + fq * 4) = acc;
            }
        }
    }
}
template <bool HALVES> DI void select16(const float (&v)[4], int lane, bool (&sel)[4], int (&pos)[4]) {
    float mx = fmaxf(fmaxf(v[0], v[1]), fmaxf(v[2], v[3])), mn = fminf(fminf(v[0], v[1]), fminf(v[2], v[3]));
#pragma unroll
    for (int o = 1; o < (HALVES ? 32 : 64); o <<= 1) { mx = fmaxf(mx, __shfl_xor(mx, o)); mn = fminf(mn, __shfl_xor(mn, o)); }
    const bool up = HALVES && lane >= 32;
    float lo = mn, hi = mx, thr = mn; bool done = false;
    for (int iter = 0; iter < 48; ++iter) {
        const float mid = done ? thr : 0.5f * (lo + hi);
        int cnt = 0;
#pragma unroll
        for (int c = 0; c < 4; ++c) { const unsigned long long m = __ballot(v[c] >= mid);
            cnt += HALVES ? (up ? __popc((unsigned)(m >> 32)) : __popc((unsigned)m)) : __popcll(m); }
        if (!done) { if (cnt == 16) { thr = mid; done = true; } else if (cnt > 16) { lo = mid; thr = mid; } else hi = mid; }
        if (__all(done)) break;
    }
    int base = 0;
#pragma unroll
    for (int c = 0; c < 4; ++c) { sel[c] = v[c] >= thr; const unsigned long long m = __ballot(sel[c]);
        const unsigned long long gm = HALVES ? (up ? (m >> 32) : (m & 0xffffffffull)) : m; const int ll = HALVES ? (lane & 31) : lane;
        pos[c] = base + __popcll(gm & ((1ull << ll) - 1ull)); base += __popcll(gm); sel[c] = sel[c] && pos[c] < 16; }
}
DI void peer_topk(const Ctx& C, const float* SCO, int* IDX, float* GATE) {
    LAS float* sv = (LAS float*)(C.lds + C.wave * 512);
    LAS int* si = (LAS int*)(C.lds + C.wave * 512 + 128);
    LAS float* fv = (LAS float*)(C.lds + C.wave * 512 + 256);
    LAS int* fi = (LAS int*)(C.lds + C.wave * 512 + 320);
    const int gw = C.vcu * NWAVES + C.wave, NGW = C.G * NWAVES, lane = C.lane;
    for (int it = gw; it < TT * 8; it += NGW) {
        const f32x4 s4 = *(const f32x4*)(SCO + (size_t)it * 256 + lane * 4);
        float v[4] = {s4.x, s4.y, s4.z, s4.w}; bool sel[4]; int pos[4];
        select16<true>(v, lane, sel, pos);
        const int p = lane >> 5;
#pragma unroll
        for (int c = 0; c < 4; ++c) if (sel[c]) { sv[p * 16 + pos[c]] = v[c]; si[p * 16 + pos[c]] = (lane & 31) * 4 + c; }
        LDS_WAIT();
        const int a = lane >> 2, bq = (lane & 3) * 4; const float va = sv[a]; const int ia = si[a];
        float w[4]; int wi[4];
#pragma unroll
        for (int c = 0; c < 4; ++c) { w[c] = va + sv[16 + bq + c]; wi[c] = ia * 128 + si[16 + bq + c]; }
        select16<false>(w, lane, sel, pos);
#pragma unroll
        for (int c = 0; c < 4; ++c) if (sel[c]) { fv[pos[c]] = w[c]; fi[pos[c]] = wi[c]; }
        LDS_WAIT();
        const float x = fv[lane & 15]; const int xi = fi[lane & 15];
        float m = x;
#pragma unroll
        for (int o = 1; o < 16; o <<= 1) m = fmaxf(m, __shfl_xor(m, o));
        const float e = __expf(x - m); float s = e;
#pragma unroll
        for (int o = 1; o < 16; o <<= 1) s += __shfl_xor(s, o);
        if (lane < 16) { IDX[(size_t)it * 16 + lane] = xi; GATE[(size_t)it * 16 + lane] = e / s; }
        LDS_WAIT();
    }
}
template <bool FINAL> DI void peer_gather(const Ctx& C, const bf16* H, const int* IDX, const float* GATE, const bf16* PU, const bf16* PV, float* X, const float* g2  ,
                                          const float* ngain, const float* nmod  , bf16* Hn) {
    const int gw = C.vcu * NWAVES + C.wave, NGW = C.G * NWAVES, lane = C.lane;
    for (int t = gw; t < TT; t += NGW) {
        float hv[16];
        { const u32x4 a = *(const u32x4*)(H + (size_t)t * 1024 + lane * 8), bq = *(const u32x4*)(H + (size_t)t * 1024 + 512 + lane * 8);
          hv[0] = bflo(a.x); hv[1] = bfhi(a.x); hv[2] = bflo(a.y); hv[3] = bfhi(a.y); hv[4] = bflo(a.z); hv[5] = bfhi(a.z); hv[6] = bflo(a.w); hv[7] = bfhi(a.w);
          hv[8] = bflo(bq.x); hv[9] = bfhi(bq.x); hv[10] = bflo(bq.y); hv[11] = bfhi(bq.y); hv[12] = bflo(bq.z); hv[13] = bfhi(bq.z); hv[14] = bflo(bq.w); hv[15] = bfhi(bq.w); }
        const int i0 = IDX[(size_t)t * 128 + lane], i1 = IDX[(size_t)t * 128 + 64 + lane];
        const float g0 = GATE[(size_t)t * 128 + lane], g1 = GATE[(size_t)t * 128 + 64 + lane];
        float a0 = 0.f, a1 = 0.f;
        for (int k = 0; k < 128; k += 4) {
            float dsum[4];
#pragma unroll
            for (int kk = 0; kk < 4; ++kk) { const int kq = k + kk; const int e = kq < 64 ? __builtin_amdgcn_readlane(i0, kq) : __builtin_amdgcn_readlane(i1, kq - 64);
                const bf16* ur = PU + (size_t)e * 1024; const u32x4 a = *(const u32x4*)(ur + lane * 8), bq = *(const u32x4*)(ur + 512 + lane * 8);
                float d = bflo(a.x) * hv[0] + bfhi(a.x) * hv[1]; d += bflo(a.y) * hv[2] + bfhi(a.y) * hv[3]; d += bflo(a.z) * hv[4] + bfhi(a.z) * hv[5]; d += bflo(a.w) * hv[6] + bfhi(a.w) * hv[7];
                d += bflo(bq.x) * hv[8] + bfhi(bq.x) * hv[9]; d += bflo(bq.y) * hv[10] + bfhi(bq.y) * hv[11]; d += bflo(bq.z) * hv[12] + bfhi(bq.z) * hv[13]; d += bflo(bq.w) * hv[14] + bfhi(bq.w) * hv[15];
                dsum[kk] = d; }
#pragma unroll
            for (int kk = 0; kk < 4; ++kk) { const int kq = k + kk; const float d = gelu_t(wave_sum(dsum[kk]));
                if (kq < 64) { if (lane == kq) a0 = d * g0; } else { if (lane == kq - 64) a1 = d * g1; } }
        }
        float o[16];
#pragma unroll
        for (int j = 0; j < 16; ++j) o[j] = 0.f;
        for (int k = 0; k < 128; k += 4) {
#pragma unroll
            for (int kk = 0; kk < 4; ++kk) { const int kq = k + kk; const int e = kq < 64 ? __builtin_amdgcn_readlane(i0, kq) : __builtin_amdgcn_readlane(i1, kq - 64);
                const float ak = __int_as_float(kq < 64 ? __builtin_amdgcn_readlane(__float_as_int(a0), kq) : __builtin_amdgcn_readlane(__float_as_int(a1), kq - 64));
                const bf16* vr = PV + (size_t)e * 1024; const u32x4 a = *(const u32x4*)(vr + lane * 8), bq = *(const u32x4*)(vr + 512 + lane * 8);
                o[0] += ak * bflo(a.x); o[1] += ak * bfhi(a.x); o[2] += ak * bflo(a.y); o[3] += ak * bfhi(a.y); o[4] += ak * bflo(a.z); o[5] += ak * bfhi(a.z); o[6] += ak * bflo(a.w); o[7] += ak * bfhi(a.w);
                o[8] += ak * bflo(bq.x); o[9] += ak * bfhi(bq.x); o[10] += ak * bflo(bq.y); o[11] += ak * bfhi(bq.y); o[12] += ak * bflo(bq.z); o[13] += ak * bfhi(bq.z); o[14] += ak * bflo(bq.w); o[15] += ak * bfhi(bq.w); }
        }
#ifdef DBG_ZERO_PEER
#pragma unroll
        for (int j = 0; j < 16; ++j) o[j] = 0.f;
#endif
        const int b = t >> 13; const float* gp = g2 + (size_t)b * 6144; float* xr = X + (size_t)t * 1024;
        float xn[16]; float ss = 0.f;
#pragma unroll
        for (int q = 0; q < 4; ++q) { const int col = (q >> 1) * 512 + lane * 8 + (q & 1) * 4; const f32x4 xv = *(const f32x4*)(xr + col), gv = *(const f32x4*)(gp + col);
#pragma unroll
            for (int j = 0; j < 4; ++j) { const float y = xv[j] + gv[j] * o[q * 4 + j]; xn[q * 4 + j] = y; ss += y * y; } }
        const float rstd = 1.0f / sqrtf(wave_sum(ss) * (1.0f / 1024.0f) + EPS);
        if (FINAL) {
#pragma unroll
            for (int q = 0; q < 4; ++q) { const int col = (q >> 1) * 512 + lane * 8 + (q & 1) * 4; const f32x4 gn = *(const f32x4*)(ngain + col); f32x4 y;
#pragma unroll
                for (int j = 0; j < 4; ++j) y[j] = xn[q * 4 + j] * rstd * gn[j];
                *(f32x4*)(xr + col) = y; }
        } else {
            const float* nm = nmod + (size_t)b * 6144;
#pragma unroll
            for (int q = 0; q < 4; ++q) { const int col = (q >> 1) * 512 + lane * 8 + (q & 1) * 4; const f32x4 gn = *(const f32x4*)(ngain + col), sh = *(const f32x4*)(nm + col), sc = *(const f32x4*)(nm + 1024 + col); f32x4 xo; float y[4];
#pragma unroll
                for (int j = 0; j < 4; ++j) { xo[j] = xn[q * 4 + j]; y[j] = xn[q * 4 + j] * rstd * gn[j] * (1.0f + sc[j]) + sh[j]; }
                *(f32x4*)(xr + col) = xo; uint2 w; w.x = pk2(y[0], y[1]); w.y = pk2(y[2], y[3]); *(uint2*)(Hn + (size_t)t * 1024 + col) = w; }
        }
    }
}
DI void sgu_gate_naive(const Ctx& C, bf16* U, const bf16* VB, const float* stats, const float* w_s, const float* b_s, const float* ln_g, const float* ln_b) {
    LAS float* Wm = (LAS float*)(C.lds);
    LAS float* mu = (LAS float*)(C.lds + 65536);
    LAS float* rsd = mu + 128;
    const int tid = C.tid;
    for (int item = C.vcu; item < 1024; item += C.G) {
        const int n = item >> 3, g = item & 7; const size_t row0 = (size_t)n * 128;
        for (int i = tid; i < 16384; i += 512) { const int r = i >> 7, c = i & 127; const float w = w_s[(size_t)g * 16384 + i]; Wm[i] = (r < 64 && c >= 64) ? 0.f : w; }
        if (tid < 128) { const float* sp = stats + (row0 + tid) * 96; float s1 = 0.f, s2 = 0.f;
            for (int q = 0; q < 48; ++q) { s1 += sp[2 * q]; s2 += sp[2 * q + 1]; }
            const float m = s1 * (1.0f / 3072.0f); const float var = s2 * (1.0f / 3072.0f) - m * m; mu[tid] = m; rsd[tid] = 1.0f / sqrtf(fmaxf(var, 0.f) + EPS); }
        __syncthreads();
        if (tid < 384) {
            const int col = g * 384 + tid; const float lg = ln_g[col], lb = ln_b[col];
#pragma unroll
            for (int pass = 0; pass < 2; ++pass) {
                float acc[64];
#pragma unroll
                for (int i = 0; i < 64; ++i) acc[i] = 0.f;
                const int jmax = pass == 0 ? 64 : 128;
                for (int j = 0; j < jmax; ++j) { const float v = bf2f(VB[(row0 + j) * 3072 + col]); const float vl = (v - mu[j]) * rsd[j] * lg + lb;
#pragma unroll
                    for (int i = 0; i < 64; ++i) acc[i] += Wm[(pass * 64 + i) * 128 + j] * vl; }
#pragma unroll
                for (int i = 0; i < 64; ++i) { const int r = pass * 64 + i; const float s = acc[i] + b_s[g * 128 + r]; bf16* up = U + (row0 + r) * 3072 + col; *up = (bf16)f2bf(bf2f(*up) * s); }
            }
        }
        __syncthreads();
    }
}
typedef short v4i16_t __attribute__((ext_vector_type(4)));
typedef unsigned u32x2_t __attribute__((ext_vector_type(2)));
typedef __bf16 bf16x2_t __attribute__((ext_vector_type(2)));
DI unsigned cvtpk(float lo, float hi) { f32x2_t v = {lo, hi}; bf16x2_t b = __builtin_convertvector(v, bf16x2_t); return __builtin_bit_cast(unsigned, b); }
DI v4i16_t trr(const LAS unsigned char* p) { return __builtin_amdgcn_ds_read_tr16_b64_v4i16((LAS v4i16_t*)p); }
DI bf16x8 cat8(v4i16_t a, v4i16_t b) { return __builtin_shufflevector(a, b, 0, 1, 2, 3, 4, 5, 6, 7); }
DI bf16x8 pack2(const f32x4& a, const f32x4& b) { u32x4 p; p.x = cvtpk(a[0], a[1]); p.y = cvtpk(a[2], a[3]); p.z = cvtpk(b[0], b[1]); p.w = cvtpk(b[2], b[3]); return __builtin_bit_cast(bf16x8, p); }
DI u32x4 scale8(u32x4 v, float s) { u32x4 o; o.x = cvtpk(bflo(v.x) * s, bfhi(v.x) * s); o.y = cvtpk(bflo(v.y) * s, bfhi(v.y) * s); o.z = cvtpk(bflo(v.z) * s, bfhi(v.z) * s); o.w = cvtpk(bflo(v.w) * s, bfhi(v.w) * s); return o; }
constexpr int SCAN_ESL = 32, SCAN_NCW = SCAN_ESL / 16, SCAN_NSL = 512 / SCAN_ESL, SCAN_NIT = 8 * SCAN_NSL;
#define SCAN_BAR() do { asm volatile("s_waitcnt lgkmcnt(0)" ::: "memory"); __builtin_amdgcn_s_barrier(); asm volatile("" ::: "memory"); } while (0)
template <int MODE = 0> DI void scan_mfma(const Ctx& C, const bf16* Q, const bf16* K, const bf16* V, bf16* CROSS) {
    constexpr int QPI = 544, KPI = 544, VPI = SCAN_ESL * 2 + 32, VCH = SCAN_ESL / 8  , NVC = 64 * VCH;
    constexpr int OQ = 0, OK_ = 64 * QPI, OV = OK_ + 64 * KPI, BUFB = OV + 64 * VPI;
    constexpr int NST = (NWAVES - 1 - SCAN_NCW) * 64;
    const int w = C.wave;
    for (int item = C.vcu; item < SCAN_NIT; item += C.G) {
        const int b = item / (4 * SCAN_NSL), h = (item / SCAN_NSL) & 3, es = item % SCAN_NSL;
        const float lg2 = log2f(1.0f - exp2f(-5.0f - (float)h)); const float gc = exp2f(lg2 * 64.0f);
        const size_t tokb = (size_t)b * SEQ;
        if (w >= SCAN_NCW) {
            int tl_ = C.tid; asm volatile("" : "+v"(tl_));
            const int st = (w == NWAVES - 1) ? (tl_ & 63) : tl_ - SCAN_NCW * 64;
            if (w == NWAVES - 1) {
                unsigned dmy = 0u;
#define SCAN_PF1(ptr) asm volatile("global_load_dword %0, %1, off" : "+v"(dmy) : "v"(ptr) : "memory")
#define SCAN_PF(n) do { const size_t t0_ = tokb + (size_t)(n) * 64; \
                if ((es & 3) == 0) { _Pragma("unroll") for (int u = 0; u < 4; ++u) { const int ln = st + 64 * u, r = ln >> 2, q = ln & 3; SCAN_PF1(Q + (t0_ + r) * 1024 + h * 256 + q * 64); SCAN_PF1(K + (t0_ + r) * 1024 + h * 256 + q * 64); } } \
                SCAN_PF1(V + (t0_ + st) * 2048 + h * 512 + es * SCAN_ESL); } while (0)
#ifndef SCAN_NOPF
                SCAN_PF(2);
#endif
                SCAN_BAR();
#pragma unroll 1
                for (int n = 0; n < 128; ++n) {
#ifndef SCAN_NOPF
                    if (n + 3 < 128) SCAN_PF(n + 3);
#endif
                    SCAN_BAR(); }
                asm volatile("s_waitcnt vmcnt(0)" : "+v"(dmy) :: "memory");
#undef SCAN_PF
#undef SCAN_PF1
            } else {
            u32x4 rq_[7], rk_[7], rv_;
#define SCAN_LD(n) do { const size_t t0_ = tokb + (size_t)(n) * 64; \
            _Pragma("unroll") for (int u = 0; u < 7; ++u) { const int c = st + NST * u; if (c < 2048) { const int r = c >> 5, cc = c & 31; \
                rq_[u] = *(const u32x4*)(Q + (t0_ + r) * 1024 + h * 256 + cc * 8); rk_[u] = *(const u32x4*)(K + (t0_ + r) * 1024 + h * 256 + cc * 8); } } \
            if (st < NVC) { const int r = st / VCH, cc = st % VCH; rv_ = *(const u32x4*)(V + (t0_ + r) * 2048 + h * 512 + es * SCAN_ESL + cc * 8); } } while (0)
#define SCAN_WR(bufo) do { LAS unsigned char* B_ = C.lds + (bufo); \
            _Pragma("unroll") for (int u = 0; u < 7; ++u) { const int c = st + NST * u; if (c < 2048) { const int r = c >> 5, cc = c & 31; \
                *(LAS u32x4*)(B_ + OQ + r * QPI + cc * 16) = rq_[u]; *(LAS u32x4*)(B_ + OK_ + r * KPI + cc * 16) = rk_[u]; } } \
            if (st < NVC) { const int r = st / VCH, cc = st % VCH; *(LAS u32x4*)(B_ + OV + r * VPI + cc * 16) = scale8(rv_, exp2f(lg2 * (float)(63 - r))); } } while (0)
            SCAN_LD(0); SCAN_WR(0); SCAN_LD(1);
            SCAN_BAR();
#pragma unroll 1
            for (int n = 0; n < 128; ++n) { if (MODE != 2 && n + 1 < 128) { SCAN_WR(((n + 1) & 1) * BUFB); if (n + 2 < 128) SCAN_LD(n + 2); } SCAN_BAR(); }
#undef SCAN_LD
#undef SCAN_WR
            }
        } else {
            int tl_ = C.tid; asm volatile("" : "+v"(tl_)); const int lane = tl_ & 63, fr = lane & 15, fq = lane >> 4;
            f32x4 S[16];
#pragma unroll
            for (int t = 0; t < 16; ++t) S[t] = (f32x4){0.f, 0.f, 0.f, 0.f};
            SCAN_BAR();
#define SC_LQ(QF, DB) do { _Pragma("unroll") for (int m = 0; m < 4; ++m) QF[m] = *(const LAS bf16x8*)(Qs + (16 * m + fr) * QPI + (32 * (DB) + 8 * fq) * 2); __builtin_amdgcn_sched_barrier(0); } while (0)
#define SC_MQ(QF, DB) do { const bf16x8 sa0 = pack2(S[2 * (DB)], S[2 * (DB) + 1]); \
            _Pragma("unroll") for (int m = 0; m < 4; ++m) acc[m] = __builtin_amdgcn_mfma_f32_16x16x32_bf16(sa0, QF[m], acc[m], 0, 0, 0); __builtin_amdgcn_sched_barrier(0); } while (0)
#define SC_LK(KF, KS, TQ) do { const LAS unsigned char* kp = Ks + (32 * (KS) + 4 * fq + (fr >> 2)) * KPI + (8 * (fr & 3)) * 2;     \
            _Pragma("unroll") for (int t4 = 0; t4 < 4; ++t4) { const int t = 4 * (TQ) + t4; KF[t4] = cat8(trr(kp + 64 * (t >> 1) + 8 * (t & 1)), trr(kp + 64 * (t >> 1) + 8 * (t & 1) + 16 * KPI)); } __builtin_amdgcn_sched_barrier(0); } while (0)
#define SC_LV(VF, KS) do { const LAS unsigned char* vp = Vs + (32 * (KS) + 4 * fq + (fr >> 2)) * VPI + (16 * w + 4 * (fr & 3)) * 2; VF = cat8(trr(vp), trr(vp + 16 * VPI)); } while (0)
#define SC_MK(KF, VF, TQ) do { _Pragma("unroll") for (int t4 = 0; t4 < 4; ++t4) S[4 * (TQ) + t4] = __builtin_amdgcn_mfma_f32_16x16x32_bf16(KF[t4], VF, S[4 * (TQ) + t4], 0, 0, 0); __builtin_amdgcn_sched_barrier(0); } while (0)
#define SCAN_CHUNK(n_, BO) do { const size_t tok0 = tokb + (size_t)(n_) * 64; LAS unsigned char* Qs = C.lds + (BO) + OQ; LAS unsigned char* Ks = C.lds + (BO) + OK_; LAS unsigned char* Vs = C.lds + (BO) + OV; \
                f32x4 acc[4]; bf16x8 fA[4], fB[4], kA[4], kB[4], vf0, vf1; \
                _Pragma("unroll") for (int m = 0; m < 4; ++m) acc[m] = (f32x4){0.f, 0.f, 0.f, 0.f}; \
                SC_LQ(fA, 0); SC_LQ(fB, 1); SC_MQ(fA, 0); SC_LQ(fA, 2); SC_MQ(fB, 1); SC_LQ(fB, 3); SC_MQ(fA, 2); SC_LQ(fA, 4); SC_MQ(fB, 3); SC_LQ(fB, 5); SC_MQ(fA, 4); SC_LQ(fA, 6); SC_MQ(fB, 5); SC_LQ(fB, 7); SC_MQ(fA, 6); SC_LV(vf0, 0); SC_LV(vf1, 1); SC_LK(kA, 0, 0); SC_MQ(fB, 7); \
                _Pragma("unroll") for (int m = 0; m < 4; ++m) { const f32x4 v = acc[m] * exp2f(lg2 * (float)(16 * m + fr + 1)); uint2 o; o.x = cvtpk(v[0], v[1]); o.y = cvtpk(v[2], v[3]); \
                    *(uint2*)(CROSS + (tok0 + 16 * m + fr) * 2048 + h * 512 + es * SCAN_ESL + 16 * w + 4 * fq) = o; } \
                _Pragma("unroll") for (int t = 0; t < 16; ++t) S[t] = S[t] * gc; \
                __builtin_amdgcn_sched_barrier(0); \
                SC_LK(kB, 0, 1); SC_MK(kA, vf0, 0); SC_LK(kA, 0, 2); SC_MK(kB, vf0, 1); SC_LK(kB, 0, 3); SC_MK(kA, vf0, 2); SC_LK(kA, 1, 0); SC_MK(kB, vf0, 3); SC_LK(kB, 1, 1); SC_MK(kA, vf1, 0); SC_LK(kA, 1, 2); SC_MK(kB, vf1, 1); SC_LK(kB, 1, 3); SC_MK(kA, vf1, 2); SC_MK(kB, vf1, 3); \
                SCAN_BAR(); } while (0)
#pragma unroll 1
            for (int n = 0; n < 128; n += 2) { if (MODE == 1) { SCAN_BAR(); SCAN_BAR(); } else { SCAN_CHUNK(n, 0); SCAN_CHUNK(n + 1, BUFB); } }
#undef SCAN_CHUNK
#undef SC_LQ
#undef SC_MQ
#undef SC_LK
#undef SC_LV
#undef SC_MK
        }
    }
}
#undef SCAN_BAR
DI void sgu_gate_mfma(const Ctx& C, bf16* U, const bf16* VB, const float* stats, const float* w_s, const float* b_s, const float* ln_g, const float* ln_b) {
    constexpr int WPI = 272, VPI = 288;
    LAS unsigned char* Ws = C.lds; LAS unsigned char* Vs = C.lds + 128 * WPI;
    LAS float* mu = (LAS float*)(C.lds + 128 * WPI + 128 * VPI); LAS float* rsd = mu + 128; LAS float* r1 = mu + 256; LAS float* r2 = mu + 384; LAS float* bsl = mu + 512;
    const int tid = C.tid, lane = C.lane, w = C.wave, fr = lane & 15, fq = lane >> 4;
    for (int item = C.vcu; item < 1024; item += C.G) {
        const int n = item >> 3, g = item & 7; const size_t row0 = (size_t)n * 128;
        if (tid < 128) { const float* sp = stats + (row0 + tid) * 96; float s1 = 0.f, s2 = 0.f;
#pragma unroll 8
            for (int q = 0; q < 48; ++q) { s1 += sp[2 * q]; s2 += sp[2 * q + 1]; }
            const float m = s1 * (1.0f / 3072.0f); const float var = s2 * (1.0f / 3072.0f) - m * m; mu[tid] = m; rsd[tid] = 1.0f / sqrtf(fmaxf(var, 0.f) + EPS); bsl[tid] = b_s[g * 128 + tid]; }
        __syncthreads();
        { const int i = tid >> 2, jq = tid & 3; const float* wp = w_s + (size_t)g * 16384 + i * 128 + jq * 32; float a1 = 0.f, a2 = 0.f;
#pragma unroll
          for (int c8 = 0; c8 < 4; ++c8) { const f32x4 wa = *(const f32x4*)(wp + c8 * 8), wb = *(const f32x4*)(wp + c8 * 8 + 4); float wv[8] = {wa[0], wa[1], wa[2], wa[3], wb[0], wb[1], wb[2], wb[3]}; float o[8];
#pragma unroll
              for (int q = 0; q < 8; ++q) { const int j = jq * 32 + c8 * 8 + q; const float wm = (i < 64 && j >= 64) ? 0.f : wv[q]; const float wr_ = wm * rsd[j]; o[q] = wr_; a1 += wr_ * mu[j]; a2 += wm; }
              u32x4 pk; pk.x = cvtpk(o[0], o[1]); pk.y = cvtpk(o[2], o[3]); pk.z = cvtpk(o[4], o[5]); pk.w = cvtpk(o[6], o[7]);
              *(LAS u32x4*)(Ws + i * WPI + (jq * 32 + c8 * 8) * 2) = pk; }
          a1 += __shfl_xor(a1, 1); a1 += __shfl_xor(a1, 2); a2 += __shfl_xor(a2, 1); a2 += __shfl_xor(a2, 2);
          if (jq == 0) { r1[i] = a1; r2[i] = a2; } }
#pragma unroll 1
        for (int cs = 0; cs < 3; ++cs) {
            const int colb = g * 384 + cs * 128;
#pragma unroll
            for (int u = 0; u < 4; ++u) { const int c = tid + 512 * u, r = c >> 4, cc = c & 15;
                *(LAS u32x4*)(Vs + r * VPI + cc * 16) = *(const u32x4*)(VB + (row0 + r) * 3072 + colb + cc * 8); }
            __syncthreads();
            f32x4 acc[8];
#pragma unroll
            for (int it = 0; it < 8; ++it) acc[it] = (f32x4){0.f, 0.f, 0.f, 0.f};
#pragma unroll
            for (int ks = 0; ks < 4; ++ks) {
                const LAS unsigned char* vp = Vs + (32 * ks + 4 * fq + (fr >> 2)) * VPI + (16 * w + 4 * (fr & 3)) * 2;
                const bf16x8 vf = cat8(trr(vp), trr(vp + 16 * VPI));
#pragma unroll
                for (int it = 0; it < 8; ++it) { if (it < 4 && ks >= 2) continue;
                    const LAS unsigned char* wp = Ws + (16 * it + fr) * WPI + (32 * ks + 4 * fq) * 2;
                    const u32x2_t lo = *(const LAS u32x2_t*)wp, hi = *(const LAS u32x2_t*)(wp + 32);
                    u32x4 ww; ww.x = lo.x; ww.y = lo.y; ww.z = hi.x; ww.w = hi.y;
                    acc[it] = __builtin_amdgcn_mfma_f32_16x16x32_bf16(vf, __builtin_bit_cast(bf16x8, ww), acc[it], 0, 0, 0); }
            }
            const int c0 = colb + 16 * w + 4 * fq;
            const f32x4 lg = *(const f32x4*)(ln_g + c0), lb = *(const f32x4*)(ln_b + c0);
#pragma unroll
            for (int it = 0; it < 8; ++it) { const int i = 16 * it + fr; const float q1 = r1[i], q2 = r2[i], bb = bsl[i];
                bf16* up = U + (row0 + i) * 3072 + c0; const u32x2_t uu = *(const u32x2_t*)up;
                const f32x4 s = lg * (acc[it] - q1) + lb * q2 + bb;
                u32x2_t o; o.x = cvtpk(bflo(uu.x) * s[0], bfhi(uu.x) * s[1]); o.y = cvtpk(bflo(uu.y) * s[2], bfhi(uu.y) * s[3]);
                *(u32x2_t*)up = o; }
            __syncthreads();
        }
    }
}
DI void up8(unsigned wd, float& a, float& b, float& c, float& d) { const f32x2_t lo = __builtin_amdgcn_cvt_pk_f32_fp8((int)wd, false), hi = __builtin_amdgcn_cvt_pk_f32_fp8((int)wd, true); a = lo.x; b = lo.y; c = hi.x; d = hi.y; }
DI float dot16(const u32x4 u, const float (&hv)[16]) {
    float f[16];
    up8(u.x, f[0], f[1], f[2], f[3]); up8(u.y, f[4], f[5], f[6], f[7]); up8(u.z, f[8], f[9], f[10], f[11]); up8(u.w, f[12], f[13], f[14], f[15]);
    float d0 = f[0] * hv[0], d1 = f[1] * hv[1];
#pragma unroll
    for (int j = 2; j < 16; j += 2) { d0 += f[j] * hv[j]; d1 += f[j + 1] * hv[j + 1]; }
    return d0 + d1;
}
template <bool FINAL> DI void peer_gather8(const Ctx& C, const bf16* Hin, const int* IDX, const float* GATE, const unsigned char* PU8, const unsigned char* PV8, const float* ISU, const float* ISV,
                                           float* X, const float* g2, const float* ngain, const float* nmod, bf16* Hn) {
    const int gw = C.vcu * NWAVES + C.wave, NGW = C.G * NWAVES, lane = C.lane;
    LAS float* DL = (LAS float*)(C.lds + C.wave * 1024);
    LAS float* AL = DL + 128;
    for (int t = gw; t < TT; t += NGW) {
        float hv[16];
        { const u32x4 a = *(const u32x4*)(Hin + (size_t)t * 1024 + lane * 16), bq = *(const u32x4*)(Hin + (size_t)t * 1024 + lane * 16 + 8);
          hv[0] = bflo(a.x); hv[1] = bfhi(a.x); hv[2] = bflo(a.y); hv[3] = bfhi(a.y); hv[4] = bflo(a.z); hv[5] = bfhi(a.z); hv[6] = bflo(a.w); hv[7] = bfhi(a.w);
          hv[8] = bflo(bq.x); hv[9] = bfhi(bq.x); hv[10] = bflo(bq.y); hv[11] = bfhi(bq.y); hv[12] = bflo(bq.z); hv[13] = bfhi(bq.z); hv[14] = bflo(bq.w); hv[15] = bfhi(bq.w); }
        const int i0 = IDX[(size_t)t * 128 + lane], i1 = IDX[(size_t)t * 128 + 64 + lane];
        const float g0 = GATE[(size_t)t * 128 + lane], g1 = GATE[(size_t)t * 128 + 64 + lane];
        const float su0 = ISU[i0], su1 = ISU[i1], sv0 = ISV[i0], sv1 = ISV[i1];
        u32x4 ub[8];
#define PG_LOADU(k0) do { _Pragma("unroll") for (int j = 0; j < 8; ++j) { const int kq = (k0) + j; const int e = kq < 64 ? __builtin_amdgcn_readlane(i0, kq) : __builtin_amdgcn_readlane(i1, kq - 64); \
            ub[j] = *(const u32x4*)(PU8 + (size_t)e * 1024 + lane * 16); } } while (0)
        PG_LOADU(0);
#pragma unroll 1
        for (int k0 = 0; k0 < 128; k0 += 8) {
            float p[8];
#pragma unroll
            for (int j = 0; j < 8; ++j) p[j] = dot16(ub[j], hv);
            if (k0 + 8 < 128) PG_LOADU(k0 + 8);
            const bool h32 = lane & 32, h16 = lane & 16, h8 = lane & 8;
            float q4[4];
#pragma unroll
            for (int j = 0; j < 4; ++j) { const float keep = h32 ? p[j + 4] : p[j], send = h32 ? p[j] : p[j + 4]; q4[j] = keep + __shfl_xor(send, 32); }
            float q2[2];
#pragma unroll
            for (int j = 0; j < 2; ++j) { const float keep = h16 ? q4[j + 2] : q4[j], send = h16 ? q4[j] : q4[j + 2]; q2[j] = keep + __shfl_xor(send, 16); }
            float q1; { const float keep = h8 ? q2[1] : q2[0], send = h8 ? q2[0] : q2[1]; q1 = keep + __shfl_xor(send, 8); }
            q1 += __shfl_xor(q1, 4); q1 += __shfl_xor(q1, 2); q1 += __shfl_xor(q1, 1);
            if ((lane & 7) == 0) DL[k0 + ((lane >> 5) & 1) * 4 + ((lane >> 4) & 1) * 2 + ((lane >> 3) & 1)] = q1;
        }
#undef PG_LOADU
        LDS_WAIT();
        { const float d0 = DL[lane], d1 = DL[64 + lane]; AL[lane] = gelu_t(d0 * su0) * g0 * sv0; AL[64 + lane] = gelu_t(d1 * su1) * g1 * sv1; }
        LDS_WAIT();
        float o[16];
#pragma unroll
        for (int j = 0; j < 16; ++j) o[j] = 0.f;
        u32x4 vb[8];
#define PG_LOADV(k0) do { _Pragma("unroll") for (int j = 0; j < 8; ++j) { const int kq = (k0) + j; const int e = kq < 64 ? __builtin_amdgcn_readlane(i0, kq) : __builtin_amdgcn_readlane(i1, kq - 64); \
            vb[j] = *(const u32x4*)(PV8 + (size_t)e * 1024 + lane * 16); } } while (0)
        PG_LOADV(0);
#pragma unroll 1
        for (int k0 = 0; k0 < 128; k0 += 8) {
            float f[8][16];
#pragma unroll
            for (int j = 0; j < 8; ++j) { up8(vb[j].x, f[j][0], f[j][1], f[j][2], f[j][3]); up8(vb[j].y, f[j][4], f[j][5], f[j][6], f[j][7]); up8(vb[j].z, f[j][8], f[j][9], f[j][10], f[j][11]); up8(vb[j].w, f[j][12], f[j][13], f[j][14], f[j][15]); }
            if (k0 + 8 < 128) PG_LOADV(k0 + 8);
#pragma unroll
            for (int j = 0; j < 8; ++j) { const float ak = AL[k0 + j];
#pragma unroll
                for (int q = 0; q < 16; ++q) o[q] += ak * f[j][q]; }
        }
#undef PG_LOADV
        const int b = t >> 13; const float* gp = g2 + (size_t)b * 6144; float* xr = X + (size_t)t * 1024;
        float xn[16]; float ss = 0.f;
#pragma unroll
        for (int q = 0; q < 4; ++q) { const int col = lane * 16 + q * 4; const f32x4 xv = *(const f32x4*)(xr + col), gv = *(const f32x4*)(gp + col);
#pragma unroll
            for (int j = 0; j < 4; ++j) { const float y = xv[j] + gv[j] * o[q * 4 + j]; xn[q * 4 + j] = y; ss += y * y; } }
        const float rstd = 1.0f / sqrtf(wave_sum(ss) * (1.0f / 1024.0f) + EPS);
        if (FINAL) {
#pragma unroll
            for (int q = 0; q < 4; ++q) { const int col = lane * 16 + q * 4; const f32x4 gn = *(const f32x4*)(ngain + col); f32x4 y;
#pragma unroll
                for (int j = 0; j < 4; ++j) y[j] = xn[q * 4 + j] * rstd * gn[j];
                *(f32x4*)(xr + col) = y; }
        } else {
            const float* nm = nmod + (size_t)b * 6144;
#pragma unroll
            for (int q = 0; q < 4; ++q) { const int col = lane * 16 + q * 4; const f32x4 gn = *(const f32x4*)(ngain + col), sh = *(const f32x4*)(nm + col), sc = *(const f32x4*)(nm + 1024 + col); f32x4 xo; float y[4];
#pragma unroll
                for (int j = 0; j < 4; ++j) { xo[j] = xn[q * 4 + j]; y[j] = xn[q * 4 + j] * rstd * gn[j] * (1.0f + sc[j]) + sh[j]; }
                *(f32x4*)(xr + col) = xo; u32x2_t wv; wv.x = cvtpk(y[0], y[1]); wv.y = cvtpk(y[2], y[3]); *(u32x2_t*)(Hn + (size_t)t * 1024 + col) = wv; }
        }
    }
}
template <int CTRL> DI float dpp_f(float x) { return __int_as_float(__builtin_amdgcn_update_dpp(0, __float_as_int(x), CTRL, 0xF, 0xF, false)); }
DI float x32(float x) { auto r = __builtin_amdgcn_permlane32_swap(__float_as_uint(x), __float_as_uint(x), false, false); return (threadIdx.x & 32) ? __uint_as_float(r[0]) : __uint_as_float(r[1]); }
DI float x16(float x) { auto r = __builtin_amdgcn_permlane16_swap(__float_as_uint(x), __float_as_uint(x), false, false); return (threadIdx.x & 16) ? __uint_as_float(r[0]) : __uint_as_float(r[1]); }
typedef _Float16 h2_t __attribute__((ext_vector_type(2)));
DI unsigned f2hu(float lo, float hi) { const f32x2_t v = {lo, hi}; const h2_t h = __builtin_convertvector(v, h2_t); return __builtin_bit_cast(unsigned, h); }
DI unsigned bf2hu(unsigned w) { const f32x2_t v = {bflo(w), bfhi(w)}; const h2_t h = __builtin_convertvector(v, h2_t); return __builtin_bit_cast(unsigned, h); }
DI h2_t bf2h(unsigned w) { return (h2_t){(_Float16)bflo(w), (_Float16)bfhi(w)}; }
template <bool FAKE> DI void up8h(const u32x4 u, h2_t (&f)[8]) {
    if (FAKE) { f[0] = __builtin_bit_cast(h2_t, u.x & 0x3bff3bffu); f[1] = __builtin_bit_cast(h2_t, u.y & 0x3bff3bffu); f[2] = __builtin_bit_cast(h2_t, u.z & 0x3bff3bffu); f[3] = __builtin_bit_cast(h2_t, u.w & 0x3bff3bffu);
        f[4] = __builtin_bit_cast(h2_t, (u.x >> 1) & 0x3bff3bffu); f[5] = __builtin_bit_cast(h2_t, (u.y >> 1) & 0x3bff3bffu); f[6] = __builtin_bit_cast(h2_t, (u.z >> 1) & 0x3bff3bffu); f[7] = __builtin_bit_cast(h2_t, (u.w >> 1) & 0x3bff3bffu); return; }
    f[0] = __builtin_amdgcn_cvt_scalef32_pk_f16_fp8((int)u.x, 1.0f, false); f[1] = __builtin_amdgcn_cvt_scalef32_pk_f16_fp8((int)u.x, 1.0f, true);
    f[2] = __builtin_amdgcn_cvt_scalef32_pk_f16_fp8((int)u.y, 1.0f, false); f[3] = __builtin_amdgcn_cvt_scalef32_pk_f16_fp8((int)u.y, 1.0f, true);
    f[4] = __builtin_amdgcn_cvt_scalef32_pk_f16_fp8((int)u.z, 1.0f, false); f[5] = __builtin_amdgcn_cvt_scalef32_pk_f16_fp8((int)u.z, 1.0f, true);
    f[6] = __builtin_amdgcn_cvt_scalef32_pk_f16_fp8((int)u.w, 1.0f, false); f[7] = __builtin_amdgcn_cvt_scalef32_pk_f16_fp8((int)u.w, 1.0f, true); }
template <bool FAKE> DI float dot16h(const u32x4 u, const h2_t (&hh)[8]) { h2_t f[8]; up8h<FAKE>(u, f); float d0 = 0.f, d1 = 0.f;
#pragma unroll
    for (int q = 0; q < 8; q += 2) { d0 = __builtin_amdgcn_fdot2(f[q], hh[q], d0, false); d1 = __builtin_amdgcn_fdot2(f[q + 1], hh[q + 1], d1, false); }
    return d0 + d1; }
template <bool FINAL, bool FAKE = false, int SKIP = 0> DI void peer_gather_rounds(const Ctx& C, const bf16* Hin, const int* IDX, const float* GATE, const unsigned char* PU8, const unsigned char* PV8, const float* ISU, const float* ISV,
                                                 float* X, const float* g2, const float* ngain, const float* nmod, bf16* Hn) {
    const int lane = C.lane, w = C.wave;
    LAS u32x2_t* LIST = (LAS u32x2_t*)(C.lds + w * 14592);
    LAS unsigned char* HL = C.lds + w * 14592 + 4096;
    LAS unsigned* ALU = (LAS unsigned*)(C.lds + w * 14592 + 12288);
    LAS int* OFFS = (LAS int*)(C.lds + w * 14592 + 14336);
    LAS float* IHS = (LAS float*)(C.lds + w * 14592 + 14336 + 160);
    const unsigned long long ltmask = (1ull << lane) - 1ull;
    for (int grp = C.vcu; grp < TT / 32; grp += C.G) {
        const int t0 = grp * 32 + w * 4;
        {
            int ee[8]; float gg[8]; unsigned su[8]; float sv[8];
#pragma unroll
            for (int r = 0; r < 8; ++r) { const size_t a = (size_t)(t0 + (r >> 1)) * 128 + 64 * (r & 1) + lane; ee[r] = IDX[a]; gg[r] = GATE[a]; }
#pragma unroll
            for (int r = 0; r < 8; ++r) { su[r] = __float_as_uint(ISU[ee[r]]) >> 23; sv[r] = ISV[ee[r]]; }
            int pos[8]; int base = 0;
#pragma unroll 1
            for (int b = 0; b < 8; ++b) {
#pragma unroll
                for (int r = 0; r < 8; ++r) { if ((r & 1) == 0 && lane == 0) OFFS[b * 4 + (r >> 1)] = base;
                    const bool mine = (ee[r] >> 11) == b; const unsigned long long m = __ballot(mine); if (mine) pos[r] = base + __popcll(m & ltmask); base += __popcll(m); }
            }
            if (lane == 0) OFFS[32] = 512;
#pragma unroll
            for (int r = 0; r < 8; ++r) { u32x2_t en; en.x = (unsigned)ee[r] | ((unsigned)(r >> 1) << 14) | (su[r] << 16); en.y = __float_as_uint(gg[r] * sv[r]); LIST[pos[r]] = en; }
#pragma unroll
            for (int tk = 0; tk < 4; ++tk) { const u32x4 a = *(const u32x4*)(Hin + (size_t)(t0 + tk) * 1024 + lane * 16), bq = *(const u32x4*)(Hin + (size_t)(t0 + tk) * 1024 + lane * 16 + 8);
                const float hv_[16] = {bflo(a.x), bfhi(a.x), bflo(a.y), bfhi(a.y), bflo(a.z), bfhi(a.z), bflo(a.w), bfhi(a.w), bflo(bq.x), bfhi(bq.x), bflo(bq.y), bfhi(bq.y), bflo(bq.z), bfhi(bq.z), bflo(bq.w), bfhi(bq.w)};
                float am = 0.f;
#pragma unroll
                for (int q = 0; q < 16; ++q) am = fmaxf(am, fabsf(hv_[q]));
                am = wave_max(am);
                const int e_ = (int)((__float_as_uint(am) >> 23) & 0xffu) - 127; const bool ok_ = am > 1e-30f;
                const float sc_ = ok_ ? __uint_as_float((unsigned)(127 + 6 - e_) << 23) : 1.0f, isc_ = ok_ ? __uint_as_float((unsigned)(127 - 6 + e_) << 23) : 1.0f;
                u32x4 o8;
#pragma unroll
                for (int q = 0; q < 4; ++q) { unsigned wd = 0u;
#pragma unroll
                    for (int j = 0; j < 4; ++j) { int qi = (int)rintf(hv_[4 * q + j] * sc_); qi = qi > 127 ? 127 : (qi < -127 ? -127 : qi); wd |= ((unsigned)qi & 0xffu) << (8 * j); }
                    o8[q] = wd; }
                *(LAS u32x4*)(HL + tk * 1024 + lane * 16) = o8; if (lane == 0) IHS[tk] = isc_; }
        }
        LDS_WAIT();
        {
            const int jL = ((lane >> 5) & 1) * 4 + ((lane >> 4) & 1) * 2 + ((lane >> 3) & 1);
#define G1_LOAD(UB, TK, G0) do { const unsigned exl_ = LIST[(G0) + (lane & 7)].x; \
            _Pragma("unroll") for (int j = 0; j < 8; ++j) { const unsigned ex = (unsigned)__builtin_amdgcn_readlane((int)exl_, j); TK[j] = (int)((ex >> 14) & 3u); \
                UB[j] = *(const u32x4*)(PU8 + (size_t)(ex & (FAKE ? 0x7fu : 0x3fffu)) * 1024 + lane * 16); } } while (0)
#define G1_RUN(UB, TK, G0) do { int p[8]; \
            _Pragma("unroll") for (int j = 0; j < 8; ++j) { const u32x4 hq = *(const LAS u32x4*)(HL + TK[j] * 1024 + lane * 16); \
                int d_ = __builtin_amdgcn_sdot4((int)UB[j].x, (int)hq.x, 0, false); d_ = __builtin_amdgcn_sdot4((int)UB[j].y, (int)hq.y, d_, false); \
                d_ = __builtin_amdgcn_sdot4((int)UB[j].z, (int)hq.z, d_, false); p[j] = __builtin_amdgcn_sdot4((int)UB[j].w, (int)hq.w, d_, false); } \
            const bool h32 = lane & 32, h16 = lane & 16, h8 = lane & 8; int q4[4]; \
            _Pragma("unroll") for (int j = 0; j < 4; ++j) { const int keep = h32 ? p[j + 4] : p[j], send = h32 ? p[j] : p[j + 4]; q4[j] = keep + __float_as_int(x32(__int_as_float(send))); } \
            int q2[2]; \
            _Pragma("unroll") for (int j = 0; j < 2; ++j) { const int keep = h16 ? q4[j + 2] : q4[j], send = h16 ? q4[j] : q4[j + 2]; q2[j] = keep + __float_as_int(x16(__int_as_float(send))); } \
            int q1; { const int keep = h8 ? q2[1] : q2[0], send = h8 ? q2[0] : q2[1]; q1 = keep + __float_as_int(dpp_f<0x128>(__int_as_float(send))); } \
            q1 += __float_as_int(dpp_f<0x141>(__int_as_float(q1))); q1 += __float_as_int(dpp_f<0xB1>(__int_as_float(q1))); q1 += __float_as_int(dpp_f<0x4E>(__int_as_float(q1))); \
            if ((lane & 7) == 0) { const u32x2_t me = LIST[(G0) + jL]; const float av_ = gelu_t((float)q1 * IHS[(me.x >> 14) & 3u] * __uint_as_float((me.x >> 16) << 23)) * __uint_as_float(me.y); ALU[(G0) + jL] = f2hu(av_, av_); } } while (0)
            u32x4 ubA[8], ubB[8]; int tkA[8], tkB[8];
            G1_LOAD(ubA, tkA, 0);
#pragma unroll 1
            for (int g0 = 0; g0 < ((SKIP & 1) ? 0 : 512); g0 += 16) {
                G1_LOAD(ubB, tkB, g0 + 8);
                G1_RUN(ubA, tkA, g0);
                if (g0 + 16 < 512) G1_LOAD(ubA, tkA, g0 + 16);
                G1_RUN(ubB, tkB, g0 + 8);
            }
#undef G1_LOAD
#undef G1_RUN
        }
        LDS_WAIT();
        h2_t o[4][8], oc[8];
#pragma unroll
        for (int q = 0; q < 8; ++q) { oc[q] = (h2_t){(_Float16)0.f, (_Float16)0.f};
#pragma unroll
            for (int tk = 0; tk < 4; ++tk) o[tk][q] = (h2_t){(_Float16)0.f, (_Float16)0.f}; }
        {
            int curA = 0;
#define G2_FLUSH() do { if (curA == 0) { _Pragma("unroll") for (int q_ = 0; q_ < 8; ++q_) o[0][q_] += oc[q_]; } else if (curA == 1) { _Pragma("unroll") for (int q_ = 0; q_ < 8; ++q_) o[1][q_] += oc[q_]; } \
            else if (curA == 2) { _Pragma("unroll") for (int q_ = 0; q_ < 8; ++q_) o[2][q_] += oc[q_]; } else { _Pragma("unroll") for (int q_ = 0; q_ < 8; ++q_) o[3][q_] += oc[q_]; } \
            _Pragma("unroll") for (int q_ = 0; q_ < 8; ++q_) oc[q_] = (h2_t){(_Float16)0.f, (_Float16)0.f}; } while (0)
#define G2_LOAD(VB, AJ, TK, G0) do { const unsigned exl_ = LIST[(G0) + (lane & 7)].x; const unsigned all_ = ALU[(G0) + (lane & 7)]; \
            _Pragma("unroll") for (int j = 0; j < 8; ++j) { const unsigned ex = (unsigned)__builtin_amdgcn_readlane((int)exl_, j); TK[j] = (int)((ex >> 14) & 3u); AJ[j] = __builtin_bit_cast(h2_t, (unsigned)__builtin_amdgcn_readlane((int)all_, j)); \
                VB[j] = *(const u32x4*)(PV8 + (size_t)(ex & (FAKE ? 0x7fu : 0x3fffu)) * 1024 + lane * 16); } } while (0)
#define G2_ACC(VB, AJ, TK) do { _Pragma("unroll") for (int j = 0; j < 8; ++j) { if (TK[j] != curA) { G2_FLUSH(); curA = TK[j]; } h2_t f_[8]; up8h<FAKE>(VB[j], f_); _Pragma("unroll") for (int q = 0; q < 8; ++q) oc[q] = f_[q] * AJ[j] + oc[q]; } } while (0)
            u32x4 vbA[8], vbB[8]; h2_t ajA[8], ajB[8]; int tA[8], tB[8];
            G2_LOAD(vbA, ajA, tA, 0);
#pragma unroll 1
            for (int g0 = 0; g0 < ((SKIP & 2) ? 0 : 512); g0 += 16) {
                G2_LOAD(vbB, ajB, tB, g0 + 8);
                G2_ACC(vbA, ajA, tA);
                if (g0 + 16 < 512) G2_LOAD(vbA, ajA, tA, g0 + 16);
                G2_ACC(vbB, ajB, tB);
            }
            G2_FLUSH();
#undef G2_FLUSH
#undef G2_LOAD
#undef G2_ACC
        }
#pragma unroll
        for (int tk = 0; tk < 4; ++tk) {
            __builtin_amdgcn_sched_barrier(0);
            const int t = t0 + tk; const int b = t >> 13; const float* gp = g2 + (size_t)b * 6144; float* xr = X + (size_t)t * 1024;
            float xn[16]; float ss = 0.f;
#pragma unroll
            for (int q = 0; q < 4; ++q) { const int col = lane * 16 + q * 4; const f32x4 xv = *(const f32x4*)(xr + col), gv = *(const f32x4*)(gp + col);
#pragma unroll
                for (int j = 0; j < 4; ++j) { const float y = xv[j] + gv[j] * (float)o[tk][q * 2 + (j >> 1)][j & 1]; xn[q * 4 + j] = y; ss += y * y; } }
            const float rstd = 1.0f / sqrtf(wave_sum(ss) * (1.0f / 1024.0f) + EPS);
            if (FINAL) {
#pragma unroll
                for (int q = 0; q < 4; ++q) { const int col = lane * 16 + q * 4; const f32x4 gn = *(const f32x4*)(ngain + col); f32x4 y;
#pragma unroll
                    for (int j = 0; j < 4; ++j) y[j] = xn[q * 4 + j] * rstd * gn[j];
                    *(f32x4*)(xr + col) = y; }
            } else {
                const float* nm = nmod + (size_t)b * 6144;
#pragma unroll
                for (int q = 0; q < 4; ++q) { const int col = lane * 16 + q * 4; const f32x4 gn = *(const f32x4*)(ngain + col), sh = *(const f32x4*)(nm + col), sc = *(const f32x4*)(nm + 1024 + col); f32x4 xo; float y[4];
#pragma unroll
                    for (int j = 0; j < 4; ++j) { xo[j] = xn[q * 4 + j]; y[j] = xn[q * 4 + j] * rstd * gn[j] * (1.0f + sc[j]) + sh[j]; }
                    *(f32x4*)(xr + col) = xo; u32x2_t wv; wv.x = cvtpk(y[0], y[1]); wv.y = cvtpk(y[2], y[3]); *(u32x2_t*)(Hn + (size_t)t * 1024 + col) = wv; }
            }
        }
        LDS_WAIT();
    }
}
constexpr int GR_R = 12;
DI void glds_row(const unsigned char* gsrc_lane, unsigned lds_dst) { unsigned keep;
    asm volatile("s_mov_b32 %0, m0\n\ts_mov_b32 m0, %2\n\ts_nop 0\n\tglobal_load_lds_dwordx4 %1, off\n\ts_mov_b32 m0, %0" : "=&s"(keep) : "v"(gsrc_lane), "s"(lds_dst) : "memory"); }
template <bool FINAL> DI void peer_gather_dma(const Ctx& C, const bf16* Hin, const int* IDX, const float* GATE, const unsigned char* PU8, const unsigned char* PV8, const float* ISU, const float* ISV,
                                              float* X, const float* g2, const float* ngain, const float* nmod, bf16* Hn) {
    const int lane = C.lane, w = C.wave;
    constexpr int WB = 4096 + 2048 + 256 + GR_R * 1024;
    LAS u32x2_t* LIST = (LAS u32x2_t*)(C.lds + w * WB);
    LAS float* AL = (LAS float*)(C.lds + w * WB + 4096);
    LAS int* OFFS = (LAS int*)(C.lds + w * WB + 6144);
    LAS unsigned char* RING = C.lds + w * WB + 6400;
    const unsigned ring0 = (unsigned)__builtin_amdgcn_readfirstlane((int)(unsigned)(size_t)RING);
    const unsigned long long ltmask = (1ull << lane) - 1ull;
#define GR_REFILL(nv_) do { unsigned ex8_[8]; _Pragma("unroll") for (int j_ = 0; j_ < 8; ++j_) ex8_[j_] = (j_ < (nv_) && nf + j_ < 1024) ? LIST[(nf + j_) & 511].x : 0u; \
        _Pragma("unroll") for (int j_ = 0; j_ < 8; ++j_) if (j_ < (nv_) && nf + j_ < 1024) { const int f_ = nf + j_; const unsigned e_ = (unsigned)__builtin_amdgcn_readfirstlane((int)ex8_[j_]) & 0x3fffu; \
            const unsigned char* tb_ = (f_ < 512) ? PU8 : PV8; glds_row(tb_ + (size_t)e_ * 1024 + lane * 16, ring0 + (unsigned)(f_ % GR_R) * 1024u); } \
        nf += (nv_); if (nf > 1024) nf = 1024; } while (0)
#define GR_ISSUE(f) do { const int f_ = (f); const unsigned ex_ = (unsigned)__builtin_amdgcn_readfirstlane((int)LIST[f_ & 511].x); \
        const unsigned char* tb_ = (f_ < 512) ? PU8 : PV8; glds_row(tb_ + (size_t)(ex_ & 0x3fffu) * 1024 + lane * 16, ring0 + (unsigned)(f_ % GR_R) * 1024u); } while (0)
    for (int grp = C.vcu; grp < TT / 32; grp += C.G) {
        const int t0 = grp * 32 + w * 4;
        float hv4[4][16];
        {
            int ee[8]; float gg[8]; unsigned su[8]; float sv[8];
#pragma unroll
            for (int r = 0; r < 8; ++r) { const size_t a = (size_t)(t0 + (r >> 1)) * 128 + 64 * (r & 1) + lane; ee[r] = IDX[a]; gg[r] = GATE[a]; }
#pragma unroll
            for (int r = 0; r < 8; ++r) { su[r] = __float_as_uint(ISU[ee[r]]) >> 23; sv[r] = ISV[ee[r]]; }
            int pos[8]; int base = 0;
#pragma unroll 1
            for (int b = 0; b < 8; ++b) {
#pragma unroll
                for (int r = 0; r < 8; ++r) { if ((r & 1) == 0 && lane == 0) OFFS[b * 4 + (r >> 1)] = base;
                    const bool mine = (ee[r] >> 11) == b; const unsigned long long m = __ballot(mine); if (mine) pos[r] = base + __popcll(m & ltmask); base += __popcll(m); }
            }
            if (lane == 0) OFFS[32] = 512;
#pragma unroll
            for (int r = 0; r < 8; ++r) { u32x2_t en; en.x = (unsigned)ee[r] | ((unsigned)(r >> 1) << 14) | (su[r] << 16); en.y = __float_as_uint(gg[r] * sv[r]); LIST[pos[r]] = en; }
#pragma unroll
            for (int tk = 0; tk < 4; ++tk) { const u32x4 a = *(const u32x4*)(Hin + (size_t)(t0 + tk) * 1024 + lane * 16), bq = *(const u32x4*)(Hin + (size_t)(t0 + tk) * 1024 + lane * 16 + 8);
                hv4[tk][0] = bflo(a.x); hv4[tk][1] = bfhi(a.x); hv4[tk][2] = bflo(a.y); hv4[tk][3] = bfhi(a.y); hv4[tk][4] = bflo(a.z); hv4[tk][5] = bfhi(a.z); hv4[tk][6] = bflo(a.w); hv4[tk][7] = bfhi(a.w);
                hv4[tk][8] = bflo(bq.x); hv4[tk][9] = bfhi(bq.x); hv4[tk][10] = bflo(bq.y); hv4[tk][11] = bfhi(bq.y); hv4[tk][12] = bflo(bq.z); hv4[tk][13] = bfhi(bq.z); hv4[tk][14] = bflo(bq.w); hv4[tk][15] = bfhi(bq.w); }
        }
        asm volatile("s_waitcnt vmcnt(0) lgkmcnt(0)" ::: "memory");
        int nf = GR_R;
#pragma unroll 1
        for (int f = 0; f < GR_R; ++f) GR_ISSUE(f);
        {
            const int jL = ((lane >> 5) & 1) * 4 + ((lane >> 4) & 1) * 2 + ((lane >> 3) & 1);
#pragma unroll 1
            for (int r = 0; r < 8; ++r) {
#pragma unroll
                for (int tk = 0; tk < 4; ++tk) {
                    const int beg = __builtin_amdgcn_readfirstlane(OFFS[r * 4 + tk]), end = __builtin_amdgcn_readfirstlane(OFFS[r * 4 + tk + 1]);
#pragma unroll 1
                    for (int g0 = beg; g0 < end; g0 += 8) {
                        const int nv = (end - g0) < 8 ? (end - g0) : 8;
                        asm volatile("s_waitcnt vmcnt(4)" ::: "memory");
                        float p[8];
#pragma unroll
                        for (int j = 0; j < 8; ++j) { p[j] = 0.f;
                            if (j < nv) { const u32x4 row = *(const LAS u32x4*)(RING + ((g0 + j) % GR_R) * 1024 + lane * 16); p[j] = dot16(row, hv4[tk]); } }
                        asm volatile("s_waitcnt lgkmcnt(0)" ::: "memory");
                        GR_REFILL(nv);
                        const bool h32 = lane & 32, h16 = lane & 16, h8 = lane & 8;
                        float q4[4];
#pragma unroll
                        for (int j = 0; j < 4; ++j) { const float keep = h32 ? p[j + 4] : p[j], send = h32 ? p[j] : p[j + 4]; q4[j] = keep + __shfl_xor(send, 32); }
                        float q2[2];
#pragma unroll
                        for (int j = 0; j < 2; ++j) { const float keep = h16 ? q4[j + 2] : q4[j], send = h16 ? q4[j] : q4[j + 2]; q2[j] = keep + __shfl_xor(send, 16); }
                        float q1; { const float keep = h8 ? q2[1] : q2[0], send = h8 ? q2[0] : q2[1]; q1 = keep + __shfl_xor(send, 8); }
                        q1 += __shfl_xor(q1, 4); q1 += __shfl_xor(q1, 2); q1 += __shfl_xor(q1, 1);
                        if ((lane & 7) == 0 && jL < nv) { const u32x2_t me = LIST[g0 + jL]; AL[g0 + jL] = gelu_t(q1 * __uint_as_float((me.x >> 16) << 23)) * __uint_as_float(me.y); }
                    }
                }
            }
        }
        float o[4][16];
#pragma unroll
        for (int tk = 0; tk < 4; ++tk)
#pragma unroll
            for (int q = 0; q < 16; ++q) o[tk][q] = 0.f;
#pragma unroll 1
        for (int r = 0; r < 8; ++r) {
#pragma unroll
            for (int tk = 0; tk < 4; ++tk) {
                const int beg = __builtin_amdgcn_readfirstlane(OFFS[r * 4 + tk]), end = __builtin_amdgcn_readfirstlane(OFFS[r * 4 + tk + 1]);
#pragma unroll 1
                for (int i0 = beg; i0 < end; i0 += 8) {
                    const int nv = (end - i0) < 8 ? (end - i0) : 8;
                    if (i0 <= 500) asm volatile("s_waitcnt vmcnt(4)" ::: "memory"); else asm volatile("s_waitcnt vmcnt(0)" ::: "memory");
                    float aq[8]; u32x4 rw[8];
#pragma unroll
                    for (int j = 0; j < 8; ++j) { aq[j] = (j < nv) ? AL[i0 + j] : 0.f; }
#pragma unroll
                    for (int j = 0; j < 8; ++j) if (j < nv) rw[j] = *(const LAS u32x4*)(RING + ((512 + i0 + j) % GR_R) * 1024 + lane * 16);
#pragma unroll
                    for (int j = 0; j < 8; ++j) if (j < nv) { const float aj = __int_as_float(__builtin_amdgcn_readfirstlane(__float_as_int(aq[j])));
                        float f_[16]; up8(rw[j].x, f_[0], f_[1], f_[2], f_[3]); up8(rw[j].y, f_[4], f_[5], f_[6], f_[7]); up8(rw[j].z, f_[8], f_[9], f_[10], f_[11]); up8(rw[j].w, f_[12], f_[13], f_[14], f_[15]);
#pragma unroll
                        for (int q = 0; q < 16; ++q) o[tk][q] += aj * f_[q]; }
                    asm volatile("s_waitcnt lgkmcnt(0)" ::: "memory");
                    GR_REFILL(nv);
                }
            }
        }
        asm volatile("s_waitcnt vmcnt(0)" ::: "memory");
#pragma unroll
        for (int tk = 0; tk < 4; ++tk) {
            const int t = t0 + tk; const int b = t >> 13; const float* gp = g2 + (size_t)b * 6144; float* xr = X + (size_t)t * 1024;
            float xn[16]; float ss = 0.f;
#pragma unroll
            for (int q = 0; q < 4; ++q) { const int col = lane * 16 + q * 4; const f32x4 xv = *(const f32x4*)(xr + col), gv = *(const f32x4*)(gp + col);
#pragma unroll
                for (int j = 0; j < 4; ++j) { const float y = xv[j] + gv[j] * o[tk][q * 4 + j]; xn[q * 4 + j] = y; ss += y * y; } }
            const float rstd = 1.0f / sqrtf(wave_sum(ss) * (1.0f / 1024.0f) + EPS);
            if (FINAL) {
#pragma unroll
                for (int q = 0; q < 4; ++q) { const int col = lane * 16 + q * 4; const f32x4 gn = *(const f32x4*)(ngain + col); f32x4 y;
#pragma unroll
                    for (int j = 0; j < 4; ++j) y[j] = xn[q * 4 + j] * rstd * gn[j];
                    *(f32x4*)(xr + col) = y; }
            } else {
                const float* nm = nmod + (size_t)b * 6144;
#pragma unroll
                for (int q = 0; q < 4; ++q) { const int col = lane * 16 + q * 4; const f32x4 gn = *(const f32x4*)(ngain + col), sh = *(const f32x4*)(nm + col), sc = *(const f32x4*)(nm + 1024 + col); f32x4 xo; float y[4];
#pragma unroll
                    for (int j = 0; j < 4; ++j) { xo[j] = xn[q * 4 + j]; y[j] = xn[q * 4 + j] * rstd * gn[j] * (1.0f + sc[j]) + sh[j]; }
                    *(f32x4*)(xr + col) = xo; u32x2_t wv; wv.x = cvtpk(y[0], y[1]); wv.y = cvtpk(y[2], y[3]); *(u32x2_t*)(Hn + (size_t)t * 1024 + col) = wv; }
            }
        }
        asm volatile("s_waitcnt vmcnt(0) lgkmcnt(0)" ::: "memory");
    }
#undef GR_ISSUE
#undef GR_REFILL
}
DI float red4_sum(float x) { auto a = __builtin_amdgcn_permlane16_swap(__float_as_uint(x), __float_as_uint(x), false, false); x = __uint_as_float(a[0]) + __uint_as_float(a[1]);
    auto b = __builtin_amdgcn_permlane32_swap(__float_as_uint(x), __float_as_uint(x), false, false); return __uint_as_float(b[0]) + __uint_as_float(b[1]); }
DI float red4_max(float x) { auto a = __builtin_amdgcn_permlane16_swap(__float_as_uint(x), __float_as_uint(x), false, false); x = fmaxf(__uint_as_float(a[0]), __uint_as_float(a[1]));
    auto b = __builtin_amdgcn_permlane32_swap(__float_as_uint(x), __float_as_uint(x), false, false); return fmaxf(__uint_as_float(b[0]), __uint_as_float(b[1])); }
DI float red4_min(float x) { auto a = __builtin_amdgcn_permlane16_swap(__float_as_uint(x), __float_as_uint(x), false, false); x = fminf(__uint_as_float(a[0]), __uint_as_float(a[1]));
    auto b = __builtin_amdgcn_permlane32_swap(__float_as_uint(x), __float_as_uint(x), false, false); return fminf(__uint_as_float(b[0]), __uint_as_float(b[1])); }
constexpr int TK_NI = 6;
DI float tk_pivot(float clo, float chi) {
    const float lc = __builtin_amdgcn_logf(clo), lh = __builtin_amdgcn_logf(fmaxf(chi, 0.5f));
    const float f = (lc - 4.0443941f) * __builtin_amdgcn_rcpf(lc - lh);
    return fminf(fmaxf(f, 0.06f), 0.94f);
}
template <int NV> DI float tk_count(const float (&v)[NV], float mid) {
    const float nb = -mid * 1.099511627776e12f;
    float c0 = 0.f, c1 = 0.f, c2 = 0.f, c3 = 0.f;
#pragma unroll
    for (int i = 0; i < NV; i += 4) {
        c0 += __builtin_amdgcn_fmed3f(__builtin_fmaf(v[i], 1.099511627776e12f, nb), 0.f, 1.f); c1 += __builtin_amdgcn_fmed3f(__builtin_fmaf(v[i + 1], 1.099511627776e12f, nb), 0.f, 1.f);
        c2 += __builtin_amdgcn_fmed3f(__builtin_fmaf(v[i + 2], 1.099511627776e12f, nb), 0.f, 1.f); c3 += __builtin_amdgcn_fmed3f(__builtin_fmaf(v[i + 3], 1.099511627776e12f, nb), 0.f, 1.f);
    }
    float c = (c0 + c1) + (c2 + c3);
    return red4_sum(c);
}
template <int NV> DI void tk_search(const float (&v)[NV], float ntot, float& thr_out) {
    float mx = v[0], mn = v[0];
#pragma unroll
    for (int i = 1; i < NV; ++i) { mx = fmaxf(mx, v[i]); mn = fminf(mn, v[i]); }
    mx = red4_max(mx); mn = red4_min(mn);
    float lo = mn, hi = mx, clo = ntot - 1.0f, chi = 0.0f, thr = mn - 1.0f; bool done = false;
#pragma unroll 1
    for (int iter = 0; iter < 48; ++iter) {
        float fr_ = tk_pivot(clo, chi); if (iter >= TK_NI) fr_ = 0.5f;
        const float mid = done ? thr : lo + (hi - lo) * fr_;
        const float cnt = tk_count<NV>(v, mid);
        if (!done) { if (cnt == 16.0f) { thr = mid; done = true; } else if (cnt > 16.0f) { lo = mid; clo = cnt; thr = mid; } else { hi = mid; chi = cnt; } }
        if (__all(done)) break;
    }
    thr_out = thr;
}
DI void tk_search2(const float (&v0)[32], const float (&v1)[32], float& t0, float& t1) {
    float mx0 = v0[0], mn0 = v0[0], mx1 = v1[0], mn1 = v1[0];
#pragma unroll
    for (int i = 1; i < 32; ++i) { mx0 = fmaxf(mx0, v0[i]); mn0 = fminf(mn0, v0[i]); mx1 = fmaxf(mx1, v1[i]); mn1 = fminf(mn1, v1[i]); }
    mx0 = red4_max(mx0); mn0 = red4_min(mn0); mx1 = red4_max(mx1); mn1 = red4_min(mn1);
    float lo0 = mn0, hi0 = mx0, clo0 = 127.0f, chi0 = 0.0f, thr0 = mn0 - 1.0f; bool done0 = false;
    float lo1 = mn1, hi1 = mx1, clo1 = 127.0f, chi1 = 0.0f, thr1 = mn1 - 1.0f; bool done1 = false;
#pragma unroll 1
    for (int iter = 0; iter < 48; ++iter) {
        float f0 = tk_pivot(clo0, chi0), f1 = tk_pivot(clo1, chi1); if (iter >= TK_NI) { f0 = 0.5f; f1 = 0.5f; }
        const float mid0 = done0 ? thr0 : lo0 + (hi0 - lo0) * f0, mid1 = done1 ? thr1 : lo1 + (hi1 - lo1) * f1;
        const float c0 = tk_count<32>(v0, mid0), c1 = tk_count<32>(v1, mid1);
        if (!done0) { if (c0 == 16.0f) { thr0 = mid0; done0 = true; } else if (c0 > 16.0f) { lo0 = mid0; clo0 = c0; thr0 = mid0; } else { hi0 = mid0; chi0 = c0; } }
        if (!done1) { if (c1 == 16.0f) { thr1 = mid1; done1 = true; } else if (c1 > 16.0f) { lo1 = mid1; clo1 = c1; thr1 = mid1; } else { hi1 = mid1; chi1 = c1; } }
        if (__all(done0 && done1)) break;
    }
    t0 = thr0; t1 = thr1;
}
template <int MODE = 0> DI void peer_topk_fused(const Ctx& C, const bf16* QP, const bf16* KEYS, int* IDX, float* GATE) {
    constexpr int KPI = 288;
    const int lane = C.lane, fr = lane & 15, fq = lane >> 4, w = C.wave;
    LAS unsigned char* KS = C.lds;
    LAS unsigned char* WB = C.lds + 73728 + w * 7168;
    LAS float* LV = (LAS float*)(WB);
    LAS int* LK = (LAS int*)(WB + 2176);
    LAS float* FV = (LAS float*)(WB + 4352);
    LAS int* FI = (LAS int*)(WB + 5504);
    LAS float* TRASH = (LAS float*)(WB + 6656) + lane;
    const int h = C.vcu & 7, nb = C.G >> 3;
    { const bf16* kg = KEYS + (size_t)h * 2 * 128 * 128;
      for (int c = C.tid; c < 4096; c += 512) { const int r = c >> 4, cc = c & 15; *(LAS u32x4*)(KS + r * KPI + cc * 16) = *(const u32x4*)(kg + (size_t)r * 128 + cc * 8); } }
    __syncthreads();
    for (int tt = (C.vcu >> 3) + nb * w; tt < 1024; tt += nb * 8) {
        const int tok = tt * 16 + fr;
        float sc0[32], sc1[32];
#pragma unroll
        for (int p = 0; p < 2; ++p) {
            bf16x8 qf[4];
#pragma unroll
            for (int ks = 0; ks < 4; ++ks) qf[ks] = *(const bf16x8*)(QP + (size_t)tok * 2048 + h * 256 + p * 128 + ks * 32 + fq * 8);
#pragma unroll
            for (int kt = 0; kt < 8; ++kt) {
                f32x4 acc = {0.f, 0.f, 0.f, 0.f};
#pragma unroll
                for (int ks = 0; ks < 4; ++ks) { const bf16x8 kf = *(const LAS bf16x8*)(KS + (p * 128 + kt * 16 + fr) * KPI + (ks * 32 + fq * 8) * 2);
                    acc = __builtin_amdgcn_mfma_f32_16x16x32_bf16(kf, qf[ks], acc, 0, 0, 0); }
                if (p == 0) { sc0[kt * 4 + 0] = acc[0]; sc0[kt * 4 + 1] = acc[1]; sc0[kt * 4 + 2] = acc[2]; sc0[kt * 4 + 3] = acc[3]; }
                else { sc1[kt * 4 + 0] = acc[0]; sc1[kt * 4 + 1] = acc[1]; sc1[kt * 4 + 2] = acc[2]; sc1[kt * 4 + 3] = acc[3]; }
            }
        }
        float thrA = 1.0f, thrB = 1.0f; if (MODE == 0) tk_search2(sc0, sc1, thrA, thrB);
#pragma unroll
        for (int p = 0; p < 2; ++p) {
            const float thr = p == 0 ? thrA : thrB;
            int cnt = 0;
#pragma unroll
            for (int i = 0; i < 32; ++i) cnt += ((p == 0 ? sc0[i] : sc1[i]) > thr) ? 1 : 0;
            const int c0 = __shfl(cnt, fr), c1 = __shfl(cnt, fr + 16), c2 = __shfl(cnt, fr + 32);
            int pos = (fq > 0 ? c0 : 0) + (fq > 1 ? c1 : 0) + (fq > 2 ? c2 : 0);
#pragma unroll
            for (int i = 0; i < 32; ++i) { const float vv = p == 0 ? sc0[i] : sc1[i]; const bool s = vv > thr && pos < 16;
                LAS float* pv = s ? (LV + fr * 33 + p * 16 + pos) : TRASH; LAS int* pk = s ? (LK + fr * 33 + p * 16 + pos) : (LAS int*)TRASH;
                *pv = vv; *pk = (i >> 2) * 16 + 4 * fq + (i & 3); pos += (vv > thr) ? 1 : 0; }
        }
        LDS_WAIT();
        float A[4], Bv[16]; int KA[4], KB[16];
#pragma unroll
        for (int a = 0; a < 4; ++a) { A[a] = LV[fr * 33 + 4 * fq + a]; KA[a] = LK[fr * 33 + 4 * fq + a]; }
#pragma unroll
        for (int bq = 0; bq < 16; ++bq) { Bv[bq] = LV[fr * 33 + 16 + bq]; KB[bq] = LK[fr * 33 + 16 + bq]; }
        float sm[64];
#pragma unroll
        for (int a = 0; a < 4; ++a)
#pragma unroll
            for (int bq = 0; bq < 16; ++bq) sm[a * 16 + bq] = A[a] + Bv[bq];
        float thr2 = 4.0f; if (MODE == 0) tk_search<64>(sm, 256.0f, thr2);
        {
            int cnt = 0;
#pragma unroll
            for (int i = 0; i < 64; ++i) cnt += (sm[i] > thr2) ? 1 : 0;
            const int c0 = __shfl(cnt, fr), c1 = __shfl(cnt, fr + 16), c2 = __shfl(cnt, fr + 32);
            int pos = (fq > 0 ? c0 : 0) + (fq > 1 ? c1 : 0) + (fq > 2 ? c2 : 0);
#pragma unroll
            for (int i = 0; i < 64; ++i) { const bool s = sm[i] > thr2 && pos < 16;
                LAS float* pv = s ? (FV + fr * 17 + pos) : TRASH; LAS int* pk = s ? (FI + fr * 17 + pos) : (LAS int*)TRASH;
                *pv = sm[i]; *pk = KA[i >> 4] * 128 + KB[i & 15]; pos += (sm[i] > thr2) ? 1 : 0; }
        }
        LDS_WAIT();
        float x[4]; int xi[4];
#pragma unroll
        for (int j = 0; j < 4; ++j) { x[j] = FV[fr * 17 + 4 * fq + j]; xi[j] = FI[fr * 17 + 4 * fq + j]; }
        float m = red4_max(fmaxf(fmaxf(x[0], x[1]), fmaxf(x[2], x[3])));
        float e[4]; float s = 0.f;
#pragma unroll
        for (int j = 0; j < 4; ++j) { e[j] = __expf(x[j] - m); s += e[j]; }
        s = red4_sum(s);
        const float inv = 1.0f / s;
        const size_t ob = ((size_t)tok * 8 + h) * 16 + 4 * fq;
        typedef int i32x4 __attribute__((ext_vector_type(4)));
        *(i32x4*)(IDX + ob) = (i32x4){xi[0], xi[1], xi[2], xi[3]}; *(f32x4*)(GATE + ob) = (f32x4){e[0] * inv, e[1] * inv, e[2] * inv, e[3] * inv};
        LDS_WAIT();
    }
}
DI void intra_mfma(const Ctx& C, const bf16* Q, const bf16* K, const bf16* V, const bf16* CROSS, bf16* G) {
    constexpr int RPI = 544, PPI = 144, VPI = 544;
    LAS unsigned char* Qs = C.lds; LAS unsigned char* Ks = Qs + 64 * RPI; LAS unsigned char* Ps = Ks + 64 * RPI; LAS unsigned char* Vs = Ps + 64 * PPI;
    LAS float* red = (LAS float*)(Vs + 64 * VPI);
    const int tid = C.tid, lane = C.lane, w = C.wave, fr = lane & 15, fq = lane >> 4;
    for (int item = C.vcu; item < 1024; item += C.G) {
        const int b = item >> 9, h = (item >> 7) & 3, n = item & 127;
        const float lg2 = log2f(1.0f - exp2f(-5.0f - (float)h));
        const size_t tok0 = (size_t)b * SEQ + (size_t)n * 64;
#pragma unroll
        for (int u = 0; u < 4; ++u) { const int c = tid + 512 * u, r = c >> 5, cc = c & 31;
            *(LAS u32x4*)(Qs + r * RPI + cc * 16) = *(const u32x4*)(Q + (tok0 + r) * 1024 + h * 256 + cc * 8);
            *(LAS u32x4*)(Ks + r * RPI + cc * 16) = *(const u32x4*)(K + (tok0 + r) * 1024 + h * 256 + cc * 8);
            *(LAS u32x4*)(Vs + r * VPI + cc * 16) = *(const u32x4*)(V + (tok0 + r) * 2048 + h * 512 + cc * 8); }
        __syncthreads();
        { const int jt = w >> 1; f32x4 sa[2] = {(f32x4){0.f, 0.f, 0.f, 0.f}, (f32x4){0.f, 0.f, 0.f, 0.f}};
#pragma unroll
          for (int ks = 0; ks < 8; ++ks) { const bf16x8 kf = *(const LAS bf16x8*)(Ks + (16 * jt + fr) * RPI + (32 * ks + 8 * fq) * 2);
#pragma unroll
              for (int q = 0; q < 2; ++q) { const int it = 2 * (w & 1) + q; const bf16x8 qf = *(const LAS bf16x8*)(Qs + (16 * it + fr) * RPI + (32 * ks + 8 * fq) * 2);
                  sa[q] = __builtin_amdgcn_mfma_f32_16x16x32_bf16(kf, qf, sa[q], 0, 0, 0); } }
#pragma unroll
          for (int q = 0; q < 2; ++q) { const int i = 16 * (2 * (w & 1) + q) + fr, j0 = 16 * jt + 4 * fq; float pv[4];
#pragma unroll
              for (int r = 0; r < 4; ++r) { const int dd = i > j0 + r ? i - j0 - r : j0 + r - i; pv[r] = sa[q][r] * exp2f(lg2 * (float)dd); }
              u32x2_t o; o.x = cvtpk(pv[0], pv[1]); o.y = cvtpk(pv[2], pv[3]); *(LAS u32x2_t*)(Ps + i * PPI + j0 * 2) = o; } }
        __syncthreads();
        f32x4 acc[2][2][4];
#pragma unroll
        for (int hf = 0; hf < 2; ++hf) {
#pragma unroll
            for (int et = 0; et < 2; ++et)
#pragma unroll
                for (int it = 0; it < 4; ++it) acc[hf][et][it] = (f32x4){0.f, 0.f, 0.f, 0.f};
            if (hf == 1) { __syncthreads();
#pragma unroll
                for (int u = 0; u < 4; ++u) { const int c = tid + 512 * u, r = c >> 5, cc = c & 31;
                    *(LAS u32x4*)(Vs + r * VPI + cc * 16) = *(const u32x4*)(V + (tok0 + r) * 2048 + h * 512 + 256 + cc * 8); }
                __syncthreads(); }
#pragma unroll
            for (int ks = 0; ks < 2; ++ks) {
                bf16x8 pf[4];
#pragma unroll
                for (int it = 0; it < 4; ++it) { const LAS unsigned char* pp = Ps + (16 * it + fr) * PPI + (32 * ks + 4 * fq) * 2;
                    const u32x2_t lo = *(const LAS u32x2_t*)pp, hi = *(const LAS u32x2_t*)(pp + 32); u32x4 ww; ww.x = lo.x; ww.y = lo.y; ww.z = hi.x; ww.w = hi.y; pf[it] = __builtin_bit_cast(bf16x8, ww); }
#pragma unroll
                for (int et = 0; et < 2; ++et) { const LAS unsigned char* vp = Vs + (32 * ks + 4 * fq + (fr >> 2)) * VPI + (32 * w + 16 * et + 4 * (fr & 3)) * 2;
                    const bf16x8 vf = cat8(trr(vp), trr(vp + 16 * VPI));
#pragma unroll
                    for (int it = 0; it < 4; ++it) acc[hf][et][it] = __builtin_amdgcn_mfma_f32_16x16x32_bf16(vf, pf[it], acc[hf][et][it], 0, 0, 0); }
            }
        }
        float ssq[4] = {0.f, 0.f, 0.f, 0.f};
#pragma unroll
        for (int hf = 0; hf < 2; ++hf)
#pragma unroll
            for (int et = 0; et < 2; ++et)
#pragma unroll
                for (int it = 0; it < 4; ++it) { const u32x2_t cv = *(const u32x2_t*)(CROSS + (tok0 + 16 * it + fr) * 2048 + h * 512 + hf * 256 + 32 * w + 16 * et + 4 * fq);
                    f32x4 y = acc[hf][et][it]; y[0] += bflo(cv.x); y[1] += bfhi(cv.x); y[2] += bflo(cv.y); y[3] += bfhi(cv.y); acc[hf][et][it] = y;
                    ssq[it] += (y[0] * y[0] + y[1] * y[1]) + (y[2] * y[2] + y[3] * y[3]); }
#pragma unroll
        for (int it = 0; it < 4; ++it) { float s = ssq[it]; s += __shfl_xor(s, 16); s += __shfl_xor(s, 32); if (fq == 0) red[w * 64 + 16 * it + fr] = s; }
        __syncthreads();
        float rs[4];
#pragma unroll
        for (int it = 0; it < 4; ++it) { float s = 0.f;
#pragma unroll
            for (int ww = 0; ww < 8; ++ww) s += red[ww * 64 + 16 * it + fr];
            rs[it] = 1.0f / sqrtf(s * (1.0f / 512.0f) + EPS); }
#pragma unroll
        for (int hf = 0; hf < 2; ++hf)
#pragma unroll
            for (int et = 0; et < 2; ++et)
#pragma unroll
                for (int it = 0; it < 4; ++it) { bf16* gp = G + (tok0 + 16 * it + fr) * 2048 + h * 512 + hf * 256 + 32 * w + 16 * et + 4 * fq; const u32x2_t gv = *(const u32x2_t*)gp;
                    const f32x4 y = acc[hf][et][it] * rs[it]; u32x2_t o; o.x = cvtpk(y[0] * bflo(gv.x), y[1] * bfhi(gv.x)); o.y = cvtpk(y[2] * bflo(gv.y), y[3] * bfhi(gv.y)); *(u32x2_t*)gp = o; }
        __syncthreads();
    }
}
#ifndef PHMASK
#define PHMASK 0xFFFFFFu
#endif
#define PH(k) ((PHMASK >> (k)) & 1u)
#ifdef USE_SGU_NAIVE
#define SGU_GATE_FN sgu_gate_naive
#else
#define SGU_GATE_FN sgu_gate_mfma
#endif
#ifdef USE_GATHER_TOKEN
#define GATHER_FN peer_gather8
#else
#ifdef USE_GATHER_ROUNDS
#define GATHER_FN peer_gather_rounds
#else
#define GATHER_FN peer_gather_dma
#endif
#endif
#ifndef DUP_GATHER_SKIP
#define DUP_GATHER_SKIP 0
#endif
#ifndef DUP_GATHER_FAKE
#define DUP_GATHER_FAKE false
#endif
struct Args { const void* in[21]; float* out; unsigned char* ws; };
__global__ void __launch_bounds__(NWAVES * 64, 2) mk_fwd(Args args) {
    extern __shared__ __attribute__((aligned(16))) unsigned char lds[];
    Ctx C; C.lds = (LAS unsigned char*)lds; C.tid = threadIdx.x; C.lane = C.tid & 63; C.wave = __builtin_amdgcn_readfirstlane(C.tid >> 6);
    C.G = gridDim.x; { const int bx = blockIdx.x; C.vcu = (C.G % 8 == 0) ? (bx % 8) * (C.G / 8) + bx / 8 : bx; }
    C.ws = args.ws;
    volatile LAS unsigned* MISC = (volatile LAS unsigned*)(C.lds + MISC_OFF);
    gu32* ctl = (gu32*)(args.ws + WS_CTL);
    for (int u = C.tid; u < (LDS_BYTES - LDSCTL_OFF) / 4; u += NWAVES * 64) ((LAS unsigned*)(C.lds + LDSCTL_OFF))[u] = 0u;
    __syncthreads();
    XcdBarrier bar = xcd_barrier_post((unsigned*)(ctl + CW_BAR), MISC + 8);
#define GRID_BAR() do { xcd_barrier(bar); asm volatile("" : "+v"(C.tid)); C.lane = C.tid & 63; C.wave = __builtin_amdgcn_readfirstlane(C.tid >> 6); } while (0)
    { LAS unsigned long long* PT = (LAS unsigned long long*)(C.lds + PTR_OFF);
      if (C.tid == 0) {
#pragma unroll
          for (int i = 0; i < 21; ++i) PT[i] = (unsigned long long)args.in[i];
      } }
    __syncthreads();
#define INP(T, i) ((const T*)ldp(C, i))
    float* out = args.out; unsigned char* ws = args.ws;
#define MODP ((float*)(ws + WS_MOD))
#define MOD0 ((const float*)(ws + WS_MOD))
#define MOD1 ((const float*)(ws + WS_MOD) + 2 * 6144)
#define cosT ((float*)(ws + WS_COS))
#define sinT ((float*)(ws + WS_SIN))
#define WRI ((bf16*)(ws + WS_WRI))
#define WRO ((bf16*)(ws + WS_WRO))
#define WSI ((bf16*)(ws + WS_WSI))
#define WSO ((bf16*)(ws + WS_WSO))
#define WQ ((bf16*)(ws + WS_WQ))
#define KEYS ((bf16*)(ws + WS_KEYS))
#define STATS ((float*)(ws + WS_STATS))
#define IDX ((int*)(ws + WS_IDX))
#define GATE ((float*)(ws + WS_GATE))
#define H ((bf16*)(ws + WS_H))
#define PU8 ((const unsigned char*)(ws + WS_PU))
#define PV8 ((const unsigned char*)(ws + WS_PV))
#define ISU ((const float*)(ws + WS_ISU))
#define ISV ((const float*)(ws + WS_ISV))
#define Qb ((bf16*)(ws + WS_Q))
#define Kb ((bf16*)(ws + WS_K))
#define Vb ((bf16*)(ws + WS_V))
#define Gb ((bf16*)(ws + WS_G))
#define CROSS ((bf16*)(ws + WS_CROSS))
#define QP ((bf16*)(ws + WS_QP))
#define SCO ((float*)(ws + WS_SC))
#define Ub ((bf16*)(ws + WS_U))
#define VBb ((bf16*)(ws + WS_VB))

    { P0In I; I.c = INP(float, 1); I.ada_w = INP(float, 5); I.ada_b = INP(float, 6); I.ret_w_in = INP(float, 7); I.ret_w_out = INP(float, 8); I.sgu_w_in = INP(float, 9); I.sgu_w_out = INP(float, 15); I.wq = INP(float, 16); I.keys = INP(float, 17); I.pu = INP(float, 18); I.pv = INP(float, 19); I.pos = INP(int, 2);
#ifdef DUP_P0
      p0_prologue(C, I);
      GRID_BAR();
#endif
      if (PH(0)) p0_prologue(C, I); }
    GRID_BAR();
    if (PH(1)) rms_mod_phase(C, INP(float, 0), INP(float, 3), MOD0, 0, 1024, H);
    GRID_BAR();
    { pg8::Gemm g{H, WRI, TT, 6144, 1024}; pg8::StaticOrder S; S.init(TT, 6144, C.G, (int)blockIdx.x);
      pg8::EpiRetProj E{Qb, Kb, Vb, Gb, cosT, sinT};
#ifdef DUP_G1
      pg8::gemm_phase<pg8::EpiRetProj, pg8::StaticOrder, true, true>(C.lds + RING_OFF, g, S, E); GRID_BAR();
#endif
      if (PH(2)) pg8::gemm_phase<pg8::EpiRetProj, pg8::StaticOrder, true, true>(C.lds + RING_OFF, g, S, E); }
    GRID_BAR();
    #ifdef USE_SCAN_NAIVE
    if (PH(3)) scan_naive(C, Qb, Kb, Vb, CROSS);
#else
#ifdef DUP_SCAN
    scan_mfma<DUP_SCAN>(C, Qb, Kb, Vb, CROSS);
    GRID_BAR();
#endif
    if (C.vcu < SCAN_NIT) { if (PH(3)) scan_mfma<0>(C, Qb, Kb, Vb, CROSS); }
    else { P0In I; I.c = nullptr; I.ada_w = nullptr; I.ada_b = nullptr; I.ret_w_in = nullptr; I.ret_w_out = nullptr; I.sgu_w_in = INP(float, 9); I.sgu_w_out = INP(float, 15); I.wq = INP(float, 16); I.keys = nullptr; I.pu = INP(float, 18); I.pv = INP(float, 19); I.pos = nullptr;
      side_work(C, I, SCAN_NIT); }
#endif
    GRID_BAR();
#ifdef USE_INTRA_NAIVE
    if (PH(4)) intra_naive(C, Qb, Kb, Vb, CROSS, Gb);
#else
    if (PH(4)) intra_mfma(C, Qb, Kb, Vb, CROSS, Gb);
#endif
    GRID_BAR();
    { pg8::Gemm g{Gb, WRO, TT, 1024, 2048}; pg8::StaticOrder S; S.init(TT, 1024, C.G, (int)blockIdx.x);
      pg8::EpiResGate E{INP(float, 0), out, MOD0 + 2048, 6144};
      if (PH(5)) pg8::gemm_phase<pg8::EpiResGate, pg8::StaticOrder, true, true>(C.lds + RING_OFF, g, S, E); }
    GRID_BAR();
    if (PH(6)) rms_mod_phase(C, out, INP(float, 4), MOD0, 3072, 4096, H);
    GRID_BAR();
    { pg8::Gemm g{H, WQ, TT, 2048, 1024}; pg8::StaticOrder S; S.init(TT, 2048, C.G, (int)blockIdx.x);
      pg8::EpiBf16<0> E{QP, 2048, nullptr, 0, 0, 1.f};
      if (PH(7)) pg8::gemm_phase<pg8::EpiBf16<0>, pg8::StaticOrder, true, true>(C.lds + RING_OFF, g, S, E); }
    GRID_BAR();
#ifdef USE_TOPK_NAIVE
    if (PH(8)) peer_scores(C, QP, KEYS, SCO);
    GRID_BAR();
    if (PH(9)) peer_topk(C, SCO, IDX, GATE);
#else
#ifdef DUP_TOPK
    peer_topk_fused<DUP_TOPK>(C, QP, KEYS, IDX, GATE);
    GRID_BAR();
#endif
    if (PH(9)) peer_topk_fused<0>(C, QP, KEYS, IDX, GATE);
#endif
    GRID_BAR();
#ifdef DUP_GATHER
    GATHER_FN<false, DUP_GATHER_FAKE, DUP_GATHER_SKIP>(C, H, IDX, GATE, PU8, PV8, ISU, ISV, (float*)(ws + WS_R), MOD0 + 5120, INP(float, 3) + 1024, MOD1, (bf16*)(ws + WS_R + 128 * MiB));
    GRID_BAR();
#endif
    if (PH(10)) GATHER_FN<false>(C, H, IDX, GATE, PU8, PV8, ISU, ISV, out, MOD0 + 5120, INP(float, 3) + 1024, MOD1, H);
    GRID_BAR();
#ifdef DUP_BAR
    for (int q_ = 0; q_ < 10; ++q_) GRID_BAR();
#endif
    { pg8::Gemm g{H, WSI, TT, 6144, 1024}; pg8::StaticOrder S; S.init(TT, 6144, C.G, (int)blockIdx.x);
      pg8::EpiSguIn E{Ub, VBb, INP(float, 10), STATS};
#ifdef DUP_G7
      pg8::gemm_phase<pg8::EpiSguIn, pg8::StaticOrder, true, true>(C.lds + RING_OFF, g, S, E); GRID_BAR();
#endif
      if (PH(11)) pg8::gemm_phase<pg8::EpiSguIn, pg8::StaticOrder, true, true>(C.lds + RING_OFF, g, S, E); }
    GRID_BAR();
    if (PH(12)) SGU_GATE_FN(C, Ub, VBb, STATS, INP(float, 13), INP(float, 14), INP(float, 11), INP(float, 12));
    GRID_BAR();
    { pg8::Gemm g{Ub, WSO, TT, 1024, 3072}; pg8::StaticOrder S; S.init(TT, 1024, C.G, (int)blockIdx.x);
      pg8::EpiResGate E{out, out, MOD1 + 2048, 6144};
      if (PH(13)) pg8::gemm_phase<pg8::EpiResGate, pg8::StaticOrder, true, true>(C.lds + RING_OFF, g, S, E); }
    GRID_BAR();
    if (PH(14)) rms_mod_phase(C, out, INP(float, 4) + 1024, MOD1, 3072, 4096, H);
    GRID_BAR();
    { pg8::Gemm g{H, WQ + (size_t)2048 * 1024, TT, 2048, 1024}; pg8::StaticOrder S; S.init(TT, 2048, C.G, (int)blockIdx.x);
      pg8::EpiBf16<0> E{QP, 2048, nullptr, 0, 0, 1.f};
      if (PH(15)) pg8::gemm_phase<pg8::EpiBf16<0>, pg8::StaticOrder, true, true>(C.lds + RING_OFF, g, S, E); }
    GRID_BAR();
#ifdef USE_TOPK_NAIVE
    if (PH(16)) peer_scores(C, QP, KEYS + (size_t)8 * 2 * 128 * 128, SCO);
    GRID_BAR();
    if (PH(17)) peer_topk(C, SCO, IDX, GATE);
#else
    if (PH(17)) peer_topk_fused<0>(C, QP, KEYS + (size_t)8 * 2 * 128 * 128, IDX, GATE);
#endif
    GRID_BAR();
    if (PH(18)) GATHER_FN<true>(C, H, IDX, GATE, PU8 + (size_t)16384 * 1024, PV8 + (size_t)16384 * 1024, ISU + 16384, ISV + 16384, out, MOD1 + 5120, INP(float, 20), nullptr, nullptr);
#undef GRID_BAR
}

extern "C" void kernel_launch(void* const* d_in, const int* in_sizes, int n_in, void* d_out, int out_size, void* d_ws, size_t ws_size, hipStream_t stream) {
    static int grid = 0;
    if (grid == 0) {
        if (n_in != 21 || in_sizes[0] != TT * DM || out_size != TT * DM || ws_size < WS_END) { fprintf(stderr, "kernel_launch: unexpected shapes/workspace: n_in %d in0 %d out %d ws %zu (need %zu)\n", n_in, n_in > 0 ? in_sizes[0] : -1, out_size, ws_size, (size_t)WS_END); grid = -1; return; }
        int dev = 0, cus = 0;
        if (hipGetDevice(&dev) != hipSuccess || hipDeviceGetAttribute(&cus, hipDeviceAttributeMultiprocessorCount, dev) != hipSuccess) { fprintf(stderr, "kernel_launch: device query failed\n"); grid = -1; return; }
        if (hipFuncSetAttribute((const void*)mk_fwd, hipFuncAttributeMaxDynamicSharedMemorySize, LDS_BYTES) != hipSuccess) { fprintf(stderr, "kernel_launch: hipFuncSetAttribute failed\n"); grid = -1; return; }
        (void)hipGetLastError();
        grid = cus;
    }
    if (grid < 0) return;
    if (hipMemsetAsync((char*)d_ws + WS_CTL, 0, CTL_ZERO_BYTES, stream) != hipSuccess) { fprintf(stderr, "kernel_launch: memset failed\n"); return; }
    Args a; memset(&a, 0, sizeof(a));
    for (int i = 0; i < 21; ++i) a.in[i] = d_in[i];
    a.out = (float*)d_out; a.ws = (unsigned char*)d_ws;
    hipLaunchKernelGGL(mk_fwd, dim3(grid), dim3(NWAVES * 64), LDS_BYTES, stream, a);
    const hipError_t le = hipPeekAtLastError();
    if (le != hipSuccess) fprintf(stderr, "kernel_launch: launch failed: %s\n", hipGetErrorName(le));
}
```

```cpp
#define USE_GATHER_ROUNDS 1
#include <hip/hip_runtime.h>
#include <cstdio>
#include <cstdint>
#include <cstring>
#include <cmath>
namespace pg8 {
#define PG8_LAS __attribute__((address_space(3)))
typedef unsigned short bf16_t;
typedef short bf16x8 __attribute__((ext_vector_type(8)));
typedef float f32x4 __attribute__((ext_vector_type(4)));
typedef unsigned u32x4 __attribute__((ext_vector_type(4)));
constexpr int BM = 256, BK = 64, HALF = 128, HTB = HALF * BK * 2  , STAGE_BYTES = 8 * HTB, NXCD = 8, WGM = 8;

__host__ __device__ __forceinline__ int lds_byte(int r, int c) { const int st = (r >> 4) * 2 + (c >> 5), rr = r & 15, cc = c & 31, ob = rr * 64 + cc * 2; return st * 1024 + (ob ^ (((ob >> 9) & 1) << 5)); }
__host__ __device__ __forceinline__ void stage_rc(int b, int& R, int& C) { const int st = b / 1024, sb = b % 1024, swz = sb ^ (((sb >> 9) & 1) << 5); R = (st >> 1) * 16 + swz / 64; C = (st & 1) * 32 + (swz % 64) / 2; }
__host__ __device__ __forceinline__ int perm32(int rho) { const int n = rho >> 4, i = rho & 15; return 8 * (i >> 2) + 4 * n + (i & 3); }

struct Unit { int pm, pn; };
struct Gemm { const bf16_t* A; const bf16_t* Bt; int M, N, K; };

struct StaticOrder {
    int nM, nN, nwg, G, c;
    __host__ __device__ void init(int M, int N, int G_, int c_) { nM = M / BM; nN = N / BM; nwg = nM * nN; G = G_; c = c_; }
    __host__ __device__ bool next(int i, Unit& u) const {
        const long L = (long)i * G + c; if (L >= nwg) return false;
        int wgid = (int)L; { const int q = nwg / NXCD, r = nwg % NXCD, xcd = wgid % NXCD, off = wgid / NXCD; wgid = (xcd < r ? xcd * (q + 1) : r * (q + 1) + (xcd - r) * q) + off; }
        const int nig = WGM * nN, gid = wgid / nig, fm = gid * WGM, gsz = (nM - fm) < WGM ? (nM - fm) : WGM;
        u.pm = fm + ((wgid % nig) % gsz); u.pn = (wgid % nig) / gsz; return true;
    }
    __device__ __forceinline__ void a_ready(const Unit&) const {}
    __device__ __forceinline__ void done(const Unit&) const {}
};

__device__ __forceinline__ unsigned cvt_pk_bf16(float lo, float hi) { unsigned r; asm volatile("v_cvt_pk_bf16_f32 %0, %1, %2" : "=v"(r) : "v"(lo), "v"(hi)); return r; }
typedef float f32x2 __attribute__((ext_vector_type(2)));
__device__ __forceinline__ f32x2 gelu_pk(f32x2 v) {
    const f32x2 av = __builtin_elementwise_abs(v), d = av * 0.2316418882f + 1.0f;
    f32x2 t; t.x = __builtin_amdgcn_rcpf(d.x); t.y = __builtin_amdgcn_rcpf(d.y);
    f32x2 q = t * 0.5307027145f + (-0.7265760135f); q = q * t + 0.7107068705f; q = q * t + (-0.142248368f); q = q * t + 0.127414796f; q = q * t;
    const f32x2 s = (v * v) * (-0.72134752044f);
    f32x2 e; e.x = __builtin_amdgcn_exp2f(s.x); e.y = __builtin_amdgcn_exp2f(s.y);
    const f32x2 m = v * (q * e), r = v - m;
    f32x2 o; o.x = v.x < 0.f ? m.x : r.x; o.y = v.y < 0.f ? m.y : r.y; return o;
}

template <int ACT  > struct EpiBf16 {
    static constexpr bool PERM = true, AFTER_DRAIN = false; static_assert(ACT == 0 || ACT == 1, "EpiBf16: ACT is 0 (none) or 1 (gelu_pk)");
    bf16_t* O; int ldc; const float* bias; int split_cols; size_t split_stride; float scale0;
    __device__ __forceinline__ void operator()(const f32x4 (&acc)[2][2][4][2], const Unit& u, int wr, int wc, int fr, int fq) const {
        const int row0 = u.pm * BM + wr * 64 + fr; int colt = u.pn * BM; bf16_t* base = O;
        float sc = 1.f; if (split_cols) { const int t = colt / split_cols; base += (size_t)t * split_stride; colt -= t * split_cols; if (t == 0) sc = scale0; }
        const int col0 = colt + wc * 32 + 8 * fq, bcol0 = u.pn * BM + wc * 32 + 8 * fq;
        f32x4 bv[2][2];
#pragma unroll
        for (int bj = 0; bj < 2; ++bj)
#pragma unroll
            for (int n = 0; n < 2; ++n) bv[bj][n] = bias ? *(const f32x4*)(bias + bcol0 + bj * HALF + 4 * n) : (f32x4){0.f, 0.f, 0.f, 0.f};
#pragma unroll
        for (int ai = 0; ai < 2; ++ai)
#pragma unroll
            for (int m = 0; m < 4; ++m) { bf16_t* rowp = base + (size_t)(row0 + ai * HALF + m * 16) * ldc + col0;
#pragma unroll
                for (int bj = 0; bj < 2; ++bj) { f32x4 v0 = acc[ai][bj][m][0] + bv[bj][0], v1 = acc[ai][bj][m][1] + bv[bj][1];
                    if (ACT == 1) { f32x2 a = gelu_pk((f32x2){v0[0], v0[1]}), b = gelu_pk((f32x2){v0[2], v0[3]}), c = gelu_pk((f32x2){v1[0], v1[1]}), d = gelu_pk((f32x2){v1[2], v1[3]});
                        v0 = (f32x4){a.x, a.y, b.x, b.y}; v1 = (f32x4){c.x, c.y, d.x, d.y}; }
                    v0 = v0 * sc; v1 = v1 * sc; u32x4 w; w.x = cvt_pk_bf16(v0[0], v0[1]); w.y = cvt_pk_bf16(v0[2], v0[3]); w.z = cvt_pk_bf16(v1[0], v1[1]); w.w = cvt_pk_bf16(v1[2], v1[3]);
                    *(u32x4*)(rowp + bj * HALF) = w; } }
    }
};
template <class Epi, class Sched, bool ALIGN_EPI = false, bool SP2 = false>
__device__ __forceinline__ void gemm_phase(PG8_LAS unsigned char* lds, const Gemm g, const Sched& S, const Epi& E) {
    int tid_ = threadIdx.x; asm volatile("" : "+v"(tid_));
    const int tid = tid_, wid = __builtin_amdgcn_readfirstlane(tid >> 6), lane = tid & 63, wr = wid >> 2, wc = wid & 3, fr = lane & 15, fq = lane >> 4;
    const int K = g.K, nt = K / BK;
    unsigned voffA[2], voffB[2];
#pragma unroll
    for (int i = 0; i < 2; ++i) { int R, C; stage_rc(tid * 16 + i * 8192, R, C); const int Rb = Epi::PERM ? ((R & ~31) + perm32(R & 31)) : R;
        voffA[i] = (unsigned)(R * K + C) * 2u; voffB[i] = (unsigned)(Rb * K + C) * 2u; }
    const size_t kstep = (size_t)(BK * 2);
    const size_t hstep = (size_t)HALF * K * 2;
    const size_t tstep = 2 * hstep;
    const unsigned ldsw = (unsigned)wid * 1024u;
    const int aoff = lds_byte(wr * 64 + fr, fq * 8), boff = lds_byte(wc * 32 + fr, fq * 8);
#define PG8_SA(b, h) (((b) * 2 + (h)) * HTB)
#define PG8_SB(b, h) ((4 + (b) * 2 + (h)) * HTB)
#define PG8_STAGE(bufoff, gbase, voff) do { _Pragma("unroll") for (int _i = 0; _i < 2; ++_i) \
        __builtin_amdgcn_global_load_lds((const unsigned*)((const char*)(gbase) + (voff)[_i]), (PG8_LAS unsigned*)(lds + (bufoff) + ldsw + _i * 8192), 16, 0, 0); } while (0)
#define PG8_LDA(dst, b, h) do { _Pragma("unroll") for (int m = 0; m < 4; ++m) _Pragma("unroll") for (int k = 0; k < 2; ++k) dst[m][k] = *(const PG8_LAS bf16x8*)(lds + PG8_SA(b, h) + aoff + m * 2048 + k * 1024); } while (0)
#define PG8_LDB(dst, b, h) do { _Pragma("unroll") for (int n = 0; n < 2; ++n) _Pragma("unroll") for (int k = 0; k < 2; ++k) dst[n][k] = *(const PG8_LAS bf16x8*)(lds + PG8_SB(b, h) + boff + n * 2048 + k * 1024); } while (0)
#define PG8_MMA(ai, bj, At, Bt) do { __builtin_amdgcn_s_setprio(1); _Pragma("unroll") for (int m = 0; m < 4; ++m) _Pragma("unroll") for (int n = 0; n < 2; ++n) _Pragma("unroll") for (int k = 0; k < 2; ++k) \
        acc[ai][bj][m][n] = __builtin_amdgcn_mfma_f32_16x16x32_bf16(Bt[n][k], At[m][k], acc[ai][bj][m][n], 0, 0, 0); __builtin_amdgcn_s_setprio(0); } while (0)
#define PG8_WAIT_V(n) asm volatile("s_waitcnt vmcnt(" #n ")" ::: "memory")
#define PG8_WAIT_L(n) asm volatile("s_waitcnt lgkmcnt(" #n ")" ::: "memory")
#define PG8_BAR __builtin_amdgcn_s_barrier()
#define PG8_SCHED __builtin_amdgcn_sched_barrier(0)
    Unit cur, nxt; int ui = 0;
    if (!S.next(0, cur)) return;
    f32x4 acc[2][2][4][2];
#pragma unroll
    for (int a = 0; a < 2; ++a)
#pragma unroll
        for (int b = 0; b < 2; ++b)
#pragma unroll
            for (int m = 0; m < 4; ++m)
#pragma unroll
                for (int n = 0; n < 2; ++n) acc[a][b][m][n] = (f32x4){0.f, 0.f, 0.f, 0.f};
    bf16x8 At[4][2], B0[2][2], B1[2][2];
    const char* cA = (const char*)g.A + (size_t)cur.pm * tstep; const char* cB = (const char*)g.Bt + (size_t)cur.pn * tstep;
    S.a_ready(cur);
    if constexpr (SP2) {
        PG8_STAGE(PG8_SB(0, 0), cB, voffB); PG8_STAGE(PG8_SB(0, 1), cB + hstep, voffB); PG8_STAGE(PG8_SA(0, 0), cA, voffA); PG8_STAGE(PG8_SA(0, 1), cA + hstep, voffA);
        if (wr == 1) PG8_BAR;
        PG8_WAIT_V(2); PG8_BAR;
        PG8_STAGE(PG8_SB(1, 0), cB + kstep, voffB); PG8_STAGE(PG8_SA(1, 0), cA + kstep, voffA); PG8_STAGE(PG8_SB(1, 1), cB + hstep + kstep, voffB);
        PG8_WAIT_V(6); PG8_BAR;
    } else {
        PG8_STAGE(PG8_SB(0, 0), cB, voffB); PG8_STAGE(PG8_SA(0, 0), cA, voffA); PG8_STAGE(PG8_SB(0, 1), cB + hstep, voffB); PG8_STAGE(PG8_SA(0, 1), cA + hstep, voffA);
        if (wr == 1) PG8_BAR;
        PG8_WAIT_V(4); PG8_BAR;
        PG8_STAGE(PG8_SB(1, 0), cB + kstep, voffB); PG8_STAGE(PG8_SA(1, 0), cA + kstep, voffA); PG8_STAGE(PG8_SB(1, 1), cB + hstep + kstep, voffB);
        PG8_WAIT_V(6); PG8_BAR;
    }
    for (;;) {
        const bool has_next = S.next(ui + 1, nxt);
        const char* nA = has_next ? (const char*)g.A + (size_t)nxt.pm * tstep : cA; const char* nB = has_next ? (const char*)g.Bt + (size_t)nxt.pn * tstep : cB;
        for (int t = 0; t < nt; t += 2) {
            const bool last = (t == nt - 2);
            const char* a1 = cA + (size_t)(t + 1) * kstep;
            const char* a2 = last ? nA : cA + (size_t)(t + 2) * kstep; const char* b2 = last ? nB : cB + (size_t)(t + 2) * kstep;
            const char* a3 = a2 + kstep; const char* b3 = b2 + kstep;
            if (last && has_next) S.a_ready(nxt);
            if constexpr (SP2) {
            PG8_LDB(B0, 0, 0); PG8_LDB(B1, 0, 1); PG8_SCHED; PG8_LDA(At, 0, 0); PG8_STAGE(PG8_SA(1, 1), a1 + hstep, voffA);
            PG8_WAIT_V(8); PG8_WAIT_L(0); PG8_BAR; PG8_MMA(0, 0, At, B0); PG8_MMA(0, 1, At, B1); PG8_BAR; PG8_SCHED;
            PG8_LDA(At, 0, 1); PG8_STAGE(PG8_SB(0, 0), b2, voffB); PG8_STAGE(PG8_SB(0, 1), b2 + hstep, voffB); PG8_STAGE(PG8_SA(0, 0), a2, voffA);
            PG8_WAIT_V(8); PG8_WAIT_L(0); PG8_BAR; PG8_MMA(1, 0, At, B0); PG8_MMA(1, 1, At, B1); PG8_BAR; PG8_SCHED;
            PG8_LDB(B0, 1, 0); PG8_LDB(B1, 1, 1); PG8_SCHED; PG8_LDA(At, 1, 0); PG8_STAGE(PG8_SA(0, 1), a2 + hstep, voffA);
            PG8_WAIT_V(8); PG8_WAIT_L(0); PG8_BAR; PG8_MMA(0, 0, At, B0); PG8_MMA(0, 1, At, B1); PG8_BAR; PG8_SCHED;
            PG8_LDA(At, 1, 1); PG8_STAGE(PG8_SB(1, 0), b3, voffB); PG8_STAGE(PG8_SB(1, 1), b3 + hstep, voffB); PG8_STAGE(PG8_SA(1, 0), a3, voffA);
            PG8_WAIT_V(8); PG8_WAIT_L(0); PG8_BAR; PG8_MMA(1, 0, At, B0); PG8_MMA(1, 1, At, B1); PG8_BAR; PG8_SCHED;
            } else {
            PG8_LDB(B0, 0, 0); PG8_SCHED; PG8_LDA(At, 0, 0); PG8_STAGE(PG8_SA(1, 1), a1 + hstep, voffA);
            PG8_WAIT_L(8); PG8_BAR; PG8_WAIT_L(0); PG8_MMA(0, 0, At, B0); PG8_BAR; PG8_SCHED;
            PG8_LDB(B1, 0, 1); PG8_STAGE(PG8_SB(0, 0), b2, voffB);
            PG8_BAR; PG8_WAIT_L(0); PG8_MMA(0, 1, At, B1); PG8_BAR;
            PG8_LDA(At, 0, 1); PG8_STAGE(PG8_SA(0, 0), a2, voffA);
            PG8_BAR; PG8_WAIT_L(0); PG8_MMA(1, 0, At, B0); PG8_BAR; PG8_SCHED;
            PG8_STAGE(PG8_SB(0, 1), b2 + hstep, voffB);
            PG8_WAIT_V(6); PG8_BAR; PG8_MMA(1, 1, At, B1); PG8_BAR;
            PG8_LDB(B0, 1, 0); PG8_SCHED; PG8_LDA(At, 1, 0); PG8_STAGE(PG8_SA(0, 1), a2 + hstep, voffA);
            PG8_WAIT_L(8); PG8_BAR; PG8_WAIT_L(0); PG8_MMA(0, 0, At, B0); PG8_BAR; PG8_SCHED;
            PG8_LDB(B1, 1, 1); PG8_STAGE(PG8_SB(1, 0), b3, voffB);
            PG8_BAR; PG8_WAIT_L(0); PG8_MMA(0, 1, At, B1); PG8_BAR;
            PG8_LDA(At, 1, 1); PG8_STAGE(PG8_SA(1, 0), a3, voffA);
            PG8_BAR; PG8_WAIT_L(0); PG8_MMA(1, 0, At, B0); PG8_BAR; PG8_SCHED;
            PG8_STAGE(PG8_SB(1, 1), b3 + hstep, voffB);
            PG8_WAIT_V(6); PG8_BAR; PG8_MMA(1, 1, At, B1); PG8_BAR;
            }
        }
        if constexpr (ALIGN_EPI) { if (wr == 0) PG8_BAR; }
        if constexpr (!Epi::AFTER_DRAIN) { E(acc, cur, wr, wc, fr, fq); S.done(cur); }
        if (!has_next) break;
#pragma unroll
        for (int a = 0; a < 2; ++a)
#pragma unroll
            for (int b = 0; b < 2; ++b)
#pragma unroll
                for (int m = 0; m < 4; ++m)
#pragma unroll
                    for (int n = 0; n < 2; ++n) acc[a][b][m][n] = (f32x4){0.f, 0.f, 0.f, 0.f};
        cur = nxt; cA = nA; cB = nB; ++ui;
        if constexpr (ALIGN_EPI) { if (wr == 1) PG8_BAR; }
    }
    PG8_WAIT_V(0);
    if constexpr (!ALIGN_EPI) { if (wr == 0) PG8_BAR; }
    PG8_BAR;
    if constexpr (Epi::AFTER_DRAIN) { E.fused(acc, cur, wr, wc, fr, fq, lds, wid, lane); S.done(cur); }
#undef PG8_SA
#undef PG8_SB
#undef PG8_STAGE
#undef PG8_LDA
#undef PG8_LDB
#undef PG8_MMA
#undef PG8_WAIT_V
#undef PG8_WAIT_L
#undef PG8_BAR
#undef PG8_SCHED
}
}
namespace pg8 {
typedef unsigned u32x2 __attribute__((ext_vector_type(2)));
__device__ __forceinline__ float gelu_tanh(float x) {
    const float e = __builtin_amdgcn_exp2f(x * (-2.302208198f - 0.1029432397f * x * x));
    return x * __builtin_amdgcn_rcpf(1.0f + e);
}
__device__ __forceinline__ float silu_f(float x) { return x * __builtin_amdgcn_rcpf(1.0f + __builtin_amdgcn_exp2f(-1.4426950409f * x)); }

struct EpiRetProj {
    static constexpr bool PERM = false, AFTER_DRAIN = false;
    bf16_t *Q, *K, *V, *G; const float *cosT, *sinT;
    __device__ __forceinline__ void operator()(const f32x4 (&acc)[2][2][4][2], const Unit& u, int wr, int wc, int fr, int fq) const {
        const int pn = u.pn;
        if (pn < 8) {
            bf16_t* dst = pn < 4 ? Q : K; const int head = pn & 3; const float sc = pn < 4 ? 1.0f : 0.0625f;
#pragma unroll
            for (int ai = 0; ai < 2; ++ai)
#pragma unroll
                for (int m = 0; m < 4; ++m) {
                    const int row = u.pm * BM + ai * HALF + wr * 64 + m * 16 + fr;
#pragma unroll
                    for (int n = 0; n < 2; ++n) {
                        const int f0 = wc * 32 + n * 16 + fq * 4;
                        const f32x4 c4 = *(const f32x4*)(cosT + (size_t)row * 128 + f0), s4 = *(const f32x4*)(sinT + (size_t)row * 128 + f0);
                        const f32x4 x1 = acc[ai][0][m][n], x2 = acc[ai][1][m][n];
                        const f32x4 o1 = (x1 * c4 - x2 * s4) * sc, o2 = (x1 * s4 + x2 * c4) * sc;
                        u32x2 w1, w2; w1.x = cvt_pk_bf16(o1[0], o1[1]); w1.y = cvt_pk_bf16(o1[2], o1[3]); w2.x = cvt_pk_bf16(o2[0], o2[1]); w2.y = cvt_pk_bf16(o2[2], o2[3]);
                        bf16_t* p = dst + (size_t)row * 1024 + head * 256 + f0;
                        *(u32x2*)p = w1; *(u32x2*)(p + 128) = w2;
                    }
                }
        } else {
            const bool isg = pn >= 16; bf16_t* dst = isg ? G : V; const int colbase = ((pn - 8) & 7) * 256;
#pragma unroll
            for (int ai = 0; ai < 2; ++ai)
#pragma unroll
                for (int m = 0; m < 4; ++m) {
                    const int row = u.pm * BM + ai * HALF + wr * 64 + m * 16 + fr;
#pragma unroll
                    for (int bj = 0; bj < 2; ++bj)
#pragma unroll
                        for (int n = 0; n < 2; ++n) {
                            f32x4 v = acc[ai][bj][m][n];
                            if (isg) { v[0] = silu_f(v[0]); v[1] = silu_f(v[1]); v[2] = silu_f(v[2]); v[3] = silu_f(v[3]); }
                            u32x2 w; w.x = cvt_pk_bf16(v[0], v[1]); w.y = cvt_pk_bf16(v[2], v[3]);
                            *(u32x2*)(dst + (size_t)row * 2048 + colbase + bj * HALF + wc * 32 + n * 16 + fq * 4) = w;
                        }
                }
        }
    }
};
struct EpiResGate {
    static constexpr bool PERM = false, AFTER_DRAIN = false;
    const float* base; float* out; const float* gate; int gstride;
    __device__ __forceinline__ void operator()(const f32x4 (&acc)[2][2][4][2], const Unit& u, int wr, int wc, int fr, int fq) const {
        const int b = (u.pm * BM) >> 13; const float* gp = gate + (size_t)b * gstride;
        const int col0 = u.pn * BM + wc * 32 + 4 * fq;
        f32x4 gv[2][2];
#pragma unroll
        for (int bj = 0; bj < 2; ++bj)
#pragma unroll
            for (int n = 0; n < 2; ++n) gv[bj][n] = *(const f32x4*)(gp + col0 + bj * HALF + n * 16);
#pragma unroll
        for (int ai = 0; ai < 2; ++ai)
#pragma unroll
            for (int m = 0; m < 4; ++m) {
                const size_t off = (size_t)(u.pm * BM + ai * HALF + wr * 64 + m * 16 + fr) * 1024 + col0;
#pragma unroll
                for (int bj = 0; bj < 2; ++bj)
#pragma unroll
                    for (int n = 0; n < 2; ++n) { const f32x4 bs = *(const f32x4*)(base + off + bj * HALF + n * 16); *(f32x4*)(out + off + bj * HALF + n * 16) = bs + gv[bj][n] * acc[ai][bj][m][n]; }
            }
    }
};
struct EpiSguIn {
    static constexpr bool PERM = true, AFTER_DRAIN = false;
    bf16_t* U; bf16_t* Vb; const float* bias; float* stats;
    __device__ __forceinline__ void operator()(const f32x4 (&acc)[2][2][4][2], const Unit& u, int wr, int wc, int fr, int fq) const {
        const bool isv = u.pn >= 12; bf16_t* base = isv ? Vb : U; const int colt = (isv ? u.pn - 12 : u.pn) * BM;
        const int col0 = colt + wc * 32 + 8 * fq, bcol0 = u.pn * BM + wc * 32 + 8 * fq;
        f32x4 bv[2][2];
#pragma unroll
        for (int bj = 0; bj < 2; ++bj)
#pragma unroll
            for (int n = 0; n < 2; ++n) bv[bj][n] = *(const f32x4*)(bias + bcol0 + bj * HALF + 4 * n);
#pragma unroll
        for (int ai = 0; ai < 2; ++ai)
#pragma unroll
            for (int m = 0; m < 4; ++m) {
                const int row = u.pm * BM + ai * HALF + wr * 64 + m * 16 + fr;
                bf16_t* rowp = base + (size_t)row * 3072 + col0;
                float s1 = 0.f, s2 = 0.f;
#pragma unroll
                for (int bj = 0; bj < 2; ++bj) {
                    f32x4 v0 = acc[ai][bj][m][0] + bv[bj][0], v1 = acc[ai][bj][m][1] + bv[bj][1];
#pragma unroll
                    for (int j = 0; j < 4; ++j) { v0[j] = gelu_tanh(v0[j]); v1[j] = gelu_tanh(v1[j]); }
                    u32x4 w; w.x = cvt_pk_bf16(v0[0], v0[1]); w.y = cvt_pk_bf16(v0[2], v0[3]); w.z = cvt_pk_bf16(v1[0], v1[1]); w.w = cvt_pk_bf16(v1[2], v1[3]);
                    *(u32x4*)(rowp + bj * HALF) = w;
                    if (isv) {
#pragma unroll
                        for (int j = 0; j < 4; ++j) { const unsigned ww = j == 0 ? w.x : j == 1 ? w.y : j == 2 ? w.z : w.w;
                            const float a = __uint_as_float(ww << 16), bq = __uint_as_float(ww & 0xffff0000u); s1 += a + bq; s2 += a * a + bq * bq; }
                    }
                }
                if (isv) {
                    s1 += __shfl_xor(s1, 16); s1 += __shfl_xor(s1, 32); s2 += __shfl_xor(s2, 16); s2 += __shfl_xor(s2, 32);
                    if (fq == 0) { float* sp = stats + ((size_t)row * 48 + (u.pn - 12) * 4 + wc) * 2; sp[0] = s1; sp[1] = s2; }
                }
            }
    }
};
}
typedef unsigned u32x4 __attribute__((ext_vector_type(4)));
#define GAS __attribute__((address_space(1)))
#define LAS __attribute__((address_space(3)))
typedef unsigned short bf16;
typedef unsigned v4u __attribute__((ext_vector_type(4)));
typedef float f32x4 __attribute__((ext_vector_type(4)));
typedef short bf16x8 __attribute__((ext_vector_type(8)));
typedef GAS unsigned gu32;
typedef GAS unsigned long long gu64;
#define RLX_AGENT __ATOMIC_RELAXED, __HIP_MEMORY_SCOPE_AGENT
#define LDS_WAIT() asm volatile("s_waitcnt lgkmcnt(0)" ::: "memory")
#define VM_WAIT() asm volatile("s_waitcnt vmcnt(0)" ::: "memory")
__device__ __forceinline__ unsigned long long rt() { return __builtin_amdgcn_s_memrealtime(); }
__device__ __forceinline__ unsigned f2bf(float f) { unsigned u = __builtin_bit_cast(unsigned, f); return (u + 0x7fffu + ((u >> 16) & 1u)) >> 16; }
__device__ __forceinline__ unsigned pk2(float lo, float hi) { return f2bf(lo) | (f2bf(hi) << 16); }

#define XB_TMO      128
#define XB_XCNT(j)  (256  + 64 * (j))
#define XB_XSUB(j)  (1280 + 64 * (j))
#define XB_XGEN(j)  (2304 + 64 * (j))
#define XB_TOP      3328
#define XB_TOPGEN   3392
#define XCD_BAR_WORDS 3456
#define XB_SPIN_CAP (1u << 18)

__device__ __forceinline__ unsigned xb_ld(unsigned* p)              { return __hip_atomic_load(p, __ATOMIC_RELAXED, __HIP_MEMORY_SCOPE_AGENT); }
__device__ __forceinline__ unsigned xb_add(unsigned* p, unsigned v) { return __hip_atomic_fetch_add(p, v, __ATOMIC_RELAXED, __HIP_MEMORY_SCOPE_AGENT); }
__device__ __forceinline__ unsigned xb_xcc_id() { return (unsigned)__builtin_amdgcn_s_getreg((3 << 11) | 20) & 0xFu; }
#define XB_SPIN(cond, bar) do { unsigned _sp = 0; while (cond) { __builtin_amdgcn_s_sleep(1); \
    if ((++_sp & 255u) == 0u) { if (xb_ld(&(bar)[XB_TMO])) break; if (_sp > XB_SPIN_CAP) { atomicAdd(&(bar)[XB_TMO], 1u); break; } } } } while (0)

struct XcdBarrier {
    unsigned* bar; unsigned x;
    volatile LAS unsigned* st;
};

__device__ __forceinline__ XcdBarrier xcd_barrier_post(unsigned* bar, volatile LAS unsigned* st) {
    XcdBarrier b; b.bar = bar; b.x = xb_xcc_id(); b.st = st;
    if (threadIdx.x == 0) (void)xb_add(&bar[XB_XCNT(b.x)], 1u);
    return b;
}
__device__ __forceinline__ void xcd_barrier_complete(unsigned* bar, unsigned x, unsigned& nloc, unsigned& nx) {
    const unsigned G = gridDim.x * gridDim.y * gridDim.z;
    unsigned sum, cnt, mine, sp = 0u;
    for (;;) {
        sum = 0u; cnt = 0u; mine = 0u;
#pragma unroll
        for (unsigned j = 0; j < 16; ++j) { const unsigned c = xb_ld(&bar[XB_XCNT(j)]); sum += c; cnt += (c > 0u) ? 1u : 0u; mine = (j == x) ? c : mine; }
        if (sum == G) break;
        __builtin_amdgcn_s_sleep(1);
        if ((++sp & 255u) == 0u) { if (xb_ld(&bar[XB_TMO])) break; if (sp > XB_SPIN_CAP) { atomicAdd(&bar[XB_TMO], 1u); break; } }
    }
    nloc = mine > 0u ? mine : 1u; nx = cnt > 0u ? cnt : 1u;
}

__device__ __forceinline__ void xcd_barrier(const XcdBarrier& b) {
    asm volatile("s_waitcnt vmcnt(0)" ::: "memory");
    __syncthreads();
    if (threadIdx.x == 0) {
        unsigned* bar = b.bar;
        __builtin_amdgcn_s_waitcnt(0);
        unsigned nloc = b.st[0], nx = b.st[1];
        if (nloc == 0u) { xcd_barrier_complete(bar, b.x, nloc, nx); b.st[0] = nloc; b.st[1] = nx; }
        const unsigned old = xb_add(&bar[XB_XSUB(b.x)], 1u);
        const unsigned gen = old / nloc;
        if (old + 1u == (gen + 1u) * nloc) {
            __builtin_amdgcn_fence(__ATOMIC_RELEASE, "agent");
            asm volatile("s_waitcnt vmcnt(0)" ::: "memory");
            const unsigned og = xb_add(&bar[XB_TOP], 1u);
            const unsigned tg = og / nx;
            if (og + 1u == (tg + 1u) * nx) xb_add(&bar[XB_TOPGEN], 1u);
            else XB_SPIN(xb_ld(&bar[XB_TOPGEN]) == tg, bar);
            __builtin_amdgcn_fence(__ATOMIC_ACQUIRE, "agent");
            xb_add(&bar[XB_XGEN(b.x)], 1u);
            asm volatile("s_waitcnt vmcnt(0)" ::: "memory");
        } else {
            XB_SPIN(xb_ld(&bar[XB_XGEN(b.x)]) == gen, bar);
            __builtin_amdgcn_fence(__ATOMIC_ACQUIRE, "agent");
            asm volatile("s_waitcnt vmcnt(0)" ::: "memory");
        }
    }
    __syncthreads();
}
__device__ __forceinline__ float wave_sum(float v) {
#pragma unroll
    for (int o = 1; o < 64; o <<= 1) v += __shfl_xor(v, o);
    return v;
}
__device__ __forceinline__ void p0_transpose_item(const float* W, int K, int N, bf16* WT, int row_off, LAS float* scr, int item, int lane) {
    const int nblk = N / 32, kb = item / nblk, nb = item % nblk, k0 = 64 * kb, n0 = 32 * nb;
#pragma unroll 8
    for (int i = 0; i < 32; ++i) { const int kk = 2 * i + (lane >> 5); scr[kk * 33 + (lane & 31)] = W[(size_t)(k0 + kk) * N + n0 + (lane & 31)]; }
    LDS_WAIT(); asm volatile("" ::: "memory");
    const int c = lane & 7;
#pragma unroll
    for (int j = 0; j < 4; ++j) { const int n = (lane >> 3) + 8 * j; const LAS float* s = scr + (8 * c) * 33 + n;
        v4u o; o.x = pk2(s[0 * 33], s[1 * 33]); o.y = pk2(s[2 * 33], s[3 * 33]); o.z = pk2(s[4 * 33], s[5 * 33]); o.w = pk2(s[6 * 33], s[7 * 33]);
        *(GAS v4u*)(WT + (size_t)(row_off + n0 + n) * K + k0 + 8 * c) = o; }
    LDS_WAIT(); asm volatile("" ::: "memory");
}
#define DI __device__ __forceinline__
constexpr int NWAVES = 8;
constexpr int TT = 16384, DM = 1024, SEQ = 8192;
constexpr size_t MiB = 1u << 20;
constexpr size_t WS_CTL = 0, CTL_ZERO_BYTES = 32768, WS_MOD = 512 * 1024;
constexpr size_t WS_COS = 2 * MiB, WS_SIN = 10 * MiB;
constexpr size_t WS_WRI = 18 * MiB, WS_WRO = 30 * MiB, WS_WSI = 34 * MiB, WS_WSO = 46 * MiB, WS_WQ = 52 * MiB, WS_KEYS = 60 * MiB;
constexpr size_t WS_ISU = 61 * MiB, WS_ISV = 61 * MiB + 256 * 1024;
constexpr size_t WS_STATS = 62 * MiB, WS_IDX = 68 * MiB, WS_GATE = 76 * MiB, WS_H = 84 * MiB, WS_PU = 116 * MiB, WS_PV = 180 * MiB;
constexpr size_t WS_R = 244 * MiB;
constexpr size_t WS_Q = WS_R, WS_K = WS_R + 32 * MiB, WS_V = WS_R + 64 * MiB, WS_G = WS_R + 128 * MiB, WS_CROSS = WS_R + 192 * MiB;
constexpr size_t WS_QP = WS_R, WS_SC = WS_R + 64 * MiB;
constexpr size_t WS_U = WS_R, WS_VB = WS_R + 96 * MiB;
constexpr size_t WS_END = 500 * MiB;
constexpr int CW_TMO = 0, CW_BAR = 4096;
constexpr int RING_OFF = 0, RING_BYTES = 131072, LDS_BYTES = 163840, LDSCTL_OFF = LDS_BYTES - 1024, MISC_OFF = LDSCTL_OFF + 320;
constexpr int PTR_OFF = LDSCTL_OFF + 512;
constexpr float EPS = 1e-6f;
typedef float f32x2_t __attribute__((ext_vector_type(2)));

DI float bf2f(bf16 h) { return __uint_as_float((unsigned)h << 16); }
DI float bflo(unsigned w) { return __uint_as_float(w << 16); }
DI float bfhi(unsigned w) { return __uint_as_float(w & 0xffff0000u); }
DI float wave_max(float v) {
#pragma unroll
    for (int o = 1; o < 64; o <<= 1) v = fmaxf(v, __shfl_xor(v, o));
    return v;
}
DI float gelu_t(float x) { return pg8::gelu_tanh(x); }

struct Ctx {
    LAS unsigned char* lds; int tid, lane, wave, vcu, G;
    unsigned char* ws;
};

DI const void* ldp(const Ctx& C, int i) {
    const unsigned long long v = ((const LAS unsigned long long*)(C.lds + PTR_OFF))[i];
    const unsigned lo = __builtin_amdgcn_readfirstlane((unsigned)v), hi = __builtin_amdgcn_readfirstlane((unsigned)(v >> 32));
    return (const void*)(((unsigned long long)hi << 32) | lo);
}
DI void cvt_rows_fp8(const float* src, unsigned char* dst, float* inv_scale, int nrows, int gw, int NGW, int lane) {
    for (int r = gw; r < nrows; r += NGW) {
        const f32x4* s = (const f32x4*)(src + (size_t)r * 1024) + lane * 4;
        f32x4 v[4]; float am = 0.f;
#pragma unroll
        for (int q = 0; q < 4; ++q) { v[q] = s[q]; am = fmaxf(am, fmaxf(fmaxf(fabsf(v[q][0]), fabsf(v[q][1])), fmaxf(fabsf(v[q][2]), fabsf(v[q][3])))); }
        am = wave_max(am);
        const int e = (int)((__float_as_uint(am) >> 23) & 0xffu) - 127;
        const bool ok = am > 1e-30f;
        const float sc = ok ? __uint_as_float((unsigned)(127 + 7 - e) << 23) : 1.0f, isc = ok ? __uint_as_float((unsigned)(127 - 7 + e) << 23) : 1.0f;
        u32x4 o;
#pragma unroll
        for (int q = 0; q < 4; ++q) { int wd = __builtin_amdgcn_cvt_pk_fp8_f32(v[q][0] * sc, v[q][1] * sc, 0, false); wd = __builtin_amdgcn_cvt_pk_fp8_f32(v[q][2] * sc, v[q][3] * sc, wd, true); o[q] = (unsigned)wd; }
        *(u32x4*)(dst + (size_t)r * 1024 + lane * 16) = o;
        if (lane == 0) inv_scale[r] = isc;
    }
}
DI void cvt_rows_i8(const float* src, unsigned char* dst, float* inv_scale, int nrows, int gw, int NGW, int lane) {
    for (int r = gw; r < nrows; r += NGW) {
        const f32x4* s = (const f32x4*)(src + (size_t)r * 1024) + lane * 4;
        f32x4 v[4]; float am = 0.f;
#pragma unroll
        for (int q = 0; q < 4; ++q) { v[q] = s[q]; am = fmaxf(am, fmaxf(fmaxf(fabsf(v[q][0]), fabsf(v[q][1])), fmaxf(fabsf(v[q][2]), fabsf(v[q][3])))); }
        am = wave_max(am);
        const int e = (int)((__float_as_uint(am) >> 23) & 0xffu) - 127;
        const bool ok = am > 1e-30f;
        const float sc = ok ? __uint_as_float((unsigned)(127 + 6 - e) << 23) : 1.0f, isc = ok ? __uint_as_float((unsigned)(127 - 6 + e) << 23) : 1.0f;
        u32x4 o;
#pragma unroll
        for (int q = 0; q < 4; ++q) { unsigned wd = 0u;
#pragma unroll
            for (int j = 0; j < 4; ++j) { int qi = (int)rintf(v[q][j] * sc); qi = qi > 127 ? 127 : (qi < -127 ? -127 : qi); wd |= ((unsigned)qi & 0xffu) << (8 * j); }
            o[q] = wd; }
        *(u32x4*)(dst + (size_t)r * 1024 + lane * 16) = o;
        if (lane == 0) inv_scale[r] = isc;
    }
}
DI void cvt_stream(const float* src, bf16* dst, size_t n4, size_t gtid, size_t gthreads) {
    const f32x4* s = (const f32x4*)src; uint2* d = (uint2*)dst;
    for (size_t i = gtid; i < n4; i += gthreads) { const f32x4 v = s[i]; uint2 o; o.x = pk2(v.x, v.y); o.y = pk2(v.z, v.w); d[i] = o; }
}
struct P0In { const float *c, *ada_w, *ada_b, *ret_w_in, *ret_w_out, *sgu_w_in, *sgu_w_out, *wq, *keys, *pu, *pv; const int* pos; };
DI void p0_prologue(const Ctx& C, const P0In& I) {
    LAS float* scr = (LAS float*)(C.lds + RING_OFF + C.wave * 16384);
    const int gw = C.vcu * NWAVES + C.wave, NGW = C.G * NWAVES;
    bf16* wri = (bf16*)(C.ws + WS_WRI); bf16* wro = (bf16*)(C.ws + WS_WRO);
    constexpr int I_RI = 16 * 192, I_RO = 32 * 32;
    constexpr int NITEMS = I_RI + I_RO;
    for (int it = gw; it < NITEMS; it += NGW) {
        int r = it;
        if (r < I_RI) { p0_transpose_item(I.ret_w_in, 1024, 6144, wri, 0, scr, r, C.lane); continue; } r -= I_RI;
        p0_transpose_item(I.ret_w_out, 2048, 1024, wro, 0, scr, r, C.lane);
    }
    const size_t gtid = (size_t)C.vcu * 512 + C.tid, gth = (size_t)C.G * 512;
    cvt_stream(I.keys, (bf16*)(C.ws + WS_KEYS), (size_t)2 * 8 * 2 * 128 * 128 / 4, gtid, gth);
    float* mod = (float*)(C.ws + WS_MOD);
    __syncthreads();
    for (int it = C.vcu; it < 2 * 96; it += C.G) {
        const int l = it / 96, cb = it % 96, kp = C.wave, n = cb * 64 + C.lane;
        const float* W = I.ada_w + (size_t)l * 1024 * 6144 + n;
        float a0 = 0.f, a1 = 0.f;
#pragma unroll 8
        for (int k = kp * 128; k < kp * 128 + 128; ++k) {
            const float w = W[(size_t)k * 6144]; const float c0 = I.c[k], c1 = I.c[1024 + k];
            a0 += pg8::silu_f(c0) * w; a1 += pg8::silu_f(c1) * w;
        }
        LAS float* red = (LAS float*)(C.lds + RING_OFF);
        red[(kp * 2 + 0) * 64 + C.lane] = a0; red[(kp * 2 + 1) * 64 + C.lane] = a1;
        __syncthreads();
        if (C.wave < 2) { float s = I.ada_b[l * 6144 + n];
#pragma unroll
            for (int q = 0; q < 8; ++q) s += red[(q * 2 + C.wave) * 64 + C.lane];
            mod[(size_t)(l * 2 + C.wave) * 6144 + n] = s; }
        __syncthreads();
    }
    float* cosT = (float*)(C.ws + WS_COS); float* sinT = (float*)(C.ws + WS_SIN);
    for (int it = gw; it < TT / 2; it += NGW) {
        const int row = 2 * it + (C.lane >> 5), f0 = (C.lane & 31) * 4; const float p = (float)I.pos[row];
        f32x4 cv, sv;
#pragma unroll
        for (int j = 0; j < 4; ++j) { const int f = f0 + j; double w = 1.0, bs = 0.93057204092969898;
#pragma unroll
            for (int bit = 0; bit < 7; ++bit) { if ((f >> bit) & 1) w *= bs; bs *= bs; }
            const float ang = p * (float)w; const double r = (double)ang * 0.15915494309189535; const float fr = (float)(r - floor(r)); cv[j] = __builtin_amdgcn_cosf(fr); sv[j] = __builtin_amdgcn_sinf(fr); }
        *(f32x4*)(cosT + (size_t)row * 128 + f0) = cv; *(f32x4*)(sinT + (size_t)row * 128 + f0) = sv;
    }
}
DI void side_work(const Ctx& C, const P0In& I, int nskip) {
    LAS float* scr = (LAS float*)(C.lds + RING_OFF + C.wave * 16384);
    const int gw = (C.vcu - nskip) * NWAVES + C.wave, NGW = (C.G - nskip) * NWAVES;
    bf16* wsi = (bf16*)(C.ws + WS_WSI); bf16* wso = (bf16*)(C.ws + WS_WSO); bf16* wq = (bf16*)(C.ws + WS_WQ);
    constexpr int I_SI = 16 * 192, I_SO = 48 * 32, I_Q = 16 * 64;
    constexpr int NITEMS = I_SI + I_SO + 2 * I_Q;
    for (int it = gw; it < NITEMS; it += NGW) {
        int r = it;
        if (r < I_SI) { p0_transpose_item(I.sgu_w_in, 1024, 6144, wsi, 0, scr, r, C.lane); continue; } r -= I_SI;
        if (r < I_SO) { p0_transpose_item(I.sgu_w_out, 3072, 1024, wso, 0, scr, r, C.lane); continue; } r -= I_SO;
        if (r < I_Q) { p0_transpose_item(I.wq, 1024, 2048, wq, 0, scr, r, C.lane); continue; } r -= I_Q;
        p0_transpose_item(I.wq + (size_t)1024 * 2048, 1024, 2048, wq + (size_t)2048 * 1024, 0, scr, r, C.lane);
    }
    cvt_rows_i8(I.pu, (unsigned char*)(C.ws + WS_PU), (float*)(C.ws + WS_ISU), 2 * 16384, gw, NGW, C.lane);
    cvt_rows_fp8(I.pv, (unsigned char*)(C.ws + WS_PV), (float*)(C.ws + WS_ISV), 2 * 16384, gw, NGW, C.lane);
}
DI void rms_mod_row(const float* xrow, const float* gain, const float* shift, const float* scale, bf16* orow, int lane) {
    const f32x4* xr = (const f32x4*)xrow + lane; f32x4 v[4]; float s = 0.f;
#pragma unroll
    for (int j = 0; j < 4; ++j) { v[j] = xr[64 * j]; s += (v[j].x * v[j].x + v[j].y * v[j].y) + (v[j].z * v[j].z + v[j].w * v[j].w); }
    const float rstd = 1.0f / sqrtf(wave_sum(s) * (1.0f / 1024.0f) + EPS);
    uint2* o8 = (uint2*)orow + lane;
#pragma unroll
    for (int j = 0; j < 4; ++j) { const f32x4 g = ((const f32x4*)gain)[lane + 64 * j], sh = ((const f32x4*)shift)[lane + 64 * j], sc = ((const f32x4*)scale)[lane + 64 * j];
        const f32x4 y = v[j] * rstd * g * (sc + 1.0f) + sh; uint2 o; o.x = pk2(y.x, y.y); o.y = pk2(y.z, y.w); o8[64 * j] = o; }
}
DI void rms_mod_phase(const Ctx& C, const float* x, const float* gain, const float* mod_l, int sh_off, int sc_off, bf16* H) {
    const int gw = C.vcu * NWAVES + C.wave, NGW = C.G * NWAVES;
    for (int m = gw; m < TT; m += NGW) { const float* ml = mod_l + (size_t)(m >> 13) * 6144; rms_mod_row(x + (size_t)m * DM, gain, ml + sh_off, ml + sc_off, H + (size_t)m * DM, C.lane); }
}

DI void scan_naive(const Ctx& C, const bf16* Q, const bf16* K, const bf16* V, bf16* CROSS) {
    LAS float* Sst = (LAS float*)(C.lds);
    LAS unsigned* Qs = (LAS unsigned*)(C.lds + 16384);
    LAS bf16* Ks = (LAS bf16*)(C.lds + 16384 + 32768);
    LAS float* Vs = (LAS float*)(C.lds + 16384 + 65536);
    const int tid = C.tid;
    for (int item = C.vcu; item < 256; item += C.G) {
        const int b = item >> 7, h = (item >> 5) & 3, es = item & 31;
        const float lg2 = log2f(1.0f - exp2f(-5.0f - (float)h)); const float gc = exp2f(lg2 * 64.0f);
        for (int i = tid; i < 4096; i += 512) Sst[i] = 0.f;
        __syncthreads();
        for (int n = 0; n < 128; ++n) {
            const size_t tok0 = (size_t)b * SEQ + (size_t)n * 64;
            for (int ch = tid; ch < 2048; ch += 512) { const int r = ch >> 5, c = ch & 31;
                const u32x4 q = *(const u32x4*)(Q + (tok0 + r) * 1024 + h * 256 + c * 8); *(LAS u32x4*)(Qs + r * 128 + c * 4) = q;
                const u32x4 k = *(const u32x4*)(K + (tok0 + r) * 1024 + h * 256 + c * 8); *(LAS u32x4*)((LAS unsigned*)Ks + r * 128 + c * 4) = k; }
            for (int o = tid; o < 1024; o += 512) { const int j = o >> 4, e = o & 15; Vs[o] = bf2f(V[(tok0 + j) * 2048 + h * 512 + es * 16 + e]) * exp2f(lg2 * (float)(63 - j)); }
            __syncthreads();
#pragma unroll
            for (int oo = 0; oo < 2; ++oo) { const int o = tid + oo * 512, i = o >> 4, e = o & 15; float acc = 0.f;
#pragma unroll 8
                for (int d2 = 0; d2 < 128; ++d2) { const unsigned q2 = Qs[i * 128 + d2]; acc += bflo(q2) * Sst[(2 * d2) * 16 + e] + bfhi(q2) * Sst[(2 * d2 + 1) * 16 + e]; }
                CROSS[(tok0 + i) * 2048 + h * 512 + es * 16 + e] = (bf16)f2bf(acc * exp2f(lg2 * (float)(i + 1))); }
            __syncthreads();
            { const int e = tid & 15, dg = tid >> 4; float a[8];
#pragma unroll
              for (int r = 0; r < 8; ++r) a[r] = gc * Sst[(dg + 32 * r) * 16 + e];
#pragma unroll 4
              for (int j = 0; j < 64; ++j) { const float vz = Vs[j * 16 + e];
#pragma unroll
                  for (int r = 0; r < 8; ++r) a[r] += bf2f(Ks[j * 256 + dg + 32 * r]) * vz; }
#pragma unroll
              for (int r = 0; r < 8; ++r) Sst[(dg + 32 * r) * 16 + e] = a[r]; }
            __syncthreads();
        }
    }
}
DI void intra_naive(const Ctx& C, const bf16* Q, const bf16* K, const bf16* V, const bf16* CROSS, bf16* G) {
    LAS unsigned* Qs = (LAS unsigned*)(C.lds);
    LAS unsigned* Ks = (LAS unsigned*)(C.lds + 32768);
    LAS float* SC = (LAS float*)(C.lds + 65536);
    LAS float* red = (LAS float*)(C.lds + 65536 + 16384);
    LAS float* rs = red + 512;
    const int tid = C.tid;
    for (int item = C.vcu; item < 1024; item += C.G) {
        const int b = item >> 9, h = (item >> 7) & 3, n = item & 127;
        const float lg2 = log2f(1.0f - exp2f(-5.0f - (float)h));
        const size_t tok0 = (size_t)b * SEQ + (size_t)n * 64;
        for (int ch = tid; ch < 2048; ch += 512) { const int r = ch >> 5, c = ch & 31;
            *(LAS u32x4*)(Qs + r * 128 + c * 4) = *(const u32x4*)(Q + (tok0 + r) * 1024 + h * 256 + c * 8);
            *(LAS u32x4*)(Ks + r * 128 + c * 4) = *(const u32x4*)(K + (tok0 + r) * 1024 + h * 256 + c * 8); }
        __syncthreads();
        { const int i = tid >> 3, jb = (tid & 7) * 8;
#pragma unroll
          for (int jj = 0; jj < 8; ++jj) { const int j = jb + jj; float acc = 0.f;
#pragma unroll 8
              for (int d2 = 0; d2 < 128; ++d2) { const unsigned q2 = Qs[i * 128 + d2], k2 = Ks[j * 128 + d2]; acc += bflo(q2) * bflo(k2) + bfhi(q2) * bfhi(k2); }
              const int dd = i > j ? i - j : j - i; SC[i * 64 + j] = acc * exp2f(lg2 * (float)dd); } }
        __syncthreads();
#pragma unroll 1
        for (int pass = 0; pass < 2; ++pass) { const int e = tid, ib = pass * 32; float y[32];
#pragma unroll
          for (int i = 0; i < 32; ++i) y[i] = 0.f;
          const bf16* vp = V + tok0 * 2048 + h * 512 + e;
#pragma unroll 1
          for (int j4 = 0; j4 < 16; ++j4) {
              const float v0 = bf2f(vp[(size_t)(4 * j4 + 0) * 2048]), v1 = bf2f(vp[(size_t)(4 * j4 + 1) * 2048]), v2 = bf2f(vp[(size_t)(4 * j4 + 2) * 2048]), v3 = bf2f(vp[(size_t)(4 * j4 + 3) * 2048]);
#pragma unroll
              for (int i = 0; i < 32; ++i) { const f32x4 s4 = *(const LAS f32x4*)(SC + (ib + i) * 64 + 4 * j4); y[i] += (s4.x * v0 + s4.y * v1) + (s4.z * v2 + s4.w * v3); }
          }
          const bf16* cp = CROSS + (tok0 + ib) * 2048 + h * 512 + e;
#pragma unroll
          for (int i = 0; i < 32; ++i) { y[i] += bf2f(cp[(size_t)i * 2048]); const float ss = wave_sum(y[i] * y[i]); if (C.lane == 0) red[C.wave * 64 + i] = ss; }
          __syncthreads();
          if (tid < 32) { float s = 0.f;
#pragma unroll
              for (int w = 0; w < 8; ++w) s += red[w * 64 + tid];
              rs[tid] = 1.0f / sqrtf(s * (1.0f / 512.0f) + EPS); }
          __syncthreads();
          bf16* gp = G + (tok0 + ib) * 2048 + h * 512 + e;
#pragma unroll
          for (int i = 0; i < 32; ++i) { const float g = bf2f(gp[(size_t)i * 2048]); gp[(size_t)i * 2048] = (bf16)f2bf(y[i] * rs[i] * g); }
          __syncthreads();
        }
        __syncthreads();
    }
}
DI void peer_scores(const Ctx& C, const bf16* QP, const bf16* KEYS  , float* SCO) {
    const int gw = C.vcu * NWAVES + C.wave, NGW = C.G * NWAVES; const int fr = C.lane & 15, fq = C.lane >> 4;
    for (int it = gw; it < 1024 * 8; it += NGW) {
        const int tt = it >> 3, h = it & 7; const int tok = tt * 16 + fr;
#pragma unroll
        for (int p = 0; p < 2; ++p) {
            bf16x8 qf[4];
#pragma unroll
            for (int ks = 0; ks < 4; ++ks) qf[ks] = *(const bf16x8*)(QP + (size_t)tok * 2048 + h * 256 + p * 128 + ks * 32 + fq * 8);
            const bf16* kb = KEYS + (size_t)(h * 2 + p) * 128 * 128;
#pragma unroll
            for (int kt = 0; kt < 8; ++kt) {
                f32x4 acc = {0.f, 0.f, 0.f, 0.f};
#pragma unroll
                for (int ks = 0; ks < 4; ++ks) { const bf16x8 kf = *(const bf16x8*)(kb + (size_t)(kt * 16 + fr) * 128 + ks * 32 + fq * 8);
                    acc = __builtin_amdgcn_mfma_f32_16x16x32_bf16(kf, qf[ks], acc, 0, 0, 0); }
                *(f32x4*)(SCO + ((size_t)tok * 8 + h) * 256 + p * 128 + kt * 16 + fq * 4) = acc;
            }
        }
    }
}
template <bool HALVES> DI void select16(const float (&v)[4], int lane, bool (&sel)[4], int (&pos)[4]) {
    float mx = fmaxf(fmaxf(v[0], v[1]), fmaxf(v[2], v[3])), mn = fminf(fminf(v[0], v[1]), fminf(v[2], v[3]));
#pragma unroll
    for (int o = 1; o < (HALVES ? 32 : 64); o <<= 1) { mx = fmaxf(mx, __shfl_xor(mx, o)); mn = fminf(mn, __shfl_xor(mn, o)); }
    const bool up = HALVES && lane >= 32;
    float lo = mn, hi = mx, thr = mn; bool done = false;
    for (int iter = 0; iter < 48; ++iter) {
        const float mid = done ? thr : 0.5f * (lo + hi);
        int cnt = 0;
#pragma unroll
        for (int c = 0; c < 4; ++c) { const unsigned long long m = __ballot(v[c] >= mid);
            cnt += HALVES ? (up ? __popc((unsigned)(m >> 32)) : __popc((unsigned)m)) : __popcll(m); }
        if (!done) { if (cnt == 16) { thr = mid; done = true; } else if (cnt > 16) { lo = mid; thr = mid; } else hi = mid; }
        if (__all(done)) break;
    }
    int base = 0;
#pragma unroll
    for (int c = 0; c < 4; ++c) { sel[c] = v[c] >= thr; const unsigned long long m = __ballot(sel[c]);
        const unsigned long long gm = HALVES ? (up ? (m >> 32) : (m & 0xffffffffull)) : m; const int ll = HALVES ? (lane & 31) : lane;
        pos[c] = base + __popcll(gm & ((1ull << ll) - 1ull)); base += __popcll(gm); sel[c] = sel[c] && pos[c] < 16; }
}
DI void peer_topk(const Ctx& C, const float* SCO, int* IDX, float* GATE) {
    LAS float* sv = (LAS float*)(C.lds + C.wave * 512);
    LAS int* si = (LAS int*)(C.lds + C.wave * 512 + 128);
    LAS float* fv = (LAS float*)(C.lds + C.wave * 512 + 256);
    LAS int* fi = (LAS int*)(C.lds + C.wave * 512 + 320);
    const int gw = C.vcu * NWAVES + C.wave, NGW = C.G * NWAVES, lane = C.lane;
    for (int it = gw; it < TT * 8; it += NGW) {
        const f32x4 s4 = *(const f32x4*)(SCO + (size_t)it * 256 + lane * 4);
        float v[4] = {s4.x, s4.y, s4.z, s4.w}; bool sel[4]; int pos[4];
        select16<true>(v, lane, sel, pos);
        const int p = lane >> 5;
#pragma unroll
        for (int c = 0; c < 4; ++c) if (sel[c]) { sv[p * 16 + pos[c]] = v[c]; si[p * 16 + pos[c]] = (lane & 31) * 4 + c; }
        LDS_WAIT();
        const int a = lane >> 2, bq = (lane & 3) * 4; const float va = sv[a]; const int ia = si[a];
        float w[4]; int wi[4];
#pragma unroll
        for (int c = 0; c < 4; ++c) { w[c] = va + sv[16 + bq + c]; wi[c] = ia * 128 + si[16 + bq + c]; }
        select16<false>(w, lane, sel, pos);
#pragma unroll
        for (int c = 0; c < 4; ++c) if (sel[c]) { fv[pos[c]] = w[c]; fi[pos[c]] = wi[c]; }
        LDS_WAIT();
        const float x = fv[lane & 15]; const int xi = fi[lane & 15];
        float m = x;
#pragma unroll
        for (int o = 1; o < 16; o <<= 1) m = fmaxf(m, __shfl_xor(m, o));
        const float e = __expf(x - m); float s = e;
#pragma unroll
        for (int o = 1; o < 16; o <<= 1) s += __shfl_xor(s, o);
        if (lane < 16) { IDX[(size_t)it * 16 + lane] = xi; GATE[(size_t)it * 16 + lane] = e / s; }
        LDS_WAIT();
    }
}
template <bool FINAL> DI void peer_gather(const Ctx& C, const bf16* H, const int* IDX, const float* GATE, const bf16* PU, const bf16* PV, float* X, const float* g2  ,
                                          const float* ngain, const float* nmod  , bf16* Hn) {
    const int gw = C.vcu * NWAVES + C.wave, NGW = C.G * NWAVES, lane = C.lane;
    for (int t = gw; t < TT; t += NGW) {
        float hv[16];
        { const u32x4 a = *(const u32x4*)(H + (size_t)t * 1024 + lane * 8), bq = *(const u32x4*)(H + (size_t)t * 1024 + 512 + lane * 8);
          hv[0] = bflo(a.x); hv[1] = bfhi(a.x); hv[2] = bflo(a.y); hv[3] = bfhi(a.y); hv[4] = bflo(a.z); hv[5] = bfhi(a.z); hv[6] = bflo(a.w); hv[7] = bfhi(a.w);
          hv[8] = bflo(bq.x); hv[9] = bfhi(bq.x); hv[10] = bflo(bq.y); hv[11] = bfhi(bq.y); hv[12] = bflo(bq.z); hv[13] = bfhi(bq.z); hv[14] = bflo(bq.w); hv[15] = bfhi(bq.w); }
        const int i0 = IDX[(size_t)t * 128 + lane], i1 = IDX[(size_t)t * 128 + 64 + lane];
        const float g0 = GATE[(size_t)t * 128 + lane], g1 = GATE[(size_t)t * 128 + 64 + lane];
        float a0 = 0.f, a1 = 0.f;
        for (int k = 0; k < 128; k += 4) {
            float dsum[4];
#pragma unroll
            for (int kk = 0; kk < 4; ++kk) { const int kq = k + kk; const int e = kq < 64 ? __builtin_amdgcn_readlane(i0, kq) : __builtin_amdgcn_readlane(i1, kq - 64);
                const bf16* ur = PU + (size_t)e * 1024; const u32x4 a = *(const u32x4*)(ur + lane * 8), bq = *(const u32x4*)(ur + 512 + lane * 8);
                float d = bflo(a.x) * hv[0] + bfhi(a.x) * hv[1]; d += bflo(a.y) * hv[2] + bfhi(a.y) * hv[3]; d += bflo(a.z) * hv[4] + bfhi(a.z) * hv[5]; d += bflo(a.w) * hv[6] + bfhi(a.w) * hv[7];
                d += bflo(bq.x) * hv[8] + bfhi(bq.x) * hv[9]; d += bflo(bq.y) * hv[10] + bfhi(bq.y) * hv[11]; d += bflo(bq.z) * hv[12] + bfhi(bq.z) * hv[13]; d += bflo(bq.w) * hv[14] + bfhi(bq.w) * hv[15];
                dsum[kk] = d; }
#pragma unroll
            for (int kk = 0; kk < 4; ++kk) { const int kq = k + kk; const float d = gelu_t(wave_sum(dsum[kk]));
                if (kq < 64) { if (lane == kq) a0 = d * g0; } else { if (lane == kq - 64) a1 = d * g1; } }
        }
        float o[16];
#pragma unroll
        for (int j = 0; j < 16; ++j) o[j] = 0.f;
        for (int k = 0; k < 128; k += 4) {
#pragma unroll
            for (int kk = 0; kk < 4; ++kk) { const int kq = k + kk; const int e = kq < 64 ? __builtin_amdgcn_readlane(i0, kq) : __builtin_amdgcn_readlane(i1, kq - 64);
                const float ak = __int_as_float(kq < 64 ? __builtin_amdgcn_readlane(__float_as_int(a0), kq) : __builtin_amdgcn_readlane(__float_as_int(a1), kq - 64));
                const bf16* vr = PV + (size_t)e * 1024; const u32x4 a = *(const u32x4*)(vr + lane * 8), bq = *(const u32x4*)(vr + 512 + lane * 8);
                o[0] += ak * bflo(a.x); o[1] += ak * bfhi(a.x); o[2] += ak * bflo(a.y); o[3] += ak * bfhi(a.y); o[4] += ak * bflo(a.z); o[5] += ak * bfhi(a.z); o[6] += ak * bflo(a.w); o[7] += ak * bfhi(a.w);
                o[8] += ak * bflo(bq.x); o[9] += ak * bfhi(bq.x); o[10] += ak * bflo(bq.y); o[11] += ak * bfhi(bq.y); o[12] += ak * bflo(bq.z); o[13] += ak * bfhi(bq.z); o[14] += ak * bflo(bq.w); o[15] += ak * bfhi(bq.w); }
        }
#ifdef DBG_ZERO_PEER
#pragma unroll
        for (int j = 0; j < 16; ++j) o[j] = 0.f;
#endif
        const int b = t >> 13; const float* gp = g2 + (size_t)b * 6144; float* xr = X + (size_t)t * 1024;
        float xn[16]; float ss = 0.f;
#pragma unroll
        for (int q = 0; q < 4; ++q) { const int col = (q >> 1) * 512 + lane * 8 + (q & 1) * 4; const f32x4 xv = *(const f32x4*)(xr + col), gv = *(const f32x4*)(gp + col);
#pragma unroll
            for (int j = 0; j < 4; ++j) { const float y = xv[j] + gv[j] * o[q * 4 + j]; xn[q * 4 + j] = y; ss += y * y; } }
        const float rstd = 1.0f / sqrtf(wave_sum(ss) * (1.0f / 1024.0f) + EPS);
        if (FINAL) {
#pragma unroll
            for (int q = 0; q < 4; ++q) { const int col = (q >> 1) * 512 + lane * 8 + (q & 1) * 4; const f32x4 gn = *(const f32x4*)(ngain + col); f32x4 y;
#pragma unroll
                for (int j = 0; j < 4; ++j) y[j] = xn[q * 4 + j] * rstd * gn[j];
                *(f32x4*)(xr + col) = y; }
        } else {
            const float* nm = nmod + (size_t)b * 6144;
#pragma unroll
            for (int q = 0; q < 4; ++q) { const int col = (q >> 1) * 512 + lane * 8 + (q & 1) * 4; const f32x4 gn = *(const f32x4*)(ngain + col), sh = *(const f32x4*)(nm + col), sc = *(const f32x4*)(nm + 1024 + col); f32x4 xo; float y[4];
#pragma unroll
                for (int j = 0; j < 4; ++j) { xo[j] = xn[q * 4 + j]; y[j] = xn[q * 4 + j] * rstd * gn[j] * (1.0f + sc[j]) + sh[j]; }
                *(f32x4*)(xr + col) = xo; uint2 w; w.x = pk2(y[0], y[1]); w.y = pk2(y[2], y[3]); *(uint2*)(Hn + (size_t)t * 1024 + col) = w; }
        }
    }
}
DI void sgu_gate_naive(const Ctx& C, bf16* U, const bf16* VB, const float* stats, const float* w_s, const float* b_s, const float* ln_g, const float* ln_b) {
    LAS float* Wm = (LAS float*)(C.lds);
    LAS float* mu = (LAS float*)(C.lds + 65536);
    LAS float* rsd = mu + 128;
    const int tid = C.tid;
    for (int item = C.vcu; item < 1024; item += C.G) {
        const int n = item >> 3, g = item & 7; const size_t row0 = (size_t)n * 128;
        for (int i = tid; i < 16384; i += 512) { const int r = i >> 7, c = i & 127; const float w = w_s[(size_t)g * 16384 + i]; Wm[i] = (r < 64 && c >= 64) ? 0.f : w; }
        if (tid < 128) { const float* sp = stats + (row0 + tid) * 96; float s1 = 0.f, s2 = 0.f;
            for (int q = 0; q < 48; ++q) { s1 += sp[2 * q]; s2 += sp[2 * q + 1]; }
            const float m = s1 * (1.0f / 3072.0f); const float var = s2 * (1.0f / 3072.0f) - m * m; mu[tid] = m; rsd[tid] = 1.0f / sqrtf(fmaxf(var, 0.f) + EPS); }
        __syncthreads();
        if (tid < 384) {
            const int col = g * 384 + tid; const float lg = ln_g[col], lb = ln_b[col];
#pragma unroll
            for (int pass = 0; pass < 2; ++pass) {
                float acc[64];
#pragma unroll
                for (int i = 0; i < 64; ++i) acc[i] = 0.f;
                const int jmax = pass == 0 ? 64 : 128;
                for (int j = 0; j < jmax; ++j) { const float v = bf2f(VB[(row0 + j) * 3072 + col]); const float vl = (v - mu[j]) * rsd[j] * lg + lb;
#pragma unroll
                    for (int i = 0; i < 64; ++i) acc[i] += Wm[(pass * 64 + i) * 128 + j] * vl; }
#pragma unroll
                for (int i = 0; i < 64; ++i) { const int r = pass * 64 + i; const float s = acc[i] + b_s[g * 128 + r]; bf16* up = U + (row0 + r) * 3072 + col; *up = (bf16)f2bf(bf2f(*up) * s); }
            }
        }
        __syncthreads();
    }
}
typedef short v4i16_t __attribute__((ext_vector_type(4)));
typedef unsigned u32x2_t __attribute__((ext_vector_type(2)));
typedef __bf16 bf16x2_t __attribute__((ext_vector_type(2)));
DI unsigned cvtpk(float lo, float hi) { f32x2_t v = {lo, hi}; bf16x2_t b = __builtin_convertvector(v, bf16x2_t); return __builtin_bit_cast(unsigned, b); }
DI v4i16_t trr(const LAS unsigned char* p) { return __builtin_amdgcn_ds_read_tr16_b64_v4i16((LAS v4i16_t*)p); }
DI bf16x8 cat8(v4i16_t a, v4i16_t b) { return __builtin_shufflevector(a, b, 0, 1, 2, 3, 4, 5, 6, 7); }
DI bf16x8 pack2(const f32x4& a, const f32x4& b) { u32x4 p; p.x = cvtpk(a[0], a[1]); p.y = cvtpk(a[2], a[3]); p.z = cvtpk(b[0], b[1]); p.w = cvtpk(b[2], b[3]); return __builtin_bit_cast(bf16x8, p); }
DI u32x4 scale8(u32x4 v, float s) { u32x4 o; o.x = cvtpk(bflo(v.x) * s, bfhi(v.x) * s); o.y = cvtpk(bflo(v.y) * s, bfhi(v.y) * s); o.z = cvtpk(bflo(v.z) * s, bfhi(v.z) * s); o.w = cvtpk(bflo(v.w) * s, bfhi(v.w) * s); return o; }
#ifndef SCAN_PFD
#define SCAN_PFD 5
#endif
constexpr int SCAN_ESL = 32, SCAN_NCW = SCAN_ESL / 16, SCAN_NSL = 512 / SCAN_ESL, SCAN_NIT = 8 * SCAN_NSL;
#define SCAN_BAR() do { asm volatile("s_waitcnt lgkmcnt(0)" ::: "memory"); __builtin_amdgcn_s_barrier(); asm volatile("" ::: "memory"); } while (0)
template <int MODE = 0> DI void scan_mfma(const Ctx& C, const bf16* Q, const bf16* K, const bf16* V, bf16* CROSS) {
    constexpr int QPI = 544, KPI = 544, VPI = SCAN_ESL * 2 + 32, VCH = SCAN_ESL / 8  , NVC = 64 * VCH;
    constexpr int OQ = 0, OK_ = 64 * QPI, OV = OK_ + 64 * KPI, BUFB = OV + 64 * VPI;
    constexpr int NST = (NWAVES - 1 - SCAN_NCW) * 64;
    const int w = C.wave;
    for (int item = C.vcu; item < SCAN_NIT; item += C.G) {
        const int b = item / (4 * SCAN_NSL), h = (item / SCAN_NSL) & 3, es = item % SCAN_NSL;
        const float lg2 = log2f(1.0f - exp2f(-5.0f - (float)h)); const float gc = exp2f(lg2 * 64.0f);
        const size_t tokb = (size_t)b * SEQ;
        if (w >= SCAN_NCW) {
            int tl_ = C.tid; asm volatile("" : "+v"(tl_));
            const int st = (w == NWAVES - 1) ? (tl_ & 63) : tl_ - SCAN_NCW * 64;
            if (w == NWAVES - 1) {
                unsigned dmy = 0u;
#define SCAN_PF1(ptr) asm volatile("global_load_dword %0, %1, off" : "+v"(dmy) : "v"(ptr) : "memory")
#define SCAN_PF(n) do { const size_t t0_ = tokb + (size_t)(n) * 64; \
                if ((es & 3) == 0) { _Pragma("unroll") for (int u = 0; u < 4; ++u) { const int ln = st + 64 * u, r = ln >> 2, q = ln & 3; SCAN_PF1(Q + (t0_ + r) * 1024 + h * 256 + q * 64); SCAN_PF1(K + (t0_ + r) * 1024 + h * 256 + q * 64); } } \
                SCAN_PF1(V + (t0_ + st) * 2048 + h * 512 + es * SCAN_ESL); } while (0)
#ifndef SCAN_NOPF
                SCAN_PF(3); SCAN_PF(4);
#endif
                SCAN_BAR();
#pragma unroll 1
                for (int n = 0; n < 128; ++n) {
#ifndef SCAN_NOPF
                    if (n + SCAN_PFD < 128) SCAN_PF(n + SCAN_PFD);
#endif
                    SCAN_BAR(); }
                asm volatile("s_waitcnt vmcnt(0)" : "+v"(dmy) :: "memory");
#undef SCAN_PF
#undef SCAN_PF1
            } else {
            u32x4 rqA[7], rkA[7], rvA, rqB[7], rkB[7], rvB;
            const unsigned qo_ = (unsigned)((st >> 5) * 2048 + (st & 31) * 16), qo6_ = (st + NST * 6 < 2048) ? qo_ + (unsigned)(6 * (NST / 32) * 2048) : qo_;
            const unsigned vo_ = (st < NVC) ? (unsigned)((st / VCH) * 4096 + (st % VCH) * 16) : 0u;
#define SCAN_LD(RQ, RK, RV, n) do { const size_t t0_ = tokb + (size_t)((n) < 127 ? (n) : 127) * 64; \
            const unsigned char* qb_ = (const unsigned char*)(Q + t0_ * 1024 + h * 256); const unsigned char* kb_ = (const unsigned char*)(K + t0_ * 1024 + h * 256); \
            const unsigned char* vb_ = (const unsigned char*)(V + t0_ * 2048 + h * 512 + es * SCAN_ESL); \
            _Pragma("unroll") for (int u = 0; u < 7; ++u) { const unsigned o_ = u == 6 ? qo6_ : qo_ + (unsigned)(u * (NST / 32) * 2048); \
                RQ[u] = *(const u32x4*)(qb_ + o_); RK[u] = *(const u32x4*)(kb_ + o_); } \
            RV = *(const u32x4*)(vb_ + vo_); } while (0)
#define SCAN_WR(RQ, RK, RV, bufo) do { LAS unsigned char* B_ = C.lds + (bufo); \
            _Pragma("unroll") for (int u = 0; u < 7; ++u) { const int c = st + NST * u; if (c < 2048) { const int r = c >> 5, cc = c & 31; \
                *(LAS u32x4*)(B_ + OQ + r * QPI + cc * 16) = RQ[u]; *(LAS u32x4*)(B_ + OK_ + r * KPI + cc * 16) = RK[u]; } } \
            if (st < NVC) { const int r = st / VCH, cc = st % VCH; *(LAS u32x4*)(B_ + OV + r * VPI + cc * 16) = scale8(RV, exp2f(lg2 * (float)(63 - r))); } } while (0)
            SCAN_LD(rqA, rkA, rvA, 0); SCAN_WR(rqA, rkA, rvA, 0); SCAN_LD(rqA, rkA, rvA, 1); SCAN_LD(rqB, rkB, rvB, 2);
            SCAN_BAR();
#pragma unroll 1
            for (int n = 0; n < 128; n += 2) {
                if (MODE != 2) { SCAN_WR(rqA, rkA, rvA, BUFB); SCAN_LD(rqA, rkA, rvA, n + 3); }
                SCAN_BAR();
                if (MODE != 2) { SCAN_WR(rqB, rkB, rvB, 0); SCAN_LD(rqB, rkB, rvB, n + 4); }
                SCAN_BAR();
            }
#undef SCAN_LD
#undef SCAN_WR
            }
        } else {
            int tl_ = C.tid; asm volatile("" : "+v"(tl_)); const int lane = tl_ & 63, fr = lane & 15, fq = lane >> 4;
            f32x4 S[16];
#pragma unroll
            for (int t = 0; t < 16; ++t) S[t] = (f32x4){0.f, 0.f, 0.f, 0.f};
            SCAN_BAR();
#define SC_LQ(QF, DB) do { _Pragma("unroll") for (int m = 0; m < 4; ++m) QF[m] = *(const LAS bf16x8*)(Qs + (16 * m + fr) * QPI + (32 * (DB) + 8 * fq) * 2); __builtin_amdgcn_sched_barrier(0); } while (0)
#define SC_MQ(QF, DB) do { const bf16x8 sa0 = pack2(S[2 * (DB)], S[2 * (DB) + 1]); \
            _Pragma("unroll") for (int m = 0; m < 4; ++m) acc[m] = __builtin_amdgcn_mfma_f32_16x16x32_bf16(sa0, QF[m], acc[m], 0, 0, 0); __builtin_amdgcn_sched_barrier(0); } while (0)
#define SC_LK(KF, KS, TQ) do { const LAS unsigned char* kp = Ks + (32 * (KS) + 4 * fq + (fr >> 2)) * KPI + (8 * (fr & 3)) * 2;     \
            _Pragma("unroll") for (int t4 = 0; t4 < 4; ++t4) { const int t = 4 * (TQ) + t4; KF[t4] = cat8(trr(kp + 64 * (t >> 1) + 8 * (t & 1)), trr(kp + 64 * (t >> 1) + 8 * (t & 1) + 16 * KPI)); } __builtin_amdgcn_sched_barrier(0); } while (0)
#define SC_LV(VF, KS) do { const LAS unsigned char* vp = Vs + (32 * (KS) + 4 * fq + (fr >> 2)) * VPI + (16 * w + 4 * (fr & 3)) * 2; VF = cat8(trr(vp), trr(vp + 16 * VPI)); } while (0)
#define SC_MK(KF, VF, TQ) do { _Pragma("unroll") for (int t4 = 0; t4 < 4; ++t4) S[4 * (TQ) + t4] = __builtin_amdgcn_mfma_f32_16x16x32_bf16(KF[t4], VF, S[4 * (TQ) + t4], 0, 0, 0); __builtin_amdgcn_sched_barrier(0); } while (0)
#define SCAN_CHUNK(n_, BO) do { const size_t tok0 = tokb + (size_t)(n_) * 64; LAS unsigned char* Qs = C.lds + (BO) + OQ; LAS unsigned char* Ks = C.lds + (BO) + OK_; LAS unsigned char* Vs = C.lds + (BO) + OV; \
                f32x4 acc[4]; bf16x8 fA[4], fB[4], kA[4], kB[4], vf0, vf1; \
                _Pragma("unroll") for (int m = 0; m < 4; ++m) acc[m] = (f32x4){0.f, 0.f, 0.f, 0.f}; \
                SC_LQ(fA, 0); SC_LQ(fB, 1); SC_MQ(fA, 0); SC_LQ(fA, 2); SC_MQ(fB, 1); SC_LQ(fB, 3); SC_MQ(fA, 2); SC_LQ(fA, 4); SC_MQ(fB, 3); SC_LQ(fB, 5); SC_MQ(fA, 4); SC_LQ(fA, 6); SC_MQ(fB, 5); SC_LQ(fB, 7); SC_MQ(fA, 6); SC_LV(vf0, 0); SC_LV(vf1, 1); SC_LK(kA, 0, 0); SC_MQ(fB, 7); \
                _Pragma("unroll") for (int m = 0; m < 4; ++m) { const f32x4 v = acc[m] * exp2f(lg2 * (float)(16 * m + fr + 1)); uint2 o; o.x = cvtpk(v[0], v[1]); o.y = cvtpk(v[2], v[3]); \
                    *(uint2*)(CROSS + (tok0 + 16 * m + fr) * 2048 + h * 512 + es * SCAN_ESL + 16 * w + 4 * fq) = o; } \
                _Pragma("unroll") for (int t = 0; t < 16; ++t) S[t] = S[t] * gc; \
                __builtin_amdgcn_sched_barrier(0); \
                SC_LK(kB, 0, 1); SC_MK(kA, vf0, 0); SC_LK(kA, 0, 2); SC_MK(kB, vf0, 1); SC_LK(kB, 0, 3); SC_MK(kA, vf0, 2); SC_LK(kA, 1, 0); SC_MK(kB, vf0, 3); SC_LK(kB, 1, 1); SC_MK(kA, vf1, 0); SC_LK(kA, 1, 2); SC_MK(kB, vf1, 1); SC_LK(kB, 1, 3); SC_MK(kA, vf1, 2); SC_MK(kB, vf1, 3); \
                SCAN_BAR(); } while (0)
#pragma unroll 1
            for (int n = 0; n < 128; n += 2) { if (MODE == 1) { SCAN_BAR(); SCAN_BAR(); } else { SCAN_CHUNK(n, 0); SCAN_CHUNK(n + 1, BUFB); } }
#undef SCAN_CHUNK
#undef SC_LQ
#undef SC_MQ
#undef SC_LK
#undef SC_LV
#undef SC_MK
        }
    }
}
#undef SCAN_BAR
DI void sgu_gate_mfma(const Ctx& C, bf16* U, const bf16* VB, const float* stats, const float* w_s, const float* b_s, const float* ln_g, const float* ln_b) {
    constexpr int WPI = 272, VPI = 288;
    LAS unsigned char* Ws = C.lds; LAS unsigned char* Vs = C.lds + 128 * WPI;
    LAS float* mu = (LAS float*)(C.lds + 128 * WPI + 128 * VPI); LAS float* rsd = mu + 128; LAS float* r1 = mu + 256; LAS float* r2 = mu + 384; LAS float* bsl = mu + 512;
    const int tid = C.tid, lane = C.lane, w = C.wave, fr = lane & 15, fq = lane >> 4;
    for (int item = C.vcu; item < 1024; item += C.G) {
        const int n = item >> 3, g = item & 7; const size_t row0 = (size_t)n * 128;
        if (tid < 128) { const float* sp = stats + (row0 + tid) * 96; float s1 = 0.f, s2 = 0.f;
#pragma unroll 8
            for (int q = 0; q < 48; ++q) { s1 += sp[2 * q]; s2 += sp[2 * q + 1]; }
            const float m = s1 * (1.0f / 3072.0f); const float var = s2 * (1.0f / 3072.0f) - m * m; mu[tid] = m; rsd[tid] = 1.0f / sqrtf(fmaxf(var, 0.f) + EPS); bsl[tid] = b_s[g * 128 + tid]; }
        __syncthreads();
        { const int i = tid >> 2, jq = tid & 3; const float* wp = w_s + (size_t)g * 16384 + i * 128 + jq * 32; float a1 = 0.f, a2 = 0.f;
#pragma unroll
          for (int c8 = 0; c8 < 4; ++c8) { const f32x4 wa = *(const f32x4*)(wp + c8 * 8), wb = *(const f32x4*)(wp + c8 * 8 + 4); float wv[8] = {wa[0], wa[1], wa[2], wa[3], wb[0], wb[1], wb[2], wb[3]}; float o[8];
#pragma unroll
              for (int q = 0; q < 8; ++q) { const int j = jq * 32 + c8 * 8 + q; const float wm = (i < 64 && j >= 64) ? 0.f : wv[q]; const float wr_ = wm * rsd[j]; o[q] = wr_; a1 += wr_ * mu[j]; a2 += wm; }
              u32x4 pk; pk.x = cvtpk(o[0], o[1]); pk.y = cvtpk(o[2], o[3]); pk.z = cvtpk(o[4], o[5]); pk.w = cvtpk(o[6], o[7]);
              *(LAS u32x4*)(Ws + i * WPI + (jq * 32 + c8 * 8) * 2) = pk; }
          a1 += __shfl_xor(a1, 1); a1 += __shfl_xor(a1, 2); a2 += __shfl_xor(a2, 1); a2 += __shfl_xor(a2, 2);
          if (jq == 0) { r1[i] = a1; r2[i] = a2; } }
#pragma unroll 1
        for (int cs = 0; cs < 3; ++cs) {
            const int colb = g * 384 + cs * 128;
#pragma unroll
            for (int u = 0; u < 4; ++u) { const int c = tid + 512 * u, r = c >> 4, cc = c & 15;
                *(LAS u32x4*)(Vs + r * VPI + cc * 16) = *(const u32x4*)(VB + (row0 + r) * 3072 + colb + cc * 8); }
            __syncthreads();
            f32x4 acc[8];
#pragma unroll
            for (int it = 0; it < 8; ++it) acc[it] = (f32x4){0.f, 0.f, 0.f, 0.f};
#pragma unroll
            for (int ks = 0; ks < 4; ++ks) {
                const LAS unsigned char* vp = Vs + (32 * ks + 4 * fq + (fr >> 2)) * VPI + (16 * w + 4 * (fr & 3)) * 2;
                const bf16x8 vf = cat8(trr(vp), trr(vp + 16 * VPI));
#pragma unroll
                for (int it = 0; it < 8; ++it) { if (it < 4 && ks >= 2) continue;
                    const LAS unsigned char* wp = Ws + (16 * it + fr) * WPI + (32 * ks + 4 * fq) * 2;
                    const u32x2_t lo = *(const LAS u32x2_t*)wp, hi = *(const LAS u32x2_t*)(wp + 32);
                    u32x4 ww; ww.x = lo.x; ww.y = lo.y; ww.z = hi.x; ww.w = hi.y;
                    acc[it] = __builtin_amdgcn_mfma_f32_16x16x32_bf16(vf, __builtin_bit_cast(bf16x8, ww), acc[it], 0, 0, 0); }
            }
            const int c0 = colb + 16 * w + 4 * fq;
            const f32x4 lg = *(const f32x4*)(ln_g + c0), lb = *(const f32x4*)(ln_b + c0);
#pragma unroll
            for (int it = 0; it < 8; ++it) { const int i = 16 * it + fr; const float q1 = r1[i], q2 = r2[i], bb = bsl[i];
                bf16* up = U + (row0 + i) * 3072 + c0; const u32x2_t uu = *(const u32x2_t*)up;
                const f32x4 s = lg * (acc[it] - q1) + lb * q2 + bb;
                u32x2_t o; o.x = cvtpk(bflo(uu.x) * s[0], bfhi(uu.x) * s[1]); o.y = cvtpk(bflo(uu.y) * s[2], bfhi(uu.y) * s[3]);
                *(u32x2_t*)up = o; }
            __syncthreads();
        }
    }
}
DI void up8(unsigned wd, float& a, float& b, float& c, float& d) { const f32x2_t lo = __builtin_amdgcn_cvt_pk_f32_fp8((int)wd, false), hi = __builtin_amdgcn_cvt_pk_f32_fp8((int)wd, true); a = lo.x; b = lo.y; c = hi.x; d = hi.y; }
DI float dot16(const u32x4 u, const float (&hv)[16]) {
    float f[16];
    up8(u.x, f[0], f[1], f[2], f[3]); up8(u.y, f[4], f[5], f[6], f[7]); up8(u.z, f[8], f[9], f[10], f[11]); up8(u.w, f[12], f[13], f[14], f[15]);
    float d0 = f[0] * hv[0], d1 = f[1] * hv[1];
#pragma unroll
    for (int j = 2; j < 16; j += 2) { d0 += f[j] * hv[j]; d1 += f[j + 1] * hv[j + 1]; }
    return d0 + d1;
}
template <bool FINAL> DI void peer_gather8(const Ctx& C, const bf16* Hin, const int* IDX, const float* GATE, const unsigned char* PU8, const unsigned char* PV8, const float* ISU, const float* ISV,
                                           float* X, const float* g2, const float* ngain, const float* nmod, bf16* Hn) {
    const int gw = C.vcu * NWAVES + C.wave, NGW = C.G * NWAVES, lane = C.lane;
    LAS float* DL = (LAS float*)(C.lds + C.wave * 1024);
    LAS float* AL = DL + 128;
    for (int t = gw; t < TT; t += NGW) {
        float hv[16];
        { const u32x4 a = *(const u32x4*)(Hin + (size_t)t * 1024 + lane * 16), bq = *(const u32x4*)(Hin + (size_t)t * 1024 + lane * 16 + 8);
          hv[0] = bflo(a.x); hv[1] = bfhi(a.x); hv[2] = bflo(a.y); hv[3] = bfhi(a.y); hv[4] = bflo(a.z); hv[5] = bfhi(a.z); hv[6] = bflo(a.w); hv[7] = bfhi(a.w);
          hv[8] = bflo(bq.x); hv[9] = bfhi(bq.x); hv[10] = bflo(bq.y); hv[11] = bfhi(bq.y); hv[12] = bflo(bq.z); hv[13] = bfhi(bq.z); hv[14] = bflo(bq.w); hv[15] = bfhi(bq.w); }
        const int i0 = IDX[(size_t)t * 128 + lane], i1 = IDX[(size_t)t * 128 + 64 + lane];
        const float g0 = GATE[(size_t)t * 128 + lane], g1 = GATE[(size_t)t * 128 + 64 + lane];
        const float su0 = ISU[i0], su1 = ISU[i1], sv0 = ISV[i0], sv1 = ISV[i1];
        u32x4 ub[8];
#define PG_LOADU(k0) do { _Pragma("unroll") for (int j = 0; j < 8; ++j) { const int kq = (k0) + j; const int e = kq < 64 ? __builtin_amdgcn_readlane(i0, kq) : __builtin_amdgcn_readlane(i1, kq - 64); \
            ub[j] = *(const u32x4*)(PU8 + (size_t)e * 1024 + lane * 16); } } while (0)
        PG_LOADU(0);
#pragma unroll 1
        for (int k0 = 0; k0 < 128; k0 += 8) {
            float p[8];
#pragma unroll
            for (int j = 0; j < 8; ++j) p[j] = dot16(ub[j], hv);
            if (k0 + 8 < 128) PG_LOADU(k0 + 8);
            const bool h32 = lane & 32, h16 = lane & 16, h8 = lane & 8;
            float q4[4];
#pragma unroll
            for (int j = 0; j < 4; ++j) { const float keep = h32 ? p[j + 4] : p[j], send = h32 ? p[j] : p[j + 4]; q4[j] = keep + __shfl_xor(send, 32); }
            float q2[2];
#pragma unroll
            for (int j = 0; j < 2; ++j) { const float keep = h16 ? q4[j + 2] : q4[j], send = h16 ? q4[j] : q4[j + 2]; q2[j] = keep + __shfl_xor(send, 16); }
            float q1; { const float keep = h8 ? q2[1] : q2[0], send = h8 ? q2[0] : q2[1]; q1 = keep + __shfl_xor(send, 8); }
            q1 += __shfl_xor(q1, 4); q1 += __shfl_xor(q1, 2); q1 += __shfl_xor(q1, 1);
            if ((lane & 7) == 0) DL[k0 + ((lane >> 5) & 1) * 4 + ((lane >> 4) & 1) * 2 + ((lane >> 3) & 1)] = q1;
        }
#undef PG_LOADU
        LDS_WAIT();
        { const float d0 = DL[lane], d1 = DL[64 + lane]; AL[lane] = gelu_t(d0 * su0) * g0 * sv0; AL[64 + lane] = gelu_t(d1 * su1) * g1 * sv1; }
        LDS_WAIT();
        float o[16];
#pragma unroll
        for (int j = 0; j < 16; ++j) o[j] = 0.f;
        u32x4 vb[8];
#define PG_LOADV(k0) do { _Pragma("unroll") for (int j = 0; j < 8; ++j) { const int kq = (k0) + j; const int e = kq < 64 ? __builtin_amdgcn_readlane(i0, kq) : __builtin_amdgcn_readlane(i1, kq - 64); \
            vb[j] = *(const u32x4*)(PV8 + (size_t)e * 1024 + lane * 16); } } while (0)
        PG_LOADV(0);
#pragma unroll 1
        for (int k0 = 0; k0 < 128; k0 += 8) {
            float f[8][16];
#pragma unroll
            for (int j = 0; j < 8; ++j) { up8(vb[j].x, f[j][0], f[j][1], f[j][2], f[j][3]); up8(vb[j].y, f[j][4], f[j][5], f[j][6], f[j][7]); up8(vb[j].z, f[j][8], f[j][9], f[j][10], f[j][11]); up8(vb[j].w, f[j][12], f[j][13], f[j][14], f[j][15]); }
            if (k0 + 8 < 128) PG_LOADV(k0 + 8);
#pragma unroll
            for (int j = 0; j < 8; ++j) { const float ak = AL[k0 + j];
#pragma unroll
                for (int q = 0; q < 16; ++q) o[q] += ak * f[j][q]; }
        }
#undef PG_LOADV
        const int b = t >> 13; const float* gp = g2 + (size_t)b * 6144; float* xr = X + (size_t)t * 1024;
        float xn[16]; float ss = 0.f;
#pragma unroll
        for (int q = 0; q < 4; ++q) { const int col = lane * 16 + q * 4; const f32x4 xv = *(const f32x4*)(xr + col), gv = *(const f32x4*)(gp + col);
#pragma unroll
            for (int j = 0; j < 4; ++j) { const float y = xv[j] + gv[j] * o[q * 4 + j]; xn[q * 4 + j] = y; ss += y * y; } }
        const float rstd = 1.0f / sqrtf(wave_sum(ss) * (1.0f / 1024.0f) + EPS);
        if (FINAL) {
#pragma unroll
            for (int q = 0; q < 4; ++q) { const int col = lane * 16 + q * 4; const f32x4 gn = *(const f32x4*)(ngain + col); f32x4 y;
#pragma unroll
                for (int j = 0; j < 4; ++j) y[j] = xn[q * 4 + j] * rstd * gn[j];
                *(f32x4*)(xr + col) = y; }
        } else {
            const float* nm = nmod + (size_t)b * 6144;
#pragma unroll
            for (int q = 0; q < 4; ++q) { const int col = lane * 16 + q * 4; const f32x4 gn = *(const f32x4*)(ngain + col), sh = *(const f32x4*)(nm + col), sc = *(const f32x4*)(nm + 1024 + col); f32x4 xo; float y[4];
#pragma unroll
                for (int j = 0; j < 4; ++j) { xo[j] = xn[q * 4 + j]; y[j] = xn[q * 4 + j] * rstd * gn[j] * (1.0f + sc[j]) + sh[j]; }
                *(f32x4*)(xr + col) = xo; u32x2_t wv; wv.x = cvtpk(y[0], y[1]); wv.y = cvtpk(y[2], y[3]); *(u32x2_t*)(Hn + (size_t)t * 1024 + col) = wv; }
        }
    }
}
template <int CTRL> DI float dpp_f(float x) { return __int_as_float(__builtin_amdgcn_update_dpp(0, __float_as_int(x), CTRL, 0xF, 0xF, false)); }
DI float x32(float x) { auto r = __builtin_amdgcn_permlane32_swap(__float_as_uint(x), __float_as_uint(x), false, false); return (threadIdx.x & 32) ? __uint_as_float(r[0]) : __uint_as_float(r[1]); }
DI float x16(float x) { auto r = __builtin_amdgcn_permlane16_swap(__float_as_uint(x), __float_as_uint(x), false, false); return (threadIdx.x & 16) ? __uint_as_float(r[0]) : __uint_as_float(r[1]); }
typedef _Float16 h2_t __attribute__((ext_vector_type(2)));
DI unsigned f2hu(float lo, float hi) { const f32x2_t v = {lo, hi}; const h2_t h = __builtin_convertvector(v, h2_t); return __builtin_bit_cast(unsigned, h); }
DI unsigned bf2hu(unsigned w) { const f32x2_t v = {bflo(w), bfhi(w)}; const h2_t h = __builtin_convertvector(v, h2_t); return __builtin_bit_cast(unsigned, h); }
DI h2_t bf2h(unsigned w) { return (h2_t){(_Float16)bflo(w), (_Float16)bfhi(w)}; }
template <bool FAKE> DI void up8h(const u32x4 u, h2_t (&f)[8]) {
    if (FAKE) { f[0] = __builtin_bit_cast(h2_t, u.x & 0x3bff3bffu); f[1] = __builtin_bit_cast(h2_t, u.y & 0x3bff3bffu); f[2] = __builtin_bit_cast(h2_t, u.z & 0x3bff3bffu); f[3] = __builtin_bit_cast(h2_t, u.w & 0x3bff3bffu);
        f[4] = __builtin_bit_cast(h2_t, (u.x >> 1) & 0x3bff3bffu); f[5] = __builtin_bit_cast(h2_t, (u.y >> 1) & 0x3bff3bffu); f[6] = __builtin_bit_cast(h2_t, (u.z >> 1) & 0x3bff3bffu); f[7] = __builtin_bit_cast(h2_t, (u.w >> 1) & 0x3bff3bffu); return; }
    f[0] = __builtin_amdgcn_cvt_scalef32_pk_f16_fp8((int)u.x, 1.0f, false); f[1] = __builtin_amdgcn_cvt_scalef32_pk_f16_fp8((int)u.x, 1.0f, true);
    f[2] = __builtin_amdgcn_cvt_scalef32_pk_f16_fp8((int)u.y, 1.0f, false); f[3] = __builtin_amdgcn_cvt_scalef32_pk_f16_fp8((int)u.y, 1.0f, true);
    f[4] = __builtin_amdgcn_cvt_scalef32_pk_f16_fp8((int)u.z, 1.0f, false); f[5] = __builtin_amdgcn_cvt_scalef32_pk_f16_fp8((int)u.z, 1.0f, true);
    f[6] = __builtin_amdgcn_cvt_scalef32_pk_f16_fp8((int)u.w, 1.0f, false); f[7] = __builtin_amdgcn_cvt_scalef32_pk_f16_fp8((int)u.w, 1.0f, true); }
template <bool FAKE> DI float dot16h(const u32x4 u, const h2_t (&hh)[8]) { h2_t f[8]; up8h<FAKE>(u, f); float d0 = 0.f, d1 = 0.f;
#pragma unroll
    for (int q = 0; q < 8; q += 2) { d0 = __builtin_amdgcn_fdot2(f[q], hh[q], d0, false); d1 = __builtin_amdgcn_fdot2(f[q + 1], hh[q + 1], d1, false); }
    return d0 + d1; }
template <bool FINAL, bool FAKE = false, int SKIP = 0> DI void peer_gather_rounds(const Ctx& C, const bf16* Hin, const int* IDX, const float* GATE, const unsigned char* PU8, const unsigned char* PV8, const float* ISU, const float* ISV,
                                                 float* X, const float* g2, const float* ngain, const float* nmod, bf16* Hn) {
    const int lane = C.lane, w = C.wave;
    LAS u32x2_t* LIST = (LAS u32x2_t*)(C.lds + w * 14592);
    LAS unsigned char* HL = C.lds + w * 14592 + 4096;
    LAS unsigned* ALU = (LAS unsigned*)(C.lds + w * 14592 + 12288);
    LAS int* OFFS = (LAS int*)(C.lds + w * 14592 + 14336);
    LAS float* IHS = (LAS float*)(C.lds + w * 14592 + 14336 + 160);
    const unsigned long long ltmask = (1ull << lane) - 1ull;
    for (int grp = C.vcu; grp < TT / 32; grp += C.G) {
        const int t0 = grp * 32 + w * 4;
        {
            int ee[8]; float gg[8]; unsigned su[8]; float sv[8];
#pragma unroll
            for (int r = 0; r < 8; ++r) { const size_t a = (size_t)(t0 + (r >> 1)) * 128 + 64 * (r & 1) + lane; ee[r] = IDX[a]; gg[r] = GATE[a]; }
#pragma unroll
            for (int r = 0; r < 8; ++r) { su[r] = __float_as_uint(ISU[ee[r]]) >> 23; sv[r] = ISV[ee[r]]; }
            int pos[8]; int base = 0;
#pragma unroll 1
            for (int b = 0; b < 8; ++b) {
#pragma unroll
                for (int r = 0; r < 8; ++r) { if ((r & 1) == 0 && lane == 0) OFFS[b * 4 + (r >> 1)] = base;
                    const bool mine = (ee[r] >> 11) == b; const unsigned long long m = __ballot(mine); if (mine) pos[r] = base + __popcll(m & ltmask); base += __popcll(m); }
            }
            if (lane == 0) OFFS[32] = 512;
#pragma unroll
            for (int r = 0; r < 8; ++r) { u32x2_t en; en.x = (unsigned)ee[r] | ((unsigned)(r >> 1) << 14) | (su[r] << 16); en.y = __float_as_uint(gg[r] * sv[r]); LIST[pos[r]] = en; }
#pragma unroll
            for (int tk = 0; tk < 4; ++tk) { const u32x4 a = *(const u32x4*)(Hin + (size_t)(t0 + tk) * 1024 + lane * 16), bq = *(const u32x4*)(Hin + (size_t)(t0 + tk) * 1024 + lane * 16 + 8);
                const float hv_[16] = {bflo(a.x), bfhi(a.x), bflo(a.y), bfhi(a.y), bflo(a.z), bfhi(a.z), bflo(a.w), bfhi(a.w), bflo(bq.x), bfhi(bq.x), bflo(bq.y), bfhi(bq.y), bflo(bq.z), bfhi(bq.z), bflo(bq.w), bfhi(bq.w)};
                float am = 0.f;
#pragma unroll
                for (int q = 0; q < 16; ++q) am = fmaxf(am, fabsf(hv_[q]));
                am = wave_max(am);
                const int e_ = (int)((__float_as_uint(am) >> 23) & 0xffu) - 127; const bool ok_ = am > 1e-30f;
                const float sc_ = ok_ ? __uint_as_float((unsigned)(127 + 6 - e_) << 23) : 1.0f, isc_ = ok_ ? __uint_as_float((unsigned)(127 - 6 + e_) << 23) : 1.0f;
                u32x4 o8;
#pragma unroll
                for (int q = 0; q < 4; ++q) { unsigned wd = 0u;
#pragma unroll
                    for (int j = 0; j < 4; ++j) { int qi = (int)rintf(hv_[4 * q + j] * sc_); qi = qi > 127 ? 127 : (qi < -127 ? -127 : qi); wd |= ((unsigned)qi & 0xffu) << (8 * j); }
                    o8[q] = wd; }
                *(LAS u32x4*)(HL + tk * 1024 + lane * 16) = o8; if (lane == 0) IHS[tk] = isc_; }
        }
        LDS_WAIT();
        {
            const int jL = ((lane >> 5) & 1) * 4 + ((lane >> 4) & 1) * 2 + ((lane >> 3) & 1);
#define G1_LOAD(UB, TK, G0) do { const unsigned exl_ = LIST[(G0) + (lane & 7)].x; \
            _Pragma("unroll") for (int j = 0; j < 8; ++j) { const unsigned ex = (unsigned)__builtin_amdgcn_readlane((int)exl_, j); TK[j] = (int)((ex >> 14) & 3u); \
                UB[j] = *(const u32x4*)(PU8 + (size_t)(ex & (FAKE ? 0x7fu : 0x3fffu)) * 1024 + lane * 16); } } while (0)
#define G1_RUN(UB, TK, G0) do { int p[8]; \
            _Pragma("unroll") for (int j = 0; j < 8; ++j) { const u32x4 hq = *(const LAS u32x4*)(HL + TK[j] * 1024 + lane * 16); \
                int d_ = __builtin_amdgcn_sdot4((int)UB[j].x, (int)hq.x, 0, false); d_ = __builtin_amdgcn_sdot4((int)UB[j].y, (int)hq.y, d_, false); \
                d_ = __builtin_amdgcn_sdot4((int)UB[j].z, (int)hq.z, d_, false); p[j] = __builtin_amdgcn_sdot4((int)UB[j].w, (int)hq.w, d_, false); } \
            const bool h32 = lane & 32, h16 = lane & 16, h8 = lane & 8; int q4[4]; \
            _Pragma("unroll") for (int j = 0; j < 4; ++j) { const int keep = h32 ? p[j + 4] : p[j], send = h32 ? p[j] : p[j + 4]; q4[j] = keep + __float_as_int(x32(__int_as_float(send))); } \
            int q2[2]; \
            _Pragma("unroll") for (int j = 0; j < 2; ++j) { const int keep = h16 ? q4[j + 2] : q4[j], send = h16 ? q4[j] : q4[j + 2]; q2[j] = keep + __float_as_int(x16(__int_as_float(send))); } \
            int q1; { const int keep = h8 ? q2[1] : q2[0], send = h8 ? q2[0] : q2[1]; q1 = keep + __float_as_int(dpp_f<0x128>(__int_as_float(send))); } \
            q1 += __float_as_int(dpp_f<0x141>(__int_as_float(q1))); q1 += __float_as_int(dpp_f<0xB1>(__int_as_float(q1))); q1 += __float_as_int(dpp_f<0x4E>(__int_as_float(q1))); \
            if ((lane & 7) == 0) { const u32x2_t me = LIST[(G0) + jL]; const float av_ = gelu_t((float)q1 * IHS[(me.x >> 14) & 3u] * __uint_as_float((me.x >> 16) << 23)) * __uint_as_float(me.y); ALU[(G0) + jL] = f2hu(av_, av_); } } while (0)
            u32x4 ubA[8], ubB[8]; int tkA[8], tkB[8];
            G1_LOAD(ubA, tkA, 0);
#pragma unroll 1
            for (int g0 = 0; g0 < ((SKIP & 1) ? 0 : 512); g0 += 16) {
                G1_LOAD(ubB, tkB, g0 + 8);
                G1_RUN(ubA, tkA, g0);
                if (g0 + 16 < 512) G1_LOAD(ubA, tkA, g0 + 16);
                G1_RUN(ubB, tkB, g0 + 8);
            }
#undef G1_LOAD
#undef G1_RUN
        }
        LDS_WAIT();
        h2_t o[4][8], oc[8];
#pragma unroll
        for (int q = 0; q < 8; ++q) { oc[q] = (h2_t){(_Float16)0.f, (_Float16)0.f};
#pragma unroll
            for (int tk = 0; tk < 4; ++tk) o[tk][q] = (h2_t){(_Float16)0.f, (_Float16)0.f}; }
        {
            int curA = 0;
#define G2_FLUSH() do { if (curA == 0) { _Pragma("unroll") for (int q_ = 0; q_ < 8; ++q_) o[0][q_] += oc[q_]; } else if (curA == 1) { _Pragma("unroll") for (int q_ = 0; q_ < 8; ++q_) o[1][q_] += oc[q_]; } \
            else if (curA == 2) { _Pragma("unroll") for (int q_ = 0; q_ < 8; ++q_) o[2][q_] += oc[q_]; } else { _Pragma("unroll") for (int q_ = 0; q_ < 8; ++q_) o[3][q_] += oc[q_]; } \
            _Pragma("unroll") for (int q_ = 0; q_ < 8; ++q_) oc[q_] = (h2_t){(_Float16)0.f, (_Float16)0.f}; } while (0)
#define G2_LOAD(VB, AJ, TK, G0) do { const unsigned exl_ = LIST[(G0) + (lane & 7)].x; const unsigned all_ = ALU[(G0) + (lane & 7)]; \
            _Pragma("unroll") for (int j = 0; j < 8; ++j) { const unsigned ex = (unsigned)__builtin_amdgcn_readlane((int)exl_, j); TK[j] = (int)((ex >> 14) & 3u); AJ[j] = __builtin_bit_cast(h2_t, (unsigned)__builtin_amdgcn_readlane((int)all_, j)); \
                VB[j] = *(const u32x4*)(PV8 + (size_t)(ex & (FAKE ? 0x7fu : 0x3fffu)) * 1024 + lane * 16); } } while (0)
#define G2_ACC(VB, AJ, TK) do { _Pragma("unroll") for (int j = 0; j < 8; ++j) { if (TK[j] != curA) { G2_FLUSH(); curA = TK[j]; } h2_t f_[8]; up8h<FAKE>(VB[j], f_); _Pragma("unroll") for (int q = 0; q < 8; ++q) oc[q] = f_[q] * AJ[j] + oc[q]; } } while (0)
            u32x4 vbA[8], vbB[8]; h2_t ajA[8], ajB[8]; int tA[8], tB[8];
            G2_LOAD(vbA, ajA, tA, 0);
#pragma unroll 1
            for (int g0 = 0; g0 < ((SKIP & 2) ? 0 : 512); g0 += 16) {
                G2_LOAD(vbB, ajB, tB, g0 + 8);
                G2_ACC(vbA, ajA, tA);
                if (g0 + 16 < 512) G2_LOAD(vbA, ajA, tA, g0 + 16);
                G2_ACC(vbB, ajB, tB);
            }
            G2_FLUSH();
#undef G2_FLUSH
#undef G2_LOAD
#undef G2_ACC
        }
#pragma unroll
        for (int tk = 0; tk < 4; ++tk) {
            __builtin_amdgcn_sched_barrier(0);
            const int t = t0 + tk; const int b = t >> 13; const float* gp = g2 + (size_t)b * 6144; float* xr = X + (size_t)t * 1024;
            float xn[16]; float ss = 0.f;
#pragma unroll
            for (int q = 0; q < 4; ++q) { const int col = lane * 16 + q * 4; const f32x4 xv = *(const f32x4*)(xr + col), gv = *(const f32x4*)(gp + col);
#pragma unroll
                for (int j = 0; j < 4; ++j) { const float y = xv[j] + gv[j] * (float)o[tk][q * 2 + (j >> 1)][j & 1]; xn[q * 4 + j] = y; ss += y * y; } }
            const float rstd = 1.0f / sqrtf(wave_sum(ss) * (1.0f / 1024.0f) + EPS);
            if (FINAL) {
#pragma unroll
                for (int q = 0; q < 4; ++q) { const int col = lane * 16 + q * 4; const f32x4 gn = *(const f32x4*)(ngain + col); f32x4 y;
#pragma unroll
                    for (int j = 0; j < 4; ++j) y[j] = xn[q * 4 + j] * rstd * gn[j];
                    *(f32x4*)(xr + col) = y; }
            } else {
                const float* nm = nmod + (size_t)b * 6144;
#pragma unroll
                for (int q = 0; q < 4; ++q) { const int col = lane * 16 + q * 4; const f32x4 gn = *(const f32x4*)(ngain + col), sh = *(const f32x4*)(nm + col), sc = *(const f32x4*)(nm + 1024 + col); f32x4 xo; float y[4];
#pragma unroll
                    for (int j = 0; j < 4; ++j) { xo[j] = xn[q * 4 + j]; y[j] = xn[q * 4 + j] * rstd * gn[j] * (1.0f + sc[j]) + sh[j]; }
                    *(f32x4*)(xr + col) = xo; u32x2_t wv; wv.x = cvtpk(y[0], y[1]); wv.y = cvtpk(y[2], y[3]); *(u32x2_t*)(Hn + (size_t)t * 1024 + col) = wv; }
            }
        }
        LDS_WAIT();
    }
}
constexpr int GR_R = 12;
DI void glds_row(const unsigned char* gsrc_lane, unsigned lds_dst) { unsigned keep;
    asm volatile("s_mov_b32 %0, m0\n\ts_mov_b32 m0, %2\n\ts_nop 0\n\tglobal_load_lds_dwordx4 %1, off\n\ts_mov_b32 m0, %0" : "=&s"(keep) : "v"(gsrc_lane), "s"(lds_dst) : "memory"); }
template <bool FINAL> DI void peer_gather_dma(const Ctx& C, const bf16* Hin, const int* IDX, const float* GATE, const unsigned char* PU8, const unsigned char* PV8, const float* ISU, const float* ISV,
                                              float* X, const float* g2, const float* ngain, const float* nmod, bf16* Hn) {
    const int lane = C.lane, w = C.wave;
    constexpr int WB = 4096 + 2048 + 256 + GR_R * 1024;
    LAS u32x2_t* LIST = (LAS u32x2_t*)(C.lds + w * WB);
    LAS float* AL = (LAS float*)(C.lds + w * WB + 4096);
    LAS int* OFFS = (LAS int*)(C.lds + w * WB + 6144);
    LAS unsigned char* RING = C.lds + w * WB + 6400;
    const unsigned ring0 = (unsigned)__builtin_amdgcn_readfirstlane((int)(unsigned)(size_t)RING);
    const unsigned long long ltmask = (1ull << lane) - 1ull;
#define GR_REFILL(nv_) do { unsigned ex8_[8]; _Pragma("unroll") for (int j_ = 0; j_ < 8; ++j_) ex8_[j_] = (j_ < (nv_) && nf + j_ < 1024) ? LIST[(nf + j_) & 511].x : 0u; \
        _Pragma("unroll") for (int j_ = 0; j_ < 8; ++j_) if (j_ < (nv_) && nf + j_ < 1024) { const int f_ = nf + j_; const unsigned e_ = (unsigned)__builtin_amdgcn_readfirstlane((int)ex8_[j_]) & 0x3fffu; \
            const unsigned char* tb_ = (f_ < 512) ? PU8 : PV8; glds_row(tb_ + (size_t)e_ * 1024 + lane * 16, ring0 + (unsigned)(f_ % GR_R) * 1024u); } \
        nf += (nv_); if (nf > 1024) nf = 1024; } while (0)
#define GR_ISSUE(f) do { const int f_ = (f); const unsigned ex_ = (unsigned)__builtin_amdgcn_readfirstlane((int)LIST[f_ & 511].x); \
        const unsigned char* tb_ = (f_ < 512) ? PU8 : PV8; glds_row(tb_ + (size_t)(ex_ & 0x3fffu) * 1024 + lane * 16, ring0 + (unsigned)(f_ % GR_R) * 1024u); } while (0)
    for (int grp = C.vcu; grp < TT / 32; grp += C.G) {
        const int t0 = grp * 32 + w * 4;
        float hv4[4][16];
        {
            int ee[8]; float gg[8]; unsigned su[8]; float sv[8];
#pragma unroll
            for (int r = 0; r < 8; ++r) { const size_t a = (size_t)(t0 + (r >> 1)) * 128 + 64 * (r & 1) + lane; ee[r] = IDX[a]; gg[r] = GATE[a]; }
#pragma unroll
            for (int r = 0; r < 8; ++r) { su[r] = __float_as_uint(ISU[ee[r]]) >> 23; sv[r] = ISV[ee[r]]; }
            int pos[8]; int base = 0;
#pragma unroll 1
            for (int b = 0; b < 8; ++b) {
#pragma unroll
                for (int r = 0; r < 8; ++r) { if ((r & 1) == 0 && lane == 0) OFFS[b * 4 + (r >> 1)] = base;
                    const bool mine = (ee[r] >> 11) == b; const unsigned long long m = __ballot(mine); if (mine) pos[r] = base + __popcll(m & ltmask); base += __popcll(m); }
            }
            if (lane == 0) OFFS[32] = 512;
#pragma unroll
            for (int r = 0; r < 8; ++r) { u32x2_t en; en.x = (unsigned)ee[r] | ((unsigned)(r >> 1) << 14) | (su[r] << 16); en.y = __float_as_uint(gg[r] * sv[r]); LIST[pos[r]] = en; }
#pragma unroll
            for (int tk = 0; tk < 4; ++tk) { const u32x4 a = *(const u32x4*)(Hin + (size_t)(t0 + tk) * 1024 + lane * 16), bq = *(const u32x4*)(Hin + (size_t)(t0 + tk) * 1024 + lane * 16 + 8);
                hv4[tk][0] = bflo(a.x); hv4[tk][1] = bfhi(a.x); hv4[tk][2] = bflo(a.y); hv4[tk][3] = bfhi(a.y); hv4[tk][4] = bflo(a.z); hv4[tk][5] = bfhi(a.z); hv4[tk][6] = bflo(a.w); hv4[tk][7] = bfhi(a.w);
                hv4[tk][8] = bflo(bq.x); hv4[tk][9] = bfhi(bq.x); hv4[tk][10] = bflo(bq.y); hv4[tk][11] = bfhi(bq.y); hv4[tk][12] = bflo(bq.z); hv4[tk][13] = bfhi(bq.z); hv4[tk][14] = bflo(bq.w); hv4[tk][15] = bfhi(bq.w); }
        }
        asm volatile("s_waitcnt vmcnt(0) lgkmcnt(0)" ::: "memory");
        int nf = GR_R;
#pragma unroll 1
        for (int f = 0; f < GR_R; ++f) GR_ISSUE(f);
        {
            const int jL = ((lane >> 5) & 1) * 4 + ((lane >> 4) & 1) * 2 + ((lane >> 3) & 1);
#pragma unroll 1
            for (int r = 0; r < 8; ++r) {
#pragma unroll
                for (int tk = 0; tk < 4; ++tk) {
                    const int beg = __builtin_amdgcn_readfirstlane(OFFS[r * 4 + tk]), end = __builtin_amdgcn_readfirstlane(OFFS[r * 4 + tk + 1]);
#pragma unroll 1
                    for (int g0 = beg; g0 < end; g0 += 8) {
                        const int nv = (end - g0) < 8 ? (end - g0) : 8;
                        asm volatile("s_waitcnt vmcnt(4)" ::: "memory");
                        float p[8];
#pragma unroll
                        for (int j = 0; j < 8; ++j) { p[j] = 0.f;
                            if (j < nv) { const u32x4 row = *(const LAS u32x4*)(RING + ((g0 + j) % GR_R) * 1024 + lane * 16); p[j] = dot16(row, hv4[tk]); } }
                        asm volatile("s_waitcnt lgkmcnt(0)" ::: "memory");
                        GR_REFILL(nv);
                        const bool h32 = lane & 32, h16 = lane & 16, h8 = lane & 8;
                        float q4[4];
#pragma unroll
                        for (int j = 0; j < 4; ++j) { const float keep = h32 ? p[j + 4] : p[j], send = h32 ? p[j] : p[j + 4]; q4[j] = keep + __shfl_xor(send, 32); }
                        float q2[2];
#pragma unroll
                        for (int j = 0; j < 2; ++j) { const float keep = h16 ? q4[j + 2] : q4[j], send = h16 ? q4[j] : q4[j + 2]; q2[j] = keep + __shfl_xor(send, 16); }
                        float q1; { const float keep = h8 ? q2[1] : q2[0], send = h8 ? q2[0] : q2[1]; q1 = keep + __shfl_xor(send, 8); }
                        q1 += __shfl_xor(q1, 4); q1 += __shfl_xor(q1, 2); q1 += __shfl_xor(q1, 1);
                        if ((lane & 7) == 0 && jL < nv) { const u32x2_t me = LIST[g0 + jL]; AL[g0 + jL] = gelu_t(q1 * __uint_as_float((me.x >> 16) << 23)) * __uint_as_float(me.y); }
                    }
                }
            }
        }
        float o[4][16];
#pragma unroll
        for (int tk = 0; tk < 4; ++tk)
#pragma unroll
            for (int q = 0; q < 16; ++q) o[tk][q] = 0.f;
#pragma unroll 1
        for (int r = 0; r < 8; ++r) {
#pragma unroll
            for (int tk = 0; tk < 4; ++tk) {
                const int beg = __builtin_amdgcn_readfirstlane(OFFS[r * 4 + tk]), end = __builtin_amdgcn_readfirstlane(OFFS[r * 4 + tk + 1]);
#pragma unroll 1
                for (int i0 = beg; i0 < end; i0 += 8) {
                    const int nv = (end - i0) < 8 ? (end - i0) : 8;
                    if (i0 <= 500) asm volatile("s_waitcnt vmcnt(4)" ::: "memory"); else asm volatile("s_waitcnt vmcnt(0)" ::: "memory");
                    float aq[8]; u32x4 rw[8];
#pragma unroll
                    for (int j = 0; j < 8; ++j) { aq[j] = (j < nv) ? AL[i0 + j] : 0.f; }
#pragma unroll
                    for (int j = 0; j < 8; ++j) if (j < nv) rw[j] = *(const LAS u32x4*)(RING + ((512 + i0 + j) % GR_R) * 1024 + lane * 16);
#pragma unroll
                    for (int j = 0; j < 8; ++j) if (j < nv) { const float aj = __int_as_float(__builtin_amdgcn_readfirstlane(__float_as_int(aq[j])));
                        float f_[16]; up8(rw[j].x, f_[0], f_[1], f_[2], f_[3]); up8(rw[j].y, f_[4], f_[5], f_[6], f_[7]); up8(rw[j].z, f_[8], f_[9], f_[10], f_[11]); up8(rw[j].w, f_[12], f_[13], f_[14], f_[15]);
#pragma unroll
                        for (int q = 0; q < 16; ++q) o[tk][q] += aj * f_[q]; }
                    asm volatile("s_waitcnt lgkmcnt(0)" ::: "memory");
                    GR_REFILL(nv);
                }
            }
        }
        asm volatile("s_waitcnt vmcnt(0)" ::: "memory");
#pragma unroll
        for (int tk = 0; tk < 4; ++tk) {
            const int t = t0 + tk; const int b = t >> 13; const float* gp = g2 + (size_t)b * 6144; float* xr = X + (size_t)t * 1024;
            float xn[16]; float ss = 0.f;
#pragma unroll
            for (int q = 0; q < 4; ++q) { const int col = lane * 16 + q * 4; const f32x4 xv = *(const f32x4*)(xr + col), gv = *(const f32x4*)(gp + col);
#pragma unroll
                for (int j = 0; j < 4; ++j) { const float y = xv[j] + gv[j] * o[tk][q * 4 + j]; xn[q * 4 + j] = y; ss += y * y; } }
            const float rstd = 1.0f / sqrtf(wave_sum(ss) * (1.0f / 1024.0f) + EPS);
            if (FINAL) {
#pragma unroll
                for (int q = 0; q < 4; ++q) { const int col = lane * 16 + q * 4; const f32x4 gn = *(const f32x4*)(ngain + col); f32x4 y;
#pragma unroll
                    for (int j = 0; j < 4; ++j) y[j] = xn[q * 4 + j] * rstd * gn[j];
                    *(f32x4*)(xr + col) = y; }
            } else {
                const float* nm = nmod + (size_t)b * 6144;
#pragma unroll
                for (int q = 0; q < 4; ++q) { const int col = lane * 16 + q * 4; const f32x4 gn = *(const f32x4*)(ngain + col), sh = *(const f32x4*)(nm + col), sc = *(const f32x4*)(nm + 1024 + col); f32x4 xo; float y[4];
#pragma unroll
                    for (int j = 0; j < 4; ++j) { xo[j] = xn[q * 4 + j]; y[j] = xn[q * 4 + j] * rstd * gn[j] * (1.0f + sc[j]) + sh[j]; }
                    *(f32x4*)(xr + col) = xo; u32x2_t wv; wv.x = cvtpk(y[0], y[1]); wv.y = cvtpk(y[2], y[3]); *(u32x2_t*)(Hn + (size_t)t * 1024 + col) = wv; }
            }
        }
        asm volatile("s_waitcnt vmcnt(0) lgkmcnt(0)" ::: "memory");
    }
#undef GR_ISSUE
#undef GR_REFILL
}
DI float red4_sum(float x) { auto a = __builtin_amdgcn_permlane16_swap(__float_as_uint(x), __float_as_uint(x), false, false); x = __uint_as_float(a[0]) + __uint_as_float(a[1]);
    auto b = __builtin_amdgcn_permlane32_swap(__float_as_uint(x), __float_as_uint(x), false, false); return __uint_as_float(b[0]) + __uint_as_float(b[1]); }
DI float red4_max(float x) { auto a = __builtin_amdgcn_permlane16_swap(__float_as_uint(x), __float_as_uint(x), false, false); x = fmaxf(__uint_as_float(a[0]), __uint_as_float(a[1]));
    auto b = __builtin_amdgcn_permlane32_swap(__float_as_uint(x), __float_as_uint(x), false, false); return fmaxf(__uint_as_float(b[0]), __uint_as_float(b[1])); }
DI float red4_min(float x) { auto a = __builtin_amdgcn_permlane16_swap(__float_as_uint(x), __float_as_uint(x), false, false); x = fminf(__uint_as_float(a[0]), __uint_as_float(a[1]));
    auto b = __builtin_amdgcn_permlane32_swap(__float_as_uint(x), __float_as_uint(x), false, false); return fminf(__uint_as_float(b[0]), __uint_as_float(b[1])); }
constexpr int TK_NI = 6;
DI float tk_pivot(float clo, float chi) {
    const float lc = __builtin_amdgcn_logf(clo), lh = __builtin_amdgcn_logf(fmaxf(chi, 0.5f));
    const float f = (lc - 4.0443941f) * __builtin_amdgcn_rcpf(lc - lh);
    return fminf(fmaxf(f, 0.06f), 0.94f);
}
template <int NV> DI float tk_count(const float (&v)[NV], float mid) {
    const float nb = -mid * 1.099511627776e12f;
    float c0 = 0.f, c1 = 0.f, c2 = 0.f, c3 = 0.f;
#pragma unroll
    for (int i = 0; i < NV; i += 4) {
        c0 += __builtin_amdgcn_fmed3f(__builtin_fmaf(v[i], 1.099511627776e12f, nb), 0.f, 1.f); c1 += __builtin_amdgcn_fmed3f(__builtin_fmaf(v[i + 1], 1.099511627776e12f, nb), 0.f, 1.f);
        c2 += __builtin_amdgcn_fmed3f(__builtin_fmaf(v[i + 2], 1.099511627776e12f, nb), 0.f, 1.f); c3 += __builtin_amdgcn_fmed3f(__builtin_fmaf(v[i + 3], 1.099511627776e12f, nb), 0.f, 1.f);
    }
    float c = (c0 + c1) + (c2 + c3);
    return red4_sum(c);
}
template <int NV> DI void tk_search(const float (&v)[NV], float ntot, float& thr_out) {
    float mx = v[0], mn = v[0];
#pragma unroll
    for (int i = 1; i < NV; ++i) { mx = fmaxf(mx, v[i]); mn = fminf(mn, v[i]); }
    mx = red4_max(mx); mn = red4_min(mn);
    float lo = mn, hi = mx, clo = ntot - 1.0f, chi = 0.0f, thr = mn - 1.0f; bool done = false;
#pragma unroll 1
    for (int iter = 0; iter < 48; ++iter) {
        float fr_ = tk_pivot(clo, chi); if (iter >= TK_NI) fr_ = 0.5f;
        const float mid = done ? thr : lo + (hi - lo) * fr_;
        const float cnt = tk_count<NV>(v, mid);
        if (!done) { if (cnt == 16.0f) { thr = mid; done = true; } else if (cnt > 16.0f) { lo = mid; clo = cnt; thr = mid; } else { hi = mid; chi = cnt; } }
        if (__all(done)) break;
    }
    thr_out = thr;
}
DI void tk_search2(const float (&v0)[32], const float (&v1)[32], float& t0, float& t1) {
    float mx0 = v0[0], mn0 = v0[0], mx1 = v1[0], mn1 = v1[0];
#pragma unroll
    for (int i = 1; i < 32; ++i) { mx0 = fmaxf(mx0, v0[i]); mn0 = fminf(mn0, v0[i]); mx1 = fmaxf(mx1, v1[i]); mn1 = fminf(mn1, v1[i]); }
    mx0 = red4_max(mx0); mn0 = red4_min(mn0); mx1 = red4_max(mx1); mn1 = red4_min(mn1);
    float lo0 = mn0, hi0 = mx0, clo0 = 127.0f, chi0 = 0.0f, thr0 = mn0 - 1.0f; bool done0 = false;
    float lo1 = mn1, hi1 = mx1, clo1 = 127.0f, chi1 = 0.0f, thr1 = mn1 - 1.0f; bool done1 = false;
#pragma unroll 1
    for (int iter = 0; iter < 48; ++iter) {
        float f0 = tk_pivot(clo0, chi0), f1 = tk_pivot(clo1, chi1); if (iter >= TK_NI) { f0 = 0.5f; f1 = 0.5f; }
        const float mid0 = done0 ? thr0 : lo0 + (hi0 - lo0) * f0, mid1 = done1 ? thr1 : lo1 + (hi1 - lo1) * f1;
        const float c0 = tk_count<32>(v0, mid0), c1 = tk_count<32>(v1, mid1);
        if (!done0) { if (c0 == 16.0f) { thr0 = mid0; done0 = true; } else if (c0 > 16.0f) { lo0 = mid0; clo0 = c0; thr0 = mid0; } else { hi0 = mid0; chi0 = c0; } }
        if (!done1) { if (c1 == 16.0f) { thr1 = mid1; done1 = true; } else if (c1 > 16.0f) { lo1 = mid1; clo1 = c1; thr1 = mid1; } else { hi1 = mid1; chi1 = c1; } }
        if (__all(done0 && done1)) break;
    }
    t0 = thr0; t1 = thr1;
}
template <int MODE = 0> DI void peer_topk_fused(const Ctx& C, const bf16* QP, const bf16* KEYS, int* IDX, float* GATE) {
    constexpr int KPI = 288;
    const int lane = C.lane, fr = lane & 15, fq = lane >> 4, w = C.wave;
    LAS unsigned char* KS = C.lds;
    LAS unsigned char* WB = C.lds + 73728 + w * 7168;
    LAS float* LV = (LAS float*)(WB);
    LAS int* LK = (LAS int*)(WB + 2176);
    LAS float* FV = (LAS float*)(WB + 4352);
    LAS int* FI = (LAS int*)(WB + 5504);
    LAS float* TRASH = (LAS float*)(WB + 6656) + lane;
    const int h = C.vcu & 7, nb = C.G >> 3;
    { const bf16* kg = KEYS + (size_t)h * 2 * 128 * 128;
      for (int c = C.tid; c < 4096; c += 512) { const int r = c >> 4, cc = c & 15; *(LAS u32x4*)(KS + r * KPI + cc * 16) = *(const u32x4*)(kg + (size_t)r * 128 + cc * 8); } }
    __syncthreads();
    for (int tt = (C.vcu >> 3) + nb * w; tt < 1024; tt += nb * 8) {
        const int tok = tt * 16 + fr;
        float sc0[32], sc1[32];
#pragma unroll
        for (int p = 0; p < 2; ++p) {
            bf16x8 qf[4];
#pragma unroll
            for (int ks = 0; ks < 4; ++ks) qf[ks] = *(const bf16x8*)(QP + (size_t)tok * 2048 + h * 256 + p * 128 + ks * 32 + fq * 8);
#pragma unroll
            for (int kt = 0; kt < 8; ++kt) {
                f32x4 acc = {0.f, 0.f, 0.f, 0.f};
#pragma unroll
                for (int ks = 0; ks < 4; ++ks) { const bf16x8 kf = *(const LAS bf16x8*)(KS + (p * 128 + kt * 16 + fr) * KPI + (ks * 32 + fq * 8) * 2);
                    acc = __builtin_amdgcn_mfma_f32_16x16x32_bf16(kf, qf[ks], acc, 0, 0, 0); }
                if (p == 0) { sc0[kt * 4 + 0] = acc[0]; sc0[kt * 4 + 1] = acc[1]; sc0[kt * 4 + 2] = acc[2]; sc0[kt * 4 + 3] = acc[3]; }
                else { sc1[kt * 4 + 0] = acc[0]; sc1[kt * 4 + 1] = acc[1]; sc1[kt * 4 + 2] = acc[2]; sc1[kt * 4 + 3] = acc[3]; }
            }
        }
        float thrA = 1.0f, thrB = 1.0f; if (MODE == 0) tk_search2(sc0, sc1, thrA, thrB);
#pragma unroll
        for (int p = 0; p < 2; ++p) {
            const float thr = p == 0 ? thrA : thrB;
            int cnt = 0;
#pragma unroll
            for (int i = 0; i < 32; ++i) cnt += ((p == 0 ? sc0[i] : sc1[i]) > thr) ? 1 : 0;
            const int c0 = __shfl(cnt, fr), c1 = __shfl(cnt, fr + 16), c2 = __shfl(cnt, fr + 32);
            int pos = (fq > 0 ? c0 : 0) + (fq > 1 ? c1 : 0) + (fq > 2 ? c2 : 0);
#pragma unroll
            for (int i = 0; i < 32; ++i) { const float vv = p == 0 ? sc0[i] : sc1[i]; const bool s = vv > thr && pos < 16;
                LAS float* pv = s ? (LV + fr * 33 + p * 16 + pos) : TRASH; LAS int* pk = s ? (LK + fr * 33 + p * 16 + pos) : (LAS int*)TRASH;
                *pv = vv; *pk = (i >> 2) * 16 + 4 * fq + (i & 3); pos += (vv > thr) ? 1 : 0; }
        }
        LDS_WAIT();
        float A[4], Bv[16]; int KA[4], KB[16];
#pragma unroll
        for (int a = 0; a < 4; ++a) { A[a] = LV[fr * 33 + 4 * fq + a]; KA[a] = LK[fr * 33 + 4 * fq + a]; }
#pragma unroll
        for (int bq = 0; bq < 16; ++bq) { Bv[bq] = LV[fr * 33 + 16 + bq]; KB[bq] = LK[fr * 33 + 16 + bq]; }
        float sm[64];
#pragma unroll
        for (int a = 0; a < 4; ++a)
#pragma unroll
            for (int bq = 0; bq < 16; ++bq) sm[a * 16 + bq] = A[a] + Bv[bq];
        float thr2 = 4.0f; if (MODE == 0) tk_search<64>(sm, 256.0f, thr2);
        {
            int cnt = 0;
#pragma unroll
            for (int i = 0; i < 64; ++i) cnt += (sm[i] > thr2) ? 1 : 0;
            const int c0 = __shfl(cnt, fr), c1 = __shfl(cnt, fr + 16), c2 = __shfl(cnt, fr + 32);
            int pos = (fq > 0 ? c0 : 0) + (fq > 1 ? c1 : 0) + (fq > 2 ? c2 : 0);
#pragma unroll
            for (int i = 0; i < 64; ++i) { const bool s = sm[i] > thr2 && pos < 16;
                LAS float* pv = s ? (FV + fr * 17 + pos) : TRASH; LAS int* pk = s ? (FI + fr * 17 + pos) : (LAS int*)TRASH;
                *pv = sm[i]; *pk = KA[i >> 4] * 128 + KB[i & 15]; pos += (sm[i] > thr2) ? 1 : 0; }
        }
        LDS_WAIT();
        float x[4]; int xi[4];
#pragma unroll
        for (int j = 0; j < 4; ++j) { x[j] = FV[fr * 17 + 4 * fq + j]; xi[j] = FI[fr * 17 + 4 * fq + j]; }
        float m = red4_max(fmaxf(fmaxf(x[0], x[1]), fmaxf(x[2], x[3])));
        float e[4]; float s = 0.f;
#pragma unroll
        for (int j = 0; j < 4; ++j) { e[j] = __expf(x[j] - m); s += e[j]; }
        s = red4_sum(s);
        const float inv = 1.0f / s;
        const size_t ob = ((size_t)tok * 8 + h) * 16 + 4 * fq;
        typedef int i32x4 __attribute__((ext_vector_type(4)));
        *(i32x4*)(IDX + ob) = (i32x4){xi[0], xi[1], xi[2], xi[3]}; *(f32x4*)(GATE + ob) = (f32x4){e[0] * inv, e[1] * inv, e[2] * inv, e[3] * inv};
        LDS_WAIT();
    }
}
DI void intra_mfma(const Ctx& C, const bf16* Q, const bf16* K, const bf16* V, const bf16* CROSS, bf16* G) {
    constexpr int RPI = 544, PPI = 144, VPI = 544;
    LAS unsigned char* Qs = C.lds; LAS unsigned char* Ks = Qs + 64 * RPI; LAS unsigned char* Ps = Ks + 64 * RPI; LAS unsigned char* Vs = Ps + 64 * PPI;
    LAS float* red = (LAS float*)(Vs + 64 * VPI);
    const int tid = C.tid, lane = C.lane, w = C.wave, fr = lane & 15, fq = lane >> 4;
    for (int item = C.vcu; item < 1024; item += C.G) {
        const int b = item >> 9, h = (item >> 7) & 3, n = item & 127;
        const float lg2 = log2f(1.0f - exp2f(-5.0f - (float)h));
        const size_t tok0 = (size_t)b * SEQ + (size_t)n * 64;
#pragma unroll
        for (int u = 0; u < 4; ++u) { const int c = tid + 512 * u, r = c >> 5, cc = c & 31;
            *(LAS u32x4*)(Qs + r * RPI + cc * 16) = *(const u32x4*)(Q + (tok0 + r) * 1024 + h * 256 + cc * 8);
            *(LAS u32x4*)(Ks + r * RPI + cc * 16) = *(const u32x4*)(K + (tok0 + r) * 1024 + h * 256 + cc * 8);
            *(LAS u32x4*)(Vs + r * VPI + cc * 16) = *(const u32x4*)(V + (tok0 + r) * 2048 + h * 512 + cc * 8); }
        __syncthreads();
        { const int jt = w >> 1; f32x4 sa[2] = {(f32x4){0.f, 0.f, 0.f, 0.f}, (f32x4){0.f, 0.f, 0.f, 0.f}};
#pragma unroll
          for (int ks = 0; ks < 8; ++ks) { const bf16x8 kf = *(const LAS bf16x8*)(Ks + (16 * jt + fr) * RPI + (32 * ks + 8 * fq) * 2);
#pragma unroll
              for (int q = 0; q < 2; ++q) { const int it = 2 * (w & 1) + q; const bf16x8 qf = *(const LAS bf16x8*)(Qs + (16 * it + fr) * RPI + (32 * ks + 8 * fq) * 2);
                  sa[q] = __builtin_amdgcn_mfma_f32_16x16x32_bf16(kf, qf, sa[q], 0, 0, 0); } }
#pragma unroll
          for (int q = 0; q < 2; ++q) { const int i = 16 * (2 * (w & 1) + q) + fr, j0 = 16 * jt + 4 * fq; float pv[4];
#pragma unroll
              for (int r = 0; r < 4; ++r) { const int dd = i > j0 + r ? i - j0 - r : j0 + r - i; pv[r] = sa[q][r] * exp2f(lg2 * (float)dd); }
              u32x2_t o; o.x = cvtpk(pv[0], pv[1]); o.y = cvtpk(pv[2], pv[3]); *(LAS u32x2_t*)(Ps + i * PPI + j0 * 2) = o; } }
        __syncthreads();
        f32x4 acc[2][2][4];
#pragma unroll
        for (int hf = 0; hf < 2; ++hf) {
#pragma unroll
            for (int et = 0; et < 2; ++et)
#pragma unroll
                for (int it = 0; it < 4; ++it) acc[hf][et][it] = (f32x4){0.f, 0.f, 0.f, 0.f};
            if (hf == 1) { __syncthreads();
#pragma unroll
                for (int u = 0; u < 4; ++u) { const int c = tid + 512 * u, r = c >> 5, cc = c & 31;
                    *(LAS u32x4*)(Vs + r * VPI + cc * 16) = *(const u32x4*)(V + (tok0 + r) * 2048 + h * 512 + 256 + cc * 8); }
                __syncthreads(); }
#pragma unroll
            for (int ks = 0; ks < 2; ++ks) {
                bf16x8 pf[4];
#pragma unroll
                for (int it = 0; it < 4; ++it) { const LAS unsigned char* pp = Ps + (16 * it + fr) * PPI + (32 * ks + 4 * fq) * 2;
                    const u32x2_t lo = *(const LAS u32x2_t*)pp, hi = *(const LAS u32x2_t*)(pp + 32); u32x4 ww; ww.x = lo.x; ww.y = lo.y; ww.z = hi.x; ww.w = hi.y; pf[it] = __builtin_bit_cast(bf16x8, ww); }
#pragma unroll
                for (int et = 0; et < 2; ++et) { const LAS unsigned char* vp = Vs + (32 * ks + 4 * fq + (fr >> 2)) * VPI + (32 * w + 16 * et + 4 * (fr & 3)) * 2;
                    const bf16x8 vf = cat8(trr(vp), trr(vp + 16 * VPI));
#pragma unroll
                    for (int it = 0; it < 4; ++it) acc[hf][et][it] = __builtin_amdgcn_mfma_f32_16x16x32_bf16(vf, pf[it], acc[hf][et][it], 0, 0, 0); }
            }
        }
        float ssq[4] = {0.f, 0.f, 0.f, 0.f};
#pragma unroll
        for (int hf = 0; hf < 2; ++hf)
#pragma unroll
            for (int et = 0; et < 2; ++et)
#pragma unroll
                for (int it = 0; it < 4; ++it) { const u32x2_t cv = *(const u32x2_t*)(CROSS + (tok0 + 16 * it + fr) * 2048 + h * 512 + hf * 256 + 32 * w + 16 * et + 4 * fq);
                    f32x4 y = acc[hf][et][it]; y[0] += bflo(cv.x); y[1] += bfhi(cv.x); y[2] += bflo(cv.y); y[3] += bfhi(cv.y); acc[hf][et][it] = y;
                    ssq[it] += (y[0] * y[0] + y[1] * y[1]) + (y[2] * y[2] + y[3] * y[3]); }
#pragma unroll
        for (int it = 0; it < 4; ++it) { float s = ssq[it]; s += __shfl_xor(s, 16); s += __shfl_xor(s, 32); if (fq == 0) red[w * 64 + 16 * it + fr] = s; }
        __syncthreads();
        float rs[4];
#pragma unroll
        for (int it = 0; it < 4; ++it) { float s = 0.f;
#pragma unroll
            for (int ww = 0; ww < 8; ++ww) s += red[ww * 64 + 16 * it + fr];
            rs[it] = 1.0f / sqrtf(s * (1.0f / 512.0f) + EPS); }
#pragma unroll
        for (int hf = 0; hf < 2; ++hf)
#pragma unroll
            for (int et = 0; et < 2; ++et)
#pragma unroll
                for (int it = 0; it < 4; ++it) { bf16* gp = G + (tok0 + 16 * it + fr) * 2048 + h * 512 + hf * 256 + 32 * w + 16 * et + 4 * fq; const u32x2_t gv = *(const u32x2_t*)gp;
                    const f32x4 y = acc[hf][et][it] * rs[it]; u32x2_t o; o.x = cvtpk(y[0] * bflo(gv.x), y[1] * bfhi(gv.x)); o.y = cvtpk(y[2] * bflo(gv.y), y[3] * bfhi(gv.y)); *(u32x2_t*)gp = o; }
        __syncthreads();
    }
}
#ifndef PHMASK
#define PHMASK 0xFFFFFFu
#endif
#define PH(k) ((PHMASK >> (k)) & 1u)
#ifdef USE_SGU_NAIVE
#define SGU_GATE_FN sgu_gate_naive
#else
#define SGU_GATE_FN sgu_gate_mfma
#endif
#ifdef USE_GATHER_TOKEN
#define GATHER_FN peer_gather8
#else
#ifdef USE_GATHER_ROUNDS
#define GATHER_FN peer_gather_rounds
#else
#define GATHER_FN peer_gather_dma
#endif
#endif
#ifndef DUP_GATHER_SKIP
#define DUP_GATHER_SKIP 0
#endif
#ifndef DUP_GATHER_FAKE
#define DUP_GATHER_FAKE false
#endif
struct Args { const void* in[21]; float* out; unsigned char* ws; };
__global__ void __launch_bounds__(NWAVES * 64, 2) mk_fwd(Args args) {
    extern __shared__ __attribute__((aligned(16))) unsigned char lds[];
    Ctx C; C.lds = (LAS unsigned char*)lds; C.tid = threadIdx.x; C.lane = C.tid & 63; C.wave = __builtin_amdgcn_readfirstlane(C.tid >> 6);
    C.G = gridDim.x; { const int bx = blockIdx.x; C.vcu = (C.G % 8 == 0) ? (bx % 8) * (C.G / 8) + bx / 8 : bx; }
    C.ws = args.ws;
    volatile LAS unsigned* MISC = (volatile LAS unsigned*)(C.lds + MISC_OFF);
    gu32* ctl = (gu32*)(args.ws + WS_CTL);
    for (int u = C.tid; u < (LDS_BYTES - LDSCTL_OFF) / 4; u += NWAVES * 64) ((LAS unsigned*)(C.lds + LDSCTL_OFF))[u] = 0u;
    __syncthreads();
    XcdBarrier bar = xcd_barrier_post((unsigned*)(ctl + CW_BAR), MISC + 8);
#define GRID_BAR() do { xcd_barrier(bar); asm volatile("" : "+v"(C.tid)); C.lane = C.tid & 63; C.wave = __builtin_amdgcn_readfirstlane(C.tid >> 6); } while (0)
    { LAS unsigned long long* PT = (LAS unsigned long long*)(C.lds + PTR_OFF);
      if (C.tid == 0) {
#pragma unroll
          for (int i = 0; i < 21; ++i) PT[i] = (unsigned long long)args.in[i];
      } }
    __syncthreads();
#define INP(T, i) ((const T*)ldp(C, i))
    float* out = args.out; unsigned char* ws = args.ws;
#define MODP ((float*)(ws + WS_MOD))
#define MOD0 ((const float*)(ws + WS_MOD))
#define MOD1 ((const float*)(ws + WS_MOD) + 2 * 6144)
#define cosT ((float*)(ws + WS_COS))
#define sinT ((float*)(ws + WS_SIN))
#define WRI ((bf16*)(ws + WS_WRI))
#define WRO ((bf16*)(ws + WS_WRO))
#define WSI ((bf16*)(ws + WS_WSI))
#define WSO ((bf16*)(ws + WS_WSO))
#define WQ ((bf16*)(ws + WS_WQ))
#define KEYS ((bf16*)(ws + WS_KEYS))
#define STATS ((float*)(ws + WS_STATS))
#define IDX ((int*)(ws + WS_IDX))
#define GATE ((float*)(ws + WS_GATE))
#define H ((bf16*)(ws + WS_H))
#define PU8 ((const unsigned char*)(ws + WS_PU))
#define PV8 ((const unsigned char*)(ws + WS_PV))
#define ISU ((const float*)(ws + WS_ISU))
#define ISV ((const float*)(ws + WS_ISV))
#define Qb ((bf16*)(ws + WS_Q))
#define Kb ((bf16*)(ws + WS_K))
#define Vb ((bf16*)(ws + WS_V))
#define Gb ((bf16*)(ws + WS_G))
#define CROSS ((bf16*)(ws + WS_CROSS))
#define QP ((bf16*)(ws + WS_QP))
#define SCO ((float*)(ws + WS_SC))
#define Ub ((bf16*)(ws + WS_U))
#define VBb ((bf16*)(ws + WS_VB))

    { P0In I; I.c = INP(float, 1); I.ada_w = INP(float, 5); I.ada_b = INP(float, 6); I.ret_w_in = INP(float, 7); I.ret_w_out = INP(float, 8); I.sgu_w_in = INP(float, 9); I.sgu_w_out = INP(float, 15); I.wq = INP(float, 16); I.keys = INP(float, 17); I.pu = INP(float, 18); I.pv = INP(float, 19); I.pos = INP(int, 2);
#ifdef DUP_P0
      p0_prologue(C, I);
      GRID_BAR();
#endif
      if (PH(0)) p0_prologue(C, I); }
    GRID_BAR();
    if (PH(1)) rms_mod_phase(C, INP(float, 0), INP(float, 3), MOD0, 0, 1024, H);
    GRID_BAR();
    { pg8::Gemm g{H, WRI, TT, 6144, 1024}; pg8::StaticOrder S; S.init(TT, 6144, C.G, (int)blockIdx.x);
      pg8::EpiRetProj E{Qb, Kb, Vb, Gb, cosT, sinT};
#ifdef DUP_G1
      pg8::gemm_phase<pg8::EpiRetProj, pg8::StaticOrder, true, true>(C.lds + RING_OFF, g, S, E); GRID_BAR();
#endif
      if (PH(2)) pg8::gemm_phase<pg8::EpiRetProj, pg8::StaticOrder, true, true>(C.lds + RING_OFF, g, S, E); }
    GRID_BAR();
    #ifdef USE_SCAN_NAIVE
    if (PH(3)) scan_naive(C, Qb, Kb, Vb, CROSS);
#else
#ifdef DUP_SCAN
    scan_mfma<DUP_SCAN>(C, Qb, Kb, Vb, CROSS);
    GRID_BAR();
#endif
    if (C.vcu < SCAN_NIT) { if (PH(3)) scan_mfma<0>(C, Qb, Kb, Vb, CROSS); }
    else { P0In I; I.c = nullptr; I.ada_w = nullptr; I.ada_b = nullptr; I.ret_w_in = nullptr; I.ret_w_out = nullptr; I.sgu_w_in = INP(float, 9); I.sgu_w_out = INP(float, 15); I.wq = INP(float, 16); I.keys = nullptr; I.pu = INP(float, 18); I.pv = INP(float, 19); I.pos = nullptr;
      side_work(C, I, SCAN_NIT); }
#endif
    GRID_BAR();
#ifdef USE_INTRA_NAIVE
    if (PH(4)) intra_naive(C, Qb, Kb, Vb, CROSS, Gb);
#else
    if (PH(4)) intra_mfma(C, Qb, Kb, Vb, CROSS, Gb);
#endif
    GRID_BAR();
    { pg8::Gemm g{Gb, WRO, TT, 1024, 2048}; pg8::StaticOrder S; S.init(TT, 1024, C.G, (int)blockIdx.x);
      pg8::EpiResGate E{INP(float, 0), out, MOD0 + 2048, 6144};
      if (PH(5)) pg8::gemm_phase<pg8::EpiResGate, pg8::StaticOrder, true, true>(C.lds + RING_OFF, g, S, E); }
    GRID_BAR();
    if (PH(6)) rms_mod_phase(C, out, INP(float, 4), MOD0, 3072, 4096, H);
    GRID_BAR();
    { pg8::Gemm g{H, WQ, TT, 2048, 1024}; pg8::StaticOrder S; S.init(TT, 2048, C.G, (int)blockIdx.x);
      pg8::EpiBf16<0> E{QP, 2048, nullptr, 0, 0, 1.f};
      if (PH(7)) pg8::gemm_phase<pg8::EpiBf16<0>, pg8::StaticOrder, true, true>(C.lds + RING_OFF, g, S, E); }
    GRID_BAR();
#ifdef USE_TOPK_NAIVE
    if (PH(8)) peer_scores(C, QP, KEYS, SCO);
    GRID_BAR();
    if (PH(9)) peer_topk(C, SCO, IDX, GATE);
#else
#ifdef DUP_TOPK
    peer_topk_fused<DUP_TOPK>(C, QP, KEYS, IDX, GATE);
    GRID_BAR();
#endif
    if (PH(9)) peer_topk_fused<0>(C, QP, KEYS, IDX, GATE);
#endif
    GRID_BAR();
#ifdef DUP_GATHER
    GATHER_FN<false, DUP_GATHER_FAKE, DUP_GATHER_SKIP>(C, H, IDX, GATE, PU8, PV8, ISU, ISV, (float*)(ws + WS_R), MOD0 + 5120, INP(float, 3) + 1024, MOD1, (bf16*)(ws + WS_R + 128 * MiB));
    GRID_BAR();
#endif
    if (PH(10)) GATHER_FN<false>(C, H, IDX, GATE, PU8, PV8, ISU, ISV, out, MOD0 + 5120, INP(float, 3) + 1024, MOD1, H);
    GRID_BAR();
#ifdef DUP_BAR
    for (int q_ = 0; q_ < 10; ++q_) GRID_BAR();
#endif
    { pg8::Gemm g{H, WSI, TT, 6144, 1024}; pg8::StaticOrder S; S.init(TT, 6144, C.G, (int)blockIdx.x);
      pg8::EpiSguIn E{Ub, VBb, INP(float, 10), STATS};
#ifdef DUP_G7
      pg8::gemm_phase<pg8::EpiSguIn, pg8::StaticOrder, true, true>(C.lds + RING_OFF, g, S, E); GRID_BAR();
#endif
      if (PH(11)) pg8::gemm_phase<pg8::EpiSguIn, pg8::StaticOrder, true, true>(C.lds + RING_OFF, g, S, E); }
    GRID_BAR();
    if (PH(12)) SGU_GATE_FN(C, Ub, VBb, STATS, INP(float, 13), INP(float, 14), INP(float, 11), INP(float, 12));
    GRID_BAR();
    { pg8::Gemm g{Ub, WSO, TT, 1024, 3072}; pg8::StaticOrder S; S.init(TT, 1024, C.G, (int)blockIdx.x);
      pg8::EpiResGate E{out, out, MOD1 + 2048, 6144};
      if (PH(13)) pg8::gemm_phase<pg8::EpiResGate, pg8::StaticOrder, true, true>(C.lds + RING_OFF, g, S, E); }
    GRID_BAR();
    if (PH(14)) rms_mod_phase(C, out, INP(float, 4) + 1024, MOD1, 3072, 4096, H);
    GRID_BAR();
    { pg8::Gemm g{H, WQ + (size_t)2048 * 1024, TT, 2048, 1024}; pg8::StaticOrder S; S.init(TT, 2048, C.G, (int)blockIdx.x);
      pg8::EpiBf16<0> E{QP, 2048, nullptr, 0, 0, 1.f};
      if (PH(15)) pg8::gemm_phase<pg8::EpiBf16<0>, pg8::StaticOrder, true, true>(C.lds + RING_OFF, g, S, E); }
    GRID_BAR();
#ifdef USE_TOPK_NAIVE
    if (PH(16)) peer_scores(C, QP, KEYS + (size_t)8 * 2 * 128 * 128, SCO);
    GRID_BAR();
    if (PH(17)) peer_topk(C, SCO, IDX, GATE);
#else
    if (PH(17)) peer_topk_fused<0>(C, QP, KEYS + (size_t)8 * 2 * 128 * 128, IDX, GATE);
#endif
    GRID_BAR();
    if (PH(18)) GATHER_FN<true>(C, H, IDX, GATE, PU8 + (size_t)16384 * 1024, PV8 + (size_t)16384 * 1024, ISU + 16384, ISV + 16384, out, MOD1 + 5120, INP(float, 20), nullptr, nullptr);
#undef GRID_BAR
}

extern "C" void kernel_launch(void* const* d_in, const int* in_sizes, int n_in, void* d_out, int out_size, void* d_ws, size_t ws_size, hipStream_t stream) {
    static int grid = 0;
    if (grid == 0) {
        if (n_in != 21 || in_sizes[0] != TT * DM || out_size != TT * DM || ws_size < WS_END) { fprintf(stderr, "kernel_launch: unexpected shapes/workspace: n_in %d in0 %d out %d ws %zu (need %zu)\n", n_in, n_in > 0 ? in_sizes[0] : -1, out_size, ws_size, (size_t)WS_END); grid = -1; return; }
        int dev = 0, cus = 0;
        if (hipGetDevice(&dev) != hipSuccess || hipDeviceGetAttribute(&cus, hipDeviceAttributeMultiprocessorCount, dev) != hipSuccess) { fprintf(stderr, "kernel_launch: device query failed\n"); grid = -1; return; }
        if (hipFuncSetAttribute((const void*)mk_fwd, hipFuncAttributeMaxDynamicSharedMemorySize, LDS_BYTES) != hipSuccess) { fprintf(stderr, "kernel_launch: hipFuncSetAttribute failed\n"); grid = -1; return; }
        (void)hipGetLastError();
        grid = cus;
    }
    if (grid < 0) return;
    if (hipMemsetAsync((char*)d_ws + WS_CTL, 0, CTL_ZERO_BYTES, stream) != hipSuccess) { fprintf(stderr, "kernel_launch: memset failed\n"); return; }
    Args a; memset(&a, 0, sizeof(a));
    for (int i = 0; i < 21; ++i) a.in[i] = d_in[i];
    a.out = (float*)d_out; a.ws = (unsigned char*)d_ws;
    hipLaunchKernelGGL(mk_fwd, dim3(grid), dim3(NWAVES * 64), LDS_BYTES, stream, a);
    const hipError_t le = hipPeekAtLastError();
    if (le != hipSuccess) fprintf(stderr, "kernel_launch: launch failed: %s\n", hipGetErrorName(le));
}
```

```cpp
#define USE_GATHER_ROUNDS 1
#include <hip/hip_runtime.h>
#include <cstdio>
#include <cstdint>
#include <cstring>
#include <cmath>
namespace pg8 {
#define PG8_LAS __attribute__((address_space(3)))
typedef unsigned short bf16_t;
typedef short bf16x8 __attribute__((ext_vector_type(8)));
typedef float f32x4 __attribute__((ext_vector_type(4)));
typedef unsigned u32x4 __attribute__((ext_vector_type(4)));
constexpr int BM = 256, BK = 64, HALF = 128, HTB = HALF * BK * 2  , STAGE_BYTES = 8 * HTB, NXCD = 8, WGM = 8;

__host__ __device__ __forceinline__ int lds_byte(int r, int c) { const int st = (r >> 4) * 2 + (c >> 5), rr = r & 15, cc = c & 31, ob = rr * 64 + cc * 2; return st * 1024 + (ob ^ (((ob >> 9) & 1) << 5)); }
__host__ __device__ __forceinline__ void stage_rc(int b, int& R, int& C) { const int st = b / 1024, sb = b % 1024, swz = sb ^ (((sb >> 9) & 1) << 5); R = (st >> 1) * 16 + swz / 64; C = (st & 1) * 32 + (swz % 64) / 2; }
__host__ __device__ __forceinline__ int perm32(int rho) { const int n = rho >> 4, i = rho & 15; return 8 * (i >> 2) + 4 * n + (i & 3); }

struct Unit { int pm, pn; };
struct Gemm { const bf16_t* A; const bf16_t* Bt; int M, N, K; };

struct StaticOrder {
    int nM, nN, nwg, G, c;
    __host__ __device__ void init(int M, int N, int G_, int c_) { nM = M / BM; nN = N / BM; nwg = nM * nN; G = G_; c = c_; }
    __host__ __device__ bool next(int i, Unit& u) const {
        const long L = (long)i * G + c; if (L >= nwg) return false;
        int wgid = (int)L; { const int q = nwg / NXCD, r = nwg % NXCD, xcd = wgid % NXCD, off = wgid / NXCD; wgid = (xcd < r ? xcd * (q + 1) : r * (q + 1) + (xcd - r) * q) + off; }
        const int nig = WGM * nN, gid = wgid / nig, fm = gid * WGM, gsz = (nM - fm) < WGM ? (nM - fm) : WGM;
        u.pm = fm + ((wgid % nig) % gsz); u.pn = (wgid % nig) / gsz; return true;
    }
    __device__ __forceinline__ void a_ready(const Unit&) const {}
    __device__ __forceinline__ void done(const Unit&) const {}
};

__device__ __forceinline__ unsigned cvt_pk_bf16(float lo, float hi) { unsigned r; asm volatile("v_cvt_pk_bf16_f32 %0, %1, %2" : "=v"(r) : "v"(lo), "v"(hi)); return r; }
typedef float f32x2 __attribute__((ext_vector_type(2)));
__device__ __forceinline__ f32x2 gelu_pk(f32x2 v) {
    const f32x2 av = __builtin_elementwise_abs(v), d = av * 0.2316418882f + 1.0f;
    f32x2 t; t.x = __builtin_amdgcn_rcpf(d.x); t.y = __builtin_amdgcn_rcpf(d.y);
    f32x2 q = t * 0.5307027145f + (-0.7265760135f); q = q * t + 0.7107068705f; q = q * t + (-0.142248368f); q = q * t + 0.127414796f; q = q * t;
    const f32x2 s = (v * v) * (-0.72134752044f);
    f32x2 e; e.x = __builtin_amdgcn_exp2f(s.x); e.y = __builtin_amdgcn_exp2f(s.y);
    const f32x2 m = v * (q * e), r = v - m;
    f32x2 o; o.x = v.x < 0.f ? m.x : r.x; o.y = v.y < 0.f ? m.y : r.y; return o;
}

template <int ACT  > struct EpiBf16 {
    static constexpr bool PERM = true, AFTER_DRAIN = false; static_assert(ACT == 0 || ACT == 1, "EpiBf16: ACT is 0 (none) or 1 (gelu_pk)");
    bf16_t* O; int ldc; const float* bias; int split_cols; size_t split_stride; float scale0;
    __device__ __forceinline__ void operator()(const f32x4 (&acc)[2][2][4][2], const Unit& u, int wr, int wc, int fr, int fq) const {
        const int row0 = u.pm * BM + wr * 64 + fr; int colt = u.pn * BM; bf16_t* base = O;
        float sc = 1.f; if (split_cols) { const int t = colt / split_cols; base += (size_t)t * split_stride; colt -= t * split_cols; if (t == 0) sc = scale0; }
        const int col0 = colt + wc * 32 + 8 * fq, bcol0 = u.pn * BM + wc * 32 + 8 * fq;
        f32x4 bv[2][2];
#pragma unroll
        for (int bj = 0; bj < 2; ++bj)
#pragma unroll
            for (int n = 0; n < 2; ++n) bv[bj][n] = bias ? *(const f32x4*)(bias + bcol0 + bj * HALF + 4 * n) : (f32x4){0.f, 0.f, 0.f, 0.f};
#pragma unroll
        for (int ai = 0; ai < 2; ++ai)
#pragma unroll
            for (int m = 0; m < 4; ++m) { bf16_t* rowp = base + (size_t)(row0 + ai * HALF + m * 16) * ldc + col0;
#pragma unroll
                for (int bj = 0; bj < 2; ++bj) { f32x4 v0 = acc[ai][bj][m][0] + bv[bj][0], v1 = acc[ai][bj][m][1] + bv[bj][1];
                    if (ACT == 1) { f32x2 a = gelu_pk((f32x2){v0[0], v0[1]}), b = gelu_pk((f32x2){v0[2], v0[3]}), c = gelu_pk((f32x2){v1[0], v1[1]}), d = gelu_pk((f32x2){v1[2], v1[3]});
                        v0 = (f32x4){a.x, a.y, b.x, b.y}; v1 = (f32x4){c.x, c.y, d.x, d.y}; }
                    v0 = v0 * sc; v1 = v1 * sc; u32x4 w; w.x = cvt_pk_bf16(v0[0], v0[1]); w.y = cvt_pk_bf16(v0[2], v0[3]); w.z = cvt_pk_bf16(v1[0], v1[1]); w.w = cvt_pk_bf16(v1[2], v1[3]);
                    *(u32x4*)(rowp + bj * HALF) = w; } }
    }
};
template <class Epi, class Sched, bool ALIGN_EPI = false, bool SP2 = false>
__device__ __forceinline__ void gemm_phase(PG8_LAS unsigned char* lds, const Gemm g, const Sched& S, const Epi& E) {
    int tid_ = threadIdx.x; asm volatile("" : "+v"(tid_));
    const int tid = tid_, wid = __builtin_amdgcn_readfirstlane(tid >> 6), lane = tid & 63, wr = wid >> 2, wc = wid & 3, fr = lane & 15, fq = lane >> 4;
    const int K = g.K, nt = K / BK;
    unsigned voffA[2], voffB[2];
#pragma unroll
    for (int i = 0; i < 2; ++i) { int R, C; stage_rc(tid * 16 + i * 8192, R, C); const int Rb = Epi::PERM ? ((R & ~31) + perm32(R & 31)) : R;
        voffA[i] = (unsigned)(R * K + C) * 2u; voffB[i] = (unsigned)(Rb * K + C) * 2u; }
    const size_t kstep = (size_t)(BK * 2);
    const size_t hstep = (size_t)HALF * K * 2;
    const size_t tstep = 2 * hstep;
    const unsigned ldsw = (unsigned)wid * 1024u;
    const int aoff = lds_byte(wr * 64 + fr, fq * 8), boff = lds_byte(wc * 32 + fr, fq * 8);
#define PG8_SA(b, h) (((b) * 2 + (h)) * HTB)
#define PG8_SB(b, h) ((4 + (b) * 2 + (h)) * HTB)
#define PG8_STAGE(bufoff, gbase, voff) do { _Pragma("unroll") for (int _i = 0; _i < 2; ++_i) \
        __builtin_amdgcn_global_load_lds((const unsigned*)((const char*)(gbase) + (voff)[_i]), (PG8_LAS unsigned*)(lds + (bufoff) + ldsw + _i * 8192), 16, 0, 0); } while (0)
#define PG8_LDA(dst, b, h) do { _Pragma("unroll") for (int m = 0; m < 4; ++m) _Pragma("unroll") for (int k = 0; k < 2; ++k) dst[m][k] = *(const PG8_LAS bf16x8*)(lds + PG8_SA(b, h) + aoff + m * 2048 + k * 1024); } while (0)
#define PG8_LDB(dst, b, h) do { _Pragma("unroll") for (int n = 0; n < 2; ++n) _Pragma("unroll") for (int k = 0; k < 2; ++k) dst[n][k] = *(const PG8_LAS bf16x8*)(lds + PG8_SB(b, h) + boff + n * 2048 + k * 1024); } while (0)
#define PG8_MMA(ai, bj, At, Bt) do { __builtin_amdgcn_s_setprio(1); _Pragma("unroll") for (int m = 0; m < 4; ++m) _Pragma("unroll") for (int n = 0; n < 2; ++n) _Pragma("unroll") for (int k = 0; k < 2; ++k) \
        acc[ai][bj][m][n] = __builtin_amdgcn_mfma_f32_16x16x32_bf16(Bt[n][k], At[m][k], acc[ai][bj][m][n], 0, 0, 0); __builtin_amdgcn_s_setprio(0); } while (0)
#define PG8_WAIT_V(n) asm volatile("s_waitcnt vmcnt(" #n ")" ::: "memory")
#define PG8_WAIT_L(n) asm volatile("s_waitcnt lgkmcnt(" #n ")" ::: "memory")
#define PG8_BAR __builtin_amdgcn_s_barrier()
#define PG8_SCHED __builtin_amdgcn_sched_barrier(0)
    Unit cur, nxt; int ui = 0;
    if (!S.next(0, cur)) return;
    f32x4 acc[2][2][4][2];
#pragma unroll
    for (int a = 0; a < 2; ++a)
#pragma unroll
        for (int b = 0; b < 2; ++b)
#pragma unroll
            for (int m = 0; m < 4; ++m)
#pragma unroll
                for (int n = 0; n < 2; ++n) acc[a][b][m][n] = (f32x4){0.f, 0.f, 0.f, 0.f};
    bf16x8 At[4][2], B0[2][2], B1[2][2];
    const char* cA = (const char*)g.A + (size_t)cur.pm * tstep; const char* cB = (const char*)g.Bt + (size_t)cur.pn * tstep;
    S.a_ready(cur);
    if constexpr (SP2) {
        PG8_STAGE(PG8_SB(0, 0), cB, voffB); PG8_STAGE(PG8_SB(0, 1), cB + hstep, voffB); PG8_STAGE(PG8_SA(0, 0), cA, voffA); PG8_STAGE(PG8_SA(0, 1), cA + hstep, voffA);
        if (wr == 1) PG8_BAR;
        PG8_WAIT_V(2); PG8_BAR;
        PG8_STAGE(PG8_SB(1, 0), cB + kstep, voffB); PG8_STAGE(PG8_SA(1, 0), cA + kstep, voffA); PG8_STAGE(PG8_SB(1, 1), cB + hstep + kstep, voffB);
        PG8_WAIT_V(6); PG8_BAR;
    } else {
        PG8_STAGE(PG8_SB(0, 0), cB, voffB); PG8_STAGE(PG8_SA(0, 0), cA, voffA); PG8_STAGE(PG8_SB(0, 1), cB + hstep, voffB); PG8_STAGE(PG8_SA(0, 1), cA + hstep, voffA);
        if (wr == 1) PG8_BAR;
        PG8_WAIT_V(4); PG8_BAR;
        PG8_STAGE(PG8_SB(1, 0), cB + kstep, voffB); PG8_STAGE(PG8_SA(1, 0), cA + kstep, voffA); PG8_STAGE(PG8_SB(1, 1), cB + hstep + kstep, voffB);
        PG8_WAIT_V(6); PG8_BAR;
    }
    for (;;) {
        const bool has_next = S.next(ui + 1, nxt);
        const char* nA = has_next ? (const char*)g.A + (size_t)nxt.pm * tstep : cA; const char* nB = has_next ? (const char*)g.Bt + (size_t)nxt.pn * tstep : cB;
        for (int t = 0; t < nt; t += 2) {
            const bool last = (t == nt - 2);
            const char* a1 = cA + (size_t)(t + 1) * kstep;
            const char* a2 = last ? nA : cA + (size_t)(t + 2) * kstep; const char* b2 = last ? nB : cB + (size_t)(t + 2) * kstep;
            const char* a3 = a2 + kstep; const char* b3 = b2 + kstep;
            if (last && has_next) S.a_ready(nxt);
            if constexpr (SP2) {
            PG8_LDB(B0, 0, 0); PG8_LDB(B1, 0, 1); PG8_SCHED; PG8_LDA(At, 0, 0); PG8_STAGE(PG8_SA(1, 1), a1 + hstep, voffA);
            PG8_WAIT_V(8); PG8_WAIT_L(0); PG8_BAR; PG8_MMA(0, 0, At, B0); PG8_MMA(0, 1, At, B1); PG8_BAR; PG8_SCHED;
            PG8_LDA(At, 0, 1); PG8_STAGE(PG8_SB(0, 0), b2, voffB); PG8_STAGE(PG8_SB(0, 1), b2 + hstep, voffB); PG8_STAGE(PG8_SA(0, 0), a2, voffA);
            PG8_WAIT_V(8); PG8_WAIT_L(0); PG8_BAR; PG8_MMA(1, 0, At, B0); PG8_MMA(1, 1, At, B1); PG8_BAR; PG8_SCHED;
            PG8_LDB(B0, 1, 0); PG8_LDB(B1, 1, 1); PG8_SCHED; PG8_LDA(At, 1, 0); PG8_STAGE(PG8_SA(0, 1), a2 + hstep, voffA);
            PG8_WAIT_V(8); PG8_WAIT_L(0); PG8_BAR; PG8_MMA(0, 0, At, B0); PG8_MMA(0, 1, At, B1); PG8_BAR; PG8_SCHED;
            PG8_LDA(At, 1, 1); PG8_STAGE(PG8_SB(1, 0), b3, voffB); PG8_STAGE(PG8_SB(1, 1), b3 + hstep, voffB); PG8_STAGE(PG8_SA(1, 0), a3, voffA);
            PG8_WAIT_V(8); PG8_WAIT_L(0); PG8_BAR; PG8_MMA(1, 0, At, B0); PG8_MMA(1, 1, At, B1); PG8_BAR; PG8_SCHED;
            } else {
            PG8_LDB(B0, 0, 0); PG8_SCHED; PG8_LDA(At, 0, 0); PG8_STAGE(PG8_SA(1, 1), a1 + hstep, voffA);
            PG8_WAIT_L(8); PG8_BAR; PG8_WAIT_L(0); PG8_MMA(0, 0, At, B0); PG8_BAR; PG8_SCHED;
            PG8_LDB(B1, 0, 1); PG8_STAGE(PG8_SB(0, 0), b2, voffB);
            PG8_BAR; PG8_WAIT_L(0); PG8_MMA(0, 1, At, B1); PG8_BAR;
            PG8_LDA(At, 0, 1); PG8_STAGE(PG8_SA(0, 0), a2, voffA);
            PG8_BAR; PG8_WAIT_L(0); PG8_MMA(1, 0, At, B0); PG8_BAR; PG8_SCHED;
            PG8_STAGE(PG8_SB(0, 1), b2 + hstep, voffB);
            PG8_WAIT_V(6); PG8_BAR; PG8_MMA(1, 1, At, B1); PG8_BAR;
            PG8_LDB(B0, 1, 0); PG8_SCHED; PG8_LDA(At, 1, 0); PG8_STAGE(PG8_SA(0, 1), a2 + hstep, voffA);
            PG8_WAIT_L(8); PG8_BAR; PG8_WAIT_L(0); PG8_MMA(0, 0, At, B0); PG8_BAR; PG8_SCHED;
            PG8_LDB(B1, 1, 1); PG8_STAGE(PG8_SB(1, 0), b3, voffB);
            PG8_BAR; PG8_WAIT_L(0); PG8_MMA(0, 1, At, B1); PG8_BAR;
            PG8_LDA(At, 1, 1); PG8_STAGE(PG8_SA(1, 0), a3, voffA);
            PG8_BAR; PG8_WAIT_L(0); PG8_MMA(1, 0, At, B0); PG8_BAR; PG8_SCHED;
            PG8_STAGE(PG8_SB(1, 1), b3 + hstep, voffB);
            PG8_WAIT_V(6); PG8_BAR; PG8_MMA(1, 1, At, B1); PG8_BAR;
            }
        }
        if constexpr (ALIGN_EPI) { if (wr == 0) PG8_BAR; }
        if constexpr (!Epi::AFTER_DRAIN) { E(acc, cur, wr, wc, fr, fq); S.done(cur); }
        if (!has_next) break;
#pragma unroll
        for (int a = 0; a < 2; ++a)
#pragma unroll
            for (int b = 0; b < 2; ++b)
#pragma unroll
                for (int m = 0; m < 4; ++m)
#pragma unroll
                    for (int n = 0; n < 2; ++n) acc[a][b][m][n] = (f32x4){0.f, 0.f, 0.f, 0.f};
        cur = nxt; cA = nA; cB = nB; ++ui;
        if constexpr (ALIGN_EPI) { if (wr == 1) PG8_BAR; }
    }
    PG8_WAIT_V(0);
    if constexpr (!ALIGN_EPI) { if (wr == 0) PG8_BAR; }
    PG8_BAR;
    if constexpr (Epi::AFTER_DRAIN) { E.fused(acc, cur, wr, wc, fr, fq, lds, wid, lane); S.done(cur); }
#undef PG8_SA
#undef PG8_SB
#undef PG8_STAGE
#undef PG8_LDA
#undef PG8_LDB
#undef PG8_MMA
#undef PG8_WAIT_V
#undef PG8_WAIT_L
#undef PG8_BAR
#undef PG8_SCHED
}
}
namespace pg8 {
typedef unsigned u32x2 __attribute__((ext_vector_type(2)));
__device__ __forceinline__ float gelu_tanh(float x) {
    const float e = __builtin_amdgcn_exp2f(x * (-2.302208198f - 0.1029432397f * x * x));
    return x * __builtin_amdgcn_rcpf(1.0f + e);
}
__device__ __forceinline__ float silu_f(float x) { return x * __builtin_amdgcn_rcpf(1.0f + __builtin_amdgcn_exp2f(-1.4426950409f * x)); }

struct EpiRetProj {
    static constexpr bool PERM = false, AFTER_DRAIN = false;
    bf16_t *Q, *K, *V, *G; const float *cosT, *sinT;
    __device__ __forceinline__ void operator()(const f32x4 (&acc)[2][2][4][2], const Unit& u, int wr, int wc, int fr, int fq) const {
        const int pn = u.pn;
        if (pn < 8) {
            bf16_t* dst = pn < 4 ? Q : K; const int head = pn & 3; const float sc = pn < 4 ? 1.0f : 0.0625f;
#pragma unroll
            for (int ai = 0; ai < 2; ++ai)
#pragma unroll
                for (int m = 0; m < 4; ++m) {
                    const int row = u.pm * BM + ai * HALF + wr * 64 + m * 16 + fr;
#pragma unroll
                    for (int n = 0; n < 2; ++n) {
                        const int f0 = wc * 32 + n * 16 + fq * 4;
                        const f32x4 c4 = *(const f32x4*)(cosT + (size_t)row * 128 + f0), s4 = *(const f32x4*)(sinT + (size_t)row * 128 + f0);
                        const f32x4 x1 = acc[ai][0][m][n], x2 = acc[ai][1][m][n];
                        const f32x4 o1 = (x1 * c4 - x2 * s4) * sc, o2 = (x1 * s4 + x2 * c4) * sc;
                        u32x2 w1, w2; w1.x = cvt_pk_bf16(o1[0], o1[1]); w1.y = cvt_pk_bf16(o1[2], o1[3]); w2.x = cvt_pk_bf16(o2[0], o2[1]); w2.y = cvt_pk_bf16(o2[2], o2[3]);
                        bf16_t* p = dst + (size_t)row * 1024 + head * 256 + f0;
                        *(u32x2*)p = w1; *(u32x2*)(p + 128) = w2;
                    }
                }
        } else {
            const bool isg = pn >= 16; bf16_t* dst = isg ? G : V; const int colbase = ((pn - 8) & 7) * 256;
#pragma unroll
            for (int ai = 0; ai < 2; ++ai)
#pragma unroll
                for (int m = 0; m < 4; ++m) {
                    const int row = u.pm * BM + ai * HALF + wr * 64 + m * 16 + fr;
#pragma unroll
                    for (int bj = 0; bj < 2; ++bj)
#pragma unroll
                        for (int n = 0; n < 2; ++n) {
                            f32x4 v = acc[ai][bj][m][n];
                            if (isg) { v[0] = silu_f(v[0]); v[1] = silu_f(v[1]); v[2] = silu_f(v[2]); v[3] = silu_f(v[3]); }
                            u32x2 w; w.x = cvt_pk_bf16(v[0], v[1]); w.y = cvt_pk_bf16(v[2], v[3]);
                            *(u32x2*)(dst + (size_t)row * 2048 + colbase + bj * HALF + wc * 32 + n * 16 + fq * 4) = w;
                        }
                }
        }
    }
};
struct EpiResGate {
    static constexpr bool PERM = false, AFTER_DRAIN = false;
    const float* base; float* out; const float* gate; int gstride;
    __device__ __forceinline__ void operator()(const f32x4 (&acc)[2][2][4][2], const Unit& u, int wr, int wc, int fr, int fq) const {
        const int b = (u.pm * BM) >> 13; const float* gp = gate + (size_t)b * gstride;
        const int col0 = u.pn * BM + wc * 32 + 4 * fq;
        f32x4 gv[2][2];
#pragma unroll
        for (int bj = 0; bj < 2; ++bj)
#pragma unroll
            for (int n = 0; n < 2; ++n) gv[bj][n] = *(const f32x4*)(gp + col0 + bj * HALF + n * 16);
#pragma unroll
        for (int ai = 0; ai < 2; ++ai)
#pragma unroll
            for (int m = 0; m < 4; ++m) {
                const size_t off = (size_t)(u.pm * BM + ai * HALF + wr * 64 + m * 16 + fr) * 1024 + col0;
#pragma unroll
                for (int bj = 0; bj < 2; ++bj)
#pragma unroll
                    for (int n = 0; n < 2; ++n) { const f32x4 bs = *(const f32x4*)(base + off + bj * HALF + n * 16); *(f32x4*)(out + off + bj * HALF + n * 16) = bs + gv[bj][n] * acc[ai][bj][m][n]; }
            }
    }
};
struct EpiSguIn {
    static constexpr bool PERM = true, AFTER_DRAIN = false;
    bf16_t* U; bf16_t* Vb; const float* bias; float* stats;
    __device__ __forceinline__ void operator()(const f32x4 (&acc)[2][2][4][2], const Unit& u, int wr, int wc, int fr, int fq) const {
        const bool isv = u.pn >= 12; bf16_t* base = isv ? Vb : U; const int colt = (isv ? u.pn - 12 : u.pn) * BM;
        const int col0 = colt + wc * 32 + 8 * fq, bcol0 = u.pn * BM + wc * 32 + 8 * fq;
        f32x4 bv[2][2];
#pragma unroll
        for (int bj = 0; bj < 2; ++bj)
#pragma unroll
            for (int n = 0; n < 2; ++n) bv[bj][n] = *(const f32x4*)(bias + bcol0 + bj * HALF + 4 * n);
#pragma unroll
        for (int ai = 0; ai < 2; ++ai)
#pragma unroll
            for (int m = 0; m < 4; ++m) {
                const int row = u.pm * BM + ai * HALF + wr * 64 + m * 16 + fr;
                bf16_t* rowp = base + (size_t)row * 3072 + col0;
                float s1 = 0.f, s2 = 0.f;
#pragma unroll
                for (int bj = 0; bj < 2; ++bj) {
                    f32x4 v0 = acc[ai][bj][m][0] + bv[bj][0], v1 = acc[ai][bj][m][1] + bv[bj][1];
#pragma unroll
                    for (int j = 0; j < 4; ++j) { v0[j] = gelu_tanh(v0[j]); v1[j] = gelu_tanh(v1[j]); }
                    u32x4 w; w.x = cvt_pk_bf16(v0[0], v0[1]); w.y = cvt_pk_bf16(v0[2], v0[3]); w.z = cvt_pk_bf16(v1[0], v1[1]); w.w = cvt_pk_bf16(v1[2], v1[3]);
                    *(u32x4*)(rowp + bj * HALF) = w;
                    if (isv) {
#pragma unroll
                        for (int j = 0; j < 4; ++j) { const unsigned ww = j == 0 ? w.x : j == 1 ? w.y : j == 2 ? w.z : w.w;
                            const float a = __uint_as_float(ww << 16), bq = __uint_as_float(ww & 0xffff0000u); s1 += a + bq; s2 += a * a + bq * bq; }
                    }
                }
                if (isv) {
                    s1 += __shfl_xor(s1, 16); s1 += __shfl_xor(s1, 32); s2 += __shfl_xor(s2, 16); s2 += __shfl_xor(s2, 32);
                    if (fq == 0) { float* sp = stats + ((size_t)row * 48 + (u.pn - 12) * 4 + wc) * 2; sp[0] = s1; sp[1] = s2; }
                }
            }
    }
};
}
typedef unsigned u32x4 __attribute__((ext_vector_type(4)));
#define GAS __attribute__((address_space(1)))
#define LAS __attribute__((address_space(3)))
typedef unsigned short bf16;
typedef unsigned v4u __attribute__((ext_vector_type(4)));
typedef float f32x4 __attribute__((ext_vector_type(4)));
typedef short bf16x8 __attribute__((ext_vector_type(8)));
typedef GAS unsigned gu32;
typedef GAS unsigned long long gu64;
#define RLX_AGENT __ATOMIC_RELAXED, __HIP_MEMORY_SCOPE_AGENT
#define LDS_WAIT() asm volatile("s_waitcnt lgkmcnt(0)" ::: "memory")
#define VM_WAIT() asm volatile("s_waitcnt vmcnt(0)" ::: "memory")
__device__ __forceinline__ unsigned long long rt() { return __builtin_amdgcn_s_memrealtime(); }
__device__ __forceinline__ unsigned f2bf(float f) { unsigned u = __builtin_bit_cast(unsigned, f); return (u + 0x7fffu + ((u >> 16) & 1u)) >> 16; }
__device__ __forceinline__ unsigned pk2(float lo, float hi) { return f2bf(lo) | (f2bf(hi) << 16); }

#define XB_TMO      128
#define XB_XCNT(j)  (256  + 64 * (j))
#define XB_XSUB(j)  (1280 + 64 * (j))
#define XB_XGEN(j)  (2304 + 64 * (j))
#define XB_TOP      3328
#define XB_TOPGEN   3392
#define XCD_BAR_WORDS 3456
#define XB_SPIN_CAP (1u << 18)

__device__ __forceinline__ unsigned xb_ld(unsigned* p)              { return __hip_atomic_load(p, __ATOMIC_RELAXED, __HIP_MEMORY_SCOPE_AGENT); }
__device__ __forceinline__ unsigned xb_add(unsigned* p, unsigned v) { return __hip_atomic_fetch_add(p, v, __ATOMIC_RELAXED, __HIP_MEMORY_SCOPE_AGENT); }
__device__ __forceinline__ unsigned xb_xcc_id() { return (unsigned)__builtin_amdgcn_s_getreg((3 << 11) | 20) & 0xFu; }
#define XB_SPIN(cond, bar) do { unsigned _sp = 0; while (cond) { __builtin_amdgcn_s_sleep(1); \
    if ((++_sp & 255u) == 0u) { if (xb_ld(&(bar)[XB_TMO])) break; if (_sp > XB_SPIN_CAP) { atomicAdd(&(bar)[XB_TMO], 1u); break; } } } } while (0)

struct XcdBarrier {
    unsigned* bar; unsigned x;
    volatile LAS unsigned* st;
};

__device__ __forceinline__ XcdBarrier xcd_barrier_post(unsigned* bar, volatile LAS unsigned* st) {
    XcdBarrier b; b.bar = bar; b.x = xb_xcc_id(); b.st = st;
    if (threadIdx.x == 0) (void)xb_add(&bar[XB_XCNT(b.x)], 1u);
    return b;
}
__device__ __forceinline__ void xcd_barrier_complete(unsigned* bar, unsigned x, unsigned& nloc, unsigned& nx) {
    const unsigned G = gridDim.x * gridDim.y * gridDim.z;
    unsigned sum, cnt, mine, sp = 0u;
    for (;;) {
        sum = 0u; cnt = 0u; mine = 0u;
#pragma unroll
        for (unsigned j = 0; j < 16; ++j) { const unsigned c = xb_ld(&bar[XB_XCNT(j)]); sum += c; cnt += (c > 0u) ? 1u : 0u; mine = (j == x) ? c : mine; }
        if (sum == G) break;
        __builtin_amdgcn_s_sleep(1);
        if ((++sp & 255u) == 0u) { if (xb_ld(&bar[XB_TMO])) break; if (sp > XB_SPIN_CAP) { atomicAdd(&bar[XB_TMO], 1u); break; } }
    }
    nloc = mine > 0u ? mine : 1u; nx = cnt > 0u ? cnt : 1u;
}

__device__ __forceinline__ void xcd_barrier(const XcdBarrier& b) {
    asm volatile("s_waitcnt vmcnt(0)" ::: "memory");
    __syncthreads();
    if (threadIdx.x == 0) {
        unsigned* bar = b.bar;
        __builtin_amdgcn_s_waitcnt(0);
        unsigned nloc = b.st[0], nx = b.st[1];
        if (nloc == 0u) { xcd_barrier_complete(bar, b.x, nloc, nx); b.st[0] = nloc; b.st[1] = nx; }
        const unsigned old = xb_add(&bar[XB_XSUB(b.x)], 1u);
        const unsigned gen = old / nloc;
        if (old + 1u == (gen + 1u) * nloc) {
            __builtin_amdgcn_fence(__ATOMIC_RELEASE, "agent");
            asm volatile("s_waitcnt vmcnt(0)" ::: "memory");
            const unsigned og = xb_add(&bar[XB_TOP], 1u);
            const unsigned tg = og / nx;
            if (og + 1u == (tg + 1u) * nx) xb_add(&bar[XB_TOPGEN], 1u);
            else XB_SPIN(xb_ld(&bar[XB_TOPGEN]) == tg, bar);
            __builtin_amdgcn_fence(__ATOMIC_ACQUIRE, "agent");
            xb_add(&bar[XB_XGEN(b.x)], 1u);
            asm volatile("s_waitcnt vmcnt(0)" ::: "memory");
        } else {
            XB_SPIN(xb_ld(&bar[XB_XGEN(b.x)]) == gen, bar);
            __builtin_amdgcn_fence(__ATOMIC_ACQUIRE, "agent");
            asm volatile("s_waitcnt vmcnt(0)" ::: "memory");
        }
    }
    __syncthreads();
}
__device__ __forceinline__ float wave_sum(float v) {
#pragma unroll
    for (int o = 1; o < 64; o <<= 1) v += __shfl_xor(v, o);
    return v;
}
__device__ __forceinline__ void p0_transpose_item(const float* W, int K, int N, bf16* WT, int row_off, LAS float* scr, int item, int lane) {
    const int nblk = N / 32, kb = item / nblk, nb = item % nblk, k0 = 64 * kb, n0 = 32 * nb;
#pragma unroll 8
    for (int i = 0; i < 32; ++i) { const int kk = 2 * i + (lane >> 5); scr[kk * 33 + (lane & 31)] = W[(size_t)(k0 + kk) * N + n0 + (lane & 31)]; }
    LDS_WAIT(); asm volatile("" ::: "memory");
    const int c = lane & 7;
#pragma unroll
    for (int j = 0; j < 4; ++j) { const int n = (lane >> 3) + 8 * j; const LAS float* s = scr + (8 * c) * 33 + n;
        v4u o; o.x = pk2(s[0 * 33], s[1 * 33]); o.y = pk2(s[2 * 33], s[3 * 33]); o.z = pk2(s[4 * 33], s[5 * 33]); o.w = pk2(s[6 * 33], s[7 * 33]);
        *(GAS v4u*)(WT + (size_t)(row_off + n0 + n) * K + k0 + 8 * c) = o; }
    LDS_WAIT(); asm volatile("" ::: "memory");
}
#define DI __device__ __forceinline__
constexpr int NWAVES = 8;
constexpr int TT = 16384, DM = 1024, SEQ = 8192;
constexpr size_t MiB = 1u << 20;
constexpr size_t WS_CTL = 0, CTL_ZERO_BYTES = 32768, WS_MOD = 512 * 1024;
constexpr size_t WS_COS = 2 * MiB, WS_SIN = 10 * MiB;
constexpr size_t WS_WRI = 18 * MiB, WS_WRO = 30 * MiB, WS_WSI = 34 * MiB, WS_WSO = 46 * MiB, WS_WQ = 52 * MiB, WS_KEYS = 60 * MiB;
constexpr size_t WS_ISU = 61 * MiB, WS_ISV = 61 * MiB + 256 * 1024;
constexpr size_t WS_STATS = 62 * MiB, WS_IDX = 68 * MiB, WS_GATE = 76 * MiB, WS_H = 84 * MiB, WS_PU = 116 * MiB, WS_PV = 180 * MiB;
constexpr size_t WS_R = 244 * MiB;
constexpr size_t WS_Q = WS_R, WS_K = WS_R + 32 * MiB, WS_V = WS_R + 64 * MiB, WS_G = WS_R + 128 * MiB, WS_CROSS = WS_R + 192 * MiB;
constexpr size_t WS_QP = WS_R, WS_SC = WS_R + 64 * MiB;
constexpr size_t WS_U = WS_R, WS_VB = WS_R + 96 * MiB;
constexpr size_t WS_END = 500 * MiB;
constexpr int CW_TMO = 0, CW_BAR = 4096;
constexpr int RING_OFF = 0, RING_BYTES = 131072, LDS_BYTES = 163840, LDSCTL_OFF = LDS_BYTES - 1024, MISC_OFF = LDSCTL_OFF + 320;
constexpr int PTR_OFF = LDSCTL_OFF + 512;
constexpr float EPS = 1e-6f;
typedef float f32x2_t __attribute__((ext_vector_type(2)));

DI float bf2f(bf16 h) { return __uint_as_float((unsigned)h << 16); }
DI float bflo(unsigned w) { return __uint_as_float(w << 16); }
DI float bfhi(unsigned w) { return __uint_as_float(w & 0xffff0000u); }
DI float wave_max(float v) {
#pragma unroll
    for (int o = 1; o < 64; o <<= 1) v = fmaxf(v, __shfl_xor(v, o));
    return v;
}
DI float gelu_t(float x) { return pg8::gelu_tanh(x); }

struct Ctx {
    LAS unsigned char* lds; int tid, lane, wave, vcu, G;
    unsigned char* ws;
};

DI const void* ldp(const Ctx& C, int i) {
    const unsigned long long v = ((const LAS unsigned long long*)(C.lds + PTR_OFF))[i];
    const unsigned lo = __builtin_amdgcn_readfirstlane((unsigned)v), hi = __builtin_amdgcn_readfirstlane((unsigned)(v >> 32));
    return (const void*)(((unsigned long long)hi << 32) | lo);
}
DI void cvt_rows_fp8(const float* src, unsigned char* dst, float* inv_scale, int nrows, int gw, int NGW, int lane) {
    for (int r = gw; r < nrows; r += NGW) {
        const f32x4* s = (const f32x4*)(src + (size_t)r * 1024) + lane * 4;
        f32x4 v[4]; float am = 0.f;
#pragma unroll
        for (int q = 0; q < 4; ++q) { v[q] = s[q]; am = fmaxf(am, fmaxf(fmaxf(fabsf(v[q][0]), fabsf(v[q][1])), fmaxf(fabsf(v[q][2]), fabsf(v[q][3])))); }
        am = wave_max(am);
        const int e = (int)((__float_as_uint(am) >> 23) & 0xffu) - 127;
        const bool ok = am > 1e-30f;
        const float sc = ok ? __uint_as_float((unsigned)(127 + 7 - e) << 23) : 1.0f, isc = ok ? __uint_as_float((unsigned)(127 - 7 + e) << 23) : 1.0f;
        u32x4 o;
#pragma unroll
        for (int q = 0; q < 4; ++q) { int wd = __builtin_amdgcn_cvt_pk_fp8_f32(v[q][0] * sc, v[q][1] * sc, 0, false); wd = __builtin_amdgcn_cvt_pk_fp8_f32(v[q][2] * sc, v[q][3] * sc, wd, true); o[q] = (unsigned)wd; }
        *(u32x4*)(dst + (size_t)r * 1024 + lane * 16) = o;
        if (lane == 0) inv_scale[r] = isc;
    }
}
DI void cvt_rows_i8(const float* src, unsigned char* dst, float* inv_scale, int nrows, int gw, int NGW, int lane) {
    for (int r = gw; r < nrows; r += NGW) {
        const f32x4* s = (const f32x4*)(src + (size_t)r * 1024) + lane * 4;
        f32x4 v[4]; float am = 0.f;
#pragma unroll
        for (int q = 0; q < 4; ++q) { v[q] = s[q]; am = fmaxf(am, fmaxf(fmaxf(fabsf(v[q][0]), fabsf(v[q][1])), fmaxf(fabsf(v[q][2]), fabsf(v[q][3])))); }
        am = wave_max(am);
        const int e = (int)((__float_as_uint(am) >> 23) & 0xffu) - 127;
        const bool ok = am > 1e-30f;
        const float sc = ok ? __uint_as_float((unsigned)(127 + 6 - e) << 23) : 1.0f, isc = ok ? __uint_as_float((unsigned)(127 - 6 + e) << 23) : 1.0f;
        u32x4 o;
#pragma unroll
        for (int q = 0; q < 4; ++q) { unsigned wd = 0u;
#pragma unroll
            for (int j = 0; j < 4; ++j) { int qi = (int)rintf(v[q][j] * sc); qi = qi > 127 ? 127 : (qi < -127 ? -127 : qi); wd |= ((unsigned)qi & 0xffu) << (8 * j); }
            o[q] = wd; }
        *(u32x4*)(dst + (size_t)r * 1024 + lane * 16) = o;
        if (lane == 0) inv_scale[r] = isc;
    }
}
DI void cvt_stream(const float* src, bf16* dst, size_t n4, size_t gtid, size_t gthreads) {
    const f32x4* s = (const f32x4*)src; uint2* d = (uint2*)dst;
    for (size_t i = gtid; i < n4; i += gthreads) { const f32x4 v = s[i]; uint2 o; o.x = pk2(v.x, v.y); o.y = pk2(v.z, v.w); d[i] = o; }
}
struct P0In { const float *c, *ada_w, *ada_b, *ret_w_in, *ret_w_out, *sgu_w_in, *sgu_w_out, *wq, *keys, *pu, *pv; const int* pos; };
DI void p0_prologue(const Ctx& C, const P0In& I) {
    LAS float* scr = (LAS float*)(C.lds + RING_OFF + C.wave * 16384);
    const int gw = C.vcu * NWAVES + C.wave, NGW = C.G * NWAVES;
    bf16* wri = (bf16*)(C.ws + WS_WRI); bf16* wro = (bf16*)(C.ws + WS_WRO);
    constexpr int I_RI = 16 * 192, I_RO = 32 * 32;
    constexpr int NITEMS = I_RI + I_RO;
    for (int it = gw; it < NITEMS; it += NGW) {
        int r = it;
        if (r < I_RI) { p0_transpose_item(I.ret_w_in, 1024, 6144, wri, 0, scr, r, C.lane); continue; } r -= I_RI;
        p0_transpose_item(I.ret_w_out, 2048, 1024, wro, 0, scr, r, C.lane);
    }
    const size_t gtid = (size_t)C.vcu * 512 + C.tid, gth = (size_t)C.G * 512;
    cvt_stream(I.keys, (bf16*)(C.ws + WS_KEYS), (size_t)2 * 8 * 2 * 128 * 128 / 4, gtid, gth);
    float* mod = (float*)(C.ws + WS_MOD);
    __syncthreads();
    for (int it = C.vcu; it < 2 * 96; it += C.G) {
        const int l = it / 96, cb = it % 96, kp = C.wave, n = cb * 64 + C.lane;
        const float* W = I.ada_w + (size_t)l * 1024 * 6144 + n;
        float a0 = 0.f, a1 = 0.f;
#pragma unroll 8
        for (int k = kp * 128; k < kp * 128 + 128; ++k) {
            const float w = W[(size_t)k * 6144]; const float c0 = I.c[k], c1 = I.c[1024 + k];
            a0 += pg8::silu_f(c0) * w; a1 += pg8::silu_f(c1) * w;
        }
        LAS float* red = (LAS float*)(C.lds + RING_OFF);
        red[(kp * 2 + 0) * 64 + C.lane] = a0; red[(kp * 2 + 1) * 64 + C.lane] = a1;
        __syncthreads();
        if (C.wave < 2) { float s = I.ada_b[l * 6144 + n];
#pragma unroll
            for (int q = 0; q < 8; ++q) s += red[(q * 2 + C.wave) * 64 + C.lane];
            mod[(size_t)(l * 2 + C.wave) * 6144 + n] = s; }
        __syncthreads();
    }
    float* cosT = (float*)(C.ws + WS_COS); float* sinT = (float*)(C.ws + WS_SIN);
    for (int it = gw; it < TT / 2; it += NGW) {
        const int row = 2 * it + (C.lane >> 5), f0 = (C.lane & 31) * 4; const float p = (float)I.pos[row];
        f32x4 cv, sv;
#pragma unroll
        for (int j = 0; j < 4; ++j) { const int f = f0 + j; double w = 1.0, bs = 0.93057204092969898;
#pragma unroll
            for (int bit = 0; bit < 7; ++bit) { if ((f >> bit) & 1) w *= bs; bs *= bs; }
            const float ang = p * (float)w; const double r = (double)ang * 0.15915494309189535; const float fr = (float)(r - floor(r)); cv[j] = __builtin_amdgcn_cosf(fr); sv[j] = __builtin_amdgcn_sinf(fr); }
        *(f32x4*)(cosT + (size_t)row * 128 + f0) = cv; *(f32x4*)(sinT + (size_t)row * 128 + f0) = sv;
    }
}
DI void side_work(const Ctx& C, const P0In& I, int nskip) {
    LAS float* scr = (LAS float*)(C.lds + RING_OFF + C.wave * 16384);
    const int gw = (C.vcu - nskip) * NWAVES + C.wave, NGW = (C.G - nskip) * NWAVES;
    bf16* wsi = (bf16*)(C.ws + WS_WSI); bf16* wso = (bf16*)(C.ws + WS_WSO); bf16* wq = (bf16*)(C.ws + WS_WQ);
    constexpr int I_SI = 16 * 192, I_SO = 48 * 32, I_Q = 16 * 64;
    constexpr int NITEMS = I_SI + I_SO + 2 * I_Q;
    for (int it = gw; it < NITEMS; it += NGW) {
        int r = it;
        if (r < I_SI) { p0_transpose_item(I.sgu_w_in, 1024, 6144, wsi, 0, scr, r, C.lane); continue; } r -= I_SI;
        if (r < I_SO) { p0_transpose_item(I.sgu_w_out, 3072, 1024, wso, 0, scr, r, C.lane); continue; } r -= I_SO;
        if (r < I_Q) { p0_transpose_item(I.wq, 1024, 2048, wq, 0, scr, r, C.lane); continue; } r -= I_Q;
        p0_transpose_item(I.wq + (size_t)1024 * 2048, 1024, 2048, wq + (size_t)2048 * 1024, 0, scr, r, C.lane);
    }
    cvt_rows_i8(I.pu, (unsigned char*)(C.ws + WS_PU), (float*)(C.ws + WS_ISU), 2 * 16384, gw, NGW, C.lane);
    cvt_rows_fp8(I.pv, (unsigned char*)(C.ws + WS_PV), (float*)(C.ws + WS_ISV), 2 * 16384, gw, NGW, C.lane);
}
DI void rms_mod_row(const float* xrow, const float* gain, const float* shift, const float* scale, bf16* orow, int lane) {
    const f32x4* xr = (const f32x4*)xrow + lane; f32x4 v[4]; float s = 0.f;
#pragma unroll
    for (int j = 0; j < 4; ++j) { v[j] = xr[64 * j]; s += (v[j].x * v[j].x + v[j].y * v[j].y) + (v[j].z * v[j].z + v[j].w * v[j].w); }
    const float rstd = 1.0f / sqrtf(wave_sum(s) * (1.0f / 1024.0f) + EPS);
    uint2* o8 = (uint2*)orow + lane;
#pragma unroll
    for (int j = 0; j < 4; ++j) { const f32x4 g = ((const f32x4*)gain)[lane + 64 * j], sh = ((const f32x4*)shift)[lane + 64 * j], sc = ((const f32x4*)scale)[lane + 64 * j];
        const f32x4 y = v[j] * rstd * g * (sc + 1.0f) + sh; uint2 o; o.x = pk2(y.x, y.y); o.y = pk2(y.z, y.w); o8[64 * j] = o; }
}
DI void rms_mod_phase(const Ctx& C, const float* x, const float* gain, const float* mod_l, int sh_off, int sc_off, bf16* H) {
    const int gw = C.vcu * NWAVES + C.wave, NGW = C.G * NWAVES;
    for (int m = gw; m < TT; m += NGW) { const float* ml = mod_l + (size_t)(m >> 13) * 6144; rms_mod_row(x + (size_t)m * DM, gain, ml + sh_off, ml + sc_off, H + (size_t)m * DM, C.lane); }
}

DI void scan_naive(const Ctx& C, const bf16* Q, const bf16* K, const bf16* V, bf16* CROSS) {
    LAS float* Sst = (LAS float*)(C.lds);
    LAS unsigned* Qs = (LAS unsigned*)(C.lds + 16384);
    LAS bf16* Ks = (LAS bf16*)(C.lds + 16384 + 32768);
    LAS float* Vs = (LAS float*)(C.lds + 16384 + 65536);
    const int tid = C.tid;
    for (int item = C.vcu; item < 256; item += C.G) {
        const int b = item >> 7, h = (item >> 5) & 3, es = item & 31;
        const float lg2 = log2f(1.0f - exp2f(-5.0f - (float)h)); const float gc = exp2f(lg2 * 64.0f);
        for (int i = tid; i < 4096; i += 512) Sst[i] = 0.f;
        __syncthreads();
        for (int n = 0; n < 128; ++n) {
            const size_t tok0 = (size_t)b * SEQ + (size_t)n * 64;
            for (int ch = tid; ch < 2048; ch += 512) { const int r = ch >> 5, c = ch & 31;
                const u32x4 q = *(const u32x4*)(Q + (tok0 + r) * 1024 + h * 256 + c * 8); *(LAS u32x4*)(Qs + r * 128 + c * 4) = q;
                const u32x4 k = *(const u32x4*)(K + (tok0 + r) * 1024 + h * 256 + c * 8); *(LAS u32x4*)((LAS unsigned*)Ks + r * 128 + c * 4) = k; }
            for (int o = tid; o < 1024; o += 512) { const int j = o >> 4, e = o & 15; Vs[o] = bf2f(V[(tok0 + j) * 2048 + h * 512 + es * 16 + e]) * exp2f(lg2 * (float)(63 - j)); }
            __syncthreads();
#pragma unroll
            for (int oo = 0; oo < 2; ++oo) { const int o = tid + oo * 512, i = o >> 4, e = o & 15; float acc = 0.f;
#pragma unroll 8
                for (int d2 = 0; d2 < 128; ++d2) { const unsigned q2 = Qs[i * 128 + d2]; acc += bflo(q2) * Sst[(2 * d2) * 16 + e] + bfhi(q2) * Sst[(2 * d2 + 1) * 16 + e]; }
                CROSS[(tok0 + i) * 2048 + h * 512 + es * 16 + e] = (bf16)f2bf(acc * exp2f(lg2 * (float)(i + 1))); }
            __syncthreads();
            { const int e = tid & 15, dg = tid >> 4; float a[8];
#pragma unroll
              for (int r = 0; r < 8; ++r) a[r] = gc * Sst[(dg + 32 * r) * 16 + e];
#pragma unroll 4
              for (int j = 0; j < 64; ++j) { const float vz = Vs[j * 16 + e];
#pragma unroll
                  for (int r = 0; r < 8; ++r) a[r] += bf2f(Ks[j * 256 + dg + 32 * r]) * vz; }
#pragma unroll
              for (int r = 0; r < 8; ++r) Sst[(dg + 32 * r) * 16 + e] = a[r]; }
            __syncthreads();
        }
    }
}
DI void intra_naive(const Ctx& C, const bf16* Q, const bf16* K, const bf16* V, const bf16* CROSS, bf16* G) {
    LAS unsigned* Qs = (LAS unsigned*)(C.lds);
    LAS unsigned* Ks = (LAS unsigned*)(C.lds + 32768);
    LAS float* SC = (LAS float*)(C.lds + 65536);
    LAS float* red = (LAS float*)(C.lds + 65536 + 16384);
    LAS float* rs = red + 512;
    const int tid = C.tid;
    for (int item = C.vcu; item < 1024; item += C.G) {
        const int b = item >> 9, h = (item >> 7) & 3, n = item & 127;
        const float lg2 = log2f(1.0f - exp2f(-5.0f - (float)h));
        const size_t tok0 = (size_t)b * SEQ + (size_t)n * 64;
        for (int ch = tid; ch < 2048; ch += 512) { const int r = ch >> 5, c = ch & 31;
            *(LAS u32x4*)(Qs + r * 128 + c * 4) = *(const u32x4*)(Q + (tok0 + r) * 1024 + h * 256 + c * 8);
            *(LAS u32x4*)(Ks + r * 128 + c * 4) = *(const u32x4*)(K + (tok0 + r) * 1024 + h * 256 + c * 8); }
        __syncthreads();
        { const int i = tid >> 3, jb = (tid & 7) * 8;
#pragma unroll
          for (int jj = 0; jj < 8; ++jj) { const int j = jb + jj; float acc = 0.f;
#pragma unroll 8
              for (int d2 = 0; d2 < 128; ++d2) { const unsigned q2 = Qs[i * 128 + d2], k2 = Ks[j * 128 + d2]; acc += bflo(q2) * bflo(k2) + bfhi(q2) * bfhi(k2); }
              const int dd = i > j ? i - j : j - i; SC[i * 64 + j] = acc * exp2f(lg2 * (float)dd); } }
        __syncthreads();
#pragma unroll 1
        for (int pass = 0; pass < 2; ++pass) { const int e = tid, ib = pass * 32; float y[32];
#pragma unroll
          for (int i = 0; i < 32; ++i) y[i] = 0.f;
          const bf16* vp = V + tok0 * 2048 + h * 512 + e;
#pragma unroll 1
          for (int j4 = 0; j4 < 16; ++j4) {
              const float v0 = bf2f(vp[(size_t)(4 * j4 + 0) * 2048]), v1 = bf2f(vp[(size_t)(4 * j4 + 1) * 2048]), v2 = bf2f(vp[(size_t)(4 * j4 + 2) * 2048]), v3 = bf2f(vp[(size_t)(4 * j4 + 3) * 2048]);
#pragma unroll
              for (int i = 0; i < 32; ++i) { const f32x4 s4 = *(const LAS f32x4*)(SC + (ib + i) * 64 + 4 * j4); y[i] += (s4.x * v0 + s4.y * v1) + (s4.z * v2 + s4.w * v3); }
          }
          const bf16* cp = CROSS + (tok0 + ib) * 2048 + h * 512 + e;
#pragma unroll
          for (int i = 0; i < 32; ++i) { y[i] += bf2f(cp[(size_t)i * 2048]); const float ss = wave_sum(y[i] * y[i]); if (C.lane == 0) red[C.wave * 64 + i] = ss; }
          __syncthreads();
          if (tid < 32) { float s = 0.f;
#pragma unroll
              for (int w = 0; w < 8; ++w) s += red[w * 64 + tid];
              rs[tid] = 1.0f / sqrtf(s * (1.0f / 512.0f) + EPS); }
          __syncthreads();
          bf16* gp = G + (tok0 + ib) * 2048 + h * 512 + e;
#pragma unroll
          for (int i = 0; i < 32; ++i) { const float g = bf2f(gp[(size_t)i * 2048]); gp[(size_t)i * 2048] = (bf16)f2bf(y[i] * rs[i] * g); }
          __syncthreads();
        }
        __syncthreads();
    }
}
DI void peer_scores(const Ctx& C, const bf16* QP, const bf16* KEYS  , float* SCO) {
    const int gw = C.vcu * NWAVES + C.wave, NGW = C.G * NWAVES; const int fr = C.lane & 15, fq = C.lane >> 4;
    for (int it = gw; it < 1024 * 8; it += NGW) {
        const int tt = it >> 3, h = it & 7; const int tok = tt * 16 + fr;
#pragma unroll
        for (int p = 0; p < 2; ++p) {
            bf16x8 qf[4];
#pragma unroll
            for (int ks = 0; ks < 4; ++ks) qf[ks] = *(const bf16x8*)(QP + (size_t)tok * 2048 + h * 256 + p * 128 + ks * 32 + fq * 8);
            const bf16* kb = KEYS + (size_t)(h * 2 + p) * 128 * 128;
#pragma unroll
            for (int kt = 0; kt < 8; ++kt) {
                f32x4 acc = {0.f, 0.f, 0.f, 0.f};
#pragma unroll
                for (int ks = 0; ks < 4; ++ks) { const bf16x8 kf = *(const bf16x8*)(kb + (size_t)(kt * 16 + fr) * 128 + ks * 32 + fq * 8);
                    acc = __builtin_amdgcn_mfma_f32_16x16x32_bf16(kf, qf[ks], acc, 0, 0, 0); }
                *(f32x4*)(SCO + ((size_t)tok * 8 + h) * 256 + p * 128 + kt * 16 + fq * 4) = acc;
            }
        }
    }
}
template <bool HALVES> DI void select16(const float (&v)[4], int lane, bool (&sel)[4], int (&pos)[4]) {
    float mx = fmaxf(fmaxf(v[0], v[1]), fmaxf(v[2], v[3])), mn = fminf(fminf(v[0], v[1]), fminf(v[2], v[3]));
#pragma unroll
    for (int o = 1; o < (HALVES ? 32 : 64); o <<= 1) { mx = fmaxf(mx, __shfl_xor(mx, o)); mn = fminf(mn, __shfl_xor(mn, o)); }
    const bool up = HALVES && lane >= 32;
    float lo = mn, hi = mx, thr = mn; bool done = false;
    for (int iter = 0; iter < 48; ++iter) {
        const float mid = done ? thr : 0.5f * (lo + hi);
        int cnt = 0;
#pragma unroll
        for (int c = 0; c < 4; ++c) { const unsigned long long m = __ballot(v[c] >= mid);
            cnt += HALVES ? (up ? __popc((unsigned)(m >> 32)) : __popc((unsigned)m)) : __popcll(m); }
        if (!done) { if (cnt == 16) { thr = mid; done = true; } else if (cnt > 16) { lo = mid; thr = mid; } else hi = mid; }
        if (__all(done)) break;
    }
    int base = 0;
#pragma unroll
    for (int c = 0; c < 4; ++c) { sel[c] = v[c] >= thr; const unsigned long long m = __ballot(sel[c]);
        const unsigned long long gm = HALVES ? (up ? (m >> 32) : (m & 0xffffffffull)) : m; const int ll = HALVES ? (lane & 31) : lane;
        pos[c] = base + __popcll(gm & ((1ull << ll) - 1ull)); base += __popcll(gm); sel[c] = sel[c] && pos[c] < 16; }
}
DI void peer_topk(const Ctx& C, const float* SCO, int* IDX, float* GATE) {
    LAS float* sv = (LAS float*)(C.lds + C.wave * 512);
    LAS int* si = (LAS int*)(C.lds + C.wave * 512 + 128);
    LAS float* fv = (LAS float*)(C.lds + C.wave * 512 + 256);
    LAS int* fi = (LAS int*)(C.lds + C.wave * 512 + 320);
    const int gw = C.vcu * NWAVES + C.wave, NGW = C.G * NWAVES, lane = C.lane;
    for (int it = gw; it < TT * 8; it += NGW) {
        const f32x4 s4 = *(const f32x4*)(SCO + (size_t)it * 256 + lane * 4);
        float v[4] = {s4.x, s4.y, s4.z, s4.w}; bool sel[4]; int pos[4];
        select16<true>(v, lane, sel, pos);
        const int p = lane >> 5;
#pragma unroll
        for (int c = 0; c < 4; ++c) if (sel[c]) { sv[p * 16 + pos[c]] = v[c]; si[p * 16 + pos[c]] = (lane & 31) * 4 + c; }
        LDS_WAIT();
        const int a = lane >> 2, bq = (lane & 3) * 4; const float va = sv[a]; const int ia = si[a];
        float w[4]; int wi[4];
#pragma unroll
        for (int c = 0; c < 4; ++c) { w[c] = va + sv[16 + bq + c]; wi[c] = ia * 128 + si[16 + bq + c]; }
        select16<false>(w, lane, sel, pos);
#pragma unroll
        for (int c = 0; c < 4; ++c) if (sel[c]) { fv[pos[c]] = w[c]; fi[pos[c]] = wi[c]; }
        LDS_WAIT();
        const float x = fv[lane & 15]; const int xi = fi[lane & 15];
        float m = x;
#pragma unroll
        for (int o = 1; o < 16; o <<= 1) m = fmaxf(m, __shfl_xor(m, o));
        const float e = __expf(x - m); float s = e;
#pragma unroll
        for (int o = 1; o < 16; o <<= 1) s += __shfl_xor(s, o);
        if (lane < 16) { IDX[(size_t)it * 16 + lane] = xi; GATE[(size_t)it * 16 + lane] = e / s; }
        LDS_WAIT();
    }
}
template <bool FINAL> DI void peer_gather(const Ctx& C, const bf16* H, const int* IDX, const float* GATE, const bf16* PU, const bf16* PV, float* X, const float* g2  ,
                                          const float* ngain, const float* nmod  , bf16* Hn) {
    const int gw = C.vcu * NWAVES + C.wave, NGW = C.G * NWAVES, lane = C.lane;
    for (int t = gw; t < TT; t += NGW) {
        float hv[16];
        { const u32x4 a = *(const u32x4*)(H + (size_t)t * 1024 + lane * 8), bq = *(const u32x4*)(H + (size_t)t * 1024 + 512 + lane * 8);
          hv[0] = bflo(a.x); hv[1] = bfhi(a.x); hv[2] = bflo(a.y); hv[3] = bfhi(a.y); hv[4] = bflo(a.z); hv[5] = bfhi(a.z); hv[6] = bflo(a.w); hv[7] = bfhi(a.w);
          hv[8] = bflo(bq.x); hv[9] = bfhi(bq.x); hv[10] = bflo(bq.y); hv[11] = bfhi(bq.y); hv[12] = bflo(bq.z); hv[13] = bfhi(bq.z); hv[14] = bflo(bq.w); hv[15] = bfhi(bq.w); }
        const int i0 = IDX[(size_t)t * 128 + lane], i1 = IDX[(size_t)t * 128 + 64 + lane];
        const float g0 = GATE[(size_t)t * 128 + lane], g1 = GATE[(size_t)t * 128 + 64 + lane];
        float a0 = 0.f, a1 = 0.f;
        for (int k = 0; k < 128; k += 4) {
            float dsum[4];
#pragma unroll
            for (int kk = 0; kk < 4; ++kk) { const int kq = k + kk; const int e = kq < 64 ? __builtin_amdgcn_readlane(i0, kq) : __builtin_amdgcn_readlane(i1, kq - 64);
                const bf16* ur = PU + (size_t)e * 1024; const u32x4 a = *(const u32x4*)(ur + lane * 8), bq = *(const u32x4*)(ur + 512 + lane * 8);
                float d = bflo(a.x) * hv[0] + bfhi(a.x) * hv[1]; d += bflo(a.y) * hv[2] + bfhi(a.y) * hv[3]; d += bflo(a.z) * hv[4] + bfhi(a.z) * hv[5]; d += bflo(a.w) * hv[6] + bfhi(a.w) * hv[7];
                d += bflo(bq.x) * hv[8] + bfhi(bq.x) * hv[9]; d += bflo(bq.y) * hv[10] + bfhi(bq.y) * hv[11]; d += bflo(bq.z) * hv[12] + bfhi(bq.z) * hv[13]; d += bflo(bq.w) * hv[14] + bfhi(bq.w) * hv[15];
                dsum[kk] = d; }
#pragma unroll
            for (int kk = 0; kk < 4; ++kk) { const int kq = k + kk; const float d = gelu_t(wave_sum(dsum[kk]));
                if (kq < 64) { if (lane == kq) a0 = d * g0; } else { if (lane == kq - 64) a1 = d * g1; } }
        }
        float o[16];
#pragma unroll
        for (int j = 0; j < 16; ++j) o[j] = 0.f;
        for (int k = 0; k < 128; k += 4) {
#pragma unroll
            for (int kk = 0; kk < 4; ++kk) { const int kq = k + kk; const int e = kq < 64 ? __builtin_amdgcn_readlane(i0, kq) : __builtin_amdgcn_readlane(i1, kq - 64);
                const float ak = __int_as_float(kq < 64 ? __builtin_amdgcn_readlane(__float_as_int(a0), kq) : __builtin_amdgcn_readlane(__float_as_int(a1), kq - 64));
                const bf16* vr = PV + (size_t)e * 1024; const u32x4 a = *(const u32x4*)(vr + lane * 8), bq = *(const u32x4*)(vr + 512 + lane * 8);
                o[0] += ak * bflo(a.x); o[1] += ak * bfhi(a.x); o[2] += ak * bflo(a.y); o[3] += ak * bfhi(a.y); o[4] += ak * bflo(a.z); o[5] += ak * bfhi(a.z); o[6] += ak * bflo(a.w); o[7] += ak * bfhi(a.w);
                o[8] += ak * bflo(bq.x); o[9] += ak * bfhi(bq.x); o[10] += ak * bflo(bq.y); o[11] += ak * bfhi(bq.y); o[12] += ak * bflo(bq.z); o[13] += ak * bfhi(bq.z); o[14] += ak * bflo(bq.w); o[15] += ak * bfhi(bq.w); }
        }
#ifdef DBG_ZERO_PEER
#pragma unroll
        for (int j = 0; j < 16; ++j) o[j] = 0.f;
#endif
        const int b = t >> 13; const float* gp = g2 + (size_t)b * 6144; float* xr = X + (size_t)t * 1024;
        float xn[16]; float ss = 0.f;
#pragma unroll
        for (int q = 0; q < 4; ++q) { const int col = (q >> 1) * 512 + lane * 8 + (q & 1) * 4; const f32x4 xv = *(const f32x4*)(xr + col), gv = *(const f32x4*)(gp + col);
#pragma unroll
            for (int j = 0; j < 4; ++j) { const float y = xv[j] + gv[j] * o[q * 4 + j]; xn[q * 4 + j] = y; ss += y * y; } }
        const float rstd = 1.0f / sqrtf(wave_sum(ss) * (1.0f / 1024.0f) + EPS);
        if (FINAL) {
#pragma unroll
            for (int q = 0; q < 4; ++q) { const int col = (q >> 1) * 512 + lane * 8 + (q & 1) * 4; const f32x4 gn = *(const f32x4*)(ngain + col); f32x4 y;
#pragma unroll
                for (int j = 0; j < 4; ++j) y[j] = xn[q * 4 + j] * rstd * gn[j];
                *(f32x4*)(xr + col) = y; }
        } else {
            const float* nm = nmod + (size_t)b * 6144;
#pragma unroll
            for (int q = 0; q < 4; ++q) { const int col = (q >> 1) * 512 + lane * 8 + (q & 1) * 4; const f32x4 gn = *(const f32x4*)(ngain + col), sh = *(const f32x4*)(nm + col), sc = *(const f32x4*)(nm + 1024 + col); f32x4 xo; float y[4];
#pragma unroll
                for (int j = 0; j < 4; ++j) { xo[j] = xn[q * 4 + j]; y[j] = xn[q * 4 + j] * rstd * gn[j] * (1.0f + sc[j]) + sh[j]; }
                *(f32x4*)(xr + col) = xo; uint2 w; w.x = pk2(y[0], y[1]); w.y = pk2(y[2], y[3]); *(uint2*)(Hn + (size_t)t * 1024 + col) = w; }
        }
    }
}
DI void sgu_gate_naive(const Ctx& C, bf16* U, const bf16* VB, const float* stats, const float* w_s, const float* b_s, const float* ln_g, const float* ln_b) {
    LAS float* Wm = (LAS float*)(C.lds);
    LAS float* mu = (LAS float*)(C.lds + 65536);
    LAS float* rsd = mu + 128;
    const int tid = C.tid;
    for (int item = C.vcu; item < 1024; item += C.G) {
        const int n = item >> 3, g = item & 7; const size_t row0 = (size_t)n * 128;
        for (int i = tid; i < 16384; i += 512) { const int r = i >> 7, c = i & 127; const float w = w_s[(size_t)g * 16384 + i]; Wm[i] = (r < 64 && c >= 64) ? 0.f : w; }
        if (tid < 128) { const float* sp = stats + (row0 + tid) * 96; float s1 = 0.f, s2 = 0.f;
            for (int q = 0; q < 48; ++q) { s1 += sp[2 * q]; s2 += sp[2 * q + 1]; }
            const float m = s1 * (1.0f / 3072.0f); const float var = s2 * (1.0f / 3072.0f) - m * m; mu[tid] = m; rsd[tid] = 1.0f / sqrtf(fmaxf(var, 0.f) + EPS); }
        __syncthreads();
        if (tid < 384) {
            const int col = g * 384 + tid; const float lg = ln_g[col], lb = ln_b[col];
#pragma unroll
            for (int pass = 0; pass < 2; ++pass) {
                float acc[64];
#pragma unroll
                for (int i = 0; i < 64; ++i) acc[i] = 0.f;
                const int jmax = pass == 0 ? 64 : 128;
                for (int j = 0; j < jmax; ++j) { const float v = bf2f(VB[(row0 + j) * 3072 + col]); const float vl = (v - mu[j]) * rsd[j] * lg + lb;
#pragma unroll
                    for (int i = 0; i < 64; ++i) acc[i] += Wm[(pass * 64 + i) * 128 + j] * vl; }
#pragma unroll
                for (int i = 0; i < 64; ++i) { const int r = pass * 64 + i; const float s = acc[i] + b_s[g * 128 + r]; bf16* up = U + (row0 + r) * 3072 + col; *up = (bf16)f2bf(bf2f(*up) * s); }
            }
        }
        __syncthreads();
    }
}
typedef short v4i16_t __attribute__((ext_vector_type(4)));
typedef unsigned u32x2_t __attribute__((ext_vector_type(2)));
typedef __bf16 bf16x2_t __attribute__((ext_vector_type(2)));
DI unsigned cvtpk(float lo, float hi) { f32x2_t v = {lo, hi}; bf16x2_t b = __builtin_convertvector(v, bf16x2_t); return __builtin_bit_cast(unsigned, b); }
DI v4i16_t trr(const LAS unsigned char* p) { return __builtin_amdgcn_ds_read_tr16_b64_v4i16((LAS v4i16_t*)p); }
DI bf16x8 cat8(v4i16_t a, v4i16_t b) { return __builtin_shufflevector(a, b, 0, 1, 2, 3, 4, 5, 6, 7); }
DI bf16x8 pack2(const f32x4& a, const f32x4& b) { u32x4 p; p.x = cvtpk(a[0], a[1]); p.y = cvtpk(a[2], a[3]); p.z = cvtpk(b[0], b[1]); p.w = cvtpk(b[2], b[3]); return __builtin_bit_cast(bf16x8, p); }
DI u32x4 scale8(u32x4 v, float s) { u32x4 o; o.x = cvtpk(bflo(v.x) * s, bfhi(v.x) * s); o.y = cvtpk(bflo(v.y) * s, bfhi(v.y) * s); o.z = cvtpk(bflo(v.z) * s, bfhi(v.z) * s); o.w = cvtpk(bflo(v.w) * s, bfhi(v.w) * s); return o; }
#ifndef SCAN_QPI
#define SCAN_QPI 544
#endif
#ifndef SCAN_KPI
#define SCAN_KPI 544
#endif
#ifndef SCAN_PFD
#define SCAN_PFD 5
#endif
constexpr int SCAN_ESL = 32, SCAN_NCW = SCAN_ESL / 16, SCAN_NSL = 512 / SCAN_ESL, SCAN_NIT = 8 * SCAN_NSL;
#define SCAN_BAR() do { asm volatile("s_waitcnt lgkmcnt(0)" ::: "memory"); __builtin_amdgcn_s_barrier(); asm volatile("" ::: "memory"); } while (0)
template <int MODE = 0> DI void scan_mfma(const Ctx& C, const bf16* Q, const bf16* K, const bf16* V, bf16* CROSS) {
    constexpr int QPI = SCAN_QPI, KPI = SCAN_KPI, VPI = SCAN_ESL * 2 + 32, VCH = SCAN_ESL / 8  , NVC = 64 * VCH;
    constexpr int OQ = 0, OK_ = 64 * QPI, OV = OK_ + 64 * KPI, BUFB = OV + 64 * VPI;
    constexpr int NST = (NWAVES - 1 - SCAN_NCW) * 64;
    const int w = C.wave;
    for (int item = C.vcu; item < SCAN_NIT; item += C.G) {
        const int b = item / (4 * SCAN_NSL), h = (item / SCAN_NSL) & 3, es = item % SCAN_NSL;
        const float lg2 = log2f(1.0f - exp2f(-5.0f - (float)h)); const float gc = exp2f(lg2 * 64.0f);
        const size_t tokb = (size_t)b * SEQ;
        if (w >= SCAN_NCW) {
            int tl_ = C.tid; asm volatile("" : "+v"(tl_));
            const int st = (w == NWAVES - 1) ? (tl_ & 63) : tl_ - SCAN_NCW * 64;
            if (w == NWAVES - 1) {
                unsigned dmy = 0u;
#define SCAN_PF1(ptr) asm volatile("global_load_dword %0, %1, off" : "+v"(dmy) : "v"(ptr) : "memory")
#define SCAN_PF(n) do { const size_t t0_ = tokb + (size_t)(n) * 64; \
                if ((es & 3) == 0) { _Pragma("unroll") for (int u = 0; u < 4; ++u) { const int ln = st + 64 * u, r = ln >> 2, q = ln & 3; SCAN_PF1(Q + (t0_ + r) * 1024 + h * 256 + q * 64); SCAN_PF1(K + (t0_ + r) * 1024 + h * 256 + q * 64); } } \
                SCAN_PF1(V + (t0_ + st) * 2048 + h * 512 + es * SCAN_ESL); } while (0)
#ifndef SCAN_NOPF
                SCAN_PF(3); SCAN_PF(4);
#endif
                SCAN_BAR();
#pragma unroll 1
                for (int n = 0; n < 128; ++n) {
#ifndef SCAN_NOPF
                    if (n + SCAN_PFD < 128) SCAN_PF(n + SCAN_PFD);
#endif
                    SCAN_BAR(); }
                asm volatile("s_waitcnt vmcnt(0)" : "+v"(dmy) :: "memory");
#undef SCAN_PF
#undef SCAN_PF1
            } else {
            u32x4 rqA[7], rkA[7], rvA, rqB[7], rkB[7], rvB;
            const unsigned qo_ = (unsigned)((st >> 5) * 2048 + (st & 31) * 16), qo6_ = (st + NST * 6 < 2048) ? qo_ + (unsigned)(6 * (NST / 32) * 2048) : qo_;
            const unsigned vo_ = (st < NVC) ? (unsigned)((st / VCH) * 4096 + (st % VCH) * 16) : 0u;
#define SCAN_LD(RQ, RK, RV, n) do { const size_t t0_ = tokb + (size_t)((n) < 127 ? (n) : 127) * 64; \
            const unsigned char* qb_ = (const unsigned char*)(Q + t0_ * 1024 + h * 256); const unsigned char* kb_ = (const unsigned char*)(K + t0_ * 1024 + h * 256); \
            const unsigned char* vb_ = (const unsigned char*)(V + t0_ * 2048 + h * 512 + es * SCAN_ESL); \
            _Pragma("unroll") for (int u = 0; u < 7; ++u) { const unsigned o_ = u == 6 ? qo6_ : qo_ + (unsigned)(u * (NST / 32) * 2048); \
                RQ[u] = *(const u32x4*)(qb_ + o_); RK[u] = *(const u32x4*)(kb_ + o_); } \
            RV = *(const u32x4*)(vb_ + vo_); } while (0)
#define SCAN_WR(RQ, RK, RV, bufo) do { LAS unsigned char* B_ = C.lds + (bufo); \
            _Pragma("unroll") for (int u = 0; u < 7; ++u) { const int c = st + NST * u; if (c < 2048) { const int r = c >> 5, cc = c & 31; \
                *(LAS u32x4*)(B_ + OQ + r * QPI + cc * 16) = RQ[u]; *(LAS u32x4*)(B_ + OK_ + r * KPI + cc * 16) = RK[u]; } } \
            if (st < NVC) { const int r = st / VCH, cc = st % VCH; *(LAS u32x4*)(B_ + OV + r * VPI + cc * 16) = scale8(RV, exp2f(lg2 * (float)(63 - r))); } } while (0)
            SCAN_LD(rqA, rkA, rvA, 0); SCAN_WR(rqA, rkA, rvA, 0); SCAN_LD(rqA, rkA, rvA, 1); SCAN_LD(rqB, rkB, rvB, 2);
            SCAN_BAR();
#pragma unroll 1
            for (int n = 0; n < 128; n += 2) {
                if (MODE != 2) { SCAN_WR(rqA, rkA, rvA, BUFB); SCAN_LD(rqA, rkA, rvA, n + 3); }
                SCAN_BAR();
                if (MODE != 2) { SCAN_WR(rqB, rkB, rvB, 0); SCAN_LD(rqB, rkB, rvB, n + 4); }
                SCAN_BAR();
            }
#undef SCAN_LD
#undef SCAN_WR
            }
        } else {
            int tl_ = C.tid; asm volatile("" : "+v"(tl_)); const int lane = tl_ & 63, fr = lane & 15, fq = lane >> 4;
            f32x4 S[16];
#pragma unroll
            for (int t = 0; t < 16; ++t) S[t] = (f32x4){0.f, 0.f, 0.f, 0.f};
            SCAN_BAR();
#define SC_LQ(QF, DB) do { _Pragma("unroll") for (int m = 0; m < 4; ++m) QF[m] = *(const LAS bf16x8*)(Qs + (16 * m + fr) * QPI + (32 * (DB) + 8 * fq) * 2); __builtin_amdgcn_sched_barrier(0); } while (0)
#define SC_MQ(QF, DB) do { const bf16x8 sa0 = pack2(S[2 * (DB)], S[2 * (DB) + 1]); \
            _Pragma("unroll") for (int m = 0; m < 4; ++m) acc[m] = __builtin_amdgcn_mfma_f32_16x16x32_bf16(sa0, QF[m], acc[m], 0, 0, 0); __builtin_amdgcn_sched_barrier(0); } while (0)
#define SC_LK(KF, KS, TQ) do { const LAS unsigned char* kp = Ks + (32 * (KS) + 4 * fq + (fr >> 2)) * KPI + (8 * (fr & 3)) * 2;     \
            _Pragma("unroll") for (int t4 = 0; t4 < 4; ++t4) { const int t = 4 * (TQ) + t4; KF[t4] = cat8(trr(kp + 64 * (t >> 1) + 8 * (t & 1)), trr(kp + 64 * (t >> 1) + 8 * (t & 1) + 16 * KPI)); } __builtin_amdgcn_sched_barrier(0); } while (0)
#define SC_LV(VF, KS) do { const LAS unsigned char* vp = Vs + (32 * (KS) + 4 * fq + (fr >> 2)) * VPI + (16 * w + 4 * (fr & 3)) * 2; VF = cat8(trr(vp), trr(vp + 16 * VPI)); } while (0)
#define SC_MK(KF, VF, TQ) do { _Pragma("unroll") for (int t4 = 0; t4 < 4; ++t4) S[4 * (TQ) + t4] = __builtin_amdgcn_mfma_f32_16x16x32_bf16(KF[t4], VF, S[4 * (TQ) + t4], 0, 0, 0); __builtin_amdgcn_sched_barrier(0); } while (0)
#define SCAN_CHUNK(n_, BO) do { const size_t tok0 = tokb + (size_t)(n_) * 64; LAS unsigned char* Qs = C.lds + (BO) + OQ; LAS unsigned char* Ks = C.lds + (BO) + OK_; LAS unsigned char* Vs = C.lds + (BO) + OV; \
                f32x4 acc[4]; bf16x8 fA[4], fB[4], kA[4], kB[4], vf0, vf1; \
                _Pragma("unroll") for (int m = 0; m < 4; ++m) acc[m] = (f32x4){0.f, 0.f, 0.f, 0.f}; \
                SC_LQ(fA, 0); SC_LQ(fB, 1); SC_MQ(fA, 0); SC_LQ(fA, 2); SC_MQ(fB, 1); SC_LQ(fB, 3); SC_MQ(fA, 2); SC_LQ(fA, 4); SC_MQ(fB, 3); SC_LQ(fB, 5); SC_MQ(fA, 4); SC_LQ(fA, 6); SC_MQ(fB, 5); SC_LQ(fB, 7); SC_MQ(fA, 6); SC_LV(vf0, 0); SC_LV(vf1, 1); SC_LK(kA, 0, 0); SC_MQ(fB, 7); \
                _Pragma("unroll") for (int m = 0; m < 4; ++m) { const f32x4 v = acc[m] * exp2f(lg2 * (float)(16 * m + fr + 1)); uint2 o; o.x = cvtpk(v[0], v[1]); o.y = cvtpk(v[2], v[3]); \
                    *(uint2*)(CROSS + (tok0 + 16 * m + fr) * 2048 + h * 512 + es * SCAN_ESL + 16 * w + 4 * fq) = o; } \
                _Pragma("unroll") for (int t = 0; t < 16; ++t) S[t] = S[t] * gc; \
                __builtin_amdgcn_sched_barrier(0); \
                SC_LK(kB, 0, 1); SC_MK(kA, vf0, 0); SC_LK(kA, 0, 2); SC_MK(kB, vf0, 1); SC_LK(kB, 0, 3); SC_MK(kA, vf0, 2); SC_LK(kA, 1, 0); SC_MK(kB, vf0, 3); SC_LK(kB, 1, 1); SC_MK(kA, vf1, 0); SC_LK(kA, 1, 2); SC_MK(kB, vf1, 1); SC_LK(kB, 1, 3); SC_MK(kA, vf1, 2); SC_MK(kB, vf1, 3); \
                SCAN_BAR(); } while (0)
#pragma unroll 1
            for (int n = 0; n < 128; n += 2) { if (MODE == 1) { SCAN_BAR(); SCAN_BAR(); } else { SCAN_CHUNK(n, 0); SCAN_CHUNK(n + 1, BUFB); } }
#undef SCAN_CHUNK
#undef SC_LQ
#undef SC_MQ
#undef SC_LK
#undef SC_LV
#undef SC_MK
        }
    }
}
#undef SCAN_BAR
DI void sgu_gate_mfma(const Ctx& C, bf16* U, const bf16* VB, const float* stats, const float* w_s, const float* b_s, const float* ln_g, const float* ln_b) {
    constexpr int WPI = 272, VPI = 288;
    LAS unsigned char* Ws = C.lds; LAS unsigned char* Vs = C.lds + 128 * WPI;
    LAS float* mu = (LAS float*)(C.lds + 128 * WPI + 128 * VPI); LAS float* rsd = mu + 128; LAS float* r1 = mu + 256; LAS float* r2 = mu + 384; LAS float* bsl = mu + 512;
    const int tid = C.tid, lane = C.lane, w = C.wave, fr = lane & 15, fq = lane >> 4;
    for (int item = C.vcu; item < 1024; item += C.G) {
        const int n = item >> 3, g = item & 7; const size_t row0 = (size_t)n * 128;
        if (tid < 128) { const float* sp = stats + (row0 + tid) * 96; float s1 = 0.f, s2 = 0.f;
#pragma unroll 8
            for (int q = 0; q < 48; ++q) { s1 += sp[2 * q]; s2 += sp[2 * q + 1]; }
            const float m = s1 * (1.0f / 3072.0f); const float var = s2 * (1.0f / 3072.0f) - m * m; mu[tid] = m; rsd[tid] = 1.0f / sqrtf(fmaxf(var, 0.f) + EPS); bsl[tid] = b_s[g * 128 + tid]; }
        __syncthreads();
        { const int i = tid >> 2, jq = tid & 3; const float* wp = w_s + (size_t)g * 16384 + i * 128 + jq * 32; float a1 = 0.f, a2 = 0.f;
#pragma unroll
          for (int c8 = 0; c8 < 4; ++c8) { const f32x4 wa = *(const f32x4*)(wp + c8 * 8), wb = *(const f32x4*)(wp + c8 * 8 + 4); float wv[8] = {wa[0], wa[1], wa[2], wa[3], wb[0], wb[1], wb[2], wb[3]}; float o[8];
#pragma unroll
              for (int q = 0; q < 8; ++q) { const int j = jq * 32 + c8 * 8 + q; const float wm = (i < 64 && j >= 64) ? 0.f : wv[q]; const float wr_ = wm * rsd[j]; o[q] = wr_; a1 += wr_ * mu[j]; a2 += wm; }
              u32x4 pk; pk.x = cvtpk(o[0], o[1]); pk.y = cvtpk(o[2], o[3]); pk.z = cvtpk(o[4], o[5]); pk.w = cvtpk(o[6], o[7]);
              *(LAS u32x4*)(Ws + i * WPI + (jq * 32 + c8 * 8) * 2) = pk; }
          a1 += __shfl_xor(a1, 1); a1 += __shfl_xor(a1, 2); a2 += __shfl_xor(a2, 1); a2 += __shfl_xor(a2, 2);
          if (jq == 0) { r1[i] = a1; r2[i] = a2; } }
#pragma unroll 1
        for (int cs = 0; cs < 3; ++cs) {
            const int colb = g * 384 + cs * 128;
#pragma unroll
            for (int u = 0; u < 4; ++u) { const int c = tid + 512 * u, r = c >> 4, cc = c & 15;
                *(LAS u32x4*)(Vs + r * VPI + cc * 16) = *(const u32x4*)(VB + (row0 + r) * 3072 + colb + cc * 8); }
            __syncthreads();
            f32x4 acc[8];
#pragma unroll
            for (int it = 0; it < 8; ++it) acc[it] = (f32x4){0.f, 0.f, 0.f, 0.f};
#pragma unroll
            for (int ks = 0; ks < 4; ++ks) {
                const LAS unsigned char* vp = Vs + (32 * ks + 4 * fq + (fr >> 2)) * VPI + (16 * w + 4 * (fr & 3)) * 2;
                const bf16x8 vf = cat8(trr(vp), trr(vp + 16 * VPI));
#pragma unroll
                for (int it = 0; it < 8; ++it) { if (it < 4 && ks >= 2) continue;
                    const LAS unsigned char* wp = Ws + (16 * it + fr) * WPI + (32 * ks + 4 * fq) * 2;
                    const u32x2_t lo = *(const LAS u32x2_t*)wp, hi = *(const LAS u32x2_t*)(wp + 32);
                    u32x4 ww; ww.x = lo.x; ww.y = lo.y; ww.z = hi.x; ww.w = hi.y;
                    acc[it] = __builtin_amdgcn_mfma_f32_16x16x32_bf16(vf, __builtin_bit_cast(bf16x8, ww), acc[it], 0, 0, 0); }
            }
            const int c0 = colb + 16 * w + 4 * fq;
            const f32x4 lg = *(const f32x4*)(ln_g + c0), lb = *(const f32x4*)(ln_b + c0);
#pragma unroll
            for (int it = 0; it < 8; ++it) { const int i = 16 * it + fr; const float q1 = r1[i], q2 = r2[i], bb = bsl[i];
                bf16* up = U + (row0 + i) * 3072 + c0; const u32x2_t uu = *(const u32x2_t*)up;
                const f32x4 s = lg * (acc[it] - q1) + lb * q2 + bb;
                u32x2_t o; o.x = cvtpk(bflo(uu.x) * s[0], bfhi(uu.x) * s[1]); o.y = cvtpk(bflo(uu.y) * s[2], bfhi(uu.y) * s[3]);
                *(u32x2_t*)up = o; }
            __syncthreads();
        }
    }
}
DI void up8(unsigned wd, float& a, float& b, float& c, float& d) { const f32x2_t lo = __builtin_amdgcn_cvt_pk_f32_fp8((int)wd, false), hi = __builtin_amdgcn_cvt_pk_f32_fp8((int)wd, true); a = lo.x; b = lo.y; c = hi.x; d = hi.y; }
DI float dot16(const u32x4 u, const float (&hv)[16]) {
    float f[16];
    up8(u.x, f[0], f[1], f[2], f[3]); up8(u.y, f[4], f[5], f[6], f[7]); up8(u.z, f[8], f[9], f[10], f[11]); up8(u.w, f[12], f[13], f[14], f[15]);
    float d0 = f[0] * hv[0], d1 = f[1] * hv[1];
#pragma unroll
    for (int j = 2; j < 16; j += 2) { d0 += f[j] * hv[j]; d1 += f[j + 1] * hv[j + 1]; }
    return d0 + d1;
}
template <bool FINAL> DI void peer_gather8(const Ctx& C, const bf16* Hin, const int* IDX, const float* GATE, const unsigned char* PU8, const unsigned char* PV8, const float* ISU, const float* ISV,
                                           float* X, const float* g2, const float* ngain, const float* nmod, bf16* Hn) {
    const int gw = C.vcu * NWAVES + C.wave, NGW = C.G * NWAVES, lane = C.lane;
    LAS float* DL = (LAS float*)(C.lds + C.wave * 1024);
    LAS float* AL = DL + 128;
    for (int t = gw; t < TT; t += NGW) {
        float hv[16];
        { const u32x4 a = *(const u32x4*)(Hin + (size_t)t * 1024 + lane * 16), bq = *(const u32x4*)(Hin + (size_t)t * 1024 + lane * 16 + 8);
          hv[0] = bflo(a.x); hv[1] = bfhi(a.x); hv[2] = bflo(a.y); hv[3] = bfhi(a.y); hv[4] = bflo(a.z); hv[5] = bfhi(a.z); hv[6] = bflo(a.w); hv[7] = bfhi(a.w);
          hv[8] = bflo(bq.x); hv[9] = bfhi(bq.x); hv[10] = bflo(bq.y); hv[11] = bfhi(bq.y); hv[12] = bflo(bq.z); hv[13] = bfhi(bq.z); hv[14] = bflo(bq.w); hv[15] = bfhi(bq.w); }
        const int i0 = IDX[(size_t)t * 128 + lane], i1 = IDX[(size_t)t * 128 + 64 + lane];
        const float g0 = GATE[(size_t)t * 128 + lane], g1 = GATE[(size_t)t * 128 + 64 + lane];
        const float su0 = ISU[i0], su1 = ISU[i1], sv0 = ISV[i0], sv1 = ISV[i1];
        u32x4 ub[8];
#define PG_LOADU(k0) do { _Pragma("unroll") for (int j = 0; j < 8; ++j) { const int kq = (k0) + j; const int e = kq < 64 ? __builtin_amdgcn_readlane(i0, kq) : __builtin_amdgcn_readlane(i1, kq - 64); \
            ub[j] = *(const u32x4*)(PU8 + (size_t)e * 1024 + lane * 16); } } while (0)
        PG_LOADU(0);
#pragma unroll 1
        for (int k0 = 0; k0 < 128; k0 += 8) {
            float p[8];
#pragma unroll
            for (int j = 0; j < 8; ++j) p[j] = dot16(ub[j], hv);
            if (k0 + 8 < 128) PG_LOADU(k0 + 8);
            const bool h32 = lane & 32, h16 = lane & 16, h8 = lane & 8;
            float q4[4];
#pragma unroll
            for (int j = 0; j < 4; ++j) { const float keep = h32 ? p[j + 4] : p[j], send = h32 ? p[j] : p[j + 4]; q4[j] = keep + __shfl_xor(send, 32); }
            float q2[2];
#pragma unroll
            for (int j = 0; j < 2; ++j) { const float keep = h16 ? q4[j + 2] : q4[j], send = h16 ? q4[j] : q4[j + 2]; q2[j] = keep + __shfl_xor(send, 16); }
            float q1; { const float keep = h8 ? q2[1] : q2[0], send = h8 ? q2[0] : q2[1]; q1 = keep + __shfl_xor(send, 8); }
            q1 += __shfl_xor(q1, 4); q1 += __shfl_xor(q1, 2); q1 += __shfl_xor(q1, 1);
            if ((lane & 7) == 0) DL[k0 + ((lane >> 5) & 1) * 4 + ((lane >> 4) & 1) * 2 + ((lane >> 3) & 1)] = q1;
        }
#undef PG_LOADU
        LDS_WAIT();
        { const float d0 = DL[lane], d1 = DL[64 + lane]; AL[lane] = gelu_t(d0 * su0) * g0 * sv0; AL[64 + lane] = gelu_t(d1 * su1) * g1 * sv1; }
        LDS_WAIT();
        float o[16];
#pragma unroll
        for (int j = 0; j < 16; ++j) o[j] = 0.f;
        u32x4 vb[8];
#define PG_LOADV(k0) do { _Pragma("unroll") for (int j = 0; j < 8; ++j) { const int kq = (k0) + j; const int e = kq < 64 ? __builtin_amdgcn_readlane(i0, kq) : __builtin_amdgcn_readlane(i1, kq - 64); \
            vb[j] = *(const u32x4*)(PV8 + (size_t)e * 1024 + lane * 16); } } while (0)
        PG_LOADV(0);
#pragma unroll 1
        for (int k0 = 0; k0 < 128; k0 += 8) {
            float f[8][16];
#pragma unroll
            for (int j = 0; j < 8; ++j) { up8(vb[j].x, f[j][0], f[j][1], f[j][2], f[j][3]); up8(vb[j].y, f[j][4], f[j][5], f[j][6], f[j][7]); up8(vb[j].z, f[j][8], f[j][9], f[j][10], f[j][11]); up8(vb[j].w, f[j][12], f[j][13], f[j][14], f[j][15]); }
            if (k0 + 8 < 128) PG_LOADV(k0 + 8);
#pragma unroll
            for (int j = 0; j < 8; ++j) { const float ak = AL[k0 + j];
#pragma unroll
                for (int q = 0; q < 16; ++q) o[q] += ak * f[j][q]; }
        }
#undef PG_LOADV
        const int b = t >> 13; const float* gp = g2 + (size_t)b * 6144; float* xr = X + (size_t)t * 1024;
        float xn[16]; float ss = 0.f;
#pragma unroll
        for (int q = 0; q < 4; ++q) { const int col = lane * 16 + q * 4; const f32x4 xv = *(const f32x4*)(xr + col), gv = *(const f32x4*)(gp + col);
#pragma unroll
            for (int j = 0; j < 4; ++j) { const float y = xv[j] + gv[j] * o[q * 4 + j]; xn[q * 4 + j] = y; ss += y * y; } }
        const float rstd = 1.0f / sqrtf(wave_sum(ss) * (1.0f / 1024.0f) + EPS);
        if (FINAL) {
#pragma unroll
            for (int q = 0; q < 4; ++q) { const int col = lane * 16 + q * 4; const f32x4 gn = *(const f32x4*)(ngain + col); f32x4 y;
#pragma unroll
                for (int j = 0; j < 4; ++j) y[j] = xn[q * 4 + j] * rstd * gn[j];
                *(f32x4*)(xr + col) = y; }
        } else {
            const float* nm = nmod + (size_t)b * 6144;
#pragma unroll
            for (int q = 0; q < 4; ++q) { const int col = lane * 16 + q * 4; const f32x4 gn = *(const f32x4*)(ngain + col), sh = *(const f32x4*)(nm + col), sc = *(const f32x4*)(nm + 1024 + col); f32x4 xo; float y[4];
#pragma unroll
                for (int j = 0; j < 4; ++j) { xo[j] = xn[q * 4 + j]; y[j] = xn[q * 4 + j] * rstd * gn[j] * (1.0f + sc[j]) + sh[j]; }
                *(f32x4*)(xr + col) = xo; u32x2_t wv; wv.x = cvtpk(y[0], y[1]); wv.y = cvtpk(y[2], y[3]); *(u32x2_t*)(Hn + (size_t)t * 1024 + col) = wv; }
        }
    }
}
template <int CTRL> DI float dpp_f(float x) { return __int_as_float(__builtin_amdgcn_update_dpp(0, __float_as_int(x), CTRL, 0xF, 0xF, false)); }
DI float x32(float x) { auto r = __builtin_amdgcn_permlane32_swap(__float_as_uint(x), __float_as_uint(x), false, false); return (threadIdx.x & 32) ? __uint_as_float(r[0]) : __uint_as_float(r[1]); }
DI float x16(float x) { auto r = __builtin_amdgcn_permlane16_swap(__float_as_uint(x), __float_as_uint(x), false, false); return (threadIdx.x & 16) ? __uint_as_float(r[0]) : __uint_as_float(r[1]); }
typedef _Float16 h2_t __attribute__((ext_vector_type(2)));
DI unsigned f2hu(float lo, float hi) { const f32x2_t v = {lo, hi}; const h2_t h = __builtin_convertvector(v, h2_t); return __builtin_bit_cast(unsigned, h); }
DI unsigned bf2hu(unsigned w) { const f32x2_t v = {bflo(w), bfhi(w)}; const h2_t h = __builtin_convertvector(v, h2_t); return __builtin_bit_cast(unsigned, h); }
DI h2_t bf2h(unsigned w) { return (h2_t){(_Float16)bflo(w), (_Float16)bfhi(w)}; }
template <bool FAKE> DI void up8h(const u32x4 u, h2_t (&f)[8]) {
    if (FAKE) { f[0] = __builtin_bit_cast(h2_t, u.x & 0x3bff3bffu); f[1] = __builtin_bit_cast(h2_t, u.y & 0x3bff3bffu); f[2] = __builtin_bit_cast(h2_t, u.z & 0x3bff3bffu); f[3] = __builtin_bit_cast(h2_t, u.w & 0x3bff3bffu);
        f[4] = __builtin_bit_cast(h2_t, (u.x >> 1) & 0x3bff3bffu); f[5] = __builtin_bit_cast(h2_t, (u.y >> 1) & 0x3bff3bffu); f[6] = __builtin_bit_cast(h2_t, (u.z >> 1) & 0x3bff3bffu); f[7] = __builtin_bit_cast(h2_t, (u.w >> 1) & 0x3bff3bffu); return; }
    f[0] = __builtin_amdgcn_cvt_scalef32_pk_f16_fp8((int)u.x, 1.0f, false); f[1] = __builtin_amdgcn_cvt_scalef32_pk_f16_fp8((int)u.x, 1.0f, true);
    f[2] = __builtin_amdgcn_cvt_scalef32_pk_f16_fp8((int)u.y, 1.0f, false); f[3] = __builtin_amdgcn_cvt_scalef32_pk_f16_fp8((int)u.y, 1.0f, true);
    f[4] = __builtin_amdgcn_cvt_scalef32_pk_f16_fp8((int)u.z, 1.0f, false); f[5] = __builtin_amdgcn_cvt_scalef32_pk_f16_fp8((int)u.z, 1.0f, true);
    f[6] = __builtin_amdgcn_cvt_scalef32_pk_f16_fp8((int)u.w, 1.0f, false); f[7] = __builtin_amdgcn_cvt_scalef32_pk_f16_fp8((int)u.w, 1.0f, true); }
template <bool FAKE> DI float dot16h(const u32x4 u, const h2_t (&hh)[8]) { h2_t f[8]; up8h<FAKE>(u, f); float d0 = 0.f, d1 = 0.f;
#pragma unroll
    for (int q = 0; q < 8; q += 2) { d0 = __builtin_amdgcn_fdot2(f[q], hh[q], d0, false); d1 = __builtin_amdgcn_fdot2(f[q + 1], hh[q + 1], d1, false); }
    return d0 + d1; }
template <bool FINAL, bool FAKE = false, int SKIP = 0> DI void peer_gather_rounds(const Ctx& C, const bf16* Hin, const int* IDX, const float* GATE, const unsigned char* PU8, const unsigned char* PV8, const float* ISU, const float* ISV,
                                                 float* X, const float* g2, const float* ngain, const float* nmod, bf16* Hn) {
    const int lane = C.lane, w = C.wave;
    LAS u32x2_t* LIST = (LAS u32x2_t*)(C.lds + w * 14592);
    LAS unsigned char* HL = C.lds + w * 14592 + 4096;
    LAS unsigned* ALU = (LAS unsigned*)(C.lds + w * 14592 + 12288);
    LAS int* OFFS = (LAS int*)(C.lds + w * 14592 + 14336);
    LAS float* IHS = (LAS float*)(C.lds + w * 14592 + 14336 + 160);
    const unsigned long long ltmask = (1ull << lane) - 1ull;
    for (int grp = C.vcu; grp < TT / 32; grp += C.G) {
        const int t0 = grp * 32 + w * 4;
        {
            int ee[8]; float gg[8]; unsigned su[8]; float sv[8];
#pragma unroll
            for (int r = 0; r < 8; ++r) { const size_t a = (size_t)(t0 + (r >> 1)) * 128 + 64 * (r & 1) + lane; ee[r] = IDX[a]; gg[r] = GATE[a]; }
#pragma unroll
            for (int r = 0; r < 8; ++r) { su[r] = __float_as_uint(ISU[ee[r]]) >> 23; sv[r] = ISV[ee[r]]; }
            int pos[8]; int base = 0;
#pragma unroll 1
            for (int b = 0; b < 8; ++b) {
#pragma unroll
                for (int r = 0; r < 8; ++r) { if ((r & 1) == 0 && lane == 0) OFFS[b * 4 + (r >> 1)] = base;
                    const bool mine = (ee[r] >> 11) == b; const unsigned long long m = __ballot(mine); if (mine) pos[r] = base + __popcll(m & ltmask); base += __popcll(m); }
            }
            if (lane == 0) OFFS[32] = 512;
#pragma unroll
            for (int r = 0; r < 8; ++r) { u32x2_t en; en.x = (unsigned)ee[r] | ((unsigned)(r >> 1) << 14) | (su[r] << 16); en.y = __float_as_uint(gg[r] * sv[r]); LIST[pos[r]] = en; }
#pragma unroll
            for (int tk = 0; tk < 4; ++tk) { const u32x4 a = *(const u32x4*)(Hin + (size_t)(t0 + tk) * 1024 + lane * 16), bq = *(const u32x4*)(Hin + (size_t)(t0 + tk) * 1024 + lane * 16 + 8);
                const float hv_[16] = {bflo(a.x), bfhi(a.x), bflo(a.y), bfhi(a.y), bflo(a.z), bfhi(a.z), bflo(a.w), bfhi(a.w), bflo(bq.x), bfhi(bq.x), bflo(bq.y), bfhi(bq.y), bflo(bq.z), bfhi(bq.z), bflo(bq.w), bfhi(bq.w)};
                float am = 0.f;
#pragma unroll
                for (int q = 0; q < 16; ++q) am = fmaxf(am, fabsf(hv_[q]));
                am = wave_max(am);
                const int e_ = (int)((__float_as_uint(am) >> 23) & 0xffu) - 127; const bool ok_ = am > 1e-30f;
                const float sc_ = ok_ ? __uint_as_float((unsigned)(127 + 6 - e_) << 23) : 1.0f, isc_ = ok_ ? __uint_as_float((unsigned)(127 - 6 + e_) << 23) : 1.0f;
                u32x4 o8;
#pragma unroll
                for (int q = 0; q < 4; ++q) { unsigned wd = 0u;
#pragma unroll
                    for (int j = 0; j < 4; ++j) { int qi = (int)rintf(hv_[4 * q + j] * sc_); qi = qi > 127 ? 127 : (qi < -127 ? -127 : qi); wd |= ((unsigned)qi & 0xffu) << (8 * j); }
                    o8[q] = wd; }
                *(LAS u32x4*)(HL + tk * 1024 + lane * 16) = o8; if (lane == 0) IHS[tk] = isc_; }
        }
        LDS_WAIT();
        {
            const int jL = ((lane >> 5) & 1) * 4 + ((lane >> 4) & 1) * 2 + ((lane >> 3) & 1);
#define G1_LOAD(UB, TK, G0) do { const unsigned exl_ = LIST[(G0) + (lane & 7)].x; \
            _Pragma("unroll") for (int j = 0; j < 8; ++j) { const unsigned ex = (unsigned)__builtin_amdgcn_readlane((int)exl_, j); TK[j] = (int)((ex >> 14) & 3u); \
                UB[j] = *(const u32x4*)(PU8 + (size_t)(ex & (FAKE ? 0x7fu : 0x3fffu)) * 1024 + lane * 16); } } while (0)
#define G1_RUN(UB, TK, G0) do { int p[8]; \
            _Pragma("unroll") for (int j = 0; j < 8; ++j) { const u32x4 hq = *(const LAS u32x4*)(HL + TK[j] * 1024 + lane * 16); \
                int d_ = __builtin_amdgcn_sdot4((int)UB[j].x, (int)hq.x, 0, false); d_ = __builtin_amdgcn_sdot4((int)UB[j].y, (int)hq.y, d_, false); \
                d_ = __builtin_amdgcn_sdot4((int)UB[j].z, (int)hq.z, d_, false); p[j] = __builtin_amdgcn_sdot4((int)UB[j].w, (int)hq.w, d_, false); } \
            const bool h32 = lane & 32, h16 = lane & 16, h8 = lane & 8; int q4[4]; \
            _Pragma("unroll") for (int j = 0; j < 4; ++j) { const int keep = h32 ? p[j + 4] : p[j], send = h32 ? p[j] : p[j + 4]; q4[j] = keep + __float_as_int(x32(__int_as_float(send))); } \
            int q2[2]; \
            _Pragma("unroll") for (int j = 0; j < 2; ++j) { const int keep = h16 ? q4[j + 2] : q4[j], send = h16 ? q4[j] : q4[j + 2]; q2[j] = keep + __float_as_int(x16(__int_as_float(send))); } \
            int q1; { const int keep = h8 ? q2[1] : q2[0], send = h8 ? q2[0] : q2[1]; q1 = keep + __float_as_int(dpp_f<0x128>(__int_as_float(send))); } \
            q1 += __float_as_int(dpp_f<0x141>(__int_as_float(q1))); q1 += __float_as_int(dpp_f<0xB1>(__int_as_float(q1))); q1 += __float_as_int(dpp_f<0x4E>(__int_as_float(q1))); \
            if ((lane & 7) == 0) { const u32x2_t me = LIST[(G0) + jL]; const float av_ = gelu_t((float)q1 * IHS[(me.x >> 14) & 3u] * __uint_as_float((me.x >> 16) << 23)) * __uint_as_float(me.y); ALU[(G0) + jL] = f2hu(av_, av_); } } while (0)
            u32x4 ubA[8], ubB[8]; int tkA[8], tkB[8];
            G1_LOAD(ubA, tkA, 0);
#pragma unroll 1
            for (int g0 = 0; g0 < ((SKIP & 1) ? 0 : 512); g0 += 16) {
                G1_LOAD(ubB, tkB, g0 + 8);
                G1_RUN(ubA, tkA, g0);
                if (g0 + 16 < 512) G1_LOAD(ubA, tkA, g0 + 16);
                G1_RUN(ubB, tkB, g0 + 8);
            }
#undef G1_LOAD
#undef G1_RUN
        }
        LDS_WAIT();
        h2_t o[4][8], oc[8];
#pragma unroll
        for (int q = 0; q < 8; ++q) { oc[q] = (h2_t){(_Float16)0.f, (_Float16)0.f};
#pragma unroll
            for (int tk = 0; tk < 4; ++tk) o[tk][q] = (h2_t){(_Float16)0.f, (_Float16)0.f}; }
        {
            int curA = 0;
#define G2_FLUSH() do { if (curA == 0) { _Pragma("unroll") for (int q_ = 0; q_ < 8; ++q_) o[0][q_] += oc[q_]; } else if (curA == 1) { _Pragma("unroll") for (int q_ = 0; q_ < 8; ++q_) o[1][q_] += oc[q_]; } \
            else if (curA == 2) { _Pragma("unroll") for (int q_ = 0; q_ < 8; ++q_) o[2][q_] += oc[q_]; } else { _Pragma("unroll") for (int q_ = 0; q_ < 8; ++q_) o[3][q_] += oc[q_]; } \
            _Pragma("unroll") for (int q_ = 0; q_ < 8; ++q_) oc[q_] = (h2_t){(_Float16)0.f, (_Float16)0.f}; } while (0)
#define G2_LOAD(VB, AJ, TK, G0) do { const unsigned exl_ = LIST[(G0) + (lane & 7)].x; const unsigned all_ = ALU[(G0) + (lane & 7)]; \
            _Pragma("unroll") for (int j = 0; j < 8; ++j) { const unsigned ex = (unsigned)__builtin_amdgcn_readlane((int)exl_, j); TK[j] = (int)((ex >> 14) & 3u); AJ[j] = __builtin_bit_cast(h2_t, (unsigned)__builtin_amdgcn_readlane((int)all_, j)); \
                VB[j] = *(const u32x4*)(PV8 + (size_t)(ex & (FAKE ? 0x7fu : 0x3fffu)) * 1024 + lane * 16); } } while (0)
#define G2_ACC(VB, AJ, TK) do { _Pragma("unroll") for (int j = 0; j < 8; ++j) { if (TK[j] != curA) { G2_FLUSH(); curA = TK[j]; } h2_t f_[8]; up8h<FAKE>(VB[j], f_); _Pragma("unroll") for (int q = 0; q < 8; ++q) oc[q] = f_[q] * AJ[j] + oc[q]; } } while (0)
            u32x4 vbA[8], vbB[8]; h2_t ajA[8], ajB[8]; int tA[8], tB[8];
            G2_LOAD(vbA, ajA, tA, 0);
#pragma unroll 1
            for (int g0 = 0; g0 < ((SKIP & 2) ? 0 : 512); g0 += 16) {
                G2_LOAD(vbB, ajB, tB, g0 + 8);
                G2_ACC(vbA, ajA, tA);
                if (g0 + 16 < 512) G2_LOAD(vbA, ajA, tA, g0 + 16);
                G2_ACC(vbB, ajB, tB);
            }
            G2_FLUSH();
#undef G2_FLUSH
#undef G2_LOAD
#undef G2_ACC
        }
#pragma unroll
        for (int tk = 0; tk < 4; ++tk) {
            __builtin_amdgcn_sched_barrier(0);
            const int t = t0 + tk; const int b = t >> 13; const float* gp = g2 + (size_t)b * 6144; float* xr = X + (size_t)t * 1024;
            float xn[16]; float ss = 0.f;
#pragma unroll
            for (int q = 0; q < 4; ++q) { const int col = lane * 16 + q * 4; const f32x4 xv = *(const f32x4*)(xr + col), gv = *(const f32x4*)(gp + col);
#pragma unroll
                for (int j = 0; j < 4; ++j) { const float y = xv[j] + gv[j] * (float)o[tk][q * 2 + (j >> 1)][j & 1]; xn[q * 4 + j] = y; ss += y * y; } }
            const float rstd = 1.0f / sqrtf(wave_sum(ss) * (1.0f / 1024.0f) + EPS);
            if (FINAL) {
#pragma unroll
                for (int q = 0; q < 4; ++q) { const int col = lane * 16 + q * 4; const f32x4 gn = *(const f32x4*)(ngain + col); f32x4 y;
#pragma unroll
                    for (int j = 0; j < 4; ++j) y[j] = xn[q * 4 + j] * rstd * gn[j];
                    *(f32x4*)(xr + col) = y; }
            } else {
                const float* nm = nmod + (size_t)b * 6144;
#pragma unroll
                for (int q = 0; q < 4; ++q) { const int col = lane * 16 + q * 4; const f32x4 gn = *(const f32x4*)(ngain + col), sh = *(const f32x4*)(nm + col), sc = *(const f32x4*)(nm + 1024 + col); f32x4 xo; float y[4];
#pragma unroll
                    for (int j = 0; j < 4; ++j) { xo[j] = xn[q * 4 + j]; y[j] = xn[q * 4 + j] * rstd * gn[j] * (1.0f + sc[j]) + sh[j]; }
                    *(f32x4*)(xr + col) = xo; u32x2_t wv; wv.x = cvtpk(y[0], y[1]); wv.y = cvtpk(y[2], y[3]); *(u32x2_t*)(Hn + (size_t)t * 1024 + col) = wv; }
            }
        }
        LDS_WAIT();
    }
}
constexpr int GR_R = 12;
DI void glds_row(const unsigned char* gsrc_lane, unsigned lds_dst) { unsigned keep;
    asm volatile("s_mov_b32 %0, m0\n\ts_mov_b32 m0, %2\n\ts_nop 0\n\tglobal_load_lds_dwordx4 %1, off\n\ts_mov_b32 m0, %0" : "=&s"(keep) : "v"(gsrc_lane), "s"(lds_dst) : "memory"); }
template <bool FINAL> DI void peer_gather_dma(const Ctx& C, const bf16* Hin, const int* IDX, const float* GATE, const unsigned char* PU8, const unsigned char* PV8, const float* ISU, const float* ISV,
                                              float* X, const float* g2, const float* ngain, const float* nmod, bf16* Hn) {
    const int lane = C.lane, w = C.wave;
    constexpr int WB = 4096 + 2048 + 256 + GR_R * 1024;
    LAS u32x2_t* LIST = (LAS u32x2_t*)(C.lds + w * WB);
    LAS float* AL = (LAS float*)(C.lds + w * WB + 4096);
    LAS int* OFFS = (LAS int*)(C.lds + w * WB + 6144);
    LAS unsigned char* RING = C.lds + w * WB + 6400;
    const unsigned ring0 = (unsigned)__builtin_amdgcn_readfirstlane((int)(unsigned)(size_t)RING);
    const unsigned long long ltmask = (1ull << lane) - 1ull;
#define GR_REFILL(nv_) do { unsigned ex8_[8]; _Pragma("unroll") for (int j_ = 0; j_ < 8; ++j_) ex8_[j_] = (j_ < (nv_) && nf + j_ < 1024) ? LIST[(nf + j_) & 511].x : 0u; \
        _Pragma("unroll") for (int j_ = 0; j_ < 8; ++j_) if (j_ < (nv_) && nf + j_ < 1024) { const int f_ = nf + j_; const unsigned e_ = (unsigned)__builtin_amdgcn_readfirstlane((int)ex8_[j_]) & 0x3fffu; \
            const unsigned char* tb_ = (f_ < 512) ? PU8 : PV8; glds_row(tb_ + (size_t)e_ * 1024 + lane * 16, ring0 + (unsigned)(f_ % GR_R) * 1024u); } \
        nf += (nv_); if (nf > 1024) nf = 1024; } while (0)
#define GR_ISSUE(f) do { const int f_ = (f); const unsigned ex_ = (unsigned)__builtin_amdgcn_readfirstlane((int)LIST[f_ & 511].x); \
        const unsigned char* tb_ = (f_ < 512) ? PU8 : PV8; glds_row(tb_ + (size_t)(ex_ & 0x3fffu) * 1024 + lane * 16, ring0 + (unsigned)(f_ % GR_R) * 1024u); } while (0)
    for (int grp = C.vcu; grp < TT / 32; grp += C.G) {
        const int t0 = grp * 32 + w * 4;
        float hv4[4][16];
        {
            int ee[8]; float gg[8]; unsigned su[8]; float sv[8];
#pragma unroll
            for (int r = 0; r < 8; ++r) { const size_t a = (size_t)(t0 + (r >> 1)) * 128 + 64 * (r & 1) + lane; ee[r] = IDX[a]; gg[r] = GATE[a]; }
#pragma unroll
            for (int r = 0; r < 8; ++r) { su[r] = __float_as_uint(ISU[ee[r]]) >> 23; sv[r] = ISV[ee[r]]; }
            int pos[8]; int base = 0;
#pragma unroll 1
            for (int b = 0; b < 8; ++b) {
#pragma unroll
                for (int r = 0; r < 8; ++r) { if ((r & 1) == 0 && lane == 0) OFFS[b * 4 + (r >> 1)] = base;
                    const bool mine = (ee[r] >> 11) == b; const unsigned long long m = __ballot(mine); if (mine) pos[r] = base + __popcll(m & ltmask); base += __popcll(m); }
            }
            if (lane == 0) OFFS[32] = 512;
#pragma unroll
            for (int r = 0; r < 8; ++r) { u32x2_t en; en.x = (unsigned)ee[r] | ((unsigned)(r >> 1) << 14) | (su[r] << 16); en.y = __float_as_uint(gg[r] * sv[r]); LIST[pos[r]] = en; }
#pragma unroll
            for (int tk = 0; tk < 4; ++tk) { const u32x4 a = *(const u32x4*)(Hin + (size_t)(t0 + tk) * 1024 + lane * 16), bq = *(const u32x4*)(Hin + (size_t)(t0 + tk) * 1024 + lane * 16 + 8);
                hv4[tk][0] = bflo(a.x); hv4[tk][1] = bfhi(a.x); hv4[tk][2] = bflo(a.y); hv4[tk][3] = bfhi(a.y); hv4[tk][4] = bflo(a.z); hv4[tk][5] = bfhi(a.z); hv4[tk][6] = bflo(a.w); hv4[tk][7] = bfhi(a.w);
                hv4[tk][8] = bflo(bq.x); hv4[tk][9] = bfhi(bq.x); hv4[tk][10] = bflo(bq.y); hv4[tk][11] = bfhi(bq.y); hv4[tk][12] = bflo(bq.z); hv4[tk][13] = bfhi(bq.z); hv4[tk][14] = bflo(bq.w); hv4[tk][15] = bfhi(bq.w); }
        }
        asm volatile("s_waitcnt vmcnt(0) lgkmcnt(0)" ::: "memory");
        int nf = GR_R;
#pragma unroll 1
        for (int f = 0; f < GR_R; ++f) GR_ISSUE(f);
        {
            const int jL = ((lane >> 5) & 1) * 4 + ((lane >> 4) & 1) * 2 + ((lane >> 3) & 1);
#pragma unroll 1
            for (int r = 0; r < 8; ++r) {
#pragma unroll
                for (int tk = 0; tk < 4; ++tk) {
                    const int beg = __builtin_amdgcn_readfirstlane(OFFS[r * 4 + tk]), end = __builtin_amdgcn_readfirstlane(OFFS[r * 4 + tk + 1]);
#pragma unroll 1
                    for (int g0 = beg; g0 < end; g0 += 8) {
                        const int nv = (end - g0) < 8 ? (end - g0) : 8;
                        asm volatile("s_waitcnt vmcnt(4)" ::: "memory");
                        float p[8];
#pragma unroll
                        for (int j = 0; j < 8; ++j) { p[j] = 0.f;
                            if (j < nv) { const u32x4 row = *(const LAS u32x4*)(RING + ((g0 + j) % GR_R) * 1024 + lane * 16); p[j] = dot16(row, hv4[tk]); } }
                        asm volatile("s_waitcnt lgkmcnt(0)" ::: "memory");
                        GR_REFILL(nv);
                        const bool h32 = lane & 32, h16 = lane & 16, h8 = lane & 8;
                        float q4[4];
#pragma unroll
                        for (int j = 0; j < 4; ++j) { const float keep = h32 ? p[j + 4] : p[j], send = h32 ? p[j] : p[j + 4]; q4[j] = keep + __shfl_xor(send, 32); }
                        float q2[2];
#pragma unroll
                        for (int j = 0; j < 2; ++j) { const float keep = h16 ? q4[j + 2] : q4[j], send = h16 ? q4[j] : q4[j + 2]; q2[j] = keep + __shfl_xor(send, 16); }
                        float q1; { const float keep = h8 ? q2[1] : q2[0], send = h8 ? q2[0] : q2[1]; q1 = keep + __shfl_xor(send, 8); }
                        q1 += __shfl_xor(q1, 4); q1 += __shfl_xor(q1, 2); q1 += __shfl_xor(q1, 1);
                        if ((lane & 7) == 0 && jL < nv) { const u32x2_t me = LIST[g0 + jL]; AL[g0 + jL] = gelu_t(q1 * __uint_as_float((me.x >> 16) << 23)) * __uint_as_float(me.y); }
                    }
                }
            }
        }
        float o[4][16];
#pragma unroll
        for (int tk = 0; tk < 4; ++tk)
#pragma unroll
            for (int q = 0; q < 16; ++q) o[tk][q] = 0.f;
#pragma unroll 1
        for (int r = 0; r < 8; ++r) {
#pragma unroll
            for (int tk = 0; tk < 4; ++tk) {
                const int beg = __builtin_amdgcn_readfirstlane(OFFS[r * 4 + tk]), end = __builtin_amdgcn_readfirstlane(OFFS[r * 4 + tk + 1]);
#pragma unroll 1
                for (int i0 = beg; i0 < end; i0 += 8) {
                    const int nv = (end - i0) < 8 ? (end - i0) : 8;
                    if (i0 <= 500) asm volatile("s_waitcnt vmcnt(4)" ::: "memory"); else asm volatile("s_waitcnt vmcnt(0)" ::: "memory");
                    float aq[8]; u32x4 rw[8];
#pragma unroll
                    for (int j = 0; j < 8; ++j) { aq[j] = (j < nv) ? AL[i0 + j] : 0.f; }
#pragma unroll
                    for (int j = 0; j < 8; ++j) if (j < nv) rw[j] = *(const LAS u32x4*)(RING + ((512 + i0 + j) % GR_R) * 1024 + lane * 16);
#pragma unroll
                    for (int j = 0; j < 8; ++j) if (j < nv) { const float aj = __int_as_float(__builtin_amdgcn_readfirstlane(__float_as_int(aq[j])));
                        float f_[16]; up8(rw[j].x, f_[0], f_[1], f_[2], f_[3]); up8(rw[j].y, f_[4], f_[5], f_[6], f_[7]); up8(rw[j].z, f_[8], f_[9], f_[10], f_[11]); up8(rw[j].w, f_[12], f_[13], f_[14], f_[15]);
#pragma unroll
                        for (int q = 0; q < 16; ++q) o[tk][q] += aj * f_[q]; }
                    asm volatile("s_waitcnt lgkmcnt(0)" ::: "memory");
                    GR_REFILL(nv);
                }
            }
        }
        asm volatile("s_waitcnt vmcnt(0)" ::: "memory");
#pragma unroll
        for (int tk = 0; tk < 4; ++tk) {
            const int t = t0 + tk; const int b = t >> 13; const float* gp = g2 + (size_t)b * 6144; float* xr = X + (size_t)t * 1024;
            float xn[16]; float ss = 0.f;
#pragma unroll
            for (int q = 0; q < 4; ++q) { const int col = lane * 16 + q * 4; const f32x4 xv = *(const f32x4*)(xr + col), gv = *(const f32x4*)(gp + col);
#pragma unroll
                for (int j = 0; j < 4; ++j) { const float y = xv[j] + gv[j] * o[tk][q * 4 + j]; xn[q * 4 + j] = y; ss += y * y; } }
            const float rstd = 1.0f / sqrtf(wave_sum(ss) * (1.0f / 1024.0f) + EPS);
            if (FINAL) {
#pragma unroll
                for (int q = 0; q < 4; ++q) { const int col = lane * 16 + q * 4; const f32x4 gn = *(const f32x4*)(ngain + col); f32x4 y;
#pragma unroll
                    for (int j = 0; j < 4; ++j) y[j] = xn[q * 4 + j] * rstd * gn[j];
                    *(f32x4*)(xr + col) = y; }
            } else {
                const float* nm = nmod + (size_t)b * 6144;
#pragma unroll
                for (int q = 0; q < 4; ++q) { const int col = lane * 16 + q * 4; const f32x4 gn = *(const f32x4*)(ngain + col), sh = *(const f32x4*)(nm + col), sc = *(const f32x4*)(nm + 1024 + col); f32x4 xo; float y[4];
#pragma unroll
                    for (int j = 0; j < 4; ++j) { xo[j] = xn[q * 4 + j]; y[j] = xn[q * 4 + j] * rstd * gn[j] * (1.0f + sc[j]) + sh[j]; }
                    *(f32x4*)(xr + col) = xo; u32x2_t wv; wv.x = cvtpk(y[0], y[1]); wv.y = cvtpk(y[2], y[3]); *(u32x2_t*)(Hn + (size_t)t * 1024 + col) = wv; }
            }
        }
        asm volatile("s_waitcnt vmcnt(0) lgkmcnt(0)" ::: "memory");
    }
#undef GR_ISSUE
#undef GR_REFILL
}
DI float red4_sum(float x) { auto a = __builtin_amdgcn_permlane16_swap(__float_as_uint(x), __float_as_uint(x), false, false); x = __uint_as_float(a[0]) + __uint_as_float(a[1]);
    auto b = __builtin_amdgcn_permlane32_swap(__float_as_uint(x), __float_as_uint(x), false, false); return __uint_as_float(b[0]) + __uint_as_float(b[1]); }
DI float red4_max(float x) { auto a = __builtin_amdgcn_permlane16_swap(__float_as_uint(x), __float_as_uint(x), false, false); x = fmaxf(__uint_as_float(a[0]), __uint_as_float(a[1]));
    auto b = __builtin_amdgcn_permlane32_swap(__float_as_uint(x), __float_as_uint(x), false, false); return fmaxf(__uint_as_float(b[0]), __uint_as_float(b[1])); }
DI float red4_min(float x) { auto a = __builtin_amdgcn_permlane16_swap(__float_as_uint(x), __float_as_uint(x), false, false); x = fminf(__uint_as_float(a[0]), __uint_as_float(a[1]));
    auto b = __builtin_amdgcn_permlane32_swap(__float_as_uint(x), __float_as_uint(x), false, false); return fminf(__uint_as_float(b[0]), __uint_as_float(b[1])); }
constexpr int TK_NI = 6;
DI float tk_pivot(float clo, float chi) {
    const float lc = __builtin_amdgcn_logf(clo), lh = __builtin_amdgcn_logf(fmaxf(chi, 0.5f));
    const float f = (lc - 4.0443941f) * __builtin_amdgcn_rcpf(lc - lh);
    return fminf(fmaxf(f, 0.06f), 0.94f);
}
template <int NV> DI float tk_count(const float (&v)[NV], float mid) {
    const float nb = -mid * 1.099511627776e12f;
    float c[4] = {0.f, 0.f, 0.f, 0.f};
#pragma unroll
    for (int i = 0; i < NV; ++i) c[i & 3] += __builtin_amdgcn_fmed3f(__builtin_fmaf(v[i], 1.099511627776e12f, nb), 0.f, 1.f);
    return red4_sum((c[0] + c[1]) + (c[2] + c[3]));
}
constexpr int tk2_pair(int n) {
    int k = 0;
    for (int i = 0; i < 16; ++i) for (int j = 0; j < 16; ++j) if ((i + 1) * (j + 1) <= 16) { if (k == n) return i | (j << 8); ++k; }
    return n == 50 ? (15 | (15 << 8)) : (15 | (14 << 8));
}
template <int NV> DI void tk_search(const float (&v)[NV], float ntot, float& thr_out) {
    float mx = v[0], mn = v[0];
#pragma unroll
    for (int i = 1; i < NV; ++i) { mx = fmaxf(mx, v[i]); mn = fminf(mn, v[i]); }
    mx = red4_max(mx); mn = red4_min(mn);
    float lo = mn, hi = mx, clo = ntot - 1.0f, chi = 0.0f, thr = mn - 1.0f; bool done = false;
#pragma unroll 1
    for (int iter = 0; iter < 48; ++iter) {
        float fr_ = tk_pivot(clo, chi); if (iter >= TK_NI) fr_ = 0.5f;
        const float mid = done ? thr : lo + (hi - lo) * fr_;
        const float cnt = tk_count<NV>(v, mid);
        if (!done) { if (cnt == 16.0f) { thr = mid; done = true; } else if (cnt > 16.0f) { lo = mid; clo = cnt; thr = mid; } else { hi = mid; chi = cnt; } }
        if (__all(done)) break;
    }
    thr_out = thr;
}
DI void tk_search2(const float (&v0)[32], const float (&v1)[32], float& t0, float& t1) {
    float mx0 = v0[0], mn0 = v0[0], mx1 = v1[0], mn1 = v1[0];
#pragma unroll
    for (int i = 1; i < 32; ++i) { mx0 = fmaxf(mx0, v0[i]); mn0 = fminf(mn0, v0[i]); mx1 = fmaxf(mx1, v1[i]); mn1 = fminf(mn1, v1[i]); }
    mx0 = red4_max(mx0); mn0 = red4_min(mn0); mx1 = red4_max(mx1); mn1 = red4_min(mn1);
    float lo0 = mn0, hi0 = mx0, clo0 = 127.0f, chi0 = 0.0f, thr0 = mn0 - 1.0f; bool done0 = false;
    float lo1 = mn1, hi1 = mx1, clo1 = 127.0f, chi1 = 0.0f, thr1 = mn1 - 1.0f; bool done1 = false;
#pragma unroll 1
    for (int iter = 0; iter < 48; ++iter) {
        float f0 = tk_pivot(clo0, chi0), f1 = tk_pivot(clo1, chi1); if (iter >= TK_NI) { f0 = 0.5f; f1 = 0.5f; }
        const float mid0 = done0 ? thr0 : lo0 + (hi0 - lo0) * f0, mid1 = done1 ? thr1 : lo1 + (hi1 - lo1) * f1;
        const float c0 = tk_count<32>(v0, mid0), c1 = tk_count<32>(v1, mid1);
        if (!done0) { if (c0 == 16.0f) { thr0 = mid0; done0 = true; } else if (c0 > 16.0f) { lo0 = mid0; clo0 = c0; thr0 = mid0; } else { hi0 = mid0; chi0 = c0; } }
        if (!done1) { if (c1 == 16.0f) { thr1 = mid1; done1 = true; } else if (c1 > 16.0f) { lo1 = mid1; clo1 = c1; thr1 = mid1; } else { hi1 = mid1; chi1 = c1; } }
        if (__all(done0 && done1)) break;
    }
    t0 = thr0; t1 = thr1;
}
template <int N> struct tk2_pair_c { static constexpr int value = tk2_pair(N); };
template <int MODE = 0> DI void peer_topk_fused(const Ctx& C, const bf16* QP, const bf16* KEYS, int* IDX, float* GATE) {
    constexpr int KPI = 288;
    const int lane = C.lane, fr = lane & 15, fq = lane >> 4, w = C.wave;
    LAS unsigned char* KS = C.lds;
    LAS unsigned char* WB = C.lds + 73728 + w * 7168;
    LAS float* LV = (LAS float*)(WB);
    LAS int* LK = (LAS int*)(WB + 2176);
    LAS float* FV = (LAS float*)(WB + 4352);
    LAS int* FI = (LAS int*)(WB + 5504);
    LAS float* TRASH = (LAS float*)(WB + 6656) + lane;
    const int h = C.vcu & 7, nb = C.G >> 3;
    { const bf16* kg = KEYS + (size_t)h * 2 * 128 * 128;
      for (int c = C.tid; c < 4096; c += 512) { const int r = c >> 4, cc = c & 15; *(LAS u32x4*)(KS + r * KPI + cc * 16) = *(const u32x4*)(kg + (size_t)r * 128 + cc * 8); } }
    __syncthreads();
    int cof[13];
#define TK2_COF(c) cof[c] = fq == 0 ? tk2_pair_c<4 * (c)>::value : fq == 1 ? tk2_pair_c<4 * (c) + 1>::value : fq == 2 ? tk2_pair_c<4 * (c) + 2>::value : tk2_pair_c<4 * (c) + 3>::value
    TK2_COF(0); TK2_COF(1); TK2_COF(2); TK2_COF(3); TK2_COF(4); TK2_COF(5); TK2_COF(6); TK2_COF(7); TK2_COF(8); TK2_COF(9); TK2_COF(10); TK2_COF(11); TK2_COF(12);
#undef TK2_COF
    for (int tt = (C.vcu >> 3) + nb * w; tt < 1024; tt += nb * 8) {
        const int tok = tt * 16 + fr;
        float sc0[32], sc1[32];
#pragma unroll
        for (int p = 0; p < 2; ++p) {
            bf16x8 qf[4];
#pragma unroll
            for (int ks = 0; ks < 4; ++ks) qf[ks] = *(const bf16x8*)(QP + (size_t)tok * 2048 + h * 256 + p * 128 + ks * 32 + fq * 8);
#pragma unroll
            for (int kt = 0; kt < 8; ++kt) {
                f32x4 acc = {0.f, 0.f, 0.f, 0.f};
#pragma unroll
                for (int ks = 0; ks < 4; ++ks) { const bf16x8 kf = *(const LAS bf16x8*)(KS + (p * 128 + kt * 16 + fr) * KPI + (ks * 32 + fq * 8) * 2);
                    acc = __builtin_amdgcn_mfma_f32_16x16x32_bf16(kf, qf[ks], acc, 0, 0, 0); }
                if (p == 0) { sc0[kt * 4 + 0] = acc[0]; sc0[kt * 4 + 1] = acc[1]; sc0[kt * 4 + 2] = acc[2]; sc0[kt * 4 + 3] = acc[3]; }
                else { sc1[kt * 4 + 0] = acc[0]; sc1[kt * 4 + 1] = acc[1]; sc1[kt * 4 + 2] = acc[2]; sc1[kt * 4 + 3] = acc[3]; }
            }
        }
        float thrA = 1.0f, thrB = 1.0f; if (MODE == 0) tk_search2(sc0, sc1, thrA, thrB);
#pragma unroll
        for (int p = 0; p < 2; ++p) {
            const float thr = p == 0 ? thrA : thrB;
            int cnt = 0;
#pragma unroll
            for (int i = 0; i < 32; ++i) cnt += ((p == 0 ? sc0[i] : sc1[i]) > thr) ? 1 : 0;
            const int c0 = __shfl(cnt, fr), c1 = __shfl(cnt, fr + 16), c2 = __shfl(cnt, fr + 32);
            int pos = (fq > 0 ? c0 : 0) + (fq > 1 ? c1 : 0) + (fq > 2 ? c2 : 0);
#pragma unroll
            for (int i = 0; i < 32; ++i) { const float vv = p == 0 ? sc0[i] : sc1[i]; const bool s = vv > thr && pos < 16;
                LAS float* pv = s ? (LV + fr * 33 + p * 16 + pos) : TRASH; LAS int* pk = s ? (LK + fr * 33 + p * 16 + pos) : (LAS int*)TRASH;
                *pv = vv; *pk = (i >> 2) * 16 + 4 * fq + (i & 3); pos += (vv > thr) ? 1 : 0; }
        }
        LDS_WAIT();
        {
            const int lb = fr * 33 + (fq >> 1) * 16, e0 = 8 * (fq & 1);
            float L[16], ownv[8], own[8]; int okey[8], rk[8];
#pragma unroll
            for (int q = 0; q < 16; ++q) L[q] = __uint_as_float((__float_as_uint(LV[lb + q]) & ~15u) | (unsigned)q);
#pragma unroll
            for (int i = 0; i < 8; ++i) { ownv[i] = LV[lb + e0 + i]; okey[i] = LK[lb + e0 + i]; own[i] = __uint_as_float((__float_as_uint(ownv[i]) & ~15u) | (unsigned)(e0 + i)); }
#pragma unroll
            for (int i = 0; i < 8; ++i) { int r = 0;
#pragma unroll
                for (int q = 0; q < 16; ++q) r += (L[q] > own[i]) ? 1 : 0;
                rk[i] = r; }
#pragma unroll
            for (int i = 0; i < 8; ++i) { LV[lb + rk[i]] = ownv[i]; LK[lb + rk[i]] = okey[i]; }
        }
        LDS_WAIT();
        float sm[13]; int ca[13], cb[13];
#pragma unroll
        for (int c = 0; c < 13; ++c) { ca[c] = fr * 33 + (cof[c] & 255); cb[c] = fr * 33 + 16 + (cof[c] >> 8); sm[c] = LV[ca[c]] + LV[cb[c]]; }
        float thr2 = 4.0f; if (MODE == 0) tk_search<13>(sm, 52.0f, thr2);
        {
            int cnt = 0;
#pragma unroll
            for (int i = 0; i < 13; ++i) cnt += (sm[i] > thr2) ? 1 : 0;
            const int c0 = __shfl(cnt, fr), c1 = __shfl(cnt, fr + 16), c2 = __shfl(cnt, fr + 32);
            int pos = (fq > 0 ? c0 : 0) + (fq > 1 ? c1 : 0) + (fq > 2 ? c2 : 0);
#pragma unroll
            for (int i = 0; i < 13; ++i) { const bool s = sm[i] > thr2 && pos < 16;
                LAS float* pv = s ? (FV + fr * 17 + pos) : TRASH; LAS int* pk = s ? (FI + fr * 17 + pos) : (LAS int*)TRASH;
                *pv = sm[i]; *pk = LK[ca[i]] * 128 + LK[cb[i]]; pos += (sm[i] > thr2) ? 1 : 0; }
        }
        LDS_WAIT();
        float x[4]; int xi[4];
#pragma unroll
        for (int j = 0; j < 4; ++j) { x[j] = FV[fr * 17 + 4 * fq + j]; xi[j] = FI[fr * 17 + 4 * fq + j]; }
        float m = red4_max(fmaxf(fmaxf(x[0], x[1]), fmaxf(x[2], x[3])));
        float e[4]; float s = 0.f;
#pragma unroll
        for (int j = 0; j < 4; ++j) { e[j] = __expf(x[j] - m); s += e[j]; }
        s = red4_sum(s);
        const float inv = 1.0f / s;
        const size_t ob = ((size_t)tok * 8 + h) * 16 + 4 * fq;
        typedef int i32x4 __attribute__((ext_vector_type(4)));
        *(i32x4*)(IDX + ob) = (i32x4){xi[0], xi[1], xi[2], xi[3]}; *(f32x4*)(GATE + ob) = (f32x4){e[0] * inv, e[1] * inv, e[2] * inv, e[3] * inv};
        LDS_WAIT();
    }
}
DI void intra_mfma(const Ctx& C, const bf16* Q, const bf16* K, const bf16* V, const bf16* CROSS, bf16* G) {
    constexpr int RPI = 544, PPI = 144, VPI = 544;
    LAS unsigned char* Qs = C.lds; LAS unsigned char* Ks = Qs + 64 * RPI; LAS unsigned char* Ps = Ks + 64 * RPI; LAS unsigned char* Vs = Ps + 64 * PPI;
    LAS float* red = (LAS float*)(Vs + 64 * VPI);
    const int tid = C.tid, lane = C.lane, w = C.wave, fr = lane & 15, fq = lane >> 4;
    for (int item = C.vcu; item < 1024; item += C.G) {
        const int b = item >> 9, h = (item >> 7) & 3, n = item & 127;
        const float lg2 = log2f(1.0f - exp2f(-5.0f - (float)h));
        const size_t tok0 = (size_t)b * SEQ + (size_t)n * 64;
#pragma unroll
        for (int u = 0; u < 4; ++u) { const int c = tid + 512 * u, r = c >> 5, cc = c & 31;
            *(LAS u32x4*)(Qs + r * RPI + cc * 16) = *(const u32x4*)(Q + (tok0 + r) * 1024 + h * 256 + cc * 8);
            *(LAS u32x4*)(Ks + r * RPI + cc * 16) = *(const u32x4*)(K + (tok0 + r) * 1024 + h * 256 + cc * 8);
            *(LAS u32x4*)(Vs + r * VPI + cc * 16) = *(const u32x4*)(V + (tok0 + r) * 2048 + h * 512 + cc * 8); }
        __syncthreads();
        { const int jt = w >> 1; f32x4 sa[2] = {(f32x4){0.f, 0.f, 0.f, 0.f}, (f32x4){0.f, 0.f, 0.f, 0.f}};
#pragma unroll
          for (int ks = 0; ks < 8; ++ks) { const bf16x8 kf = *(const LAS bf16x8*)(Ks + (16 * jt + fr) * RPI + (32 * ks + 8 * fq) * 2);
#pragma unroll
              for (int q = 0; q < 2; ++q) { const int it = 2 * (w & 1) + q; const bf16x8 qf = *(const LAS bf16x8*)(Qs + (16 * it + fr) * RPI + (32 * ks + 8 * fq) * 2);
                  sa[q] = __builtin_amdgcn_mfma_f32_16x16x32_bf16(kf, qf, sa[q], 0, 0, 0); } }
#pragma unroll
          for (int q = 0; q < 2; ++q) { const int i = 16 * (2 * (w & 1) + q) + fr, j0 = 16 * jt + 4 * fq; float pv[4];
#pragma unroll
              for (int r = 0; r < 4; ++r) { const int dd = i > j0 + r ? i - j0 - r : j0 + r - i; pv[r] = sa[q][r] * exp2f(lg2 * (float)dd); }
              u32x2_t o; o.x = cvtpk(pv[0], pv[1]); o.y = cvtpk(pv[2], pv[3]); *(LAS u32x2_t*)(Ps + i * PPI + j0 * 2) = o; } }
        __syncthreads();
        f32x4 acc[2][2][4];
#pragma unroll
        for (int hf = 0; hf < 2; ++hf) {
#pragma unroll
            for (int et = 0; et < 2; ++et)
#pragma unroll
                for (int it = 0; it < 4; ++it) acc[hf][et][it] = (f32x4){0.f, 0.f, 0.f, 0.f};
            if (hf == 1) { __syncthreads();
#pragma unroll
                for (int u = 0; u < 4; ++u) { const int c = tid + 512 * u, r = c >> 5, cc = c & 31;
                    *(LAS u32x4*)(Vs + r * VPI + cc * 16) = *(const u32x4*)(V + (tok0 + r) * 2048 + h * 512 + 256 + cc * 8); }
                __syncthreads(); }
#pragma unroll
            for (int ks = 0; ks < 2; ++ks) {
                bf16x8 pf[4];
#pragma unroll
                for (int it = 0; it < 4; ++it) { const LAS unsigned char* pp = Ps + (16 * it + fr) * PPI + (32 * ks + 4 * fq) * 2;
                    const u32x2_t lo = *(const LAS u32x2_t*)pp, hi = *(const LAS u32x2_t*)(pp + 32); u32x4 ww; ww.x = lo.x; ww.y = lo.y; ww.z = hi.x; ww.w = hi.y; pf[it] = __builtin_bit_cast(bf16x8, ww); }
#pragma unroll
                for (int et = 0; et < 2; ++et) { const LAS unsigned char* vp = Vs + (32 * ks + 4 * fq + (fr >> 2)) * VPI + (32 * w + 16 * et + 4 * (fr & 3)) * 2;
                    const bf16x8 vf = cat8(trr(vp), trr(vp + 16 * VPI));
#pragma unroll
                    for (int it = 0; it < 4; ++it) acc[hf][et][it] = __builtin_amdgcn_mfma_f32_16x16x32_bf16(vf, pf[it], acc[hf][et][it], 0, 0, 0); }
            }
        }
        float ssq[4] = {0.f, 0.f, 0.f, 0.f};
#pragma unroll
        for (int hf = 0; hf < 2; ++hf)
#pragma unroll
            for (int et = 0; et < 2; ++et)
#pragma unroll
                for (int it = 0; it < 4; ++it) { const u32x2_t cv = *(const u32x2_t*)(CROSS + (tok0 + 16 * it + fr) * 2048 + h * 512 + hf * 256 + 32 * w + 16 * et + 4 * fq);
                    f32x4 y = acc[hf][et][it]; y[0] += bflo(cv.x); y[1] += bfhi(cv.x); y[2] += bflo(cv.y); y[3] += bfhi(cv.y); acc[hf][et][it] = y;
                    ssq[it] += (y[0] * y[0] + y[1] * y[1]) + (y[2] * y[2] + y[3] * y[3]); }
#pragma unroll
        for (int it = 0; it < 4; ++it) { float s = ssq[it]; s += __shfl_xor(s, 16); s += __shfl_xor(s, 32); if (fq == 0) red[w * 64 + 16 * it + fr] = s; }
        __syncthreads();
        float rs[4];
#pragma unroll
        for (int it = 0; it < 4; ++it) { float s = 0.f;
#pragma unroll
            for (int ww = 0; ww < 8; ++ww) s += red[ww * 64 + 16 * it + fr];
            rs[it] = 1.0f / sqrtf(s * (1.0f / 512.0f) + EPS); }
#pragma unroll
        for (int hf = 0; hf < 2; ++hf)
#pragma unroll
            for (int et = 0; et < 2; ++et)
#pragma unroll
                for (int it = 0; it < 4; ++it) { bf16* gp = G + (tok0 + 16 * it + fr) * 2048 + h * 512 + hf * 256 + 32 * w + 16 * et + 4 * fq; const u32x2_t gv = *(const u32x2_t*)gp;
                    const f32x4 y = acc[hf][et][it] * rs[it]; u32x2_t o; o.x = cvtpk(y[0] * bflo(gv.x), y[1] * bfhi(gv.x)); o.y = cvtpk(y[2] * bflo(gv.y), y[3] * bfhi(gv.y)); *(u32x2_t*)gp = o; }
        __syncthreads();
    }
}
#ifndef PHMASK
#define PHMASK 0xFFFFFFu
#endif
#define PH(k) ((PHMASK >> (k)) & 1u)
#ifdef USE_SGU_NAIVE
#define SGU_GATE_FN sgu_gate_naive
#else
#define SGU_GATE_FN sgu_gate_mfma
#endif
#ifdef USE_GATHER_TOKEN
#define GATHER_FN peer_gather8
#else
#ifdef USE_GATHER_ROUNDS
#define GATHER_FN peer_gather_rounds
#else
#define GATHER_FN peer_gather_dma
#endif
#endif
#ifndef DUP_GATHER_SKIP
#define DUP_GATHER_SKIP 0
#endif
#ifndef DUP_GATHER_FAKE
#define DUP_GATHER_FAKE false
#endif
struct Args { const void* in[21]; float* out; unsigned char* ws; };
__global__ void __launch_bounds__(NWAVES * 64, 2) mk_fwd(Args args) {
    extern __shared__ __attribute__((aligned(16))) unsigned char lds[];
    Ctx C; C.lds = (LAS unsigned char*)lds; C.tid = threadIdx.x; C.lane = C.tid & 63; C.wave = __builtin_amdgcn_readfirstlane(C.tid >> 6);
    C.G = gridDim.x; { const int bx = blockIdx.x; C.vcu = (C.G % 8 == 0) ? (bx % 8) * (C.G / 8) + bx / 8 : bx; }
    C.ws = args.ws;
    volatile LAS unsigned* MISC = (volatile LAS unsigned*)(C.lds + MISC_OFF);
    gu32* ctl = (gu32*)(args.ws + WS_CTL);
    for (int u = C.tid; u < (LDS_BYTES - LDSCTL_OFF) / 4; u += NWAVES * 64) ((LAS unsigned*)(C.lds + LDSCTL_OFF))[u] = 0u;
    __syncthreads();
    XcdBarrier bar = xcd_barrier_post((unsigned*)(ctl + CW_BAR), MISC + 8);
#define GRID_BAR() do { xcd_barrier(bar); asm volatile("" : "+v"(C.tid)); C.lane = C.tid & 63; C.wave = __builtin_amdgcn_readfirstlane(C.tid >> 6); } while (0)
    { LAS unsigned long long* PT = (LAS unsigned long long*)(C.lds + PTR_OFF);
      if (C.tid == 0) {
#pragma unroll
          for (int i = 0; i < 21; ++i) PT[i] = (unsigned long long)args.in[i];
      } }
    __syncthreads();
#define INP(T, i) ((const T*)ldp(C, i))
    float* out = args.out; unsigned char* ws = args.ws;
#define MODP ((float*)(ws + WS_MOD))
#define MOD0 ((const float*)(ws + WS_MOD))
#define MOD1 ((const float*)(ws + WS_MOD) + 2 * 6144)
#define cosT ((float*)(ws + WS_COS))
#define sinT ((float*)(ws + WS_SIN))
#define WRI ((bf16*)(ws + WS_WRI))
#define WRO ((bf16*)(ws + WS_WRO))
#define WSI ((bf16*)(ws + WS_WSI))
#define WSO ((bf16*)(ws + WS_WSO))
#define WQ ((bf16*)(ws + WS_WQ))
#define KEYS ((bf16*)(ws + WS_KEYS))
#define STATS ((float*)(ws + WS_STATS))
#define IDX ((int*)(ws + WS_IDX))
#define GATE ((float*)(ws + WS_GATE))
#define H ((bf16*)(ws + WS_H))
#define PU8 ((const unsigned char*)(ws + WS_PU))
#define PV8 ((const unsigned char*)(ws + WS_PV))
#define ISU ((const float*)(ws + WS_ISU))
#define ISV ((const float*)(ws + WS_ISV))
#define Qb ((bf16*)(ws + WS_Q))
#define Kb ((bf16*)(ws + WS_K))
#define Vb ((bf16*)(ws + WS_V))
#define Gb ((bf16*)(ws + WS_G))
#define CROSS ((bf16*)(ws + WS_CROSS))
#define QP ((bf16*)(ws + WS_QP))
#define SCO ((float*)(ws + WS_SC))
#define Ub ((bf16*)(ws + WS_U))
#define VBb ((bf16*)(ws + WS_VB))

    { P0In I; I.c = INP(float, 1); I.ada_w = INP(float, 5); I.ada_b = INP(float, 6); I.ret_w_in = INP(float, 7); I.ret_w_out = INP(float, 8); I.sgu_w_in = INP(float, 9); I.sgu_w_out = INP(float, 15); I.wq = INP(float, 16); I.keys = INP(float, 17); I.pu = INP(float, 18); I.pv = INP(float, 19); I.pos = INP(int, 2);
#ifdef DUP_P0
      p0_prologue(C, I);
      GRID_BAR();
#endif
      if (PH(0)) p0_prologue(C, I); }
    GRID_BAR();
    if (PH(1)) rms_mod_phase(C, INP(float, 0), INP(float, 3), MOD0, 0, 1024, H);
    GRID_BAR();
    { pg8::Gemm g{H, WRI, TT, 6144, 1024}; pg8::StaticOrder S; S.init(TT, 6144, C.G, (int)blockIdx.x);
      pg8::EpiRetProj E{Qb, Kb, Vb, Gb, cosT, sinT};
#ifdef DUP_G1
      pg8::gemm_phase<pg8::EpiRetProj, pg8::StaticOrder, true, true>(C.lds + RING_OFF, g, S, E); GRID_BAR();
#endif
      if (PH(2)) pg8::gemm_phase<pg8::EpiRetProj, pg8::StaticOrder, true, true>(C.lds + RING_OFF, g, S, E); }
    GRID_BAR();
    #ifdef USE_SCAN_NAIVE
    if (PH(3)) scan_naive(C, Qb, Kb, Vb, CROSS);
#else
#ifdef DUP_SCAN
    scan_mfma<DUP_SCAN>(C, Qb, Kb, Vb, CROSS);
    GRID_BAR();
#endif
    if (C.vcu < SCAN_NIT) { if (PH(3)) scan_mfma<0>(C, Qb, Kb, Vb, CROSS); }
    else { P0In I; I.c = nullptr; I.ada_w = nullptr; I.ada_b = nullptr; I.ret_w_in = nullptr; I.ret_w_out = nullptr; I.sgu_w_in = INP(float, 9); I.sgu_w_out = INP(float, 15); I.wq = INP(float, 16); I.keys = nullptr; I.pu = INP(float, 18); I.pv = INP(float, 19); I.pos = nullptr;
      side_work(C, I, SCAN_NIT); }
#endif
    GRID_BAR();
#ifdef USE_INTRA_NAIVE
    if (PH(4)) intra_naive(C, Qb, Kb, Vb, CROSS, Gb);
#else
    if (PH(4)) intra_mfma(C, Qb, Kb, Vb, CROSS, Gb);
#endif
    GRID_BAR();
    { pg8::Gemm g{Gb, WRO, TT, 1024, 2048}; pg8::StaticOrder S; S.init(TT, 1024, C.G, (int)blockIdx.x);
      pg8::EpiResGate E{INP(float, 0), out, MOD0 + 2048, 6144};
      if (PH(5)) pg8::gemm_phase<pg8::EpiResGate, pg8::StaticOrder, true, true>(C.lds + RING_OFF, g, S, E); }
    GRID_BAR();
    if (PH(6)) rms_mod_phase(C, out, INP(float, 4), MOD0, 3072, 4096, H);
    GRID_BAR();
    { pg8::Gemm g{H, WQ, TT, 2048, 1024}; pg8::StaticOrder S; S.init(TT, 2048, C.G, (int)blockIdx.x);
      pg8::EpiBf16<0> E{QP, 2048, nullptr, 0, 0, 1.f};
      if (PH(7)) pg8::gemm_phase<pg8::EpiBf16<0>, pg8::StaticOrder, true, true>(C.lds + RING_OFF, g, S, E); }
    GRID_BAR();
#ifdef USE_TOPK_NAIVE
    if (PH(8)) peer_scores(C, QP, KEYS, SCO);
    GRID_BAR();
    if (PH(9)) peer_topk(C, SCO, IDX, GATE);
#else
#ifdef DUP_TOPK
    peer_topk_fused<DUP_TOPK>(C, QP, KEYS, IDX, GATE);
    GRID_BAR();
#endif
    if (PH(9)) peer_topk_fused<0>(C, QP, KEYS, IDX, GATE);
#endif
    GRID_BAR();
#ifdef DUP_GATHER
    GATHER_FN<false, DUP_GATHER_FAKE, DUP_GATHER_SKIP>(C, H, IDX, GATE, PU8, PV8, ISU, ISV, (float*)(ws + WS_R), MOD0 + 5120, INP(float, 3) + 1024, MOD1, (bf16*)(ws + WS_R + 128 * MiB));
    GRID_BAR();
#endif
    if (PH(10)) GATHER_FN<false>(C, H, IDX, GATE, PU8, PV8, ISU, ISV, out, MOD0 + 5120, INP(float, 3) + 1024, MOD1, H);
    GRID_BAR();
#ifdef DUP_BAR
    for (int q_ = 0; q_ < 10; ++q_) GRID_BAR();
#endif
    { pg8::Gemm g{H, WSI, TT, 6144, 1024}; pg8::StaticOrder S; S.init(TT, 6144, C.G, (int)blockIdx.x);
      pg8::EpiSguIn E{Ub, VBb, INP(float, 10), STATS};
#ifdef DUP_G7
      pg8::gemm_phase<pg8::EpiSguIn, pg8::StaticOrder, true, true>(C.lds + RING_OFF, g, S, E); GRID_BAR();
#endif
      if (PH(11)) pg8::gemm_phase<pg8::EpiSguIn, pg8::StaticOrder, true, true>(C.lds + RING_OFF, g, S, E); }
    GRID_BAR();
    if (PH(12)) SGU_GATE_FN(C, Ub, VBb, STATS, INP(float, 13), INP(float, 14), INP(float, 11), INP(float, 12));
    GRID_BAR();
    { pg8::Gemm g{Ub, WSO, TT, 1024, 3072}; pg8::StaticOrder S; S.init(TT, 1024, C.G, (int)blockIdx.x);
      pg8::EpiResGate E{out, out, MOD1 + 2048, 6144};
      if (PH(13)) pg8::gemm_phase<pg8::EpiResGate, pg8::StaticOrder, true, true>(C.lds + RING_OFF, g, S, E); }
    GRID_BAR();
    if (PH(14)) rms_mod_phase(C, out, INP(float, 4) + 1024, MOD1, 3072, 4096, H);
    GRID_BAR();
    { pg8::Gemm g{H, WQ + (size_t)2048 * 1024, TT, 2048, 1024}; pg8::StaticOrder S; S.init(TT, 2048, C.G, (int)blockIdx.x);
      pg8::EpiBf16<0> E{QP, 2048, nullptr, 0, 0, 1.f};
      if (PH(15)) pg8::gemm_phase<pg8::EpiBf16<0>, pg8::StaticOrder, true, true>(C.lds + RING_OFF, g, S, E); }
    GRID_BAR();
#ifdef USE_TOPK_NAIVE
    if (PH(16)) peer_scores(C, QP, KEYS + (size_t)8 * 2 * 128 * 128, SCO);
    GRID_BAR();
    if (PH(17)) peer_topk(C, SCO, IDX, GATE);
#else
    if (PH(17)) peer_topk_fused<0>(C, QP, KEYS + (size_t)8 * 2 * 128 * 128, IDX, GATE);
#endif
    GRID_BAR();
    if (PH(18)) GATHER_FN<true>(C, H, IDX, GATE, PU8 + (size_t)16384 * 1024, PV8 + (size_t)16384 * 1024, ISU + 16384, ISV + 16384, out, MOD1 + 5120, INP(float, 20), nullptr, nullptr);
#undef GRID_BAR
}

extern "C" void kernel_launch(void* const* d_in, const int* in_sizes, int n_in, void* d_out, int out_size, void* d_ws, size_t ws_size, hipStream_t stream) {
    static int grid = 0;
    if (grid == 0) {
        if (n_in != 21 || in_sizes[0] != TT * DM || out_size != TT * DM || ws_size < WS_END) { fprintf(stderr, "kernel_launch: unexpected shapes/workspace: n_in %d in0 %d out %d ws %zu (need %zu)\n", n_in, n_in > 0 ? in_sizes[0] : -1, out_size, ws_size, (size_t)WS_END); grid = -1; return; }
        int dev = 0, cus = 0;
        if (hipGetDevice(&dev) != hipSuccess || hipDeviceGetAttribute(&cus, hipDeviceAttributeMultiprocessorCount, dev) != hipSuccess) { fprintf(stderr, "kernel_launch: device query failed\n"); grid = -1; return; }
        if (hipFuncSetAttribute((const void*)mk_fwd, hipFuncAttributeMaxDynamicSharedMemorySize, LDS_BYTES) != hipSuccess) { fprintf(stderr, "kernel_launch: hipFuncSetAttribute failed\n"); grid = -1; return; }
        (void)hipGetLastError();
        grid = cus;
    }
    if (grid < 0) return;
    if (hipMemsetAsync((char*)d_ws + WS_CTL, 0, CTL_ZERO_BYTES, stream) != hipSuccess) { fprintf(stderr, "kernel_launch: memset failed\n"); return; }
    Args a; memset(&a, 0, sizeof(a));
    for (int i = 0; i < 21; ++i) a.in[i] = d_in[i];
    a.out = (float*)d_out; a.ws = (unsigned char*)d_ws;
    hipLaunchKernelGGL(mk_fwd, dim3(grid), dim3(NWAVES * 64), LDS_BYTES, stream, a);
    const hipError_t le = hipPeekAtLastError();
    if (le != hipSuccess) fprintf(stderr, "kernel_launch: launch failed: %s\n", hipGetErrorName(le));
}
```

```cpp
#define USE_GATHER_ROUNDS 1
#include <hip/hip_runtime.h>
#include <cstdio>
#include <cstdint>
#include <cstring>
#include <cmath>
namespace pg8 {
#define PG8_LAS __attribute__((address_space(3)))
typedef unsigned short bf16_t;
typedef short bf16x8 __attribute__((ext_vector_type(8)));
typedef float f32x4 __attribute__((ext_vector_type(4)));
typedef unsigned u32x4 __attribute__((ext_vector_type(4)));
constexpr int BM = 256, BK = 64, HALF = 128, HTB = HALF * BK * 2  , STAGE_BYTES = 8 * HTB, NXCD = 8, WGM = 8;

__host__ __device__ __forceinline__ int lds_byte(int r, int c) { const int st = (r >> 4) * 2 + (c >> 5), rr = r & 15, cc = c & 31, ob = rr * 64 + cc * 2; return st * 1024 + (ob ^ (((ob >> 9) & 1) << 5)); }
__host__ __device__ __forceinline__ void stage_rc(int b, int& R, int& C) { const int st = b / 1024, sb = b % 1024, swz = sb ^ (((sb >> 9) & 1) << 5); R = (st >> 1) * 16 + swz / 64; C = (st & 1) * 32 + (swz % 64) / 2; }
__host__ __device__ __forceinline__ int perm32(int rho) { const int n = rho >> 4, i = rho & 15; return 8 * (i >> 2) + 4 * n + (i & 3); }

struct Unit { int pm, pn; };
struct Gemm { const bf16_t* A; const bf16_t* Bt; int M, N, K; };

struct StaticOrder {
    int nM, nN, nwg, G, c;
    __host__ __device__ void init(int M, int N, int G_, int c_) { nM = M / BM; nN = N / BM; nwg = nM * nN; G = G_; c = c_; }
    __host__ __device__ bool next(int i, Unit& u) const {
        const long L = (long)i * G + c; if (L >= nwg) return false;
        int wgid = (int)L; { const int q = nwg / NXCD, r = nwg % NXCD, xcd = wgid % NXCD, off = wgid / NXCD; wgid = (xcd < r ? xcd * (q + 1) : r * (q + 1) + (xcd - r) * q) + off; }
        const int nig = WGM * nN, gid = wgid / nig, fm = gid * WGM, gsz = (nM - fm) < WGM ? (nM - fm) : WGM;
        u.pm = fm + ((wgid % nig) % gsz); u.pn = (wgid % nig) / gsz; return true;
    }
    __device__ __forceinline__ void a_ready(const Unit&) const {}
    __device__ __forceinline__ void done(const Unit&) const {}
};

__device__ __forceinline__ unsigned cvt_pk_bf16(float lo, float hi) { unsigned r; asm volatile("v_cvt_pk_bf16_f32 %0, %1, %2" : "=v"(r) : "v"(lo), "v"(hi)); return r; }
typedef float f32x2 __attribute__((ext_vector_type(2)));
__device__ __forceinline__ f32x2 gelu_pk(f32x2 v) {
    const f32x2 av = __builtin_elementwise_abs(v), d = av * 0.2316418882f + 1.0f;
    f32x2 t; t.x = __builtin_amdgcn_rcpf(d.x); t.y = __builtin_amdgcn_rcpf(d.y);
    f32x2 q = t * 0.5307027145f + (-0.7265760135f); q = q * t + 0.7107068705f; q = q * t + (-0.142248368f); q = q * t + 0.127414796f; q = q * t;
    const f32x2 s = (v * v) * (-0.72134752044f);
    f32x2 e; e.x = __builtin_amdgcn_exp2f(s.x); e.y = __builtin_amdgcn_exp2f(s.y);
    const f32x2 m = v * (q * e), r = v - m;
    f32x2 o; o.x = v.x < 0.f ? m.x : r.x; o.y = v.y < 0.f ? m.y : r.y; return o;
}

template <int ACT  > struct EpiBf16 {
    static constexpr bool PERM = true, AFTER_DRAIN = false; static_assert(ACT == 0 || ACT == 1, "EpiBf16: ACT is 0 (none) or 1 (gelu_pk)");
    bf16_t* O; int ldc; const float* bias; int split_cols; size_t split_stride; float scale0;
    __device__ __forceinline__ void operator()(const f32x4 (&acc)[2][2][4][2], const Unit& u, int wr, int wc, int fr, int fq) const {
        const int row0 = u.pm * BM + wr * 64 + fr; int colt = u.pn * BM; bf16_t* base = O;
        float sc = 1.f; if (split_cols) { const int t = colt / split_cols; base += (size_t)t * split_stride; colt -= t * split_cols; if (t == 0) sc = scale0; }
        const int col0 = colt + wc * 32 + 8 * fq, bcol0 = u.pn * BM + wc * 32 + 8 * fq;
        f32x4 bv[2][2];
#pragma unroll
        for (int bj = 0; bj < 2; ++bj)
#pragma unroll
            for (int n = 0; n < 2; ++n) bv[bj][n] = bias ? *(const f32x4*)(bias + bcol0 + bj * HALF + 4 * n) : (f32x4){0.f, 0.f, 0.f, 0.f};
#pragma unroll
        for (int ai = 0; ai < 2; ++ai)
#pragma unroll
            for (int m = 0; m < 4; ++m) { bf16_t* rowp = base + (size_t)(row0 + ai * HALF + m * 16) * ldc + col0;
#pragma unroll
                for (int bj = 0; bj < 2; ++bj) { f32x4 v0 = acc[ai][bj][m][0] + bv[bj][0], v1 = acc[ai][bj][m][1] + bv[bj][1];
                    if (ACT == 1) { f32x2 a = gelu_pk((f32x2){v0[0], v0[1]}), b = gelu_pk((f32x2){v0[2], v0[3]}), c = gelu_pk((f32x2){v1[0], v1[1]}), d = gelu_pk((f32x2){v1[2], v1[3]});
                        v0 = (f32x4){a.x, a.y, b.x, b.y}; v1 = (f32x4){c.x, c.y, d.x, d.y}; }
                    v0 = v0 * sc; v1 = v1 * sc; u32x4 w; w.x = cvt_pk_bf16(v0[0], v0[1]); w.y = cvt_pk_bf16(v0[2], v0[3]); w.z = cvt_pk_bf16(v1[0], v1[1]); w.w = cvt_pk_bf16(v1[2], v1[3]);
                    *(u32x4*)(rowp + bj * HALF) = w; } }
    }
};
template <class Epi, class Sched, bool ALIGN_EPI = false, bool SP2 = false>
__device__ __forceinline__ void gemm_phase(PG8_LAS unsigned char* lds, const Gemm g, const Sched& S, const Epi& E) {
    int tid_ = threadIdx.x; asm volatile("" : "+v"(tid_));
    const int tid = tid_, wid = __builtin_amdgcn_readfirstlane(tid >> 6), lane = tid & 63, wr = wid >> 2, wc = wid & 3, fr = lane & 15, fq = lane >> 4;
    const int K = g.K, nt = K / BK;
    unsigned voffA[2], voffB[2];
#pragma unroll
    for (int i = 0; i < 2; ++i) { int R, C; stage_rc(tid * 16 + i * 8192, R, C); const int Rb = Epi::PERM ? ((R & ~31) + perm32(R & 31)) : R;
        voffA[i] = (unsigned)(R * K + C) * 2u; voffB[i] = (unsigned)(Rb * K + C) * 2u; }
    const size_t kstep = (size_t)(BK * 2);
    const size_t hstep = (size_t)HALF * K * 2;
    const size_t tstep = 2 * hstep;
    const unsigned ldsw = (unsigned)wid * 1024u;
    const int aoff = lds_byte(wr * 64 + fr, fq * 8), boff = lds_byte(wc * 32 + fr, fq * 8);
#define PG8_SA(b, h) (((b) * 2 + (h)) * HTB)
#define PG8_SB(b, h) ((4 + (b) * 2 + (h)) * HTB)
#define PG8_STAGE(bufoff, gbase, voff) do { _Pragma("unroll") for (int _i = 0; _i < 2; ++_i) \
        __builtin_amdgcn_global_load_lds((const unsigned*)((const char*)(gbase) + (voff)[_i]), (PG8_LAS unsigned*)(lds + (bufoff) + ldsw + _i * 8192), 16, 0, 0); } while (0)
#define PG8_LDA(dst, b, h) do { _Pragma("unroll") for (int m = 0; m < 4; ++m) _Pragma("unroll") for (int k = 0; k < 2; ++k) dst[m][k] = *(const PG8_LAS bf16x8*)(lds + PG8_SA(b, h) + aoff + m * 2048 + k * 1024); } while (0)
#define PG8_LDB(dst, b, h) do { _Pragma("unroll") for (int n = 0; n < 2; ++n) _Pragma("unroll") for (int k = 0; k < 2; ++k) dst[n][k] = *(const PG8_LAS bf16x8*)(lds + PG8_SB(b, h) + boff + n * 2048 + k * 1024); } while (0)
#define PG8_MMA(ai, bj, At, Bt) do { __builtin_amdgcn_s_setprio(1); _Pragma("unroll") for (int m = 0; m < 4; ++m) _Pragma("unroll") for (int n = 0; n < 2; ++n) _Pragma("unroll") for (int k = 0; k < 2; ++k) \
        acc[ai][bj][m][n] = __builtin_amdgcn_mfma_f32_16x16x32_bf16(Bt[n][k], At[m][k], acc[ai][bj][m][n], 0, 0, 0); __builtin_amdgcn_s_setprio(0); } while (0)
#define PG8_WAIT_V(n) asm volatile("s_waitcnt vmcnt(" #n ")" ::: "memory")
#define PG8_WAIT_L(n) asm volatile("s_waitcnt lgkmcnt(" #n ")" ::: "memory")
#define PG8_BAR __builtin_amdgcn_s_barrier()
#define PG8_SCHED __builtin_amdgcn_sched_barrier(0)
    Unit cur, nxt; int ui = 0;
    if (!S.next(0, cur)) return;
    f32x4 acc[2][2][4][2];
#pragma unroll
    for (int a = 0; a < 2; ++a)
#pragma unroll
        for (int b = 0; b < 2; ++b)
#pragma unroll
            for (int m = 0; m < 4; ++m)
#pragma unroll
                for (int n = 0; n < 2; ++n) acc[a][b][m][n] = (f32x4){0.f, 0.f, 0.f, 0.f};
    bf16x8 At[4][2], B0[2][2], B1[2][2];
    const char* cA = (const char*)g.A + (size_t)cur.pm * tstep; const char* cB = (const char*)g.Bt + (size_t)cur.pn * tstep;
    S.a_ready(cur);
    if constexpr (SP2) {
        PG8_STAGE(PG8_SB(0, 0), cB, voffB); PG8_STAGE(PG8_SB(0, 1), cB + hstep, voffB); PG8_STAGE(PG8_SA(0, 0), cA, voffA); PG8_STAGE(PG8_SA(0, 1), cA + hstep, voffA);
        if (wr == 1) PG8_BAR;
        PG8_WAIT_V(2); PG8_BAR;
        PG8_STAGE(PG8_SB(1, 0), cB + kstep, voffB); PG8_STAGE(PG8_SA(1, 0), cA + kstep, voffA); PG8_STAGE(PG8_SB(1, 1), cB + hstep + kstep, voffB);
        PG8_WAIT_V(6); PG8_BAR;
    } else {
        PG8_STAGE(PG8_SB(0, 0), cB, voffB); PG8_STAGE(PG8_SA(0, 0), cA, voffA); PG8_STAGE(PG8_SB(0, 1), cB + hstep, voffB); PG8_STAGE(PG8_SA(0, 1), cA + hstep, voffA);
        if (wr == 1) PG8_BAR;
        PG8_WAIT_V(4); PG8_BAR;
        PG8_STAGE(PG8_SB(1, 0), cB + kstep, voffB); PG8_STAGE(PG8_SA(1, 0), cA + kstep, voffA); PG8_STAGE(PG8_SB(1, 1), cB + hstep + kstep, voffB);
        PG8_WAIT_V(6); PG8_BAR;
    }
    for (;;) {
        const bool has_next = S.next(ui + 1, nxt);
        const char* nA = has_next ? (const char*)g.A + (size_t)nxt.pm * tstep : cA; const char* nB = has_next ? (const char*)g.Bt + (size_t)nxt.pn * tstep : cB;
        for (int t = 0; t < nt; t += 2) {
            const bool last = (t == nt - 2);
            const char* a1 = cA + (size_t)(t + 1) * kstep;
            const char* a2 = last ? nA : cA + (size_t)(t + 2) * kstep; const char* b2 = last ? nB : cB + (size_t)(t + 2) * kstep;
            const char* a3 = a2 + kstep; const char* b3 = b2 + kstep;
            if (last && has_next) S.a_ready(nxt);
            if constexpr (SP2) {
            PG8_LDB(B0, 0, 0); PG8_LDB(B1, 0, 1); PG8_SCHED; PG8_LDA(At, 0, 0); PG8_STAGE(PG8_SA(1, 1), a1 + hstep, voffA);
            PG8_WAIT_V(8); PG8_WAIT_L(0); PG8_BAR; PG8_MMA(0, 0, At, B0); PG8_MMA(0, 1, At, B1); PG8_BAR; PG8_SCHED;
            PG8_LDA(At, 0, 1); PG8_STAGE(PG8_SB(0, 0), b2, voffB); PG8_STAGE(PG8_SB(0, 1), b2 + hstep, voffB); PG8_STAGE(PG8_SA(0, 0), a2, voffA);
            PG8_WAIT_V(8); PG8_WAIT_L(0); PG8_BAR; PG8_MMA(1, 0, At, B0); PG8_MMA(1, 1, At, B1); PG8_BAR; PG8_SCHED;
            PG8_LDB(B0, 1, 0); PG8_LDB(B1, 1, 1); PG8_SCHED; PG8_LDA(At, 1, 0); PG8_STAGE(PG8_SA(0, 1), a2 + hstep, voffA);
            PG8_WAIT_V(8); PG8_WAIT_L(0); PG8_BAR; PG8_MMA(0, 0, At, B0); PG8_MMA(0, 1, At, B1); PG8_BAR; PG8_SCHED;
            PG8_LDA(At, 1, 1); PG8_STAGE(PG8_SB(1, 0), b3, voffB); PG8_STAGE(PG8_SB(1, 1), b3 + hstep, voffB); PG8_STAGE(PG8_SA(1, 0), a3, voffA);
            PG8_WAIT_V(8); PG8_WAIT_L(0); PG8_BAR; PG8_MMA(1, 0, At, B0); PG8_MMA(1, 1, At, B1); PG8_BAR; PG8_SCHED;
            } else {
            PG8_LDB(B0, 0, 0); PG8_SCHED; PG8_LDA(At, 0, 0); PG8_STAGE(PG8_SA(1, 1), a1 + hstep, voffA);
            PG8_WAIT_L(8); PG8_BAR; PG8_WAIT_L(0); PG8_MMA(0, 0, At, B0); PG8_BAR; PG8_SCHED;
            PG8_LDB(B1, 0, 1); PG8_STAGE(PG8_SB(0, 0), b2, voffB);
            PG8_BAR; PG8_WAIT_L(0); PG8_MMA(0, 1, At, B1); PG8_BAR;
            PG8_LDA(At, 0, 1); PG8_STAGE(PG8_SA(0, 0), a2, voffA);
            PG8_BAR; PG8_WAIT_L(0); PG8_MMA(1, 0, At, B0); PG8_BAR; PG8_SCHED;
            PG8_STAGE(PG8_SB(0, 1), b2 + hstep, voffB);
            PG8_WAIT_V(6); PG8_BAR; PG8_MMA(1, 1, At, B1); PG8_BAR;
            PG8_LDB(B0, 1, 0); PG8_SCHED; PG8_LDA(At, 1, 0); PG8_STAGE(PG8_SA(0, 1), a2 + hstep, voffA);
            PG8_WAIT_L(8); PG8_BAR; PG8_WAIT_L(0); PG8_MMA(0, 0, At, B0); PG8_BAR; PG8_SCHED;
            PG8_LDB(B1, 1, 1); PG8_STAGE(PG8_SB(1, 0), b3, voffB);
            PG8_BAR; PG8_WAIT_L(0); PG8_MMA(0, 1, At, B1); PG8_BAR;
            PG8_LDA(At, 1, 1); PG8_STAGE(PG8_SA(1, 0), a3, voffA);
            PG8_BAR; PG8_WAIT_L(0); PG8_MMA(1, 0, At, B0); PG8_BAR; PG8_SCHED;
            PG8_STAGE(PG8_SB(1, 1), b3 + hstep, voffB);
            PG8_WAIT_V(6); PG8_BAR; PG8_MMA(1, 1, At, B1); PG8_BAR;
            }
        }
        if constexpr (ALIGN_EPI) { if (wr == 0) PG8_BAR; }
        if constexpr (!Epi::AFTER_DRAIN) { E(acc, cur, wr, wc, fr, fq); S.done(cur); }
        if (!has_next) break;
#pragma unroll
        for (int a = 0; a < 2; ++a)
#pragma unroll
            for (int b = 0; b < 2; ++b)
#pragma unroll
                for (int m = 0; m < 4; ++m)
#pragma unroll
                    for (int n = 0; n < 2; ++n) acc[a][b][m][n] = (f32x4){0.f, 0.f, 0.f, 0.f};
        cur = nxt; cA = nA; cB = nB; ++ui;
        if constexpr (ALIGN_EPI) { if (wr == 1) PG8_BAR; }
    }
    PG8_WAIT_V(0);
    if constexpr (!ALIGN_EPI) { if (wr == 0) PG8_BAR; }
    PG8_BAR;
    if constexpr (Epi::AFTER_DRAIN) { E.fused(acc, cur, wr, wc, fr, fq, lds, wid, lane); S.done(cur); }
#undef PG8_SA
#undef PG8_SB
#undef PG8_STAGE
#undef PG8_LDA
#undef PG8_LDB
#undef PG8_MMA
#undef PG8_WAIT_V
#undef PG8_WAIT_L
#undef PG8_BAR
#undef PG8_SCHED
}
}
namespace pg8 {
typedef unsigned u32x2 __attribute__((ext_vector_type(2)));
__device__ __forceinline__ float gelu_tanh(float x) {
    const float e = __builtin_amdgcn_exp2f(x * (-2.302208198f - 0.1029432397f * x * x));
    return x * __builtin_amdgcn_rcpf(1.0f + e);
}
__device__ __forceinline__ float silu_f(float x) { return x * __builtin_amdgcn_rcpf(1.0f + __builtin_amdgcn_exp2f(-1.4426950409f * x)); }

struct EpiRetProj {
    static constexpr bool PERM = false, AFTER_DRAIN = false;
    bf16_t *Q, *K, *V, *G; const float *cosT, *sinT;
    __device__ __forceinline__ void operator()(const f32x4 (&acc)[2][2][4][2], const Unit& u, int wr, int wc, int fr, int fq) const {
        const int pn = u.pn;
        if (pn < 8) {
            bf16_t* dst = pn < 4 ? Q : K; const int head = pn & 3; const float sc = pn < 4 ? 1.0f : 0.0625f;
#pragma unroll
            for (int ai = 0; ai < 2; ++ai)
#pragma unroll
                for (int m = 0; m < 4; ++m) {
                    const int row = u.pm * BM + ai * HALF + wr * 64 + m * 16 + fr;
#pragma unroll
                    for (int n = 0; n < 2; ++n) {
                        const int f0 = wc * 32 + n * 16 + fq * 4;
                        const f32x4 c4 = *(const f32x4*)(cosT + (size_t)row * 128 + f0), s4 = *(const f32x4*)(sinT + (size_t)row * 128 + f0);
                        const f32x4 x1 = acc[ai][0][m][n], x2 = acc[ai][1][m][n];
                        const f32x4 o1 = (x1 * c4 - x2 * s4) * sc, o2 = (x1 * s4 + x2 * c4) * sc;
                        u32x2 w1, w2; w1.x = cvt_pk_bf16(o1[0], o1[1]); w1.y = cvt_pk_bf16(o1[2], o1[3]); w2.x = cvt_pk_bf16(o2[0], o2[1]); w2.y = cvt_pk_bf16(o2[2], o2[3]);
                        bf16_t* p = dst + (size_t)row * 1024 + head * 256 + f0;
                        *(u32x2*)p = w1; *(u32x2*)(p + 128) = w2;
                    }
                }
        } else {
            const bool isg = pn >= 16; bf16_t* dst = isg ? G : V; const int colbase = ((pn - 8) & 7) * 256;
#pragma unroll
            for (int ai = 0; ai < 2; ++ai)
#pragma unroll
                for (int m = 0; m < 4; ++m) {
                    const int row = u.pm * BM + ai * HALF + wr * 64 + m * 16 + fr;
#pragma unroll
                    for (int bj = 0; bj < 2; ++bj)
#pragma unroll
                        for (int n = 0; n < 2; ++n) {
                            f32x4 v = acc[ai][bj][m][n];
                            if (isg) { v[0] = silu_f(v[0]); v[1] = silu_f(v[1]); v[2] = silu_f(v[2]); v[3] = silu_f(v[3]); }
                            u32x2 w; w.x = cvt_pk_bf16(v[0], v[1]); w.y = cvt_pk_bf16(v[2], v[3]);
                            *(u32x2*)(dst + (size_t)row * 2048 + colbase + bj * HALF + wc * 32 + n * 16 + fq * 4) = w;
                        }
                }
        }
    }
};
struct EpiResGate {
    static constexpr bool PERM = false, AFTER_DRAIN = false;
    const float* base; float* out; const float* gate; int gstride;
    __device__ __forceinline__ void operator()(const f32x4 (&acc)[2][2][4][2], const Unit& u, int wr, int wc, int fr, int fq) const {
        const int b = (u.pm * BM) >> 13; const float* gp = gate + (size_t)b * gstride;
        const int col0 = u.pn * BM + wc * 32 + 4 * fq;
        f32x4 gv[2][2];
#pragma unroll
        for (int bj = 0; bj < 2; ++bj)
#pragma unroll
            for (int n = 0; n < 2; ++n) gv[bj][n] = *(const f32x4*)(gp + col0 + bj * HALF + n * 16);
#pragma unroll
        for (int ai = 0; ai < 2; ++ai)
#pragma unroll
            for (int m = 0; m < 4; ++m) {
                const size_t off = (size_t)(u.pm * BM + ai * HALF + wr * 64 + m * 16 + fr) * 1024 + col0;
#pragma unroll
                for (int bj = 0; bj < 2; ++bj)
#pragma unroll
                    for (int n = 0; n < 2; ++n) { const f32x4 bs = *(const f32x4*)(base + off + bj * HALF + n * 16); *(f32x4*)(out + off + bj * HALF + n * 16) = bs + gv[bj][n] * acc[ai][bj][m][n]; }
            }
    }
};
struct EpiSguIn {
    static constexpr bool PERM = true, AFTER_DRAIN = false;
    bf16_t* U; bf16_t* Vb; const float* bias; float* stats;
    __device__ __forceinline__ void operator()(const f32x4 (&acc)[2][2][4][2], const Unit& u, int wr, int wc, int fr, int fq) const {
        const bool isv = u.pn >= 12; bf16_t* base = isv ? Vb : U; const int colt = (isv ? u.pn - 12 : u.pn) * BM;
        const int col0 = colt + wc * 32 + 8 * fq, bcol0 = u.pn * BM + wc * 32 + 8 * fq;
        f32x4 bv[2][2];
#pragma unroll
        for (int bj = 0; bj < 2; ++bj)
#pragma unroll
            for (int n = 0; n < 2; ++n) bv[bj][n] = *(const f32x4*)(bias + bcol0 + bj * HALF + 4 * n);
#pragma unroll
        for (int ai = 0; ai < 2; ++ai)
#pragma unroll
            for (int m = 0; m < 4; ++m) {
                const int row = u.pm * BM + ai * HALF + wr * 64 + m * 16 + fr;
                bf16_t* rowp = base + (size_t)row * 3072 + col0;
                float s1 = 0.f, s2 = 0.f;
#pragma unroll
                for (int bj = 0; bj < 2; ++bj) {
                    f32x4 v0 = acc[ai][bj][m][0] + bv[bj][0], v1 = acc[ai][bj][m][1] + bv[bj][1];
#pragma unroll
                    for (int j = 0; j < 4; ++j) { v0[j] = gelu_tanh(v0[j]); v1[j] = gelu_tanh(v1[j]); }
                    u32x4 w; w.x = cvt_pk_bf16(v0[0], v0[1]); w.y = cvt_pk_bf16(v0[2], v0[3]); w.z = cvt_pk_bf16(v1[0], v1[1]); w.w = cvt_pk_bf16(v1[2], v1[3]);
                    *(u32x4*)(rowp + bj * HALF) = w;
                    if (isv) {
#pragma unroll
                        for (int j = 0; j < 4; ++j) { const unsigned ww = j == 0 ? w.x : j == 1 ? w.y : j == 2 ? w.z : w.w;
                            const float a = __uint_as_float(ww << 16), bq = __uint_as_float(ww & 0xffff0000u); s1 += a + bq; s2 += a * a + bq * bq; }
                    }
                }
                if (isv) {
                    s1 += __shfl_xor(s1, 16); s1 += __shfl_xor(s1, 32); s2 += __shfl_xor(s2, 16); s2 += __shfl_xor(s2, 32);
                    if (fq == 0) { float* sp = stats + ((size_t)row * 48 + (u.pn - 12) * 4 + wc) * 2; sp[0] = s1; sp[1] = s2; }
                }
            }
    }
};
}
typedef unsigned u32x4 __attribute__((ext_vector_type(4)));
#define GAS __attribute__((address_space(1)))
#define LAS __attribute__((address_space(3)))
typedef unsigned short bf16;
typedef unsigned v4u __attribute__((ext_vector_type(4)));
typedef float f32x4 __attribute__((ext_vector_type(4)));
typedef short bf16x8 __attribute__((ext_vector_type(8)));
typedef GAS unsigned gu32;
typedef GAS unsigned long long gu64;
#define RLX_AGENT __ATOMIC_RELAXED, __HIP_MEMORY_SCOPE_AGENT
#define LDS_WAIT() asm volatile("s_waitcnt lgkmcnt(0)" ::: "memory")
#define VM_WAIT() asm volatile("s_waitcnt vmcnt(0)" ::: "memory")
__device__ __forceinline__ unsigned long long rt() { return __builtin_amdgcn_s_memrealtime(); }
__device__ __forceinline__ unsigned f2bf(float f) { unsigned u = __builtin_bit_cast(unsigned, f); return (u + 0x7fffu + ((u >> 16) & 1u)) >> 16; }
__device__ __forceinline__ unsigned pk2(float lo, float hi) { return f2bf(lo) | (f2bf(hi) << 16); }

#define XB_TMO      128
#define XB_XCNT(j)  (256  + 64 * (j))
#define XB_XSUB(j)  (1280 + 64 * (j))
#define XB_XGEN(j)  (2304 + 64 * (j))
#define XB_TOP      3328
#define XB_TOPGEN   3392
#define XCD_BAR_WORDS 3456
#define XB_SPIN_CAP (1u << 18)

__device__ __forceinline__ unsigned xb_ld(unsigned* p)              { return __hip_atomic_load(p, __ATOMIC_RELAXED, __HIP_MEMORY_SCOPE_AGENT); }
__device__ __forceinline__ unsigned xb_add(unsigned* p, unsigned v) { return __hip_atomic_fetch_add(p, v, __ATOMIC_RELAXED, __HIP_MEMORY_SCOPE_AGENT); }
__device__ __forceinline__ unsigned xb_xcc_id() { return (unsigned)__builtin_amdgcn_s_getreg((3 << 11) | 20) & 0xFu; }
#define XB_SPIN(cond, bar) do { unsigned _sp = 0; while (cond) { __builtin_amdgcn_s_sleep(1); \
    if ((++_sp & 255u) == 0u) { if (xb_ld(&(bar)[XB_TMO])) break; if (_sp > XB_SPIN_CAP) { atomicAdd(&(bar)[XB_TMO], 1u); break; } } } } while (0)

struct XcdBarrier {
    unsigned* bar; unsigned x;
    volatile LAS unsigned* st;
};

__device__ __forceinline__ XcdBarrier xcd_barrier_post(unsigned* bar, volatile LAS unsigned* st) {
    XcdBarrier b; b.bar = bar; b.x = xb_xcc_id(); b.st = st;
    if (threadIdx.x == 0) (void)xb_add(&bar[XB_XCNT(b.x)], 1u);
    return b;
}
__device__ __forceinline__ void xcd_barrier_complete(unsigned* bar, unsigned x, unsigned& nloc, unsigned& nx) {
    const unsigned G = gridDim.x * gridDim.y * gridDim.z;
    unsigned sum, cnt, mine, sp = 0u;
    for (;;) {
        sum = 0u; cnt = 0u; mine = 0u;
#pragma unroll
        for (unsigned j = 0; j < 16; ++j) { const unsigned c = xb_ld(&bar[XB_XCNT(j)]); sum += c; cnt += (c > 0u) ? 1u : 0u; mine = (j == x) ? c : mine; }
        if (sum == G) break;
        __builtin_amdgcn_s_sleep(1);
        if ((++sp & 255u) == 0u) { if (xb_ld(&bar[XB_TMO])) break; if (sp > XB_SPIN_CAP) { atomicAdd(&bar[XB_TMO], 1u); break; } }
    }
    nloc = mine > 0u ? mine : 1u; nx = cnt > 0u ? cnt : 1u;
}

__device__ __forceinline__ void xcd_barrier(const XcdBarrier& b) {
    asm volatile("s_waitcnt vmcnt(0)" ::: "memory");
    __syncthreads();
    if (threadIdx.x == 0) {
        unsigned* bar = b.bar;
        __builtin_amdgcn_s_waitcnt(0);
        unsigned nloc = b.st[0], nx = b.st[1];
        if (nloc == 0u) { xcd_barrier_complete(bar, b.x, nloc, nx); b.st[0] = nloc; b.st[1] = nx; }
        const unsigned old = xb_add(&bar[XB_XSUB(b.x)], 1u);
        const unsigned gen = old / nloc;
        if (old + 1u == (gen + 1u) * nloc) {
            __builtin_amdgcn_fence(__ATOMIC_RELEASE, "agent");
            asm volatile("s_waitcnt vmcnt(0)" ::: "memory");
            const unsigned og = xb_add(&bar[XB_TOP], 1u);
            const unsigned tg = og / nx;
            if (og + 1u == (tg + 1u) * nx) xb_add(&bar[XB_TOPGEN], 1u);
            else XB_SPIN(xb_ld(&bar[XB_TOPGEN]) == tg, bar);
            __builtin_amdgcn_fence(__ATOMIC_ACQUIRE, "agent");
            xb_add(&bar[XB_XGEN(b.x)], 1u);
            asm volatile("s_waitcnt vmcnt(0)" ::: "memory");
        } else {
            XB_SPIN(xb_ld(&bar[XB_XGEN(b.x)]) == gen, bar);
            __builtin_amdgcn_fence(__ATOMIC_ACQUIRE, "agent");
            asm volatile("s_waitcnt vmcnt(0)" ::: "memory");
        }
    }
    __syncthreads();
}
__device__ __forceinline__ float wave_sum(float v) {
#pragma unroll
    for (int o = 1; o < 64; o <<= 1) v += __shfl_xor(v, o);
    return v;
}
__device__ __forceinline__ void p0_transpose_item(const float* W, int K, int N, bf16* WT, int row_off, LAS float* scr, int item, int lane) {
    const int nblk = N / 32, kb = item / nblk, nb = item % nblk, k0 = 64 * kb, n0 = 32 * nb;
#pragma unroll 8
    for (int i = 0; i < 32; ++i) { const int kk = 2 * i + (lane >> 5); scr[kk * 33 + (lane & 31)] = W[(size_t)(k0 + kk) * N + n0 + (lane & 31)]; }
    LDS_WAIT(); asm volatile("" ::: "memory");
    const int c = lane & 7;
#pragma unroll
    for (int j = 0; j < 4; ++j) { const int n = (lane >> 3) + 8 * j; const LAS float* s = scr + (8 * c) * 33 + n;
        v4u o; o.x = pk2(s[0 * 33], s[1 * 33]); o.y = pk2(s[2 * 33], s[3 * 33]); o.z = pk2(s[4 * 33], s[5 * 33]); o.w = pk2(s[6 * 33], s[7 * 33]);
        *(GAS v4u*)(WT + (size_t)(row_off + n0 + n) * K + k0 + 8 * c) = o; }
    LDS_WAIT(); asm volatile("" ::: "memory");
}
#define DI __device__ __forceinline__
constexpr int NWAVES = 8;
constexpr int TT = 16384, DM = 1024, SEQ = 8192;
constexpr size_t MiB = 1u << 20;
constexpr size_t WS_CTL = 0, CTL_ZERO_BYTES = 32768, WS_MOD = 512 * 1024;
constexpr size_t WS_COS = 2 * MiB, WS_SIN = 10 * MiB;
constexpr size_t WS_WRI = 18 * MiB, WS_WRO = 30 * MiB, WS_WSI = 34 * MiB, WS_WSO = 46 * MiB, WS_WQ = 52 * MiB, WS_KEYS = 60 * MiB;
constexpr size_t WS_ISU = 61 * MiB, WS_ISV = 61 * MiB + 256 * 1024;
constexpr size_t WS_STATS = 62 * MiB, WS_IDX = 68 * MiB, WS_GATE = 76 * MiB, WS_H = 84 * MiB, WS_PU = 116 * MiB, WS_PV = 180 * MiB;
constexpr size_t WS_R = 244 * MiB;
constexpr size_t WS_Q = WS_R, WS_K = WS_R + 32 * MiB, WS_V = WS_R + 64 * MiB, WS_G = WS_R + 128 * MiB, WS_CROSS = WS_R + 192 * MiB;
constexpr size_t WS_QP = WS_R, WS_SC = WS_R + 64 * MiB;
constexpr size_t WS_U = WS_R, WS_VB = WS_R + 96 * MiB;
constexpr size_t WS_END = 500 * MiB;
constexpr int CW_TMO = 0, CW_BAR = 4096;
constexpr int RING_OFF = 0, RING_BYTES = 131072, LDS_BYTES = 163840, LDSCTL_OFF = LDS_BYTES - 1024, MISC_OFF = LDSCTL_OFF + 320;
constexpr int PTR_OFF = LDSCTL_OFF + 512;
constexpr float EPS = 1e-6f;
typedef float f32x2_t __attribute__((ext_vector_type(2)));

DI float bf2f(bf16 h) { return __uint_as_float((unsigned)h << 16); }
DI float bflo(unsigned w) { return __uint_as_float(w << 16); }
DI float bfhi(unsigned w) { return __uint_as_float(w & 0xffff0000u); }
DI float wave_max(float v) {
#pragma unroll
    for (int o = 1; o < 64; o <<= 1) v = fmaxf(v, __shfl_xor(v, o));
    return v;
}
DI float gelu_t(float x) { return pg8::gelu_tanh(x); }

struct Ctx {
    LAS unsigned char* lds; int tid, lane, wave, vcu, G;
    unsigned char* ws;
};

DI const void* ldp(const Ctx& C, int i) {
    const unsigned long long v = ((const LAS unsigned long long*)(C.lds + PTR_OFF))[i];
    const unsigned lo = __builtin_amdgcn_readfirstlane((unsigned)v), hi = __builtin_amdgcn_readfirstlane((unsigned)(v >> 32));
    return (const void*)(((unsigned long long)hi << 32) | lo);
}
DI void cvt_rows_fp8(const float* src, unsigned char* dst, float* inv_scale, int nrows, int gw, int NGW, int lane) {
    for (int r = gw; r < nrows; r += NGW) {
        const f32x4* s = (const f32x4*)(src + (size_t)r * 1024) + lane * 4;
        f32x4 v[4]; float am = 0.f;
#pragma unroll
        for (int q = 0; q < 4; ++q) { v[q] = s[q]; am = fmaxf(am, fmaxf(fmaxf(fabsf(v[q][0]), fabsf(v[q][1])), fmaxf(fabsf(v[q][2]), fabsf(v[q][3])))); }
        am = wave_max(am);
        const int e = (int)((__float_as_uint(am) >> 23) & 0xffu) - 127;
        const bool ok = am > 1e-30f;
        const float sc = ok ? __uint_as_float((unsigned)(127 + 7 - e) << 23) : 1.0f, isc = ok ? __uint_as_float((unsigned)(127 - 7 + e) << 23) : 1.0f;
        u32x4 o;
#pragma unroll
        for (int q = 0; q < 4; ++q) { int wd = __builtin_amdgcn_cvt_pk_fp8_f32(v[q][0] * sc, v[q][1] * sc, 0, false); wd = __builtin_amdgcn_cvt_pk_fp8_f32(v[q][2] * sc, v[q][3] * sc, wd, true); o[q] = (unsigned)wd; }
        *(u32x4*)(dst + (size_t)r * 1024 + lane * 16) = o;
        if (lane == 0) inv_scale[r] = isc;
    }
}
DI void cvt_rows_i8(const float* src, unsigned char* dst, float* inv_scale, int nrows, int gw, int NGW, int lane) {
    for (int r = gw; r < nrows; r += NGW) {
        const f32x4* s = (const f32x4*)(src + (size_t)r * 1024) + lane * 4;
        f32x4 v[4]; float am = 0.f;
#pragma unroll
        for (int q = 0; q < 4; ++q) { v[q] = s[q]; am = fmaxf(am, fmaxf(fmaxf(fabsf(v[q][0]), fabsf(v[q][1])), fmaxf(fabsf(v[q][2]), fabsf(v[q][3])))); }
        am = wave_max(am);
        const int e = (int)((__float_as_uint(am) >> 23) & 0xffu) - 127;
        const bool ok = am > 1e-30f;
        const float sc = ok ? __uint_as_float((unsigned)(127 + 6 - e) << 23) : 1.0f, isc = ok ? __uint_as_float((unsigned)(127 - 6 + e) << 23) : 1.0f;
        u32x4 o;
#pragma unroll
        for (int q = 0; q < 4; ++q) { unsigned wd = 0u;
#pragma unroll
            for (int j = 0; j < 4; ++j) { int qi = (int)rintf(v[q][j] * sc); qi = qi > 127 ? 127 : (qi < -127 ? -127 : qi); wd |= ((unsigned)qi & 0xffu) << (8 * j); }
            o[q] = wd; }
        *(u32x4*)(dst + (size_t)r * 1024 + lane * 16) = o;
        if (lane == 0) inv_scale[r] = isc;
    }
}
DI void cvt_stream(const float* src, bf16* dst, size_t n4, size_t gtid, size_t gthreads) {
    const f32x4* s = (const f32x4*)src; uint2* d = (uint2*)dst;
    for (size_t i = gtid; i < n4; i += gthreads) { const f32x4 v = s[i]; uint2 o; o.x = pk2(v.x, v.y); o.y = pk2(v.z, v.w); d[i] = o; }
}
struct P0In { const float *c, *ada_w, *ada_b, *ret_w_in, *ret_w_out, *sgu_w_in, *sgu_w_out, *wq, *keys, *pu, *pv; const int* pos; };
DI void p0_prologue(const Ctx& C, const P0In& I) {
    LAS float* scr = (LAS float*)(C.lds + RING_OFF + C.wave * 16384);
    const int gw = C.vcu * NWAVES + C.wave, NGW = C.G * NWAVES;
    bf16* wri = (bf16*)(C.ws + WS_WRI); bf16* wro = (bf16*)(C.ws + WS_WRO);
    constexpr int I_RI = 16 * 192, I_RO = 32 * 32;
    constexpr int NITEMS = I_RI + I_RO;
    for (int it = gw; it < NITEMS; it += NGW) {
        int r = it;
        if (r < I_RI) { p0_transpose_item(I.ret_w_in, 1024, 6144, wri, 0, scr, r, C.lane); continue; } r -= I_RI;
        p0_transpose_item(I.ret_w_out, 2048, 1024, wro, 0, scr, r, C.lane);
    }
    const size_t gtid = (size_t)C.vcu * 512 + C.tid, gth = (size_t)C.G * 512;
    cvt_stream(I.keys, (bf16*)(C.ws + WS_KEYS), (size_t)2 * 8 * 2 * 128 * 128 / 4, gtid, gth);
    float* mod = (float*)(C.ws + WS_MOD);
    __syncthreads();
    for (int it = C.vcu; it < 2 * 96; it += C.G) {
        const int l = it / 96, cb = it % 96, kp = C.wave, n = cb * 64 + C.lane;
        const float* W = I.ada_w + (size_t)l * 1024 * 6144 + n;
        float a0 = 0.f, a1 = 0.f;
#pragma unroll 8
        for (int k = kp * 128; k < kp * 128 + 128; ++k) {
            const float w = W[(size_t)k * 6144]; const float c0 = I.c[k], c1 = I.c[1024 + k];
            a0 += pg8::silu_f(c0) * w; a1 += pg8::silu_f(c1) * w;
        }
        LAS float* red = (LAS float*)(C.lds + RING_OFF);
        red[(kp * 2 + 0) * 64 + C.lane] = a0; red[(kp * 2 + 1) * 64 + C.lane] = a1;
        __syncthreads();
        if (C.wave < 2) { float s = I.ada_b[l * 6144 + n];
#pragma unroll
            for (int q = 0; q < 8; ++q) s += red[(q * 2 + C.wave) * 64 + C.lane];
            mod[(size_t)(l * 2 + C.wave) * 6144 + n] = s; }
        __syncthreads();
    }
    float* cosT = (float*)(C.ws + WS_COS); float* sinT = (float*)(C.ws + WS_SIN);
    for (int it = gw; it < TT / 2; it += NGW) {
        const int row = 2 * it + (C.lane >> 5), f0 = (C.lane & 31) * 4; const float p = (float)I.pos[row];
        f32x4 cv, sv;
#pragma unroll
        for (int j = 0; j < 4; ++j) { const int f = f0 + j; double w = 1.0, bs = 0.93057204092969898;
#pragma unroll
            for (int bit = 0; bit < 7; ++bit) { if ((f >> bit) & 1) w *= bs; bs *= bs; }
            const float ang = p * (float)w; const double r = (double)ang * 0.15915494309189535; const float fr = (float)(r - floor(r)); cv[j] = __builtin_amdgcn_cosf(fr); sv[j] = __builtin_amdgcn_sinf(fr); }
        *(f32x4*)(cosT + (size_t)row * 128 + f0) = cv; *(f32x4*)(sinT + (size_t)row * 128 + f0) = sv;
    }
}
DI void side_work(const Ctx& C, const P0In& I, int nskip) {
    LAS float* scr = (LAS float*)(C.lds + RING_OFF + C.wave * 16384);
    const int gw = (C.vcu - nskip) * NWAVES + C.wave, NGW = (C.G - nskip) * NWAVES;
    bf16* wsi = (bf16*)(C.ws + WS_WSI); bf16* wso = (bf16*)(C.ws + WS_WSO); bf16* wq = (bf16*)(C.ws + WS_WQ);
    constexpr int I_SI = 16 * 192, I_SO = 48 * 32, I_Q = 16 * 64;
    constexpr int NITEMS = I_SI + I_SO + 2 * I_Q;
    for (int it = gw; it < NITEMS; it += NGW) {
        int r = it;
        if (r < I_SI) { p0_transpose_item(I.sgu_w_in, 1024, 6144, wsi, 0, scr, r, C.lane); continue; } r -= I_SI;
        if (r < I_SO) { p0_transpose_item(I.sgu_w_out, 3072, 1024, wso, 0, scr, r, C.lane); continue; } r -= I_SO;
        if (r < I_Q) { p0_transpose_item(I.wq, 1024, 2048, wq, 0, scr, r, C.lane); continue; } r -= I_Q;
        p0_transpose_item(I.wq + (size_t)1024 * 2048, 1024, 2048, wq + (size_t)2048 * 1024, 0, scr, r, C.lane);
    }
    cvt_rows_i8(I.pu, (unsigned char*)(C.ws + WS_PU), (float*)(C.ws + WS_ISU), 2 * 16384, gw, NGW, C.lane);
    cvt_rows_fp8(I.pv, (unsigned char*)(C.ws + WS_PV), (float*)(C.ws + WS_ISV), 2 * 16384, gw, NGW, C.lane);
}
DI void rms_mod_row(const float* xrow, const float* gain, const float* shift, const float* scale, bf16* orow, int lane) {
    const f32x4* xr = (const f32x4*)xrow + lane; f32x4 v[4]; float s = 0.f;
#pragma unroll
    for (int j = 0; j < 4; ++j) { v[j] = xr[64 * j]; s += (v[j].x * v[j].x + v[j].y * v[j].y) + (v[j].z * v[j].z + v[j].w * v[j].w); }
    const float rstd = 1.0f / sqrtf(wave_sum(s) * (1.0f / 1024.0f) + EPS);
    uint2* o8 = (uint2*)orow + lane;
#pragma unroll
    for (int j = 0; j < 4; ++j) { const f32x4 g = ((const f32x4*)gain)[lane + 64 * j], sh = ((const f32x4*)shift)[lane + 64 * j], sc = ((const f32x4*)scale)[lane + 64 * j];
        const f32x4 y = v[j] * rstd * g * (sc + 1.0f) + sh; uint2 o; o.x = pk2(y.x, y.y); o.y = pk2(y.z, y.w); o8[64 * j] = o; }
}
DI void rms_mod_phase(const Ctx& C, const float* x, const float* gain, const float* mod_l, int sh_off, int sc_off, bf16* H) {
    const int gw = C.vcu * NWAVES + C.wave, NGW = C.G * NWAVES;
    for (int m = gw; m < TT; m += NGW) { const float* ml = mod_l + (size_t)(m >> 13) * 6144; rms_mod_row(x + (size_t)m * DM, gain, ml + sh_off, ml + sc_off, H + (size_t)m * DM, C.lane); }
}

DI void scan_naive(const Ctx& C, const bf16* Q, const bf16* K, const bf16* V, bf16* CROSS) {
    LAS float* Sst = (LAS float*)(C.lds);
    LAS unsigned* Qs = (LAS unsigned*)(C.lds + 16384);
    LAS bf16* Ks = (LAS bf16*)(C.lds + 16384 + 32768);
    LAS float* Vs = (LAS float*)(C.lds + 16384 + 65536);
    const int tid = C.tid;
    for (int item = C.vcu; item < 256; item += C.G) {
        const int b = item >> 7, h = (item >> 5) & 3, es = item & 31;
        const float lg2 = log2f(1.0f - exp2f(-5.0f - (float)h)); const float gc = exp2f(lg2 * 64.0f);
        for (int i = tid; i < 4096; i += 512) Sst[i] = 0.f;
        __syncthreads();
        for (int n = 0; n < 128; ++n) {
            const size_t tok0 = (size_t)b * SEQ + (size_t)n * 64;
            for (int ch = tid; ch < 2048; ch += 512) { const int r = ch >> 5, c = ch & 31;
                const u32x4 q = *(const u32x4*)(Q + (tok0 + r) * 1024 + h * 256 + c * 8); *(LAS u32x4*)(Qs + r * 128 + c * 4) = q;
                const u32x4 k = *(const u32x4*)(K + (tok0 + r) * 1024 + h * 256 + c * 8); *(LAS u32x4*)((LAS unsigned*)Ks + r * 128 + c * 4) = k; }
            for (int o = tid; o < 1024; o += 512) { const int j = o >> 4, e = o & 15; Vs[o] = bf2f(V[(tok0 + j) * 2048 + h * 512 + es * 16 + e]) * exp2f(lg2 * (float)(63 - j)); }
            __syncthreads();
#pragma unroll
            for (int oo = 0; oo < 2; ++oo) { const int o = tid + oo * 512, i = o >> 4, e = o & 15; float acc = 0.f;
#pragma unroll 8
                for (int d2 = 0; d2 < 128; ++d2) { const unsigned q2 = Qs[i * 128 + d2]; acc += bflo(q2) * Sst[(2 * d2) * 16 + e] + bfhi(q2) * Sst[(2 * d2 + 1) * 16 + e]; }
                CROSS[(tok0 + i) * 2048 + h * 512 + es * 16 + e] = (bf16)f2bf(acc * exp2f(lg2 * (float)(i + 1))); }
            __syncthreads();
            { const int e = tid & 15, dg = tid >> 4; float a[8];
#pragma unroll
              for (int r = 0; r < 8; ++r) a[r] = gc * Sst[(dg + 32 * r) * 16 + e];
#pragma unroll 4
              for (int j = 0; j < 64; ++j) { const float vz = Vs[j * 16 + e];
#pragma unroll
                  for (int r = 0; r < 8; ++r) a[r] += bf2f(Ks[j * 256 + dg + 32 * r]) * vz; }
#pragma unroll
              for (int r = 0; r < 8; ++r) Sst[(dg + 32 * r) * 16 + e] = a[r]; }
            __syncthreads();
        }
    }
}
DI void intra_naive(const Ctx& C, const bf16* Q, const bf16* K, const bf16* V, const bf16* CROSS, bf16* G) {
    LAS unsigned* Qs = (LAS unsigned*)(C.lds);
    LAS unsigned* Ks = (LAS unsigned*)(C.lds + 32768);
    LAS float* SC = (LAS float*)(C.lds + 65536);
    LAS float* red = (LAS float*)(C.lds + 65536 + 16384);
    LAS float* rs = red + 512;
    const int tid = C.tid;
    for (int item = C.vcu; item < 1024; item += C.G) {
        const int b = item >> 9, h = (item >> 7) & 3, n = item & 127;
        const float lg2 = log2f(1.0f - exp2f(-5.0f - (float)h));
        const size_t tok0 = (size_t)b * SEQ + (size_t)n * 64;
        for (int ch = tid; ch < 2048; ch += 512) { const int r = ch >> 5, c = ch & 31;
            *(LAS u32x4*)(Qs + r * 128 + c * 4) = *(const u32x4*)(Q + (tok0 + r) * 1024 + h * 256 + c * 8);
            *(LAS u32x4*)(Ks + r * 128 + c * 4) = *(const u32x4*)(K + (tok0 + r) * 1024 + h * 256 + c * 8); }
        __syncthreads();
        { const int i = tid >> 3, jb = (tid & 7) * 8;
#pragma unroll
          for (int jj = 0; jj < 8; ++jj) { const int j = jb + jj; float acc = 0.f;
#pragma unroll 8
              for (int d2 = 0; d2 < 128; ++d2) { const unsigned q2 = Qs[i * 128 + d2], k2 = Ks[j * 128 + d2]; acc += bflo(q2) * bflo(k2) + bfhi(q2) * bfhi(k2); }
              const int dd = i > j ? i - j : j - i; SC[i * 64 + j] = acc * exp2f(lg2 * (float)dd); } }
        __syncthreads();
#pragma unroll 1
        for (int pass = 0; pass < 2; ++pass) { const int e = tid, ib = pass * 32; float y[32];
#pragma unroll
          for (int i = 0; i < 32; ++i) y[i] = 0.f;
          const bf16* vp = V + tok0 * 2048 + h * 512 + e;
#pragma unroll 1
          for (int j4 = 0; j4 < 16; ++j4) {
              const float v0 = bf2f(vp[(size_t)(4 * j4 + 0) * 2048]), v1 = bf2f(vp[(size_t)(4 * j4 + 1) * 2048]), v2 = bf2f(vp[(size_t)(4 * j4 + 2) * 2048]), v3 = bf2f(vp[(size_t)(4 * j4 + 3) * 2048]);
#pragma unroll
              for (int i = 0; i < 32; ++i) { const f32x4 s4 = *(const LAS f32x4*)(SC + (ib + i) * 64 + 4 * j4); y[i] += (s4.x * v0 + s4.y * v1) + (s4.z * v2 + s4.w * v3); }
          }
          const bf16* cp = CROSS + (tok0 + ib) * 2048 + h * 512 + e;
#pragma unroll
          for (int i = 0; i < 32; ++i) { y[i] += bf2f(cp[(size_t)i * 2048]); const float ss = wave_sum(y[i] * y[i]); if (C.lane == 0) red[C.wave * 64 + i] = ss; }
          __syncthreads();
          if (tid < 32) { float s = 0.f;
#pragma unroll
              for (int w = 0; w < 8; ++w) s += red[w * 64 + tid];
              rs[tid] = 1.0f / sqrtf(s * (1.0f / 512.0f) + EPS); }
          __syncthreads();
          bf16* gp = G + (tok0 + ib) * 2048 + h * 512 + e;
#pragma unroll
          for (int i = 0; i < 32; ++i) { const float g = bf2f(gp[(size_t)i * 2048]); gp[(size_t)i * 2048] = (bf16)f2bf(y[i] * rs[i] * g); }
          __syncthreads();
        }
        __syncthreads();
    }
}
DI void peer_scores(const Ctx& C, const bf16* QP, const bf16* KEYS  , float* SCO) {
    const int gw = C.vcu * NWAVES + C.wave, NGW = C.G * NWAVES; const int fr = C.lane & 15, fq = C.lane >> 4;
    for (int it = gw; it < 1024 * 8; it += NGW) {
        const int tt = it >> 3, h = it & 7; const int tok = tt * 16 + fr;
#pragma unroll
        for (int p = 0; p < 2; ++p) {
            bf16x8 qf[4];
#pragma unroll
            for (int ks = 0; ks < 4; ++ks) qf[ks] = *(const bf16x8*)(QP + (size_t)tok * 2048 + h * 256 + p * 128 + ks * 32 + fq * 8);
            const bf16* kb = KEYS + (size_t)(h * 2 + p) * 128 * 128;
#pragma unroll
            for (int kt = 0; kt < 8; ++kt) {
                f32x4 acc = {0.f, 0.f, 0.f, 0.f};
#pragma unroll
                for (int ks = 0; ks < 4; ++ks) { const bf16x8 kf = *(const bf16x8*)(kb + (size_t)(kt * 16 + fr) * 128 + ks * 32 + fq * 8);
                    acc = __builtin_amdgcn_mfma_f32_16x16x32_bf16(kf, qf[ks], acc, 0, 0, 0); }
                *(f32x4*)(SCO + ((size_t)tok * 8 + h) * 256 + p * 128 + kt * 16 + fq * 4) = acc;
            }
        }
    }
}
template <bool HALVES> DI void select16(const float (&v)[4], int lane, bool (&sel)[4], int (&pos)[4]) {
    float mx = fmaxf(fmaxf(v[0], v[1]), fmaxf(v[2], v[3])), mn = fminf(fminf(v[0], v[1]), fminf(v[2], v[3]));
#pragma unroll
    for (int o = 1; o < (HALVES ? 32 : 64); o <<= 1) { mx = fmaxf(mx, __shfl_xor(mx, o)); mn = fminf(mn, __shfl_xor(mn, o)); }
    const bool up = HALVES && lane >= 32;
    float lo = mn, hi = mx, thr = mn; bool done = false;
    for (int iter = 0; iter < 48; ++iter) {
        const float mid = done ? thr : 0.5f * (lo + hi);
        int cnt = 0;
#pragma unroll
        for (int c = 0; c < 4; ++c) { const unsigned long long m = __ballot(v[c] >= mid);
            cnt += HALVES ? (up ? __popc((unsigned)(m >> 32)) : __popc((unsigned)m)) : __popcll(m); }
        if (!done) { if (cnt == 16) { thr = mid; done = true; } else if (cnt > 16) { lo = mid; thr = mid; } else hi = mid; }
        if (__all(done)) break;
    }
    int base = 0;
#pragma unroll
    for (int c = 0; c < 4; ++c) { sel[c] = v[c] >= thr; const unsigned long long m = __ballot(sel[c]);
        const unsigned long long gm = HALVES ? (up ? (m >> 32) : (m & 0xffffffffull)) : m; const int ll = HALVES ? (lane & 31) : lane;
        pos[c] = base + __popcll(gm & ((1ull << ll) - 1ull)); base += __popcll(gm); sel[c] = sel[c] && pos[c] < 16; }
}
DI void peer_topk(const Ctx& C, const float* SCO, int* IDX, float* GATE) {
    LAS float* sv = (LAS float*)(C.lds + C.wave * 512);
    LAS int* si = (LAS int*)(C.lds + C.wave * 512 + 128);
    LAS float* fv = (LAS float*)(C.lds + C.wave * 512 + 256);
    LAS int* fi = (LAS int*)(C.lds + C.wave * 512 + 320);
    const int gw = C.vcu * NWAVES + C.wave, NGW = C.G * NWAVES, lane = C.lane;
    for (int it = gw; it < TT * 8; it += NGW) {
        const f32x4 s4 = *(const f32x4*)(SCO + (size_t)it * 256 + lane * 4);
        float v[4] = {s4.x, s4.y, s4.z, s4.w}; bool sel[4]; int pos[4];
        select16<true>(v, lane, sel, pos);
        const int p = lane >> 5;
#pragma unroll
        for (int c = 0; c < 4; ++c) if (sel[c]) { sv[p * 16 + pos[c]] = v[c]; si[p * 16 + pos[c]] = (lane & 31) * 4 + c; }
        LDS_WAIT();
        const int a = lane >> 2, bq = (lane & 3) * 4; const float va = sv[a]; const int ia = si[a];
        float w[4]; int wi[4];
#pragma unroll
        for (int c = 0; c < 4; ++c) { w[c] = va + sv[16 + bq + c]; wi[c] = ia * 128 + si[16 + bq + c]; }
        select16<false>(w, lane, sel, pos);
#pragma unroll
        for (int c = 0; c < 4; ++c) if (sel[c]) { fv[pos[c]] = w[c]; fi[pos[c]] = wi[c]; }
        LDS_WAIT();
        const float x = fv[lane & 15]; const int xi = fi[lane & 15];
        float m = x;
#pragma unroll
        for (int o = 1; o < 16; o <<= 1) m = fmaxf(m, __shfl_xor(m, o));
        const float e = __expf(x - m); float s = e;
#pragma unroll
        for (int o = 1; o < 16; o <<= 1) s += __shfl_xor(s, o);
        if (lane < 16) { IDX[(size_t)it * 16 + lane] = xi; GATE[(size_t)it * 16 + lane] = e / s; }
        LDS_WAIT();
    }
}
template <bool FINAL> DI void peer_gather(const Ctx& C, const bf16* H, const int* IDX, const float* GATE, const bf16* PU, const bf16* PV, float* X, const float* g2  ,
                                          const float* ngain, const float* nmod  , bf16* Hn) {
    const int gw = C.vcu * NWAVES + C.wave, NGW = C.G * NWAVES, lane = C.lane;
    for (int t = gw; t < TT; t += NGW) {
        float hv[16];
        { const u32x4 a = *(const u32x4*)(H + (size_t)t * 1024 + lane * 8), bq = *(const u32x4*)(H + (size_t)t * 1024 + 512 + lane * 8);
          hv[0] = bflo(a.x); hv[1] = bfhi(a.x); hv[2] = bflo(a.y); hv[3] = bfhi(a.y); hv[4] = bflo(a.z); hv[5] = bfhi(a.z); hv[6] = bflo(a.w); hv[7] = bfhi(a.w);
          hv[8] = bflo(bq.x); hv[9] = bfhi(bq.x); hv[10] = bflo(bq.y); hv[11] = bfhi(bq.y); hv[12] = bflo(bq.z); hv[13] = bfhi(bq.z); hv[14] = bflo(bq.w); hv[15] = bfhi(bq.w); }
        const int i0 = IDX[(size_t)t * 128 + lane], i1 = IDX[(size_t)t * 128 + 64 + lane];
        const float g0 = GATE[(size_t)t * 128 + lane], g1 = GATE[(size_t)t * 128 + 64 + lane];
        float a0 = 0.f, a1 = 0.f;
        for (int k = 0; k < 128; k += 4) {
            float dsum[4];
#pragma unroll
            for (int kk = 0; kk < 4; ++kk) { const int kq = k + kk; const int e = kq < 64 ? __builtin_amdgcn_readlane(i0, kq) : __builtin_amdgcn_readlane(i1, kq - 64);
                const bf16* ur = PU + (size_t)e * 1024; const u32x4 a = *(const u32x4*)(ur + lane * 8), bq = *(const u32x4*)(ur + 512 + lane * 8);
                float d = bflo(a.x) * hv[0] + bfhi(a.x) * hv[1]; d += bflo(a.y) * hv[2] + bfhi(a.y) * hv[3]; d += bflo(a.z) * hv[4] + bfhi(a.z) * hv[5]; d += bflo(a.w) * hv[6] + bfhi(a.w) * hv[7];
                d += bflo(bq.x) * hv[8] + bfhi(bq.x) * hv[9]; d += bflo(bq.y) * hv[10] + bfhi(bq.y) * hv[11]; d += bflo(bq.z) * hv[12] + bfhi(bq.z) * hv[13]; d += bflo(bq.w) * hv[14] + bfhi(bq.w) * hv[15];
                dsum[kk] = d; }
#pragma unroll
            for (int kk = 0; kk < 4; ++kk) { const int kq = k + kk; const float d = gelu_t(wave_sum(dsum[kk]));
                if (kq < 64) { if (lane == kq) a0 = d * g0; } else { if (lane == kq - 64) a1 = d * g1; } }
        }
        float o[16];
#pragma unroll
        for (int j = 0; j < 16; ++j) o[j] = 0.f;
        for (int k = 0; k < 128; k += 4) {
#pragma unroll
            for (int kk = 0; kk < 4; ++kk) { const int kq = k + kk; const int e = kq < 64 ? __builtin_amdgcn_readlane(i0, kq) : __builtin_amdgcn_readlane(i1, kq - 64);
                const float ak = __int_as_float(kq < 64 ? __builtin_amdgcn_readlane(__float_as_int(a0), kq) : __builtin_amdgcn_readlane(__float_as_int(a1), kq - 64));
                const bf16* vr = PV + (size_t)e * 1024; const u32x4 a = *(const u32x4*)(vr + lane * 8), bq = *(const u32x4*)(vr + 512 + lane * 8);
                o[0] += ak * bflo(a.x); o[1] += ak * bfhi(a.x); o[2] += ak * bflo(a.y); o[3] += ak * bfhi(a.y); o[4] += ak * bflo(a.z); o[5] += ak * bfhi(a.z); o[6] += ak * bflo(a.w); o[7] += ak * bfhi(a.w);
                o[8] += ak * bflo(bq.x); o[9] += ak * bfhi(bq.x); o[10] += ak * bflo(bq.y); o[11] += ak * bfhi(bq.y); o[12] += ak * bflo(bq.z); o[13] += ak * bfhi(bq.z); o[14] += ak * bflo(bq.w); o[15] += ak * bfhi(bq.w); }
        }
#ifdef DBG_ZERO_PEER
#pragma unroll
        for (int j = 0; j < 16; ++j) o[j] = 0.f;
#endif
        const int b = t >> 13; const float* gp = g2 + (size_t)b * 6144; float* xr = X + (size_t)t * 1024;
        float xn[16]; float ss = 0.f;
#pragma unroll
        for (int q = 0; q < 4; ++q) { const int col = (q >> 1) * 512 + lane * 8 + (q & 1) * 4; const f32x4 xv = *(const f32x4*)(xr + col), gv = *(const f32x4*)(gp + col);
#pragma unroll
            for (int j = 0; j < 4; ++j) { const float y = xv[j] + gv[j] * o[q * 4 + j]; xn[q * 4 + j] = y; ss += y * y; } }
        const float rstd = 1.0f / sqrtf(wave_sum(ss) * (1.0f / 1024.0f) + EPS);
        if (FINAL) {
#pragma unroll
            for (int q = 0; q < 4; ++q) { const int col = (q >> 1) * 512 + lane * 8 + (q & 1) * 4; const f32x4 gn = *(const f32x4*)(ngain + col); f32x4 y;
#pragma unroll
                for (int j = 0; j < 4; ++j) y[j] = xn[q * 4 + j] * rstd * gn[j];
                *(f32x4*)(xr + col) = y; }
        } else {
            const float* nm = nmod + (size_t)b * 6144;
#pragma unroll
            for (int q = 0; q < 4; ++q) { const int col = (q >> 1) * 512 + lane * 8 + (q & 1) * 4; const f32x4 gn = *(const f32x4*)(ngain + col), sh = *(const f32x4*)(nm + col), sc = *(const f32x4*)(nm + 1024 + col); f32x4 xo; float y[4];
#pragma unroll
                for (int j = 0; j < 4; ++j) { xo[j] = xn[q * 4 + j]; y[j] = xn[q * 4 + j] * rstd * gn[j] * (1.0f + sc[j]) + sh[j]; }
                *(f32x4*)(xr + col) = xo; uint2 w; w.x = pk2(y[0], y[1]); w.y = pk2(y[2], y[3]); *(uint2*)(Hn + (size_t)t * 1024 + col) = w; }
        }
    }
}
DI void sgu_gate_naive(const Ctx& C, bf16* U, const bf16* VB, const float* stats, const float* w_s, const float* b_s, const float* ln_g, const float* ln_b) {
    LAS float* Wm = (LAS float*)(C.lds);
    LAS float* mu = (LAS float*)(C.lds + 65536);
    LAS float* rsd = mu + 128;
    const int tid = C.tid;
    for (int item = C.vcu; item < 1024; item += C.G) {
        const int n = item >> 3, g = item & 7; const size_t row0 = (size_t)n * 128;
        for (int i = tid; i < 16384; i += 512) { const int r = i >> 7, c = i & 127; const float w = w_s[(size_t)g * 16384 + i]; Wm[i] = (r < 64 && c >= 64) ? 0.f : w; }
        if (tid < 128) { const float* sp = stats + (row0 + tid) * 96; float s1 = 0.f, s2 = 0.f;
            for (int q = 0; q < 48; ++q) { s1 += sp[2 * q]; s2 += sp[2 * q + 1]; }
            const float m = s1 * (1.0f / 3072.0f); const float var = s2 * (1.0f / 3072.0f) - m * m; mu[tid] = m; rsd[tid] = 1.0f / sqrtf(fmaxf(var, 0.f) + EPS); }
        __syncthreads();
        if (tid < 384) {
            const int col = g * 384 + tid; const float lg = ln_g[col], lb = ln_b[col];
#pragma unroll
            for (int pass = 0; pass < 2; ++pass) {
                float acc[64];
#pragma unroll
                for (int i = 0; i < 64; ++i) acc[i] = 0.f;
                const int jmax = pass == 0 ? 64 : 128;
                for (int j = 0; j < jmax; ++j) { const float v = bf2f(VB[(row0 + j) * 3072 + col]); const float vl = (v - mu[j]) * rsd[j] * lg + lb;
#pragma unroll
                    for (int i = 0; i < 64; ++i) acc[i] += Wm[(pass * 64 + i) * 128 + j] * vl; }
#pragma unroll
                for (int i = 0; i < 64; ++i) { const int r = pass * 64 + i; const float s = acc[i] + b_s[g * 128 + r]; bf16* up = U + (row0 + r) * 3072 + col; *up = (bf16)f2bf(bf2f(*up) * s); }
            }
        }
        __syncthreads();
    }
}
typedef short v4i16_t __attribute__((ext_vector_type(4)));
typedef unsigned u32x2_t __attribute__((ext_vector_type(2)));
typedef __bf16 bf16x2_t __attribute__((ext_vector_type(2)));
DI unsigned cvtpk(float lo, float hi) { f32x2_t v = {lo, hi}; bf16x2_t b = __builtin_convertvector(v, bf16x2_t); return __builtin_bit_cast(unsigned, b); }
DI v4i16_t trr(const LAS unsigned char* p) { return __builtin_amdgcn_ds_read_tr16_b64_v4i16((LAS v4i16_t*)p); }
DI bf16x8 cat8(v4i16_t a, v4i16_t b) { return __builtin_shufflevector(a, b, 0, 1, 2, 3, 4, 5, 6, 7); }
DI bf16x8 pack2(const f32x4& a, const f32x4& b) { u32x4 p; p.x = cvtpk(a[0], a[1]); p.y = cvtpk(a[2], a[3]); p.z = cvtpk(b[0], b[1]); p.w = cvtpk(b[2], b[3]); return __builtin_bit_cast(bf16x8, p); }
DI u32x4 scale8(u32x4 v, float s) { u32x4 o; o.x = cvtpk(bflo(v.x) * s, bfhi(v.x) * s); o.y = cvtpk(bflo(v.y) * s, bfhi(v.y) * s); o.z = cvtpk(bflo(v.z) * s, bfhi(v.z) * s); o.w = cvtpk(bflo(v.w) * s, bfhi(v.w) * s); return o; }
#ifndef SCAN_QPI
#define SCAN_QPI 544
#endif
#ifndef SCAN_KPI
#define SCAN_KPI 544
#endif
#ifndef SCAN_PFD
#define SCAN_PFD 5
#endif
constexpr int SCAN_ESL = 32, SCAN_NCW = SCAN_ESL / 16, SCAN_NSL = 512 / SCAN_ESL, SCAN_NIT = 8 * SCAN_NSL;
#define SCAN_BAR() do { asm volatile("s_waitcnt lgkmcnt(0)" ::: "memory"); __builtin_amdgcn_s_barrier(); asm volatile("" ::: "memory"); } while (0)
template <int MODE = 0> DI void scan_mfma(const Ctx& C, const bf16* Q, const bf16* K, const bf16* V, bf16* CROSS) {
    constexpr int QPI = SCAN_QPI, KPI = SCAN_KPI, VPI = SCAN_ESL * 2 + 32, VCH = SCAN_ESL / 8  , NVC = 64 * VCH;
    constexpr int OQ = 0, OK_ = 64 * QPI, OV = OK_ + 64 * KPI, BUFB = OV + 64 * VPI;
    constexpr int NST = (NWAVES - 1 - SCAN_NCW) * 64;
    const int w = C.wave;
    for (int item = C.vcu; item < SCAN_NIT; item += C.G) {
        const int b = item / (4 * SCAN_NSL), h = (item / SCAN_NSL) & 3, es = item % SCAN_NSL;
        const float lg2 = log2f(1.0f - exp2f(-5.0f - (float)h)); const float gc = exp2f(lg2 * 64.0f);
        const size_t tokb = (size_t)b * SEQ;
        if (w >= SCAN_NCW) {
            int tl_ = C.tid; asm volatile("" : "+v"(tl_));
            const int st = (w == NWAVES - 1) ? (tl_ & 63) : tl_ - SCAN_NCW * 64;
            if (w == NWAVES - 1) {
                unsigned dmy = 0u;
#define SCAN_PF1(ptr) asm volatile("global_load_dword %0, %1, off" : "+v"(dmy) : "v"(ptr) : "memory")
#define SCAN_PF(n) do { const size_t t0_ = tokb + (size_t)(n) * 64; \
                if ((es & 3) == 0) { _Pragma("unroll") for (int u = 0; u < 4; ++u) { const int ln = st + 64 * u, r = ln >> 2, q = ln & 3; SCAN_PF1(Q + (t0_ + r) * 1024 + h * 256 + q * 64); SCAN_PF1(K + (t0_ + r) * 1024 + h * 256 + q * 64); } } \
                SCAN_PF1(V + (t0_ + st) * 2048 + h * 512 + es * SCAN_ESL); } while (0)
#ifndef SCAN_NOPF
                SCAN_PF(3); SCAN_PF(4);
#endif
                SCAN_BAR();
#pragma unroll 1
                for (int n = 0; n < 128; ++n) {
#ifndef SCAN_NOPF
                    if (n + SCAN_PFD < 128) SCAN_PF(n + SCAN_PFD);
#endif
                    SCAN_BAR(); }
                asm volatile("s_waitcnt vmcnt(0)" : "+v"(dmy) :: "memory");
#undef SCAN_PF
#undef SCAN_PF1
            } else {
            u32x4 rqA[7], rkA[7], rvA, rqB[7], rkB[7], rvB;
            const unsigned qo_ = (unsigned)((st >> 5) * 2048 + (st & 31) * 16), qo6_ = (st + NST * 6 < 2048) ? qo_ + (unsigned)(6 * (NST / 32) * 2048) : qo_;
            const unsigned vo_ = (st < NVC) ? (unsigned)((st / VCH) * 4096 + (st % VCH) * 16) : 0u;
#define SCAN_LD(RQ, RK, RV, n) do { const size_t t0_ = tokb + (size_t)((n) < 127 ? (n) : 127) * 64; \
            const unsigned char* qb_ = (const unsigned char*)(Q + t0_ * 1024 + h * 256); const unsigned char* kb_ = (const unsigned char*)(K + t0_ * 1024 + h * 256); \
            const unsigned char* vb_ = (const unsigned char*)(V + t0_ * 2048 + h * 512 + es * SCAN_ESL); \
            _Pragma("unroll") for (int u = 0; u < 7; ++u) { const unsigned o_ = u == 6 ? qo6_ : qo_ + (unsigned)(u * (NST / 32) * 2048); \
                RQ[u] = *(const u32x4*)(qb_ + o_); RK[u] = *(const u32x4*)(kb_ + o_); } \
            RV = *(const u32x4*)(vb_ + vo_); } while (0)
#define SCAN_WR(RQ, RK, RV, bufo) do { LAS unsigned char* B_ = C.lds + (bufo); \
            _Pragma("unroll") for (int u = 0; u < 7; ++u) { const int c = st + NST * u; if (c < 2048) { const int r = c >> 5, cc = c & 31; \
                *(LAS u32x4*)(B_ + OQ + r * QPI + cc * 16) = RQ[u]; *(LAS u32x4*)(B_ + OK_ + r * KPI + cc * 16) = RK[u]; } } \
            if (st < NVC) { const int r = st / VCH, cc = st % VCH; *(LAS u32x4*)(B_ + OV + r * VPI + cc * 16) = scale8(RV, exp2f(lg2 * (float)(63 - r))); } } while (0)
            SCAN_LD(rqA, rkA, rvA, 0); SCAN_WR(rqA, rkA, rvA, 0); SCAN_LD(rqA, rkA, rvA, 1); SCAN_LD(rqB, rkB, rvB, 2);
            SCAN_BAR();
#pragma unroll 1
            for (int n = 0; n < 128; n += 2) {
                if (MODE != 2) { SCAN_WR(rqA, rkA, rvA, BUFB); SCAN_LD(rqA, rkA, rvA, n + 3); }
                SCAN_BAR();
                if (MODE != 2) { SCAN_WR(rqB, rkB, rvB, 0); SCAN_LD(rqB, rkB, rvB, n + 4); }
                SCAN_BAR();
            }
#undef SCAN_LD
#undef SCAN_WR
            }
        } else {
            int tl_ = C.tid; asm volatile("" : "+v"(tl_)); const int lane = tl_ & 63, fr = lane & 15, fq = lane >> 4;
            f32x4 S[16];
#pragma unroll
            for (int t = 0; t < 16; ++t) S[t] = (f32x4){0.f, 0.f, 0.f, 0.f};
            SCAN_BAR();
#define SC_LQ(QF, DB) do { _Pragma("unroll") for (int m = 0; m < 4; ++m) QF[m] = *(const LAS bf16x8*)(Qs + (16 * m + fr) * QPI + (32 * (DB) + 8 * fq) * 2); __builtin_amdgcn_sched_barrier(0); } while (0)
#define SC_MQ(QF, DB) do { const bf16x8 sa0 = pack2(S[2 * (DB)], S[2 * (DB) + 1]); \
            _Pragma("unroll") for (int m = 0; m < 4; ++m) acc[m] = __builtin_amdgcn_mfma_f32_16x16x32_bf16(sa0, QF[m], acc[m], 0, 0, 0); __builtin_amdgcn_sched_barrier(0); } while (0)
#define SC_LK(KF, KS, TQ) do { const LAS unsigned char* kp = Ks + (32 * (KS) + 4 * fq + (fr >> 2)) * KPI + (8 * (fr & 3)) * 2;     \
            _Pragma("unroll") for (int t4 = 0; t4 < 4; ++t4) { const int t = 4 * (TQ) + t4; KF[t4] = cat8(trr(kp + 64 * (t >> 1) + 8 * (t & 1)), trr(kp + 64 * (t >> 1) + 8 * (t & 1) + 16 * KPI)); } __builtin_amdgcn_sched_barrier(0); } while (0)
#define SC_LV(VF, KS) do { const LAS unsigned char* vp = Vs + (32 * (KS) + 4 * fq + (fr >> 2)) * VPI + (16 * w + 4 * (fr & 3)) * 2; VF = cat8(trr(vp), trr(vp + 16 * VPI)); } while (0)
#define SC_MK(KF, VF, TQ) do { _Pragma("unroll") for (int t4 = 0; t4 < 4; ++t4) S[4 * (TQ) + t4] = __builtin_amdgcn_mfma_f32_16x16x32_bf16(KF[t4], VF, S[4 * (TQ) + t4], 0, 0, 0); __builtin_amdgcn_sched_barrier(0); } while (0)
#define SCAN_CHUNK(n_, BO) do { const size_t tok0 = tokb + (size_t)(n_) * 64; LAS unsigned char* Qs = C.lds + (BO) + OQ; LAS unsigned char* Ks = C.lds + (BO) + OK_; LAS unsigned char* Vs = C.lds + (BO) + OV; \
                f32x4 acc[4]; bf16x8 fA[4], fB[4], kA[4], kB[4], vf0, vf1; \
                _Pragma("unroll") for (int m = 0; m < 4; ++m) acc[m] = (f32x4){0.f, 0.f, 0.f, 0.f}; \
                SC_LQ(fA, 0); SC_LQ(fB, 1); SC_MQ(fA, 0); SC_LQ(fA, 2); SC_MQ(fB, 1); SC_LQ(fB, 3); SC_MQ(fA, 2); SC_LQ(fA, 4); SC_MQ(fB, 3); SC_LQ(fB, 5); SC_MQ(fA, 4); SC_LQ(fA, 6); SC_MQ(fB, 5); SC_LQ(fB, 7); SC_MQ(fA, 6); SC_LV(vf0, 0); SC_LV(vf1, 1); SC_LK(kA, 0, 0); SC_MQ(fB, 7); \
                _Pragma("unroll") for (int m = 0; m < 4; ++m) { const f32x4 v = acc[m] * exp2f(lg2 * (float)(16 * m + fr + 1)); uint2 o; o.x = cvtpk(v[0], v[1]); o.y = cvtpk(v[2], v[3]); \
                    *(uint2*)(CROSS + (tok0 + 16 * m + fr) * 2048 + h * 512 + es * SCAN_ESL + 16 * w + 4 * fq) = o; } \
                _Pragma("unroll") for (int t = 0; t < 16; ++t) S[t] = S[t] * gc; \
                __builtin_amdgcn_sched_barrier(0); \
                SC_LK(kB, 0, 1); SC_MK(kA, vf0, 0); SC_LK(kA, 0, 2); SC_MK(kB, vf0, 1); SC_LK(kB, 0, 3); SC_MK(kA, vf0, 2); SC_LK(kA, 1, 0); SC_MK(kB, vf0, 3); SC_LK(kB, 1, 1); SC_MK(kA, vf1, 0); SC_LK(kA, 1, 2); SC_MK(kB, vf1, 1); SC_LK(kB, 1, 3); SC_MK(kA, vf1, 2); SC_MK(kB, vf1, 3); \
                SCAN_BAR(); } while (0)
#pragma unroll 1
            for (int n = 0; n < 128; n += 2) { if (MODE == 1) { SCAN_BAR(); SCAN_BAR(); } else { SCAN_CHUNK(n, 0); SCAN_CHUNK(n + 1, BUFB); } }
#undef SCAN_CHUNK
#undef SC_LQ
#undef SC_MQ
#undef SC_LK
#undef SC_LV
#undef SC_MK
        }
    }
}
#undef SCAN_BAR
DI void sgu_gate_mfma(const Ctx& C, bf16* U, const bf16* VB, const float* stats, const float* w_s, const float* b_s, const float* ln_g, const float* ln_b) {
    constexpr int WPI = 272, VPI = 288;
    LAS unsigned char* Ws = C.lds; LAS unsigned char* Vs = C.lds + 128 * WPI;
    LAS float* mu = (LAS float*)(C.lds + 128 * WPI + 128 * VPI); LAS float* rsd = mu + 128; LAS float* r1 = mu + 256; LAS float* r2 = mu + 384; LAS float* bsl = mu + 512;
    const int tid = C.tid, lane = C.lane, w = C.wave, fr = lane & 15, fq = lane >> 4;
    for (int item = C.vcu; item < 1024; item += C.G) {
        const int n = item >> 3, g = item & 7; const size_t row0 = (size_t)n * 128;
        if (tid < 128) { const float* sp = stats + (row0 + tid) * 96; float s1 = 0.f, s2 = 0.f;
#pragma unroll 8
            for (int q = 0; q < 48; ++q) { s1 += sp[2 * q]; s2 += sp[2 * q + 1]; }
            const float m = s1 * (1.0f / 3072.0f); const float var = s2 * (1.0f / 3072.0f) - m * m; mu[tid] = m; rsd[tid] = 1.0f / sqrtf(fmaxf(var, 0.f) + EPS); bsl[tid] = b_s[g * 128 + tid]; }
        __syncthreads();
        { const int i = tid >> 2, jq = tid & 3; const float* wp = w_s + (size_t)g * 16384 + i * 128 + jq * 32; float a1 = 0.f, a2 = 0.f;
#pragma unroll
          for (int c8 = 0; c8 < 4; ++c8) { const f32x4 wa = *(const f32x4*)(wp + c8 * 8), wb = *(const f32x4*)(wp + c8 * 8 + 4); float wv[8] = {wa[0], wa[1], wa[2], wa[3], wb[0], wb[1], wb[2], wb[3]}; float o[8];
#pragma unroll
              for (int q = 0; q < 8; ++q) { const int j = jq * 32 + c8 * 8 + q; const float wm = (i < 64 && j >= 64) ? 0.f : wv[q]; const float wr_ = wm * rsd[j]; o[q] = wr_; a1 += wr_ * mu[j]; a2 += wm; }
              u32x4 pk; pk.x = cvtpk(o[0], o[1]); pk.y = cvtpk(o[2], o[3]); pk.z = cvtpk(o[4], o[5]); pk.w = cvtpk(o[6], o[7]);
              *(LAS u32x4*)(Ws + i * WPI + (jq * 32 + c8 * 8) * 2) = pk; }
          a1 += __shfl_xor(a1, 1); a1 += __shfl_xor(a1, 2); a2 += __shfl_xor(a2, 1); a2 += __shfl_xor(a2, 2);
          if (jq == 0) { r1[i] = a1; r2[i] = a2; } }
#pragma unroll 1
        for (int cs = 0; cs < 3; ++cs) {
            const int colb = g * 384 + cs * 128;
#pragma unroll
            for (int u = 0; u < 4; ++u) { const int c = tid + 512 * u, r = c >> 4, cc = c & 15;
                *(LAS u32x4*)(Vs + r * VPI + cc * 16) = *(const u32x4*)(VB + (row0 + r) * 3072 + colb + cc * 8); }
            __syncthreads();
            f32x4 acc[8];
#pragma unroll
            for (int it = 0; it < 8; ++it) acc[it] = (f32x4){0.f, 0.f, 0.f, 0.f};
#pragma unroll
            for (int ks = 0; ks < 4; ++ks) {
                const LAS unsigned char* vp = Vs + (32 * ks + 4 * fq + (fr >> 2)) * VPI + (16 * w + 4 * (fr & 3)) * 2;
                const bf16x8 vf = cat8(trr(vp), trr(vp + 16 * VPI));
#pragma unroll
                for (int it = 0; it < 8; ++it) { if (it < 4 && ks >= 2) continue;
                    const LAS unsigned char* wp = Ws + (16 * it + fr) * WPI + (32 * ks + 4 * fq) * 2;
                    const u32x2_t lo = *(const LAS u32x2_t*)wp, hi = *(const LAS u32x2_t*)(wp + 32);
                    u32x4 ww; ww.x = lo.x; ww.y = lo.y; ww.z = hi.x; ww.w = hi.y;
                    acc[it] = __builtin_amdgcn_mfma_f32_16x16x32_bf16(vf, __builtin_bit_cast(bf16x8, ww), acc[it], 0, 0, 0); }
            }
            const int c0 = colb + 16 * w + 4 * fq;
            const f32x4 lg = *(const f32x4*)(ln_g + c0), lb = *(const f32x4*)(ln_b + c0);
#pragma unroll
            for (int it = 0; it < 8; ++it) { const int i = 16 * it + fr; const float q1 = r1[i], q2 = r2[i], bb = bsl[i];
                bf16* up = U + (row0 + i) * 3072 + c0; const u32x2_t uu = *(const u32x2_t*)up;
                const f32x4 s = lg * (acc[it] - q1) + lb * q2 + bb;
                u32x2_t o; o.x = cvtpk(bflo(uu.x) * s[0], bfhi(uu.x) * s[1]); o.y = cvtpk(bflo(uu.y) * s[2], bfhi(uu.y) * s[3]);
                *(u32x2_t*)up = o; }
            __syncthreads();
        }
    }
}
DI void up8(unsigned wd, float& a, float& b, float& c, float& d) { const f32x2_t lo = __builtin_amdgcn_cvt_pk_f32_fp8((int)wd, false), hi = __builtin_amdgcn_cvt_pk_f32_fp8((int)wd, true); a = lo.x; b = lo.y; c = hi.x; d = hi.y; }
DI float dot16(const u32x4 u, const float (&hv)[16]) {
    float f[16];
    up8(u.x, f[0], f[1], f[2], f[3]); up8(u.y, f[4], f[5], f[6], f[7]); up8(u.z, f[8], f[9], f[10], f[11]); up8(u.w, f[12], f[13], f[14], f[15]);
    float d0 = f[0] * hv[0], d1 = f[1] * hv[1];
#pragma unroll
    for (int j = 2; j < 16; j += 2) { d0 += f[j] * hv[j]; d1 += f[j + 1] * hv[j + 1]; }
    return d0 + d1;
}
template <bool FINAL> DI void peer_gather8(const Ctx& C, const bf16* Hin, const int* IDX, const float* GATE, const unsigned char* PU8, const unsigned char* PV8, const float* ISU, const float* ISV,
                                           float* X, const float* g2, const float* ngain, const float* nmod, bf16* Hn) {
    const int gw = C.vcu * NWAVES + C.wave, NGW = C.G * NWAVES, lane = C.lane;
    LAS float* DL = (LAS float*)(C.lds + C.wave * 1024);
    LAS float* AL = DL + 128;
    for (int t = gw; t < TT; t += NGW) {
        float hv[16];
        { const u32x4 a = *(const u32x4*)(Hin + (size_t)t * 1024 + lane * 16), bq = *(const u32x4*)(Hin + (size_t)t * 1024 + lane * 16 + 8);
          hv[0] = bflo(a.x); hv[1] = bfhi(a.x); hv[2] = bflo(a.y); hv[3] = bfhi(a.y); hv[4] = bflo(a.z); hv[5] = bfhi(a.z); hv[6] = bflo(a.w); hv[7] = bfhi(a.w);
          hv[8] = bflo(bq.x); hv[9] = bfhi(bq.x); hv[10] = bflo(bq.y); hv[11] = bfhi(bq.y); hv[12] = bflo(bq.z); hv[13] = bfhi(bq.z); hv[14] = bflo(bq.w); hv[15] = bfhi(bq.w); }
        const int i0 = IDX[(size_t)t * 128 + lane], i1 = IDX[(size_t)t * 128 + 64 + lane];
        const float g0 = GATE[(size_t)t * 128 + lane], g1 = GATE[(size_t)t * 128 + 64 + lane];
        const float su0 = ISU[i0], su1 = ISU[i1], sv0 = ISV[i0], sv1 = ISV[i1];
        u32x4 ub[8];
#define PG_LOADU(k0) do { _Pragma("unroll") for (int j = 0; j < 8; ++j) { const int kq = (k0) + j; const int e = kq < 64 ? __builtin_amdgcn_readlane(i0, kq) : __builtin_amdgcn_readlane(i1, kq - 64); \
            ub[j] = *(const u32x4*)(PU8 + (size_t)e * 1024 + lane * 16); } } while (0)
        PG_LOADU(0);
#pragma unroll 1
        for (int k0 = 0; k0 < 128; k0 += 8) {
            float p[8];
#pragma unroll
            for (int j = 0; j < 8; ++j) p[j] = dot16(ub[j], hv);
            if (k0 + 8 < 128) PG_LOADU(k0 + 8);
            const bool h32 = lane & 32, h16 = lane & 16, h8 = lane & 8;
            float q4[4];
#pragma unroll
            for (int j = 0; j < 4; ++j) { const float keep = h32 ? p[j + 4] : p[j], send = h32 ? p[j] : p[j + 4]; q4[j] = keep + __shfl_xor(send, 32); }
            float q2[2];
#pragma unroll
            for (int j = 0; j < 2; ++j) { const float keep = h16 ? q4[j + 2] : q4[j], send = h16 ? q4[j] : q4[j + 2]; q2[j] = keep + __shfl_xor(send, 16); }
            float q1; { const float keep = h8 ? q2[1] : q2[0], send = h8 ? q2[0] : q2[1]; q1 = keep + __shfl_xor(send, 8); }
            q1 += __shfl_xor(q1, 4); q1 += __shfl_xor(q1, 2); q1 += __shfl_xor(q1, 1);
            if ((lane & 7) == 0) DL[k0 + ((lane >> 5) & 1) * 4 + ((lane >> 4) & 1) * 2 + ((lane >> 3) & 1)] = q1;
        }
#undef PG_LOADU
        LDS_WAIT();
        { const float d0 = DL[lane], d1 = DL[64 + lane]; AL[lane] = gelu_t(d0 * su0) * g0 * sv0; AL[64 + lane] = gelu_t(d1 * su1) * g1 * sv1; }
        LDS_WAIT();
        float o[16];
#pragma unroll
        for (int j = 0; j < 16; ++j) o[j] = 0.f;
        u32x4 vb[8];
#define PG_LOADV(k0) do { _Pragma("unroll") for (int j = 0; j < 8; ++j) { const int kq = (k0) + j; const int e = kq < 64 ? __builtin_amdgcn_readlane(i0, kq) : __builtin_amdgcn_readlane(i1, kq - 64); \
            vb[j] = *(const u32x4*)(PV8 + (size_t)e * 1024 + lane * 16); } } while (0)
        PG_LOADV(0);
#pragma unroll 1
        for (int k0 = 0; k0 < 128; k0 += 8) {
            float f[8][16];
#pragma unroll
            for (int j = 0; j < 8; ++j) { up8(vb[j].x, f[j][0], f[j][1], f[j][2], f[j][3]); up8(vb[j].y, f[j][4], f[j][5], f[j][6], f[j][7]); up8(vb[j].z, f[j][8], f[j][9], f[j][10], f[j][11]); up8(vb[j].w, f[j][12], f[j][13], f[j][14], f[j][15]); }
            if (k0 + 8 < 128) PG_LOADV(k0 + 8);
#pragma unroll
            for (int j = 0; j < 8; ++j) { const float ak = AL[k0 + j];
#pragma unroll
                for (int q = 0; q < 16; ++q) o[q] += ak * f[j][q]; }
        }
#undef PG_LOADV
        const int b = t >> 13; const float* gp = g2 + (size_t)b * 6144; float* xr = X + (size_t)t * 1024;
        float xn[16]; float ss = 0.f;
#pragma unroll
        for (int q = 0; q < 4; ++q) { const int col = lane * 16 + q * 4; const f32x4 xv = *(const f32x4*)(xr + col), gv = *(const f32x4*)(gp + col);
#pragma unroll
            for (int j = 0; j < 4; ++j) { const float y = xv[j] + gv[j] * o[q * 4 + j]; xn[q * 4 + j] = y; ss += y * y; } }
        const float rstd = 1.0f / sqrtf(wave_sum(ss) * (1.0f / 1024.0f) + EPS);
        if (FINAL) {
#pragma unroll
            for (int q = 0; q < 4; ++q) { const int col = lane * 16 + q * 4; const f32x4 gn = *(const f32x4*)(ngain + col); f32x4 y;
#pragma unroll
                for (int j = 0; j < 4; ++j) y[j] = xn[q * 4 + j] * rstd * gn[j];
                *(f32x4*)(xr + col) = y; }
        } else {
            const float* nm = nmod + (size_t)b * 6144;
#pragma unroll
            for (int q = 0; q < 4; ++q) { const int col = lane * 16 + q * 4; const f32x4 gn = *(const f32x4*)(ngain + col), sh = *(const f32x4*)(nm + col), sc = *(const f32x4*)(nm + 1024 + col); f32x4 xo; float y[4];
#pragma unroll
                for (int j = 0; j < 4; ++j) { xo[j] = xn[q * 4 + j]; y[j] = xn[q * 4 + j] * rstd * gn[j] * (1.0f + sc[j]) + sh[j]; }
                *(f32x4*)(xr + col) = xo; u32x2_t wv; wv.x = cvtpk(y[0], y[1]); wv.y = cvtpk(y[2], y[3]); *(u32x2_t*)(Hn + (size_t)t * 1024 + col) = wv; }
        }
    }
}
template <int CTRL> DI float dpp_f(float x) { return __int_as_float(__builtin_amdgcn_update_dpp(0, __float_as_int(x), CTRL, 0xF, 0xF, false)); }
DI float x32(float x) { auto r = __builtin_amdgcn_permlane32_swap(__float_as_uint(x), __float_as_uint(x), false, false); return (threadIdx.x & 32) ? __uint_as_float(r[0]) : __uint_as_float(r[1]); }
DI float x16(float x) { auto r = __builtin_amdgcn_permlane16_swap(__float_as_uint(x), __float_as_uint(x), false, false); return (threadIdx.x & 16) ? __uint_as_float(r[0]) : __uint_as_float(r[1]); }
typedef _Float16 h2_t __attribute__((ext_vector_type(2)));
DI unsigned f2hu(float lo, float hi) { const f32x2_t v = {lo, hi}; const h2_t h = __builtin_convertvector(v, h2_t); return __builtin_bit_cast(unsigned, h); }
DI unsigned bf2hu(unsigned w) { const f32x2_t v = {bflo(w), bfhi(w)}; const h2_t h = __builtin_convertvector(v, h2_t); return __builtin_bit_cast(unsigned, h); }
DI h2_t bf2h(unsigned w) { return (h2_t){(_Float16)bflo(w), (_Float16)bfhi(w)}; }
template <bool FAKE> DI void up8h(const u32x4 u, h2_t (&f)[8]) {
    if (FAKE) { f[0] = __builtin_bit_cast(h2_t, u.x & 0x3bff3bffu); f[1] = __builtin_bit_cast(h2_t, u.y & 0x3bff3bffu); f[2] = __builtin_bit_cast(h2_t, u.z & 0x3bff3bffu); f[3] = __builtin_bit_cast(h2_t, u.w & 0x3bff3bffu);
        f[4] = __builtin_bit_cast(h2_t, (u.x >> 1) & 0x3bff3bffu); f[5] = __builtin_bit_cast(h2_t, (u.y >> 1) & 0x3bff3bffu); f[6] = __builtin_bit_cast(h2_t, (u.z >> 1) & 0x3bff3bffu); f[7] = __builtin_bit_cast(h2_t, (u.w >> 1) & 0x3bff3bffu); return; }
    f[0] = __builtin_amdgcn_cvt_scalef32_pk_f16_fp8((int)u.x, 1.0f, false); f[1] = __builtin_amdgcn_cvt_scalef32_pk_f16_fp8((int)u.x, 1.0f, true);
    f[2] = __builtin_amdgcn_cvt_scalef32_pk_f16_fp8((int)u.y, 1.0f, false); f[3] = __builtin_amdgcn_cvt_scalef32_pk_f16_fp8((int)u.y, 1.0f, true);
    f[4] = __builtin_amdgcn_cvt_scalef32_pk_f16_fp8((int)u.z, 1.0f, false); f[5] = __builtin_amdgcn_cvt_scalef32_pk_f16_fp8((int)u.z, 1.0f, true);
    f[6] = __builtin_amdgcn_cvt_scalef32_pk_f16_fp8((int)u.w, 1.0f, false); f[7] = __builtin_amdgcn_cvt_scalef32_pk_f16_fp8((int)u.w, 1.0f, true); }
template <bool FAKE> DI float dot16h(const u32x4 u, const h2_t (&hh)[8]) { h2_t f[8]; up8h<FAKE>(u, f); float d0 = 0.f, d1 = 0.f;
#pragma unroll
    for (int q = 0; q < 8; q += 2) { d0 = __builtin_amdgcn_fdot2(f[q], hh[q], d0, false); d1 = __builtin_amdgcn_fdot2(f[q + 1], hh[q + 1], d1, false); }
    return d0 + d1; }
template <bool FINAL, bool FAKE = false, int SKIP = 0> DI void peer_gather_rounds(const Ctx& C, const bf16* Hin, const int* IDX, const float* GATE, const unsigned char* PU8, const unsigned char* PV8, const float* ISU, const float* ISV,
                                                 float* X, const float* g2, const float* ngain, const float* nmod, bf16* Hn) {
    const int lane = C.lane, w = C.wave;
    LAS u32x2_t* LIST = (LAS u32x2_t*)(C.lds + w * 14592);
    LAS unsigned char* HL = C.lds + w * 14592 + 4096;
    LAS unsigned* ALU = (LAS unsigned*)(C.lds + w * 14592 + 12288);
    LAS int* OFFS = (LAS int*)(C.lds + w * 14592 + 14336);
    LAS float* IHS = (LAS float*)(C.lds + w * 14592 + 14336 + 160);
    const unsigned long long ltmask = (1ull << lane) - 1ull;
    for (int grp = C.vcu; grp < TT / 32; grp += C.G) {
        const int t0 = grp * 32 + w * 4;
        {
            int ee[8]; float gg[8]; unsigned su[8]; float sv[8];
#pragma unroll
            for (int r = 0; r < 8; ++r) { const size_t a = (size_t)(t0 + (r >> 1)) * 128 + 64 * (r & 1) + lane; ee[r] = IDX[a]; gg[r] = GATE[a]; }
#pragma unroll
            for (int r = 0; r < 8; ++r) { su[r] = __float_as_uint(ISU[ee[r]]) >> 23; sv[r] = ISV[ee[r]]; }
            int pos[8]; int base = 0;
#pragma unroll 1
            for (int b = 0; b < 8; ++b) {
#pragma unroll
                for (int r = 0; r < 8; ++r) { if ((r & 1) == 0 && lane == 0) OFFS[b * 4 + (r >> 1)] = base;
                    const bool mine = (ee[r] >> 11) == b; const unsigned long long m = __ballot(mine); if (mine) pos[r] = base + __popcll(m & ltmask); base += __popcll(m); }
            }
            if (lane == 0) OFFS[32] = 512;
#pragma unroll
            for (int r = 0; r < 8; ++r) { u32x2_t en; en.x = (unsigned)ee[r] | ((unsigned)(r >> 1) << 14) | (su[r] << 16); en.y = __float_as_uint(gg[r] * sv[r]); LIST[pos[r]] = en; }
#pragma unroll
            for (int tk = 0; tk < 4; ++tk) { const u32x4 a = *(const u32x4*)(Hin + (size_t)(t0 + tk) * 1024 + lane * 16), bq = *(const u32x4*)(Hin + (size_t)(t0 + tk) * 1024 + lane * 16 + 8);
                const float hv_[16] = {bflo(a.x), bfhi(a.x), bflo(a.y), bfhi(a.y), bflo(a.z), bfhi(a.z), bflo(a.w), bfhi(a.w), bflo(bq.x), bfhi(bq.x), bflo(bq.y), bfhi(bq.y), bflo(bq.z), bfhi(bq.z), bflo(bq.w), bfhi(bq.w)};
                float am = 0.f;
#pragma unroll
                for (int q = 0; q < 16; ++q) am = fmaxf(am, fabsf(hv_[q]));
                am = wave_max(am);
                const int e_ = (int)((__float_as_uint(am) >> 23) & 0xffu) - 127; const bool ok_ = am > 1e-30f;
                const float sc_ = ok_ ? __uint_as_float((unsigned)(127 + 6 - e_) << 23) : 1.0f, isc_ = ok_ ? __uint_as_float((unsigned)(127 - 6 + e_) << 23) : 1.0f;
                u32x4 o8;
#pragma unroll
                for (int q = 0; q < 4; ++q) { unsigned wd = 0u;
#pragma unroll
                    for (int j = 0; j < 4; ++j) { int qi = (int)rintf(hv_[4 * q + j] * sc_); qi = qi > 127 ? 127 : (qi < -127 ? -127 : qi); wd |= ((unsigned)qi & 0xffu) << (8 * j); }
                    o8[q] = wd; }
                *(LAS u32x4*)(HL + tk * 1024 + lane * 16) = o8; if (lane == 0) IHS[tk] = isc_; }
        }
        LDS_WAIT();
        {
            const int jL = ((lane >> 5) & 1) * 4 + ((lane >> 4) & 1) * 2 + ((lane >> 3) & 1);
#define G1_LOAD(UB, TK, G0) do { const unsigned exl_ = LIST[(G0) + (lane & 7)].x; \
            _Pragma("unroll") for (int j = 0; j < 8; ++j) { const unsigned ex = (unsigned)__builtin_amdgcn_readlane((int)exl_, j); TK[j] = (int)((ex >> 14) & 3u); \
                UB[j] = *(const u32x4*)(PU8 + (size_t)(ex & (FAKE ? 0x7fu : 0x3fffu)) * 1024 + lane * 16); } } while (0)
#define G1_RUN(UB, TK, G0) do { int p[8]; \
            _Pragma("unroll") for (int j = 0; j < 8; ++j) { const u32x4 hq = *(const LAS u32x4*)(HL + TK[j] * 1024 + lane * 16); \
                int d_ = __builtin_amdgcn_sdot4((int)UB[j].x, (int)hq.x, 0, false); d_ = __builtin_amdgcn_sdot4((int)UB[j].y, (int)hq.y, d_, false); \
                d_ = __builtin_amdgcn_sdot4((int)UB[j].z, (int)hq.z, d_, false); p[j] = __builtin_amdgcn_sdot4((int)UB[j].w, (int)hq.w, d_, false); } \
            const bool h32 = lane & 32, h16 = lane & 16, h8 = lane & 8; int q4[4]; \
            _Pragma("unroll") for (int j = 0; j < 4; ++j) { const int keep = h32 ? p[j + 4] : p[j], send = h32 ? p[j] : p[j + 4]; q4[j] = keep + __float_as_int(x32(__int_as_float(send))); } \
            int q2[2]; \
            _Pragma("unroll") for (int j = 0; j < 2; ++j) { const int keep = h16 ? q4[j + 2] : q4[j], send = h16 ? q4[j] : q4[j + 2]; q2[j] = keep + __float_as_int(x16(__int_as_float(send))); } \
            int q1; { const int keep = h8 ? q2[1] : q2[0], send = h8 ? q2[0] : q2[1]; q1 = keep + __float_as_int(dpp_f<0x128>(__int_as_float(send))); } \
            q1 += __float_as_int(dpp_f<0x141>(__int_as_float(q1))); q1 += __float_as_int(dpp_f<0xB1>(__int_as_float(q1))); q1 += __float_as_int(dpp_f<0x4E>(__int_as_float(q1))); \
            if ((lane & 7) == 0) { const u32x2_t me = LIST[(G0) + jL]; const float av_ = gelu_t((float)q1 * IHS[(me.x >> 14) & 3u] * __uint_as_float((me.x >> 16) << 23)) * __uint_as_float(me.y); ALU[(G0) + jL] = f2hu(av_, av_); } } while (0)
            u32x4 ubA[8], ubB[8]; int tkA[8], tkB[8];
            G1_LOAD(ubA, tkA, 0);
#pragma unroll 1
            for (int g0 = 0; g0 < ((SKIP & 1) ? 0 : 512); g0 += 16) {
                G1_LOAD(ubB, tkB, g0 + 8);
                G1_RUN(ubA, tkA, g0);
                if (g0 + 16 < 512) G1_LOAD(ubA, tkA, g0 + 16);
                G1_RUN(ubB, tkB, g0 + 8);
            }
#undef G1_LOAD
#undef G1_RUN
        }
        LDS_WAIT();
        h2_t o[4][8], oc[8];
#pragma unroll
        for (int q = 0; q < 8; ++q) { oc[q] = (h2_t){(_Float16)0.f, (_Float16)0.f};
#pragma unroll
            for (int tk = 0; tk < 4; ++tk) o[tk][q] = (h2_t){(_Float16)0.f, (_Float16)0.f}; }
        {
            int curA = 0;
#define G2_FLUSH() do { if (curA == 0) { _Pragma("unroll") for (int q_ = 0; q_ < 8; ++q_) o[0][q_] += oc[q_]; } else if (curA == 1) { _Pragma("unroll") for (int q_ = 0; q_ < 8; ++q_) o[1][q_] += oc[q_]; } \
            else if (curA == 2) { _Pragma("unroll") for (int q_ = 0; q_ < 8; ++q_) o[2][q_] += oc[q_]; } else { _Pragma("unroll") for (int q_ = 0; q_ < 8; ++q_) o[3][q_] += oc[q_]; } \
            _Pragma("unroll") for (int q_ = 0; q_ < 8; ++q_) oc[q_] = (h2_t){(_Float16)0.f, (_Float16)0.f}; } while (0)
#define G2_LOAD(VB, AJ, TK, G0) do { const unsigned exl_ = LIST[(G0) + (lane & 7)].x; const unsigned all_ = ALU[(G0) + (lane & 7)]; \
            _Pragma("unroll") for (int j = 0; j < 8; ++j) { const unsigned ex = (unsigned)__builtin_amdgcn_readlane((int)exl_, j); TK[j] = (int)((ex >> 14) & 3u); AJ[j] = __builtin_bit_cast(h2_t, (unsigned)__builtin_amdgcn_readlane((int)all_, j)); \
                VB[j] = *(const u32x4*)(PV8 + (size_t)(ex & (FAKE ? 0x7fu : 0x3fffu)) * 1024 + lane * 16); } } while (0)
#define G2_ACC(VB, AJ, TK) do { _Pragma("unroll") for (int j = 0; j < 8; ++j) { if (TK[j] != curA) { G2_FLUSH(); curA = TK[j]; } h2_t f_[8]; up8h<FAKE>(VB[j], f_); _Pragma("unroll") for (int q = 0; q < 8; ++q) oc[q] = f_[q] * AJ[j] + oc[q]; } } while (0)
            u32x4 vbA[8], vbB[8]; h2_t ajA[8], ajB[8]; int tA[8], tB[8];
            G2_LOAD(vbA, ajA, tA, 0);
#pragma unroll 1
            for (int g0 = 0; g0 < ((SKIP & 2) ? 0 : 512); g0 += 16) {
                G2_LOAD(vbB, ajB, tB, g0 + 8);
                G2_ACC(vbA, ajA, tA);
                if (g0 + 16 < 512) G2_LOAD(vbA, ajA, tA, g0 + 16);
                G2_ACC(vbB, ajB, tB);
            }
            G2_FLUSH();
#undef G2_FLUSH
#undef G2_LOAD
#undef G2_ACC
        }
#pragma unroll
        for (int tk = 0; tk < 4; ++tk) {
            __builtin_amdgcn_sched_barrier(0);
            const int t = t0 + tk; const int b = t >> 13; const float* gp = g2 + (size_t)b * 6144; float* xr = X + (size_t)t * 1024;
            float xn[16]; float ss = 0.f;
#pragma unroll
            for (int q = 0; q < 4; ++q) { const int col = lane * 16 + q * 4; const f32x4 xv = *(const f32x4*)(xr + col), gv = *(const f32x4*)(gp + col);
#pragma unroll
                for (int j = 0; j < 4; ++j) { const float y = xv[j] + gv[j] * (float)o[tk][q * 2 + (j >> 1)][j & 1]; xn[q * 4 + j] = y; ss += y * y; } }
            const float rstd = 1.0f / sqrtf(wave_sum(ss) * (1.0f / 1024.0f) + EPS);
            if (FINAL) {
#pragma unroll
                for (int q = 0; q < 4; ++q) { const int col = lane * 16 + q * 4; const f32x4 gn = *(const f32x4*)(ngain + col); f32x4 y;
#pragma unroll
                    for (int j = 0; j < 4; ++j) y[j] = xn[q * 4 + j] * rstd * gn[j];
                    *(f32x4*)(xr + col) = y; }
            } else {
                const float* nm = nmod + (size_t)b * 6144;
#pragma unroll
                for (int q = 0; q < 4; ++q) { const int col = lane * 16 + q * 4; const f32x4 gn = *(const f32x4*)(ngain + col), sh = *(const f32x4*)(nm + col), sc = *(const f32x4*)(nm + 1024 + col); f32x4 xo; float y[4];
#pragma unroll
                    for (int j = 0; j < 4; ++j) { xo[j] = xn[q * 4 + j]; y[j] = xn[q * 4 + j] * rstd * gn[j] * (1.0f + sc[j]) + sh[j]; }
                    *(f32x4*)(xr + col) = xo; u32x2_t wv; wv.x = cvtpk(y[0], y[1]); wv.y = cvtpk(y[2], y[3]); *(u32x2_t*)(Hn + (size_t)t * 1024 + col) = wv; }
            }
        }
        LDS_WAIT();
    }
}
constexpr int GR_R = 12;
DI void glds_row(const unsigned char* gsrc_lane, unsigned lds_dst) { unsigned keep;
    asm volatile("s_mov_b32 %0, m0\n\ts_mov_b32 m0, %2\n\ts_nop 0\n\tglobal_load_lds_dwordx4 %1, off\n\ts_mov_b32 m0, %0" : "=&s"(keep) : "v"(gsrc_lane), "s"(lds_dst) : "memory"); }
template <bool FINAL> DI void peer_gather_dma(const Ctx& C, const bf16* Hin, const int* IDX, const float* GATE, const unsigned char* PU8, const unsigned char* PV8, const float* ISU, const float* ISV,
                                              float* X, const float* g2, const float* ngain, const float* nmod, bf16* Hn) {
    const int lane = C.lane, w = C.wave;
    constexpr int WB = 4096 + 2048 + 256 + GR_R * 1024;
    LAS u32x2_t* LIST = (LAS u32x2_t*)(C.lds + w * WB);
    LAS float* AL = (LAS float*)(C.lds + w * WB + 4096);
    LAS int* OFFS = (LAS int*)(C.lds + w * WB + 6144);
    LAS unsigned char* RING = C.lds + w * WB + 6400;
    const unsigned ring0 = (unsigned)__builtin_amdgcn_readfirstlane((int)(unsigned)(size_t)RING);
    const unsigned long long ltmask = (1ull << lane) - 1ull;
#define GR_REFILL(nv_) do { unsigned ex8_[8]; _Pragma("unroll") for (int j_ = 0; j_ < 8; ++j_) ex8_[j_] = (j_ < (nv_) && nf + j_ < 1024) ? LIST[(nf + j_) & 511].x : 0u; \
        _Pragma("unroll") for (int j_ = 0; j_ < 8; ++j_) if (j_ < (nv_) && nf + j_ < 1024) { const int f_ = nf + j_; const unsigned e_ = (unsigned)__builtin_amdgcn_readfirstlane((int)ex8_[j_]) & 0x3fffu; \
            const unsigned char* tb_ = (f_ < 512) ? PU8 : PV8; glds_row(tb_ + (size_t)e_ * 1024 + lane * 16, ring0 + (unsigned)(f_ % GR_R) * 1024u); } \
        nf += (nv_); if (nf > 1024) nf = 1024; } while (0)
#define GR_ISSUE(f) do { const int f_ = (f); const unsigned ex_ = (unsigned)__builtin_amdgcn_readfirstlane((int)LIST[f_ & 511].x); \
        const unsigned char* tb_ = (f_ < 512) ? PU8 : PV8; glds_row(tb_ + (size_t)(ex_ & 0x3fffu) * 1024 + lane * 16, ring0 + (unsigned)(f_ % GR_R) * 1024u); } while (0)
    for (int grp = C.vcu; grp < TT / 32; grp += C.G) {
        const int t0 = grp * 32 + w * 4;
        float hv4[4][16];
        {
            int ee[8]; float gg[8]; unsigned su[8]; float sv[8];
#pragma unroll
            for (int r = 0; r < 8; ++r) { const size_t a = (size_t)(t0 + (r >> 1)) * 128 + 64 * (r & 1) + lane; ee[r] = IDX[a]; gg[r] = GATE[a]; }
#pragma unroll
            for (int r = 0; r < 8; ++r) { su[r] = __float_as_uint(ISU[ee[r]]) >> 23; sv[r] = ISV[ee[r]]; }
            int pos[8]; int base = 0;
#pragma unroll 1
            for (int b = 0; b < 8; ++b) {
#pragma unroll
                for (int r = 0; r < 8; ++r) { if ((r & 1) == 0 && lane == 0) OFFS[b * 4 + (r >> 1)] = base;
                    const bool mine = (ee[r] >> 11) == b; const unsigned long long m = __ballot(mine); if (mine) pos[r] = base + __popcll(m & ltmask); base += __popcll(m); }
            }
            if (lane == 0) OFFS[32] = 512;
#pragma unroll
            for (int r = 0; r < 8; ++r) { u32x2_t en; en.x = (unsigned)ee[r] | ((unsigned)(r >> 1) << 14) | (su[r] << 16); en.y = __float_as_uint(gg[r] * sv[r]); LIST[pos[r]] = en; }
#pragma unroll
            for (int tk = 0; tk < 4; ++tk) { const u32x4 a = *(const u32x4*)(Hin + (size_t)(t0 + tk) * 1024 + lane * 16), bq = *(const u32x4*)(Hin + (size_t)(t0 + tk) * 1024 + lane * 16 + 8);
                hv4[tk][0] = bflo(a.x); hv4[tk][1] = bfhi(a.x); hv4[tk][2] = bflo(a.y); hv4[tk][3] = bfhi(a.y); hv4[tk][4] = bflo(a.z); hv4[tk][5] = bfhi(a.z); hv4[tk][6] = bflo(a.w); hv4[tk][7] = bfhi(a.w);
                hv4[tk][8] = bflo(bq.x); hv4[tk][9] = bfhi(bq.x); hv4[tk][10] = bflo(bq.y); hv4[tk][11] = bfhi(bq.y); hv4[tk][12] = bflo(bq.z); hv4[tk][13] = bfhi(bq.z); hv4[tk][14] = bflo(bq.w); hv4[tk][15] = bfhi(bq.w); }
        }
        asm volatile("s_waitcnt vmcnt(0) lgkmcnt(0)" ::: "memory");
        int nf = GR_R;
#pragma unroll 1
        for (int f = 0; f < GR_R; ++f) GR_ISSUE(f);
        {
            const int jL = ((lane >> 5) & 1) * 4 + ((lane >> 4) & 1) * 2 + ((lane >> 3) & 1);
#pragma unroll 1
            for (int r = 0; r < 8; ++r) {
#pragma unroll
                for (int tk = 0; tk < 4; ++tk) {
                    const int beg = __builtin_amdgcn_readfirstlane(OFFS[r * 4 + tk]), end = __builtin_amdgcn_readfirstlane(OFFS[r * 4 + tk + 1]);
#pragma unroll 1
                    for (int g0 = beg; g0 < end; g0 += 8) {
                        const int nv = (end - g0) < 8 ? (end - g0) : 8;
                        asm volatile("s_waitcnt vmcnt(4)" ::: "memory");
                        float p[8];
#pragma unroll
                        for (int j = 0; j < 8; ++j) { p[j] = 0.f;
                            if (j < nv) { const u32x4 row = *(const LAS u32x4*)(RING + ((g0 + j) % GR_R) * 1024 + lane * 16); p[j] = dot16(row, hv4[tk]); } }
                        asm volatile("s_waitcnt lgkmcnt(0)" ::: "memory");
                        GR_REFILL(nv);
                        const bool h32 = lane & 32, h16 = lane & 16, h8 = lane & 8;
                        float q4[4];
#pragma unroll
                        for (int j = 0; j < 4; ++j) { const float keep = h32 ? p[j + 4] : p[j], send = h32 ? p[j] : p[j + 4]; q4[j] = keep + __shfl_xor(send, 32); }
                        float q2[2];
#pragma unroll
                        for (int j = 0; j < 2; ++j) { const float keep = h16 ? q4[j + 2] : q4[j], send = h16 ? q4[j] : q4[j + 2]; q2[j] = keep + __shfl_xor(send, 16); }
                        float q1; { const float keep = h8 ? q2[1] : q2[0], send = h8 ? q2[0] : q2[1]; q1 = keep + __shfl_xor(send, 8); }
                        q1 += __shfl_xor(q1, 4); q1 += __shfl_xor(q1, 2); q1 += __shfl_xor(q1, 1);
                        if ((lane & 7) == 0 && jL < nv) { const u32x2_t me = LIST[g0 + jL]; AL[g0 + jL] = gelu_t(q1 * __uint_as_float((me.x >> 16) << 23)) * __uint_as_float(me.y); }
                    }
                }
            }
        }
        float o[4][16];
#pragma unroll
        for (int tk = 0; tk < 4; ++tk)
#pragma unroll
            for (int q = 0; q < 16; ++q) o[tk][q] = 0.f;
#pragma unroll 1
        for (int r = 0; r < 8; ++r) {
#pragma unroll
            for (int tk = 0; tk < 4; ++tk) {
                const int beg = __builtin_amdgcn_readfirstlane(OFFS[r * 4 + tk]), end = __builtin_amdgcn_readfirstlane(OFFS[r * 4 + tk + 1]);
#pragma unroll 1
                for (int i0 = beg; i0 < end; i0 += 8) {
                    const int nv = (end - i0) < 8 ? (end - i0) : 8;
                    if (i0 <= 500) asm volatile("s_waitcnt vmcnt(4)" ::: "memory"); else asm volatile("s_waitcnt vmcnt(0)" ::: "memory");
                    float aq[8]; u32x4 rw[8];
#pragma unroll
                    for (int j = 0; j < 8; ++j) { aq[j] = (j < nv) ? AL[i0 + j] : 0.f; }
#pragma unroll
                    for (int j = 0; j < 8; ++j) if (j < nv) rw[j] = *(const LAS u32x4*)(RING + ((512 + i0 + j) % GR_R) * 1024 + lane * 16);
#pragma unroll
                    for (int j = 0; j < 8; ++j) if (j < nv) { const float aj = __int_as_float(__builtin_amdgcn_readfirstlane(__float_as_int(aq[j])));
                        float f_[16]; up8(rw[j].x, f_[0], f_[1], f_[2], f_[3]); up8(rw[j].y, f_[4], f_[5], f_[6], f_[7]); up8(rw[j].z, f_[8], f_[9], f_[10], f_[11]); up8(rw[j].w, f_[12], f_[13], f_[14], f_[15]);
#pragma unroll
                        for (int q = 0; q < 16; ++q) o[tk][q] += aj * f_[q]; }
                    asm volatile("s_waitcnt lgkmcnt(0)" ::: "memory");
                    GR_REFILL(nv);
                }
            }
        }
        asm volatile("s_waitcnt vmcnt(0)" ::: "memory");
#pragma unroll
        for (int tk = 0; tk < 4; ++tk) {
            const int t = t0 + tk; const int b = t >> 13; const float* gp = g2 + (size_t)b * 6144; float* xr = X + (size_t)t * 1024;
            float xn[16]; float ss = 0.f;
#pragma unroll
            for (int q = 0; q < 4; ++q) { const int col = lane * 16 + q * 4; const f32x4 xv = *(const f32x4*)(xr + col), gv = *(const f32x4*)(gp + col);
#pragma unroll
                for (int j = 0; j < 4; ++j) { const float y = xv[j] + gv[j] * o[tk][q * 4 + j]; xn[q * 4 + j] = y; ss += y * y; } }
            const float rstd = 1.0f / sqrtf(wave_sum(ss) * (1.0f / 1024.0f) + EPS);
            if (FINAL) {
#pragma unroll
                for (int q = 0; q < 4; ++q) { const int col = lane * 16 + q * 4; const f32x4 gn = *(const f32x4*)(ngain + col); f32x4 y;
#pragma unroll
                    for (int j = 0; j < 4; ++j) y[j] = xn[q * 4 + j] * rstd * gn[j];
                    *(f32x4*)(xr + col) = y; }
            } else {
                const float* nm = nmod + (size_t)b * 6144;
#pragma unroll
                for (int q = 0; q < 4; ++q) { const int col = lane * 16 + q * 4; const f32x4 gn = *(const f32x4*)(ngain + col), sh = *(const f32x4*)(nm + col), sc = *(const f32x4*)(nm + 1024 + col); f32x4 xo; float y[4];
#pragma unroll
                    for (int j = 0; j < 4; ++j) { xo[j] = xn[q * 4 + j]; y[j] = xn[q * 4 + j] * rstd * gn[j] * (1.0f + sc[j]) + sh[j]; }
                    *(f32x4*)(xr + col) = xo; u32x2_t wv; wv.x = cvtpk(y[0], y[1]); wv.y = cvtpk(y[2], y[3]); *(u32x2_t*)(Hn + (size_t)t * 1024 + col) = wv; }
            }
        }
        asm volatile("s_waitcnt vmcnt(0) lgkmcnt(0)" ::: "memory");
    }
#undef GR_ISSUE
#undef GR_REFILL
}
DI float red4_sum(float x) { auto a = __builtin_amdgcn_permlane16_swap(__float_as_uint(x), __float_as_uint(x), false, false); x = __uint_as_float(a[0]) + __uint_as_float(a[1]);
    auto b = __builtin_amdgcn_permlane32_swap(__float_as_uint(x), __float_as_uint(x), false, false); return __uint_as_float(b[0]) + __uint_as_float(b[1]); }
DI float red4_max(float x) { auto a = __builtin_amdgcn_permlane16_swap(__float_as_uint(x), __float_as_uint(x), false, false); x = fmaxf(__uint_as_float(a[0]), __uint_as_float(a[1]));
    auto b = __builtin_amdgcn_permlane32_swap(__float_as_uint(x), __float_as_uint(x), false, false); return fmaxf(__uint_as_float(b[0]), __uint_as_float(b[1])); }
DI float red4_min(float x) { auto a = __builtin_amdgcn_permlane16_swap(__float_as_uint(x), __float_as_uint(x), false, false); x = fminf(__uint_as_float(a[0]), __uint_as_float(a[1]));
    auto b = __builtin_amdgcn_permlane32_swap(__float_as_uint(x), __float_as_uint(x), false, false); return fminf(__uint_as_float(b[0]), __uint_as_float(b[1])); }
constexpr int TK_NI = 6;
DI float tk_pivot(float clo, float chi) {
    const float lc = __builtin_amdgcn_logf(clo), lh = __builtin_amdgcn_logf(fmaxf(chi, 0.5f));
    const float f = (lc - 4.0443941f) * __builtin_amdgcn_rcpf(lc - lh);
    return fminf(fmaxf(f, 0.06f), 0.94f);
}
template <int NV> DI float tk_count(const float (&v)[NV], float mid) {
    const float nb = -mid * 1.099511627776e12f;
    float c[4] = {0.f, 0.f, 0.f, 0.f};
#pragma unroll
    for (int i = 0; i < NV; ++i) c[i & 3] += __builtin_amdgcn_fmed3f(__builtin_fmaf(v[i], 1.099511627776e12f, nb), 0.f, 1.f);
    return red4_sum((c[0] + c[1]) + (c[2] + c[3]));
}
constexpr int tk2_pair(int n) {
    int k = 0;
    for (int i = 0; i < 16; ++i) for (int j = 0; j < 16; ++j) if ((i + 1) * (j + 1) <= 16) { if (k == n) return i | (j << 8); ++k; }
    return n == 50 ? (15 | (15 << 8)) : (15 | (14 << 8));
}
template <int NV> DI void tk_search(const float (&v)[NV], float ntot, float& thr_out) {
    float mx = v[0], mn = v[0];
#pragma unroll
    for (int i = 1; i < NV; ++i) { mx = fmaxf(mx, v[i]); mn = fminf(mn, v[i]); }
    mx = red4_max(mx); mn = red4_min(mn);
    float lo = mn, hi = mx, clo = ntot - 1.0f, chi = 0.0f, thr = mn - 1.0f; bool done = false;
#pragma unroll 1
    for (int iter = 0; iter < 48; ++iter) {
        float fr_ = tk_pivot(clo, chi); if (iter >= TK_NI) fr_ = 0.5f;
        const float mid = done ? thr : lo + (hi - lo) * fr_;
        const float cnt = tk_count<NV>(v, mid);
        if (!done) { if (cnt == 16.0f) { thr = mid; done = true; } else if (cnt > 16.0f) { lo = mid; clo = cnt; thr = mid; } else { hi = mid; chi = cnt; } }
        if (__all(done)) break;
    }
    thr_out = thr;
}
constexpr int TK_STEP = 2;
DI void tk_search2(const float (&v0)[32], const float (&v1)[32], float& t0, float& t1) {
    float mx0 = v0[0], mn0 = v0[0], mx1 = v1[0], mn1 = v1[0], s0 = v0[0], s1 = v1[0], q0 = v0[0] * v0[0], q1 = v1[0] * v1[0];
#pragma unroll
    for (int i = 1; i < 32; ++i) { mx0 = fmaxf(mx0, v0[i]); mn0 = fminf(mn0, v0[i]); mx1 = fmaxf(mx1, v1[i]); mn1 = fminf(mn1, v1[i]);
        s0 += v0[i]; s1 += v1[i]; q0 = __builtin_fmaf(v0[i], v0[i], q0); q1 = __builtin_fmaf(v1[i], v1[i], q1); }
    mx0 = red4_max(mx0); mn0 = red4_min(mn0); mx1 = red4_max(mx1); mn1 = red4_min(mn1); s0 = red4_sum(s0); s1 = red4_sum(s1); q0 = red4_sum(q0); q1 = red4_sum(q1);
    const float me0 = s0 * (1.0f / 128.0f), me1 = s1 * (1.0f / 128.0f);
    const float g0 = fminf(fmaxf(me0 + 1.05f * sqrtf(fmaxf(q0 * (1.0f / 128.0f) - me0 * me0, 0.f)), mn0), mx0), g1 = fminf(fmaxf(me1 + 1.05f * sqrtf(fmaxf(q1 * (1.0f / 128.0f) - me1 * me1, 0.f)), mn1), mx1);
    float lo0 = mn0, hi0 = mx0, clo0 = 127.0f, chi0 = 0.0f; bool done0 = false;
    float lo1 = mn1, hi1 = mx1, clo1 = 127.0f, chi1 = 0.0f; bool done1 = false;
#pragma unroll 1
    for (int iter = 0; iter < 48; ++iter) {
        const bool r0 = done0 || clo0 <= 16.0f + (float)TK_STEP, r1 = done1 || clo1 <= 16.0f + (float)TK_STEP;
        if (__all(r0 && r1)) break;
        float f0 = tk_pivot(clo0, chi0), f1 = tk_pivot(clo1, chi1); if (iter >= TK_NI) { f0 = 0.5f; f1 = 0.5f; }
        float mid0 = lo0 + (hi0 - lo0) * f0, mid1 = lo1 + (hi1 - lo1) * f1; if (iter == 0) { mid0 = g0; mid1 = g1; }
        if (r0) mid0 = lo0; if (r1) mid1 = lo1;
        const float c0 = tk_count<32>(v0, mid0), c1 = tk_count<32>(v1, mid1);
        if (!r0) { if (c0 == 16.0f) { lo0 = mid0; clo0 = 16.0f; done0 = true; } else if (c0 > 16.0f) { lo0 = mid0; clo0 = c0; } else { hi0 = mid0; chi0 = c0; } }
        if (!r1) { if (c1 == 16.0f) { lo1 = mid1; clo1 = 16.0f; done1 = true; } else if (c1 > 16.0f) { lo1 = mid1; clo1 = c1; } else { hi1 = mid1; chi1 = c1; } }
    }
    const float sl0 = lo0, sl1 = lo1;
#pragma unroll 1
    for (int r = 0; r < TK_STEP; ++r) {
        const bool n0 = clo0 > 16.0f, n1 = clo1 > 16.0f;
        if (!__any(n0 || n1)) break;
        float y0 = 3.0e38f, y1 = 3.0e38f;
#pragma unroll
        for (int i = 0; i < 32; ++i) { y0 = fminf(y0, v0[i] > lo0 ? v0[i] : 3.0e38f); y1 = fminf(y1, v1[i] > lo1 ? v1[i] : 3.0e38f); }
        y0 = red4_min(y0); y1 = red4_min(y1);
        if (n0) { lo0 = y0; clo0 -= 1.0f; }
        if (n1) { lo1 = y1; clo1 -= 1.0f; }
    }
    if (__any(!done0 || !done1)) {
        const float c0 = tk_count<32>(v0, lo0), c1 = tk_count<32>(v1, lo1);
        if (c0 != 16.0f) lo0 = sl0; if (c1 != 16.0f) lo1 = sl1;
    }
    t0 = lo0; t1 = lo1;
}
template <int N> struct tk2_pair_c { static constexpr int value = tk2_pair(N); };
template <int MODE = 0> DI void peer_topk_fused(const Ctx& C, const bf16* QP, const bf16* KEYS, int* IDX, float* GATE) {
    constexpr int KPI = 288;
    const int lane = C.lane, fr = lane & 15, fq = lane >> 4, w = C.wave;
    LAS unsigned char* KS = C.lds;
    LAS unsigned char* WB = C.lds + 73728 + w * 7168;
    LAS float* LV = (LAS float*)(WB);
    LAS int* LK = (LAS int*)(WB + 2176);
    LAS float* FV = (LAS float*)(WB + 4352);
    LAS int* FI = (LAS int*)(WB + 5504);
    LAS float* TRASH = (LAS float*)(WB + 6656) + lane;
    const int h = C.vcu & 7, nb = C.G >> 3;
    { const bf16* kg = KEYS + (size_t)h * 2 * 128 * 128;
      for (int c = C.tid; c < 4096; c += 512) { const int r = c >> 4, cc = c & 15; *(LAS u32x4*)(KS + r * KPI + cc * 16) = *(const u32x4*)(kg + (size_t)r * 128 + cc * 8); } }
    __syncthreads();
    int cof[13];
#define TK2_COF(c) cof[c] = fq == 0 ? tk2_pair_c<4 * (c)>::value : fq == 1 ? tk2_pair_c<4 * (c) + 1>::value : fq == 2 ? tk2_pair_c<4 * (c) + 2>::value : tk2_pair_c<4 * (c) + 3>::value
    TK2_COF(0); TK2_COF(1); TK2_COF(2); TK2_COF(3); TK2_COF(4); TK2_COF(5); TK2_COF(6); TK2_COF(7); TK2_COF(8); TK2_COF(9); TK2_COF(10); TK2_COF(11); TK2_COF(12);
#undef TK2_COF
    for (int tt = (C.vcu >> 3) + nb * w; tt < 1024; tt += nb * 8) {
        const int tok = tt * 16 + fr;
        float sc0[32], sc1[32];
#pragma unroll
        for (int p = 0; p < 2; ++p) {
            bf16x8 qf[4];
#pragma unroll
            for (int ks = 0; ks < 4; ++ks) qf[ks] = *(const bf16x8*)(QP + (size_t)tok * 2048 + h * 256 + p * 128 + ks * 32 + fq * 8);
#pragma unroll
            for (int kt = 0; kt < 8; ++kt) {
                f32x4 acc = {0.f, 0.f, 0.f, 0.f};
#pragma unroll
                for (int ks = 0; ks < 4; ++ks) { const bf16x8 kf = *(const LAS bf16x8*)(KS + (p * 128 + kt * 16 + fr) * KPI + (ks * 32 + fq * 8) * 2);
                    acc = __builtin_amdgcn_mfma_f32_16x16x32_bf16(kf, qf[ks], acc, 0, 0, 0); }
                if (p == 0) { sc0[kt * 4 + 0] = acc[0]; sc0[kt * 4 + 1] = acc[1]; sc0[kt * 4 + 2] = acc[2]; sc0[kt * 4 + 3] = acc[3]; }
                else { sc1[kt * 4 + 0] = acc[0]; sc1[kt * 4 + 1] = acc[1]; sc1[kt * 4 + 2] = acc[2]; sc1[kt * 4 + 3] = acc[3]; }
            }
        }
        float thrA = 1.0f, thrB = 1.0f; if (MODE == 0) tk_search2(sc0, sc1, thrA, thrB);
#pragma unroll
        for (int p = 0; p < 2; ++p) {
            const float thr = p == 0 ? thrA : thrB;
            int cnt = 0;
#pragma unroll
            for (int i = 0; i < 32; ++i) cnt += ((p == 0 ? sc0[i] : sc1[i]) > thr) ? 1 : 0;
            const int c0 = __shfl(cnt, fr), c1 = __shfl(cnt, fr + 16), c2 = __shfl(cnt, fr + 32);
            int pos = (fq > 0 ? c0 : 0) + (fq > 1 ? c1 : 0) + (fq > 2 ? c2 : 0);
#pragma unroll
            for (int i = 0; i < 32; ++i) { const float vv = p == 0 ? sc0[i] : sc1[i]; const bool s = vv > thr && pos < 16;
                LAS float* pv = s ? (LV + fr * 33 + p * 16 + pos) : TRASH; LAS int* pk = s ? (LK + fr * 33 + p * 16 + pos) : (LAS int*)TRASH;
                *pv = vv; *pk = (i >> 2) * 16 + 4 * fq + (i & 3); pos += (vv > thr) ? 1 : 0; }
        }
        LDS_WAIT();
        {
            const int lb = fr * 33 + (fq >> 1) * 16, e0 = 8 * (fq & 1);
            float L[16], ownv[8], own[8]; int okey[8], rk[8];
#pragma unroll
            for (int q = 0; q < 16; ++q) L[q] = __uint_as_float((__float_as_uint(LV[lb + q]) & ~15u) | (unsigned)q);
#pragma unroll
            for (int i = 0; i < 8; ++i) { ownv[i] = LV[lb + e0 + i]; okey[i] = LK[lb + e0 + i]; own[i] = __uint_as_float((__float_as_uint(ownv[i]) & ~15u) | (unsigned)(e0 + i)); }
#pragma unroll
            for (int i = 0; i < 8; ++i) { int r = 0;
#pragma unroll
                for (int q = 0; q < 16; ++q) r += (L[q] > own[i]) ? 1 : 0;
                rk[i] = r; }
#pragma unroll
            for (int i = 0; i < 8; ++i) { LV[lb + rk[i]] = ownv[i]; LK[lb + rk[i]] = okey[i]; }
        }
        LDS_WAIT();
        float sm[13]; int ca[13], cb[13];
#pragma unroll
        for (int c = 0; c < 13; ++c) { ca[c] = fr * 33 + (cof[c] & 255); cb[c] = fr * 33 + 16 + (cof[c] >> 8); sm[c] = LV[ca[c]] + LV[cb[c]]; }
        float thr2 = 4.0f; if (MODE == 0) tk_search<13>(sm, 52.0f, thr2);
        {
            int cnt = 0;
#pragma unroll
            for (int i = 0; i < 13; ++i) cnt += (sm[i] > thr2) ? 1 : 0;
            const int c0 = __shfl(cnt, fr), c1 = __shfl(cnt, fr + 16), c2 = __shfl(cnt, fr + 32);
            int pos = (fq > 0 ? c0 : 0) + (fq > 1 ? c1 : 0) + (fq > 2 ? c2 : 0);
#pragma unroll
            for (int i = 0; i < 13; ++i) { const bool s = sm[i] > thr2 && pos < 16;
                LAS float* pv = s ? (FV + fr * 17 + pos) : TRASH; LAS int* pk = s ? (FI + fr * 17 + pos) : (LAS int*)TRASH;
                *pv = sm[i]; *pk = LK[ca[i]] * 128 + LK[cb[i]]; pos += (sm[i] > thr2) ? 1 : 0; }
        }
        LDS_WAIT();
        float x[4]; int xi[4];
#pragma unroll
        for (int j = 0; j < 4; ++j) { x[j] = FV[fr * 17 + 4 * fq + j]; xi[j] = FI[fr * 17 + 4 * fq + j]; }
        float m = red4_max(fmaxf(fmaxf(x[0], x[1]), fmaxf(x[2], x[3])));
        float e[4]; float s = 0.f;
#pragma unroll
        for (int j = 0; j < 4; ++j) { e[j] = __expf(x[j] - m); s += e[j]; }
        s = red4_sum(s);
        const float inv = 1.0f / s;
        const size_t ob = ((size_t)tok * 8 + h) * 16 + 4 * fq;
        typedef int i32x4 __attribute__((ext_vector_type(4)));
        *(i32x4*)(IDX + ob) = (i32x4){xi[0], xi[1], xi[2], xi[3]}; *(f32x4*)(GATE + ob) = (f32x4){e[0] * inv, e[1] * inv, e[2] * inv, e[3] * inv};
        LDS_WAIT();
    }
}
DI void intra_mfma(const Ctx& C, const bf16* Q, const bf16* K, const bf16* V, const bf16* CROSS, bf16* G) {
    constexpr int RPI = 544, PPI = 144, VPI = 544;
    LAS unsigned char* Qs = C.lds; LAS unsigned char* Ks = Qs + 64 * RPI; LAS unsigned char* Ps = Ks + 64 * RPI; LAS unsigned char* Vs = Ps + 64 * PPI;
    LAS float* red = (LAS float*)(Vs + 64 * VPI);
    const int tid = C.tid, lane = C.lane, w = C.wave, fr = lane & 15, fq = lane >> 4;
    for (int item = C.vcu; item < 1024; item += C.G) {
        const int b = item >> 9, h = (item >> 7) & 3, n = item & 127;
        const float lg2 = log2f(1.0f - exp2f(-5.0f - (float)h));
        const size_t tok0 = (size_t)b * SEQ + (size_t)n * 64;
#pragma unroll
        for (int u = 0; u < 4; ++u) { const int c = tid + 512 * u, r = c >> 5, cc = c & 31;
            *(LAS u32x4*)(Qs + r * RPI + cc * 16) = *(const u32x4*)(Q + (tok0 + r) * 1024 + h * 256 + cc * 8);
            *(LAS u32x4*)(Ks + r * RPI + cc * 16) = *(const u32x4*)(K + (tok0 + r) * 1024 + h * 256 + cc * 8);
            *(LAS u32x4*)(Vs + r * VPI + cc * 16) = *(const u32x4*)(V + (tok0 + r) * 2048 + h * 512 + cc * 8); }
        __syncthreads();
        { const int jt = w >> 1; f32x4 sa[2] = {(f32x4){0.f, 0.f, 0.f, 0.f}, (f32x4){0.f, 0.f, 0.f, 0.f}};
#pragma unroll
          for (int ks = 0; ks < 8; ++ks) { const bf16x8 kf = *(const LAS bf16x8*)(Ks + (16 * jt + fr) * RPI + (32 * ks + 8 * fq) * 2);
#pragma unroll
              for (int q = 0; q < 2; ++q) { const int it = 2 * (w & 1) + q; const bf16x8 qf = *(const LAS bf16x8*)(Qs + (16 * it + fr) * RPI + (32 * ks + 8 * fq) * 2);
                  sa[q] = __builtin_amdgcn_mfma_f32_16x16x32_bf16(kf, qf, sa[q], 0, 0, 0); } }
#pragma unroll
          for (int q = 0; q < 2; ++q) { const int i = 16 * (2 * (w & 1) + q) + fr, j0 = 16 * jt + 4 * fq; float pv[4];
#pragma unroll
              for (int r = 0; r < 4; ++r) { const int dd = i > j0 + r ? i - j0 - r : j0 + r - i; pv[r] = sa[q][r] * exp2f(lg2 * (float)dd); }
              u32x2_t o; o.x = cvtpk(pv[0], pv[1]); o.y = cvtpk(pv[2], pv[3]); *(LAS u32x2_t*)(Ps + i * PPI + j0 * 2) = o; } }
        __syncthreads();
        f32x4 acc[2][2][4];
#pragma unroll
        for (int hf = 0; hf < 2; ++hf) {
#pragma unroll
            for (int et = 0; et < 2; ++et)
#pragma unroll
                for (int it = 0; it < 4; ++it) acc[hf][et][it] = (f32x4){0.f, 0.f, 0.f, 0.f};
            if (hf == 1) { __syncthreads();
#pragma unroll
                for (int u = 0; u < 4; ++u) { const int c = tid + 512 * u, r = c >> 5, cc = c & 31;
                    *(LAS u32x4*)(Vs + r * VPI + cc * 16) = *(const u32x4*)(V + (tok0 + r) * 2048 + h * 512 + 256 + cc * 8); }
                __syncthreads(); }
#pragma unroll
            for (int ks = 0; ks < 2; ++ks) {
                bf16x8 pf[4];
#pragma unroll
                for (int it = 0; it < 4; ++it) { const LAS unsigned char* pp = Ps + (16 * it + fr) * PPI + (32 * ks + 4 * fq) * 2;
                    const u32x2_t lo = *(const LAS u32x2_t*)pp, hi = *(const LAS u32x2_t*)(pp + 32); u32x4 ww; ww.x = lo.x; ww.y = lo.y; ww.z = hi.x; ww.w = hi.y; pf[it] = __builtin_bit_cast(bf16x8, ww); }
#pragma unroll
                for (int et = 0; et < 2; ++et) { const LAS unsigned char* vp = Vs + (32 * ks + 4 * fq + (fr >> 2)) * VPI + (32 * w + 16 * et + 4 * (fr & 3)) * 2;
                    const bf16x8 vf = cat8(trr(vp), trr(vp + 16 * VPI));
#pragma unroll
                    for (int it = 0; it < 4; ++it) acc[hf][et][it] = __builtin_amdgcn_mfma_f32_16x16x32_bf16(vf, pf[it], acc[hf][et][it], 0, 0, 0); }
            }
        }
        float ssq[4] = {0.f, 0.f, 0.f, 0.f};
#pragma unroll
        for (int hf = 0; hf < 2; ++hf)
#pragma unroll
            for (int et = 0; et < 2; ++et)
#pragma unroll
                for (int it = 0; it < 4; ++it) { const u32x2_t cv = *(const u32x2_t*)(CROSS + (tok0 + 16 * it + fr) * 2048 + h * 512 + hf * 256 + 32 * w + 16 * et + 4 * fq);
                    f32x4 y = acc[hf][et][it]; y[0] += bflo(cv.x); y[1] += bfhi(cv.x); y[2] += bflo(cv.y); y[3] += bfhi(cv.y); acc[hf][et][it] = y;
                    ssq[it] += (y[0] * y[0] + y[1] * y[1]) + (y[2] * y[2] + y[3] * y[3]); }
#pragma unroll
        for (int it = 0; it < 4; ++it) { float s = ssq[it]; s += __shfl_xor(s, 16); s += __shfl_xor(s, 32); if (fq == 0) red[w * 64 + 16 * it + fr] = s; }
        __syncthreads();
        float rs[4];
#pragma unroll
        for (int it = 0; it < 4; ++it) { float s = 0.f;
#pragma unroll
            for (int ww = 0; ww < 8; ++ww) s += red[ww * 64 + 16 * it + fr];
            rs[it] = 1.0f / sqrtf(s * (1.0f / 512.0f) + EPS); }
#pragma unroll
        for (int hf = 0; hf < 2; ++hf)
#pragma unroll
            for (int et = 0; et < 2; ++et)
#pragma unroll
                for (int it = 0; it < 4; ++it) { bf16* gp = G + (tok0 + 16 * it + fr) * 2048 + h * 512 + hf * 256 + 32 * w + 16 * et + 4 * fq; const u32x2_t gv = *(const u32x2_t*)gp;
                    const f32x4 y = acc[hf][et][it] * rs[it]; u32x2_t o; o.x = cvtpk(y[0] * bflo(gv.x), y[1] * bfhi(gv.x)); o.y = cvtpk(y[2] * bflo(gv.y), y[3] * bfhi(gv.y)); *(u32x2_t*)gp = o; }
        __syncthreads();
    }
}
#ifndef PHMASK
#define PHMASK 0xFFFFFFu
#endif
#define PH(k) ((PHMASK >> (k)) & 1u)
#ifdef USE_SGU_NAIVE
#define SGU_GATE_FN sgu_gate_naive
#else
#define SGU_GATE_FN sgu_gate_mfma
#endif
#ifdef USE_GATHER_TOKEN
#define GATHER_FN peer_gather8
#else
#ifdef USE_GATHER_ROUNDS
#define GATHER_FN peer_gather_rounds
#else
#define GATHER_FN peer_gather_dma
#endif
#endif
#ifndef DUP_GATHER_SKIP
#define DUP_GATHER_SKIP 0
#endif
#ifndef DUP_GATHER_FAKE
#define DUP_GATHER_FAKE false
#endif
struct Args { const void* in[21]; float* out; unsigned char* ws; };
__global__ void __launch_bounds__(NWAVES * 64, 2) mk_fwd(Args args) {
    extern __shared__ __attribute__((aligned(16))) unsigned char lds[];
    Ctx C; C.lds = (LAS unsigned char*)lds; C.tid = threadIdx.x; C.lane = C.tid & 63; C.wave = __builtin_amdgcn_readfirstlane(C.tid >> 6);
    C.G = gridDim.x; { const int bx = blockIdx.x; C.vcu = (C.G % 8 == 0) ? (bx % 8) * (C.G / 8) + bx / 8 : bx; }
    C.ws = args.ws;
    volatile LAS unsigned* MISC = (volatile LAS unsigned*)(C.lds + MISC_OFF);
    gu32* ctl = (gu32*)(args.ws + WS_CTL);
    for (int u = C.tid; u < (LDS_BYTES - LDSCTL_OFF) / 4; u += NWAVES * 64) ((LAS unsigned*)(C.lds + LDSCTL_OFF))[u] = 0u;
    __syncthreads();
    XcdBarrier bar = xcd_barrier_post((unsigned*)(ctl + CW_BAR), MISC + 8);
#define GRID_BAR() do { xcd_barrier(bar); asm volatile("" : "+v"(C.tid)); C.lane = C.tid & 63; C.wave = __builtin_amdgcn_readfirstlane(C.tid >> 6); } while (0)
    { LAS unsigned long long* PT = (LAS unsigned long long*)(C.lds + PTR_OFF);
      if (C.tid == 0) {
#pragma unroll
          for (int i = 0; i < 21; ++i) PT[i] = (unsigned long long)args.in[i];
      } }
    __syncthreads();
#define INP(T, i) ((const T*)ldp(C, i))
    float* out = args.out; unsigned char* ws = args.ws;
#define MODP ((float*)(ws + WS_MOD))
#define MOD0 ((const float*)(ws + WS_MOD))
#define MOD1 ((const float*)(ws + WS_MOD) + 2 * 6144)
#define cosT ((float*)(ws + WS_COS))
#define sinT ((float*)(ws + WS_SIN))
#define WRI ((bf16*)(ws + WS_WRI))
#define WRO ((bf16*)(ws + WS_WRO))
#define WSI ((bf16*)(ws + WS_WSI))
#define WSO ((bf16*)(ws + WS_WSO))
#define WQ ((bf16*)(ws + WS_WQ))
#define KEYS ((bf16*)(ws + WS_KEYS))
#define STATS ((float*)(ws + WS_STATS))
#define IDX ((int*)(ws + WS_IDX))
#define GATE ((float*)(ws + WS_GATE))
#define H ((bf16*)(ws + WS_H))
#define PU8 ((const unsigned char*)(ws + WS_PU))
#define PV8 ((const unsigned char*)(ws + WS_PV))
#define ISU ((const float*)(ws + WS_ISU))
#define ISV ((const float*)(ws + WS_ISV))
#define Qb ((bf16*)(ws + WS_Q))
#define Kb ((bf16*)(ws + WS_K))
#define Vb ((bf16*)(ws + WS_V))
#define Gb ((bf16*)(ws + WS_G))
#define CROSS ((bf16*)(ws + WS_CROSS))
#define QP ((bf16*)(ws + WS_QP))
#define SCO ((float*)(ws + WS_SC))
#define Ub ((bf16*)(ws + WS_U))
#define VBb ((bf16*)(ws + WS_VB))

    { P0In I; I.c = INP(float, 1); I.ada_w = INP(float, 5); I.ada_b = INP(float, 6); I.ret_w_in = INP(float, 7); I.ret_w_out = INP(float, 8); I.sgu_w_in = INP(float, 9); I.sgu_w_out = INP(float, 15); I.wq = INP(float, 16); I.keys = INP(float, 17); I.pu = INP(float, 18); I.pv = INP(float, 19); I.pos = INP(int, 2);
#ifdef DUP_P0
      p0_prologue(C, I);
      GRID_BAR();
#endif
      if (PH(0)) p0_prologue(C, I); }
    GRID_BAR();
    if (PH(1)) rms_mod_phase(C, INP(float, 0), INP(float, 3), MOD0, 0, 1024, H);
    GRID_BAR();
    { pg8::Gemm g{H, WRI, TT, 6144, 1024}; pg8::StaticOrder S; S.init(TT, 6144, C.G, (int)blockIdx.x);
      pg8::EpiRetProj E{Qb, Kb, Vb, Gb, cosT, sinT};
#ifdef DUP_G1
      pg8::gemm_phase<pg8::EpiRetProj, pg8::StaticOrder, true, true>(C.lds + RING_OFF, g, S, E); GRID_BAR();
#endif
      if (PH(2)) pg8::gemm_phase<pg8::EpiRetProj, pg8::StaticOrder, true, true>(C.lds + RING_OFF, g, S, E); }
    GRID_BAR();
    #ifdef USE_SCAN_NAIVE
    if (PH(3)) scan_naive(C, Qb, Kb, Vb, CROSS);
#else
#ifdef DUP_SCAN
    scan_mfma<DUP_SCAN>(C, Qb, Kb, Vb, CROSS);
    GRID_BAR();
#endif
    if (C.vcu < SCAN_NIT) { if (PH(3)) scan_mfma<0>(C, Qb, Kb, Vb, CROSS); }
    else { P0In I; I.c = nullptr; I.ada_w = nullptr; I.ada_b = nullptr; I.ret_w_in = nullptr; I.ret_w_out = nullptr; I.sgu_w_in = INP(float, 9); I.sgu_w_out = INP(float, 15); I.wq = INP(float, 16); I.keys = nullptr; I.pu = INP(float, 18); I.pv = INP(float, 19); I.pos = nullptr;
      side_work(C, I, SCAN_NIT); }
#endif
    GRID_BAR();
#ifdef USE_INTRA_NAIVE
    if (PH(4)) intra_naive(C, Qb, Kb, Vb, CROSS, Gb);
#else
    if (PH(4)) intra_mfma(C, Qb, Kb, Vb, CROSS, Gb);
#endif
    GRID_BAR();
    { pg8::Gemm g{Gb, WRO, TT, 1024, 2048}; pg8::StaticOrder S; S.init(TT, 1024, C.G, (int)blockIdx.x);
      pg8::EpiResGate E{INP(float, 0), out, MOD0 + 2048, 6144};
      if (PH(5)) pg8::gemm_phase<pg8::EpiResGate, pg8::StaticOrder, true, true>(C.lds + RING_OFF, g, S, E); }
    GRID_BAR();
    if (PH(6)) rms_mod_phase(C, out, INP(float, 4), MOD0, 3072, 4096, H);
    GRID_BAR();
    { pg8::Gemm g{H, WQ, TT, 2048, 1024}; pg8::StaticOrder S; S.init(TT, 2048, C.G, (int)blockIdx.x);
      pg8::EpiBf16<0> E{QP, 2048, nullptr, 0, 0, 1.f};
      if (PH(7)) pg8::gemm_phase<pg8::EpiBf16<0>, pg8::StaticOrder, true, true>(C.lds + RING_OFF, g, S, E); }
    GRID_BAR();
#ifdef USE_TOPK_NAIVE
    if (PH(8)) peer_scores(C, QP, KEYS, SCO);
    GRID_BAR();
    if (PH(9)) peer_topk(C, SCO, IDX, GATE);
#else
#ifdef DUP_TOPK
    peer_topk_fused<DUP_TOPK>(C, QP, KEYS, IDX, GATE);
    GRID_BAR();
#endif
    if (PH(9)) peer_topk_fused<0>(C, QP, KEYS, IDX, GATE);
#endif
    GRID_BAR();
#ifdef DUP_GATHER
    GATHER_FN<false, DUP_GATHER_FAKE, DUP_GATHER_SKIP>(C, H, IDX, GATE, PU8, PV8, ISU, ISV, (float*)(ws + WS_R), MOD0 + 5120, INP(float, 3) + 1024, MOD1, (bf16*)(ws + WS_R + 128 * MiB));
    GRID_BAR();
#endif
    if (PH(10)) GATHER_FN<false>(C, H, IDX, GATE, PU8, PV8, ISU, ISV, out, MOD0 + 5120, INP(float, 3) + 1024, MOD1, H);
    GRID_BAR();
#ifdef DUP_BAR
    for (int q_ = 0; q_ < 10; ++q_) GRID_BAR();
#endif
    { pg8::Gemm g{H, WSI, TT, 6144, 1024}; pg8::StaticOrder S; S.init(TT, 6144, C.G, (int)blockIdx.x);
      pg8::EpiSguIn E{Ub, VBb, INP(float, 10), STATS};
#ifdef DUP_G7
      pg8::gemm_phase<pg8::EpiSguIn, pg8::StaticOrder, true, true>(C.lds + RING_OFF, g, S, E); GRID_BAR();
#endif
      if (PH(11)) pg8::gemm_phase<pg8::EpiSguIn, pg8::StaticOrder, true, true>(C.lds + RING_OFF, g, S, E); }
    GRID_BAR();
    if (PH(12)) SGU_GATE_FN(C, Ub, VBb, STATS, INP(float, 13), INP(float, 14), INP(float, 11), INP(float, 12));
    GRID_BAR();
    { pg8::Gemm g{Ub, WSO, TT, 1024, 3072}; pg8::StaticOrder S; S.init(TT, 1024, C.G, (int)blockIdx.x);
      pg8::EpiResGate E{out, out, MOD1 + 2048, 6144};
      if (PH(13)) pg8::gemm_phase<pg8::EpiResGate, pg8::StaticOrder, true, true>(C.lds + RING_OFF, g, S, E); }
    GRID_BAR();
    if (PH(14)) rms_mod_phase(C, out, INP(float, 4) + 1024, MOD1, 3072, 4096, H);
    GRID_BAR();
    { pg8::Gemm g{H, WQ + (size_t)2048 * 1024, TT, 2048, 1024}; pg8::StaticOrder S; S.init(TT, 2048, C.G, (int)blockIdx.x);
      pg8::EpiBf16<0> E{QP, 2048, nullptr, 0, 0, 1.f};
      if (PH(15)) pg8::gemm_phase<pg8::EpiBf16<0>, pg8::StaticOrder, true, true>(C.lds + RING_OFF, g, S, E); }
    GRID_BAR();
#ifdef USE_TOPK_NAIVE
    if (PH(16)) peer_scores(C, QP, KEYS + (size_t)8 * 2 * 128 * 128, SCO);
    GRID_BAR();
    if (PH(17)) peer_topk(C, SCO, IDX, GATE);
#else
    if (PH(17)) peer_topk_fused<0>(C, QP, KEYS + (size_t)8 * 2 * 128 * 128, IDX, GATE);
#endif
    GRID_BAR();
    if (PH(18)) GATHER_FN<true>(C, H, IDX, GATE, PU8 + (size_t)16384 * 1024, PV8 + (size_t)16384 * 1024, ISU + 16384, ISV + 16384, out, MOD1 + 5120, INP(float, 20), nullptr, nullptr);
#undef GRID_BAR
}

extern "C" void kernel_launch(void* const* d_in, const int* in_sizes, int n_in, void* d_out, int out_size, void* d_ws, size_t ws_size, hipStream_t stream) {
    static int grid = 0;
    if (grid == 0) {
        if (n_in != 21 || in_sizes[0] != TT * DM || out_size != TT * DM || ws_size < WS_END) { fprintf(stderr, "kernel_launch: unexpected shapes/workspace: n_in %d in0 %d out %d ws %zu (need %zu)\n", n_in, n_in > 0 ? in_sizes[0] : -1, out_size, ws_size, (size_t)WS_END); grid = -1; return; }
        int dev = 0, cus = 0;
        if (hipGetDevice(&dev) != hipSuccess || hipDeviceGetAttribute(&cus, hipDeviceAttributeMultiprocessorCount, dev) != hipSuccess) { fprintf(stderr, "kernel_launch: device query failed\n"); grid = -1; return; }
        if (hipFuncSetAttribute((const void*)mk_fwd, hipFuncAttributeMaxDynamicSharedMemorySize, LDS_BYTES) != hipSuccess) { fprintf(stderr, "kernel_launch: hipFuncSetAttribute failed\n"); grid = -1; return; }
        (void)hipGetLastError();
        grid = cus;
    }
    if (grid < 0) return;
    if (hipMemsetAsync((char*)d_ws + WS_CTL, 0, CTL_ZERO_BYTES, stream) != hipSuccess) { fprintf(stderr, "kernel_launch: memset failed\n"); return; }
    Args a; memset(&a, 0, sizeof(a));
    for (int i = 0; i < 21; ++i) a.in[i] = d_in[i];
    a.out = (float*)d_out; a.ws = (unsigned char*)d_ws;
    hipLaunchKernelGGL(mk_fwd, dim3(grid), dim3(NWAVES * 64), LDS_BYTES, stream, a);
    const hipError_t le = hipPeekAtLastError();
    if (le != hipSuccess) fprintf(stderr, "kernel_launch: launch failed: %s\n", hipGetErrorName(le));
}
```

```cpp
#define USE_GATHER_ROUNDS 1
#include <hip/hip_runtime.h>
#include <cstdio>
#include <cstdint>
#include <cstring>
#include <cmath>
namespace pg8 {
#define PG8_LAS __attribute__((address_space(3)))
typedef unsigned short bf16_t;
typedef short bf16x8 __attribute__((ext_vector_type(8)));
typedef float f32x4 __attribute__((ext_vector_type(4)));
typedef unsigned u32x4 __attribute__((ext_vector_type(4)));
constexpr int BM = 256, BK = 64, HALF = 128, HTB = HALF * BK * 2  , STAGE_BYTES = 8 * HTB, NXCD = 8, WGM = 8;

__host__ __device__ __forceinline__ int lds_byte(int r, int c) { const int st = (r >> 4) * 2 + (c >> 5), rr = r & 15, cc = c & 31, ob = rr * 64 + cc * 2; return st * 1024 + (ob ^ (((ob >> 9) & 1) << 5)); }
__host__ __device__ __forceinline__ void stage_rc(int b, int& R, int& C) { const int st = b / 1024, sb = b % 1024, swz = sb ^ (((sb >> 9) & 1) << 5); R = (st >> 1) * 16 + swz / 64; C = (st & 1) * 32 + (swz % 64) / 2; }
__host__ __device__ __forceinline__ int perm32(int rho) { const int n = rho >> 4, i = rho & 15; return 8 * (i >> 2) + 4 * n + (i & 3); }

struct Unit { int pm, pn; };
struct Gemm { const bf16_t* A; const bf16_t* Bt; int M, N, K; };

struct StaticOrder {
    int nM, nN, nwg, G, c;
    __host__ __device__ void init(int M, int N, int G_, int c_) { nM = M / BM; nN = N / BM; nwg = nM * nN; G = G_; c = c_; }
    __host__ __device__ bool next(int i, Unit& u) const {
        const long L = (long)i * G + c; if (L >= nwg) return false;
        int wgid = (int)L; { const int q = nwg / NXCD, r = nwg % NXCD, xcd = wgid % NXCD, off = wgid / NXCD; wgid = (xcd < r ? xcd * (q + 1) : r * (q + 1) + (xcd - r) * q) + off; }
        const int nig = WGM * nN, gid = wgid / nig, fm = gid * WGM, gsz = (nM - fm) < WGM ? (nM - fm) : WGM;
        u.pm = fm + ((wgid % nig) % gsz); u.pn = (wgid % nig) / gsz; return true;
    }
    __device__ __forceinline__ void a_ready(const Unit&) const {}
    __device__ __forceinline__ void done(const Unit&) const {}
};

__device__ __forceinline__ unsigned cvt_pk_bf16(float lo, float hi) { unsigned r; asm volatile("v_cvt_pk_bf16_f32 %0, %1, %2" : "=v"(r) : "v"(lo), "v"(hi)); return r; }
typedef float f32x2 __attribute__((ext_vector_type(2)));
__device__ __forceinline__ f32x2 gelu_pk(f32x2 v) {
    const f32x2 av = __builtin_elementwise_abs(v), d = av * 0.2316418882f + 1.0f;
    f32x2 t; t.x = __builtin_amdgcn_rcpf(d.x); t.y = __builtin_amdgcn_rcpf(d.y);
    f32x2 q = t * 0.5307027145f + (-0.7265760135f); q = q * t + 0.7107068705f; q = q * t + (-0.142248368f); q = q * t + 0.127414796f; q = q * t;
    const f32x2 s = (v * v) * (-0.72134752044f);
    f32x2 e; e.x = __builtin_amdgcn_exp2f(s.x); e.y = __builtin_amdgcn_exp2f(s.y);
    const f32x2 m = v * (q * e), r = v - m;
    f32x2 o; o.x = v.x < 0.f ? m.x : r.x; o.y = v.y < 0.f ? m.y : r.y; return o;
}

template <int ACT  > struct EpiBf16 {
    static constexpr bool PERM = true, AFTER_DRAIN = false; static_assert(ACT == 0 || ACT == 1, "EpiBf16: ACT is 0 (none) or 1 (gelu_pk)");
    bf16_t* O; int ldc; const float* bias; int split_cols; size_t split_stride; float scale0;
    __device__ __forceinline__ void operator()(const f32x4 (&acc)[2][2][4][2], const Unit& u, int wr, int wc, int fr, int fq) const {
        const int row0 = u.pm * BM + wr * 64 + fr; int colt = u.pn * BM; bf16_t* base = O;
        float sc = 1.f; if (split_cols) { const int t = colt / split_cols; base += (size_t)t * split_stride; colt -= t * split_cols; if (t == 0) sc = scale0; }
        const int col0 = colt + wc * 32 + 8 * fq, bcol0 = u.pn * BM + wc * 32 + 8 * fq;
        f32x4 bv[2][2];
#pragma unroll
        for (int bj = 0; bj < 2; ++bj)
#pragma unroll
            for (int n = 0; n < 2; ++n) bv[bj][n] = bias ? *(const f32x4*)(bias + bcol0 + bj * HALF + 4 * n) : (f32x4){0.f, 0.f, 0.f, 0.f};
#pragma unroll
        for (int ai = 0; ai < 2; ++ai)
#pragma unroll
            for (int m = 0; m < 4; ++m) { bf16_t* rowp = base + (size_t)(row0 + ai * HALF + m * 16) * ldc + col0;
#pragma unroll
                for (int bj = 0; bj < 2; ++bj) { f32x4 v0 = acc[ai][bj][m][0] + bv[bj][0], v1 = acc[ai][bj][m][1] + bv[bj][1];
                    if (ACT == 1) { f32x2 a = gelu_pk((f32x2){v0[0], v0[1]}), b = gelu_pk((f32x2){v0[2], v0[3]}), c = gelu_pk((f32x2){v1[0], v1[1]}), d = gelu_pk((f32x2){v1[2], v1[3]});
                        v0 = (f32x4){a.x, a.y, b.x, b.y}; v1 = (f32x4){c.x, c.y, d.x, d.y}; }
                    v0 = v0 * sc; v1 = v1 * sc; u32x4 w; w.x = cvt_pk_bf16(v0[0], v0[1]); w.y = cvt_pk_bf16(v0[2], v0[3]); w.z = cvt_pk_bf16(v1[0], v1[1]); w.w = cvt_pk_bf16(v1[2], v1[3]);
                    *(u32x4*)(rowp + bj * HALF) = w; } }
    }
};
template <class Epi, class Sched, bool ALIGN_EPI = false, bool SP2 = false>
__device__ __forceinline__ void gemm_phase(PG8_LAS unsigned char* lds, const Gemm g, const Sched& S, const Epi& E) {
    int tid_ = threadIdx.x; asm volatile("" : "+v"(tid_));
    const int tid = tid_, wid = __builtin_amdgcn_readfirstlane(tid >> 6), lane = tid & 63, wr = wid >> 2, wc = wid & 3, fr = lane & 15, fq = lane >> 4;
    const int K = g.K, nt = K / BK;
    unsigned voffA[2], voffB[2];
#pragma unroll
    for (int i = 0; i < 2; ++i) { int R, C; stage_rc(tid * 16 + i * 8192, R, C); const int Rb = Epi::PERM ? ((R & ~31) + perm32(R & 31)) : R;
        voffA[i] = (unsigned)(R * K + C) * 2u; voffB[i] = (unsigned)(Rb * K + C) * 2u; }
    const size_t kstep = (size_t)(BK * 2);
    const size_t hstep = (size_t)HALF * K * 2;
    const size_t tstep = 2 * hstep;
    const unsigned ldsw = (unsigned)wid * 1024u;
    const int aoff = lds_byte(wr * 64 + fr, fq * 8), boff = lds_byte(wc * 32 + fr, fq * 8);
#define PG8_SA(b, h) (((b) * 2 + (h)) * HTB)
#define PG8_SB(b, h) ((4 + (b) * 2 + (h)) * HTB)
#define PG8_STAGE(bufoff, gbase, voff) do { _Pragma("unroll") for (int _i = 0; _i < 2; ++_i) \
        __builtin_amdgcn_global_load_lds((const unsigned*)((const char*)(gbase) + (voff)[_i]), (PG8_LAS unsigned*)(lds + (bufoff) + ldsw + _i * 8192), 16, 0, 0); } while (0)
#define PG8_LDA(dst, b, h) do { _Pragma("unroll") for (int m = 0; m < 4; ++m) _Pragma("unroll") for (int k = 0; k < 2; ++k) dst[m][k] = *(const PG8_LAS bf16x8*)(lds + PG8_SA(b, h) + aoff + m * 2048 + k * 1024); } while (0)
#define PG8_LDB(dst, b, h) do { _Pragma("unroll") for (int n = 0; n < 2; ++n) _Pragma("unroll") for (int k = 0; k < 2; ++k) dst[n][k] = *(const PG8_LAS bf16x8*)(lds + PG8_SB(b, h) + boff + n * 2048 + k * 1024); } while (0)
#define PG8_MMA(ai, bj, At, Bt) do { __builtin_amdgcn_s_setprio(1); _Pragma("unroll") for (int m = 0; m < 4; ++m) _Pragma("unroll") for (int n = 0; n < 2; ++n) _Pragma("unroll") for (int k = 0; k < 2; ++k) \
        acc[ai][bj][m][n] = __builtin_amdgcn_mfma_f32_16x16x32_bf16(Bt[n][k], At[m][k], acc[ai][bj][m][n], 0, 0, 0); __builtin_amdgcn_s_setprio(0); } while (0)
#define PG8_WAIT_V(n) asm volatile("s_waitcnt vmcnt(" #n ")" ::: "memory")
#define PG8_WAIT_L(n) asm volatile("s_waitcnt lgkmcnt(" #n ")" ::: "memory")
#define PG8_BAR __builtin_amdgcn_s_barrier()
#define PG8_SCHED __builtin_amdgcn_sched_barrier(0)
    Unit cur, nxt; int ui = 0;
    if (!S.next(0, cur)) return;
    f32x4 acc[2][2][4][2];
#pragma unroll
    for (int a = 0; a < 2; ++a)
#pragma unroll
        for (int b = 0; b < 2; ++b)
#pragma unroll
            for (int m = 0; m < 4; ++m)
#pragma unroll
                for (int n = 0; n < 2; ++n) acc[a][b][m][n] = (f32x4){0.f, 0.f, 0.f, 0.f};
    bf16x8 At[4][2], B0[2][2], B1[2][2];
    const char* cA = (const char*)g.A + (size_t)cur.pm * tstep; const char* cB = (const char*)g.Bt + (size_t)cur.pn * tstep;
    S.a_ready(cur);
    if constexpr (SP2) {
        PG8_STAGE(PG8_SB(0, 0), cB, voffB); PG8_STAGE(PG8_SB(0, 1), cB + hstep, voffB); PG8_STAGE(PG8_SA(0, 0), cA, voffA); PG8_STAGE(PG8_SA(0, 1), cA + hstep, voffA);
        if (wr == 1) PG8_BAR;
        PG8_WAIT_V(2); PG8_BAR;
        PG8_STAGE(PG8_SB(1, 0), cB + kstep, voffB); PG8_STAGE(PG8_SA(1, 0), cA + kstep, voffA); PG8_STAGE(PG8_SB(1, 1), cB + hstep + kstep, voffB);
        PG8_WAIT_V(6); PG8_BAR;
    } else {
        PG8_STAGE(PG8_SB(0, 0), cB, voffB); PG8_STAGE(PG8_SA(0, 0), cA, voffA); PG8_STAGE(PG8_SB(0, 1), cB + hstep, voffB); PG8_STAGE(PG8_SA(0, 1), cA + hstep, voffA);
        if (wr == 1) PG8_BAR;
        PG8_WAIT_V(4); PG8_BAR;
        PG8_STAGE(PG8_SB(1, 0), cB + kstep, voffB); PG8_STAGE(PG8_SA(1, 0), cA + kstep, voffA); PG8_STAGE(PG8_SB(1, 1), cB + hstep + kstep, voffB);
        PG8_WAIT_V(6); PG8_BAR;
    }
    for (;;) {
        const bool has_next = S.next(ui + 1, nxt);
        const char* nA = has_next ? (const char*)g.A + (size_t)nxt.pm * tstep : cA; const char* nB = has_next ? (const char*)g.Bt + (size_t)nxt.pn * tstep : cB;
        for (int t = 0; t < nt; t += 2) {
            const bool last = (t == nt - 2);
            const char* a1 = cA + (size_t)(t + 1) * kstep;
            const char* a2 = last ? nA : cA + (size_t)(t + 2) * kstep; const char* b2 = last ? nB : cB + (size_t)(t + 2) * kstep;
            const char* a3 = a2 + kstep; const char* b3 = b2 + kstep;
            if (last && has_next) S.a_ready(nxt);
            if constexpr (SP2) {
            PG8_LDB(B0, 0, 0); PG8_LDB(B1, 0, 1); PG8_SCHED; PG8_LDA(At, 0, 0); PG8_STAGE(PG8_SA(1, 1), a1 + hstep, voffA);
            PG8_WAIT_V(8); PG8_WAIT_L(0); PG8_BAR; PG8_MMA(0, 0, At, B0); PG8_MMA(0, 1, At, B1); PG8_BAR; PG8_SCHED;
            PG8_LDA(At, 0, 1); PG8_STAGE(PG8_SB(0, 0), b2, voffB); PG8_STAGE(PG8_SB(0, 1), b2 + hstep, voffB); PG8_STAGE(PG8_SA(0, 0), a2, voffA);
            PG8_WAIT_V(8); PG8_WAIT_L(0); PG8_BAR; PG8_MMA(1, 0, At, B0); PG8_MMA(1, 1, At, B1); PG8_BAR; PG8_SCHED;
            PG8_LDB(B0, 1, 0); PG8_LDB(B1, 1, 1); PG8_SCHED; PG8_LDA(At, 1, 0); PG8_STAGE(PG8_SA(0, 1), a2 + hstep, voffA);
            PG8_WAIT_V(8); PG8_WAIT_L(0); PG8_BAR; PG8_MMA(0, 0, At, B0); PG8_MMA(0, 1, At, B1); PG8_BAR; PG8_SCHED;
            PG8_LDA(At, 1, 1); PG8_STAGE(PG8_SB(1, 0), b3, voffB); PG8_STAGE(PG8_SB(1, 1), b3 + hstep, voffB); PG8_STAGE(PG8_SA(1, 0), a3, voffA);
            PG8_WAIT_V(8); PG8_WAIT_L(0); PG8_BAR; PG8_MMA(1, 0, At, B0); PG8_MMA(1, 1, At, B1); PG8_BAR; PG8_SCHED;
            } else {
            PG8_LDB(B0, 0, 0); PG8_SCHED; PG8_LDA(At, 0, 0); PG8_STAGE(PG8_SA(1, 1), a1 + hstep, voffA);
            PG8_WAIT_L(8); PG8_BAR; PG8_WAIT_L(0); PG8_MMA(0, 0, At, B0); PG8_BAR; PG8_SCHED;
            PG8_LDB(B1, 0, 1); PG8_STAGE(PG8_SB(0, 0), b2, voffB);
            PG8_BAR; PG8_WAIT_L(0); PG8_MMA(0, 1, At, B1); PG8_BAR;
            PG8_LDA(At, 0, 1); PG8_STAGE(PG8_SA(0, 0), a2, voffA);
            PG8_BAR; PG8_WAIT_L(0); PG8_MMA(1, 0, At, B0); PG8_BAR; PG8_SCHED;
            PG8_STAGE(PG8_SB(0, 1), b2 + hstep, voffB);
            PG8_WAIT_V(6); PG8_BAR; PG8_MMA(1, 1, At, B1); PG8_BAR;
            PG8_LDB(B0, 1, 0); PG8_SCHED; PG8_LDA(At, 1, 0); PG8_STAGE(PG8_SA(0, 1), a2 + hstep, voffA);
            PG8_WAIT_L(8); PG8_BAR; PG8_WAIT_L(0); PG8_MMA(0, 0, At, B0); PG8_BAR; PG8_SCHED;
            PG8_LDB(B1, 1, 1); PG8_STAGE(PG8_SB(1, 0), b3, voffB);
            PG8_BAR; PG8_WAIT_L(0); PG8_MMA(0, 1, At, B1); PG8_BAR;
            PG8_LDA(At, 1, 1); PG8_STAGE(PG8_SA(1, 0), a3, voffA);
            PG8_BAR; PG8_WAIT_L(0); PG8_MMA(1, 0, At, B0); PG8_BAR; PG8_SCHED;
            PG8_STAGE(PG8_SB(1, 1), b3 + hstep, voffB);
            PG8_WAIT_V(6); PG8_BAR; PG8_MMA(1, 1, At, B1); PG8_BAR;
            }
        }
        if constexpr (ALIGN_EPI) { if (wr == 0) PG8_BAR; }
        if constexpr (!Epi::AFTER_DRAIN) { E(acc, cur, wr, wc, fr, fq); S.done(cur); }
        if (!has_next) break;
#pragma unroll
        for (int a = 0; a < 2; ++a)
#pragma unroll
            for (int b = 0; b < 2; ++b)
#pragma unroll
                for (int m = 0; m < 4; ++m)
#pragma unroll
                    for (int n = 0; n < 2; ++n) acc[a][b][m][n] = (f32x4){0.f, 0.f, 0.f, 0.f};
        cur = nxt; cA = nA; cB = nB; ++ui;
        if constexpr (ALIGN_EPI) { if (wr == 1) PG8_BAR; }
    }
    PG8_WAIT_V(0);
    if constexpr (!ALIGN_EPI) { if (wr == 0) PG8_BAR; }
    PG8_BAR;
    if constexpr (Epi::AFTER_DRAIN) { E.fused(acc, cur, wr, wc, fr, fq, lds, wid, lane); S.done(cur); }
#undef PG8_SA
#undef PG8_SB
#undef PG8_STAGE
#undef PG8_LDA
#undef PG8_LDB
#undef PG8_MMA
#undef PG8_WAIT_V
#undef PG8_WAIT_L
#undef PG8_BAR
#undef PG8_SCHED
}
}
namespace pg8 {
typedef unsigned u32x2 __attribute__((ext_vector_type(2)));
__device__ __forceinline__ float gelu_tanh(float x) {
    const float e = __builtin_amdgcn_exp2f(x * (-2.302208198f - 0.1029432397f * x * x));
    return x * __builtin_amdgcn_rcpf(1.0f + e);
}
__device__ __forceinline__ float silu_f(float x) { return x * __builtin_amdgcn_rcpf(1.0f + __builtin_amdgcn_exp2f(-1.4426950409f * x)); }

struct EpiRetProj {
    static constexpr bool PERM = false, AFTER_DRAIN = false;
    bf16_t *Q, *K, *V, *G; const float *cosT, *sinT;
    __device__ __forceinline__ void operator()(const f32x4 (&acc)[2][2][4][2], const Unit& u, int wr, int wc, int fr, int fq) const {
        const int pn = u.pn;
        if (pn < 8) {
            bf16_t* dst = pn < 4 ? Q : K; const int head = pn & 3; const float sc = pn < 4 ? 1.0f : 0.0625f;
#pragma unroll
            for (int ai = 0; ai < 2; ++ai)
#pragma unroll
                for (int m = 0; m < 4; ++m) {
                    const int row = u.pm * BM + ai * HALF + wr * 64 + m * 16 + fr;
#pragma unroll
                    for (int n = 0; n < 2; ++n) {
                        const int f0 = wc * 32 + n * 16 + fq * 4;
                        const f32x4 c4 = *(const f32x4*)(cosT + (size_t)row * 128 + f0), s4 = *(const f32x4*)(sinT + (size_t)row * 128 + f0);
                        const f32x4 x1 = acc[ai][0][m][n], x2 = acc[ai][1][m][n];
                        const f32x4 o1 = (x1 * c4 - x2 * s4) * sc, o2 = (x1 * s4 + x2 * c4) * sc;
                        u32x2 w1, w2; w1.x = cvt_pk_bf16(o1[0], o1[1]); w1.y = cvt_pk_bf16(o1[2], o1[3]); w2.x = cvt_pk_bf16(o2[0], o2[1]); w2.y = cvt_pk_bf16(o2[2], o2[3]);
                        bf16_t* p = dst + (size_t)row * 1024 + head * 256 + f0;
                        *(u32x2*)p = w1; *(u32x2*)(p + 128) = w2;
                    }
                }
        } else {
            const bool isg = pn >= 16; bf16_t* dst = isg ? G : V; const int colbase = ((pn - 8) & 7) * 256;
#pragma unroll
            for (int ai = 0; ai < 2; ++ai)
#pragma unroll
                for (int m = 0; m < 4; ++m) {
                    const int row = u.pm * BM + ai * HALF + wr * 64 + m * 16 + fr;
#pragma unroll
                    for (int bj = 0; bj < 2; ++bj)
#pragma unroll
                        for (int n = 0; n < 2; ++n) {
                            f32x4 v = acc[ai][bj][m][n];
                            if (isg) { v[0] = silu_f(v[0]); v[1] = silu_f(v[1]); v[2] = silu_f(v[2]); v[3] = silu_f(v[3]); }
                            u32x2 w; w.x = cvt_pk_bf16(v[0], v[1]); w.y = cvt_pk_bf16(v[2], v[3]);
                            *(u32x2*)(dst + (size_t)row * 2048 + colbase + bj * HALF + wc * 32 + n * 16 + fq * 4) = w;
                        }
                }
        }
    }
};
struct EpiResGate {
    static constexpr bool PERM = false, AFTER_DRAIN = false;
    const float* base; float* out; const float* gate; int gstride;
    __device__ __forceinline__ void operator()(const f32x4 (&acc)[2][2][4][2], const Unit& u, int wr, int wc, int fr, int fq) const {
        const int b = (u.pm * BM) >> 13; const float* gp = gate + (size_t)b * gstride;
        const int col0 = u.pn * BM + wc * 32 + 4 * fq;
        f32x4 gv[2][2];
#pragma unroll
        for (int bj = 0; bj < 2; ++bj)
#pragma unroll
            for (int n = 0; n < 2; ++n) gv[bj][n] = *(const f32x4*)(gp + col0 + bj * HALF + n * 16);
#pragma unroll
        for (int ai = 0; ai < 2; ++ai)
#pragma unroll
            for (int m = 0; m < 4; ++m) {
                const size_t off = (size_t)(u.pm * BM + ai * HALF + wr * 64 + m * 16 + fr) * 1024 + col0;
#pragma unroll
                for (int bj = 0; bj < 2; ++bj)
#pragma unroll
                    for (int n = 0; n < 2; ++n) { const f32x4 bs = *(const f32x4*)(base + off + bj * HALF + n * 16); *(f32x4*)(out + off + bj * HALF + n * 16) = bs + gv[bj][n] * acc[ai][bj][m][n]; }
            }
    }
};
struct EpiSguIn {
    static constexpr bool PERM = true, AFTER_DRAIN = false;
    bf16_t* U; bf16_t* Vb; const float* bias; float* stats;
    __device__ __forceinline__ void operator()(const f32x4 (&acc)[2][2][4][2], const Unit& u, int wr, int wc, int fr, int fq) const {
        const bool isv = u.pn >= 12; bf16_t* base = isv ? Vb : U; const int colt = (isv ? u.pn - 12 : u.pn) * BM;
        const int col0 = colt + wc * 32 + 8 * fq, bcol0 = u.pn * BM + wc * 32 + 8 * fq;
        f32x4 bv[2][2];
#pragma unroll
        for (int bj = 0; bj < 2; ++bj)
#pragma unroll
            for (int n = 0; n < 2; ++n) bv[bj][n] = *(const f32x4*)(bias + bcol0 + bj * HALF + 4 * n);
#pragma unroll
        for (int ai = 0; ai < 2; ++ai)
#pragma unroll
            for (int m = 0; m < 4; ++m) {
                const int row = u.pm * BM + ai * HALF + wr * 64 + m * 16 + fr;
                bf16_t* rowp = base + (size_t)row * 3072 + col0;
                float s1 = 0.f, s2 = 0.f;
#pragma unroll
                for (int bj = 0; bj < 2; ++bj) {
                    f32x4 v0 = acc[ai][bj][m][0] + bv[bj][0], v1 = acc[ai][bj][m][1] + bv[bj][1];
#pragma unroll
                    for (int j = 0; j < 4; ++j) { v0[j] = gelu_tanh(v0[j]); v1[j] = gelu_tanh(v1[j]); }
                    u32x4 w; w.x = cvt_pk_bf16(v0[0], v0[1]); w.y = cvt_pk_bf16(v0[2], v0[3]); w.z = cvt_pk_bf16(v1[0], v1[1]); w.w = cvt_pk_bf16(v1[2], v1[3]);
                    *(u32x4*)(rowp + bj * HALF) = w;
                    if (isv) {
#pragma unroll
                        for (int j = 0; j < 4; ++j) { const unsigned ww = j == 0 ? w.x : j == 1 ? w.y : j == 2 ? w.z : w.w;
                            const float a = __uint_as_float(ww << 16), bq = __uint_as_float(ww & 0xffff0000u); s1 += a + bq; s2 += a * a + bq * bq; }
                    }
                }
                if (isv) {
                    s1 += __shfl_xor(s1, 16); s1 += __shfl_xor(s1, 32); s2 += __shfl_xor(s2, 16); s2 += __shfl_xor(s2, 32);
                    if (fq == 0) { float* sp = stats + ((size_t)row * 48 + (u.pn - 12) * 4 + wc) * 2; sp[0] = s1; sp[1] = s2; }
                }
            }
    }
};
}
typedef unsigned u32x4 __attribute__((ext_vector_type(4)));
#define GAS __attribute__((address_space(1)))
#define LAS __attribute__((address_space(3)))
typedef unsigned short bf16;
typedef unsigned v4u __attribute__((ext_vector_type(4)));
typedef float f32x4 __attribute__((ext_vector_type(4)));
typedef short bf16x8 __attribute__((ext_vector_type(8)));
typedef GAS unsigned gu32;
typedef GAS unsigned long long gu64;
#define RLX_AGENT __ATOMIC_RELAXED, __HIP_MEMORY_SCOPE_AGENT
#define LDS_WAIT() asm volatile("s_waitcnt lgkmcnt(0)" ::: "memory")
#define VM_WAIT() asm volatile("s_waitcnt vmcnt(0)" ::: "memory")
__device__ __forceinline__ unsigned long long rt() { return __builtin_amdgcn_s_memrealtime(); }
__device__ __forceinline__ unsigned f2bf(float f) { unsigned u = __builtin_bit_cast(unsigned, f); return (u + 0x7fffu + ((u >> 16) & 1u)) >> 16; }
__device__ __forceinline__ unsigned pk2(float lo, float hi) { return f2bf(lo) | (f2bf(hi) << 16); }

#define XB_TMO      128
#define XB_XCNT(j)  (256  + 64 * (j))
#define XB_XSUB(j)  (1280 + 64 * (j))
#define XB_XGEN(j)  (2304 + 64 * (j))
#define XB_TOP      3328
#define XB_TOPGEN   3392
#define XCD_BAR_WORDS 3456
#define XB_SPIN_CAP (1u << 18)

__device__ __forceinline__ unsigned xb_ld(unsigned* p)              { return __hip_atomic_load(p, __ATOMIC_RELAXED, __HIP_MEMORY_SCOPE_AGENT); }
__device__ __forceinline__ unsigned xb_add(unsigned* p, unsigned v) { return __hip_atomic_fetch_add(p, v, __ATOMIC_RELAXED, __HIP_MEMORY_SCOPE_AGENT); }
__device__ __forceinline__ unsigned xb_xcc_id() { return (unsigned)__builtin_amdgcn_s_getreg((3 << 11) | 20) & 0xFu; }
#define XB_SPIN(cond, bar) do { unsigned _sp = 0; while (cond) { __builtin_amdgcn_s_sleep(1); \
    if ((++_sp & 255u) == 0u) { if (xb_ld(&(bar)[XB_TMO])) break; if (_sp > XB_SPIN_CAP) { atomicAdd(&(bar)[XB_TMO], 1u); break; } } } } while (0)

struct XcdBarrier {
    unsigned* bar; unsigned x;
    volatile LAS unsigned* st;
};

__device__ __forceinline__ XcdBarrier xcd_barrier_post(unsigned* bar, volatile LAS unsigned* st) {
    XcdBarrier b; b.bar = bar; b.x = xb_xcc_id(); b.st = st;
    if (threadIdx.x == 0) (void)xb_add(&bar[XB_XCNT(b.x)], 1u);
    return b;
}
__device__ __forceinline__ void xcd_barrier_complete(unsigned* bar, unsigned x, unsigned& nloc, unsigned& nx) {
    const unsigned G = gridDim.x * gridDim.y * gridDim.z;
    unsigned sum, cnt, mine, sp = 0u;
    for (;;) {
        sum = 0u; cnt = 0u; mine = 0u;
#pragma unroll
        for (unsigned j = 0; j < 16; ++j) { const unsigned c = xb_ld(&bar[XB_XCNT(j)]); sum += c; cnt += (c > 0u) ? 1u : 0u; mine = (j == x) ? c : mine; }
        if (sum == G) break;
        __builtin_amdgcn_s_sleep(1);
        if ((++sp & 255u) == 0u) { if (xb_ld(&bar[XB_TMO])) break; if (sp > XB_SPIN_CAP) { atomicAdd(&bar[XB_TMO], 1u); break; } }
    }
    nloc = mine > 0u ? mine : 1u; nx = cnt > 0u ? cnt : 1u;
}

__device__ __forceinline__ void xcd_barrier(const XcdBarrier& b) {
    asm volatile("s_waitcnt vmcnt(0)" ::: "memory");
    __syncthreads();
    if (threadIdx.x == 0) {
        unsigned* bar = b.bar;
        __builtin_amdgcn_s_waitcnt(0);
        unsigned nloc = b.st[0], nx = b.st[1];
        if (nloc == 0u) { xcd_barrier_complete(bar, b.x, nloc, nx); b.st[0] = nloc; b.st[1] = nx; }
        const unsigned old = xb_add(&bar[XB_XSUB(b.x)], 1u);
        const unsigned gen = old / nloc;
        if (old + 1u == (gen + 1u) * nloc) {
            __builtin_amdgcn_fence(__ATOMIC_RELEASE, "agent");
            asm volatile("s_waitcnt vmcnt(0)" ::: "memory");
            const unsigned og = xb_add(&bar[XB_TOP], 1u);
            const unsigned tg = og / nx;
            if (og + 1u == (tg + 1u) * nx) xb_add(&bar[XB_TOPGEN], 1u);
            else XB_SPIN(xb_ld(&bar[XB_TOPGEN]) == tg, bar);
            __builtin_amdgcn_fence(__ATOMIC_ACQUIRE, "agent");
            xb_add(&bar[XB_XGEN(b.x)], 1u);
            asm volatile("s_waitcnt vmcnt(0)" ::: "memory");
        } else {
            XB_SPIN(xb_ld(&bar[XB_XGEN(b.x)]) == gen, bar);
            __builtin_amdgcn_fence(__ATOMIC_ACQUIRE, "agent");
            asm volatile("s_waitcnt vmcnt(0)" ::: "memory");
        }
    }
    __syncthreads();
}
__device__ __forceinline__ float wave_sum(float v) {
#pragma unroll
    for (int o = 1; o < 64; o <<= 1) v += __shfl_xor(v, o);
    return v;
}
__device__ __forceinline__ void p0_transpose_item(const float* W, int K, int N, bf16* WT, int row_off, LAS float* scr, int item, int lane) {
    const int nblk = N / 32, kb = item / nblk, nb = item % nblk, k0 = 64 * kb, n0 = 32 * nb;
#pragma unroll 8
    for (int i = 0; i < 32; ++i) { const int kk = 2 * i + (lane >> 5); scr[kk * 33 + (lane & 31)] = W[(size_t)(k0 + kk) * N + n0 + (lane & 31)]; }
    LDS_WAIT(); asm volatile("" ::: "memory");
    const int c = lane & 7;
#pragma unroll
    for (int j = 0; j < 4; ++j) { const int n = (lane >> 3) + 8 * j; const LAS float* s = scr + (8 * c) * 33 + n;
        v4u o; o.x = pk2(s[0 * 33], s[1 * 33]); o.y = pk2(s[2 * 33], s[3 * 33]); o.z = pk2(s[4 * 33], s[5 * 33]); o.w = pk2(s[6 * 33], s[7 * 33]);
        *(GAS v4u*)(WT + (size_t)(row_off + n0 + n) * K + k0 + 8 * c) = o; }
    LDS_WAIT(); asm volatile("" ::: "memory");
}
#define DI __device__ __forceinline__
constexpr int NWAVES = 8;
constexpr int TT = 16384, DM = 1024, SEQ = 8192;
constexpr size_t MiB = 1u << 20;
constexpr size_t WS_CTL = 0, CTL_ZERO_BYTES = 32768, WS_MOD = 512 * 1024;
constexpr size_t WS_COS = 2 * MiB, WS_SIN = 10 * MiB;
constexpr size_t WS_WRI = 18 * MiB, WS_WRO = 30 * MiB, WS_WSI = 34 * MiB, WS_WSO = 46 * MiB, WS_WQ = 52 * MiB, WS_KEYS = 60 * MiB;
constexpr size_t WS_ISU = 61 * MiB, WS_ISV = 61 * MiB + 256 * 1024;
constexpr size_t WS_STATS = 62 * MiB, WS_IDX = 68 * MiB, WS_GATE = 76 * MiB, WS_H = 84 * MiB, WS_PU = 116 * MiB, WS_PV = 180 * MiB;
constexpr size_t WS_R = 244 * MiB;
constexpr size_t WS_Q = WS_R, WS_K = WS_R + 32 * MiB, WS_V = WS_R + 64 * MiB, WS_G = WS_R + 128 * MiB, WS_CROSS = WS_R + 192 * MiB;
constexpr size_t WS_QP = WS_R, WS_SC = WS_R + 64 * MiB;
constexpr size_t WS_U = WS_R, WS_VB = WS_R + 96 * MiB;
constexpr size_t WS_END = 500 * MiB;
constexpr int CW_TMO = 0, CW_BAR = 4096;
constexpr int RING_OFF = 0, RING_BYTES = 131072, LDS_BYTES = 163840, LDSCTL_OFF = LDS_BYTES - 1024, MISC_OFF = LDSCTL_OFF + 320;
constexpr int PTR_OFF = LDSCTL_OFF + 512;
constexpr float EPS = 1e-6f;
typedef float f32x2_t __attribute__((ext_vector_type(2)));

DI float bf2f(bf16 h) { return __uint_as_float((unsigned)h << 16); }
DI float bflo(unsigned w) { return __uint_as_float(w << 16); }
DI float bfhi(unsigned w) { return __uint_as_float(w & 0xffff0000u); }
DI float wave_max(float v) {
#pragma unroll
    for (int o = 1; o < 64; o <<= 1) v = fmaxf(v, __shfl_xor(v, o));
    return v;
}
DI float gelu_t(float x) { return pg8::gelu_tanh(x); }

struct Ctx {
    LAS unsigned char* lds; int tid, lane, wave, vcu, G;
    unsigned char* ws;
};

DI const void* ldp(const Ctx& C, int i) {
    const unsigned long long v = ((const LAS unsigned long long*)(C.lds + PTR_OFF))[i];
    const unsigned lo = __builtin_amdgcn_readfirstlane((unsigned)v), hi = __builtin_amdgcn_readfirstlane((unsigned)(v >> 32));
    return (const void*)(((unsigned long long)hi << 32) | lo);
}
DI void cvt_rows_fp8(const float* src, unsigned char* dst, float* inv_scale, int nrows, int gw, int NGW, int lane) {
    for (int r = gw; r < nrows; r += NGW) {
        const f32x4* s = (const f32x4*)(src + (size_t)r * 1024) + lane * 4;
        f32x4 v[4]; float am = 0.f;
#pragma unroll
        for (int q = 0; q < 4; ++q) { v[q] = s[q]; am = fmaxf(am, fmaxf(fmaxf(fabsf(v[q][0]), fabsf(v[q][1])), fmaxf(fabsf(v[q][2]), fabsf(v[q][3])))); }
        am = wave_max(am);
        const int e = (int)((__float_as_uint(am) >> 23) & 0xffu) - 127;
        const bool ok = am > 1e-30f;
        const float sc = ok ? __uint_as_float((unsigned)(127 + 7 - e) << 23) : 1.0f, isc = ok ? __uint_as_float((unsigned)(127 - 7 + e) << 23) : 1.0f;
        u32x4 o;
#pragma unroll
        for (int q = 0; q < 4; ++q) { int wd = __builtin_amdgcn_cvt_pk_fp8_f32(v[q][0] * sc, v[q][1] * sc, 0, false); wd = __builtin_amdgcn_cvt_pk_fp8_f32(v[q][2] * sc, v[q][3] * sc, wd, true); o[q] = (unsigned)wd; }
        *(u32x4*)(dst + (size_t)r * 1024 + lane * 16) = o;
        if (lane == 0) inv_scale[r] = isc;
    }
}
DI void cvt_rows_i8(const float* src, unsigned char* dst, float* inv_scale, int nrows, int gw, int NGW, int lane) {
    for (int r = gw; r < nrows; r += NGW) {
        const f32x4* s = (const f32x4*)(src + (size_t)r * 1024) + lane * 4;
        f32x4 v[4]; float am = 0.f;
#pragma unroll
        for (int q = 0; q < 4; ++q) { v[q] = s[q]; am = fmaxf(am, fmaxf(fmaxf(fabsf(v[q][0]), fabsf(v[q][1])), fmaxf(fabsf(v[q][2]), fabsf(v[q][3])))); }
        am = wave_max(am);
        const int e = (int)((__float_as_uint(am) >> 23) & 0xffu) - 127;
        const bool ok = am > 1e-30f;
        const float sc = ok ? __uint_as_float((unsigned)(127 + 6 - e) << 23) : 1.0f, isc = ok ? __uint_as_float((unsigned)(127 - 6 + e) << 23) : 1.0f;
        u32x4 o;
#pragma unroll
        for (int q = 0; q < 4; ++q) { unsigned wd = 0u;
#pragma unroll
            for (int j = 0; j < 4; ++j) { int qi = (int)rintf(v[q][j] * sc); qi = qi > 127 ? 127 : (qi < -127 ? -127 : qi); wd |= ((unsigned)qi & 0xffu) << (8 * j); }
            o[q] = wd; }
        *(u32x4*)(dst + (size_t)r * 1024 + lane * 16) = o;
        if (lane == 0) inv_scale[r] = isc;
    }
}
DI void cvt_stream(const float* src, bf16* dst, size_t n4, size_t gtid, size_t gthreads) {
    const f32x4* s = (const f32x4*)src; uint2* d = (uint2*)dst;
    for (size_t i = gtid; i < n4; i += gthreads) { const f32x4 v = s[i]; uint2 o; o.x = pk2(v.x, v.y); o.y = pk2(v.z, v.w); d[i] = o; }
}
struct P0In { const float *c, *ada_w, *ada_b, *ret_w_in, *ret_w_out, *sgu_w_in, *sgu_w_out, *wq, *keys, *pu, *pv; const int* pos; };
DI void p0_prologue(const Ctx& C, const P0In& I) {
    LAS float* scr = (LAS float*)(C.lds + RING_OFF + C.wave * 16384);
    const int gw = C.vcu * NWAVES + C.wave, NGW = C.G * NWAVES;
    bf16* wri = (bf16*)(C.ws + WS_WRI); bf16* wro = (bf16*)(C.ws + WS_WRO);
    constexpr int I_RI = 16 * 192, I_RO = 32 * 32;
    constexpr int NITEMS = I_RI + I_RO;
    for (int it = gw; it < NITEMS; it += NGW) {
        int r = it;
        if (r < I_RI) { p0_transpose_item(I.ret_w_in, 1024, 6144, wri, 0, scr, r, C.lane); continue; } r -= I_RI;
        p0_transpose_item(I.ret_w_out, 2048, 1024, wro, 0, scr, r, C.lane);
    }
    const size_t gtid = (size_t)C.vcu * 512 + C.tid, gth = (size_t)C.G * 512;
    cvt_stream(I.keys, (bf16*)(C.ws + WS_KEYS), (size_t)2 * 8 * 2 * 128 * 128 / 4, gtid, gth);
    float* mod = (float*)(C.ws + WS_MOD);
    __syncthreads();
    for (int it = C.vcu; it < 2 * 96; it += C.G) {
        const int l = it / 96, cb = it % 96, kp = C.wave, n = cb * 64 + C.lane;
        const float* W = I.ada_w + (size_t)l * 1024 * 6144 + n;
        float a0 = 0.f, a1 = 0.f;
#pragma unroll 8
        for (int k = kp * 128; k < kp * 128 + 128; ++k) {
            const float w = W[(size_t)k * 6144]; const float c0 = I.c[k], c1 = I.c[1024 + k];
            a0 += pg8::silu_f(c0) * w; a1 += pg8::silu_f(c1) * w;
        }
        LAS float* red = (LAS float*)(C.lds + RING_OFF);
        red[(kp * 2 + 0) * 64 + C.lane] = a0; red[(kp * 2 + 1) * 64 + C.lane] = a1;
        __syncthreads();
        if (C.wave < 2) { float s = I.ada_b[l * 6144 + n];
#pragma unroll
            for (int q = 0; q < 8; ++q) s += red[(q * 2 + C.wave) * 64 + C.lane];
            mod[(size_t)(l * 2 + C.wave) * 6144 + n] = s; }
        __syncthreads();
    }
    float* cosT = (float*)(C.ws + WS_COS); float* sinT = (float*)(C.ws + WS_SIN);
    for (int it = gw; it < TT / 2; it += NGW) {
        const int row = 2 * it + (C.lane >> 5), f0 = (C.lane & 31) * 4; const float p = (float)I.pos[row];
        f32x4 cv, sv;
#pragma unroll
        for (int j = 0; j < 4; ++j) { const int f = f0 + j; double w = 1.0, bs = 0.93057204092969898;
#pragma unroll
            for (int bit = 0; bit < 7; ++bit) { if ((f >> bit) & 1) w *= bs; bs *= bs; }
            const float ang = p * (float)w; const double r = (double)ang * 0.15915494309189535; const float fr = (float)(r - floor(r)); cv[j] = __builtin_amdgcn_cosf(fr); sv[j] = __builtin_amdgcn_sinf(fr); }
        *(f32x4*)(cosT + (size_t)row * 128 + f0) = cv; *(f32x4*)(sinT + (size_t)row * 128 + f0) = sv;
    }
}
DI void side_work(const Ctx& C, const P0In& I, int nskip) {
    LAS float* scr = (LAS float*)(C.lds + RING_OFF + C.wave * 16384);
    const int gw = (C.vcu - nskip) * NWAVES + C.wave, NGW = (C.G - nskip) * NWAVES;
    bf16* wsi = (bf16*)(C.ws + WS_WSI); bf16* wso = (bf16*)(C.ws + WS_WSO); bf16* wq = (bf16*)(C.ws + WS_WQ);
    constexpr int I_SI = 16 * 192, I_SO = 48 * 32, I_Q = 16 * 64;
    constexpr int NITEMS = I_SI + I_SO + 2 * I_Q;
    for (int it = gw; it < NITEMS; it += NGW) {
        int r = it;
        if (r < I_SI) { p0_transpose_item(I.sgu_w_in, 1024, 6144, wsi, 0, scr, r, C.lane); continue; } r -= I_SI;
        if (r < I_SO) { p0_transpose_item(I.sgu_w_out, 3072, 1024, wso, 0, scr, r, C.lane); continue; } r -= I_SO;
        if (r < I_Q) { p0_transpose_item(I.wq, 1024, 2048, wq, 0, scr, r, C.lane); continue; } r -= I_Q;
        p0_transpose_item(I.wq + (size_t)1024 * 2048, 1024, 2048, wq + (size_t)2048 * 1024, 0, scr, r, C.lane);
    }
    cvt_rows_i8(I.pu, (unsigned char*)(C.ws + WS_PU), (float*)(C.ws + WS_ISU), 2 * 16384, gw, NGW, C.lane);
    cvt_rows_fp8(I.pv, (unsigned char*)(C.ws + WS_PV), (float*)(C.ws + WS_ISV), 2 * 16384, gw, NGW, C.lane);
}
DI void rms_mod_row(const float* xrow, const float* gain, const float* shift, const float* scale, bf16* orow, int lane) {
    const f32x4* xr = (const f32x4*)xrow + lane; f32x4 v[4]; float s = 0.f;
#pragma unroll
    for (int j = 0; j < 4; ++j) { v[j] = xr[64 * j]; s += (v[j].x * v[j].x + v[j].y * v[j].y) + (v[j].z * v[j].z + v[j].w * v[j].w); }
    const float rstd = 1.0f / sqrtf(wave_sum(s) * (1.0f / 1024.0f) + EPS);
    uint2* o8 = (uint2*)orow + lane;
#pragma unroll
    for (int j = 0; j < 4; ++j) { const f32x4 g = ((const f32x4*)gain)[lane + 64 * j], sh = ((const f32x4*)shift)[lane + 64 * j], sc = ((const f32x4*)scale)[lane + 64 * j];
        const f32x4 y = v[j] * rstd * g * (sc + 1.0f) + sh; uint2 o; o.x = pk2(y.x, y.y); o.y = pk2(y.z, y.w); o8[64 * j] = o; }
}
DI void rms_mod_phase(const Ctx& C, const float* x, const float* gain, const float* mod_l, int sh_off, int sc_off, bf16* H) {
    const int gw = C.vcu * NWAVES + C.wave, NGW = C.G * NWAVES;
    for (int m = gw; m < TT; m += NGW) { const float* ml = mod_l + (size_t)(m >> 13) * 6144; rms_mod_row(x + (size_t)m * DM, gain, ml + sh_off, ml + sc_off, H + (size_t)m * DM, C.lane); }
}

DI void scan_naive(const Ctx& C, const bf16* Q, const bf16* K, const bf16* V, bf16* CROSS) {
    LAS float* Sst = (LAS float*)(C.lds);
    LAS unsigned* Qs = (LAS unsigned*)(C.lds + 16384);
    LAS bf16* Ks = (LAS bf16*)(C.lds + 16384 + 32768);
    LAS float* Vs = (LAS float*)(C.lds + 16384 + 65536);
    const int tid = C.tid;
    for (int item = C.vcu; item < 256; item += C.G) {
        const int b = item >> 7, h = (item >> 5) & 3, es = item & 31;
        const float lg2 = log2f(1.0f - exp2f(-5.0f - (float)h)); const float gc = exp2f(lg2 * 64.0f);
        for (int i = tid; i < 4096; i += 512) Sst[i] = 0.f;
        __syncthreads();
        for (int n = 0; n < 128; ++n) {
            const size_t tok0 = (size_t)b * SEQ + (size_t)n * 64;
            for (int ch = tid; ch < 2048; ch += 512) { const int r = ch >> 5, c = ch & 31;
                const u32x4 q = *(const u32x4*)(Q + (tok0 + r) * 1024 + h * 256 + c * 8); *(LAS u32x4*)(Qs + r * 128 + c * 4) = q;
                const u32x4 k = *(const u32x4*)(K + (tok0 + r) * 1024 + h * 256 + c * 8); *(LAS u32x4*)((LAS unsigned*)Ks + r * 128 + c * 4) = k; }
            for (int o = tid; o < 1024; o += 512) { const int j = o >> 4, e = o & 15; Vs[o] = bf2f(V[(tok0 + j) * 2048 + h * 512 + es * 16 + e]) * exp2f(lg2 * (float)(63 - j)); }
            __syncthreads();
#pragma unroll
            for (int oo = 0; oo < 2; ++oo) { const int o = tid + oo * 512, i = o >> 4, e = o & 15; float acc = 0.f;
#pragma unroll 8
                for (int d2 = 0; d2 < 128; ++d2) { const unsigned q2 = Qs[i * 128 + d2]; acc += bflo(q2) * Sst[(2 * d2) * 16 + e] + bfhi(q2) * Sst[(2 * d2 + 1) * 16 + e]; }
                CROSS[(tok0 + i) * 2048 + h * 512 + es * 16 + e] = (bf16)f2bf(acc * exp2f(lg2 * (float)(i + 1))); }
            __syncthreads();
            { const int e = tid & 15, dg = tid >> 4; float a[8];
#pragma unroll
              for (int r = 0; r < 8; ++r) a[r] = gc * Sst[(dg + 32 * r) * 16 + e];
#pragma unroll 4
              for (int j = 0; j < 64; ++j) { const float vz = Vs[j * 16 + e];
#pragma unroll
                  for (int r = 0; r < 8; ++r) a[r] += bf2f(Ks[j * 256 + dg + 32 * r]) * vz; }
#pragma unroll
              for (int r = 0; r < 8; ++r) Sst[(dg + 32 * r) * 16 + e] = a[r]; }
            __syncthreads();
        }
    }
}
DI void intra_naive(const Ctx& C, const bf16* Q, const bf16* K, const bf16* V, const bf16* CROSS, bf16* G) {
    LAS unsigned* Qs = (LAS unsigned*)(C.lds);
    LAS unsigned* Ks = (LAS unsigned*)(C.lds + 32768);
    LAS float* SC = (LAS float*)(C.lds + 65536);
    LAS float* red = (LAS float*)(C.lds + 65536 + 16384);
    LAS float* rs = red + 512;
    const int tid = C.tid;
    for (int item = C.vcu; item < 1024; item += C.G) {
        const int b = item >> 9, h = (item >> 7) & 3, n = item & 127;
        const float lg2 = log2f(1.0f - exp2f(-5.0f - (float)h));
        const size_t tok0 = (size_t)b * SEQ + (size_t)n * 64;
        for (int ch = tid; ch < 2048; ch += 512) { const int r = ch >> 5, c = ch & 31;
            *(LAS u32x4*)(Qs + r * 128 + c * 4) = *(const u32x4*)(Q + (tok0 + r) * 1024 + h * 256 + c * 8);
            *(LAS u32x4*)(Ks + r * 128 + c * 4) = *(const u32x4*)(K + (tok0 + r) * 1024 + h * 256 + c * 8); }
        __syncthreads();
        { const int i = tid >> 3, jb = (tid & 7) * 8;
#pragma unroll
          for (int jj = 0; jj < 8; ++jj) { const int j = jb + jj; float acc = 0.f;
#pragma unroll 8
              for (int d2 = 0; d2 < 128; ++d2) { const unsigned q2 = Qs[i * 128 + d2], k2 = Ks[j * 128 + d2]; acc += bflo(q2) * bflo(k2) + bfhi(q2) * bfhi(k2); }
              const int dd = i > j ? i - j : j - i; SC[i * 64 + j] = acc * exp2f(lg2 * (float)dd); } }
        __syncthreads();
#pragma unroll 1
        for (int pass = 0; pass < 2; ++pass) { const int e = tid, ib = pass * 32; float y[32];
#pragma unroll
          for (int i = 0; i < 32; ++i) y[i] = 0.f;
          const bf16* vp = V + tok0 * 2048 + h * 512 + e;
#pragma unroll 1
          for (int j4 = 0; j4 < 16; ++j4) {
              const float v0 = bf2f(vp[(size_t)(4 * j4 + 0) * 2048]), v1 = bf2f(vp[(size_t)(4 * j4 + 1) * 2048]), v2 = bf2f(vp[(size_t)(4 * j4 + 2) * 2048]), v3 = bf2f(vp[(size_t)(4 * j4 + 3) * 2048]);
#pragma unroll
              for (int i = 0; i < 32; ++i) { const f32x4 s4 = *(const LAS f32x4*)(SC + (ib + i) * 64 + 4 * j4); y[i] += (s4.x * v0 + s4.y * v1) + (s4.z * v2 + s4.w * v3); }
          }
          const bf16* cp = CROSS + (tok0 + ib) * 2048 + h * 512 + e;
#pragma unroll
          for (int i = 0; i < 32; ++i) { y[i] += bf2f(cp[(size_t)i * 2048]); const float ss = wave_sum(y[i] * y[i]); if (C.lane == 0) red[C.wave * 64 + i] = ss; }
          __syncthreads();
          if (tid < 32) { float s = 0.f;
#pragma unroll
              for (int w = 0; w < 8; ++w) s += red[w * 64 + tid];
              rs[tid] = 1.0f / sqrtf(s * (1.0f / 512.0f) + EPS); }
          __syncthreads();
          bf16* gp = G + (tok0 + ib) * 2048 + h * 512 + e;
#pragma unroll
          for (int i = 0; i < 32; ++i) { const float g = bf2f(gp[(size_t)i * 2048]); gp[(size_t)i * 2048] = (bf16)f2bf(y[i] * rs[i] * g); }
          __syncthreads();
        }
        __syncthreads();
    }
}
DI void peer_scores(const Ctx& C, const bf16* QP, const bf16* KEYS  , float* SCO) {
    const int gw = C.vcu * NWAVES + C.wave, NGW = C.G * NWAVES; const int fr = C.lane & 15, fq = C.lane >> 4;
    for (int it = gw; it < 1024 * 8; it += NGW) {
        const int tt = it >> 3, h = it & 7; const int tok = tt * 16 + fr;
#pragma unroll
        for (int p = 0; p < 2; ++p) {
            bf16x8 qf[4];
#pragma unroll
            for (int ks = 0; ks < 4; ++ks) qf[ks] = *(const bf16x8*)(QP + (size_t)tok * 2048 + h * 256 + p * 128 + ks * 32 + fq * 8);
            const bf16* kb = KEYS + (size_t)(h * 2 + p) * 128 * 128;
#pragma unroll
            for (int kt = 0; kt < 8; ++kt) {
                f32x4 acc = {0.f, 0.f, 0.f, 0.f};
#pragma unroll
                for (int ks = 0; ks < 4; ++ks) { const bf16x8 kf = *(const bf16x8*)(kb + (size_t)(kt * 16 + fr) * 128 + ks * 32 + fq * 8);
                    acc = __builtin_amdgcn_mfma_f32_16x16x32_bf16(kf, qf[ks], acc, 0, 0, 0); }
                *(f32x4*)(SCO + ((size_t)tok * 8 + h) * 256 + p * 128 + kt * 16 + fq * 4) = acc;
            }
        }
    }
}
template <bool HALVES> DI void select16(const float (&v)[4], int lane, bool (&sel)[4], int (&pos)[4]) {
    float mx = fmaxf(fmaxf(v[0], v[1]), fmaxf(v[2], v[3])), mn = fminf(fminf(v[0], v[1]), fminf(v[2], v[3]));
#pragma unroll
    for (int o = 1; o < (HALVES ? 32 : 64); o <<= 1) { mx = fmaxf(mx, __shfl_xor(mx, o)); mn = fminf(mn, __shfl_xor(mn, o)); }
    const bool up = HALVES && lane >= 32;
    float lo = mn, hi = mx, thr = mn; bool done = false;
    for (int iter = 0; iter < 48; ++iter) {
        const float mid = done ? thr : 0.5f * (lo + hi);
        int cnt = 0;
#pragma unroll
        for (int c = 0; c < 4; ++c) { const unsigned long long m = __ballot(v[c] >= mid);
            cnt += HALVES ? (up ? __popc((unsigned)(m >> 32)) : __popc((unsigned)m)) : __popcll(m); }
        if (!done) { if (cnt == 16) { thr = mid; done = true; } else if (cnt > 16) { lo = mid; thr = mid; } else hi = mid; }
        if (__all(done)) break;
    }
    int base = 0;
#pragma unroll
    for (int c = 0; c < 4; ++c) { sel[c] = v[c] >= thr; const unsigned long long m = __ballot(sel[c]);
        const unsigned long long gm = HALVES ? (up ? (m >> 32) : (m & 0xffffffffull)) : m; const int ll = HALVES ? (lane & 31) : lane;
        pos[c] = base + __popcll(gm & ((1ull << ll) - 1ull)); base += __popcll(gm); sel[c] = sel[c] && pos[c] < 16; }
}
DI void peer_topk(const Ctx& C, const float* SCO, int* IDX, float* GATE) {
    LAS float* sv = (LAS float*)(C.lds + C.wave * 512);
    LAS int* si = (LAS int*)(C.lds + C.wave * 512 + 128);
    LAS float* fv = (LAS float*)(C.lds + C.wave * 512 + 256);
    LAS int* fi = (LAS int*)(C.lds + C.wave * 512 + 320);
    const int gw = C.vcu * NWAVES + C.wave, NGW = C.G * NWAVES, lane = C.lane;
    for (int it = gw; it < TT * 8; it += NGW) {
        const f32x4 s4 = *(const f32x4*)(SCO + (size_t)it * 256 + lane * 4);
        float v[4] = {s4.x, s4.y, s4.z, s4.w}; bool sel[4]; int pos[4];
        select16<true>(v, lane, sel, pos);
        const int p = lane >> 5;
#pragma unroll
        for (int c = 0; c < 4; ++c) if (sel[c]) { sv[p * 16 + pos[c]] = v[c]; si[p * 16 + pos[c]] = (lane & 31) * 4 + c; }
        LDS_WAIT();
        const int a = lane >> 2, bq = (lane & 3) * 4; const float va = sv[a]; const int ia = si[a];
        float w[4]; int wi[4];
#pragma unroll
        for (int c = 0; c < 4; ++c) { w[c] = va + sv[16 + bq + c]; wi[c] = ia * 128 + si[16 + bq + c]; }
        select16<false>(w, lane, sel, pos);
#pragma unroll
        for (int c = 0; c < 4; ++c) if (sel[c]) { fv[pos[c]] = w[c]; fi[pos[c]] = wi[c]; }
        LDS_WAIT();
        const float x = fv[lane & 15]; const int xi = fi[lane & 15];
        float m = x;
#pragma unroll
        for (int o = 1; o < 16; o <<= 1) m = fmaxf(m, __shfl_xor(m, o));
        const float e = __expf(x - m); float s = e;
#pragma unroll
        for (int o = 1; o < 16; o <<= 1) s += __shfl_xor(s, o);
        if (lane < 16) { IDX[(size_t)it * 16 + lane] = xi; GATE[(size_t)it * 16 + lane] = e / s; }
        LDS_WAIT();
    }
}
template <bool FINAL> DI void peer_gather(const Ctx& C, const bf16* H, const int* IDX, const float* GATE, const bf16* PU, const bf16* PV, float* X, const float* g2  ,
                                          const float* ngain, const float* nmod  , bf16* Hn) {
    const int gw = C.vcu * NWAVES + C.wave, NGW = C.G * NWAVES, lane = C.lane;
    for (int t = gw; t < TT; t += NGW) {
        float hv[16];
        { const u32x4 a = *(const u32x4*)(H + (size_t)t * 1024 + lane * 8), bq = *(const u32x4*)(H + (size_t)t * 1024 + 512 + lane * 8);
          hv[0] = bflo(a.x); hv[1] = bfhi(a.x); hv[2] = bflo(a.y); hv[3] = bfhi(a.y); hv[4] = bflo(a.z); hv[5] = bfhi(a.z); hv[6] = bflo(a.w); hv[7] = bfhi(a.w);
          hv[8] = bflo(bq.x); hv[9] = bfhi(bq.x); hv[10] = bflo(bq.y); hv[11] = bfhi(bq.y); hv[12] = bflo(bq.z); hv[13] = bfhi(bq.z); hv[14] = bflo(bq.w); hv[15] = bfhi(bq.w); }
        const int i0 = IDX[(size_t)t * 128 + lane], i1 = IDX[(size_t)t * 128 + 64 + lane];
        const float g0 = GATE[(size_t)t * 128 + lane], g1 = GATE[(size_t)t * 128 + 64 + lane];
        float a0 = 0.f, a1 = 0.f;
        for (int k = 0; k < 128; k += 4) {
            float dsum[4];
#pragma unroll
            for (int kk = 0; kk < 4; ++kk) { const int kq = k + kk; const int e = kq < 64 ? __builtin_amdgcn_readlane(i0, kq) : __builtin_amdgcn_readlane(i1, kq - 64);
                const bf16* ur = PU + (size_t)e * 1024; const u32x4 a = *(const u32x4*)(ur + lane * 8), bq = *(const u32x4*)(ur + 512 + lane * 8);
                float d = bflo(a.x) * hv[0] + bfhi(a.x) * hv[1]; d += bflo(a.y) * hv[2] + bfhi(a.y) * hv[3]; d += bflo(a.z) * hv[4] + bfhi(a.z) * hv[5]; d += bflo(a.w) * hv[6] + bfhi(a.w) * hv[7];
                d += bflo(bq.x) * hv[8] + bfhi(bq.x) * hv[9]; d += bflo(bq.y) * hv[10] + bfhi(bq.y) * hv[11]; d += bflo(bq.z) * hv[12] + bfhi(bq.z) * hv[13]; d += bflo(bq.w) * hv[14] + bfhi(bq.w) * hv[15];
                dsum[kk] = d; }
#pragma unroll
            for (int kk = 0; kk < 4; ++kk) { const int kq = k + kk; const float d = gelu_t(wave_sum(dsum[kk]));
                if (kq < 64) { if (lane == kq) a0 = d * g0; } else { if (lane == kq - 64) a1 = d * g1; } }
        }
        float o[16];
#pragma unroll
        for (int j = 0; j < 16; ++j) o[j] = 0.f;
        for (int k = 0; k < 128; k += 4) {
#pragma unroll
            for (int kk = 0; kk < 4; ++kk) { const int kq = k + kk; const int e = kq < 64 ? __builtin_amdgcn_readlane(i0, kq) : __builtin_amdgcn_readlane(i1, kq - 64);
                const float ak = __int_as_float(kq < 64 ? __builtin_amdgcn_readlane(__float_as_int(a0), kq) : __builtin_amdgcn_readlane(__float_as_int(a1), kq - 64));
                const bf16* vr = PV + (size_t)e * 1024; const u32x4 a = *(const u32x4*)(vr + lane * 8), bq = *(const u32x4*)(vr + 512 + lane * 8);
                o[0] += ak * bflo(a.x); o[1] += ak * bfhi(a.x); o[2] += ak * bflo(a.y); o[3] += ak * bfhi(a.y); o[4] += ak * bflo(a.z); o[5] += ak * bfhi(a.z); o[6] += ak * bflo(a.w); o[7] += ak * bfhi(a.w);
                o[8] += ak * bflo(bq.x); o[9] += ak * bfhi(bq.x); o[10] += ak * bflo(bq.y); o[11] += ak * bfhi(bq.y); o[12] += ak * bflo(bq.z); o[13] += ak * bfhi(bq.z); o[14] += ak * bflo(bq.w); o[15] += ak * bfhi(bq.w); }
        }
#ifdef DBG_ZERO_PEER
#pragma unroll
        for (int j = 0; j < 16; ++j) o[j] = 0.f;
#endif
        const int b = t >> 13; const float* gp = g2 + (size_t)b * 6144; float* xr = X + (size_t)t * 1024;
        float xn[16]; float ss = 0.f;
#pragma unroll
        for (int q = 0; q < 4; ++q) { const int col = (q >> 1) * 512 + lane * 8 + (q & 1) * 4; const f32x4 xv = *(const f32x4*)(xr + col), gv = *(const f32x4*)(gp + col);
#pragma unroll
            for (int j = 0; j < 4; ++j) { const float y = xv[j] + gv[j] * o[q * 4 + j]; xn[q * 4 + j] = y; ss += y * y; } }
        const float rstd = 1.0f / sqrtf(wave_sum(ss) * (1.0f / 1024.0f) + EPS);
        if (FINAL) {
#pragma unroll
            for (int q = 0; q < 4; ++q) { const int col = (q >> 1) * 512 + lane * 8 + (q & 1) * 4; const f32x4 gn = *(const f32x4*)(ngain + col); f32x4 y;
#pragma unroll
                for (int j = 0; j < 4; ++j) y[j] = xn[q * 4 + j] * rstd * gn[j];
                *(f32x4*)(xr + col) = y; }
        } else {
            const float* nm = nmod + (size_t)b * 6144;
#pragma unroll
            for (int q = 0; q < 4; ++q) { const int col = (q >> 1) * 512 + lane * 8 + (q & 1) * 4; const f32x4 gn = *(const f32x4*)(ngain + col), sh = *(const f32x4*)(nm + col), sc = *(const f32x4*)(nm + 1024 + col); f32x4 xo; float y[4];
#pragma unroll
                for (int j = 0; j < 4; ++j) { xo[j] = xn[q * 4 + j]; y[j] = xn[q * 4 + j] * rstd * gn[j] * (1.0f + sc[j]) + sh[j]; }
                *(f32x4*)(xr + col) = xo; uint2 w; w.x = pk2(y[0], y[1]); w.y = pk2(y[2], y[3]); *(uint2*)(Hn + (size_t)t * 1024 + col) = w; }
        }
    }
}
DI void sgu_gate_naive(const Ctx& C, bf16* U, const bf16* VB, const float* stats, const float* w_s, const float* b_s, const float* ln_g, const float* ln_b) {
    LAS float* Wm = (LAS float*)(C.lds);
    LAS float* mu = (LAS float*)(C.lds + 65536);
    LAS float* rsd = mu + 128;
    const int tid = C.tid;
    for (int item = C.vcu; item < 1024; item += C.G) {
        const int n = item >> 3, g = item & 7; const size_t row0 = (size_t)n * 128;
        for (int i = tid; i < 16384; i += 512) { const int r = i >> 7, c = i & 127; const float w = w_s[(size_t)g * 16384 + i]; Wm[i] = (r < 64 && c >= 64) ? 0.f : w; }
        if (tid < 128) { const float* sp = stats + (row0 + tid) * 96; float s1 = 0.f, s2 = 0.f;
            for (int q = 0; q < 48; ++q) { s1 += sp[2 * q]; s2 += sp[2 * q + 1]; }
            const float m = s1 * (1.0f / 3072.0f); const float var = s2 * (1.0f / 3072.0f) - m * m; mu[tid] = m; rsd[tid] = 1.0f / sqrtf(fmaxf(var, 0.f) + EPS); }
        __syncthreads();
        if (tid < 384) {
            const int col = g * 384 + tid; const float lg = ln_g[col], lb = ln_b[col];
#pragma unroll
            for (int pass = 0; pass < 2; ++pass) {
                float acc[64];
#pragma unroll
                for (int i = 0; i < 64; ++i) acc[i] = 0.f;
                const int jmax = pass == 0 ? 64 : 128;
                for (int j = 0; j < jmax; ++j) { const float v = bf2f(VB[(row0 + j) * 3072 + col]); const float vl = (v - mu[j]) * rsd[j] * lg + lb;
#pragma unroll
                    for (int i = 0; i < 64; ++i) acc[i] += Wm[(pass * 64 + i) * 128 + j] * vl; }
#pragma unroll
                for (int i = 0; i < 64; ++i) { const int r = pass * 64 + i; const float s = acc[i] + b_s[g * 128 + r]; bf16* up = U + (row0 + r) * 3072 + col; *up = (bf16)f2bf(bf2f(*up) * s); }
            }
        }
        __syncthreads();
    }
}
typedef short v4i16_t __attribute__((ext_vector_type(4)));
typedef unsigned u32x2_t __attribute__((ext_vector_type(2)));
typedef __bf16 bf16x2_t __attribute__((ext_vector_type(2)));
DI unsigned cvtpk(float lo, float hi) { f32x2_t v = {lo, hi}; bf16x2_t b = __builtin_convertvector(v, bf16x2_t); return __builtin_bit_cast(unsigned, b); }
DI v4i16_t trr(const LAS unsigned char* p) { return __builtin_amdgcn_ds_read_tr16_b64_v4i16((LAS v4i16_t*)p); }
DI bf16x8 cat8(v4i16_t a, v4i16_t b) { return __builtin_shufflevector(a, b, 0, 1, 2, 3, 4, 5, 6, 7); }
DI bf16x8 pack2(const f32x4& a, const f32x4& b) { u32x4 p; p.x = cvtpk(a[0], a[1]); p.y = cvtpk(a[2], a[3]); p.z = cvtpk(b[0], b[1]); p.w = cvtpk(b[2], b[3]); return __builtin_bit_cast(bf16x8, p); }
DI u32x4 scale8(u32x4 v, float s) { u32x4 o; o.x = cvtpk(bflo(v.x) * s, bfhi(v.x) * s); o.y = cvtpk(bflo(v.y) * s, bfhi(v.y) * s); o.z = cvtpk(bflo(v.z) * s, bfhi(v.z) * s); o.w = cvtpk(bflo(v.w) * s, bfhi(v.w) * s); return o; }
#ifndef SCAN_QPI
#define SCAN_QPI 544
#endif
#ifndef SCAN_KPI
#define SCAN_KPI 544
#endif
#ifndef SCAN_PFD
#define SCAN_PFD 5
#endif
constexpr int SCAN_ESL = 32, SCAN_NCW = SCAN_ESL / 16, SCAN_NSL = 512 / SCAN_ESL, SCAN_NIT = 8 * SCAN_NSL;
#define SCAN_BAR() do { asm volatile("s_waitcnt lgkmcnt(0)" ::: "memory"); __builtin_amdgcn_s_barrier(); asm volatile("" ::: "memory"); } while (0)
template <int MODE = 0> DI void scan_mfma(const Ctx& C, const bf16* Q, const bf16* K, const bf16* V, bf16* CROSS) {
    constexpr int QPI = SCAN_QPI, KPI = SCAN_KPI, VPI = SCAN_ESL * 2 + 32, VCH = SCAN_ESL / 8  , NVC = 64 * VCH;
    constexpr int OQ = 0, OK_ = 64 * QPI, OV = OK_ + 64 * KPI, BUFB = OV + 64 * VPI;
    constexpr int NST = (NWAVES - 1 - SCAN_NCW) * 64;
    const int w = C.wave;
    for (int item = C.vcu; item < SCAN_NIT; item += C.G) {
        const int b = item / (4 * SCAN_NSL), h = (item / SCAN_NSL) & 3, es = item % SCAN_NSL;
        const float lg2 = log2f(1.0f - exp2f(-5.0f - (float)h)); const float gc = exp2f(lg2 * 64.0f);
        const size_t tokb = (size_t)b * SEQ;
        if (w >= SCAN_NCW) {
            int tl_ = C.tid; asm volatile("" : "+v"(tl_));
            const int st = (w == NWAVES - 1) ? (tl_ & 63) : tl_ - SCAN_NCW * 64;
            if (w == NWAVES - 1) {
                unsigned dmy = 0u;
#define SCAN_PF1(ptr) asm volatile("global_load_dword %0, %1, off" : "+v"(dmy) : "v"(ptr) : "memory")
#define SCAN_PF(n) do { const size_t t0_ = tokb + (size_t)(n) * 64; \
                if ((es & 3) == 0) { _Pragma("unroll") for (int u = 0; u < 4; ++u) { const int ln = st + 64 * u, r = ln >> 2, q = ln & 3; SCAN_PF1(Q + (t0_ + r) * 1024 + h * 256 + q * 64); SCAN_PF1(K + (t0_ + r) * 1024 + h * 256 + q * 64); } } \
                SCAN_PF1(V + (t0_ + st) * 2048 + h * 512 + es * SCAN_ESL); } while (0)
#ifndef SCAN_NOPF
                SCAN_PF(3); SCAN_PF(4);
#endif
                SCAN_BAR();
#pragma unroll 1
                for (int n = 0; n < 128; ++n) {
#ifndef SCAN_NOPF
                    if (n + SCAN_PFD < 128) SCAN_PF(n + SCAN_PFD);
#endif
                    SCAN_BAR(); }
                asm volatile("s_waitcnt vmcnt(0)" : "+v"(dmy) :: "memory");
#undef SCAN_PF
#undef SCAN_PF1
            } else {
            u32x4 rqA[7], rkA[7], rvA, rqB[7], rkB[7], rvB;
            const unsigned qo_ = (unsigned)((st >> 5) * 2048 + (st & 31) * 16), qo6_ = (st + NST * 6 < 2048) ? qo_ + (unsigned)(6 * (NST / 32) * 2048) : qo_;
            const unsigned vo_ = (st < NVC) ? (unsigned)((st / VCH) * 4096 + (st % VCH) * 16) : 0u;
#define SCAN_LD(RQ, RK, RV, n) do { const size_t t0_ = tokb + (size_t)((n) < 127 ? (n) : 127) * 64; \
            const unsigned char* qb_ = (const unsigned char*)(Q + t0_ * 1024 + h * 256); const unsigned char* kb_ = (const unsigned char*)(K + t0_ * 1024 + h * 256); \
            const unsigned char* vb_ = (const unsigned char*)(V + t0_ * 2048 + h * 512 + es * SCAN_ESL); \
            _Pragma("unroll") for (int u = 0; u < 7; ++u) { const unsigned o_ = u == 6 ? qo6_ : qo_ + (unsigned)(u * (NST / 32) * 2048); \
                RQ[u] = *(const u32x4*)(qb_ + o_); RK[u] = *(const u32x4*)(kb_ + o_); } \
            RV = *(const u32x4*)(vb_ + vo_); } while (0)
#define SCAN_WR(RQ, RK, RV, bufo) do { LAS unsigned char* B_ = C.lds + (bufo); \
            _Pragma("unroll") for (int u = 0; u < 7; ++u) { const int c = st + NST * u; if (c < 2048) { const int r = c >> 5, cc = c & 31; \
                *(LAS u32x4*)(B_ + OQ + r * QPI + cc * 16) = RQ[u]; *(LAS u32x4*)(B_ + OK_ + r * KPI + cc * 16) = RK[u]; } } \
            if (st < NVC) { const int r = st / VCH, cc = st % VCH; *(LAS u32x4*)(B_ + OV + r * VPI + cc * 16) = scale8(RV, exp2f(lg2 * (float)(63 - r))); } } while (0)
            SCAN_LD(rqA, rkA, rvA, 0); SCAN_WR(rqA, rkA, rvA, 0); SCAN_LD(rqA, rkA, rvA, 1); SCAN_LD(rqB, rkB, rvB, 2);
            SCAN_BAR();
#pragma unroll 1
            for (int n = 0; n < 128; n += 2) {
                if (MODE != 2) { SCAN_WR(rqA, rkA, rvA, BUFB); SCAN_LD(rqA, rkA, rvA, n + 3); }
                SCAN_BAR();
                if (MODE != 2) { SCAN_WR(rqB, rkB, rvB, 0); SCAN_LD(rqB, rkB, rvB, n + 4); }
                SCAN_BAR();
            }
#undef SCAN_LD
#undef SCAN_WR
            }
        } else {
            int tl_ = C.tid; asm volatile("" : "+v"(tl_)); const int lane = tl_ & 63, fr = lane & 15, fq = lane >> 4;
            f32x4 S[16];
#pragma unroll
            for (int t = 0; t < 16; ++t) S[t] = (f32x4){0.f, 0.f, 0.f, 0.f};
            SCAN_BAR();
#define SC_LQ(QF, DB) do { _Pragma("unroll") for (int m = 0; m < 4; ++m) QF[m] = *(const LAS bf16x8*)(Qs + (16 * m + fr) * QPI + (32 * (DB) + 8 * fq) * 2); __builtin_amdgcn_sched_barrier(0); } while (0)
#define SC_MQ(QF, DB) do { const bf16x8 sa0 = pack2(S[2 * (DB)], S[2 * (DB) + 1]); \
            _Pragma("unroll") for (int m = 0; m < 4; ++m) acc[m] = __builtin_amdgcn_mfma_f32_16x16x32_bf16(sa0, QF[m], acc[m], 0, 0, 0); __builtin_amdgcn_sched_barrier(0); } while (0)
#define SC_LK(KF, KS, TQ) do { const LAS unsigned char* kp = Ks + (32 * (KS) + 4 * fq + (fr >> 2)) * KPI + (8 * (fr & 3)) * 2;     \
            _Pragma("unroll") for (int t4 = 0; t4 < 4; ++t4) { const int t = 4 * (TQ) + t4; KF[t4] = cat8(trr(kp + 64 * (t >> 1) + 8 * (t & 1)), trr(kp + 64 * (t >> 1) + 8 * (t & 1) + 16 * KPI)); } __builtin_amdgcn_sched_barrier(0); } while (0)
#define SC_LV(VF, KS) do { const LAS unsigned char* vp = Vs + (32 * (KS) + 4 * fq + (fr >> 2)) * VPI + (16 * w + 4 * (fr & 3)) * 2; VF = cat8(trr(vp), trr(vp + 16 * VPI)); } while (0)
#define SC_MK(KF, VF, TQ) do { _Pragma("unroll") for (int t4 = 0; t4 < 4; ++t4) S[4 * (TQ) + t4] = __builtin_amdgcn_mfma_f32_16x16x32_bf16(KF[t4], VF, S[4 * (TQ) + t4], 0, 0, 0); __builtin_amdgcn_sched_barrier(0); } while (0)
#define SCAN_CHUNK(n_, BO) do { const size_t tok0 = tokb + (size_t)(n_) * 64; LAS unsigned char* Qs = C.lds + (BO) + OQ; LAS unsigned char* Ks = C.lds + (BO) + OK_; LAS unsigned char* Vs = C.lds + (BO) + OV; \
                f32x4 acc[4]; bf16x8 fA[4], fB[4], kA[4], kB[4], vf0, vf1; \
                _Pragma("unroll") for (int m = 0; m < 4; ++m) acc[m] = (f32x4){0.f, 0.f, 0.f, 0.f}; \
                SC_LQ(fA, 0); SC_LQ(fB, 1); SC_MQ(fA, 0); SC_LQ(fA, 2); SC_MQ(fB, 1); SC_LQ(fB, 3); SC_MQ(fA, 2); SC_LQ(fA, 4); SC_MQ(fB, 3); SC_LQ(fB, 5); SC_MQ(fA, 4); SC_LQ(fA, 6); SC_MQ(fB, 5); SC_LQ(fB, 7); SC_MQ(fA, 6); SC_LV(vf0, 0); SC_LV(vf1, 1); SC_LK(kA, 0, 0); SC_MQ(fB, 7); \
                _Pragma("unroll") for (int m = 0; m < 4; ++m) { const f32x4 v = acc[m] * exp2f(lg2 * (float)(16 * m + fr + 1)); uint2 o; o.x = cvtpk(v[0], v[1]); o.y = cvtpk(v[2], v[3]); \
                    *(uint2*)(CROSS + (tok0 + 16 * m + fr) * 2048 + h * 512 + es * SCAN_ESL + 16 * w + 4 * fq) = o; } \
                _Pragma("unroll") for (int t = 0; t < 16; ++t) S[t] = S[t] * gc; \
                __builtin_amdgcn_sched_barrier(0); \
                SC_LK(kB, 0, 1); SC_MK(kA, vf0, 0); SC_LK(kA, 0, 2); SC_MK(kB, vf0, 1); SC_LK(kB, 0, 3); SC_MK(kA, vf0, 2); SC_LK(kA, 1, 0); SC_MK(kB, vf0, 3); SC_LK(kB, 1, 1); SC_MK(kA, vf1, 0); SC_LK(kA, 1, 2); SC_MK(kB, vf1, 1); SC_LK(kB, 1, 3); SC_MK(kA, vf1, 2); SC_MK(kB, vf1, 3); \
                SCAN_BAR(); } while (0)
#pragma unroll 1
            for (int n = 0; n < 128; n += 2) { if (MODE == 1) { SCAN_BAR(); SCAN_BAR(); } else { SCAN_CHUNK(n, 0); SCAN_CHUNK(n + 1, BUFB); } }
#undef SCAN_CHUNK
#undef SC_LQ
#undef SC_MQ
#undef SC_LK
#undef SC_LV
#undef SC_MK
        }
    }
}
#undef SCAN_BAR
DI void sgu_gate_mfma(const Ctx& C, bf16* U, const bf16* VB, const float* stats, const float* w_s, const float* b_s, const float* ln_g, const float* ln_b) {
    constexpr int WPI = 272, VPI = 288;
    LAS unsigned char* Ws = C.lds; LAS unsigned char* Vs = C.lds + 128 * WPI;
    LAS float* mu = (LAS float*)(C.lds + 128 * WPI + 128 * VPI); LAS float* rsd = mu + 128; LAS float* r1 = mu + 256; LAS float* r2 = mu + 384; LAS float* bsl = mu + 512;
    const int tid = C.tid, lane = C.lane, w = C.wave, fr = lane & 15, fq = lane >> 4;
    for (int item = C.vcu; item < 1024; item += C.G) {
        const int n = item >> 3, g = item & 7; const size_t row0 = (size_t)n * 128;
        if (tid < 128) { const float* sp = stats + (row0 + tid) * 96; float s1 = 0.f, s2 = 0.f;
#pragma unroll 8
            for (int q = 0; q < 48; ++q) { s1 += sp[2 * q]; s2 += sp[2 * q + 1]; }
            const float m = s1 * (1.0f / 3072.0f); const float var = s2 * (1.0f / 3072.0f) - m * m; mu[tid] = m; rsd[tid] = 1.0f / sqrtf(fmaxf(var, 0.f) + EPS); bsl[tid] = b_s[g * 128 + tid]; }
        __syncthreads();
        { const int i = tid >> 2, jq = tid & 3; const float* wp = w_s + (size_t)g * 16384 + i * 128 + jq * 32; float a1 = 0.f, a2 = 0.f;
#pragma unroll
          for (int c8 = 0; c8 < 4; ++c8) { const f32x4 wa = *(const f32x4*)(wp + c8 * 8), wb = *(const f32x4*)(wp + c8 * 8 + 4); float wv[8] = {wa[0], wa[1], wa[2], wa[3], wb[0], wb[1], wb[2], wb[3]}; float o[8];
#pragma unroll
              for (int q = 0; q < 8; ++q) { const int j = jq * 32 + c8 * 8 + q; const float wm = (i < 64 && j >= 64) ? 0.f : wv[q]; const float wr_ = wm * rsd[j]; o[q] = wr_; a1 += wr_ * mu[j]; a2 += wm; }
              u32x4 pk; pk.x = cvtpk(o[0], o[1]); pk.y = cvtpk(o[2], o[3]); pk.z = cvtpk(o[4], o[5]); pk.w = cvtpk(o[6], o[7]);
              *(LAS u32x4*)(Ws + i * WPI + (jq * 32 + c8 * 8) * 2) = pk; }
          a1 += __shfl_xor(a1, 1); a1 += __shfl_xor(a1, 2); a2 += __shfl_xor(a2, 1); a2 += __shfl_xor(a2, 2);
          if (jq == 0) { r1[i] = a1; r2[i] = a2; } }
#pragma unroll 1
        for (int cs = 0; cs < 3; ++cs) {
            const int colb = g * 384 + cs * 128;
#pragma unroll
            for (int u = 0; u < 4; ++u) { const int c = tid + 512 * u, r = c >> 4, cc = c & 15;
                *(LAS u32x4*)(Vs + r * VPI + cc * 16) = *(const u32x4*)(VB + (row0 + r) * 3072 + colb + cc * 8); }
            __syncthreads();
            f32x4 acc[8];
#pragma unroll
            for (int it = 0; it < 8; ++it) acc[it] = (f32x4){0.f, 0.f, 0.f, 0.f};
#pragma unroll
            for (int ks = 0; ks < 4; ++ks) {
                const LAS unsigned char* vp = Vs + (32 * ks + 4 * fq + (fr >> 2)) * VPI + (16 * w + 4 * (fr & 3)) * 2;
                const bf16x8 vf = cat8(trr(vp), trr(vp + 16 * VPI));
#pragma unroll
                for (int it = 0; it < 8; ++it) { if (it < 4 && ks >= 2) continue;
                    const LAS unsigned char* wp = Ws + (16 * it + fr) * WPI + (32 * ks + 4 * fq) * 2;
                    const u32x2_t lo = *(const LAS u32x2_t*)wp, hi = *(const LAS u32x2_t*)(wp + 32);
                    u32x4 ww; ww.x = lo.x; ww.y = lo.y; ww.z = hi.x; ww.w = hi.y;
                    acc[it] = __builtin_amdgcn_mfma_f32_16x16x32_bf16(vf, __builtin_bit_cast(bf16x8, ww), acc[it], 0, 0, 0); }
            }
            const int c0 = colb + 16 * w + 4 * fq;
            const f32x4 lg = *(const f32x4*)(ln_g + c0), lb = *(const f32x4*)(ln_b + c0);
#pragma unroll
            for (int it = 0; it < 8; ++it) { const int i = 16 * it + fr; const float q1 = r1[i], q2 = r2[i], bb = bsl[i];
                bf16* up = U + (row0 + i) * 3072 + c0; const u32x2_t uu = *(const u32x2_t*)up;
                const f32x4 s = lg * (acc[it] - q1) + lb * q2 + bb;
                u32x2_t o; o.x = cvtpk(bflo(uu.x) * s[0], bfhi(uu.x) * s[1]); o.y = cvtpk(bflo(uu.y) * s[2], bfhi(uu.y) * s[3]);
                *(u32x2_t*)up = o; }
            __syncthreads();
        }
    }
}
DI void up8(unsigned wd, float& a, float& b, float& c, float& d) { const f32x2_t lo = __builtin_amdgcn_cvt_pk_f32_fp8((int)wd, false), hi = __builtin_amdgcn_cvt_pk_f32_fp8((int)wd, true); a = lo.x; b = lo.y; c = hi.x; d = hi.y; }
DI float dot16(const u32x4 u, const float (&hv)[16]) {
    float f[16];
    up8(u.x, f[0], f[1], f[2], f[3]); up8(u.y, f[4], f[5], f[6], f[7]); up8(u.z, f[8], f[9], f[10], f[11]); up8(u.w, f[12], f[13], f[14], f[15]);
    float d0 = f[0] * hv[0], d1 = f[1] * hv[1];
#pragma unroll
    for (int j = 2; j < 16; j += 2) { d0 += f[j] * hv[j]; d1 += f[j + 1] * hv[j + 1]; }
    return d0 + d1;
}
template <bool FINAL> DI void peer_gather8(const Ctx& C, const bf16* Hin, const int* IDX, const float* GATE, const unsigned char* PU8, const unsigned char* PV8, const float* ISU, const float* ISV,
                                           float* X, const float* g2, const float* ngain, const float* nmod, bf16* Hn) {
    const int gw = C.vcu * NWAVES + C.wave, NGW = C.G * NWAVES, lane = C.lane;
    LAS float* DL = (LAS float*)(C.lds + C.wave * 1024);
    LAS float* AL = DL + 128;
    for (int t = gw; t < TT; t += NGW) {
        float hv[16];
        { const u32x4 a = *(const u32x4*)(Hin + (size_t)t * 1024 + lane * 16), bq = *(const u32x4*)(Hin + (size_t)t * 1024 + lane * 16 + 8);
          hv[0] = bflo(a.x); hv[1] = bfhi(a.x); hv[2] = bflo(a.y); hv[3] = bfhi(a.y); hv[4] = bflo(a.z); hv[5] = bfhi(a.z); hv[6] = bflo(a.w); hv[7] = bfhi(a.w);
          hv[8] = bflo(bq.x); hv[9] = bfhi(bq.x); hv[10] = bflo(bq.y); hv[11] = bfhi(bq.y); hv[12] = bflo(bq.z); hv[13] = bfhi(bq.z); hv[14] = bflo(bq.w); hv[15] = bfhi(bq.w); }
        const int i0 = IDX[(size_t)t * 128 + lane], i1 = IDX[(size_t)t * 128 + 64 + lane];
        const float g0 = GATE[(size_t)t * 128 + lane], g1 = GATE[(size_t)t * 128 + 64 + lane];
        const float su0 = ISU[i0], su1 = ISU[i1], sv0 = ISV[i0], sv1 = ISV[i1];
        u32x4 ub[8];
#define PG_LOADU(k0) do { _Pragma("unroll") for (int j = 0; j < 8; ++j) { const int kq = (k0) + j; const int e = kq < 64 ? __builtin_amdgcn_readlane(i0, kq) : __builtin_amdgcn_readlane(i1, kq - 64); \
            ub[j] = *(const u32x4*)(PU8 + (size_t)e * 1024 + lane * 16); } } while (0)
        PG_LOADU(0);
#pragma unroll 1
        for (int k0 = 0; k0 < 128; k0 += 8) {
            float p[8];
#pragma unroll
            for (int j = 0; j < 8; ++j) p[j] = dot16(ub[j], hv);
            if (k0 + 8 < 128) PG_LOADU(k0 + 8);
            const bool h32 = lane & 32, h16 = lane & 16, h8 = lane & 8;
            float q4[4];
#pragma unroll
            for (int j = 0; j < 4; ++j) { const float keep = h32 ? p[j + 4] : p[j], send = h32 ? p[j] : p[j + 4]; q4[j] = keep + __shfl_xor(send, 32); }
            float q2[2];
#pragma unroll
            for (int j = 0; j < 2; ++j) { const float keep = h16 ? q4[j + 2] : q4[j], send = h16 ? q4[j] : q4[j + 2]; q2[j] = keep + __shfl_xor(send, 16); }
            float q1; { const float keep = h8 ? q2[1] : q2[0], send = h8 ? q2[0] : q2[1]; q1 = keep + __shfl_xor(send, 8); }
            q1 += __shfl_xor(q1, 4); q1 += __shfl_xor(q1, 2); q1 += __shfl_xor(q1, 1);
            if ((lane & 7) == 0) DL[k0 + ((lane >> 5) & 1) * 4 + ((lane >> 4) & 1) * 2 + ((lane >> 3) & 1)] = q1;
        }
#undef PG_LOADU
        LDS_WAIT();
        { const float d0 = DL[lane], d1 = DL[64 + lane]; AL[lane] = gelu_t(d0 * su0) * g0 * sv0; AL[64 + lane] = gelu_t(d1 * su1) * g1 * sv1; }
        LDS_WAIT();
        float o[16];
#pragma unroll
        for (int j = 0; j < 16; ++j) o[j] = 0.f;
        u32x4 vb[8];
#define PG_LOADV(k0) do { _Pragma("unroll") for (int j = 0; j < 8; ++j) { const int kq = (k0) + j; const int e = kq < 64 ? __builtin_amdgcn_readlane(i0, kq) : __builtin_amdgcn_readlane(i1, kq - 64); \
            vb[j] = *(const u32x4*)(PV8 + (size_t)e * 1024 + lane * 16); } } while (0)
        PG_LOADV(0);
#pragma unroll 1
        for (int k0 = 0; k0 < 128; k0 += 8) {
            float f[8][16];
#pragma unroll
            for (int j = 0; j < 8; ++j) { up8(vb[j].x, f[j][0], f[j][1], f[j][2], f[j][3]); up8(vb[j].y, f[j][4], f[j][5], f[j][6], f[j][7]); up8(vb[j].z, f[j][8], f[j][9], f[j][10], f[j][11]); up8(vb[j].w, f[j][12], f[j][13], f[j][14], f[j][15]); }
            if (k0 + 8 < 128) PG_LOADV(k0 + 8);
#pragma unroll
            for (int j = 0; j < 8; ++j) { const float ak = AL[k0 + j];
#pragma unroll
                for (int q = 0; q < 16; ++q) o[q] += ak * f[j][q]; }
        }
#undef PG_LOADV
        const int b = t >> 13; const float* gp = g2 + (size_t)b * 6144; float* xr = X + (size_t)t * 1024;
        float xn[16]; float ss = 0.f;
#pragma unroll
        for (int q = 0; q < 4; ++q) { const int col = lane * 16 + q * 4; const f32x4 xv = *(const f32x4*)(xr + col), gv = *(const f32x4*)(gp + col);
#pragma unroll
            for (int j = 0; j < 4; ++j) { const float y = xv[j] + gv[j] * o[q * 4 + j]; xn[q * 4 + j] = y; ss += y * y; } }
        const float rstd = 1.0f / sqrtf(wave_sum(ss) * (1.0f / 1024.0f) + EPS);
        if (FINAL) {
#pragma unroll
            for (int q = 0; q < 4; ++q) { const int col = lane * 16 + q * 4; const f32x4 gn = *(const f32x4*)(ngain + col); f32x4 y;
#pragma unroll
                for (int j = 0; j < 4; ++j) y[j] = xn[q * 4 + j] * rstd * gn[j];
                *(f32x4*)(xr + col) = y; }
        } else {
            const float* nm = nmod + (size_t)b * 6144;
#pragma unroll
            for (int q = 0; q < 4; ++q) { const int col = lane * 16 + q * 4; const f32x4 gn = *(const f32x4*)(ngain + col), sh = *(const f32x4*)(nm + col), sc = *(const f32x4*)(nm + 1024 + col); f32x4 xo; float y[4];
#pragma unroll
                for (int j = 0; j < 4; ++j) { xo[j] = xn[q * 4 + j]; y[j] = xn[q * 4 + j] * rstd * gn[j] * (1.0f + sc[j]) + sh[j]; }
                *(f32x4*)(xr + col) = xo; u32x2_t wv; wv.x = cvtpk(y[0], y[1]); wv.y = cvtpk(y[2], y[3]); *(u32x2_t*)(Hn + (size_t)t * 1024 + col) = wv; }
        }
    }
}
template <int CTRL> DI float dpp_f(float x) { return __int_as_float(__builtin_amdgcn_update_dpp(0, __float_as_int(x), CTRL, 0xF, 0xF, false)); }
DI float x32(float x) { auto r = __builtin_amdgcn_permlane32_swap(__float_as_uint(x), __float_as_uint(x), false, false); return (threadIdx.x & 32) ? __uint_as_float(r[0]) : __uint_as_float(r[1]); }
DI float x16(float x) { auto r = __builtin_amdgcn_permlane16_swap(__float_as_uint(x), __float_as_uint(x), false, false); return (threadIdx.x & 16) ? __uint_as_float(r[0]) : __uint_as_float(r[1]); }
typedef _Float16 h2_t __attribute__((ext_vector_type(2)));
DI unsigned f2hu(float lo, float hi) { const f32x2_t v = {lo, hi}; const h2_t h = __builtin_convertvector(v, h2_t); return __builtin_bit_cast(unsigned, h); }
DI unsigned bf2hu(unsigned w) { const f32x2_t v = {bflo(w), bfhi(w)}; const h2_t h = __builtin_convertvector(v, h2_t); return __builtin_bit_cast(unsigned, h); }
DI h2_t bf2h(unsigned w) { return (h2_t){(_Float16)bflo(w), (_Float16)bfhi(w)}; }
template <bool FAKE> DI void up8h(const u32x4 u, h2_t (&f)[8]) {
    if (FAKE) { f[0] = __builtin_bit_cast(h2_t, u.x & 0x3bff3bffu); f[1] = __builtin_bit_cast(h2_t, u.y & 0x3bff3bffu); f[2] = __builtin_bit_cast(h2_t, u.z & 0x3bff3bffu); f[3] = __builtin_bit_cast(h2_t, u.w & 0x3bff3bffu);
        f[4] = __builtin_bit_cast(h2_t, (u.x >> 1) & 0x3bff3bffu); f[5] = __builtin_bit_cast(h2_t, (u.y >> 1) & 0x3bff3bffu); f[6] = __builtin_bit_cast(h2_t, (u.z >> 1) & 0x3bff3bffu); f[7] = __builtin_bit_cast(h2_t, (u.w >> 1) & 0x3bff3bffu); return; }
    f[0] = __builtin_amdgcn_cvt_scalef32_pk_f16_fp8((int)u.x, 1.0f, false); f[1] = __builtin_amdgcn_cvt_scalef32_pk_f16_fp8((int)u.x, 1.0f, true);
    f[2] = __builtin_amdgcn_cvt_scalef32_pk_f16_fp8((int)u.y, 1.0f, false); f[3] = __builtin_amdgcn_cvt_scalef32_pk_f16_fp8((int)u.y, 1.0f, true);
    f[4] = __builtin_amdgcn_cvt_scalef32_pk_f16_fp8((int)u.z, 1.0f, false); f[5] = __builtin_amdgcn_cvt_scalef32_pk_f16_fp8((int)u.z, 1.0f, true);
    f[6] = __builtin_amdgcn_cvt_scalef32_pk_f16_fp8((int)u.w, 1.0f, false); f[7] = __builtin_amdgcn_cvt_scalef32_pk_f16_fp8((int)u.w, 1.0f, true); }
template <bool FAKE> DI float dot16h(const u32x4 u, const h2_t (&hh)[8]) { h2_t f[8]; up8h<FAKE>(u, f); float d0 = 0.f, d1 = 0.f;
#pragma unroll
    for (int q = 0; q < 8; q += 2) { d0 = __builtin_amdgcn_fdot2(f[q], hh[q], d0, false); d1 = __builtin_amdgcn_fdot2(f[q + 1], hh[q + 1], d1, false); }
    return d0 + d1; }
template <bool FINAL, bool FAKE = false, int SKIP = 0> DI void peer_gather_rounds(const Ctx& C, const bf16* Hin, const int* IDX, const float* GATE, const unsigned char* PU8, const unsigned char* PV8, const float* ISU, const float* ISV,
                                                 float* X, const float* g2, const float* ngain, const float* nmod, bf16* Hn) {
    const int lane = C.lane, w = C.wave;
    LAS u32x2_t* LIST = (LAS u32x2_t*)(C.lds + w * 14592);
    LAS unsigned char* HL = C.lds + w * 14592 + 4096;
    LAS unsigned* ALU = (LAS unsigned*)(C.lds + w * 14592 + 12288);
    LAS int* OFFS = (LAS int*)(C.lds + w * 14592 + 14336);
    LAS float* IHS = (LAS float*)(C.lds + w * 14592 + 14336 + 160);
    const unsigned long long ltmask = (1ull << lane) - 1ull;
    for (int grp = C.vcu; grp < TT / 32; grp += C.G) {
        const int t0 = grp * 32 + w * 4;
        {
            int ee[8]; float gg[8]; unsigned su[8]; float sv[8];
#pragma unroll
            for (int r = 0; r < 8; ++r) { const size_t a = (size_t)(t0 + (r >> 1)) * 128 + 64 * (r & 1) + lane; ee[r] = IDX[a]; gg[r] = GATE[a]; }
#pragma unroll
            for (int r = 0; r < 8; ++r) { su[r] = __float_as_uint(ISU[ee[r]]) >> 23; sv[r] = ISV[ee[r]]; }
            int pos[8]; int base = 0;
#pragma unroll 1
            for (int b = 0; b < 8; ++b) {
#pragma unroll
                for (int r = 0; r < 8; ++r) { if ((r & 1) == 0 && lane == 0) OFFS[b * 4 + (r >> 1)] = base;
                    const bool mine = (ee[r] >> 11) == b; const unsigned long long m = __ballot(mine); if (mine) pos[r] = base + __popcll(m & ltmask); base += __popcll(m); }
            }
            if (lane == 0) OFFS[32] = 512;
#pragma unroll
            for (int r = 0; r < 8; ++r) { u32x2_t en; en.x = (unsigned)ee[r] | ((unsigned)(r >> 1) << 14) | (su[r] << 16); en.y = __float_as_uint(gg[r] * sv[r]); LIST[pos[r]] = en; }
#pragma unroll
            for (int tk = 0; tk < 4; ++tk) { const u32x4 a = *(const u32x4*)(Hin + (size_t)(t0 + tk) * 1024 + lane * 16), bq = *(const u32x4*)(Hin + (size_t)(t0 + tk) * 1024 + lane * 16 + 8);
                const float hv_[16] = {bflo(a.x), bfhi(a.x), bflo(a.y), bfhi(a.y), bflo(a.z), bfhi(a.z), bflo(a.w), bfhi(a.w), bflo(bq.x), bfhi(bq.x), bflo(bq.y), bfhi(bq.y), bflo(bq.z), bfhi(bq.z), bflo(bq.w), bfhi(bq.w)};
                float am = 0.f;
#pragma unroll
                for (int q = 0; q < 16; ++q) am = fmaxf(am, fabsf(hv_[q]));
                am = wave_max(am);
                const int e_ = (int)((__float_as_uint(am) >> 23) & 0xffu) - 127; const bool ok_ = am > 1e-30f;
                const float sc_ = ok_ ? __uint_as_float((unsigned)(127 + 6 - e_) << 23) : 1.0f, isc_ = ok_ ? __uint_as_float((unsigned)(127 - 6 + e_) << 23) : 1.0f;
                u32x4 o8;
#pragma unroll
                for (int q = 0; q < 4; ++q) { unsigned wd = 0u;
#pragma unroll
                    for (int j = 0; j < 4; ++j) { int qi = (int)rintf(hv_[4 * q + j] * sc_); qi = qi > 127 ? 127 : (qi < -127 ? -127 : qi); wd |= ((unsigned)qi & 0xffu) << (8 * j); }
                    o8[q] = wd; }
                *(LAS u32x4*)(HL + tk * 1024 + lane * 16) = o8; if (lane == 0) IHS[tk] = isc_; }
        }
        LDS_WAIT();
        {
            const int jL = ((lane >> 5) & 1) * 4 + ((lane >> 4) & 1) * 2 + ((lane >> 3) & 1);
#define G1_LOAD(UB, TK, G0) do { const unsigned exl_ = LIST[(G0) + (lane & 7)].x; \
            _Pragma("unroll") for (int j = 0; j < 8; ++j) { const unsigned ex = (unsigned)__builtin_amdgcn_readlane((int)exl_, j); TK[j] = (int)((ex >> 14) & 3u); \
                UB[j] = *(const u32x4*)(PU8 + (size_t)(ex & (FAKE ? 0x7fu : 0x3fffu)) * 1024 + lane * 16); } } while (0)
#define G1_RUN(UB, TK, G0) do { int p[8]; \
            _Pragma("unroll") for (int j = 0; j < 8; ++j) { const u32x4 hq = *(const LAS u32x4*)(HL + TK[j] * 1024 + lane * 16); \
                int d_ = __builtin_amdgcn_sdot4((int)UB[j].x, (int)hq.x, 0, false); d_ = __builtin_amdgcn_sdot4((int)UB[j].y, (int)hq.y, d_, false); \
                d_ = __builtin_amdgcn_sdot4((int)UB[j].z, (int)hq.z, d_, false); p[j] = __builtin_amdgcn_sdot4((int)UB[j].w, (int)hq.w, d_, false); } \
            const bool h32 = lane & 32, h16 = lane & 16, h8 = lane & 8; int q4[4]; \
            _Pragma("unroll") for (int j = 0; j < 4; ++j) { const int keep = h32 ? p[j + 4] : p[j], send = h32 ? p[j] : p[j + 4]; q4[j] = keep + __float_as_int(x32(__int_as_float(send))); } \
            int q2[2]; \
            _Pragma("unroll") for (int j = 0; j < 2; ++j) { const int keep = h16 ? q4[j + 2] : q4[j], send = h16 ? q4[j] : q4[j + 2]; q2[j] = keep + __float_as_int(x16(__int_as_float(send))); } \
            int q1; { const int keep = h8 ? q2[1] : q2[0], send = h8 ? q2[0] : q2[1]; q1 = keep + __float_as_int(dpp_f<0x128>(__int_as_float(send))); } \
            q1 += __float_as_int(dpp_f<0x141>(__int_as_float(q1))); q1 += __float_as_int(dpp_f<0xB1>(__int_as_float(q1))); q1 += __float_as_int(dpp_f<0x4E>(__int_as_float(q1))); \
            if ((lane & 7) == 0) { const u32x2_t me = LIST[(G0) + jL]; const float av_ = gelu_t((float)q1 * IHS[(me.x >> 14) & 3u] * __uint_as_float((me.x >> 16) << 23)) * __uint_as_float(me.y); ALU[(G0) + jL] = f2hu(av_, av_); } } while (0)
            u32x4 ubA[8], ubB[8]; int tkA[8], tkB[8];
            G1_LOAD(ubA, tkA, 0);
#pragma unroll 1
            for (int g0 = 0; g0 < ((SKIP & 1) ? 0 : 512); g0 += 16) {
                G1_LOAD(ubB, tkB, g0 + 8);
                G1_RUN(ubA, tkA, g0);
                if (g0 + 16 < 512) G1_LOAD(ubA, tkA, g0 + 16);
                G1_RUN(ubB, tkB, g0 + 8);
            }
#undef G1_LOAD
#undef G1_RUN
        }
        LDS_WAIT();
        h2_t o[4][8], oc[8];
#pragma unroll
        for (int q = 0; q < 8; ++q) { oc[q] = (h2_t){(_Float16)0.f, (_Float16)0.f};
#pragma unroll
            for (int tk = 0; tk < 4; ++tk) o[tk][q] = (h2_t){(_Float16)0.f, (_Float16)0.f}; }
        {
            int curA = 0;
#define G2_FLUSH() do { if (curA == 0) { _Pragma("unroll") for (int q_ = 0; q_ < 8; ++q_) o[0][q_] += oc[q_]; } else if (curA == 1) { _Pragma("unroll") for (int q_ = 0; q_ < 8; ++q_) o[1][q_] += oc[q_]; } \
            else if (curA == 2) { _Pragma("unroll") for (int q_ = 0; q_ < 8; ++q_) o[2][q_] += oc[q_]; } else { _Pragma("unroll") for (int q_ = 0; q_ < 8; ++q_) o[3][q_] += oc[q_]; } \
            _Pragma("unroll") for (int q_ = 0; q_ < 8; ++q_) oc[q_] = (h2_t){(_Float16)0.f, (_Float16)0.f}; } while (0)
#define G2_LOAD(VB, AJ, TK, G0) do { const unsigned exl_ = LIST[(G0) + (lane & 7)].x; const unsigned all_ = ALU[(G0) + (lane & 7)]; \
            _Pragma("unroll") for (int j = 0; j < 8; ++j) { const unsigned ex = (unsigned)__builtin_amdgcn_readlane((int)exl_, j); TK[j] = (int)((ex >> 14) & 3u); AJ[j] = __builtin_bit_cast(h2_t, (unsigned)__builtin_amdgcn_readlane((int)all_, j)); \
                VB[j] = *(const u32x4*)(PV8 + (size_t)(ex & (FAKE ? 0x7fu : 0x3fffu)) * 1024 + lane * 16); } } while (0)
#define G2_ACC(VB, AJ, TK) do { _Pragma("unroll") for (int j = 0; j < 8; ++j) { if (TK[j] != curA) { G2_FLUSH(); curA = TK[j]; } h2_t f_[8]; up8h<FAKE>(VB[j], f_); _Pragma("unroll") for (int q = 0; q < 8; ++q) oc[q] = f_[q] * AJ[j] + oc[q]; } } while (0)
            u32x4 vbA[8], vbB[8]; h2_t ajA[8], ajB[8]; int tA[8], tB[8];
            G2_LOAD(vbA, ajA, tA, 0);
#pragma unroll 1
            for (int g0 = 0; g0 < ((SKIP & 2) ? 0 : 512); g0 += 16) {
                G2_LOAD(vbB, ajB, tB, g0 + 8);
                G2_ACC(vbA, ajA, tA);
                if (g0 + 16 < 512) G2_LOAD(vbA, ajA, tA, g0 + 16);
                G2_ACC(vbB, ajB, tB);
            }
            G2_FLUSH();
#undef G2_FLUSH
#undef G2_LOAD
#undef G2_ACC
        }
#pragma unroll
        for (int tk = 0; tk < 4; ++tk) {
            __builtin_amdgcn_sched_barrier(0);
            const int t = t0 + tk; const int b = t >> 13; const float* gp = g2 + (size_t)b * 6144; float* xr = X + (size_t)t * 1024;
            float xn[16]; float ss = 0.f;
#pragma unroll
            for (int q = 0; q < 4; ++q) { const int col = lane * 16 + q * 4; const f32x4 xv = *(const f32x4*)(xr + col), gv = *(const f32x4*)(gp + col);
#pragma unroll
                for (int j = 0; j < 4; ++j) { const float y = xv[j] + gv[j] * (float)o[tk][q * 2 + (j >> 1)][j & 1]; xn[q * 4 + j] = y; ss += y * y; } }
            const float rstd = 1.0f / sqrtf(wave_sum(ss) * (1.0f / 1024.0f) + EPS);
            if (FINAL) {
#pragma unroll
                for (int q = 0; q < 4; ++q) { const int col = lane * 16 + q * 4; const f32x4 gn = *(const f32x4*)(ngain + col); f32x4 y;
#pragma unroll
                    for (int j = 0; j < 4; ++j) y[j] = xn[q * 4 + j] * rstd * gn[j];
                    *(f32x4*)(xr + col) = y; }
            } else {
                const float* nm = nmod + (size_t)b * 6144;
#pragma unroll
                for (int q = 0; q < 4; ++q) { const int col = lane * 16 + q * 4; const f32x4 gn = *(const f32x4*)(ngain + col), sh = *(const f32x4*)(nm + col), sc = *(const f32x4*)(nm + 1024 + col); f32x4 xo; float y[4];
#pragma unroll
                    for (int j = 0; j < 4; ++j) { xo[j] = xn[q * 4 + j]; y[j] = xn[q * 4 + j] * rstd * gn[j] * (1.0f + sc[j]) + sh[j]; }
                    *(f32x4*)(xr + col) = xo; u32x2_t wv; wv.x = cvtpk(y[0], y[1]); wv.y = cvtpk(y[2], y[3]); *(u32x2_t*)(Hn + (size_t)t * 1024 + col) = wv; }
            }
        }
        LDS_WAIT();
    }
}
constexpr int GR_R = 12;
DI void glds_row(const unsigned char* gsrc_lane, unsigned lds_dst) { unsigned keep;
    asm volatile("s_mov_b32 %0, m0\n\ts_mov_b32 m0, %2\n\ts_nop 0\n\tglobal_load_lds_dwordx4 %1, off\n\ts_mov_b32 m0, %0" : "=&s"(keep) : "v"(gsrc_lane), "s"(lds_dst) : "memory"); }
template <bool FINAL> DI void peer_gather_dma(const Ctx& C, const bf16* Hin, const int* IDX, const float* GATE, const unsigned char* PU8, const unsigned char* PV8, const float* ISU, const float* ISV,
                                              float* X, const float* g2, const float* ngain, const float* nmod, bf16* Hn) {
    const int lane = C.lane, w = C.wave;
    constexpr int WB = 4096 + 2048 + 256 + GR_R * 1024;
    LAS u32x2_t* LIST = (LAS u32x2_t*)(C.lds + w * WB);
    LAS float* AL = (LAS float*)(C.lds + w * WB + 4096);
    LAS int* OFFS = (LAS int*)(C.lds + w * WB + 6144);
    LAS unsigned char* RING = C.lds + w * WB + 6400;
    const unsigned ring0 = (unsigned)__builtin_amdgcn_readfirstlane((int)(unsigned)(size_t)RING);
    const unsigned long long ltmask = (1ull << lane) - 1ull;
#define GR_REFILL(nv_) do { unsigned ex8_[8]; _Pragma("unroll") for (int j_ = 0; j_ < 8; ++j_) ex8_[j_] = (j_ < (nv_) && nf + j_ < 1024) ? LIST[(nf + j_) & 511].x : 0u; \
        _Pragma("unroll") for (int j_ = 0; j_ < 8; ++j_) if (j_ < (nv_) && nf + j_ < 1024) { const int f_ = nf + j_; const unsigned e_ = (unsigned)__builtin_amdgcn_readfirstlane((int)ex8_[j_]) & 0x3fffu; \
            const unsigned char* tb_ = (f_ < 512) ? PU8 : PV8; glds_row(tb_ + (size_t)e_ * 1024 + lane * 16, ring0 + (unsigned)(f_ % GR_R) * 1024u); } \
        nf += (nv_); if (nf > 1024) nf = 1024; } while (0)
#define GR_ISSUE(f) do { const int f_ = (f); const unsigned ex_ = (unsigned)__builtin_amdgcn_readfirstlane((int)LIST[f_ & 511].x); \
        const unsigned char* tb_ = (f_ < 512) ? PU8 : PV8; glds_row(tb_ + (size_t)(ex_ & 0x3fffu) * 1024 + lane * 16, ring0 + (unsigned)(f_ % GR_R) * 1024u); } while (0)
    for (int grp = C.vcu; grp < TT / 32; grp += C.G) {
        const int t0 = grp * 32 + w * 4;
        float hv4[4][16];
        {
            int ee[8]; float gg[8]; unsigned su[8]; float sv[8];
#pragma unroll
            for (int r = 0; r < 8; ++r) { const size_t a = (size_t)(t0 + (r >> 1)) * 128 + 64 * (r & 1) + lane; ee[r] = IDX[a]; gg[r] = GATE[a]; }
#pragma unroll
            for (int r = 0; r < 8; ++r) { su[r] = __float_as_uint(ISU[ee[r]]) >> 23; sv[r] = ISV[ee[r]]; }
            int pos[8]; int base = 0;
#pragma unroll 1
            for (int b = 0; b < 8; ++b) {
#pragma unroll
                for (int r = 0; r < 8; ++r) { if ((r & 1) == 0 && lane == 0) OFFS[b * 4 + (r >> 1)] = base;
                    const bool mine = (ee[r] >> 11) == b; const unsigned long long m = __ballot(mine); if (mine) pos[r] = base + __popcll(m & ltmask); base += __popcll(m); }
            }
            if (lane == 0) OFFS[32] = 512;
#pragma unroll
            for (int r = 0; r < 8; ++r) { u32x2_t en; en.x = (unsigned)ee[r] | ((unsigned)(r >> 1) << 14) | (su[r] << 16); en.y = __float_as_uint(gg[r] * sv[r]); LIST[pos[r]] = en; }
#pragma unroll
            for (int tk = 0; tk < 4; ++tk) { const u32x4 a = *(const u32x4*)(Hin + (size_t)(t0 + tk) * 1024 + lane * 16), bq = *(const u32x4*)(Hin + (size_t)(t0 + tk) * 1024 + lane * 16 + 8);
                hv4[tk][0] = bflo(a.x); hv4[tk][1] = bfhi(a.x); hv4[tk][2] = bflo(a.y); hv4[tk][3] = bfhi(a.y); hv4[tk][4] = bflo(a.z); hv4[tk][5] = bfhi(a.z); hv4[tk][6] = bflo(a.w); hv4[tk][7] = bfhi(a.w);
                hv4[tk][8] = bflo(bq.x); hv4[tk][9] = bfhi(bq.x); hv4[tk][10] = bflo(bq.y); hv4[tk][11] = bfhi(bq.y); hv4[tk][12] = bflo(bq.z); hv4[tk][13] = bfhi(bq.z); hv4[tk][14] = bflo(bq.w); hv4[tk][15] = bfhi(bq.w); }
        }
        asm volatile("s_waitcnt vmcnt(0) lgkmcnt(0)" ::: "memory");
        int nf = GR_R;
#pragma unroll 1
        for (int f = 0; f < GR_R; ++f) GR_ISSUE(f);
        {
            const int jL = ((lane >> 5) & 1) * 4 + ((lane >> 4) & 1) * 2 + ((lane >> 3) & 1);
#pragma unroll 1
            for (int r = 0; r < 8; ++r) {
#pragma unroll
                for (int tk = 0; tk < 4; ++tk) {
                    const int beg = __builtin_amdgcn_readfirstlane(OFFS[r * 4 + tk]), end = __builtin_amdgcn_readfirstlane(OFFS[r * 4 + tk + 1]);
#pragma unroll 1
                    for (int g0 = beg; g0 < end; g0 += 8) {
                        const int nv = (end - g0) < 8 ? (end - g0) : 8;
                        asm volatile("s_waitcnt vmcnt(4)" ::: "memory");
                        float p[8];
#pragma unroll
                        for (int j = 0; j < 8; ++j) { p[j] = 0.f;
                            if (j < nv) { const u32x4 row = *(const LAS u32x4*)(RING + ((g0 + j) % GR_R) * 1024 + lane * 16); p[j] = dot16(row, hv4[tk]); } }
                        asm volatile("s_waitcnt lgkmcnt(0)" ::: "memory");
                        GR_REFILL(nv);
                        const bool h32 = lane & 32, h16 = lane & 16, h8 = lane & 8;
                        float q4[4];
#pragma unroll
                        for (int j = 0; j < 4; ++j) { const float keep = h32 ? p[j + 4] : p[j], send = h32 ? p[j] : p[j + 4]; q4[j] = keep + __shfl_xor(send, 32); }
                        float q2[2];
#pragma unroll
                        for (int j = 0; j < 2; ++j) { const float keep = h16 ? q4[j + 2] : q4[j], send = h16 ? q4[j] : q4[j + 2]; q2[j] = keep + __shfl_xor(send, 16); }
                        float q1; { const float keep = h8 ? q2[1] : q2[0], send = h8 ? q2[0] : q2[1]; q1 = keep + __shfl_xor(send, 8); }
                        q1 += __shfl_xor(q1, 4); q1 += __shfl_xor(q1, 2); q1 += __shfl_xor(q1, 1);
                        if ((lane & 7) == 0 && jL < nv) { const u32x2_t me = LIST[g0 + jL]; AL[g0 + jL] = gelu_t(q1 * __uint_as_float((me.x >> 16) << 23)) * __uint_as_float(me.y); }
                    }
                }
            }
        }
        float o[4][16];
#pragma unroll
        for (int tk = 0; tk < 4; ++tk)
#pragma unroll
            for (int q = 0; q < 16; ++q) o[tk][q] = 0.f;
#pragma unroll 1
        for (int r = 0; r < 8; ++r) {
#pragma unroll
            for (int tk = 0; tk < 4; ++tk) {
                const int beg = __builtin_amdgcn_readfirstlane(OFFS[r * 4 + tk]), end = __builtin_amdgcn_readfirstlane(OFFS[r * 4 + tk + 1]);
#pragma unroll 1
                for (int i0 = beg; i0 < end; i0 += 8) {
                    const int nv = (end - i0) < 8 ? (end - i0) : 8;
                    if (i0 <= 500) asm volatile("s_waitcnt vmcnt(4)" ::: "memory"); else asm volatile("s_waitcnt vmcnt(0)" ::: "memory");
                    float aq[8]; u32x4 rw[8];
#pragma unroll
                    for (int j = 0; j < 8; ++j) { aq[j] = (j < nv) ? AL[i0 + j] : 0.f; }
#pragma unroll
                    for (int j = 0; j < 8; ++j) if (j < nv) rw[j] = *(const LAS u32x4*)(RING + ((512 + i0 + j) % GR_R) * 1024 + lane * 16);
#pragma unroll
                    for (int j = 0; j < 8; ++j) if (j < nv) { const float aj = __int_as_float(__builtin_amdgcn_readfirstlane(__float_as_int(aq[j])));
                        float f_[16]; up8(rw[j].x, f_[0], f_[1], f_[2], f_[3]); up8(rw[j].y, f_[4], f_[5], f_[6], f_[7]); up8(rw[j].z, f_[8], f_[9], f_[10], f_[11]); up8(rw[j].w, f_[12], f_[13], f_[14], f_[15]);
#pragma unroll
                        for (int q = 0; q < 16; ++q) o[tk][q] += aj * f_[q]; }
                    asm volatile("s_waitcnt lgkmcnt(0)" ::: "memory");
                    GR_REFILL(nv);
                }
            }
        }
        asm volatile("s_waitcnt vmcnt(0)" ::: "memory");
#pragma unroll
        for (int tk = 0; tk < 4; ++tk) {
            const int t = t0 + tk; const int b = t >> 13; const float* gp = g2 + (size_t)b * 6144; float* xr = X + (size_t)t * 1024;
            float xn[16]; float ss = 0.f;
#pragma unroll
            for (int q = 0; q < 4; ++q) { const int col = lane * 16 + q * 4; const f32x4 xv = *(const f32x4*)(xr + col), gv = *(const f32x4*)(gp + col);
#pragma unroll
                for (int j = 0; j < 4; ++j) { const float y = xv[j] + gv[j] * o[tk][q * 4 + j]; xn[q * 4 + j] = y; ss += y * y; } }
            const float rstd = 1.0f / sqrtf(wave_sum(ss) * (1.0f / 1024.0f) + EPS);
            if (FINAL) {
#pragma unroll
                for (int q = 0; q < 4; ++q) { const int col = lane * 16 + q * 4; const f32x4 gn = *(const f32x4*)(ngain + col); f32x4 y;
#pragma unroll
                    for (int j = 0; j < 4; ++j) y[j] = xn[q * 4 + j] * rstd * gn[j];
                    *(f32x4*)(xr + col) = y; }
            } else {
                const float* nm = nmod + (size_t)b * 6144;
#pragma unroll
                for (int q = 0; q < 4; ++q) { const int col = lane * 16 + q * 4; const f32x4 gn = *(const f32x4*)(ngain + col), sh = *(const f32x4*)(nm + col), sc = *(const f32x4*)(nm + 1024 + col); f32x4 xo; float y[4];
#pragma unroll
                    for (int j = 0; j < 4; ++j) { xo[j] = xn[q * 4 + j]; y[j] = xn[q * 4 + j] * rstd * gn[j] * (1.0f + sc[j]) + sh[j]; }
                    *(f32x4*)(xr + col) = xo; u32x2_t wv; wv.x = cvtpk(y[0], y[1]); wv.y = cvtpk(y[2], y[3]); *(u32x2_t*)(Hn + (size_t)t * 1024 + col) = wv; }
            }
        }
        asm volatile("s_waitcnt vmcnt(0) lgkmcnt(0)" ::: "memory");
    }
#undef GR_ISSUE
#undef GR_REFILL
}
DI float red4_sum(float x) { auto a = __builtin_amdgcn_permlane16_swap(__float_as_uint(x), __float_as_uint(x), false, false); x = __uint_as_float(a[0]) + __uint_as_float(a[1]);
    auto b = __builtin_amdgcn_permlane32_swap(__float_as_uint(x), __float_as_uint(x), false, false); return __uint_as_float(b[0]) + __uint_as_float(b[1]); }
DI float red4_max(float x) { auto a = __builtin_amdgcn_permlane16_swap(__float_as_uint(x), __float_as_uint(x), false, false); x = fmaxf(__uint_as_float(a[0]), __uint_as_float(a[1]));
    auto b = __builtin_amdgcn_permlane32_swap(__float_as_uint(x), __float_as_uint(x), false, false); return fmaxf(__uint_as_float(b[0]), __uint_as_float(b[1])); }
DI float red4_min(float x) { auto a = __builtin_amdgcn_permlane16_swap(__float_as_uint(x), __float_as_uint(x), false, false); x = fminf(__uint_as_float(a[0]), __uint_as_float(a[1]));
    auto b = __builtin_amdgcn_permlane32_swap(__float_as_uint(x), __float_as_uint(x), false, false); return fminf(__uint_as_float(b[0]), __uint_as_float(b[1])); }
constexpr int TK_NI = 6;
DI float tk_pivot(float clo, float chi) {
    const float lc = __builtin_amdgcn_logf(clo), lh = __builtin_amdgcn_logf(fmaxf(chi, 0.5f));
    const float f = (lc - 4.0443941f) * __builtin_amdgcn_rcpf(lc - lh);
    return fminf(fmaxf(f, 0.06f), 0.94f);
}
template <int NV> DI float tk_count(const float (&v)[NV], float mid) {
    const float nb = -mid * 1.099511627776e12f;
    float c[4] = {0.f, 0.f, 0.f, 0.f};
#pragma unroll
    for (int i = 0; i < NV; ++i) c[i & 3] += __builtin_amdgcn_fmed3f(__builtin_fmaf(v[i], 1.099511627776e12f, nb), 0.f, 1.f);
    return red4_sum((c[0] + c[1]) + (c[2] + c[3]));
}
constexpr int tk2_pair(int n) {
    int k = 0;
    for (int i = 0; i < 16; ++i) for (int j = 0; j < 16; ++j) if ((i + 1) * (j + 1) <= 16) { if (k == n) return i | (j << 8); ++k; }
    return n == 50 ? (15 | (15 << 8)) : (15 | (14 << 8));
}
constexpr int TK_STEP = 2;
template <int NV> DI void tk_search(const float (&v)[NV], float ntot, float& thr_out) {
    float mx = v[0], mn = v[0];
#pragma unroll
    for (int i = 1; i < NV; ++i) { mx = fmaxf(mx, v[i]); mn = fminf(mn, v[i]); }
    mx = red4_max(mx); mn = red4_min(mn);
    float lo = mn, hi = mx, clo = ntot - 1.0f, chi = 0.0f; bool done = false;
#pragma unroll 1
    for (int iter = 0; iter < 48; ++iter) {
        const bool rdy = done || clo <= 16.0f + (float)TK_STEP;
        if (__all(rdy)) break;
        float fr_ = tk_pivot(clo, chi); if (iter >= TK_NI) fr_ = 0.5f;
        const float mid = rdy ? lo : lo + (hi - lo) * fr_;
        const float cnt = tk_count<NV>(v, mid);
        if (!rdy) { if (cnt == 16.0f) { lo = mid; clo = 16.0f; done = true; } else if (cnt > 16.0f) { lo = mid; clo = cnt; } else { hi = mid; chi = cnt; } }
    }
    const float sl = lo;
#pragma unroll 1
    for (int r = 0; r < TK_STEP; ++r) {
        const bool nd = clo > 16.0f;
        if (!__any(nd)) break;
        float y = 3.0e38f;
#pragma unroll
        for (int i = 0; i < NV; ++i) y = fminf(y, v[i] > lo ? v[i] : 3.0e38f);
        y = red4_min(y);
        if (nd) { lo = y; clo -= 1.0f; }
    }
    if (__any(!done)) { const float c = tk_count<NV>(v, lo); if (c != 16.0f) lo = sl; }
    thr_out = lo;
}
DI void tk_search2(const float (&v0)[32], const float (&v1)[32], float& t0, float& t1) {
    float mx0 = v0[0], mn0 = v0[0], mx1 = v1[0], mn1 = v1[0], s0 = v0[0], s1 = v1[0], q0 = v0[0] * v0[0], q1 = v1[0] * v1[0];
#pragma unroll
    for (int i = 1; i < 32; ++i) { mx0 = fmaxf(mx0, v0[i]); mn0 = fminf(mn0, v0[i]); mx1 = fmaxf(mx1, v1[i]); mn1 = fminf(mn1, v1[i]);
        s0 += v0[i]; s1 += v1[i]; q0 = __builtin_fmaf(v0[i], v0[i], q0); q1 = __builtin_fmaf(v1[i], v1[i], q1); }
    mx0 = red4_max(mx0); mn0 = red4_min(mn0); mx1 = red4_max(mx1); mn1 = red4_min(mn1); s0 = red4_sum(s0); s1 = red4_sum(s1); q0 = red4_sum(q0); q1 = red4_sum(q1);
    const float me0 = s0 * (1.0f / 128.0f), me1 = s1 * (1.0f / 128.0f);
    const float g0 = fminf(fmaxf(me0 + 1.05f * sqrtf(fmaxf(q0 * (1.0f / 128.0f) - me0 * me0, 0.f)), mn0), mx0), g1 = fminf(fmaxf(me1 + 1.05f * sqrtf(fmaxf(q1 * (1.0f / 128.0f) - me1 * me1, 0.f)), mn1), mx1);
    float lo0 = mn0, hi0 = mx0, clo0 = 127.0f, chi0 = 0.0f; bool done0 = false;
    float lo1 = mn1, hi1 = mx1, clo1 = 127.0f, chi1 = 0.0f; bool done1 = false;
#pragma unroll 1
    for (int iter = 0; iter < 48; ++iter) {
        const bool r0 = done0 || clo0 <= 16.0f + (float)TK_STEP, r1 = done1 || clo1 <= 16.0f + (float)TK_STEP;
        if (__all(r0 && r1)) break;
        float f0 = tk_pivot(clo0, chi0), f1 = tk_pivot(clo1, chi1); if (iter >= TK_NI) { f0 = 0.5f; f1 = 0.5f; }
        float mid0 = lo0 + (hi0 - lo0) * f0, mid1 = lo1 + (hi1 - lo1) * f1; if (iter == 0) { mid0 = g0; mid1 = g1; }
        if (r0) mid0 = lo0; if (r1) mid1 = lo1;
        const float c0 = tk_count<32>(v0, mid0), c1 = tk_count<32>(v1, mid1);
        if (!r0) { if (c0 == 16.0f) { lo0 = mid0; clo0 = 16.0f; done0 = true; } else if (c0 > 16.0f) { lo0 = mid0; clo0 = c0; } else { hi0 = mid0; chi0 = c0; } }
        if (!r1) { if (c1 == 16.0f) { lo1 = mid1; clo1 = 16.0f; done1 = true; } else if (c1 > 16.0f) { lo1 = mid1; clo1 = c1; } else { hi1 = mid1; chi1 = c1; } }
    }
    const float sl0 = lo0, sl1 = lo1;
#pragma unroll 1
    for (int r = 0; r < TK_STEP; ++r) {
        const bool n0 = clo0 > 16.0f, n1 = clo1 > 16.0f;
        if (!__any(n0 || n1)) break;
        float y0 = 3.0e38f, y1 = 3.0e38f;
#pragma unroll
        for (int i = 0; i < 32; ++i) { y0 = fminf(y0, v0[i] > lo0 ? v0[i] : 3.0e38f); y1 = fminf(y1, v1[i] > lo1 ? v1[i] : 3.0e38f); }
        y0 = red4_min(y0); y1 = red4_min(y1);
        if (n0) { lo0 = y0; clo0 -= 1.0f; }
        if (n1) { lo1 = y1; clo1 -= 1.0f; }
    }
    if (__any(!done0 || !done1)) {
        const float c0 = tk_count<32>(v0, lo0), c1 = tk_count<32>(v1, lo1);
        if (c0 != 16.0f) lo0 = sl0; if (c1 != 16.0f) lo1 = sl1;
    }
    t0 = lo0; t1 = lo1;
}
template <int N> struct tk2_pair_c { static constexpr int value = tk2_pair(N); };
template <int MODE = 0> DI void peer_topk_fused(const Ctx& C, const bf16* QP, const bf16* KEYS, int* IDX, float* GATE) {
    constexpr int KPI = 288;
    const int lane = C.lane, fr = lane & 15, fq = lane >> 4, w = C.wave;
    LAS unsigned char* KS = C.lds;
    LAS unsigned char* WB = C.lds + 73728 + w * 7168;
    LAS float* LV = (LAS float*)(WB);
    LAS int* LK = (LAS int*)(WB + 2176);
    LAS float* FV = (LAS float*)(WB + 4352);
    LAS int* FI = (LAS int*)(WB + 5504);
    LAS float* TRASH = (LAS float*)(WB + 6656) + lane;
    const int h = C.vcu & 7, nb = C.G >> 3;
    { const bf16* kg = KEYS + (size_t)h * 2 * 128 * 128;
      for (int c = C.tid; c < 4096; c += 512) { const int r = c >> 4, cc = c & 15; *(LAS u32x4*)(KS + r * KPI + cc * 16) = *(const u32x4*)(kg + (size_t)r * 128 + cc * 8); } }
    __syncthreads();
    int cof[13];
#define TK2_COF(c) cof[c] = fq == 0 ? tk2_pair_c<4 * (c)>::value : fq == 1 ? tk2_pair_c<4 * (c) + 1>::value : fq == 2 ? tk2_pair_c<4 * (c) + 2>::value : tk2_pair_c<4 * (c) + 3>::value
    TK2_COF(0); TK2_COF(1); TK2_COF(2); TK2_COF(3); TK2_COF(4); TK2_COF(5); TK2_COF(6); TK2_COF(7); TK2_COF(8); TK2_COF(9); TK2_COF(10); TK2_COF(11); TK2_COF(12);
#undef TK2_COF
    for (int tt = (C.vcu >> 3) + nb * w; tt < 1024; tt += nb * 8) {
        const int tok = tt * 16 + fr;
        float sc0[32], sc1[32];
#pragma unroll
        for (int p = 0; p < 2; ++p) {
            bf16x8 qf[4];
#pragma unroll
            for (int ks = 0; ks < 4; ++ks) qf[ks] = *(const bf16x8*)(QP + (size_t)tok * 2048 + h * 256 + p * 128 + ks * 32 + fq * 8);
#pragma unroll
            for (int kt = 0; kt < 8; ++kt) {
                f32x4 acc = {0.f, 0.f, 0.f, 0.f};
#pragma unroll
                for (int ks = 0; ks < 4; ++ks) { const bf16x8 kf = *(const LAS bf16x8*)(KS + (p * 128 + kt * 16 + fr) * KPI + (ks * 32 + fq * 8) * 2);
                    acc = __builtin_amdgcn_mfma_f32_16x16x32_bf16(kf, qf[ks], acc, 0, 0, 0); }
                if (p == 0) { sc0[kt * 4 + 0] = acc[0]; sc0[kt * 4 + 1] = acc[1]; sc0[kt * 4 + 2] = acc[2]; sc0[kt * 4 + 3] = acc[3]; }
                else { sc1[kt * 4 + 0] = acc[0]; sc1[kt * 4 + 1] = acc[1]; sc1[kt * 4 + 2] = acc[2]; sc1[kt * 4 + 3] = acc[3]; }
            }
        }
        float thrA = 1.0f, thrB = 1.0f; if (MODE == 0) tk_search2(sc0, sc1, thrA, thrB);
#pragma unroll
        for (int p = 0; p < 2; ++p) {
            const float thr = p == 0 ? thrA : thrB;
            int cnt = 0;
#pragma unroll
            for (int i = 0; i < 32; ++i) cnt += ((p == 0 ? sc0[i] : sc1[i]) > thr) ? 1 : 0;
            const int c0 = __shfl(cnt, fr), c1 = __shfl(cnt, fr + 16), c2 = __shfl(cnt, fr + 32);
            int pos = (fq > 0 ? c0 : 0) + (fq > 1 ? c1 : 0) + (fq > 2 ? c2 : 0);
#pragma unroll
            for (int i = 0; i < 32; ++i) { const float vv = p == 0 ? sc0[i] : sc1[i]; const bool s = vv > thr && pos < 16;
                LAS float* pv = s ? (LV + fr * 33 + p * 16 + pos) : TRASH; LAS int* pk = s ? (LK + fr * 33 + p * 16 + pos) : (LAS int*)TRASH;
                *pv = vv; *pk = (i >> 2) * 16 + 4 * fq + (i & 3); pos += (vv > thr) ? 1 : 0; }
        }
        LDS_WAIT();
        {
            const int lb = fr * 33 + (fq >> 1) * 16, e0 = 8 * (fq & 1);
            float L[16], ownv[8], own[8]; int okey[8], rk[8];
#pragma unroll
            for (int q = 0; q < 16; ++q) L[q] = __uint_as_float((__float_as_uint(LV[lb + q]) & ~15u) | (unsigned)q);
#pragma unroll
            for (int i = 0; i < 8; ++i) { ownv[i] = LV[lb + e0 + i]; okey[i] = LK[lb + e0 + i]; own[i] = __uint_as_float((__float_as_uint(ownv[i]) & ~15u) | (unsigned)(e0 + i)); }
#pragma unroll
            for (int i = 0; i < 8; ++i) { int r = 0;
#pragma unroll
                for (int q = 0; q < 16; ++q) r += (L[q] > own[i]) ? 1 : 0;
                rk[i] = r; }
#pragma unroll
            for (int i = 0; i < 8; ++i) { LV[lb + rk[i]] = ownv[i]; LK[lb + rk[i]] = okey[i]; }
        }
        LDS_WAIT();
        float sm[13]; int ca[13], cb[13];
#pragma unroll
        for (int c = 0; c < 13; ++c) { ca[c] = fr * 33 + (cof[c] & 255); cb[c] = fr * 33 + 16 + (cof[c] >> 8); sm[c] = LV[ca[c]] + LV[cb[c]]; }
        float thr2 = 4.0f; if (MODE == 0) tk_search<13>(sm, 52.0f, thr2);
        {
            int cnt = 0;
#pragma unroll
            for (int i = 0; i < 13; ++i) cnt += (sm[i] > thr2) ? 1 : 0;
            const int c0 = __shfl(cnt, fr), c1 = __shfl(cnt, fr + 16), c2 = __shfl(cnt, fr + 32);
            int pos = (fq > 0 ? c0 : 0) + (fq > 1 ? c1 : 0) + (fq > 2 ? c2 : 0);
#pragma unroll
            for (int i = 0; i < 13; ++i) { const bool s = sm[i] > thr2 && pos < 16;
                LAS float* pv = s ? (FV + fr * 17 + pos) : TRASH; LAS int* pk = s ? (FI + fr * 17 + pos) : (LAS int*)TRASH;
                *pv = sm[i]; *pk = LK[ca[i]] * 128 + LK[cb[i]]; pos += (sm[i] > thr2) ? 1 : 0; }
        }
        LDS_WAIT();
        float x[4]; int xi[4];
#pragma unroll
        for (int j = 0; j < 4; ++j) { x[j] = FV[fr * 17 + 4 * fq + j]; xi[j] = FI[fr * 17 + 4 * fq + j]; }
        float m = red4_max(fmaxf(fmaxf(x[0], x[1]), fmaxf(x[2], x[3])));
        float e[4]; float s = 0.f;
#pragma unroll
        for (int j = 0; j < 4; ++j) { e[j] = __expf(x[j] - m); s += e[j]; }
        s = red4_sum(s);
        const float inv = 1.0f / s;
        const size_t ob = ((size_t)tok * 8 + h) * 16 + 4 * fq;
        typedef int i32x4 __attribute__((ext_vector_type(4)));
        *(i32x4*)(IDX + ob) = (i32x4){xi[0], xi[1], xi[2], xi[3]}; *(f32x4*)(GATE + ob) = (f32x4){e[0] * inv, e[1] * inv, e[2] * inv, e[3] * inv};
        LDS_WAIT();
    }
}
DI void intra_mfma(const Ctx& C, const bf16* Q, const bf16* K, const bf16* V, const bf16* CROSS, bf16* G) {
    constexpr int RPI = 544, PPI = 144, VPI = 544;
    LAS unsigned char* Qs = C.lds; LAS unsigned char* Ks = Qs + 64 * RPI; LAS unsigned char* Ps = Ks + 64 * RPI; LAS unsigned char* Vs = Ps + 64 * PPI;
    LAS float* red = (LAS float*)(Vs + 64 * VPI);
    const int tid = C.tid, lane = C.lane, w = C.wave, fr = lane & 15, fq = lane >> 4;
    for (int item = C.vcu; item < 1024; item += C.G) {
        const int b = item >> 9, h = (item >> 7) & 3, n = item & 127;
        const float lg2 = log2f(1.0f - exp2f(-5.0f - (float)h));
        const size_t tok0 = (size_t)b * SEQ + (size_t)n * 64;
#pragma unroll
        for (int u = 0; u < 4; ++u) { const int c = tid + 512 * u, r = c >> 5, cc = c & 31;
            *(LAS u32x4*)(Qs + r * RPI + cc * 16) = *(const u32x4*)(Q + (tok0 + r) * 1024 + h * 256 + cc * 8);
            *(LAS u32x4*)(Ks + r * RPI + cc * 16) = *(const u32x4*)(K + (tok0 + r) * 1024 + h * 256 + cc * 8);
            *(LAS u32x4*)(Vs + r * VPI + cc * 16) = *(const u32x4*)(V + (tok0 + r) * 2048 + h * 512 + cc * 8); }
        __syncthreads();
        { const int jt = w >> 1; f32x4 sa[2] = {(f32x4){0.f, 0.f, 0.f, 0.f}, (f32x4){0.f, 0.f, 0.f, 0.f}};
#pragma unroll
          for (int ks = 0; ks < 8; ++ks) { const bf16x8 kf = *(const LAS bf16x8*)(Ks + (16 * jt + fr) * RPI + (32 * ks + 8 * fq) * 2);
#pragma unroll
              for (int q = 0; q < 2; ++q) { const int it = 2 * (w & 1) + q; const bf16x8 qf = *(const LAS bf16x8*)(Qs + (16 * it + fr) * RPI + (32 * ks + 8 * fq) * 2);
                  sa[q] = __builtin_amdgcn_mfma_f32_16x16x32_bf16(kf, qf, sa[q], 0, 0, 0); } }
#pragma unroll
          for (int q = 0; q < 2; ++q) { const int i = 16 * (2 * (w & 1) + q) + fr, j0 = 16 * jt + 4 * fq; float pv[4];
#pragma unroll
              for (int r = 0; r < 4; ++r) { const int dd = i > j0 + r ? i - j0 - r : j0 + r - i; pv[r] = sa[q][r] * exp2f(lg2 * (float)dd); }
              u32x2_t o; o.x = cvtpk(pv[0], pv[1]); o.y = cvtpk(pv[2], pv[3]); *(LAS u32x2_t*)(Ps + i * PPI + j0 * 2) = o; } }
        __syncthreads();
        f32x4 acc[2][2][4];
#pragma unroll
        for (int hf = 0; hf < 2; ++hf) {
#pragma unroll
            for (int et = 0; et < 2; ++et)
#pragma unroll
                for (int it = 0; it < 4; ++it) acc[hf][et][it] = (f32x4){0.f, 0.f, 0.f, 0.f};
            if (hf == 1) { __syncthreads();
#pragma unroll
                for (int u = 0; u < 4; ++u) { const int c = tid + 512 * u, r = c >> 5, cc = c & 31;
                    *(LAS u32x4*)(Vs + r * VPI + cc * 16) = *(const u32x4*)(V + (tok0 + r) * 2048 + h * 512 + 256 + cc * 8); }
                __syncthreads(); }
#pragma unroll
            for (int ks = 0; ks < 2; ++ks) {
                bf16x8 pf[4];
#pragma unroll
                for (int it = 0; it < 4; ++it) { const LAS unsigned char* pp = Ps + (16 * it + fr) * PPI + (32 * ks + 4 * fq) * 2;
                    const u32x2_t lo = *(const LAS u32x2_t*)pp, hi = *(const LAS u32x2_t*)(pp + 32); u32x4 ww; ww.x = lo.x; ww.y = lo.y; ww.z = hi.x; ww.w = hi.y; pf[it] = __builtin_bit_cast(bf16x8, ww); }
#pragma unroll
                for (int et = 0; et < 2; ++et) { const LAS unsigned char* vp = Vs + (32 * ks + 4 * fq + (fr >> 2)) * VPI + (32 * w + 16 * et + 4 * (fr & 3)) * 2;
                    const bf16x8 vf = cat8(trr(vp), trr(vp + 16 * VPI));
#pragma unroll
                    for (int it = 0; it < 4; ++it) acc[hf][et][it] = __builtin_amdgcn_mfma_f32_16x16x32_bf16(vf, pf[it], acc[hf][et][it], 0, 0, 0); }
            }
        }
        float ssq[4] = {0.f, 0.f, 0.f, 0.f};
#pragma unroll
        for (int hf = 0; hf < 2; ++hf)
#pragma unroll
            for (int et = 0; et < 2; ++et)
#pragma unroll
                for (int it = 0; it < 4; ++it) { const u32x2_t cv = *(const u32x2_t*)(CROSS + (tok0 + 16 * it + fr) * 2048 + h * 512 + hf * 256 + 32 * w + 16 * et + 4 * fq);
                    f32x4 y = acc[hf][et][it]; y[0] += bflo(cv.x); y[1] += bfhi(cv.x); y[2] += bflo(cv.y); y[3] += bfhi(cv.y); acc[hf][et][it] = y;
                    ssq[it] += (y[0] * y[0] + y[1] * y[1]) + (y[2] * y[2] + y[3] * y[3]); }
#pragma unroll
        for (int it = 0; it < 4; ++it) { float s = ssq[it]; s += __shfl_xor(s, 16); s += __shfl_xor(s, 32); if (fq == 0) red[w * 64 + 16 * it + fr] = s; }
        __syncthreads();
        float rs[4];
#pragma unroll
        for (int it = 0; it < 4; ++it) { float s = 0.f;
#pragma unroll
            for (int ww = 0; ww < 8; ++ww) s += red[ww * 64 + 16 * it + fr];
            rs[it] = 1.0f / sqrtf(s * (1.0f / 512.0f) + EPS); }
#pragma unroll
        for (int hf = 0; hf < 2; ++hf)
#pragma unroll
            for (int et = 0; et < 2; ++et)
#pragma unroll
                for (int it = 0; it < 4; ++it) { bf16* gp = G + (tok0 + 16 * it + fr) * 2048 + h * 512 + hf * 256 + 32 * w + 16 * et + 4 * fq; const u32x2_t gv = *(const u32x2_t*)gp;
                    const f32x4 y = acc[hf][et][it] * rs[it]; u32x2_t o; o.x = cvtpk(y[0] * bflo(gv.x), y[1] * bfhi(gv.x)); o.y = cvtpk(y[2] * bflo(gv.y), y[3] * bfhi(gv.y)); *(u32x2_t*)gp = o; }
        __syncthreads();
    }
}
#ifndef PHMASK
#define PHMASK 0xFFFFFFu
#endif
#define PH(k) ((PHMASK >> (k)) & 1u)
#ifdef USE_SGU_NAIVE
#define SGU_GATE_FN sgu_gate_naive
#else
#define SGU_GATE_FN sgu_gate_mfma
#endif
#ifdef USE_GATHER_TOKEN
#define GATHER_FN peer_gather8
#else
#ifdef USE_GATHER_ROUNDS
#define GATHER_FN peer_gather_rounds
#else
#define GATHER_FN peer_gather_dma
#endif
#endif
#ifndef DUP_GATHER_SKIP
#define DUP_GATHER_SKIP 0
#endif
#ifndef DUP_GATHER_FAKE
#define DUP_GATHER_FAKE false
#endif
struct Args { const void* in[21]; float* out; unsigned char* ws; };
__global__ void __launch_bounds__(NWAVES * 64, 2) mk_fwd(Args args) {
    extern __shared__ __attribute__((aligned(16))) unsigned char lds[];
    Ctx C; C.lds = (LAS unsigned char*)lds; C.tid = threadIdx.x; C.lane = C.tid & 63; C.wave = __builtin_amdgcn_readfirstlane(C.tid >> 6);
    C.G = gridDim.x; { const int bx = blockIdx.x; C.vcu = (C.G % 8 == 0) ? (bx % 8) * (C.G / 8) + bx / 8 : bx; }
    C.ws = args.ws;
    volatile LAS unsigned* MISC = (volatile LAS unsigned*)(C.lds + MISC_OFF);
    gu32* ctl = (gu32*)(args.ws + WS_CTL);
    for (int u = C.tid; u < (LDS_BYTES - LDSCTL_OFF) / 4; u += NWAVES * 64) ((LAS unsigned*)(C.lds + LDSCTL_OFF))[u] = 0u;
    __syncthreads();
    XcdBarrier bar = xcd_barrier_post((unsigned*)(ctl + CW_BAR), MISC + 8);
#define GRID_BAR() do { xcd_barrier(bar); asm volatile("" : "+v"(C.tid)); C.lane = C.tid & 63; C.wave = __builtin_amdgcn_readfirstlane(C.tid >> 6); } while (0)
    { LAS unsigned long long* PT = (LAS unsigned long long*)(C.lds + PTR_OFF);
      if (C.tid == 0) {
#pragma unroll
          for (int i = 0; i < 21; ++i) PT[i] = (unsigned long long)args.in[i];
      } }
    __syncthreads();
#define INP(T, i) ((const T*)ldp(C, i))
    float* out = args.out; unsigned char* ws = args.ws;
#define MODP ((float*)(ws + WS_MOD))
#define MOD0 ((const float*)(ws + WS_MOD))
#define MOD1 ((const float*)(ws + WS_MOD) + 2 * 6144)
#define cosT ((float*)(ws + WS_COS))
#define sinT ((float*)(ws + WS_SIN))
#define WRI ((bf16*)(ws + WS_WRI))
#define WRO ((bf16*)(ws + WS_WRO))
#define WSI ((bf16*)(ws + WS_WSI))
#define WSO ((bf16*)(ws + WS_WSO))
#define WQ ((bf16*)(ws + WS_WQ))
#define KEYS ((bf16*)(ws + WS_KEYS))
#define STATS ((float*)(ws + WS_STATS))
#define IDX ((int*)(ws + WS_IDX))
#define GATE ((float*)(ws + WS_GATE))
#define H ((bf16*)(ws + WS_H))
#define PU8 ((const unsigned char*)(ws + WS_PU))
#define PV8 ((const unsigned char*)(ws + WS_PV))
#define ISU ((const float*)(ws + WS_ISU))
#define ISV ((const float*)(ws + WS_ISV))
#define Qb ((bf16*)(ws + WS_Q))
#define Kb ((bf16*)(ws + WS_K))
#define Vb ((bf16*)(ws + WS_V))
#define Gb ((bf16*)(ws + WS_G))
#define CROSS ((bf16*)(ws + WS_CROSS))
#define QP ((bf16*)(ws + WS_QP))
#define SCO ((float*)(ws + WS_SC))
#define Ub ((bf16*)(ws + WS_U))
#define VBb ((bf16*)(ws + WS_VB))

    { P0In I; I.c = INP(float, 1); I.ada_w = INP(float, 5); I.ada_b = INP(float, 6); I.ret_w_in = INP(float, 7); I.ret_w_out = INP(float, 8); I.sgu_w_in = INP(float, 9); I.sgu_w_out = INP(float, 15); I.wq = INP(float, 16); I.keys = INP(float, 17); I.pu = INP(float, 18); I.pv = INP(float, 19); I.pos = INP(int, 2);
#ifdef DUP_P0
      p0_prologue(C, I);
      GRID_BAR();
#endif
      if (PH(0)) p0_prologue(C, I); }
    GRID_BAR();
    if (PH(1)) rms_mod_phase(C, INP(float, 0), INP(float, 3), MOD0, 0, 1024, H);
    GRID_BAR();
    { pg8::Gemm g{H, WRI, TT, 6144, 1024}; pg8::StaticOrder S; S.init(TT, 6144, C.G, (int)blockIdx.x);
      pg8::EpiRetProj E{Qb, Kb, Vb, Gb, cosT, sinT};
#ifdef DUP_G1
      pg8::gemm_phase<pg8::EpiRetProj, pg8::StaticOrder, true, true>(C.lds + RING_OFF, g, S, E); GRID_BAR();
#endif
      if (PH(2)) pg8::gemm_phase<pg8::EpiRetProj, pg8::StaticOrder, true, true>(C.lds + RING_OFF, g, S, E); }
    GRID_BAR();
    #ifdef USE_SCAN_NAIVE
    if (PH(3)) scan_naive(C, Qb, Kb, Vb, CROSS);
#else
#ifdef DUP_SCAN
    scan_mfma<DUP_SCAN>(C, Qb, Kb, Vb, CROSS);
    GRID_BAR();
#endif
    if (C.vcu < SCAN_NIT) { if (PH(3)) scan_mfma<0>(C, Qb, Kb, Vb, CROSS); }
    else { P0In I; I.c = nullptr; I.ada_w = nullptr; I.ada_b = nullptr; I.ret_w_in = nullptr; I.ret_w_out = nullptr; I.sgu_w_in = INP(float, 9); I.sgu_w_out = INP(float, 15); I.wq = INP(float, 16); I.keys = nullptr; I.pu = INP(float, 18); I.pv = INP(float, 19); I.pos = nullptr;
      side_work(C, I, SCAN_NIT); }
#endif
    GRID_BAR();
#ifdef USE_INTRA_NAIVE
    if (PH(4)) intra_naive(C, Qb, Kb, Vb, CROSS, Gb);
#else
    if (PH(4)) intra_mfma(C, Qb, Kb, Vb, CROSS, Gb);
#endif
    GRID_BAR();
    { pg8::Gemm g{Gb, WRO, TT, 1024, 2048}; pg8::StaticOrder S; S.init(TT, 1024, C.G, (int)blockIdx.x);
      pg8::EpiResGate E{INP(float, 0), out, MOD0 + 2048, 6144};
      if (PH(5)) pg8::gemm_phase<pg8::EpiResGate, pg8::StaticOrder, true, true>(C.lds + RING_OFF, g, S, E); }
    GRID_BAR();
    if (PH(6)) rms_mod_phase(C, out, INP(float, 4), MOD0, 3072, 4096, H);
    GRID_BAR();
    { pg8::Gemm g{H, WQ, TT, 2048, 1024}; pg8::StaticOrder S; S.init(TT, 2048, C.G, (int)blockIdx.x);
      pg8::EpiBf16<0> E{QP, 2048, nullptr, 0, 0, 1.f};
      if (PH(7)) pg8::gemm_phase<pg8::EpiBf16<0>, pg8::StaticOrder, true, true>(C.lds + RING_OFF, g, S, E); }
    GRID_BAR();
#ifdef USE_TOPK_NAIVE
    if (PH(8)) peer_scores(C, QP, KEYS, SCO);
    GRID_BAR();
    if (PH(9)) peer_topk(C, SCO, IDX, GATE);
#else
#ifdef DUP_TOPK
    peer_topk_fused<DUP_TOPK>(C, QP, KEYS, IDX, GATE);
    GRID_BAR();
#endif
    if (PH(9)) peer_topk_fused<0>(C, QP, KEYS, IDX, GATE);
#endif
    GRID_BAR();
#ifdef DUP_GATHER
    GATHER_FN<false, DUP_GATHER_FAKE, DUP_GATHER_SKIP>(C, H, IDX, GATE, PU8, PV8, ISU, ISV, (float*)(ws + WS_R), MOD0 + 5120, INP(float, 3) + 1024, MOD1, (bf16*)(ws + WS_R + 128 * MiB));
    GRID_BAR();
#endif
    if (PH(10)) GATHER_FN<false>(C, H, IDX, GATE, PU8, PV8, ISU, ISV, out, MOD0 + 5120, INP(float, 3) + 1024, MOD1, H);
    GRID_BAR();
#ifdef DUP_BAR
    for (int q_ = 0; q_ < 10; ++q_) GRID_BAR();
#endif
    { pg8::Gemm g{H, WSI, TT, 6144, 1024}; pg8::StaticOrder S; S.init(TT, 6144, C.G, (int)blockIdx.x);
      pg8::EpiSguIn E{Ub, VBb, INP(float, 10), STATS};
#ifdef DUP_G7
      pg8::gemm_phase<pg8::EpiSguIn, pg8::StaticOrder, true, true>(C.lds + RING_OFF, g, S, E); GRID_BAR();
#endif
      if (PH(11)) pg8::gemm_phase<pg8::EpiSguIn, pg8::StaticOrder, true, true>(C.lds + RING_OFF, g, S, E); }
    GRID_BAR();
    if (PH(12)) SGU_GATE_FN(C, Ub, VBb, STATS, INP(float, 13), INP(float, 14), INP(float, 11), INP(float, 12));
    GRID_BAR();
    { pg8::Gemm g{Ub, WSO, TT, 1024, 3072}; pg8::StaticOrder S; S.init(TT, 1024, C.G, (int)blockIdx.x);
      pg8::EpiResGate E{out, out, MOD1 + 2048, 6144};
      if (PH(13)) pg8::gemm_phase<pg8::EpiResGate, pg8::StaticOrder, true, true>(C.lds + RING_OFF, g, S, E); }
    GRID_BAR();
    if (PH(14)) rms_mod_phase(C, out, INP(float, 4) + 1024, MOD1, 3072, 4096, H);
    GRID_BAR();
    { pg8::Gemm g{H, WQ + (size_t)2048 * 1024, TT, 2048, 1024}; pg8::StaticOrder S; S.init(TT, 2048, C.G, (int)blockIdx.x);
      pg8::EpiBf16<0> E{QP, 2048, nullptr, 0, 0, 1.f};
      if (PH(15)) pg8::gemm_phase<pg8::EpiBf16<0>, pg8::StaticOrder, true, true>(C.lds + RING_OFF, g, S, E); }
    GRID_BAR();
#ifdef USE_TOPK_NAIVE
    if (PH(16)) peer_scores(C, QP, KEYS + (size_t)8 * 2 * 128 * 128, SCO);
    GRID_BAR();
    if (PH(17)) peer_topk(C, SCO, IDX, GATE);
#else
    if (PH(17)) peer_topk_fused<0>(C, QP, KEYS + (size_t)8 * 2 * 128 * 128, IDX, GATE);
#endif
    GRID_BAR();
    if (PH(18)) GATHER_FN<true>(C, H, IDX, GATE, PU8 + (size_t)16384 * 1024, PV8 + (size_t)16384 * 1024, ISU + 16384, ISV + 16384, out, MOD1 + 5120, INP(float, 20), nullptr, nullptr);
#undef GRID_BAR
}

extern "C" void kernel_launch(void* const* d_in, const int* in_sizes, int n_in, void* d_out, int out_size, void* d_ws, size_t ws_size, hipStream_t stream) {
    static int grid = 0;
    if (grid == 0) {
        if (n_in != 21 || in_sizes[0] != TT * DM || out_size != TT * DM || ws_size < WS_END) { fprintf(stderr, "kernel_launch: unexpected shapes/workspace: n_in %d in0 %d out %d ws %zu (need %zu)\n", n_in, n_in > 0 ? in_sizes[0] : -1, out_size, ws_size, (size_t)WS_END); grid = -1; return; }
        int dev = 0, cus = 0;
        if (hipGetDevice(&dev) != hipSuccess || hipDeviceGetAttribute(&cus, hipDeviceAttributeMultiprocessorCount, dev) != hipSuccess) { fprintf(stderr, "kernel_launch: device query failed\n"); grid = -1; return; }
        if (hipFuncSetAttribute((const void*)mk_fwd, hipFuncAttributeMaxDynamicSharedMemorySize, LDS_BYTES) != hipSuccess) { fprintf(stderr, "kernel_launch: hipFuncSetAttribute failed\n"); grid = -1; return; }
        (void)hipGetLastError();
        grid = cus;
    }
    if (grid < 0) return;
    if (hipMemsetAsync((char*)d_ws + WS_CTL, 0, CTL_ZERO_BYTES, stream) != hipSuccess) { fprintf(stderr, "kernel_launch: memset failed\n"); return; }
    Args a; memset(&a, 0, sizeof(a));
    for (int i = 0; i < 21; ++i) a.in[i] = d_in[i];
    a.out = (float*)d_out; a.ws = (unsigned char*)d_ws;
    hipLaunchKernelGGL(mk_fwd, dim3(grid), dim3(NWAVES * 64), LDS_BYTES, stream, a);
    const hipError_t le = hipPeekAtLastError();
    if (le != hipSuccess) fprintf(stderr, "kernel_launch: launch failed: %s\n", hipGetErrorName(le));
}
```

```cpp
#define USE_GATHER_ROUNDS 1
#include <hip/hip_runtime.h>
#include <cstdio>
#include <cstdint>
#include <cstring>
#include <cmath>
namespace pg8 {
#define PG8_LAS __attribute__((address_space(3)))
typedef unsigned short bf16_t;
typedef short bf16x8 __attribute__((ext_vector_type(8)));
typedef float f32x4 __attribute__((ext_vector_type(4)));
typedef unsigned u32x4 __attribute__((ext_vector_type(4)));
constexpr int BM = 256, BK = 64, HALF = 128, HTB = HALF * BK * 2  , STAGE_BYTES = 8 * HTB, NXCD = 8, WGM = 8;

__host__ __device__ __forceinline__ int lds_byte(int r, int c) { const int st = (r >> 4) * 2 + (c >> 5), rr = r & 15, cc = c & 31, ob = rr * 64 + cc * 2; return st * 1024 + (ob ^ (((ob >> 9) & 1) << 5)); }
__host__ __device__ __forceinline__ void stage_rc(int b, int& R, int& C) { const int st = b / 1024, sb = b % 1024, swz = sb ^ (((sb >> 9) & 1) << 5); R = (st >> 1) * 16 + swz / 64; C = (st & 1) * 32 + (swz % 64) / 2; }
__host__ __device__ __forceinline__ int perm32(int rho) { const int n = rho >> 4, i = rho & 15; return 8 * (i >> 2) + 4 * n + (i & 3); }

struct Unit { int pm, pn; };
struct Gemm { const bf16_t* A; const bf16_t* Bt; int M, N, K; };

struct StaticOrder {
    int nM, nN, nwg, G, c;
    __host__ __device__ void init(int M, int N, int G_, int c_) { nM = M / BM; nN = N / BM; nwg = nM * nN; G = G_; c = c_; }
    __host__ __device__ bool next(int i, Unit& u) const {
        const long L = (long)i * G + c; if (L >= nwg) return false;
        int wgid = (int)L; { const int q = nwg / NXCD, r = nwg % NXCD, xcd = wgid % NXCD, off = wgid / NXCD; wgid = (xcd < r ? xcd * (q + 1) : r * (q + 1) + (xcd - r) * q) + off; }
        const int nig = WGM * nN, gid = wgid / nig, fm = gid * WGM, gsz = (nM - fm) < WGM ? (nM - fm) : WGM;
        u.pm = fm + ((wgid % nig) % gsz); u.pn = (wgid % nig) / gsz; return true;
    }
    __device__ __forceinline__ void a_ready(const Unit&) const {}
    __device__ __forceinline__ void done(const Unit&) const {}
};

__device__ __forceinline__ unsigned cvt_pk_bf16(float lo, float hi) { unsigned r; asm volatile("v_cvt_pk_bf16_f32 %0, %1, %2" : "=v"(r) : "v"(lo), "v"(hi)); return r; }
typedef float f32x2 __attribute__((ext_vector_type(2)));
__device__ __forceinline__ f32x2 gelu_pk(f32x2 v) {
    const f32x2 av = __builtin_elementwise_abs(v), d = av * 0.2316418882f + 1.0f;
    f32x2 t; t.x = __builtin_amdgcn_rcpf(d.x); t.y = __builtin_amdgcn_rcpf(d.y);
    f32x2 q = t * 0.5307027145f + (-0.7265760135f); q = q * t + 0.7107068705f; q = q * t + (-0.142248368f); q = q * t + 0.127414796f; q = q * t;
    const f32x2 s = (v * v) * (-0.72134752044f);
    f32x2 e; e.x = __builtin_amdgcn_exp2f(s.x); e.y = __builtin_amdgcn_exp2f(s.y);
    const f32x2 m = v * (q * e), r = v - m;
    f32x2 o; o.x = v.x < 0.f ? m.x : r.x; o.y = v.y < 0.f ? m.y : r.y; return o;
}

template <int ACT  > struct EpiBf16 {
    static constexpr bool PERM = true, AFTER_DRAIN = false; static_assert(ACT == 0 || ACT == 1, "EpiBf16: ACT is 0 (none) or 1 (gelu_pk)");
    bf16_t* O; int ldc; const float* bias; int split_cols; size_t split_stride; float scale0;
    __device__ __forceinline__ void operator()(const f32x4 (&acc)[2][2][4][2], const Unit& u, int wr, int wc, int fr, int fq) const {
        const int row0 = u.pm * BM + wr * 64 + fr; int colt = u.pn * BM; bf16_t* base = O;
        float sc = 1.f; if (split_cols) { const int t = colt / split_cols; base += (size_t)t * split_stride; colt -= t * split_cols; if (t == 0) sc = scale0; }
        const int col0 = colt + wc * 32 + 8 * fq, bcol0 = u.pn * BM + wc * 32 + 8 * fq;
        f32x4 bv[2][2];
#pragma unroll
        for (int bj = 0; bj < 2; ++bj)
#pragma unroll
            for (int n = 0; n < 2; ++n) bv[bj][n] = bias ? *(const f32x4*)(bias + bcol0 + bj * HALF + 4 * n) : (f32x4){0.f, 0.f, 0.f, 0.f};
#pragma unroll
        for (int ai = 0; ai < 2; ++ai)
#pragma unroll
            for (int m = 0; m < 4; ++m) { bf16_t* rowp = base + (size_t)(row0 + ai * HALF + m * 16) * ldc + col0;
#pragma unroll
                for (int bj = 0; bj < 2; ++bj) { f32x4 v0 = acc[ai][bj][m][0] + bv[bj][0], v1 = acc[ai][bj][m][1] + bv[bj][1];
                    if (ACT == 1) { f32x2 a = gelu_pk((f32x2){v0[0], v0[1]}), b = gelu_pk((f32x2){v0[2], v0[3]}), c = gelu_pk((f32x2){v1[0], v1[1]}), d = gelu_pk((f32x2){v1[2], v1[3]});
                        v0 = (f32x4){a.x, a.y, b.x, b.y}; v1 = (f32x4){c.x, c.y, d.x, d.y}; }
                    v0 = v0 * sc; v1 = v1 * sc; u32x4 w; w.x = cvt_pk_bf16(v0[0], v0[1]); w.y = cvt_pk_bf16(v0[2], v0[3]); w.z = cvt_pk_bf16(v1[0], v1[1]); w.w = cvt_pk_bf16(v1[2], v1[3]);
                    *(u32x4*)(rowp + bj * HALF) = w; } }
    }
};
template <class Epi, class Sched, bool ALIGN_EPI = false, bool SP2 = false>
__device__ __forceinline__ void gemm_phase(PG8_LAS unsigned char* lds, const Gemm g, const Sched& S, const Epi& E) {
    int tid_ = threadIdx.x; asm volatile("" : "+v"(tid_));
    const int tid = tid_, wid = __builtin_amdgcn_readfirstlane(tid >> 6), lane = tid & 63, wr = wid >> 2, wc = wid & 3, fr = lane & 15, fq = lane >> 4;
    const int K = g.K, nt = K / BK;
    unsigned voffA[2], voffB[2];
#pragma unroll
    for (int i = 0; i < 2; ++i) { int R, C; stage_rc(tid * 16 + i * 8192, R, C); const int Rb = Epi::PERM ? ((R & ~31) + perm32(R & 31)) : R;
        voffA[i] = (unsigned)(R * K + C) * 2u; voffB[i] = (unsigned)(Rb * K + C) * 2u; }
    const size_t kstep = (size_t)(BK * 2);
    const size_t hstep = (size_t)HALF * K * 2;
    const size_t tstep = 2 * hstep;
    const unsigned ldsw = (unsigned)wid * 1024u;
    const int aoff = lds_byte(wr * 64 + fr, fq * 8), boff = lds_byte(wc * 32 + fr, fq * 8);
#define PG8_SA(b, h) (((b) * 2 + (h)) * HTB)
#define PG8_SB(b, h) ((4 + (b) * 2 + (h)) * HTB)
#define PG8_STAGE(bufoff, gbase, voff) do { _Pragma("unroll") for (int _i = 0; _i < 2; ++_i) \
        __builtin_amdgcn_global_load_lds((const unsigned*)((const char*)(gbase) + (voff)[_i]), (PG8_LAS unsigned*)(lds + (bufoff) + ldsw + _i * 8192), 16, 0, 0); } while (0)
#define PG8_LDA(dst, b, h) do { _Pragma("unroll") for (int m = 0; m < 4; ++m) _Pragma("unroll") for (int k = 0; k < 2; ++k) dst[m][k] = *(const PG8_LAS bf16x8*)(lds + PG8_SA(b, h) + aoff + m * 2048 + k * 1024); } while (0)
#define PG8_LDB(dst, b, h) do { _Pragma("unroll") for (int n = 0; n < 2; ++n) _Pragma("unroll") for (int k = 0; k < 2; ++k) dst[n][k] = *(const PG8_LAS bf16x8*)(lds + PG8_SB(b, h) + boff + n * 2048 + k * 1024); } while (0)
#define PG8_MMA(ai, bj, At, Bt) do { __builtin_amdgcn_s_setprio(1); _Pragma("unroll") for (int m = 0; m < 4; ++m) _Pragma("unroll") for (int n = 0; n < 2; ++n) _Pragma("unroll") for (int k = 0; k < 2; ++k) \
        acc[ai][bj][m][n] = __builtin_amdgcn_mfma_f32_16x16x32_bf16(Bt[n][k], At[m][k], acc[ai][bj][m][n], 0, 0, 0); __builtin_amdgcn_s_setprio(0); } while (0)
#define PG8_WAIT_V(n) asm volatile("s_waitcnt vmcnt(" #n ")" ::: "memory")
#define PG8_WAIT_L(n) asm volatile("s_waitcnt lgkmcnt(" #n ")" ::: "memory")
#define PG8_BAR __builtin_amdgcn_s_barrier()
#define PG8_SCHED __builtin_amdgcn_sched_barrier(0)
    Unit cur, nxt; int ui = 0;
    if (!S.next(0, cur)) return;
    f32x4 acc[2][2][4][2];
#pragma unroll
    for (int a = 0; a < 2; ++a)
#pragma unroll
        for (int b = 0; b < 2; ++b)
#pragma unroll
            for (int m = 0; m < 4; ++m)
#pragma unroll
                for (int n = 0; n < 2; ++n) acc[a][b][m][n] = (f32x4){0.f, 0.f, 0.f, 0.f};
    bf16x8 At[4][2], B0[2][2], B1[2][2];
    const char* cA = (const char*)g.A + (size_t)cur.pm * tstep; const char* cB = (const char*)g.Bt + (size_t)cur.pn * tstep;
    S.a_ready(cur);
    if constexpr (SP2) {
        PG8_STAGE(PG8_SB(0, 0), cB, voffB); PG8_STAGE(PG8_SB(0, 1), cB + hstep, voffB); PG8_STAGE(PG8_SA(0, 0), cA, voffA); PG8_STAGE(PG8_SA(0, 1), cA + hstep, voffA);
        if (wr == 1) PG8_BAR;
        PG8_WAIT_V(2); PG8_BAR;
        PG8_STAGE(PG8_SB(1, 0), cB + kstep, voffB); PG8_STAGE(PG8_SA(1, 0), cA + kstep, voffA); PG8_STAGE(PG8_SB(1, 1), cB + hstep + kstep, voffB);
        PG8_WAIT_V(6); PG8_BAR;
    } else {
        PG8_STAGE(PG8_SB(0, 0), cB, voffB); PG8_STAGE(PG8_SA(0, 0), cA, voffA); PG8_STAGE(PG8_SB(0, 1), cB + hstep, voffB); PG8_STAGE(PG8_SA(0, 1), cA + hstep, voffA);
        if (wr == 1) PG8_BAR;
        PG8_WAIT_V(4); PG8_BAR;
        PG8_STAGE(PG8_SB(1, 0), cB + kstep, voffB); PG8_STAGE(PG8_SA(1, 0), cA + kstep, voffA); PG8_STAGE(PG8_SB(1, 1), cB + hstep + kstep, voffB);
        PG8_WAIT_V(6); PG8_BAR;
    }
    for (;;) {
        const bool has_next = S.next(ui + 1, nxt);
        const char* nA = has_next ? (const char*)g.A + (size_t)nxt.pm * tstep : cA; const char* nB = has_next ? (const char*)g.Bt + (size_t)nxt.pn * tstep : cB;
        for (int t = 0; t < nt; t += 2) {
            const bool last = (t == nt - 2);
            const char* a1 = cA + (size_t)(t + 1) * kstep;
            const char* a2 = last ? nA : cA + (size_t)(t + 2) * kstep; const char* b2 = last ? nB : cB + (size_t)(t + 2) * kstep;
            const char* a3 = a2 + kstep; const char* b3 = b2 + kstep;
            if (last && has_next) S.a_ready(nxt);
            if constexpr (SP2) {
            PG8_LDB(B0, 0, 0); PG8_LDB(B1, 0, 1); PG8_SCHED; PG8_LDA(At, 0, 0); PG8_STAGE(PG8_SA(1, 1), a1 + hstep, voffA);
            PG8_WAIT_V(8); PG8_WAIT_L(0); PG8_BAR; PG8_MMA(0, 0, At, B0); PG8_MMA(0, 1, At, B1); PG8_BAR; PG8_SCHED;
            PG8_LDA(At, 0, 1); PG8_STAGE(PG8_SB(0, 0), b2, voffB); PG8_STAGE(PG8_SB(0, 1), b2 + hstep, voffB); PG8_STAGE(PG8_SA(0, 0), a2, voffA);
            PG8_WAIT_V(8); PG8_WAIT_L(0); PG8_BAR; PG8_MMA(1, 0, At, B0); PG8_MMA(1, 1, At, B1); PG8_BAR; PG8_SCHED;
            PG8_LDB(B0, 1, 0); PG8_LDB(B1, 1, 1); PG8_SCHED; PG8_LDA(At, 1, 0); PG8_STAGE(PG8_SA(0, 1), a2 + hstep, voffA);
            PG8_WAIT_V(8); PG8_WAIT_L(0); PG8_BAR; PG8_MMA(0, 0, At, B0); PG8_MMA(0, 1, At, B1); PG8_BAR; PG8_SCHED;
            PG8_LDA(At, 1, 1); PG8_STAGE(PG8_SB(1, 0), b3, voffB); PG8_STAGE(PG8_SB(1, 1), b3 + hstep, voffB); PG8_STAGE(PG8_SA(1, 0), a3, voffA);
            PG8_WAIT_V(8); PG8_WAIT_L(0); PG8_BAR; PG8_MMA(1, 0, At, B0); PG8_MMA(1, 1, At, B1); PG8_BAR; PG8_SCHED;
            } else {
            PG8_LDB(B0, 0, 0); PG8_SCHED; PG8_LDA(At, 0, 0); PG8_STAGE(PG8_SA(1, 1), a1 + hstep, voffA);
            PG8_WAIT_L(8); PG8_BAR; PG8_WAIT_L(0); PG8_MMA(0, 0, At, B0); PG8_BAR; PG8_SCHED;
            PG8_LDB(B1, 0, 1); PG8_STAGE(PG8_SB(0, 0), b2, voffB);
            PG8_BAR; PG8_WAIT_L(0); PG8_MMA(0, 1, At, B1); PG8_BAR;
            PG8_LDA(At, 0, 1); PG8_STAGE(PG8_SA(0, 0), a2, voffA);
            PG8_BAR; PG8_WAIT_L(0); PG8_MMA(1, 0, At, B0); PG8_BAR; PG8_SCHED;
            PG8_STAGE(PG8_SB(0, 1), b2 + hstep, voffB);
            PG8_WAIT_V(6); PG8_BAR; PG8_MMA(1, 1, At, B1); PG8_BAR;
            PG8_LDB(B0, 1, 0); PG8_SCHED; PG8_LDA(At, 1, 0); PG8_STAGE(PG8_SA(0, 1), a2 + hstep, voffA);
            PG8_WAIT_L(8); PG8_BAR; PG8_WAIT_L(0); PG8_MMA(0, 0, At, B0); PG8_BAR; PG8_SCHED;
            PG8_LDB(B1, 1, 1); PG8_STAGE(PG8_SB(1, 0), b3, voffB);
            PG8_BAR; PG8_WAIT_L(0); PG8_MMA(0, 1, At, B1); PG8_BAR;
            PG8_LDA(At, 1, 1); PG8_STAGE(PG8_SA(1, 0), a3, voffA);
            PG8_BAR; PG8_WAIT_L(0); PG8_MMA(1, 0, At, B0); PG8_BAR; PG8_SCHED;
            PG8_STAGE(PG8_SB(1, 1), b3 + hstep, voffB);
            PG8_WAIT_V(6); PG8_BAR; PG8_MMA(1, 1, At, B1); PG8_BAR;
            }
        }
        if constexpr (ALIGN_EPI) { if (wr == 0) PG8_BAR; }
        if constexpr (!Epi::AFTER_DRAIN) { E(acc, cur, wr, wc, fr, fq); S.done(cur); }
        if (!has_next) break;
#pragma unroll
        for (int a = 0; a < 2; ++a)
#pragma unroll
            for (int b = 0; b < 2; ++b)
#pragma unroll
                for (int m = 0; m < 4; ++m)
#pragma unroll
                    for (int n = 0; n < 2; ++n) acc[a][b][m][n] = (f32x4){0.f, 0.f, 0.f, 0.f};
        cur = nxt; cA = nA; cB = nB; ++ui;
        if constexpr (ALIGN_EPI) { if (wr == 1) PG8_BAR; }
    }
    PG8_WAIT_V(0);
    if constexpr (!ALIGN_EPI) { if (wr == 0) PG8_BAR; }
    PG8_BAR;
    if constexpr (Epi::AFTER_DRAIN) { E.fused(acc, cur, wr, wc, fr, fq, lds, wid, lane); S.done(cur); }
#undef PG8_SA
#undef PG8_SB
#undef PG8_STAGE
#undef PG8_LDA
#undef PG8_LDB
#undef PG8_MMA
#undef PG8_WAIT_V
#undef PG8_WAIT_L
#undef PG8_BAR
#undef PG8_SCHED
}
}
namespace pg8 {
typedef unsigned u32x2 __attribute__((ext_vector_type(2)));
__device__ __forceinline__ float gelu_tanh(float x) {
    const float e = __builtin_amdgcn_exp2f(x * (-2.302208198f - 0.1029432397f * x * x));
    return x * __builtin_amdgcn_rcpf(1.0f + e);
}
__device__ __forceinline__ float silu_f(float x) { return x * __builtin_amdgcn_rcpf(1.0f + __builtin_amdgcn_exp2f(-1.4426950409f * x)); }

typedef _Float16 eh2_t __attribute__((ext_vector_type(2)));
struct EpiRetProj {
    static constexpr bool PERM = true, AFTER_DRAIN = false;
    bf16_t *Q, *K, *V, *G; const unsigned* trig;
    __device__ __forceinline__ void operator()(const f32x4 (&acc)[2][2][4][2], const Unit& u, int wr, int wc, int fr, int fq) const {
        const int pn = u.pn;
        if (pn < 8) {
            bf16_t* dst = pn < 4 ? Q : K; const int head = pn & 3; const float sc = pn < 4 ? 1.0f : 0.0625f;
            const int f0 = wc * 32 + 8 * fq;
#pragma unroll
            for (int ai = 0; ai < 2; ++ai) {
                u32x4 tg[4][2];
#pragma unroll
                for (int m = 0; m < 4; ++m) { const int row = u.pm * BM + ai * HALF + wr * 64 + m * 16 + fr; const unsigned* tp = trig + (size_t)row * 128 + f0;
                    tg[m][0] = *(const u32x4*)tp; tg[m][1] = *(const u32x4*)(tp + 4); }
#pragma unroll
                for (int m = 0; m < 4; ++m) {
                    const int row = u.pm * BM + ai * HALF + wr * 64 + m * 16 + fr;
                    u32x4 w1, w2;
#pragma unroll
                    for (int n = 0; n < 2; ++n) {
                        const f32x4 x1 = acc[ai][0][m][n], x2 = acc[ai][1][m][n]; float o1[4], o2[4];
#pragma unroll
                        for (int j = 0; j < 4; ++j) { const unsigned tw = tg[m][n][j]; const float c = (float)__builtin_bit_cast(_Float16, (unsigned short)(tw & 0xffffu)) * sc, sn = (float)__builtin_bit_cast(_Float16, (unsigned short)(tw >> 16)) * sc;
                            o1[j] = x1[j] * c - x2[j] * sn; o2[j] = x1[j] * sn + x2[j] * c; }
                        w1[2 * n] = cvt_pk_bf16(o1[0], o1[1]); w1[2 * n + 1] = cvt_pk_bf16(o1[2], o1[3]); w2[2 * n] = cvt_pk_bf16(o2[0], o2[1]); w2[2 * n + 1] = cvt_pk_bf16(o2[2], o2[3]);
                    }
                    bf16_t* p = dst + (size_t)row * 1024 + head * 256 + f0;
                    *(u32x4*)p = w1; *(u32x4*)(p + 128) = w2;
                }
            }
        } else {
            const bool isg = pn >= 16; bf16_t* dst = isg ? G : V; const int colbase = ((pn - 8) & 7) * 256 + wc * 32 + 8 * fq;
#pragma unroll
            for (int ai = 0; ai < 2; ++ai)
#pragma unroll
                for (int m = 0; m < 4; ++m) {
                    const int row = u.pm * BM + ai * HALF + wr * 64 + m * 16 + fr;
#pragma unroll
                    for (int bj = 0; bj < 2; ++bj) {
                        f32x4 v0 = acc[ai][bj][m][0], v1 = acc[ai][bj][m][1];
                        if (isg) {
#pragma unroll
                            for (int j = 0; j < 4; ++j) { v0[j] = silu_f(v0[j]); v1[j] = silu_f(v1[j]); } }
                        u32x4 w; w.x = cvt_pk_bf16(v0[0], v0[1]); w.y = cvt_pk_bf16(v0[2], v0[3]); w.z = cvt_pk_bf16(v1[0], v1[1]); w.w = cvt_pk_bf16(v1[2], v1[3]);
                        *(u32x4*)(dst + (size_t)row * 2048 + colbase + bj * HALF) = w;
                    }
                }
        }
    }
};
struct EpiResGate {
    static constexpr bool PERM = false, AFTER_DRAIN = false;
    const float* base; float* out; const float* gate; int gstride;
    __device__ __forceinline__ void operator()(const f32x4 (&acc)[2][2][4][2], const Unit& u, int wr, int wc, int fr, int fq) const {
        const int b = (u.pm * BM) >> 13; const float* gp = gate + (size_t)b * gstride;
        const int col0 = u.pn * BM + wc * 32 + 4 * fq;
        f32x4 gv[2][2];
#pragma unroll
        for (int bj = 0; bj < 2; ++bj)
#pragma unroll
            for (int n = 0; n < 2; ++n) gv[bj][n] = *(const f32x4*)(gp + col0 + bj * HALF + n * 16);
#pragma unroll
        for (int ai = 0; ai < 2; ++ai)
#pragma unroll
            for (int m = 0; m < 4; ++m) {
                const size_t off = (size_t)(u.pm * BM + ai * HALF + wr * 64 + m * 16 + fr) * 1024 + col0;
#pragma unroll
                for (int bj = 0; bj < 2; ++bj)
#pragma unroll
                    for (int n = 0; n < 2; ++n) { const f32x4 bs = *(const f32x4*)(base + off + bj * HALF + n * 16); *(f32x4*)(out + off + bj * HALF + n * 16) = bs + gv[bj][n] * acc[ai][bj][m][n]; }
            }
    }
};
struct EpiSguIn {
    static constexpr bool PERM = true, AFTER_DRAIN = false;
    bf16_t* U; bf16_t* Vb; const float* bias; float* stats;
    __device__ __forceinline__ void operator()(const f32x4 (&acc)[2][2][4][2], const Unit& u, int wr, int wc, int fr, int fq) const {
        const bool isv = u.pn >= 12; bf16_t* base = isv ? Vb : U; const int colt = (isv ? u.pn - 12 : u.pn) * BM;
        const int col0 = colt + wc * 32 + 8 * fq, bcol0 = u.pn * BM + wc * 32 + 8 * fq;
        f32x4 bv[2][2];
#pragma unroll
        for (int bj = 0; bj < 2; ++bj)
#pragma unroll
            for (int n = 0; n < 2; ++n) bv[bj][n] = *(const f32x4*)(bias + bcol0 + bj * HALF + 4 * n);
#pragma unroll
        for (int ai = 0; ai < 2; ++ai)
#pragma unroll
            for (int m = 0; m < 4; ++m) {
                const int row = u.pm * BM + ai * HALF + wr * 64 + m * 16 + fr;
                bf16_t* rowp = base + (size_t)row * 3072 + col0;
                float s1 = 0.f, s2 = 0.f;
#pragma unroll
                for (int bj = 0; bj < 2; ++bj) {
                    f32x4 v0 = acc[ai][bj][m][0] + bv[bj][0], v1 = acc[ai][bj][m][1] + bv[bj][1];
#pragma unroll
                    for (int j = 0; j < 4; ++j) { v0[j] = gelu_tanh(v0[j]); v1[j] = gelu_tanh(v1[j]); }
                    u32x4 w; w.x = cvt_pk_bf16(v0[0], v0[1]); w.y = cvt_pk_bf16(v0[2], v0[3]); w.z = cvt_pk_bf16(v1[0], v1[1]); w.w = cvt_pk_bf16(v1[2], v1[3]);
                    *(u32x4*)(rowp + bj * HALF) = w;
                    if (isv) {
#pragma unroll
                        for (int j = 0; j < 4; ++j) { const unsigned ww = j == 0 ? w.x : j == 1 ? w.y : j == 2 ? w.z : w.w;
                            const float a = __uint_as_float(ww << 16), bq = __uint_as_float(ww & 0xffff0000u); s1 += a + bq; s2 += a * a + bq * bq; }
                    }
                }
                if (isv) {
                    s1 += __shfl_xor(s1, 16); s1 += __shfl_xor(s1, 32); s2 += __shfl_xor(s2, 16); s2 += __shfl_xor(s2, 32);
                    if (fq == 0) { float* sp = stats + ((size_t)row * 48 + (u.pn - 12) * 4 + wc) * 2; sp[0] = s1; sp[1] = s2; }
                }
            }
    }
};
}
typedef unsigned u32x4 __attribute__((ext_vector_type(4)));
#define GAS __attribute__((address_space(1)))
#define LAS __attribute__((address_space(3)))
typedef unsigned short bf16;
typedef unsigned v4u __attribute__((ext_vector_type(4)));
typedef float f32x4 __attribute__((ext_vector_type(4)));
typedef short bf16x8 __attribute__((ext_vector_type(8)));
typedef GAS unsigned gu32;
typedef GAS unsigned long long gu64;
#define RLX_AGENT __ATOMIC_RELAXED, __HIP_MEMORY_SCOPE_AGENT
#define LDS_WAIT() asm volatile("s_waitcnt lgkmcnt(0)" ::: "memory")
#define VM_WAIT() asm volatile("s_waitcnt vmcnt(0)" ::: "memory")
__device__ __forceinline__ unsigned long long rt() { return __builtin_amdgcn_s_memrealtime(); }
__device__ __forceinline__ unsigned f2bf(float f) { unsigned u = __builtin_bit_cast(unsigned, f); return (u + 0x7fffu + ((u >> 16) & 1u)) >> 16; }
__device__ __forceinline__ unsigned pk2(float lo, float hi) { return f2bf(lo) | (f2bf(hi) << 16); }

#define XB_TMO      128
#define XB_XCNT(j)  (256  + 64 * (j))
#define XB_XSUB(j)  (1280 + 64 * (j))
#define XB_XGEN(j)  (2304 + 64 * (j))
#define XB_TOP      3328
#define XB_TOPGEN   3392
#define XCD_BAR_WORDS 3456
#define XB_SPIN_CAP (1u << 18)

__device__ __forceinline__ unsigned xb_ld(unsigned* p)              { return __hip_atomic_load(p, __ATOMIC_RELAXED, __HIP_MEMORY_SCOPE_AGENT); }
__device__ __forceinline__ unsigned xb_add(unsigned* p, unsigned v) { return __hip_atomic_fetch_add(p, v, __ATOMIC_RELAXED, __HIP_MEMORY_SCOPE_AGENT); }
__device__ __forceinline__ unsigned xb_xcc_id() { return (unsigned)__builtin_amdgcn_s_getreg((3 << 11) | 20) & 0xFu; }
#define XB_SPIN(cond, bar) do { unsigned _sp = 0; while (cond) { __builtin_amdgcn_s_sleep(1); \
    if ((++_sp & 255u) == 0u) { if (xb_ld(&(bar)[XB_TMO])) break; if (_sp > XB_SPIN_CAP) { atomicAdd(&(bar)[XB_TMO], 1u); break; } } } } while (0)

struct XcdBarrier {
    unsigned* bar; unsigned x;
    volatile LAS unsigned* st;
};

__device__ __forceinline__ XcdBarrier xcd_barrier_post(unsigned* bar, volatile LAS unsigned* st) {
    XcdBarrier b; b.bar = bar; b.x = xb_xcc_id(); b.st = st;
    if (threadIdx.x == 0) (void)xb_add(&bar[XB_XCNT(b.x)], 1u);
    return b;
}
__device__ __forceinline__ void xcd_barrier_complete(unsigned* bar, unsigned x, unsigned& nloc, unsigned& nx) {
    const unsigned G = gridDim.x * gridDim.y * gridDim.z;
    unsigned sum, cnt, mine, sp = 0u;
    for (;;) {
        sum = 0u; cnt = 0u; mine = 0u;
#pragma unroll
        for (unsigned j = 0; j < 16; ++j) { const unsigned c = xb_ld(&bar[XB_XCNT(j)]); sum += c; cnt += (c > 0u) ? 1u : 0u; mine = (j == x) ? c : mine; }
        if (sum == G) break;
        __builtin_amdgcn_s_sleep(1);
        if ((++sp & 255u) == 0u) { if (xb_ld(&bar[XB_TMO])) break; if (sp > XB_SPIN_CAP) { atomicAdd(&bar[XB_TMO], 1u); break; } }
    }
    nloc = mine > 0u ? mine : 1u; nx = cnt > 0u ? cnt : 1u;
}

__device__ __forceinline__ void xcd_barrier(const XcdBarrier& b) {
    asm volatile("s_waitcnt vmcnt(0)" ::: "memory");
    __syncthreads();
    if (threadIdx.x == 0) {
        unsigned* bar = b.bar;
        __builtin_amdgcn_s_waitcnt(0);
        unsigned nloc = b.st[0], nx = b.st[1];
        if (nloc == 0u) { xcd_barrier_complete(bar, b.x, nloc, nx); b.st[0] = nloc; b.st[1] = nx; }
        const unsigned old = xb_add(&bar[XB_XSUB(b.x)], 1u);
        const unsigned gen = old / nloc;
        if (old + 1u == (gen + 1u) * nloc) {
            __builtin_amdgcn_fence(__ATOMIC_RELEASE, "agent");
            asm volatile("s_waitcnt vmcnt(0)" ::: "memory");
            const unsigned og = xb_add(&bar[XB_TOP], 1u);
            const unsigned tg = og / nx;
            if (og + 1u == (tg + 1u) * nx) xb_add(&bar[XB_TOPGEN], 1u);
            else XB_SPIN(xb_ld(&bar[XB_TOPGEN]) == tg, bar);
            __builtin_amdgcn_fence(__ATOMIC_ACQUIRE, "agent");
            xb_add(&bar[XB_XGEN(b.x)], 1u);
            asm volatile("s_waitcnt vmcnt(0)" ::: "memory");
        } else {
            XB_SPIN(xb_ld(&bar[XB_XGEN(b.x)]) == gen, bar);
            __builtin_amdgcn_fence(__ATOMIC_ACQUIRE, "agent");
            asm volatile("s_waitcnt vmcnt(0)" ::: "memory");
        }
    }
    __syncthreads();
}
__device__ __forceinline__ float wave_sum(float v) {
#pragma unroll
    for (int o = 1; o < 64; o <<= 1) v += __shfl_xor(v, o);
    return v;
}
__device__ __forceinline__ void p0_transpose_item(const float* W, int K, int N, bf16* WT, int row_off, LAS float* scr, int item, int lane) {
    const int nblk = N / 32, kb = item / nblk, nb = item % nblk, k0 = 64 * kb, n0 = 32 * nb;
#pragma unroll 8
    for (int i = 0; i < 32; ++i) { const int kk = 2 * i + (lane >> 5); scr[kk * 33 + (lane & 31)] = W[(size_t)(k0 + kk) * N + n0 + (lane & 31)]; }
    LDS_WAIT(); asm volatile("" ::: "memory");
    const int c = lane & 7;
#pragma unroll
    for (int j = 0; j < 4; ++j) { const int n = (lane >> 3) + 8 * j; const LAS float* s = scr + (8 * c) * 33 + n;
        v4u o; o.x = pk2(s[0 * 33], s[1 * 33]); o.y = pk2(s[2 * 33], s[3 * 33]); o.z = pk2(s[4 * 33], s[5 * 33]); o.w = pk2(s[6 * 33], s[7 * 33]);
        *(GAS v4u*)(WT + (size_t)(row_off + n0 + n) * K + k0 + 8 * c) = o; }
    LDS_WAIT(); asm volatile("" ::: "memory");
}
#define DI __device__ __forceinline__
constexpr int NWAVES = 8;
constexpr int TT = 16384, DM = 1024, SEQ = 8192;
constexpr size_t MiB = 1u << 20;
constexpr size_t WS_CTL = 0, CTL_ZERO_BYTES = 32768, WS_MOD = 512 * 1024;
constexpr size_t WS_COS = 2 * MiB, WS_SIN = 10 * MiB;
constexpr size_t WS_WRI = 18 * MiB, WS_WRO = 30 * MiB, WS_WSI = 34 * MiB, WS_WSO = 46 * MiB, WS_WQ = 52 * MiB, WS_KEYS = 60 * MiB;
constexpr size_t WS_ISU = 61 * MiB, WS_ISV = 61 * MiB + 256 * 1024;
constexpr size_t WS_STATS = 62 * MiB, WS_IDX = 68 * MiB, WS_GATE = 76 * MiB, WS_H = 84 * MiB, WS_PU = 116 * MiB, WS_PV = 180 * MiB;
constexpr size_t WS_R = 244 * MiB;
constexpr size_t WS_Q = WS_R, WS_K = WS_R + 32 * MiB, WS_V = WS_R + 64 * MiB, WS_G = WS_R + 128 * MiB, WS_CROSS = WS_R + 192 * MiB;
constexpr size_t WS_QP = WS_R, WS_SC = WS_R + 64 * MiB;
constexpr size_t WS_U = WS_R, WS_VB = WS_R + 96 * MiB;
constexpr size_t WS_END = 500 * MiB;
constexpr int CW_TMO = 0, CW_BAR = 4096;
constexpr int RING_OFF = 0, RING_BYTES = 131072, LDS_BYTES = 163840, LDSCTL_OFF = LDS_BYTES - 1024, MISC_OFF = LDSCTL_OFF + 320;
constexpr int PTR_OFF = LDSCTL_OFF + 512;
constexpr float EPS = 1e-6f;
typedef float f32x2_t __attribute__((ext_vector_type(2)));

DI float bf2f(bf16 h) { return __uint_as_float((unsigned)h << 16); }
DI float bflo(unsigned w) { return __uint_as_float(w << 16); }
DI float bfhi(unsigned w) { return __uint_as_float(w & 0xffff0000u); }
DI float wave_max(float v) {
#pragma unroll
    for (int o = 1; o < 64; o <<= 1) v = fmaxf(v, __shfl_xor(v, o));
    return v;
}
DI float gelu_t(float x) { return pg8::gelu_tanh(x); }

struct Ctx {
    LAS unsigned char* lds; int tid, lane, wave, vcu, G;
    unsigned char* ws;
};

DI const void* ldp(const Ctx& C, int i) {
    const unsigned long long v = ((const LAS unsigned long long*)(C.lds + PTR_OFF))[i];
    const unsigned lo = __builtin_amdgcn_readfirstlane((unsigned)v), hi = __builtin_amdgcn_readfirstlane((unsigned)(v >> 32));
    return (const void*)(((unsigned long long)hi << 32) | lo);
}
DI void cvt_rows_fp8(const float* src, unsigned char* dst, float* inv_scale, int nrows, int gw, int NGW, int lane) {
    for (int r = gw; r < nrows; r += NGW) {
        const f32x4* s = (const f32x4*)(src + (size_t)r * 1024) + lane * 4;
        f32x4 v[4]; float am = 0.f;
#pragma unroll
        for (int q = 0; q < 4; ++q) { v[q] = s[q]; am = fmaxf(am, fmaxf(fmaxf(fabsf(v[q][0]), fabsf(v[q][1])), fmaxf(fabsf(v[q][2]), fabsf(v[q][3])))); }
        am = wave_max(am);
        const int e = (int)((__float_as_uint(am) >> 23) & 0xffu) - 127;
        const bool ok = am > 1e-30f;
        const float sc = ok ? __uint_as_float((unsigned)(127 + 7 - e) << 23) : 1.0f, isc = ok ? __uint_as_float((unsigned)(127 - 7 + e) << 23) : 1.0f;
        u32x4 o;
#pragma unroll
        for (int q = 0; q < 4; ++q) { int wd = __builtin_amdgcn_cvt_pk_fp8_f32(v[q][0] * sc, v[q][1] * sc, 0, false); wd = __builtin_amdgcn_cvt_pk_fp8_f32(v[q][2] * sc, v[q][3] * sc, wd, true); o[q] = (unsigned)wd; }
        *(u32x4*)(dst + (size_t)r * 1024 + lane * 16) = o;
        if (lane == 0) inv_scale[r] = isc;
    }
}
DI void cvt_rows_i8(const float* src, unsigned char* dst, float* inv_scale, int nrows, int gw, int NGW, int lane) {
    for (int r = gw; r < nrows; r += NGW) {
        const f32x4* s = (const f32x4*)(src + (size_t)r * 1024) + lane * 4;
        f32x4 v[4]; float am = 0.f;
#pragma unroll
        for (int q = 0; q < 4; ++q) { v[q] = s[q]; am = fmaxf(am, fmaxf(fmaxf(fabsf(v[q][0]), fabsf(v[q][1])), fmaxf(fabsf(v[q][2]), fabsf(v[q][3])))); }
        am = wave_max(am);
        const int e = (int)((__float_as_uint(am) >> 23) & 0xffu) - 127;
        const bool ok = am > 1e-30f;
        const float sc = ok ? __uint_as_float((unsigned)(127 + 6 - e) << 23) : 1.0f, isc = ok ? __uint_as_float((unsigned)(127 - 6 + e) << 23) : 1.0f;
        u32x4 o;
#pragma unroll
        for (int q = 0; q < 4; ++q) { unsigned wd = 0u;
#pragma unroll
            for (int j = 0; j < 4; ++j) { int qi = (int)rintf(v[q][j] * sc); qi = qi > 127 ? 127 : (qi < -127 ? -127 : qi); wd |= ((unsigned)qi & 0xffu) << (8 * j); }
            o[q] = wd; }
        *(u32x4*)(dst + (size_t)r * 1024 + lane * 16) = o;
        if (lane == 0) inv_scale[r] = isc;
    }
}
DI void cvt_stream(const float* src, bf16* dst, size_t n4, size_t gtid, size_t gthreads) {
    const f32x4* s = (const f32x4*)src; uint2* d = (uint2*)dst;
    for (size_t i = gtid; i < n4; i += gthreads) { const f32x4 v = s[i]; uint2 o; o.x = pk2(v.x, v.y); o.y = pk2(v.z, v.w); d[i] = o; }
}
struct P0In { const float *c, *ada_w, *ada_b, *ret_w_in, *ret_w_out, *sgu_w_in, *sgu_w_out, *wq, *keys, *pu, *pv; const int* pos; };
DI void p0_prologue(const Ctx& C, const P0In& I) {
    LAS float* scr = (LAS float*)(C.lds + RING_OFF + C.wave * 16384);
    const int gw = C.vcu * NWAVES + C.wave, NGW = C.G * NWAVES;
    bf16* wri = (bf16*)(C.ws + WS_WRI); bf16* wro = (bf16*)(C.ws + WS_WRO);
    constexpr int I_RI = 16 * 192, I_RO = 32 * 32;
    constexpr int NITEMS = I_RI + I_RO;
    for (int it = gw; it < NITEMS; it += NGW) {
        int r = it;
        if (r < I_RI) { p0_transpose_item(I.ret_w_in, 1024, 6144, wri, 0, scr, r, C.lane); continue; } r -= I_RI;
        p0_transpose_item(I.ret_w_out, 2048, 1024, wro, 0, scr, r, C.lane);
    }
    const size_t gtid = (size_t)C.vcu * 512 + C.tid, gth = (size_t)C.G * 512;
    cvt_stream(I.keys, (bf16*)(C.ws + WS_KEYS), (size_t)2 * 8 * 2 * 128 * 128 / 4, gtid, gth);
    float* mod = (float*)(C.ws + WS_MOD);
    __syncthreads();
    for (int it = C.vcu; it < 2 * 96; it += C.G) {
        const int l = it / 96, cb = it % 96, kp = C.wave, n = cb * 64 + C.lane;
        const float* W = I.ada_w + (size_t)l * 1024 * 6144 + n;
        float a0 = 0.f, a1 = 0.f;
#pragma unroll 8
        for (int k = kp * 128; k < kp * 128 + 128; ++k) {
            const float w = W[(size_t)k * 6144]; const float c0 = I.c[k], c1 = I.c[1024 + k];
            a0 += pg8::silu_f(c0) * w; a1 += pg8::silu_f(c1) * w;
        }
        LAS float* red = (LAS float*)(C.lds + RING_OFF);
        red[(kp * 2 + 0) * 64 + C.lane] = a0; red[(kp * 2 + 1) * 64 + C.lane] = a1;
        __syncthreads();
        if (C.wave < 2) { float s = I.ada_b[l * 6144 + n];
#pragma unroll
            for (int q = 0; q < 8; ++q) s += red[(q * 2 + C.wave) * 64 + C.lane];
            mod[(size_t)(l * 2 + C.wave) * 6144 + n] = s; }
        __syncthreads();
    }
    unsigned* trg = (unsigned*)(C.ws + WS_COS);
    typedef _Float16 ph2_t __attribute__((ext_vector_type(2)));
    for (int it = gw; it < TT / 2; it += NGW) {
        const int row = 2 * it + (C.lane >> 5), f0 = (C.lane & 31) * 4; const float p = (float)I.pos[row];
        u32x4 tv;
#pragma unroll
        for (int j = 0; j < 4; ++j) { const int f = f0 + j; double w = 1.0, bs = 0.93057204092969898;
#pragma unroll
            for (int bit = 0; bit < 7; ++bit) { if ((f >> bit) & 1) w *= bs; bs *= bs; }
            const float ang = p * (float)w; const double r = (double)ang * 0.15915494309189535; const float fr = (float)(r - floor(r));
            const unsigned clo_ = __builtin_bit_cast(unsigned short, (_Float16)__builtin_amdgcn_cosf(fr)), shi_ = __builtin_bit_cast(unsigned short, (_Float16)__builtin_amdgcn_sinf(fr)); tv[j] = clo_ | (shi_ << 16); }
        *(u32x4*)(trg + (size_t)row * 128 + f0) = tv;
    }
}
DI void side_work(const Ctx& C, const P0In& I, int nskip) {
    LAS float* scr = (LAS float*)(C.lds + RING_OFF + C.wave * 16384);
    const int gw = (C.vcu - nskip) * NWAVES + C.wave, NGW = (C.G - nskip) * NWAVES;
    bf16* wsi = (bf16*)(C.ws + WS_WSI); bf16* wso = (bf16*)(C.ws + WS_WSO); bf16* wq = (bf16*)(C.ws + WS_WQ);
    constexpr int I_SI = 16 * 192, I_SO = 48 * 32, I_Q = 16 * 64;
    constexpr int NITEMS = I_SI + I_SO + 2 * I_Q;
    for (int it = gw; it < NITEMS; it += NGW) {
        int r = it;
        if (r < I_SI) { p0_transpose_item(I.sgu_w_in, 1024, 6144, wsi, 0, scr, r, C.lane); continue; } r -= I_SI;
        if (r < I_SO) { p0_transpose_item(I.sgu_w_out, 3072, 1024, wso, 0, scr, r, C.lane); continue; } r -= I_SO;
        if (r < I_Q) { p0_transpose_item(I.wq, 1024, 2048, wq, 0, scr, r, C.lane); continue; } r -= I_Q;
        p0_transpose_item(I.wq + (size_t)1024 * 2048, 1024, 2048, wq + (size_t)2048 * 1024, 0, scr, r, C.lane);
    }
    cvt_rows_i8(I.pu, (unsigned char*)(C.ws + WS_PU), (float*)(C.ws + WS_ISU), 2 * 16384, gw, NGW, C.lane);
    cvt_rows_fp8(I.pv, (unsigned char*)(C.ws + WS_PV), (float*)(C.ws + WS_ISV), 2 * 16384, gw, NGW, C.lane);
}
DI void rms_mod_row(const float* xrow, const float* gain, const float* shift, const float* scale, bf16* orow, int lane) {
    const f32x4* xr = (const f32x4*)xrow + lane; f32x4 v[4]; float s = 0.f;
#pragma unroll
    for (int j = 0; j < 4; ++j) { v[j] = xr[64 * j]; s += (v[j].x * v[j].x + v[j].y * v[j].y) + (v[j].z * v[j].z + v[j].w * v[j].w); }
    const float rstd = 1.0f / sqrtf(wave_sum(s) * (1.0f / 1024.0f) + EPS);
    uint2* o8 = (uint2*)orow + lane;
#pragma unroll
    for (int j = 0; j < 4; ++j) { const f32x4 g = ((const f32x4*)gain)[lane + 64 * j], sh = ((const f32x4*)shift)[lane + 64 * j], sc = ((const f32x4*)scale)[lane + 64 * j];
        const f32x4 y = v[j] * rstd * g * (sc + 1.0f) + sh; uint2 o; o.x = pk2(y.x, y.y); o.y = pk2(y.z, y.w); o8[64 * j] = o; }
}
DI void rms_mod_phase(const Ctx& C, const float* x, const float* gain, const float* mod_l, int sh_off, int sc_off, bf16* H) {
    const int gw = C.vcu * NWAVES + C.wave, NGW = C.G * NWAVES;
    for (int m = gw; m < TT; m += NGW) { const float* ml = mod_l + (size_t)(m >> 13) * 6144; rms_mod_row(x + (size_t)m * DM, gain, ml + sh_off, ml + sc_off, H + (size_t)m * DM, C.lane); }
}

DI void scan_naive(const Ctx& C, const bf16* Q, const bf16* K, const bf16* V, bf16* CROSS) {
    LAS float* Sst = (LAS float*)(C.lds);
    LAS unsigned* Qs = (LAS unsigned*)(C.lds + 16384);
    LAS bf16* Ks = (LAS bf16*)(C.lds + 16384 + 32768);
    LAS float* Vs = (LAS float*)(C.lds + 16384 + 65536);
    const int tid = C.tid;
    for (int item = C.vcu; item < 256; item += C.G) {
        const int b = item >> 7, h = (item >> 5) & 3, es = item & 31;
        const float lg2 = log2f(1.0f - exp2f(-5.0f - (float)h)); const float gc = exp2f(lg2 * 64.0f);
        for (int i = tid; i < 4096; i += 512) Sst[i] = 0.f;
        __syncthreads();
        for (int n = 0; n < 128; ++n) {
            const size_t tok0 = (size_t)b * SEQ + (size_t)n * 64;
            for (int ch = tid; ch < 2048; ch += 512) { const int r = ch >> 5, c = ch & 31;
                const u32x4 q = *(const u32x4*)(Q + (tok0 + r) * 1024 + h * 256 + c * 8); *(LAS u32x4*)(Qs + r * 128 + c * 4) = q;
                const u32x4 k = *(const u32x4*)(K + (tok0 + r) * 1024 + h * 256 + c * 8); *(LAS u32x4*)((LAS unsigned*)Ks + r * 128 + c * 4) = k; }
            for (int o = tid; o < 1024; o += 512) { const int j = o >> 4, e = o & 15; Vs[o] = bf2f(V[(tok0 + j) * 2048 + h * 512 + es * 16 + e]) * exp2f(lg2 * (float)(63 - j)); }
            __syncthreads();
#pragma unroll
            for (int oo = 0; oo < 2; ++oo) { const int o = tid + oo * 512, i = o >> 4, e = o & 15; float acc = 0.f;
#pragma unroll 8
                for (int d2 = 0; d2 < 128; ++d2) { const unsigned q2 = Qs[i * 128 + d2]; acc += bflo(q2) * Sst[(2 * d2) * 16 + e] + bfhi(q2) * Sst[(2 * d2 + 1) * 16 + e]; }
                CROSS[(tok0 + i) * 2048 + h * 512 + es * 16 + e] = (bf16)f2bf(acc * exp2f(lg2 * (float)(i + 1))); }
            __syncthreads();
            { const int e = tid & 15, dg = tid >> 4; float a[8];
#pragma unroll
              for (int r = 0; r < 8; ++r) a[r] = gc * Sst[(dg + 32 * r) * 16 + e];
#pragma unroll 4
              for (int j = 0; j < 64; ++j) { const float vz = Vs[j * 16 + e];
#pragma unroll
                  for (int r = 0; r < 8; ++r) a[r] += bf2f(Ks[j * 256 + dg + 32 * r]) * vz; }
#pragma unroll
              for (int r = 0; r < 8; ++r) Sst[(dg + 32 * r) * 16 + e] = a[r]; }
            __syncthreads();
        }
    }
}
DI void intra_naive(const Ctx& C, const bf16* Q, const bf16* K, const bf16* V, const bf16* CROSS, bf16* G) {
    LAS unsigned* Qs = (LAS unsigned*)(C.lds);
    LAS unsigned* Ks = (LAS unsigned*)(C.lds + 32768);
    LAS float* SC = (LAS float*)(C.lds + 65536);
    LAS float* red = (LAS float*)(C.lds + 65536 + 16384);
    LAS float* rs = red + 512;
    const int tid = C.tid;
    for (int item = C.vcu; item < 1024; item += C.G) {
        const int b = item >> 9, h = (item >> 7) & 3, n = item & 127;
        const float lg2 = log2f(1.0f - exp2f(-5.0f - (float)h));
        const size_t tok0 = (size_t)b * SEQ + (size_t)n * 64;
        for (int ch = tid; ch < 2048; ch += 512) { const int r = ch >> 5, c = ch & 31;
            *(LAS u32x4*)(Qs + r * 128 + c * 4) = *(const u32x4*)(Q + (tok0 + r) * 1024 + h * 256 + c * 8);
            *(LAS u32x4*)(Ks + r * 128 + c * 4) = *(const u32x4*)(K + (tok0 + r) * 1024 + h * 256 + c * 8); }
        __syncthreads();
        { const int i = tid >> 3, jb = (tid & 7) * 8;
#pragma unroll
          for (int jj = 0; jj < 8; ++jj) { const int j = jb + jj; float acc = 0.f;
#pragma unroll 8
              for (int d2 = 0; d2 < 128; ++d2) { const unsigned q2 = Qs[i * 128 + d2], k2 = Ks[j * 128 + d2]; acc += bflo(q2) * bflo(k2) + bfhi(q2) * bfhi(k2); }
              const int dd = i > j ? i - j : j - i; SC[i * 64 + j] = acc * exp2f(lg2 * (float)dd); } }
        __syncthreads();
#pragma unroll 1
        for (int pass = 0; pass < 2; ++pass) { const int e = tid, ib = pass * 32; float y[32];
#pragma unroll
          for (int i = 0; i < 32; ++i) y[i] = 0.f;
          const bf16* vp = V + tok0 * 2048 + h * 512 + e;
#pragma unroll 1
          for (int j4 = 0; j4 < 16; ++j4) {
              const float v0 = bf2f(vp[(size_t)(4 * j4 + 0) * 2048]), v1 = bf2f(vp[(size_t)(4 * j4 + 1) * 2048]), v2 = bf2f(vp[(size_t)(4 * j4 + 2) * 2048]), v3 = bf2f(vp[(size_t)(4 * j4 + 3) * 2048]);
#pragma unroll
              for (int i = 0; i < 32; ++i) { const f32x4 s4 = *(const LAS f32x4*)(SC + (ib + i) * 64 + 4 * j4); y[i] += (s4.x * v0 + s4.y * v1) + (s4.z * v2 + s4.w * v3); }
          }
          const bf16* cp = CROSS + (tok0 + ib) * 2048 + h * 512 + e;
#pragma unroll
          for (int i = 0; i < 32; ++i) { y[i] += bf2f(cp[(size_t)i * 2048]); const float ss = wave_sum(y[i] * y[i]); if (C.lane == 0) red[C.wave * 64 + i] = ss; }
          __syncthreads();
          if (tid < 32) { float s = 0.f;
#pragma unroll
              for (int w = 0; w < 8; ++w) s += red[w * 64 + tid];
              rs[tid] = 1.0f / sqrtf(s * (1.0f / 512.0f) + EPS); }
          __syncthreads();
          bf16* gp = G + (tok0 + ib) * 2048 + h * 512 + e;
#pragma unroll
          for (int i = 0; i < 32; ++i) { const float g = bf2f(gp[(size_t)i * 2048]); gp[(size_t)i * 2048] = (bf16)f2bf(y[i] * rs[i] * g); }
          __syncthreads();
        }
        __syncthreads();
    }
}
DI void peer_scores(const Ctx& C, const bf16* QP, const bf16* KEYS  , float* SCO) {
    const int gw = C.vcu * NWAVES + C.wave, NGW = C.G * NWAVES; const int fr = C.lane & 15, fq = C.lane >> 4;
    for (int it = gw; it < 1024 * 8; it += NGW) {
        const int tt = it >> 3, h = it & 7; const int tok = tt * 16 + fr;
#pragma unroll
        for (int p = 0; p < 2; ++p) {
            bf16x8 qf[4];
#pragma unroll
            for (int ks = 0; ks < 4; ++ks) qf[ks] = *(const bf16x8*)(QP + (size_t)tok * 2048 + h * 256 + p * 128 + ks * 32 + fq * 8);
            const bf16* kb = KEYS + (size_t)(h * 2 + p) * 128 * 128;
#pragma unroll
            for (int kt = 0; kt < 8; ++kt) {
                f32x4 acc = {0.f, 0.f, 0.f, 0.f};
#pragma unroll
                for (int ks = 0; ks < 4; ++ks) { const bf16x8 kf = *(const bf16x8*)(kb + (size_t)(kt * 16 + fr) * 128 + ks * 32 + fq * 8);
                    acc = __builtin_amdgcn_mfma_f32_16x16x32_bf16(kf, qf[ks], acc, 0, 0, 0); }
                *(f32x4*)(SCO + ((size_t)tok * 8 + h) * 256 + p * 128 + kt * 16 + fq * 4) = acc;
            }
        }
    }
}
template <bool HALVES> DI void select16(const float (&v)[4], int lane, bool (&sel)[4], int (&pos)[4]) {
    float mx = fmaxf(fmaxf(v[0], v[1]), fmaxf(v[2], v[3])), mn = fminf(fminf(v[0], v[1]), fminf(v[2], v[3]));
#pragma unroll
    for (int o = 1; o < (HALVES ? 32 : 64); o <<= 1) { mx = fmaxf(mx, __shfl_xor(mx, o)); mn = fminf(mn, __shfl_xor(mn, o)); }
    const bool up = HALVES && lane >= 32;
    float lo = mn, hi = mx, thr = mn; bool done = false;
    for (int iter = 0; iter < 48; ++iter) {
        const float mid = done ? thr : 0.5f * (lo + hi);
        int cnt = 0;
#pragma unroll
        for (int c = 0; c < 4; ++c) { const unsigned long long m = __ballot(v[c] >= mid);
            cnt += HALVES ? (up ? __popc((unsigned)(m >> 32)) : __popc((unsigned)m)) : __popcll(m); }
        if (!done) { if (cnt == 16) { thr = mid; done = true; } else if (cnt > 16) { lo = mid; thr = mid; } else hi = mid; }
        if (__all(done)) break;
    }
    int base = 0;
#pragma unroll
    for (int c = 0; c < 4; ++c) { sel[c] = v[c] >= thr; const unsigned long long m = __ballot(sel[c]);
        const unsigned long long gm = HALVES ? (up ? (m >> 32) : (m & 0xffffffffull)) : m; const int ll = HALVES ? (lane & 31) : lane;
        pos[c] = base + __popcll(gm & ((1ull << ll) - 1ull)); base += __popcll(gm); sel[c] = sel[c] && pos[c] < 16; }
}
DI void peer_topk(const Ctx& C, const float* SCO, int* IDX, float* GATE) {
    LAS float* sv = (LAS float*)(C.lds + C.wave * 512);
    LAS int* si = (LAS int*)(C.lds + C.wave * 512 + 128);
    LAS float* fv = (LAS float*)(C.lds + C.wave * 512 + 256);
    LAS int* fi = (LAS int*)(C.lds + C.wave * 512 + 320);
    const int gw = C.vcu * NWAVES + C.wave, NGW = C.G * NWAVES, lane = C.lane;
    for (int it = gw; it < TT * 8; it += NGW) {
        const f32x4 s4 = *(const f32x4*)(SCO + (size_t)it * 256 + lane * 4);
        float v[4] = {s4.x, s4.y, s4.z, s4.w}; bool sel[4]; int pos[4];
        select16<true>(v, lane, sel, pos);
        const int p = lane >> 5;
#pragma unroll
        for (int c = 0; c < 4; ++c) if (sel[c]) { sv[p * 16 + pos[c]] = v[c]; si[p * 16 + pos[c]] = (lane & 31) * 4 + c; }
        LDS_WAIT();
        const int a = lane >> 2, bq = (lane & 3) * 4; const float va = sv[a]; const int ia = si[a];
        float w[4]; int wi[4];
#pragma unroll
        for (int c = 0; c < 4; ++c) { w[c] = va + sv[16 + bq + c]; wi[c] = ia * 128 + si[16 + bq + c]; }
        select16<false>(w, lane, sel, pos);
#pragma unroll
        for (int c = 0; c < 4; ++c) if (sel[c]) { fv[pos[c]] = w[c]; fi[pos[c]] = wi[c]; }
        LDS_WAIT();
        const float x = fv[lane & 15]; const int xi = fi[lane & 15];
        float m = x;
#pragma unroll
        for (int o = 1; o < 16; o <<= 1) m = fmaxf(m, __shfl_xor(m, o));
        const float e = __expf(x - m); float s = e;
#pragma unroll
        for (int o = 1; o < 16; o <<= 1) s += __shfl_xor(s, o);
        if (lane < 16) { IDX[(size_t)it * 16 + lane] = xi; GATE[(size_t)it * 16 + lane] = e / s; }
        LDS_WAIT();
    }
}
template <bool FINAL> DI void peer_gather(const Ctx& C, const bf16* H, const int* IDX, const float* GATE, const bf16* PU, const bf16* PV, float* X, const float* g2  ,
                                          const float* ngain, const float* nmod  , bf16* Hn) {
    const int gw = C.vcu * NWAVES + C.wave, NGW = C.G * NWAVES, lane = C.lane;
    for (int t = gw; t < TT; t += NGW) {
        float hv[16];
        { const u32x4 a = *(const u32x4*)(H + (size_t)t * 1024 + lane * 8), bq = *(const u32x4*)(H + (size_t)t * 1024 + 512 + lane * 8);
          hv[0] = bflo(a.x); hv[1] = bfhi(a.x); hv[2] = bflo(a.y); hv[3] = bfhi(a.y); hv[4] = bflo(a.z); hv[5] = bfhi(a.z); hv[6] = bflo(a.w); hv[7] = bfhi(a.w);
          hv[8] = bflo(bq.x); hv[9] = bfhi(bq.x); hv[10] = bflo(bq.y); hv[11] = bfhi(bq.y); hv[12] = bflo(bq.z); hv[13] = bfhi(bq.z); hv[14] = bflo(bq.w); hv[15] = bfhi(bq.w); }
        const int i0 = IDX[(size_t)t * 128 + lane], i1 = IDX[(size_t)t * 128 + 64 + lane];
        const float g0 = GATE[(size_t)t * 128 + lane], g1 = GATE[(size_t)t * 128 + 64 + lane];
        float a0 = 0.f, a1 = 0.f;
        for (int k = 0; k < 128; k += 4) {
            float dsum[4];
#pragma unroll
            for (int kk = 0; kk < 4; ++kk) { const int kq = k + kk; const int e = kq < 64 ? __builtin_amdgcn_readlane(i0, kq) : __builtin_amdgcn_readlane(i1, kq - 64);
                const bf16* ur = PU + (size_t)e * 1024; const u32x4 a = *(const u32x4*)(ur + lane * 8), bq = *(const u32x4*)(ur + 512 + lane * 8);
                float d = bflo(a.x) * hv[0] + bfhi(a.x) * hv[1]; d += bflo(a.y) * hv[2] + bfhi(a.y) * hv[3]; d += bflo(a.z) * hv[4] + bfhi(a.z) * hv[5]; d += bflo(a.w) * hv[6] + bfhi(a.w) * hv[7];
                d += bflo(bq.x) * hv[8] + bfhi(bq.x) * hv[9]; d += bflo(bq.y) * hv[10] + bfhi(bq.y) * hv[11]; d += bflo(bq.z) * hv[12] + bfhi(bq.z) * hv[13]; d += bflo(bq.w) * hv[14] + bfhi(bq.w) * hv[15];
                dsum[kk] = d; }
#pragma unroll
            for (int kk = 0; kk < 4; ++kk) { const int kq = k + kk; const float d = gelu_t(wave_sum(dsum[kk]));
                if (kq < 64) { if (lane == kq) a0 = d * g0; } else { if (lane == kq - 64) a1 = d * g1; } }
        }
        float o[16];
#pragma unroll
        for (int j = 0; j < 16; ++j) o[j] = 0.f;
        for (int k = 0; k < 128; k += 4) {
#pragma unroll
            for (int kk = 0; kk < 4; ++kk) { const int kq = k + kk; const int e = kq < 64 ? __builtin_amdgcn_readlane(i0, kq) : __builtin_amdgcn_readlane(i1, kq - 64);
                const float ak = __int_as_float(kq < 64 ? __builtin_amdgcn_readlane(__float_as_int(a0), kq) : __builtin_amdgcn_readlane(__float_as_int(a1), kq - 64));
                const bf16* vr = PV + (size_t)e * 1024; const u32x4 a = *(const u32x4*)(vr + lane * 8), bq = *(const u32x4*)(vr + 512 + lane * 8);
                o[0] += ak * bflo(a.x); o[1] += ak * bfhi(a.x); o[2] += ak * bflo(a.y); o[3] += ak * bfhi(a.y); o[4] += ak * bflo(a.z); o[5] += ak * bfhi(a.z); o[6] += ak * bflo(a.w); o[7] += ak * bfhi(a.w);
                o[8] += ak * bflo(bq.x); o[9] += ak * bfhi(bq.x); o[10] += ak * bflo(bq.y); o[11] += ak * bfhi(bq.y); o[12] += ak * bflo(bq.z); o[13] += ak * bfhi(bq.z); o[14] += ak * bflo(bq.w); o[15] += ak * bfhi(bq.w); }
        }
#ifdef DBG_ZERO_PEER
#pragma unroll
        for (int j = 0; j < 16; ++j) o[j] = 0.f;
#endif
        const int b = t >> 13; const float* gp = g2 + (size_t)b * 6144; float* xr = X + (size_t)t * 1024;
        float xn[16]; float ss = 0.f;
#pragma unroll
        for (int q = 0; q < 4; ++q) { const int col = (q >> 1) * 512 + lane * 8 + (q & 1) * 4; const f32x4 xv = *(const f32x4*)(xr + col), gv = *(const f32x4*)(gp + col);
#pragma unroll
            for (int j = 0; j < 4; ++j) { const float y = xv[j] + gv[j] * o[q * 4 + j]; xn[q * 4 + j] = y; ss += y * y; } }
        const float rstd = 1.0f / sqrtf(wave_sum(ss) * (1.0f / 1024.0f) + EPS);
        if (FINAL) {
#pragma unroll
            for (int q = 0; q < 4; ++q) { const int col = (q >> 1) * 512 + lane * 8 + (q & 1) * 4; const f32x4 gn = *(const f32x4*)(ngain + col); f32x4 y;
#pragma unroll
                for (int j = 0; j < 4; ++j) y[j] = xn[q * 4 + j] * rstd * gn[j];
                *(f32x4*)(xr + col) = y; }
        } else {
            const float* nm = nmod + (size_t)b * 6144;
#pragma unroll
            for (int q = 0; q < 4; ++q) { const int col = (q >> 1) * 512 + lane * 8 + (q & 1) * 4; const f32x4 gn = *(const f32x4*)(ngain + col), sh = *(const f32x4*)(nm + col), sc = *(const f32x4*)(nm + 1024 + col); f32x4 xo; float y[4];
#pragma unroll
                for (int j = 0; j < 4; ++j) { xo[j] = xn[q * 4 + j]; y[j] = xn[q * 4 + j] * rstd * gn[j] * (1.0f + sc[j]) + sh[j]; }
                *(f32x4*)(xr + col) = xo; uint2 w; w.x = pk2(y[0], y[1]); w.y = pk2(y[2], y[3]); *(uint2*)(Hn + (size_t)t * 1024 + col) = w; }
        }
    }
}
DI void sgu_gate_naive(const Ctx& C, bf16* U, const bf16* VB, const float* stats, const float* w_s, const float* b_s, const float* ln_g, const float* ln_b) {
    LAS float* Wm = (LAS float*)(C.lds);
    LAS float* mu = (LAS float*)(C.lds + 65536);
    LAS float* rsd = mu + 128;
    const int tid = C.tid;
    for (int item = C.vcu; item < 1024; item += C.G) {
        const int n = item >> 3, g = item & 7; const size_t row0 = (size_t)n * 128;
        for (int i = tid; i < 16384; i += 512) { const int r = i >> 7, c = i & 127; const float w = w_s[(size_t)g * 16384 + i]; Wm[i] = (r < 64 && c >= 64) ? 0.f : w; }
        if (tid < 128) { const float* sp = stats + (row0 + tid) * 96; float s1 = 0.f, s2 = 0.f;
            for (int q = 0; q < 48; ++q) { s1 += sp[2 * q]; s2 += sp[2 * q + 1]; }
            const float m = s1 * (1.0f / 3072.0f); const float var = s2 * (1.0f / 3072.0f) - m * m; mu[tid] = m; rsd[tid] = 1.0f / sqrtf(fmaxf(var, 0.f) + EPS); }
        __syncthreads();
        if (tid < 384) {
            const int col = g * 384 + tid; const float lg = ln_g[col], lb = ln_b[col];
#pragma unroll
            for (int pass = 0; pass < 2; ++pass) {
                float acc[64];
#pragma unroll
                for (int i = 0; i < 64; ++i) acc[i] = 0.f;
                const int jmax = pass == 0 ? 64 : 128;
                for (int j = 0; j < jmax; ++j) { const float v = bf2f(VB[(row0 + j) * 3072 + col]); const float vl = (v - mu[j]) * rsd[j] * lg + lb;
#pragma unroll
                    for (int i = 0; i < 64; ++i) acc[i] += Wm[(pass * 64 + i) * 128 + j] * vl; }
#pragma unroll
                for (int i = 0; i < 64; ++i) { const int r = pass * 64 + i; const float s = acc[i] + b_s[g * 128 + r]; bf16* up = U + (row0 + r) * 3072 + col; *up = (bf16)f2bf(bf2f(*up) * s); }
            }
        }
        __syncthreads();
    }
}
typedef short v4i16_t __attribute__((ext_vector_type(4)));
typedef unsigned u32x2_t __attribute__((ext_vector_type(2)));
typedef __bf16 bf16x2_t __attribute__((ext_vector_type(2)));
DI unsigned cvtpk(float lo, float hi) { f32x2_t v = {lo, hi}; bf16x2_t b = __builtin_convertvector(v, bf16x2_t); return __builtin_bit_cast(unsigned, b); }
DI v4i16_t trr(const LAS unsigned char* p) { return __builtin_amdgcn_ds_read_tr16_b64_v4i16((LAS v4i16_t*)p); }
DI bf16x8 cat8(v4i16_t a, v4i16_t b) { return __builtin_shufflevector(a, b, 0, 1, 2, 3, 4, 5, 6, 7); }
DI bf16x8 pack2(const f32x4& a, const f32x4& b) { u32x4 p; p.x = cvtpk(a[0], a[1]); p.y = cvtpk(a[2], a[3]); p.z = cvtpk(b[0], b[1]); p.w = cvtpk(b[2], b[3]); return __builtin_bit_cast(bf16x8, p); }
DI u32x4 scale8(u32x4 v, float s) { u32x4 o; o.x = cvtpk(bflo(v.x) * s, bfhi(v.x) * s); o.y = cvtpk(bflo(v.y) * s, bfhi(v.y) * s); o.z = cvtpk(bflo(v.z) * s, bfhi(v.z) * s); o.w = cvtpk(bflo(v.w) * s, bfhi(v.w) * s); return o; }
#ifndef SCAN_QPI
#define SCAN_QPI 544
#endif
#ifndef SCAN_KPI
#define SCAN_KPI 544
#endif
#ifndef SCAN_PFD
#define SCAN_PFD 5
#endif
constexpr int SCAN_ESL = 32, SCAN_NCW = SCAN_ESL / 16, SCAN_NSL = 512 / SCAN_ESL, SCAN_NIT = 8 * SCAN_NSL;
#define SCAN_BAR() do { asm volatile("s_waitcnt lgkmcnt(0)" ::: "memory"); __builtin_amdgcn_s_barrier(); asm volatile("" ::: "memory"); } while (0)
template <int MODE = 0> DI void scan_mfma(const Ctx& C, const bf16* Q, const bf16* K, const bf16* V, bf16* CROSS) {
    constexpr int QPI = SCAN_QPI, KPI = SCAN_KPI, VPI = SCAN_ESL * 2 + 32, VCH = SCAN_ESL / 8  , NVC = 64 * VCH;
    constexpr int OQ = 0, OK_ = 64 * QPI, OV = OK_ + 64 * KPI, BUFB = OV + 64 * VPI;
    constexpr int NST = (NWAVES - 1 - SCAN_NCW) * 64;
    const int w = C.wave;
    for (int item = C.vcu; item < SCAN_NIT; item += C.G) {
        const int b = item / (4 * SCAN_NSL), h = (item / SCAN_NSL) & 3, es = item % SCAN_NSL;
        const float lg2 = log2f(1.0f - exp2f(-5.0f - (float)h)); const float gc = exp2f(lg2 * 64.0f);
        const size_t tokb = (size_t)b * SEQ;
        if (w >= SCAN_NCW) {
            int tl_ = C.tid; asm volatile("" : "+v"(tl_));
            const int st = (w == NWAVES - 1) ? (tl_ & 63) : tl_ - SCAN_NCW * 64;
            if (w == NWAVES - 1) {
                unsigned dmy = 0u;
#define SCAN_PF1(ptr) asm volatile("global_load_dword %0, %1, off" : "+v"(dmy) : "v"(ptr) : "memory")
#define SCAN_PF(n) do { const size_t t0_ = tokb + (size_t)(n) * 64; \
                if ((es & 3) == 0) { _Pragma("unroll") for (int u = 0; u < 4; ++u) { const int ln = st + 64 * u, r = ln >> 2, q = ln & 3; SCAN_PF1(Q + (t0_ + r) * 1024 + h * 256 + q * 64); SCAN_PF1(K + (t0_ + r) * 1024 + h * 256 + q * 64); } } \
                SCAN_PF1(V + (t0_ + st) * 2048 + h * 512 + es * SCAN_ESL); } while (0)
#ifndef SCAN_NOPF
                SCAN_PF(3); SCAN_PF(4);
#endif
                SCAN_BAR();
#pragma unroll 1
                for (int n = 0; n < 128; ++n) {
#ifndef SCAN_NOPF
                    if (n + SCAN_PFD < 128) SCAN_PF(n + SCAN_PFD);
#endif
                    SCAN_BAR(); }
                asm volatile("s_waitcnt vmcnt(0)" : "+v"(dmy) :: "memory");
#undef SCAN_PF
#undef SCAN_PF1
            } else {
            u32x4 rqA[7], rkA[7], rvA, rqB[7], rkB[7], rvB;
            const unsigned qo_ = (unsigned)((st >> 5) * 2048 + (st & 31) * 16), qo6_ = (st + NST * 6 < 2048) ? qo_ + (unsigned)(6 * (NST / 32) * 2048) : qo_;
            const unsigned vo_ = (st < NVC) ? (unsigned)((st / VCH) * 4096 + (st % VCH) * 16) : 0u;
#define SCAN_LD(RQ, RK, RV, n) do { const size_t t0_ = tokb + (size_t)((n) < 127 ? (n) : 127) * 64; \
            const unsigned char* qb_ = (const unsigned char*)(Q + t0_ * 1024 + h * 256); const unsigned char* kb_ = (const unsigned char*)(K + t0_ * 1024 + h * 256); \
            const unsigned char* vb_ = (const unsigned char*)(V + t0_ * 2048 + h * 512 + es * SCAN_ESL); \
            _Pragma("unroll") for (int u = 0; u < 7; ++u) { const unsigned o_ = u == 6 ? qo6_ : qo_ + (unsigned)(u * (NST / 32) * 2048); \
                RQ[u] = *(const u32x4*)(qb_ + o_); RK[u] = *(const u32x4*)(kb_ + o_); } \
            RV = *(const u32x4*)(vb_ + vo_); } while (0)
#define SCAN_WR(RQ, RK, RV, bufo) do { LAS unsigned char* B_ = C.lds + (bufo); \
            _Pragma("unroll") for (int u = 0; u < 7; ++u) { const int c = st + NST * u; if (c < 2048) { const int r = c >> 5, cc = c & 31; \
                *(LAS u32x4*)(B_ + OQ + r * QPI + cc * 16) = RQ[u]; *(LAS u32x4*)(B_ + OK_ + r * KPI + cc * 16) = RK[u]; } } \
            if (st < NVC) { const int r = st / VCH, cc = st % VCH; *(LAS u32x4*)(B_ + OV + r * VPI + cc * 16) = scale8(RV, exp2f(lg2 * (float)(63 - r))); } } while (0)
            SCAN_LD(rqA, rkA, rvA, 0); SCAN_WR(rqA, rkA, rvA, 0); SCAN_LD(rqA, rkA, rvA, 1); SCAN_LD(rqB, rkB, rvB, 2);
            SCAN_BAR();
#pragma unroll 1
            for (int n = 0; n < 128; n += 2) {
                if (MODE != 2) { SCAN_WR(rqA, rkA, rvA, BUFB); SCAN_LD(rqA, rkA, rvA, n + 3); }
                SCAN_BAR();
                if (MODE != 2) { SCAN_WR(rqB, rkB, rvB, 0); SCAN_LD(rqB, rkB, rvB, n + 4); }
                SCAN_BAR();
            }
#undef SCAN_LD
#undef SCAN_WR
            }
        } else {
            int tl_ = C.tid; asm volatile("" : "+v"(tl_)); const int lane = tl_ & 63, fr = lane & 15, fq = lane >> 4;
            f32x4 S[16];
#pragma unroll
            for (int t = 0; t < 16; ++t) S[t] = (f32x4){0.f, 0.f, 0.f, 0.f};
            SCAN_BAR();
#define SC_LQ(QF, DB) do { _Pragma("unroll") for (int m = 0; m < 4; ++m) QF[m] = *(const LAS bf16x8*)(Qs + (16 * m + fr) * QPI + (32 * (DB) + 8 * fq) * 2); __builtin_amdgcn_sched_barrier(0); } while (0)
#define SC_MQ(QF, DB) do { const bf16x8 sa0 = pack2(S[2 * (DB)], S[2 * (DB) + 1]); \
            _Pragma("unroll") for (int m = 0; m < 4; ++m) acc[m] = __builtin_amdgcn_mfma_f32_16x16x32_bf16(sa0, QF[m], acc[m], 0, 0, 0); __builtin_amdgcn_sched_barrier(0); } while (0)
#define SC_LK(KF, KS, TQ) do { const LAS unsigned char* kp = Ks + (32 * (KS) + 4 * fq + (fr >> 2)) * KPI + (8 * (fr & 3)) * 2;     \
            _Pragma("unroll") for (int t4 = 0; t4 < 4; ++t4) { const int t = 4 * (TQ) + t4; KF[t4] = cat8(trr(kp + 64 * (t >> 1) + 8 * (t & 1)), trr(kp + 64 * (t >> 1) + 8 * (t & 1) + 16 * KPI)); } __builtin_amdgcn_sched_barrier(0); } while (0)
#define SC_LV(VF, KS) do { const LAS unsigned char* vp = Vs + (32 * (KS) + 4 * fq + (fr >> 2)) * VPI + (16 * w + 4 * (fr & 3)) * 2; VF = cat8(trr(vp), trr(vp + 16 * VPI)); } while (0)
#define SC_MK(KF, VF, TQ) do { _Pragma("unroll") for (int t4 = 0; t4 < 4; ++t4) S[4 * (TQ) + t4] = __builtin_amdgcn_mfma_f32_16x16x32_bf16(KF[t4], VF, S[4 * (TQ) + t4], 0, 0, 0); __builtin_amdgcn_sched_barrier(0); } while (0)
#define SCAN_CHUNK(n_, BO) do { const size_t tok0 = tokb + (size_t)(n_) * 64; LAS unsigned char* Qs = C.lds + (BO) + OQ; LAS unsigned char* Ks = C.lds + (BO) + OK_; LAS unsigned char* Vs = C.lds + (BO) + OV; \
                f32x4 acc[4]; bf16x8 fA[4], fB[4], kA[4], kB[4], vf0, vf1; \
                _Pragma("unroll") for (int m = 0; m < 4; ++m) acc[m] = (f32x4){0.f, 0.f, 0.f, 0.f}; \
                SC_LQ(fA, 0); SC_LQ(fB, 1); SC_MQ(fA, 0); SC_LQ(fA, 2); SC_MQ(fB, 1); SC_LQ(fB, 3); SC_MQ(fA, 2); SC_LQ(fA, 4); SC_MQ(fB, 3); SC_LQ(fB, 5); SC_MQ(fA, 4); SC_LQ(fA, 6); SC_MQ(fB, 5); SC_LQ(fB, 7); SC_MQ(fA, 6); SC_LV(vf0, 0); SC_LV(vf1, 1); SC_LK(kA, 0, 0); SC_MQ(fB, 7); \
                _Pragma("unroll") for (int m = 0; m < 4; ++m) { const f32x4 v = acc[m] * exp2f(lg2 * (float)(16 * m + fr + 1)); uint2 o; o.x = cvtpk(v[0], v[1]); o.y = cvtpk(v[2], v[3]); \
                    *(uint2*)(CROSS + (tok0 + 16 * m + fr) * 2048 + h * 512 + es * SCAN_ESL + 16 * w + 4 * fq) = o; } \
                _Pragma("unroll") for (int t = 0; t < 16; ++t) S[t] = S[t] * gc; \
                __builtin_amdgcn_sched_barrier(0); \
                SC_LK(kB, 0, 1); SC_MK(kA, vf0, 0); SC_LK(kA, 0, 2); SC_MK(kB, vf0, 1); SC_LK(kB, 0, 3); SC_MK(kA, vf0, 2); SC_LK(kA, 1, 0); SC_MK(kB, vf0, 3); SC_LK(kB, 1, 1); SC_MK(kA, vf1, 0); SC_LK(kA, 1, 2); SC_MK(kB, vf1, 1); SC_LK(kB, 1, 3); SC_MK(kA, vf1, 2); SC_MK(kB, vf1, 3); \
                SCAN_BAR(); } while (0)
#pragma unroll 1
            for (int n = 0; n < 128; n += 2) { if (MODE == 1) { SCAN_BAR(); SCAN_BAR(); } else { SCAN_CHUNK(n, 0); SCAN_CHUNK(n + 1, BUFB); } }
#undef SCAN_CHUNK
#undef SC_LQ
#undef SC_MQ
#undef SC_LK
#undef SC_LV
#undef SC_MK
        }
    }
}
#undef SCAN_BAR
DI void sgu_gate_mfma(const Ctx& C, bf16* U, const bf16* VB, const float* stats, const float* w_s, const float* b_s, const float* ln_g, const float* ln_b) {
    constexpr int WPI = 272, VPI = 288;
    LAS unsigned char* Ws = C.lds; LAS unsigned char* Vs = C.lds + 128 * WPI;
    LAS float* mu = (LAS float*)(C.lds + 128 * WPI + 128 * VPI); LAS float* rsd = mu + 128; LAS float* r1 = mu + 256; LAS float* r2 = mu + 384; LAS float* bsl = mu + 512;
    const int tid = C.tid, lane = C.lane, w = C.wave, fr = lane & 15, fq = lane >> 4;
    for (int item = C.vcu; item < 1024; item += C.G) {
        const int n = item >> 3, g = item & 7; const size_t row0 = (size_t)n * 128;
        if (tid < 128) { const float* sp = stats + (row0 + tid) * 96; float s1 = 0.f, s2 = 0.f;
#pragma unroll 8
            for (int q = 0; q < 48; ++q) { s1 += sp[2 * q]; s2 += sp[2 * q + 1]; }
            const float m = s1 * (1.0f / 3072.0f); const float var = s2 * (1.0f / 3072.0f) - m * m; mu[tid] = m; rsd[tid] = 1.0f / sqrtf(fmaxf(var, 0.f) + EPS); bsl[tid] = b_s[g * 128 + tid]; }
        __syncthreads();
        { const int i = tid >> 2, jq = tid & 3; const float* wp = w_s + (size_t)g * 16384 + i * 128 + jq * 32; float a1 = 0.f, a2 = 0.f;
#pragma unroll
          for (int c8 = 0; c8 < 4; ++c8) { const f32x4 wa = *(const f32x4*)(wp + c8 * 8), wb = *(const f32x4*)(wp + c8 * 8 + 4); float wv[8] = {wa[0], wa[1], wa[2], wa[3], wb[0], wb[1], wb[2], wb[3]}; float o[8];
#pragma unroll
              for (int q = 0; q < 8; ++q) { const int j = jq * 32 + c8 * 8 + q; const float wm = (i < 64 && j >= 64) ? 0.f : wv[q]; const float wr_ = wm * rsd[j]; o[q] = wr_; a1 += wr_ * mu[j]; a2 += wm; }
              u32x4 pk; pk.x = cvtpk(o[0], o[1]); pk.y = cvtpk(o[2], o[3]); pk.z = cvtpk(o[4], o[5]); pk.w = cvtpk(o[6], o[7]);
              *(LAS u32x4*)(Ws + i * WPI + (jq * 32 + c8 * 8) * 2) = pk; }
          a1 += __shfl_xor(a1, 1); a1 += __shfl_xor(a1, 2); a2 += __shfl_xor(a2, 1); a2 += __shfl_xor(a2, 2);
          if (jq == 0) { r1[i] = a1; r2[i] = a2; } }
#pragma unroll 1
        for (int cs = 0; cs < 3; ++cs) {
            const int colb = g * 384 + cs * 128;
#pragma unroll
            for (int u = 0; u < 4; ++u) { const int c = tid + 512 * u, r = c >> 4, cc = c & 15;
                *(LAS u32x4*)(Vs + r * VPI + cc * 16) = *(const u32x4*)(VB + (row0 + r) * 3072 + colb + cc * 8); }
            __syncthreads();
            f32x4 acc[8];
#pragma unroll
            for (int it = 0; it < 8; ++it) acc[it] = (f32x4){0.f, 0.f, 0.f, 0.f};
#pragma unroll
            for (int ks = 0; ks < 4; ++ks) {
                const LAS unsigned char* vp = Vs + (32 * ks + 4 * fq + (fr >> 2)) * VPI + (16 * w + 4 * (fr & 3)) * 2;
                const bf16x8 vf = cat8(trr(vp), trr(vp + 16 * VPI));
#pragma unroll
                for (int it = 0; it < 8; ++it) { if (it < 4 && ks >= 2) continue;
                    const LAS unsigned char* wp = Ws + (16 * it + fr) * WPI + (32 * ks + 4 * fq) * 2;
                    const u32x2_t lo = *(const LAS u32x2_t*)wp, hi = *(const LAS u32x2_t*)(wp + 32);
                    u32x4 ww; ww.x = lo.x; ww.y = lo.y; ww.z = hi.x; ww.w = hi.y;
                    acc[it] = __builtin_amdgcn_mfma_f32_16x16x32_bf16(vf, __builtin_bit_cast(bf16x8, ww), acc[it], 0, 0, 0); }
            }
            const int c0 = colb + 16 * w + 4 * fq;
            const f32x4 lg = *(const f32x4*)(ln_g + c0), lb = *(const f32x4*)(ln_b + c0);
#pragma unroll
            for (int it = 0; it < 8; ++it) { const int i = 16 * it + fr; const float q1 = r1[i], q2 = r2[i], bb = bsl[i];
                bf16* up = U + (row0 + i) * 3072 + c0; const u32x2_t uu = *(const u32x2_t*)up;
                const f32x4 s = lg * (acc[it] - q1) + lb * q2 + bb;
                u32x2_t o; o.x = cvtpk(bflo(uu.x) * s[0], bfhi(uu.x) * s[1]); o.y = cvtpk(bflo(uu.y) * s[2], bfhi(uu.y) * s[3]);
                *(u32x2_t*)up = o; }
            __syncthreads();
        }
    }
}
DI void up8(unsigned wd, float& a, float& b, float& c, float& d) { const f32x2_t lo = __builtin_amdgcn_cvt_pk_f32_fp8((int)wd, false), hi = __builtin_amdgcn_cvt_pk_f32_fp8((int)wd, true); a = lo.x; b = lo.y; c = hi.x; d = hi.y; }
DI float dot16(const u32x4 u, const float (&hv)[16]) {
    float f[16];
    up8(u.x, f[0], f[1], f[2], f[3]); up8(u.y, f[4], f[5], f[6], f[7]); up8(u.z, f[8], f[9], f[10], f[11]); up8(u.w, f[12], f[13], f[14], f[15]);
    float d0 = f[0] * hv[0], d1 = f[1] * hv[1];
#pragma unroll
    for (int j = 2; j < 16; j += 2) { d0 += f[j] * hv[j]; d1 += f[j + 1] * hv[j + 1]; }
    return d0 + d1;
}
template <bool FINAL> DI void peer_gather8(const Ctx& C, const bf16* Hin, const int* IDX, const float* GATE, const unsigned char* PU8, const unsigned char* PV8, const float* ISU, const float* ISV,
                                           float* X, const float* g2, const float* ngain, const float* nmod, bf16* Hn) {
    const int gw = C.vcu * NWAVES + C.wave, NGW = C.G * NWAVES, lane = C.lane;
    LAS float* DL = (LAS float*)(C.lds + C.wave * 1024);
    LAS float* AL = DL + 128;
    for (int t = gw; t < TT; t += NGW) {
        float hv[16];
        { const u32x4 a = *(const u32x4*)(Hin + (size_t)t * 1024 + lane * 16), bq = *(const u32x4*)(Hin + (size_t)t * 1024 + lane * 16 + 8);
          hv[0] = bflo(a.x); hv[1] = bfhi(a.x); hv[2] = bflo(a.y); hv[3] = bfhi(a.y); hv[4] = bflo(a.z); hv[5] = bfhi(a.z); hv[6] = bflo(a.w); hv[7] = bfhi(a.w);
          hv[8] = bflo(bq.x); hv[9] = bfhi(bq.x); hv[10] = bflo(bq.y); hv[11] = bfhi(bq.y); hv[12] = bflo(bq.z); hv[13] = bfhi(bq.z); hv[14] = bflo(bq.w); hv[15] = bfhi(bq.w); }
        const int i0 = IDX[(size_t)t * 128 + lane], i1 = IDX[(size_t)t * 128 + 64 + lane];
        const float g0 = GATE[(size_t)t * 128 + lane], g1 = GATE[(size_t)t * 128 + 64 + lane];
        const float su0 = ISU[i0], su1 = ISU[i1], sv0 = ISV[i0], sv1 = ISV[i1];
        u32x4 ub[8];
#define PG_LOADU(k0) do { _Pragma("unroll") for (int j = 0; j < 8; ++j) { const int kq = (k0) + j; const int e = kq < 64 ? __builtin_amdgcn_readlane(i0, kq) : __builtin_amdgcn_readlane(i1, kq - 64); \
            ub[j] = *(const u32x4*)(PU8 + (size_t)e * 1024 + lane * 16); } } while (0)
        PG_LOADU(0);
#pragma unroll 1
        for (int k0 = 0; k0 < 128; k0 += 8) {
            float p[8];
#pragma unroll
            for (int j = 0; j < 8; ++j) p[j] = dot16(ub[j], hv);
            if (k0 + 8 < 128) PG_LOADU(k0 + 8);
            const bool h32 = lane & 32, h16 = lane & 16, h8 = lane & 8;
            float q4[4];
#pragma unroll
            for (int j = 0; j < 4; ++j) { const float keep = h32 ? p[j + 4] : p[j], send = h32 ? p[j] : p[j + 4]; q4[j] = keep + __shfl_xor(send, 32); }
            float q2[2];
#pragma unroll
            for (int j = 0; j < 2; ++j) { const float keep = h16 ? q4[j + 2] : q4[j], send = h16 ? q4[j] : q4[j + 2]; q2[j] = keep + __shfl_xor(send, 16); }
            float q1; { const float keep = h8 ? q2[1] : q2[0], send = h8 ? q2[0] : q2[1]; q1 = keep + __shfl_xor(send, 8); }
            q1 += __shfl_xor(q1, 4); q1 += __shfl_xor(q1, 2); q1 += __shfl_xor(q1, 1);
            if ((lane & 7) == 0) DL[k0 + ((lane >> 5) & 1) * 4 + ((lane >> 4) & 1) * 2 + ((lane >> 3) & 1)] = q1;
        }
#undef PG_LOADU
        LDS_WAIT();
        { const float d0 = DL[lane], d1 = DL[64 + lane]; AL[lane] = gelu_t(d0 * su0) * g0 * sv0; AL[64 + lane] = gelu_t(d1 * su1) * g1 * sv1; }
        LDS_WAIT();
        float o[16];
#pragma unroll
        for (int j = 0; j < 16; ++j) o[j] = 0.f;
        u32x4 vb[8];
#define PG_LOADV(k0) do { _Pragma("unroll") for (int j = 0; j < 8; ++j) { const int kq = (k0) + j; const int e = kq < 64 ? __builtin_amdgcn_readlane(i0, kq) : __builtin_amdgcn_readlane(i1, kq - 64); \
            vb[j] = *(const u32x4*)(PV8 + (size_t)e * 1024 + lane * 16); } } while (0)
        PG_LOADV(0);
#pragma unroll 1
        for (int k0 = 0; k0 < 128; k0 += 8) {
            float f[8][16];
#pragma unroll
            for (int j = 0; j < 8; ++j) { up8(vb[j].x, f[j][0], f[j][1], f[j][2], f[j][3]); up8(vb[j].y, f[j][4], f[j][5], f[j][6], f[j][7]); up8(vb[j].z, f[j][8], f[j][9], f[j][10], f[j][11]); up8(vb[j].w, f[j][12], f[j][13], f[j][14], f[j][15]); }
            if (k0 + 8 < 128) PG_LOADV(k0 + 8);
#pragma unroll
            for (int j = 0; j < 8; ++j) { const float ak = AL[k0 + j];
#pragma unroll
                for (int q = 0; q < 16; ++q) o[q] += ak * f[j][q]; }
        }
#undef PG_LOADV
        const int b = t >> 13; const float* gp = g2 + (size_t)b * 6144; float* xr = X + (size_t)t * 1024;
        float xn[16]; float ss = 0.f;
#pragma unroll
        for (int q = 0; q < 4; ++q) { const int col = lane * 16 + q * 4; const f32x4 xv = *(const f32x4*)(xr + col), gv = *(const f32x4*)(gp + col);
#pragma unroll
            for (int j = 0; j < 4; ++j) { const float y = xv[j] + gv[j] * o[q * 4 + j]; xn[q * 4 + j] = y; ss += y * y; } }
        const float rstd = 1.0f / sqrtf(wave_sum(ss) * (1.0f / 1024.0f) + EPS);
        if (FINAL) {
#pragma unroll
            for (int q = 0; q < 4; ++q) { const int col = lane * 16 + q * 4; const f32x4 gn = *(const f32x4*)(ngain + col); f32x4 y;
#pragma unroll
                for (int j = 0; j < 4; ++j) y[j] = xn[q * 4 + j] * rstd * gn[j];
                *(f32x4*)(xr + col) = y; }
        } else {
            const float* nm = nmod + (size_t)b * 6144;
#pragma unroll
            for (int q = 0; q < 4; ++q) { const int col = lane * 16 + q * 4; const f32x4 gn = *(const f32x4*)(ngain + col), sh = *(const f32x4*)(nm + col), sc = *(const f32x4*)(nm + 1024 + col); f32x4 xo; float y[4];
#pragma unroll
                for (int j = 0; j < 4; ++j) { xo[j] = xn[q * 4 + j]; y[j] = xn[q * 4 + j] * rstd * gn[j] * (1.0f + sc[j]) + sh[j]; }
                *(f32x4*)(xr + col) = xo; u32x2_t wv; wv.x = cvtpk(y[0], y[1]); wv.y = cvtpk(y[2], y[3]); *(u32x2_t*)(Hn + (size_t)t * 1024 + col) = wv; }
        }
    }
}
template <int CTRL> DI float dpp_f(float x) { return __int_as_float(__builtin_amdgcn_update_dpp(0, __float_as_int(x), CTRL, 0xF, 0xF, false)); }
DI float x32(float x) { auto r = __builtin_amdgcn_permlane32_swap(__float_as_uint(x), __float_as_uint(x), false, false); return (threadIdx.x & 32) ? __uint_as_float(r[0]) : __uint_as_float(r[1]); }
DI float x16(float x) { auto r = __builtin_amdgcn_permlane16_swap(__float_as_uint(x), __float_as_uint(x), false, false); return (threadIdx.x & 16) ? __uint_as_float(r[0]) : __uint_as_float(r[1]); }
typedef _Float16 h2_t __attribute__((ext_vector_type(2)));
DI unsigned f2hu(float lo, float hi) { const f32x2_t v = {lo, hi}; const h2_t h = __builtin_convertvector(v, h2_t); return __builtin_bit_cast(unsigned, h); }
DI unsigned bf2hu(unsigned w) { const f32x2_t v = {bflo(w), bfhi(w)}; const h2_t h = __builtin_convertvector(v, h2_t); return __builtin_bit_cast(unsigned, h); }
DI h2_t bf2h(unsigned w) { return (h2_t){(_Float16)bflo(w), (_Float16)bfhi(w)}; }
template <bool FAKE> DI void up8h(const u32x4 u, h2_t (&f)[8]) {
    if (FAKE) { f[0] = __builtin_bit_cast(h2_t, u.x & 0x3bff3bffu); f[1] = __builtin_bit_cast(h2_t, u.y & 0x3bff3bffu); f[2] = __builtin_bit_cast(h2_t, u.z & 0x3bff3bffu); f[3] = __builtin_bit_cast(h2_t, u.w & 0x3bff3bffu);
        f[4] = __builtin_bit_cast(h2_t, (u.x >> 1) & 0x3bff3bffu); f[5] = __builtin_bit_cast(h2_t, (u.y >> 1) & 0x3bff3bffu); f[6] = __builtin_bit_cast(h2_t, (u.z >> 1) & 0x3bff3bffu); f[7] = __builtin_bit_cast(h2_t, (u.w >> 1) & 0x3bff3bffu); return; }
    f[0] = __builtin_amdgcn_cvt_scalef32_pk_f16_fp8((int)u.x, 1.0f, false); f[1] = __builtin_amdgcn_cvt_scalef32_pk_f16_fp8((int)u.x, 1.0f, true);
    f[2] = __builtin_amdgcn_cvt_scalef32_pk_f16_fp8((int)u.y, 1.0f, false); f[3] = __builtin_amdgcn_cvt_scalef32_pk_f16_fp8((int)u.y, 1.0f, true);
    f[4] = __builtin_amdgcn_cvt_scalef32_pk_f16_fp8((int)u.z, 1.0f, false); f[5] = __builtin_amdgcn_cvt_scalef32_pk_f16_fp8((int)u.z, 1.0f, true);
    f[6] = __builtin_amdgcn_cvt_scalef32_pk_f16_fp8((int)u.w, 1.0f, false); f[7] = __builtin_amdgcn_cvt_scalef32_pk_f16_fp8((int)u.w, 1.0f, true); }
template <bool FAKE> DI float dot16h(const u32x4 u, const h2_t (&hh)[8]) { h2_t f[8]; up8h<FAKE>(u, f); float d0 = 0.f, d1 = 0.f;
#pragma unroll
    for (int q = 0; q < 8; q += 2) { d0 = __builtin_amdgcn_fdot2(f[q], hh[q], d0, false); d1 = __builtin_amdgcn_fdot2(f[q + 1], hh[q + 1], d1, false); }
    return d0 + d1; }
template <bool FINAL, bool FAKE = false, int SKIP = 0> DI void peer_gather_rounds(const Ctx& C, const bf16* Hin, const int* IDX, const float* GATE, const unsigned char* PU8, const unsigned char* PV8, const float* ISU, const float* ISV,
                                                 float* X, const float* g2, const float* ngain, const float* nmod, bf16* Hn) {
    const int lane = C.lane, w = C.wave;
    LAS u32x2_t* LIST = (LAS u32x2_t*)(C.lds + w * 14592);
    LAS unsigned char* HL = C.lds + w * 14592 + 4096;
    LAS unsigned* ALU = (LAS unsigned*)(C.lds + w * 14592 + 12288);
    LAS int* OFFS = (LAS int*)(C.lds + w * 14592 + 14336);
    LAS float* IHS = (LAS float*)(C.lds + w * 14592 + 14336 + 160);
    const unsigned long long ltmask = (1ull << lane) - 1ull;
    for (int grp = C.vcu; grp < TT / 32; grp += C.G) {
        const int t0 = grp * 32 + w * 4;
        {
            int ee[8]; float gg[8]; unsigned su[8]; float sv[8];
#pragma unroll
            for (int r = 0; r < 8; ++r) { const size_t a = (size_t)(t0 + (r >> 1)) * 128 + 64 * (r & 1) + lane; ee[r] = IDX[a]; gg[r] = GATE[a]; }
#pragma unroll
            for (int r = 0; r < 8; ++r) { su[r] = __float_as_uint(ISU[ee[r]]) >> 23; sv[r] = ISV[ee[r]]; }
            int pos[8]; int base = 0;
#pragma unroll 1
            for (int b = 0; b < 8; ++b) {
#pragma unroll
                for (int r = 0; r < 8; ++r) { if ((r & 1) == 0 && lane == 0) OFFS[b * 4 + (r >> 1)] = base;
                    const bool mine = (ee[r] >> 11) == b; const unsigned long long m = __ballot(mine); if (mine) pos[r] = base + __popcll(m & ltmask); base += __popcll(m); }
            }
            if (lane == 0) OFFS[32] = 512;
#pragma unroll
            for (int r = 0; r < 8; ++r) { u32x2_t en; en.x = (unsigned)ee[r] | ((unsigned)(r >> 1) << 14) | (su[r] << 16); en.y = __float_as_uint(gg[r] * sv[r]); LIST[pos[r]] = en; }
#pragma unroll
            for (int tk = 0; tk < 4; ++tk) { const u32x4 a = *(const u32x4*)(Hin + (size_t)(t0 + tk) * 1024 + lane * 16), bq = *(const u32x4*)(Hin + (size_t)(t0 + tk) * 1024 + lane * 16 + 8);
                const float hv_[16] = {bflo(a.x), bfhi(a.x), bflo(a.y), bfhi(a.y), bflo(a.z), bfhi(a.z), bflo(a.w), bfhi(a.w), bflo(bq.x), bfhi(bq.x), bflo(bq.y), bfhi(bq.y), bflo(bq.z), bfhi(bq.z), bflo(bq.w), bfhi(bq.w)};
                float am = 0.f;
#pragma unroll
                for (int q = 0; q < 16; ++q) am = fmaxf(am, fabsf(hv_[q]));
                am = wave_max(am);
                const int e_ = (int)((__float_as_uint(am) >> 23) & 0xffu) - 127; const bool ok_ = am > 1e-30f;
                const float sc_ = ok_ ? __uint_as_float((unsigned)(127 + 6 - e_) << 23) : 1.0f, isc_ = ok_ ? __uint_as_float((unsigned)(127 - 6 + e_) << 23) : 1.0f;
                u32x4 o8;
#pragma unroll
                for (int q = 0; q < 4; ++q) { unsigned wd = 0u;
#pragma unroll
                    for (int j = 0; j < 4; ++j) { int qi = (int)rintf(hv_[4 * q + j] * sc_); qi = qi > 127 ? 127 : (qi < -127 ? -127 : qi); wd |= ((unsigned)qi & 0xffu) << (8 * j); }
                    o8[q] = wd; }
                *(LAS u32x4*)(HL + tk * 1024 + lane * 16) = o8; if (lane == 0) IHS[tk] = isc_; }
        }
        LDS_WAIT();
        {
            const int jL = ((lane >> 5) & 1) * 4 + ((lane >> 4) & 1) * 2 + ((lane >> 3) & 1);
#define G1_LOAD(UB, TK, G0) do { const unsigned exl_ = LIST[(G0) + (lane & 7)].x; \
            _Pragma("unroll") for (int j = 0; j < 8; ++j) { const unsigned ex = (unsigned)__builtin_amdgcn_readlane((int)exl_, j); TK[j] = (int)((ex >> 14) & 3u); \
                UB[j] = *(const u32x4*)(PU8 + (size_t)(ex & (FAKE ? 0x7fu : 0x3fffu)) * 1024 + lane * 16); } } while (0)
#define G1_RUN(UB, TK, G0) do { int p[8]; \
            _Pragma("unroll") for (int j = 0; j < 8; ++j) { const u32x4 hq = *(const LAS u32x4*)(HL + TK[j] * 1024 + lane * 16); \
                int d_ = __builtin_amdgcn_sdot4((int)UB[j].x, (int)hq.x, 0, false); d_ = __builtin_amdgcn_sdot4((int)UB[j].y, (int)hq.y, d_, false); \
                d_ = __builtin_amdgcn_sdot4((int)UB[j].z, (int)hq.z, d_, false); p[j] = __builtin_amdgcn_sdot4((int)UB[j].w, (int)hq.w, d_, false); } \
            const bool h32 = lane & 32, h16 = lane & 16, h8 = lane & 8; int q4[4]; \
            _Pragma("unroll") for (int j = 0; j < 4; ++j) { const int keep = h32 ? p[j + 4] : p[j], send = h32 ? p[j] : p[j + 4]; q4[j] = keep + __float_as_int(x32(__int_as_float(send))); } \
            int q2[2]; \
            _Pragma("unroll") for (int j = 0; j < 2; ++j) { const int keep = h16 ? q4[j + 2] : q4[j], send = h16 ? q4[j] : q4[j + 2]; q2[j] = keep + __float_as_int(x16(__int_as_float(send))); } \
            int q1; { const int keep = h8 ? q2[1] : q2[0], send = h8 ? q2[0] : q2[1]; q1 = keep + __float_as_int(dpp_f<0x128>(__int_as_float(send))); } \
            q1 += __float_as_int(dpp_f<0x141>(__int_as_float(q1))); q1 += __float_as_int(dpp_f<0xB1>(__int_as_float(q1))); q1 += __float_as_int(dpp_f<0x4E>(__int_as_float(q1))); \
            if ((lane & 7) == 0) { const u32x2_t me = LIST[(G0) + jL]; const float av_ = gelu_t((float)q1 * IHS[(me.x >> 14) & 3u] * __uint_as_float((me.x >> 16) << 23)) * __uint_as_float(me.y); ALU[(G0) + jL] = f2hu(av_, av_); } } while (0)
            u32x4 ubA[8], ubB[8]; int tkA[8], tkB[8];
            G1_LOAD(ubA, tkA, 0);
#pragma unroll 1
            for (int g0 = 0; g0 < ((SKIP & 1) ? 0 : 512); g0 += 16) {
                G1_LOAD(ubB, tkB, g0 + 8);
                G1_RUN(ubA, tkA, g0);
                if (g0 + 16 < 512) G1_LOAD(ubA, tkA, g0 + 16);
                G1_RUN(ubB, tkB, g0 + 8);
            }
#undef G1_LOAD
#undef G1_RUN
        }
        LDS_WAIT();
        h2_t o[4][8], oc[8];
#pragma unroll
        for (int q = 0; q < 8; ++q) { oc[q] = (h2_t){(_Float16)0.f, (_Float16)0.f};
#pragma unroll
            for (int tk = 0; tk < 4; ++tk) o[tk][q] = (h2_t){(_Float16)0.f, (_Float16)0.f}; }
        {
            int curA = 0;
#define G2_FLUSH() do { if (curA == 0) { _Pragma("unroll") for (int q_ = 0; q_ < 8; ++q_) o[0][q_] += oc[q_]; } else if (curA == 1) { _Pragma("unroll") for (int q_ = 0; q_ < 8; ++q_) o[1][q_] += oc[q_]; } \
            else if (curA == 2) { _Pragma("unroll") for (int q_ = 0; q_ < 8; ++q_) o[2][q_] += oc[q_]; } else { _Pragma("unroll") for (int q_ = 0; q_ < 8; ++q_) o[3][q_] += oc[q_]; } \
            _Pragma("unroll") for (int q_ = 0; q_ < 8; ++q_) oc[q_] = (h2_t){(_Float16)0.f, (_Float16)0.f}; } while (0)
#define G2_LOAD(VB, AJ, TK, G0) do { const unsigned exl_ = LIST[(G0) + (lane & 7)].x; const unsigned all_ = ALU[(G0) + (lane & 7)]; \
            _Pragma("unroll") for (int j = 0; j < 8; ++j) { const unsigned ex = (unsigned)__builtin_amdgcn_readlane((int)exl_, j); TK[j] = (int)((ex >> 14) & 3u); AJ[j] = __builtin_bit_cast(h2_t, (unsigned)__builtin_amdgcn_readlane((int)all_, j)); \
                VB[j] = *(const u32x4*)(PV8 + (size_t)(ex & (FAKE ? 0x7fu : 0x3fffu)) * 1024 + lane * 16); } } while (0)
#define G2_ACC(VB, AJ, TK) do { _Pragma("unroll") for (int j = 0; j < 8; ++j) { if (TK[j] != curA) { G2_FLUSH(); curA = TK[j]; } h2_t f_[8]; up8h<FAKE>(VB[j], f_); _Pragma("unroll") for (int q = 0; q < 8; ++q) oc[q] = f_[q] * AJ[j] + oc[q]; } } while (0)
            u32x4 vbA[8], vbB[8]; h2_t ajA[8], ajB[8]; int tA[8], tB[8];
            G2_LOAD(vbA, ajA, tA, 0);
#pragma unroll 1
            for (int g0 = 0; g0 < ((SKIP & 2) ? 0 : 512); g0 += 16) {
                G2_LOAD(vbB, ajB, tB, g0 + 8);
                G2_ACC(vbA, ajA, tA);
                if (g0 + 16 < 512) G2_LOAD(vbA, ajA, tA, g0 + 16);
                G2_ACC(vbB, ajB, tB);
            }
            G2_FLUSH();
#undef G2_FLUSH
#undef G2_LOAD
#undef G2_ACC
        }
#pragma unroll
        for (int tk = 0; tk < 4; ++tk) {
            __builtin_amdgcn_sched_barrier(0);
            const int t = t0 + tk; const int b = t >> 13; const float* gp = g2 + (size_t)b * 6144; float* xr = X + (size_t)t * 1024;
            float xn[16]; float ss = 0.f;
#pragma unroll
            for (int q = 0; q < 4; ++q) { const int col = lane * 16 + q * 4; const f32x4 xv = *(const f32x4*)(xr + col), gv = *(const f32x4*)(gp + col);
#pragma unroll
                for (int j = 0; j < 4; ++j) { const float y = xv[j] + gv[j] * (float)o[tk][q * 2 + (j >> 1)][j & 1]; xn[q * 4 + j] = y; ss += y * y; } }
            const float rstd = 1.0f / sqrtf(wave_sum(ss) * (1.0f / 1024.0f) + EPS);
            if (FINAL) {
#pragma unroll
                for (int q = 0; q < 4; ++q) { const int col = lane * 16 + q * 4; const f32x4 gn = *(const f32x4*)(ngain + col); f32x4 y;
#pragma unroll
                    for (int j = 0; j < 4; ++j) y[j] = xn[q * 4 + j] * rstd * gn[j];
                    *(f32x4*)(xr + col) = y; }
            } else {
                const float* nm = nmod + (size_t)b * 6144;
#pragma unroll
                for (int q = 0; q < 4; ++q) { const int col = lane * 16 + q * 4; const f32x4 gn = *(const f32x4*)(ngain + col), sh = *(const f32x4*)(nm + col), sc = *(const f32x4*)(nm + 1024 + col); f32x4 xo; float y[4];
#pragma unroll
                    for (int j = 0; j < 4; ++j) { xo[j] = xn[q * 4 + j]; y[j] = xn[q * 4 + j] * rstd * gn[j] * (1.0f + sc[j]) + sh[j]; }
                    *(f32x4*)(xr + col) = xo; u32x2_t wv; wv.x = cvtpk(y[0], y[1]); wv.y = cvtpk(y[2], y[3]); *(u32x2_t*)(Hn + (size_t)t * 1024 + col) = wv; }
            }
        }
        LDS_WAIT();
    }
}
constexpr int GR_R = 12;
DI void glds_row(const unsigned char* gsrc_lane, unsigned lds_dst) { unsigned keep;
    asm volatile("s_mov_b32 %0, m0\n\ts_mov_b32 m0, %2\n\ts_nop 0\n\tglobal_load_lds_dwordx4 %1, off\n\ts_mov_b32 m0, %0" : "=&s"(keep) : "v"(gsrc_lane), "s"(lds_dst) : "memory"); }
template <bool FINAL> DI void peer_gather_dma(const Ctx& C, const bf16* Hin, const int* IDX, const float* GATE, const unsigned char* PU8, const unsigned char* PV8, const float* ISU, const float* ISV,
                                              float* X, const float* g2, const float* ngain, const float* nmod, bf16* Hn) {
    const int lane = C.lane, w = C.wave;
    constexpr int WB = 4096 + 2048 + 256 + GR_R * 1024;
    LAS u32x2_t* LIST = (LAS u32x2_t*)(C.lds + w * WB);
    LAS float* AL = (LAS float*)(C.lds + w * WB + 4096);
    LAS int* OFFS = (LAS int*)(C.lds + w * WB + 6144);
    LAS unsigned char* RING = C.lds + w * WB + 6400;
    const unsigned ring0 = (unsigned)__builtin_amdgcn_readfirstlane((int)(unsigned)(size_t)RING);
    const unsigned long long ltmask = (1ull << lane) - 1ull;
#define GR_REFILL(nv_) do { unsigned ex8_[8]; _Pragma("unroll") for (int j_ = 0; j_ < 8; ++j_) ex8_[j_] = (j_ < (nv_) && nf + j_ < 1024) ? LIST[(nf + j_) & 511].x : 0u; \
        _Pragma("unroll") for (int j_ = 0; j_ < 8; ++j_) if (j_ < (nv_) && nf + j_ < 1024) { const int f_ = nf + j_; const unsigned e_ = (unsigned)__builtin_amdgcn_readfirstlane((int)ex8_[j_]) & 0x3fffu; \
            const unsigned char* tb_ = (f_ < 512) ? PU8 : PV8; glds_row(tb_ + (size_t)e_ * 1024 + lane * 16, ring0 + (unsigned)(f_ % GR_R) * 1024u); } \
        nf += (nv_); if (nf > 1024) nf = 1024; } while (0)
#define GR_ISSUE(f) do { const int f_ = (f); const unsigned ex_ = (unsigned)__builtin_amdgcn_readfirstlane((int)LIST[f_ & 511].x); \
        const unsigned char* tb_ = (f_ < 512) ? PU8 : PV8; glds_row(tb_ + (size_t)(ex_ & 0x3fffu) * 1024 + lane * 16, ring0 + (unsigned)(f_ % GR_R) * 1024u); } while (0)
    for (int grp = C.vcu; grp < TT / 32; grp += C.G) {
        const int t0 = grp * 32 + w * 4;
        float hv4[4][16];
        {
            int ee[8]; float gg[8]; unsigned su[8]; float sv[8];
#pragma unroll
            for (int r = 0; r < 8; ++r) { const size_t a = (size_t)(t0 + (r >> 1)) * 128 + 64 * (r & 1) + lane; ee[r] = IDX[a]; gg[r] = GATE[a]; }
#pragma unroll
            for (int r = 0; r < 8; ++r) { su[r] = __float_as_uint(ISU[ee[r]]) >> 23; sv[r] = ISV[ee[r]]; }
            int pos[8]; int base = 0;
#pragma unroll 1
            for (int b = 0; b < 8; ++b) {
#pragma unroll
                for (int r = 0; r < 8; ++r) { if ((r & 1) == 0 && lane == 0) OFFS[b * 4 + (r >> 1)] = base;
                    const bool mine = (ee[r] >> 11) == b; const unsigned long long m = __ballot(mine); if (mine) pos[r] = base + __popcll(m & ltmask); base += __popcll(m); }
            }
            if (lane == 0) OFFS[32] = 512;
#pragma unroll
            for (int r = 0; r < 8; ++r) { u32x2_t en; en.x = (unsigned)ee[r] | ((unsigned)(r >> 1) << 14) | (su[r] << 16); en.y = __float_as_uint(gg[r] * sv[r]); LIST[pos[r]] = en; }
#pragma unroll
            for (int tk = 0; tk < 4; ++tk) { const u32x4 a = *(const u32x4*)(Hin + (size_t)(t0 + tk) * 1024 + lane * 16), bq = *(const u32x4*)(Hin + (size_t)(t0 + tk) * 1024 + lane * 16 + 8);
                hv4[tk][0] = bflo(a.x); hv4[tk][1] = bfhi(a.x); hv4[tk][2] = bflo(a.y); hv4[tk][3] = bfhi(a.y); hv4[tk][4] = bflo(a.z); hv4[tk][5] = bfhi(a.z); hv4[tk][6] = bflo(a.w); hv4[tk][7] = bfhi(a.w);
                hv4[tk][8] = bflo(bq.x); hv4[tk][9] = bfhi(bq.x); hv4[tk][10] = bflo(bq.y); hv4[tk][11] = bfhi(bq.y); hv4[tk][12] = bflo(bq.z); hv4[tk][13] = bfhi(bq.z); hv4[tk][14] = bflo(bq.w); hv4[tk][15] = bfhi(bq.w); }
        }
        asm volatile("s_waitcnt vmcnt(0) lgkmcnt(0)" ::: "memory");
        int nf = GR_R;
#pragma unroll 1
        for (int f = 0; f < GR_R; ++f) GR_ISSUE(f);
        {
            const int jL = ((lane >> 5) & 1) * 4 + ((lane >> 4) & 1) * 2 + ((lane >> 3) & 1);
#pragma unroll 1
            for (int r = 0; r < 8; ++r) {
#pragma unroll
                for (int tk = 0; tk < 4; ++tk) {
                    const int beg = __builtin_amdgcn_readfirstlane(OFFS[r * 4 + tk]), end = __builtin_amdgcn_readfirstlane(OFFS[r * 4 + tk + 1]);
#pragma unroll 1
                    for (int g0 = beg; g0 < end; g0 += 8) {
                        const int nv = (end - g0) < 8 ? (end - g0) : 8;
                        asm volatile("s_waitcnt vmcnt(4)" ::: "memory");
                        float p[8];
#pragma unroll
                        for (int j = 0; j < 8; ++j) { p[j] = 0.f;
                            if (j < nv) { const u32x4 row = *(const LAS u32x4*)(RING + ((g0 + j) % GR_R) * 1024 + lane * 16); p[j] = dot16(row, hv4[tk]); } }
                        asm volatile("s_waitcnt lgkmcnt(0)" ::: "memory");
                        GR_REFILL(nv);
                        const bool h32 = lane & 32, h16 = lane & 16, h8 = lane & 8;
                        float q4[4];
#pragma unroll
                        for (int j = 0; j < 4; ++j) { const float keep = h32 ? p[j + 4] : p[j], send = h32 ? p[j] : p[j + 4]; q4[j] = keep + __shfl_xor(send, 32); }
                        float q2[2];
#pragma unroll
                        for (int j = 0; j < 2; ++j) { const float keep = h16 ? q4[j + 2] : q4[j], send = h16 ? q4[j] : q4[j + 2]; q2[j] = keep + __shfl_xor(send, 16); }
                        float q1; { const float keep = h8 ? q2[1] : q2[0], send = h8 ? q2[0] : q2[1]; q1 = keep + __shfl_xor(send, 8); }
                        q1 += __shfl_xor(q1, 4); q1 += __shfl_xor(q1, 2); q1 += __shfl_xor(q1, 1);
                        if ((lane & 7) == 0 && jL < nv) { const u32x2_t me = LIST[g0 + jL]; AL[g0 + jL] = gelu_t(q1 * __uint_as_float((me.x >> 16) << 23)) * __uint_as_float(me.y); }
                    }
                }
            }
        }
        float o[4][16];
#pragma unroll
        for (int tk = 0; tk < 4; ++tk)
#pragma unroll
            for (int q = 0; q < 16; ++q) o[tk][q] = 0.f;
#pragma unroll 1
        for (int r = 0; r < 8; ++r) {
#pragma unroll
            for (int tk = 0; tk < 4; ++tk) {
                const int beg = __builtin_amdgcn_readfirstlane(OFFS[r * 4 + tk]), end = __builtin_amdgcn_readfirstlane(OFFS[r * 4 + tk + 1]);
#pragma unroll 1
                for (int i0 = beg; i0 < end; i0 += 8) {
                    const int nv = (end - i0) < 8 ? (end - i0) : 8;
                    if (i0 <= 500) asm volatile("s_waitcnt vmcnt(4)" ::: "memory"); else asm volatile("s_waitcnt vmcnt(0)" ::: "memory");
                    float aq[8]; u32x4 rw[8];
#pragma unroll
                    for (int j = 0; j < 8; ++j) { aq[j] = (j < nv) ? AL[i0 + j] : 0.f; }
#pragma unroll
                    for (int j = 0; j < 8; ++j) if (j < nv) rw[j] = *(const LAS u32x4*)(RING + ((512 + i0 + j) % GR_R) * 1024 + lane * 16);
#pragma unroll
                    for (int j = 0; j < 8; ++j) if (j < nv) { const float aj = __int_as_float(__builtin_amdgcn_readfirstlane(__float_as_int(aq[j])));
                        float f_[16]; up8(rw[j].x, f_[0], f_[1], f_[2], f_[3]); up8(rw[j].y, f_[4], f_[5], f_[6], f_[7]); up8(rw[j].z, f_[8], f_[9], f_[10], f_[11]); up8(rw[j].w, f_[12], f_[13], f_[14], f_[15]);
#pragma unroll
                        for (int q = 0; q < 16; ++q) o[tk][q] += aj * f_[q]; }
                    asm volatile("s_waitcnt lgkmcnt(0)" ::: "memory");
                    GR_REFILL(nv);
                }
            }
        }
        asm volatile("s_waitcnt vmcnt(0)" ::: "memory");
#pragma unroll
        for (int tk = 0; tk < 4; ++tk) {
            const int t = t0 + tk; const int b = t >> 13; const float* gp = g2 + (size_t)b * 6144; float* xr = X + (size_t)t * 1024;
            float xn[16]; float ss = 0.f;
#pragma unroll
            for (int q = 0; q < 4; ++q) { const int col = lane * 16 + q * 4; const f32x4 xv = *(const f32x4*)(xr + col), gv = *(const f32x4*)(gp + col);
#pragma unroll
                for (int j = 0; j < 4; ++j) { const float y = xv[j] + gv[j] * o[tk][q * 4 + j]; xn[q * 4 + j] = y; ss += y * y; } }
            const float rstd = 1.0f / sqrtf(wave_sum(ss) * (1.0f / 1024.0f) + EPS);
            if (FINAL) {
#pragma unroll
                for (int q = 0; q < 4; ++q) { const int col = lane * 16 + q * 4; const f32x4 gn = *(const f32x4*)(ngain + col); f32x4 y;
#pragma unroll
                    for (int j = 0; j < 4; ++j) y[j] = xn[q * 4 + j] * rstd * gn[j];
                    *(f32x4*)(xr + col) = y; }
            } else {
                const float* nm = nmod + (size_t)b * 6144;
#pragma unroll
                for (int q = 0; q < 4; ++q) { const int col = lane * 16 + q * 4; const f32x4 gn = *(const f32x4*)(ngain + col), sh = *(const f32x4*)(nm + col), sc = *(const f32x4*)(nm + 1024 + col); f32x4 xo; float y[4];
#pragma unroll
                    for (int j = 0; j < 4; ++j) { xo[j] = xn[q * 4 + j]; y[j] = xn[q * 4 + j] * rstd * gn[j] * (1.0f + sc[j]) + sh[j]; }
                    *(f32x4*)(xr + col) = xo; u32x2_t wv; wv.x = cvtpk(y[0], y[1]); wv.y = cvtpk(y[2], y[3]); *(u32x2_t*)(Hn + (size_t)t * 1024 + col) = wv; }
            }
        }
        asm volatile("s_waitcnt vmcnt(0) lgkmcnt(0)" ::: "memory");
    }
#undef GR_ISSUE
#undef GR_REFILL
}
DI float red4_sum(float x) { auto a = __builtin_amdgcn_permlane16_swap(__float_as_uint(x), __float_as_uint(x), false, false); x = __uint_as_float(a[0]) + __uint_as_float(a[1]);
    auto b = __builtin_amdgcn_permlane32_swap(__float_as_uint(x), __float_as_uint(x), false, false); return __uint_as_float(b[0]) + __uint_as_float(b[1]); }
DI float red4_max(float x) { auto a = __builtin_amdgcn_permlane16_swap(__float_as_uint(x), __float_as_uint(x), false, false); x = fmaxf(__uint_as_float(a[0]), __uint_as_float(a[1]));
    auto b = __builtin_amdgcn_permlane32_swap(__float_as_uint(x), __float_as_uint(x), false, false); return fmaxf(__uint_as_float(b[0]), __uint_as_float(b[1])); }
DI float red4_min(float x) { auto a = __builtin_amdgcn_permlane16_swap(__float_as_uint(x), __float_as_uint(x), false, false); x = fminf(__uint_as_float(a[0]), __uint_as_float(a[1]));
    auto b = __builtin_amdgcn_permlane32_swap(__float_as_uint(x), __float_as_uint(x), false, false); return fminf(__uint_as_float(b[0]), __uint_as_float(b[1])); }
constexpr int TK_NI = 6;
DI float tk_pivot(float clo, float chi) {
    const float lc = __builtin_amdgcn_logf(clo), lh = __builtin_amdgcn_logf(fmaxf(chi, 0.5f));
    const float f = (lc - 4.0443941f) * __builtin_amdgcn_rcpf(lc - lh);
    return fminf(fmaxf(f, 0.06f), 0.94f);
}
template <int NV> DI float tk_count(const float (&v)[NV], float mid) {
    const float nb = -mid * 1.099511627776e12f;
    float c[4] = {0.f, 0.f, 0.f, 0.f};
#pragma unroll
    for (int i = 0; i < NV; ++i) c[i & 3] += __builtin_amdgcn_fmed3f(__builtin_fmaf(v[i], 1.099511627776e12f, nb), 0.f, 1.f);
    return red4_sum((c[0] + c[1]) + (c[2] + c[3]));
}
constexpr int tk2_pair(int n) {
    int k = 0;
    for (int i = 0; i < 16; ++i) for (int j = 0; j < 16; ++j) if ((i + 1) * (j + 1) <= 16) { if (k == n) return i | (j << 8); ++k; }
    return n == 50 ? (15 | (15 << 8)) : (15 | (14 << 8));
}
#ifndef TK_STEP_N
#define TK_STEP_N 2
#endif
constexpr int TK_STEP = TK_STEP_N;
template <int NV> DI void tk_search(const float (&v)[NV], float ntot, float& thr_out) {
    float mx = v[0], mn = v[0];
#pragma unroll
    for (int i = 1; i < NV; ++i) { mx = fmaxf(mx, v[i]); mn = fminf(mn, v[i]); }
    mx = red4_max(mx); mn = red4_min(mn);
    float lo = mn, hi = mx, clo = ntot - 1.0f, chi = 0.0f; bool done = false;
#pragma unroll 1
    for (int iter = 0; iter < 48; ++iter) {
        const bool rdy = done || clo <= 16.0f + (float)TK_STEP;
        if (__all(rdy)) break;
        float fr_ = tk_pivot(clo, chi); if (iter >= TK_NI) fr_ = 0.5f;
        const float mid = rdy ? lo : lo + (hi - lo) * fr_;
        const float cnt = tk_count<NV>(v, mid);
        if (!rdy) { if (cnt == 16.0f) { lo = mid; clo = 16.0f; done = true; } else if (cnt > 16.0f) { lo = mid; clo = cnt; } else { hi = mid; chi = cnt; } }
    }
    const float sl = lo;
#pragma unroll 1
    for (int r = 0; r < TK_STEP; ++r) {
        const bool nd = clo > 16.0f;
        if (!__any(nd)) break;
        float y = 3.0e38f;
#pragma unroll
        for (int i = 0; i < NV; ++i) y = fminf(y, v[i] > lo ? v[i] : 3.0e38f);
        y = red4_min(y);
        if (nd) { lo = y; clo -= 1.0f; }
    }
    if (__any(!done)) { const float c = tk_count<NV>(v, lo); if (c != 16.0f) lo = sl; }
    thr_out = lo;
}
DI void tk_search2(const float (&v0)[32], const float (&v1)[32], float& t0, float& t1) {
    float mx0 = v0[0], mn0 = v0[0], mx1 = v1[0], mn1 = v1[0], s0 = v0[0], s1 = v1[0], q0 = v0[0] * v0[0], q1 = v1[0] * v1[0];
#pragma unroll
    for (int i = 1; i < 32; ++i) { mx0 = fmaxf(mx0, v0[i]); mn0 = fminf(mn0, v0[i]); mx1 = fmaxf(mx1, v1[i]); mn1 = fminf(mn1, v1[i]);
        s0 += v0[i]; s1 += v1[i]; q0 = __builtin_fmaf(v0[i], v0[i], q0); q1 = __builtin_fmaf(v1[i], v1[i], q1); }
    mx0 = red4_max(mx0); mn0 = red4_min(mn0); mx1 = red4_max(mx1); mn1 = red4_min(mn1); s0 = red4_sum(s0); s1 = red4_sum(s1); q0 = red4_sum(q0); q1 = red4_sum(q1);
    const float me0 = s0 * (1.0f / 128.0f), me1 = s1 * (1.0f / 128.0f);
    const float g0 = fminf(fmaxf(me0 + 1.05f * sqrtf(fmaxf(q0 * (1.0f / 128.0f) - me0 * me0, 0.f)), mn0), mx0), g1 = fminf(fmaxf(me1 + 1.05f * sqrtf(fmaxf(q1 * (1.0f / 128.0f) - me1 * me1, 0.f)), mn1), mx1);
    float lo0 = mn0, hi0 = mx0, clo0 = 127.0f, chi0 = 0.0f; bool done0 = false;
    float lo1 = mn1, hi1 = mx1, clo1 = 127.0f, chi1 = 0.0f; bool done1 = false;
#pragma unroll 1
    for (int iter = 0; iter < 48; ++iter) {
        const bool r0 = done0 || clo0 <= 16.0f + (float)TK_STEP, r1 = done1 || clo1 <= 16.0f + (float)TK_STEP;
        if (__all(r0 && r1)) break;
        float f0 = tk_pivot(clo0, chi0), f1 = tk_pivot(clo1, chi1); if (iter >= TK_NI) { f0 = 0.5f; f1 = 0.5f; }
        float mid0 = lo0 + (hi0 - lo0) * f0, mid1 = lo1 + (hi1 - lo1) * f1; if (iter == 0) { mid0 = g0; mid1 = g1; }
        if (r0) mid0 = lo0; if (r1) mid1 = lo1;
        const float c0 = tk_count<32>(v0, mid0), c1 = tk_count<32>(v1, mid1);
        if (!r0) { if (c0 == 16.0f) { lo0 = mid0; clo0 = 16.0f; done0 = true; } else if (c0 > 16.0f) { lo0 = mid0; clo0 = c0; } else { hi0 = mid0; chi0 = c0; } }
        if (!r1) { if (c1 == 16.0f) { lo1 = mid1; clo1 = 16.0f; done1 = true; } else if (c1 > 16.0f) { lo1 = mid1; clo1 = c1; } else { hi1 = mid1; chi1 = c1; } }
    }
    const float sl0 = lo0, sl1 = lo1;
#pragma unroll 1
    for (int r = 0; r < TK_STEP; ++r) {
        const bool n0 = clo0 > 16.0f, n1 = clo1 > 16.0f;
        if (!__any(n0 || n1)) break;
        float y0 = 3.0e38f, y1 = 3.0e38f;
#pragma unroll
        for (int i = 0; i < 32; ++i) { y0 = fminf(y0, v0[i] > lo0 ? v0[i] : 3.0e38f); y1 = fminf(y1, v1[i] > lo1 ? v1[i] : 3.0e38f); }
        y0 = red4_min(y0); y1 = red4_min(y1);
        if (n0) { lo0 = y0; clo0 -= 1.0f; }
        if (n1) { lo1 = y1; clo1 -= 1.0f; }
    }
    if (__any(!done0 || !done1)) {
        const float c0 = tk_count<32>(v0, lo0), c1 = tk_count<32>(v1, lo1);
        if (c0 != 16.0f) lo0 = sl0; if (c1 != 16.0f) lo1 = sl1;
    }
    t0 = lo0; t1 = lo1;
}
template <int N> struct tk2_pair_c { static constexpr int value = tk2_pair(N); };
template <int MODE = 0> DI void peer_topk_fused(const Ctx& C, const bf16* QP, const bf16* KEYS, int* IDX, float* GATE) {
    constexpr int KPI = 288;
    const int lane = C.lane, fr = lane & 15, fq = lane >> 4, w = C.wave;
    LAS unsigned char* KS = C.lds;
    LAS unsigned char* WB = C.lds + 73728 + w * 7168;
    LAS float* LV = (LAS float*)(WB);
    LAS int* LK = (LAS int*)(WB + 2176);
    LAS float* FV = (LAS float*)(WB + 4352);
    LAS int* FI = (LAS int*)(WB + 5504);
    LAS float* TRASH = (LAS float*)(WB + 6656) + lane;
    const int h = C.vcu & 7, nb = C.G >> 3;
    { const bf16* kg = KEYS + (size_t)h * 2 * 128 * 128;
      for (int c = C.tid; c < 4096; c += 512) { const int r = c >> 4, cc = c & 15; *(LAS u32x4*)(KS + r * KPI + cc * 16) = *(const u32x4*)(kg + (size_t)r * 128 + cc * 8); } }
    __syncthreads();
    int cof[13];
#define TK2_COF(c) cof[c] = fq == 0 ? tk2_pair_c<4 * (c)>::value : fq == 1 ? tk2_pair_c<4 * (c) + 1>::value : fq == 2 ? tk2_pair_c<4 * (c) + 2>::value : tk2_pair_c<4 * (c) + 3>::value
    TK2_COF(0); TK2_COF(1); TK2_COF(2); TK2_COF(3); TK2_COF(4); TK2_COF(5); TK2_COF(6); TK2_COF(7); TK2_COF(8); TK2_COF(9); TK2_COF(10); TK2_COF(11); TK2_COF(12);
#undef TK2_COF
    for (int tt = (C.vcu >> 3) + nb * w; tt < 1024; tt += nb * 8) {
        const int tok = tt * 16 + fr;
        float sc0[32], sc1[32];
#pragma unroll
        for (int p = 0; p < 2; ++p) {
            bf16x8 qf[4];
#pragma unroll
            for (int ks = 0; ks < 4; ++ks) qf[ks] = *(const bf16x8*)(QP + (size_t)tok * 2048 + h * 256 + p * 128 + ks * 32 + fq * 8);
#pragma unroll
            for (int kt = 0; kt < 8; ++kt) {
                f32x4 acc = {0.f, 0.f, 0.f, 0.f};
#pragma unroll
                for (int ks = 0; ks < 4; ++ks) { const bf16x8 kf = *(const LAS bf16x8*)(KS + (p * 128 + kt * 16 + fr) * KPI + (ks * 32 + fq * 8) * 2);
                    acc = __builtin_amdgcn_mfma_f32_16x16x32_bf16(kf, qf[ks], acc, 0, 0, 0); }
                if (p == 0) { sc0[kt * 4 + 0] = acc[0]; sc0[kt * 4 + 1] = acc[1]; sc0[kt * 4 + 2] = acc[2]; sc0[kt * 4 + 3] = acc[3]; }
                else { sc1[kt * 4 + 0] = acc[0]; sc1[kt * 4 + 1] = acc[1]; sc1[kt * 4 + 2] = acc[2]; sc1[kt * 4 + 3] = acc[3]; }
            }
        }
        float thrA = 1.0f, thrB = 1.0f; if (MODE == 0) tk_search2(sc0, sc1, thrA, thrB);
#pragma unroll
        for (int p = 0; p < 2; ++p) {
            const float thr = p == 0 ? thrA : thrB;
            int cnt = 0;
#pragma unroll
            for (int i = 0; i < 32; ++i) cnt += ((p == 0 ? sc0[i] : sc1[i]) > thr) ? 1 : 0;
            const int c0 = __shfl(cnt, fr), c1 = __shfl(cnt, fr + 16), c2 = __shfl(cnt, fr + 32);
            int pos = (fq > 0 ? c0 : 0) + (fq > 1 ? c1 : 0) + (fq > 2 ? c2 : 0);
#pragma unroll
            for (int i = 0; i < 32; ++i) { const float vv = p == 0 ? sc0[i] : sc1[i]; const bool s = vv > thr && pos < 16;
                LAS float* pv = s ? (LV + fr * 33 + p * 16 + pos) : TRASH; LAS int* pk = s ? (LK + fr * 33 + p * 16 + pos) : (LAS int*)TRASH;
                *pv = vv; *pk = (i >> 2) * 16 + 4 * fq + (i & 3); pos += (vv > thr) ? 1 : 0; }
        }
        LDS_WAIT();
        {
            const int lb = fr * 33 + (fq >> 1) * 16, e0 = 8 * (fq & 1);
            float L[16], ownv[8], own[8]; int okey[8], rk[8];
#pragma unroll
            for (int q = 0; q < 16; ++q) L[q] = __uint_as_float((__float_as_uint(LV[lb + q]) & ~15u) | (unsigned)q);
#pragma unroll
            for (int i = 0; i < 8; ++i) { ownv[i] = LV[lb + e0 + i]; okey[i] = LK[lb + e0 + i]; own[i] = __uint_as_float((__float_as_uint(ownv[i]) & ~15u) | (unsigned)(e0 + i)); }
#pragma unroll
            for (int i = 0; i < 8; ++i) { int r = 0;
#pragma unroll
                for (int q = 0; q < 16; ++q) r += (L[q] > own[i]) ? 1 : 0;
                rk[i] = r; }
#pragma unroll
            for (int i = 0; i < 8; ++i) { LV[lb + rk[i]] = ownv[i]; LK[lb + rk[i]] = okey[i]; }
        }
        LDS_WAIT();
        float sm[13]; int ca[13], cb[13];
#pragma unroll
        for (int c = 0; c < 13; ++c) { ca[c] = fr * 33 + (cof[c] & 255); cb[c] = fr * 33 + 16 + (cof[c] >> 8); sm[c] = LV[ca[c]] + LV[cb[c]]; }
        float thr2 = 4.0f; if (MODE == 0) tk_search<13>(sm, 52.0f, thr2);
        {
            int cnt = 0;
#pragma unroll
            for (int i = 0; i < 13; ++i) cnt += (sm[i] > thr2) ? 1 : 0;
            const int c0 = __shfl(cnt, fr), c1 = __shfl(cnt, fr + 16), c2 = __shfl(cnt, fr + 32);
            int pos = (fq > 0 ? c0 : 0) + (fq > 1 ? c1 : 0) + (fq > 2 ? c2 : 0);
#pragma unroll
            for (int i = 0; i < 13; ++i) { const bool s = sm[i] > thr2 && pos < 16;
                LAS float* pv = s ? (FV + fr * 17 + pos) : TRASH; LAS int* pk = s ? (FI + fr * 17 + pos) : (LAS int*)TRASH;
                *pv = sm[i]; *pk = LK[ca[i]] * 128 + LK[cb[i]]; pos += (sm[i] > thr2) ? 1 : 0; }
        }
        LDS_WAIT();
        float x[4]; int xi[4];
#pragma unroll
        for (int j = 0; j < 4; ++j) { x[j] = FV[fr * 17 + 4 * fq + j]; xi[j] = FI[fr * 17 + 4 * fq + j]; }
        float m = red4_max(fmaxf(fmaxf(x[0], x[1]), fmaxf(x[2], x[3])));
        float e[4]; float s = 0.f;
#pragma unroll
        for (int j = 0; j < 4; ++j) { e[j] = __expf(x[j] - m); s += e[j]; }
        s = red4_sum(s);
        const float inv = 1.0f / s;
        const size_t ob = ((size_t)tok * 8 + h) * 16 + 4 * fq;
        typedef int i32x4 __attribute__((ext_vector_type(4)));
        *(i32x4*)(IDX + ob) = (i32x4){xi[0], xi[1], xi[2], xi[3]}; *(f32x4*)(GATE + ob) = (f32x4){e[0] * inv, e[1] * inv, e[2] * inv, e[3] * inv};
        LDS_WAIT();
    }
}
DI void intra_mfma(const Ctx& C, const bf16* Q, const bf16* K, const bf16* V, const bf16* CROSS, bf16* G) {
    constexpr int RPI = 544, PPI = 144, VPI = 544;
    LAS unsigned char* Qs = C.lds; LAS unsigned char* Ks = Qs + 64 * RPI; LAS unsigned char* Ps = Ks + 64 * RPI; LAS unsigned char* Vs = Ps + 64 * PPI;
    LAS float* red = (LAS float*)(Vs + 64 * VPI);
    const int tid = C.tid, lane = C.lane, w = C.wave, fr = lane & 15, fq = lane >> 4;
    for (int item = C.vcu; item < 1024; item += C.G) {
        const int b = item >> 9, h = (item >> 7) & 3, n = item & 127;
        const float lg2 = log2f(1.0f - exp2f(-5.0f - (float)h));
        const size_t tok0 = (size_t)b * SEQ + (size_t)n * 64;
#pragma unroll
        for (int u = 0; u < 4; ++u) { const int c = tid + 512 * u, r = c >> 5, cc = c & 31;
            *(LAS u32x4*)(Qs + r * RPI + cc * 16) = *(const u32x4*)(Q + (tok0 + r) * 1024 + h * 256 + cc * 8);
            *(LAS u32x4*)(Ks + r * RPI + cc * 16) = *(const u32x4*)(K + (tok0 + r) * 1024 + h * 256 + cc * 8);
            *(LAS u32x4*)(Vs + r * VPI + cc * 16) = *(const u32x4*)(V + (tok0 + r) * 2048 + h * 512 + cc * 8); }
        __syncthreads();
        { const int jt = w >> 1; f32x4 sa[2] = {(f32x4){0.f, 0.f, 0.f, 0.f}, (f32x4){0.f, 0.f, 0.f, 0.f}};
#pragma unroll
          for (int ks = 0; ks < 8; ++ks) { const bf16x8 kf = *(const LAS bf16x8*)(Ks + (16 * jt + fr) * RPI + (32 * ks + 8 * fq) * 2);
#pragma unroll
              for (int q = 0; q < 2; ++q) { const int it = 2 * (w & 1) + q; const bf16x8 qf = *(const LAS bf16x8*)(Qs + (16 * it + fr) * RPI + (32 * ks + 8 * fq) * 2);
                  sa[q] = __builtin_amdgcn_mfma_f32_16x16x32_bf16(kf, qf, sa[q], 0, 0, 0); } }
#pragma unroll
          for (int q = 0; q < 2; ++q) { const int i = 16 * (2 * (w & 1) + q) + fr, j0 = 16 * jt + 4 * fq; float pv[4];
#pragma unroll
              for (int r = 0; r < 4; ++r) { const int dd = i > j0 + r ? i - j0 - r : j0 + r - i; pv[r] = sa[q][r] * exp2f(lg2 * (float)dd); }
              u32x2_t o; o.x = cvtpk(pv[0], pv[1]); o.y = cvtpk(pv[2], pv[3]); *(LAS u32x2_t*)(Ps + i * PPI + j0 * 2) = o; } }
        __syncthreads();
        f32x4 acc[2][2][4];
#pragma unroll
        for (int hf = 0; hf < 2; ++hf) {
#pragma unroll
            for (int et = 0; et < 2; ++et)
#pragma unroll
                for (int it = 0; it < 4; ++it) acc[hf][et][it] = (f32x4){0.f, 0.f, 0.f, 0.f};
            if (hf == 1) { __syncthreads();
#pragma unroll
                for (int u = 0; u < 4; ++u) { const int c = tid + 512 * u, r = c >> 5, cc = c & 31;
                    *(LAS u32x4*)(Vs + r * VPI + cc * 16) = *(const u32x4*)(V + (tok0 + r) * 2048 + h * 512 + 256 + cc * 8); }
                __syncthreads(); }
#pragma unroll
            for (int ks = 0; ks < 2; ++ks) {
                bf16x8 pf[4];
#pragma unroll
                for (int it = 0; it < 4; ++it) { const LAS unsigned char* pp = Ps + (16 * it + fr) * PPI + (32 * ks + 4 * fq) * 2;
                    const u32x2_t lo = *(const LAS u32x2_t*)pp, hi = *(const LAS u32x2_t*)(pp + 32); u32x4 ww; ww.x = lo.x; ww.y = lo.y; ww.z = hi.x; ww.w = hi.y; pf[it] = __builtin_bit_cast(bf16x8, ww); }
#pragma unroll
                for (int et = 0; et < 2; ++et) { const LAS unsigned char* vp = Vs + (32 * ks + 4 * fq + (fr >> 2)) * VPI + (32 * w + 16 * et + 4 * (fr & 3)) * 2;
                    const bf16x8 vf = cat8(trr(vp), trr(vp + 16 * VPI));
#pragma unroll
                    for (int it = 0; it < 4; ++it) acc[hf][et][it] = __builtin_amdgcn_mfma_f32_16x16x32_bf16(vf, pf[it], acc[hf][et][it], 0, 0, 0); }
            }
        }
        float ssq[4] = {0.f, 0.f, 0.f, 0.f};
#pragma unroll
        for (int hf = 0; hf < 2; ++hf)
#pragma unroll
            for (int et = 0; et < 2; ++et)
#pragma unroll
                for (int it = 0; it < 4; ++it) { const u32x2_t cv = *(const u32x2_t*)(CROSS + (tok0 + 16 * it + fr) * 2048 + h * 512 + hf * 256 + 32 * w + 16 * et + 4 * fq);
                    f32x4 y = acc[hf][et][it]; y[0] += bflo(cv.x); y[1] += bfhi(cv.x); y[2] += bflo(cv.y); y[3] += bfhi(cv.y); acc[hf][et][it] = y;
                    ssq[it] += (y[0] * y[0] + y[1] * y[1]) + (y[2] * y[2] + y[3] * y[3]); }
#pragma unroll
        for (int it = 0; it < 4; ++it) { float s = ssq[it]; s += __shfl_xor(s, 16); s += __shfl_xor(s, 32); if (fq == 0) red[w * 64 + 16 * it + fr] = s; }
        __syncthreads();
        float rs[4];
#pragma unroll
        for (int it = 0; it < 4; ++it) { float s = 0.f;
#pragma unroll
            for (int ww = 0; ww < 8; ++ww) s += red[ww * 64 + 16 * it + fr];
            rs[it] = 1.0f / sqrtf(s * (1.0f / 512.0f) + EPS); }
#pragma unroll
        for (int hf = 0; hf < 2; ++hf)
#pragma unroll
            for (int et = 0; et < 2; ++et)
#pragma unroll
                for (int it = 0; it < 4; ++it) { bf16* gp = G + (tok0 + 16 * it + fr) * 2048 + h * 512 + hf * 256 + 32 * w + 16 * et + 4 * fq; const u32x2_t gv = *(const u32x2_t*)gp;
                    const f32x4 y = acc[hf][et][it] * rs[it]; u32x2_t o; o.x = cvtpk(y[0] * bflo(gv.x), y[1] * bfhi(gv.x)); o.y = cvtpk(y[2] * bflo(gv.y), y[3] * bfhi(gv.y)); *(u32x2_t*)gp = o; }
        __syncthreads();
    }
}
#ifndef PHMASK
#define PHMASK 0xFFFFFFu
#endif
#define PH(k) ((PHMASK >> (k)) & 1u)
#ifdef USE_SGU_NAIVE
#define SGU_GATE_FN sgu_gate_naive
#else
#define SGU_GATE_FN sgu_gate_mfma
#endif
#ifdef USE_GATHER_TOKEN
#define GATHER_FN peer_gather8
#else
#ifdef USE_GATHER_ROUNDS
#define GATHER_FN peer_gather_rounds
#else
#define GATHER_FN peer_gather_dma
#endif
#endif
#ifndef DUP_GATHER_SKIP
#define DUP_GATHER_SKIP 0
#endif
#ifndef DUP_GATHER_FAKE
#define DUP_GATHER_FAKE false
#endif
struct Args { const void* in[21]; float* out; unsigned char* ws; };
__global__ void __launch_bounds__(NWAVES * 64, 2) mk_fwd(Args args) {
    extern __shared__ __attribute__((aligned(16))) unsigned char lds[];
    Ctx C; C.lds = (LAS unsigned char*)lds; C.tid = threadIdx.x; C.lane = C.tid & 63; C.wave = __builtin_amdgcn_readfirstlane(C.tid >> 6);
    C.G = gridDim.x; { const int bx = blockIdx.x; C.vcu = (C.G % 8 == 0) ? (bx % 8) * (C.G / 8) + bx / 8 : bx; }
    C.ws = args.ws;
    volatile LAS unsigned* MISC = (volatile LAS unsigned*)(C.lds + MISC_OFF);
    gu32* ctl = (gu32*)(args.ws + WS_CTL);
    for (int u = C.tid; u < (LDS_BYTES - LDSCTL_OFF) / 4; u += NWAVES * 64) ((LAS unsigned*)(C.lds + LDSCTL_OFF))[u] = 0u;
    __syncthreads();
    XcdBarrier bar = xcd_barrier_post((unsigned*)(ctl + CW_BAR), MISC + 8);
#define GRID_BAR() do { xcd_barrier(bar); asm volatile("" : "+v"(C.tid)); C.lane = C.tid & 63; C.wave = __builtin_amdgcn_readfirstlane(C.tid >> 6); } while (0)
    { LAS unsigned long long* PT = (LAS unsigned long long*)(C.lds + PTR_OFF);
      if (C.tid == 0) {
#pragma unroll
          for (int i = 0; i < 21; ++i) PT[i] = (unsigned long long)args.in[i];
      } }
    __syncthreads();
#define INP(T, i) ((const T*)ldp(C, i))
    float* out = args.out; unsigned char* ws = args.ws;
#define MODP ((float*)(ws + WS_MOD))
#define MOD0 ((const float*)(ws + WS_MOD))
#define MOD1 ((const float*)(ws + WS_MOD) + 2 * 6144)
#define cosT ((float*)(ws + WS_COS))
#define sinT ((float*)(ws + WS_SIN))
#define WRI ((bf16*)(ws + WS_WRI))
#define WRO ((bf16*)(ws + WS_WRO))
#define WSI ((bf16*)(ws + WS_WSI))
#define WSO ((bf16*)(ws + WS_WSO))
#define WQ ((bf16*)(ws + WS_WQ))
#define KEYS ((bf16*)(ws + WS_KEYS))
#define STATS ((float*)(ws + WS_STATS))
#define IDX ((int*)(ws + WS_IDX))
#define GATE ((float*)(ws + WS_GATE))
#define H ((bf16*)(ws + WS_H))
#define PU8 ((const unsigned char*)(ws + WS_PU))
#define PV8 ((const unsigned char*)(ws + WS_PV))
#define ISU ((const float*)(ws + WS_ISU))
#define ISV ((const float*)(ws + WS_ISV))
#define Qb ((bf16*)(ws + WS_Q))
#define Kb ((bf16*)(ws + WS_K))
#define Vb ((bf16*)(ws + WS_V))
#define Gb ((bf16*)(ws + WS_G))
#define CROSS ((bf16*)(ws + WS_CROSS))
#define QP ((bf16*)(ws + WS_QP))
#define SCO ((float*)(ws + WS_SC))
#define Ub ((bf16*)(ws + WS_U))
#define VBb ((bf16*)(ws + WS_VB))

    { P0In I; I.c = INP(float, 1); I.ada_w = INP(float, 5); I.ada_b = INP(float, 6); I.ret_w_in = INP(float, 7); I.ret_w_out = INP(float, 8); I.sgu_w_in = INP(float, 9); I.sgu_w_out = INP(float, 15); I.wq = INP(float, 16); I.keys = INP(float, 17); I.pu = INP(float, 18); I.pv = INP(float, 19); I.pos = INP(int, 2);
#ifdef DUP_P0
      p0_prologue(C, I);
      GRID_BAR();
#endif
      if (PH(0)) p0_prologue(C, I); }
    GRID_BAR();
    if (PH(1)) rms_mod_phase(C, INP(float, 0), INP(float, 3), MOD0, 0, 1024, H);
    GRID_BAR();
    { pg8::Gemm g{H, WRI, TT, 6144, 1024}; pg8::StaticOrder S; S.init(TT, 6144, C.G, (int)blockIdx.x);
      pg8::EpiRetProj E{Qb, Kb, Vb, Gb, (const unsigned*)(ws + WS_COS)};
#ifdef DUP_G1
      pg8::gemm_phase<pg8::EpiRetProj, pg8::StaticOrder, true, true>(C.lds + RING_OFF, g, S, E); GRID_BAR();
#endif
#ifdef DUP_G1B
      { pg8::EpiBf16<0> E2{(bf16*)(ws + WS_R), 6144, nullptr, 0, 0, 1.f}; pg8::gemm_phase<pg8::EpiBf16<0>, pg8::StaticOrder, true, true>(C.lds + RING_OFF, g, S, E2); GRID_BAR(); }
#endif
      if (PH(2)) pg8::gemm_phase<pg8::EpiRetProj, pg8::StaticOrder, true, true>(C.lds + RING_OFF, g, S, E); }
    GRID_BAR();
    #ifdef USE_SCAN_NAIVE
    if (PH(3)) scan_naive(C, Qb, Kb, Vb, CROSS);
#else
#ifdef DUP_SCAN
    scan_mfma<DUP_SCAN>(C, Qb, Kb, Vb, CROSS);
    GRID_BAR();
#endif
    if (C.vcu < SCAN_NIT) { if (PH(3)) scan_mfma<0>(C, Qb, Kb, Vb, CROSS); }
    else { P0In I; I.c = nullptr; I.ada_w = nullptr; I.ada_b = nullptr; I.ret_w_in = nullptr; I.ret_w_out = nullptr; I.sgu_w_in = INP(float, 9); I.sgu_w_out = INP(float, 15); I.wq = INP(float, 16); I.keys = nullptr; I.pu = INP(float, 18); I.pv = INP(float, 19); I.pos = nullptr;
      side_work(C, I, SCAN_NIT); }
#endif
    GRID_BAR();
#ifdef USE_INTRA_NAIVE
    if (PH(4)) intra_naive(C, Qb, Kb, Vb, CROSS, Gb);
#else
    if (PH(4)) intra_mfma(C, Qb, Kb, Vb, CROSS, Gb);
#endif
    GRID_BAR();
    { pg8::Gemm g{Gb, WRO, TT, 1024, 2048}; pg8::StaticOrder S; S.init(TT, 1024, C.G, (int)blockIdx.x);
      pg8::EpiResGate E{INP(float, 0), out, MOD0 + 2048, 6144};
      if (PH(5)) pg8::gemm_phase<pg8::EpiResGate, pg8::StaticOrder, true, true>(C.lds + RING_OFF, g, S, E); }
    GRID_BAR();
    if (PH(6)) rms_mod_phase(C, out, INP(float, 4), MOD0, 3072, 4096, H);
    GRID_BAR();
    { pg8::Gemm g{H, WQ, TT, 2048, 1024}; pg8::StaticOrder S; S.init(TT, 2048, C.G, (int)blockIdx.x);
      pg8::EpiBf16<0> E{QP, 2048, nullptr, 0, 0, 1.f};
      if (PH(7)) pg8::gemm_phase<pg8::EpiBf16<0>, pg8::StaticOrder, true, true>(C.lds + RING_OFF, g, S, E); }
    GRID_BAR();
#ifdef USE_TOPK_NAIVE
    if (PH(8)) peer_scores(C, QP, KEYS, SCO);
    GRID_BAR();
    if (PH(9)) peer_topk(C, SCO, IDX, GATE);
#else
#ifdef DUP_TOPK
    peer_topk_fused<DUP_TOPK>(C, QP, KEYS, IDX, GATE);
    GRID_BAR();
#endif
    if (PH(9)) peer_topk_fused<0>(C, QP, KEYS, IDX, GATE);
#endif
    GRID_BAR();
#ifdef DUP_GATHER
    GATHER_FN<false, DUP_GATHER_FAKE, DUP_GATHER_SKIP>(C, H, IDX, GATE, PU8, PV8, ISU, ISV, (float*)(ws + WS_R), MOD0 + 5120, INP(float, 3) + 1024, MOD1, (bf16*)(ws + WS_R + 128 * MiB));
    GRID_BAR();
#endif
    if (PH(10)) GATHER_FN<false>(C, H, IDX, GATE, PU8, PV8, ISU, ISV, out, MOD0 + 5120, INP(float, 3) + 1024, MOD1, H);
    GRID_BAR();
#ifdef DUP_BAR
    for (int q_ = 0; q_ < 10; ++q_) GRID_BAR();
#endif
    { pg8::Gemm g{H, WSI, TT, 6144, 1024}; pg8::StaticOrder S; S.init(TT, 6144, C.G, (int)blockIdx.x);
      pg8::EpiSguIn E{Ub, VBb, INP(float, 10), STATS};
#ifdef DUP_G7
      pg8::gemm_phase<pg8::EpiSguIn, pg8::StaticOrder, true, true>(C.lds + RING_OFF, g, S, E); GRID_BAR();
#endif
      if (PH(11)) pg8::gemm_phase<pg8::EpiSguIn, pg8::StaticOrder, true, true>(C.lds + RING_OFF, g, S, E); }
    GRID_BAR();
    if (PH(12)) SGU_GATE_FN(C, Ub, VBb, STATS, INP(float, 13), INP(float, 14), INP(float, 11), INP(float, 12));
    GRID_BAR();
    { pg8::Gemm g{Ub, WSO, TT, 1024, 3072}; pg8::StaticOrder S; S.init(TT, 1024, C.G, (int)blockIdx.x);
      pg8::EpiResGate E{out, out, MOD1 + 2048, 6144};
      if (PH(13)) pg8::gemm_phase<pg8::EpiResGate, pg8::StaticOrder, true, true>(C.lds + RING_OFF, g, S, E); }
    GRID_BAR();
    if (PH(14)) rms_mod_phase(C, out, INP(float, 4) + 1024, MOD1, 3072, 4096, H);
    GRID_BAR();
    { pg8::Gemm g{H, WQ + (size_t)2048 * 1024, TT, 2048, 1024}; pg8::StaticOrder S; S.init(TT, 2048, C.G, (int)blockIdx.x);
      pg8::EpiBf16<0> E{QP, 2048, nullptr, 0, 0, 1.f};
      if (PH(15)) pg8::gemm_phase<pg8::EpiBf16<0>, pg8::StaticOrder, true, true>(C.lds + RING_OFF, g, S, E); }
    GRID_BAR();
#ifdef USE_TOPK_NAIVE
    if (PH(16)) peer_scores(C, QP, KEYS + (size_t)8 * 2 * 128 * 128, SCO);
    GRID_BAR();
    if (PH(17)) peer_topk(C, SCO, IDX, GATE);
#else
    if (PH(17)) peer_topk_fused<0>(C, QP, KEYS + (size_t)8 * 2 * 128 * 128, IDX, GATE);
#endif
    GRID_BAR();
    if (PH(18)) GATHER_FN<true>(C, H, IDX, GATE, PU8 + (size_t)16384 * 1024, PV8 + (size_t)16384 * 1024, ISU + 16384, ISV + 16384, out, MOD1 + 5120, INP(float, 20), nullptr, nullptr);
#undef GRID_BAR
}

extern "C" void kernel_launch(void* const* d_in, const int* in_sizes, int n_in, void* d_out, int out_size, void* d_ws, size_t ws_size, hipStream_t stream) {
    static int grid = 0;
    if (grid == 0) {
        if (n_in != 21 || in_sizes[0] != TT * DM || out_size != TT * DM || ws_size < WS_END) { fprintf(stderr, "kernel_launch: unexpected shapes/workspace: n_in %d in0 %d out %d ws %zu (need %zu)\n", n_in, n_in > 0 ? in_sizes[0] : -1, out_size, ws_size, (size_t)WS_END); grid = -1; return; }
        int dev = 0, cus = 0;
        if (hipGetDevice(&dev) != hipSuccess || hipDeviceGetAttribute(&cus, hipDeviceAttributeMultiprocessorCount, dev) != hipSuccess) { fprintf(stderr, "kernel_launch: device query failed\n"); grid = -1; return; }
        if (hipFuncSetAttribute((const void*)mk_fwd, hipFuncAttributeMaxDynamicSharedMemorySize, LDS_BYTES) != hipSuccess) { fprintf(stderr, "kernel_launch: hipFuncSetAttribute failed\n"); grid = -1; return; }
        (void)hipGetLastError();
        grid = cus;
    }
    if (grid < 0) return;
    if (hipMemsetAsync((char*)d_ws + WS_CTL, 0, CTL_ZERO_BYTES, stream) != hipSuccess) { fprintf(stderr, "kernel_launch: memset failed\n"); return; }
    Args a; memset(&a, 0, sizeof(a));
    for (int i = 0; i < 21; ++i) a.in[i] = d_in[i];
    a.out = (float*)d_out; a.ws = (unsigned char*)d_ws;
    hipLaunchKernelGGL(mk_fwd, dim3(grid), dim3(NWAVES * 64), LDS_BYTES, stream, a);
    const hipError_t le = hipPeekAtLastError();
    if (le != hipSuccess) fprintf(stderr, "kernel_launch: launch failed: %s\n", hipGetErrorName(le));
}
```

```cpp
#define USE_GATHER_ROUNDS 1
#include <hip/hip_runtime.h>
#include <cstdio>
#include <cstdint>
#include <cstring>
#include <cmath>
namespace pg8 {
#define PG8_LAS __attribute__((address_space(3)))
typedef unsigned short bf16_t;
typedef short bf16x8 __attribute__((ext_vector_type(8)));
typedef float f32x4 __attribute__((ext_vector_type(4)));
typedef unsigned u32x4 __attribute__((ext_vector_type(4)));
constexpr int BM = 256, BK = 64, HALF = 128, HTB = HALF * BK * 2  , STAGE_BYTES = 8 * HTB, NXCD = 8, WGM = 8;

__host__ __device__ __forceinline__ int lds_byte(int r, int c) { const int st = (r >> 4) * 2 + (c >> 5), rr = r & 15, cc = c & 31, ob = rr * 64 + cc * 2; return st * 1024 + (ob ^ (((ob >> 9) & 1) << 5)); }
__host__ __device__ __forceinline__ void stage_rc(int b, int& R, int& C) { const int st = b / 1024, sb = b % 1024, swz = sb ^ (((sb >> 9) & 1) << 5); R = (st >> 1) * 16 + swz / 64; C = (st & 1) * 32 + (swz % 64) / 2; }
__host__ __device__ __forceinline__ int perm32(int rho) { const int n = rho >> 4, i = rho & 15; return 8 * (i >> 2) + 4 * n + (i & 3); }

struct Unit { int pm, pn; };
struct Gemm { const bf16_t* A; const bf16_t* Bt; int M, N, K; };

struct StaticOrder {
    int nM, nN, nwg, G, c;
    __host__ __device__ void init(int M, int N, int G_, int c_) { nM = M / BM; nN = N / BM; nwg = nM * nN; G = G_; c = c_; }
    __host__ __device__ bool next(int i, Unit& u) const {
        const long L = (long)i * G + c; if (L >= nwg) return false;
        int wgid = (int)L; { const int q = nwg / NXCD, r = nwg % NXCD, xcd = wgid % NXCD, off = wgid / NXCD; wgid = (xcd < r ? xcd * (q + 1) : r * (q + 1) + (xcd - r) * q) + off; }
        const int nig = WGM * nN, gid = wgid / nig, fm = gid * WGM, gsz = (nM - fm) < WGM ? (nM - fm) : WGM;
        u.pm = fm + ((wgid % nig) % gsz); u.pn = (wgid % nig) / gsz; return true;
    }
    __device__ __forceinline__ void a_ready(const Unit&) const {}
    __device__ __forceinline__ void done(const Unit&) const {}
};

__device__ __forceinline__ unsigned cvt_pk_bf16(float lo, float hi) { unsigned r; asm volatile("v_cvt_pk_bf16_f32 %0, %1, %2" : "=v"(r) : "v"(lo), "v"(hi)); return r; }
typedef float f32x2 __attribute__((ext_vector_type(2)));
__device__ __forceinline__ f32x2 gelu_pk(f32x2 v) {
    const f32x2 av = __builtin_elementwise_abs(v), d = av * 0.2316418882f + 1.0f;
    f32x2 t; t.x = __builtin_amdgcn_rcpf(d.x); t.y = __builtin_amdgcn_rcpf(d.y);
    f32x2 q = t * 0.5307027145f + (-0.7265760135f); q = q * t + 0.7107068705f; q = q * t + (-0.142248368f); q = q * t + 0.127414796f; q = q * t;
    const f32x2 s = (v * v) * (-0.72134752044f);
    f32x2 e; e.x = __builtin_amdgcn_exp2f(s.x); e.y = __builtin_amdgcn_exp2f(s.y);
    const f32x2 m = v * (q * e), r = v - m;
    f32x2 o; o.x = v.x < 0.f ? m.x : r.x; o.y = v.y < 0.f ? m.y : r.y; return o;
}

template <int ACT  > struct EpiBf16 {
    static constexpr bool PERM = true, AFTER_DRAIN = false; static_assert(ACT == 0 || ACT == 1, "EpiBf16: ACT is 0 (none) or 1 (gelu_pk)");
    bf16_t* O; int ldc; const float* bias; int split_cols; size_t split_stride; float scale0;
    __device__ __forceinline__ void operator()(const f32x4 (&acc)[2][2][4][2], const Unit& u, int wr, int wc, int fr, int fq) const {
        const int row0 = u.pm * BM + wr * 64 + fr; int colt = u.pn * BM; bf16_t* base = O;
        float sc = 1.f; if (split_cols) { const int t = colt / split_cols; base += (size_t)t * split_stride; colt -= t * split_cols; if (t == 0) sc = scale0; }
        const int col0 = colt + wc * 32 + 8 * fq, bcol0 = u.pn * BM + wc * 32 + 8 * fq;
        f32x4 bv[2][2];
#pragma unroll
        for (int bj = 0; bj < 2; ++bj)
#pragma unroll
            for (int n = 0; n < 2; ++n) bv[bj][n] = bias ? *(const f32x4*)(bias + bcol0 + bj * HALF + 4 * n) : (f32x4){0.f, 0.f, 0.f, 0.f};
#pragma unroll
        for (int ai = 0; ai < 2; ++ai)
#pragma unroll
            for (int m = 0; m < 4; ++m) { bf16_t* rowp = base + (size_t)(row0 + ai * HALF + m * 16) * ldc + col0;
#pragma unroll
                for (int bj = 0; bj < 2; ++bj) { f32x4 v0 = acc[ai][bj][m][0] + bv[bj][0], v1 = acc[ai][bj][m][1] + bv[bj][1];
                    if (ACT == 1) { f32x2 a = gelu_pk((f32x2){v0[0], v0[1]}), b = gelu_pk((f32x2){v0[2], v0[3]}), c = gelu_pk((f32x2){v1[0], v1[1]}), d = gelu_pk((f32x2){v1[2], v1[3]});
                        v0 = (f32x4){a.x, a.y, b.x, b.y}; v1 = (f32x4){c.x, c.y, d.x, d.y}; }
                    v0 = v0 * sc; v1 = v1 * sc; u32x4 w; w.x = cvt_pk_bf16(v0[0], v0[1]); w.y = cvt_pk_bf16(v0[2], v0[3]); w.z = cvt_pk_bf16(v1[0], v1[1]); w.w = cvt_pk_bf16(v1[2], v1[3]);
                    *(u32x4*)(rowp + bj * HALF) = w; } }
    }
};
template <class Epi, class Sched, bool ALIGN_EPI = false, bool SP2 = false>
__device__ __forceinline__ void gemm_phase(PG8_LAS unsigned char* lds, const Gemm g, const Sched& S, const Epi& E) {
    int tid_ = threadIdx.x; asm volatile("" : "+v"(tid_));
    const int tid = tid_, wid = __builtin_amdgcn_readfirstlane(tid >> 6), lane = tid & 63, wr = wid >> 2, wc = wid & 3, fr = lane & 15, fq = lane >> 4;
    const int K = g.K, nt = K / BK;
    unsigned voffA[2], voffB[2];
#pragma unroll
    for (int i = 0; i < 2; ++i) { int R, C; stage_rc(tid * 16 + i * 8192, R, C); const int Rb = Epi::PERM ? ((R & ~31) + perm32(R & 31)) : R;
        voffA[i] = (unsigned)(R * K + C) * 2u; voffB[i] = (unsigned)(Rb * K + C) * 2u; }
    const size_t kstep = (size_t)(BK * 2);
    const size_t hstep = (size_t)HALF * K * 2;
    const size_t tstep = 2 * hstep;
    const unsigned ldsw = (unsigned)wid * 1024u;
    const int aoff = lds_byte(wr * 64 + fr, fq * 8), boff = lds_byte(wc * 32 + fr, fq * 8);
#define PG8_SA(b, h) (((b) * 2 + (h)) * HTB)
#define PG8_SB(b, h) ((4 + (b) * 2 + (h)) * HTB)
#define PG8_STAGE(bufoff, gbase, voff) do { _Pragma("unroll") for (int _i = 0; _i < 2; ++_i) \
        __builtin_amdgcn_global_load_lds((const unsigned*)((const char*)(gbase) + (voff)[_i]), (PG8_LAS unsigned*)(lds + (bufoff) + ldsw + _i * 8192), 16, 0, 0); } while (0)
#define PG8_LDA(dst, b, h) do { _Pragma("unroll") for (int m = 0; m < 4; ++m) _Pragma("unroll") for (int k = 0; k < 2; ++k) dst[m][k] = *(const PG8_LAS bf16x8*)(lds + PG8_SA(b, h) + aoff + m * 2048 + k * 1024); } while (0)
#define PG8_LDB(dst, b, h) do { _Pragma("unroll") for (int n = 0; n < 2; ++n) _Pragma("unroll") for (int k = 0; k < 2; ++k) dst[n][k] = *(const PG8_LAS bf16x8*)(lds + PG8_SB(b, h) + boff + n * 2048 + k * 1024); } while (0)
#define PG8_MMA(ai, bj, At, Bt) do { __builtin_amdgcn_s_setprio(1); _Pragma("unroll") for (int m = 0; m < 4; ++m) _Pragma("unroll") for (int n = 0; n < 2; ++n) _Pragma("unroll") for (int k = 0; k < 2; ++k) \
        acc[ai][bj][m][n] = __builtin_amdgcn_mfma_f32_16x16x32_bf16(Bt[n][k], At[m][k], acc[ai][bj][m][n], 0, 0, 0); __builtin_amdgcn_s_setprio(0); } while (0)
#define PG8_WAIT_V(n) asm volatile("s_waitcnt vmcnt(" #n ")" ::: "memory")
#define PG8_WAIT_L(n) asm volatile("s_waitcnt lgkmcnt(" #n ")" ::: "memory")
#define PG8_BAR __builtin_amdgcn_s_barrier()
#define PG8_SCHED __builtin_amdgcn_sched_barrier(0)
    Unit cur, nxt; int ui = 0;
    if (!S.next(0, cur)) return;
    f32x4 acc[2][2][4][2];
#pragma unroll
    for (int a = 0; a < 2; ++a)
#pragma unroll
        for (int b = 0; b < 2; ++b)
#pragma unroll
            for (int m = 0; m < 4; ++m)
#pragma unroll
                for (int n = 0; n < 2; ++n) acc[a][b][m][n] = (f32x4){0.f, 0.f, 0.f, 0.f};
    bf16x8 At[4][2], B0[2][2], B1[2][2];
    const char* cA = (const char*)g.A + (size_t)cur.pm * tstep; const char* cB = (const char*)g.Bt + (size_t)cur.pn * tstep;
    S.a_ready(cur);
    if constexpr (SP2) {
        PG8_STAGE(PG8_SB(0, 0), cB, voffB); PG8_STAGE(PG8_SB(0, 1), cB + hstep, voffB); PG8_STAGE(PG8_SA(0, 0), cA, voffA); PG8_STAGE(PG8_SA(0, 1), cA + hstep, voffA);
        if (wr == 1) PG8_BAR;
        PG8_WAIT_V(2); PG8_BAR;
        PG8_STAGE(PG8_SB(1, 0), cB + kstep, voffB); PG8_STAGE(PG8_SA(1, 0), cA + kstep, voffA); PG8_STAGE(PG8_SB(1, 1), cB + hstep + kstep, voffB);
        PG8_WAIT_V(6); PG8_BAR;
    } else {
        PG8_STAGE(PG8_SB(0, 0), cB, voffB); PG8_STAGE(PG8_SA(0, 0), cA, voffA); PG8_STAGE(PG8_SB(0, 1), cB + hstep, voffB); PG8_STAGE(PG8_SA(0, 1), cA + hstep, voffA);
        if (wr == 1) PG8_BAR;
        PG8_WAIT_V(4); PG8_BAR;
        PG8_STAGE(PG8_SB(1, 0), cB + kstep, voffB); PG8_STAGE(PG8_SA(1, 0), cA + kstep, voffA); PG8_STAGE(PG8_SB(1, 1), cB + hstep + kstep, voffB);
        PG8_WAIT_V(6); PG8_BAR;
    }
    for (;;) {
        const bool has_next = S.next(ui + 1, nxt);
        const char* nA = has_next ? (const char*)g.A + (size_t)nxt.pm * tstep : cA; const char* nB = has_next ? (const char*)g.Bt + (size_t)nxt.pn * tstep : cB;
        for (int t = 0; t < nt; t += 2) {
            const bool last = (t == nt - 2);
            const char* a1 = cA + (size_t)(t + 1) * kstep;
            const char* a2 = last ? nA : cA + (size_t)(t + 2) * kstep; const char* b2 = last ? nB : cB + (size_t)(t + 2) * kstep;
            const char* a3 = a2 + kstep; const char* b3 = b2 + kstep;
            if (last && has_next) S.a_ready(nxt);
            if constexpr (SP2) {
            PG8_LDB(B0, 0, 0); PG8_LDB(B1, 0, 1); PG8_SCHED; PG8_LDA(At, 0, 0); PG8_STAGE(PG8_SA(1, 1), a1 + hstep, voffA);
            PG8_WAIT_V(8); PG8_WAIT_L(0); PG8_BAR; PG8_MMA(0, 0, At, B0); PG8_MMA(0, 1, At, B1); PG8_BAR; PG8_SCHED;
            PG8_LDA(At, 0, 1); PG8_STAGE(PG8_SB(0, 0), b2, voffB); PG8_STAGE(PG8_SB(0, 1), b2 + hstep, voffB); PG8_STAGE(PG8_SA(0, 0), a2, voffA);
            PG8_WAIT_V(8); PG8_WAIT_L(0); PG8_BAR; PG8_MMA(1, 0, At, B0); PG8_MMA(1, 1, At, B1); PG8_BAR; PG8_SCHED;
            PG8_LDB(B0, 1, 0); PG8_LDB(B1, 1, 1); PG8_SCHED; PG8_LDA(At, 1, 0); PG8_STAGE(PG8_SA(0, 1), a2 + hstep, voffA);
            PG8_WAIT_V(8); PG8_WAIT_L(0); PG8_BAR; PG8_MMA(0, 0, At, B0); PG8_MMA(0, 1, At, B1); PG8_BAR; PG8_SCHED;
            PG8_LDA(At, 1, 1); PG8_STAGE(PG8_SB(1, 0), b3, voffB); PG8_STAGE(PG8_SB(1, 1), b3 + hstep, voffB); PG8_STAGE(PG8_SA(1, 0), a3, voffA);
            PG8_WAIT_V(8); PG8_WAIT_L(0); PG8_BAR; PG8_MMA(1, 0, At, B0); PG8_MMA(1, 1, At, B1); PG8_BAR; PG8_SCHED;
            } else {
            PG8_LDB(B0, 0, 0); PG8_SCHED; PG8_LDA(At, 0, 0); PG8_STAGE(PG8_SA(1, 1), a1 + hstep, voffA);
            PG8_WAIT_L(8); PG8_BAR; PG8_WAIT_L(0); PG8_MMA(0, 0, At, B0); PG8_BAR; PG8_SCHED;
            PG8_LDB(B1, 0, 1); PG8_STAGE(PG8_SB(0, 0), b2, voffB);
            PG8_BAR; PG8_WAIT_L(0); PG8_MMA(0, 1, At, B1); PG8_BAR;
            PG8_LDA(At, 0, 1); PG8_STAGE(PG8_SA(0, 0), a2, voffA);
            PG8_BAR; PG8_WAIT_L(0); PG8_MMA(1, 0, At, B0); PG8_BAR; PG8_SCHED;
            PG8_STAGE(PG8_SB(0, 1), b2 + hstep, voffB);
            PG8_WAIT_V(6); PG8_BAR; PG8_MMA(1, 1, At, B1); PG8_BAR;
            PG8_LDB(B0, 1, 0); PG8_SCHED; PG8_LDA(At, 1, 0); PG8_STAGE(PG8_SA(0, 1), a2 + hstep, voffA);
            PG8_WAIT_L(8); PG8_BAR; PG8_WAIT_L(0); PG8_MMA(0, 0, At, B0); PG8_BAR; PG8_SCHED;
            PG8_LDB(B1, 1, 1); PG8_STAGE(PG8_SB(1, 0), b3, voffB);
            PG8_BAR; PG8_WAIT_L(0); PG8_MMA(0, 1, At, B1); PG8_BAR;
            PG8_LDA(At, 1, 1); PG8_STAGE(PG8_SA(1, 0), a3, voffA);
            PG8_BAR; PG8_WAIT_L(0); PG8_MMA(1, 0, At, B0); PG8_BAR; PG8_SCHED;
            PG8_STAGE(PG8_SB(1, 1), b3 + hstep, voffB);
            PG8_WAIT_V(6); PG8_BAR; PG8_MMA(1, 1, At, B1); PG8_BAR;
            }
        }
        if constexpr (ALIGN_EPI) { if (wr == 0) PG8_BAR; }
        if constexpr (!Epi::AFTER_DRAIN) { E(acc, cur, wr, wc, fr, fq); S.done(cur); }
        if (!has_next) break;
#pragma unroll
        for (int a = 0; a < 2; ++a)
#pragma unroll
            for (int b = 0; b < 2; ++b)
#pragma unroll
                for (int m = 0; m < 4; ++m)
#pragma unroll
                    for (int n = 0; n < 2; ++n) acc[a][b][m][n] = (f32x4){0.f, 0.f, 0.f, 0.f};
        cur = nxt; cA = nA; cB = nB; ++ui;
        if constexpr (ALIGN_EPI) { if (wr == 1) PG8_BAR; }
    }
    PG8_WAIT_V(0);
    if constexpr (!ALIGN_EPI) { if (wr == 0) PG8_BAR; }
    PG8_BAR;
    if constexpr (Epi::AFTER_DRAIN) { E.fused(acc, cur, wr, wc, fr, fq, lds, wid, lane); S.done(cur); }
#undef PG8_SA
#undef PG8_SB
#undef PG8_STAGE
#undef PG8_LDA
#undef PG8_LDB
#undef PG8_MMA
#undef PG8_WAIT_V
#undef PG8_WAIT_L
#undef PG8_BAR
#undef PG8_SCHED
}
}
namespace pg8 {
typedef unsigned u32x2 __attribute__((ext_vector_type(2)));
__device__ __forceinline__ float gelu_tanh(float x) {
    const float e = __builtin_amdgcn_exp2f(x * (-2.302208198f - 0.1029432397f * x * x));
    return x * __builtin_amdgcn_rcpf(1.0f + e);
}
__device__ __forceinline__ float silu_f(float x) { return x * __builtin_amdgcn_rcpf(1.0f + __builtin_amdgcn_exp2f(-1.4426950409f * x)); }

typedef _Float16 eh2_t __attribute__((ext_vector_type(2)));
struct EpiRetProj {
    static constexpr bool PERM = true, AFTER_DRAIN = false;
    bf16_t *Q, *K, *V, *G; const unsigned* trig;
    __device__ __forceinline__ void operator()(const f32x4 (&acc)[2][2][4][2], const Unit& u, int wr, int wc, int fr, int fq) const {
        const int pn = u.pn;
        if (pn < 8) {
            bf16_t* dst = pn < 4 ? Q : K; const int head = pn & 3; const float sc = pn < 4 ? 1.0f : 0.0625f;
            const int f0 = wc * 32 + 8 * fq;
#pragma unroll
            for (int ai = 0; ai < 2; ++ai) {
                u32x4 tg[4][2];
#pragma unroll
                for (int m = 0; m < 4; ++m) { const int row = u.pm * BM + ai * HALF + wr * 64 + m * 16 + fr; const unsigned* tp = trig + (size_t)row * 128 + f0;
                    tg[m][0] = *(const u32x4*)tp; tg[m][1] = *(const u32x4*)(tp + 4); }
#pragma unroll
                for (int m = 0; m < 4; ++m) {
                    const int row = u.pm * BM + ai * HALF + wr * 64 + m * 16 + fr;
                    u32x4 w1, w2;
#pragma unroll
                    for (int n = 0; n < 2; ++n) {
                        const f32x4 x1 = acc[ai][0][m][n], x2 = acc[ai][1][m][n]; float o1[4], o2[4];
#pragma unroll
                        for (int j = 0; j < 4; ++j) { const unsigned tw = tg[m][n][j]; const float c = (float)__builtin_bit_cast(_Float16, (unsigned short)(tw & 0xffffu)) * sc, sn = (float)__builtin_bit_cast(_Float16, (unsigned short)(tw >> 16)) * sc;
                            o1[j] = x1[j] * c - x2[j] * sn; o2[j] = x1[j] * sn + x2[j] * c; }
                        w1[2 * n] = cvt_pk_bf16(o1[0], o1[1]); w1[2 * n + 1] = cvt_pk_bf16(o1[2], o1[3]); w2[2 * n] = cvt_pk_bf16(o2[0], o2[1]); w2[2 * n + 1] = cvt_pk_bf16(o2[2], o2[3]);
                    }
                    bf16_t* p = dst + (size_t)row * 1024 + head * 256 + f0;
                    *(u32x4*)p = w1; *(u32x4*)(p + 128) = w2;
                }
            }
        } else {
            const bool isg = pn >= 16; bf16_t* dst = isg ? G : V; const int colbase = ((pn - 8) & 7) * 256 + wc * 32 + 8 * fq;
#pragma unroll
            for (int ai = 0; ai < 2; ++ai)
#pragma unroll
                for (int m = 0; m < 4; ++m) {
                    const int row = u.pm * BM + ai * HALF + wr * 64 + m * 16 + fr;
#pragma unroll
                    for (int bj = 0; bj < 2; ++bj) {
                        f32x4 v0 = acc[ai][bj][m][0], v1 = acc[ai][bj][m][1];
                        if (isg) {
#pragma unroll
                            for (int j = 0; j < 4; ++j) { v0[j] = silu_f(v0[j]); v1[j] = silu_f(v1[j]); } }
                        u32x4 w; w.x = cvt_pk_bf16(v0[0], v0[1]); w.y = cvt_pk_bf16(v0[2], v0[3]); w.z = cvt_pk_bf16(v1[0], v1[1]); w.w = cvt_pk_bf16(v1[2], v1[3]);
                        *(u32x4*)(dst + (size_t)row * 2048 + colbase + bj * HALF) = w;
                    }
                }
        }
    }
};
template <bool BF> struct EpiResGateT {
    static constexpr bool PERM = true, AFTER_DRAIN = false;
    const void* base; bf16_t* out; const float* gate; int gstride;
    __device__ __forceinline__ void operator()(const f32x4 (&acc)[2][2][4][2], const Unit& u, int wr, int wc, int fr, int fq) const {
        const int b = (u.pm * BM) >> 13; const float* gp = gate + (size_t)b * gstride;
        const int col0 = u.pn * BM + wc * 32 + 8 * fq;
        f32x4 gv[2][2];
#pragma unroll
        for (int bj = 0; bj < 2; ++bj)
#pragma unroll
            for (int n = 0; n < 2; ++n) gv[bj][n] = *(const f32x4*)(gp + col0 + bj * HALF + 4 * n);
#pragma unroll
        for (int ai = 0; ai < 2; ++ai)
#pragma unroll
            for (int m = 0; m < 4; ++m) {
                const size_t off = (size_t)(u.pm * BM + ai * HALF + wr * 64 + m * 16 + fr) * 1024 + col0;
#pragma unroll
                for (int bj = 0; bj < 2; ++bj) {
                    f32x4 b0, b1;
                    if (BF) { const u32x4 bw = *(const u32x4*)((const bf16_t*)base + off + bj * HALF);
                        b0[0] = __uint_as_float(bw.x << 16); b0[1] = __uint_as_float(bw.x & 0xffff0000u); b0[2] = __uint_as_float(bw.y << 16); b0[3] = __uint_as_float(bw.y & 0xffff0000u);
                        b1[0] = __uint_as_float(bw.z << 16); b1[1] = __uint_as_float(bw.z & 0xffff0000u); b1[2] = __uint_as_float(bw.w << 16); b1[3] = __uint_as_float(bw.w & 0xffff0000u); }
                    else { b0 = *(const f32x4*)((const float*)base + off + bj * HALF); b1 = *(const f32x4*)((const float*)base + off + bj * HALF + 4); }
                    const f32x4 y0 = b0 + gv[bj][0] * acc[ai][bj][m][0], y1 = b1 + gv[bj][1] * acc[ai][bj][m][1];
                    u32x4 w; w.x = cvt_pk_bf16(y0[0], y0[1]); w.y = cvt_pk_bf16(y0[2], y0[3]); w.z = cvt_pk_bf16(y1[0], y1[1]); w.w = cvt_pk_bf16(y1[2], y1[3]);
                    *(u32x4*)(out + off + bj * HALF) = w;
                }
            }
    }
};
struct EpiSguIn {
    static constexpr bool PERM = true, AFTER_DRAIN = false;
    bf16_t* U; bf16_t* Vb; const float* bias; float* stats;
    __device__ __forceinline__ void operator()(const f32x4 (&acc)[2][2][4][2], const Unit& u, int wr, int wc, int fr, int fq) const {
        const bool isv = u.pn >= 12; bf16_t* base = isv ? Vb : U; const int colt = (isv ? u.pn - 12 : u.pn) * BM;
        const int col0 = colt + wc * 32 + 8 * fq, bcol0 = u.pn * BM + wc * 32 + 8 * fq;
        f32x4 bv[2][2];
#pragma unroll
        for (int bj = 0; bj < 2; ++bj)
#pragma unroll
            for (int n = 0; n < 2; ++n) bv[bj][n] = *(const f32x4*)(bias + bcol0 + bj * HALF + 4 * n);
#pragma unroll
        for (int ai = 0; ai < 2; ++ai)
#pragma unroll
            for (int m = 0; m < 4; ++m) {
                const int row = u.pm * BM + ai * HALF + wr * 64 + m * 16 + fr;
                bf16_t* rowp = base + (size_t)row * 3072 + col0;
                float s1 = 0.f, s2 = 0.f;
#pragma unroll
                for (int bj = 0; bj < 2; ++bj) {
                    f32x4 v0 = acc[ai][bj][m][0] + bv[bj][0], v1 = acc[ai][bj][m][1] + bv[bj][1];
#pragma unroll
                    for (int j = 0; j < 4; ++j) { v0[j] = gelu_tanh(v0[j]); v1[j] = gelu_tanh(v1[j]); }
                    u32x4 w; w.x = cvt_pk_bf16(v0[0], v0[1]); w.y = cvt_pk_bf16(v0[2], v0[3]); w.z = cvt_pk_bf16(v1[0], v1[1]); w.w = cvt_pk_bf16(v1[2], v1[3]);
                    *(u32x4*)(rowp + bj * HALF) = w;
                    if (isv) {
#pragma unroll
                        for (int j = 0; j < 4; ++j) { const unsigned ww = j == 0 ? w.x : j == 1 ? w.y : j == 2 ? w.z : w.w;
                            const float a = __uint_as_float(ww << 16), bq = __uint_as_float(ww & 0xffff0000u); s1 += a + bq; s2 += a * a + bq * bq; }
                    }
                }
                if (isv) {
                    s1 += __shfl_xor(s1, 16); s1 += __shfl_xor(s1, 32); s2 += __shfl_xor(s2, 16); s2 += __shfl_xor(s2, 32);
                    if (fq == 0) { float* sp = stats + ((size_t)row * 48 + (u.pn - 12) * 4 + wc) * 2; sp[0] = s1; sp[1] = s2; }
                }
            }
    }
};
}
typedef unsigned u32x4 __attribute__((ext_vector_type(4)));
#define GAS __attribute__((address_space(1)))
#define LAS __attribute__((address_space(3)))
typedef unsigned short bf16;
typedef unsigned v4u __attribute__((ext_vector_type(4)));
typedef float f32x4 __attribute__((ext_vector_type(4)));
typedef short bf16x8 __attribute__((ext_vector_type(8)));
typedef GAS unsigned gu32;
typedef GAS unsigned long long gu64;
#define RLX_AGENT __ATOMIC_RELAXED, __HIP_MEMORY_SCOPE_AGENT
#define LDS_WAIT() asm volatile("s_waitcnt lgkmcnt(0)" ::: "memory")
#define VM_WAIT() asm volatile("s_waitcnt vmcnt(0)" ::: "memory")
__device__ __forceinline__ unsigned long long rt() { return __builtin_amdgcn_s_memrealtime(); }
__device__ __forceinline__ unsigned f2bf(float f) { unsigned u = __builtin_bit_cast(unsigned, f); return (u + 0x7fffu + ((u >> 16) & 1u)) >> 16; }
__device__ __forceinline__ unsigned pk2(float lo, float hi) { return f2bf(lo) | (f2bf(hi) << 16); }

#define XB_TMO      128
#define XB_XCNT(j)  (256  + 64 * (j))
#define XB_XSUB(j)  (1280 + 64 * (j))
#define XB_XGEN(j)  (2304 + 64 * (j))
#define XB_TOP      3328
#define XB_TOPGEN   3392
#define XCD_BAR_WORDS 3456
#define XB_SPIN_CAP (1u << 18)

__device__ __forceinline__ unsigned xb_ld(unsigned* p)              { return __hip_atomic_load(p, __ATOMIC_RELAXED, __HIP_MEMORY_SCOPE_AGENT); }
__device__ __forceinline__ unsigned xb_add(unsigned* p, unsigned v) { return __hip_atomic_fetch_add(p, v, __ATOMIC_RELAXED, __HIP_MEMORY_SCOPE_AGENT); }
__device__ __forceinline__ unsigned xb_xcc_id() { return (unsigned)__builtin_amdgcn_s_getreg((3 << 11) | 20) & 0xFu; }
#define XB_SPIN(cond, bar) do { unsigned _sp = 0; while (cond) { __builtin_amdgcn_s_sleep(1); \
    if ((++_sp & 255u) == 0u) { if (xb_ld(&(bar)[XB_TMO])) break; if (_sp > XB_SPIN_CAP) { atomicAdd(&(bar)[XB_TMO], 1u); break; } } } } while (0)

struct XcdBarrier {
    unsigned* bar; unsigned x;
    volatile LAS unsigned* st;
};

__device__ __forceinline__ XcdBarrier xcd_barrier_post(unsigned* bar, volatile LAS unsigned* st) {
    XcdBarrier b; b.bar = bar; b.x = xb_xcc_id(); b.st = st;
    if (threadIdx.x == 0) (void)xb_add(&bar[XB_XCNT(b.x)], 1u);
    return b;
}
__device__ __forceinline__ void xcd_barrier_complete(unsigned* bar, unsigned x, unsigned& nloc, unsigned& nx) {
    const unsigned G = gridDim.x * gridDim.y * gridDim.z;
    unsigned sum, cnt, mine, sp = 0u;
    for (;;) {
        sum = 0u; cnt = 0u; mine = 0u;
#pragma unroll
        for (unsigned j = 0; j < 16; ++j) { const unsigned c = xb_ld(&bar[XB_XCNT(j)]); sum += c; cnt += (c > 0u) ? 1u : 0u; mine = (j == x) ? c : mine; }
        if (sum == G) break;
        __builtin_amdgcn_s_sleep(1);
        if ((++sp & 255u) == 0u) { if (xb_ld(&bar[XB_TMO])) break; if (sp > XB_SPIN_CAP) { atomicAdd(&bar[XB_TMO], 1u); break; } }
    }
    nloc = mine > 0u ? mine : 1u; nx = cnt > 0u ? cnt : 1u;
}

__device__ __forceinline__ void xcd_barrier(const XcdBarrier& b) {
    asm volatile("s_waitcnt vmcnt(0)" ::: "memory");
    __syncthreads();
    if (threadIdx.x == 0) {
        unsigned* bar = b.bar;
        __builtin_amdgcn_s_waitcnt(0);
        unsigned nloc = b.st[0], nx = b.st[1];
        if (nloc == 0u) { xcd_barrier_complete(bar, b.x, nloc, nx); b.st[0] = nloc; b.st[1] = nx; }
        const unsigned old = xb_add(&bar[XB_XSUB(b.x)], 1u);
        const unsigned gen = old / nloc;
        if (old + 1u == (gen + 1u) * nloc) {
            __builtin_amdgcn_fence(__ATOMIC_RELEASE, "agent");
            asm volatile("s_waitcnt vmcnt(0)" ::: "memory");
            const unsigned og = xb_add(&bar[XB_TOP], 1u);
            const unsigned tg = og / nx;
            if (og + 1u == (tg + 1u) * nx) xb_add(&bar[XB_TOPGEN], 1u);
            else XB_SPIN(xb_ld(&bar[XB_TOPGEN]) == tg, bar);
            __builtin_amdgcn_fence(__ATOMIC_ACQUIRE, "agent");
            xb_add(&bar[XB_XGEN(b.x)], 1u);
            asm volatile("s_waitcnt vmcnt(0)" ::: "memory");
        } else {
            XB_SPIN(xb_ld(&bar[XB_XGEN(b.x)]) == gen, bar);
            __builtin_amdgcn_fence(__ATOMIC_ACQUIRE, "agent");
            asm volatile("s_waitcnt vmcnt(0)" ::: "memory");
        }
    }
    __syncthreads();
}
__device__ __forceinline__ float wave_sum(float v) {
#pragma unroll
    for (int o = 1; o < 64; o <<= 1) v += __shfl_xor(v, o);
    return v;
}
__device__ __forceinline__ void p0_transpose_item(const float* W, int K, int N, bf16* WT, int row_off, LAS float* scr, int item, int lane) {
    const int nblk = N / 32, kb = item / nblk, nb = item % nblk, k0 = 64 * kb, n0 = 32 * nb;
#pragma unroll 8
    for (int i = 0; i < 32; ++i) { const int kk = 2 * i + (lane >> 5); scr[kk * 33 + (lane & 31)] = W[(size_t)(k0 + kk) * N + n0 + (lane & 31)]; }
    LDS_WAIT(); asm volatile("" ::: "memory");
    const int c = lane & 7;
#pragma unroll
    for (int j = 0; j < 4; ++j) { const int n = (lane >> 3) + 8 * j; const LAS float* s = scr + (8 * c) * 33 + n;
        v4u o; o.x = pk2(s[0 * 33], s[1 * 33]); o.y = pk2(s[2 * 33], s[3 * 33]); o.z = pk2(s[4 * 33], s[5 * 33]); o.w = pk2(s[6 * 33], s[7 * 33]);
        *(GAS v4u*)(WT + (size_t)(row_off + n0 + n) * K + k0 + 8 * c) = o; }
    LDS_WAIT(); asm volatile("" ::: "memory");
}
#define DI __device__ __forceinline__
constexpr int NWAVES = 8;
constexpr int TT = 16384, DM = 1024, SEQ = 8192;
constexpr size_t MiB = 1u << 20;
constexpr size_t WS_CTL = 0, CTL_ZERO_BYTES = 32768, WS_MOD = 512 * 1024;
constexpr size_t WS_COS = 2 * MiB, WS_SIN = 10 * MiB;
constexpr size_t WS_WRI = 18 * MiB, WS_WRO = 30 * MiB, WS_WSI = 34 * MiB, WS_WSO = 46 * MiB, WS_WQ = 52 * MiB, WS_KEYS = 60 * MiB;
constexpr size_t WS_ISU = 61 * MiB, WS_ISV = 61 * MiB + 256 * 1024;
constexpr size_t WS_STATS = 62 * MiB, WS_IDX = 68 * MiB, WS_GATE = 76 * MiB, WS_H = 84 * MiB, WS_PU = 116 * MiB, WS_PV = 180 * MiB;
constexpr size_t WS_R = 244 * MiB;
constexpr size_t WS_Q = WS_R, WS_K = WS_R + 32 * MiB, WS_V = WS_R + 64 * MiB, WS_G = WS_R + 128 * MiB, WS_CROSS = WS_R + 192 * MiB;
constexpr size_t WS_XB = WS_R + 192 * MiB;
constexpr size_t WS_QP = WS_R, WS_SC = WS_R + 64 * MiB;
constexpr size_t WS_U = WS_R, WS_VB = WS_R + 96 * MiB;
constexpr size_t WS_END = 500 * MiB;
constexpr int CW_TMO = 0, CW_BAR = 4096;
constexpr int RING_OFF = 0, RING_BYTES = 131072, LDS_BYTES = 163840, LDSCTL_OFF = LDS_BYTES - 1024, MISC_OFF = LDSCTL_OFF + 320;
constexpr int PTR_OFF = LDSCTL_OFF + 512;
constexpr float EPS = 1e-6f;
typedef float f32x2_t __attribute__((ext_vector_type(2)));

DI float bf2f(bf16 h) { return __uint_as_float((unsigned)h << 16); }
DI float bflo(unsigned w) { return __uint_as_float(w << 16); }
DI float bfhi(unsigned w) { return __uint_as_float(w & 0xffff0000u); }
DI float wave_max(float v) {
#pragma unroll
    for (int o = 1; o < 64; o <<= 1) v = fmaxf(v, __shfl_xor(v, o));
    return v;
}
DI float gelu_t(float x) { return pg8::gelu_tanh(x); }

struct Ctx {
    LAS unsigned char* lds; int tid, lane, wave, vcu, G;
    unsigned char* ws;
};

DI const void* ldp(const Ctx& C, int i) {
    const unsigned long long v = ((const LAS unsigned long long*)(C.lds + PTR_OFF))[i];
    const unsigned lo = __builtin_amdgcn_readfirstlane((unsigned)v), hi = __builtin_amdgcn_readfirstlane((unsigned)(v >> 32));
    return (const void*)(((unsigned long long)hi << 32) | lo);
}
DI void cvt_rows_fp8(const float* src, unsigned char* dst, float* inv_scale, int nrows, int gw, int NGW, int lane) {
    for (int r = gw; r < nrows; r += NGW) {
        const f32x4* s = (const f32x4*)(src + (size_t)r * 1024) + lane * 4;
        f32x4 v[4]; float am = 0.f;
#pragma unroll
        for (int q = 0; q < 4; ++q) { v[q] = s[q]; am = fmaxf(am, fmaxf(fmaxf(fabsf(v[q][0]), fabsf(v[q][1])), fmaxf(fabsf(v[q][2]), fabsf(v[q][3])))); }
        am = wave_max(am);
        const int e = (int)((__float_as_uint(am) >> 23) & 0xffu) - 127;
        const bool ok = am > 1e-30f;
        const float sc = ok ? __uint_as_float((unsigned)(127 + 7 - e) << 23) : 1.0f, isc = ok ? __uint_as_float((unsigned)(127 - 7 + e) << 23) : 1.0f;
        u32x4 o;
#pragma unroll
        for (int q = 0; q < 4; ++q) { int wd = __builtin_amdgcn_cvt_pk_fp8_f32(v[q][0] * sc, v[q][1] * sc, 0, false); wd = __builtin_amdgcn_cvt_pk_fp8_f32(v[q][2] * sc, v[q][3] * sc, wd, true); o[q] = (unsigned)wd; }
        *(u32x4*)(dst + (size_t)r * 1024 + lane * 16) = o;
        if (lane == 0) inv_scale[r] = isc;
    }
}
DI void cvt_rows_i8(const float* src, unsigned char* dst, float* inv_scale, int nrows, int gw, int NGW, int lane) {
    for (int r = gw; r < nrows; r += NGW) {
        const f32x4* s = (const f32x4*)(src + (size_t)r * 1024) + lane * 4;
        f32x4 v[4]; float am = 0.f;
#pragma unroll
        for (int q = 0; q < 4; ++q) { v[q] = s[q]; am = fmaxf(am, fmaxf(fmaxf(fabsf(v[q][0]), fabsf(v[q][1])), fmaxf(fabsf(v[q][2]), fabsf(v[q][3])))); }
        am = wave_max(am);
        const int e = (int)((__float_as_uint(am) >> 23) & 0xffu) - 127;
        const bool ok = am > 1e-30f;
        const float sc = ok ? __uint_as_float((unsigned)(127 + 6 - e) << 23) : 1.0f, isc = ok ? __uint_as_float((unsigned)(127 - 6 + e) << 23) : 1.0f;
        u32x4 o;
#pragma unroll
        for (int q = 0; q < 4; ++q) { unsigned wd = 0u;
#pragma unroll
            for (int j = 0; j < 4; ++j) { int qi = (int)rintf(v[q][j] * sc); qi = qi > 127 ? 127 : (qi < -127 ? -127 : qi); wd |= ((unsigned)qi & 0xffu) << (8 * j); }
            o[q] = wd; }
        *(u32x4*)(dst + (size_t)r * 1024 + lane * 16) = o;
        if (lane == 0) inv_scale[r] = isc;
    }
}
DI void cvt_stream(const float* src, bf16* dst, size_t n4, size_t gtid, size_t gthreads) {
    const f32x4* s = (const f32x4*)src; uint2* d = (uint2*)dst;
    for (size_t i = gtid; i < n4; i += gthreads) { const f32x4 v = s[i]; uint2 o; o.x = pk2(v.x, v.y); o.y = pk2(v.z, v.w); d[i] = o; }
}
struct P0In { const float *c, *ada_w, *ada_b, *ret_w_in, *ret_w_out, *sgu_w_in, *sgu_w_out, *wq, *keys, *pu, *pv; const int* pos; };
DI void p0_prologue(const Ctx& C, const P0In& I) {
    LAS float* scr = (LAS float*)(C.lds + RING_OFF + C.wave * 16384);
    const int gw = C.vcu * NWAVES + C.wave, NGW = C.G * NWAVES;
    bf16* wri = (bf16*)(C.ws + WS_WRI); bf16* wro = (bf16*)(C.ws + WS_WRO);
    constexpr int I_RI = 16 * 192, I_RO = 32 * 32;
    constexpr int NITEMS = I_RI + I_RO;
    for (int it = gw; it < NITEMS; it += NGW) {
        int r = it;
        if (r < I_RI) { p0_transpose_item(I.ret_w_in, 1024, 6144, wri, 0, scr, r, C.lane); continue; } r -= I_RI;
        p0_transpose_item(I.ret_w_out, 2048, 1024, wro, 0, scr, r, C.lane);
    }
    const size_t gtid = (size_t)C.vcu * 512 + C.tid, gth = (size_t)C.G * 512;
    cvt_stream(I.keys, (bf16*)(C.ws + WS_KEYS), (size_t)2 * 8 * 2 * 128 * 128 / 4, gtid, gth);
    float* mod = (float*)(C.ws + WS_MOD);
    __syncthreads();
    for (int it = C.vcu; it < 2 * 96; it += C.G) {
        const int l = it / 96, cb = it % 96, kp = C.wave, n = cb * 64 + C.lane;
        const float* W = I.ada_w + (size_t)l * 1024 * 6144 + n;
        float a0 = 0.f, a1 = 0.f;
#pragma unroll 8
        for (int k = kp * 128; k < kp * 128 + 128; ++k) {
            const float w = W[(size_t)k * 6144]; const float c0 = I.c[k], c1 = I.c[1024 + k];
            a0 += pg8::silu_f(c0) * w; a1 += pg8::silu_f(c1) * w;
        }
        LAS float* red = (LAS float*)(C.lds + RING_OFF);
        red[(kp * 2 + 0) * 64 + C.lane] = a0; red[(kp * 2 + 1) * 64 + C.lane] = a1;
        __syncthreads();
        if (C.wave < 2) { float s = I.ada_b[l * 6144 + n];
#pragma unroll
            for (int q = 0; q < 8; ++q) s += red[(q * 2 + C.wave) * 64 + C.lane];
            mod[(size_t)(l * 2 + C.wave) * 6144 + n] = s; }
        __syncthreads();
    }
    unsigned* trg = (unsigned*)(C.ws + WS_COS);
    typedef _Float16 ph2_t __attribute__((ext_vector_type(2)));
    for (int it = gw; it < TT / 2; it += NGW) {
        const int row = 2 * it + (C.lane >> 5), f0 = (C.lane & 31) * 4; const float p = (float)I.pos[row];
        u32x4 tv;
#pragma unroll
        for (int j = 0; j < 4; ++j) { const int f = f0 + j; double w = 1.0, bs = 0.93057204092969898;
#pragma unroll
            for (int bit = 0; bit < 7; ++bit) { if ((f >> bit) & 1) w *= bs; bs *= bs; }
            const float ang = p * (float)w; const double r = (double)ang * 0.15915494309189535; const float fr = (float)(r - floor(r));
            const unsigned clo_ = __builtin_bit_cast(unsigned short, (_Float16)__builtin_amdgcn_cosf(fr)), shi_ = __builtin_bit_cast(unsigned short, (_Float16)__builtin_amdgcn_sinf(fr)); tv[j] = clo_ | (shi_ << 16); }
        *(u32x4*)(trg + (size_t)row * 128 + f0) = tv;
    }
}
DI void side_work(const Ctx& C, const P0In& I, int nskip) {
    LAS float* scr = (LAS float*)(C.lds + RING_OFF + C.wave * 16384);
    const int gw = (C.vcu - nskip) * NWAVES + C.wave, NGW = (C.G - nskip) * NWAVES;
    bf16* wsi = (bf16*)(C.ws + WS_WSI); bf16* wso = (bf16*)(C.ws + WS_WSO); bf16* wq = (bf16*)(C.ws + WS_WQ);
    constexpr int I_SI = 16 * 192, I_SO = 48 * 32, I_Q = 16 * 64;
    constexpr int NITEMS = I_SI + I_SO + 2 * I_Q;
    for (int it = gw; it < NITEMS; it += NGW) {
        int r = it;
        if (r < I_SI) { p0_transpose_item(I.sgu_w_in, 1024, 6144, wsi, 0, scr, r, C.lane); continue; } r -= I_SI;
        if (r < I_SO) { p0_transpose_item(I.sgu_w_out, 3072, 1024, wso, 0, scr, r, C.lane); continue; } r -= I_SO;
        if (r < I_Q) { p0_transpose_item(I.wq, 1024, 2048, wq, 0, scr, r, C.lane); continue; } r -= I_Q;
        p0_transpose_item(I.wq + (size_t)1024 * 2048, 1024, 2048, wq + (size_t)2048 * 1024, 0, scr, r, C.lane);
    }
    cvt_rows_i8(I.pu, (unsigned char*)(C.ws + WS_PU), (float*)(C.ws + WS_ISU), 2 * 16384, gw, NGW, C.lane);
    cvt_rows_fp8(I.pv, (unsigned char*)(C.ws + WS_PV), (float*)(C.ws + WS_ISV), 2 * 16384, gw, NGW, C.lane);
}
DI void rms_mod_row(const float* xrow, const float* gain, const float* shift, const float* scale, bf16* orow, int lane) {
    const f32x4* xr = (const f32x4*)xrow + lane; f32x4 v[4]; float s = 0.f;
#pragma unroll
    for (int j = 0; j < 4; ++j) { v[j] = xr[64 * j]; s += (v[j].x * v[j].x + v[j].y * v[j].y) + (v[j].z * v[j].z + v[j].w * v[j].w); }
    const float rstd = 1.0f / sqrtf(wave_sum(s) * (1.0f / 1024.0f) + EPS);
    uint2* o8 = (uint2*)orow + lane;
#pragma unroll
    for (int j = 0; j < 4; ++j) { const f32x4 g = ((const f32x4*)gain)[lane + 64 * j], sh = ((const f32x4*)shift)[lane + 64 * j], sc = ((const f32x4*)scale)[lane + 64 * j];
        const f32x4 y = v[j] * rstd * g * (sc + 1.0f) + sh; uint2 o; o.x = pk2(y.x, y.y); o.y = pk2(y.z, y.w); o8[64 * j] = o; }
}
DI void rms_mod_row_b(const bf16* xrow, const float* gain, const float* shift, const float* scale, bf16* orow, int lane) {
    const uint2* xr = (const uint2*)xrow + lane; f32x4 v[4]; float s = 0.f;
#pragma unroll
    for (int j = 0; j < 4; ++j) { const uint2 w = xr[64 * j]; v[j].x = __uint_as_float(w.x << 16); v[j].y = __uint_as_float(w.x & 0xffff0000u); v[j].z = __uint_as_float(w.y << 16); v[j].w = __uint_as_float(w.y & 0xffff0000u);
        s += (v[j].x * v[j].x + v[j].y * v[j].y) + (v[j].z * v[j].z + v[j].w * v[j].w); }
    const float rstd = 1.0f / sqrtf(wave_sum(s) * (1.0f / 1024.0f) + EPS);
    uint2* o8 = (uint2*)orow + lane;
#pragma unroll
    for (int j = 0; j < 4; ++j) { const f32x4 g = ((const f32x4*)gain)[lane + 64 * j], sh = ((const f32x4*)shift)[lane + 64 * j], sc = ((const f32x4*)scale)[lane + 64 * j];
        const f32x4 y = v[j] * rstd * g * (sc + 1.0f) + sh; uint2 o; o.x = pk2(y.x, y.y); o.y = pk2(y.z, y.w); o8[64 * j] = o; }
}
DI void rms_mod_phase_b(const Ctx& C, const bf16* x, const float* gain, const float* mod_l, int sh_off, int sc_off, bf16* H) {
    const int gw = C.vcu * NWAVES + C.wave, NGW = C.G * NWAVES;
    for (int m = gw; m < TT; m += NGW) { const float* ml = mod_l + (size_t)(m >> 13) * 6144; rms_mod_row_b(x + (size_t)m * DM, gain, ml + sh_off, ml + sc_off, H + (size_t)m * DM, C.lane); }
}
DI void rms_mod_phase(const Ctx& C, const float* x, const float* gain, const float* mod_l, int sh_off, int sc_off, bf16* H) {
    const int gw = C.vcu * NWAVES + C.wave, NGW = C.G * NWAVES;
    for (int m = gw; m < TT; m += NGW) { const float* ml = mod_l + (size_t)(m >> 13) * 6144; rms_mod_row(x + (size_t)m * DM, gain, ml + sh_off, ml + sc_off, H + (size_t)m * DM, C.lane); }
}

DI void scan_naive(const Ctx& C, const bf16* Q, const bf16* K, const bf16* V, bf16* CROSS) {
    LAS float* Sst = (LAS float*)(C.lds);
    LAS unsigned* Qs = (LAS unsigned*)(C.lds + 16384);
    LAS bf16* Ks = (LAS bf16*)(C.lds + 16384 + 32768);
    LAS float* Vs = (LAS float*)(C.lds + 16384 + 65536);
    const int tid = C.tid;
    for (int item = C.vcu; item < 256; item += C.G) {
        const int b = item >> 7, h = (item >> 5) & 3, es = item & 31;
        const float lg2 = log2f(1.0f - exp2f(-5.0f - (float)h)); const float gc = exp2f(lg2 * 64.0f);
        for (int i = tid; i < 4096; i += 512) Sst[i] = 0.f;
        __syncthreads();
        for (int n = 0; n < 128; ++n) {
            const size_t tok0 = (size_t)b * SEQ + (size_t)n * 64;
            for (int ch = tid; ch < 2048; ch += 512) { const int r = ch >> 5, c = ch & 31;
                const u32x4 q = *(const u32x4*)(Q + (tok0 + r) * 1024 + h * 256 + c * 8); *(LAS u32x4*)(Qs + r * 128 + c * 4) = q;
                const u32x4 k = *(const u32x4*)(K + (tok0 + r) * 1024 + h * 256 + c * 8); *(LAS u32x4*)((LAS unsigned*)Ks + r * 128 + c * 4) = k; }
            for (int o = tid; o < 1024; o += 512) { const int j = o >> 4, e = o & 15; Vs[o] = bf2f(V[(tok0 + j) * 2048 + h * 512 + es * 16 + e]) * exp2f(lg2 * (float)(63 - j)); }
            __syncthreads();
#pragma unroll
            for (int oo = 0; oo < 2; ++oo) { const int o = tid + oo * 512, i = o >> 4, e = o & 15; float acc = 0.f;
#pragma unroll 8
                for (int d2 = 0; d2 < 128; ++d2) { const unsigned q2 = Qs[i * 128 + d2]; acc += bflo(q2) * Sst[(2 * d2) * 16 + e] + bfhi(q2) * Sst[(2 * d2 + 1) * 16 + e]; }
                CROSS[(tok0 + i) * 2048 + h * 512 + es * 16 + e] = (bf16)f2bf(acc * exp2f(lg2 * (float)(i + 1))); }
            __syncthreads();
            { const int e = tid & 15, dg = tid >> 4; float a[8];
#pragma unroll
              for (int r = 0; r < 8; ++r) a[r] = gc * Sst[(dg + 32 * r) * 16 + e];
#pragma unroll 4
              for (int j = 0; j < 64; ++j) { const float vz = Vs[j * 16 + e];
#pragma unroll
                  for (int r = 0; r < 8; ++r) a[r] += bf2f(Ks[j * 256 + dg + 32 * r]) * vz; }
#pragma unroll
              for (int r = 0; r < 8; ++r) Sst[(dg + 32 * r) * 16 + e] = a[r]; }
            __syncthreads();
        }
    }
}
DI void intra_naive(const Ctx& C, const bf16* Q, const bf16* K, const bf16* V, const bf16* CROSS, bf16* G) {
    LAS unsigned* Qs = (LAS unsigned*)(C.lds);
    LAS unsigned* Ks = (LAS unsigned*)(C.lds + 32768);
    LAS float* SC = (LAS float*)(C.lds + 65536);
    LAS float* red = (LAS float*)(C.lds + 65536 + 16384);
    LAS float* rs = red + 512;
    const int tid = C.tid;
    for (int item = C.vcu; item < 1024; item += C.G) {
        const int b = item >> 9, h = (item >> 7) & 3, n = item & 127;
        const float lg2 = log2f(1.0f - exp2f(-5.0f - (float)h));
        const size_t tok0 = (size_t)b * SEQ + (size_t)n * 64;
        for (int ch = tid; ch < 2048; ch += 512) { const int r = ch >> 5, c = ch & 31;
            *(LAS u32x4*)(Qs + r * 128 + c * 4) = *(const u32x4*)(Q + (tok0 + r) * 1024 + h * 256 + c * 8);
            *(LAS u32x4*)(Ks + r * 128 + c * 4) = *(const u32x4*)(K + (tok0 + r) * 1024 + h * 256 + c * 8); }
        __syncthreads();
        { const int i = tid >> 3, jb = (tid & 7) * 8;
#pragma unroll
          for (int jj = 0; jj < 8; ++jj) { const int j = jb + jj; float acc = 0.f;
#pragma unroll 8
              for (int d2 = 0; d2 < 128; ++d2) { const unsigned q2 = Qs[i * 128 + d2], k2 = Ks[j * 128 + d2]; acc += bflo(q2) * bflo(k2) + bfhi(q2) * bfhi(k2); }
              const int dd = i > j ? i - j : j - i; SC[i * 64 + j] = acc * exp2f(lg2 * (float)dd); } }
        __syncthreads();
#pragma unroll 1
        for (int pass = 0; pass < 2; ++pass) { const int e = tid, ib = pass * 32; float y[32];
#pragma unroll
          for (int i = 0; i < 32; ++i) y[i] = 0.f;
          const bf16* vp = V + tok0 * 2048 + h * 512 + e;
#pragma unroll 1
          for (int j4 = 0; j4 < 16; ++j4) {
              const float v0 = bf2f(vp[(size_t)(4 * j4 + 0) * 2048]), v1 = bf2f(vp[(size_t)(4 * j4 + 1) * 2048]), v2 = bf2f(vp[(size_t)(4 * j4 + 2) * 2048]), v3 = bf2f(vp[(size_t)(4 * j4 + 3) * 2048]);
#pragma unroll
              for (int i = 0; i < 32; ++i) { const f32x4 s4 = *(const LAS f32x4*)(SC + (ib + i) * 64 + 4 * j4); y[i] += (s4.x * v0 + s4.y * v1) + (s4.z * v2 + s4.w * v3); }
          }
          const bf16* cp = CROSS + (tok0 + ib) * 2048 + h * 512 + e;
#pragma unroll
          for (int i = 0; i < 32; ++i) { y[i] += bf2f(cp[(size_t)i * 2048]); const float ss = wave_sum(y[i] * y[i]); if (C.lane == 0) red[C.wave * 64 + i] = ss; }
          __syncthreads();
          if (tid < 32) { float s = 0.f;
#pragma unroll
              for (int w = 0; w < 8; ++w) s += red[w * 64 + tid];
              rs[tid] = 1.0f / sqrtf(s * (1.0f / 512.0f) + EPS); }
          __syncthreads();
          bf16* gp = G + (tok0 + ib) * 2048 + h * 512 + e;
#pragma unroll
          for (int i = 0; i < 32; ++i) { const float g = bf2f(gp[(size_t)i * 2048]); gp[(size_t)i * 2048] = (bf16)f2bf(y[i] * rs[i] * g); }
          __syncthreads();
        }
        __syncthreads();
    }
}
DI void peer_scores(const Ctx& C, const bf16* QP, const bf16* KEYS  , float* SCO) {
    const int gw = C.vcu * NWAVES + C.wave, NGW = C.G * NWAVES; const int fr = C.lane & 15, fq = C.lane >> 4;
    for (int it = gw; it < 1024 * 8; it += NGW) {
        const int tt = it >> 3, h = it & 7; const int tok = tt * 16 + fr;
#pragma unroll
        for (int p = 0; p < 2; ++p) {
            bf16x8 qf[4];
#pragma unroll
            for (int ks = 0; ks < 4; ++ks) qf[ks] = *(const bf16x8*)(QP + (size_t)tok * 2048 + h * 256 + p * 128 + ks * 32 + fq * 8);
            const bf16* kb = KEYS + (size_t)(h * 2 + p) * 128 * 128;
#pragma unroll
            for (int kt = 0; kt < 8; ++kt) {
                f32x4 acc = {0.f, 0.f, 0.f, 0.f};
#pragma unroll
                for (int ks = 0; ks < 4; ++ks) { const bf16x8 kf = *(const bf16x8*)(kb + (size_t)(kt * 16 + fr) * 128 + ks * 32 + fq * 8);
                    acc = __builtin_amdgcn_mfma_f32_16x16x32_bf16(kf, qf[ks], acc, 0, 0, 0); }
                *(f32x4*)(SCO + ((size_t)tok * 8 + h) * 256 + p * 128 + kt * 16 + fq * 4) = acc;
            }
        }
    }
}
template <bool HALVES> DI void select16(const float (&v)[4], int lane, bool (&sel)[4], int (&pos)[4]) {
    float mx = fmaxf(fmaxf(v[0], v[1]), fmaxf(v[2], v[3])), mn = fminf(fminf(v[0], v[1]), fminf(v[2], v[3]));
#pragma unroll
    for (int o = 1; o < (HALVES ? 32 : 64); o <<= 1) { mx = fmaxf(mx, __shfl_xor(mx, o)); mn = fminf(mn, __shfl_xor(mn, o)); }
    const bool up = HALVES && lane >= 32;
    float lo = mn, hi = mx, thr = mn; bool done = false;
    for (int iter = 0; iter < 48; ++iter) {
        const float mid = done ? thr : 0.5f * (lo + hi);
        int cnt = 0;
#pragma unroll
        for (int c = 0; c < 4; ++c) { const unsigned long long m = __ballot(v[c] >= mid);
            cnt += HALVES ? (up ? __popc((unsigned)(m >> 32)) : __popc((unsigned)m)) : __popcll(m); }
        if (!done) { if (cnt == 16) { thr = mid; done = true; } else if (cnt > 16) { lo = mid; thr = mid; } else hi = mid; }
        if (__all(done)) break;
    }
    int base = 0;
#pragma unroll
    for (int c = 0; c < 4; ++c) { sel[c] = v[c] >= thr; const unsigned long long m = __ballot(sel[c]);
        const unsigned long long gm = HALVES ? (up ? (m >> 32) : (m & 0xffffffffull)) : m; const int ll = HALVES ? (lane & 31) : lane;
        pos[c] = base + __popcll(gm & ((1ull << ll) - 1ull)); base += __popcll(gm); sel[c] = sel[c] && pos[c] < 16; }
}
DI void peer_topk(const Ctx& C, const float* SCO, int* IDX, float* GATE) {
    LAS float* sv = (LAS float*)(C.lds + C.wave * 512);
    LAS int* si = (LAS int*)(C.lds + C.wave * 512 + 128);
    LAS float* fv = (LAS float*)(C.lds + C.wave * 512 + 256);
    LAS int* fi = (LAS int*)(C.lds + C.wave * 512 + 320);
    const int gw = C.vcu * NWAVES + C.wave, NGW = C.G * NWAVES, lane = C.lane;
    for (int it = gw; it < TT * 8; it += NGW) {
        const f32x4 s4 = *(const f32x4*)(SCO + (size_t)it * 256 + lane * 4);
        float v[4] = {s4.x, s4.y, s4.z, s4.w}; bool sel[4]; int pos[4];
        select16<true>(v, lane, sel, pos);
        const int p = lane >> 5;
#pragma unroll
        for (int c = 0; c < 4; ++c) if (sel[c]) { sv[p * 16 + pos[c]] = v[c]; si[p * 16 + pos[c]] = (lane & 31) * 4 + c; }
        LDS_WAIT();
        const int a = lane >> 2, bq = (lane & 3) * 4; const float va = sv[a]; const int ia = si[a];
        float w[4]; int wi[4];
#pragma unroll
        for (int c = 0; c < 4; ++c) { w[c] = va + sv[16 + bq + c]; wi[c] = ia * 128 + si[16 + bq + c]; }
        select16<false>(w, lane, sel, pos);
#pragma unroll
        for (int c = 0; c < 4; ++c) if (sel[c]) { fv[pos[c]] = w[c]; fi[pos[c]] = wi[c]; }
        LDS_WAIT();
        const float x = fv[lane & 15]; const int xi = fi[lane & 15];
        float m = x;
#pragma unroll
        for (int o = 1; o < 16; o <<= 1) m = fmaxf(m, __shfl_xor(m, o));
        const float e = __expf(x - m); float s = e;
#pragma unroll
        for (int o = 1; o < 16; o <<= 1) s += __shfl_xor(s, o);
        if (lane < 16) { IDX[(size_t)it * 16 + lane] = xi; GATE[(size_t)it * 16 + lane] = e / s; }
        LDS_WAIT();
    }
}
template <bool FINAL> DI void peer_gather(const Ctx& C, const bf16* H, const int* IDX, const float* GATE, const bf16* PU, const bf16* PV, float* X, const float* g2  ,
                                          const float* ngain, const float* nmod  , bf16* Hn) {
    const int gw = C.vcu * NWAVES + C.wave, NGW = C.G * NWAVES, lane = C.lane;
    for (int t = gw; t < TT; t += NGW) {
        float hv[16];
        { const u32x4 a = *(const u32x4*)(H + (size_t)t * 1024 + lane * 8), bq = *(const u32x4*)(H + (size_t)t * 1024 + 512 + lane * 8);
          hv[0] = bflo(a.x); hv[1] = bfhi(a.x); hv[2] = bflo(a.y); hv[3] = bfhi(a.y); hv[4] = bflo(a.z); hv[5] = bfhi(a.z); hv[6] = bflo(a.w); hv[7] = bfhi(a.w);
          hv[8] = bflo(bq.x); hv[9] = bfhi(bq.x); hv[10] = bflo(bq.y); hv[11] = bfhi(bq.y); hv[12] = bflo(bq.z); hv[13] = bfhi(bq.z); hv[14] = bflo(bq.w); hv[15] = bfhi(bq.w); }
        const int i0 = IDX[(size_t)t * 128 + lane], i1 = IDX[(size_t)t * 128 + 64 + lane];
        const float g0 = GATE[(size_t)t * 128 + lane], g1 = GATE[(size_t)t * 128 + 64 + lane];
        float a0 = 0.f, a1 = 0.f;
        for (int k = 0; k < 128; k += 4) {
            float dsum[4];
#pragma unroll
            for (int kk = 0; kk < 4; ++kk) { const int kq = k + kk; const int e = kq < 64 ? __builtin_amdgcn_readlane(i0, kq) : __builtin_amdgcn_readlane(i1, kq - 64);
                const bf16* ur = PU + (size_t)e * 1024; const u32x4 a = *(const u32x4*)(ur + lane * 8), bq = *(const u32x4*)(ur + 512 + lane * 8);
                float d = bflo(a.x) * hv[0] + bfhi(a.x) * hv[1]; d += bflo(a.y) * hv[2] + bfhi(a.y) * hv[3]; d += bflo(a.z) * hv[4] + bfhi(a.z) * hv[5]; d += bflo(a.w) * hv[6] + bfhi(a.w) * hv[7];
                d += bflo(bq.x) * hv[8] + bfhi(bq.x) * hv[9]; d += bflo(bq.y) * hv[10] + bfhi(bq.y) * hv[11]; d += bflo(bq.z) * hv[12] + bfhi(bq.z) * hv[13]; d += bflo(bq.w) * hv[14] + bfhi(bq.w) * hv[15];
                dsum[kk] = d; }
#pragma unroll
            for (int kk = 0; kk < 4; ++kk) { const int kq = k + kk; const float d = gelu_t(wave_sum(dsum[kk]));
                if (kq < 64) { if (lane == kq) a0 = d * g0; } else { if (lane == kq - 64) a1 = d * g1; } }
        }
        float o[16];
#pragma unroll
        for (int j = 0; j < 16; ++j) o[j] = 0.f;
        for (int k = 0; k < 128; k += 4) {
#pragma unroll
            for (int kk = 0; kk < 4; ++kk) { const int kq = k + kk; const int e = kq < 64 ? __builtin_amdgcn_readlane(i0, kq) : __builtin_amdgcn_readlane(i1, kq - 64);
                const float ak = __int_as_float(kq < 64 ? __builtin_amdgcn_readlane(__float_as_int(a0), kq) : __builtin_amdgcn_readlane(__float_as_int(a1), kq - 64));
                const bf16* vr = PV + (size_t)e * 1024; const u32x4 a = *(const u32x4*)(vr + lane * 8), bq = *(const u32x4*)(vr + 512 + lane * 8);
                o[0] += ak * bflo(a.x); o[1] += ak * bfhi(a.x); o[2] += ak * bflo(a.y); o[3] += ak * bfhi(a.y); o[4] += ak * bflo(a.z); o[5] += ak * bfhi(a.z); o[6] += ak * bflo(a.w); o[7] += ak * bfhi(a.w);
                o[8] += ak * bflo(bq.x); o[9] += ak * bfhi(bq.x); o[10] += ak * bflo(bq.y); o[11] += ak * bfhi(bq.y); o[12] += ak * bflo(bq.z); o[13] += ak * bfhi(bq.z); o[14] += ak * bflo(bq.w); o[15] += ak * bfhi(bq.w); }
        }
#ifdef DBG_ZERO_PEER
#pragma unroll
        for (int j = 0; j < 16; ++j) o[j] = 0.f;
#endif
        const int b = t >> 13; const float* gp = g2 + (size_t)b * 6144; float* xr = X + (size_t)t * 1024;
        float xn[16]; float ss = 0.f;
#pragma unroll
        for (int q = 0; q < 4; ++q) { const int col = (q >> 1) * 512 + lane * 8 + (q & 1) * 4; const f32x4 xv = *(const f32x4*)(xr + col), gv = *(const f32x4*)(gp + col);
#pragma unroll
            for (int j = 0; j < 4; ++j) { const float y = xv[j] + gv[j] * o[q * 4 + j]; xn[q * 4 + j] = y; ss += y * y; } }
        const float rstd = 1.0f / sqrtf(wave_sum(ss) * (1.0f / 1024.0f) + EPS);
        if (FINAL) {
#pragma unroll
            for (int q = 0; q < 4; ++q) { const int col = (q >> 1) * 512 + lane * 8 + (q & 1) * 4; const f32x4 gn = *(const f32x4*)(ngain + col); f32x4 y;
#pragma unroll
                for (int j = 0; j < 4; ++j) y[j] = xn[q * 4 + j] * rstd * gn[j];
                *(f32x4*)(xr + col) = y; }
        } else {
            const float* nm = nmod + (size_t)b * 6144;
#pragma unroll
            for (int q = 0; q < 4; ++q) { const int col = (q >> 1) * 512 + lane * 8 + (q & 1) * 4; const f32x4 gn = *(const f32x4*)(ngain + col), sh = *(const f32x4*)(nm + col), sc = *(const f32x4*)(nm + 1024 + col); f32x4 xo; float y[4];
#pragma unroll
                for (int j = 0; j < 4; ++j) { xo[j] = xn[q * 4 + j]; y[j] = xn[q * 4 + j] * rstd * gn[j] * (1.0f + sc[j]) + sh[j]; }
                *(f32x4*)(xr + col) = xo; uint2 w; w.x = pk2(y[0], y[1]); w.y = pk2(y[2], y[3]); *(uint2*)(Hn + (size_t)t * 1024 + col) = w; }
        }
    }
}
DI void sgu_gate_naive(const Ctx& C, bf16* U, const bf16* VB, const float* stats, const float* w_s, const float* b_s, const float* ln_g, const float* ln_b) {
    LAS float* Wm = (LAS float*)(C.lds);
    LAS float* mu = (LAS float*)(C.lds + 65536);
    LAS float* rsd = mu + 128;
    const int tid = C.tid;
    for (int item = C.vcu; item < 1024; item += C.G) {
        const int n = item >> 3, g = item & 7; const size_t row0 = (size_t)n * 128;
        for (int i = tid; i < 16384; i += 512) { const int r = i >> 7, c = i & 127; const float w = w_s[(size_t)g * 16384 + i]; Wm[i] = (r < 64 && c >= 64) ? 0.f : w; }
        if (tid < 128) { const float* sp = stats + (row0 + tid) * 96; float s1 = 0.f, s2 = 0.f;
            for (int q = 0; q < 48; ++q) { s1 += sp[2 * q]; s2 += sp[2 * q + 1]; }
            const float m = s1 * (1.0f / 3072.0f); const float var = s2 * (1.0f / 3072.0f) - m * m; mu[tid] = m; rsd[tid] = 1.0f / sqrtf(fmaxf(var, 0.f) + EPS); }
        __syncthreads();
        if (tid < 384) {
            const int col = g * 384 + tid; const float lg = ln_g[col], lb = ln_b[col];
#pragma unroll
            for (int pass = 0; pass < 2; ++pass) {
                float acc[64];
#pragma unroll
                for (int i = 0; i < 64; ++i) acc[i] = 0.f;
                const int jmax = pass == 0 ? 64 : 128;
                for (int j = 0; j < jmax; ++j) { const float v = bf2f(VB[(row0 + j) * 3072 + col]); const float vl = (v - mu[j]) * rsd[j] * lg + lb;
#pragma unroll
                    for (int i = 0; i < 64; ++i) acc[i] += Wm[(pass * 64 + i) * 128 + j] * vl; }
#pragma unroll
                for (int i = 0; i < 64; ++i) { const int r = pass * 64 + i; const float s = acc[i] + b_s[g * 128 + r]; bf16* up = U + (row0 + r) * 3072 + col; *up = (bf16)f2bf(bf2f(*up) * s); }
            }
        }
        __syncthreads();
    }
}
typedef short v4i16_t __attribute__((ext_vector_type(4)));
typedef unsigned u32x2_t __attribute__((ext_vector_type(2)));
typedef __bf16 bf16x2_t __attribute__((ext_vector_type(2)));
DI unsigned cvtpk(float lo, float hi) { f32x2_t v = {lo, hi}; bf16x2_t b = __builtin_convertvector(v, bf16x2_t); return __builtin_bit_cast(unsigned, b); }
DI v4i16_t trr(const LAS unsigned char* p) { return __builtin_amdgcn_ds_read_tr16_b64_v4i16((LAS v4i16_t*)p); }
DI bf16x8 cat8(v4i16_t a, v4i16_t b) { return __builtin_shufflevector(a, b, 0, 1, 2, 3, 4, 5, 6, 7); }
DI bf16x8 pack2(const f32x4& a, const f32x4& b) { u32x4 p; p.x = cvtpk(a[0], a[1]); p.y = cvtpk(a[2], a[3]); p.z = cvtpk(b[0], b[1]); p.w = cvtpk(b[2], b[3]); return __builtin_bit_cast(bf16x8, p); }
DI u32x4 scale8(u32x4 v, float s) { u32x4 o; o.x = cvtpk(bflo(v.x) * s, bfhi(v.x) * s); o.y = cvtpk(bflo(v.y) * s, bfhi(v.y) * s); o.z = cvtpk(bflo(v.z) * s, bfhi(v.z) * s); o.w = cvtpk(bflo(v.w) * s, bfhi(v.w) * s); return o; }
#ifndef SCAN_QPI
#define SCAN_QPI 544
#endif
#ifndef SCAN_KPI
#define SCAN_KPI 544
#endif
#ifndef SCAN_PFD
#define SCAN_PFD 5
#endif
constexpr int SCAN_ESL = 32, SCAN_NCW = SCAN_ESL / 16, SCAN_NSL = 512 / SCAN_ESL, SCAN_NIT = 8 * SCAN_NSL;
#define SCAN_BAR() do { asm volatile("s_waitcnt lgkmcnt(0)" ::: "memory"); __builtin_amdgcn_s_barrier(); asm volatile("" ::: "memory"); } while (0)
template <int MODE = 0> DI void scan_mfma(const Ctx& C, const bf16* Q, const bf16* K, const bf16* V, bf16* CROSS) {
    constexpr int QPI = SCAN_QPI, KPI = SCAN_KPI, VPI = SCAN_ESL * 2 + 32, VCH = SCAN_ESL / 8  , NVC = 64 * VCH;
    constexpr int OQ = 0, OK_ = 64 * QPI, OV = OK_ + 64 * KPI, BUFB = OV + 64 * VPI;
    constexpr int NST = (NWAVES - 1 - SCAN_NCW) * 64;
    const int w = C.wave;
    for (int item = C.vcu; item < SCAN_NIT; item += C.G) {
        const int b = item / (4 * SCAN_NSL), h = (item / SCAN_NSL) & 3, es = item % SCAN_NSL;
        const float lg2 = log2f(1.0f - exp2f(-5.0f - (float)h)); const float gc = exp2f(lg2 * 64.0f);
        const size_t tokb = (size_t)b * SEQ;
        if (w >= SCAN_NCW) {
            int tl_ = C.tid; asm volatile("" : "+v"(tl_));
            const int st = (w == NWAVES - 1) ? (tl_ & 63) : tl_ - SCAN_NCW * 64;
            if (w == NWAVES - 1) {
                unsigned dmy = 0u;
#define SCAN_PF1(ptr) asm volatile("global_load_dword %0, %1, off" : "+v"(dmy) : "v"(ptr) : "memory")
#define SCAN_PF(n) do { const size_t t0_ = tokb + (size_t)(n) * 64; \
                if ((es & 3) == 0) { _Pragma("unroll") for (int u = 0; u < 4; ++u) { const int ln = st + 64 * u, r = ln >> 2, q = ln & 3; SCAN_PF1(Q + (t0_ + r) * 1024 + h * 256 + q * 64); SCAN_PF1(K + (t0_ + r) * 1024 + h * 256 + q * 64); } } \
                SCAN_PF1(V + (t0_ + st) * 2048 + h * 512 + es * SCAN_ESL); } while (0)
#ifndef SCAN_NOPF
                SCAN_PF(3); SCAN_PF(4);
#endif
                SCAN_BAR();
#pragma unroll 1
                for (int n = 0; n < 128; ++n) {
#ifndef SCAN_NOPF
                    if (n + SCAN_PFD < 128) SCAN_PF(n + SCAN_PFD);
#endif
                    SCAN_BAR(); }
                asm volatile("s_waitcnt vmcnt(0)" : "+v"(dmy) :: "memory");
#undef SCAN_PF
#undef SCAN_PF1
            } else {
            u32x4 rqA[7], rkA[7], rvA, rqB[7], rkB[7], rvB;
            const unsigned qo_ = (unsigned)((st >> 5) * 2048 + (st & 31) * 16), qo6_ = (st + NST * 6 < 2048) ? qo_ + (unsigned)(6 * (NST / 32) * 2048) : qo_;
            const unsigned vo_ = (st < NVC) ? (unsigned)((st / VCH) * 4096 + (st % VCH) * 16) : 0u;
#define SCAN_LD(RQ, RK, RV, n) do { const size_t t0_ = tokb + (size_t)((n) < 127 ? (n) : 127) * 64; \
            const unsigned char* qb_ = (const unsigned char*)(Q + t0_ * 1024 + h * 256); const unsigned char* kb_ = (const unsigned char*)(K + t0_ * 1024 + h * 256); \
            const unsigned char* vb_ = (const unsigned char*)(V + t0_ * 2048 + h * 512 + es * SCAN_ESL); \
            _Pragma("unroll") for (int u = 0; u < 7; ++u) { const unsigned o_ = u == 6 ? qo6_ : qo_ + (unsigned)(u * (NST / 32) * 2048); \
                RQ[u] = *(const u32x4*)(qb_ + o_); RK[u] = *(const u32x4*)(kb_ + o_); } \
            RV = *(const u32x4*)(vb_ + vo_); } while (0)
#define SCAN_WR(RQ, RK, RV, bufo) do { LAS unsigned char* B_ = C.lds + (bufo); \
            _Pragma("unroll") for (int u = 0; u < 7; ++u) { const int c = st + NST * u; if (c < 2048) { const int r = c >> 5, cc = c & 31; \
                *(LAS u32x4*)(B_ + OQ + r * QPI + cc * 16) = RQ[u]; *(LAS u32x4*)(B_ + OK_ + r * KPI + cc * 16) = RK[u]; } } \
            if (st < NVC) { const int r = st / VCH, cc = st % VCH; *(LAS u32x4*)(B_ + OV + r * VPI + cc * 16) = scale8(RV, exp2f(lg2 * (float)(63 - r))); } } while (0)
            SCAN_LD(rqA, rkA, rvA, 0); SCAN_WR(rqA, rkA, rvA, 0); SCAN_LD(rqA, rkA, rvA, 1); SCAN_LD(rqB, rkB, rvB, 2);
            SCAN_BAR();
#pragma unroll 1
            for (int n = 0; n < 128; n += 2) {
                if (MODE != 2) { SCAN_WR(rqA, rkA, rvA, BUFB); SCAN_LD(rqA, rkA, rvA, n + 3); }
                SCAN_BAR();
                if (MODE != 2) { SCAN_WR(rqB, rkB, rvB, 0); SCAN_LD(rqB, rkB, rvB, n + 4); }
                SCAN_BAR();
            }
#undef SCAN_LD
#undef SCAN_WR
            }
        } else {
            int tl_ = C.tid; asm volatile("" : "+v"(tl_)); const int lane = tl_ & 63, fr = lane & 15, fq = lane >> 4;
            f32x4 S[16];
#pragma unroll
            for (int t = 0; t < 16; ++t) S[t] = (f32x4){0.f, 0.f, 0.f, 0.f};
            SCAN_BAR();
#define SC_LQ(QF, DB) do { _Pragma("unroll") for (int m = 0; m < 4; ++m) QF[m] = *(const LAS bf16x8*)(Qs + (16 * m + fr) * QPI + (32 * (DB) + 8 * fq) * 2); __builtin_amdgcn_sched_barrier(0); } while (0)
#define SC_MQ(QF, DB) do { const bf16x8 sa0 = pack2(S[2 * (DB)], S[2 * (DB) + 1]); \
            _Pragma("unroll") for (int m = 0; m < 4; ++m) acc[m] = __builtin_amdgcn_mfma_f32_16x16x32_bf16(sa0, QF[m], acc[m], 0, 0, 0); __builtin_amdgcn_sched_barrier(0); } while (0)
#define SC_LK(KF, KS, TQ) do { const LAS unsigned char* kp = Ks + (32 * (KS) + 4 * fq + (fr >> 2)) * KPI + (8 * (fr & 3)) * 2;     \
            _Pragma("unroll") for (int t4 = 0; t4 < 4; ++t4) { const int t = 4 * (TQ) + t4; KF[t4] = cat8(trr(kp + 64 * (t >> 1) + 8 * (t & 1)), trr(kp + 64 * (t >> 1) + 8 * (t & 1) + 16 * KPI)); } __builtin_amdgcn_sched_barrier(0); } while (0)
#define SC_LV(VF, KS) do { const LAS unsigned char* vp = Vs + (32 * (KS) + 4 * fq + (fr >> 2)) * VPI + (16 * w + 4 * (fr & 3)) * 2; VF = cat8(trr(vp), trr(vp + 16 * VPI)); } while (0)
#define SC_MK(KF, VF, TQ) do { _Pragma("unroll") for (int t4 = 0; t4 < 4; ++t4) S[4 * (TQ) + t4] = __builtin_amdgcn_mfma_f32_16x16x32_bf16(KF[t4], VF, S[4 * (TQ) + t4], 0, 0, 0); __builtin_amdgcn_sched_barrier(0); } while (0)
#define SCAN_CHUNK(n_, BO) do { const size_t tok0 = tokb + (size_t)(n_) * 64; LAS unsigned char* Qs = C.lds + (BO) + OQ; LAS unsigned char* Ks = C.lds + (BO) + OK_; LAS unsigned char* Vs = C.lds + (BO) + OV; \
                f32x4 acc[4]; bf16x8 fA[4], fB[4], kA[4], kB[4], vf0, vf1; \
                _Pragma("unroll") for (int m = 0; m < 4; ++m) acc[m] = (f32x4){0.f, 0.f, 0.f, 0.f}; \
                SC_LQ(fA, 0); SC_LQ(fB, 1); SC_MQ(fA, 0); SC_LQ(fA, 2); SC_MQ(fB, 1); SC_LQ(fB, 3); SC_MQ(fA, 2); SC_LQ(fA, 4); SC_MQ(fB, 3); SC_LQ(fB, 5); SC_MQ(fA, 4); SC_LQ(fA, 6); SC_MQ(fB, 5); SC_LQ(fB, 7); SC_MQ(fA, 6); SC_LV(vf0, 0); SC_LV(vf1, 1); SC_LK(kA, 0, 0); SC_MQ(fB, 7); \
                _Pragma("unroll") for (int m = 0; m < 4; ++m) { const f32x4 v = acc[m] * exp2f(lg2 * (float)(16 * m + fr + 1)); uint2 o; o.x = cvtpk(v[0], v[1]); o.y = cvtpk(v[2], v[3]); \
                    *(uint2*)(CROSS + (tok0 + 16 * m + fr) * 2048 + h * 512 + es * SCAN_ESL + 16 * w + 4 * fq) = o; } \
                _Pragma("unroll") for (int t = 0; t < 16; ++t) S[t] = S[t] * gc; \
                __builtin_amdgcn_sched_barrier(0); \
                SC_LK(kB, 0, 1); SC_MK(kA, vf0, 0); SC_LK(kA, 0, 2); SC_MK(kB, vf0, 1); SC_LK(kB, 0, 3); SC_MK(kA, vf0, 2); SC_LK(kA, 1, 0); SC_MK(kB, vf0, 3); SC_LK(kB, 1, 1); SC_MK(kA, vf1, 0); SC_LK(kA, 1, 2); SC_MK(kB, vf1, 1); SC_LK(kB, 1, 3); SC_MK(kA, vf1, 2); SC_MK(kB, vf1, 3); \
                SCAN_BAR(); } while (0)
#pragma unroll 1
            for (int n = 0; n < 128; n += 2) { if (MODE == 1) { SCAN_BAR(); SCAN_BAR(); } else { SCAN_CHUNK(n, 0); SCAN_CHUNK(n + 1, BUFB); } }
#undef SCAN_CHUNK
#undef SC_LQ
#undef SC_MQ
#undef SC_LK
#undef SC_LV
#undef SC_MK
        }
    }
}
#undef SCAN_BAR
DI void sgu_gate_mfma(const Ctx& C, bf16* U, const bf16* VB, const float* stats, const float* w_s, const float* b_s, const float* ln_g, const float* ln_b) {
    constexpr int WPI = 272, VPI = 288;
    LAS unsigned char* Ws = C.lds; LAS unsigned char* Vs = C.lds + 128 * WPI;
    LAS float* mu = (LAS float*)(C.lds + 128 * WPI + 128 * VPI); LAS float* rsd = mu + 128; LAS float* r1 = mu + 256; LAS float* r2 = mu + 384; LAS float* bsl = mu + 512;
    const int tid = C.tid, lane = C.lane, w = C.wave, fr = lane & 15, fq = lane >> 4;
    for (int item = C.vcu; item < 1024; item += C.G) {
        const int n = item >> 3, g = item & 7; const size_t row0 = (size_t)n * 128;
        if (tid < 128) { const float* sp = stats + (row0 + tid) * 96; float s1 = 0.f, s2 = 0.f;
#pragma unroll 8
            for (int q = 0; q < 48; ++q) { s1 += sp[2 * q]; s2 += sp[2 * q + 1]; }
            const float m = s1 * (1.0f / 3072.0f); const float var = s2 * (1.0f / 3072.0f) - m * m; mu[tid] = m; rsd[tid] = 1.0f / sqrtf(fmaxf(var, 0.f) + EPS); bsl[tid] = b_s[g * 128 + tid]; }
        __syncthreads();
        { const int i = tid >> 2, jq = tid & 3; const float* wp = w_s + (size_t)g * 16384 + i * 128 + jq * 32; float a1 = 0.f, a2 = 0.f;
#pragma unroll
          for (int c8 = 0; c8 < 4; ++c8) { const f32x4 wa = *(const f32x4*)(wp + c8 * 8), wb = *(const f32x4*)(wp + c8 * 8 + 4); float wv[8] = {wa[0], wa[1], wa[2], wa[3], wb[0], wb[1], wb[2], wb[3]}; float o[8];
#pragma unroll
              for (int q = 0; q < 8; ++q) { const int j = jq * 32 + c8 * 8 + q; const float wm = (i < 64 && j >= 64) ? 0.f : wv[q]; const float wr_ = wm * rsd[j]; o[q] = wr_; a1 += wr_ * mu[j]; a2 += wm; }
              u32x4 pk; pk.x = cvtpk(o[0], o[1]); pk.y = cvtpk(o[2], o[3]); pk.z = cvtpk(o[4], o[5]); pk.w = cvtpk(o[6], o[7]);
              *(LAS u32x4*)(Ws + i * WPI + (jq * 32 + c8 * 8) * 2) = pk; }
          a1 += __shfl_xor(a1, 1); a1 += __shfl_xor(a1, 2); a2 += __shfl_xor(a2, 1); a2 += __shfl_xor(a2, 2);
          if (jq == 0) { r1[i] = a1; r2[i] = a2; } }
#pragma unroll 1
        for (int cs = 0; cs < 3; ++cs) {
            const int colb = g * 384 + cs * 128;
#pragma unroll
            for (int u = 0; u < 4; ++u) { const int c = tid + 512 * u, r = c >> 4, cc = c & 15;
                *(LAS u32x4*)(Vs + r * VPI + cc * 16) = *(const u32x4*)(VB + (row0 + r) * 3072 + colb + cc * 8); }
            __syncthreads();
            f32x4 acc[8];
#pragma unroll
            for (int it = 0; it < 8; ++it) acc[it] = (f32x4){0.f, 0.f, 0.f, 0.f};
#pragma unroll
            for (int ks = 0; ks < 4; ++ks) {
                const LAS unsigned char* vp = Vs + (32 * ks + 4 * fq + (fr >> 2)) * VPI + (16 * w + 4 * (fr & 3)) * 2;
                const bf16x8 vf = cat8(trr(vp), trr(vp + 16 * VPI));
#pragma unroll
                for (int it = 0; it < 8; ++it) { if (it < 4 && ks >= 2) continue;
                    const LAS unsigned char* wp = Ws + (16 * it + fr) * WPI + (32 * ks + 4 * fq) * 2;
                    const u32x2_t lo = *(const LAS u32x2_t*)wp, hi = *(const LAS u32x2_t*)(wp + 32);
                    u32x4 ww; ww.x = lo.x; ww.y = lo.y; ww.z = hi.x; ww.w = hi.y;
                    acc[it] = __builtin_amdgcn_mfma_f32_16x16x32_bf16(vf, __builtin_bit_cast(bf16x8, ww), acc[it], 0, 0, 0); }
            }
            const int c0 = colb + 16 * w + 4 * fq;
            const f32x4 lg = *(const f32x4*)(ln_g + c0), lb = *(const f32x4*)(ln_b + c0);
#pragma unroll
            for (int it = 0; it < 8; ++it) { const int i = 16 * it + fr; const float q1 = r1[i], q2 = r2[i], bb = bsl[i];
                bf16* up = U + (row0 + i) * 3072 + c0; const u32x2_t uu = *(const u32x2_t*)up;
                const f32x4 s = lg * (acc[it] - q1) + lb * q2 + bb;
                u32x2_t o; o.x = cvtpk(bflo(uu.x) * s[0], bfhi(uu.x) * s[1]); o.y = cvtpk(bflo(uu.y) * s[2], bfhi(uu.y) * s[3]);
                *(u32x2_t*)up = o; }
            __syncthreads();
        }
    }
}
DI void up8(unsigned wd, float& a, float& b, float& c, float& d) { const f32x2_t lo = __builtin_amdgcn_cvt_pk_f32_fp8((int)wd, false), hi = __builtin_amdgcn_cvt_pk_f32_fp8((int)wd, true); a = lo.x; b = lo.y; c = hi.x; d = hi.y; }
DI float dot16(const u32x4 u, const float (&hv)[16]) {
    float f[16];
    up8(u.x, f[0], f[1], f[2], f[3]); up8(u.y, f[4], f[5], f[6], f[7]); up8(u.z, f[8], f[9], f[10], f[11]); up8(u.w, f[12], f[13], f[14], f[15]);
    float d0 = f[0] * hv[0], d1 = f[1] * hv[1];
#pragma unroll
    for (int j = 2; j < 16; j += 2) { d0 += f[j] * hv[j]; d1 += f[j + 1] * hv[j + 1]; }
    return d0 + d1;
}
template <bool FINAL> DI void peer_gather8(const Ctx& C, const bf16* Hin, const int* IDX, const float* GATE, const unsigned char* PU8, const unsigned char* PV8, const float* ISU, const float* ISV,
                                           float* X, const float* g2, const float* ngain, const float* nmod, bf16* Hn) {
    const int gw = C.vcu * NWAVES + C.wave, NGW = C.G * NWAVES, lane = C.lane;
    LAS float* DL = (LAS float*)(C.lds + C.wave * 1024);
    LAS float* AL = DL + 128;
    for (int t = gw; t < TT; t += NGW) {
        float hv[16];
        { const u32x4 a = *(const u32x4*)(Hin + (size_t)t * 1024 + lane * 16), bq = *(const u32x4*)(Hin + (size_t)t * 1024 + lane * 16 + 8);
          hv[0] = bflo(a.x); hv[1] = bfhi(a.x); hv[2] = bflo(a.y); hv[3] = bfhi(a.y); hv[4] = bflo(a.z); hv[5] = bfhi(a.z); hv[6] = bflo(a.w); hv[7] = bfhi(a.w);
          hv[8] = bflo(bq.x); hv[9] = bfhi(bq.x); hv[10] = bflo(bq.y); hv[11] = bfhi(bq.y); hv[12] = bflo(bq.z); hv[13] = bfhi(bq.z); hv[14] = bflo(bq.w); hv[15] = bfhi(bq.w); }
        const int i0 = IDX[(size_t)t * 128 + lane], i1 = IDX[(size_t)t * 128 + 64 + lane];
        const float g0 = GATE[(size_t)t * 128 + lane], g1 = GATE[(size_t)t * 128 + 64 + lane];
        const float su0 = ISU[i0], su1 = ISU[i1], sv0 = ISV[i0], sv1 = ISV[i1];
        u32x4 ub[8];
#define PG_LOADU(k0) do { _Pragma("unroll") for (int j = 0; j < 8; ++j) { const int kq = (k0) + j; const int e = kq < 64 ? __builtin_amdgcn_readlane(i0, kq) : __builtin_amdgcn_readlane(i1, kq - 64); \
            ub[j] = *(const u32x4*)(PU8 + (size_t)e * 1024 + lane * 16); } } while (0)
        PG_LOADU(0);
#pragma unroll 1
        for (int k0 = 0; k0 < 128; k0 += 8) {
            float p[8];
#pragma unroll
            for (int j = 0; j < 8; ++j) p[j] = dot16(ub[j], hv);
            if (k0 + 8 < 128) PG_LOADU(k0 + 8);
            const bool h32 = lane & 32, h16 = lane & 16, h8 = lane & 8;
            float q4[4];
#pragma unroll
            for (int j = 0; j < 4; ++j) { const float keep = h32 ? p[j + 4] : p[j], send = h32 ? p[j] : p[j + 4]; q4[j] = keep + __shfl_xor(send, 32); }
            float q2[2];
#pragma unroll
            for (int j = 0; j < 2; ++j) { const float keep = h16 ? q4[j + 2] : q4[j], send = h16 ? q4[j] : q4[j + 2]; q2[j] = keep + __shfl_xor(send, 16); }
            float q1; { const float keep = h8 ? q2[1] : q2[0], send = h8 ? q2[0] : q2[1]; q1 = keep + __shfl_xor(send, 8); }
            q1 += __shfl_xor(q1, 4); q1 += __shfl_xor(q1, 2); q1 += __shfl_xor(q1, 1);
            if ((lane & 7) == 0) DL[k0 + ((lane >> 5) & 1) * 4 + ((lane >> 4) & 1) * 2 + ((lane >> 3) & 1)] = q1;
        }
#undef PG_LOADU
        LDS_WAIT();
        { const float d0 = DL[lane], d1 = DL[64 + lane]; AL[lane] = gelu_t(d0 * su0) * g0 * sv0; AL[64 + lane] = gelu_t(d1 * su1) * g1 * sv1; }
        LDS_WAIT();
        float o[16];
#pragma unroll
        for (int j = 0; j < 16; ++j) o[j] = 0.f;
        u32x4 vb[8];
#define PG_LOADV(k0) do { _Pragma("unroll") for (int j = 0; j < 8; ++j) { const int kq = (k0) + j; const int e = kq < 64 ? __builtin_amdgcn_readlane(i0, kq) : __builtin_amdgcn_readlane(i1, kq - 64); \
            vb[j] = *(const u32x4*)(PV8 + (size_t)e * 1024 + lane * 16); } } while (0)
        PG_LOADV(0);
#pragma unroll 1
        for (int k0 = 0; k0 < 128; k0 += 8) {
            float f[8][16];
#pragma unroll
            for (int j = 0; j < 8; ++j) { up8(vb[j].x, f[j][0], f[j][1], f[j][2], f[j][3]); up8(vb[j].y, f[j][4], f[j][5], f[j][6], f[j][7]); up8(vb[j].z, f[j][8], f[j][9], f[j][10], f[j][11]); up8(vb[j].w, f[j][12], f[j][13], f[j][14], f[j][15]); }
            if (k0 + 8 < 128) PG_LOADV(k0 + 8);
#pragma unroll
            for (int j = 0; j < 8; ++j) { const float ak = AL[k0 + j];
#pragma unroll
                for (int q = 0; q < 16; ++q) o[q] += ak * f[j][q]; }
        }
#undef PG_LOADV
        const int b = t >> 13; const float* gp = g2 + (size_t)b * 6144; float* xr = X + (size_t)t * 1024;
        float xn[16]; float ss = 0.f;
#pragma unroll
        for (int q = 0; q < 4; ++q) { const int col = lane * 16 + q * 4; const f32x4 xv = *(const f32x4*)(xr + col), gv = *(const f32x4*)(gp + col);
#pragma unroll
            for (int j = 0; j < 4; ++j) { const float y = xv[j] + gv[j] * o[q * 4 + j]; xn[q * 4 + j] = y; ss += y * y; } }
        const float rstd = 1.0f / sqrtf(wave_sum(ss) * (1.0f / 1024.0f) + EPS);
        if (FINAL) {
#pragma unroll
            for (int q = 0; q < 4; ++q) { const int col = lane * 16 + q * 4; const f32x4 gn = *(const f32x4*)(ngain + col); f32x4 y;
#pragma unroll
                for (int j = 0; j < 4; ++j) y[j] = xn[q * 4 + j] * rstd * gn[j];
                *(f32x4*)(xr + col) = y; }
        } else {
            const float* nm = nmod + (size_t)b * 6144;
#pragma unroll
            for (int q = 0; q < 4; ++q) { const int col = lane * 16 + q * 4; const f32x4 gn = *(const f32x4*)(ngain + col), sh = *(const f32x4*)(nm + col), sc = *(const f32x4*)(nm + 1024 + col); f32x4 xo; float y[4];
#pragma unroll
                for (int j = 0; j < 4; ++j) { xo[j] = xn[q * 4 + j]; y[j] = xn[q * 4 + j] * rstd * gn[j] * (1.0f + sc[j]) + sh[j]; }
                *(f32x4*)(xr + col) = xo; u32x2_t wv; wv.x = cvtpk(y[0], y[1]); wv.y = cvtpk(y[2], y[3]); *(u32x2_t*)(Hn + (size_t)t * 1024 + col) = wv; }
        }
    }
}
template <int CTRL> DI float dpp_f(float x) { return __int_as_float(__builtin_amdgcn_update_dpp(0, __float_as_int(x), CTRL, 0xF, 0xF, false)); }
DI float x32(float x) { auto r = __builtin_amdgcn_permlane32_swap(__float_as_uint(x), __float_as_uint(x), false, false); return (threadIdx.x & 32) ? __uint_as_float(r[0]) : __uint_as_float(r[1]); }
DI float x16(float x) { auto r = __builtin_amdgcn_permlane16_swap(__float_as_uint(x), __float_as_uint(x), false, false); return (threadIdx.x & 16) ? __uint_as_float(r[0]) : __uint_as_float(r[1]); }
typedef _Float16 h2_t __attribute__((ext_vector_type(2)));
DI unsigned f2hu(float lo, float hi) { const f32x2_t v = {lo, hi}; const h2_t h = __builtin_convertvector(v, h2_t); return __builtin_bit_cast(unsigned, h); }
DI unsigned bf2hu(unsigned w) { const f32x2_t v = {bflo(w), bfhi(w)}; const h2_t h = __builtin_convertvector(v, h2_t); return __builtin_bit_cast(unsigned, h); }
DI h2_t bf2h(unsigned w) { return (h2_t){(_Float16)bflo(w), (_Float16)bfhi(w)}; }
template <bool FAKE> DI void up8h(const u32x4 u, h2_t (&f)[8]) {
    if (FAKE) { f[0] = __builtin_bit_cast(h2_t, u.x & 0x3bff3bffu); f[1] = __builtin_bit_cast(h2_t, u.y & 0x3bff3bffu); f[2] = __builtin_bit_cast(h2_t, u.z & 0x3bff3bffu); f[3] = __builtin_bit_cast(h2_t, u.w & 0x3bff3bffu);
        f[4] = __builtin_bit_cast(h2_t, (u.x >> 1) & 0x3bff3bffu); f[5] = __builtin_bit_cast(h2_t, (u.y >> 1) & 0x3bff3bffu); f[6] = __builtin_bit_cast(h2_t, (u.z >> 1) & 0x3bff3bffu); f[7] = __builtin_bit_cast(h2_t, (u.w >> 1) & 0x3bff3bffu); return; }
    f[0] = __builtin_amdgcn_cvt_scalef32_pk_f16_fp8((int)u.x, 1.0f, false); f[1] = __builtin_amdgcn_cvt_scalef32_pk_f16_fp8((int)u.x, 1.0f, true);
    f[2] = __builtin_amdgcn_cvt_scalef32_pk_f16_fp8((int)u.y, 1.0f, false); f[3] = __builtin_amdgcn_cvt_scalef32_pk_f16_fp8((int)u.y, 1.0f, true);
    f[4] = __builtin_amdgcn_cvt_scalef32_pk_f16_fp8((int)u.z, 1.0f, false); f[5] = __builtin_amdgcn_cvt_scalef32_pk_f16_fp8((int)u.z, 1.0f, true);
    f[6] = __builtin_amdgcn_cvt_scalef32_pk_f16_fp8((int)u.w, 1.0f, false); f[7] = __builtin_amdgcn_cvt_scalef32_pk_f16_fp8((int)u.w, 1.0f, true); }
template <bool FAKE> DI float dot16h(const u32x4 u, const h2_t (&hh)[8]) { h2_t f[8]; up8h<FAKE>(u, f); float d0 = 0.f, d1 = 0.f;
#pragma unroll
    for (int q = 0; q < 8; q += 2) { d0 = __builtin_amdgcn_fdot2(f[q], hh[q], d0, false); d1 = __builtin_amdgcn_fdot2(f[q + 1], hh[q + 1], d1, false); }
    return d0 + d1; }
template <bool FINAL, bool FAKE = false, int SKIP = 0> DI void peer_gather_rounds(const Ctx& C, const bf16* Hin, const int* IDX, const float* GATE, const unsigned char* PU8, const unsigned char* PV8, const float* ISU, const float* ISV,
                                                 const bf16* Xin, bf16* Xout, float* Fout, const float* g2, const float* ngain, const float* nmod, bf16* Hn) {
    const int lane = C.lane, w = C.wave;
    LAS u32x2_t* LIST = (LAS u32x2_t*)(C.lds + w * 14592);
    LAS unsigned char* HL = C.lds + w * 14592 + 4096;
    LAS unsigned* ALU = (LAS unsigned*)(C.lds + w * 14592 + 12288);
    LAS int* OFFS = (LAS int*)(C.lds + w * 14592 + 14336);
    LAS float* IHS = (LAS float*)(C.lds + w * 14592 + 14336 + 160);
    const unsigned long long ltmask = (1ull << lane) - 1ull;
    for (int grp = C.vcu; grp < TT / 32; grp += C.G) {
        const int t0 = grp * 32 + w * 4;
        {
            int ee[8]; float gg[8]; unsigned su[8]; float sv[8];
#pragma unroll
            for (int r = 0; r < 8; ++r) { const size_t a = (size_t)(t0 + (r >> 1)) * 128 + 64 * (r & 1) + lane; ee[r] = IDX[a]; gg[r] = GATE[a]; }
#pragma unroll
            for (int r = 0; r < 8; ++r) { su[r] = __float_as_uint(ISU[ee[r]]) >> 23; sv[r] = ISV[ee[r]]; }
            int pos[8]; int base = 0;
#pragma unroll 1
            for (int b = 0; b < 8; ++b) {
#pragma unroll
                for (int r = 0; r < 8; ++r) { if ((r & 1) == 0 && lane == 0) OFFS[b * 4 + (r >> 1)] = base;
                    const bool mine = (ee[r] >> 11) == b; const unsigned long long m = __ballot(mine); if (mine) pos[r] = base + __popcll(m & ltmask); base += __popcll(m); }
            }
            if (lane == 0) OFFS[32] = 512;
#pragma unroll
            for (int r = 0; r < 8; ++r) { u32x2_t en; en.x = (unsigned)ee[r] | ((unsigned)(r >> 1) << 14) | (su[r] << 16); en.y = __float_as_uint(gg[r] * sv[r]); LIST[pos[r]] = en; }
#pragma unroll
            for (int tk = 0; tk < 4; ++tk) { const u32x4 a = *(const u32x4*)(Hin + (size_t)(t0 + tk) * 1024 + lane * 16), bq = *(const u32x4*)(Hin + (size_t)(t0 + tk) * 1024 + lane * 16 + 8);
                const float hv_[16] = {bflo(a.x), bfhi(a.x), bflo(a.y), bfhi(a.y), bflo(a.z), bfhi(a.z), bflo(a.w), bfhi(a.w), bflo(bq.x), bfhi(bq.x), bflo(bq.y), bfhi(bq.y), bflo(bq.z), bfhi(bq.z), bflo(bq.w), bfhi(bq.w)};
                float am = 0.f;
#pragma unroll
                for (int q = 0; q < 16; ++q) am = fmaxf(am, fabsf(hv_[q]));
                am = wave_max(am);
                const int e_ = (int)((__float_as_uint(am) >> 23) & 0xffu) - 127; const bool ok_ = am > 1e-30f;
                const float sc_ = ok_ ? __uint_as_float((unsigned)(127 + 6 - e_) << 23) : 1.0f, isc_ = ok_ ? __uint_as_float((unsigned)(127 - 6 + e_) << 23) : 1.0f;
                u32x4 o8;
#pragma unroll
                for (int q = 0; q < 4; ++q) { unsigned wd = 0u;
#pragma unroll
                    for (int j = 0; j < 4; ++j) { int qi = (int)rintf(hv_[4 * q + j] * sc_); qi = qi > 127 ? 127 : (qi < -127 ? -127 : qi); wd |= ((unsigned)qi & 0xffu) << (8 * j); }
                    o8[q] = wd; }
                *(LAS u32x4*)(HL + tk * 1024 + lane * 16) = o8; if (lane == 0) IHS[tk] = isc_; }
        }
        LDS_WAIT();
        {
            const int jL = ((lane >> 5) & 1) * 4 + ((lane >> 4) & 1) * 2 + ((lane >> 3) & 1);
#define G1_LOAD(UB, TK, G0) do { const unsigned exl_ = LIST[(G0) + (lane & 7)].x; \
            _Pragma("unroll") for (int j = 0; j < 8; ++j) { const unsigned ex = (unsigned)__builtin_amdgcn_readlane((int)exl_, j); TK[j] = (int)((ex >> 14) & 3u); \
                UB[j] = *(const u32x4*)(PU8 + (size_t)(ex & (FAKE ? 0x7fu : 0x3fffu)) * 1024 + lane * 16); } } while (0)
#define G1_RUN(UB, TK, G0) do { int p[8]; \
            _Pragma("unroll") for (int j = 0; j < 8; ++j) { const u32x4 hq = *(const LAS u32x4*)(HL + TK[j] * 1024 + lane * 16); \
                int d_ = __builtin_amdgcn_sdot4((int)UB[j].x, (int)hq.x, 0, false); d_ = __builtin_amdgcn_sdot4((int)UB[j].y, (int)hq.y, d_, false); \
                d_ = __builtin_amdgcn_sdot4((int)UB[j].z, (int)hq.z, d_, false); p[j] = __builtin_amdgcn_sdot4((int)UB[j].w, (int)hq.w, d_, false); } \
            const bool h32 = lane & 32, h16 = lane & 16, h8 = lane & 8; int q4[4]; \
            _Pragma("unroll") for (int j = 0; j < 4; ++j) { const int keep = h32 ? p[j + 4] : p[j], send = h32 ? p[j] : p[j + 4]; q4[j] = keep + __float_as_int(x32(__int_as_float(send))); } \
            int q2[2]; \
            _Pragma("unroll") for (int j = 0; j < 2; ++j) { const int keep = h16 ? q4[j + 2] : q4[j], send = h16 ? q4[j] : q4[j + 2]; q2[j] = keep + __float_as_int(x16(__int_as_float(send))); } \
            int q1; { const int keep = h8 ? q2[1] : q2[0], send = h8 ? q2[0] : q2[1]; q1 = keep + __float_as_int(dpp_f<0x128>(__int_as_float(send))); } \
            q1 += __float_as_int(dpp_f<0x141>(__int_as_float(q1))); q1 += __float_as_int(dpp_f<0xB1>(__int_as_float(q1))); q1 += __float_as_int(dpp_f<0x4E>(__int_as_float(q1))); \
            if ((lane & 7) == 0) { const u32x2_t me = LIST[(G0) + jL]; const float av_ = gelu_t((float)q1 * IHS[(me.x >> 14) & 3u] * __uint_as_float((me.x >> 16) << 23)) * __uint_as_float(me.y); ALU[(G0) + jL] = f2hu(av_, av_); } } while (0)
            u32x4 ubA[8], ubB[8]; int tkA[8], tkB[8];
            G1_LOAD(ubA, tkA, 0);
#pragma unroll 1
            for (int g0 = 0; g0 < ((SKIP & 1) ? 0 : 512); g0 += 16) {
                G1_LOAD(ubB, tkB, g0 + 8);
                G1_RUN(ubA, tkA, g0);
                if (g0 + 16 < 512) G1_LOAD(ubA, tkA, g0 + 16);
                G1_RUN(ubB, tkB, g0 + 8);
            }
#undef G1_LOAD
#undef G1_RUN
        }
        LDS_WAIT();
        h2_t o[4][8], oc[8];
#pragma unroll
        for (int q = 0; q < 8; ++q) { oc[q] = (h2_t){(_Float16)0.f, (_Float16)0.f};
#pragma unroll
            for (int tk = 0; tk < 4; ++tk) o[tk][q] = (h2_t){(_Float16)0.f, (_Float16)0.f}; }
        {
            int curA = 0;
#define G2_FLUSH() do { if (curA == 0) { _Pragma("unroll") for (int q_ = 0; q_ < 8; ++q_) o[0][q_] += oc[q_]; } else if (curA == 1) { _Pragma("unroll") for (int q_ = 0; q_ < 8; ++q_) o[1][q_] += oc[q_]; } \
            else if (curA == 2) { _Pragma("unroll") for (int q_ = 0; q_ < 8; ++q_) o[2][q_] += oc[q_]; } else { _Pragma("unroll") for (int q_ = 0; q_ < 8; ++q_) o[3][q_] += oc[q_]; } \
            _Pragma("unroll") for (int q_ = 0; q_ < 8; ++q_) oc[q_] = (h2_t){(_Float16)0.f, (_Float16)0.f}; } while (0)
#define G2_LOAD(VB, AJ, TK, G0) do { const unsigned exl_ = LIST[(G0) + (lane & 7)].x; const unsigned all_ = ALU[(G0) + (lane & 7)]; \
            _Pragma("unroll") for (int j = 0; j < 8; ++j) { const unsigned ex = (unsigned)__builtin_amdgcn_readlane((int)exl_, j); TK[j] = (int)((ex >> 14) & 3u); AJ[j] = __builtin_bit_cast(h2_t, (unsigned)__builtin_amdgcn_readlane((int)all_, j)); \
                VB[j] = *(const u32x4*)(PV8 + (size_t)(ex & (FAKE ? 0x7fu : 0x3fffu)) * 1024 + lane * 16); } } while (0)
#define G2_ACC(VB, AJ, TK) do { _Pragma("unroll") for (int j = 0; j < 8; ++j) { if (TK[j] != curA) { G2_FLUSH(); curA = TK[j]; } h2_t f_[8]; up8h<FAKE>(VB[j], f_); _Pragma("unroll") for (int q = 0; q < 8; ++q) oc[q] = f_[q] * AJ[j] + oc[q]; } } while (0)
            u32x4 vbA[8], vbB[8]; h2_t ajA[8], ajB[8]; int tA[8], tB[8];
            G2_LOAD(vbA, ajA, tA, 0);
#pragma unroll 1
            for (int g0 = 0; g0 < ((SKIP & 2) ? 0 : 512); g0 += 16) {
                G2_LOAD(vbB, ajB, tB, g0 + 8);
                G2_ACC(vbA, ajA, tA);
                if (g0 + 16 < 512) G2_LOAD(vbA, ajA, tA, g0 + 16);
                G2_ACC(vbB, ajB, tB);
            }
            G2_FLUSH();
#undef G2_FLUSH
#undef G2_LOAD
#undef G2_ACC
        }
#pragma unroll
        for (int tk = 0; tk < 4; ++tk) {
            __builtin_amdgcn_sched_barrier(0);
            const int t = t0 + tk; const int b = t >> 13; const float* gp = g2 + (size_t)b * 6144;
            const u32x4 xa = *(const u32x4*)(Xin + (size_t)t * 1024 + lane * 16), xb = *(const u32x4*)(Xin + (size_t)t * 1024 + lane * 16 + 8);
            const unsigned xw[8] = {xa.x, xa.y, xa.z, xa.w, xb.x, xb.y, xb.z, xb.w};
            float xn[16]; float ss = 0.f;
#pragma unroll
            for (int q = 0; q < 4; ++q) { const int col = lane * 16 + q * 4; const f32x4 gv = *(const f32x4*)(gp + col);
#pragma unroll
                for (int j = 0; j < 4; ++j) { const unsigned w_ = xw[q * 2 + (j >> 1)]; const float xv = (j & 1) ? __uint_as_float(w_ & 0xffff0000u) : __uint_as_float(w_ << 16);
                    const float y = xv + gv[j] * (float)o[tk][q * 2 + (j >> 1)][j & 1]; xn[q * 4 + j] = y; ss += y * y; } }
            const float rstd = 1.0f / sqrtf(wave_sum(ss) * (1.0f / 1024.0f) + EPS);
            if (FINAL) {
#pragma unroll
                for (int q = 0; q < 4; ++q) { const int col = lane * 16 + q * 4; const f32x4 gn = *(const f32x4*)(ngain + col); f32x4 y;
#pragma unroll
                    for (int j = 0; j < 4; ++j) y[j] = xn[q * 4 + j] * rstd * gn[j];
                    *(f32x4*)(Fout + (size_t)t * 1024 + col) = y; }
            } else {
                const float* nm = nmod + (size_t)b * 6144;
                u32x4 xo[2];
#pragma unroll
                for (int q = 0; q < 4; ++q) { const int col = lane * 16 + q * 4; const f32x4 gn = *(const f32x4*)(ngain + col), sh = *(const f32x4*)(nm + col), sc = *(const f32x4*)(nm + 1024 + col); float y[4];
#pragma unroll
                    for (int j = 0; j < 4; ++j) y[j] = xn[q * 4 + j] * rstd * gn[j] * (1.0f + sc[j]) + sh[j];
                    xo[q >> 1][2 * (q & 1)] = cvtpk(xn[q * 4], xn[q * 4 + 1]); xo[q >> 1][2 * (q & 1) + 1] = cvtpk(xn[q * 4 + 2], xn[q * 4 + 3]);
                    u32x2_t wv; wv.x = cvtpk(y[0], y[1]); wv.y = cvtpk(y[2], y[3]); *(u32x2_t*)(Hn + (size_t)t * 1024 + col) = wv; }
                *(u32x4*)(Xout + (size_t)t * 1024 + lane * 16) = xo[0]; *(u32x4*)(Xout + (size_t)t * 1024 + lane * 16 + 8) = xo[1];
            }
        }
        LDS_WAIT();
    }
}
constexpr int GR_R = 12;
DI void glds_row(const unsigned char* gsrc_lane, unsigned lds_dst) { unsigned keep;
    asm volatile("s_mov_b32 %0, m0\n\ts_mov_b32 m0, %2\n\ts_nop 0\n\tglobal_load_lds_dwordx4 %1, off\n\ts_mov_b32 m0, %0" : "=&s"(keep) : "v"(gsrc_lane), "s"(lds_dst) : "memory"); }
template <bool FINAL> DI void peer_gather_dma(const Ctx& C, const bf16* Hin, const int* IDX, const float* GATE, const unsigned char* PU8, const unsigned char* PV8, const float* ISU, const float* ISV,
                                              float* X, const float* g2, const float* ngain, const float* nmod, bf16* Hn) {
    const int lane = C.lane, w = C.wave;
    constexpr int WB = 4096 + 2048 + 256 + GR_R * 1024;
    LAS u32x2_t* LIST = (LAS u32x2_t*)(C.lds + w * WB);
    LAS float* AL = (LAS float*)(C.lds + w * WB + 4096);
    LAS int* OFFS = (LAS int*)(C.lds + w * WB + 6144);
    LAS unsigned char* RING = C.lds + w * WB + 6400;
    const unsigned ring0 = (unsigned)__builtin_amdgcn_readfirstlane((int)(unsigned)(size_t)RING);
    const unsigned long long ltmask = (1ull << lane) - 1ull;
#define GR_REFILL(nv_) do { unsigned ex8_[8]; _Pragma("unroll") for (int j_ = 0; j_ < 8; ++j_) ex8_[j_] = (j_ < (nv_) && nf + j_ < 1024) ? LIST[(nf + j_) & 511].x : 0u; \
        _Pragma("unroll") for (int j_ = 0; j_ < 8; ++j_) if (j_ < (nv_) && nf + j_ < 1024) { const int f_ = nf + j_; const unsigned e_ = (unsigned)__builtin_amdgcn_readfirstlane((int)ex8_[j_]) & 0x3fffu; \
            const unsigned char* tb_ = (f_ < 512) ? PU8 : PV8; glds_row(tb_ + (size_t)e_ * 1024 + lane * 16, ring0 + (unsigned)(f_ % GR_R) * 1024u); } \
        nf += (nv_); if (nf > 1024) nf = 1024; } while (0)
#define GR_ISSUE(f) do { const int f_ = (f); const unsigned ex_ = (unsigned)__builtin_amdgcn_readfirstlane((int)LIST[f_ & 511].x); \
        const unsigned char* tb_ = (f_ < 512) ? PU8 : PV8; glds_row(tb_ + (size_t)(ex_ & 0x3fffu) * 1024 + lane * 16, ring0 + (unsigned)(f_ % GR_R) * 1024u); } while (0)
    for (int grp = C.vcu; grp < TT / 32; grp += C.G) {
        const int t0 = grp * 32 + w * 4;
        float hv4[4][16];
        {
            int ee[8]; float gg[8]; unsigned su[8]; float sv[8];
#pragma unroll
            for (int r = 0; r < 8; ++r) { const size_t a = (size_t)(t0 + (r >> 1)) * 128 + 64 * (r & 1) + lane; ee[r] = IDX[a]; gg[r] = GATE[a]; }
#pragma unroll
            for (int r = 0; r < 8; ++r) { su[r] = __float_as_uint(ISU[ee[r]]) >> 23; sv[r] = ISV[ee[r]]; }
            int pos[8]; int base = 0;
#pragma unroll 1
            for (int b = 0; b < 8; ++b) {
#pragma unroll
                for (int r = 0; r < 8; ++r) { if ((r & 1) == 0 && lane == 0) OFFS[b * 4 + (r >> 1)] = base;
                    const bool mine = (ee[r] >> 11) == b; const unsigned long long m = __ballot(mine); if (mine) pos[r] = base + __popcll(m & ltmask); base += __popcll(m); }
            }
            if (lane == 0) OFFS[32] = 512;
#pragma unroll
            for (int r = 0; r < 8; ++r) { u32x2_t en; en.x = (unsigned)ee[r] | ((unsigned)(r >> 1) << 14) | (su[r] << 16); en.y = __float_as_uint(gg[r] * sv[r]); LIST[pos[r]] = en; }
#pragma unroll
            for (int tk = 0; tk < 4; ++tk) { const u32x4 a = *(const u32x4*)(Hin + (size_t)(t0 + tk) * 1024 + lane * 16), bq = *(const u32x4*)(Hin + (size_t)(t0 + tk) * 1024 + lane * 16 + 8);
                hv4[tk][0] = bflo(a.x); hv4[tk][1] = bfhi(a.x); hv4[tk][2] = bflo(a.y); hv4[tk][3] = bfhi(a.y); hv4[tk][4] = bflo(a.z); hv4[tk][5] = bfhi(a.z); hv4[tk][6] = bflo(a.w); hv4[tk][7] = bfhi(a.w);
                hv4[tk][8] = bflo(bq.x); hv4[tk][9] = bfhi(bq.x); hv4[tk][10] = bflo(bq.y); hv4[tk][11] = bfhi(bq.y); hv4[tk][12] = bflo(bq.z); hv4[tk][13] = bfhi(bq.z); hv4[tk][14] = bflo(bq.w); hv4[tk][15] = bfhi(bq.w); }
        }
        asm volatile("s_waitcnt vmcnt(0) lgkmcnt(0)" ::: "memory");
        int nf = GR_R;
#pragma unroll 1
        for (int f = 0; f < GR_R; ++f) GR_ISSUE(f);
        {
            const int jL = ((lane >> 5) & 1) * 4 + ((lane >> 4) & 1) * 2 + ((lane >> 3) & 1);
#pragma unroll 1
            for (int r = 0; r < 8; ++r) {
#pragma unroll
                for (int tk = 0; tk < 4; ++tk) {
                    const int beg = __builtin_amdgcn_readfirstlane(OFFS[r * 4 + tk]), end = __builtin_amdgcn_readfirstlane(OFFS[r * 4 + tk + 1]);
#pragma unroll 1
                    for (int g0 = beg; g0 < end; g0 += 8) {
                        const int nv = (end - g0) < 8 ? (end - g0) : 8;
                        asm volatile("s_waitcnt vmcnt(4)" ::: "memory");
                        float p[8];
#pragma unroll
                        for (int j = 0; j < 8; ++j) { p[j] = 0.f;
                            if (j < nv) { const u32x4 row = *(const LAS u32x4*)(RING + ((g0 + j) % GR_R) * 1024 + lane * 16); p[j] = dot16(row, hv4[tk]); } }
                        asm volatile("s_waitcnt lgkmcnt(0)" ::: "memory");
                        GR_REFILL(nv);
                        const bool h32 = lane & 32, h16 = lane & 16, h8 = lane & 8;
                        float q4[4];
#pragma unroll
                        for (int j = 0; j < 4; ++j) { const float keep = h32 ? p[j + 4] : p[j], send = h32 ? p[j] : p[j + 4]; q4[j] = keep + __shfl_xor(send, 32); }
                        float q2[2];
#pragma unroll
                        for (int j = 0; j < 2; ++j) { const float keep = h16 ? q4[j + 2] : q4[j], send = h16 ? q4[j] : q4[j + 2]; q2[j] = keep + __shfl_xor(send, 16); }
                        float q1; { const float keep = h8 ? q2[1] : q2[0], send = h8 ? q2[0] : q2[1]; q1 = keep + __shfl_xor(send, 8); }
                        q1 += __shfl_xor(q1, 4); q1 += __shfl_xor(q1, 2); q1 += __shfl_xor(q1, 1);
                        if ((lane & 7) == 0 && jL < nv) { const u32x2_t me = LIST[g0 + jL]; AL[g0 + jL] = gelu_t(q1 * __uint_as_float((me.x >> 16) << 23)) * __uint_as_float(me.y); }
                    }
                }
            }
        }
        float o[4][16];
#pragma unroll
        for (int tk = 0; tk < 4; ++tk)
#pragma unroll
            for (int q = 0; q < 16; ++q) o[tk][q] = 0.f;
#pragma unroll 1
        for (int r = 0; r < 8; ++r) {
#pragma unroll
            for (int tk = 0; tk < 4; ++tk) {
                const int beg = __builtin_amdgcn_readfirstlane(OFFS[r * 4 + tk]), end = __builtin_amdgcn_readfirstlane(OFFS[r * 4 + tk + 1]);
#pragma unroll 1
                for (int i0 = beg; i0 < end; i0 += 8) {
                    const int nv = (end - i0) < 8 ? (end - i0) : 8;
                    if (i0 <= 500) asm volatile("s_waitcnt vmcnt(4)" ::: "memory"); else asm volatile("s_waitcnt vmcnt(0)" ::: "memory");
                    float aq[8]; u32x4 rw[8];
#pragma unroll
                    for (int j = 0; j < 8; ++j) { aq[j] = (j < nv) ? AL[i0 + j] : 0.f; }
#pragma unroll
                    for (int j = 0; j < 8; ++j) if (j < nv) rw[j] = *(const LAS u32x4*)(RING + ((512 + i0 + j) % GR_R) * 1024 + lane * 16);
#pragma unroll
                    for (int j = 0; j < 8; ++j) if (j < nv) { const float aj = __int_as_float(__builtin_amdgcn_readfirstlane(__float_as_int(aq[j])));
                        float f_[16]; up8(rw[j].x, f_[0], f_[1], f_[2], f_[3]); up8(rw[j].y, f_[4], f_[5], f_[6], f_[7]); up8(rw[j].z, f_[8], f_[9], f_[10], f_[11]); up8(rw[j].w, f_[12], f_[13], f_[14], f_[15]);
#pragma unroll
                        for (int q = 0; q < 16; ++q) o[tk][q] += aj * f_[q]; }
                    asm volatile("s_waitcnt lgkmcnt(0)" ::: "memory");
                    GR_REFILL(nv);
                }
            }
        }
        asm volatile("s_waitcnt vmcnt(0)" ::: "memory");
#pragma unroll
        for (int tk = 0; tk < 4; ++tk) {
            const int t = t0 + tk; const int b = t >> 13; const float* gp = g2 + (size_t)b * 6144; float* xr = X + (size_t)t * 1024;
            float xn[16]; float ss = 0.f;
#pragma unroll
            for (int q = 0; q < 4; ++q) { const int col = lane * 16 + q * 4; const f32x4 xv = *(const f32x4*)(xr + col), gv = *(const f32x4*)(gp + col);
#pragma unroll
                for (int j = 0; j < 4; ++j) { const float y = xv[j] + gv[j] * o[tk][q * 4 + j]; xn[q * 4 + j] = y; ss += y * y; } }
            const float rstd = 1.0f / sqrtf(wave_sum(ss) * (1.0f / 1024.0f) + EPS);
            if (FINAL) {
#pragma unroll
                for (int q = 0; q < 4; ++q) { const int col = lane * 16 + q * 4; const f32x4 gn = *(const f32x4*)(ngain + col); f32x4 y;
#pragma unroll
                    for (int j = 0; j < 4; ++j) y[j] = xn[q * 4 + j] * rstd * gn[j];
                    *(f32x4*)(xr + col) = y; }
            } else {
                const float* nm = nmod + (size_t)b * 6144;
#pragma unroll
                for (int q = 0; q < 4; ++q) { const int col = lane * 16 + q * 4; const f32x4 gn = *(const f32x4*)(ngain + col), sh = *(const f32x4*)(nm + col), sc = *(const f32x4*)(nm + 1024 + col); f32x4 xo; float y[4];
#pragma unroll
                    for (int j = 0; j < 4; ++j) { xo[j] = xn[q * 4 + j]; y[j] = xn[q * 4 + j] * rstd * gn[j] * (1.0f + sc[j]) + sh[j]; }
                    *(f32x4*)(xr + col) = xo; u32x2_t wv; wv.x = cvtpk(y[0], y[1]); wv.y = cvtpk(y[2], y[3]); *(u32x2_t*)(Hn + (size_t)t * 1024 + col) = wv; }
            }
        }
        asm volatile("s_waitcnt vmcnt(0) lgkmcnt(0)" ::: "memory");
    }
#undef GR_ISSUE
#undef GR_REFILL
}
DI float red4_sum(float x) { auto a = __builtin_amdgcn_permlane16_swap(__float_as_uint(x), __float_as_uint(x), false, false); x = __uint_as_float(a[0]) + __uint_as_float(a[1]);
    auto b = __builtin_amdgcn_permlane32_swap(__float_as_uint(x), __float_as_uint(x), false, false); return __uint_as_float(b[0]) + __uint_as_float(b[1]); }
DI float red4_max(float x) { auto a = __builtin_amdgcn_permlane16_swap(__float_as_uint(x), __float_as_uint(x), false, false); x = fmaxf(__uint_as_float(a[0]), __uint_as_float(a[1]));
    auto b = __builtin_amdgcn_permlane32_swap(__float_as_uint(x), __float_as_uint(x), false, false); return fmaxf(__uint_as_float(b[0]), __uint_as_float(b[1])); }
DI float red4_min(float x) { auto a = __builtin_amdgcn_permlane16_swap(__float_as_uint(x), __float_as_uint(x), false, false); x = fminf(__uint_as_float(a[0]), __uint_as_float(a[1]));
    auto b = __builtin_amdgcn_permlane32_swap(__float_as_uint(x), __float_as_uint(x), false, false); return fminf(__uint_as_float(b[0]), __uint_as_float(b[1])); }
constexpr int TK_NI = 6;
DI float tk_pivot(float clo, float chi) {
    const float lc = __builtin_amdgcn_logf(clo), lh = __builtin_amdgcn_logf(fmaxf(chi, 0.5f));
    const float f = (lc - 4.0443941f) * __builtin_amdgcn_rcpf(lc - lh);
    return fminf(fmaxf(f, 0.06f), 0.94f);
}
template <int NV> DI float tk_count(const float (&v)[NV], float mid) {
    const float nb = -mid * 1.099511627776e12f;
    float c[4] = {0.f, 0.f, 0.f, 0.f};
#pragma unroll
    for (int i = 0; i < NV; ++i) c[i & 3] += __builtin_amdgcn_fmed3f(__builtin_fmaf(v[i], 1.099511627776e12f, nb), 0.f, 1.f);
    return red4_sum((c[0] + c[1]) + (c[2] + c[3]));
}
constexpr int tk2_pair(int n) {
    int k = 0;
    for (int i = 0; i < 16; ++i) for (int j = 0; j < 16; ++j) if ((i + 1) * (j + 1) <= 16) { if (k == n) return i | (j << 8); ++k; }
    return n == 50 ? (15 | (15 << 8)) : (15 | (14 << 8));
}
#ifndef TK_STEP_N
#define TK_STEP_N 2
#endif
constexpr int TK_STEP = TK_STEP_N;
template <int NV> DI void tk_search(const float (&v)[NV], float ntot, float& thr_out) {
    float mx = v[0], mn = v[0];
#pragma unroll
    for (int i = 1; i < NV; ++i) { mx = fmaxf(mx, v[i]); mn = fminf(mn, v[i]); }
    mx = red4_max(mx); mn = red4_min(mn);
    float lo = mn, hi = mx, clo = ntot - 1.0f, chi = 0.0f; bool done = false;
#pragma unroll 1
    for (int iter = 0; iter < 48; ++iter) {
        const bool rdy = done || clo <= 16.0f + (float)TK_STEP;
        if (__all(rdy)) break;
        float fr_ = tk_pivot(clo, chi); if (iter >= TK_NI) fr_ = 0.5f;
        const float mid = rdy ? lo : lo + (hi - lo) * fr_;
        const float cnt = tk_count<NV>(v, mid);
        if (!rdy) { if (cnt == 16.0f) { lo = mid; clo = 16.0f; done = true; } else if (cnt > 16.0f) { lo = mid; clo = cnt; } else { hi = mid; chi = cnt; } }
    }
    const float sl = lo;
#pragma unroll 1
    for (int r = 0; r < TK_STEP; ++r) {
        const bool nd = clo > 16.0f;
        if (!__any(nd)) break;
        float y = 3.0e38f;
#pragma unroll
        for (int i = 0; i < NV; ++i) y = fminf(y, v[i] > lo ? v[i] : 3.0e38f);
        y = red4_min(y);
        if (nd) { lo = y; clo -= 1.0f; }
    }
    if (__any(!done)) { const float c = tk_count<NV>(v, lo); if (c != 16.0f) lo = sl; }
    thr_out = lo;
}
DI void tk_search2(const float (&v0)[32], const float (&v1)[32], float& t0, float& t1) {
    float mx0 = v0[0], mn0 = v0[0], mx1 = v1[0], mn1 = v1[0], s0 = v0[0], s1 = v1[0], q0 = v0[0] * v0[0], q1 = v1[0] * v1[0];
#pragma unroll
    for (int i = 1; i < 32; ++i) { mx0 = fmaxf(mx0, v0[i]); mn0 = fminf(mn0, v0[i]); mx1 = fmaxf(mx1, v1[i]); mn1 = fminf(mn1, v1[i]);
        s0 += v0[i]; s1 += v1[i]; q0 = __builtin_fmaf(v0[i], v0[i], q0); q1 = __builtin_fmaf(v1[i], v1[i], q1); }
    mx0 = red4_max(mx0); mn0 = red4_min(mn0); mx1 = red4_max(mx1); mn1 = red4_min(mn1); s0 = red4_sum(s0); s1 = red4_sum(s1); q0 = red4_sum(q0); q1 = red4_sum(q1);
    const float me0 = s0 * (1.0f / 128.0f), me1 = s1 * (1.0f / 128.0f);
    const float g0 = fminf(fmaxf(me0 + 1.05f * sqrtf(fmaxf(q0 * (1.0f / 128.0f) - me0 * me0, 0.f)), mn0), mx0), g1 = fminf(fmaxf(me1 + 1.05f * sqrtf(fmaxf(q1 * (1.0f / 128.0f) - me1 * me1, 0.f)), mn1), mx1);
    float lo0 = mn0, hi0 = mx0, clo0 = 127.0f, chi0 = 0.0f; bool done0 = false;
    float lo1 = mn1, hi1 = mx1, clo1 = 127.0f, chi1 = 0.0f; bool done1 = false;
#pragma unroll 1
    for (int iter = 0; iter < 48; ++iter) {
        const bool r0 = done0 || clo0 <= 16.0f + (float)TK_STEP, r1 = done1 || clo1 <= 16.0f + (float)TK_STEP;
        if (__all(r0 && r1)) break;
        float f0 = tk_pivot(clo0, chi0), f1 = tk_pivot(clo1, chi1); if (iter >= TK_NI) { f0 = 0.5f; f1 = 0.5f; }
        float mid0 = lo0 + (hi0 - lo0) * f0, mid1 = lo1 + (hi1 - lo1) * f1; if (iter == 0) { mid0 = g0; mid1 = g1; }
        if (r0) mid0 = lo0; if (r1) mid1 = lo1;
        const float c0 = tk_count<32>(v0, mid0), c1 = tk_count<32>(v1, mid1);
        if (!r0) { if (c0 == 16.0f) { lo0 = mid0; clo0 = 16.0f; done0 = true; } else if (c0 > 16.0f) { lo0 = mid0; clo0 = c0; } else { hi0 = mid0; chi0 = c0; } }
        if (!r1) { if (c1 == 16.0f) { lo1 = mid1; clo1 = 16.0f; done1 = true; } else if (c1 > 16.0f) { lo1 = mid1; clo1 = c1; } else { hi1 = mid1; chi1 = c1; } }
    }
    const float sl0 = lo0, sl1 = lo1;
#pragma unroll 1
    for (int r = 0; r < TK_STEP; ++r) {
        const bool n0 = clo0 > 16.0f, n1 = clo1 > 16.0f;
        if (!__any(n0 || n1)) break;
        float y0 = 3.0e38f, y1 = 3.0e38f;
#pragma unroll
        for (int i = 0; i < 32; ++i) { y0 = fminf(y0, v0[i] > lo0 ? v0[i] : 3.0e38f); y1 = fminf(y1, v1[i] > lo1 ? v1[i] : 3.0e38f); }
        y0 = red4_min(y0); y1 = red4_min(y1);
        if (n0) { lo0 = y0; clo0 -= 1.0f; }
        if (n1) { lo1 = y1; clo1 -= 1.0f; }
    }
    if (__any(!done0 || !done1)) {
        const float c0 = tk_count<32>(v0, lo0), c1 = tk_count<32>(v1, lo1);
        if (c0 != 16.0f) lo0 = sl0; if (c1 != 16.0f) lo1 = sl1;
    }
    t0 = lo0; t1 = lo1;
}
template <int N> struct tk2_pair_c { static constexpr int value = tk2_pair(N); };
template <int MODE = 0> DI void peer_topk_fused(const Ctx& C, const bf16* QP, const bf16* KEYS, int* IDX, float* GATE) {
    constexpr int KPI = 288;
    const int lane = C.lane, fr = lane & 15, fq = lane >> 4, w = C.wave;
    LAS unsigned char* KS = C.lds;
    LAS unsigned char* WB = C.lds + 73728 + w * 7168;
    LAS float* LV = (LAS float*)(WB);
    LAS int* LK = (LAS int*)(WB + 2176);
    LAS float* FV = (LAS float*)(WB + 4352);
    LAS int* FI = (LAS int*)(WB + 5504);
    LAS float* TRASH = (LAS float*)(WB + 6656) + lane;
    const int h = C.vcu & 7, nb = C.G >> 3;
    { const bf16* kg = KEYS + (size_t)h * 2 * 128 * 128;
      for (int c = C.tid; c < 4096; c += 512) { const int r = c >> 4, cc = c & 15; *(LAS u32x4*)(KS + r * KPI + cc * 16) = *(const u32x4*)(kg + (size_t)r * 128 + cc * 8); } }
    __syncthreads();
    int cof[13];
#define TK2_COF(c) cof[c] = fq == 0 ? tk2_pair_c<4 * (c)>::value : fq == 1 ? tk2_pair_c<4 * (c) + 1>::value : fq == 2 ? tk2_pair_c<4 * (c) + 2>::value : tk2_pair_c<4 * (c) + 3>::value
    TK2_COF(0); TK2_COF(1); TK2_COF(2); TK2_COF(3); TK2_COF(4); TK2_COF(5); TK2_COF(6); TK2_COF(7); TK2_COF(8); TK2_COF(9); TK2_COF(10); TK2_COF(11); TK2_COF(12);
#undef TK2_COF
    for (int tt = (C.vcu >> 3) + nb * w; tt < 1024; tt += nb * 8) {
        const int tok = tt * 16 + fr;
        float sc0[32], sc1[32];
#pragma unroll
        for (int p = 0; p < 2; ++p) {
            bf16x8 qf[4];
#pragma unroll
            for (int ks = 0; ks < 4; ++ks) qf[ks] = *(const bf16x8*)(QP + (size_t)tok * 2048 + h * 256 + p * 128 + ks * 32 + fq * 8);
#pragma unroll
            for (int kt = 0; kt < 8; ++kt) {
                f32x4 acc = {0.f, 0.f, 0.f, 0.f};
#pragma unroll
                for (int ks = 0; ks < 4; ++ks) { const bf16x8 kf = *(const LAS bf16x8*)(KS + (p * 128 + kt * 16 + fr) * KPI + (ks * 32 + fq * 8) * 2);
                    acc = __builtin_amdgcn_mfma_f32_16x16x32_bf16(kf, qf[ks], acc, 0, 0, 0); }
                if (p == 0) { sc0[kt * 4 + 0] = acc[0]; sc0[kt * 4 + 1] = acc[1]; sc0[kt * 4 + 2] = acc[2]; sc0[kt * 4 + 3] = acc[3]; }
                else { sc1[kt * 4 + 0] = acc[0]; sc1[kt * 4 + 1] = acc[1]; sc1[kt * 4 + 2] = acc[2]; sc1[kt * 4 + 3] = acc[3]; }
            }
        }
        float thrA = 1.0f, thrB = 1.0f; if (MODE == 0) tk_search2(sc0, sc1, thrA, thrB);
#pragma unroll
        for (int p = 0; p < 2; ++p) {
            const float thr = p == 0 ? thrA : thrB;
            int cnt = 0;
#pragma unroll
            for (int i = 0; i < 32; ++i) cnt += ((p == 0 ? sc0[i] : sc1[i]) > thr) ? 1 : 0;
            const int c0 = __shfl(cnt, fr), c1 = __shfl(cnt, fr + 16), c2 = __shfl(cnt, fr + 32);
            int pos = (fq > 0 ? c0 : 0) + (fq > 1 ? c1 : 0) + (fq > 2 ? c2 : 0);
#pragma unroll
            for (int i = 0; i < 32; ++i) { const float vv = p == 0 ? sc0[i] : sc1[i]; const bool s = vv > thr && pos < 16;
                LAS float* pv = s ? (LV + fr * 33 + p * 16 + pos) : TRASH; LAS int* pk = s ? (LK + fr * 33 + p * 16 + pos) : (LAS int*)TRASH;
                *pv = vv; *pk = (i >> 2) * 16 + 4 * fq + (i & 3); pos += (vv > thr) ? 1 : 0; }
        }
        LDS_WAIT();
        {
            const int lb = fr * 33 + (fq >> 1) * 16, e0 = 8 * (fq & 1);
            float L[16], ownv[8], own[8]; int okey[8], rk[8];
#pragma unroll
            for (int q = 0; q < 16; ++q) L[q] = __uint_as_float((__float_as_uint(LV[lb + q]) & ~15u) | (unsigned)q);
#pragma unroll
            for (int i = 0; i < 8; ++i) { ownv[i] = LV[lb + e0 + i]; okey[i] = LK[lb + e0 + i]; own[i] = __uint_as_float((__float_as_uint(ownv[i]) & ~15u) | (unsigned)(e0 + i)); }
#pragma unroll
            for (int i = 0; i < 8; ++i) { int r = 0;
#pragma unroll
                for (int q = 0; q < 16; ++q) r += (L[q] > own[i]) ? 1 : 0;
                rk[i] = r; }
#pragma unroll
            for (int i = 0; i < 8; ++i) { LV[lb + rk[i]] = ownv[i]; LK[lb + rk[i]] = okey[i]; }
        }
        LDS_WAIT();
        float sm[13]; int ca[13], cb[13];
#pragma unroll
        for (int c = 0; c < 13; ++c) { ca[c] = fr * 33 + (cof[c] & 255); cb[c] = fr * 33 + 16 + (cof[c] >> 8); sm[c] = LV[ca[c]] + LV[cb[c]]; }
        float thr2 = 4.0f; if (MODE == 0) tk_search<13>(sm, 52.0f, thr2);
        {
            int cnt = 0;
#pragma unroll
            for (int i = 0; i < 13; ++i) cnt += (sm[i] > thr2) ? 1 : 0;
            const int c0 = __shfl(cnt, fr), c1 = __shfl(cnt, fr + 16), c2 = __shfl(cnt, fr + 32);
            int pos = (fq > 0 ? c0 : 0) + (fq > 1 ? c1 : 0) + (fq > 2 ? c2 : 0);
#pragma unroll
            for (int i = 0; i < 13; ++i) { const bool s = sm[i] > thr2 && pos < 16;
                LAS float* pv = s ? (FV + fr * 17 + pos) : TRASH; LAS int* pk = s ? (FI + fr * 17 + pos) : (LAS int*)TRASH;
                *pv = sm[i]; *pk = LK[ca[i]] * 128 + LK[cb[i]]; pos += (sm[i] > thr2) ? 1 : 0; }
        }
        LDS_WAIT();
        float x[4]; int xi[4];
#pragma unroll
        for (int j = 0; j < 4; ++j) { x[j] = FV[fr * 17 + 4 * fq + j]; xi[j] = FI[fr * 17 + 4 * fq + j]; }
        float m = red4_max(fmaxf(fmaxf(x[0], x[1]), fmaxf(x[2], x[3])));
        float e[4]; float s = 0.f;
#pragma unroll
        for (int j = 0; j < 4; ++j) { e[j] = __expf(x[j] - m); s += e[j]; }
        s = red4_sum(s);
        const float inv = 1.0f / s;
        const size_t ob = ((size_t)tok * 8 + h) * 16 + 4 * fq;
        typedef int i32x4 __attribute__((ext_vector_type(4)));
        *(i32x4*)(IDX + ob) = (i32x4){xi[0], xi[1], xi[2], xi[3]}; *(f32x4*)(GATE + ob) = (f32x4){e[0] * inv, e[1] * inv, e[2] * inv, e[3] * inv};
        LDS_WAIT();
    }
}
DI void intra_mfma(const Ctx& C, const bf16* Q, const bf16* K, const bf16* V, const bf16* CROSS, bf16* G) {
    constexpr int RPI = 544, PPI = 144, VPI = 544;
    LAS unsigned char* Qs = C.lds; LAS unsigned char* Ks = Qs + 64 * RPI; LAS unsigned char* Ps = Ks + 64 * RPI; LAS unsigned char* Vs = Ps + 64 * PPI;
    LAS float* red = (LAS float*)(Vs + 64 * VPI);
    const int tid = C.tid, lane = C.lane, w = C.wave, fr = lane & 15, fq = lane >> 4;
    for (int item = C.vcu; item < 1024; item += C.G) {
        const int b = item >> 9, h = (item >> 7) & 3, n = item & 127;
        const float lg2 = log2f(1.0f - exp2f(-5.0f - (float)h));
        const size_t tok0 = (size_t)b * SEQ + (size_t)n * 64;
#pragma unroll
        for (int u = 0; u < 4; ++u) { const int c = tid + 512 * u, r = c >> 5, cc = c & 31;
            *(LAS u32x4*)(Qs + r * RPI + cc * 16) = *(const u32x4*)(Q + (tok0 + r) * 1024 + h * 256 + cc * 8);
            *(LAS u32x4*)(Ks + r * RPI + cc * 16) = *(const u32x4*)(K + (tok0 + r) * 1024 + h * 256 + cc * 8);
            *(LAS u32x4*)(Vs + r * VPI + cc * 16) = *(const u32x4*)(V + (tok0 + r) * 2048 + h * 512 + cc * 8); }
        __syncthreads();
        { const int jt = w >> 1; f32x4 sa[2] = {(f32x4){0.f, 0.f, 0.f, 0.f}, (f32x4){0.f, 0.f, 0.f, 0.f}};
#pragma unroll
          for (int ks = 0; ks < 8; ++ks) { const bf16x8 kf = *(const LAS bf16x8*)(Ks + (16 * jt + fr) * RPI + (32 * ks + 8 * fq) * 2);
#pragma unroll
              for (int q = 0; q < 2; ++q) { const int it = 2 * (w & 1) + q; const bf16x8 qf = *(const LAS bf16x8*)(Qs + (16 * it + fr) * RPI + (32 * ks + 8 * fq) * 2);
                  sa[q] = __builtin_amdgcn_mfma_f32_16x16x32_bf16(kf, qf, sa[q], 0, 0, 0); } }
#pragma unroll
          for (int q = 0; q < 2; ++q) { const int i = 16 * (2 * (w & 1) + q) + fr, j0 = 16 * jt + 4 * fq; float pv[4];
#pragma unroll
              for (int r = 0; r < 4; ++r) { const int dd = i > j0 + r ? i - j0 - r : j0 + r - i; pv[r] = sa[q][r] * exp2f(lg2 * (float)dd); }
              u32x2_t o; o.x = cvtpk(pv[0], pv[1]); o.y = cvtpk(pv[2], pv[3]); *(LAS u32x2_t*)(Ps + i * PPI + j0 * 2) = o; } }
        __syncthreads();
        f32x4 acc[2][2][4];
#pragma unroll
        for (int hf = 0; hf < 2; ++hf) {
#pragma unroll
            for (int et = 0; et < 2; ++et)
#pragma unroll
                for (int it = 0; it < 4; ++it) acc[hf][et][it] = (f32x4){0.f, 0.f, 0.f, 0.f};
            if (hf == 1) { __syncthreads();
#pragma unroll
                for (int u = 0; u < 4; ++u) { const int c = tid + 512 * u, r = c >> 5, cc = c & 31;
                    *(LAS u32x4*)(Vs + r * VPI + cc * 16) = *(const u32x4*)(V + (tok0 + r) * 2048 + h * 512 + 256 + cc * 8); }
                __syncthreads(); }
#pragma unroll
            for (int ks = 0; ks < 2; ++ks) {
                bf16x8 pf[4];
#pragma unroll
                for (int it = 0; it < 4; ++it) { const LAS unsigned char* pp = Ps + (16 * it + fr) * PPI + (32 * ks + 4 * fq) * 2;
                    const u32x2_t lo = *(const LAS u32x2_t*)pp, hi = *(const LAS u32x2_t*)(pp + 32); u32x4 ww; ww.x = lo.x; ww.y = lo.y; ww.z = hi.x; ww.w = hi.y; pf[it] = __builtin_bit_cast(bf16x8, ww); }
#pragma unroll
                for (int et = 0; et < 2; ++et) { const LAS unsigned char* vp = Vs + (32 * ks + 4 * fq + (fr >> 2)) * VPI + (32 * w + 16 * et + 4 * (fr & 3)) * 2;
                    const bf16x8 vf = cat8(trr(vp), trr(vp + 16 * VPI));
#pragma unroll
                    for (int it = 0; it < 4; ++it) acc[hf][et][it] = __builtin_amdgcn_mfma_f32_16x16x32_bf16(vf, pf[it], acc[hf][et][it], 0, 0, 0); }
            }
        }
        float ssq[4] = {0.f, 0.f, 0.f, 0.f};
#pragma unroll
        for (int hf = 0; hf < 2; ++hf)
#pragma unroll
            for (int et = 0; et < 2; ++et)
#pragma unroll
                for (int it = 0; it < 4; ++it) { const u32x2_t cv = *(const u32x2_t*)(CROSS + (tok0 + 16 * it + fr) * 2048 + h * 512 + hf * 256 + 32 * w + 16 * et + 4 * fq);
                    f32x4 y = acc[hf][et][it]; y[0] += bflo(cv.x); y[1] += bfhi(cv.x); y[2] += bflo(cv.y); y[3] += bfhi(cv.y); acc[hf][et][it] = y;
                    ssq[it] += (y[0] * y[0] + y[1] * y[1]) + (y[2] * y[2] + y[3] * y[3]); }
#pragma unroll
        for (int it = 0; it < 4; ++it) { float s = ssq[it]; s += __shfl_xor(s, 16); s += __shfl_xor(s, 32); if (fq == 0) red[w * 64 + 16 * it + fr] = s; }
        __syncthreads();
        float rs[4];
#pragma unroll
        for (int it = 0; it < 4; ++it) { float s = 0.f;
#pragma unroll
            for (int ww = 0; ww < 8; ++ww) s += red[ww * 64 + 16 * it + fr];
            rs[it] = 1.0f / sqrtf(s * (1.0f / 512.0f) + EPS); }
#pragma unroll
        for (int hf = 0; hf < 2; ++hf)
#pragma unroll
            for (int et = 0; et < 2; ++et)
#pragma unroll
                for (int it = 0; it < 4; ++it) { bf16* gp = G + (tok0 + 16 * it + fr) * 2048 + h * 512 + hf * 256 + 32 * w + 16 * et + 4 * fq; const u32x2_t gv = *(const u32x2_t*)gp;
                    const f32x4 y = acc[hf][et][it] * rs[it]; u32x2_t o; o.x = cvtpk(y[0] * bflo(gv.x), y[1] * bfhi(gv.x)); o.y = cvtpk(y[2] * bflo(gv.y), y[3] * bfhi(gv.y)); *(u32x2_t*)gp = o; }
        __syncthreads();
    }
}
#ifndef PHMASK
#define PHMASK 0xFFFFFFu
#endif
#define PH(k) ((PHMASK >> (k)) & 1u)
#ifdef USE_SGU_NAIVE
#define SGU_GATE_FN sgu_gate_naive
#else
#define SGU_GATE_FN sgu_gate_mfma
#endif
#ifdef USE_GATHER_TOKEN
#define GATHER_FN peer_gather8
#else
#ifdef USE_GATHER_ROUNDS
#define GATHER_FN peer_gather_rounds
#else
#define GATHER_FN peer_gather_dma
#endif
#endif
#ifndef DUP_GATHER_SKIP
#define DUP_GATHER_SKIP 0
#endif
#ifndef DUP_GATHER_FAKE
#define DUP_GATHER_FAKE false
#endif
struct Args { const void* in[21]; float* out; unsigned char* ws; };
__global__ void __launch_bounds__(NWAVES * 64, 2) mk_fwd(Args args) {
    extern __shared__ __attribute__((aligned(16))) unsigned char lds[];
    Ctx C; C.lds = (LAS unsigned char*)lds; C.tid = threadIdx.x; C.lane = C.tid & 63; C.wave = __builtin_amdgcn_readfirstlane(C.tid >> 6);
    C.G = gridDim.x; { const int bx = blockIdx.x; C.vcu = (C.G % 8 == 0) ? (bx % 8) * (C.G / 8) + bx / 8 : bx; }
    C.ws = args.ws;
    volatile LAS unsigned* MISC = (volatile LAS unsigned*)(C.lds + MISC_OFF);
    gu32* ctl = (gu32*)(args.ws + WS_CTL);
    for (int u = C.tid; u < (LDS_BYTES - LDSCTL_OFF) / 4; u += NWAVES * 64) ((LAS unsigned*)(C.lds + LDSCTL_OFF))[u] = 0u;
    __syncthreads();
    XcdBarrier bar = xcd_barrier_post((unsigned*)(ctl + CW_BAR), MISC + 8);
#define GRID_BAR() do { xcd_barrier(bar); asm volatile("" : "+v"(C.tid)); C.lane = C.tid & 63; C.wave = __builtin_amdgcn_readfirstlane(C.tid >> 6); } while (0)
    { LAS unsigned long long* PT = (LAS unsigned long long*)(C.lds + PTR_OFF);
      if (C.tid == 0) {
#pragma unroll
          for (int i = 0; i < 21; ++i) PT[i] = (unsigned long long)args.in[i];
      } }
    __syncthreads();
#define INP(T, i) ((const T*)ldp(C, i))
    float* out = args.out; unsigned char* ws = args.ws;
#define MODP ((float*)(ws + WS_MOD))
#define MOD0 ((const float*)(ws + WS_MOD))
#define MOD1 ((const float*)(ws + WS_MOD) + 2 * 6144)
#define cosT ((float*)(ws + WS_COS))
#define sinT ((float*)(ws + WS_SIN))
#define WRI ((bf16*)(ws + WS_WRI))
#define WRO ((bf16*)(ws + WS_WRO))
#define WSI ((bf16*)(ws + WS_WSI))
#define WSO ((bf16*)(ws + WS_WSO))
#define WQ ((bf16*)(ws + WS_WQ))
#define KEYS ((bf16*)(ws + WS_KEYS))
#define STATS ((float*)(ws + WS_STATS))
#define IDX ((int*)(ws + WS_IDX))
#define GATE ((float*)(ws + WS_GATE))
#define H ((bf16*)(ws + WS_H))
#define PU8 ((const unsigned char*)(ws + WS_PU))
#define PV8 ((const unsigned char*)(ws + WS_PV))
#define ISU ((const float*)(ws + WS_ISU))
#define ISV ((const float*)(ws + WS_ISV))
#define Qb ((bf16*)(ws + WS_Q))
#define Kb ((bf16*)(ws + WS_K))
#define Vb ((bf16*)(ws + WS_V))
#define Gb ((bf16*)(ws + WS_G))
#define CROSS ((bf16*)(ws + WS_CROSS))
#define QP ((bf16*)(ws + WS_QP))
#define SCO ((float*)(ws + WS_SC))
#define Ub ((bf16*)(ws + WS_U))
#define XB ((bf16*)(ws + WS_XB))
#define VBb ((bf16*)(ws + WS_VB))

    { P0In I; I.c = INP(float, 1); I.ada_w = INP(float, 5); I.ada_b = INP(float, 6); I.ret_w_in = INP(float, 7); I.ret_w_out = INP(float, 8); I.sgu_w_in = INP(float, 9); I.sgu_w_out = INP(float, 15); I.wq = INP(float, 16); I.keys = INP(float, 17); I.pu = INP(float, 18); I.pv = INP(float, 19); I.pos = INP(int, 2);
#ifdef DUP_P0
      p0_prologue(C, I);
      GRID_BAR();
#endif
      if (PH(0)) p0_prologue(C, I); }
    GRID_BAR();
    if (PH(1)) rms_mod_phase(C, INP(float, 0), INP(float, 3), MOD0, 0, 1024, H);
    GRID_BAR();
    { pg8::Gemm g{H, WRI, TT, 6144, 1024}; pg8::StaticOrder S; S.init(TT, 6144, C.G, (int)blockIdx.x);
      pg8::EpiRetProj E{Qb, Kb, Vb, Gb, (const unsigned*)(ws + WS_COS)};
#ifdef DUP_G1
      pg8::gemm_phase<pg8::EpiRetProj, pg8::StaticOrder, true, true>(C.lds + RING_OFF, g, S, E); GRID_BAR();
#endif
#ifdef DUP_G1B
      { pg8::EpiBf16<0> E2{(bf16*)(ws + WS_R), 6144, nullptr, 0, 0, 1.f}; pg8::gemm_phase<pg8::EpiBf16<0>, pg8::StaticOrder, true, true>(C.lds + RING_OFF, g, S, E2); GRID_BAR(); }
#endif
      if (PH(2)) pg8::gemm_phase<pg8::EpiRetProj, pg8::StaticOrder, true, true>(C.lds + RING_OFF, g, S, E); }
    GRID_BAR();
    #ifdef USE_SCAN_NAIVE
    if (PH(3)) scan_naive(C, Qb, Kb, Vb, CROSS);
#else
#ifdef DUP_SCAN
    scan_mfma<DUP_SCAN>(C, Qb, Kb, Vb, CROSS);
    GRID_BAR();
#endif
    if (C.vcu < SCAN_NIT) { if (PH(3)) scan_mfma<0>(C, Qb, Kb, Vb, CROSS); }
    else { P0In I; I.c = nullptr; I.ada_w = nullptr; I.ada_b = nullptr; I.ret_w_in = nullptr; I.ret_w_out = nullptr; I.sgu_w_in = INP(float, 9); I.sgu_w_out = INP(float, 15); I.wq = INP(float, 16); I.keys = nullptr; I.pu = INP(float, 18); I.pv = INP(float, 19); I.pos = nullptr;
      side_work(C, I, SCAN_NIT); }
#endif
    GRID_BAR();
#ifdef USE_INTRA_NAIVE
    if (PH(4)) intra_naive(C, Qb, Kb, Vb, CROSS, Gb);
#else
    if (PH(4)) intra_mfma(C, Qb, Kb, Vb, CROSS, Gb);
#endif
    GRID_BAR();
    { pg8::Gemm g{Gb, WRO, TT, 1024, 2048}; pg8::StaticOrder S; S.init(TT, 1024, C.G, (int)blockIdx.x);
      pg8::EpiResGateT<false> E{INP(float, 0), XB, MOD0 + 2048, 6144};
      if (PH(5)) pg8::gemm_phase<pg8::EpiResGateT<false>, pg8::StaticOrder, true, true>(C.lds + RING_OFF, g, S, E); }
    GRID_BAR();
    if (PH(6)) rms_mod_phase_b(C, XB, INP(float, 4), MOD0, 3072, 4096, H);
    GRID_BAR();
    { pg8::Gemm g{H, WQ, TT, 2048, 1024}; pg8::StaticOrder S; S.init(TT, 2048, C.G, (int)blockIdx.x);
      pg8::EpiBf16<0> E{QP, 2048, nullptr, 0, 0, 1.f};
      if (PH(7)) pg8::gemm_phase<pg8::EpiBf16<0>, pg8::StaticOrder, true, true>(C.lds + RING_OFF, g, S, E); }
    GRID_BAR();
#ifdef USE_TOPK_NAIVE
    if (PH(8)) peer_scores(C, QP, KEYS, SCO);
    GRID_BAR();
    if (PH(9)) peer_topk(C, SCO, IDX, GATE);
#else
#ifdef DUP_TOPK
    peer_topk_fused<DUP_TOPK>(C, QP, KEYS, IDX, GATE);
    GRID_BAR();
#endif
    if (PH(9)) peer_topk_fused<0>(C, QP, KEYS, IDX, GATE);
#endif
    GRID_BAR();
#ifdef DUP_GATHER
    GATHER_FN<false, DUP_GATHER_FAKE, DUP_GATHER_SKIP>(C, H, IDX, GATE, PU8, PV8, ISU, ISV, XB, (bf16*)(ws + WS_R), nullptr, MOD0 + 5120, INP(float, 3) + 1024, MOD1, (bf16*)(ws + WS_R + 128 * MiB));
    GRID_BAR();
#endif
    if (PH(10)) GATHER_FN<false>(C, H, IDX, GATE, PU8, PV8, ISU, ISV, XB, XB, nullptr, MOD0 + 5120, INP(float, 3) + 1024, MOD1, H);
    GRID_BAR();
#ifdef DUP_BAR
    for (int q_ = 0; q_ < 10; ++q_) GRID_BAR();
#endif
    { pg8::Gemm g{H, WSI, TT, 6144, 1024}; pg8::StaticOrder S; S.init(TT, 6144, C.G, (int)blockIdx.x);
      pg8::EpiSguIn E{Ub, VBb, INP(float, 10), STATS};
#ifdef DUP_G7
      pg8::gemm_phase<pg8::EpiSguIn, pg8::StaticOrder, true, true>(C.lds + RING_OFF, g, S, E); GRID_BAR();
#endif
      if (PH(11)) pg8::gemm_phase<pg8::EpiSguIn, pg8::StaticOrder, true, true>(C.lds + RING_OFF, g, S, E); }
    GRID_BAR();
    if (PH(12)) SGU_GATE_FN(C, Ub, VBb, STATS, INP(float, 13), INP(float, 14), INP(float, 11), INP(float, 12));
    GRID_BAR();
    { pg8::Gemm g{Ub, WSO, TT, 1024, 3072}; pg8::StaticOrder S; S.init(TT, 1024, C.G, (int)blockIdx.x);
      pg8::EpiResGateT<true> E{XB, XB, MOD1 + 2048, 6144};
      if (PH(13)) pg8::gemm_phase<pg8::EpiResGateT<true>, pg8::StaticOrder, true, true>(C.lds + RING_OFF, g, S, E); }
    GRID_BAR();
    if (PH(14)) rms_mod_phase_b(C, XB, INP(float, 4) + 1024, MOD1, 3072, 4096, H);
    GRID_BAR();
    { pg8::Gemm g{H, WQ + (size_t)2048 * 1024, TT, 2048, 1024}; pg8::StaticOrder S; S.init(TT, 2048, C.G, (int)blockIdx.x);
      pg8::EpiBf16<0> E{QP, 2048, nullptr, 0, 0, 1.f};
      if (PH(15)) pg8::gemm_phase<pg8::EpiBf16<0>, pg8::StaticOrder, true, true>(C.lds + RING_OFF, g, S, E); }
    GRID_BAR();
#ifdef USE_TOPK_NAIVE
    if (PH(16)) peer_scores(C, QP, KEYS + (size_t)8 * 2 * 128 * 128, SCO);
    GRID_BAR();
    if (PH(17)) peer_topk(C, SCO, IDX, GATE);
#else
    if (PH(17)) peer_topk_fused<0>(C, QP, KEYS + (size_t)8 * 2 * 128 * 128, IDX, GATE);
#endif
    GRID_BAR();
    if (PH(18)) GATHER_FN<true>(C, H, IDX, GATE, PU8 + (size_t)16384 * 1024, PV8 + (size_t)16384 * 1024, ISU + 16384, ISV + 16384, XB, nullptr, out, MOD1 + 5120, INP(float, 20), nullptr, nullptr);
#undef GRID_BAR
}

extern "C" void kernel_launch(void* const* d_in, const int* in_sizes, int n_in, void* d_out, int out_size, void* d_ws, size_t ws_size, hipStream_t stream) {
    static int grid = 0;
    if (grid == 0) {
        if (n_in != 21 || in_sizes[0] != TT * DM || out_size != TT * DM || ws_size < WS_END) { fprintf(stderr, "kernel_launch: unexpected shapes/workspace: n_in %d in0 %d out %d ws %zu (need %zu)\n", n_in, n_in > 0 ? in_sizes[0] : -1, out_size, ws_size, (size_t)WS_END); grid = -1; return; }
        int dev = 0, cus = 0;
        if (hipGetDevice(&dev) != hipSuccess || hipDeviceGetAttribute(&cus, hipDeviceAttributeMultiprocessorCount, dev) != hipSuccess) { fprintf(stderr, "kernel_launch: device query failed\n"); grid = -1; return; }
        if (hipFuncSetAttribute((const void*)mk_fwd, hipFuncAttributeMaxDynamicSharedMemorySize, LDS_BYTES) != hipSuccess) { fprintf(stderr, "kernel_launch: hipFuncSetAttribute failed\n"); grid = -1; return; }
        (void)hipGetLastError();
        grid = cus;
    }
    if (grid < 0) return;
    if (hipMemsetAsync((char*)d_ws + WS_CTL, 0, CTL_ZERO_BYTES, stream) != hipSuccess) { fprintf(stderr, "kernel_launch: memset failed\n"); return; }
    Args a; memset(&a, 0, sizeof(a));
    for (int i = 0; i < 21; ++i) a.in[i] = d_in[i];
    a.out = (float*)d_out; a.ws = (unsigned char*)d_ws;
    hipLaunchKernelGGL(mk_fwd, dim3(grid), dim3(NWAVES * 64), LDS_BYTES, stream, a);
    const hipError_t le = hipPeekAtLastError();
    if (le != hipSuccess) fprintf(stderr, "kernel_launch: launch failed: %s\n", hipGetErrorName(le));
}
```

```cpp
#define USE_GATHER_ROUNDS 1
#include <hip/hip_runtime.h>
#include <cstdio>
#include <cstdint>
#include <cstring>
#include <cmath>
namespace pg8 {
#define PG8_LAS __attribute__((address_space(3)))
typedef unsigned short bf16_t;
typedef short bf16x8 __attribute__((ext_vector_type(8)));
typedef float f32x4 __attribute__((ext_vector_type(4)));
typedef unsigned u32x4 __attribute__((ext_vector_type(4)));
constexpr int BM = 256, BK = 64, HALF = 128, HTB = HALF * BK * 2  , STAGE_BYTES = 8 * HTB, NXCD = 8, WGM = 8;

__host__ __device__ __forceinline__ int lds_byte(int r, int c) { const int st = (r >> 4) * 2 + (c >> 5), rr = r & 15, cc = c & 31, ob = rr * 64 + cc * 2; return st * 1024 + (ob ^ (((ob >> 9) & 1) << 5)); }
__host__ __device__ __forceinline__ void stage_rc(int b, int& R, int& C) { const int st = b / 1024, sb = b % 1024, swz = sb ^ (((sb >> 9) & 1) << 5); R = (st >> 1) * 16 + swz / 64; C = (st & 1) * 32 + (swz % 64) / 2; }
__host__ __device__ __forceinline__ int perm32(int rho) { const int n = rho >> 4, i = rho & 15; return 8 * (i >> 2) + 4 * n + (i & 3); }

struct Unit { int pm, pn; };
struct Gemm { const bf16_t* A; const bf16_t* Bt; int M, N, K; };

struct StaticOrder {
    int nM, nN, nwg, G, c;
    __host__ __device__ void init(int M, int N, int G_, int c_) { nM = M / BM; nN = N / BM; nwg = nM * nN; G = G_; c = c_; }
    __host__ __device__ bool next(int i, Unit& u) const {
        const long L = (long)i * G + c; if (L >= nwg) return false;
        int wgid = (int)L; { const int q = nwg / NXCD, r = nwg % NXCD, xcd = wgid % NXCD, off = wgid / NXCD; wgid = (xcd < r ? xcd * (q + 1) : r * (q + 1) + (xcd - r) * q) + off; }
        const int nig = WGM * nN, gid = wgid / nig, fm = gid * WGM, gsz = (nM - fm) < WGM ? (nM - fm) : WGM;
        u.pm = fm + ((wgid % nig) % gsz); u.pn = (wgid % nig) / gsz; return true;
    }
    __device__ __forceinline__ void a_ready(const Unit&) const {}
    __device__ __forceinline__ void done(const Unit&) const {}
};

__device__ __forceinline__ unsigned cvt_pk_bf16(float lo, float hi) { unsigned r; asm volatile("v_cvt_pk_bf16_f32 %0, %1, %2" : "=v"(r) : "v"(lo), "v"(hi)); return r; }
typedef float f32x2 __attribute__((ext_vector_type(2)));
__device__ __forceinline__ f32x2 gelu_pk(f32x2 v) {
    const f32x2 av = __builtin_elementwise_abs(v), d = av * 0.2316418882f + 1.0f;
    f32x2 t; t.x = __builtin_amdgcn_rcpf(d.x); t.y = __builtin_amdgcn_rcpf(d.y);
    f32x2 q = t * 0.5307027145f + (-0.7265760135f); q = q * t + 0.7107068705f; q = q * t + (-0.142248368f); q = q * t + 0.127414796f; q = q * t;
    const f32x2 s = (v * v) * (-0.72134752044f);
    f32x2 e; e.x = __builtin_amdgcn_exp2f(s.x); e.y = __builtin_amdgcn_exp2f(s.y);
    const f32x2 m = v * (q * e), r = v - m;
    f32x2 o; o.x = v.x < 0.f ? m.x : r.x; o.y = v.y < 0.f ? m.y : r.y; return o;
}

template <int ACT  > struct EpiBf16 {
    static constexpr bool PERM = true, AFTER_DRAIN = false; static_assert(ACT == 0 || ACT == 1, "EpiBf16: ACT is 0 (none) or 1 (gelu_pk)");
    bf16_t* O; int ldc; const float* bias; int split_cols; size_t split_stride; float scale0;
    __device__ __forceinline__ void operator()(const f32x4 (&acc)[2][2][4][2], const Unit& u, int wr, int wc, int fr, int fq) const {
        const int row0 = u.pm * BM + wr * 64 + fr; int colt = u.pn * BM; bf16_t* base = O;
        float sc = 1.f; if (split_cols) { const int t = colt / split_cols; base += (size_t)t * split_stride; colt -= t * split_cols; if (t == 0) sc = scale0; }
        const int col0 = colt + wc * 32 + 8 * fq, bcol0 = u.pn * BM + wc * 32 + 8 * fq;
        f32x4 bv[2][2];
#pragma unroll
        for (int bj = 0; bj < 2; ++bj)
#pragma unroll
            for (int n = 0; n < 2; ++n) bv[bj][n] = bias ? *(const f32x4*)(bias + bcol0 + bj * HALF + 4 * n) : (f32x4){0.f, 0.f, 0.f, 0.f};
#pragma unroll
        for (int ai = 0; ai < 2; ++ai)
#pragma unroll
            for (int m = 0; m < 4; ++m) { bf16_t* rowp = base + (size_t)(row0 + ai * HALF + m * 16) * ldc + col0;
#pragma unroll
                for (int bj = 0; bj < 2; ++bj) { f32x4 v0 = acc[ai][bj][m][0] + bv[bj][0], v1 = acc[ai][bj][m][1] + bv[bj][1];
                    if (ACT == 1) { f32x2 a = gelu_pk((f32x2){v0[0], v0[1]}), b = gelu_pk((f32x2){v0[2], v0[3]}), c = gelu_pk((f32x2){v1[0], v1[1]}), d = gelu_pk((f32x2){v1[2], v1[3]});
                        v0 = (f32x4){a.x, a.y, b.x, b.y}; v1 = (f32x4){c.x, c.y, d.x, d.y}; }
                    v0 = v0 * sc; v1 = v1 * sc; u32x4 w; w.x = cvt_pk_bf16(v0[0], v0[1]); w.y = cvt_pk_bf16(v0[2], v0[3]); w.z = cvt_pk_bf16(v1[0], v1[1]); w.w = cvt_pk_bf16(v1[2], v1[3]);
                    *(u32x4*)(rowp + bj * HALF) = w; } }
    }
};
template <class Epi, class Sched, bool ALIGN_EPI = false, bool SP2 = false>
__device__ __forceinline__ void gemm_phase(PG8_LAS unsigned char* lds, const Gemm g, const Sched& S, const Epi& E) {
    int tid_ = threadIdx.x; asm volatile("" : "+v"(tid_));
    const int tid = tid_, wid = __builtin_amdgcn_readfirstlane(tid >> 6), lane = tid & 63, wr = wid >> 2, wc = wid & 3, fr = lane & 15, fq = lane >> 4;
    const int K = g.K, nt = K / BK;
    unsigned voffA[2], voffB[2];
#pragma unroll
    for (int i = 0; i < 2; ++i) { int R, C; stage_rc(tid * 16 + i * 8192, R, C); const int Rb = Epi::PERM ? ((R & ~31) + perm32(R & 31)) : R;
        voffA[i] = (unsigned)(R * K + C) * 2u; voffB[i] = (unsigned)(Rb * K + C) * 2u; }
    const size_t kstep = (size_t)(BK * 2);
    const size_t hstep = (size_t)HALF * K * 2;
    const size_t tstep = 2 * hstep;
    const unsigned ldsw = (unsigned)wid * 1024u;
    const int aoff = lds_byte(wr * 64 + fr, fq * 8), boff = lds_byte(wc * 32 + fr, fq * 8);
#define PG8_SA(b, h) (((b) * 2 + (h)) * HTB)
#define PG8_SB(b, h) ((4 + (b) * 2 + (h)) * HTB)
#define PG8_STAGE(bufoff, gbase, voff) do { _Pragma("unroll") for (int _i = 0; _i < 2; ++_i) \
        __builtin_amdgcn_global_load_lds((const unsigned*)((const char*)(gbase) + (voff)[_i]), (PG8_LAS unsigned*)(lds + (bufoff) + ldsw + _i * 8192), 16, 0, 0); } while (0)
#define PG8_LDA(dst, b, h) do { _Pragma("unroll") for (int m = 0; m < 4; ++m) _Pragma("unroll") for (int k = 0; k < 2; ++k) dst[m][k] = *(const PG8_LAS bf16x8*)(lds + PG8_SA(b, h) + aoff + m * 2048 + k * 1024); } while (0)
#define PG8_LDB(dst, b, h) do { _Pragma("unroll") for (int n = 0; n < 2; ++n) _Pragma("unroll") for (int k = 0; k < 2; ++k) dst[n][k] = *(const PG8_LAS bf16x8*)(lds + PG8_SB(b, h) + boff + n * 2048 + k * 1024); } while (0)
#define PG8_MMA(ai, bj, At, Bt) do { __builtin_amdgcn_s_setprio(1); _Pragma("unroll") for (int m = 0; m < 4; ++m) _Pragma("unroll") for (int n = 0; n < 2; ++n) _Pragma("unroll") for (int k = 0; k < 2; ++k) \
        acc[ai][bj][m][n] = __builtin_amdgcn_mfma_f32_16x16x32_bf16(Bt[n][k], At[m][k], acc[ai][bj][m][n], 0, 0, 0); __builtin_amdgcn_s_setprio(0); } while (0)
#define PG8_WAIT_V(n) asm volatile("s_waitcnt vmcnt(" #n ")" ::: "memory")
#define PG8_WAIT_L(n) asm volatile("s_waitcnt lgkmcnt(" #n ")" ::: "memory")
#define PG8_BAR __builtin_amdgcn_s_barrier()
#define PG8_SCHED __builtin_amdgcn_sched_barrier(0)
    Unit cur, nxt; int ui = 0;
    if (!S.next(0, cur)) return;
    f32x4 acc[2][2][4][2];
#pragma unroll
    for (int a = 0; a < 2; ++a)
#pragma unroll
        for (int b = 0; b < 2; ++b)
#pragma unroll
            for (int m = 0; m < 4; ++m)
#pragma unroll
                for (int n = 0; n < 2; ++n) acc[a][b][m][n] = (f32x4){0.f, 0.f, 0.f, 0.f};
    bf16x8 At[4][2], B0[2][2], B1[2][2];
    const char* cA = (const char*)g.A + (size_t)cur.pm * tstep; const char* cB = (const char*)g.Bt + (size_t)cur.pn * tstep;
    S.a_ready(cur);
    if constexpr (SP2) {
        PG8_STAGE(PG8_SB(0, 0), cB, voffB); PG8_STAGE(PG8_SB(0, 1), cB + hstep, voffB); PG8_STAGE(PG8_SA(0, 0), cA, voffA); PG8_STAGE(PG8_SA(0, 1), cA + hstep, voffA);
        if (wr == 1) PG8_BAR;
        PG8_WAIT_V(2); PG8_BAR;
        PG8_STAGE(PG8_SB(1, 0), cB + kstep, voffB); PG8_STAGE(PG8_SA(1, 0), cA + kstep, voffA); PG8_STAGE(PG8_SB(1, 1), cB + hstep + kstep, voffB);
        PG8_WAIT_V(6); PG8_BAR;
    } else {
        PG8_STAGE(PG8_SB(0, 0), cB, voffB); PG8_STAGE(PG8_SA(0, 0), cA, voffA); PG8_STAGE(PG8_SB(0, 1), cB + hstep, voffB); PG8_STAGE(PG8_SA(0, 1), cA + hstep, voffA);
        if (wr == 1) PG8_BAR;
        PG8_WAIT_V(4); PG8_BAR;
        PG8_STAGE(PG8_SB(1, 0), cB + kstep, voffB); PG8_STAGE(PG8_SA(1, 0), cA + kstep, voffA); PG8_STAGE(PG8_SB(1, 1), cB + hstep + kstep, voffB);
        PG8_WAIT_V(6); PG8_BAR;
    }
    for (;;) {
        const bool has_next = S.next(ui + 1, nxt);
        const char* nA = has_next ? (const char*)g.A + (size_t)nxt.pm * tstep : cA; const char* nB = has_next ? (const char*)g.Bt + (size_t)nxt.pn * tstep : cB;
        for (int t = 0; t < nt; t += 2) {
            const bool last = (t == nt - 2);
            const char* a1 = cA + (size_t)(t + 1) * kstep;
            const char* a2 = last ? nA : cA + (size_t)(t + 2) * kstep; const char* b2 = last ? nB : cB + (size_t)(t + 2) * kstep;
            const char* a3 = a2 + kstep; const char* b3 = b2 + kstep;
            if (last && has_next) S.a_ready(nxt);
            if constexpr (SP2) {
            PG8_LDB(B0, 0, 0); PG8_LDB(B1, 0, 1); PG8_SCHED; PG8_LDA(At, 0, 0); PG8_STAGE(PG8_SA(1, 1), a1 + hstep, voffA);
            PG8_WAIT_V(8); PG8_WAIT_L(0); PG8_BAR; PG8_MMA(0, 0, At, B0); PG8_MMA(0, 1, At, B1); PG8_BAR; PG8_SCHED;
            PG8_LDA(At, 0, 1); PG8_STAGE(PG8_SB(0, 0), b2, voffB); PG8_STAGE(PG8_SB(0, 1), b2 + hstep, voffB); PG8_STAGE(PG8_SA(0, 0), a2, voffA);
            PG8_WAIT_V(8); PG8_WAIT_L(0); PG8_BAR; PG8_MMA(1, 0, At, B0); PG8_MMA(1, 1, At, B1); PG8_BAR; PG8_SCHED;
            PG8_LDB(B0, 1, 0); PG8_LDB(B1, 1, 1); PG8_SCHED; PG8_LDA(At, 1, 0); PG8_STAGE(PG8_SA(0, 1), a2 + hstep, voffA);
            PG8_WAIT_V(8); PG8_WAIT_L(0); PG8_BAR; PG8_MMA(0, 0, At, B0); PG8_MMA(0, 1, At, B1); PG8_BAR; PG8_SCHED;
            PG8_LDA(At, 1, 1); PG8_STAGE(PG8_SB(1, 0), b3, voffB); PG8_STAGE(PG8_SB(1, 1), b3 + hstep, voffB); PG8_STAGE(PG8_SA(1, 0), a3, voffA);
            PG8_WAIT_V(8); PG8_WAIT_L(0); PG8_BAR; PG8_MMA(1, 0, At, B0); PG8_MMA(1, 1, At, B1); PG8_BAR; PG8_SCHED;
            } else {
            PG8_LDB(B0, 0, 0); PG8_SCHED; PG8_LDA(At, 0, 0); PG8_STAGE(PG8_SA(1, 1), a1 + hstep, voffA);
            PG8_WAIT_L(8); PG8_BAR; PG8_WAIT_L(0); PG8_MMA(0, 0, At, B0); PG8_BAR; PG8_SCHED;
            PG8_LDB(B1, 0, 1); PG8_STAGE(PG8_SB(0, 0), b2, voffB);
            PG8_BAR; PG8_WAIT_L(0); PG8_MMA(0, 1, At, B1); PG8_BAR;
            PG8_LDA(At, 0, 1); PG8_STAGE(PG8_SA(0, 0), a2, voffA);
            PG8_BAR; PG8_WAIT_L(0); PG8_MMA(1, 0, At, B0); PG8_BAR; PG8_SCHED;
            PG8_STAGE(PG8_SB(0, 1), b2 + hstep, voffB);
            PG8_WAIT_V(6); PG8_BAR; PG8_MMA(1, 1, At, B1); PG8_BAR;
            PG8_LDB(B0, 1, 0); PG8_SCHED; PG8_LDA(At, 1, 0); PG8_STAGE(PG8_SA(0, 1), a2 + hstep, voffA);
            PG8_WAIT_L(8); PG8_BAR; PG8_WAIT_L(0); PG8_MMA(0, 0, At, B0); PG8_BAR; PG8_SCHED;
            PG8_LDB(B1, 1, 1); PG8_STAGE(PG8_SB(1, 0), b3, voffB);
            PG8_BAR; PG8_WAIT_L(0); PG8_MMA(0, 1, At, B1); PG8_BAR;
            PG8_LDA(At, 1, 1); PG8_STAGE(PG8_SA(1, 0), a3, voffA);
            PG8_BAR; PG8_WAIT_L(0); PG8_MMA(1, 0, At, B0); PG8_BAR; PG8_SCHED;
            PG8_STAGE(PG8_SB(1, 1), b3 + hstep, voffB);
            PG8_WAIT_V(6); PG8_BAR; PG8_MMA(1, 1, At, B1); PG8_BAR;
            }
        }
        if constexpr (ALIGN_EPI) { if (wr == 0) PG8_BAR; }
        if constexpr (!Epi::AFTER_DRAIN) { E(acc, cur, wr, wc, fr, fq); S.done(cur); }
        if (!has_next) break;
#pragma unroll
        for (int a = 0; a < 2; ++a)
#pragma unroll
            for (int b = 0; b < 2; ++b)
#pragma unroll
                for (int m = 0; m < 4; ++m)
#pragma unroll
                    for (int n = 0; n < 2; ++n) acc[a][b][m][n] = (f32x4){0.f, 0.f, 0.f, 0.f};
        cur = nxt; cA = nA; cB = nB; ++ui;
        if constexpr (ALIGN_EPI) { if (wr == 1) PG8_BAR; }
    }
    PG8_WAIT_V(0);
    if constexpr (!ALIGN_EPI) { if (wr == 0) PG8_BAR; }
    PG8_BAR;
    if constexpr (Epi::AFTER_DRAIN) { E.fused(acc, cur, wr, wc, fr, fq, lds, wid, lane); S.done(cur); }
#undef PG8_SA
#undef PG8_SB
#undef PG8_STAGE
#undef PG8_LDA
#undef PG8_LDB
#undef PG8_MMA
#undef PG8_WAIT_V
#undef PG8_WAIT_L
#undef PG8_BAR
#undef PG8_SCHED
}
}
namespace pg8 {
typedef unsigned u32x2 __attribute__((ext_vector_type(2)));
__device__ __forceinline__ float gelu_tanh(float x) {
    const float e = __builtin_amdgcn_exp2f(x * (-2.302208198f - 0.1029432397f * x * x));
    return x * __builtin_amdgcn_rcpf(1.0f + e);
}
__device__ __forceinline__ float silu_f(float x) { return x * __builtin_amdgcn_rcpf(1.0f + __builtin_amdgcn_exp2f(-1.4426950409f * x)); }

typedef _Float16 eh2_t __attribute__((ext_vector_type(2)));
struct EpiRetProj {
    static constexpr bool PERM = true, AFTER_DRAIN = false;
    bf16_t *Q, *K, *V, *G; const unsigned* trig;
    __device__ __forceinline__ void operator()(const f32x4 (&acc)[2][2][4][2], const Unit& u, int wr, int wc, int fr, int fq) const {
        const int pn = u.pn;
        if (pn < 8) {
            bf16_t* dst = pn < 4 ? Q : K; const int head = pn & 3; const float sc = pn < 4 ? 1.0f : 0.0625f;
            const int f0 = wc * 32 + 8 * fq;
#pragma unroll
            for (int ai = 0; ai < 2; ++ai) {
                u32x4 tg[4][2];
#pragma unroll
                for (int m = 0; m < 4; ++m) { const int row = u.pm * BM + ai * HALF + wr * 64 + m * 16 + fr; const unsigned* tp = trig + (size_t)row * 128 + f0;
                    tg[m][0] = *(const u32x4*)tp; tg[m][1] = *(const u32x4*)(tp + 4); }
#pragma unroll
                for (int m = 0; m < 4; ++m) {
                    const int row = u.pm * BM + ai * HALF + wr * 64 + m * 16 + fr;
                    u32x4 w1, w2;
#pragma unroll
                    for (int n = 0; n < 2; ++n) {
                        const f32x4 x1 = acc[ai][0][m][n], x2 = acc[ai][1][m][n]; float o1[4], o2[4];
#pragma unroll
                        for (int j = 0; j < 4; ++j) { const unsigned tw = tg[m][n][j]; const float c = (float)__builtin_bit_cast(_Float16, (unsigned short)(tw & 0xffffu)) * sc, sn = (float)__builtin_bit_cast(_Float16, (unsigned short)(tw >> 16)) * sc;
                            o1[j] = x1[j] * c - x2[j] * sn; o2[j] = x1[j] * sn + x2[j] * c; }
                        w1[2 * n] = cvt_pk_bf16(o1[0], o1[1]); w1[2 * n + 1] = cvt_pk_bf16(o1[2], o1[3]); w2[2 * n] = cvt_pk_bf16(o2[0], o2[1]); w2[2 * n + 1] = cvt_pk_bf16(o2[2], o2[3]);
                    }
                    bf16_t* p = dst + (size_t)row * 1024 + head * 256 + f0;
                    *(u32x4*)p = w1; *(u32x4*)(p + 128) = w2;
                }
            }
        } else {
            const bool isg = pn >= 16; bf16_t* dst = isg ? G : V; const int colbase = ((pn - 8) & 7) * 256 + wc * 32 + 8 * fq;
#pragma unroll
            for (int ai = 0; ai < 2; ++ai)
#pragma unroll
                for (int m = 0; m < 4; ++m) {
                    const int row = u.pm * BM + ai * HALF + wr * 64 + m * 16 + fr;
#pragma unroll
                    for (int bj = 0; bj < 2; ++bj) {
                        f32x4 v0 = acc[ai][bj][m][0], v1 = acc[ai][bj][m][1];
                        if (isg) {
#pragma unroll
                            for (int j = 0; j < 4; ++j) { v0[j] = silu_f(v0[j]); v1[j] = silu_f(v1[j]); } }
                        u32x4 w; w.x = cvt_pk_bf16(v0[0], v0[1]); w.y = cvt_pk_bf16(v0[2], v0[3]); w.z = cvt_pk_bf16(v1[0], v1[1]); w.w = cvt_pk_bf16(v1[2], v1[3]);
                        *(u32x4*)(dst + (size_t)row * 2048 + colbase + bj * HALF) = w;
                    }
                }
        }
    }
};
template <bool BF> struct EpiResGateT {
    static constexpr bool PERM = true, AFTER_DRAIN = false;
    const void* base; bf16_t* out; const float* gate; int gstride;
    __device__ __forceinline__ void operator()(const f32x4 (&acc)[2][2][4][2], const Unit& u, int wr, int wc, int fr, int fq) const {
        const int b = (u.pm * BM) >> 13; const float* gp = gate + (size_t)b * gstride;
        const int col0 = u.pn * BM + wc * 32 + 8 * fq;
        f32x4 gv[2][2];
#pragma unroll
        for (int bj = 0; bj < 2; ++bj)
#pragma unroll
            for (int n = 0; n < 2; ++n) gv[bj][n] = *(const f32x4*)(gp + col0 + bj * HALF + 4 * n);
#pragma unroll
        for (int ai = 0; ai < 2; ++ai)
#pragma unroll
            for (int m = 0; m < 4; ++m) {
                const size_t off = (size_t)(u.pm * BM + ai * HALF + wr * 64 + m * 16 + fr) * 1024 + col0;
#pragma unroll
                for (int bj = 0; bj < 2; ++bj) {
                    f32x4 b0, b1;
                    if (BF) { const u32x4 bw = *(const u32x4*)((const bf16_t*)base + off + bj * HALF);
                        b0[0] = __uint_as_float(bw.x << 16); b0[1] = __uint_as_float(bw.x & 0xffff0000u); b0[2] = __uint_as_float(bw.y << 16); b0[3] = __uint_as_float(bw.y & 0xffff0000u);
                        b1[0] = __uint_as_float(bw.z << 16); b1[1] = __uint_as_float(bw.z & 0xffff0000u); b1[2] = __uint_as_float(bw.w << 16); b1[3] = __uint_as_float(bw.w & 0xffff0000u); }
                    else { b0 = *(const f32x4*)((const float*)base + off + bj * HALF); b1 = *(const f32x4*)((const float*)base + off + bj * HALF + 4); }
                    const f32x4 y0 = b0 + gv[bj][0] * acc[ai][bj][m][0], y1 = b1 + gv[bj][1] * acc[ai][bj][m][1];
                    u32x4 w; w.x = cvt_pk_bf16(y0[0], y0[1]); w.y = cvt_pk_bf16(y0[2], y0[3]); w.z = cvt_pk_bf16(y1[0], y1[1]); w.w = cvt_pk_bf16(y1[2], y1[3]);
                    *(u32x4*)(out + off + bj * HALF) = w;
                }
            }
    }
};
struct EpiSguIn {
    static constexpr bool PERM = true, AFTER_DRAIN = false;
    bf16_t* U; bf16_t* Vb; const float* bias; float* stats;
    __device__ __forceinline__ void operator()(const f32x4 (&acc)[2][2][4][2], const Unit& u, int wr, int wc, int fr, int fq) const {
        const bool isv = u.pn >= 12; bf16_t* base = isv ? Vb : U; const int colt = (isv ? u.pn - 12 : u.pn) * BM;
        const int col0 = colt + wc * 32 + 8 * fq, bcol0 = u.pn * BM + wc * 32 + 8 * fq;
        f32x4 bv[2][2];
#pragma unroll
        for (int bj = 0; bj < 2; ++bj)
#pragma unroll
            for (int n = 0; n < 2; ++n) bv[bj][n] = *(const f32x4*)(bias + bcol0 + bj * HALF + 4 * n);
#pragma unroll
        for (int ai = 0; ai < 2; ++ai)
#pragma unroll
            for (int m = 0; m < 4; ++m) {
                const int row = u.pm * BM + ai * HALF + wr * 64 + m * 16 + fr;
                bf16_t* rowp = base + (size_t)row * 3072 + col0;
                float s1 = 0.f, s2 = 0.f;
#pragma unroll
                for (int bj = 0; bj < 2; ++bj) {
                    f32x4 v0 = acc[ai][bj][m][0] + bv[bj][0], v1 = acc[ai][bj][m][1] + bv[bj][1];
#pragma unroll
                    for (int j = 0; j < 4; ++j) { v0[j] = gelu_tanh(v0[j]); v1[j] = gelu_tanh(v1[j]); }
                    u32x4 w; w.x = cvt_pk_bf16(v0[0], v0[1]); w.y = cvt_pk_bf16(v0[2], v0[3]); w.z = cvt_pk_bf16(v1[0], v1[1]); w.w = cvt_pk_bf16(v1[2], v1[3]);
                    *(u32x4*)(rowp + bj * HALF) = w;
                    if (isv) {
#pragma unroll
                        for (int j = 0; j < 4; ++j) { const unsigned ww = j == 0 ? w.x : j == 1 ? w.y : j == 2 ? w.z : w.w;
                            const float a = __uint_as_float(ww << 16), bq = __uint_as_float(ww & 0xffff0000u); s1 += a + bq; s2 += a * a + bq * bq; }
                    }
                }
                if (isv) {
                    s1 += __shfl_xor(s1, 16); s1 += __shfl_xor(s1, 32); s2 += __shfl_xor(s2, 16); s2 += __shfl_xor(s2, 32);
                    if (fq == 0) { float* sp = stats + ((size_t)row * 48 + (u.pn - 12) * 4 + wc) * 2; sp[0] = s1; sp[1] = s2; }
                }
            }
    }
};
}
typedef unsigned u32x4 __attribute__((ext_vector_type(4)));
#define GAS __attribute__((address_space(1)))
#define LAS __attribute__((address_space(3)))
typedef unsigned short bf16;
typedef unsigned v4u __attribute__((ext_vector_type(4)));
typedef float f32x4 __attribute__((ext_vector_type(4)));
typedef short bf16x8 __attribute__((ext_vector_type(8)));
typedef GAS unsigned gu32;
typedef GAS unsigned long long gu64;
#define RLX_AGENT __ATOMIC_RELAXED, __HIP_MEMORY_SCOPE_AGENT
#define LDS_WAIT() asm volatile("s_waitcnt lgkmcnt(0)" ::: "memory")
#define VM_WAIT() asm volatile("s_waitcnt vmcnt(0)" ::: "memory")
__device__ __forceinline__ unsigned long long rt() { return __builtin_amdgcn_s_memrealtime(); }
__device__ __forceinline__ unsigned f2bf(float f) { unsigned u = __builtin_bit_cast(unsigned, f); return (u + 0x7fffu + ((u >> 16) & 1u)) >> 16; }
__device__ __forceinline__ unsigned pk2(float lo, float hi) { return f2bf(lo) | (f2bf(hi) << 16); }

#define XB_TMO      128
#define XB_XCNT(j)  (256  + 64 * (j))
#define XB_XSUB(j)  (1280 + 64 * (j))
#define XB_XGEN(j)  (2304 + 64 * (j))
#define XB_TOP      3328
#define XB_TOPGEN   3392
#define XCD_BAR_WORDS 3456
#define XB_SPIN_CAP (1u << 18)

__device__ __forceinline__ unsigned xb_ld(unsigned* p)              { return __hip_atomic_load(p, __ATOMIC_RELAXED, __HIP_MEMORY_SCOPE_AGENT); }
__device__ __forceinline__ unsigned xb_add(unsigned* p, unsigned v) { return __hip_atomic_fetch_add(p, v, __ATOMIC_RELAXED, __HIP_MEMORY_SCOPE_AGENT); }
__device__ __forceinline__ unsigned xb_xcc_id() { return (unsigned)__builtin_amdgcn_s_getreg((3 << 11) | 20) & 0xFu; }
#define XB_SPIN(cond, bar) do { unsigned _sp = 0; while (cond) { __builtin_amdgcn_s_sleep(1); \
    if ((++_sp & 255u) == 0u) { if (xb_ld(&(bar)[XB_TMO])) break; if (_sp > XB_SPIN_CAP) { atomicAdd(&(bar)[XB_TMO], 1u); break; } } } } while (0)

struct XcdBarrier {
    unsigned* bar; unsigned x;
    volatile LAS unsigned* st;
};

__device__ __forceinline__ XcdBarrier xcd_barrier_post(unsigned* bar, volatile LAS unsigned* st) {
    XcdBarrier b; b.bar = bar; b.x = xb_xcc_id(); b.st = st;
    if (threadIdx.x == 0) (void)xb_add(&bar[XB_XCNT(b.x)], 1u);
    return b;
}
__device__ __forceinline__ void xcd_barrier_complete(unsigned* bar, unsigned x, unsigned& nloc, unsigned& nx) {
    const unsigned G = gridDim.x * gridDim.y * gridDim.z;
    unsigned sum, cnt, mine, sp = 0u;
    for (;;) {
        sum = 0u; cnt = 0u; mine = 0u;
#pragma unroll
        for (unsigned j = 0; j < 16; ++j) { const unsigned c = xb_ld(&bar[XB_XCNT(j)]); sum += c; cnt += (c > 0u) ? 1u : 0u; mine = (j == x) ? c : mine; }
        if (sum == G) break;
        __builtin_amdgcn_s_sleep(1);
        if ((++sp & 255u) == 0u) { if (xb_ld(&bar[XB_TMO])) break; if (sp > XB_SPIN_CAP) { atomicAdd(&bar[XB_TMO], 1u); break; } }
    }
    nloc = mine > 0u ? mine : 1u; nx = cnt > 0u ? cnt : 1u;
}

__device__ __forceinline__ void xcd_barrier(const XcdBarrier& b) {
    asm volatile("s_waitcnt vmcnt(0)" ::: "memory");
    __syncthreads();
    if (threadIdx.x == 0) {
        unsigned* bar = b.bar;
        __builtin_amdgcn_s_waitcnt(0);
        unsigned nloc = b.st[0], nx = b.st[1];
        if (nloc == 0u) { xcd_barrier_complete(bar, b.x, nloc, nx); b.st[0] = nloc; b.st[1] = nx; }
        const unsigned old = xb_add(&bar[XB_XSUB(b.x)], 1u);
        const unsigned gen = old / nloc;
        if (old + 1u == (gen + 1u) * nloc) {
            __builtin_amdgcn_fence(__ATOMIC_RELEASE, "agent");
            asm volatile("s_waitcnt vmcnt(0)" ::: "memory");
            const unsigned og = xb_add(&bar[XB_TOP], 1u);
            const unsigned tg = og / nx;
            if (og + 1u == (tg + 1u) * nx) xb_add(&bar[XB_TOPGEN], 1u);
            else XB_SPIN(xb_ld(&bar[XB_TOPGEN]) == tg, bar);
            __builtin_amdgcn_fence(__ATOMIC_ACQUIRE, "agent");
            xb_add(&bar[XB_XGEN(b.x)], 1u);
            asm volatile("s_waitcnt vmcnt(0)" ::: "memory");
        } else {
            XB_SPIN(xb_ld(&bar[XB_XGEN(b.x)]) == gen, bar);
            __builtin_amdgcn_fence(__ATOMIC_ACQUIRE, "agent");
            asm volatile("s_waitcnt vmcnt(0)" ::: "memory");
        }
    }
    __syncthreads();
}
__device__ __forceinline__ float wave_sum(float v) {
#pragma unroll
    for (int o = 1; o < 64; o <<= 1) v += __shfl_xor(v, o);
    return v;
}
__device__ __forceinline__ void p0_transpose_item(const float* W, int K, int N, bf16* WT, int row_off, LAS float* scr, int item, int lane) {
    const int nblk = N / 32, kb = item / nblk, nb = item % nblk, k0 = 64 * kb, n0 = 32 * nb;
    { f32x4 tv_[8]; const int c4 = (lane & 7) * 4;
#pragma unroll
      for (int i = 0; i < 8; ++i) tv_[i] = *(const f32x4*)(W + (size_t)(k0 + 8 * i + (lane >> 3)) * N + n0 + c4);
#pragma unroll
      for (int i = 0; i < 8; ++i) { LAS float* d_ = scr + (8 * i + (lane >> 3)) * 33 + c4; d_[0] = tv_[i][0]; d_[1] = tv_[i][1]; d_[2] = tv_[i][2]; d_[3] = tv_[i][3]; } }
    LDS_WAIT(); asm volatile("" ::: "memory");
    const int c = lane & 7;
#pragma unroll
    for (int j = 0; j < 4; ++j) { const int n = (lane >> 3) + 8 * j; const LAS float* s = scr + (8 * c) * 33 + n;
        v4u o; o.x = pk2(s[0 * 33], s[1 * 33]); o.y = pk2(s[2 * 33], s[3 * 33]); o.z = pk2(s[4 * 33], s[5 * 33]); o.w = pk2(s[6 * 33], s[7 * 33]);
        *(GAS v4u*)(WT + (size_t)(row_off + n0 + n) * K + k0 + 8 * c) = o; }
    LDS_WAIT(); asm volatile("" ::: "memory");
}
#define DI __device__ __forceinline__
constexpr int NWAVES = 8;
constexpr int TT = 16384, DM = 1024, SEQ = 8192;
constexpr size_t MiB = 1u << 20;
constexpr size_t WS_CTL = 0, CTL_ZERO_BYTES = 32768, WS_MOD = 512 * 1024;
constexpr size_t WS_COS = 2 * MiB, WS_SIN = 10 * MiB;
constexpr size_t WS_WRI = 18 * MiB, WS_WRO = 30 * MiB, WS_WSI = 34 * MiB, WS_WSO = 46 * MiB, WS_WQ = 52 * MiB, WS_KEYS = 60 * MiB;
constexpr size_t WS_ISU = 61 * MiB, WS_ISV = 61 * MiB + 256 * 1024;
constexpr size_t WS_STATS = 62 * MiB, WS_IDX = 68 * MiB, WS_GATE = 76 * MiB, WS_H = 84 * MiB, WS_PU = 116 * MiB, WS_PV = 180 * MiB;
constexpr size_t WS_R = 244 * MiB;
constexpr size_t WS_Q = WS_R, WS_K = WS_R + 32 * MiB, WS_V = WS_R + 64 * MiB, WS_G = WS_R + 128 * MiB, WS_CROSS = WS_R + 192 * MiB;
constexpr size_t WS_XB = WS_R + 192 * MiB;
constexpr size_t WS_QP = WS_R, WS_SC = WS_R + 64 * MiB;
constexpr size_t WS_U = WS_R, WS_VB = WS_R + 96 * MiB;
constexpr size_t WS_END = 500 * MiB;
constexpr int CW_TMO = 0, CW_BAR = 4096;
constexpr int RING_OFF = 0, RING_BYTES = 131072, LDS_BYTES = 163840, LDSCTL_OFF = LDS_BYTES - 1024, MISC_OFF = LDSCTL_OFF + 320;
constexpr int PTR_OFF = LDSCTL_OFF + 512;
constexpr float EPS = 1e-6f;
typedef float f32x2_t __attribute__((ext_vector_type(2)));

DI float bf2f(bf16 h) { return __uint_as_float((unsigned)h << 16); }
DI float bflo(unsigned w) { return __uint_as_float(w << 16); }
DI float bfhi(unsigned w) { return __uint_as_float(w & 0xffff0000u); }
DI float wave_max(float v) {
#pragma unroll
    for (int o = 1; o < 64; o <<= 1) v = fmaxf(v, __shfl_xor(v, o));
    return v;
}
DI float gelu_t(float x) { return pg8::gelu_tanh(x); }

struct Ctx {
    LAS unsigned char* lds; int tid, lane, wave, vcu, G;
    unsigned char* ws;
};

DI const void* ldp(const Ctx& C, int i) {
    const unsigned long long v = ((const LAS unsigned long long*)(C.lds + PTR_OFF))[i];
    const unsigned lo = __builtin_amdgcn_readfirstlane((unsigned)v), hi = __builtin_amdgcn_readfirstlane((unsigned)(v >> 32));
    return (const void*)(((unsigned long long)hi << 32) | lo);
}
DI void cvt_rows_fp8(const float* src, unsigned char* dst, float* inv_scale, int nrows, int gw, int NGW, int lane) {
    for (int r = gw; r < nrows; r += NGW) {
        const f32x4* s = (const f32x4*)(src + (size_t)r * 1024) + lane * 4;
        f32x4 v[4]; float am = 0.f;
#pragma unroll
        for (int q = 0; q < 4; ++q) { v[q] = s[q]; am = fmaxf(am, fmaxf(fmaxf(fabsf(v[q][0]), fabsf(v[q][1])), fmaxf(fabsf(v[q][2]), fabsf(v[q][3])))); }
        am = wave_max(am);
        const int e = (int)((__float_as_uint(am) >> 23) & 0xffu) - 127;
        const bool ok = am > 1e-30f;
        const float sc = ok ? __uint_as_float((unsigned)(127 + 7 - e) << 23) : 1.0f, isc = ok ? __uint_as_float((unsigned)(127 - 7 + e) << 23) : 1.0f;
        u32x4 o;
#pragma unroll
        for (int q = 0; q < 4; ++q) { int wd = __builtin_amdgcn_cvt_pk_fp8_f32(v[q][0] * sc, v[q][1] * sc, 0, false); wd = __builtin_amdgcn_cvt_pk_fp8_f32(v[q][2] * sc, v[q][3] * sc, wd, true); o[q] = (unsigned)wd; }
        *(u32x4*)(dst + (size_t)r * 1024 + lane * 16) = o;
        if (lane == 0) inv_scale[r] = isc;
    }
}
DI void cvt_rows_i8(const float* src, unsigned char* dst, float* inv_scale, int nrows, int gw, int NGW, int lane) {
    for (int r = gw; r < nrows; r += NGW) {
        const f32x4* s = (const f32x4*)(src + (size_t)r * 1024) + lane * 4;
        f32x4 v[4]; float am = 0.f;
#pragma unroll
        for (int q = 0; q < 4; ++q) { v[q] = s[q]; am = fmaxf(am, fmaxf(fmaxf(fabsf(v[q][0]), fabsf(v[q][1])), fmaxf(fabsf(v[q][2]), fabsf(v[q][3])))); }
        am = wave_max(am);
        const int e = (int)((__float_as_uint(am) >> 23) & 0xffu) - 127;
        const bool ok = am > 1e-30f;
        const float sc = ok ? __uint_as_float((unsigned)(127 + 6 - e) << 23) : 1.0f, isc = ok ? __uint_as_float((unsigned)(127 - 6 + e) << 23) : 1.0f;
        u32x4 o;
#pragma unroll
        for (int q = 0; q < 4; ++q) { unsigned wd = 0u;
#pragma unroll
            for (int j = 0; j < 4; ++j) { int qi = (int)rintf(v[q][j] * sc); qi = qi > 127 ? 127 : (qi < -127 ? -127 : qi); wd |= ((unsigned)qi & 0xffu) << (8 * j); }
            o[q] = wd; }
        *(u32x4*)(dst + (size_t)r * 1024 + lane * 16) = o;
        if (lane == 0) inv_scale[r] = isc;
    }
}
DI void cvt_stream(const float* src, bf16* dst, size_t n4, size_t gtid, size_t gthreads) {
    const f32x4* s = (const f32x4*)src; uint2* d = (uint2*)dst;
    for (size_t i = gtid; i < n4; i += gthreads) { const f32x4 v = s[i]; uint2 o; o.x = pk2(v.x, v.y); o.y = pk2(v.z, v.w); d[i] = o; }
}
struct P0In { const float *c, *ada_w, *ada_b, *ret_w_in, *ret_w_out, *sgu_w_in, *sgu_w_out, *wq, *keys, *pu, *pv; const int* pos; };
DI void p0_prologue(const Ctx& C, const P0In& I) {
    LAS float* scr = (LAS float*)(C.lds + RING_OFF + C.wave * 16384);
    const int gw = C.vcu * NWAVES + C.wave, NGW = C.G * NWAVES;
    bf16* wri = (bf16*)(C.ws + WS_WRI); bf16* wro = (bf16*)(C.ws + WS_WRO);
    constexpr int I_RI = 16 * 192, I_RO = 32 * 32;
    constexpr int NITEMS = I_RI + I_RO;
    for (int it = gw; it < NITEMS; it += NGW) {
        int r = it;
        if (r < I_RI) { p0_transpose_item(I.ret_w_in, 1024, 6144, wri, 0, scr, r, C.lane); continue; } r -= I_RI;
        p0_transpose_item(I.ret_w_out, 2048, 1024, wro, 0, scr, r, C.lane);
    }
    const size_t gtid = (size_t)C.vcu * 512 + C.tid, gth = (size_t)C.G * 512;
    cvt_stream(I.keys, (bf16*)(C.ws + WS_KEYS), (size_t)2 * 8 * 2 * 128 * 128 / 4, gtid, gth);
    float* mod = (float*)(C.ws + WS_MOD);
    __syncthreads();
    for (int it = C.vcu; it < 2 * 96; it += C.G) {
        const int l = it / 96, cb = it % 96, kp = C.wave, n = cb * 64 + C.lane;
        const float* W = I.ada_w + (size_t)l * 1024 * 6144 + n;
        float a0 = 0.f, a1 = 0.f;
#pragma unroll 8
        for (int k = kp * 128; k < kp * 128 + 128; ++k) {
            const float w = W[(size_t)k * 6144]; const float c0 = I.c[k], c1 = I.c[1024 + k];
            a0 += pg8::silu_f(c0) * w; a1 += pg8::silu_f(c1) * w;
        }
        LAS float* red = (LAS float*)(C.lds + RING_OFF);
        red[(kp * 2 + 0) * 64 + C.lane] = a0; red[(kp * 2 + 1) * 64 + C.lane] = a1;
        __syncthreads();
        if (C.wave < 2) { float s = I.ada_b[l * 6144 + n];
#pragma unroll
            for (int q = 0; q < 8; ++q) s += red[(q * 2 + C.wave) * 64 + C.lane];
            mod[(size_t)(l * 2 + C.wave) * 6144 + n] = s; }
        __syncthreads();
    }
    unsigned* trg = (unsigned*)(C.ws + WS_COS);
    typedef _Float16 ph2_t __attribute__((ext_vector_type(2)));
    for (int it = gw; it < TT / 2; it += NGW) {
        const int row = 2 * it + (C.lane >> 5), f0 = (C.lane & 31) * 4; const float p = (float)I.pos[row];
        u32x4 tv;
#pragma unroll
        for (int j = 0; j < 4; ++j) { const int f = f0 + j; double w = 1.0, bs = 0.93057204092969898;
#pragma unroll
            for (int bit = 0; bit < 7; ++bit) { if ((f >> bit) & 1) w *= bs; bs *= bs; }
            const float ang = p * (float)w; const double r = (double)ang * 0.15915494309189535; const float fr = (float)(r - floor(r));
            const unsigned clo_ = __builtin_bit_cast(unsigned short, (_Float16)__builtin_amdgcn_cosf(fr)), shi_ = __builtin_bit_cast(unsigned short, (_Float16)__builtin_amdgcn_sinf(fr)); tv[j] = clo_ | (shi_ << 16); }
        *(u32x4*)(trg + (size_t)row * 128 + f0) = tv;
    }
}
template <int SKIP = 0> DI void side_work(const Ctx& C, const P0In& I, int sidx, int nside) {
    LAS float* scr = (LAS float*)(C.lds + RING_OFF + C.wave * 16384);
    const int gw = sidx * NWAVES + C.wave, NGW = nside * NWAVES;
    bf16* wsi = (bf16*)(C.ws + WS_WSI); bf16* wso = (bf16*)(C.ws + WS_WSO); bf16* wq = (bf16*)(C.ws + WS_WQ);
    constexpr int I_SI = 16 * 192, I_SO = 48 * 32, I_Q = 16 * 64;
    constexpr int NITEMS = I_SI + I_SO + 2 * I_Q;
    if (!(SKIP & 1))
    for (int it = gw; it < NITEMS; it += NGW) {
        int r = it;
        if (r < I_SI) { p0_transpose_item(I.sgu_w_in, 1024, 6144, wsi, 0, scr, r, C.lane); continue; } r -= I_SI;
        if (r < I_SO) { p0_transpose_item(I.sgu_w_out, 3072, 1024, wso, 0, scr, r, C.lane); continue; } r -= I_SO;
        if (r < I_Q) { p0_transpose_item(I.wq, 1024, 2048, wq, 0, scr, r, C.lane); continue; } r -= I_Q;
        p0_transpose_item(I.wq + (size_t)1024 * 2048, 1024, 2048, wq + (size_t)2048 * 1024, 0, scr, r, C.lane);
    }
    if (!(SKIP & 2))
    cvt_rows_i8(I.pu, (unsigned char*)(C.ws + WS_PU), (float*)(C.ws + WS_ISU), 2 * 16384, gw, NGW, C.lane);
    if (!(SKIP & 4))
    cvt_rows_fp8(I.pv, (unsigned char*)(C.ws + WS_PV), (float*)(C.ws + WS_ISV), 2 * 16384, gw, NGW, C.lane);
}
DI void rms_mod_row(const float* xrow, const float* gain, const float* shift, const float* scale, bf16* orow, int lane) {
    const f32x4* xr = (const f32x4*)xrow + lane; f32x4 v[4]; float s = 0.f;
#pragma unroll
    for (int j = 0; j < 4; ++j) { v[j] = xr[64 * j]; s += (v[j].x * v[j].x + v[j].y * v[j].y) + (v[j].z * v[j].z + v[j].w * v[j].w); }
    const float rstd = 1.0f / sqrtf(wave_sum(s) * (1.0f / 1024.0f) + EPS);
    uint2* o8 = (uint2*)orow + lane;
#pragma unroll
    for (int j = 0; j < 4; ++j) { const f32x4 g = ((const f32x4*)gain)[lane + 64 * j], sh = ((const f32x4*)shift)[lane + 64 * j], sc = ((const f32x4*)scale)[lane + 64 * j];
        const f32x4 y = v[j] * rstd * g * (sc + 1.0f) + sh; uint2 o; o.x = pk2(y.x, y.y); o.y = pk2(y.z, y.w); o8[64 * j] = o; }
}
DI void rms_mod_row_b(const bf16* xrow, const float* gain, const float* shift, const float* scale, bf16* orow, int lane) {
    const uint2* xr = (const uint2*)xrow + lane; f32x4 v[4]; float s = 0.f;
#pragma unroll
    for (int j = 0; j < 4; ++j) { const uint2 w = xr[64 * j]; v[j].x = __uint_as_float(w.x << 16); v[j].y = __uint_as_float(w.x & 0xffff0000u); v[j].z = __uint_as_float(w.y << 16); v[j].w = __uint_as_float(w.y & 0xffff0000u);
        s += (v[j].x * v[j].x + v[j].y * v[j].y) + (v[j].z * v[j].z + v[j].w * v[j].w); }
    const float rstd = 1.0f / sqrtf(wave_sum(s) * (1.0f / 1024.0f) + EPS);
    uint2* o8 = (uint2*)orow + lane;
#pragma unroll
    for (int j = 0; j < 4; ++j) { const f32x4 g = ((const f32x4*)gain)[lane + 64 * j], sh = ((const f32x4*)shift)[lane + 64 * j], sc = ((const f32x4*)scale)[lane + 64 * j];
        const f32x4 y = v[j] * rstd * g * (sc + 1.0f) + sh; uint2 o; o.x = pk2(y.x, y.y); o.y = pk2(y.z, y.w); o8[64 * j] = o; }
}
DI void rms_mod_phase_b(const Ctx& C, const bf16* x, const float* gain, const float* mod_l, int sh_off, int sc_off, bf16* H) {
    const int gw = C.vcu * NWAVES + C.wave, NGW = C.G * NWAVES;
    for (int m = gw; m < TT; m += NGW) { const float* ml = mod_l + (size_t)(m >> 13) * 6144; rms_mod_row_b(x + (size_t)m * DM, gain, ml + sh_off, ml + sc_off, H + (size_t)m * DM, C.lane); }
}
DI void rms_mod_phase(const Ctx& C, const float* x, const float* gain, const float* mod_l, int sh_off, int sc_off, bf16* H) {
    const int gw = C.vcu * NWAVES + C.wave, NGW = C.G * NWAVES;
    for (int m = gw; m < TT; m += NGW) { const float* ml = mod_l + (size_t)(m >> 13) * 6144; rms_mod_row(x + (size_t)m * DM, gain, ml + sh_off, ml + sc_off, H + (size_t)m * DM, C.lane); }
}

DI void scan_naive(const Ctx& C, const bf16* Q, const bf16* K, const bf16* V, bf16* CROSS) {
    LAS float* Sst = (LAS float*)(C.lds);
    LAS unsigned* Qs = (LAS unsigned*)(C.lds + 16384);
    LAS bf16* Ks = (LAS bf16*)(C.lds + 16384 + 32768);
    LAS float* Vs = (LAS float*)(C.lds + 16384 + 65536);
    const int tid = C.tid;
    for (int item = C.vcu; item < 256; item += C.G) {
        const int b = item >> 7, h = (item >> 5) & 3, es = item & 31;
        const float lg2 = log2f(1.0f - exp2f(-5.0f - (float)h)); const float gc = exp2f(lg2 * 64.0f);
        for (int i = tid; i < 4096; i += 512) Sst[i] = 0.f;
        __syncthreads();
        for (int n = 0; n < 128; ++n) {
            const size_t tok0 = (size_t)b * SEQ + (size_t)n * 64;
            for (int ch = tid; ch < 2048; ch += 512) { const int r = ch >> 5, c = ch & 31;
                const u32x4 q = *(const u32x4*)(Q + (tok0 + r) * 1024 + h * 256 + c * 8); *(LAS u32x4*)(Qs + r * 128 + c * 4) = q;
                const u32x4 k = *(const u32x4*)(K + (tok0 + r) * 1024 + h * 256 + c * 8); *(LAS u32x4*)((LAS unsigned*)Ks + r * 128 + c * 4) = k; }
            for (int o = tid; o < 1024; o += 512) { const int j = o >> 4, e = o & 15; Vs[o] = bf2f(V[(tok0 + j) * 2048 + h * 512 + es * 16 + e]) * exp2f(lg2 * (float)(63 - j)); }
            __syncthreads();
#pragma unroll
            for (int oo = 0; oo < 2; ++oo) { const int o = tid + oo * 512, i = o >> 4, e = o & 15; float acc = 0.f;
#pragma unroll 8
                for (int d2 = 0; d2 < 128; ++d2) { const unsigned q2 = Qs[i * 128 + d2]; acc += bflo(q2) * Sst[(2 * d2) * 16 + e] + bfhi(q2) * Sst[(2 * d2 + 1) * 16 + e]; }
                CROSS[(tok0 + i) * 2048 + h * 512 + es * 16 + e] = (bf16)f2bf(acc * exp2f(lg2 * (float)(i + 1))); }
            __syncthreads();
            { const int e = tid & 15, dg = tid >> 4; float a[8];
#pragma unroll
              for (int r = 0; r < 8; ++r) a[r] = gc * Sst[(dg + 32 * r) * 16 + e];
#pragma unroll 4
              for (int j = 0; j < 64; ++j) { const float vz = Vs[j * 16 + e];
#pragma unroll
                  for (int r = 0; r < 8; ++r) a[r] += bf2f(Ks[j * 256 + dg + 32 * r]) * vz; }
#pragma unroll
              for (int r = 0; r < 8; ++r) Sst[(dg + 32 * r) * 16 + e] = a[r]; }
            __syncthreads();
        }
    }
}
DI void intra_naive(const Ctx& C, const bf16* Q, const bf16* K, const bf16* V, const bf16* CROSS, bf16* G) {
    LAS unsigned* Qs = (LAS unsigned*)(C.lds);
    LAS unsigned* Ks = (LAS unsigned*)(C.lds + 32768);
    LAS float* SC = (LAS float*)(C.lds + 65536);
    LAS float* red = (LAS float*)(C.lds + 65536 + 16384);
    LAS float* rs = red + 512;
    const int tid = C.tid;
    for (int item = C.vcu; item < 1024; item += C.G) {
        const int b = item >> 9, h = (item >> 7) & 3, n = item & 127;
        const float lg2 = log2f(1.0f - exp2f(-5.0f - (float)h));
        const size_t tok0 = (size_t)b * SEQ + (size_t)n * 64;
        for (int ch = tid; ch < 2048; ch += 512) { const int r = ch >> 5, c = ch & 31;
            *(LAS u32x4*)(Qs + r * 128 + c * 4) = *(const u32x4*)(Q + (tok0 + r) * 1024 + h * 256 + c * 8);
            *(LAS u32x4*)(Ks + r * 128 + c * 4) = *(const u32x4*)(K + (tok0 + r) * 1024 + h * 256 + c * 8); }
        __syncthreads();
        { const int i = tid >> 3, jb = (tid & 7) * 8;
#pragma unroll
          for (int jj = 0; jj < 8; ++jj) { const int j = jb + jj; float acc = 0.f;
#pragma unroll 8
              for (int d2 = 0; d2 < 128; ++d2) { const unsigned q2 = Qs[i * 128 + d2], k2 = Ks[j * 128 + d2]; acc += bflo(q2) * bflo(k2) + bfhi(q2) * bfhi(k2); }
              const int dd = i > j ? i - j : j - i; SC[i * 64 + j] = acc * exp2f(lg2 * (float)dd); } }
        __syncthreads();
#pragma unroll 1
        for (int pass = 0; pass < 2; ++pass) { const int e = tid, ib = pass * 32; float y[32];
#pragma unroll
          for (int i = 0; i < 32; ++i) y[i] = 0.f;
          const bf16* vp = V + tok0 * 2048 + h * 512 + e;
#pragma unroll 1
          for (int j4 = 0; j4 < 16; ++j4) {
              const float v0 = bf2f(vp[(size_t)(4 * j4 + 0) * 2048]), v1 = bf2f(vp[(size_t)(4 * j4 + 1) * 2048]), v2 = bf2f(vp[(size_t)(4 * j4 + 2) * 2048]), v3 = bf2f(vp[(size_t)(4 * j4 + 3) * 2048]);
#pragma unroll
              for (int i = 0; i < 32; ++i) { const f32x4 s4 = *(const LAS f32x4*)(SC + (ib + i) * 64 + 4 * j4); y[i] += (s4.x * v0 + s4.y * v1) + (s4.z * v2 + s4.w * v3); }
          }
          const bf16* cp = CROSS + (tok0 + ib) * 2048 + h * 512 + e;
#pragma unroll
          for (int i = 0; i < 32; ++i) { y[i] += bf2f(cp[(size_t)i * 2048]); const float ss = wave_sum(y[i] * y[i]); if (C.lane == 0) red[C.wave * 64 + i] = ss; }
          __syncthreads();
          if (tid < 32) { float s = 0.f;
#pragma unroll
              for (int w = 0; w < 8; ++w) s += red[w * 64 + tid];
              rs[tid] = 1.0f / sqrtf(s * (1.0f / 512.0f) + EPS); }
          __syncthreads();
          bf16* gp = G + (tok0 + ib) * 2048 + h * 512 + e;
#pragma unroll
          for (int i = 0; i < 32; ++i) { const float g = bf2f(gp[(size_t)i * 2048]); gp[(size_t)i * 2048] = (bf16)f2bf(y[i] * rs[i] * g); }
          __syncthreads();
        }
        __syncthreads();
    }
}
DI void peer_scores(const Ctx& C, const bf16* QP, const bf16* KEYS  , float* SCO) {
    const int gw = C.vcu * NWAVES + C.wave, NGW = C.G * NWAVES; const int fr = C.lane & 15, fq = C.lane >> 4;
    for (int it = gw; it < 1024 * 8; it += NGW) {
        const int tt = it >> 3, h = it & 7; const int tok = tt * 16 + fr;
#pragma unroll
        for (int p = 0; p < 2; ++p) {
            bf16x8 qf[4];
#pragma unroll
            for (int ks = 0; ks < 4; ++ks) qf[ks] = *(const bf16x8*)(QP + (size_t)tok * 2048 + h * 256 + p * 128 + ks * 32 + fq * 8);
            const bf16* kb = KEYS + (size_t)(h * 2 + p) * 128 * 128;
#pragma unroll
            for (int kt = 0; kt < 8; ++kt) {
                f32x4 acc = {0.f, 0.f, 0.f, 0.f};
#pragma unroll
                for (int ks = 0; ks < 4; ++ks) { const bf16x8 kf = *(const bf16x8*)(kb + (size_t)(kt * 16 + fr) * 128 + ks * 32 + fq * 8);
                    acc = __builtin_amdgcn_mfma_f32_16x16x32_bf16(kf, qf[ks], acc, 0, 0, 0); }
                *(f32x4*)(SCO + ((size_t)tok * 8 + h) * 256 + p * 128 + kt * 16 + fq * 4) = acc;
            }
        }
    }
}
template <bool HALVES> DI void select16(const float (&v)[4], int lane, bool (&sel)[4], int (&pos)[4]) {
    float mx = fmaxf(fmaxf(v[0], v[1]), fmaxf(v[2], v[3])), mn = fminf(fminf(v[0], v[1]), fminf(v[2], v[3]));
#pragma unroll
    for (int o = 1; o < (HALVES ? 32 : 64); o <<= 1) { mx = fmaxf(mx, __shfl_xor(mx, o)); mn = fminf(mn, __shfl_xor(mn, o)); }
    const bool up = HALVES && lane >= 32;
    float lo = mn, hi = mx, thr = mn; bool done = false;
    for (int iter = 0; iter < 48; ++iter) {
        const float mid = done ? thr : 0.5f * (lo + hi);
        int cnt = 0;
#pragma unroll
        for (int c = 0; c < 4; ++c) { const unsigned long long m = __ballot(v[c] >= mid);
            cnt += HALVES ? (up ? __popc((unsigned)(m >> 32)) : __popc((unsigned)m)) : __popcll(m); }
        if (!done) { if (cnt == 16) { thr = mid; done = true; } else if (cnt > 16) { lo = mid; thr = mid; } else hi = mid; }
        if (__all(done)) break;
    }
    int base = 0;
#pragma unroll
    for (int c = 0; c < 4; ++c) { sel[c] = v[c] >= thr; const unsigned long long m = __ballot(sel[c]);
        const unsigned long long gm = HALVES ? (up ? (m >> 32) : (m & 0xffffffffull)) : m; const int ll = HALVES ? (lane & 31) : lane;
        pos[c] = base + __popcll(gm & ((1ull << ll) - 1ull)); base += __popcll(gm); sel[c] = sel[c] && pos[c] < 16; }
}
DI void peer_topk(const Ctx& C, const float* SCO, int* IDX, float* GATE) {
    LAS float* sv = (LAS float*)(C.lds + C.wave * 512);
    LAS int* si = (LAS int*)(C.lds + C.wave * 512 + 128);
    LAS float* fv = (LAS float*)(C.lds + C.wave * 512 + 256);
    LAS int* fi = (LAS int*)(C.lds + C.wave * 512 + 320);
    const int gw = C.vcu * NWAVES + C.wave, NGW = C.G * NWAVES, lane = C.lane;
    for (int it = gw; it < TT * 8; it += NGW) {
        const f32x4 s4 = *(const f32x4*)(SCO + (size_t)it * 256 + lane * 4);
        float v[4] = {s4.x, s4.y, s4.z, s4.w}; bool sel[4]; int pos[4];
        select16<true>(v, lane, sel, pos);
        const int p = lane >> 5;
#pragma unroll
        for (int c = 0; c < 4; ++c) if (sel[c]) { sv[p * 16 + pos[c]] = v[c]; si[p * 16 + pos[c]] = (lane & 31) * 4 + c; }
        LDS_WAIT();
        const int a = lane >> 2, bq = (lane & 3) * 4; const float va = sv[a]; const int ia = si[a];
        float w[4]; int wi[4];
#pragma unroll
        for (int c = 0; c < 4; ++c) { w[c] = va + sv[16 + bq + c]; wi[c] = ia * 128 + si[16 + bq + c]; }
        select16<false>(w, lane, sel, pos);
#pragma unroll
        for (int c = 0; c < 4; ++c) if (sel[c]) { fv[pos[c]] = w[c]; fi[pos[c]] = wi[c]; }
        LDS_WAIT();
        const float x = fv[lane & 15]; const int xi = fi[lane & 15];
        float m = x;
#pragma unroll
        for (int o = 1; o < 16; o <<= 1) m = fmaxf(m, __shfl_xor(m, o));
        const float e = __expf(x - m); float s = e;
#pragma unroll
        for (int o = 1; o < 16; o <<= 1) s += __shfl_xor(s, o);
        if (lane < 16) { IDX[(size_t)it * 16 + lane] = xi; GATE[(size_t)it * 16 + lane] = e / s; }
        LDS_WAIT();
    }
}
template <bool FINAL> DI void peer_gather(const Ctx& C, const bf16* H, const int* IDX, const float* GATE, const bf16* PU, const bf16* PV, float* X, const float* g2  ,
                                          const float* ngain, const float* nmod  , bf16* Hn) {
    const int gw = C.vcu * NWAVES + C.wave, NGW = C.G * NWAVES, lane = C.lane;
    for (int t = gw; t < TT; t += NGW) {
        float hv[16];
        { const u32x4 a = *(const u32x4*)(H + (size_t)t * 1024 + lane * 8), bq = *(const u32x4*)(H + (size_t)t * 1024 + 512 + lane * 8);
          hv[0] = bflo(a.x); hv[1] = bfhi(a.x); hv[2] = bflo(a.y); hv[3] = bfhi(a.y); hv[4] = bflo(a.z); hv[5] = bfhi(a.z); hv[6] = bflo(a.w); hv[7] = bfhi(a.w);
          hv[8] = bflo(bq.x); hv[9] = bfhi(bq.x); hv[10] = bflo(bq.y); hv[11] = bfhi(bq.y); hv[12] = bflo(bq.z); hv[13] = bfhi(bq.z); hv[14] = bflo(bq.w); hv[15] = bfhi(bq.w); }
        const int i0 = IDX[(size_t)t * 128 + lane], i1 = IDX[(size_t)t * 128 + 64 + lane];
        const float g0 = GATE[(size_t)t * 128 + lane], g1 = GATE[(size_t)t * 128 + 64 + lane];
        float a0 = 0.f, a1 = 0.f;
        for (int k = 0; k < 128; k += 4) {
            float dsum[4];
#pragma unroll
            for (int kk = 0; kk < 4; ++kk) { const int kq = k + kk; const int e = kq < 64 ? __builtin_amdgcn_readlane(i0, kq) : __builtin_amdgcn_readlane(i1, kq - 64);
                const bf16* ur = PU + (size_t)e * 1024; const u32x4 a = *(const u32x4*)(ur + lane * 8), bq = *(const u32x4*)(ur + 512 + lane * 8);
                float d = bflo(a.x) * hv[0] + bfhi(a.x) * hv[1]; d += bflo(a.y) * hv[2] + bfhi(a.y) * hv[3]; d += bflo(a.z) * hv[4] + bfhi(a.z) * hv[5]; d += bflo(a.w) * hv[6] + bfhi(a.w) * hv[7];
                d += bflo(bq.x) * hv[8] + bfhi(bq.x) * hv[9]; d += bflo(bq.y) * hv[10] + bfhi(bq.y) * hv[11]; d += bflo(bq.z) * hv[12] + bfhi(bq.z) * hv[13]; d += bflo(bq.w) * hv[14] + bfhi(bq.w) * hv[15];
                dsum[kk] = d; }
#pragma unroll
            for (int kk = 0; kk < 4; ++kk) { const int kq = k + kk; const float d = gelu_t(wave_sum(dsum[kk]));
                if (kq < 64) { if (lane == kq) a0 = d * g0; } else { if (lane == kq - 64) a1 = d * g1; } }
        }
        float o[16];
#pragma unroll
        for (int j = 0; j < 16; ++j) o[j] = 0.f;
        for (int k = 0; k < 128; k += 4) {
#pragma unroll
            for (int kk = 0; kk < 4; ++kk) { const int kq = k + kk; const int e = kq < 64 ? __builtin_amdgcn_readlane(i0, kq) : __builtin_amdgcn_readlane(i1, kq - 64);
                const float ak = __int_as_float(kq < 64 ? __builtin_amdgcn_readlane(__float_as_int(a0), kq) : __builtin_amdgcn_readlane(__float_as_int(a1), kq - 64));
                const bf16* vr = PV + (size_t)e * 1024; const u32x4 a = *(const u32x4*)(vr + lane * 8), bq = *(const u32x4*)(vr + 512 + lane * 8);
                o[0] += ak * bflo(a.x); o[1] += ak * bfhi(a.x); o[2] += ak * bflo(a.y); o[3] += ak * bfhi(a.y); o[4] += ak * bflo(a.z); o[5] += ak * bfhi(a.z); o[6] += ak * bflo(a.w); o[7] += ak * bfhi(a.w);
                o[8] += ak * bflo(bq.x); o[9] += ak * bfhi(bq.x); o[10] += ak * bflo(bq.y); o[11] += ak * bfhi(bq.y); o[12] += ak * bflo(bq.z); o[13] += ak * bfhi(bq.z); o[14] += ak * bflo(bq.w); o[15] += ak * bfhi(bq.w); }
        }
#ifdef DBG_ZERO_PEER
#pragma unroll
        for (int j = 0; j < 16; ++j) o[j] = 0.f;
#endif
        const int b = t >> 13; const float* gp = g2 + (size_t)b * 6144; float* xr = X + (size_t)t * 1024;
        float xn[16]; float ss = 0.f;
#pragma unroll
        for (int q = 0; q < 4; ++q) { const int col = (q >> 1) * 512 + lane * 8 + (q & 1) * 4; const f32x4 xv = *(const f32x4*)(xr + col), gv = *(const f32x4*)(gp + col);
#pragma unroll
            for (int j = 0; j < 4; ++j) { const float y = xv[j] + gv[j] * o[q * 4 + j]; xn[q * 4 + j] = y; ss += y * y; } }
        const float rstd = 1.0f / sqrtf(wave_sum(ss) * (1.0f / 1024.0f) + EPS);
        if (FINAL) {
#pragma unroll
            for (int q = 0; q < 4; ++q) { const int col = (q >> 1) * 512 + lane * 8 + (q & 1) * 4; const f32x4 gn = *(const f32x4*)(ngain + col); f32x4 y;
#pragma unroll
                for (int j = 0; j < 4; ++j) y[j] = xn[q * 4 + j] * rstd * gn[j];
                *(f32x4*)(xr + col) = y; }
        } else {
            const float* nm = nmod + (size_t)b * 6144;
#pragma unroll
            for (int q = 0; q < 4; ++q) { const int col = (q >> 1) * 512 + lane * 8 + (q & 1) * 4; const f32x4 gn = *(const f32x4*)(ngain + col), sh = *(const f32x4*)(nm + col), sc = *(const f32x4*)(nm + 1024 + col); f32x4 xo; float y[4];
#pragma unroll
                for (int j = 0; j < 4; ++j) { xo[j] = xn[q * 4 + j]; y[j] = xn[q * 4 + j] * rstd * gn[j] * (1.0f + sc[j]) + sh[j]; }
                *(f32x4*)(xr + col) = xo; uint2 w; w.x = pk2(y[0], y[1]); w.y = pk2(y[2], y[3]); *(uint2*)(Hn + (size_t)t * 1024 + col) = w; }
        }
    }
}
DI void sgu_gate_naive(const Ctx& C, bf16* U, const bf16* VB, const float* stats, const float* w_s, const float* b_s, const float* ln_g, const float* ln_b) {
    LAS float* Wm = (LAS float*)(C.lds);
    LAS float* mu = (LAS float*)(C.lds + 65536);
    LAS float* rsd = mu + 128;
    const int tid = C.tid;
    for (int item = C.vcu; item < 1024; item += C.G) {
        const int n = item >> 3, g = item & 7; const size_t row0 = (size_t)n * 128;
        for (int i = tid; i < 16384; i += 512) { const int r = i >> 7, c = i & 127; const float w = w_s[(size_t)g * 16384 + i]; Wm[i] = (r < 64 && c >= 64) ? 0.f : w; }
        if (tid < 128) { const float* sp = stats + (row0 + tid) * 96; float s1 = 0.f, s2 = 0.f;
            for (int q = 0; q < 48; ++q) { s1 += sp[2 * q]; s2 += sp[2 * q + 1]; }
            const float m = s1 * (1.0f / 3072.0f); const float var = s2 * (1.0f / 3072.0f) - m * m; mu[tid] = m; rsd[tid] = 1.0f / sqrtf(fmaxf(var, 0.f) + EPS); }
        __syncthreads();
        if (tid < 384) {
            const int col = g * 384 + tid; const float lg = ln_g[col], lb = ln_b[col];
#pragma unroll
            for (int pass = 0; pass < 2; ++pass) {
                float acc[64];
#pragma unroll
                for (int i = 0; i < 64; ++i) acc[i] = 0.f;
                const int jmax = pass == 0 ? 64 : 128;
                for (int j = 0; j < jmax; ++j) { const float v = bf2f(VB[(row0 + j) * 3072 + col]); const float vl = (v - mu[j]) * rsd[j] * lg + lb;
#pragma unroll
                    for (int i = 0; i < 64; ++i) acc[i] += Wm[(pass * 64 + i) * 128 + j] * vl; }
#pragma unroll
                for (int i = 0; i < 64; ++i) { const int r = pass * 64 + i; const float s = acc[i] + b_s[g * 128 + r]; bf16* up = U + (row0 + r) * 3072 + col; *up = (bf16)f2bf(bf2f(*up) * s); }
            }
        }
        __syncthreads();
    }
}
typedef short v4i16_t __attribute__((ext_vector_type(4)));
typedef unsigned u32x2_t __attribute__((ext_vector_type(2)));
typedef __bf16 bf16x2_t __attribute__((ext_vector_type(2)));
DI unsigned cvtpk(float lo, float hi) { f32x2_t v = {lo, hi}; bf16x2_t b = __builtin_convertvector(v, bf16x2_t); return __builtin_bit_cast(unsigned, b); }
DI v4i16_t trr(const LAS unsigned char* p) { return __builtin_amdgcn_ds_read_tr16_b64_v4i16((LAS v4i16_t*)p); }
DI bf16x8 cat8(v4i16_t a, v4i16_t b) { return __builtin_shufflevector(a, b, 0, 1, 2, 3, 4, 5, 6, 7); }
DI bf16x8 pack2(const f32x4& a, const f32x4& b) { u32x4 p; p.x = cvtpk(a[0], a[1]); p.y = cvtpk(a[2], a[3]); p.z = cvtpk(b[0], b[1]); p.w = cvtpk(b[2], b[3]); return __builtin_bit_cast(bf16x8, p); }
DI u32x4 scale8(u32x4 v, float s) { u32x4 o; o.x = cvtpk(bflo(v.x) * s, bfhi(v.x) * s); o.y = cvtpk(bflo(v.y) * s, bfhi(v.y) * s); o.z = cvtpk(bflo(v.z) * s, bfhi(v.z) * s); o.w = cvtpk(bflo(v.w) * s, bfhi(v.w) * s); return o; }
#ifndef SCAN_QPI
#define SCAN_QPI 544
#endif
#ifndef SCAN_KPI
#define SCAN_KPI 544
#endif
#ifndef SCAN_PFD
#define SCAN_PFD 5
#endif
constexpr int SCAN_ESL = 32, SCAN_NCW = SCAN_ESL / 16, SCAN_NSL = 512 / SCAN_ESL, SCAN_NIT = 8 * SCAN_NSL;
#define SCAN_BAR() do { asm volatile("s_waitcnt lgkmcnt(0)" ::: "memory"); __builtin_amdgcn_s_barrier(); asm volatile("" ::: "memory"); } while (0)
template <int MODE = 0> DI void scan_mfma(const Ctx& C, const bf16* Q, const bf16* K, const bf16* V, bf16* CROSS, int item0, int istride) {
    constexpr int QPI = SCAN_QPI, KPI = SCAN_KPI, VPI = SCAN_ESL * 2 + 32, VCH = SCAN_ESL / 8  , NVC = 64 * VCH;
    constexpr int OQ = 0, OK_ = 64 * QPI, OV = OK_ + 64 * KPI, BUFB = OV + 64 * VPI;
    constexpr int NST = (NWAVES - 1 - SCAN_NCW) * 64;
    const int w = C.wave;
    for (int item = item0; item < SCAN_NIT; item += istride) {
        const int b = item / (4 * SCAN_NSL), h = (item / SCAN_NSL) & 3, es = item % SCAN_NSL;
        const float lg2 = log2f(1.0f - exp2f(-5.0f - (float)h)); const float gc = exp2f(lg2 * 64.0f);
        const size_t tokb = (size_t)b * SEQ;
        if (w >= SCAN_NCW) {
            int tl_ = C.tid; asm volatile("" : "+v"(tl_));
            const int st = (w == NWAVES - 1) ? (tl_ & 63) : tl_ - SCAN_NCW * 64;
            if (w == NWAVES - 1) {
                unsigned dmy = 0u;
#define SCAN_PF1(ptr) asm volatile("global_load_dword %0, %1, off" : "+v"(dmy) : "v"(ptr) : "memory")
#define SCAN_PF(n) do { const size_t t0_ = tokb + (size_t)(n) * 64; \
                if ((es & 3) == 0) { _Pragma("unroll") for (int u = 0; u < 4; ++u) { const int ln = st + 64 * u, r = ln >> 2, q = ln & 3; SCAN_PF1(Q + (t0_ + r) * 1024 + h * 256 + q * 64); SCAN_PF1(K + (t0_ + r) * 1024 + h * 256 + q * 64); } } \
                SCAN_PF1(V + (t0_ + st) * 2048 + h * 512 + es * SCAN_ESL); } while (0)
#ifndef SCAN_NOPF
                SCAN_PF(3); SCAN_PF(4);
#endif
                SCAN_BAR();
#pragma unroll 1
                for (int n = 0; n < 128; ++n) {
#ifndef SCAN_NOPF
                    if (n + SCAN_PFD < 128) SCAN_PF(n + SCAN_PFD);
#endif
                    SCAN_BAR(); }
                asm volatile("s_waitcnt vmcnt(0)" : "+v"(dmy) :: "memory");
#undef SCAN_PF
#undef SCAN_PF1
            } else {
            u32x4 rqA[7], rkA[7], rvA, rqB[7], rkB[7], rvB;
            const unsigned qo_ = (unsigned)((st >> 5) * 2048 + (st & 31) * 16), qo6_ = (st + NST * 6 < 2048) ? qo_ + (unsigned)(6 * (NST / 32) * 2048) : qo_;
            const unsigned vo_ = (st < NVC) ? (unsigned)((st / VCH) * 4096 + (st % VCH) * 16) : 0u;
#define SCAN_LD(RQ, RK, RV, n) do { const size_t t0_ = tokb + (size_t)((n) < 127 ? (n) : 127) * 64; \
            const unsigned char* qb_ = (const unsigned char*)(Q + t0_ * 1024 + h * 256); const unsigned char* kb_ = (const unsigned char*)(K + t0_ * 1024 + h * 256); \
            const unsigned char* vb_ = (const unsigned char*)(V + t0_ * 2048 + h * 512 + es * SCAN_ESL); \
            _Pragma("unroll") for (int u = 0; u < 7; ++u) { const unsigned o_ = u == 6 ? qo6_ : qo_ + (unsigned)(u * (NST / 32) * 2048); \
                RQ[u] = *(const u32x4*)(qb_ + o_); RK[u] = *(const u32x4*)(kb_ + o_); } \
            RV = *(const u32x4*)(vb_ + vo_); } while (0)
#define SCAN_WR(RQ, RK, RV, bufo) do { LAS unsigned char* B_ = C.lds + (bufo); \
            _Pragma("unroll") for (int u = 0; u < 7; ++u) { const int c = st + NST * u; if (c < 2048) { const int r = c >> 5, cc = c & 31; \
                *(LAS u32x4*)(B_ + OQ + r * QPI + cc * 16) = RQ[u]; *(LAS u32x4*)(B_ + OK_ + r * KPI + cc * 16) = RK[u]; } } \
            if (st < NVC) { const int r = st / VCH, cc = st % VCH; *(LAS u32x4*)(B_ + OV + r * VPI + cc * 16) = scale8(RV, exp2f(lg2 * (float)(63 - r))); } } while (0)
            SCAN_LD(rqA, rkA, rvA, 0); SCAN_WR(rqA, rkA, rvA, 0); SCAN_LD(rqA, rkA, rvA, 1); SCAN_LD(rqB, rkB, rvB, 2);
            SCAN_BAR();
#pragma unroll 1
            for (int n = 0; n < 128; n += 2) {
                if (MODE != 2) { SCAN_WR(rqA, rkA, rvA, BUFB); SCAN_LD(rqA, rkA, rvA, n + 3); }
                SCAN_BAR();
                if (MODE != 2) { SCAN_WR(rqB, rkB, rvB, 0); SCAN_LD(rqB, rkB, rvB, n + 4); }
                SCAN_BAR();
            }
#undef SCAN_LD
#undef SCAN_WR
            }
        } else {
            int tl_ = C.tid; asm volatile("" : "+v"(tl_)); const int lane = tl_ & 63, fr = lane & 15, fq = lane >> 4;
            f32x4 S[16];
#pragma unroll
            for (int t = 0; t < 16; ++t) S[t] = (f32x4){0.f, 0.f, 0.f, 0.f};
            SCAN_BAR();
#define SC_LQ(QF, DB) do { _Pragma("unroll") for (int m = 0; m < 4; ++m) QF[m] = *(const LAS bf16x8*)(Qs + (16 * m + fr) * QPI + (32 * (DB) + 8 * fq) * 2); __builtin_amdgcn_sched_barrier(0); } while (0)
#define SC_MQ(QF, DB) do { const bf16x8 sa0 = pack2(S[2 * (DB)], S[2 * (DB) + 1]); \
            _Pragma("unroll") for (int m = 0; m < 4; ++m) acc[m] = __builtin_amdgcn_mfma_f32_16x16x32_bf16(sa0, QF[m], acc[m], 0, 0, 0); __builtin_amdgcn_sched_barrier(0); } while (0)
#define SC_LK(KF, KS, TQ) do { const LAS unsigned char* kp = Ks + (32 * (KS) + 4 * fq + (fr >> 2)) * KPI + (8 * (fr & 3)) * 2;     \
            _Pragma("unroll") for (int t4 = 0; t4 < 4; ++t4) { const int t = 4 * (TQ) + t4; KF[t4] = cat8(trr(kp + 64 * (t >> 1) + 8 * (t & 1)), trr(kp + 64 * (t >> 1) + 8 * (t & 1) + 16 * KPI)); } __builtin_amdgcn_sched_barrier(0); } while (0)
#define SC_LV(VF, KS) do { const LAS unsigned char* vp = Vs + (32 * (KS) + 4 * fq + (fr >> 2)) * VPI + (16 * w + 4 * (fr & 3)) * 2; VF = cat8(trr(vp), trr(vp + 16 * VPI)); } while (0)
#define SC_MK(KF, VF, TQ) do { _Pragma("unroll") for (int t4 = 0; t4 < 4; ++t4) S[4 * (TQ) + t4] = __builtin_amdgcn_mfma_f32_16x16x32_bf16(KF[t4], VF, S[4 * (TQ) + t4], 0, 0, 0); __builtin_amdgcn_sched_barrier(0); } while (0)
#define SCAN_CHUNK(n_, BO) do { const size_t tok0 = tokb + (size_t)(n_) * 64; LAS unsigned char* Qs = C.lds + (BO) + OQ; LAS unsigned char* Ks = C.lds + (BO) + OK_; LAS unsigned char* Vs = C.lds + (BO) + OV; \
                f32x4 acc[4]; bf16x8 fA[4], fB[4], kA[4], kB[4], vf0, vf1; \
                _Pragma("unroll") for (int m = 0; m < 4; ++m) acc[m] = (f32x4){0.f, 0.f, 0.f, 0.f}; \
                SC_LQ(fA, 0); SC_LQ(fB, 1); SC_MQ(fA, 0); SC_LQ(fA, 2); SC_MQ(fB, 1); SC_LQ(fB, 3); SC_MQ(fA, 2); SC_LQ(fA, 4); SC_MQ(fB, 3); SC_LQ(fB, 5); SC_MQ(fA, 4); SC_LQ(fA, 6); SC_MQ(fB, 5); SC_LQ(fB, 7); SC_MQ(fA, 6); SC_LV(vf0, 0); SC_LV(vf1, 1); SC_LK(kA, 0, 0); SC_MQ(fB, 7); \
                _Pragma("unroll") for (int m = 0; m < 4; ++m) { const f32x4 v = acc[m] * exp2f(lg2 * (float)(16 * m + fr + 1)); uint2 o; o.x = cvtpk(v[0], v[1]); o.y = cvtpk(v[2], v[3]); \
                    *(uint2*)(CROSS + (tok0 + 16 * m + fr) * 2048 + h * 512 + es * SCAN_ESL + 16 * w + 4 * fq) = o; } \
                _Pragma("unroll") for (int t = 0; t < 16; ++t) S[t] = S[t] * gc; \
                __builtin_amdgcn_sched_barrier(0); \
                SC_LK(kB, 0, 1); SC_MK(kA, vf0, 0); SC_LK(kA, 0, 2); SC_MK(kB, vf0, 1); SC_LK(kB, 0, 3); SC_MK(kA, vf0, 2); SC_LK(kA, 1, 0); SC_MK(kB, vf0, 3); SC_LK(kB, 1, 1); SC_MK(kA, vf1, 0); SC_LK(kA, 1, 2); SC_MK(kB, vf1, 1); SC_LK(kB, 1, 3); SC_MK(kA, vf1, 2); SC_MK(kB, vf1, 3); \
                SCAN_BAR(); } while (0)
#pragma unroll 1
            for (int n = 0; n < 128; n += 2) { if (MODE == 1) { SCAN_BAR(); SCAN_BAR(); } else { SCAN_CHUNK(n, 0); SCAN_CHUNK(n + 1, BUFB); } }
#undef SCAN_CHUNK
#undef SC_LQ
#undef SC_MQ
#undef SC_LK
#undef SC_LV
#undef SC_MK
        }
    }
}
#undef SCAN_BAR
DI void sgu_gate_mfma(const Ctx& C, bf16* U, const bf16* VB, const float* stats, const float* w_s, const float* b_s, const float* ln_g, const float* ln_b) {
    constexpr int WPI = 272, VPI = 288;
    LAS unsigned char* Ws = C.lds; LAS unsigned char* Vs = C.lds + 128 * WPI;
    LAS float* mu = (LAS float*)(C.lds + 128 * WPI + 128 * VPI); LAS float* rsd = mu + 128; LAS float* r1 = mu + 256; LAS float* r2 = mu + 384; LAS float* bsl = mu + 512;
    const int tid = C.tid, lane = C.lane, w = C.wave, fr = lane & 15, fq = lane >> 4;
    for (int item = C.vcu; item < 1024; item += C.G) {
        const int n = item >> 3, g = item & 7; const size_t row0 = (size_t)n * 128;
        if (tid < 128) { const float* sp = stats + (row0 + tid) * 96; float s1 = 0.f, s2 = 0.f;
#pragma unroll 8
            for (int q = 0; q < 48; ++q) { s1 += sp[2 * q]; s2 += sp[2 * q + 1]; }
            const float m = s1 * (1.0f / 3072.0f); const float var = s2 * (1.0f / 3072.0f) - m * m; mu[tid] = m; rsd[tid] = 1.0f / sqrtf(fmaxf(var, 0.f) + EPS); bsl[tid] = b_s[g * 128 + tid]; }
        __syncthreads();
        { const int i = tid >> 2, jq = tid & 3; const float* wp = w_s + (size_t)g * 16384 + i * 128 + jq * 32; float a1 = 0.f, a2 = 0.f;
#pragma unroll
          for (int c8 = 0; c8 < 4; ++c8) { const f32x4 wa = *(const f32x4*)(wp + c8 * 8), wb = *(const f32x4*)(wp + c8 * 8 + 4); float wv[8] = {wa[0], wa[1], wa[2], wa[3], wb[0], wb[1], wb[2], wb[3]}; float o[8];
#pragma unroll
              for (int q = 0; q < 8; ++q) { const int j = jq * 32 + c8 * 8 + q; const float wm = (i < 64 && j >= 64) ? 0.f : wv[q]; const float wr_ = wm * rsd[j]; o[q] = wr_; a1 += wr_ * mu[j]; a2 += wm; }
              u32x4 pk; pk.x = cvtpk(o[0], o[1]); pk.y = cvtpk(o[2], o[3]); pk.z = cvtpk(o[4], o[5]); pk.w = cvtpk(o[6], o[7]);
              *(LAS u32x4*)(Ws + i * WPI + (jq * 32 + c8 * 8) * 2) = pk; }
          a1 += __shfl_xor(a1, 1); a1 += __shfl_xor(a1, 2); a2 += __shfl_xor(a2, 1); a2 += __shfl_xor(a2, 2);
          if (jq == 0) { r1[i] = a1; r2[i] = a2; } }
#pragma unroll 1
        for (int cs = 0; cs < 3; ++cs) {
            const int colb = g * 384 + cs * 128;
#pragma unroll
            for (int u = 0; u < 4; ++u) { const int c = tid + 512 * u, r = c >> 4, cc = c & 15;
                *(LAS u32x4*)(Vs + r * VPI + cc * 16) = *(const u32x4*)(VB + (row0 + r) * 3072 + colb + cc * 8); }
            __syncthreads();
            f32x4 acc[8];
#pragma unroll
            for (int it = 0; it < 8; ++it) acc[it] = (f32x4){0.f, 0.f, 0.f, 0.f};
#pragma unroll
            for (int ks = 0; ks < 4; ++ks) {
                const LAS unsigned char* vp = Vs + (32 * ks + 4 * fq + (fr >> 2)) * VPI + (16 * w + 4 * (fr & 3)) * 2;
                const bf16x8 vf = cat8(trr(vp), trr(vp + 16 * VPI));
#pragma unroll
                for (int it = 0; it < 8; ++it) { if (it < 4 && ks >= 2) continue;
                    const LAS unsigned char* wp = Ws + (16 * it + fr) * WPI + (32 * ks + 4 * fq) * 2;
                    const u32x2_t lo = *(const LAS u32x2_t*)wp, hi = *(const LAS u32x2_t*)(wp + 32);
                    u32x4 ww; ww.x = lo.x; ww.y = lo.y; ww.z = hi.x; ww.w = hi.y;
                    acc[it] = __builtin_amdgcn_mfma_f32_16x16x32_bf16(vf, __builtin_bit_cast(bf16x8, ww), acc[it], 0, 0, 0); }
            }
            const int c0 = colb + 16 * w + 4 * fq;
            const f32x4 lg = *(const f32x4*)(ln_g + c0), lb = *(const f32x4*)(ln_b + c0);
#pragma unroll
            for (int it = 0; it < 8; ++it) { const int i = 16 * it + fr; const float q1 = r1[i], q2 = r2[i], bb = bsl[i];
                bf16* up = U + (row0 + i) * 3072 + c0; const u32x2_t uu = *(const u32x2_t*)up;
                const f32x4 s = lg * (acc[it] - q1) + lb * q2 + bb;
                u32x2_t o; o.x = cvtpk(bflo(uu.x) * s[0], bfhi(uu.x) * s[1]); o.y = cvtpk(bflo(uu.y) * s[2], bfhi(uu.y) * s[3]);
                *(u32x2_t*)up = o; }
            __syncthreads();
        }
    }
}
DI void up8(unsigned wd, float& a, float& b, float& c, float& d) { const f32x2_t lo = __builtin_amdgcn_cvt_pk_f32_fp8((int)wd, false), hi = __builtin_amdgcn_cvt_pk_f32_fp8((int)wd, true); a = lo.x; b = lo.y; c = hi.x; d = hi.y; }
DI float dot16(const u32x4 u, const float (&hv)[16]) {
    float f[16];
    up8(u.x, f[0], f[1], f[2], f[3]); up8(u.y, f[4], f[5], f[6], f[7]); up8(u.z, f[8], f[9], f[10], f[11]); up8(u.w, f[12], f[13], f[14], f[15]);
    float d0 = f[0] * hv[0], d1 = f[1] * hv[1];
#pragma unroll
    for (int j = 2; j < 16; j += 2) { d0 += f[j] * hv[j]; d1 += f[j + 1] * hv[j + 1]; }
    return d0 + d1;
}
template <bool FINAL> DI void peer_gather8(const Ctx& C, const bf16* Hin, const int* IDX, const float* GATE, const unsigned char* PU8, const unsigned char* PV8, const float* ISU, const float* ISV,
                                           float* X, const float* g2, const float* ngain, const float* nmod, bf16* Hn) {
    const int gw = C.vcu * NWAVES + C.wave, NGW = C.G * NWAVES, lane = C.lane;
    LAS float* DL = (LAS float*)(C.lds + C.wave * 1024);
    LAS float* AL = DL + 128;
    for (int t = gw; t < TT; t += NGW) {
        float hv[16];
        { const u32x4 a = *(const u32x4*)(Hin + (size_t)t * 1024 + lane * 16), bq = *(const u32x4*)(Hin + (size_t)t * 1024 + lane * 16 + 8);
          hv[0] = bflo(a.x); hv[1] = bfhi(a.x); hv[2] = bflo(a.y); hv[3] = bfhi(a.y); hv[4] = bflo(a.z); hv[5] = bfhi(a.z); hv[6] = bflo(a.w); hv[7] = bfhi(a.w);
          hv[8] = bflo(bq.x); hv[9] = bfhi(bq.x); hv[10] = bflo(bq.y); hv[11] = bfhi(bq.y); hv[12] = bflo(bq.z); hv[13] = bfhi(bq.z); hv[14] = bflo(bq.w); hv[15] = bfhi(bq.w); }
        const int i0 = IDX[(size_t)t * 128 + lane], i1 = IDX[(size_t)t * 128 + 64 + lane];
        const float g0 = GATE[(size_t)t * 128 + lane], g1 = GATE[(size_t)t * 128 + 64 + lane];
        const float su0 = ISU[i0], su1 = ISU[i1], sv0 = ISV[i0], sv1 = ISV[i1];
        u32x4 ub[8];
#define PG_LOADU(k0) do { _Pragma("unroll") for (int j = 0; j < 8; ++j) { const int kq = (k0) + j; const int e = kq < 64 ? __builtin_amdgcn_readlane(i0, kq) : __builtin_amdgcn_readlane(i1, kq - 64); \
            ub[j] = *(const u32x4*)(PU8 + (size_t)e * 1024 + lane * 16); } } while (0)
        PG_LOADU(0);
#pragma unroll 1
        for (int k0 = 0; k0 < 128; k0 += 8) {
            float p[8];
#pragma unroll
            for (int j = 0; j < 8; ++j) p[j] = dot16(ub[j], hv);
            if (k0 + 8 < 128) PG_LOADU(k0 + 8);
            const bool h32 = lane & 32, h16 = lane & 16, h8 = lane & 8;
            float q4[4];
#pragma unroll
            for (int j = 0; j < 4; ++j) { const float keep = h32 ? p[j + 4] : p[j], send = h32 ? p[j] : p[j + 4]; q4[j] = keep + __shfl_xor(send, 32); }
            float q2[2];
#pragma unroll
            for (int j = 0; j < 2; ++j) { const float keep = h16 ? q4[j + 2] : q4[j], send = h16 ? q4[j] : q4[j + 2]; q2[j] = keep + __shfl_xor(send, 16); }
            float q1; { const float keep = h8 ? q2[1] : q2[0], send = h8 ? q2[0] : q2[1]; q1 = keep + __shfl_xor(send, 8); }
            q1 += __shfl_xor(q1, 4); q1 += __shfl_xor(q1, 2); q1 += __shfl_xor(q1, 1);
            if ((lane & 7) == 0) DL[k0 + ((lane >> 5) & 1) * 4 + ((lane >> 4) & 1) * 2 + ((lane >> 3) & 1)] = q1;
        }
#undef PG_LOADU
        LDS_WAIT();
        { const float d0 = DL[lane], d1 = DL[64 + lane]; AL[lane] = gelu_t(d0 * su0) * g0 * sv0; AL[64 + lane] = gelu_t(d1 * su1) * g1 * sv1; }
        LDS_WAIT();
        float o[16];
#pragma unroll
        for (int j = 0; j < 16; ++j) o[j] = 0.f;
        u32x4 vb[8];
#define PG_LOADV(k0) do { _Pragma("unroll") for (int j = 0; j < 8; ++j) { const int kq = (k0) + j; const int e = kq < 64 ? __builtin_amdgcn_readlane(i0, kq) : __builtin_amdgcn_readlane(i1, kq - 64); \
            vb[j] = *(const u32x4*)(PV8 + (size_t)e * 1024 + lane * 16); } } while (0)
        PG_LOADV(0);
#pragma unroll 1
        for (int k0 = 0; k0 < 128; k0 += 8) {
            float f[8][16];
#pragma unroll
            for (int j = 0; j < 8; ++j) { up8(vb[j].x, f[j][0], f[j][1], f[j][2], f[j][3]); up8(vb[j].y, f[j][4], f[j][5], f[j][6], f[j][7]); up8(vb[j].z, f[j][8], f[j][9], f[j][10], f[j][11]); up8(vb[j].w, f[j][12], f[j][13], f[j][14], f[j][15]); }
            if (k0 + 8 < 128) PG_LOADV(k0 + 8);
#pragma unroll
            for (int j = 0; j < 8; ++j) { const float ak = AL[k0 + j];
#pragma unroll
                for (int q = 0; q < 16; ++q) o[q] += ak * f[j][q]; }
        }
#undef PG_LOADV
        const int b = t >> 13; const float* gp = g2 + (size_t)b * 6144; float* xr = X + (size_t)t * 1024;
        float xn[16]; float ss = 0.f;
#pragma unroll
        for (int q = 0; q < 4; ++q) { const int col = lane * 16 + q * 4; const f32x4 xv = *(const f32x4*)(xr + col), gv = *(const f32x4*)(gp + col);
#pragma unroll
            for (int j = 0; j < 4; ++j) { const float y = xv[j] + gv[j] * o[q * 4 + j]; xn[q * 4 + j] = y; ss += y * y; } }
        const float rstd = 1.0f / sqrtf(wave_sum(ss) * (1.0f / 1024.0f) + EPS);
        if (FINAL) {
#pragma unroll
            for (int q = 0; q < 4; ++q) { const int col = lane * 16 + q * 4; const f32x4 gn = *(const f32x4*)(ngain + col); f32x4 y;
#pragma unroll
                for (int j = 0; j < 4; ++j) y[j] = xn[q * 4 + j] * rstd * gn[j];
                *(f32x4*)(xr + col) = y; }
        } else {
            const float* nm = nmod + (size_t)b * 6144;
#pragma unroll
            for (int q = 0; q < 4; ++q) { const int col = lane * 16 + q * 4; const f32x4 gn = *(const f32x4*)(ngain + col), sh = *(const f32x4*)(nm + col), sc = *(const f32x4*)(nm + 1024 + col); f32x4 xo; float y[4];
#pragma unroll
                for (int j = 0; j < 4; ++j) { xo[j] = xn[q * 4 + j]; y[j] = xn[q * 4 + j] * rstd * gn[j] * (1.0f + sc[j]) + sh[j]; }
                *(f32x4*)(xr + col) = xo; u32x2_t wv; wv.x = cvtpk(y[0], y[1]); wv.y = cvtpk(y[2], y[3]); *(u32x2_t*)(Hn + (size_t)t * 1024 + col) = wv; }
        }
    }
}
template <int CTRL> DI float dpp_f(float x) { return __int_as_float(__builtin_amdgcn_update_dpp(0, __float_as_int(x), CTRL, 0xF, 0xF, false)); }
DI float x32(float x) { auto r = __builtin_amdgcn_permlane32_swap(__float_as_uint(x), __float_as_uint(x), false, false); return (threadIdx.x & 32) ? __uint_as_float(r[0]) : __uint_as_float(r[1]); }
DI float x16(float x) { auto r = __builtin_amdgcn_permlane16_swap(__float_as_uint(x), __float_as_uint(x), false, false); return (threadIdx.x & 16) ? __uint_as_float(r[0]) : __uint_as_float(r[1]); }
typedef _Float16 h2_t __attribute__((ext_vector_type(2)));
DI unsigned f2hu(float lo, float hi) { const f32x2_t v = {lo, hi}; const h2_t h = __builtin_convertvector(v, h2_t); return __builtin_bit_cast(unsigned, h); }
DI unsigned bf2hu(unsigned w) { const f32x2_t v = {bflo(w), bfhi(w)}; const h2_t h = __builtin_convertvector(v, h2_t); return __builtin_bit_cast(unsigned, h); }
DI h2_t bf2h(unsigned w) { return (h2_t){(_Float16)bflo(w), (_Float16)bfhi(w)}; }
template <bool FAKE> DI void up8h(const u32x4 u, h2_t (&f)[8]) {
    if (FAKE) { f[0] = __builtin_bit_cast(h2_t, u.x & 0x3bff3bffu); f[1] = __builtin_bit_cast(h2_t, u.y & 0x3bff3bffu); f[2] = __builtin_bit_cast(h2_t, u.z & 0x3bff3bffu); f[3] = __builtin_bit_cast(h2_t, u.w & 0x3bff3bffu);
        f[4] = __builtin_bit_cast(h2_t, (u.x >> 1) & 0x3bff3bffu); f[5] = __builtin_bit_cast(h2_t, (u.y >> 1) & 0x3bff3bffu); f[6] = __builtin_bit_cast(h2_t, (u.z >> 1) & 0x3bff3bffu); f[7] = __builtin_bit_cast(h2_t, (u.w >> 1) & 0x3bff3bffu); return; }
    f[0] = __builtin_amdgcn_cvt_scalef32_pk_f16_fp8((int)u.x, 1.0f, false); f[1] = __builtin_amdgcn_cvt_scalef32_pk_f16_fp8((int)u.x, 1.0f, true);
    f[2] = __builtin_amdgcn_cvt_scalef32_pk_f16_fp8((int)u.y, 1.0f, false); f[3] = __builtin_amdgcn_cvt_scalef32_pk_f16_fp8((int)u.y, 1.0f, true);
    f[4] = __builtin_amdgcn_cvt_scalef32_pk_f16_fp8((int)u.z, 1.0f, false); f[5] = __builtin_amdgcn_cvt_scalef32_pk_f16_fp8((int)u.z, 1.0f, true);
    f[6] = __builtin_amdgcn_cvt_scalef32_pk_f16_fp8((int)u.w, 1.0f, false); f[7] = __builtin_amdgcn_cvt_scalef32_pk_f16_fp8((int)u.w, 1.0f, true); }
template <bool FAKE> DI float dot16h(const u32x4 u, const h2_t (&hh)[8]) { h2_t f[8]; up8h<FAKE>(u, f); float d0 = 0.f, d1 = 0.f;
#pragma unroll
    for (int q = 0; q < 8; q += 2) { d0 = __builtin_amdgcn_fdot2(f[q], hh[q], d0, false); d1 = __builtin_amdgcn_fdot2(f[q + 1], hh[q + 1], d1, false); }
    return d0 + d1; }
template <bool FINAL, bool FAKE = false, int SKIP = 0> DI void peer_gather_rounds(const Ctx& C, const bf16* Hin, const int* IDX, const float* GATE, const unsigned char* PU8, const unsigned char* PV8, const float* ISU, const float* ISV,
                                                 const bf16* Xin, bf16* Xout, float* Fout, const float* g2, const float* ngain, const float* nmod, bf16* Hn) {
    const int lane = C.lane, w = C.wave;
    LAS u32x2_t* LIST = (LAS u32x2_t*)(C.lds + w * 14592);
    LAS unsigned char* HL = C.lds + w * 14592 + 4096;
    LAS unsigned* ALU = (LAS unsigned*)(C.lds + w * 14592 + 12288);
    LAS int* OFFS = (LAS int*)(C.lds + w * 14592 + 14336);
    LAS float* IHS = (LAS float*)(C.lds + w * 14592 + 14336 + 160);
    const unsigned long long ltmask = (1ull << lane) - 1ull;
    for (int grp = C.vcu; grp < TT / 32; grp += C.G) {
        const int t0 = grp * 32 + w * 4;
        {
            int ee[8]; float gg[8]; unsigned su[8]; float sv[8];
#pragma unroll
            for (int r = 0; r < 8; ++r) { const size_t a = (size_t)(t0 + (r >> 1)) * 128 + 64 * (r & 1) + lane; ee[r] = IDX[a]; gg[r] = GATE[a]; }
#pragma unroll
            for (int r = 0; r < 8; ++r) { su[r] = __float_as_uint(ISU[ee[r]]) >> 23; sv[r] = ISV[ee[r]]; }
            int pos[8]; int base = 0;
#pragma unroll 1
            for (int b = 0; b < 8; ++b) {
#pragma unroll
                for (int r = 0; r < 8; ++r) { if ((r & 1) == 0 && lane == 0) OFFS[b * 4 + (r >> 1)] = base;
                    const bool mine = (ee[r] >> 11) == b; const unsigned long long m = __ballot(mine); if (mine) pos[r] = base + __popcll(m & ltmask); base += __popcll(m); }
            }
            if (lane == 0) OFFS[32] = 512;
#pragma unroll
            for (int r = 0; r < 8; ++r) { u32x2_t en; en.x = (unsigned)ee[r] | ((unsigned)(r >> 1) << 14) | (su[r] << 16); en.y = __float_as_uint(gg[r] * sv[r]); LIST[pos[r]] = en; }
#pragma unroll
            for (int tk = 0; tk < 4; ++tk) { const u32x4 a = *(const u32x4*)(Hin + (size_t)(t0 + tk) * 1024 + lane * 16), bq = *(const u32x4*)(Hin + (size_t)(t0 + tk) * 1024 + lane * 16 + 8);
                const float hv_[16] = {bflo(a.x), bfhi(a.x), bflo(a.y), bfhi(a.y), bflo(a.z), bfhi(a.z), bflo(a.w), bfhi(a.w), bflo(bq.x), bfhi(bq.x), bflo(bq.y), bfhi(bq.y), bflo(bq.z), bfhi(bq.z), bflo(bq.w), bfhi(bq.w)};
                float am = 0.f;
#pragma unroll
                for (int q = 0; q < 16; ++q) am = fmaxf(am, fabsf(hv_[q]));
                am = wave_max(am);
                const int e_ = (int)((__float_as_uint(am) >> 23) & 0xffu) - 127; const bool ok_ = am > 1e-30f;
                const float sc_ = ok_ ? __uint_as_float((unsigned)(127 + 6 - e_) << 23) : 1.0f, isc_ = ok_ ? __uint_as_float((unsigned)(127 - 6 + e_) << 23) : 1.0f;
                u32x4 o8;
#pragma unroll
                for (int q = 0; q < 4; ++q) { unsigned wd = 0u;
#pragma unroll
                    for (int j = 0; j < 4; ++j) { int qi = (int)rintf(hv_[4 * q + j] * sc_); qi = qi > 127 ? 127 : (qi < -127 ? -127 : qi); wd |= ((unsigned)qi & 0xffu) << (8 * j); }
                    o8[q] = wd; }
                *(LAS u32x4*)(HL + tk * 1024 + lane * 16) = o8; if (lane == 0) IHS[tk] = isc_; }
        }
        LDS_WAIT();
        {
            const int jL = ((lane >> 5) & 1) * 4 + ((lane >> 4) & 1) * 2 + ((lane >> 3) & 1);
#define G1_LOAD(UB, TK, G0) do { const unsigned exl_ = LIST[(G0) + (lane & 7)].x; \
            _Pragma("unroll") for (int j = 0; j < 8; ++j) { const unsigned ex = (unsigned)__builtin_amdgcn_readlane((int)exl_, j); TK[j] = (int)((ex >> 14) & 3u); \
                UB[j] = *(const u32x4*)(PU8 + (size_t)(ex & (FAKE ? 0x7fu : 0x3fffu)) * 1024 + lane * 16); } } while (0)
#define G1_RUN(UB, TK, G0) do { int p[8]; \
            _Pragma("unroll") for (int j = 0; j < 8; ++j) { const u32x4 hq = *(const LAS u32x4*)(HL + TK[j] * 1024 + lane * 16); \
                int d_ = __builtin_amdgcn_sdot4((int)UB[j].x, (int)hq.x, 0, false); d_ = __builtin_amdgcn_sdot4((int)UB[j].y, (int)hq.y, d_, false); \
                d_ = __builtin_amdgcn_sdot4((int)UB[j].z, (int)hq.z, d_, false); p[j] = __builtin_amdgcn_sdot4((int)UB[j].w, (int)hq.w, d_, false); } \
            const bool h32 = lane & 32, h16 = lane & 16, h8 = lane & 8; int q4[4]; \
            _Pragma("unroll") for (int j = 0; j < 4; ++j) { const int keep = h32 ? p[j + 4] : p[j], send = h32 ? p[j] : p[j + 4]; q4[j] = keep + __float_as_int(x32(__int_as_float(send))); } \
            int q2[2]; \
            _Pragma("unroll") for (int j = 0; j < 2; ++j) { const int keep = h16 ? q4[j + 2] : q4[j], send = h16 ? q4[j] : q4[j + 2]; q2[j] = keep + __float_as_int(x16(__int_as_float(send))); } \
            int q1; { const int keep = h8 ? q2[1] : q2[0], send = h8 ? q2[0] : q2[1]; q1 = keep + __float_as_int(dpp_f<0x128>(__int_as_float(send))); } \
            q1 += __float_as_int(dpp_f<0x141>(__int_as_float(q1))); q1 += __float_as_int(dpp_f<0xB1>(__int_as_float(q1))); q1 += __float_as_int(dpp_f<0x4E>(__int_as_float(q1))); \
            if ((lane & 7) == 0) { const u32x2_t me = LIST[(G0) + jL]; const float av_ = gelu_t((float)q1 * IHS[(me.x >> 14) & 3u] * __uint_as_float((me.x >> 16) << 23)) * __uint_as_float(me.y); ALU[(G0) + jL] = f2hu(av_, av_); } } while (0)
            u32x4 ubA[8], ubB[8]; int tkA[8], tkB[8];
            G1_LOAD(ubA, tkA, 0);
#pragma unroll 1
            for (int g0 = 0; g0 < ((SKIP & 1) ? 0 : 512); g0 += 16) {
                G1_LOAD(ubB, tkB, g0 + 8);
                G1_RUN(ubA, tkA, g0);
                if (g0 + 16 < 512) G1_LOAD(ubA, tkA, g0 + 16);
                G1_RUN(ubB, tkB, g0 + 8);
            }
#undef G1_LOAD
#undef G1_RUN
        }
        LDS_WAIT();
        h2_t o[4][8], oc[8];
#pragma unroll
        for (int q = 0; q < 8; ++q) { oc[q] = (h2_t){(_Float16)0.f, (_Float16)0.f};
#pragma unroll
            for (int tk = 0; tk < 4; ++tk) o[tk][q] = (h2_t){(_Float16)0.f, (_Float16)0.f}; }
        {
            int curA = 0;
#define G2_FLUSH() do { if (curA == 0) { _Pragma("unroll") for (int q_ = 0; q_ < 8; ++q_) o[0][q_] += oc[q_]; } else if (curA == 1) { _Pragma("unroll") for (int q_ = 0; q_ < 8; ++q_) o[1][q_] += oc[q_]; } \
            else if (curA == 2) { _Pragma("unroll") for (int q_ = 0; q_ < 8; ++q_) o[2][q_] += oc[q_]; } else { _Pragma("unroll") for (int q_ = 0; q_ < 8; ++q_) o[3][q_] += oc[q_]; } \
            _Pragma("unroll") for (int q_ = 0; q_ < 8; ++q_) oc[q_] = (h2_t){(_Float16)0.f, (_Float16)0.f}; } while (0)
#define G2_LOAD(VB, AJ, TK, G0) do { const unsigned exl_ = LIST[(G0) + (lane & 7)].x; const unsigned all_ = ALU[(G0) + (lane & 7)]; \
            _Pragma("unroll") for (int j = 0; j < 8; ++j) { const unsigned ex = (unsigned)__builtin_amdgcn_readlane((int)exl_, j); TK[j] = (int)((ex >> 14) & 3u); AJ[j] = __builtin_bit_cast(h2_t, (unsigned)__builtin_amdgcn_readlane((int)all_, j)); \
                VB[j] = *(const u32x4*)(PV8 + (size_t)(ex & (FAKE ? 0x7fu : 0x3fffu)) * 1024 + lane * 16); } } while (0)
#define G2_ACC(VB, AJ, TK) do { _Pragma("unroll") for (int j = 0; j < 8; ++j) { if (TK[j] != curA) { G2_FLUSH(); curA = TK[j]; } h2_t f_[8]; up8h<FAKE>(VB[j], f_); _Pragma("unroll") for (int q = 0; q < 8; ++q) oc[q] = f_[q] * AJ[j] + oc[q]; } } while (0)
            u32x4 vbA[8], vbB[8]; h2_t ajA[8], ajB[8]; int tA[8], tB[8];
            G2_LOAD(vbA, ajA, tA, 0);
#pragma unroll 1
            for (int g0 = 0; g0 < ((SKIP & 2) ? 0 : 512); g0 += 16) {
                G2_LOAD(vbB, ajB, tB, g0 + 8);
                G2_ACC(vbA, ajA, tA);
                if (g0 + 16 < 512) G2_LOAD(vbA, ajA, tA, g0 + 16);
                G2_ACC(vbB, ajB, tB);
            }
            G2_FLUSH();
#undef G2_FLUSH
#undef G2_LOAD
#undef G2_ACC
        }
#pragma unroll
        for (int tk = 0; tk < 4; ++tk) {
            __builtin_amdgcn_sched_barrier(0);
            const int t = t0 + tk; const int b = t >> 13; const float* gp = g2 + (size_t)b * 6144;
            const u32x4 xa = *(const u32x4*)(Xin + (size_t)t * 1024 + lane * 16), xb = *(const u32x4*)(Xin + (size_t)t * 1024 + lane * 16 + 8);
            const unsigned xw[8] = {xa.x, xa.y, xa.z, xa.w, xb.x, xb.y, xb.z, xb.w};
            float xn[16]; float ss = 0.f;
#pragma unroll
            for (int q = 0; q < 4; ++q) { const int col = lane * 16 + q * 4; const f32x4 gv = *(const f32x4*)(gp + col);
#pragma unroll
                for (int j = 0; j < 4; ++j) { const unsigned w_ = xw[q * 2 + (j >> 1)]; const float xv = (j & 1) ? __uint_as_float(w_ & 0xffff0000u) : __uint_as_float(w_ << 16);
                    const float y = xv + gv[j] * (float)o[tk][q * 2 + (j >> 1)][j & 1]; xn[q * 4 + j] = y; ss += y * y; } }
            const float rstd = 1.0f / sqrtf(wave_sum(ss) * (1.0f / 1024.0f) + EPS);
            if (FINAL) {
#pragma unroll
                for (int q = 0; q < 4; ++q) { const int col = lane * 16 + q * 4; const f32x4 gn = *(const f32x4*)(ngain + col); f32x4 y;
#pragma unroll
                    for (int j = 0; j < 4; ++j) y[j] = xn[q * 4 + j] * rstd * gn[j];
                    *(f32x4*)(Fout + (size_t)t * 1024 + col) = y; }
            } else {
                const float* nm = nmod + (size_t)b * 6144;
                u32x4 xo[2];
#pragma unroll
                for (int q = 0; q < 4; ++q) { const int col = lane * 16 + q * 4; const f32x4 gn = *(const f32x4*)(ngain + col), sh = *(const f32x4*)(nm + col), sc = *(const f32x4*)(nm + 1024 + col); float y[4];
#pragma unroll
                    for (int j = 0; j < 4; ++j) y[j] = xn[q * 4 + j] * rstd * gn[j] * (1.0f + sc[j]) + sh[j];
                    xo[q >> 1][2 * (q & 1)] = cvtpk(xn[q * 4], xn[q * 4 + 1]); xo[q >> 1][2 * (q & 1) + 1] = cvtpk(xn[q * 4 + 2], xn[q * 4 + 3]);
                    u32x2_t wv; wv.x = cvtpk(y[0], y[1]); wv.y = cvtpk(y[2], y[3]); *(u32x2_t*)(Hn + (size_t)t * 1024 + col) = wv; }
                *(u32x4*)(Xout + (size_t)t * 1024 + lane * 16) = xo[0]; *(u32x4*)(Xout + (size_t)t * 1024 + lane * 16 + 8) = xo[1];
            }
        }
        LDS_WAIT();
    }
}
constexpr int GR_R = 12;
DI void glds_row(const unsigned char* gsrc_lane, unsigned lds_dst) { unsigned keep;
    asm volatile("s_mov_b32 %0, m0\n\ts_mov_b32 m0, %2\n\ts_nop 0\n\tglobal_load_lds_dwordx4 %1, off\n\ts_mov_b32 m0, %0" : "=&s"(keep) : "v"(gsrc_lane), "s"(lds_dst) : "memory"); }
template <bool FINAL> DI void peer_gather_dma(const Ctx& C, const bf16* Hin, const int* IDX, const float* GATE, const unsigned char* PU8, const unsigned char* PV8, const float* ISU, const float* ISV,
                                              float* X, const float* g2, const float* ngain, const float* nmod, bf16* Hn) {
    const int lane = C.lane, w = C.wave;
    constexpr int WB = 4096 + 2048 + 256 + GR_R * 1024;
    LAS u32x2_t* LIST = (LAS u32x2_t*)(C.lds + w * WB);
    LAS float* AL = (LAS float*)(C.lds + w * WB + 4096);
    LAS int* OFFS = (LAS int*)(C.lds + w * WB + 6144);
    LAS unsigned char* RING = C.lds + w * WB + 6400;
    const unsigned ring0 = (unsigned)__builtin_amdgcn_readfirstlane((int)(unsigned)(size_t)RING);
    const unsigned long long ltmask = (1ull << lane) - 1ull;
#define GR_REFILL(nv_) do { unsigned ex8_[8]; _Pragma("unroll") for (int j_ = 0; j_ < 8; ++j_) ex8_[j_] = (j_ < (nv_) && nf + j_ < 1024) ? LIST[(nf + j_) & 511].x : 0u; \
        _Pragma("unroll") for (int j_ = 0; j_ < 8; ++j_) if (j_ < (nv_) && nf + j_ < 1024) { const int f_ = nf + j_; const unsigned e_ = (unsigned)__builtin_amdgcn_readfirstlane((int)ex8_[j_]) & 0x3fffu; \
            const unsigned char* tb_ = (f_ < 512) ? PU8 : PV8; glds_row(tb_ + (size_t)e_ * 1024 + lane * 16, ring0 + (unsigned)(f_ % GR_R) * 1024u); } \
        nf += (nv_); if (nf > 1024) nf = 1024; } while (0)
#define GR_ISSUE(f) do { const int f_ = (f); const unsigned ex_ = (unsigned)__builtin_amdgcn_readfirstlane((int)LIST[f_ & 511].x); \
        const unsigned char* tb_ = (f_ < 512) ? PU8 : PV8; glds_row(tb_ + (size_t)(ex_ & 0x3fffu) * 1024 + lane * 16, ring0 + (unsigned)(f_ % GR_R) * 1024u); } while (0)
    for (int grp = C.vcu; grp < TT / 32; grp += C.G) {
        const int t0 = grp * 32 + w * 4;
        float hv4[4][16];
        {
            int ee[8]; float gg[8]; unsigned su[8]; float sv[8];
#pragma unroll
            for (int r = 0; r < 8; ++r) { const size_t a = (size_t)(t0 + (r >> 1)) * 128 + 64 * (r & 1) + lane; ee[r] = IDX[a]; gg[r] = GATE[a]; }
#pragma unroll
            for (int r = 0; r < 8; ++r) { su[r] = __float_as_uint(ISU[ee[r]]) >> 23; sv[r] = ISV[ee[r]]; }
            int pos[8]; int base = 0;
#pragma unroll 1
            for (int b = 0; b < 8; ++b) {
#pragma unroll
                for (int r = 0; r < 8; ++r) { if ((r & 1) == 0 && lane == 0) OFFS[b * 4 + (r >> 1)] = base;
                    const bool mine = (ee[r] >> 11) == b; const unsigned long long m = __ballot(mine); if (mine) pos[r] = base + __popcll(m & ltmask); base += __popcll(m); }
            }
            if (lane == 0) OFFS[32] = 512;
#pragma unroll
            for (int r = 0; r < 8; ++r) { u32x2_t en; en.x = (unsigned)ee[r] | ((unsigned)(r >> 1) << 14) | (su[r] << 16); en.y = __float_as_uint(gg[r] * sv[r]); LIST[pos[r]] = en; }
#pragma unroll
            for (int tk = 0; tk < 4; ++tk) { const u32x4 a = *(const u32x4*)(Hin + (size_t)(t0 + tk) * 1024 + lane * 16), bq = *(const u32x4*)(Hin + (size_t)(t0 + tk) * 1024 + lane * 16 + 8);
                hv4[tk][0] = bflo(a.x); hv4[tk][1] = bfhi(a.x); hv4[tk][2] = bflo(a.y); hv4[tk][3] = bfhi(a.y); hv4[tk][4] = bflo(a.z); hv4[tk][5] = bfhi(a.z); hv4[tk][6] = bflo(a.w); hv4[tk][7] = bfhi(a.w);
                hv4[tk][8] = bflo(bq.x); hv4[tk][9] = bfhi(bq.x); hv4[tk][10] = bflo(bq.y); hv4[tk][11] = bfhi(bq.y); hv4[tk][12] = bflo(bq.z); hv4[tk][13] = bfhi(bq.z); hv4[tk][14] = bflo(bq.w); hv4[tk][15] = bfhi(bq.w); }
        }
        asm volatile("s_waitcnt vmcnt(0) lgkmcnt(0)" ::: "memory");
        int nf = GR_R;
#pragma unroll 1
        for (int f = 0; f < GR_R; ++f) GR_ISSUE(f);
        {
            const int jL = ((lane >> 5) & 1) * 4 + ((lane >> 4) & 1) * 2 + ((lane >> 3) & 1);
#pragma unroll 1
            for (int r = 0; r < 8; ++r) {
#pragma unroll
                for (int tk = 0; tk < 4; ++tk) {
                    const int beg = __builtin_amdgcn_readfirstlane(OFFS[r * 4 + tk]), end = __builtin_amdgcn_readfirstlane(OFFS[r * 4 + tk + 1]);
#pragma unroll 1
                    for (int g0 = beg; g0 < end; g0 += 8) {
                        const int nv = (end - g0) < 8 ? (end - g0) : 8;
                        asm volatile("s_waitcnt vmcnt(4)" ::: "memory");
                        float p[8];
#pragma unroll
                        for (int j = 0; j < 8; ++j) { p[j] = 0.f;
                            if (j < nv) { const u32x4 row = *(const LAS u32x4*)(RING + ((g0 + j) % GR_R) * 1024 + lane * 16); p[j] = dot16(row, hv4[tk]); } }
                        asm volatile("s_waitcnt lgkmcnt(0)" ::: "memory");
                        GR_REFILL(nv);
                        const bool h32 = lane & 32, h16 = lane & 16, h8 = lane & 8;
                        float q4[4];
#pragma unroll
                        for (int j = 0; j < 4; ++j) { const float keep = h32 ? p[j + 4] : p[j], send = h32 ? p[j] : p[j + 4]; q4[j] = keep + __shfl_xor(send, 32); }
                        float q2[2];
#pragma unroll
                        for (int j = 0; j < 2; ++j) { const float keep = h16 ? q4[j + 2] : q4[j], send = h16 ? q4[j] : q4[j + 2]; q2[j] = keep + __shfl_xor(send, 16); }
                        float q1; { const float keep = h8 ? q2[1] : q2[0], send = h8 ? q2[0] : q2[1]; q1 = keep + __shfl_xor(send, 8); }
                        q1 += __shfl_xor(q1, 4); q1 += __shfl_xor(q1, 2); q1 += __shfl_xor(q1, 1);
                        if ((lane & 7) == 0 && jL < nv) { const u32x2_t me = LIST[g0 + jL]; AL[g0 + jL] = gelu_t(q1 * __uint_as_float((me.x >> 16) << 23)) * __uint_as_float(me.y); }
                    }
                }
            }
        }
        float o[4][16];
#pragma unroll
        for (int tk = 0; tk < 4; ++tk)
#pragma unroll
            for (int q = 0; q < 16; ++q) o[tk][q] = 0.f;
#pragma unroll 1
        for (int r = 0; r < 8; ++r) {
#pragma unroll
            for (int tk = 0; tk < 4; ++tk) {
                const int beg = __builtin_amdgcn_readfirstlane(OFFS[r * 4 + tk]), end = __builtin_amdgcn_readfirstlane(OFFS[r * 4 + tk + 1]);
#pragma unroll 1
                for (int i0 = beg; i0 < end; i0 += 8) {
                    const int nv = (end - i0) < 8 ? (end - i0) : 8;
                    if (i0 <= 500) asm volatile("s_waitcnt vmcnt(4)" ::: "memory"); else asm volatile("s_waitcnt vmcnt(0)" ::: "memory");
                    float aq[8]; u32x4 rw[8];
#pragma unroll
                    for (int j = 0; j < 8; ++j) { aq[j] = (j < nv) ? AL[i0 + j] : 0.f; }
#pragma unroll
                    for (int j = 0; j < 8; ++j) if (j < nv) rw[j] = *(const LAS u32x4*)(RING + ((512 + i0 + j) % GR_R) * 1024 + lane * 16);
#pragma unroll
                    for (int j = 0; j < 8; ++j) if (j < nv) { const float aj = __int_as_float(__builtin_amdgcn_readfirstlane(__float_as_int(aq[j])));
                        float f_[16]; up8(rw[j].x, f_[0], f_[1], f_[2], f_[3]); up8(rw[j].y, f_[4], f_[5], f_[6], f_[7]); up8(rw[j].z, f_[8], f_[9], f_[10], f_[11]); up8(rw[j].w, f_[12], f_[13], f_[14], f_[15]);
#pragma unroll
                        for (int q = 0; q < 16; ++q) o[tk][q] += aj * f_[q]; }
                    asm volatile("s_waitcnt lgkmcnt(0)" ::: "memory");
                    GR_REFILL(nv);
                }
            }
        }
        asm volatile("s_waitcnt vmcnt(0)" ::: "memory");
#pragma unroll
        for (int tk = 0; tk < 4; ++tk) {
            const int t = t0 + tk; const int b = t >> 13; const float* gp = g2 + (size_t)b * 6144; float* xr = X + (size_t)t * 1024;
            float xn[16]; float ss = 0.f;
#pragma unroll
            for (int q = 0; q < 4; ++q) { const int col = lane * 16 + q * 4; const f32x4 xv = *(const f32x4*)(xr + col), gv = *(const f32x4*)(gp + col);
#pragma unroll
                for (int j = 0; j < 4; ++j) { const float y = xv[j] + gv[j] * o[tk][q * 4 + j]; xn[q * 4 + j] = y; ss += y * y; } }
            const float rstd = 1.0f / sqrtf(wave_sum(ss) * (1.0f / 1024.0f) + EPS);
            if (FINAL) {
#pragma unroll
                for (int q = 0; q < 4; ++q) { const int col = lane * 16 + q * 4; const f32x4 gn = *(const f32x4*)(ngain + col); f32x4 y;
#pragma unroll
                    for (int j = 0; j < 4; ++j) y[j] = xn[q * 4 + j] * rstd * gn[j];
                    *(f32x4*)(xr + col) = y; }
            } else {
                const float* nm = nmod + (size_t)b * 6144;
#pragma unroll
                for (int q = 0; q < 4; ++q) { const int col = lane * 16 + q * 4; const f32x4 gn = *(const f32x4*)(ngain + col), sh = *(const f32x4*)(nm + col), sc = *(const f32x4*)(nm + 1024 + col); f32x4 xo; float y[4];
#pragma unroll
                    for (int j = 0; j < 4; ++j) { xo[j] = xn[q * 4 + j]; y[j] = xn[q * 4 + j] * rstd * gn[j] * (1.0f + sc[j]) + sh[j]; }
                    *(f32x4*)(xr + col) = xo; u32x2_t wv; wv.x = cvtpk(y[0], y[1]); wv.y = cvtpk(y[2], y[3]); *(u32x2_t*)(Hn + (size_t)t * 1024 + col) = wv; }
            }
        }
        asm volatile("s_waitcnt vmcnt(0) lgkmcnt(0)" ::: "memory");
    }
#undef GR_ISSUE
#undef GR_REFILL
}
DI float red4_sum(float x) { auto a = __builtin_amdgcn_permlane16_swap(__float_as_uint(x), __float_as_uint(x), false, false); x = __uint_as_float(a[0]) + __uint_as_float(a[1]);
    auto b = __builtin_amdgcn_permlane32_swap(__float_as_uint(x), __float_as_uint(x), false, false); return __uint_as_float(b[0]) + __uint_as_float(b[1]); }
DI float red4_max(float x) { auto a = __builtin_amdgcn_permlane16_swap(__float_as_uint(x), __float_as_uint(x), false, false); x = fmaxf(__uint_as_float(a[0]), __uint_as_float(a[1]));
    auto b = __builtin_amdgcn_permlane32_swap(__float_as_uint(x), __float_as_uint(x), false, false); return fmaxf(__uint_as_float(b[0]), __uint_as_float(b[1])); }
DI float red4_min(float x) { auto a = __builtin_amdgcn_permlane16_swap(__float_as_uint(x), __float_as_uint(x), false, false); x = fminf(__uint_as_float(a[0]), __uint_as_float(a[1]));
    auto b = __builtin_amdgcn_permlane32_swap(__float_as_uint(x), __float_as_uint(x), false, false); return fminf(__uint_as_float(b[0]), __uint_as_float(b[1])); }
constexpr int TK_NI = 6;
DI float tk_pivot(float clo, float chi) {
    const float lc = __builtin_amdgcn_logf(clo), lh = __builtin_amdgcn_logf(fmaxf(chi, 0.5f));
    const float f = (lc - 4.0443941f) * __builtin_amdgcn_rcpf(lc - lh);
    return fminf(fmaxf(f, 0.06f), 0.94f);
}
template <int NV> DI float tk_count(const float (&v)[NV], float mid) {
    const float nb = -mid * 1.099511627776e12f;
    float c[4] = {0.f, 0.f, 0.f, 0.f};
#pragma unroll
    for (int i = 0; i < NV; ++i) c[i & 3] += __builtin_amdgcn_fmed3f(__builtin_fmaf(v[i], 1.099511627776e12f, nb), 0.f, 1.f);
    return red4_sum((c[0] + c[1]) + (c[2] + c[3]));
}
constexpr int tk2_pair(int n) {
    int k = 0;
    for (int i = 0; i < 16; ++i) for (int j = 0; j < 16; ++j) if ((i + 1) * (j + 1) <= 16) { if (k == n) return i | (j << 8); ++k; }
    return n == 50 ? (15 | (15 << 8)) : (15 | (14 << 8));
}
#ifndef TK_STEP_N
#define TK_STEP_N 2
#endif
constexpr int TK_STEP = TK_STEP_N;
template <int NV> DI void tk_search(const float (&v)[NV], float ntot, float& thr_out) {
    float mx = v[0], mn = v[0];
#pragma unroll
    for (int i = 1; i < NV; ++i) { mx = fmaxf(mx, v[i]); mn = fminf(mn, v[i]); }
    mx = red4_max(mx); mn = red4_min(mn);
    float lo = mn, hi = mx, clo = ntot - 1.0f, chi = 0.0f; bool done = false;
#pragma unroll 1
    for (int iter = 0; iter < 48; ++iter) {
        const bool rdy = done || clo <= 16.0f + (float)TK_STEP;
        if (__all(rdy)) break;
        float fr_ = tk_pivot(clo, chi); if (iter >= TK_NI) fr_ = 0.5f;
        const float mid = rdy ? lo : lo + (hi - lo) * fr_;
        const float cnt = tk_count<NV>(v, mid);
        if (!rdy) { if (cnt == 16.0f) { lo = mid; clo = 16.0f; done = true; } else if (cnt > 16.0f) { lo = mid; clo = cnt; } else { hi = mid; chi = cnt; } }
    }
    const float sl = lo;
#pragma unroll 1
    for (int r = 0; r < TK_STEP; ++r) {
        const bool nd = clo > 16.0f;
        if (!__any(nd)) break;
        float y = 3.0e38f;
#pragma unroll
        for (int i = 0; i < NV; ++i) y = fminf(y, v[i] > lo ? v[i] : 3.0e38f);
        y = red4_min(y);
        if (nd) { lo = y; clo -= 1.0f; }
    }
    if (__any(!done)) { const float c = tk_count<NV>(v, lo); if (c != 16.0f) lo = sl; }
    thr_out = lo;
}
DI void tk_search2(const float (&v0)[32], const float (&v1)[32], float& t0, float& t1) {
    float mx0 = v0[0], mn0 = v0[0], mx1 = v1[0], mn1 = v1[0], s0 = v0[0], s1 = v1[0], q0 = v0[0] * v0[0], q1 = v1[0] * v1[0];
#pragma unroll
    for (int i = 1; i < 32; ++i) { mx0 = fmaxf(mx0, v0[i]); mn0 = fminf(mn0, v0[i]); mx1 = fmaxf(mx1, v1[i]); mn1 = fminf(mn1, v1[i]);
        s0 += v0[i]; s1 += v1[i]; q0 = __builtin_fmaf(v0[i], v0[i], q0); q1 = __builtin_fmaf(v1[i], v1[i], q1); }
    mx0 = red4_max(mx0); mn0 = red4_min(mn0); mx1 = red4_max(mx1); mn1 = red4_min(mn1); s0 = red4_sum(s0); s1 = red4_sum(s1); q0 = red4_sum(q0); q1 = red4_sum(q1);
    const float me0 = s0 * (1.0f / 128.0f), me1 = s1 * (1.0f / 128.0f);
    const float g0 = fminf(fmaxf(me0 + 1.05f * sqrtf(fmaxf(q0 * (1.0f / 128.0f) - me0 * me0, 0.f)), mn0), mx0), g1 = fminf(fmaxf(me1 + 1.05f * sqrtf(fmaxf(q1 * (1.0f / 128.0f) - me1 * me1, 0.f)), mn1), mx1);
    float lo0 = mn0, hi0 = mx0, clo0 = 127.0f, chi0 = 0.0f; bool done0 = false;
    float lo1 = mn1, hi1 = mx1, clo1 = 127.0f, chi1 = 0.0f; bool done1 = false;
#pragma unroll 1
    for (int iter = 0; iter < 48; ++iter) {
        const bool r0 = done0 || clo0 <= 16.0f + (float)TK_STEP, r1 = done1 || clo1 <= 16.0f + (float)TK_STEP;
        if (__all(r0 && r1)) break;
        float f0 = tk_pivot(clo0, chi0), f1 = tk_pivot(clo1, chi1); if (iter >= TK_NI) { f0 = 0.5f; f1 = 0.5f; }
        float mid0 = lo0 + (hi0 - lo0) * f0, mid1 = lo1 + (hi1 - lo1) * f1; if (iter == 0) { mid0 = g0; mid1 = g1; }
        if (r0) mid0 = lo0; if (r1) mid1 = lo1;
        const float c0 = tk_count<32>(v0, mid0), c1 = tk_count<32>(v1, mid1);
        if (!r0) { if (c0 == 16.0f) { lo0 = mid0; clo0 = 16.0f; done0 = true; } else if (c0 > 16.0f) { lo0 = mid0; clo0 = c0; } else { hi0 = mid0; chi0 = c0; } }
        if (!r1) { if (c1 == 16.0f) { lo1 = mid1; clo1 = 16.0f; done1 = true; } else if (c1 > 16.0f) { lo1 = mid1; clo1 = c1; } else { hi1 = mid1; chi1 = c1; } }
    }
    const float sl0 = lo0, sl1 = lo1;
#pragma unroll 1
    for (int r = 0; r < TK_STEP; ++r) {
        const bool n0 = clo0 > 16.0f, n1 = clo1 > 16.0f;
        if (!__any(n0 || n1)) break;
        float y0 = 3.0e38f, y1 = 3.0e38f;
#pragma unroll
        for (int i = 0; i < 32; ++i) { y0 = fminf(y0, v0[i] > lo0 ? v0[i] : 3.0e38f); y1 = fminf(y1, v1[i] > lo1 ? v1[i] : 3.0e38f); }
        y0 = red4_min(y0); y1 = red4_min(y1);
        if (n0) { lo0 = y0; clo0 -= 1.0f; }
        if (n1) { lo1 = y1; clo1 -= 1.0f; }
    }
    if (__any(!done0 || !done1)) {
        const float c0 = tk_count<32>(v0, lo0), c1 = tk_count<32>(v1, lo1);
        if (c0 != 16.0f) lo0 = sl0; if (c1 != 16.0f) lo1 = sl1;
    }
    t0 = lo0; t1 = lo1;
}
template <int N> struct tk2_pair_c { static constexpr int value = tk2_pair(N); };
template <int MODE = 0> DI void peer_topk_fused(const Ctx& C, const bf16* QP, const bf16* KEYS, int* IDX, float* GATE) {
    constexpr int KPI = 288;
    const int lane = C.lane, fr = lane & 15, fq = lane >> 4, w = C.wave;
    LAS unsigned char* KS = C.lds;
    LAS unsigned char* WB = C.lds + 73728 + w * 7168;
    LAS float* LV = (LAS float*)(WB);
    LAS int* LK = (LAS int*)(WB + 2176);
    LAS float* FV = (LAS float*)(WB + 4352);
    LAS int* FI = (LAS int*)(WB + 5504);
    LAS float* TRASH = (LAS float*)(WB + 6656) + lane;
    const int h = C.vcu & 7, nb = C.G >> 3;
    { const bf16* kg = KEYS + (size_t)h * 2 * 128 * 128;
      for (int c = C.tid; c < 4096; c += 512) { const int r = c >> 4, cc = c & 15; *(LAS u32x4*)(KS + r * KPI + cc * 16) = *(const u32x4*)(kg + (size_t)r * 128 + cc * 8); } }
    __syncthreads();
    int cof[13];
#define TK2_COF(c) cof[c] = fq == 0 ? tk2_pair_c<4 * (c)>::value : fq == 1 ? tk2_pair_c<4 * (c) + 1>::value : fq == 2 ? tk2_pair_c<4 * (c) + 2>::value : tk2_pair_c<4 * (c) + 3>::value
    TK2_COF(0); TK2_COF(1); TK2_COF(2); TK2_COF(3); TK2_COF(4); TK2_COF(5); TK2_COF(6); TK2_COF(7); TK2_COF(8); TK2_COF(9); TK2_COF(10); TK2_COF(11); TK2_COF(12);
#undef TK2_COF
    for (int tt = (C.vcu >> 3) + nb * w; tt < 1024; tt += nb * 8) {
        const int tok = tt * 16 + fr;
        float sc0[32], sc1[32];
#pragma unroll
        for (int p = 0; p < 2; ++p) {
            bf16x8 qf[4];
#pragma unroll
            for (int ks = 0; ks < 4; ++ks) qf[ks] = *(const bf16x8*)(QP + (size_t)tok * 2048 + h * 256 + p * 128 + ks * 32 + fq * 8);
#pragma unroll
            for (int kt = 0; kt < 8; ++kt) {
                f32x4 acc = {0.f, 0.f, 0.f, 0.f};
#pragma unroll
                for (int ks = 0; ks < 4; ++ks) { const bf16x8 kf = *(const LAS bf16x8*)(KS + (p * 128 + kt * 16 + fr) * KPI + (ks * 32 + fq * 8) * 2);
                    acc = __builtin_amdgcn_mfma_f32_16x16x32_bf16(kf, qf[ks], acc, 0, 0, 0); }
                if (p == 0) { sc0[kt * 4 + 0] = acc[0]; sc0[kt * 4 + 1] = acc[1]; sc0[kt * 4 + 2] = acc[2]; sc0[kt * 4 + 3] = acc[3]; }
                else { sc1[kt * 4 + 0] = acc[0]; sc1[kt * 4 + 1] = acc[1]; sc1[kt * 4 + 2] = acc[2]; sc1[kt * 4 + 3] = acc[3]; }
            }
        }
        float thrA = 1.0f, thrB = 1.0f; if (MODE == 0) tk_search2(sc0, sc1, thrA, thrB);
#pragma unroll
        for (int p = 0; p < 2; ++p) {
            const float thr = p == 0 ? thrA : thrB;
            int cnt = 0;
#pragma unroll
            for (int i = 0; i < 32; ++i) cnt += ((p == 0 ? sc0[i] : sc1[i]) > thr) ? 1 : 0;
            const int c0 = __shfl(cnt, fr), c1 = __shfl(cnt, fr + 16), c2 = __shfl(cnt, fr + 32);
            int pos = (fq > 0 ? c0 : 0) + (fq > 1 ? c1 : 0) + (fq > 2 ? c2 : 0);
#pragma unroll
            for (int i = 0; i < 32; ++i) { const float vv = p == 0 ? sc0[i] : sc1[i]; const bool s = vv > thr && pos < 16;
                LAS float* pv = s ? (LV + fr * 33 + p * 16 + pos) : TRASH; LAS int* pk = s ? (LK + fr * 33 + p * 16 + pos) : (LAS int*)TRASH;
                *pv = vv; *pk = (i >> 2) * 16 + 4 * fq + (i & 3); pos += (vv > thr) ? 1 : 0; }
        }
        LDS_WAIT();
        {
            const int lb = fr * 33 + (fq >> 1) * 16, e0 = 8 * (fq & 1);
            float L[16], ownv[8], own[8]; int okey[8], rk[8];
#pragma unroll
            for (int q = 0; q < 16; ++q) L[q] = __uint_as_float((__float_as_uint(LV[lb + q]) & ~15u) | (unsigned)q);
#pragma unroll
            for (int i = 0; i < 8; ++i) { ownv[i] = LV[lb + e0 + i]; okey[i] = LK[lb + e0 + i]; own[i] = __uint_as_float((__float_as_uint(ownv[i]) & ~15u) | (unsigned)(e0 + i)); }
#pragma unroll
            for (int i = 0; i < 8; ++i) { int r = 0;
#pragma unroll
                for (int q = 0; q < 16; ++q) r += (L[q] > own[i]) ? 1 : 0;
                rk[i] = r; }
#pragma unroll
            for (int i = 0; i < 8; ++i) { LV[lb + rk[i]] = ownv[i]; LK[lb + rk[i]] = okey[i]; }
        }
        LDS_WAIT();
        float sm[13]; int ca[13], cb[13];
#pragma unroll
        for (int c = 0; c < 13; ++c) { ca[c] = fr * 33 + (cof[c] & 255); cb[c] = fr * 33 + 16 + (cof[c] >> 8); sm[c] = LV[ca[c]] + LV[cb[c]]; }
        float thr2 = 4.0f; if (MODE == 0) tk_search<13>(sm, 52.0f, thr2);
        {
            int cnt = 0;
#pragma unroll
            for (int i = 0; i < 13; ++i) cnt += (sm[i] > thr2) ? 1 : 0;
            const int c0 = __shfl(cnt, fr), c1 = __shfl(cnt, fr + 16), c2 = __shfl(cnt, fr + 32);
            int pos = (fq > 0 ? c0 : 0) + (fq > 1 ? c1 : 0) + (fq > 2 ? c2 : 0);
#pragma unroll
            for (int i = 0; i < 13; ++i) { const bool s = sm[i] > thr2 && pos < 16;
                LAS float* pv = s ? (FV + fr * 17 + pos) : TRASH; LAS int* pk = s ? (FI + fr * 17 + pos) : (LAS int*)TRASH;
                *pv = sm[i]; *pk = LK[ca[i]] * 128 + LK[cb[i]]; pos += (sm[i] > thr2) ? 1 : 0; }
        }
        LDS_WAIT();
        float x[4]; int xi[4];
#pragma unroll
        for (int j = 0; j < 4; ++j) { x[j] = FV[fr * 17 + 4 * fq + j]; xi[j] = FI[fr * 17 + 4 * fq + j]; }
        float m = red4_max(fmaxf(fmaxf(x[0], x[1]), fmaxf(x[2], x[3])));
        float e[4]; float s = 0.f;
#pragma unroll
        for (int j = 0; j < 4; ++j) { e[j] = __expf(x[j] - m); s += e[j]; }
        s = red4_sum(s);
        const float inv = 1.0f / s;
        const size_t ob = ((size_t)tok * 8 + h) * 16 + 4 * fq;
        typedef int i32x4 __attribute__((ext_vector_type(4)));
        *(i32x4*)(IDX + ob) = (i32x4){xi[0], xi[1], xi[2], xi[3]}; *(f32x4*)(GATE + ob) = (f32x4){e[0] * inv, e[1] * inv, e[2] * inv, e[3] * inv};
        LDS_WAIT();
    }
}
DI void intra_mfma(const Ctx& C, const bf16* Q, const bf16* K, const bf16* V, const bf16* CROSS, bf16* G) {
    constexpr int RPI = 544, PPI = 144, VPI = 544;
    LAS unsigned char* Qs = C.lds; LAS unsigned char* Ks = Qs + 64 * RPI; LAS unsigned char* Ps = Ks + 64 * RPI; LAS unsigned char* Vs = Ps + 64 * PPI;
    LAS float* red = (LAS float*)(Vs + 64 * VPI);
    const int tid = C.tid, lane = C.lane, w = C.wave, fr = lane & 15, fq = lane >> 4;
    for (int item = C.vcu; item < 1024; item += C.G) {
        const int b = item >> 9, h = (item >> 7) & 3, n = item & 127;
        const float lg2 = log2f(1.0f - exp2f(-5.0f - (float)h));
        const size_t tok0 = (size_t)b * SEQ + (size_t)n * 64;
#pragma unroll
        for (int u = 0; u < 4; ++u) { const int c = tid + 512 * u, r = c >> 5, cc = c & 31;
            *(LAS u32x4*)(Qs + r * RPI + cc * 16) = *(const u32x4*)(Q + (tok0 + r) * 1024 + h * 256 + cc * 8);
            *(LAS u32x4*)(Ks + r * RPI + cc * 16) = *(const u32x4*)(K + (tok0 + r) * 1024 + h * 256 + cc * 8);
            *(LAS u32x4*)(Vs + r * VPI + cc * 16) = *(const u32x4*)(V + (tok0 + r) * 2048 + h * 512 + cc * 8); }
        __syncthreads();
        { const int jt = w >> 1; f32x4 sa[2] = {(f32x4){0.f, 0.f, 0.f, 0.f}, (f32x4){0.f, 0.f, 0.f, 0.f}};
#pragma unroll
          for (int ks = 0; ks < 8; ++ks) { const bf16x8 kf = *(const LAS bf16x8*)(Ks + (16 * jt + fr) * RPI + (32 * ks + 8 * fq) * 2);
#pragma unroll
              for (int q = 0; q < 2; ++q) { const int it = 2 * (w & 1) + q; const bf16x8 qf = *(const LAS bf16x8*)(Qs + (16 * it + fr) * RPI + (32 * ks + 8 * fq) * 2);
                  sa[q] = __builtin_amdgcn_mfma_f32_16x16x32_bf16(kf, qf, sa[q], 0, 0, 0); } }
#pragma unroll
          for (int q = 0; q < 2; ++q) { const int i = 16 * (2 * (w & 1) + q) + fr, j0 = 16 * jt + 4 * fq; float pv[4];
#pragma unroll
              for (int r = 0; r < 4; ++r) { const int dd = i > j0 + r ? i - j0 - r : j0 + r - i; pv[r] = sa[q][r] * exp2f(lg2 * (float)dd); }
              u32x2_t o; o.x = cvtpk(pv[0], pv[1]); o.y = cvtpk(pv[2], pv[3]); *(LAS u32x2_t*)(Ps + i * PPI + j0 * 2) = o; } }
        __syncthreads();
        f32x4 acc[2][2][4];
#pragma unroll
        for (int hf = 0; hf < 2; ++hf) {
#pragma unroll
            for (int et = 0; et < 2; ++et)
#pragma unroll
                for (int it = 0; it < 4; ++it) acc[hf][et][it] = (f32x4){0.f, 0.f, 0.f, 0.f};
            if (hf == 1) { __syncthreads();
#pragma unroll
                for (int u = 0; u < 4; ++u) { const int c = tid + 512 * u, r = c >> 5, cc = c & 31;
                    *(LAS u32x4*)(Vs + r * VPI + cc * 16) = *(const u32x4*)(V + (tok0 + r) * 2048 + h * 512 + 256 + cc * 8); }
                __syncthreads(); }
#pragma unroll
            for (int ks = 0; ks < 2; ++ks) {
                bf16x8 pf[4];
#pragma unroll
                for (int it = 0; it < 4; ++it) { const LAS unsigned char* pp = Ps + (16 * it + fr) * PPI + (32 * ks + 4 * fq) * 2;
                    const u32x2_t lo = *(const LAS u32x2_t*)pp, hi = *(const LAS u32x2_t*)(pp + 32); u32x4 ww; ww.x = lo.x; ww.y = lo.y; ww.z = hi.x; ww.w = hi.y; pf[it] = __builtin_bit_cast(bf16x8, ww); }
#pragma unroll
                for (int et = 0; et < 2; ++et) { const LAS unsigned char* vp = Vs + (32 * ks + 4 * fq + (fr >> 2)) * VPI + (32 * w + 16 * et + 4 * (fr & 3)) * 2;
                    const bf16x8 vf = cat8(trr(vp), trr(vp + 16 * VPI));
#pragma unroll
                    for (int it = 0; it < 4; ++it) acc[hf][et][it] = __builtin_amdgcn_mfma_f32_16x16x32_bf16(vf, pf[it], acc[hf][et][it], 0, 0, 0); }
            }
        }
        float ssq[4] = {0.f, 0.f, 0.f, 0.f};
#pragma unroll
        for (int hf = 0; hf < 2; ++hf)
#pragma unroll
            for (int et = 0; et < 2; ++et)
#pragma unroll
                for (int it = 0; it < 4; ++it) { const u32x2_t cv = *(const u32x2_t*)(CROSS + (tok0 + 16 * it + fr) * 2048 + h * 512 + hf * 256 + 32 * w + 16 * et + 4 * fq);
                    f32x4 y = acc[hf][et][it]; y[0] += bflo(cv.x); y[1] += bfhi(cv.x); y[2] += bflo(cv.y); y[3] += bfhi(cv.y); acc[hf][et][it] = y;
                    ssq[it] += (y[0] * y[0] + y[1] * y[1]) + (y[2] * y[2] + y[3] * y[3]); }
#pragma unroll
        for (int it = 0; it < 4; ++it) { float s = ssq[it]; s += __shfl_xor(s, 16); s += __shfl_xor(s, 32); if (fq == 0) red[w * 64 + 16 * it + fr] = s; }
        __syncthreads();
        float rs[4];
#pragma unroll
        for (int it = 0; it < 4; ++it) { float s = 0.f;
#pragma unroll
            for (int ww = 0; ww < 8; ++ww) s += red[ww * 64 + 16 * it + fr];
            rs[it] = 1.0f / sqrtf(s * (1.0f / 512.0f) + EPS); }
#pragma unroll
        for (int hf = 0; hf < 2; ++hf)
#pragma unroll
            for (int et = 0; et < 2; ++et)
#pragma unroll
                for (int it = 0; it < 4; ++it) { bf16* gp = G + (tok0 + 16 * it + fr) * 2048 + h * 512 + hf * 256 + 32 * w + 16 * et + 4 * fq; const u32x2_t gv = *(const u32x2_t*)gp;
                    const f32x4 y = acc[hf][et][it] * rs[it]; u32x2_t o; o.x = cvtpk(y[0] * bflo(gv.x), y[1] * bfhi(gv.x)); o.y = cvtpk(y[2] * bflo(gv.y), y[3] * bfhi(gv.y)); *(u32x2_t*)gp = o; }
        __syncthreads();
    }
}
#ifndef PHMASK
#define PHMASK 0xFFFFFFu
#endif
#define PH(k) ((PHMASK >> (k)) & 1u)
#ifdef USE_SGU_NAIVE
#define SGU_GATE_FN sgu_gate_naive
#else
#define SGU_GATE_FN sgu_gate_mfma
#endif
#ifdef USE_GATHER_TOKEN
#define GATHER_FN peer_gather8
#else
#ifdef USE_GATHER_ROUNDS
#define GATHER_FN peer_gather_rounds
#else
#define GATHER_FN peer_gather_dma
#endif
#endif
#ifndef DUP_GATHER_SKIP
#define DUP_GATHER_SKIP 0
#endif
#ifndef DUP_GATHER_FAKE
#define DUP_GATHER_FAKE false
#endif
struct Args { const void* in[21]; float* out; unsigned char* ws; };
__global__ void __launch_bounds__(NWAVES * 64, 2) mk_fwd(Args args) {
    extern __shared__ __attribute__((aligned(16))) unsigned char lds[];
    Ctx C; C.lds = (LAS unsigned char*)lds; C.tid = threadIdx.x; C.lane = C.tid & 63; C.wave = __builtin_amdgcn_readfirstlane(C.tid >> 6);
    C.G = gridDim.x; { const int bx = blockIdx.x; C.vcu = (C.G % 8 == 0) ? (bx % 8) * (C.G / 8) + bx / 8 : bx; }
    C.ws = args.ws;
    volatile LAS unsigned* MISC = (volatile LAS unsigned*)(C.lds + MISC_OFF);
    gu32* ctl = (gu32*)(args.ws + WS_CTL);
    for (int u = C.tid; u < (LDS_BYTES - LDSCTL_OFF) / 4; u += NWAVES * 64) ((LAS unsigned*)(C.lds + LDSCTL_OFF))[u] = 0u;
    __syncthreads();
    XcdBarrier bar = xcd_barrier_post((unsigned*)(ctl + CW_BAR), MISC + 8);
#define GRID_BAR() do { xcd_barrier(bar); asm volatile("" : "+v"(C.tid)); C.lane = C.tid & 63; C.wave = __builtin_amdgcn_readfirstlane(C.tid >> 6); } while (0)
    { LAS unsigned long long* PT = (LAS unsigned long long*)(C.lds + PTR_OFF);
      if (C.tid == 0) {
#pragma unroll
          for (int i = 0; i < 21; ++i) PT[i] = (unsigned long long)args.in[i];
      } }
    __syncthreads();
#define INP(T, i) ((const T*)ldp(C, i))
    float* out = args.out; unsigned char* ws = args.ws;
#define MODP ((float*)(ws + WS_MOD))
#define MOD0 ((const float*)(ws + WS_MOD))
#define MOD1 ((const float*)(ws + WS_MOD) + 2 * 6144)
#define cosT ((float*)(ws + WS_COS))
#define sinT ((float*)(ws + WS_SIN))
#define WRI ((bf16*)(ws + WS_WRI))
#define WRO ((bf16*)(ws + WS_WRO))
#define WSI ((bf16*)(ws + WS_WSI))
#define WSO ((bf16*)(ws + WS_WSO))
#define WQ ((bf16*)(ws + WS_WQ))
#define KEYS ((bf16*)(ws + WS_KEYS))
#define STATS ((float*)(ws + WS_STATS))
#define IDX ((int*)(ws + WS_IDX))
#define GATE ((float*)(ws + WS_GATE))
#define H ((bf16*)(ws + WS_H))
#define PU8 ((const unsigned char*)(ws + WS_PU))
#define PV8 ((const unsigned char*)(ws + WS_PV))
#define ISU ((const float*)(ws + WS_ISU))
#define ISV ((const float*)(ws + WS_ISV))
#define Qb ((bf16*)(ws + WS_Q))
#define Kb ((bf16*)(ws + WS_K))
#define Vb ((bf16*)(ws + WS_V))
#define Gb ((bf16*)(ws + WS_G))
#define CROSS ((bf16*)(ws + WS_CROSS))
#define QP ((bf16*)(ws + WS_QP))
#define SCO ((float*)(ws + WS_SC))
#define Ub ((bf16*)(ws + WS_U))
#define XB ((bf16*)(ws + WS_XB))
#define VBb ((bf16*)(ws + WS_VB))

    { P0In I; I.c = INP(float, 1); I.ada_w = INP(float, 5); I.ada_b = INP(float, 6); I.ret_w_in = INP(float, 7); I.ret_w_out = INP(float, 8); I.sgu_w_in = INP(float, 9); I.sgu_w_out = INP(float, 15); I.wq = INP(float, 16); I.keys = INP(float, 17); I.pu = INP(float, 18); I.pv = INP(float, 19); I.pos = INP(int, 2);
#ifdef DUP_P0
      p0_prologue(C, I);
      GRID_BAR();
#endif
      if (PH(0)) p0_prologue(C, I); }
    GRID_BAR();
    if (PH(1)) rms_mod_phase(C, INP(float, 0), INP(float, 3), MOD0, 0, 1024, H);
    GRID_BAR();
    { pg8::Gemm g{H, WRI, TT, 6144, 1024}; pg8::StaticOrder S; S.init(TT, 6144, C.G, (int)blockIdx.x);
      pg8::EpiRetProj E{Qb, Kb, Vb, Gb, (const unsigned*)(ws + WS_COS)};
#ifdef DUP_G1
      pg8::gemm_phase<pg8::EpiRetProj, pg8::StaticOrder, true, true>(C.lds + RING_OFF, g, S, E); GRID_BAR();
#endif
#ifdef DUP_G1B
      { pg8::EpiBf16<0> E2{(bf16*)(ws + WS_R), 6144, nullptr, 0, 0, 1.f}; pg8::gemm_phase<pg8::EpiBf16<0>, pg8::StaticOrder, true, true>(C.lds + RING_OFF, g, S, E2); GRID_BAR(); }
#endif
      if (PH(2)) pg8::gemm_phase<pg8::EpiRetProj, pg8::StaticOrder, true, true>(C.lds + RING_OFF, g, S, E); }
    GRID_BAR();
    #ifdef USE_SCAN_NAIVE
    if (PH(3)) scan_naive(C, Qb, Kb, Vb, CROSS);
#else
#ifdef DUP_SCAN
    if (C.vcu < SCAN_NIT) scan_mfma<DUP_SCAN>(C, Qb, Kb, Vb, CROSS, C.vcu, SCAN_NIT);
    GRID_BAR();
#endif
    int scan_item = -1, scan_stride = SCAN_NIT, side_idx = -1, nside = 1;
    if (C.G == 256) { const int x_ = C.vcu >> 5, j_ = C.vcu & 31; if (j_ < 16) scan_item = x_ * 16 + j_; else side_idx = x_ * 16 + j_ - 16; nside = 128; }
    else if (C.G > SCAN_NIT) { if (C.vcu < SCAN_NIT) scan_item = C.vcu; else side_idx = C.vcu - SCAN_NIT; nside = C.G - SCAN_NIT; }
    else { scan_item = C.vcu; scan_stride = C.G; side_idx = C.vcu; nside = C.G; }
    P0In SI; SI.c = nullptr; SI.ada_w = nullptr; SI.ada_b = nullptr; SI.ret_w_in = nullptr; SI.ret_w_out = nullptr; SI.sgu_w_in = INP(float, 9); SI.sgu_w_out = INP(float, 15); SI.wq = INP(float, 16); SI.keys = nullptr; SI.pu = INP(float, 18); SI.pv = INP(float, 19); SI.pos = nullptr;
#ifdef DUP_SIDE
    if (side_idx >= 0) side_work<DUP_SIDE>(C, SI, side_idx, nside);
    GRID_BAR();
#endif
    if (C.G > SCAN_NIT) { if (scan_item >= 0) { if (PH(3)) scan_mfma<0>(C, Qb, Kb, Vb, CROSS, scan_item, scan_stride); } else side_work(C, SI, side_idx, nside); }
    else { if (PH(3)) scan_mfma<0>(C, Qb, Kb, Vb, CROSS, scan_item, scan_stride); __syncthreads(); side_work(C, SI, side_idx, nside); }
#endif
    GRID_BAR();
#ifdef USE_INTRA_NAIVE
    if (PH(4)) intra_naive(C, Qb, Kb, Vb, CROSS, Gb);
#else
    if (PH(4)) intra_mfma(C, Qb, Kb, Vb, CROSS, Gb);
#endif
    GRID_BAR();
    { pg8::Gemm g{Gb, WRO, TT, 1024, 2048}; pg8::StaticOrder S; S.init(TT, 1024, C.G, (int)blockIdx.x);
      pg8::EpiResGateT<false> E{INP(float, 0), XB, MOD0 + 2048, 6144};
#ifdef DUP_G5
      { pg8::EpiResGateT<false> E2{INP(float, 0), (bf16*)(ws + WS_R), MOD0 + 2048, 6144}; pg8::gemm_phase<pg8::EpiResGateT<false>, pg8::StaticOrder, true, true>(C.lds + RING_OFF, g, S, E2); GRID_BAR(); }
#endif
#ifdef DUP_G5B
      { pg8::EpiBf16<0> E2{(bf16*)(ws + WS_R), 1024, nullptr, 0, 0, 1.f}; pg8::gemm_phase<pg8::EpiBf16<0>, pg8::StaticOrder, true, true>(C.lds + RING_OFF, g, S, E2); GRID_BAR(); }
#endif
      if (PH(5)) pg8::gemm_phase<pg8::EpiResGateT<false>, pg8::StaticOrder, true, true>(C.lds + RING_OFF, g, S, E); }
    GRID_BAR();
    if (PH(6)) rms_mod_phase_b(C, XB, INP(float, 4), MOD0, 3072, 4096, H);
    GRID_BAR();
    { pg8::Gemm g{H, WQ, TT, 2048, 1024}; pg8::StaticOrder S; S.init(TT, 2048, C.G, (int)blockIdx.x);
      pg8::EpiBf16<0> E{QP, 2048, nullptr, 0, 0, 1.f};
      if (PH(7)) pg8::gemm_phase<pg8::EpiBf16<0>, pg8::StaticOrder, true, true>(C.lds + RING_OFF, g, S, E); }
    GRID_BAR();
#ifdef USE_TOPK_NAIVE
    if (PH(8)) peer_scores(C, QP, KEYS, SCO);
    GRID_BAR();
    if (PH(9)) peer_topk(C, SCO, IDX, GATE);
#else
#ifdef DUP_TOPK
    peer_topk_fused<DUP_TOPK>(C, QP, KEYS, IDX, GATE);
    GRID_BAR();
#endif
    if (PH(9)) peer_topk_fused<0>(C, QP, KEYS, IDX, GATE);
#endif
    GRID_BAR();
#ifdef DUP_GATHER
    GATHER_FN<false, DUP_GATHER_FAKE, DUP_GATHER_SKIP>(C, H, IDX, GATE, PU8, PV8, ISU, ISV, XB, (bf16*)(ws + WS_R), nullptr, MOD0 + 5120, INP(float, 3) + 1024, MOD1, (bf16*)(ws + WS_R + 128 * MiB));
    GRID_BAR();
#endif
    if (PH(10)) GATHER_FN<false>(C, H, IDX, GATE, PU8, PV8, ISU, ISV, XB, XB, nullptr, MOD0 + 5120, INP(float, 3) + 1024, MOD1, H);
    GRID_BAR();
#ifdef DUP_BAR
    for (int q_ = 0; q_ < 10; ++q_) { xcd_barrier_probe<DUP_BAR>(bar); asm volatile("" : "+v"(C.tid)); }
#endif
    { pg8::Gemm g{H, WSI, TT, 6144, 1024}; pg8::StaticOrder S; S.init(TT, 6144, C.G, (int)blockIdx.x);
      pg8::EpiSguIn E{Ub, VBb, INP(float, 10), STATS};
#ifdef DUP_G7
      pg8::gemm_phase<pg8::EpiSguIn, pg8::StaticOrder, true, true>(C.lds + RING_OFF, g, S, E); GRID_BAR();
#endif
      if (PH(11)) pg8::gemm_phase<pg8::EpiSguIn, pg8::StaticOrder, true, true>(C.lds + RING_OFF, g, S, E); }
    GRID_BAR();
    if (PH(12)) SGU_GATE_FN(C, Ub, VBb, STATS, INP(float, 13), INP(float, 14), INP(float, 11), INP(float, 12));
    GRID_BAR();
    { pg8::Gemm g{Ub, WSO, TT, 1024, 3072}; pg8::StaticOrder S; S.init(TT, 1024, C.G, (int)blockIdx.x);
      pg8::EpiResGateT<true> E{XB, XB, MOD1 + 2048, 6144};
      if (PH(13)) pg8::gemm_phase<pg8::EpiResGateT<true>, pg8::StaticOrder, true, true>(C.lds + RING_OFF, g, S, E); }
    GRID_BAR();
    if (PH(14)) rms_mod_phase_b(C, XB, INP(float, 4) + 1024, MOD1, 3072, 4096, H);
    GRID_BAR();
    { pg8::Gemm g{H, WQ + (size_t)2048 * 1024, TT, 2048, 1024}; pg8::StaticOrder S; S.init(TT, 2048, C.G, (int)blockIdx.x);
      pg8::EpiBf16<0> E{QP, 2048, nullptr, 0, 0, 1.f};
      if (PH(15)) pg8::gemm_phase<pg8::EpiBf16<0>, pg8::StaticOrder, true, true>(C.lds + RING_OFF, g, S, E); }
    GRID_BAR();
#ifdef USE_TOPK_NAIVE
    if (PH(16)) peer_scores(C, QP, KEYS + (size_t)8 * 2 * 128 * 128, SCO);
    GRID_BAR();
    if (PH(17)) peer_topk(C, SCO, IDX, GATE);
#else
    if (PH(17)) peer_topk_fused<0>(C, QP, KEYS + (size_t)8 * 2 * 128 * 128, IDX, GATE);
#endif
    GRID_BAR();
    if (PH(18)) GATHER_FN<true>(C, H, IDX, GATE, PU8 + (size_t)16384 * 1024, PV8 + (size_t)16384 * 1024, ISU + 16384, ISV + 16384, XB, nullptr, out, MOD1 + 5120, INP(float, 20), nullptr, nullptr);
#undef GRID_BAR
}

extern "C" void kernel_launch(void* const* d_in, const int* in_sizes, int n_in, void* d_out, int out_size, void* d_ws, size_t ws_size, hipStream_t stream) {
    static int grid = 0;
    if (grid == 0) {
        if (n_in != 21 || in_sizes[0] != TT * DM || out_size != TT * DM || ws_size < WS_END) { fprintf(stderr, "kernel_launch: unexpected shapes/workspace: n_in %d in0 %d out %d ws %zu (need %zu)\n", n_in, n_in > 0 ? in_sizes[0] : -1, out_size, ws_size, (size_t)WS_END); grid = -1; return; }
        int dev = 0, cus = 0;
        if (hipGetDevice(&dev) != hipSuccess || hipDeviceGetAttribute(&cus, hipDeviceAttributeMultiprocessorCount, dev) != hipSuccess) { fprintf(stderr, "kernel_launch: device query failed\n"); grid = -1; return; }
        if (hipFuncSetAttribute((const void*)mk_fwd, hipFuncAttributeMaxDynamicSharedMemorySize, LDS_BYTES) != hipSuccess) { fprintf(stderr, "kernel_launch: hipFuncSetAttribute failed\n"); grid = -1; return; }
        (void)hipGetLastError();
        grid = cus;
    }
    if (grid < 0) return;
    if (hipMemsetAsync((char*)d_ws + WS_CTL, 0, CTL_ZERO_BYTES, stream) != hipSuccess) { fprintf(stderr, "kernel_launch: memset failed\n"); return; }
    Args a; memset(&a, 0, sizeof(a));
    for (int i = 0; i < 21; ++i) a.in[i] = d_in[i];
    a.out = (float*)d_out; a.ws = (unsigned char*)d_ws;
    hipLaunchKernelGGL(mk_fwd, dim3(grid), dim3(NWAVES * 64), LDS_BYTES, stream, a);
    const hipError_t le = hipPeekAtLastError();
    if (le != hipSuccess) fprintf(stderr, "kernel_launch: launch failed: %s\n", hipGetErrorName(le));
}
```

```cpp
#define USE_GATHER_ROUNDS 1
#include <hip/hip_runtime.h>
#include <cstdio>
#include <cstdint>
#include <cstring>
#include <cmath>
namespace pg8 {
#define PG8_LAS __attribute__((address_space(3)))
typedef unsigned short bf16_t;
typedef short bf16x8 __attribute__((ext_vector_type(8)));
typedef float f32x4 __attribute__((ext_vector_type(4)));
typedef unsigned u32x4 __attribute__((ext_vector_type(4)));
constexpr int BM = 256, BK = 64, HALF = 128, HTB = HALF * BK * 2  , STAGE_BYTES = 8 * HTB, NXCD = 8, WGM = 8;

__host__ __device__ __forceinline__ int lds_byte(int r, int c) { const int st = (r >> 4) * 2 + (c >> 5), rr = r & 15, cc = c & 31, ob = rr * 64 + cc * 2; return st * 1024 + (ob ^ (((ob >> 9) & 1) << 5)); }
__host__ __device__ __forceinline__ void stage_rc(int b, int& R, int& C) { const int st = b / 1024, sb = b % 1024, swz = sb ^ (((sb >> 9) & 1) << 5); R = (st >> 1) * 16 + swz / 64; C = (st & 1) * 32 + (swz % 64) / 2; }
__host__ __device__ __forceinline__ int perm32(int rho) { const int n = rho >> 4, i = rho & 15; return 8 * (i >> 2) + 4 * n + (i & 3); }

struct Unit { int pm, pn; };
struct Gemm { const bf16_t* A; const bf16_t* Bt; int M, N, K; };

struct StaticOrder {
    int nM, nN, nwg, G, c;
    __host__ __device__ void init(int M, int N, int G_, int c_) { nM = M / BM; nN = N / BM; nwg = nM * nN; G = G_; c = c_; }
    __host__ __device__ bool next(int i, Unit& u) const {
        const long L = (long)i * G + c; if (L >= nwg) return false;
        int wgid = (int)L; { const int q = nwg / NXCD, r = nwg % NXCD, xcd = wgid % NXCD, off = wgid / NXCD; wgid = (xcd < r ? xcd * (q + 1) : r * (q + 1) + (xcd - r) * q) + off; }
        const int nig = WGM * nN, gid = wgid / nig, fm = gid * WGM, gsz = (nM - fm) < WGM ? (nM - fm) : WGM;
        u.pm = fm + ((wgid % nig) % gsz); u.pn = (wgid % nig) / gsz; return true;
    }
    __device__ __forceinline__ void a_ready(const Unit&) const {}
    __device__ __forceinline__ void done(const Unit&) const {}
};

__device__ __forceinline__ unsigned cvt_pk_bf16(float lo, float hi) { unsigned r; asm volatile("v_cvt_pk_bf16_f32 %0, %1, %2" : "=v"(r) : "v"(lo), "v"(hi)); return r; }
typedef float f32x2 __attribute__((ext_vector_type(2)));
__device__ __forceinline__ f32x2 gelu_pk(f32x2 v) {
    const f32x2 av = __builtin_elementwise_abs(v), d = av * 0.2316418882f + 1.0f;
    f32x2 t; t.x = __builtin_amdgcn_rcpf(d.x); t.y = __builtin_amdgcn_rcpf(d.y);
    f32x2 q = t * 0.5307027145f + (-0.7265760135f); q = q * t + 0.7107068705f; q = q * t + (-0.142248368f); q = q * t + 0.127414796f; q = q * t;
    const f32x2 s = (v * v) * (-0.72134752044f);
    f32x2 e; e.x = __builtin_amdgcn_exp2f(s.x); e.y = __builtin_amdgcn_exp2f(s.y);
    const f32x2 m = v * (q * e), r = v - m;
    f32x2 o; o.x = v.x < 0.f ? m.x : r.x; o.y = v.y < 0.f ? m.y : r.y; return o;
}

template <int ACT  > struct EpiBf16 {
    static constexpr bool PERM = true, AFTER_DRAIN = false; static_assert(ACT == 0 || ACT == 1, "EpiBf16: ACT is 0 (none) or 1 (gelu_pk)");
    bf16_t* O; int ldc; const float* bias; int split_cols; size_t split_stride; float scale0;
    __device__ __forceinline__ void operator()(const f32x4 (&acc)[2][2][4][2], const Unit& u, int wr, int wc, int fr, int fq) const {
        const int row0 = u.pm * BM + wr * 64 + fr; int colt = u.pn * BM; bf16_t* base = O;
        float sc = 1.f; if (split_cols) { const int t = colt / split_cols; base += (size_t)t * split_stride; colt -= t * split_cols; if (t == 0) sc = scale0; }
        const int col0 = colt + wc * 32 + 8 * fq, bcol0 = u.pn * BM + wc * 32 + 8 * fq;
        f32x4 bv[2][2];
#pragma unroll
        for (int bj = 0; bj < 2; ++bj)
#pragma unroll
            for (int n = 0; n < 2; ++n) bv[bj][n] = bias ? *(const f32x4*)(bias + bcol0 + bj * HALF + 4 * n) : (f32x4){0.f, 0.f, 0.f, 0.f};
#pragma unroll
        for (int ai = 0; ai < 2; ++ai)
#pragma unroll
            for (int m = 0; m < 4; ++m) { bf16_t* rowp = base + (size_t)(row0 + ai * HALF + m * 16) * ldc + col0;
#pragma unroll
                for (int bj = 0; bj < 2; ++bj) { f32x4 v0 = acc[ai][bj][m][0] + bv[bj][0], v1 = acc[ai][bj][m][1] + bv[bj][1];
                    if (ACT == 1) { f32x2 a = gelu_pk((f32x2){v0[0], v0[1]}), b = gelu_pk((f32x2){v0[2], v0[3]}), c = gelu_pk((f32x2){v1[0], v1[1]}), d = gelu_pk((f32x2){v1[2], v1[3]});
                        v0 = (f32x4){a.x, a.y, b.x, b.y}; v1 = (f32x4){c.x, c.y, d.x, d.y}; }
                    v0 = v0 * sc; v1 = v1 * sc; u32x4 w; w.x = cvt_pk_bf16(v0[0], v0[1]); w.y = cvt_pk_bf16(v0[2], v0[3]); w.z = cvt_pk_bf16(v1[0], v1[1]); w.w = cvt_pk_bf16(v1[2], v1[3]);
                    *(u32x4*)(rowp + bj * HALF) = w; } }
    }
};
template <class Epi, class Sched, bool ALIGN_EPI = false, bool SP2 = false>
__device__ __forceinline__ void gemm_phase(PG8_LAS unsigned char* lds, const Gemm g, const Sched& S, const Epi& E) {
    int tid_ = threadIdx.x; asm volatile("" : "+v"(tid_));
    const int tid = tid_, wid = __builtin_amdgcn_readfirstlane(tid >> 6), lane = tid & 63, wr = wid >> 2, wc = wid & 3, fr = lane & 15, fq = lane >> 4;
    const int K = g.K, nt = K / BK;
    unsigned voffA[2], voffB[2];
#pragma unroll
    for (int i = 0; i < 2; ++i) { int R, C; stage_rc(tid * 16 + i * 8192, R, C); const int Rb = Epi::PERM ? ((R & ~31) + perm32(R & 31)) : R;
        voffA[i] = (unsigned)(R * K + C) * 2u; voffB[i] = (unsigned)(Rb * K + C) * 2u; }
    const size_t kstep = (size_t)(BK * 2);
    const size_t hstep = (size_t)HALF * K * 2;
    const size_t tstep = 2 * hstep;
    const unsigned ldsw = (unsigned)wid * 1024u;
    const int aoff = lds_byte(wr * 64 + fr, fq * 8), boff = lds_byte(wc * 32 + fr, fq * 8);
#define PG8_SA(b, h) (((b) * 2 + (h)) * HTB)
#define PG8_SB(b, h) ((4 + (b) * 2 + (h)) * HTB)
#define PG8_STAGE(bufoff, gbase, voff) do { _Pragma("unroll") for (int _i = 0; _i < 2; ++_i) \
        __builtin_amdgcn_global_load_lds((const unsigned*)((const char*)(gbase) + (voff)[_i]), (PG8_LAS unsigned*)(lds + (bufoff) + ldsw + _i * 8192), 16, 0, 0); } while (0)
#define PG8_LDA(dst, b, h) do { _Pragma("unroll") for (int m = 0; m < 4; ++m) _Pragma("unroll") for (int k = 0; k < 2; ++k) dst[m][k] = *(const PG8_LAS bf16x8*)(lds + PG8_SA(b, h) + aoff + m * 2048 + k * 1024); } while (0)
#define PG8_LDB(dst, b, h) do { _Pragma("unroll") for (int n = 0; n < 2; ++n) _Pragma("unroll") for (int k = 0; k < 2; ++k) dst[n][k] = *(const PG8_LAS bf16x8*)(lds + PG8_SB(b, h) + boff + n * 2048 + k * 1024); } while (0)
#define PG8_MMA(ai, bj, At, Bt) do { __builtin_amdgcn_s_setprio(1); _Pragma("unroll") for (int m = 0; m < 4; ++m) _Pragma("unroll") for (int n = 0; n < 2; ++n) _Pragma("unroll") for (int k = 0; k < 2; ++k) \
        acc[ai][bj][m][n] = __builtin_amdgcn_mfma_f32_16x16x32_bf16(Bt[n][k], At[m][k], acc[ai][bj][m][n], 0, 0, 0); __builtin_amdgcn_s_setprio(0); } while (0)
#define PG8_WAIT_V(n) asm volatile("s_waitcnt vmcnt(" #n ")" ::: "memory")
#define PG8_WAIT_L(n) asm volatile("s_waitcnt lgkmcnt(" #n ")" ::: "memory")
#define PG8_BAR __builtin_amdgcn_s_barrier()
#define PG8_SCHED __builtin_amdgcn_sched_barrier(0)
    Unit cur, nxt; int ui = 0;
    if (!S.next(0, cur)) return;
    f32x4 acc[2][2][4][2];
#pragma unroll
    for (int a = 0; a < 2; ++a)
#pragma unroll
        for (int b = 0; b < 2; ++b)
#pragma unroll
            for (int m = 0; m < 4; ++m)
#pragma unroll
                for (int n = 0; n < 2; ++n) acc[a][b][m][n] = (f32x4){0.f, 0.f, 0.f, 0.f};
    bf16x8 At[4][2], B0[2][2], B1[2][2];
    const char* cA = (const char*)g.A + (size_t)cur.pm * tstep; const char* cB = (const char*)g.Bt + (size_t)cur.pn * tstep;
    S.a_ready(cur);
    if constexpr (SP2) {
        PG8_STAGE(PG8_SB(0, 0), cB, voffB); PG8_STAGE(PG8_SB(0, 1), cB + hstep, voffB); PG8_STAGE(PG8_SA(0, 0), cA, voffA); PG8_STAGE(PG8_SA(0, 1), cA + hstep, voffA);
        if (wr == 1) PG8_BAR;
        PG8_WAIT_V(2); PG8_BAR;
        PG8_STAGE(PG8_SB(1, 0), cB + kstep, voffB); PG8_STAGE(PG8_SA(1, 0), cA + kstep, voffA); PG8_STAGE(PG8_SB(1, 1), cB + hstep + kstep, voffB);
        PG8_WAIT_V(6); PG8_BAR;
    } else {
        PG8_STAGE(PG8_SB(0, 0), cB, voffB); PG8_STAGE(PG8_SA(0, 0), cA, voffA); PG8_STAGE(PG8_SB(0, 1), cB + hstep, voffB); PG8_STAGE(PG8_SA(0, 1), cA + hstep, voffA);
        if (wr == 1) PG8_BAR;
        PG8_WAIT_V(4); PG8_BAR;
        PG8_STAGE(PG8_SB(1, 0), cB + kstep, voffB); PG8_STAGE(PG8_SA(1, 0), cA + kstep, voffA); PG8_STAGE(PG8_SB(1, 1), cB + hstep + kstep, voffB);
        PG8_WAIT_V(6); PG8_BAR;
    }
    for (;;) {
        const bool has_next = S.next(ui + 1, nxt);
        const char* nA = has_next ? (const char*)g.A + (size_t)nxt.pm * tstep : cA; const char* nB = has_next ? (const char*)g.Bt + (size_t)nxt.pn * tstep : cB;
        for (int t = 0; t < nt; t += 2) {
            const bool last = (t == nt - 2);
            const char* a1 = cA + (size_t)(t + 1) * kstep;
            const char* a2 = last ? nA : cA + (size_t)(t + 2) * kstep; const char* b2 = last ? nB : cB + (size_t)(t + 2) * kstep;
            const char* a3 = a2 + kstep; const char* b3 = b2 + kstep;
            if (last && has_next) S.a_ready(nxt);
            if constexpr (SP2) {
            PG8_LDB(B0, 0, 0); PG8_LDB(B1, 0, 1); PG8_SCHED; PG8_LDA(At, 0, 0); PG8_STAGE(PG8_SA(1, 1), a1 + hstep, voffA);
            PG8_WAIT_V(8); PG8_WAIT_L(0); PG8_BAR; PG8_MMA(0, 0, At, B0); PG8_MMA(0, 1, At, B1); PG8_BAR; PG8_SCHED;
            PG8_LDA(At, 0, 1); PG8_STAGE(PG8_SB(0, 0), b2, voffB); PG8_STAGE(PG8_SB(0, 1), b2 + hstep, voffB); PG8_STAGE(PG8_SA(0, 0), a2, voffA);
            PG8_WAIT_V(8); PG8_WAIT_L(0); PG8_BAR; PG8_MMA(1, 0, At, B0); PG8_MMA(1, 1, At, B1); PG8_BAR; PG8_SCHED;
            PG8_LDB(B0, 1, 0); PG8_LDB(B1, 1, 1); PG8_SCHED; PG8_LDA(At, 1, 0); PG8_STAGE(PG8_SA(0, 1), a2 + hstep, voffA);
            PG8_WAIT_V(8); PG8_WAIT_L(0); PG8_BAR; PG8_MMA(0, 0, At, B0); PG8_MMA(0, 1, At, B1); PG8_BAR; PG8_SCHED;
            PG8_LDA(At, 1, 1); PG8_STAGE(PG8_SB(1, 0), b3, voffB); PG8_STAGE(PG8_SB(1, 1), b3 + hstep, voffB); PG8_STAGE(PG8_SA(1, 0), a3, voffA);
            PG8_WAIT_V(8); PG8_WAIT_L(0); PG8_BAR; PG8_MMA(1, 0, At, B0); PG8_MMA(1, 1, At, B1); PG8_BAR; PG8_SCHED;
            } else {
            PG8_LDB(B0, 0, 0); PG8_SCHED; PG8_LDA(At, 0, 0); PG8_STAGE(PG8_SA(1, 1), a1 + hstep, voffA);
            PG8_WAIT_L(8); PG8_BAR; PG8_WAIT_L(0); PG8_MMA(0, 0, At, B0); PG8_BAR; PG8_SCHED;
            PG8_LDB(B1, 0, 1); PG8_STAGE(PG8_SB(0, 0), b2, voffB);
            PG8_BAR; PG8_WAIT_L(0); PG8_MMA(0, 1, At, B1); PG8_BAR;
            PG8_LDA(At, 0, 1); PG8_STAGE(PG8_SA(0, 0), a2, voffA);
            PG8_BAR; PG8_WAIT_L(0); PG8_MMA(1, 0, At, B0); PG8_BAR; PG8_SCHED;
            PG8_STAGE(PG8_SB(0, 1), b2 + hstep, voffB);
            PG8_WAIT_V(6); PG8_BAR; PG8_MMA(1, 1, At, B1); PG8_BAR;
            PG8_LDB(B0, 1, 0); PG8_SCHED; PG8_LDA(At, 1, 0); PG8_STAGE(PG8_SA(0, 1), a2 + hstep, voffA);
            PG8_WAIT_L(8); PG8_BAR; PG8_WAIT_L(0); PG8_MMA(0, 0, At, B0); PG8_BAR; PG8_SCHED;
            PG8_LDB(B1, 1, 1); PG8_STAGE(PG8_SB(1, 0), b3, voffB);
            PG8_BAR; PG8_WAIT_L(0); PG8_MMA(0, 1, At, B1); PG8_BAR;
            PG8_LDA(At, 1, 1); PG8_STAGE(PG8_SA(1, 0), a3, voffA);
            PG8_BAR; PG8_WAIT_L(0); PG8_MMA(1, 0, At, B0); PG8_BAR; PG8_SCHED;
            PG8_STAGE(PG8_SB(1, 1), b3 + hstep, voffB);
            PG8_WAIT_V(6); PG8_BAR; PG8_MMA(1, 1, At, B1); PG8_BAR;
            }
        }
        if constexpr (ALIGN_EPI) { if (wr == 0) PG8_BAR; }
        if constexpr (!Epi::AFTER_DRAIN) { E(acc, cur, wr, wc, fr, fq); S.done(cur); }
        if (!has_next) break;
#pragma unroll
        for (int a = 0; a < 2; ++a)
#pragma unroll
            for (int b = 0; b < 2; ++b)
#pragma unroll
                for (int m = 0; m < 4; ++m)
#pragma unroll
                    for (int n = 0; n < 2; ++n) acc[a][b][m][n] = (f32x4){0.f, 0.f, 0.f, 0.f};
        cur = nxt; cA = nA; cB = nB; ++ui;
        if constexpr (ALIGN_EPI) { if (wr == 1) PG8_BAR; }
    }
    PG8_WAIT_V(0);
    if constexpr (!ALIGN_EPI) { if (wr == 0) PG8_BAR; }
    PG8_BAR;
    if constexpr (Epi::AFTER_DRAIN) { E.fused(acc, cur, wr, wc, fr, fq, lds, wid, lane); S.done(cur); }
#undef PG8_SA
#undef PG8_SB
#undef PG8_STAGE
#undef PG8_LDA
#undef PG8_LDB
#undef PG8_MMA
#undef PG8_WAIT_V
#undef PG8_WAIT_L
#undef PG8_BAR
#undef PG8_SCHED
}
}
namespace pg8 {
typedef unsigned u32x2 __attribute__((ext_vector_type(2)));
__device__ __forceinline__ float gelu_tanh(float x) {
    const float e = __builtin_amdgcn_exp2f(x * (-2.302208198f - 0.1029432397f * x * x));
    return x * __builtin_amdgcn_rcpf(1.0f + e);
}
__device__ __forceinline__ float silu_f(float x) { return x * __builtin_amdgcn_rcpf(1.0f + __builtin_amdgcn_exp2f(-1.4426950409f * x)); }

typedef _Float16 eh2_t __attribute__((ext_vector_type(2)));
struct EpiRetProj {
    static constexpr bool PERM = true, AFTER_DRAIN = false;
    bf16_t *Q, *K, *V, *G; const unsigned* trig;
    __device__ __forceinline__ void operator()(const f32x4 (&acc)[2][2][4][2], const Unit& u, int wr, int wc, int fr, int fq) const {
        const int pn = u.pn;
        if (pn < 8) {
            bf16_t* dst = pn < 4 ? Q : K; const int head = pn & 3; const float sc = pn < 4 ? 1.0f : 0.0625f;
            const int f0 = wc * 32 + 8 * fq;
#pragma unroll
            for (int ai = 0; ai < 2; ++ai) {
                u32x4 tg[4][2];
#pragma unroll
                for (int m = 0; m < 4; ++m) { const int row = u.pm * BM + ai * HALF + wr * 64 + m * 16 + fr; const unsigned* tp = trig + (size_t)row * 128 + f0;
                    tg[m][0] = *(const u32x4*)tp; tg[m][1] = *(const u32x4*)(tp + 4); }
#pragma unroll
                for (int m = 0; m < 4; ++m) {
                    const int row = u.pm * BM + ai * HALF + wr * 64 + m * 16 + fr;
                    u32x4 w1, w2;
#pragma unroll
                    for (int n = 0; n < 2; ++n) {
                        const f32x4 x1 = acc[ai][0][m][n], x2 = acc[ai][1][m][n]; float o1[4], o2[4];
#pragma unroll
                        for (int j = 0; j < 4; ++j) { const unsigned tw = tg[m][n][j]; const float c = (float)__builtin_bit_cast(_Float16, (unsigned short)(tw & 0xffffu)) * sc, sn = (float)__builtin_bit_cast(_Float16, (unsigned short)(tw >> 16)) * sc;
                            o1[j] = x1[j] * c - x2[j] * sn; o2[j] = x1[j] * sn + x2[j] * c; }
                        w1[2 * n] = cvt_pk_bf16(o1[0], o1[1]); w1[2 * n + 1] = cvt_pk_bf16(o1[2], o1[3]); w2[2 * n] = cvt_pk_bf16(o2[0], o2[1]); w2[2 * n + 1] = cvt_pk_bf16(o2[2], o2[3]);
                    }
                    bf16_t* p = dst + (size_t)row * 1024 + head * 256 + f0;
                    *(u32x4*)p = w1; *(u32x4*)(p + 128) = w2;
                }
            }
        } else {
            const bool isg = pn >= 16; bf16_t* dst = isg ? G : V; const int colbase = ((pn - 8) & 7) * 256 + wc * 32 + 8 * fq;
#pragma unroll
            for (int ai = 0; ai < 2; ++ai)
#pragma unroll
                for (int m = 0; m < 4; ++m) {
                    const int row = u.pm * BM + ai * HALF + wr * 64 + m * 16 + fr;
#pragma unroll
                    for (int bj = 0; bj < 2; ++bj) {
                        f32x4 v0 = acc[ai][bj][m][0], v1 = acc[ai][bj][m][1];
                        if (isg) {
#pragma unroll
                            for (int j = 0; j < 4; ++j) { v0[j] = silu_f(v0[j]); v1[j] = silu_f(v1[j]); } }
                        u32x4 w; w.x = cvt_pk_bf16(v0[0], v0[1]); w.y = cvt_pk_bf16(v0[2], v0[3]); w.z = cvt_pk_bf16(v1[0], v1[1]); w.w = cvt_pk_bf16(v1[2], v1[3]);
                        *(u32x4*)(dst + (size_t)row * 2048 + colbase + bj * HALF) = w;
                    }
                }
        }
    }
};
template <bool BF> struct EpiResGateT {
    static constexpr bool PERM = true, AFTER_DRAIN = false;
    const void* base; bf16_t* out; const float* gate; int gstride;
    __device__ __forceinline__ void operator()(const f32x4 (&acc)[2][2][4][2], const Unit& u, int wr, int wc, int fr, int fq) const {
        const int b = (u.pm * BM) >> 13; const float* gp = gate + (size_t)b * gstride;
        const int col0 = u.pn * BM + wc * 32 + 8 * fq;
        f32x4 gv[2][2];
#pragma unroll
        for (int bj = 0; bj < 2; ++bj)
#pragma unroll
            for (int n = 0; n < 2; ++n) gv[bj][n] = *(const f32x4*)(gp + col0 + bj * HALF + 4 * n);
#pragma unroll
        for (int ai = 0; ai < 2; ++ai)
#pragma unroll
            for (int m = 0; m < 4; ++m) {
                const size_t off = (size_t)(u.pm * BM + ai * HALF + wr * 64 + m * 16 + fr) * 1024 + col0;
#pragma unroll
                for (int bj = 0; bj < 2; ++bj) {
                    f32x4 b0, b1;
                    if (BF) { const u32x4 bw = *(const u32x4*)((const bf16_t*)base + off + bj * HALF);
                        b0[0] = __uint_as_float(bw.x << 16); b0[1] = __uint_as_float(bw.x & 0xffff0000u); b0[2] = __uint_as_float(bw.y << 16); b0[3] = __uint_as_float(bw.y & 0xffff0000u);
                        b1[0] = __uint_as_float(bw.z << 16); b1[1] = __uint_as_float(bw.z & 0xffff0000u); b1[2] = __uint_as_float(bw.w << 16); b1[3] = __uint_as_float(bw.w & 0xffff0000u); }
                    else { b0 = *(const f32x4*)((const float*)base + off + bj * HALF); b1 = *(const f32x4*)((const float*)base + off + bj * HALF + 4); }
                    const f32x4 y0 = b0 + gv[bj][0] * acc[ai][bj][m][0], y1 = b1 + gv[bj][1] * acc[ai][bj][m][1];
                    u32x4 w; w.x = cvt_pk_bf16(y0[0], y0[1]); w.y = cvt_pk_bf16(y0[2], y0[3]); w.z = cvt_pk_bf16(y1[0], y1[1]); w.w = cvt_pk_bf16(y1[2], y1[3]);
                    *(u32x4*)(out + off + bj * HALF) = w;
                }
            }
    }
};
struct EpiSguIn {
    static constexpr bool PERM = true, AFTER_DRAIN = false;
    bf16_t* U; bf16_t* Vb; const float* bias; float* stats;
    __device__ __forceinline__ void operator()(const f32x4 (&acc)[2][2][4][2], const Unit& u, int wr, int wc, int fr, int fq) const {
        const bool isv = u.pn >= 12; bf16_t* base = isv ? Vb : U; const int colt = (isv ? u.pn - 12 : u.pn) * BM;
        const int col0 = colt + wc * 32 + 8 * fq, bcol0 = u.pn * BM + wc * 32 + 8 * fq;
        f32x4 bv[2][2];
#pragma unroll
        for (int bj = 0; bj < 2; ++bj)
#pragma unroll
            for (int n = 0; n < 2; ++n) bv[bj][n] = *(const f32x4*)(bias + bcol0 + bj * HALF + 4 * n);
#pragma unroll
        for (int ai = 0; ai < 2; ++ai)
#pragma unroll
            for (int m = 0; m < 4; ++m) {
                const int row = u.pm * BM + ai * HALF + wr * 64 + m * 16 + fr;
                bf16_t* rowp = base + (size_t)row * 3072 + col0;
                float s1 = 0.f, s2 = 0.f;
#pragma unroll
                for (int bj = 0; bj < 2; ++bj) {
                    f32x4 v0 = acc[ai][bj][m][0] + bv[bj][0], v1 = acc[ai][bj][m][1] + bv[bj][1];
#pragma unroll
                    for (int j = 0; j < 4; ++j) { v0[j] = gelu_tanh(v0[j]); v1[j] = gelu_tanh(v1[j]); }
                    u32x4 w; w.x = cvt_pk_bf16(v0[0], v0[1]); w.y = cvt_pk_bf16(v0[2], v0[3]); w.z = cvt_pk_bf16(v1[0], v1[1]); w.w = cvt_pk_bf16(v1[2], v1[3]);
                    *(u32x4*)(rowp + bj * HALF) = w;
                    if (isv) {
#pragma unroll
                        for (int j = 0; j < 4; ++j) { const unsigned ww = j == 0 ? w.x : j == 1 ? w.y : j == 2 ? w.z : w.w;
                            const float a = __uint_as_float(ww << 16), bq = __uint_as_float(ww & 0xffff0000u); s1 += a + bq; s2 += a * a + bq * bq; }
                    }
                }
                if (isv) {
                    s1 += __shfl_xor(s1, 16); s1 += __shfl_xor(s1, 32); s2 += __shfl_xor(s2, 16); s2 += __shfl_xor(s2, 32);
                    if (fq == 0) { float* sp = stats + ((size_t)row * 48 + (u.pn - 12) * 4 + wc) * 2; sp[0] = s1; sp[1] = s2; }
                }
            }
    }
};
}
typedef unsigned u32x4 __attribute__((ext_vector_type(4)));
#define GAS __attribute__((address_space(1)))
#define LAS __attribute__((address_space(3)))
typedef unsigned short bf16;
typedef unsigned v4u __attribute__((ext_vector_type(4)));
typedef float f32x4 __attribute__((ext_vector_type(4)));
typedef short bf16x8 __attribute__((ext_vector_type(8)));
typedef GAS unsigned gu32;
typedef GAS unsigned long long gu64;
#define RLX_AGENT __ATOMIC_RELAXED, __HIP_MEMORY_SCOPE_AGENT
#define LDS_WAIT() asm volatile("s_waitcnt lgkmcnt(0)" ::: "memory")
#define VM_WAIT() asm volatile("s_waitcnt vmcnt(0)" ::: "memory")
__device__ __forceinline__ unsigned long long rt() { return __builtin_amdgcn_s_memrealtime(); }
__device__ __forceinline__ unsigned f2bf(float f) { unsigned u = __builtin_bit_cast(unsigned, f); return (u + 0x7fffu + ((u >> 16) & 1u)) >> 16; }
__device__ __forceinline__ unsigned pk2(float lo, float hi) { return f2bf(lo) | (f2bf(hi) << 16); }

#define XB_TMO      128
#define XB_XCNT(j)  (256  + 64 * (j))
#define XB_XSUB(j)  (1280 + 64 * (j))
#define XB_XGEN(j)  (2304 + 64 * (j))
#define XB_TOP      3328
#define XB_TOPGEN   3392
#define XCD_BAR_WORDS 3456
#define XB_SPIN_CAP (1u << 18)

__device__ __forceinline__ unsigned xb_ld(unsigned* p)              { return __hip_atomic_load(p, __ATOMIC_RELAXED, __HIP_MEMORY_SCOPE_AGENT); }
__device__ __forceinline__ unsigned xb_add(unsigned* p, unsigned v) { return __hip_atomic_fetch_add(p, v, __ATOMIC_RELAXED, __HIP_MEMORY_SCOPE_AGENT); }
__device__ __forceinline__ unsigned xb_xcc_id() { return (unsigned)__builtin_amdgcn_s_getreg((3 << 11) | 20) & 0xFu; }
#define XB_SPIN(cond, bar) do { unsigned _sp = 0; while (cond) { __builtin_amdgcn_s_sleep(1); \
    if ((++_sp & 255u) == 0u) { if (xb_ld(&(bar)[XB_TMO])) break; if (_sp > XB_SPIN_CAP) { atomicAdd(&(bar)[XB_TMO], 1u); break; } } } } while (0)

struct XcdBarrier {
    unsigned* bar; unsigned x;
    volatile LAS unsigned* st;
};

__device__ __forceinline__ XcdBarrier xcd_barrier_post(unsigned* bar, volatile LAS unsigned* st) {
    XcdBarrier b; b.bar = bar; b.x = xb_xcc_id(); b.st = st;
    if (threadIdx.x == 0) (void)xb_add(&bar[XB_XCNT(b.x)], 1u);
    return b;
}
__device__ __forceinline__ void xcd_barrier_complete(unsigned* bar, unsigned x, unsigned& nloc, unsigned& nx) {
    const unsigned G = gridDim.x * gridDim.y * gridDim.z;
    unsigned sum, cnt, mine, sp = 0u;
    for (;;) {
        sum = 0u; cnt = 0u; mine = 0u;
#pragma unroll
        for (unsigned j = 0; j < 16; ++j) { const unsigned c = xb_ld(&bar[XB_XCNT(j)]); sum += c; cnt += (c > 0u) ? 1u : 0u; mine = (j == x) ? c : mine; }
        if (sum == G) break;
        __builtin_amdgcn_s_sleep(1);
        if ((++sp & 255u) == 0u) { if (xb_ld(&bar[XB_TMO])) break; if (sp > XB_SPIN_CAP) { atomicAdd(&bar[XB_TMO], 1u); break; } }
    }
    nloc = mine > 0u ? mine : 1u; nx = cnt > 0u ? cnt : 1u;
}

__device__ __forceinline__ void xcd_barrier(const XcdBarrier& b) {
    asm volatile("s_waitcnt vmcnt(0)" ::: "memory");
    __syncthreads();
    if (threadIdx.x == 0) {
        unsigned* bar = b.bar;
        __builtin_amdgcn_s_waitcnt(0);
        unsigned nloc = b.st[0], nx = b.st[1];
        if (nloc == 0u) { xcd_barrier_complete(bar, b.x, nloc, nx); b.st[0] = nloc; b.st[1] = nx; }
        const unsigned old = xb_add(&bar[XB_XSUB(b.x)], 1u);
        const unsigned gen = old / nloc;
        if (old + 1u == (gen + 1u) * nloc) {
            __builtin_amdgcn_fence(__ATOMIC_RELEASE, "agent");
            asm volatile("s_waitcnt vmcnt(0)" ::: "memory");
            const unsigned og = xb_add(&bar[XB_TOP], 1u);
            const unsigned tg = og / nx;
            if (og + 1u == (tg + 1u) * nx) xb_add(&bar[XB_TOPGEN], 1u);
            else XB_SPIN(xb_ld(&bar[XB_TOPGEN]) == tg, bar);
            __builtin_amdgcn_fence(__ATOMIC_ACQUIRE, "agent");
            xb_add(&bar[XB_XGEN(b.x)], 1u);
            asm volatile("s_waitcnt vmcnt(0)" ::: "memory");
        } else {
            XB_SPIN(xb_ld(&bar[XB_XGEN(b.x)]) == gen, bar);
            __builtin_amdgcn_fence(__ATOMIC_ACQUIRE, "agent");
            asm volatile("s_waitcnt vmcnt(0)" ::: "memory");
        }
    }
    __syncthreads();
}
__device__ __forceinline__ float wave_sum(float v) {
#pragma unroll
    for (int o = 1; o < 64; o <<= 1) v += __shfl_xor(v, o);
    return v;
}
__device__ __forceinline__ void p0_transpose_item(const float* W, int K, int N, bf16* WT, int row_off, LAS float* scr, int item, int lane) {
    const int nblk = N / 32, kb = item / nblk, nb = item % nblk, k0 = 64 * kb, n0 = 32 * nb;
    { f32x4 tv_[8]; const int c4 = (lane & 7) * 4;
#pragma unroll
      for (int i = 0; i < 8; ++i) tv_[i] = *(const f32x4*)(W + (size_t)(k0 + 8 * i + (lane >> 3)) * N + n0 + c4);
#pragma unroll
      for (int i = 0; i < 8; ++i) { LAS float* d_ = scr + (8 * i + (lane >> 3)) * 33 + c4; d_[0] = tv_[i][0]; d_[1] = tv_[i][1]; d_[2] = tv_[i][2]; d_[3] = tv_[i][3]; } }
    LDS_WAIT(); asm volatile("" ::: "memory");
    const int c = lane & 7;
#pragma unroll
    for (int j = 0; j < 4; ++j) { const int n = (lane >> 3) + 8 * j; const LAS float* s = scr + (8 * c) * 33 + n;
        v4u o; o.x = pk2(s[0 * 33], s[1 * 33]); o.y = pk2(s[2 * 33], s[3 * 33]); o.z = pk2(s[4 * 33], s[5 * 33]); o.w = pk2(s[6 * 33], s[7 * 33]);
        *(GAS v4u*)(WT + (size_t)(row_off + n0 + n) * K + k0 + 8 * c) = o; }
    LDS_WAIT(); asm volatile("" ::: "memory");
}
#define DI __device__ __forceinline__
constexpr int NWAVES = 8;
constexpr int TT = 16384, DM = 1024, SEQ = 8192;
constexpr size_t MiB = 1u << 20;
constexpr size_t WS_CTL = 0, CTL_ZERO_BYTES = 32768, WS_MOD = 512 * 1024;
constexpr size_t WS_COS = 2 * MiB, WS_SIN = 10 * MiB;
constexpr size_t WS_WRI = 18 * MiB, WS_WRO = 30 * MiB, WS_WSI = 34 * MiB, WS_WSO = 46 * MiB, WS_WQ = 52 * MiB, WS_KEYS = 60 * MiB;
constexpr size_t WS_ISU = 61 * MiB, WS_ISV = 61 * MiB + 256 * 1024;
constexpr size_t WS_STATS = 62 * MiB, WS_IDX = 68 * MiB, WS_GATE = 76 * MiB, WS_H = 84 * MiB, WS_PU = 116 * MiB, WS_PV = 180 * MiB;
constexpr size_t WS_R = 244 * MiB;
constexpr size_t WS_Q = WS_R, WS_K = WS_R + 32 * MiB, WS_V = WS_R + 64 * MiB, WS_G = WS_R + 128 * MiB, WS_CROSS = WS_R + 192 * MiB;
constexpr size_t WS_XB = WS_R + 192 * MiB;
constexpr size_t WS_QP = WS_R, WS_SC = WS_R + 64 * MiB;
constexpr size_t WS_U = WS_R, WS_VB = WS_R + 96 * MiB;
constexpr size_t WS_END = 500 * MiB;
constexpr int CW_TMO = 0, CW_BAR = 4096;
constexpr int RING_OFF = 0, RING_BYTES = 131072, LDS_BYTES = 163840, LDSCTL_OFF = LDS_BYTES - 1024, MISC_OFF = LDSCTL_OFF + 320;
constexpr int PTR_OFF = LDSCTL_OFF + 512;
constexpr float EPS = 1e-6f;
typedef float f32x2_t __attribute__((ext_vector_type(2)));

DI float bf2f(bf16 h) { return __uint_as_float((unsigned)h << 16); }
DI float bflo(unsigned w) { return __uint_as_float(w << 16); }
DI float bfhi(unsigned w) { return __uint_as_float(w & 0xffff0000u); }
DI float wave_max(float v) {
#pragma unroll
    for (int o = 1; o < 64; o <<= 1) v = fmaxf(v, __shfl_xor(v, o));
    return v;
}
DI float gelu_t(float x) { return pg8::gelu_tanh(x); }

struct Ctx {
    LAS unsigned char* lds; int tid, lane, wave, vcu, G;
    unsigned char* ws;
};

DI const void* ldp(const Ctx& C, int i) {
    const unsigned long long v = ((const LAS unsigned long long*)(C.lds + PTR_OFF))[i];
    const unsigned lo = __builtin_amdgcn_readfirstlane((unsigned)v), hi = __builtin_amdgcn_readfirstlane((unsigned)(v >> 32));
    return (const void*)(((unsigned long long)hi << 32) | lo);
}
DI void cvt_rows_fp8(const float* src, unsigned char* dst, float* inv_scale, int nrows, int gw, int NGW, int lane) {
    for (int r = gw; r < nrows; r += NGW) {
        const f32x4* s = (const f32x4*)(src + (size_t)r * 1024) + lane * 4;
        f32x4 v[4]; float am = 0.f;
#pragma unroll
        for (int q = 0; q < 4; ++q) { v[q] = s[q]; am = fmaxf(am, fmaxf(fmaxf(fabsf(v[q][0]), fabsf(v[q][1])), fmaxf(fabsf(v[q][2]), fabsf(v[q][3])))); }
        am = wave_max(am);
        const int e = (int)((__float_as_uint(am) >> 23) & 0xffu) - 127;
        const bool ok = am > 1e-30f;
        const float sc = ok ? __uint_as_float((unsigned)(127 + 7 - e) << 23) : 1.0f, isc = ok ? __uint_as_float((unsigned)(127 - 7 + e) << 23) : 1.0f;
        u32x4 o;
#pragma unroll
        for (int q = 0; q < 4; ++q) { int wd = __builtin_amdgcn_cvt_pk_fp8_f32(v[q][0] * sc, v[q][1] * sc, 0, false); wd = __builtin_amdgcn_cvt_pk_fp8_f32(v[q][2] * sc, v[q][3] * sc, wd, true); o[q] = (unsigned)wd; }
        *(u32x4*)(dst + (size_t)r * 1024 + lane * 16) = o;
        if (lane == 0) inv_scale[r] = isc;
    }
}
DI void cvt_rows_i8(const float* src, unsigned char* dst, float* inv_scale, int nrows, int gw, int NGW, int lane) {
    for (int r = gw; r < nrows; r += NGW) {
        const f32x4* s = (const f32x4*)(src + (size_t)r * 1024) + lane * 4;
        f32x4 v[4]; float am = 0.f;
#pragma unroll
        for (int q = 0; q < 4; ++q) { v[q] = s[q]; am = fmaxf(am, fmaxf(fmaxf(fabsf(v[q][0]), fabsf(v[q][1])), fmaxf(fabsf(v[q][2]), fabsf(v[q][3])))); }
        am = wave_max(am);
        const int e = (int)((__float_as_uint(am) >> 23) & 0xffu) - 127;
        const bool ok = am > 1e-30f;
        const float sc = ok ? __uint_as_float((unsigned)(127 + 6 - e) << 23) : 1.0f, isc = ok ? __uint_as_float((unsigned)(127 - 6 + e) << 23) : 1.0f;
        u32x4 o;
#pragma unroll
        for (int q = 0; q < 4; ++q) { unsigned wd = 0u;
#pragma unroll
            for (int j = 0; j < 4; ++j) { int qi = (int)rintf(v[q][j] * sc); qi = qi > 127 ? 127 : (qi < -127 ? -127 : qi); wd |= ((unsigned)qi & 0xffu) << (8 * j); }
            o[q] = wd; }
        *(u32x4*)(dst + (size_t)r * 1024 + lane * 16) = o;
        if (lane == 0) inv_scale[r] = isc;
    }
}
DI void cvt_stream(const float* src, bf16* dst, size_t n4, size_t gtid, size_t gthreads) {
    const f32x4* s = (const f32x4*)src; uint2* d = (uint2*)dst;
    for (size_t i = gtid; i < n4; i += gthreads) { const f32x4 v = s[i]; uint2 o; o.x = pk2(v.x, v.y); o.y = pk2(v.z, v.w); d[i] = o; }
}
struct P0In { const float *c, *ada_w, *ada_b, *ret_w_in, *ret_w_out, *sgu_w_in, *sgu_w_out, *wq, *keys, *pu, *pv; const int* pos; };
DI void p0_prologue(const Ctx& C, const P0In& I) {
    LAS float* scr = (LAS float*)(C.lds + RING_OFF + C.wave * 16384);
    const int gw = C.vcu * NWAVES + C.wave, NGW = C.G * NWAVES;
    bf16* wri = (bf16*)(C.ws + WS_WRI); bf16* wro = (bf16*)(C.ws + WS_WRO);
    constexpr int I_RI = 16 * 192, I_RO = 32 * 32;
    constexpr int NITEMS = I_RI + I_RO;
    for (int it = gw; it < NITEMS; it += NGW) {
        int r = it;
        if (r < I_RI) { p0_transpose_item(I.ret_w_in, 1024, 6144, wri, 0, scr, r, C.lane); continue; } r -= I_RI;
        p0_transpose_item(I.ret_w_out, 2048, 1024, wro, 0, scr, r, C.lane);
    }
    const size_t gtid = (size_t)C.vcu * 512 + C.tid, gth = (size_t)C.G * 512;
    cvt_stream(I.keys, (bf16*)(C.ws + WS_KEYS), (size_t)2 * 8 * 2 * 128 * 128 / 4, gtid, gth);
    float* mod = (float*)(C.ws + WS_MOD);
    __syncthreads();
    for (int it = C.vcu; it < 2 * 96; it += C.G) {
        const int l = it / 96, cb = it % 96, kp = C.wave, n = cb * 64 + C.lane;
        const float* W = I.ada_w + (size_t)l * 1024 * 6144 + n;
        float a0 = 0.f, a1 = 0.f;
#pragma unroll 8
        for (int k = kp * 128; k < kp * 128 + 128; ++k) {
            const float w = W[(size_t)k * 6144]; const float c0 = I.c[k], c1 = I.c[1024 + k];
            a0 += pg8::silu_f(c0) * w; a1 += pg8::silu_f(c1) * w;
        }
        LAS float* red = (LAS float*)(C.lds + RING_OFF);
        red[(kp * 2 + 0) * 64 + C.lane] = a0; red[(kp * 2 + 1) * 64 + C.lane] = a1;
        __syncthreads();
        if (C.wave < 2) { float s = I.ada_b[l * 6144 + n];
#pragma unroll
            for (int q = 0; q < 8; ++q) s += red[(q * 2 + C.wave) * 64 + C.lane];
            mod[(size_t)(l * 2 + C.wave) * 6144 + n] = s; }
        __syncthreads();
    }
    unsigned* trg = (unsigned*)(C.ws + WS_COS);
    typedef _Float16 ph2_t __attribute__((ext_vector_type(2)));
    for (int it = gw; it < TT / 2; it += NGW) {
        const int row = 2 * it + (C.lane >> 5), f0 = (C.lane & 31) * 4; const float p = (float)I.pos[row];
        u32x4 tv;
#pragma unroll
        for (int j = 0; j < 4; ++j) { const int f = f0 + j; double w = 1.0, bs = 0.93057204092969898;
#pragma unroll
            for (int bit = 0; bit < 7; ++bit) { if ((f >> bit) & 1) w *= bs; bs *= bs; }
            const float ang = p * (float)w; const double r = (double)ang * 0.15915494309189535; const float fr = (float)(r - floor(r));
            const unsigned clo_ = __builtin_bit_cast(unsigned short, (_Float16)__builtin_amdgcn_cosf(fr)), shi_ = __builtin_bit_cast(unsigned short, (_Float16)__builtin_amdgcn_sinf(fr)); tv[j] = clo_ | (shi_ << 16); }
        *(u32x4*)(trg + (size_t)row * 128 + f0) = tv;
    }
}
template <int SKIP = 0> DI void side_work(const Ctx& C, const P0In& I, int sidx, int nside) {
    LAS float* scr = (LAS float*)(C.lds + RING_OFF + C.wave * 16384);
    const int gw = sidx * NWAVES + C.wave, NGW = nside * NWAVES;
    bf16* wsi = (bf16*)(C.ws + WS_WSI); bf16* wso = (bf16*)(C.ws + WS_WSO); bf16* wq = (bf16*)(C.ws + WS_WQ);
    constexpr int I_SI = 16 * 192, I_SO = 48 * 32, I_Q = 16 * 64;
    constexpr int NITEMS = I_SI + I_SO + 2 * I_Q;
    if (!(SKIP & 1))
    for (int it = gw; it < NITEMS; it += NGW) {
        int r = it;
        if (r < I_SI) { p0_transpose_item(I.sgu_w_in, 1024, 6144, wsi, 0, scr, r, C.lane); continue; } r -= I_SI;
        if (r < I_SO) { p0_transpose_item(I.sgu_w_out, 3072, 1024, wso, 0, scr, r, C.lane); continue; } r -= I_SO;
        if (r < I_Q) { p0_transpose_item(I.wq, 1024, 2048, wq, 0, scr, r, C.lane); continue; } r -= I_Q;
        p0_transpose_item(I.wq + (size_t)1024 * 2048, 1024, 2048, wq + (size_t)2048 * 1024, 0, scr, r, C.lane);
    }
    if (!(SKIP & 2))
    cvt_rows_i8(I.pu, (unsigned char*)(C.ws + WS_PU), (float*)(C.ws + WS_ISU), 2 * 16384, gw, NGW, C.lane);
    if (!(SKIP & 4))
    cvt_rows_fp8(I.pv, (unsigned char*)(C.ws + WS_PV), (float*)(C.ws + WS_ISV), 2 * 16384, gw, NGW, C.lane);
}
DI void rms_mod_row(const float* xrow, const float* gain, const float* shift, const float* scale, bf16* orow, int lane) {
    const f32x4* xr = (const f32x4*)xrow + lane; f32x4 v[4]; float s = 0.f;
#pragma unroll
    for (int j = 0; j < 4; ++j) { v[j] = xr[64 * j]; s += (v[j].x * v[j].x + v[j].y * v[j].y) + (v[j].z * v[j].z + v[j].w * v[j].w); }
    const float rstd = 1.0f / sqrtf(wave_sum(s) * (1.0f / 1024.0f) + EPS);
    uint2* o8 = (uint2*)orow + lane;
#pragma unroll
    for (int j = 0; j < 4; ++j) { const f32x4 g = ((const f32x4*)gain)[lane + 64 * j], sh = ((const f32x4*)shift)[lane + 64 * j], sc = ((const f32x4*)scale)[lane + 64 * j];
        const f32x4 y = v[j] * rstd * g * (sc + 1.0f) + sh; uint2 o; o.x = pk2(y.x, y.y); o.y = pk2(y.z, y.w); o8[64 * j] = o; }
}
DI void rms_mod_row_b(const bf16* xrow, const float* gain, const float* shift, const float* scale, bf16* orow, int lane) {
    const uint2* xr = (const uint2*)xrow + lane; f32x4 v[4]; float s = 0.f;
#pragma unroll
    for (int j = 0; j < 4; ++j) { const uint2 w = xr[64 * j]; v[j].x = __uint_as_float(w.x << 16); v[j].y = __uint_as_float(w.x & 0xffff0000u); v[j].z = __uint_as_float(w.y << 16); v[j].w = __uint_as_float(w.y & 0xffff0000u);
        s += (v[j].x * v[j].x + v[j].y * v[j].y) + (v[j].z * v[j].z + v[j].w * v[j].w); }
    const float rstd = 1.0f / sqrtf(wave_sum(s) * (1.0f / 1024.0f) + EPS);
    uint2* o8 = (uint2*)orow + lane;
#pragma unroll
    for (int j = 0; j < 4; ++j) { const f32x4 g = ((const f32x4*)gain)[lane + 64 * j], sh = ((const f32x4*)shift)[lane + 64 * j], sc = ((const f32x4*)scale)[lane + 64 * j];
        const f32x4 y = v[j] * rstd * g * (sc + 1.0f) + sh; uint2 o; o.x = pk2(y.x, y.y); o.y = pk2(y.z, y.w); o8[64 * j] = o; }
}
DI void rms_mod_phase_b(const Ctx& C, const bf16* x, const float* gain, const float* mod_l, int sh_off, int sc_off, bf16* H) {
    const int gw = C.vcu * NWAVES + C.wave, NGW = C.G * NWAVES;
    for (int m = gw; m < TT; m += NGW) { const float* ml = mod_l + (size_t)(m >> 13) * 6144; rms_mod_row_b(x + (size_t)m * DM, gain, ml + sh_off, ml + sc_off, H + (size_t)m * DM, C.lane); }
}
DI void rms_mod_phase(const Ctx& C, const float* x, const float* gain, const float* mod_l, int sh_off, int sc_off, bf16* H) {
    const int gw = C.vcu * NWAVES + C.wave, NGW = C.G * NWAVES;
    for (int m = gw; m < TT; m += NGW) { const float* ml = mod_l + (size_t)(m >> 13) * 6144; rms_mod_row(x + (size_t)m * DM, gain, ml + sh_off, ml + sc_off, H + (size_t)m * DM, C.lane); }
}

DI void scan_naive(const Ctx& C, const bf16* Q, const bf16* K, const bf16* V, bf16* CROSS) {
    LAS float* Sst = (LAS float*)(C.lds);
    LAS unsigned* Qs = (LAS unsigned*)(C.lds + 16384);
    LAS bf16* Ks = (LAS bf16*)(C.lds + 16384 + 32768);
    LAS float* Vs = (LAS float*)(C.lds + 16384 + 65536);
    const int tid = C.tid;
    for (int item = C.vcu; item < 256; item += C.G) {
        const int b = item >> 7, h = (item >> 5) & 3, es = item & 31;
        const float lg2 = log2f(1.0f - exp2f(-5.0f - (float)h)); const float gc = exp2f(lg2 * 64.0f);
        for (int i = tid; i < 4096; i += 512) Sst[i] = 0.f;
        __syncthreads();
        for (int n = 0; n < 128; ++n) {
            const size_t tok0 = (size_t)b * SEQ + (size_t)n * 64;
            for (int ch = tid; ch < 2048; ch += 512) { const int r = ch >> 5, c = ch & 31;
                const u32x4 q = *(const u32x4*)(Q + (tok0 + r) * 1024 + h * 256 + c * 8); *(LAS u32x4*)(Qs + r * 128 + c * 4) = q;
                const u32x4 k = *(const u32x4*)(K + (tok0 + r) * 1024 + h * 256 + c * 8); *(LAS u32x4*)((LAS unsigned*)Ks + r * 128 + c * 4) = k; }
            for (int o = tid; o < 1024; o += 512) { const int j = o >> 4, e = o & 15; Vs[o] = bf2f(V[(tok0 + j) * 2048 + h * 512 + es * 16 + e]) * exp2f(lg2 * (float)(63 - j)); }
            __syncthreads();
#pragma unroll
            for (int oo = 0; oo < 2; ++oo) { const int o = tid + oo * 512, i = o >> 4, e = o & 15; float acc = 0.f;
#pragma unroll 8
                for (int d2 = 0; d2 < 128; ++d2) { const unsigned q2 = Qs[i * 128 + d2]; acc += bflo(q2) * Sst[(2 * d2) * 16 + e] + bfhi(q2) * Sst[(2 * d2 + 1) * 16 + e]; }
                CROSS[(tok0 + i) * 2048 + h * 512 + es * 16 + e] = (bf16)f2bf(acc * exp2f(lg2 * (float)(i + 1))); }
            __syncthreads();
            { const int e = tid & 15, dg = tid >> 4; float a[8];
#pragma unroll
              for (int r = 0; r < 8; ++r) a[r] = gc * Sst[(dg + 32 * r) * 16 + e];
#pragma unroll 4
              for (int j = 0; j < 64; ++j) { const float vz = Vs[j * 16 + e];
#pragma unroll
                  for (int r = 0; r < 8; ++r) a[r] += bf2f(Ks[j * 256 + dg + 32 * r]) * vz; }
#pragma unroll
              for (int r = 0; r < 8; ++r) Sst[(dg + 32 * r) * 16 + e] = a[r]; }
            __syncthreads();
        }
    }
}
DI void intra_naive(const Ctx& C, const bf16* Q, const bf16* K, const bf16* V, const bf16* CROSS, bf16* G) {
    LAS unsigned* Qs = (LAS unsigned*)(C.lds);
    LAS unsigned* Ks = (LAS unsigned*)(C.lds + 32768);
    LAS float* SC = (LAS float*)(C.lds + 65536);
    LAS float* red = (LAS float*)(C.lds + 65536 + 16384);
    LAS float* rs = red + 512;
    const int tid = C.tid;
    for (int item = C.vcu; item < 1024; item += C.G) {
        const int b = item >> 9, h = (item >> 7) & 3, n = item & 127;
        const float lg2 = log2f(1.0f - exp2f(-5.0f - (float)h));
        const size_t tok0 = (size_t)b * SEQ + (size_t)n * 64;
        for (int ch = tid; ch < 2048; ch += 512) { const int r = ch >> 5, c = ch & 31;
            *(LAS u32x4*)(Qs + r * 128 + c * 4) = *(const u32x4*)(Q + (tok0 + r) * 1024 + h * 256 + c * 8);
            *(LAS u32x4*)(Ks + r * 128 + c * 4) = *(const u32x4*)(K + (tok0 + r) * 1024 + h * 256 + c * 8); }
        __syncthreads();
        { const int i = tid >> 3, jb = (tid & 7) * 8;
#pragma unroll
          for (int jj = 0; jj < 8; ++jj) { const int j = jb + jj; float acc = 0.f;
#pragma unroll 8
              for (int d2 = 0; d2 < 128; ++d2) { const unsigned q2 = Qs[i * 128 + d2], k2 = Ks[j * 128 + d2]; acc += bflo(q2) * bflo(k2) + bfhi(q2) * bfhi(k2); }
              const int dd = i > j ? i - j : j - i; SC[i * 64 + j] = acc * exp2f(lg2 * (float)dd); } }
        __syncthreads();
#pragma unroll 1
        for (int pass = 0; pass < 2; ++pass) { const int e = tid, ib = pass * 32; float y[32];
#pragma unroll
          for (int i = 0; i < 32; ++i) y[i] = 0.f;
          const bf16* vp = V + tok0 * 2048 + h * 512 + e;
#pragma unroll 1
          for (int j4 = 0; j4 < 16; ++j4) {
              const float v0 = bf2f(vp[(size_t)(4 * j4 + 0) * 2048]), v1 = bf2f(vp[(size_t)(4 * j4 + 1) * 2048]), v2 = bf2f(vp[(size_t)(4 * j4 + 2) * 2048]), v3 = bf2f(vp[(size_t)(4 * j4 + 3) * 2048]);
#pragma unroll
              for (int i = 0; i < 32; ++i) { const f32x4 s4 = *(const LAS f32x4*)(SC + (ib + i) * 64 + 4 * j4); y[i] += (s4.x * v0 + s4.y * v1) + (s4.z * v2 + s4.w * v3); }
          }
          const bf16* cp = CROSS + (tok0 + ib) * 2048 + h * 512 + e;
#pragma unroll
          for (int i = 0; i < 32; ++i) { y[i] += bf2f(cp[(size_t)i * 2048]); const float ss = wave_sum(y[i] * y[i]); if (C.lane == 0) red[C.wave * 64 + i] = ss; }
          __syncthreads();
          if (tid < 32) { float s = 0.f;
#pragma unroll
              for (int w = 0; w < 8; ++w) s += red[w * 64 + tid];
              rs[tid] = 1.0f / sqrtf(s * (1.0f / 512.0f) + EPS); }
          __syncthreads();
          bf16* gp = G + (tok0 + ib) * 2048 + h * 512 + e;
#pragma unroll
          for (int i = 0; i < 32; ++i) { const float g = bf2f(gp[(size_t)i * 2048]); gp[(size_t)i * 2048] = (bf16)f2bf(y[i] * rs[i] * g); }
          __syncthreads();
        }
        __syncthreads();
    }
}
DI void peer_scores(const Ctx& C, const bf16* QP, const bf16* KEYS  , float* SCO) {
    const int gw = C.vcu * NWAVES + C.wave, NGW = C.G * NWAVES; const int fr = C.lane & 15, fq = C.lane >> 4;
    for (int it = gw; it < 1024 * 8; it += NGW) {
        const int tt = it >> 3, h = it & 7; const int tok = tt * 16 + fr;
#pragma unroll
        for (int p = 0; p < 2; ++p) {
            bf16x8 qf[4];
#pragma unroll
            for (int ks = 0; ks < 4; ++ks) qf[ks] = *(const bf16x8*)(QP + (size_t)tok * 2048 + h * 256 + p * 128 + ks * 32 + fq * 8);
            const bf16* kb = KEYS + (size_t)(h * 2 + p) * 128 * 128;
#pragma unroll
            for (int kt = 0; kt < 8; ++kt) {
                f32x4 acc = {0.f, 0.f, 0.f, 0.f};
#pragma unroll
                for (int ks = 0; ks < 4; ++ks) { const bf16x8 kf = *(const bf16x8*)(kb + (size_t)(kt * 16 + fr) * 128 + ks * 32 + fq * 8);
                    acc = __builtin_amdgcn_mfma_f32_16x16x32_bf16(kf, qf[ks], acc, 0, 0, 0); }
                *(f32x4*)(SCO + ((size_t)tok * 8 + h) * 256 + p * 128 + kt * 16 + fq * 4) = acc;
            }
        }
    }
}
template <bool HALVES> DI void select16(const float (&v)[4], int lane, bool (&sel)[4], int (&pos)[4]) {
    float mx = fmaxf(fmaxf(v[0], v[1]), fmaxf(v[2], v[3])), mn = fminf(fminf(v[0], v[1]), fminf(v[2], v[3]));
#pragma unroll
    for (int o = 1; o < (HALVES ? 32 : 64); o <<= 1) { mx = fmaxf(mx, __shfl_xor(mx, o)); mn = fminf(mn, __shfl_xor(mn, o)); }
    const bool up = HALVES && lane >= 32;
    float lo = mn, hi = mx, thr = mn; bool done = false;
    for (int iter = 0; iter < 48; ++iter) {
        const float mid = done ? thr : 0.5f * (lo + hi);
        int cnt = 0;
#pragma unroll
        for (int c = 0; c < 4; ++c) { const unsigned long long m = __ballot(v[c] >= mid);
            cnt += HALVES ? (up ? __popc((unsigned)(m >> 32)) : __popc((unsigned)m)) : __popcll(m); }
        if (!done) { if (cnt == 16) { thr = mid; done = true; } else if (cnt > 16) { lo = mid; thr = mid; } else hi = mid; }
        if (__all(done)) break;
    }
    int base = 0;
#pragma unroll
    for (int c = 0; c < 4; ++c) { sel[c] = v[c] >= thr; const unsigned long long m = __ballot(sel[c]);
        const unsigned long long gm = HALVES ? (up ? (m >> 32) : (m & 0xffffffffull)) : m; const int ll = HALVES ? (lane & 31) : lane;
        pos[c] = base + __popcll(gm & ((1ull << ll) - 1ull)); base += __popcll(gm); sel[c] = sel[c] && pos[c] < 16; }
}
DI void peer_topk(const Ctx& C, const float* SCO, int* IDX, float* GATE) {
    LAS float* sv = (LAS float*)(C.lds + C.wave * 512);
    LAS int* si = (LAS int*)(C.lds + C.wave * 512 + 128);
    LAS float* fv = (LAS float*)(C.lds + C.wave * 512 + 256);
    LAS int* fi = (LAS int*)(C.lds + C.wave * 512 + 320);
    const int gw = C.vcu * NWAVES + C.wave, NGW = C.G * NWAVES, lane = C.lane;
    for (int it = gw; it < TT * 8; it += NGW) {
        const f32x4 s4 = *(const f32x4*)(SCO + (size_t)it * 256 + lane * 4);
        float v[4] = {s4.x, s4.y, s4.z, s4.w}; bool sel[4]; int pos[4];
        select16<true>(v, lane, sel, pos);
        const int p = lane >> 5;
#pragma unroll
        for (int c = 0; c < 4; ++c) if (sel[c]) { sv[p * 16 + pos[c]] = v[c]; si[p * 16 + pos[c]] = (lane & 31) * 4 + c; }
        LDS_WAIT();
        const int a = lane >> 2, bq = (lane & 3) * 4; const float va = sv[a]; const int ia = si[a];
        float w[4]; int wi[4];
#pragma unroll
        for (int c = 0; c < 4; ++c) { w[c] = va + sv[16 + bq + c]; wi[c] = ia * 128 + si[16 + bq + c]; }
        select16<false>(w, lane, sel, pos);
#pragma unroll
        for (int c = 0; c < 4; ++c) if (sel[c]) { fv[pos[c]] = w[c]; fi[pos[c]] = wi[c]; }
        LDS_WAIT();
        const float x = fv[lane & 15]; const int xi = fi[lane & 15];
        float m = x;
#pragma unroll
        for (int o = 1; o < 16; o <<= 1) m = fmaxf(m, __shfl_xor(m, o));
        const float e = __expf(x - m); float s = e;
#pragma unroll
        for (int o = 1; o < 16; o <<= 1) s += __shfl_xor(s, o);
        if (lane < 16) { IDX[(size_t)it * 16 + lane] = xi; GATE[(size_t)it * 16 + lane] = e / s; }
        LDS_WAIT();
    }
}
template <bool FINAL> DI void peer_gather(const Ctx& C, const bf16* H, const int* IDX, const float* GATE, const bf16* PU, const bf16* PV, float* X, const float* g2  ,
                                          const float* ngain, const float* nmod  , bf16* Hn) {
    const int gw = C.vcu * NWAVES + C.wave, NGW = C.G * NWAVES, lane = C.lane;
    for (int t = gw; t < TT; t += NGW) {
        float hv[16];
        { const u32x4 a = *(const u32x4*)(H + (size_t)t * 1024 + lane * 8), bq = *(const u32x4*)(H + (size_t)t * 1024 + 512 + lane * 8);
          hv[0] = bflo(a.x); hv[1] = bfhi(a.x); hv[2] = bflo(a.y); hv[3] = bfhi(a.y); hv[4] = bflo(a.z); hv[5] = bfhi(a.z); hv[6] = bflo(a.w); hv[7] = bfhi(a.w);
          hv[8] = bflo(bq.x); hv[9] = bfhi(bq.x); hv[10] = bflo(bq.y); hv[11] = bfhi(bq.y); hv[12] = bflo(bq.z); hv[13] = bfhi(bq.z); hv[14] = bflo(bq.w); hv[15] = bfhi(bq.w); }
        const int i0 = IDX[(size_t)t * 128 + lane], i1 = IDX[(size_t)t * 128 + 64 + lane];
        const float g0 = GATE[(size_t)t * 128 + lane], g1 = GATE[(size_t)t * 128 + 64 + lane];
        float a0 = 0.f, a1 = 0.f;
        for (int k = 0; k < 128; k += 4) {
            float dsum[4];
#pragma unroll
            for (int kk = 0; kk < 4; ++kk) { const int kq = k + kk; const int e = kq < 64 ? __builtin_amdgcn_readlane(i0, kq) : __builtin_amdgcn_readlane(i1, kq - 64);
                const bf16* ur = PU + (size_t)e * 1024; const u32x4 a = *(const u32x4*)(ur + lane * 8), bq = *(const u32x4*)(ur + 512 + lane * 8);
                float d = bflo(a.x) * hv[0] + bfhi(a.x) * hv[1]; d += bflo(a.y) * hv[2] + bfhi(a.y) * hv[3]; d += bflo(a.z) * hv[4] + bfhi(a.z) * hv[5]; d += bflo(a.w) * hv[6] + bfhi(a.w) * hv[7];
                d += bflo(bq.x) * hv[8] + bfhi(bq.x) * hv[9]; d += bflo(bq.y) * hv[10] + bfhi(bq.y) * hv[11]; d += bflo(bq.z) * hv[12] + bfhi(bq.z) * hv[13]; d += bflo(bq.w) * hv[14] + bfhi(bq.w) * hv[15];
                dsum[kk] = d; }
#pragma unroll
            for (int kk = 0; kk < 4; ++kk) { const int kq = k + kk; const float d = gelu_t(wave_sum(dsum[kk]));
                if (kq < 64) { if (lane == kq) a0 = d * g0; } else { if (lane == kq - 64) a1 = d * g1; } }
        }
        float o[16];
#pragma unroll
        for (int j = 0; j < 16; ++j) o[j] = 0.f;
        for (int k = 0; k < 128; k += 4) {
#pragma unroll
            for (int kk = 0; kk < 4; ++kk) { const int kq = k + kk; const int e = kq < 64 ? __builtin_amdgcn_readlane(i0, kq) : __builtin_amdgcn_readlane(i1, kq - 64);
                const float ak = __int_as_float(kq < 64 ? __builtin_amdgcn_readlane(__float_as_int(a0), kq) : __builtin_amdgcn_readlane(__float_as_int(a1), kq - 64));
                const bf16* vr = PV + (size_t)e * 1024; const u32x4 a = *(const u32x4*)(vr + lane * 8), bq = *(const u32x4*)(vr + 512 + lane * 8);
                o[0] += ak * bflo(a.x); o[1] += ak * bfhi(a.x); o[2] += ak * bflo(a.y); o[3] += ak * bfhi(a.y); o[4] += ak * bflo(a.z); o[5] += ak * bfhi(a.z); o[6] += ak * bflo(a.w); o[7] += ak * bfhi(a.w);
                o[8] += ak * bflo(bq.x); o[9] += ak * bfhi(bq.x); o[10] += ak * bflo(bq.y); o[11] += ak * bfhi(bq.y); o[12] += ak * bflo(bq.z); o[13] += ak * bfhi(bq.z); o[14] += ak * bflo(bq.w); o[15] += ak * bfhi(bq.w); }
        }
#ifdef DBG_ZERO_PEER
#pragma unroll
        for (int j = 0; j < 16; ++j) o[j] = 0.f;
#endif
        const int b = t >> 13; const float* gp = g2 + (size_t)b * 6144; float* xr = X + (size_t)t * 1024;
        float xn[16]; float ss = 0.f;
#pragma unroll
        for (int q = 0; q < 4; ++q) { const int col = (q >> 1) * 512 + lane * 8 + (q & 1) * 4; const f32x4 xv = *(const f32x4*)(xr + col), gv = *(const f32x4*)(gp + col);
#pragma unroll
            for (int j = 0; j < 4; ++j) { const float y = xv[j] + gv[j] * o[q * 4 + j]; xn[q * 4 + j] = y; ss += y * y; } }
        const float rstd = 1.0f / sqrtf(wave_sum(ss) * (1.0f / 1024.0f) + EPS);
        if (FINAL) {
#pragma unroll
            for (int q = 0; q < 4; ++q) { const int col = (q >> 1) * 512 + lane * 8 + (q & 1) * 4; const f32x4 gn = *(const f32x4*)(ngain + col); f32x4 y;
#pragma unroll
                for (int j = 0; j < 4; ++j) y[j] = xn[q * 4 + j] * rstd * gn[j];
                *(f32x4*)(xr + col) = y; }
        } else {
            const float* nm = nmod + (size_t)b * 6144;
#pragma unroll
            for (int q = 0; q < 4; ++q) { const int col = (q >> 1) * 512 + lane * 8 + (q & 1) * 4; const f32x4 gn = *(const f32x4*)(ngain + col), sh = *(const f32x4*)(nm + col), sc = *(const f32x4*)(nm + 1024 + col); f32x4 xo; float y[4];
#pragma unroll
                for (int j = 0; j < 4; ++j) { xo[j] = xn[q * 4 + j]; y[j] = xn[q * 4 + j] * rstd * gn[j] * (1.0f + sc[j]) + sh[j]; }
                *(f32x4*)(xr + col) = xo; uint2 w; w.x = pk2(y[0], y[1]); w.y = pk2(y[2], y[3]); *(uint2*)(Hn + (size_t)t * 1024 + col) = w; }
        }
    }
}
DI void sgu_gate_naive(const Ctx& C, bf16* U, const bf16* VB, const float* stats, const float* w_s, const float* b_s, const float* ln_g, const float* ln_b) {
    LAS float* Wm = (LAS float*)(C.lds);
    LAS float* mu = (LAS float*)(C.lds + 65536);
    LAS float* rsd = mu + 128;
    const int tid = C.tid;
    for (int item = C.vcu; item < 1024; item += C.G) {
        const int n = item >> 3, g = item & 7; const size_t row0 = (size_t)n * 128;
        for (int i = tid; i < 16384; i += 512) { const int r = i >> 7, c = i & 127; const float w = w_s[(size_t)g * 16384 + i]; Wm[i] = (r < 64 && c >= 64) ? 0.f : w; }
        if (tid < 128) { const float* sp = stats + (row0 + tid) * 96; float s1 = 0.f, s2 = 0.f;
            for (int q = 0; q < 48; ++q) { s1 += sp[2 * q]; s2 += sp[2 * q + 1]; }
            const float m = s1 * (1.0f / 3072.0f); const float var = s2 * (1.0f / 3072.0f) - m * m; mu[tid] = m; rsd[tid] = 1.0f / sqrtf(fmaxf(var, 0.f) + EPS); }
        __syncthreads();
        if (tid < 384) {
            const int col = g * 384 + tid; const float lg = ln_g[col], lb = ln_b[col];
#pragma unroll
            for (int pass = 0; pass < 2; ++pass) {
                float acc[64];
#pragma unroll
                for (int i = 0; i < 64; ++i) acc[i] = 0.f;
                const int jmax = pass == 0 ? 64 : 128;
                for (int j = 0; j < jmax; ++j) { const float v = bf2f(VB[(row0 + j) * 3072 + col]); const float vl = (v - mu[j]) * rsd[j] * lg + lb;
#pragma unroll
                    for (int i = 0; i < 64; ++i) acc[i] += Wm[(pass * 64 + i) * 128 + j] * vl; }
#pragma unroll
                for (int i = 0; i < 64; ++i) { const int r = pass * 64 + i; const float s = acc[i] + b_s[g * 128 + r]; bf16* up = U + (row0 + r) * 3072 + col; *up = (bf16)f2bf(bf2f(*up) * s); }
            }
        }
        __syncthreads();
    }
}
typedef short v4i16_t __attribute__((ext_vector_type(4)));
typedef unsigned u32x2_t __attribute__((ext_vector_type(2)));
typedef __bf16 bf16x2_t __attribute__((ext_vector_type(2)));
DI unsigned cvtpk(float lo, float hi) { f32x2_t v = {lo, hi}; bf16x2_t b = __builtin_convertvector(v, bf16x2_t); return __builtin_bit_cast(unsigned, b); }
DI v4i16_t trr(const LAS unsigned char* p) { return __builtin_amdgcn_ds_read_tr16_b64_v4i16((LAS v4i16_t*)p); }
DI bf16x8 cat8(v4i16_t a, v4i16_t b) { return __builtin_shufflevector(a, b, 0, 1, 2, 3, 4, 5, 6, 7); }
DI bf16x8 pack2(const f32x4& a, const f32x4& b) { u32x4 p; p.x = cvtpk(a[0], a[1]); p.y = cvtpk(a[2], a[3]); p.z = cvtpk(b[0], b[1]); p.w = cvtpk(b[2], b[3]); return __builtin_bit_cast(bf16x8, p); }
DI u32x4 scale8(u32x4 v, float s) { u32x4 o; o.x = cvtpk(bflo(v.x) * s, bfhi(v.x) * s); o.y = cvtpk(bflo(v.y) * s, bfhi(v.y) * s); o.z = cvtpk(bflo(v.z) * s, bfhi(v.z) * s); o.w = cvtpk(bflo(v.w) * s, bfhi(v.w) * s); return o; }
#ifndef SCAN_QPI
#define SCAN_QPI 544
#endif
#ifndef SCAN_KPI
#define SCAN_KPI 544
#endif
#ifndef SCAN_PFD
#define SCAN_PFD 5
#endif
constexpr int SCAN_ESL = 32, SCAN_NEW = SCAN_ESL / 16, SCAN_NCW = 2 * SCAN_NEW, SCAN_NSL = 512 / SCAN_ESL, SCAN_NIT = 8 * SCAN_NSL;
#define SCAN_BAR() do { asm volatile("s_waitcnt lgkmcnt(0)" ::: "memory"); __builtin_amdgcn_s_barrier(); asm volatile("" ::: "memory"); } while (0)
template <int MODE = 0> DI void scan_mfma(const Ctx& C, const bf16* Q, const bf16* K, const bf16* V, bf16* CROSS, int item0, int istride) {
    constexpr int QPI = 544, KPI = 544, VPI = SCAN_ESL * 2 + 32, VCH = SCAN_ESL / 8  , NVC = 64 * VCH;
    constexpr int OQ = 0, OK_ = 64 * QPI, OV = OK_ + 64 * KPI, BUFB = OV + 64 * VPI;
    constexpr int XOFF = 2 * BUFB;
    constexpr int NST = (NWAVES - 1 - SCAN_NCW) * 64;
    static_assert(NST == 192 && NVC == 256 && XOFF + 8192 <= LDSCTL_OFF, "scan: staging split / LDS budget");
    const int w = C.wave;
    for (int item = item0; item < SCAN_NIT; item += istride) {
        const int b = item / (4 * SCAN_NSL), h = (item / SCAN_NSL) & 3, es = item % SCAN_NSL;
        const float lg2 = log2f(1.0f - exp2f(-5.0f - (float)h)); const float gc = exp2f(lg2 * 64.0f);
        const size_t tokb = (size_t)b * SEQ;
        if (w >= SCAN_NCW) {
            int tl_ = C.tid; asm volatile("" : "+v"(tl_));
            const int st = (w == NWAVES - 1) ? (tl_ & 63) : tl_ - SCAN_NCW * 64;
            if (w == NWAVES - 1) {
                unsigned dmy = 0u;
#define SCAN_PF1(ptr) asm volatile("global_load_dword %0, %1, off" : "+v"(dmy) : "v"(ptr) : "memory")
#define SCAN_PF(n) do { const size_t t0_ = tokb + (size_t)(n) * 64; \
                if ((es & 3) == 0) { _Pragma("unroll") for (int u = 0; u < 4; ++u) { const int ln = st + 64 * u, r = ln >> 2, q = ln & 3; SCAN_PF1(Q + (t0_ + r) * 1024 + h * 256 + q * 64); SCAN_PF1(K + (t0_ + r) * 1024 + h * 256 + q * 64); } } \
                SCAN_PF1(V + (t0_ + st) * 2048 + h * 512 + es * SCAN_ESL); } while (0)
#ifndef SCAN_NOPF
                SCAN_PF(3); SCAN_PF(4);
#endif
                SCAN_BAR();
#pragma unroll 1
                for (int n = 0; n < 128; ++n) {
#ifndef SCAN_NOPF
                    if (n + SCAN_PFD < 128) SCAN_PF(n + SCAN_PFD);
#endif
                    SCAN_BAR(); }
                asm volatile("s_waitcnt vmcnt(0)" : "+v"(dmy) :: "memory");
#undef SCAN_PF
#undef SCAN_PF1
            } else {
            u32x4 rqA[11], rkA[11], rvA[2], rqB[11], rkB[11], rvB[2];
            const unsigned qo_ = (unsigned)((st >> 5) * 2048 + (st & 31) * 16), qo10_ = (st < 128) ? qo_ + (unsigned)(10 * 6 * 2048) : qo_;
            const unsigned vo0_ = (unsigned)((st >> 2) * 4096 + (st & 3) * 16), vo1_ = (st < 64) ? (unsigned)(((st + 192) >> 2) * 4096 + (st & 3) * 16) : 0u;
#define SCAN_LD(RQ, RK, RV, n) do { const size_t t0_ = tokb + (size_t)((n) < 127 ? (n) : 127) * 64; \
            const unsigned char* qb_ = (const unsigned char*)(Q + t0_ * 1024 + h * 256); const unsigned char* kb_ = (const unsigned char*)(K + t0_ * 1024 + h * 256); \
            const unsigned char* vb_ = (const unsigned char*)(V + t0_ * 2048 + h * 512 + es * SCAN_ESL); \
            _Pragma("unroll") for (int u = 0; u < 11; ++u) { const unsigned o_ = u == 10 ? qo10_ : qo_ + (unsigned)(u * 6 * 2048); \
                RQ[u] = *(const u32x4*)(qb_ + o_); RK[u] = *(const u32x4*)(kb_ + o_); } \
            RV[0] = *(const u32x4*)(vb_ + vo0_); RV[1] = *(const u32x4*)(vb_ + vo1_); } while (0)
#define SCAN_WR(RQ, RK, RV, bufo) do { LAS unsigned char* B_ = C.lds + (bufo); const int r0_ = st >> 5, cc_ = st & 31; \
            _Pragma("unroll") for (int u = 0; u < 11; ++u) { if (u < 10 || st < 128) { const int r = r0_ + 6 * u; \
                *(LAS u32x4*)(B_ + OQ + r * QPI + cc_ * 16) = RQ[u]; *(LAS u32x4*)(B_ + OK_ + r * KPI + cc_ * 16) = RK[u]; } } \
            { const int r = st >> 2, cc = st & 3; *(LAS u32x4*)(B_ + OV + r * VPI + cc * 16) = scale8(RV[0], exp2f(lg2 * (float)(63 - r))); } \
            if (st < 64) { const int r = (st + 192) >> 2, cc = st & 3; *(LAS u32x4*)(B_ + OV + r * VPI + cc * 16) = scale8(RV[1], exp2f(lg2 * (float)(63 - r))); } } while (0)
            SCAN_LD(rqA, rkA, rvA, 0); SCAN_WR(rqA, rkA, rvA, 0); SCAN_LD(rqA, rkA, rvA, 1); SCAN_LD(rqB, rkB, rvB, 2);
            SCAN_BAR();
#pragma unroll 1
            for (int n = 0; n < 128; n += 2) {
                if (MODE != 2) { SCAN_WR(rqA, rkA, rvA, BUFB); SCAN_LD(rqA, rkA, rvA, n + 3); }
                SCAN_BAR();
                if (MODE != 2) { SCAN_WR(rqB, rkB, rvB, 0); SCAN_LD(rqB, rkB, rvB, n + 4); }
                SCAN_BAR();
            }
#undef SCAN_LD
#undef SCAN_WR
            }
        } else {
            int tl_ = C.tid; asm volatile("" : "+v"(tl_)); const int lane = tl_ & 63, fr = lane & 15, fq = lane >> 4;
            const int ew = w & 1, dh = w >> 1;
            f32x4 S[8], accp[4];
#pragma unroll
            for (int t = 0; t < 8; ++t) S[t] = (f32x4){0.f, 0.f, 0.f, 0.f};
#pragma unroll
            for (int m = 0; m < 4; ++m) accp[m] = (f32x4){0.f, 0.f, 0.f, 0.f};
            SCAN_BAR();
#define SC_LQ(QF, DBL) do { _Pragma("unroll") for (int m = 0; m < 4; ++m) QF[m] = *(const LAS bf16x8*)(Qd + (16 * m + fr) * QPI + (32 * (DBL) + 8 * fq) * 2); __builtin_amdgcn_sched_barrier(0); } while (0)
#define SC_MQ(QF, DBL) do { const bf16x8 sa0 = pack2(S[2 * (DBL)], S[2 * (DBL) + 1]); \
            _Pragma("unroll") for (int m = 0; m < 4; ++m) acc[m] = __builtin_amdgcn_mfma_f32_16x16x32_bf16(sa0, QF[m], acc[m], 0, 0, 0); __builtin_amdgcn_sched_barrier(0); } while (0)
#define SC_LK(KF, KS, TQL) do { const LAS unsigned char* kp = Kd + (32 * (KS) + 4 * fq + (fr >> 2)) * KPI + (8 * (fr & 3)) * 2; \
            _Pragma("unroll") for (int t4 = 0; t4 < 4; ++t4) { const int t = 4 * (TQL) + t4; KF[t4] = cat8(trr(kp + 64 * (t >> 1) + 8 * (t & 1)), trr(kp + 64 * (t >> 1) + 8 * (t & 1) + 16 * KPI)); } __builtin_amdgcn_sched_barrier(0); } while (0)
#define SC_LV(VF, KS) do { const LAS unsigned char* vp = Vs + (32 * (KS) + 4 * fq + (fr >> 2)) * VPI + (16 * ew + 4 * (fr & 3)) * 2; VF = cat8(trr(vp), trr(vp + 16 * VPI)); } while (0)
#define SC_MK(KF, VF, TQL) do { _Pragma("unroll") for (int t4 = 0; t4 < 4; ++t4) S[4 * (TQL) + t4] = __builtin_amdgcn_mfma_f32_16x16x32_bf16(KF[t4], VF, S[4 * (TQL) + t4], 0, 0, 0); __builtin_amdgcn_sched_barrier(0); } while (0)
#define SC_FIN(np_, PARP) do { const size_t tokp = tokb + (size_t)(np_) * 64; const LAS unsigned char* xs_ = C.lds + XOFF + (ew * 2 + (PARP)) * 2048 + lane * 8; \
                _Pragma("unroll") for (int m = 0; m < 4; ++m) { const u32x2_t pv = *(const LAS u32x2_t*)(xs_ + m * 512); \
                    f32x4 v = accp[m]; v[0] += bflo(pv.x); v[1] += bfhi(pv.x); v[2] += bflo(pv.y); v[3] += bfhi(pv.y); v = v * exp2f(lg2 * (float)(16 * m + fr + 1)); \
                    uint2 o; o.x = cvtpk(v[0], v[1]); o.y = cvtpk(v[2], v[3]); \
                    *(uint2*)(CROSS + (tokp + 16 * m + fr) * 2048 + h * 512 + es * SCAN_ESL + 16 * ew + 4 * fq) = o; } } while (0)
#define SCAN_CHUNK(n_, BO, PAR) do { LAS unsigned char* Qd = C.lds + (BO) + OQ + dh * 256; LAS unsigned char* Kd = C.lds + (BO) + OK_ + dh * 256; LAS unsigned char* Vs = C.lds + (BO) + OV; \
                f32x4 acc[4]; bf16x8 fA[4], fB[4], vf0, vf1; \
                _Pragma("unroll") for (int m = 0; m < 4; ++m) acc[m] = (f32x4){0.f, 0.f, 0.f, 0.f}; \
                SC_LQ(fA, 0); SC_LQ(fB, 1); \
                if (dh == 0 && (n_) > 0) SC_FIN((n_) - 1, 1 - (PAR)); \
                __builtin_amdgcn_sched_barrier(0); \
                SC_MQ(fA, 0); SC_LQ(fA, 2); SC_MQ(fB, 1); SC_LQ(fB, 3); SC_MQ(fA, 2); SC_LV(vf0, 0); SC_LV(vf1, 1); SC_LK(fA, 0, 0); SC_MQ(fB, 3); SC_LK(fB, 0, 1); \
                if (dh != 0) { LAS unsigned char* xs_ = C.lds + XOFF + (ew * 2 + (PAR)) * 2048 + lane * 8; \
                    _Pragma("unroll") for (int m = 0; m < 4; ++m) { u32x2_t o; o.x = cvtpk(acc[m][0], acc[m][1]); o.y = cvtpk(acc[m][2], acc[m][3]); *(LAS u32x2_t*)(xs_ + m * 512) = o; } } \
                else { _Pragma("unroll") for (int m = 0; m < 4; ++m) accp[m] = acc[m]; } \
                _Pragma("unroll") for (int t = 0; t < 8; ++t) S[t] = S[t] * gc; \
                __builtin_amdgcn_sched_barrier(0); \
                SC_MK(fA, vf0, 0); SC_LK(fA, 1, 0); SC_MK(fB, vf0, 1); SC_LK(fB, 1, 1); SC_MK(fA, vf1, 0); SC_MK(fB, vf1, 1); \
                SCAN_BAR(); } while (0)
#pragma unroll 1
            for (int n = 0; n < 128; n += 2) { if (MODE == 1) { SCAN_BAR(); SCAN_BAR(); } else { SCAN_CHUNK(n, 0, 0); SCAN_CHUNK(n + 1, BUFB, 1); } }
            if (MODE != 1 && dh == 0) SC_FIN(127, 1);
#undef SCAN_CHUNK
#undef SC_FIN
#undef SC_LQ
#undef SC_MQ
#undef SC_LK
#undef SC_LV
#undef SC_MK
        }
    }
}
#undef SCAN_BAR
DI void sgu_gate_mfma(const Ctx& C, bf16* U, const bf16* VB, const float* stats, const float* w_s, const float* b_s, const float* ln_g, const float* ln_b) {
    constexpr int WPI = 272, VPI = 288;
    LAS unsigned char* Ws = C.lds; LAS unsigned char* Vs = C.lds + 128 * WPI;
    LAS float* mu = (LAS float*)(C.lds + 128 * WPI + 128 * VPI); LAS float* rsd = mu + 128; LAS float* r1 = mu + 256; LAS float* r2 = mu + 384; LAS float* bsl = mu + 512;
    const int tid = C.tid, lane = C.lane, w = C.wave, fr = lane & 15, fq = lane >> 4;
    for (int item = C.vcu; item < 1024; item += C.G) {
        const int n = item >> 3, g = item & 7; const size_t row0 = (size_t)n * 128;
        if (tid < 128) { const float* sp = stats + (row0 + tid) * 96; float s1 = 0.f, s2 = 0.f;
#pragma unroll 8
            for (int q = 0; q < 48; ++q) { s1 += sp[2 * q]; s2 += sp[2 * q + 1]; }
            const float m = s1 * (1.0f / 3072.0f); const float var = s2 * (1.0f / 3072.0f) - m * m; mu[tid] = m; rsd[tid] = 1.0f / sqrtf(fmaxf(var, 0.f) + EPS); bsl[tid] = b_s[g * 128 + tid]; }
        __syncthreads();
        { const int i = tid >> 2, jq = tid & 3; const float* wp = w_s + (size_t)g * 16384 + i * 128 + jq * 32; float a1 = 0.f, a2 = 0.f;
#pragma unroll
          for (int c8 = 0; c8 < 4; ++c8) { const f32x4 wa = *(const f32x4*)(wp + c8 * 8), wb = *(const f32x4*)(wp + c8 * 8 + 4); float wv[8] = {wa[0], wa[1], wa[2], wa[3], wb[0], wb[1], wb[2], wb[3]}; float o[8];
#pragma unroll
              for (int q = 0; q < 8; ++q) { const int j = jq * 32 + c8 * 8 + q; const float wm = (i < 64 && j >= 64) ? 0.f : wv[q]; const float wr_ = wm * rsd[j]; o[q] = wr_; a1 += wr_ * mu[j]; a2 += wm; }
              u32x4 pk; pk.x = cvtpk(o[0], o[1]); pk.y = cvtpk(o[2], o[3]); pk.z = cvtpk(o[4], o[5]); pk.w = cvtpk(o[6], o[7]);
              *(LAS u32x4*)(Ws + i * WPI + (jq * 32 + c8 * 8) * 2) = pk; }
          a1 += __shfl_xor(a1, 1); a1 += __shfl_xor(a1, 2); a2 += __shfl_xor(a2, 1); a2 += __shfl_xor(a2, 2);
          if (jq == 0) { r1[i] = a1; r2[i] = a2; } }
#pragma unroll 1
        for (int cs = 0; cs < 3; ++cs) {
            const int colb = g * 384 + cs * 128;
#pragma unroll
            for (int u = 0; u < 4; ++u) { const int c = tid + 512 * u, r = c >> 4, cc = c & 15;
                *(LAS u32x4*)(Vs + r * VPI + cc * 16) = *(const u32x4*)(VB + (row0 + r) * 3072 + colb + cc * 8); }
            __syncthreads();
            f32x4 acc[8];
#pragma unroll
            for (int it = 0; it < 8; ++it) acc[it] = (f32x4){0.f, 0.f, 0.f, 0.f};
#pragma unroll
            for (int ks = 0; ks < 4; ++ks) {
                const LAS unsigned char* vp = Vs + (32 * ks + 4 * fq + (fr >> 2)) * VPI + (16 * w + 4 * (fr & 3)) * 2;
                const bf16x8 vf = cat8(trr(vp), trr(vp + 16 * VPI));
#pragma unroll
                for (int it = 0; it < 8; ++it) { if (it < 4 && ks >= 2) continue;
                    const LAS unsigned char* wp = Ws + (16 * it + fr) * WPI + (32 * ks + 4 * fq) * 2;
                    const u32x2_t lo = *(const LAS u32x2_t*)wp, hi = *(const LAS u32x2_t*)(wp + 32);
                    u32x4 ww; ww.x = lo.x; ww.y = lo.y; ww.z = hi.x; ww.w = hi.y;
                    acc[it] = __builtin_amdgcn_mfma_f32_16x16x32_bf16(vf, __builtin_bit_cast(bf16x8, ww), acc[it], 0, 0, 0); }
            }
            const int c0 = colb + 16 * w + 4 * fq;
            const f32x4 lg = *(const f32x4*)(ln_g + c0), lb = *(const f32x4*)(ln_b + c0);
#pragma unroll
            for (int it = 0; it < 8; ++it) { const int i = 16 * it + fr; const float q1 = r1[i], q2 = r2[i], bb = bsl[i];
                bf16* up = U + (row0 + i) * 3072 + c0; const u32x2_t uu = *(const u32x2_t*)up;
                const f32x4 s = lg * (acc[it] - q1) + lb * q2 + bb;
                u32x2_t o; o.x = cvtpk(bflo(uu.x) * s[0], bfhi(uu.x) * s[1]); o.y = cvtpk(bflo(uu.y) * s[2], bfhi(uu.y) * s[3]);
                *(u32x2_t*)up = o; }
            __syncthreads();
        }
    }
}
DI void up8(unsigned wd, float& a, float& b, float& c, float& d) { const f32x2_t lo = __builtin_amdgcn_cvt_pk_f32_fp8((int)wd, false), hi = __builtin_amdgcn_cvt_pk_f32_fp8((int)wd, true); a = lo.x; b = lo.y; c = hi.x; d = hi.y; }
DI float dot16(const u32x4 u, const float (&hv)[16]) {
    float f[16];
    up8(u.x, f[0], f[1], f[2], f[3]); up8(u.y, f[4], f[5], f[6], f[7]); up8(u.z, f[8], f[9], f[10], f[11]); up8(u.w, f[12], f[13], f[14], f[15]);
    float d0 = f[0] * hv[0], d1 = f[1] * hv[1];
#pragma unroll
    for (int j = 2; j < 16; j += 2) { d0 += f[j] * hv[j]; d1 += f[j + 1] * hv[j + 1]; }
    return d0 + d1;
}
template <bool FINAL> DI void peer_gather8(const Ctx& C, const bf16* Hin, const int* IDX, const float* GATE, const unsigned char* PU8, const unsigned char* PV8, const float* ISU, const float* ISV,
                                           float* X, const float* g2, const float* ngain, const float* nmod, bf16* Hn) {
    const int gw = C.vcu * NWAVES + C.wave, NGW = C.G * NWAVES, lane = C.lane;
    LAS float* DL = (LAS float*)(C.lds + C.wave * 1024);
    LAS float* AL = DL + 128;
    for (int t = gw; t < TT; t += NGW) {
        float hv[16];
        { const u32x4 a = *(const u32x4*)(Hin + (size_t)t * 1024 + lane * 16), bq = *(const u32x4*)(Hin + (size_t)t * 1024 + lane * 16 + 8);
          hv[0] = bflo(a.x); hv[1] = bfhi(a.x); hv[2] = bflo(a.y); hv[3] = bfhi(a.y); hv[4] = bflo(a.z); hv[5] = bfhi(a.z); hv[6] = bflo(a.w); hv[7] = bfhi(a.w);
          hv[8] = bflo(bq.x); hv[9] = bfhi(bq.x); hv[10] = bflo(bq.y); hv[11] = bfhi(bq.y); hv[12] = bflo(bq.z); hv[13] = bfhi(bq.z); hv[14] = bflo(bq.w); hv[15] = bfhi(bq.w); }
        const int i0 = IDX[(size_t)t * 128 + lane], i1 = IDX[(size_t)t * 128 + 64 + lane];
        const float g0 = GATE[(size_t)t * 128 + lane], g1 = GATE[(size_t)t * 128 + 64 + lane];
        const float su0 = ISU[i0], su1 = ISU[i1], sv0 = ISV[i0], sv1 = ISV[i1];
        u32x4 ub[8];
#define PG_LOADU(k0) do { _Pragma("unroll") for (int j = 0; j < 8; ++j) { const int kq = (k0) + j; const int e = kq < 64 ? __builtin_amdgcn_readlane(i0, kq) : __builtin_amdgcn_readlane(i1, kq - 64); \
            ub[j] = *(const u32x4*)(PU8 + (size_t)e * 1024 + lane * 16); } } while (0)
        PG_LOADU(0);
#pragma unroll 1
        for (int k0 = 0; k0 < 128; k0 += 8) {
            float p[8];
#pragma unroll
            for (int j = 0; j < 8; ++j) p[j] = dot16(ub[j], hv);
            if (k0 + 8 < 128) PG_LOADU(k0 + 8);
            const bool h32 = lane & 32, h16 = lane & 16, h8 = lane & 8;
            float q4[4];
#pragma unroll
            for (int j = 0; j < 4; ++j) { const float keep = h32 ? p[j + 4] : p[j], send = h32 ? p[j] : p[j + 4]; q4[j] = keep + __shfl_xor(send, 32); }
            float q2[2];
#pragma unroll
            for (int j = 0; j < 2; ++j) { const float keep = h16 ? q4[j + 2] : q4[j], send = h16 ? q4[j] : q4[j + 2]; q2[j] = keep + __shfl_xor(send, 16); }
            float q1; { const float keep = h8 ? q2[1] : q2[0], send = h8 ? q2[0] : q2[1]; q1 = keep + __shfl_xor(send, 8); }
            q1 += __shfl_xor(q1, 4); q1 += __shfl_xor(q1, 2); q1 += __shfl_xor(q1, 1);
            if ((lane & 7) == 0) DL[k0 + ((lane >> 5) & 1) * 4 + ((lane >> 4) & 1) * 2 + ((lane >> 3) & 1)] = q1;
        }
#undef PG_LOADU
        LDS_WAIT();
        { const float d0 = DL[lane], d1 = DL[64 + lane]; AL[lane] = gelu_t(d0 * su0) * g0 * sv0; AL[64 + lane] = gelu_t(d1 * su1) * g1 * sv1; }
        LDS_WAIT();
        float o[16];
#pragma unroll
        for (int j = 0; j < 16; ++j) o[j] = 0.f;
        u32x4 vb[8];
#define PG_LOADV(k0) do { _Pragma("unroll") for (int j = 0; j < 8; ++j) { const int kq = (k0) + j; const int e = kq < 64 ? __builtin_amdgcn_readlane(i0, kq) : __builtin_amdgcn_readlane(i1, kq - 64); \
            vb[j] = *(const u32x4*)(PV8 + (size_t)e * 1024 + lane * 16); } } while (0)
        PG_LOADV(0);
#pragma unroll 1
        for (int k0 = 0; k0 < 128; k0 += 8) {
            float f[8][16];
#pragma unroll
            for (int j = 0; j < 8; ++j) { up8(vb[j].x, f[j][0], f[j][1], f[j][2], f[j][3]); up8(vb[j].y, f[j][4], f[j][5], f[j][6], f[j][7]); up8(vb[j].z, f[j][8], f[j][9], f[j][10], f[j][11]); up8(vb[j].w, f[j][12], f[j][13], f[j][14], f[j][15]); }
            if (k0 + 8 < 128) PG_LOADV(k0 + 8);
#pragma unroll
            for (int j = 0; j < 8; ++j) { const float ak = AL[k0 + j];
#pragma unroll
                for (int q = 0; q < 16; ++q) o[q] += ak * f[j][q]; }
        }
#undef PG_LOADV
        const int b = t >> 13; const float* gp = g2 + (size_t)b * 6144; float* xr = X + (size_t)t * 1024;
        float xn[16]; float ss = 0.f;
#pragma unroll
        for (int q = 0; q < 4; ++q) { const int col = lane * 16 + q * 4; const f32x4 xv = *(const f32x4*)(xr + col), gv = *(const f32x4*)(gp + col);
#pragma unroll
            for (int j = 0; j < 4; ++j) { const float y = xv[j] + gv[j] * o[q * 4 + j]; xn[q * 4 + j] = y; ss += y * y; } }
        const float rstd = 1.0f / sqrtf(wave_sum(ss) * (1.0f / 1024.0f) + EPS);
        if (FINAL) {
#pragma unroll
            for (int q = 0; q < 4; ++q) { const int col = lane * 16 + q * 4; const f32x4 gn = *(const f32x4*)(ngain + col); f32x4 y;
#pragma unroll
                for (int j = 0; j < 4; ++j) y[j] = xn[q * 4 + j] * rstd * gn[j];
                *(f32x4*)(xr + col) = y; }
        } else {
            const float* nm = nmod + (size_t)b * 6144;
#pragma unroll
            for (int q = 0; q < 4; ++q) { const int col = lane * 16 + q * 4; const f32x4 gn = *(const f32x4*)(ngain + col), sh = *(const f32x4*)(nm + col), sc = *(const f32x4*)(nm + 1024 + col); f32x4 xo; float y[4];
#pragma unroll
                for (int j = 0; j < 4; ++j) { xo[j] = xn[q * 4 + j]; y[j] = xn[q * 4 + j] * rstd * gn[j] * (1.0f + sc[j]) + sh[j]; }
                *(f32x4*)(xr + col) = xo; u32x2_t wv; wv.x = cvtpk(y[0], y[1]); wv.y = cvtpk(y[2], y[3]); *(u32x2_t*)(Hn + (size_t)t * 1024 + col) = wv; }
        }
    }
}
template <int CTRL> DI float dpp_f(float x) { return __int_as_float(__builtin_amdgcn_update_dpp(0, __float_as_int(x), CTRL, 0xF, 0xF, false)); }
DI float x32(float x) { auto r = __builtin_amdgcn_permlane32_swap(__float_as_uint(x), __float_as_uint(x), false, false); return (threadIdx.x & 32) ? __uint_as_float(r[0]) : __uint_as_float(r[1]); }
DI float x16(float x) { auto r = __builtin_amdgcn_permlane16_swap(__float_as_uint(x), __float_as_uint(x), false, false); return (threadIdx.x & 16) ? __uint_as_float(r[0]) : __uint_as_float(r[1]); }
typedef _Float16 h2_t __attribute__((ext_vector_type(2)));
DI unsigned f2hu(float lo, float hi) { const f32x2_t v = {lo, hi}; const h2_t h = __builtin_convertvector(v, h2_t); return __builtin_bit_cast(unsigned, h); }
DI unsigned bf2hu(unsigned w) { const f32x2_t v = {bflo(w), bfhi(w)}; const h2_t h = __builtin_convertvector(v, h2_t); return __builtin_bit_cast(unsigned, h); }
DI h2_t bf2h(unsigned w) { return (h2_t){(_Float16)bflo(w), (_Float16)bfhi(w)}; }
template <bool FAKE> DI void up8h(const u32x4 u, h2_t (&f)[8]) {
    if (FAKE) { f[0] = __builtin_bit_cast(h2_t, u.x & 0x3bff3bffu); f[1] = __builtin_bit_cast(h2_t, u.y & 0x3bff3bffu); f[2] = __builtin_bit_cast(h2_t, u.z & 0x3bff3bffu); f[3] = __builtin_bit_cast(h2_t, u.w & 0x3bff3bffu);
        f[4] = __builtin_bit_cast(h2_t, (u.x >> 1) & 0x3bff3bffu); f[5] = __builtin_bit_cast(h2_t, (u.y >> 1) & 0x3bff3bffu); f[6] = __builtin_bit_cast(h2_t, (u.z >> 1) & 0x3bff3bffu); f[7] = __builtin_bit_cast(h2_t, (u.w >> 1) & 0x3bff3bffu); return; }
    f[0] = __builtin_amdgcn_cvt_scalef32_pk_f16_fp8((int)u.x, 1.0f, false); f[1] = __builtin_amdgcn_cvt_scalef32_pk_f16_fp8((int)u.x, 1.0f, true);
    f[2] = __builtin_amdgcn_cvt_scalef32_pk_f16_fp8((int)u.y, 1.0f, false); f[3] = __builtin_amdgcn_cvt_scalef32_pk_f16_fp8((int)u.y, 1.0f, true);
    f[4] = __builtin_amdgcn_cvt_scalef32_pk_f16_fp8((int)u.z, 1.0f, false); f[5] = __builtin_amdgcn_cvt_scalef32_pk_f16_fp8((int)u.z, 1.0f, true);
    f[6] = __builtin_amdgcn_cvt_scalef32_pk_f16_fp8((int)u.w, 1.0f, false); f[7] = __builtin_amdgcn_cvt_scalef32_pk_f16_fp8((int)u.w, 1.0f, true); }
template <bool FAKE> DI float dot16h(const u32x4 u, const h2_t (&hh)[8]) { h2_t f[8]; up8h<FAKE>(u, f); float d0 = 0.f, d1 = 0.f;
#pragma unroll
    for (int q = 0; q < 8; q += 2) { d0 = __builtin_amdgcn_fdot2(f[q], hh[q], d0, false); d1 = __builtin_amdgcn_fdot2(f[q + 1], hh[q + 1], d1, false); }
    return d0 + d1; }
template <bool FINAL, bool FAKE = false, int SKIP = 0> DI void peer_gather_rounds(const Ctx& C, const bf16* Hin, const int* IDX, const float* GATE, const unsigned char* PU8, const unsigned char* PV8, const float* ISU, const float* ISV,
                                                 const bf16* Xin, bf16* Xout, float* Fout, const float* g2, const float* ngain, const float* nmod, bf16* Hn) {
    const int lane = C.lane, w = C.wave;
    LAS u32x2_t* LIST = (LAS u32x2_t*)(C.lds + w * 14592);
    LAS unsigned char* HL = C.lds + w * 14592 + 4096;
    LAS unsigned* ALU = (LAS unsigned*)(C.lds + w * 14592 + 12288);
    LAS int* OFFS = (LAS int*)(C.lds + w * 14592 + 14336);
    LAS float* IHS = (LAS float*)(C.lds + w * 14592 + 14336 + 160);
    const unsigned long long ltmask = (1ull << lane) - 1ull;
    for (int grp = C.vcu; grp < TT / 32; grp += C.G) {
        const int t0 = grp * 32 + w * 4;
        {
            int ee[8]; float gg[8]; unsigned su[8]; float sv[8];
#pragma unroll
            for (int r = 0; r < 8; ++r) { const size_t a = (size_t)(t0 + (r >> 1)) * 128 + 64 * (r & 1) + lane; ee[r] = IDX[a]; gg[r] = GATE[a]; }
#pragma unroll
            for (int r = 0; r < 8; ++r) { su[r] = __float_as_uint(ISU[ee[r]]) >> 23; sv[r] = ISV[ee[r]]; }
            int pos[8]; int base = 0;
#pragma unroll 1
            for (int b = 0; b < 8; ++b) {
#pragma unroll
                for (int r = 0; r < 8; ++r) { if ((r & 1) == 0 && lane == 0) OFFS[b * 4 + (r >> 1)] = base;
                    const bool mine = (ee[r] >> 11) == b; const unsigned long long m = __ballot(mine); if (mine) pos[r] = base + __popcll(m & ltmask); base += __popcll(m); }
            }
            if (lane == 0) OFFS[32] = 512;
#pragma unroll
            for (int r = 0; r < 8; ++r) { u32x2_t en; en.x = (unsigned)ee[r] | ((unsigned)(r >> 1) << 14) | (su[r] << 16); en.y = __float_as_uint(gg[r] * sv[r]); LIST[pos[r]] = en; }
#pragma unroll
            for (int tk = 0; tk < 4; ++tk) { const u32x4 a = *(const u32x4*)(Hin + (size_t)(t0 + tk) * 1024 + lane * 16), bq = *(const u32x4*)(Hin + (size_t)(t0 + tk) * 1024 + lane * 16 + 8);
                const float hv_[16] = {bflo(a.x), bfhi(a.x), bflo(a.y), bfhi(a.y), bflo(a.z), bfhi(a.z), bflo(a.w), bfhi(a.w), bflo(bq.x), bfhi(bq.x), bflo(bq.y), bfhi(bq.y), bflo(bq.z), bfhi(bq.z), bflo(bq.w), bfhi(bq.w)};
                float am = 0.f;
#pragma unroll
                for (int q = 0; q < 16; ++q) am = fmaxf(am, fabsf(hv_[q]));
                am = wave_max(am);
                const int e_ = (int)((__float_as_uint(am) >> 23) & 0xffu) - 127; const bool ok_ = am > 1e-30f;
                const float sc_ = ok_ ? __uint_as_float((unsigned)(127 + 6 - e_) << 23) : 1.0f, isc_ = ok_ ? __uint_as_float((unsigned)(127 - 6 + e_) << 23) : 1.0f;
                u32x4 o8;
#pragma unroll
                for (int q = 0; q < 4; ++q) { unsigned wd = 0u;
#pragma unroll
                    for (int j = 0; j < 4; ++j) { int qi = (int)rintf(hv_[4 * q + j] * sc_); qi = qi > 127 ? 127 : (qi < -127 ? -127 : qi); wd |= ((unsigned)qi & 0xffu) << (8 * j); }
                    o8[q] = wd; }
                *(LAS u32x4*)(HL + tk * 1024 + lane * 16) = o8; if (lane == 0) IHS[tk] = isc_; }
        }
        LDS_WAIT();
        {
            const int jL = ((lane >> 5) & 1) * 4 + ((lane >> 4) & 1) * 2 + ((lane >> 3) & 1);
#define G1_LOAD(UB, TK, G0) do { const unsigned exl_ = LIST[(G0) + (lane & 7)].x; \
            _Pragma("unroll") for (int j = 0; j < 8; ++j) { const unsigned ex = (unsigned)__builtin_amdgcn_readlane((int)exl_, j); TK[j] = (int)((ex >> 14) & 3u); \
                UB[j] = *(const u32x4*)(PU8 + (size_t)(ex & (FAKE ? 0x7fu : 0x3fffu)) * 1024 + lane * 16); } } while (0)
#define G1_RUN(UB, TK, G0) do { int p[8]; \
            _Pragma("unroll") for (int j = 0; j < 8; ++j) { const u32x4 hq = *(const LAS u32x4*)(HL + TK[j] * 1024 + lane * 16); \
                int d_ = __builtin_amdgcn_sdot4((int)UB[j].x, (int)hq.x, 0, false); d_ = __builtin_amdgcn_sdot4((int)UB[j].y, (int)hq.y, d_, false); \
                d_ = __builtin_amdgcn_sdot4((int)UB[j].z, (int)hq.z, d_, false); p[j] = __builtin_amdgcn_sdot4((int)UB[j].w, (int)hq.w, d_, false); } \
            const bool h32 = lane & 32, h16 = lane & 16, h8 = lane & 8; int q4[4]; \
            _Pragma("unroll") for (int j = 0; j < 4; ++j) { const int keep = h32 ? p[j + 4] : p[j], send = h32 ? p[j] : p[j + 4]; q4[j] = keep + __float_as_int(x32(__int_as_float(send))); } \
            int q2[2]; \
            _Pragma("unroll") for (int j = 0; j < 2; ++j) { const int keep = h16 ? q4[j + 2] : q4[j], send = h16 ? q4[j] : q4[j + 2]; q2[j] = keep + __float_as_int(x16(__int_as_float(send))); } \
            int q1; { const int keep = h8 ? q2[1] : q2[0], send = h8 ? q2[0] : q2[1]; q1 = keep + __float_as_int(dpp_f<0x128>(__int_as_float(send))); } \
            q1 += __float_as_int(dpp_f<0x141>(__int_as_float(q1))); q1 += __float_as_int(dpp_f<0xB1>(__int_as_float(q1))); q1 += __float_as_int(dpp_f<0x4E>(__int_as_float(q1))); \
            if ((lane & 7) == 0) { const u32x2_t me = LIST[(G0) + jL]; const float av_ = gelu_t((float)q1 * IHS[(me.x >> 14) & 3u] * __uint_as_float((me.x >> 16) << 23)) * __uint_as_float(me.y); ALU[(G0) + jL] = f2hu(av_, av_); } } while (0)
            u32x4 ubA[8], ubB[8]; int tkA[8], tkB[8];
            G1_LOAD(ubA, tkA, 0);
#pragma unroll 1
            for (int g0 = 0; g0 < ((SKIP & 1) ? 0 : 512); g0 += 16) {
                G1_LOAD(ubB, tkB, g0 + 8);
                G1_RUN(ubA, tkA, g0);
                if (g0 + 16 < 512) G1_LOAD(ubA, tkA, g0 + 16);
                G1_RUN(ubB, tkB, g0 + 8);
            }
#undef G1_LOAD
#undef G1_RUN
        }
        LDS_WAIT();
        h2_t o[4][8], oc[8];
#pragma unroll
        for (int q = 0; q < 8; ++q) { oc[q] = (h2_t){(_Float16)0.f, (_Float16)0.f};
#pragma unroll
            for (int tk = 0; tk < 4; ++tk) o[tk][q] = (h2_t){(_Float16)0.f, (_Float16)0.f}; }
        {
            int curA = 0;
#define G2_FLUSH() do { if (curA == 0) { _Pragma("unroll") for (int q_ = 0; q_ < 8; ++q_) o[0][q_] += oc[q_]; } else if (curA == 1) { _Pragma("unroll") for (int q_ = 0; q_ < 8; ++q_) o[1][q_] += oc[q_]; } \
            else if (curA == 2) { _Pragma("unroll") for (int q_ = 0; q_ < 8; ++q_) o[2][q_] += oc[q_]; } else { _Pragma("unroll") for (int q_ = 0; q_ < 8; ++q_) o[3][q_] += oc[q_]; } \
            _Pragma("unroll") for (int q_ = 0; q_ < 8; ++q_) oc[q_] = (h2_t){(_Float16)0.f, (_Float16)0.f}; } while (0)
#define G2_LOAD(VB, AJ, TK, G0) do { const unsigned exl_ = LIST[(G0) + (lane & 7)].x; const unsigned all_ = ALU[(G0) + (lane & 7)]; \
            _Pragma("unroll") for (int j = 0; j < 8; ++j) { const unsigned ex = (unsigned)__builtin_amdgcn_readlane((int)exl_, j); TK[j] = (int)((ex >> 14) & 3u); AJ[j] = __builtin_bit_cast(h2_t, (unsigned)__builtin_amdgcn_readlane((int)all_, j)); \
                VB[j] = *(const u32x4*)(PV8 + (size_t)(ex & (FAKE ? 0x7fu : 0x3fffu)) * 1024 + lane * 16); } } while (0)
#define G2_ACC(VB, AJ, TK) do { _Pragma("unroll") for (int j = 0; j < 8; ++j) { if (TK[j] != curA) { G2_FLUSH(); curA = TK[j]; } h2_t f_[8]; up8h<FAKE>(VB[j], f_); _Pragma("unroll") for (int q = 0; q < 8; ++q) oc[q] = f_[q] * AJ[j] + oc[q]; } } while (0)
            u32x4 vbA[8], vbB[8]; h2_t ajA[8], ajB[8]; int tA[8], tB[8];
            G2_LOAD(vbA, ajA, tA, 0);
#pragma unroll 1
            for (int g0 = 0; g0 < ((SKIP & 2) ? 0 : 512); g0 += 16) {
                G2_LOAD(vbB, ajB, tB, g0 + 8);
                G2_ACC(vbA, ajA, tA);
                if (g0 + 16 < 512) G2_LOAD(vbA, ajA, tA, g0 + 16);
                G2_ACC(vbB, ajB, tB);
            }
            G2_FLUSH();
#undef G2_FLUSH
#undef G2_LOAD
#undef G2_ACC
        }
#pragma unroll
        for (int tk = 0; tk < 4; ++tk) {
            __builtin_amdgcn_sched_barrier(0);
            const int t = t0 + tk; const int b = t >> 13; const float* gp = g2 + (size_t)b * 6144;
            const u32x4 xa = *(const u32x4*)(Xin + (size_t)t * 1024 + lane * 16), xb = *(const u32x4*)(Xin + (size_t)t * 1024 + lane * 16 + 8);
            const unsigned xw[8] = {xa.x, xa.y, xa.z, xa.w, xb.x, xb.y, xb.z, xb.w};
            float xn[16]; float ss = 0.f;
#pragma unroll
            for (int q = 0; q < 4; ++q) { const int col = lane * 16 + q * 4; const f32x4 gv = *(const f32x4*)(gp + col);
#pragma unroll
                for (int j = 0; j < 4; ++j) { const unsigned w_ = xw[q * 2 + (j >> 1)]; const float xv = (j & 1) ? __uint_as_float(w_ & 0xffff0000u) : __uint_as_float(w_ << 16);
                    const float y = xv + gv[j] * (float)o[tk][q * 2 + (j >> 1)][j & 1]; xn[q * 4 + j] = y; ss += y * y; } }
            const float rstd = 1.0f / sqrtf(wave_sum(ss) * (1.0f / 1024.0f) + EPS);
            if (FINAL) {
#pragma unroll
                for (int q = 0; q < 4; ++q) { const int col = lane * 16 + q * 4; const f32x4 gn = *(const f32x4*)(ngain + col); f32x4 y;
#pragma unroll
                    for (int j = 0; j < 4; ++j) y[j] = xn[q * 4 + j] * rstd * gn[j];
                    *(f32x4*)(Fout + (size_t)t * 1024 + col) = y; }
            } else {
                const float* nm = nmod + (size_t)b * 6144;
                u32x4 xo[2];
#pragma unroll
                for (int q = 0; q < 4; ++q) { const int col = lane * 16 + q * 4; const f32x4 gn = *(const f32x4*)(ngain + col), sh = *(const f32x4*)(nm + col), sc = *(const f32x4*)(nm + 1024 + col); float y[4];
#pragma unroll
                    for (int j = 0; j < 4; ++j) y[j] = xn[q * 4 + j] * rstd * gn[j] * (1.0f + sc[j]) + sh[j];
                    xo[q >> 1][2 * (q & 1)] = cvtpk(xn[q * 4], xn[q * 4 + 1]); xo[q >> 1][2 * (q & 1) + 1] = cvtpk(xn[q * 4 + 2], xn[q * 4 + 3]);
                    u32x2_t wv; wv.x = cvtpk(y[0], y[1]); wv.y = cvtpk(y[2], y[3]); *(u32x2_t*)(Hn + (size_t)t * 1024 + col) = wv; }
                *(u32x4*)(Xout + (size_t)t * 1024 + lane * 16) = xo[0]; *(u32x4*)(Xout + (size_t)t * 1024 + lane * 16 + 8) = xo[1];
            }
        }
        LDS_WAIT();
    }
}
constexpr int GR_R = 12;
DI void glds_row(const unsigned char* gsrc_lane, unsigned lds_dst) { unsigned keep;
    asm volatile("s_mov_b32 %0, m0\n\ts_mov_b32 m0, %2\n\ts_nop 0\n\tglobal_load_lds_dwordx4 %1, off\n\ts_mov_b32 m0, %0" : "=&s"(keep) : "v"(gsrc_lane), "s"(lds_dst) : "memory"); }
template <bool FINAL> DI void peer_gather_dma(const Ctx& C, const bf16* Hin, const int* IDX, const float* GATE, const unsigned char* PU8, const unsigned char* PV8, const float* ISU, const float* ISV,
                                              float* X, const float* g2, const float* ngain, const float* nmod, bf16* Hn) {
    const int lane = C.lane, w = C.wave;
    constexpr int WB = 4096 + 2048 + 256 + GR_R * 1024;
    LAS u32x2_t* LIST = (LAS u32x2_t*)(C.lds + w * WB);
    LAS float* AL = (LAS float*)(C.lds + w * WB + 4096);
    LAS int* OFFS = (LAS int*)(C.lds + w * WB + 6144);
    LAS unsigned char* RING = C.lds + w * WB + 6400;
    const unsigned ring0 = (unsigned)__builtin_amdgcn_readfirstlane((int)(unsigned)(size_t)RING);
    const unsigned long long ltmask = (1ull << lane) - 1ull;
#define GR_REFILL(nv_) do { unsigned ex8_[8]; _Pragma("unroll") for (int j_ = 0; j_ < 8; ++j_) ex8_[j_] = (j_ < (nv_) && nf + j_ < 1024) ? LIST[(nf + j_) & 511].x : 0u; \
        _Pragma("unroll") for (int j_ = 0; j_ < 8; ++j_) if (j_ < (nv_) && nf + j_ < 1024) { const int f_ = nf + j_; const unsigned e_ = (unsigned)__builtin_amdgcn_readfirstlane((int)ex8_[j_]) & 0x3fffu; \
            const unsigned char* tb_ = (f_ < 512) ? PU8 : PV8; glds_row(tb_ + (size_t)e_ * 1024 + lane * 16, ring0 + (unsigned)(f_ % GR_R) * 1024u); } \
        nf += (nv_); if (nf > 1024) nf = 1024; } while (0)
#define GR_ISSUE(f) do { const int f_ = (f); const unsigned ex_ = (unsigned)__builtin_amdgcn_readfirstlane((int)LIST[f_ & 511].x); \
        const unsigned char* tb_ = (f_ < 512) ? PU8 : PV8; glds_row(tb_ + (size_t)(ex_ & 0x3fffu) * 1024 + lane * 16, ring0 + (unsigned)(f_ % GR_R) * 1024u); } while (0)
    for (int grp = C.vcu; grp < TT / 32; grp += C.G) {
        const int t0 = grp * 32 + w * 4;
        float hv4[4][16];
        {
            int ee[8]; float gg[8]; unsigned su[8]; float sv[8];
#pragma unroll
            for (int r = 0; r < 8; ++r) { const size_t a = (size_t)(t0 + (r >> 1)) * 128 + 64 * (r & 1) + lane; ee[r] = IDX[a]; gg[r] = GATE[a]; }
#pragma unroll
            for (int r = 0; r < 8; ++r) { su[r] = __float_as_uint(ISU[ee[r]]) >> 23; sv[r] = ISV[ee[r]]; }
            int pos[8]; int base = 0;
#pragma unroll 1
            for (int b = 0; b < 8; ++b) {
#pragma unroll
                for (int r = 0; r < 8; ++r) { if ((r & 1) == 0 && lane == 0) OFFS[b * 4 + (r >> 1)] = base;
                    const bool mine = (ee[r] >> 11) == b; const unsigned long long m = __ballot(mine); if (mine) pos[r] = base + __popcll(m & ltmask); base += __popcll(m); }
            }
            if (lane == 0) OFFS[32] = 512;
#pragma unroll
            for (int r = 0; r < 8; ++r) { u32x2_t en; en.x = (unsigned)ee[r] | ((unsigned)(r >> 1) << 14) | (su[r] << 16); en.y = __float_as_uint(gg[r] * sv[r]); LIST[pos[r]] = en; }
#pragma unroll
            for (int tk = 0; tk < 4; ++tk) { const u32x4 a = *(const u32x4*)(Hin + (size_t)(t0 + tk) * 1024 + lane * 16), bq = *(const u32x4*)(Hin + (size_t)(t0 + tk) * 1024 + lane * 16 + 8);
                hv4[tk][0] = bflo(a.x); hv4[tk][1] = bfhi(a.x); hv4[tk][2] = bflo(a.y); hv4[tk][3] = bfhi(a.y); hv4[tk][4] = bflo(a.z); hv4[tk][5] = bfhi(a.z); hv4[tk][6] = bflo(a.w); hv4[tk][7] = bfhi(a.w);
                hv4[tk][8] = bflo(bq.x); hv4[tk][9] = bfhi(bq.x); hv4[tk][10] = bflo(bq.y); hv4[tk][11] = bfhi(bq.y); hv4[tk][12] = bflo(bq.z); hv4[tk][13] = bfhi(bq.z); hv4[tk][14] = bflo(bq.w); hv4[tk][15] = bfhi(bq.w); }
        }
        asm volatile("s_waitcnt vmcnt(0) lgkmcnt(0)" ::: "memory");
        int nf = GR_R;
#pragma unroll 1
        for (int f = 0; f < GR_R; ++f) GR_ISSUE(f);
        {
            const int jL = ((lane >> 5) & 1) * 4 + ((lane >> 4) & 1) * 2 + ((lane >> 3) & 1);
#pragma unroll 1
            for (int r = 0; r < 8; ++r) {
#pragma unroll
                for (int tk = 0; tk < 4; ++tk) {
                    const int beg = __builtin_amdgcn_readfirstlane(OFFS[r * 4 + tk]), end = __builtin_amdgcn_readfirstlane(OFFS[r * 4 + tk + 1]);
#pragma unroll 1
                    for (int g0 = beg; g0 < end; g0 += 8) {
                        const int nv = (end - g0) < 8 ? (end - g0) : 8;
                        asm volatile("s_waitcnt vmcnt(4)" ::: "memory");
                        float p[8];
#pragma unroll
                        for (int j = 0; j < 8; ++j) { p[j] = 0.f;
                            if (j < nv) { const u32x4 row = *(const LAS u32x4*)(RING + ((g0 + j) % GR_R) * 1024 + lane * 16); p[j] = dot16(row, hv4[tk]); } }
                        asm volatile("s_waitcnt lgkmcnt(0)" ::: "memory");
                        GR_REFILL(nv);
                        const bool h32 = lane & 32, h16 = lane & 16, h8 = lane & 8;
                        float q4[4];
#pragma unroll
                        for (int j = 0; j < 4; ++j) { const float keep = h32 ? p[j + 4] : p[j], send = h32 ? p[j] : p[j + 4]; q4[j] = keep + __shfl_xor(send, 32); }
                        float q2[2];
#pragma unroll
                        for (int j = 0; j < 2; ++j) { const float keep = h16 ? q4[j + 2] : q4[j], send = h16 ? q4[j] : q4[j + 2]; q2[j] = keep + __shfl_xor(send, 16); }
                        float q1; { const float keep = h8 ? q2[1] : q2[0], send = h8 ? q2[0] : q2[1]; q1 = keep + __shfl_xor(send, 8); }
                        q1 += __shfl_xor(q1, 4); q1 += __shfl_xor(q1, 2); q1 += __shfl_xor(q1, 1);
                        if ((lane & 7) == 0 && jL < nv) { const u32x2_t me = LIST[g0 + jL]; AL[g0 + jL] = gelu_t(q1 * __uint_as_float((me.x >> 16) << 23)) * __uint_as_float(me.y); }
                    }
                }
            }
        }
        float o[4][16];
#pragma unroll
        for (int tk = 0; tk < 4; ++tk)
#pragma unroll
            for (int q = 0; q < 16; ++q) o[tk][q] = 0.f;
#pragma unroll 1
        for (int r = 0; r < 8; ++r) {
#pragma unroll
            for (int tk = 0; tk < 4; ++tk) {
                const int beg = __builtin_amdgcn_readfirstlane(OFFS[r * 4 + tk]), end = __builtin_amdgcn_readfirstlane(OFFS[r * 4 + tk + 1]);
#pragma unroll 1
                for (int i0 = beg; i0 < end; i0 += 8) {
                    const int nv = (end - i0) < 8 ? (end - i0) : 8;
                    if (i0 <= 500) asm volatile("s_waitcnt vmcnt(4)" ::: "memory"); else asm volatile("s_waitcnt vmcnt(0)" ::: "memory");
                    float aq[8]; u32x4 rw[8];
#pragma unroll
                    for (int j = 0; j < 8; ++j) { aq[j] = (j < nv) ? AL[i0 + j] : 0.f; }
#pragma unroll
                    for (int j = 0; j < 8; ++j) if (j < nv) rw[j] = *(const LAS u32x4*)(RING + ((512 + i0 + j) % GR_R) * 1024 + lane * 16);
#pragma unroll
                    for (int j = 0; j < 8; ++j) if (j < nv) { const float aj = __int_as_float(__builtin_amdgcn_readfirstlane(__float_as_int(aq[j])));
                        float f_[16]; up8(rw[j].x, f_[0], f_[1], f_[2], f_[3]); up8(rw[j].y, f_[4], f_[5], f_[6], f_[7]); up8(rw[j].z, f_[8], f_[9], f_[10], f_[11]); up8(rw[j].w, f_[12], f_[13], f_[14], f_[15]);
#pragma unroll
                        for (int q = 0; q < 16; ++q) o[tk][q] += aj * f_[q]; }
                    asm volatile("s_waitcnt lgkmcnt(0)" ::: "memory");
                    GR_REFILL(nv);
                }
            }
        }
        asm volatile("s_waitcnt vmcnt(0)" ::: "memory");
#pragma unroll
        for (int tk = 0; tk < 4; ++tk) {
            const int t = t0 + tk; const int b = t >> 13; const float* gp = g2 + (size_t)b * 6144; float* xr = X + (size_t)t * 1024;
            float xn[16]; float ss = 0.f;
#pragma unroll
            for (int q = 0; q < 4; ++q) { const int col = lane * 16 + q * 4; const f32x4 xv = *(const f32x4*)(xr + col), gv = *(const f32x4*)(gp + col);
#pragma unroll
                for (int j = 0; j < 4; ++j) { const float y = xv[j] + gv[j] * o[tk][q * 4 + j]; xn[q * 4 + j] = y; ss += y * y; } }
            const float rstd = 1.0f / sqrtf(wave_sum(ss) * (1.0f / 1024.0f) + EPS);
            if (FINAL) {
#pragma unroll
                for (int q = 0; q < 4; ++q) { const int col = lane * 16 + q * 4; const f32x4 gn = *(const f32x4*)(ngain + col); f32x4 y;
#pragma unroll
                    for (int j = 0; j < 4; ++j) y[j] = xn[q * 4 + j] * rstd * gn[j];
                    *(f32x4*)(xr + col) = y; }
            } else {
                const float* nm = nmod + (size_t)b * 6144;
#pragma unroll
                for (int q = 0; q < 4; ++q) { const int col = lane * 16 + q * 4; const f32x4 gn = *(const f32x4*)(ngain + col), sh = *(const f32x4*)(nm + col), sc = *(const f32x4*)(nm + 1024 + col); f32x4 xo; float y[4];
#pragma unroll
                    for (int j = 0; j < 4; ++j) { xo[j] = xn[q * 4 + j]; y[j] = xn[q * 4 + j] * rstd * gn[j] * (1.0f + sc[j]) + sh[j]; }
                    *(f32x4*)(xr + col) = xo; u32x2_t wv; wv.x = cvtpk(y[0], y[1]); wv.y = cvtpk(y[2], y[3]); *(u32x2_t*)(Hn + (size_t)t * 1024 + col) = wv; }
            }
        }
        asm volatile("s_waitcnt vmcnt(0) lgkmcnt(0)" ::: "memory");
    }
#undef GR_ISSUE
#undef GR_REFILL
}
DI float red4_sum(float x) { auto a = __builtin_amdgcn_permlane16_swap(__float_as_uint(x), __float_as_uint(x), false, false); x = __uint_as_float(a[0]) + __uint_as_float(a[1]);
    auto b = __builtin_amdgcn_permlane32_swap(__float_as_uint(x), __float_as_uint(x), false, false); return __uint_as_float(b[0]) + __uint_as_float(b[1]); }
DI float red4_max(float x) { auto a = __builtin_amdgcn_permlane16_swap(__float_as_uint(x), __float_as_uint(x), false, false); x = fmaxf(__uint_as_float(a[0]), __uint_as_float(a[1]));
    auto b = __builtin_amdgcn_permlane32_swap(__float_as_uint(x), __float_as_uint(x), false, false); return fmaxf(__uint_as_float(b[0]), __uint_as_float(b[1])); }
DI float red4_min(float x) { auto a = __builtin_amdgcn_permlane16_swap(__float_as_uint(x), __float_as_uint(x), false, false); x = fminf(__uint_as_float(a[0]), __uint_as_float(a[1]));
    auto b = __builtin_amdgcn_permlane32_swap(__float_as_uint(x), __float_as_uint(x), false, false); return fminf(__uint_as_float(b[0]), __uint_as_float(b[1])); }
constexpr int TK_NI = 6;
DI float tk_pivot(float clo, float chi) {
    const float lc = __builtin_amdgcn_logf(clo), lh = __builtin_amdgcn_logf(fmaxf(chi, 0.5f));
    const float f = (lc - 4.0443941f) * __builtin_amdgcn_rcpf(lc - lh);
    return fminf(fmaxf(f, 0.06f), 0.94f);
}
template <int NV> DI float tk_count(const float (&v)[NV], float mid) {
    const float nb = -mid * 1.099511627776e12f;
    float c[4] = {0.f, 0.f, 0.f, 0.f};
#pragma unroll
    for (int i = 0; i < NV; ++i) c[i & 3] += __builtin_amdgcn_fmed3f(__builtin_fmaf(v[i], 1.099511627776e12f, nb), 0.f, 1.f);
    return red4_sum((c[0] + c[1]) + (c[2] + c[3]));
}
constexpr int tk2_pair(int n) {
    int k = 0;
    for (int i = 0; i < 16; ++i) for (int j = 0; j < 16; ++j) if ((i + 1) * (j + 1) <= 16) { if (k == n) return i | (j << 8); ++k; }
    return n == 50 ? (15 | (15 << 8)) : (15 | (14 << 8));
}
#ifndef TK_STEP_N
#define TK_STEP_N 2
#endif
constexpr int TK_STEP = TK_STEP_N;
template <int NV> DI void tk_search(const float (&v)[NV], float ntot, float& thr_out) {
    float mx = v[0], mn = v[0];
#pragma unroll
    for (int i = 1; i < NV; ++i) { mx = fmaxf(mx, v[i]); mn = fminf(mn, v[i]); }
    mx = red4_max(mx); mn = red4_min(mn);
    float lo = mn, hi = mx, clo = ntot - 1.0f, chi = 0.0f; bool done = false;
#pragma unroll 1
    for (int iter = 0; iter < 48; ++iter) {
        const bool rdy = done || clo <= 16.0f + (float)TK_STEP;
        if (__all(rdy)) break;
        float fr_ = tk_pivot(clo, chi); if (iter >= TK_NI) fr_ = 0.5f;
        const float mid = rdy ? lo : lo + (hi - lo) * fr_;
        const float cnt = tk_count<NV>(v, mid);
        if (!rdy) { if (cnt == 16.0f) { lo = mid; clo = 16.0f; done = true; } else if (cnt > 16.0f) { lo = mid; clo = cnt; } else { hi = mid; chi = cnt; } }
    }
    const float sl = lo;
#pragma unroll 1
    for (int r = 0; r < TK_STEP; ++r) {
        const bool nd = clo > 16.0f;
        if (!__any(nd)) break;
        float y = 3.0e38f;
#pragma unroll
        for (int i = 0; i < NV; ++i) y = fminf(y, v[i] > lo ? v[i] : 3.0e38f);
        y = red4_min(y);
        if (nd) { lo = y; clo -= 1.0f; }
    }
    if (__any(!done)) { const float c = tk_count<NV>(v, lo); if (c != 16.0f) lo = sl; }
    thr_out = lo;
}
DI void tk_search2(const float (&v0)[32], const float (&v1)[32], float& t0, float& t1) {
    float mx0 = v0[0], mn0 = v0[0], mx1 = v1[0], mn1 = v1[0], s0 = v0[0], s1 = v1[0], q0 = v0[0] * v0[0], q1 = v1[0] * v1[0];
#pragma unroll
    for (int i = 1; i < 32; ++i) { mx0 = fmaxf(mx0, v0[i]); mn0 = fminf(mn0, v0[i]); mx1 = fmaxf(mx1, v1[i]); mn1 = fminf(mn1, v1[i]);
        s0 += v0[i]; s1 += v1[i]; q0 = __builtin_fmaf(v0[i], v0[i], q0); q1 = __builtin_fmaf(v1[i], v1[i], q1); }
    mx0 = red4_max(mx0); mn0 = red4_min(mn0); mx1 = red4_max(mx1); mn1 = red4_min(mn1); s0 = red4_sum(s0); s1 = red4_sum(s1); q0 = red4_sum(q0); q1 = red4_sum(q1);
    const float me0 = s0 * (1.0f / 128.0f), me1 = s1 * (1.0f / 128.0f);
    const float g0 = fminf(fmaxf(me0 + 1.05f * sqrtf(fmaxf(q0 * (1.0f / 128.0f) - me0 * me0, 0.f)), mn0), mx0), g1 = fminf(fmaxf(me1 + 1.05f * sqrtf(fmaxf(q1 * (1.0f / 128.0f) - me1 * me1, 0.f)), mn1), mx1);
    float lo0 = mn0, hi0 = mx0, clo0 = 127.0f, chi0 = 0.0f; bool done0 = false;
    float lo1 = mn1, hi1 = mx1, clo1 = 127.0f, chi1 = 0.0f; bool done1 = false;
#pragma unroll 1
    for (int iter = 0; iter < 48; ++iter) {
        const bool r0 = done0 || clo0 <= 16.0f + (float)TK_STEP, r1 = done1 || clo1 <= 16.0f + (float)TK_STEP;
        if (__all(r0 && r1)) break;
        float f0 = tk_pivot(clo0, chi0), f1 = tk_pivot(clo1, chi1); if (iter >= TK_NI) { f0 = 0.5f; f1 = 0.5f; }
        float mid0 = lo0 + (hi0 - lo0) * f0, mid1 = lo1 + (hi1 - lo1) * f1; if (iter == 0) { mid0 = g0; mid1 = g1; }
        if (r0) mid0 = lo0; if (r1) mid1 = lo1;
        const float c0 = tk_count<32>(v0, mid0), c1 = tk_count<32>(v1, mid1);
        if (!r0) { if (c0 == 16.0f) { lo0 = mid0; clo0 = 16.0f; done0 = true; } else if (c0 > 16.0f) { lo0 = mid0; clo0 = c0; } else { hi0 = mid0; chi0 = c0; } }
        if (!r1) { if (c1 == 16.0f) { lo1 = mid1; clo1 = 16.0f; done1 = true; } else if (c1 > 16.0f) { lo1 = mid1; clo1 = c1; } else { hi1 = mid1; chi1 = c1; } }
    }
    const float sl0 = lo0, sl1 = lo1;
#pragma unroll 1
    for (int r = 0; r < TK_STEP; ++r) {
        const bool n0 = clo0 > 16.0f, n1 = clo1 > 16.0f;
        if (!__any(n0 || n1)) break;
        float y0 = 3.0e38f, y1 = 3.0e38f;
#pragma unroll
        for (int i = 0; i < 32; ++i) { y0 = fminf(y0, v0[i] > lo0 ? v0[i] : 3.0e38f); y1 = fminf(y1, v1[i] > lo1 ? v1[i] : 3.0e38f); }
        y0 = red4_min(y0); y1 = red4_min(y1);
        if (n0) { lo0 = y0; clo0 -= 1.0f; }
        if (n1) { lo1 = y1; clo1 -= 1.0f; }
    }
    if (__any(!done0 || !done1)) {
        const float c0 = tk_count<32>(v0, lo0), c1 = tk_count<32>(v1, lo1);
        if (c0 != 16.0f) lo0 = sl0; if (c1 != 16.0f) lo1 = sl1;
    }
    t0 = lo0; t1 = lo1;
}
template <int N> struct tk2_pair_c { static constexpr int value = tk2_pair(N); };
template <int MODE = 0> DI void peer_topk_fused(const Ctx& C, const bf16* QP, const bf16* KEYS, int* IDX, float* GATE) {
    constexpr int KPI = 288;
    const int lane = C.lane, fr = lane & 15, fq = lane >> 4, w = C.wave;
    LAS unsigned char* KS = C.lds;
    LAS unsigned char* WB = C.lds + 73728 + w * 7168;
    LAS float* LV = (LAS float*)(WB);
    LAS int* LK = (LAS int*)(WB + 2176);
    LAS float* FV = (LAS float*)(WB + 4352);
    LAS int* FI = (LAS int*)(WB + 5504);
    LAS float* TRASH = (LAS float*)(WB + 6656) + lane;
    const int h = C.vcu & 7, nb = C.G >> 3;
    { const bf16* kg = KEYS + (size_t)h * 2 * 128 * 128;
      for (int c = C.tid; c < 4096; c += 512) { const int r = c >> 4, cc = c & 15; *(LAS u32x4*)(KS + r * KPI + cc * 16) = *(const u32x4*)(kg + (size_t)r * 128 + cc * 8); } }
    __syncthreads();
    int cof[13];
#define TK2_COF(c) cof[c] = fq == 0 ? tk2_pair_c<4 * (c)>::value : fq == 1 ? tk2_pair_c<4 * (c) + 1>::value : fq == 2 ? tk2_pair_c<4 * (c) + 2>::value : tk2_pair_c<4 * (c) + 3>::value
    TK2_COF(0); TK2_COF(1); TK2_COF(2); TK2_COF(3); TK2_COF(4); TK2_COF(5); TK2_COF(6); TK2_COF(7); TK2_COF(8); TK2_COF(9); TK2_COF(10); TK2_COF(11); TK2_COF(12);
#undef TK2_COF
    for (int tt = (C.vcu >> 3) + nb * w; tt < 1024; tt += nb * 8) {
        const int tok = tt * 16 + fr;
        float sc0[32], sc1[32];
#pragma unroll
        for (int p = 0; p < 2; ++p) {
            bf16x8 qf[4];
#pragma unroll
            for (int ks = 0; ks < 4; ++ks) qf[ks] = *(const bf16x8*)(QP + (size_t)tok * 2048 + h * 256 + p * 128 + ks * 32 + fq * 8);
#pragma unroll
            for (int kt = 0; kt < 8; ++kt) {
                f32x4 acc = {0.f, 0.f, 0.f, 0.f};
#pragma unroll
                for (int ks = 0; ks < 4; ++ks) { const bf16x8 kf = *(const LAS bf16x8*)(KS + (p * 128 + kt * 16 + fr) * KPI + (ks * 32 + fq * 8) * 2);
                    acc = __builtin_amdgcn_mfma_f32_16x16x32_bf16(kf, qf[ks], acc, 0, 0, 0); }
                if (p == 0) { sc0[kt * 4 + 0] = acc[0]; sc0[kt * 4 + 1] = acc[1]; sc0[kt * 4 + 2] = acc[2]; sc0[kt * 4 + 3] = acc[3]; }
                else { sc1[kt * 4 + 0] = acc[0]; sc1[kt * 4 + 1] = acc[1]; sc1[kt * 4 + 2] = acc[2]; sc1[kt * 4 + 3] = acc[3]; }
            }
        }
        float thrA = 1.0f, thrB = 1.0f; if (MODE == 0) tk_search2(sc0, sc1, thrA, thrB);
#pragma unroll
        for (int p = 0; p < 2; ++p) {
            const float thr = p == 0 ? thrA : thrB;
            int cnt = 0;
#pragma unroll
            for (int i = 0; i < 32; ++i) cnt += ((p == 0 ? sc0[i] : sc1[i]) > thr) ? 1 : 0;
            const int c0 = __shfl(cnt, fr), c1 = __shfl(cnt, fr + 16), c2 = __shfl(cnt, fr + 32);
            int pos = (fq > 0 ? c0 : 0) + (fq > 1 ? c1 : 0) + (fq > 2 ? c2 : 0);
#pragma unroll
            for (int i = 0; i < 32; ++i) { const float vv = p == 0 ? sc0[i] : sc1[i]; const bool s = vv > thr && pos < 16;
                LAS float* pv = s ? (LV + fr * 33 + p * 16 + pos) : TRASH; LAS int* pk = s ? (LK + fr * 33 + p * 16 + pos) : (LAS int*)TRASH;
                *pv = vv; *pk = (i >> 2) * 16 + 4 * fq + (i & 3); pos += (vv > thr) ? 1 : 0; }
        }
        LDS_WAIT();
        {
            const int lb = fr * 33 + (fq >> 1) * 16, e0 = 8 * (fq & 1);
            float L[16], ownv[8], own[8]; int okey[8], rk[8];
#pragma unroll
            for (int q = 0; q < 16; ++q) L[q] = __uint_as_float((__float_as_uint(LV[lb + q]) & ~15u) | (unsigned)q);
#pragma unroll
            for (int i = 0; i < 8; ++i) { ownv[i] = LV[lb + e0 + i]; okey[i] = LK[lb + e0 + i]; own[i] = __uint_as_float((__float_as_uint(ownv[i]) & ~15u) | (unsigned)(e0 + i)); }
#pragma unroll
            for (int i = 0; i < 8; ++i) { int r = 0;
#pragma unroll
                for (int q = 0; q < 16; ++q) r += (L[q] > own[i]) ? 1 : 0;
                rk[i] = r; }
#pragma unroll
            for (int i = 0; i < 8; ++i) { LV[lb + rk[i]] = ownv[i]; LK[lb + rk[i]] = okey[i]; }
        }
        LDS_WAIT();
        float sm[13]; int ca[13], cb[13];
#pragma unroll
        for (int c = 0; c < 13; ++c) { ca[c] = fr * 33 + (cof[c] & 255); cb[c] = fr * 33 + 16 + (cof[c] >> 8); sm[c] = LV[ca[c]] + LV[cb[c]]; }
        float thr2 = 4.0f; if (MODE == 0) tk_search<13>(sm, 52.0f, thr2);
        {
            int cnt = 0;
#pragma unroll
            for (int i = 0; i < 13; ++i) cnt += (sm[i] > thr2) ? 1 : 0;
            const int c0 = __shfl(cnt, fr), c1 = __shfl(cnt, fr + 16), c2 = __shfl(cnt, fr + 32);
            int pos = (fq > 0 ? c0 : 0) + (fq > 1 ? c1 : 0) + (fq > 2 ? c2 : 0);
#pragma unroll
            for (int i = 0; i < 13; ++i) { const bool s = sm[i] > thr2 && pos < 16;
                LAS float* pv = s ? (FV + fr * 17 + pos) : TRASH; LAS int* pk = s ? (FI + fr * 17 + pos) : (LAS int*)TRASH;
                *pv = sm[i]; *pk = LK[ca[i]] * 128 + LK[cb[i]]; pos += (sm[i] > thr2) ? 1 : 0; }
        }
        LDS_WAIT();
        float x[4]; int xi[4];
#pragma unroll
        for (int j = 0; j < 4; ++j) { x[j] = FV[fr * 17 + 4 * fq + j]; xi[j] = FI[fr * 17 + 4 * fq + j]; }
        float m = red4_max(fmaxf(fmaxf(x[0], x[1]), fmaxf(x[2], x[3])));
        float e[4]; float s = 0.f;
#pragma unroll
        for (int j = 0; j < 4; ++j) { e[j] = __expf(x[j] - m); s += e[j]; }
        s = red4_sum(s);
        const float inv = 1.0f / s;
        const size_t ob = ((size_t)tok * 8 + h) * 16 + 4 * fq;
        typedef int i32x4 __attribute__((ext_vector_type(4)));
        *(i32x4*)(IDX + ob) = (i32x4){xi[0], xi[1], xi[2], xi[3]}; *(f32x4*)(GATE + ob) = (f32x4){e[0] * inv, e[1] * inv, e[2] * inv, e[3] * inv};
        LDS_WAIT();
    }
}
DI void intra_mfma(const Ctx& C, const bf16* Q, const bf16* K, const bf16* V, const bf16* CROSS, bf16* G) {
    constexpr int RPI = 544, PPI = 144, VPI = 544;
    LAS unsigned char* Qs = C.lds; LAS unsigned char* Ks = Qs + 64 * RPI; LAS unsigned char* Ps = Ks + 64 * RPI; LAS unsigned char* Vs = Ps + 64 * PPI;
    LAS float* red = (LAS float*)(Vs + 64 * VPI);
    const int tid = C.tid, lane = C.lane, w = C.wave, fr = lane & 15, fq = lane >> 4;
    for (int item = C.vcu; item < 1024; item += C.G) {
        const int b = item >> 9, h = (item >> 7) & 3, n = item & 127;
        const float lg2 = log2f(1.0f - exp2f(-5.0f - (float)h));
        const size_t tok0 = (size_t)b * SEQ + (size_t)n * 64;
#pragma unroll
        for (int u = 0; u < 4; ++u) { const int c = tid + 512 * u, r = c >> 5, cc = c & 31;
            *(LAS u32x4*)(Qs + r * RPI + cc * 16) = *(const u32x4*)(Q + (tok0 + r) * 1024 + h * 256 + cc * 8);
            *(LAS u32x4*)(Ks + r * RPI + cc * 16) = *(const u32x4*)(K + (tok0 + r) * 1024 + h * 256 + cc * 8);
            *(LAS u32x4*)(Vs + r * VPI + cc * 16) = *(const u32x4*)(V + (tok0 + r) * 2048 + h * 512 + cc * 8); }
        __syncthreads();
        { const int jt = w >> 1; f32x4 sa[2] = {(f32x4){0.f, 0.f, 0.f, 0.f}, (f32x4){0.f, 0.f, 0.f, 0.f}};
#pragma unroll
          for (int ks = 0; ks < 8; ++ks) { const bf16x8 kf = *(const LAS bf16x8*)(Ks + (16 * jt + fr) * RPI + (32 * ks + 8 * fq) * 2);
#pragma unroll
              for (int q = 0; q < 2; ++q) { const int it = 2 * (w & 1) + q; const bf16x8 qf = *(const LAS bf16x8*)(Qs + (16 * it + fr) * RPI + (32 * ks + 8 * fq) * 2);
                  sa[q] = __builtin_amdgcn_mfma_f32_16x16x32_bf16(kf, qf, sa[q], 0, 0, 0); } }
#pragma unroll
          for (int q = 0; q < 2; ++q) { const int i = 16 * (2 * (w & 1) + q) + fr, j0 = 16 * jt + 4 * fq; float pv[4];
#pragma unroll
              for (int r = 0; r < 4; ++r) { const int dd = i > j0 + r ? i - j0 - r : j0 + r - i; pv[r] = sa[q][r] * exp2f(lg2 * (float)dd); }
              u32x2_t o; o.x = cvtpk(pv[0], pv[1]); o.y = cvtpk(pv[2], pv[3]); *(LAS u32x2_t*)(Ps + i * PPI + j0 * 2) = o; } }
        __syncthreads();
        f32x4 acc[2][2][4];
#pragma unroll
        for (int hf = 0; hf < 2; ++hf) {
#pragma unroll
            for (int et = 0; et < 2; ++et)
#pragma unroll
                for (int it = 0; it < 4; ++it) acc[hf][et][it] = (f32x4){0.f, 0.f, 0.f, 0.f};
            if (hf == 1) { __syncthreads();
#pragma unroll
                for (int u = 0; u < 4; ++u) { const int c = tid + 512 * u, r = c >> 5, cc = c & 31;
                    *(LAS u32x4*)(Vs + r * VPI + cc * 16) = *(const u32x4*)(V + (tok0 + r) * 2048 + h * 512 + 256 + cc * 8); }
                __syncthreads(); }
#pragma unroll
            for (int ks = 0; ks < 2; ++ks) {
                bf16x8 pf[4];
#pragma unroll
                for (int it = 0; it < 4; ++it) { const LAS unsigned char* pp = Ps + (16 * it + fr) * PPI + (32 * ks + 4 * fq) * 2;
                    const u32x2_t lo = *(const LAS u32x2_t*)pp, hi = *(const LAS u32x2_t*)(pp + 32); u32x4 ww; ww.x = lo.x; ww.y = lo.y; ww.z = hi.x; ww.w = hi.y; pf[it] = __builtin_bit_cast(bf16x8, ww); }
#pragma unroll
                for (int et = 0; et < 2; ++et) { const LAS unsigned char* vp = Vs + (32 * ks + 4 * fq + (fr >> 2)) * VPI + (32 * w + 16 * et + 4 * (fr & 3)) * 2;
                    const bf16x8 vf = cat8(trr(vp), trr(vp + 16 * VPI));
#pragma unroll
                    for (int it = 0; it < 4; ++it) acc[hf][et][it] = __builtin_amdgcn_mfma_f32_16x16x32_bf16(vf, pf[it], acc[hf][et][it], 0, 0, 0); }
            }
        }
        float ssq[4] = {0.f, 0.f, 0.f, 0.f};
#pragma unroll
        for (int hf = 0; hf < 2; ++hf)
#pragma unroll
            for (int et = 0; et < 2; ++et)
#pragma unroll
                for (int it = 0; it < 4; ++it) { const u32x2_t cv = *(const u32x2_t*)(CROSS + (tok0 + 16 * it + fr) * 2048 + h * 512 + hf * 256 + 32 * w + 16 * et + 4 * fq);
                    f32x4 y = acc[hf][et][it]; y[0] += bflo(cv.x); y[1] += bfhi(cv.x); y[2] += bflo(cv.y); y[3] += bfhi(cv.y); acc[hf][et][it] = y;
                    ssq[it] += (y[0] * y[0] + y[1] * y[1]) + (y[2] * y[2] + y[3] * y[3]); }
#pragma unroll
        for (int it = 0; it < 4; ++it) { float s = ssq[it]; s += __shfl_xor(s, 16); s += __shfl_xor(s, 32); if (fq == 0) red[w * 64 + 16 * it + fr] = s; }
        __syncthreads();
        float rs[4];
#pragma unroll
        for (int it = 0; it < 4; ++it) { float s = 0.f;
#pragma unroll
            for (int ww = 0; ww < 8; ++ww) s += red[ww * 64 + 16 * it + fr];
            rs[it] = 1.0f / sqrtf(s * (1.0f / 512.0f) + EPS); }
#pragma unroll
        for (int hf = 0; hf < 2; ++hf)
#pragma unroll
            for (int et = 0; et < 2; ++et)
#pragma unroll
                for (int it = 0; it < 4; ++it) { bf16* gp = G + (tok0 + 16 * it + fr) * 2048 + h * 512 + hf * 256 + 32 * w + 16 * et + 4 * fq; const u32x2_t gv = *(const u32x2_t*)gp;
                    const f32x4 y = acc[hf][et][it] * rs[it]; u32x2_t o; o.x = cvtpk(y[0] * bflo(gv.x), y[1] * bfhi(gv.x)); o.y = cvtpk(y[2] * bflo(gv.y), y[3] * bfhi(gv.y)); *(u32x2_t*)gp = o; }
        __syncthreads();
    }
}
#ifndef PHMASK
#define PHMASK 0xFFFFFFu
#endif
#define PH(k) ((PHMASK >> (k)) & 1u)
#ifdef USE_SGU_NAIVE
#define SGU_GATE_FN sgu_gate_naive
#else
#define SGU_GATE_FN sgu_gate_mfma
#endif
#ifdef USE_GATHER_TOKEN
#define GATHER_FN peer_gather8
#else
#ifdef USE_GATHER_ROUNDS
#define GATHER_FN peer_gather_rounds
#else
#define GATHER_FN peer_gather_dma
#endif
#endif
#ifndef DUP_GATHER_SKIP
#define DUP_GATHER_SKIP 0
#endif
#ifndef DUP_GATHER_FAKE
#define DUP_GATHER_FAKE false
#endif
struct Args { const void* in[21]; float* out; unsigned char* ws; };
__global__ void __launch_bounds__(NWAVES * 64, 2) mk_fwd(Args args) {
    extern __shared__ __attribute__((aligned(16))) unsigned char lds[];
    Ctx C; C.lds = (LAS unsigned char*)lds; C.tid = threadIdx.x; C.lane = C.tid & 63; C.wave = __builtin_amdgcn_readfirstlane(C.tid >> 6);
    C.G = gridDim.x; { const int bx = blockIdx.x; C.vcu = (C.G % 8 == 0) ? (bx % 8) * (C.G / 8) + bx / 8 : bx; }
    C.ws = args.ws;
    volatile LAS unsigned* MISC = (volatile LAS unsigned*)(C.lds + MISC_OFF);
    gu32* ctl = (gu32*)(args.ws + WS_CTL);
    for (int u = C.tid; u < (LDS_BYTES - LDSCTL_OFF) / 4; u += NWAVES * 64) ((LAS unsigned*)(C.lds + LDSCTL_OFF))[u] = 0u;
    __syncthreads();
    XcdBarrier bar = xcd_barrier_post((unsigned*)(ctl + CW_BAR), MISC + 8);
#define GRID_BAR() do { xcd_barrier(bar); asm volatile("" : "+v"(C.tid)); C.lane = C.tid & 63; C.wave = __builtin_amdgcn_readfirstlane(C.tid >> 6); } while (0)
    { LAS unsigned long long* PT = (LAS unsigned long long*)(C.lds + PTR_OFF);
      if (C.tid == 0) {
#pragma unroll
          for (int i = 0; i < 21; ++i) PT[i] = (unsigned long long)args.in[i];
      } }
    __syncthreads();
#define INP(T, i) ((const T*)ldp(C, i))
    float* out = args.out; unsigned char* ws = args.ws;
#define MODP ((float*)(ws + WS_MOD))
#define MOD0 ((const float*)(ws + WS_MOD))
#define MOD1 ((const float*)(ws + WS_MOD) + 2 * 6144)
#define cosT ((float*)(ws + WS_COS))
#define sinT ((float*)(ws + WS_SIN))
#define WRI ((bf16*)(ws + WS_WRI))
#define WRO ((bf16*)(ws + WS_WRO))
#define WSI ((bf16*)(ws + WS_WSI))
#define WSO ((bf16*)(ws + WS_WSO))
#define WQ ((bf16*)(ws + WS_WQ))
#define KEYS ((bf16*)(ws + WS_KEYS))
#define STATS ((float*)(ws + WS_STATS))
#define IDX ((int*)(ws + WS_IDX))
#define GATE ((float*)(ws + WS_GATE))
#define H ((bf16*)(ws + WS_H))
#define PU8 ((const unsigned char*)(ws + WS_PU))
#define PV8 ((const unsigned char*)(ws + WS_PV))
#define ISU ((const float*)(ws + WS_ISU))
#define ISV ((const float*)(ws + WS_ISV))
#define Qb ((bf16*)(ws + WS_Q))
#define Kb ((bf16*)(ws + WS_K))
#define Vb ((bf16*)(ws + WS_V))
#define Gb ((bf16*)(ws + WS_G))
#define CROSS ((bf16*)(ws + WS_CROSS))
#define QP ((bf16*)(ws + WS_QP))
#define SCO ((float*)(ws + WS_SC))
#define Ub ((bf16*)(ws + WS_U))
#define XB ((bf16*)(ws + WS_XB))
#define VBb ((bf16*)(ws + WS_VB))

    { P0In I; I.c = INP(float, 1); I.ada_w = INP(float, 5); I.ada_b = INP(float, 6); I.ret_w_in = INP(float, 7); I.ret_w_out = INP(float, 8); I.sgu_w_in = INP(float, 9); I.sgu_w_out = INP(float, 15); I.wq = INP(float, 16); I.keys = INP(float, 17); I.pu = INP(float, 18); I.pv = INP(float, 19); I.pos = INP(int, 2);
#ifdef DUP_P0
      p0_prologue(C, I);
      GRID_BAR();
#endif
      if (PH(0)) p0_prologue(C, I); }
    GRID_BAR();
    if (PH(1)) rms_mod_phase(C, INP(float, 0), INP(float, 3), MOD0, 0, 1024, H);
    GRID_BAR();
    { pg8::Gemm g{H, WRI, TT, 6144, 1024}; pg8::StaticOrder S; S.init(TT, 6144, C.G, (int)blockIdx.x);
      pg8::EpiRetProj E{Qb, Kb, Vb, Gb, (const unsigned*)(ws + WS_COS)};
#ifdef DUP_G1
      pg8::gemm_phase<pg8::EpiRetProj, pg8::StaticOrder, true, true>(C.lds + RING_OFF, g, S, E); GRID_BAR();
#endif
#ifdef DUP_G1B
      { pg8::EpiBf16<0> E2{(bf16*)(ws + WS_R), 6144, nullptr, 0, 0, 1.f}; pg8::gemm_phase<pg8::EpiBf16<0>, pg8::StaticOrder, true, true>(C.lds + RING_OFF, g, S, E2); GRID_BAR(); }
#endif
      if (PH(2)) pg8::gemm_phase<pg8::EpiRetProj, pg8::StaticOrder, true, true>(C.lds + RING_OFF, g, S, E); }
    GRID_BAR();
    #ifdef USE_SCAN_NAIVE
    if (PH(3)) scan_naive(C, Qb, Kb, Vb, CROSS);
#else
#ifdef DUP_SCAN
    if (C.vcu < SCAN_NIT) scan_mfma<DUP_SCAN>(C, Qb, Kb, Vb, CROSS, C.vcu, SCAN_NIT);
    GRID_BAR();
#endif
    int scan_item = -1, scan_stride = SCAN_NIT, side_idx = -1, nside = 1;
    if (C.G == 256) { const int x_ = C.vcu >> 5, j_ = C.vcu & 31; if (j_ < 16) scan_item = x_ * 16 + j_; else side_idx = x_ * 16 + j_ - 16; nside = 128; }
    else if (C.G > SCAN_NIT) { if (C.vcu < SCAN_NIT) scan_item = C.vcu; else side_idx = C.vcu - SCAN_NIT; nside = C.G - SCAN_NIT; }
    else { scan_item = C.vcu; scan_stride = C.G; side_idx = C.vcu; nside = C.G; }
    P0In SI; SI.c = nullptr; SI.ada_w = nullptr; SI.ada_b = nullptr; SI.ret_w_in = nullptr; SI.ret_w_out = nullptr; SI.sgu_w_in = INP(float, 9); SI.sgu_w_out = INP(float, 15); SI.wq = INP(float, 16); SI.keys = nullptr; SI.pu = INP(float, 18); SI.pv = INP(float, 19); SI.pos = nullptr;
#ifdef DUP_SIDE
    if (side_idx >= 0) side_work<DUP_SIDE>(C, SI, side_idx, nside);
    GRID_BAR();
#endif
    if (C.G > SCAN_NIT) { if (scan_item >= 0) { if (PH(3)) scan_mfma<0>(C, Qb, Kb, Vb, CROSS, scan_item, scan_stride); } else side_work(C, SI, side_idx, nside); }
    else { if (PH(3)) scan_mfma<0>(C, Qb, Kb, Vb, CROSS, scan_item, scan_stride); __syncthreads(); side_work(C, SI, side_idx, nside); }
#endif
    GRID_BAR();
#ifdef USE_INTRA_NAIVE
    if (PH(4)) intra_naive(C, Qb, Kb, Vb, CROSS, Gb);
#else
    if (PH(4)) intra_mfma(C, Qb, Kb, Vb, CROSS, Gb);
#endif
    GRID_BAR();
    { pg8::Gemm g{Gb, WRO, TT, 1024, 2048}; pg8::StaticOrder S; S.init(TT, 1024, C.G, (int)blockIdx.x);
      pg8::EpiResGateT<false> E{INP(float, 0), XB, MOD0 + 2048, 6144};
#ifdef DUP_G5
      { pg8::EpiResGateT<false> E2{INP(float, 0), (bf16*)(ws + WS_R), MOD0 + 2048, 6144}; pg8::gemm_phase<pg8::EpiResGateT<false>, pg8::StaticOrder, true, true>(C.lds + RING_OFF, g, S, E2); GRID_BAR(); }
#endif
#ifdef DUP_G5B
      { pg8::EpiBf16<0> E2{(bf16*)(ws + WS_R), 1024, nullptr, 0, 0, 1.f}; pg8::gemm_phase<pg8::EpiBf16<0>, pg8::StaticOrder, true, true>(C.lds + RING_OFF, g, S, E2); GRID_BAR(); }
#endif
      if (PH(5)) pg8::gemm_phase<pg8::EpiResGateT<false>, pg8::StaticOrder, true, true>(C.lds + RING_OFF, g, S, E); }
    GRID_BAR();
    if (PH(6)) rms_mod_phase_b(C, XB, INP(float, 4), MOD0, 3072, 4096, H);
    GRID_BAR();
    { pg8::Gemm g{H, WQ, TT, 2048, 1024}; pg8::StaticOrder S; S.init(TT, 2048, C.G, (int)blockIdx.x);
      pg8::EpiBf16<0> E{QP, 2048, nullptr, 0, 0, 1.f};
      if (PH(7)) pg8::gemm_phase<pg8::EpiBf16<0>, pg8::StaticOrder, true, true>(C.lds + RING_OFF, g, S, E); }
    GRID_BAR();
#ifdef USE_TOPK_NAIVE
    if (PH(8)) peer_scores(C, QP, KEYS, SCO);
    GRID_BAR();
    if (PH(9)) peer_topk(C, SCO, IDX, GATE);
#else
#ifdef DUP_TOPK
    peer_topk_fused<DUP_TOPK>(C, QP, KEYS, IDX, GATE);
    GRID_BAR();
#endif
    if (PH(9)) peer_topk_fused<0>(C, QP, KEYS, IDX, GATE);
#endif
    GRID_BAR();
#ifdef DUP_GATHER
    GATHER_FN<false, DUP_GATHER_FAKE, DUP_GATHER_SKIP>(C, H, IDX, GATE, PU8, PV8, ISU, ISV, XB, (bf16*)(ws + WS_R), nullptr, MOD0 + 5120, INP(float, 3) + 1024, MOD1, (bf16*)(ws + WS_R + 128 * MiB));
    GRID_BAR();
#endif
    if (PH(10)) GATHER_FN<false>(C, H, IDX, GATE, PU8, PV8, ISU, ISV, XB, XB, nullptr, MOD0 + 5120, INP(float, 3) + 1024, MOD1, H);
    GRID_BAR();
#ifdef DUP_BAR
    for (int q_ = 0; q_ < 10; ++q_) { xcd_barrier_probe<DUP_BAR>(bar); asm volatile("" : "+v"(C.tid)); }
#endif
    { pg8::Gemm g{H, WSI, TT, 6144, 1024}; pg8::StaticOrder S; S.init(TT, 6144, C.G, (int)blockIdx.x);
      pg8::EpiSguIn E{Ub, VBb, INP(float, 10), STATS};
#ifdef DUP_G7
      pg8::gemm_phase<pg8::EpiSguIn, pg8::StaticOrder, true, true>(C.lds + RING_OFF, g, S, E); GRID_BAR();
#endif
      if (PH(11)) pg8::gemm_phase<pg8::EpiSguIn, pg8::StaticOrder, true, true>(C.lds + RING_OFF, g, S, E); }
    GRID_BAR();
    if (PH(12)) SGU_GATE_FN(C, Ub, VBb, STATS, INP(float, 13), INP(float, 14), INP(float, 11), INP(float, 12));
    GRID_BAR();
    { pg8::Gemm g{Ub, WSO, TT, 1024, 3072}; pg8::StaticOrder S; S.init(TT, 1024, C.G, (int)blockIdx.x);
      pg8::EpiResGateT<true> E{XB, XB, MOD1 + 2048, 6144};
      if (PH(13)) pg8::gemm_phase<pg8::EpiResGateT<true>, pg8::StaticOrder, true, true>(C.lds + RING_OFF, g, S, E); }
    GRID_BAR();
    if (PH(14)) rms_mod_phase_b(C, XB, INP(float, 4) + 1024, MOD1, 3072, 4096, H);
    GRID_BAR();
    { pg8::Gemm g{H, WQ + (size_t)2048 * 1024, TT, 2048, 1024}; pg8::StaticOrder S; S.init(TT, 2048, C.G, (int)blockIdx.x);
      pg8::EpiBf16<0> E{QP, 2048, nullptr, 0, 0, 1.f};
      if (PH(15)) pg8::gemm_phase<pg8::EpiBf16<0>, pg8::StaticOrder, true, true>(C.lds + RING_OFF, g, S, E); }
    GRID_BAR();
#ifdef USE_TOPK_NAIVE
    if (PH(16)) peer_scores(C, QP, KEYS + (size_t)8 * 2 * 128 * 128, SCO);
    GRID_BAR();
    if (PH(17)) peer_topk(C, SCO, IDX, GATE);
#else
    if (PH(17)) peer_topk_fused<0>(C, QP, KEYS + (size_t)8 * 2 * 128 * 128, IDX, GATE);
#endif
    GRID_BAR();
    if (PH(18)) GATHER_FN<true>(C, H, IDX, GATE, PU8 + (size_t)16384 * 1024, PV8 + (size_t)16384 * 1024, ISU + 16384, ISV + 16384, XB, nullptr, out, MOD1 + 5120, INP(float, 20), nullptr, nullptr);
#undef GRID_BAR
}

extern "C" void kernel_launch(void* const* d_in, const int* in_sizes, int n_in, void* d_out, int out_size, void* d_ws, size_t ws_size, hipStream_t stream) {
    static int grid = 0;
    if (grid == 0) {
        if (n_in != 21 || in_sizes[0] != TT * DM || out_size != TT * DM || ws_size < WS_END) { fprintf(stderr, "kernel_launch: unexpected shapes/workspace: n_in %d in0 %d out %d ws %zu (need %zu)\n", n_in, n_in > 0 ? in_sizes[0] : -1, out_size, ws_size, (size_t)WS_END); grid = -1; return; }
        int dev = 0, cus = 0;
        if (hipGetDevice(&dev) != hipSuccess || hipDeviceGetAttribute(&cus, hipDeviceAttributeMultiprocessorCount, dev) != hipSuccess) { fprintf(stderr, "kernel_launch: device query failed\n"); grid = -1; return; }
        if (hipFuncSetAttribute((const void*)mk_fwd, hipFuncAttributeMaxDynamicSharedMemorySize, LDS_BYTES) != hipSuccess) { fprintf(stderr, "kernel_launch: hipFuncSetAttribute failed\n"); grid = -1; return; }
        (void)hipGetLastError();
        grid = cus;
    }
    if (grid < 0) return;
    if (hipMemsetAsync((char*)d_ws + WS_CTL, 0, CTL_ZERO_BYTES, stream) != hipSuccess) { fprintf(stderr, "kernel_launch: memset failed\n"); return; }
    Args a; memset(&a, 0, sizeof(a));
    for (int i = 0; i < 21; ++i) a.in[i] = d_in[i];
    a.out = (float*)d_out; a.ws = (unsigned char*)d_ws;
    hipLaunchKernelGGL(mk_fwd, dim3(grid), dim3(NWAVES * 64), LDS_BYTES, stream, a);
    const hipError_t le = hipPeekAtLastError();
    if (le != hipSuccess) fprintf(stderr, "kernel_launch: launch failed: %s\n", hipGetErrorName(le));
}
```
